# Optimizing an MI355X kernel written in HIP

```python
import jax, jax.numpy as jnp
from jax import lax
import numpy as np

D_MODEL = 1024
BATCH = 2
SEQ = 8192
DEPTH = 4

N_EVEN = (DEPTH + 1) // 2
N_ODD = DEPTH // 2
EPS = 1e-6
NEG_INF = -1e30
Q_BLOCK = 128
A_HEADS = 4
A_HEAD_DIM = 128
A_CHUNK = 128
A_WIDTH = A_HEADS * A_HEAD_DIM
B_HEADS = 8
B_HEAD_DIM = 64
B_WIDTH = B_HEADS * B_HEAD_DIM
B_BRANCHES = ((128, 1), (512, 4), (2048, 16))
EVEN_IN = 2 * A_WIDTH + 3 * B_WIDTH
MIX_WIDTH = A_WIDTH + B_WIDTH
C_HEADS = 8
C_NOPE = 128
C_ROPE = 64
C_V = 128
C_Q_LORA = 512
C_KV_LORA = 256
ROPE_THETA = 10000.0
ODD_IN = C_Q_LORA + C_KV_LORA + C_ROPE
N_EXPERTS = 32
TOP_K = 4
D_EXPERT = 1024
SWIGLU_ALPHA = 1.702
SWIGLU_LIMIT = 7.0
MOE_BLOCK = 256

kernel_name = "hybrid_gmlp_dilated_mla_moe_trunk"


def rms_norm(x, g):
    xf = x.astype(jnp.float32)
    y = xf * lax.rsqrt(jnp.mean(xf * xf, axis=-1, keepdims=True) + EPS)
    return (y * g.astype(jnp.float32)).astype(x.dtype)


def rope(x, pos):
    half = x.shape[-1] // 2
    inv = ROPE_THETA ** (-jnp.arange(half, dtype=jnp.float32) / half)
    ang = pos.astype(jnp.float32)[:, None] * inv[None, :]
    cos = jnp.cos(ang)[:, None, :]
    sin = jnp.sin(ang)[:, None, :]
    xf = x.astype(jnp.float32)
    x1, x2 = xf[..., :half], xf[..., half:]
    return jnp.concatenate([x1 * cos - x2 * sin, x1 * sin + x2 * cos], axis=-1).astype(x.dtype)


def chunked_gating_mlp(u, v, w_s, b_s, g_v):
    bsz, s, h, dh = v.shape
    v = rms_norm(v, g_v)
    vc = v.reshape(bsz, s // A_CHUNK, A_CHUNK, h, dh)
    causal = jnp.tril(jnp.ones((A_CHUNK, A_CHUNK), dtype=bool))
    w = jnp.where(causal[None], w_s, 0.0)
    mixed = jnp.einsum('hts,bnshd->bnthd', w, vc) + b_s.T[None, None, :, :, None]
    return u * mixed.reshape(bsz, s, h, dh)


def dilated_window_attention(q, k, v):
    bsz, s, h, dh = q.shape
    nb = s // Q_BLOCK
    scale = dh ** -0.5
    qb = q.reshape(bsz, nb, Q_BLOCK, h, dh).swapaxes(0, 1)

    def block(args):
        q_blk, i = args
        t = i * Q_BLOCK + jnp.arange(Q_BLOCK)
        outs = []
        lses = []
        for window, dil in B_BRANCHES:
            n_keys = window // dil + 1
            pos = t[:, None] - dil * jnp.arange(n_keys)[None, :]
            valid = pos >= 0
            pos_c = jnp.maximum(pos, 0)
            kg = jnp.take(k, pos_c, axis=1)
            vg = jnp.take(v, pos_c, axis=1)
            logits = jnp.einsum('bqhd,bqkhd->bhqk', q_blk, kg).astype(jnp.float32) * scale
            logits = jnp.where(valid[None, None], logits, NEG_INF)
            lse = jax.nn.logsumexp(logits, axis=-1)
            p = jnp.exp(logits - lse[..., None])
            outs.append(jnp.einsum('bhqk,bqkhd->bqhd', p.astype(v.dtype), vg))
            lses.append(lse)
        wts = jax.nn.softmax(jnp.stack(lses, axis=0), axis=0)
        wts = wts.transpose(0, 1, 3, 2)[..., None].astype(v.dtype)
        return jnp.sum(wts * jnp.stack(outs, axis=0), axis=0)

    out = lax.map(block, (qb, jnp.arange(nb)))
    return out.swapaxes(0, 1).reshape(bsz, s, h, dh)


def causal_block_attention(q, k, v):
    bsz, s, h, dq = q.shape
    nb = s // Q_BLOCK
    scale = dq ** -0.5
    qb = q.reshape(bsz, nb, Q_BLOCK, h, dq).swapaxes(0, 1)
    kpos = jnp.arange(s)

    def block(args):
        q_blk, i = args
        qpos = i * Q_BLOCK + jnp.arange(Q_BLOCK)
        sc = jnp.einsum('bqhd,bkhd->bhqk', q_blk, k).astype(jnp.float32) * scale
        sc = jnp.where(kpos[None, :] <= qpos[:, None], sc, NEG_INF)
        p = jax.nn.softmax(sc, axis=-1)
        return jnp.einsum('bhqk,bkhd->bqhd', p.astype(v.dtype), v)

    out = lax.map(block, (qb, jnp.arange(nb)))
    return out.swapaxes(0, 1).reshape(bsz, s, h, v.shape[-1])


def even_mixer(h, w_in, w_s, b_s, g_v, g_q, g_k, w_out):
    bsz, s, _ = h.shape
    z = h @ w_in
    zu, zv, q, k, v = jnp.split(z, [A_WIDTH, 2 * A_WIDTH, 2 * A_WIDTH + B_WIDTH, 2 * A_WIDTH + 2 * B_WIDTH], axis=-1)
    u = jax.nn.gelu(zu, approximate=False).reshape(bsz, s, A_HEADS, A_HEAD_DIM)
    vv = jax.nn.gelu(zv, approximate=False).reshape(bsz, s, A_HEADS, A_HEAD_DIM)
    a_out = chunked_gating_mlp(u, vv, w_s, b_s, g_v)
    q = rms_norm(q.reshape(bsz, s, B_HEADS, B_HEAD_DIM), g_q)
    k = rms_norm(k.reshape(bsz, s, B_HEADS, B_HEAD_DIM), g_k)
    v = v.reshape(bsz, s, B_HEADS, B_HEAD_DIM)
    b_out = dilated_window_attention(q, k, v)
    mixed = jnp.concatenate([a_out.reshape(bsz, s, A_WIDTH), b_out.reshape(bsz, s, B_WIDTH)], axis=-1)
    return mixed @ w_out


def mla_mixer(h, w_in, g_cq, g_ckv, w_uq, w_ukv, g_q, g_k, w_out):
    bsz, s, _ = h.shape
    z = h @ w_in
    c_q, c_kv, k_r = jnp.split(z, [C_Q_LORA, C_Q_LORA + C_KV_LORA], axis=-1)
    c_q = rms_norm(c_q, g_cq)
    c_kv = rms_norm(c_kv, g_ckv)
    q = (c_q @ w_uq).reshape(bsz, s, C_HEADS, C_NOPE + C_ROPE)
    kv = (c_kv @ w_ukv).reshape(bsz, s, C_HEADS, C_NOPE + C_V)
    k_nope, v = kv[..., :C_NOPE], kv[..., C_NOPE:]
    k_rope = jnp.broadcast_to(k_r[:, :, None, :], (bsz, s, C_HEADS, C_ROPE))
    k = jnp.concatenate([k_nope, k_rope], axis=-1)
    q = rms_norm(q, g_q)
    k = rms_norm(k, g_k)
    pos = jnp.arange(s)
    q = jnp.concatenate([q[..., :C_NOPE], rope(q[..., C_NOPE:], pos)], axis=-1)
    k = jnp.concatenate([k[..., :C_NOPE], rope(k[..., C_NOPE:], pos)], axis=-1)
    o = causal_block_attention(q, k, v)
    return o.reshape(bsz, s, C_HEADS * C_V) @ w_out


def moe_ffn(h, w_router, b_router, w1, b1, w2, b2):
    bsz, s, d = h.shape
    x = h.reshape(-1, d)
    n_tok = x.shape[0]
    n_assign = n_tok * TOP_K
    logits = (x @ w_router + b_router).astype(jnp.float32)
    top_val, top_idx = lax.top_k(logits, TOP_K)
    gates = jax.nn.softmax(top_val, axis=-1)
    e_flat = top_idx.reshape(-1)
    tok_flat = jnp.repeat(jnp.arange(n_tok, dtype=jnp.int32), TOP_K)
    g_flat = gates.reshape(-1)
    counts = jnp.bincount(e_flat, length=N_EXPERTS)
    padded = (counts + MOE_BLOCK - 1) // MOE_BLOCK * MOE_BLOCK
    pad_end = jnp.cumsum(padded)
    pad_start = pad_end - padded
    start = jnp.cumsum(counts) - counts
    order = jnp.argsort(e_flat)
    e_sorted = e_flat[order]
    rank = jnp.arange(n_assign) - start[e_sorted]
    slot = pad_start[e_sorted] + rank
    n_blocks = -(-(n_assign + N_EXPERTS * (MOE_BLOCK - 1)) // MOE_BLOCK)
    n_rows = n_blocks * MOE_BLOCK
    row_tok = jnp.zeros((n_rows,), jnp.int32).at[slot].set(tok_flat[order])
    row_gate = jnp.zeros((n_rows,), jnp.float32).at[slot].set(g_flat[order])
    block_start = jnp.arange(n_blocks) * MOE_BLOCK
    block_expert = jnp.minimum(jnp.searchsorted(pad_end, block_start, side='right'), N_EXPERTS - 1)
    xb = x[row_tok].reshape(n_blocks, MOE_BLOCK, d)

    def expert_block(args):
        x_blk, e = args
        hid = x_blk @ w1[e] + b1[e]
        glu, lin = hid[:, ::2], hid[:, 1::2]
        glu = jnp.minimum(glu, SWIGLU_LIMIT)
        lin = jnp.clip(lin, -SWIGLU_LIMIT, SWIGLU_LIMIT)
        act = glu * jax.nn.sigmoid(SWIGLU_ALPHA * glu) * (lin + 1.0)
        return act @ w2[e] + b2[e]

    yb = lax.map(expert_block, (xb, block_expert))
    y_rows = yb.reshape(n_rows, d) * row_gate[:, None].astype(yb.dtype)
    y = jax.ops.segment_sum(y_rows, row_tok, num_segments=n_tok)
    return y.reshape(bsz, s, d)


def setup_inputs(seed: int = 0) -> dict:
    key = jax.random.key(seed)
    ks = iter(jax.random.split(key, 32))
    f32 = jnp.float32

    def nrm(shape, scale):
        return jax.random.normal(next(ks), shape, f32) * scale

    def gain(shape):
        return 1.0 + 0.05 * jax.random.normal(next(ks), shape, f32)

    return {
        'x': nrm((BATCH, SEQ, D_MODEL), 1.0),
        'mix_norm': gain((DEPTH, D_MODEL)),
        'ffn_norm': gain((DEPTH, D_MODEL)),
        'even_w_in': nrm((N_EVEN, D_MODEL, EVEN_IN), D_MODEL ** -0.5),
        'even_w_s': nrm((N_EVEN, A_HEADS, A_CHUNK, A_CHUNK), A_CHUNK ** -0.5),
        'even_b_s': gain((N_EVEN, A_HEADS, A_CHUNK)),
        'even_g_v': gain((N_EVEN, A_HEADS, A_HEAD_DIM)),
        'even_g_q': gain((N_EVEN, B_HEAD_DIM)),
        'even_g_k': gain((N_EVEN, B_HEAD_DIM)),
        'even_w_out': nrm((N_EVEN, MIX_WIDTH, D_MODEL), 0.5 * MIX_WIDTH ** -0.5),
        'odd_w_in': nrm((N_ODD, D_MODEL, ODD_IN), D_MODEL ** -0.5),
        'odd_g_cq': gain((N_ODD, C_Q_LORA)),
        'odd_g_ckv': gain((N_ODD, C_KV_LORA)),
        'odd_w_uq': nrm((N_ODD, C_Q_LORA, C_HEADS * (C_NOPE + C_ROPE)), C_Q_LORA ** -0.5),
        'odd_w_ukv': nrm((N_ODD, C_KV_LORA, C_HEADS * (C_NOPE + C_V)), C_KV_LORA ** -0.5),
        'odd_g_q': gain((N_ODD, C_NOPE + C_ROPE)),
        'odd_g_k': gain((N_ODD, C_NOPE + C_ROPE)),
        'odd_w_out': nrm((N_ODD, C_HEADS * C_V, D_MODEL), 0.5 * (C_HEADS * C_V) ** -0.5),
        'router_w': nrm((DEPTH, D_MODEL, N_EXPERTS), D_MODEL ** -0.5),
        'router_b': nrm((DEPTH, N_EXPERTS), 0.01),
        'expert_w1': nrm((DEPTH, N_EXPERTS, D_MODEL, 2 * D_EXPERT), D_MODEL ** -0.5),
        'expert_b1': nrm((DEPTH, N_EXPERTS, 2 * D_EXPERT), 0.02),
        'expert_w2': nrm((DEPTH, N_EXPERTS, D_EXPERT, D_MODEL), 0.5 * D_EXPERT ** -0.5),
        'expert_b2': nrm((DEPTH, N_EXPERTS, D_MODEL), 0.02),
    }


def reference(x, mix_norm, ffn_norm, even_w_in, even_w_s, even_b_s, even_g_v, even_g_q, even_g_k, even_w_out, odd_w_in, odd_g_cq, odd_g_ckv, odd_w_uq, odd_w_ukv, odd_g_q, odd_g_k, odd_w_out, router_w, router_b, expert_w1, expert_b1, expert_w2, expert_b2):
    for l in range(DEPTH):
        i = l // 2
        h = rms_norm(x, mix_norm[l])
        if l % 2 == 0:
            x = x + even_mixer(h, even_w_in[i], even_w_s[i], even_b_s[i], even_g_v[i], even_g_q[i], even_g_k[i], even_w_out[i])
        else:
            x = x + mla_mixer(h, odd_w_in[i], odd_g_cq[i], odd_g_ckv[i], odd_w_uq[i], odd_w_ukv[i], odd_g_q[i], odd_g_k[i], odd_w_out[i])
        h = rms_norm(x, ffn_norm[l])
        x = x + moe_ffn(h, router_w[l], router_b[l], expert_w1[l], expert_b1[l], expert_w2[l], expert_b2[l])
    return x
```

```cpp
#include <hip/hip_runtime.h>
#include <hip/hip_bf16.h>
#include <cstdio>
#include <cstdint>

#define LAS __attribute__((address_space(3)))
#define GAS __attribute__((address_space(1)))
typedef unsigned short bf16_t;
typedef short bf16x8 __attribute__((ext_vector_type(8)));
typedef short s16x4 __attribute__((ext_vector_type(4)));
typedef float f32x2 __attribute__((ext_vector_type(2)));
typedef float f32x4 __attribute__((ext_vector_type(4)));
typedef float f32x16 __attribute__((ext_vector_type(16)));
typedef unsigned u32x2 __attribute__((ext_vector_type(2)));
typedef unsigned u32x4 __attribute__((ext_vector_type(4)));

constexpr int BATCH = 2, SEQ = 8192, DM = 1024, M = BATCH * SEQ, DEPTH = 4;
constexpr int EVEN_IN = 2560, ODD_IN = 832, ODD_INP = 1024;
constexpr int NE = 32, DE = 1024, ECAP = 16384;
constexpr float EPS = 1e-6f;
constexpr float LOG2E = 1.4426950408889634f;
constexpr float C2_B = 0.125f * LOG2E;
constexpr float C2_C = 0.07216878364870322f * LOG2E;

__device__ __forceinline__ unsigned cvt_pk_bf16(float lo, float hi) { unsigned r; asm volatile("v_cvt_pk_bf16_f32 %0, %1, %2" : "=v"(r) : "v"(lo), "v"(hi)); return r; }
__device__ __forceinline__ float bf2f(bf16_t v) { return __uint_as_float(((unsigned)v) << 16); }
__device__ __forceinline__ float bflo(unsigned w) { return __uint_as_float(w << 16); }
__device__ __forceinline__ float bfhi(unsigned w) { return __uint_as_float(w & 0xffff0000u); }
__device__ __forceinline__ bf16_t f2bf(float f) { return (bf16_t)(cvt_pk_bf16(f, 0.f) & 0xffffu); }

namespace pg8 {
constexpr int BM = 256, BK = 64, HALF = 128, HTB = HALF * BK * 2, STAGE_BYTES = 8 * HTB, NXCD = 8, WGM = 8;
__host__ __device__ __forceinline__ int lds_byte(int r, int c) { const int st = (r >> 4) * 2 + (c >> 5), rr = r & 15, cc = c & 31, ob = rr * 64 + cc * 2; return st * 1024 + (ob ^ (((ob >> 9) & 1) << 5)); }
__host__ __device__ __forceinline__ void stage_rc(int b, int& R, int& C) { const int st = b / 1024, sb = b % 1024, swz = sb ^ (((sb >> 9) & 1) << 5); R = (st >> 1) * 16 + swz / 64; C = (st & 1) * 32 + (swz % 64) / 2; }
__host__ __device__ __forceinline__ int perm32(int rho) { const int n = rho >> 4, i = rho & 15; return 8 * (i >> 2) + 4 * n + (i & 3); }

struct Unit { int pm, pn, pb; };
struct Gemm { const bf16_t* A; const bf16_t* Bt; int lda, K; };

struct StaticOrder {
    int nM, nN, nwg, G, c;
    __device__ void init(int M_, int N_, int G_, int c_) { nM = M_ / BM; nN = N_ / BM; nwg = nM * nN; G = G_; c = c_; }
    __device__ bool next(int i, Unit& u) const {
        const long L = (long)i * G + c; if (L >= nwg) return false;
        int wgid = (int)L; { const int q = nwg / NXCD, r = nwg % NXCD, xcd = wgid % NXCD, off = wgid / NXCD; wgid = (xcd < r ? xcd * (q + 1) : r * (q + 1) + (xcd - r) * q) + off; }
        const int nig = WGM * nN, gid = wgid / nig, fm = gid * WGM, gsz = (nM - fm) < WGM ? (nM - fm) : WGM;
        u.pm = fm + ((wgid % nig) % gsz); u.pn = (wgid % nig) / gsz; u.pb = u.pn; return true;
    }
};

__device__ __forceinline__ f32x2 gelu_pk(f32x2 v) {
    const f32x2 av = __builtin_elementwise_abs(v), d = av * 0.2316418882f + 1.0f;
    f32x2 t; t.x = __builtin_amdgcn_rcpf(d.x); t.y = __builtin_amdgcn_rcpf(d.y);
    f32x2 q = t * 0.5307027145f + (-0.7265760135f); q = q * t + 0.7107068705f; q = q * t + (-0.142248368f); q = q * t + 0.127414796f; q = q * t;
    const f32x2 s = (v * v) * (-0.72134752044f);
    f32x2 e; e.x = __builtin_amdgcn_exp2f(s.x); e.y = __builtin_amdgcn_exp2f(s.y);
    const f32x2 m = v * (q * e), r = v - m;
    f32x2 o; o.x = v.x < 0.f ? m.x : r.x; o.y = v.y < 0.f ? m.y : r.y; return o;
}
__device__ __forceinline__ f32x4 gelu4(f32x4 v) { const f32x2 a = gelu_pk((f32x2){v[0], v[1]}), b = gelu_pk((f32x2){v[2], v[3]}); return (f32x4){a.x, a.y, b.x, b.y}; }

template <class Epi, class Sched>
__device__ __forceinline__ void gemm_phase(LAS unsigned char* lds, const Gemm g, const Sched& S, const Epi& E) {
    int tid_ = threadIdx.x; asm volatile("" : "+v"(tid_));
    const int tid = tid_, wid = __builtin_amdgcn_readfirstlane(tid >> 6), lane = tid & 63, wr = wid >> 2, wc = wid & 3, fr = lane & 15, fq = lane >> 4;
    const int K = g.K, nt = K / BK;
    unsigned voffA[2], voffB[2];
#pragma unroll
    for (int i = 0; i < 2; ++i) { int R, C; stage_rc(tid * 16 + i * 8192, R, C); const int Rb = Epi::PERM ? ((R & ~31) + perm32(R & 31)) : R;
        voffA[i] = (unsigned)(R * g.lda + C) * 2u; voffB[i] = (unsigned)(Rb * K + C) * 2u; }
    const size_t kstep = (size_t)(BK * 2);
    const size_t hstepA = (size_t)HALF * g.lda * 2, tstepA = 2 * hstepA;
    const size_t hstepB = (size_t)HALF * K * 2, tstepB = 2 * hstepB;
    const unsigned ldsw = (unsigned)wid * 1024u;
    const int aoff = lds_byte(wr * 64 + fr, fq * 8), boff = lds_byte(wc * 32 + fr, fq * 8);
#define PG8_SA(b, h) (((b) * 2 + (h)) * HTB)
#define PG8_SB(b, h) ((4 + (b) * 2 + (h)) * HTB)
#define PG8_STAGE(bufoff, gbase, voff) do { _Pragma("unroll") for (int _i = 0; _i < 2; ++_i) \
        __builtin_amdgcn_global_load_lds((const unsigned*)((const char*)(gbase) + (voff)[_i]), (LAS unsigned*)(lds + (bufoff) + ldsw + _i * 8192), 16, 0, 0); } while (0)
#define PG8_LDA(dst, b, h) do { _Pragma("unroll") for (int m = 0; m < 4; ++m) _Pragma("unroll") for (int k = 0; k < 2; ++k) dst[m][k] = *(const LAS bf16x8*)(lds + PG8_SA(b, h) + aoff + m * 2048 + k * 1024); } while (0)
#define PG8_LDB(dst, b, h) do { _Pragma("unroll") for (int n = 0; n < 2; ++n) _Pragma("unroll") for (int k = 0; k < 2; ++k) dst[n][k] = *(const LAS bf16x8*)(lds + PG8_SB(b, h) + boff + n * 2048 + k * 1024); } while (0)
#define PG8_MMA(ai, bj, At, Bt) do { __builtin_amdgcn_s_setprio(1); _Pragma("unroll") for (int m = 0; m < 4; ++m) _Pragma("unroll") for (int n = 0; n < 2; ++n) _Pragma("unroll") for (int k = 0; k < 2; ++k) \
        acc[ai][bj][m][n] = __builtin_amdgcn_mfma_f32_16x16x32_bf16(Bt[n][k], At[m][k], acc[ai][bj][m][n], 0, 0, 0); __builtin_amdgcn_s_setprio(0); } while (0)
#define PG8_WAIT_V(n) asm volatile("s_waitcnt vmcnt(" #n ")" ::: "memory")
#define PG8_WAIT_L(n) asm volatile("s_waitcnt lgkmcnt(" #n ")" ::: "memory")
#define PG8_BAR __builtin_amdgcn_s_barrier()
#define PG8_SCHED __builtin_amdgcn_sched_barrier(0)
    Unit cur, nxt; int ui = 0;
    if (!S.next(0, cur)) return;
    f32x4 acc[2][2][4][2];
#pragma unroll
    for (int a = 0; a < 2; ++a)
#pragma unroll
        for (int b = 0; b < 2; ++b)
#pragma unroll
            for (int m = 0; m < 4; ++m)
#pragma unroll
                for (int n = 0; n < 2; ++n) acc[a][b][m][n] = (f32x4){0.f, 0.f, 0.f, 0.f};
    bf16x8 At[4][2], B0[2][2], B1[2][2];
    const char* cA = (const char*)g.A + (size_t)cur.pm * tstepA; const char* cB = (const char*)g.Bt + (size_t)cur.pb * tstepB;
    PG8_STAGE(PG8_SB(0, 0), cB, voffB); PG8_STAGE(PG8_SB(0, 1), cB + hstepB, voffB); PG8_STAGE(PG8_SA(0, 0), cA, voffA); PG8_STAGE(PG8_SA(0, 1), cA + hstepA, voffA);
    if (wr == 1) PG8_BAR;
    PG8_WAIT_V(2); PG8_BAR;
    PG8_STAGE(PG8_SB(1, 0), cB + kstep, voffB); PG8_STAGE(PG8_SA(1, 0), cA + kstep, voffA); PG8_STAGE(PG8_SB(1, 1), cB + hstepB + kstep, voffB);
    PG8_WAIT_V(6); PG8_BAR;
    for (;;) {
        const bool has_next = S.next(ui + 1, nxt);
        const char* nA = has_next ? (const char*)g.A + (size_t)nxt.pm * tstepA : cA; const char* nB = has_next ? (const char*)g.Bt + (size_t)nxt.pb * tstepB : cB;
        for (int t = 0; t < nt; t += 2) {
            const bool last = (t == nt - 2);
            const char* a1 = cA + (size_t)(t + 1) * kstep;
            const char* a2 = last ? nA : cA + (size_t)(t + 2) * kstep; const char* b2 = last ? nB : cB + (size_t)(t + 2) * kstep;
            const char* a3 = a2 + kstep; const char* b3 = b2 + kstep;
            PG8_LDB(B0, 0, 0); PG8_LDB(B1, 0, 1); PG8_SCHED; PG8_LDA(At, 0, 0); PG8_STAGE(PG8_SA(1, 1), a1 + hstepA, voffA);
            PG8_WAIT_V(8); PG8_WAIT_L(0); PG8_BAR; PG8_MMA(0, 0, At, B0); PG8_MMA(0, 1, At, B1); PG8_BAR; PG8_SCHED;
            PG8_LDA(At, 0, 1); PG8_STAGE(PG8_SB(0, 0), b2, voffB); PG8_STAGE(PG8_SB(0, 1), b2 + hstepB, voffB); PG8_STAGE(PG8_SA(0, 0), a2, voffA);
            PG8_WAIT_V(8); PG8_WAIT_L(0); PG8_BAR; PG8_MMA(1, 0, At, B0); PG8_MMA(1, 1, At, B1); PG8_BAR; PG8_SCHED;
            PG8_LDB(B0, 1, 0); PG8_LDB(B1, 1, 1); PG8_SCHED; PG8_LDA(At, 1, 0); PG8_STAGE(PG8_SA(0, 1), a2 + hstepA, voffA);
            PG8_WAIT_V(8); PG8_WAIT_L(0); PG8_BAR; PG8_MMA(0, 0, At, B0); PG8_MMA(0, 1, At, B1); PG8_BAR; PG8_SCHED;
            PG8_LDA(At, 1, 1); PG8_STAGE(PG8_SB(1, 0), b3, voffB); PG8_STAGE(PG8_SB(1, 1), b3 + hstepB, voffB); PG8_STAGE(PG8_SA(1, 0), a3, voffA);
            PG8_WAIT_V(8); PG8_WAIT_L(0); PG8_BAR; PG8_MMA(1, 0, At, B0); PG8_MMA(1, 1, At, B1); PG8_BAR; PG8_SCHED;
        }
        if (wr == 0) PG8_BAR;
        { int te_ = threadIdx.x; asm volatile("" : "+v"(te_));
          E(acc, cur, wr, wc, te_ & 15, (te_ & 63) >> 4); }
        if (!has_next) break;
#pragma unroll
        for (int a = 0; a < 2; ++a)
#pragma unroll
            for (int b = 0; b < 2; ++b)
#pragma unroll
                for (int m = 0; m < 4; ++m)
#pragma unroll
                    for (int n = 0; n < 2; ++n) acc[a][b][m][n] = (f32x4){0.f, 0.f, 0.f, 0.f};
        cur = nxt; cA = nA; cB = nB; ++ui;
        if (wr == 1) PG8_BAR;
    }
    PG8_WAIT_V(0);
    PG8_BAR;
#undef PG8_SA
#undef PG8_SB
#undef PG8_STAGE
#undef PG8_LDA
#undef PG8_LDB
#undef PG8_MMA
#undef PG8_WAIT_V
#undef PG8_WAIT_L
#undef PG8_BAR
#undef PG8_SCHED
}
}
constexpr int STAGE_LIMIT = 8;

namespace att {
__device__ __forceinline__ int crow(int r, int hi) { return (r & 3) + 8 * (r >> 2) + 4 * hi; }
__device__ __forceinline__ int v_rd_base(int lane) { return ((lane & 3) << 3) | (((lane >> 2) & 3) << 6) | (((lane >> 4) & 1) << 5) | (((lane >> 5) & 1) << 8); }
constexpr int LUTN = 2052;

template <int DQK, int DV, int MODE>
struct Cfg {
    static constexpr int KP = DQK * 2 + 16;
    static constexpr int KB = 64 * KP, VB = 64 * DV * 2;
    static constexpr int OFF_K = 0, OFF_V = 2 * KB, OFF_WS = 2 * KB + 2 * VB, OFF_LUT = OFF_WS + 8 * 256, BYTES = OFF_LUT + (MODE == 1 ? LUTN * 4 : 0);
    static constexpr int CPR = KP / 16;
    static constexpr int NKP = KB / 1024, KPW = (NKP + 7) / 8;
    static constexpr int NVP = VB / 1024, VPW = NVP / 8;
    static_assert(KB % 1024 == 0 && NVP % 8 == 0, "tile images are whole DMA pieces");
};

template <int DQK, int DV, int MODE>
__device__ __forceinline__ void attn_unit(const bf16_t* __restrict__ Qh, int qp, const bf16_t* __restrict__ Kh, int kp, const bf16_t* __restrict__ Vh, int vp,
                                          bf16_t* __restrict__ Oh, int op, int q0, LAS unsigned char* lds) {
    typedef Cfg<DQK, DV, MODE> C;
    constexpr int NCB = DV / 32;
    int tid_ = threadIdx.x; asm volatile("" : "+v"(tid_));
    const int tid = tid_, wid = __builtin_amdgcn_readfirstlane(tid >> 6), lane = tid & 63, r32 = lane & 31, hi = lane >> 5;
    const int qlo = q0 + wid * 32, qpos = qlo + r32;
    LAS float* wsf = (LAS float*)(lds + C::OFF_WS) + wid * 64;
    const LAS float* lut = (const LAS float*)(lds + C::OFF_LUT);
    int j_lo = 0; if (MODE == 1) { const int lo = q0 - 2048; j_lo = lo > 0 ? lo / 64 : 0; }
    const int j_hi = (q0 + 256) / 64, NT = j_hi - j_lo;
    unsigned kso[C::KPW], vso[C::VPW];
#pragma unroll
    for (int i = 0; i < C::KPW; ++i) { const int c = (wid + 8 * i) * 64 + lane, row = c / C::CPR; int cc = c % C::CPR; if (cc > C::CPR - 2) cc = C::CPR - 2;
        kso[i] = (unsigned)((row & 63) * kp + cc * 8); }
#pragma unroll
    for (int i = 0; i < C::VPW; ++i) { const int off = ((wid + 8 * i) * 64 + lane) * 16, st = off >> 9, within = off & 511, kk = (st / NCB) * 8 + (within >> 6);
        const int k = (kk & ~0xC) | ((kk & 4) << 1) | ((kk & 8) >> 1), col = (st % NCB) * 32 + ((within & 63) >> 1);
        vso[i] = (unsigned)(k * vp + col); }
#define ATT_DMA(j, bf) do { const bf16_t* kt_ = Kh + (size_t)(j) * 64 * kp; const bf16_t* vt_ = Vh + (size_t)(j) * 64 * vp; \
        _Pragma("unroll") for (int i = 0; i < C::KPW; ++i) if (wid + 8 * i < C::NKP) \
            __builtin_amdgcn_global_load_lds((const unsigned*)(kt_ + kso[i]), (LAS unsigned*)(lds + C::OFF_K + (bf) * C::KB + (wid + 8 * i) * 1024), 16, 0, 0); \
        _Pragma("unroll") for (int i = 0; i < C::VPW; ++i) \
            __builtin_amdgcn_global_load_lds((const unsigned*)(vt_ + vso[i]), (LAS unsigned*)(lds + C::OFF_V + (bf) * C::VB + (wid + 8 * i) * 1024), 16, 0, 0); } while (0)
    ATT_DMA(j_lo, 0);
    bf16x8 qr[DQK / 16];
#pragma unroll
    for (int d0 = 0; d0 < DQK / 16; ++d0) qr[d0] = *(const bf16x8*)(Qh + (size_t)qpos * qp + d0 * 16 + hi * 8);
    float m_reg = -1e30f, l_reg = 0.f;
    f32x16 o[NCB];
#pragma unroll
    for (int d = 0; d < NCB; ++d) o[d] = f32x16{};
    const int koff = r32 * C::KP + hi * 16;
    const unsigned vb0 = (unsigned)(uintptr_t)(lds + C::OFF_V) + (unsigned)v_rd_base(lane);
    asm volatile("s_waitcnt vmcnt(0)" ::: "memory");
    __syncthreads();
    for (int t = 0; t < NT; ++t) {
        const int buf = t & 1;
        if (t + 1 < NT) ATT_DMA(j_lo + t + 1, buf ^ 1);
        const int kb = (j_lo + t) * 64;
#pragma unroll
        for (int hf = 0; hf < 2; ++hf) {
            const int kb2 = kb + 32 * hf;
            bool act = kb2 <= qlo + 31;
            if (MODE == 1) act = act && (qlo - kb2 - 31 <= 2048);
            if (act) {
                f32x16 p = f32x16{};
                const LAS unsigned char* kbase = lds + C::OFF_K + buf * C::KB + hf * 32 * C::KP + koff;
#pragma unroll
                for (int d0 = 0; d0 < DQK / 16; ++d0) {
                    const bf16x8 b0 = *(const LAS bf16x8*)(kbase + d0 * 32);
                    p = __builtin_amdgcn_mfma_f32_32x32x16_bf16(b0, qr[d0], p, 0, 0, 0);
                    if ((d0 & 3) == 3) __builtin_amdgcn_sched_barrier(0);
                }
                const int dq = qpos - kb2 - 4 * hi;
                if (MODE == 0) {
                    if (kb2 + 31 > qlo) {
                        const float NEG = -__builtin_inff();
#pragma unroll
                        for (int r = 0; r < 16; ++r) { const int c = (r & 3) + 8 * (r >> 2); if (dq - c < 0) p[r] = NEG; }
                    }
                } else {
#pragma unroll
                    for (int r = 0; r < 16; ++r) { const int c = (r & 3) + 8 * (r >> 2);
                        unsigned i0 = (unsigned)(dq - c); i0 = i0 < 2049u ? i0 : 2049u; p[r] += lut[i0]; }
                }
                float pmax = p[0];
#pragma unroll
                for (int r = 1; r < 16; ++r) pmax = fmaxf(pmax, p[r]);
                { auto rr = __builtin_amdgcn_permlane32_swap(__float_as_uint(pmax), __float_as_uint(pmax), false, false);
                  pmax = fmaxf(__uint_as_float(rr[0]), __uint_as_float(rr[1])); }
                const float mn = fmaxf(m_reg, pmax);
                const float alpha = __builtin_amdgcn_exp2f(m_reg - mn);
                m_reg = mn;
                float ps = 0.f;
#pragma unroll
                for (int r = 0; r < 16; ++r) { p[r] = __builtin_amdgcn_exp2f(p[r] - mn); ps += p[r]; }
                { auto rr = __builtin_amdgcn_permlane32_swap(__float_as_uint(ps), __float_as_uint(ps), false, false);
                  ps = __uint_as_float(rr[0]) + __uint_as_float(rr[1]); }
                l_reg = l_reg * alpha + ps;
                bf16x8 pa0, pa1;
#define ATT_PK4(P, B_, OUT) do { unsigned a0 = cvt_pk_bf16(P[B_+0], P[B_+1]), a1 = cvt_pk_bf16(P[B_+2], P[B_+3]);                          \
                unsigned b0_ = cvt_pk_bf16(P[B_+4], P[B_+5]), b1_ = cvt_pk_bf16(P[B_+6], P[B_+7]);                                             \
                auto r0 = __builtin_amdgcn_permlane32_swap(a0, b0_, false, false); auto r1 = __builtin_amdgcn_permlane32_swap(a1, b1_, false, false); \
                u32x4 w = {r0[0], r1[0], r0[1], r1[1]}; OUT = __builtin_bit_cast(bf16x8, w); } while (0)
                ATT_PK4(p, 0, pa0); ATT_PK4(p, 8, pa1);
#undef ATT_PK4
                if (__any(alpha < 1.f)) {
                    if (hi == 0) wsf[r32] = alpha;
                    asm volatile("s_waitcnt lgkmcnt(0)" ::: "memory");
#pragma unroll
                    for (int r = 0; r < 16; ++r) { const float a = wsf[crow(r, hi)];
#pragma unroll
                        for (int d = 0; d < NCB; ++d) o[d][r] *= a; }
                }
                const unsigned vb = vb0 + (unsigned)(buf * C::VB);
                constexpr int KS = NCB * 1024, HF = NCB * 512;
#pragma unroll
                for (int d0 = 0; d0 < NCB; ++d0) {
                    s16x4 l0, l1, h0, h1;
#define ATT_TRRD(dst, off) asm volatile("ds_read_b64_tr_b16 %0, %1 offset:%2" : "=&v"(dst) : "v"(vb), "i"(off) : "memory")
                    if (hf == 0) { ATT_TRRD(l0, d0 * 512 + 0 * KS); ATT_TRRD(h0, d0 * 512 + 0 * KS + HF); ATT_TRRD(l1, d0 * 512 + 1 * KS); ATT_TRRD(h1, d0 * 512 + 1 * KS + HF); }
                    else         { ATT_TRRD(l0, d0 * 512 + 2 * KS); ATT_TRRD(h0, d0 * 512 + 2 * KS + HF); ATT_TRRD(l1, d0 * 512 + 3 * KS); ATT_TRRD(h1, d0 * 512 + 3 * KS + HF); }
#undef ATT_TRRD
                    asm volatile("s_waitcnt lgkmcnt(0)" ::: "memory"); __builtin_amdgcn_sched_barrier(0);
                    o[d0] = __builtin_amdgcn_mfma_f32_32x32x16_bf16(pa0, (bf16x8){l0[0], l0[1], l0[2], l0[3], h0[0], h0[1], h0[2], h0[3]}, o[d0], 0, 0, 0);
                    o[d0] = __builtin_amdgcn_mfma_f32_32x32x16_bf16(pa1, (bf16x8){l1[0], l1[1], l1[2], l1[3], h1[0], h1[1], h1[2], h1[3]}, o[d0], 0, 0, 0);
                }
            }
        }
        asm volatile("s_waitcnt vmcnt(0)" ::: "memory");
        __syncthreads();
    }
#undef ATT_DMA
    if (hi == 0) wsf[32 + r32] = l_reg;
    asm volatile("s_waitcnt lgkmcnt(0)" ::: "memory");
    bf16_t* Ow = Oh + (size_t)qlo * op;
#pragma unroll
    for (int r = 0; r < 16; ++r) { const int orow = crow(r, hi); const float rl = __builtin_amdgcn_rcpf(wsf[32 + orow]);
#pragma unroll
        for (int d0 = 0; d0 < NCB; ++d0) { const float v = o[d0][r] * rl; const float vn = __shfl_xor(v, 1);
            if ((r32 & 1) == 0) *(unsigned*)(Ow + (size_t)orow * op + d0 * 32 + r32) = cvt_pk_bf16(v, vn); } }
    __syncthreads();
}
}

constexpr int NWAVES = 8;
constexpr size_t MiB = 1u << 20;
constexpr size_t WS_CTL = 0, CTL_ZERO_BYTES = 1 * MiB;
constexpr size_t WS_WEIN = 2 * MiB;
constexpr size_t WS_WEOUT = 12 * MiB;
constexpr size_t WS_WOIN = 16 * MiB;
constexpr size_t WS_WUQ = 20 * MiB;
constexpr size_t WS_WUKV = 23 * MiB;
constexpr size_t WS_WOOUT = 25 * MiB;
constexpr size_t WS_B1P = 29 * MiB;
constexpr size_t WS_SSQ = 30 * MiB;
constexpr size_t WS_TOKER = 31 * MiB;
constexpr size_t WS_TOKG = 31 * MiB + 512 * 1024;
constexpr size_t WS_XN = 32 * MiB;
constexpr size_t WS_Z = 64 * MiB;
constexpr size_t WS_MIX = 144 * MiB;
constexpr size_t WS_QR = 176 * MiB;
constexpr size_t WS_KVR = 224 * MiB;
constexpr size_t WS_QF = 288 * MiB;
constexpr size_t WS_KF = 336 * MiB;
constexpr size_t WS_W1 = 384 * MiB;
constexpr size_t WS_W2 = 896 * MiB;
constexpr size_t WS_XG = 1152 * MiB;
constexpr size_t WS_ACT = 2176 * MiB;
constexpr size_t WS_END = 3200 * MiB;
constexpr int CW_TMO = 0, CW_CODE = 1, CW_BAR = 4096, CW_CNT = 16384;
constexpr int RING_OFF = 0, RING_BYTES = 131072;
constexpr int LDSCTL_OFF = RING_BYTES, MISC_OFF = LDSCTL_OFF + 320;
constexpr int SCR_OFF = RING_BYTES + 1024;
constexpr int LDS_BYTES = 155648;
constexpr int SCR_BYTES = LDS_BYTES - SCR_OFF;

typedef GAS unsigned gu32;
#define RLX_AGENT __ATOMIC_RELAXED, __HIP_MEMORY_SCOPE_AGENT

#define XB_TMO      128
#define XB_XCNT(j)  (256  + 64 * (j))
#define XB_XSUB(j)  (1280 + 64 * (j))
#define XB_XGEN(j)  (2304 + 64 * (j))
#define XB_TOP      3328
#define XB_TOPGEN   3392
#define XCD_BAR_WORDS 3456
#define XB_SPIN_CAP (1u << 18)
__device__ __forceinline__ unsigned xb_ld(unsigned* p)              { return __hip_atomic_load(p, __ATOMIC_RELAXED, __HIP_MEMORY_SCOPE_AGENT); }
__device__ __forceinline__ unsigned xb_add(unsigned* p, unsigned v) { return __hip_atomic_fetch_add(p, v, __ATOMIC_RELAXED, __HIP_MEMORY_SCOPE_AGENT); }
__device__ __forceinline__ unsigned xb_xcc_id() { return (unsigned)__builtin_amdgcn_s_getreg((3 << 11) | 20) & 0xFu; }
#define XB_SPIN(cond, bar) do { unsigned _sp = 0; while (cond) { __builtin_amdgcn_s_sleep(1); \
    if ((++_sp & 255u) == 0u) { if (xb_ld(&(bar)[XB_TMO])) break; if (_sp > XB_SPIN_CAP) { atomicAdd(&(bar)[XB_TMO], 1u); break; } } } } while (0)
struct XcdBarrier { unsigned* bar; unsigned x; volatile LAS unsigned* st; };
__device__ __forceinline__ XcdBarrier xcd_barrier_post(unsigned* bar, volatile LAS unsigned* st) {
    XcdBarrier b; b.bar = bar; b.x = xb_xcc_id(); b.st = st;
    if (threadIdx.x == 0) (void)xb_add(&bar[XB_XCNT(b.x)], 1u);
    return b;
}
__device__ __forceinline__ void xcd_barrier_complete(unsigned* bar, unsigned x, unsigned& nloc, unsigned& nx) {
    const unsigned G = gridDim.x * gridDim.y * gridDim.z;
    unsigned sum, cnt, mine, sp = 0u;
    for (;;) {
        sum = 0u; cnt = 0u; mine = 0u;
#pragma unroll
        for (unsigned j = 0; j < 16; ++j) { const unsigned c = xb_ld(&bar[XB_XCNT(j)]); sum += c; cnt += (c > 0u) ? 1u : 0u; mine = (j == x) ? c : mine; }
        if (sum == G) break;
        __builtin_amdgcn_s_sleep(1);
        if ((++sp & 255u) == 0u) { if (xb_ld(&bar[XB_TMO])) break; if (sp > XB_SPIN_CAP) { atomicAdd(&bar[XB_TMO], 1u); break; } }
    }
    nloc = mine > 0u ? mine : 1u; nx = cnt > 0u ? cnt : 1u;
}
__device__ __forceinline__ void xcd_barrier(const XcdBarrier& b) {
    asm volatile("s_waitcnt vmcnt(0)" ::: "memory");
    __syncthreads();
    if (threadIdx.x == 0) {
        unsigned* bar = b.bar;
        __builtin_amdgcn_s_waitcnt(0);
        unsigned nloc = b.st[0], nx = b.st[1];
        if (nloc == 0u) { xcd_barrier_complete(bar, b.x, nloc, nx); b.st[0] = nloc; b.st[1] = nx; }
        const unsigned old = xb_add(&bar[XB_XSUB(b.x)], 1u);
        const unsigned gen = old / nloc;
        if (old + 1u == (gen + 1u) * nloc) {
            __builtin_amdgcn_fence(__ATOMIC_RELEASE, "agent");
            asm volatile("s_waitcnt vmcnt(0)" ::: "memory");
            const unsigned og = xb_add(&bar[XB_TOP], 1u);
            const unsigned tg = og / nx;
            if (og + 1u == (tg + 1u) * nx) xb_add(&bar[XB_TOPGEN], 1u);
            else XB_SPIN(xb_ld(&bar[XB_TOPGEN]) == tg, bar);
            __builtin_amdgcn_fence(__ATOMIC_ACQUIRE, "agent");
            xb_add(&bar[XB_XGEN(b.x)], 1u);
            asm volatile("s_waitcnt vmcnt(0)" ::: "memory");
        } else {
            XB_SPIN(xb_ld(&bar[XB_XGEN(b.x)]) == gen, bar);
            __builtin_amdgcn_fence(__ATOMIC_ACQUIRE, "agent");
            asm volatile("s_waitcnt vmcnt(0)" ::: "memory");
        }
    }
    __syncthreads();
}

struct Args {
    const float* in[24]; float* out; unsigned char* ws; int stage_limit; int pad;
};
enum { I_X = 0, I_MIXN, I_FFNN, I_EWIN, I_EWS, I_EBS, I_EGV, I_EGQ, I_EGK, I_EWOUT, I_OWIN, I_OGCQ, I_OGCKV, I_OWUQ, I_OWUKV, I_OGQ, I_OGK, I_OWOUT,
       I_RW, I_RB, I_W1, I_B1, I_W2, I_B2 };

struct Frame {
    LAS unsigned char* lds;
    int vcu, G;
};

__device__ __forceinline__ float wave_sum(float v) {
#pragma unroll
    for (int o = 1; o < 64; o <<= 1) v += __shfl_xor(v, o);
    return v;
}
#define LDS_WAIT() asm volatile("s_waitcnt lgkmcnt(0)" ::: "memory")

template <int MODE> __device__ __forceinline__ int dst_row(int o) {
    if (MODE == 1) { if (o >= 1024 && o < 2048) return (o & ~255) | (((o >> 5) & 1) << 7) | (((o >> 6) & 3) << 5) | (o & 31); return o; }
    if (MODE == 2) return ((o >> 8) << 8) | ((o & 1) << 7) | ((o & 255) >> 1);
    return o;
}
template <int MODE>
__device__ __forceinline__ void transpose_item(const float* __restrict__ W, int K, int N, bf16_t* __restrict__ WT, const float* __restrict__ gain, LAS float* scr, int item, int lane) {
    const int nblk = N / 32, kb = item / nblk, nb = item % nblk, k0 = 64 * kb, n0 = 32 * nb;
#pragma unroll 8
    for (int i = 0; i < 32; ++i) { const int kk = 2 * i + (lane >> 5); float w = W[(size_t)(k0 + kk) * N + n0 + (lane & 31)]; if (gain) w *= gain[k0 + kk]; scr[kk * 33 + (lane & 31)] = w; }
    LDS_WAIT(); asm volatile("" ::: "memory");
    const int c = lane & 7;
#pragma unroll
    for (int j = 0; j < 4; ++j) { const int n = (lane >> 3) + 8 * j; const LAS float* s = scr + (8 * c) * 33 + n;
        u32x4 o; o.x = cvt_pk_bf16(s[0 * 33], s[1 * 33]); o.y = cvt_pk_bf16(s[2 * 33], s[3 * 33]); o.z = cvt_pk_bf16(s[4 * 33], s[5 * 33]); o.w = cvt_pk_bf16(s[6 * 33], s[7 * 33]);
        *(u32x4*)(WT + (size_t)dst_row<MODE>(n0 + n) * K + k0 + 8 * c) = o; }
    LDS_WAIT(); asm volatile("" ::: "memory");
}
template <int MODE>
__device__ __forceinline__ void transpose_job(Frame& F, const float* W, int K, int N, int nmat, size_t src_stride, bf16_t* WT, size_t dst_stride, const float* gain, int gain_stride) {
    int tid_ = threadIdx.x; asm volatile("" : "+v"(tid_));
    const int wave = __builtin_amdgcn_readfirstlane(tid_ >> 6), lane = tid_ & 63;
    LAS float* scr = (LAS float*)(F.lds + RING_OFF + wave * 16384);
    const int gw = F.vcu * NWAVES + wave, NGW = F.G * NWAVES;
    const int per = (K / 64) * (N / 32), total = per * nmat;
    for (int it = gw; it < total; it += NGW) { const int mi = it / per, item = it - mi * per;
        transpose_item<MODE>(W + (size_t)mi * src_stride, K, N, WT + (size_t)mi * dst_stride, gain ? gain + (size_t)mi * gain_stride : nullptr, scr, item, lane); }
}

__device__ __forceinline__ void rms_row_to_bf16(int lane, const float* xrow, const float* g, bf16_t* orow, float* copy) {
    const f32x4* xr = (const f32x4*)xrow + lane; const f32x4* gr = (const f32x4*)g + lane;
    f32x4 v[4]; float s = 0.f;
#pragma unroll
    for (int j = 0; j < 4; ++j) { v[j] = xr[64 * j]; s += (v[j].x * v[j].x + v[j].y * v[j].y) + (v[j].z * v[j].z + v[j].w * v[j].w); }
    const float rstd = 1.0f / sqrtf(wave_sum(s) * (1.f / DM) + EPS);
    u32x2* o8 = (u32x2*)orow + lane;
#pragma unroll
    for (int j = 0; j < 4; ++j) { const f32x4 gg = gr[64 * j]; if (copy) ((f32x4*)copy + lane)[64 * j] = v[j];
        u32x2 w; w.x = cvt_pk_bf16(v[j].x * rstd * gg.x, v[j].y * rstd * gg.y); w.y = cvt_pk_bf16(v[j].z * rstd * gg.z, v[j].w * rstd * gg.w); o8[64 * j] = w; }
}

namespace pg8 {
struct EpiEvenIn {
    static constexpr bool PERM = false;
    bf16_t* Z; const float* gq; const float* gk;
    __device__ __forceinline__ void operator()(const f32x4 (&acc)[2][2][4][2], const Unit& u, int wr, int wc, int fr, int fq) const {
        const int row0 = u.pm * BM + wr * 64 + fr, pn = u.pn;
        if (pn >= 4 && pn < 8) {
            const float* g = pn < 6 ? gq : gk; const float sc = pn < 6 ? C2_B : 1.0f;
            f32x4 gv[2][2];
#pragma unroll
            for (int bj = 0; bj < 2; ++bj)
#pragma unroll
                for (int n = 0; n < 2; ++n) gv[bj][n] = *(const f32x4*)(g + 32 * bj + 16 * n + 4 * fq);
#pragma unroll
            for (int ai = 0; ai < 2; ++ai)
#pragma unroll
                for (int m = 0; m < 4; ++m) {
                    float ss = 0.f;
#pragma unroll
                    for (int bj = 0; bj < 2; ++bj)
#pragma unroll
                        for (int n = 0; n < 2; ++n) { const f32x4 v = acc[ai][bj][m][n]; ss += (v[0] * v[0] + v[1] * v[1]) + (v[2] * v[2] + v[3] * v[3]); }
                    ss += __shfl_xor(ss, 16); ss += __shfl_xor(ss, 32);
                    const float rstd = sc / sqrtf(ss * (1.0f / 64.0f) + EPS);
                    bf16_t* rowp = Z + (size_t)(row0 + ai * HALF + m * 16) * EVEN_IN + pn * BM + wc * 64 + 4 * fq;
#pragma unroll
                    for (int bj = 0; bj < 2; ++bj)
#pragma unroll
                        for (int n = 0; n < 2; ++n) { const f32x4 v = acc[ai][bj][m][n] * rstd * gv[bj][n];
                            u32x2 w; w.x = cvt_pk_bf16(v[0], v[1]); w.y = cvt_pk_bf16(v[2], v[3]); *(u32x2*)(rowp + 32 * bj + 16 * n) = w; }
                }
        } else {
            const bool act = pn < 4;
#pragma unroll
            for (int ai = 0; ai < 2; ++ai)
#pragma unroll
                for (int m = 0; m < 4; ++m) { bf16_t* rowp = Z + (size_t)(row0 + ai * HALF + m * 16) * EVEN_IN + pn * BM + wc * 32 + 4 * fq;
#pragma unroll
                    for (int bj = 0; bj < 2; ++bj)
#pragma unroll
                        for (int n = 0; n < 2; ++n) { f32x4 v = acc[ai][bj][m][n]; if (act) v = gelu4(v);
                            u32x2 w; w.x = cvt_pk_bf16(v[0], v[1]); w.y = cvt_pk_bf16(v[2], v[3]); *(u32x2*)(rowp + bj * HALF + 16 * n) = w; } }
        }
    }
};
struct EpiResid {
    static constexpr bool PERM = false;
    float* out;
    __device__ __forceinline__ void operator()(const f32x4 (&acc)[2][2][4][2], const Unit& u, int wr, int wc, int fr, int fq) const {
        const int row0 = u.pm * BM + wr * 64 + fr;
#pragma unroll
        for (int ai = 0; ai < 2; ++ai)
#pragma unroll
            for (int m = 0; m < 4; ++m) { float* rowp = out + (size_t)(row0 + ai * HALF + m * 16) * DM + u.pn * BM + wc * 32 + 4 * fq;
#pragma unroll
                for (int bj = 0; bj < 2; ++bj)
#pragma unroll
                    for (int n = 0; n < 2; ++n) { f32x4* p = (f32x4*)(rowp + bj * HALF + 16 * n); *p = *p + acc[ai][bj][m][n]; }
                if (m & 1) asm volatile("" ::: "memory"); }
    }
};
struct EpiOddIn {
    static constexpr bool PERM = false;
    bf16_t* Z; float* ssq;
    __device__ __forceinline__ void operator()(const f32x4 (&acc)[2][2][4][2], const Unit& u, int wr, int wc, int fr, int fq) const {
        const int row0 = u.pm * BM + wr * 64 + fr, pn = u.pn;
#pragma unroll
        for (int ai = 0; ai < 2; ++ai)
#pragma unroll
            for (int m = 0; m < 4; ++m) { const int row = row0 + ai * HALF + m * 16; bf16_t* rowp = Z + (size_t)row * ODD_INP + pn * BM + wc * 32 + 4 * fq;
                float ss = 0.f;
#pragma unroll
                for (int bj = 0; bj < 2; ++bj)
#pragma unroll
                    for (int n = 0; n < 2; ++n) { const f32x4 v = acc[ai][bj][m][n]; ss += (v[0] * v[0] + v[1] * v[1]) + (v[2] * v[2] + v[3] * v[3]);
                        u32x2 w; w.x = cvt_pk_bf16(v[0], v[1]); w.y = cvt_pk_bf16(v[2], v[3]); *(u32x2*)(rowp + bj * HALF + 16 * n) = w; }
                ss += __shfl_xor(ss, 16); ss += __shfl_xor(ss, 32);
                if (fq == 0) ssq[(size_t)row * 16 + pn * 4 + wc] = ss; }
    }
};
template <int NS> struct EpiRowScale {
    static constexpr bool PERM = true;
    bf16_t* O; int ldc; const float* ssq; int s0; float inv_cols;
    __device__ __forceinline__ void operator()(const f32x4 (&acc)[2][2][4][2], const Unit& u, int wr, int wc, int fr, int fq) const {
        const int row0 = u.pm * BM + wr * 64 + fr; const int col0 = u.pn * BM + wc * 32 + 8 * fq;
#pragma unroll
        for (int ai = 0; ai < 2; ++ai)
#pragma unroll
            for (int m = 0; m < 4; ++m) { const int row = row0 + ai * HALF + m * 16;
                float ss = 0.f; const f32x4* sp = (const f32x4*)(ssq + (size_t)row * 16 + s0);
#pragma unroll
                for (int q = 0; q < NS; ++q) { const f32x4 t = sp[q]; ss += (t[0] + t[1]) + (t[2] + t[3]); }
                const float rstd = 1.0f / sqrtf(ss * inv_cols + EPS);
                bf16_t* rowp = O + (size_t)row * ldc + col0;
#pragma unroll
                for (int bj = 0; bj < 2; ++bj) { const f32x4 v0 = acc[ai][bj][m][0] * rstd, v1 = acc[ai][bj][m][1] * rstd;
                    u32x4 w; w.x = cvt_pk_bf16(v0[0], v0[1]); w.y = cvt_pk_bf16(v0[2], v0[3]); w.z = cvt_pk_bf16(v1[0], v1[1]); w.w = cvt_pk_bf16(v1[2], v1[3]);
                    *(u32x4*)(rowp + bj * HALF) = w; }
                asm volatile("" ::: "memory"); }
    }
};
struct EpiSwiglu {
    static constexpr bool PERM = true;
    bf16_t* ACT; const float* b1p;
    __device__ __forceinline__ void operator()(const f32x4 (&acc)[2][2][4][2], const Unit& u, int wr, int wc, int fr, int fq) const {
        const int row0 = u.pm * BM + wr * 64 + fr, e = u.pb >> 3, pn = u.pn;
        const float* bp = b1p + (size_t)e * 2048 + pn * BM + wc * 32 + 8 * fq;
        f32x4 bg[2], bl[2];
#pragma unroll
        for (int n = 0; n < 2; ++n) { bg[n] = *(const f32x4*)(bp + 4 * n); bl[n] = *(const f32x4*)(bp + HALF + 4 * n); }
#pragma unroll
        for (int ai = 0; ai < 2; ++ai)
#pragma unroll
            for (int m = 0; m < 4; ++m) { bf16_t* rowp = ACT + (size_t)(row0 + ai * HALF + m * 16) * DE + pn * HALF + wc * 32 + 8 * fq;
                float a[8];
#pragma unroll
                for (int n = 0; n < 2; ++n) { const f32x4 gv = acc[ai][0][m][n] + bg[n], lv = acc[ai][1][m][n] + bl[n];
#pragma unroll
                    for (int i = 0; i < 4; ++i) { const float gl = fminf(gv[i], 7.0f), li = fminf(fmaxf(lv[i], -7.0f), 7.0f);
                        const float sg = __builtin_amdgcn_rcpf(1.0f + __builtin_amdgcn_exp2f(-1.702f * LOG2E * gl));
                        a[4 * n + i] = gl * sg * (li + 1.0f); } }
                u32x4 w; w.x = cvt_pk_bf16(a[0], a[1]); w.y = cvt_pk_bf16(a[2], a[3]); w.z = cvt_pk_bf16(a[4], a[5]); w.w = cvt_pk_bf16(a[6], a[7]);
                *(u32x4*)rowp = w; }
    }
};
struct EpiDown {
    static constexpr bool PERM = true;
    bf16_t* Y; const float* b2;
    __device__ __forceinline__ void operator()(const f32x4 (&acc)[2][2][4][2], const Unit& u, int wr, int wc, int fr, int fq) const {
        const int row0 = u.pm * BM + wr * 64 + fr, e = u.pb >> 2, pn = u.pn;
        const float* bp = b2 + (size_t)e * DM + pn * BM + wc * 32 + 8 * fq;
        f32x4 bv[2][2];
#pragma unroll
        for (int bj = 0; bj < 2; ++bj)
#pragma unroll
            for (int n = 0; n < 2; ++n) bv[bj][n] = *(const f32x4*)(bp + bj * HALF + 4 * n);
#pragma unroll
        for (int ai = 0; ai < 2; ++ai)
#pragma unroll
            for (int m = 0; m < 4; ++m) { bf16_t* rowp = Y + (size_t)(row0 + ai * HALF + m * 16) * DM + pn * BM + wc * 32 + 8 * fq;
#pragma unroll
                for (int bj = 0; bj < 2; ++bj) { const f32x4 v0 = acc[ai][bj][m][0] + bv[bj][0], v1 = acc[ai][bj][m][1] + bv[bj][1];
                    u32x4 w; w.x = cvt_pk_bf16(v0[0], v0[1]); w.y = cvt_pk_bf16(v0[2], v0[3]); w.z = cvt_pk_bf16(v1[0], v1[1]); w.w = cvt_pk_bf16(v1[2], v1[3]);
                    *(u32x4*)(rowp + bj * HALF) = w; } }
    }
};
struct MoeOrder {
    const LAS int* tbl; int nN, G, c;
    __device__ bool next(int i, Unit& u) const {
        const long L = (long)i * G + c; const int rb = (int)(L / nN);
        if (rb >= tbl[32]) return false;
        int e = 0;
#pragma unroll
        for (int k = 1; k < 32; ++k) e += (tbl[k] <= rb) ? 1 : 0;
        u.pm = e * (ECAP / BM) + (rb - tbl[e]); u.pn = (int)(L % nN); u.pb = e * nN + u.pn; return true;
    }
};
}

__device__ __forceinline__ void gmlp_unit(Frame& F, const bf16_t* Z, bf16_t* MIX, const float* Ws, const float* bs, const float* gv, int unit) {
    constexpr int VP = 272;
    LAS unsigned char* VT = F.lds + RING_OFF;
    const int h = unit & 3, chunk = unit >> 2;
    int tid_ = threadIdx.x; asm volatile("" : "+v"(tid_));
    const int t0 = chunk * 128, tid = tid_, lane = tid & 63, w = __builtin_amdgcn_readfirstlane(tid >> 6);
    {
        const int s = tid >> 2, dq = (tid & 3) * 32;
        const bf16_t* vp = Z + (size_t)(t0 + s) * EVEN_IN + 512 + h * 128 + dq;
        u32x4 raw[4]; float ss = 0.f;
#pragma unroll
        for (int i = 0; i < 4; ++i) { raw[i] = *(const u32x4*)(vp + 8 * i);
#pragma unroll
            for (int j = 0; j < 4; ++j) { const float a = bflo(raw[i][j]), b = bfhi(raw[i][j]); ss += a * a + b * b; } }
        ss += __shfl_xor(ss, 1); ss += __shfl_xor(ss, 2);
        const float rstd = 1.0f / sqrtf(ss * (1.0f / 128.0f) + EPS);
#pragma unroll
        for (int i = 0; i < 4; ++i)
#pragma unroll
            for (int j = 0; j < 4; ++j) { const int d = dq + 8 * i + 2 * j;
                *(LAS bf16_t*)(VT + (d) * VP + s * 2) = f2bf(bflo(raw[i][j]) * rstd);
                *(LAS bf16_t*)(VT + (d + 1) * VP + s * 2) = f2bf(bfhi(raw[i][j]) * rstd); }
    }
    __syncthreads();
    const int fr = lane & 15, fq = lane >> 4;
    f32x4 acc[8];
#pragma unroll
    for (int nb = 0; nb < 8; ++nb) acc[nb] = (f32x4){0.f, 0.f, 0.f, 0.f};
    const int trow = 16 * w + fr;
    const float* wrow = Ws + ((size_t)h * 128 + trow) * 128;
#pragma unroll
    for (int ks = 0; ks < 4; ++ks) {
        if (32 * ks <= 16 * w + 15) {
            const int s0 = 32 * ks + 8 * fq;
            const f32x4 wa = *(const f32x4*)(wrow + s0), wb = *(const f32x4*)(wrow + s0 + 4);
            float wv[8] = {wa[0], wa[1], wa[2], wa[3], wb[0], wb[1], wb[2], wb[3]};
#pragma unroll
            for (int j = 0; j < 8; ++j) if (s0 + j > trow) wv[j] = 0.f;
            u32x4 aw; aw.x = cvt_pk_bf16(wv[0], wv[1]); aw.y = cvt_pk_bf16(wv[2], wv[3]); aw.z = cvt_pk_bf16(wv[4], wv[5]); aw.w = cvt_pk_bf16(wv[6], wv[7]);
            const bf16x8 af = __builtin_bit_cast(bf16x8, aw);
#pragma unroll
            for (int nb = 0; nb < 8; ++nb) { const bf16x8 bfr = *(const LAS bf16x8*)(VT + (16 * nb + fr) * VP + s0 * 2);
                acc[nb] = __builtin_amdgcn_mfma_f32_16x16x32_bf16(af, bfr, acc[nb], 0, 0, 0); }
        }
    }
#pragma unroll
    for (int i = 0; i < 4; ++i) { const int tl = 16 * w + 4 * fq + i; const float bt = bs[h * 128 + tl];
        const bf16_t* up = Z + (size_t)(t0 + tl) * EVEN_IN + h * 128 + fr; bf16_t* op = MIX + (size_t)(t0 + tl) * DM + h * 128 + fr;
#pragma unroll
        for (int nb = 0; nb < 8; ++nb) { const float uu = bf2f(up[16 * nb]); op[16 * nb] = f2bf(uu * (gv[h * 128 + 16 * nb + fr] * acc[nb][i] + bt)); } }
    __syncthreads();
}

__device__ __forceinline__ void router_phase(Frame& F, const float* x, const float* gain, const float* Wr, const float* br, gu32* cnt  ,
                                             unsigned* tok_er, float* tok_g, bf16_t* XG) {
    LAS float* WrT = (LAS float*)(F.lds + RING_OFF);
    LAS float* lg = (LAS float*)(F.lds + SCR_OFF);
    LAS unsigned* hist = (LAS unsigned*)(F.lds + SCR_OFF + 64 * 33 * 4);
    LAS unsigned* base = hist + 32;
    LAS unsigned* ers = base + 32;
    int tid_ = threadIdx.x; asm volatile("" : "+v"(tid_));
    const int tid = tid_, lane = tid & 63, w = __builtin_amdgcn_readfirstlane(tid >> 6);
    for (int idx = tid; idx < 8192; idx += 512) { const int e4 = idx >> 10, k = idx & 1023; const f32x4 v = *(const f32x4*)(Wr + (size_t)k * 32 + 4 * e4);
        WrT[(4 * e4 + 0) * 1024 + k] = v[0]; WrT[(4 * e4 + 1) * 1024 + k] = v[1]; WrT[(4 * e4 + 2) * 1024 + k] = v[2]; WrT[(4 * e4 + 3) * 1024 + k] = v[3]; }
    __syncthreads();
    f32x4 gg[4];
#pragma unroll
    for (int j = 0; j < 4; ++j) gg[j] = ((const f32x4*)gain + lane)[64 * j];
    const float brl = br[lane & 31];
    for (int tg = F.vcu; tg < M / 64; tg += F.G) {
    const int tokb = tg * 64;
    if (tid < 32) hist[tid] = 0u;
    for (int tt = 0; tt < 8; ++tt) {
        const int tl = w * 8 + tt; const float* xrow = x + (size_t)(tokb + tl) * DM;
        f32x4 hv[4]; float s = 0.f;
#pragma unroll
        for (int j = 0; j < 4; ++j) { hv[j] = ((const f32x4*)xrow + lane)[64 * j]; s += (hv[j].x * hv[j].x + hv[j].y * hv[j].y) + (hv[j].z * hv[j].z + hv[j].w * hv[j].w); }
        const float rstd = 1.0f / sqrtf(wave_sum(s) * (1.f / DM) + EPS);
#pragma unroll
        for (int j = 0; j < 4; ++j) hv[j] = hv[j] * rstd * gg[j];
        float a[32];
#pragma unroll
        for (int e = 0; e < 32; ++e) { float t = 0.f;
#pragma unroll
            for (int j = 0; j < 4; ++j) { const f32x4 wv = *(const LAS f32x4*)(WrT + e * 1024 + 256 * j + 4 * lane); t += (hv[j].x * wv.x + hv[j].y * wv.y) + (hv[j].z * wv.z + hv[j].w * wv.w); }
            a[e] = t; }
#define RSTEP(N, BIT) _Pragma("unroll") for (int i = 0; i < N; ++i) { const bool up = (lane & BIT) != 0; const float keep = up ? a[2 * i + 1] : a[2 * i], send = up ? a[2 * i] : a[2 * i + 1]; a[i] = keep + __shfl_xor(send, BIT); }
        RSTEP(16, 1) RSTEP(8, 2) RSTEP(4, 4) RSTEP(2, 8) RSTEP(1, 16)
#undef RSTEP
        float logit = a[0] + __shfl_xor(a[0], 32) + brl;
        if (lane < 32) lg[tl * 33 + lane] = logit;
    }
    __syncthreads();
    unsigned my_e[4] = {0, 0, 0, 0}, my_lr[4] = {0, 0, 0, 0}; float my_g[4] = {0, 0, 0, 0};
    if (tid < 64) {
        float v[32];
#pragma unroll
        for (int e = 0; e < 32; ++e) v[e] = lg[tid * 33 + e];
        int c0 = -1, c1 = -1, c2 = -1; float tv[4];
#pragma unroll
        for (int r = 0; r < 4; ++r) { float best = -__builtin_inff(); int bi = 0;
#pragma unroll
            for (int e = 0; e < 32; ++e) { const bool ok = (e != c0) && (e != c1) && (e != c2); if (ok && v[e] > best) { best = v[e]; bi = e; } }
            tv[r] = best; my_e[r] = (unsigned)bi; if (r == 0) c0 = bi; else if (r == 1) c1 = bi; else if (r == 2) c2 = bi; }
        const float p1 = __expf(tv[1] - tv[0]), p2 = __expf(tv[2] - tv[0]), p3 = __expf(tv[3] - tv[0]); const float inv = 1.0f / (1.0f + p1 + p2 + p3);
        my_g[0] = inv; my_g[1] = p1 * inv; my_g[2] = p2 * inv; my_g[3] = p3 * inv;
#pragma unroll
        for (int r = 0; r < 4; ++r) my_lr[r] = __hip_atomic_fetch_add(hist + my_e[r], 1u, __ATOMIC_RELAXED, __HIP_MEMORY_SCOPE_WORKGROUP);
    }
    __syncthreads();
    if (tid < 32) { const unsigned hc = hist[tid]; base[tid] = hc ? __hip_atomic_fetch_add(cnt + 64 * tid, hc, RLX_AGENT) : 0u; }
    __syncthreads();
    if (tid < 64) {
        u32x4 er; f32x4 gt;
#pragma unroll
        for (int r = 0; r < 4; ++r) { const unsigned rank = base[my_e[r]] + my_lr[r]; er[r] = (my_e[r] << 16) | rank; gt[r] = my_g[r]; ers[tid * 4 + r] = er[r]; }
        *(u32x4*)(tok_er + (size_t)(tokb + tid) * 4) = er; *(f32x4*)(tok_g + (size_t)(tokb + tid) * 4) = gt;
    }
    __syncthreads();
    for (int tt = 0; tt < 8; ++tt) {
        const int tl = w * 8 + tt; const float* xrow = x + (size_t)(tokb + tl) * DM;
        f32x4 hv[4]; float s = 0.f;
#pragma unroll
        for (int j = 0; j < 4; ++j) { hv[j] = ((const f32x4*)xrow + lane)[64 * j]; s += (hv[j].x * hv[j].x + hv[j].y * hv[j].y) + (hv[j].z * hv[j].z + hv[j].w * hv[j].w); }
        const float rstd = 1.0f / sqrtf(wave_sum(s) * (1.f / DM) + EPS);
        u32x2 wv[4];
#pragma unroll
        for (int j = 0; j < 4; ++j) { const f32x4 t = hv[j] * rstd * gg[j]; wv[j].x = cvt_pk_bf16(t.x, t.y); wv[j].y = cvt_pk_bf16(t.z, t.w); }
#pragma unroll
        for (int r = 0; r < 4; ++r) { const unsigned er = ers[tl * 4 + r]; const size_t slot = (size_t)(er >> 16) * ECAP + (er & 0xffffu);
            u32x2* o8 = (u32x2*)(XG + slot * DM) + lane;
#pragma unroll
            for (int j = 0; j < 4; ++j) o8[64 * j] = wv[j]; }
    }
    __syncthreads();
    }
}

__device__ __forceinline__ void combine_phase(Frame& F, float* x, const unsigned* tok_er, const float* tok_g, const bf16_t* Y, const float* g_next, bf16_t* XN) {
    int tid_ = threadIdx.x; asm volatile("" : "+v"(tid_));
    const int gw = F.vcu * NWAVES + __builtin_amdgcn_readfirstlane(tid_ >> 6), NGW = F.G * NWAVES, lane = tid_ & 63;
    for (int m = gw; m < M; m += NGW) {
        const u32x4 er = *(const u32x4*)(tok_er + (size_t)m * 4); const f32x4 gt = *(const f32x4*)(tok_g + (size_t)m * 4);
        f32x4 v[4]; float* xrow = x + (size_t)m * DM;
#pragma unroll
        for (int j = 0; j < 4; ++j) v[j] = ((const f32x4*)xrow + lane)[64 * j];
#pragma unroll
        for (int r = 0; r < 4; ++r) { const size_t slot = (size_t)(er[r] >> 16) * ECAP + (er[r] & 0xffffu); const u32x2* yp = (const u32x2*)(Y + slot * DM) + lane; const float g = gt[r];
#pragma unroll
            for (int j = 0; j < 4; ++j) { const u32x2 yv = yp[64 * j]; v[j].x += g * bflo(yv.x); v[j].y += g * bfhi(yv.x); v[j].z += g * bflo(yv.y); v[j].w += g * bfhi(yv.y); } }
#pragma unroll
        for (int j = 0; j < 4; ++j) ((f32x4*)xrow + lane)[64 * j] = v[j];
        if (g_next) {
            float s = 0.f;
#pragma unroll
            for (int j = 0; j < 4; ++j) s += (v[j].x * v[j].x + v[j].y * v[j].y) + (v[j].z * v[j].z + v[j].w * v[j].w);
            const float rstd = 1.0f / sqrtf(wave_sum(s) * (1.f / DM) + EPS);
            u32x2* o8 = (u32x2*)(XN + (size_t)m * DM) + lane;
#pragma unroll
            for (int j = 0; j < 4; ++j) { const f32x4 gg = ((const f32x4*)g_next + lane)[64 * j];
                u32x2 w; w.x = cvt_pk_bf16(v[j].x * rstd * gg.x, v[j].y * rstd * gg.y); w.y = cvt_pk_bf16(v[j].z * rstd * gg.z, v[j].w * rstd * gg.w); o8[64 * j] = w; }
        }
    }
}

__device__ __forceinline__ void mla_finalize_phase(Frame& F, const bf16_t* QR, const bf16_t* KVR, const bf16_t* Z, const float* gq, const float* gk, bf16_t* QF, bf16_t* KF) {
    int tid_ = threadIdx.x; asm volatile("" : "+v"(tid_));
    const int gw = F.vcu * NWAVES + __builtin_amdgcn_readfirstlane(tid_ >> 6), NGW = F.G * NWAVES, lane = tid_ & 63;
    const int fi = lane & 31;
    const float invf = __builtin_amdgcn_exp2f(-(float)fi * (13.287712379549449f / 32.0f));
    const float gq0 = gq[lane], gq1 = gq[64 + lane], gq2 = gq[128 + lane], gk0 = gk[lane], gk1 = gk[64 + lane], gk2 = gk[128 + lane];
    for (int m = gw; m < M; m += NGW) {
        const int pos = m & (SEQ - 1);
        const double rev = (double)pos * (double)invf * 0.15915494309189535;
        const float fr = (float)(rev - __builtin_rint(rev));
        const float sn = __builtin_amdgcn_sinf(fr), cs = __builtin_amdgcn_cosf(fr);
        const float kr = bf2f(Z[(size_t)m * ODD_INP + 768 + lane]);
#pragma unroll
        for (int h = 0; h < 8; ++h) {
            {   const bf16_t* qp = QR + (size_t)m * 1536 + h * 192;
                float a = bf2f(qp[lane]), b = bf2f(qp[64 + lane]), c = bf2f(qp[128 + lane]);
                const float rstd = 1.0f / sqrtf(wave_sum(a * a + b * b + c * c) * (1.0f / 192.0f) + EPS);
                a *= rstd * gq0; b *= rstd * gq1; c *= rstd * gq2;
                const float pc = __shfl_xor(c, 32);
                const float rc = lane < 32 ? (c * cs - pc * sn) : (pc * sn + c * cs);
                bf16_t* op = QF + (size_t)m * 1536 + h * 192;
                op[lane] = f2bf(a * C2_C); op[64 + lane] = f2bf(b * C2_C); op[128 + lane] = f2bf(rc * C2_C); }
            {   const bf16_t* kp = KVR + (size_t)m * 2048 + h * 256;
                float a = bf2f(kp[lane]), b = bf2f(kp[64 + lane]), c = kr;
                const float rstd = 1.0f / sqrtf(wave_sum(a * a + b * b + c * c) * (1.0f / 192.0f) + EPS);
                a *= rstd * gk0; b *= rstd * gk1; c *= rstd * gk2;
                const float pc = __shfl_xor(c, 32);
                const float rc = lane < 32 ? (c * cs - pc * sn) : (pc * sn + c * cs);
                bf16_t* op = KF + (size_t)m * 1536 + h * 192;
                op[lane] = f2bf(a); op[64 + lane] = f2bf(b); op[128 + lane] = f2bf(rc); }
        }
    }
}

#ifndef PHMASK
#define PHMASK 0xFFFF
#endif

#define LAUNDER_S(x) asm volatile("" : "+s"(x))
__device__ __forceinline__ const float* in_ptr(const Args& a, int i) { LAUNDER_S(i); return a.in[i]; }
#define PHASE_BEGIN() unsigned wso_ = 0u; LAUNDER_S(wso_); unsigned char* ws = args.ws + wso_; Frame Fp = F; Fp.vcu = __builtin_amdgcn_readfirstlane(Fp.vcu); Fp.G = __builtin_amdgcn_readfirstlane(Fp.G); LAUNDER_S(Fp.vcu); LAUNDER_S(Fp.G); \
    int bx_ = __builtin_amdgcn_readfirstlane((int)blockIdx.x); LAUNDER_S(bx_); (void)bx_; (void)ws
#define XN  ((bf16_t*)(ws + WS_XN))
#define Z   ((bf16_t*)(ws + WS_Z))
#define MIX ((bf16_t*)(ws + WS_MIX))
#define QR  ((bf16_t*)(ws + WS_QR))
#define KVR ((bf16_t*)(ws + WS_KVR))
#define QF  ((bf16_t*)(ws + WS_QF))
#define KF  ((bf16_t*)(ws + WS_KF))
#define XG  ((bf16_t*)(ws + WS_XG))
#define ACT ((bf16_t*)(ws + WS_ACT))
#define YB  ((bf16_t*)(ws + WS_XG))
#define SSQ ((float*)(ws + WS_SSQ))
#define TOKER ((unsigned*)(ws + WS_TOKER))
#define TOKG ((float*)(ws + WS_TOKG))
#define B1P ((float*)(ws + WS_B1P))
#define IN(i) in_ptr(args, (i))
__global__ void __launch_bounds__(NWAVES * 64, 2) trunk_fwd(Args args) {
    extern __shared__ __attribute__((aligned(16))) unsigned char lds_raw[];
    Frame F;
    F.lds = (LAS unsigned char*)lds_raw;
    F.G = gridDim.x; { const int bx = blockIdx.x; F.vcu = (F.G % 8 == 0) ? (bx % 8) * (F.G / 8) + bx / 8 : bx; }
    for (int u = threadIdx.x; u < (SCR_OFF - LDSCTL_OFF) / 4; u += NWAVES * 64) ((LAS unsigned*)(F.lds + LDSCTL_OFF))[u] = 0u;
    __syncthreads();
    (void)xcd_barrier_post((unsigned*)((gu32*)(args.ws + WS_CTL) + CW_BAR), (volatile LAS unsigned*)(F.lds + MISC_OFF) + 8);
#define GRID_BAR() do { unsigned wsb_ = 0u; LAUNDER_S(wsb_); XcdBarrier bar_; bar_.bar = (unsigned*)((gu32*)(args.ws + wsb_ + WS_CTL) + CW_BAR); bar_.x = xb_xcc_id(); \
        bar_.st = (volatile LAS unsigned*)(F.lds + MISC_OFF) + 8; xcd_barrier(bar_); } while (0)
    float* const X = args.out;
    const int stage_limit = args.stage_limit;

#if (PHMASK >> 0) & 1
    {   PHASE_BEGIN(); const int ptid = threadIdx.x, gw = Fp.vcu * NWAVES + __builtin_amdgcn_readfirstlane(ptid >> 6), NGW = Fp.G * NWAVES;
        transpose_job<1>(Fp, IN(I_EWIN), DM, EVEN_IN, 2, (size_t)DM * EVEN_IN, (bf16_t*)(ws + WS_WEIN), (size_t)EVEN_IN * DM, nullptr, 0);
        transpose_job<0>(Fp, IN(I_EWOUT), DM, DM, 2, (size_t)DM * DM, (bf16_t*)(ws + WS_WEOUT), (size_t)DM * DM, nullptr, 0);
        transpose_job<0>(Fp, IN(I_OWIN), DM, ODD_IN, 2, (size_t)DM * ODD_IN, (bf16_t*)(ws + WS_WOIN), (size_t)ODD_INP * DM, nullptr, 0);
        transpose_job<0>(Fp, IN(I_OWUQ), 512, 1536, 2, (size_t)512 * 1536, (bf16_t*)(ws + WS_WUQ), (size_t)1536 * 512, IN(I_OGCQ), 512);
        transpose_job<0>(Fp, IN(I_OWUKV), 256, 2048, 2, (size_t)256 * 2048, (bf16_t*)(ws + WS_WUKV), (size_t)2048 * 256, IN(I_OGCKV), 256);
        transpose_job<0>(Fp, IN(I_OWOUT), DM, DM, 2, (size_t)DM * DM, (bf16_t*)(ws + WS_WOOUT), (size_t)DM * DM, nullptr, 0);
        transpose_job<2>(Fp, IN(I_W1), DM, 2 * DE, DEPTH * NE, (size_t)DM * 2 * DE, (bf16_t*)(ws + WS_W1), (size_t)2 * DE * DM, nullptr, 0);
        transpose_job<0>(Fp, IN(I_W2), DE, DM, DEPTH * NE, (size_t)DE * DM, (bf16_t*)(ws + WS_W2), (size_t)DM * DE, nullptr, 0);
        for (int i = bx_ * 512 + ptid; i < 2 * 24576; i += Fp.G * 512) { const int mi = i / 24576, r = i % 24576;
            *(u32x4*)((bf16_t*)(ws + WS_WOIN) + (size_t)mi * ODD_INP * DM + (size_t)ODD_IN * DM + (size_t)r * 8) = (u32x4){0u, 0u, 0u, 0u}; }
        for (int i = bx_ * 512 + ptid; i < DEPTH * NE * 2048; i += Fp.G * 512) { const int c = i & 2047, o = 2 * (128 * (c >> 8) + (c & 127)) + ((c >> 7) & 1);
            B1P[i] = IN(I_B1)[(size_t)(i & ~2047) + o]; }
        for (int m = gw; m < M; m += NGW) rms_row_to_bf16(ptid & 63, IN(I_X) + (size_t)m * DM, IN(I_MIXN), XN + (size_t)m * DM, X + (size_t)m * DM);
    }
#endif
    GRID_BAR();

    for (int l = 0; l < DEPTH; ++l) {
        const int li = l >> 1;
        if (2 * l + 1 > stage_limit) break;
        if ((l & 1) == 0) {
#if (PHMASK >> 1) & 1
            {   PHASE_BEGIN(); pg8::Gemm g{XN, (const bf16_t*)(ws + WS_WEIN) + (size_t)li * EVEN_IN * DM, DM, DM}; pg8::StaticOrder S; S.init(M, EVEN_IN, Fp.G, bx_);
                pg8::EpiEvenIn E{Z, IN(I_EGQ) + li * 64, IN(I_EGK) + li * 64};
                pg8::gemm_phase<pg8::EpiEvenIn, pg8::StaticOrder>(Fp.lds + RING_OFF, g, S, E); }
#endif
            GRID_BAR();
            {   PHASE_BEGIN();
#if (PHMASK >> 2) & 1
                for (int u = Fp.vcu; u < 512; u += Fp.G)
                    gmlp_unit(Fp, Z, MIX, IN(I_EWS) + (size_t)li * 4 * 128 * 128, IN(I_EBS) + li * 512, IN(I_EGV) + li * 512, u);
#endif
#if (PHMASK >> 3) & 1
                typedef att::Cfg<64, 64, 1> C;
                LAS float* lut = (LAS float*)(Fp.lds + RING_OFF + C::OFF_LUT);
                int tl_ = threadIdx.x; asm volatile("" : "+v"(tl_));
                for (int d = tl_; d < att::LUTN; d += 512) { const int c = (d <= 128 ? 1 : 0) + ((d <= 512 && (d & 3) == 0) ? 1 : 0) + ((d <= 2048 && (d & 15) == 0) ? 1 : 0);
                    lut[d] = c == 0 ? -__builtin_inff() : (c == 1 ? 0.f : (c == 2 ? 1.f : 1.5849625007211562f)); }
                __syncthreads();
                for (int u = Fp.vcu; u < 256; u += Fp.G) { const int bh = u >> 4, s = u & 15, b = bh >> 3, h = bh & 7;
                    for (int pass = 0; pass < 2; ++pass) { const int qb = pass ? 31 - s : s;
                        const bf16_t* zb = Z + (size_t)b * SEQ * EVEN_IN;
                        att::attn_unit<64, 64, 1>(zb + 1024 + 64 * h, EVEN_IN, zb + 1536 + 64 * h, EVEN_IN, zb + 2048 + 64 * h, EVEN_IN,
                                                  MIX + (size_t)b * SEQ * DM + 512 + 64 * h, DM, qb * 256, Fp.lds + RING_OFF); } }
#endif
            }
            GRID_BAR();
#if (PHMASK >> 4) & 1
            {   PHASE_BEGIN(); pg8::Gemm g{MIX, (const bf16_t*)(ws + WS_WEOUT) + (size_t)li * DM * DM, DM, DM}; pg8::StaticOrder S; S.init(M, DM, Fp.G, bx_);
                pg8::EpiResid E{X};
                pg8::gemm_phase<pg8::EpiResid, pg8::StaticOrder>(Fp.lds + RING_OFF, g, S, E); }
#endif
            GRID_BAR();
        } else {
#if (PHMASK >> 5) & 1
            {   PHASE_BEGIN(); pg8::Gemm g{XN, (const bf16_t*)(ws + WS_WOIN) + (size_t)li * ODD_INP * DM, DM, DM}; pg8::StaticOrder S; S.init(M, ODD_INP, Fp.G, bx_);
                pg8::EpiOddIn E{Z, SSQ};
                pg8::gemm_phase<pg8::EpiOddIn, pg8::StaticOrder>(Fp.lds + RING_OFF, g, S, E); }
#endif
            GRID_BAR();
#if (PHMASK >> 6) & 1
            {   PHASE_BEGIN(); pg8::Gemm g{Z + 512, (const bf16_t*)(ws + WS_WUKV) + (size_t)li * 2048 * 256, ODD_INP, 256}; pg8::StaticOrder S; S.init(M, 2048, Fp.G, bx_);
                pg8::EpiRowScale<1> E{KVR, 2048, SSQ, 8, 1.0f / 256.0f};
                pg8::gemm_phase<pg8::EpiRowScale<1>, pg8::StaticOrder>(Fp.lds + RING_OFF, g, S, E); }
            {   PHASE_BEGIN(); pg8::Gemm g{Z, (const bf16_t*)(ws + WS_WUQ) + (size_t)li * 1536 * 512, ODD_INP, 512}; pg8::StaticOrder S; S.init(M, 1536, Fp.G, bx_);
                pg8::EpiRowScale<2> E{QR, 1536, SSQ, 0, 1.0f / 512.0f};
                pg8::gemm_phase<pg8::EpiRowScale<2>, pg8::StaticOrder>(Fp.lds + RING_OFF, g, S, E); }
#endif
            GRID_BAR();
#if (PHMASK >> 7) & 1
            {   PHASE_BEGIN(); mla_finalize_phase(Fp, QR, KVR, Z, IN(I_OGQ) + li * 192, IN(I_OGK) + li * 192, QF, KF); }
#endif
            GRID_BAR();
#if (PHMASK >> 8) & 1
            {   PHASE_BEGIN();
                for (int u = Fp.vcu; u < 256; u += Fp.G) { const int bh = u >> 4, s = u & 15, b = bh >> 3, h = bh & 7;
                    for (int pass = 0; pass < 2; ++pass) { const int qb = pass ? 31 - s : s;
                        att::attn_unit<192, 128, 0>(QF + (size_t)b * SEQ * 1536 + 192 * h, 1536, KF + (size_t)b * SEQ * 1536 + 192 * h, 1536, KVR + (size_t)b * SEQ * 2048 + 256 * h + 128, 2048,
                                                    MIX + (size_t)b * SEQ * DM + 128 * h, DM, qb * 256, Fp.lds + RING_OFF); } }
            }
#endif
            GRID_BAR();
#if (PHMASK >> 9) & 1
            {   PHASE_BEGIN(); pg8::Gemm g{MIX, (const bf16_t*)(ws + WS_WOOUT) + (size_t)li * DM * DM, DM, DM}; pg8::StaticOrder S; S.init(M, DM, Fp.G, bx_);
                pg8::EpiResid E{X};
                pg8::gemm_phase<pg8::EpiResid, pg8::StaticOrder>(Fp.lds + RING_OFF, g, S, E); }
#endif
            GRID_BAR();
        }
        if (2 * l + 2 > stage_limit) break;
#if (PHMASK >> 10) & 1
        {   PHASE_BEGIN(); gu32* cnt = (gu32*)(ws + WS_CTL) + CW_CNT + (size_t)l * 32 * 64;
        router_phase(Fp, X, IN(I_FFNN) + l * DM, IN(I_RW) + (size_t)l * DM * NE, IN(I_RB) + l * NE, cnt, TOKER, TOKG, XG); }
#endif
        GRID_BAR();
        LAS int* tbl = (LAS int*)(F.lds + SCR_OFF + 12288);
        {   PHASE_BEGIN(); gu32* cnt = (gu32*)(ws + WS_CTL) + CW_CNT + (size_t)l * 32 * 64;
        if (threadIdx.x == 0) { int acc = 0; for (int e = 0; e < NE; ++e) { tbl[e] = acc; const unsigned c = __hip_atomic_load(cnt + 64 * e, RLX_AGENT); acc += (int)((c + 255u) >> 8); } tbl[NE] = acc; }
        __syncthreads(); }
#if (PHMASK >> 11) & 1
        {   PHASE_BEGIN(); pg8::Gemm g{XG, (const bf16_t*)(ws + WS_W1) + (size_t)l * NE * 2 * DE * DM, DM, DM}; pg8::MoeOrder S{tbl, 8, Fp.G, Fp.vcu};
            pg8::EpiSwiglu E{ACT, B1P + (size_t)l * NE * 2048};
            pg8::gemm_phase<pg8::EpiSwiglu, pg8::MoeOrder>(Fp.lds + RING_OFF, g, S, E); }
#endif
        GRID_BAR();
#if (PHMASK >> 12) & 1
        {   PHASE_BEGIN(); pg8::Gemm g{ACT, (const bf16_t*)(ws + WS_W2) + (size_t)l * NE * DM * DE, DE, DE}; pg8::MoeOrder S{tbl, 4, Fp.G, Fp.vcu};
            pg8::EpiDown E{YB, IN(I_B2) + (size_t)l * NE * DM};
            pg8::gemm_phase<pg8::EpiDown, pg8::MoeOrder>(Fp.lds + RING_OFF, g, S, E); }
#endif
        GRID_BAR();
#if (PHMASK >> 13) & 1
        {   PHASE_BEGIN(); combine_phase(Fp, X, TOKER, TOKG, YB, (l + 1 < DEPTH) ? IN(I_MIXN) + (l + 1) * DM : nullptr, XN); }
#endif
        GRID_BAR();
    }
#undef GRID_BAR
}

extern "C" void kernel_launch(void* const* d_in, const int* in_sizes, int n_in, void* d_out, int out_size, void* d_ws, size_t ws_size, hipStream_t stream) {
    static int grid = 0;
    if (grid == 0) {
        if (n_in != 24 || in_sizes[0] != M * DM || out_size != M * DM || ws_size < WS_END) {
            fprintf(stderr, "kernel_launch: unexpected shapes (n_in %d, in0 %d, out %d, ws %zu, need %zu)\n", n_in, n_in > 0 ? in_sizes[0] : -1, out_size, ws_size, (size_t)WS_END); grid = -1; return; }
        int dev = 0, cus = 0, per_cu = 0;
        if (hipGetDevice(&dev) != hipSuccess || hipDeviceGetAttribute(&cus, hipDeviceAttributeMultiprocessorCount, dev) != hipSuccess) { grid = -1; return; }
        if (hipFuncSetAttribute((const void*)trunk_fwd, hipFuncAttributeMaxDynamicSharedMemorySize, LDS_BYTES) != hipSuccess) { fprintf(stderr, "kernel_launch: hipFuncSetAttribute failed\n"); grid = -1; return; }
        if (hipOccupancyMaxActiveBlocksPerMultiprocessor(&per_cu, (const void*)trunk_fwd, NWAVES * 64, LDS_BYTES) != hipSuccess || per_cu < 1)
            fprintf(stderr, "kernel_launch: occupancy query reports %d workgroups per CU\n", per_cu);
        (void)hipGetLastError();
        grid = cus;
    }
    if (grid < 0) return;
    if (hipMemsetAsync((char*)d_ws + WS_CTL, 0, CTL_ZERO_BYTES, stream) != hipSuccess) return;
    Args a{};
    for (int i = 0; i < 24; ++i) a.in[i] = (const float*)d_in[i];
    a.out = (float*)d_out; a.ws = (unsigned char*)d_ws; a.stage_limit = STAGE_LIMIT; a.pad = 0;
    hipLaunchKernelGGL(trunk_fwd, dim3(grid), dim3(NWAVES * 64), LDS_BYTES, stream, a);
}
```

```cpp
#include <hip/hip_runtime.h>
#include <hip/hip_bf16.h>
#include <cstdio>
#include <cstdint>

#define LAS __attribute__((address_space(3)))
#define GAS __attribute__((address_space(1)))
typedef unsigned short bf16_t;
typedef short bf16x8 __attribute__((ext_vector_type(8)));
typedef short s16x4 __attribute__((ext_vector_type(4)));
typedef float f32x2 __attribute__((ext_vector_type(2)));
typedef float f32x4 __attribute__((ext_vector_type(4)));
typedef float f32x16 __attribute__((ext_vector_type(16)));
typedef unsigned u32x2 __attribute__((ext_vector_type(2)));
typedef unsigned u32x4 __attribute__((ext_vector_type(4)));
typedef int i32x4 __attribute__((ext_vector_type(4)));
typedef int i32x8 __attribute__((ext_vector_type(8)));

constexpr int BATCH = 2, SEQ = 8192, DM = 1024, M = BATCH * SEQ, DEPTH = 4;
constexpr int EVEN_IN = 2560, ODD_IN = 832, ODD_INP = 1024;
constexpr int NE = 32, DE = 1024, ECAP = 16384;
constexpr float EPS = 1e-6f;
constexpr float LOG2E = 1.4426950408889634f;
constexpr float C2_B = 0.125f * LOG2E;
constexpr float C2_C = 0.07216878364870322f * LOG2E;

__device__ __forceinline__ unsigned cvt_pk_bf16(float lo, float hi) { unsigned r; asm volatile("v_cvt_pk_bf16_f32 %0, %1, %2" : "=v"(r) : "v"(lo), "v"(hi)); return r; }
__device__ __forceinline__ float bf2f(bf16_t v) { return __uint_as_float(((unsigned)v) << 16); }
__device__ __forceinline__ float bflo(unsigned w) { return __uint_as_float(w << 16); }
__device__ __forceinline__ float bfhi(unsigned w) { return __uint_as_float(w & 0xffff0000u); }
__device__ __forceinline__ bf16_t f2bf(float f) { return (bf16_t)(cvt_pk_bf16(f, 0.f) & 0xffffu); }

__device__ __forceinline__ unsigned pk4_fp8(float a, float b, float c, float d) { int w = 0; w = __builtin_amdgcn_cvt_pk_fp8_f32(a, b, w, false); w = __builtin_amdgcn_cvt_pk_fp8_f32(c, d, w, true); return (unsigned)w; }
constexpr float W8_SCALE = 64.0f, W8_INV = 1.0f / 64.0f;

namespace pg8 {
constexpr int BM = 256, BK = 64, HALF = 128, HTB = HALF * BK * 2, STAGE_BYTES = 8 * HTB, NXCD = 8, WGM = 8;
__host__ __device__ __forceinline__ int lds_byte(int r, int c) { const int st = (r >> 4) * 2 + (c >> 5), rr = r & 15, cc = c & 31, ob = rr * 64 + cc * 2; return st * 1024 + (ob ^ (((ob >> 9) & 1) << 5)); }
__host__ __device__ __forceinline__ void stage_rc(int b, int& R, int& C) { const int st = b / 1024, sb = b % 1024, swz = sb ^ (((sb >> 9) & 1) << 5); R = (st >> 1) * 16 + swz / 64; C = (st & 1) * 32 + (swz % 64) / 2; }
__host__ __device__ __forceinline__ int perm32(int rho) { const int n = rho >> 4, i = rho & 15; return 8 * (i >> 2) + 4 * n + (i & 3); }

struct Unit { int pm, pn, pb; };
struct Gemm { const bf16_t* A; const bf16_t* Bt; int lda, K; };

struct StaticOrder {
    int nM, nN, nwg, G, c;
    __device__ void init(int M_, int N_, int G_, int c_) { nM = M_ / BM; nN = N_ / BM; nwg = nM * nN; G = G_; c = c_; }
    __device__ bool next(int i, Unit& u) const {
        const long L = (long)i * G + c; if (L >= nwg) return false;
        int wgid = (int)L; { const int q = nwg / NXCD, r = nwg % NXCD, xcd = wgid % NXCD, off = wgid / NXCD; wgid = (xcd < r ? xcd * (q + 1) : r * (q + 1) + (xcd - r) * q) + off; }
        const int nig = WGM * nN, gid = wgid / nig, fm = gid * WGM, gsz = (nM - fm) < WGM ? (nM - fm) : WGM;
        u.pm = fm + ((wgid % nig) % gsz); u.pn = (wgid % nig) / gsz; u.pb = u.pn; return true;
    }
};

__device__ __forceinline__ f32x2 gelu_pk(f32x2 v) {
    const f32x2 av = __builtin_elementwise_abs(v), d = av * 0.2316418882f + 1.0f;
    f32x2 t; t.x = __builtin_amdgcn_rcpf(d.x); t.y = __builtin_amdgcn_rcpf(d.y);
    f32x2 q = t * 0.5307027145f + (-0.7265760135f); q = q * t + 0.7107068705f; q = q * t + (-0.142248368f); q = q * t + 0.127414796f; q = q * t;
    const f32x2 s = (v * v) * (-0.72134752044f);
    f32x2 e; e.x = __builtin_amdgcn_exp2f(s.x); e.y = __builtin_amdgcn_exp2f(s.y);
    const f32x2 m = v * (q * e), r = v - m;
    f32x2 o; o.x = v.x < 0.f ? m.x : r.x; o.y = v.y < 0.f ? m.y : r.y; return o;
}
__device__ __forceinline__ f32x4 gelu4(f32x4 v) { const f32x2 a = gelu_pk((f32x2){v[0], v[1]}), b = gelu_pk((f32x2){v[2], v[3]}); return (f32x4){a.x, a.y, b.x, b.y}; }

template <class Epi, class Sched, bool FP8 = false>
__device__ __forceinline__ void gemm_phase(LAS unsigned char* lds, const Gemm g, const Sched& S, const Epi& E) {
    int tid_ = threadIdx.x; asm volatile("" : "+v"(tid_));
    const int tid = tid_, wid = __builtin_amdgcn_readfirstlane(tid >> 6), lane = tid & 63, wr = wid >> 2, wc = wid & 3, fr = lane & 15, fq = lane >> 4;
    const int K = g.K, nt = K / BK;
    unsigned voffA[2], voffB[2];
#pragma unroll
    for (int i = 0; i < 2; ++i) { int R, C; stage_rc(tid * 16 + i * 8192, R, C); const int Rb = Epi::PERM ? ((R & ~31) + perm32(R & 31)) : R;
        voffA[i] = (unsigned)(R * g.lda + C) * 2u; voffB[i] = (unsigned)(Rb * K + C) * 2u; }
    const size_t kstep = (size_t)(BK * 2);
    const size_t hstepA = (size_t)HALF * g.lda * 2, tstepA = 2 * hstepA;
    const size_t hstepB = (size_t)HALF * K * 2, tstepB = 2 * hstepB;
    const unsigned ldsw = (unsigned)wid * 1024u;
    const int aoff = lds_byte(wr * 64 + fr, fq * 8), boff = lds_byte(wc * 32 + fr, fq * 8);
#define PG8_SA(b, h) (((b) * 2 + (h)) * HTB)
#define PG8_SB(b, h) ((4 + (b) * 2 + (h)) * HTB)
#define PG8_STAGE(bufoff, gbase, voff) do { _Pragma("unroll") for (int _i = 0; _i < 2; ++_i) \
        __builtin_amdgcn_global_load_lds((const unsigned*)((const char*)(gbase) + (voff)[_i]), (LAS unsigned*)(lds + (bufoff) + ldsw + _i * 8192), 16, 0, 0); } while (0)
#define PG8_LDA(dst, b, h) do { _Pragma("unroll") for (int m = 0; m < 4; ++m) { if constexpr (FP8) { const i32x4 lo_ = *(const LAS i32x4*)(lds + PG8_SA(b, h) + aoff + m * 2048), hi_ = *(const LAS i32x4*)(lds + PG8_SA(b, h) + aoff + m * 2048 + 1024); dst##8[m] = __builtin_shufflevector(lo_, hi_, 0, 1, 2, 3, 4, 5, 6, 7); } \
        else { _Pragma("unroll") for (int k = 0; k < 2; ++k) dst[m][k] = *(const LAS bf16x8*)(lds + PG8_SA(b, h) + aoff + m * 2048 + k * 1024); } } } while (0)
#define PG8_LDB(dst, b, h) do { _Pragma("unroll") for (int n = 0; n < 2; ++n) { if constexpr (FP8) { const i32x4 lo_ = *(const LAS i32x4*)(lds + PG8_SB(b, h) + boff + n * 2048), hi_ = *(const LAS i32x4*)(lds + PG8_SB(b, h) + boff + n * 2048 + 1024); dst##8[n] = __builtin_shufflevector(lo_, hi_, 0, 1, 2, 3, 4, 5, 6, 7); } \
        else { _Pragma("unroll") for (int k = 0; k < 2; ++k) dst[n][k] = *(const LAS bf16x8*)(lds + PG8_SB(b, h) + boff + n * 2048 + k * 1024); } } } while (0)
#define PG8_MMA(ai, bj, At, Bt) do { __builtin_amdgcn_s_setprio(1); _Pragma("unroll") for (int m = 0; m < 4; ++m) _Pragma("unroll") for (int n = 0; n < 2; ++n) { \
        if constexpr (FP8) asm volatile("s_nop 1\n\tv_mfma_f32_16x16x128_f8f6f4 %0, %1, %2, %0" : "+v"(acc[ai][bj][m][n]) : "v"(Bt##8[n]), "v"(At##8[m])); \
        else { _Pragma("unroll") for (int k = 0; k < 2; ++k) acc[ai][bj][m][n] = __builtin_amdgcn_mfma_f32_16x16x32_bf16(Bt[n][k], At[m][k], acc[ai][bj][m][n], 0, 0, 0); } } \
        __builtin_amdgcn_s_setprio(0); } while (0)
#define PG8_WAIT_V(n) asm volatile("s_waitcnt vmcnt(" #n ")" ::: "memory")
#define PG8_WAIT_L(n) asm volatile("s_waitcnt lgkmcnt(" #n ")" ::: "memory")
#define PG8_BAR __builtin_amdgcn_s_barrier()
#define PG8_SCHED __builtin_amdgcn_sched_barrier(0)
    Unit cur, nxt; int ui = 0;
    if (!S.next(0, cur)) return;
    f32x4 acc[2][2][4][2];
#pragma unroll
    for (int a = 0; a < 2; ++a)
#pragma unroll
        for (int b = 0; b < 2; ++b)
#pragma unroll
            for (int m = 0; m < 4; ++m)
#pragma unroll
                for (int n = 0; n < 2; ++n) acc[a][b][m][n] = (f32x4){0.f, 0.f, 0.f, 0.f};
    bf16x8 At[4][2], B0[2][2], B1[2][2]; i32x8 At8[4], B08[2], B18[2];
    const char* cA = (const char*)g.A + (size_t)cur.pm * tstepA; const char* cB = (const char*)g.Bt + (size_t)cur.pb * tstepB;
    PG8_STAGE(PG8_SB(0, 0), cB, voffB); PG8_STAGE(PG8_SB(0, 1), cB + hstepB, voffB); PG8_STAGE(PG8_SA(0, 0), cA, voffA); PG8_STAGE(PG8_SA(0, 1), cA + hstepA, voffA);
    if (wr == 1) PG8_BAR;
    PG8_WAIT_V(2); PG8_BAR;
    PG8_STAGE(PG8_SB(1, 0), cB + kstep, voffB); PG8_STAGE(PG8_SA(1, 0), cA + kstep, voffA); PG8_STAGE(PG8_SB(1, 1), cB + hstepB + kstep, voffB);
    PG8_WAIT_V(6); PG8_BAR;
    for (;;) {
        const bool has_next = S.next(ui + 1, nxt);
        const char* nA = has_next ? (const char*)g.A + (size_t)nxt.pm * tstepA : cA; const char* nB = has_next ? (const char*)g.Bt + (size_t)nxt.pb * tstepB : cB;
#pragma unroll 1
        for (int t = 0; t < nt; t += 2) {
            const bool last = (t == nt - 2);
            const char* a1 = cA + (size_t)(t + 1) * kstep;
            const char* a2 = last ? nA : cA + (size_t)(t + 2) * kstep; const char* b2 = last ? nB : cB + (size_t)(t + 2) * kstep;
            const char* a3 = a2 + kstep; const char* b3 = b2 + kstep;
            PG8_LDB(B0, 0, 0); PG8_LDB(B1, 0, 1); PG8_SCHED; PG8_LDA(At, 0, 0); PG8_STAGE(PG8_SA(1, 1), a1 + hstepA, voffA);
            PG8_WAIT_V(8); PG8_WAIT_L(0); PG8_BAR; PG8_MMA(0, 0, At, B0); PG8_MMA(0, 1, At, B1); PG8_BAR; PG8_SCHED;
            PG8_LDA(At, 0, 1); PG8_STAGE(PG8_SB(0, 0), b2, voffB); PG8_STAGE(PG8_SB(0, 1), b2 + hstepB, voffB); PG8_STAGE(PG8_SA(0, 0), a2, voffA);
            PG8_WAIT_V(8); PG8_WAIT_L(0); PG8_BAR; PG8_MMA(1, 0, At, B0); PG8_MMA(1, 1, At, B1); PG8_BAR; PG8_SCHED;
            PG8_LDB(B0, 1, 0); PG8_LDB(B1, 1, 1); PG8_SCHED; PG8_LDA(At, 1, 0); PG8_STAGE(PG8_SA(0, 1), a2 + hstepA, voffA);
            PG8_WAIT_V(8); PG8_WAIT_L(0); PG8_BAR; PG8_MMA(0, 0, At, B0); PG8_MMA(0, 1, At, B1); PG8_BAR; PG8_SCHED;
            PG8_LDA(At, 1, 1); PG8_STAGE(PG8_SB(1, 0), b3, voffB); PG8_STAGE(PG8_SB(1, 1), b3 + hstepB, voffB); PG8_STAGE(PG8_SA(1, 0), a3, voffA);
            PG8_WAIT_V(8); PG8_WAIT_L(0); PG8_BAR; PG8_MMA(1, 0, At, B0); PG8_MMA(1, 1, At, B1); PG8_BAR; PG8_SCHED;
        }
        if (wr == 0) PG8_BAR;
        if constexpr (FP8) asm volatile("s_nop 15\n\ts_nop 7" ::: "memory");
        { int te_ = threadIdx.x; asm volatile("" : "+v"(te_));
          E(acc, cur, wr, wc, te_ & 15, (te_ & 63) >> 4); }
        if (!has_next) break;
#pragma unroll
        for (int a = 0; a < 2; ++a)
#pragma unroll
            for (int b = 0; b < 2; ++b)
#pragma unroll
                for (int m = 0; m < 4; ++m)
#pragma unroll
                    for (int n = 0; n < 2; ++n) acc[a][b][m][n] = (f32x4){0.f, 0.f, 0.f, 0.f};
        cur = nxt; cA = nA; cB = nB; ++ui;
        if (wr == 1) PG8_BAR;
    }
    PG8_WAIT_V(0);
    PG8_BAR;
#undef PG8_SA
#undef PG8_SB
#undef PG8_STAGE
#undef PG8_LDA
#undef PG8_LDB
#undef PG8_MMA
#undef PG8_WAIT_V
#undef PG8_WAIT_L
#undef PG8_BAR
#undef PG8_SCHED
}
}
constexpr int STAGE_LIMIT = 8;

namespace att {
__device__ __forceinline__ int crow(int r, int hi) { return (r & 3) + 8 * (r >> 2) + 4 * hi; }
__device__ __forceinline__ int v_rd_base(int lane) { return ((lane & 3) << 3) | (((lane >> 2) & 3) << 6) | (((lane >> 4) & 1) << 5) | (((lane >> 5) & 1) << 8); }
constexpr int LUTN = 2052;

template <int DQK, int DV, int MODE>
struct Cfg {
    static constexpr int KP = DQK * 2 + 16;
    static constexpr int KB = 64 * KP, VB = 64 * DV * 2;
    static constexpr int OFF_K = 0, OFF_V = 2 * KB, OFF_WS = 2 * KB + 2 * VB, OFF_LUT = OFF_WS + 8 * 256, BYTES = OFF_LUT + (MODE == 1 ? LUTN * 4 : 0);
    static constexpr int CPR = KP / 16;
    static constexpr int NKP = KB / 1024, KPW = (NKP + 7) / 8;
    static constexpr int NVP = VB / 1024, VPW = NVP / 8;
    static_assert(KB % 1024 == 0 && NVP % 8 == 0, "tile images are whole DMA pieces");
};

template <int DQK, int DV, int MODE>
__device__ __forceinline__ void attn_unit(const bf16_t* __restrict__ Qh, int qp, const bf16_t* __restrict__ Kh, int kp, const bf16_t* __restrict__ Vh, int vp,
                                          bf16_t* __restrict__ Oh, int op, int q0, LAS unsigned char* lds) {
    typedef Cfg<DQK, DV, MODE> C;
    constexpr int NCB = DV / 32;
    int tid_ = threadIdx.x; asm volatile("" : "+v"(tid_));
    const int tid = tid_, wid = __builtin_amdgcn_readfirstlane(tid >> 6), lane = tid & 63, r32 = lane & 31, hi = lane >> 5;
    const int qlo = q0 + wid * 32, qpos = qlo + r32;
    LAS float* wsf = (LAS float*)(lds + C::OFF_WS) + wid * 64;
    const LAS float* lut = (const LAS float*)(lds + C::OFF_LUT);
    int j_lo = 0; if (MODE == 1) { const int lo = q0 - 2048; j_lo = lo > 0 ? lo / 64 : 0; }
    const int j_hi = (q0 + 256) / 64, NT = j_hi - j_lo;
    unsigned kso[C::KPW], vso[C::VPW];
#pragma unroll
    for (int i = 0; i < C::KPW; ++i) { const int c = (wid + 8 * i) * 64 + lane, row = c / C::CPR; int cc = c % C::CPR; if (cc > C::CPR - 2) cc = C::CPR - 2;
        kso[i] = (unsigned)((row & 63) * kp + cc * 8); }
#pragma unroll
    for (int i = 0; i < C::VPW; ++i) { const int off = ((wid + 8 * i) * 64 + lane) * 16, st = off >> 9, within = off & 511, kk = (st / NCB) * 8 + (within >> 6);
        const int k = (kk & ~0xC) | ((kk & 4) << 1) | ((kk & 8) >> 1), col = (st % NCB) * 32 + ((within & 63) >> 1);
        vso[i] = (unsigned)(k * vp + col); }
#define ATT_DMA(j, bf) do { const bf16_t* kt_ = Kh + (size_t)(j) * 64 * kp; const bf16_t* vt_ = Vh + (size_t)(j) * 64 * vp; \
        _Pragma("unroll") for (int i = 0; i < C::KPW; ++i) if (wid + 8 * i < C::NKP) \
            __builtin_amdgcn_global_load_lds((const unsigned*)(kt_ + kso[i]), (LAS unsigned*)(lds + C::OFF_K + (bf) * C::KB + (wid + 8 * i) * 1024), 16, 0, 0); \
        _Pragma("unroll") for (int i = 0; i < C::VPW; ++i) \
            __builtin_amdgcn_global_load_lds((const unsigned*)(vt_ + vso[i]), (LAS unsigned*)(lds + C::OFF_V + (bf) * C::VB + (wid + 8 * i) * 1024), 16, 0, 0); } while (0)
    ATT_DMA(j_lo, 0);
    bf16x8 qr[DQK / 16];
#pragma unroll
    for (int d0 = 0; d0 < DQK / 16; ++d0) qr[d0] = *(const bf16x8*)(Qh + (size_t)qpos * qp + d0 * 16 + hi * 8);
    float m_reg = -1e30f, l_reg = 0.f;
    f32x16 o[NCB];
#pragma unroll
    for (int d = 0; d < NCB; ++d) o[d] = f32x16{};
    const int koff = r32 * C::KP + hi * 16;
    const unsigned vb0 = (unsigned)(uintptr_t)(lds + C::OFF_V) + (unsigned)v_rd_base(lane);
    asm volatile("s_waitcnt vmcnt(0)" ::: "memory");
    __syncthreads();
    for (int t = 0; t < NT; ++t) {
        const int buf = t & 1;
        if (t + 1 < NT) ATT_DMA(j_lo + t + 1, buf ^ 1);
        const int kb = (j_lo + t) * 64;
#pragma unroll
        for (int hf = 0; hf < 2; ++hf) {
            const int kb2 = kb + 32 * hf;
            bool act = kb2 <= qlo + 31;
            if (MODE == 1) act = act && (qlo - kb2 - 31 <= 2048);
            if (act) {
                f32x16 p = f32x16{};
                const LAS unsigned char* kbase = lds + C::OFF_K + buf * C::KB + hf * 32 * C::KP + koff;
#pragma unroll
                for (int d0 = 0; d0 < DQK / 16; ++d0) {
                    const bf16x8 b0 = *(const LAS bf16x8*)(kbase + d0 * 32);
                    p = __builtin_amdgcn_mfma_f32_32x32x16_bf16(b0, qr[d0], p, 0, 0, 0);
                    if ((d0 & 3) == 3) __builtin_amdgcn_sched_barrier(0);
                }
                const int dq = qpos - kb2 - 4 * hi;
                if (MODE == 0) {
                    if (kb2 + 31 > qlo) {
                        const float NEG = -__builtin_inff();
#pragma unroll
                        for (int r = 0; r < 16; ++r) { const int c = (r & 3) + 8 * (r >> 2); if (dq - c < 0) p[r] = NEG; }
                    }
                } else {
#pragma unroll
                    for (int r = 0; r < 16; ++r) { const int c = (r & 3) + 8 * (r >> 2);
                        unsigned i0 = (unsigned)(dq - c); i0 = i0 < 2049u ? i0 : 2049u; p[r] += lut[i0]; }
                }
                float pmax = p[0];
#pragma unroll
                for (int r = 1; r < 16; ++r) pmax = fmaxf(pmax, p[r]);
                { auto rr = __builtin_amdgcn_permlane32_swap(__float_as_uint(pmax), __float_as_uint(pmax), false, false);
                  pmax = fmaxf(__uint_as_float(rr[0]), __uint_as_float(rr[1])); }
                const float mn = fmaxf(m_reg, pmax);
                const float alpha = __builtin_amdgcn_exp2f(m_reg - mn);
                m_reg = mn;
                float ps = 0.f;
#pragma unroll
                for (int r = 0; r < 16; ++r) { p[r] = __builtin_amdgcn_exp2f(p[r] - mn); ps += p[r]; }
                { auto rr = __builtin_amdgcn_permlane32_swap(__float_as_uint(ps), __float_as_uint(ps), false, false);
                  ps = __uint_as_float(rr[0]) + __uint_as_float(rr[1]); }
                l_reg = l_reg * alpha + ps;
                bf16x8 pa0, pa1;
#define ATT_PK4(P, B_, OUT) do { unsigned a0 = cvt_pk_bf16(P[B_+0], P[B_+1]), a1 = cvt_pk_bf16(P[B_+2], P[B_+3]);                          \
                unsigned b0_ = cvt_pk_bf16(P[B_+4], P[B_+5]), b1_ = cvt_pk_bf16(P[B_+6], P[B_+7]);                                             \
                auto r0 = __builtin_amdgcn_permlane32_swap(a0, b0_, false, false); auto r1 = __builtin_amdgcn_permlane32_swap(a1, b1_, false, false); \
                u32x4 w = {r0[0], r1[0], r0[1], r1[1]}; OUT = __builtin_bit_cast(bf16x8, w); } while (0)
                ATT_PK4(p, 0, pa0); ATT_PK4(p, 8, pa1);
#undef ATT_PK4
                if (__any(alpha < 1.f)) {
                    if (hi == 0) wsf[r32] = alpha;
                    asm volatile("s_waitcnt lgkmcnt(0)" ::: "memory");
#pragma unroll
                    for (int r = 0; r < 16; ++r) { const float a = wsf[crow(r, hi)];
#pragma unroll
                        for (int d = 0; d < NCB; ++d) o[d][r] *= a; }
                }
                const unsigned vb = vb0 + (unsigned)(buf * C::VB);
                constexpr int KS = NCB * 1024, HF = NCB * 512;
#pragma unroll
                for (int d0 = 0; d0 < NCB; ++d0) {
                    s16x4 l0, l1, h0, h1;
#define ATT_TRRD(dst, off) asm volatile("ds_read_b64_tr_b16 %0, %1 offset:%2" : "=&v"(dst) : "v"(vb), "i"(off) : "memory")
                    if (hf == 0) { ATT_TRRD(l0, d0 * 512 + 0 * KS); ATT_TRRD(h0, d0 * 512 + 0 * KS + HF); ATT_TRRD(l1, d0 * 512 + 1 * KS); ATT_TRRD(h1, d0 * 512 + 1 * KS + HF); }
                    else         { ATT_TRRD(l0, d0 * 512 + 2 * KS); ATT_TRRD(h0, d0 * 512 + 2 * KS + HF); ATT_TRRD(l1, d0 * 512 + 3 * KS); ATT_TRRD(h1, d0 * 512 + 3 * KS + HF); }
#undef ATT_TRRD
                    asm volatile("s_waitcnt lgkmcnt(0)" ::: "memory"); __builtin_amdgcn_sched_barrier(0);
                    o[d0] = __builtin_amdgcn_mfma_f32_32x32x16_bf16(pa0, (bf16x8){l0[0], l0[1], l0[2], l0[3], h0[0], h0[1], h0[2], h0[3]}, o[d0], 0, 0, 0);
                    o[d0] = __builtin_amdgcn_mfma_f32_32x32x16_bf16(pa1, (bf16x8){l1[0], l1[1], l1[2], l1[3], h1[0], h1[1], h1[2], h1[3]}, o[d0], 0, 0, 0);
                }
            }
        }
        asm volatile("s_waitcnt vmcnt(0)" ::: "memory");
        __syncthreads();
    }
#undef ATT_DMA
    if (hi == 0) wsf[32 + r32] = l_reg;
    asm volatile("s_waitcnt lgkmcnt(0)" ::: "memory");
    bf16_t* Ow = Oh + (size_t)qlo * op;
#pragma unroll
    for (int r = 0; r < 16; ++r) { const int orow = crow(r, hi); const float rl = __builtin_amdgcn_rcpf(wsf[32 + orow]);
#pragma unroll
        for (int d0 = 0; d0 < NCB; ++d0) { const float v = o[d0][r] * rl; const float vn = __shfl_xor(v, 1);
            if ((r32 & 1) == 0) *(unsigned*)(Ow + (size_t)orow * op + d0 * 32 + r32) = cvt_pk_bf16(v, vn); } }
    __syncthreads();
}
}

constexpr int NWAVES = 8;
constexpr size_t MiB = 1u << 20;
constexpr size_t WS_CTL = 0, CTL_ZERO_BYTES = 1 * MiB;
constexpr size_t WS_WEIN = 2 * MiB;
constexpr size_t WS_WEOUT = 12 * MiB;
constexpr size_t WS_WOIN = 16 * MiB;
constexpr size_t WS_WUQ = 20 * MiB;
constexpr size_t WS_WUKV = 23 * MiB;
constexpr size_t WS_WOOUT = 25 * MiB;
constexpr size_t WS_B1P = 29 * MiB;
constexpr size_t WS_SSQ = 30 * MiB;
constexpr size_t WS_TOKER = 31 * MiB;
constexpr size_t WS_TOKG = 31 * MiB + 512 * 1024;
constexpr size_t WS_XN = 32 * MiB;
constexpr size_t WS_Z = 64 * MiB;
constexpr size_t WS_MIX = 144 * MiB;
constexpr size_t WS_QR = 176 * MiB;
constexpr size_t WS_KVR = 224 * MiB;
constexpr size_t WS_QF = 288 * MiB;
constexpr size_t WS_KF = 336 * MiB;
constexpr size_t WS_W1 = 384 * MiB;
constexpr size_t WS_W2 = 896 * MiB;
constexpr size_t WS_XG = 1152 * MiB;
constexpr size_t WS_ACT = 2176 * MiB;
constexpr size_t WS_END = 3200 * MiB;
constexpr int CW_TMO = 0, CW_CODE = 1, CW_BAR = 4096, CW_CNT = 16384;
constexpr int RING_OFF = 0, RING_BYTES = 131072;
constexpr int LDSCTL_OFF = RING_BYTES, MISC_OFF = LDSCTL_OFF + 320;
constexpr int SCR_OFF = RING_BYTES + 1024;
constexpr int LDS_BYTES = 155648;
constexpr int SCR_BYTES = LDS_BYTES - SCR_OFF;

typedef GAS unsigned gu32;
#define RLX_AGENT __ATOMIC_RELAXED, __HIP_MEMORY_SCOPE_AGENT

#define XB_TMO      128
#define XB_XCNT(j)  (256  + 64 * (j))
#define XB_XSUB(j)  (1280 + 64 * (j))
#define XB_XGEN(j)  (2304 + 64 * (j))
#define XB_TOP      3328
#define XB_TOPGEN   3392
#define XCD_BAR_WORDS 3456
#define XB_SPIN_CAP (1u << 18)
__device__ __forceinline__ unsigned xb_ld(unsigned* p)              { return __hip_atomic_load(p, __ATOMIC_RELAXED, __HIP_MEMORY_SCOPE_AGENT); }
__device__ __forceinline__ unsigned xb_add(unsigned* p, unsigned v) { return __hip_atomic_fetch_add(p, v, __ATOMIC_RELAXED, __HIP_MEMORY_SCOPE_AGENT); }
__device__ __forceinline__ unsigned xb_xcc_id() { return (unsigned)__builtin_amdgcn_s_getreg((3 << 11) | 20) & 0xFu; }
#define XB_SPIN(cond, bar) do { unsigned _sp = 0; while (cond) { __builtin_amdgcn_s_sleep(1); \
    if ((++_sp & 255u) == 0u) { if (xb_ld(&(bar)[XB_TMO])) break; if (_sp > XB_SPIN_CAP) { atomicAdd(&(bar)[XB_TMO], 1u); break; } } } } while (0)
struct XcdBarrier { unsigned* bar; unsigned x; volatile LAS unsigned* st; };
__device__ __forceinline__ XcdBarrier xcd_barrier_post(unsigned* bar, volatile LAS unsigned* st) {
    XcdBarrier b; b.bar = bar; b.x = xb_xcc_id(); b.st = st;
    if (threadIdx.x == 0) (void)xb_add(&bar[XB_XCNT(b.x)], 1u);
    return b;
}
__device__ __forceinline__ void xcd_barrier_complete(unsigned* bar, unsigned x, unsigned& nloc, unsigned& nx) {
    const unsigned G = gridDim.x * gridDim.y * gridDim.z;
    unsigned sum, cnt, mine, sp = 0u;
    for (;;) {
        sum = 0u; cnt = 0u; mine = 0u;
#pragma unroll
        for (unsigned j = 0; j < 16; ++j) { const unsigned c = xb_ld(&bar[XB_XCNT(j)]); sum += c; cnt += (c > 0u) ? 1u : 0u; mine = (j == x) ? c : mine; }
        if (sum == G) break;
        __builtin_amdgcn_s_sleep(1);
        if ((++sp & 255u) == 0u) { if (xb_ld(&bar[XB_TMO])) break; if (sp > XB_SPIN_CAP) { atomicAdd(&bar[XB_TMO], 1u); break; } }
    }
    nloc = mine > 0u ? mine : 1u; nx = cnt > 0u ? cnt : 1u;
}
__device__ __forceinline__ void xcd_barrier(const XcdBarrier& b) {
    asm volatile("s_waitcnt vmcnt(0)" ::: "memory");
    __syncthreads();
    if (threadIdx.x == 0) {
        unsigned* bar = b.bar;
        __builtin_amdgcn_s_waitcnt(0);
        unsigned nloc = b.st[0], nx = b.st[1];
        if (nloc == 0u) { xcd_barrier_complete(bar, b.x, nloc, nx); b.st[0] = nloc; b.st[1] = nx; }
        const unsigned old = xb_add(&bar[XB_XSUB(b.x)], 1u);
        const unsigned gen = old / nloc;
        if (old + 1u == (gen + 1u) * nloc) {
            __builtin_amdgcn_fence(__ATOMIC_RELEASE, "agent");
            asm volatile("s_waitcnt vmcnt(0)" ::: "memory");
            const unsigned og = xb_add(&bar[XB_TOP], 1u);
            const unsigned tg = og / nx;
            if (og + 1u == (tg + 1u) * nx) xb_add(&bar[XB_TOPGEN], 1u);
            else XB_SPIN(xb_ld(&bar[XB_TOPGEN]) == tg, bar);
            __builtin_amdgcn_fence(__ATOMIC_ACQUIRE, "agent");
            xb_add(&bar[XB_XGEN(b.x)], 1u);
            asm volatile("s_waitcnt vmcnt(0)" ::: "memory");
        } else {
            XB_SPIN(xb_ld(&bar[XB_XGEN(b.x)]) == gen, bar);
            __builtin_amdgcn_fence(__ATOMIC_ACQUIRE, "agent");
            asm volatile("s_waitcnt vmcnt(0)" ::: "memory");
        }
    }
    __syncthreads();
}

struct Args {
    const float* in[24]; float* out; unsigned char* ws; int stage_limit; int pad;
};
enum { I_X = 0, I_MIXN, I_FFNN, I_EWIN, I_EWS, I_EBS, I_EGV, I_EGQ, I_EGK, I_EWOUT, I_OWIN, I_OGCQ, I_OGCKV, I_OWUQ, I_OWUKV, I_OGQ, I_OGK, I_OWOUT,
       I_RW, I_RB, I_W1, I_B1, I_W2, I_B2 };

struct Frame {
    LAS unsigned char* lds;
    int vcu, G;
};

__device__ __forceinline__ float wave_sum(float v) {
#pragma unroll
    for (int o = 1; o < 64; o <<= 1) v += __shfl_xor(v, o);
    return v;
}
#define LDS_WAIT() asm volatile("s_waitcnt lgkmcnt(0)" ::: "memory")

template <int MODE> __device__ __forceinline__ int dst_row(int o) {
    if (MODE == 1) { if (o >= 1024 && o < 2048) return (o & ~255) | (((o >> 5) & 1) << 7) | (((o >> 6) & 3) << 5) | (o & 31); return o; }
    if (MODE == 2) return ((o >> 8) << 8) | ((o & 1) << 7) | ((o & 255) >> 1);
    return o;
}
template <int MODE>
__device__ __forceinline__ void transpose_item(const float* __restrict__ W, int K, int N, bf16_t* __restrict__ WT, const float* __restrict__ gain, LAS float* scr, int item, int lane) {
    const int nblk = N / 32, kb = item / nblk, nb = item % nblk, k0 = 64 * kb, n0 = 32 * nb;
#pragma unroll 8
    for (int i = 0; i < 32; ++i) { const int kk = 2 * i + (lane >> 5); float w = W[(size_t)(k0 + kk) * N + n0 + (lane & 31)]; if (gain) w *= gain[k0 + kk]; scr[kk * 33 + (lane & 31)] = w; }
    LDS_WAIT(); asm volatile("" ::: "memory");
    const int c = lane & 7;
#pragma unroll
    for (int j = 0; j < 4; ++j) { const int n = (lane >> 3) + 8 * j; const LAS float* s = scr + (8 * c) * 33 + n;
        u32x4 o; o.x = cvt_pk_bf16(s[0 * 33], s[1 * 33]); o.y = cvt_pk_bf16(s[2 * 33], s[3 * 33]); o.z = cvt_pk_bf16(s[4 * 33], s[5 * 33]); o.w = cvt_pk_bf16(s[6 * 33], s[7 * 33]);
        *(u32x4*)(WT + (size_t)dst_row<MODE>(n0 + n) * K + k0 + 8 * c) = o; }
    LDS_WAIT(); asm volatile("" ::: "memory");
}
template <int MODE>
__device__ __forceinline__ void transpose_job(Frame& F, const float* W, int K, int N, int nmat, size_t src_stride, bf16_t* WT, size_t dst_stride, const float* gain, int gain_stride) {
    int tid_ = threadIdx.x; asm volatile("" : "+v"(tid_));
    const int wave = __builtin_amdgcn_readfirstlane(tid_ >> 6), lane = tid_ & 63;
    LAS float* scr = (LAS float*)(F.lds + RING_OFF + wave * 16384);
    const int gw = F.vcu * NWAVES + wave, NGW = F.G * NWAVES;
    const int per = (K / 64) * (N / 32), total = per * nmat;
    for (int it = gw; it < total; it += NGW) { const int mi = it / per, item = it - mi * per;
        transpose_item<MODE>(W + (size_t)mi * src_stride, K, N, WT + (size_t)mi * dst_stride, gain ? gain + (size_t)mi * gain_stride : nullptr, scr, item, lane); }
}


template <int MODE>
__device__ __forceinline__ void transpose_item_fp8(const float* __restrict__ W, int K, int N, unsigned char* __restrict__ WT, LAS float* scr, int item, int lane) {
    const int nblk = N / 32, kb = item / nblk, nb = item % nblk, k0 = 64 * kb, n0 = 32 * nb;
#pragma unroll 8
    for (int i = 0; i < 32; ++i) { const int kk = 2 * i + (lane >> 5); scr[kk * 33 + (lane & 31)] = W[(size_t)(k0 + kk) * N + n0 + (lane & 31)] * W8_SCALE; }
    LDS_WAIT(); asm volatile("" ::: "memory");
    const int c = lane & 3;
#pragma unroll
    for (int j = 0; j < 2; ++j) { const int n = (lane >> 2) + 16 * j; const LAS float* s = scr + (16 * c) * 33 + n;
        u32x4 o; o.x = pk4_fp8(s[0 * 33], s[1 * 33], s[2 * 33], s[3 * 33]); o.y = pk4_fp8(s[4 * 33], s[5 * 33], s[6 * 33], s[7 * 33]);
        o.z = pk4_fp8(s[8 * 33], s[9 * 33], s[10 * 33], s[11 * 33]); o.w = pk4_fp8(s[12 * 33], s[13 * 33], s[14 * 33], s[15 * 33]);
        *(u32x4*)(WT + (size_t)dst_row<MODE>(n0 + n) * K + k0 + 16 * c) = o; }
    LDS_WAIT(); asm volatile("" ::: "memory");
}
template <int MODE>
__device__ __forceinline__ void transpose_job_fp8(Frame& F, const float* W, int K, int N, int nmat, size_t src_stride, unsigned char* WT, size_t dst_stride) {
    int tid_ = threadIdx.x; asm volatile("" : "+v"(tid_));
    const int wave = __builtin_amdgcn_readfirstlane(tid_ >> 6), lane = tid_ & 63;
    LAS float* scr = (LAS float*)(F.lds + RING_OFF + wave * 16384);
    const int gw = F.vcu * NWAVES + wave, NGW = F.G * NWAVES;
    const int per = (K / 64) * (N / 32), total = per * nmat;
    for (int it = gw; it < total; it += NGW) { const int mi = it / per, item = it - mi * per;
        transpose_item_fp8<MODE>(W + (size_t)mi * src_stride, K, N, WT + (size_t)mi * dst_stride, scr, item, lane); }
}

__device__ __forceinline__ void rms_row_to_bf16(int lane, const float* xrow, const float* g, bf16_t* orow, float* copy) {
    const f32x4* xr = (const f32x4*)xrow + lane; const f32x4* gr = (const f32x4*)g + lane;
    f32x4 v[4]; float s = 0.f;
#pragma unroll
    for (int j = 0; j < 4; ++j) { v[j] = xr[64 * j]; s += (v[j].x * v[j].x + v[j].y * v[j].y) + (v[j].z * v[j].z + v[j].w * v[j].w); }
    const float rstd = 1.0f / sqrtf(wave_sum(s) * (1.f / DM) + EPS);
    u32x2* o8 = (u32x2*)orow + lane;
#pragma unroll
    for (int j = 0; j < 4; ++j) { const f32x4 gg = gr[64 * j]; if (copy) ((f32x4*)copy + lane)[64 * j] = v[j];
        u32x2 w; w.x = cvt_pk_bf16(v[j].x * rstd * gg.x, v[j].y * rstd * gg.y); w.y = cvt_pk_bf16(v[j].z * rstd * gg.z, v[j].w * rstd * gg.w); o8[64 * j] = w; }
}

namespace pg8 {
struct EpiEvenIn {
    static constexpr bool PERM = false;
    bf16_t* Z; const float* gq; const float* gk;
    __device__ __forceinline__ void operator()(const f32x4 (&acc)[2][2][4][2], const Unit& u, int wr, int wc, int fr, int fq) const {
        const int row0 = u.pm * BM + wr * 64 + fr, pn = u.pn;
        if (pn >= 4 && pn < 8) {
            const float* g = pn < 6 ? gq : gk; const float sc = pn < 6 ? C2_B : 1.0f;
            f32x4 gv[2][2];
#pragma unroll
            for (int bj = 0; bj < 2; ++bj)
#pragma unroll
                for (int n = 0; n < 2; ++n) gv[bj][n] = *(const f32x4*)(g + 32 * bj + 16 * n + 4 * fq);
#pragma unroll
            for (int ai = 0; ai < 2; ++ai)
#pragma unroll
                for (int m = 0; m < 4; ++m) {
                    float ss = 0.f;
#pragma unroll
                    for (int bj = 0; bj < 2; ++bj)
#pragma unroll
                        for (int n = 0; n < 2; ++n) { const f32x4 v = acc[ai][bj][m][n]; ss += (v[0] * v[0] + v[1] * v[1]) + (v[2] * v[2] + v[3] * v[3]); }
                    ss += __shfl_xor(ss, 16); ss += __shfl_xor(ss, 32);
                    const float rstd = sc / sqrtf(ss * (1.0f / 64.0f) + EPS);
                    bf16_t* rowp = Z + (size_t)(row0 + ai * HALF + m * 16) * EVEN_IN + pn * BM + wc * 64 + 4 * fq;
#pragma unroll
                    for (int bj = 0; bj < 2; ++bj)
#pragma unroll
                        for (int n = 0; n < 2; ++n) { const f32x4 v = acc[ai][bj][m][n] * rstd * gv[bj][n];
                            u32x2 w; w.x = cvt_pk_bf16(v[0], v[1]); w.y = cvt_pk_bf16(v[2], v[3]); *(u32x2*)(rowp + 32 * bj + 16 * n) = w; }
                }
        } else {
            const bool act = pn < 4;
#pragma unroll
            for (int ai = 0; ai < 2; ++ai)
#pragma unroll
                for (int m = 0; m < 4; ++m) { bf16_t* rowp = Z + (size_t)(row0 + ai * HALF + m * 16) * EVEN_IN + pn * BM + wc * 32 + 4 * fq;
#pragma unroll
                    for (int bj = 0; bj < 2; ++bj)
#pragma unroll
                        for (int n = 0; n < 2; ++n) { f32x4 v = acc[ai][bj][m][n]; if (act) v = gelu4(v);
                            u32x2 w; w.x = cvt_pk_bf16(v[0], v[1]); w.y = cvt_pk_bf16(v[2], v[3]); *(u32x2*)(rowp + bj * HALF + 16 * n) = w; } }
        }
    }
};
struct EpiResid {
    static constexpr bool PERM = false;
    float* out;
    __device__ __forceinline__ void operator()(const f32x4 (&acc)[2][2][4][2], const Unit& u, int wr, int wc, int fr, int fq) const {
        const int row0 = u.pm * BM + wr * 64 + fr;
#pragma unroll
        for (int ai = 0; ai < 2; ++ai)
#pragma unroll
            for (int m = 0; m < 4; ++m) { float* rowp = out + (size_t)(row0 + ai * HALF + m * 16) * DM + u.pn * BM + wc * 32 + 4 * fq;
#pragma unroll
                for (int bj = 0; bj < 2; ++bj)
#pragma unroll
                    for (int n = 0; n < 2; ++n) { f32x4* p = (f32x4*)(rowp + bj * HALF + 16 * n); *p = *p + acc[ai][bj][m][n]; }
                if (m & 1) asm volatile("" ::: "memory"); }
    }
};
struct EpiOddIn {
    static constexpr bool PERM = false;
    bf16_t* Z; float* ssq;
    __device__ __forceinline__ void operator()(const f32x4 (&acc)[2][2][4][2], const Unit& u, int wr, int wc, int fr, int fq) const {
        const int row0 = u.pm * BM + wr * 64 + fr, pn = u.pn;
#pragma unroll
        for (int ai = 0; ai < 2; ++ai)
#pragma unroll
            for (int m = 0; m < 4; ++m) { const int row = row0 + ai * HALF + m * 16; bf16_t* rowp = Z + (size_t)row * ODD_INP + pn * BM + wc * 32 + 4 * fq;
                float ss = 0.f;
#pragma unroll
                for (int bj = 0; bj < 2; ++bj)
#pragma unroll
                    for (int n = 0; n < 2; ++n) { const f32x4 v = acc[ai][bj][m][n]; ss += (v[0] * v[0] + v[1] * v[1]) + (v[2] * v[2] + v[3] * v[3]);
                        u32x2 w; w.x = cvt_pk_bf16(v[0], v[1]); w.y = cvt_pk_bf16(v[2], v[3]); *(u32x2*)(rowp + bj * HALF + 16 * n) = w; }
                ss += __shfl_xor(ss, 16); ss += __shfl_xor(ss, 32);
                if (fq == 0) ssq[(size_t)row * 16 + pn * 4 + wc] = ss; }
    }
};
template <int NS> struct EpiRowScale {
    static constexpr bool PERM = true;
    bf16_t* O; int ldc; const float* ssq; int s0; float inv_cols;
    __device__ __forceinline__ void operator()(const f32x4 (&acc)[2][2][4][2], const Unit& u, int wr, int wc, int fr, int fq) const {
        const int row0 = u.pm * BM + wr * 64 + fr; const int col0 = u.pn * BM + wc * 32 + 8 * fq;
#pragma unroll
        for (int ai = 0; ai < 2; ++ai)
#pragma unroll
            for (int m = 0; m < 4; ++m) { const int row = row0 + ai * HALF + m * 16;
                float ss = 0.f; const f32x4* sp = (const f32x4*)(ssq + (size_t)row * 16 + s0);
#pragma unroll
                for (int q = 0; q < NS; ++q) { const f32x4 t = sp[q]; ss += (t[0] + t[1]) + (t[2] + t[3]); }
                const float rstd = 1.0f / sqrtf(ss * inv_cols + EPS);
                bf16_t* rowp = O + (size_t)row * ldc + col0;
#pragma unroll
                for (int bj = 0; bj < 2; ++bj) { const f32x4 v0 = acc[ai][bj][m][0] * rstd, v1 = acc[ai][bj][m][1] * rstd;
                    u32x4 w; w.x = cvt_pk_bf16(v0[0], v0[1]); w.y = cvt_pk_bf16(v0[2], v0[3]); w.z = cvt_pk_bf16(v1[0], v1[1]); w.w = cvt_pk_bf16(v1[2], v1[3]);
                    *(u32x4*)(rowp + bj * HALF) = w; }
                asm volatile("" ::: "memory"); }
    }
};
struct EpiSwiglu {
    static constexpr bool PERM = true;
    unsigned char* ACT; const float* b1p;
    __device__ __forceinline__ void operator()(const f32x4 (&acc)[2][2][4][2], const Unit& u, int wr, int wc, int fr, int fq) const {
        const int row0 = u.pm * BM + wr * 64 + fr, e = u.pb >> 3, pn = u.pn;
        const float* bp = b1p + (size_t)e * 2048 + pn * BM + wc * 32 + 8 * fq;
        f32x4 bg[2], bl[2];
#pragma unroll
        for (int n = 0; n < 2; ++n) { bg[n] = *(const f32x4*)(bp + 4 * n); bl[n] = *(const f32x4*)(bp + HALF + 4 * n); }
#pragma unroll
        for (int ai = 0; ai < 2; ++ai)
#pragma unroll
            for (int m = 0; m < 4; ++m) { unsigned char* rowp = ACT + (size_t)(row0 + ai * HALF + m * 16) * DE + pn * HALF + wc * 32 + 8 * fq;
                float a[8];
#pragma unroll
                for (int n = 0; n < 2; ++n) { const f32x4 gv = acc[ai][0][m][n] * W8_INV + bg[n], lv = acc[ai][1][m][n] * W8_INV + bl[n];
#pragma unroll
                    for (int i = 0; i < 4; ++i) { const float gl = fminf(gv[i], 7.0f), li = fminf(fmaxf(lv[i], -7.0f), 7.0f);
                        const float sg = __builtin_amdgcn_rcpf(1.0f + __builtin_amdgcn_exp2f(-1.702f * LOG2E * gl));
                        a[4 * n + i] = gl * sg * (li + 1.0f); } }
                u32x2 w; w.x = pk4_fp8(a[0], a[1], a[2], a[3]); w.y = pk4_fp8(a[4], a[5], a[6], a[7]);
                *(u32x2*)rowp = w; }
    }
};
struct EpiDown {
    static constexpr bool PERM = true;
    bf16_t* Y; const float* b2;
    __device__ __forceinline__ void operator()(const f32x4 (&acc)[2][2][4][2], const Unit& u, int wr, int wc, int fr, int fq) const {
        const int row0 = u.pm * BM + wr * 64 + fr, e = u.pb >> 2, pn = u.pn;
        const float* bp = b2 + (size_t)e * DM + pn * BM + wc * 32 + 8 * fq;
        f32x4 bv[2][2];
#pragma unroll
        for (int bj = 0; bj < 2; ++bj)
#pragma unroll
            for (int n = 0; n < 2; ++n) bv[bj][n] = *(const f32x4*)(bp + bj * HALF + 4 * n);
#pragma unroll
        for (int ai = 0; ai < 2; ++ai)
#pragma unroll
            for (int m = 0; m < 4; ++m) { bf16_t* rowp = Y + (size_t)(row0 + ai * HALF + m * 16) * DM + pn * BM + wc * 32 + 8 * fq;
#pragma unroll
                for (int bj = 0; bj < 2; ++bj) { const f32x4 v0 = acc[ai][bj][m][0] * W8_INV + bv[bj][0], v1 = acc[ai][bj][m][1] * W8_INV + bv[bj][1];
                    u32x4 w; w.x = cvt_pk_bf16(v0[0], v0[1]); w.y = cvt_pk_bf16(v0[2], v0[3]); w.z = cvt_pk_bf16(v1[0], v1[1]); w.w = cvt_pk_bf16(v1[2], v1[3]);
                    *(u32x4*)(rowp + bj * HALF) = w; } }
    }
};
struct MoeOrder {
    const LAS int* tbl; int nN, G, c;
    __device__ bool next(int i, Unit& u) const {
        const long L = (long)i * G + c; const int rb = (int)(L / nN);
        if (rb >= __builtin_amdgcn_readfirstlane(tbl[32])) return false;
        int e = 0;
#pragma unroll
        for (int k = 1; k < 32; ++k) e += (tbl[k] <= rb) ? 1 : 0;
        e = __builtin_amdgcn_readfirstlane(e); const int rbl = __builtin_amdgcn_readfirstlane(rb - tbl[e]);
        u.pm = e * (ECAP / BM) + rbl; u.pn = (int)(L % nN); u.pb = e * nN + u.pn; return true;
    }
};
}

__device__ __forceinline__ void gmlp_unit(Frame& F, const bf16_t* Z, bf16_t* MIX, const float* Ws, const float* bs, const float* gv, int unit) {
    constexpr int VP = 272;
    LAS unsigned char* VT = F.lds + RING_OFF;
    const int h = unit & 3, chunk = unit >> 2;
    int tid_ = threadIdx.x; asm volatile("" : "+v"(tid_));
    const int t0 = chunk * 128, tid = tid_, lane = tid & 63, w = __builtin_amdgcn_readfirstlane(tid >> 6);
    {
        const int s = tid >> 2, dq = (tid & 3) * 32;
        const bf16_t* vp = Z + (size_t)(t0 + s) * EVEN_IN + 512 + h * 128 + dq;
        u32x4 raw[4]; float ss = 0.f;
#pragma unroll
        for (int i = 0; i < 4; ++i) { raw[i] = *(const u32x4*)(vp + 8 * i);
#pragma unroll
            for (int j = 0; j < 4; ++j) { const float a = bflo(raw[i][j]), b = bfhi(raw[i][j]); ss += a * a + b * b; } }
        ss += __shfl_xor(ss, 1); ss += __shfl_xor(ss, 2);
        const float rstd = 1.0f / sqrtf(ss * (1.0f / 128.0f) + EPS);
#pragma unroll
        for (int i = 0; i < 4; ++i)
#pragma unroll
            for (int j = 0; j < 4; ++j) { const int d = dq + 8 * i + 2 * j;
                *(LAS bf16_t*)(VT + (d) * VP + s * 2) = f2bf(bflo(raw[i][j]) * rstd);
                *(LAS bf16_t*)(VT + (d + 1) * VP + s * 2) = f2bf(bfhi(raw[i][j]) * rstd); }
    }
    __syncthreads();
    const int fr = lane & 15, fq = lane >> 4;
    f32x4 acc[8];
#pragma unroll
    for (int nb = 0; nb < 8; ++nb) acc[nb] = (f32x4){0.f, 0.f, 0.f, 0.f};
    const int trow = 16 * w + fr;
    const float* wrow = Ws + ((size_t)h * 128 + trow) * 128;
#pragma unroll
    for (int ks = 0; ks < 4; ++ks) {
        if (32 * ks <= 16 * w + 15) {
            const int s0 = 32 * ks + 8 * fq;
            const f32x4 wa = *(const f32x4*)(wrow + s0), wb = *(const f32x4*)(wrow + s0 + 4);
            float wv[8] = {wa[0], wa[1], wa[2], wa[3], wb[0], wb[1], wb[2], wb[3]};
#pragma unroll
            for (int j = 0; j < 8; ++j) if (s0 + j > trow) wv[j] = 0.f;
            u32x4 aw; aw.x = cvt_pk_bf16(wv[0], wv[1]); aw.y = cvt_pk_bf16(wv[2], wv[3]); aw.z = cvt_pk_bf16(wv[4], wv[5]); aw.w = cvt_pk_bf16(wv[6], wv[7]);
            const bf16x8 af = __builtin_bit_cast(bf16x8, aw);
#pragma unroll
            for (int nb = 0; nb < 8; ++nb) { const bf16x8 bfr = *(const LAS bf16x8*)(VT + (16 * nb + fr) * VP + s0 * 2);
                acc[nb] = __builtin_amdgcn_mfma_f32_16x16x32_bf16(af, bfr, acc[nb], 0, 0, 0); }
        }
    }
#pragma unroll
    for (int i = 0; i < 4; ++i) { const int tl = 16 * w + 4 * fq + i; const float bt = bs[h * 128 + tl];
        const bf16_t* up = Z + (size_t)(t0 + tl) * EVEN_IN + h * 128 + fr; bf16_t* op = MIX + (size_t)(t0 + tl) * DM + h * 128 + fr;
#pragma unroll
        for (int nb = 0; nb < 8; ++nb) { const float uu = bf2f(up[16 * nb]); op[16 * nb] = f2bf(uu * (gv[h * 128 + 16 * nb + fr] * acc[nb][i] + bt)); } }
    __syncthreads();
}

__device__ __forceinline__ void router_phase(Frame& F, const float* x, const float* gain, const float* Wr, const float* br, gu32* cnt  ,
                                             unsigned* tok_er, float* tok_g, unsigned char* XG) {
    LAS float* WrT = (LAS float*)(F.lds + RING_OFF);
    LAS float* lg = (LAS float*)(F.lds + SCR_OFF);
    LAS unsigned* hist = (LAS unsigned*)(F.lds + SCR_OFF + 64 * 33 * 4);
    LAS unsigned* base = hist + 32;
    LAS unsigned* ers = base + 32;
    int tid_ = threadIdx.x; asm volatile("" : "+v"(tid_));
    const int tid = tid_, lane = tid & 63, w = __builtin_amdgcn_readfirstlane(tid >> 6);
    for (int idx = tid; idx < 8192; idx += 512) { const int e4 = idx >> 10, k = idx & 1023; const f32x4 v = *(const f32x4*)(Wr + (size_t)k * 32 + 4 * e4);
        WrT[(4 * e4 + 0) * 1024 + k] = v[0]; WrT[(4 * e4 + 1) * 1024 + k] = v[1]; WrT[(4 * e4 + 2) * 1024 + k] = v[2]; WrT[(4 * e4 + 3) * 1024 + k] = v[3]; }
    __syncthreads();
    f32x4 gg[4];
#pragma unroll
    for (int j = 0; j < 4; ++j) gg[j] = ((const f32x4*)gain + lane)[64 * j];
    const float brl = br[lane & 31];
    for (int tg = F.vcu; tg < M / 64; tg += F.G) {
    const int tokb = tg * 64;
    if (tid < 32) hist[tid] = 0u;
    for (int tt = 0; tt < 8; ++tt) {
        const int tl = w * 8 + tt; const float* xrow = x + (size_t)(tokb + tl) * DM;
        f32x4 hv[4]; float s = 0.f;
#pragma unroll
        for (int j = 0; j < 4; ++j) { hv[j] = ((const f32x4*)xrow + lane)[64 * j]; s += (hv[j].x * hv[j].x + hv[j].y * hv[j].y) + (hv[j].z * hv[j].z + hv[j].w * hv[j].w); }
        const float rstd = 1.0f / sqrtf(wave_sum(s) * (1.f / DM) + EPS);
#pragma unroll
        for (int j = 0; j < 4; ++j) hv[j] = hv[j] * rstd * gg[j];
        float a[32];
#pragma unroll
        for (int e = 0; e < 32; ++e) { float t = 0.f;
#pragma unroll
            for (int j = 0; j < 4; ++j) { const f32x4 wv = *(const LAS f32x4*)(WrT + e * 1024 + 256 * j + 4 * lane); t += (hv[j].x * wv.x + hv[j].y * wv.y) + (hv[j].z * wv.z + hv[j].w * wv.w); }
            a[e] = t; }
#define RSTEP(N, BIT) _Pragma("unroll") for (int i = 0; i < N; ++i) { const bool up = (lane & BIT) != 0; const float keep = up ? a[2 * i + 1] : a[2 * i], send = up ? a[2 * i] : a[2 * i + 1]; a[i] = keep + __shfl_xor(send, BIT); }
        RSTEP(16, 1) RSTEP(8, 2) RSTEP(4, 4) RSTEP(2, 8) RSTEP(1, 16)
#undef RSTEP
        float logit = a[0] + __shfl_xor(a[0], 32) + brl;
        if (lane < 32) lg[tl * 33 + lane] = logit;
    }
    __syncthreads();
    unsigned my_e[4] = {0, 0, 0, 0}, my_lr[4] = {0, 0, 0, 0}; float my_g[4] = {0, 0, 0, 0};
    if (tid < 64) {
        float v[32];
#pragma unroll
        for (int e = 0; e < 32; ++e) v[e] = lg[tid * 33 + e];
        int c0 = -1, c1 = -1, c2 = -1; float tv[4];
#pragma unroll
        for (int r = 0; r < 4; ++r) { float best = -__builtin_inff(); int bi = 0;
#pragma unroll
            for (int e = 0; e < 32; ++e) { const bool ok = (e != c0) && (e != c1) && (e != c2); if (ok && v[e] > best) { best = v[e]; bi = e; } }
            tv[r] = best; my_e[r] = (unsigned)bi; if (r == 0) c0 = bi; else if (r == 1) c1 = bi; else if (r == 2) c2 = bi; }
        const float p1 = __expf(tv[1] - tv[0]), p2 = __expf(tv[2] - tv[0]), p3 = __expf(tv[3] - tv[0]); const float inv = 1.0f / (1.0f + p1 + p2 + p3);
        my_g[0] = inv; my_g[1] = p1 * inv; my_g[2] = p2 * inv; my_g[3] = p3 * inv;
#pragma unroll
        for (int r = 0; r < 4; ++r) my_lr[r] = __hip_atomic_fetch_add(hist + my_e[r], 1u, __ATOMIC_RELAXED, __HIP_MEMORY_SCOPE_WORKGROUP);
    }
    __syncthreads();
    if (tid < 32) { const unsigned hc = hist[tid]; base[tid] = hc ? __hip_atomic_fetch_add(cnt + 64 * tid, hc, RLX_AGENT) : 0u; }
    __syncthreads();
    if (tid < 64) {
        u32x4 er; f32x4 gt;
#pragma unroll
        for (int r = 0; r < 4; ++r) { const unsigned rank = base[my_e[r]] + my_lr[r]; er[r] = (my_e[r] << 16) | rank; gt[r] = my_g[r]; ers[tid * 4 + r] = er[r]; }
        *(u32x4*)(tok_er + (size_t)(tokb + tid) * 4) = er; *(f32x4*)(tok_g + (size_t)(tokb + tid) * 4) = gt;
    }
    __syncthreads();
    for (int tt = 0; tt < 8; ++tt) {
        const int tl = w * 8 + tt; const float* xrow = x + (size_t)(tokb + tl) * DM;
        f32x4 hv[4]; float s = 0.f;
#pragma unroll
        for (int j = 0; j < 4; ++j) { hv[j] = ((const f32x4*)xrow + lane)[64 * j]; s += (hv[j].x * hv[j].x + hv[j].y * hv[j].y) + (hv[j].z * hv[j].z + hv[j].w * hv[j].w); }
        const float rstd = 1.0f / sqrtf(wave_sum(s) * (1.f / DM) + EPS);
        unsigned wv[4];
#pragma unroll
        for (int j = 0; j < 4; ++j) { const f32x4 t = hv[j] * rstd * gg[j]; wv[j] = pk4_fp8(t.x, t.y, t.z, t.w); }
#pragma unroll
        for (int r = 0; r < 4; ++r) { const unsigned er = ers[tl * 4 + r]; const size_t slot = (size_t)(er >> 16) * ECAP + (er & 0xffffu);
            unsigned* o4 = (unsigned*)(XG + slot * DM) + lane;
#pragma unroll
            for (int j = 0; j < 4; ++j) o4[64 * j] = wv[j]; }
    }
    __syncthreads();
    }
}

__device__ __forceinline__ void combine_phase(Frame& F, const float* x, float* xout, const unsigned* tok_er, const float* tok_g, const bf16_t* Y, const float* g_next, bf16_t* XN) {
    int tid_ = threadIdx.x; asm volatile("" : "+v"(tid_));
    const int gw = F.vcu * NWAVES + __builtin_amdgcn_readfirstlane(tid_ >> 6), NGW = F.G * NWAVES, lane = tid_ & 63;
    for (int m = gw; m < M; m += NGW) {
        const u32x4 er = *(const u32x4*)(tok_er + (size_t)m * 4); const f32x4 gt = *(const f32x4*)(tok_g + (size_t)m * 4);
        f32x4 v[4]; const float* xrow = x + (size_t)m * DM; float* xorow = xout + (size_t)m * DM;
#pragma unroll
        for (int j = 0; j < 4; ++j) v[j] = ((const f32x4*)xrow + lane)[64 * j];
#pragma unroll
        for (int r = 0; r < 4; ++r) { const size_t slot = (size_t)(er[r] >> 16) * ECAP + (er[r] & 0xffffu); const u32x2* yp = (const u32x2*)(Y + slot * DM) + lane; const float g = gt[r];
#pragma unroll
            for (int j = 0; j < 4; ++j) { const u32x2 yv = yp[64 * j]; v[j].x += g * bflo(yv.x); v[j].y += g * bfhi(yv.x); v[j].z += g * bflo(yv.y); v[j].w += g * bfhi(yv.y); } }
#pragma unroll
        for (int j = 0; j < 4; ++j) ((f32x4*)xorow + lane)[64 * j] = v[j];
        if (g_next) {
            float s = 0.f;
#pragma unroll
            for (int j = 0; j < 4; ++j) s += (v[j].x * v[j].x + v[j].y * v[j].y) + (v[j].z * v[j].z + v[j].w * v[j].w);
            const float rstd = 1.0f / sqrtf(wave_sum(s) * (1.f / DM) + EPS);
            u32x2* o8 = (u32x2*)(XN + (size_t)m * DM) + lane;
#pragma unroll
            for (int j = 0; j < 4; ++j) { const f32x4 gg = ((const f32x4*)g_next + lane)[64 * j];
                u32x2 w; w.x = cvt_pk_bf16(v[j].x * rstd * gg.x, v[j].y * rstd * gg.y); w.y = cvt_pk_bf16(v[j].z * rstd * gg.z, v[j].w * rstd * gg.w); o8[64 * j] = w; }
        }
    }
}

__device__ __forceinline__ void mla_finalize_phase(Frame& F, const bf16_t* QR, const bf16_t* KVR, const bf16_t* Z, const float* gq, const float* gk, bf16_t* QF, bf16_t* KF) {
    int tid_ = threadIdx.x; asm volatile("" : "+v"(tid_));
    const int gw = F.vcu * NWAVES + __builtin_amdgcn_readfirstlane(tid_ >> 6), NGW = F.G * NWAVES, lane = tid_ & 63;
    const int fi = lane & 31;
    const float invf = __builtin_amdgcn_exp2f(-(float)fi * (13.287712379549449f / 32.0f));
    const float gq0 = gq[lane], gq1 = gq[64 + lane], gq2 = gq[128 + lane], gk0 = gk[lane], gk1 = gk[64 + lane], gk2 = gk[128 + lane];
    for (int m = gw; m < M; m += NGW) {
        const int pos = m & (SEQ - 1);
        const double rev = (double)pos * (double)invf * 0.15915494309189535;
        const float fr = (float)(rev - __builtin_rint(rev));
        const float sn = __builtin_amdgcn_sinf(fr), cs = __builtin_amdgcn_cosf(fr);
        const float kr = bf2f(Z[(size_t)m * ODD_INP + 768 + lane]);
#pragma unroll
        for (int h = 0; h < 8; ++h) {
            {   const bf16_t* qp = QR + (size_t)m * 1536 + h * 192;
                float a = bf2f(qp[lane]), b = bf2f(qp[64 + lane]), c = bf2f(qp[128 + lane]);
                const float rstd = 1.0f / sqrtf(wave_sum(a * a + b * b + c * c) * (1.0f / 192.0f) + EPS);
                a *= rstd * gq0; b *= rstd * gq1; c *= rstd * gq2;
                const float pc = __shfl_xor(c, 32);
                const float rc = lane < 32 ? (c * cs - pc * sn) : (pc * sn + c * cs);
                bf16_t* op = QF + (size_t)m * 1536 + h * 192;
                op[lane] = f2bf(a * C2_C); op[64 + lane] = f2bf(b * C2_C); op[128 + lane] = f2bf(rc * C2_C); }
            {   const bf16_t* kp = KVR + (size_t)m * 2048 + h * 256;
                float a = bf2f(kp[lane]), b = bf2f(kp[64 + lane]), c = kr;
                const float rstd = 1.0f / sqrtf(wave_sum(a * a + b * b + c * c) * (1.0f / 192.0f) + EPS);
                a *= rstd * gk0; b *= rstd * gk1; c *= rstd * gk2;
                const float pc = __shfl_xor(c, 32);
                const float rc = lane < 32 ? (c * cs - pc * sn) : (pc * sn + c * cs);
                bf16_t* op = KF + (size_t)m * 1536 + h * 192;
                op[lane] = f2bf(a); op[64 + lane] = f2bf(b); op[128 + lane] = f2bf(rc); }
        }
    }
}

#ifndef PHMASK
#define PHMASK 0xFFFF
#endif
#ifndef REPMASK
#define REPMASK 0
#endif
#ifndef REPCNT
#define REPCNT 3
#endif
#define NREP(k) ((((REPMASK) >> (k)) & 1) ? (REPCNT) : 1)

#define LAUNDER_S(x) asm volatile("" : "+s"(x))
__device__ __forceinline__ const float* in_ptr(const Args& a, int i) { LAUNDER_S(i); return a.in[i]; }
#define PHASE_BEGIN() unsigned wso_ = 0u; LAUNDER_S(wso_); unsigned char* ws = args.ws + wso_; Frame Fp = F; Fp.vcu = __builtin_amdgcn_readfirstlane(Fp.vcu); Fp.G = __builtin_amdgcn_readfirstlane(Fp.G); LAUNDER_S(Fp.vcu); LAUNDER_S(Fp.G); \
    int bx_ = __builtin_amdgcn_readfirstlane((int)blockIdx.x); LAUNDER_S(bx_); (void)bx_; (void)ws
#define XN  ((bf16_t*)(ws + WS_XN))
#define Z   ((bf16_t*)(ws + WS_Z))
#define MIX ((bf16_t*)(ws + WS_MIX))
#define QR  ((bf16_t*)(ws + WS_QR))
#define KVR ((bf16_t*)(ws + WS_KVR))
#define QF  ((bf16_t*)(ws + WS_QF))
#define KF  ((bf16_t*)(ws + WS_KF))
#define XG  ((unsigned char*)(ws + WS_XG))
#define ACT ((unsigned char*)(ws + WS_ACT))
#define YB  ((bf16_t*)(ws + WS_XG))
#define SSQ ((float*)(ws + WS_SSQ))
#define TOKER ((unsigned*)(ws + WS_TOKER))
#define TOKG ((float*)(ws + WS_TOKG))
#define B1P ((float*)(ws + WS_B1P))
#define IN(i) in_ptr(args, (i))
__global__ void __launch_bounds__(NWAVES * 64, 2) trunk_fwd(Args args) {
    extern __shared__ __attribute__((aligned(16))) unsigned char lds_raw[];
    Frame F;
    F.lds = (LAS unsigned char*)lds_raw;
    F.G = gridDim.x; { const int bx = blockIdx.x; F.vcu = (F.G % 8 == 0) ? (bx % 8) * (F.G / 8) + bx / 8 : bx; }
    for (int u = threadIdx.x; u < (SCR_OFF - LDSCTL_OFF) / 4; u += NWAVES * 64) ((LAS unsigned*)(F.lds + LDSCTL_OFF))[u] = 0u;
    __syncthreads();
    (void)xcd_barrier_post((unsigned*)((gu32*)(args.ws + WS_CTL) + CW_BAR), (volatile LAS unsigned*)(F.lds + MISC_OFF) + 8);
#define GRID_BAR() do { unsigned wsb_ = 0u; LAUNDER_S(wsb_); XcdBarrier bar_; bar_.bar = (unsigned*)((gu32*)(args.ws + wsb_ + WS_CTL) + CW_BAR); bar_.x = xb_xcc_id(); \
        bar_.st = (volatile LAS unsigned*)(F.lds + MISC_OFF) + 8; xcd_barrier(bar_); } while (0)
    float* const X = args.out;
    const int stage_limit = args.stage_limit;

#if (PHMASK >> 0) & 1
            _Pragma("unroll") for (int rep_ = 0; rep_ < NREP(0); ++rep_) { if (rep_) GRID_BAR();
    {   PHASE_BEGIN(); const int ptid = threadIdx.x, gw = Fp.vcu * NWAVES + __builtin_amdgcn_readfirstlane(ptid >> 6), NGW = Fp.G * NWAVES;
        transpose_job<1>(Fp, IN(I_EWIN), DM, EVEN_IN, 2, (size_t)DM * EVEN_IN, (bf16_t*)(ws + WS_WEIN), (size_t)EVEN_IN * DM, nullptr, 0);
        transpose_job<0>(Fp, IN(I_EWOUT), DM, DM, 2, (size_t)DM * DM, (bf16_t*)(ws + WS_WEOUT), (size_t)DM * DM, nullptr, 0);
        transpose_job<0>(Fp, IN(I_OWIN), DM, ODD_IN, 2, (size_t)DM * ODD_IN, (bf16_t*)(ws + WS_WOIN), (size_t)ODD_INP * DM, nullptr, 0);
        transpose_job<0>(Fp, IN(I_OWUQ), 512, 1536, 2, (size_t)512 * 1536, (bf16_t*)(ws + WS_WUQ), (size_t)1536 * 512, IN(I_OGCQ), 512);
        transpose_job<0>(Fp, IN(I_OWUKV), 256, 2048, 2, (size_t)256 * 2048, (bf16_t*)(ws + WS_WUKV), (size_t)2048 * 256, IN(I_OGCKV), 256);
        transpose_job<0>(Fp, IN(I_OWOUT), DM, DM, 2, (size_t)DM * DM, (bf16_t*)(ws + WS_WOOUT), (size_t)DM * DM, nullptr, 0);
        transpose_job_fp8<2>(Fp, IN(I_W1), DM, 2 * DE, DEPTH * NE, (size_t)DM * 2 * DE, ws + WS_W1, (size_t)2 * DE * DM);
        transpose_job_fp8<0>(Fp, IN(I_W2), DE, DM, DEPTH * NE, (size_t)DE * DM, ws + WS_W2, (size_t)DM * DE);
        for (int i = bx_ * 512 + ptid; i < 2 * 24576; i += Fp.G * 512) { const int mi = i / 24576, r = i % 24576;
            *(u32x4*)((bf16_t*)(ws + WS_WOIN) + (size_t)mi * ODD_INP * DM + (size_t)ODD_IN * DM + (size_t)r * 8) = (u32x4){0u, 0u, 0u, 0u}; }
        for (int i = bx_ * 512 + ptid; i < DEPTH * NE * 2048; i += Fp.G * 512) { const int c = i & 2047, o = 2 * (128 * (c >> 8) + (c & 127)) + ((c >> 7) & 1);
            B1P[i] = IN(I_B1)[(size_t)(i & ~2047) + o]; }
        for (int m = gw; m < M; m += NGW) rms_row_to_bf16(ptid & 63, IN(I_X) + (size_t)m * DM, IN(I_MIXN), XN + (size_t)m * DM, X + (size_t)m * DM);
    }
            }
#endif
    GRID_BAR();

    for (int l = 0; l < DEPTH; ++l) {
        const int li = l >> 1;
        if (2 * l + 1 > stage_limit) break;
        if ((l & 1) == 0) {
#if (PHMASK >> 1) & 1
            _Pragma("unroll") for (int rep_ = 0; rep_ < NREP(1); ++rep_) { if (rep_) GRID_BAR();
            {   PHASE_BEGIN(); pg8::Gemm g{XN, (const bf16_t*)(ws + WS_WEIN) + (size_t)li * EVEN_IN * DM, DM, DM}; pg8::StaticOrder S; S.init(M, EVEN_IN, Fp.G, bx_);
                pg8::EpiEvenIn E{Z, IN(I_EGQ) + li * 64, IN(I_EGK) + li * 64};
                pg8::gemm_phase<pg8::EpiEvenIn, pg8::StaticOrder>(Fp.lds + RING_OFF, g, S, E); }
            }
#endif
            GRID_BAR();
            {   PHASE_BEGIN();
#if (PHMASK >> 2) & 1
            _Pragma("unroll") for (int rep_ = 0; rep_ < NREP(2); ++rep_) { if (rep_) GRID_BAR();
                for (int u = Fp.vcu; u < 512; u += Fp.G)
                    gmlp_unit(Fp, Z, MIX, IN(I_EWS) + (size_t)li * 4 * 128 * 128, IN(I_EBS) + li * 512, IN(I_EGV) + li * 512, u);
            }
#endif
#if (PHMASK >> 3) & 1
            _Pragma("unroll") for (int rep_ = 0; rep_ < NREP(3); ++rep_) { if (rep_) GRID_BAR();
                typedef att::Cfg<64, 64, 1> C;
                LAS float* lut = (LAS float*)(Fp.lds + RING_OFF + C::OFF_LUT);
                int tl_ = threadIdx.x; asm volatile("" : "+v"(tl_));
                for (int d = tl_; d < att::LUTN; d += 512) { const int c = (d <= 128 ? 1 : 0) + ((d <= 512 && (d & 3) == 0) ? 1 : 0) + ((d <= 2048 && (d & 15) == 0) ? 1 : 0);
                    lut[d] = c == 0 ? -__builtin_inff() : (c == 1 ? 0.f : (c == 2 ? 1.f : 1.5849625007211562f)); }
                __syncthreads();
                for (int u = Fp.vcu; u < 256; u += Fp.G) { const int bh = u >> 4, s = u & 15, b = bh >> 3, h = bh & 7;
                    for (int pass = 0; pass < 2; ++pass) { const int qb = pass ? 31 - s : s;
                        const bf16_t* zb = Z + (size_t)b * SEQ * EVEN_IN;
                        att::attn_unit<64, 64, 1>(zb + 1024 + 64 * h, EVEN_IN, zb + 1536 + 64 * h, EVEN_IN, zb + 2048 + 64 * h, EVEN_IN,
                                                  MIX + (size_t)b * SEQ * DM + 512 + 64 * h, DM, qb * 256, Fp.lds + RING_OFF); } }
            }
#endif
            }
            GRID_BAR();
#if (PHMASK >> 4) & 1
            _Pragma("unroll") for (int rep_ = 0; rep_ < NREP(4); ++rep_) { if (rep_) GRID_BAR();
            {   PHASE_BEGIN(); pg8::Gemm g{MIX, (const bf16_t*)(ws + WS_WEOUT) + (size_t)li * DM * DM, DM, DM}; pg8::StaticOrder S; S.init(M, DM, Fp.G, bx_);
                pg8::EpiResid E{X};
                pg8::gemm_phase<pg8::EpiResid, pg8::StaticOrder>(Fp.lds + RING_OFF, g, S, E); }
            }
#endif
            GRID_BAR();
        } else {
#if (PHMASK >> 5) & 1
            _Pragma("unroll") for (int rep_ = 0; rep_ < NREP(5); ++rep_) { if (rep_) GRID_BAR();
            {   PHASE_BEGIN(); pg8::Gemm g{XN, (const bf16_t*)(ws + WS_WOIN) + (size_t)li * ODD_INP * DM, DM, DM}; pg8::StaticOrder S; S.init(M, ODD_INP, Fp.G, bx_);
                pg8::EpiOddIn E{Z, SSQ};
                pg8::gemm_phase<pg8::EpiOddIn, pg8::StaticOrder>(Fp.lds + RING_OFF, g, S, E); }
            }
#endif
            GRID_BAR();
#if (PHMASK >> 6) & 1
            _Pragma("unroll") for (int rep_ = 0; rep_ < NREP(6); ++rep_) { if (rep_) GRID_BAR();
            {   PHASE_BEGIN(); pg8::Gemm g{Z + 512, (const bf16_t*)(ws + WS_WUKV) + (size_t)li * 2048 * 256, ODD_INP, 256}; pg8::StaticOrder S; S.init(M, 2048, Fp.G, bx_);
                pg8::EpiRowScale<1> E{KVR, 2048, SSQ, 8, 1.0f / 256.0f};
                pg8::gemm_phase<pg8::EpiRowScale<1>, pg8::StaticOrder>(Fp.lds + RING_OFF, g, S, E); }
            {   PHASE_BEGIN(); pg8::Gemm g{Z, (const bf16_t*)(ws + WS_WUQ) + (size_t)li * 1536 * 512, ODD_INP, 512}; pg8::StaticOrder S; S.init(M, 1536, Fp.G, bx_);
                pg8::EpiRowScale<2> E{QR, 1536, SSQ, 0, 1.0f / 512.0f};
                pg8::gemm_phase<pg8::EpiRowScale<2>, pg8::StaticOrder>(Fp.lds + RING_OFF, g, S, E); }
            }
#endif
            GRID_BAR();
#if (PHMASK >> 7) & 1
            _Pragma("unroll") for (int rep_ = 0; rep_ < NREP(7); ++rep_) { if (rep_) GRID_BAR();
            {   PHASE_BEGIN(); mla_finalize_phase(Fp, QR, KVR, Z, IN(I_OGQ) + li * 192, IN(I_OGK) + li * 192, QF, KF); }
            }
#endif
            GRID_BAR();
#if (PHMASK >> 8) & 1
            _Pragma("unroll") for (int rep_ = 0; rep_ < NREP(8); ++rep_) { if (rep_) GRID_BAR();
            {   PHASE_BEGIN();
                for (int u = Fp.vcu; u < 256; u += Fp.G) { const int bh = u >> 4, s = u & 15, b = bh >> 3, h = bh & 7;
                    for (int pass = 0; pass < 2; ++pass) { const int qb = pass ? 31 - s : s;
                        att::attn_unit<192, 128, 0>(QF + (size_t)b * SEQ * 1536 + 192 * h, 1536, KF + (size_t)b * SEQ * 1536 + 192 * h, 1536, KVR + (size_t)b * SEQ * 2048 + 256 * h + 128, 2048,
                                                    MIX + (size_t)b * SEQ * DM + 128 * h, DM, qb * 256, Fp.lds + RING_OFF); } }
            }
            }
#endif
            GRID_BAR();
#if (PHMASK >> 9) & 1
            _Pragma("unroll") for (int rep_ = 0; rep_ < NREP(9); ++rep_) { if (rep_) GRID_BAR();
            {   PHASE_BEGIN(); pg8::Gemm g{MIX, (const bf16_t*)(ws + WS_WOOUT) + (size_t)li * DM * DM, DM, DM}; pg8::StaticOrder S; S.init(M, DM, Fp.G, bx_);
                pg8::EpiResid E{X};
                pg8::gemm_phase<pg8::EpiResid, pg8::StaticOrder>(Fp.lds + RING_OFF, g, S, E); }
            }
#endif
            GRID_BAR();
        }
        if (2 * l + 2 > stage_limit) break;
#if (PHMASK >> 10) & 1
            _Pragma("unroll") for (int rep_ = 0; rep_ < NREP(10); ++rep_) {
        {   PHASE_BEGIN(); const bool dry = rep_ + 1 < NREP(10);
            gu32* cnt = (gu32*)(ws + WS_CTL) + CW_CNT + (size_t)(dry ? 8 + 4 * rep_ + l : l) * 32 * 64;
        router_phase(Fp, X, IN(I_FFNN) + l * DM, IN(I_RW) + (size_t)l * DM * NE, IN(I_RB) + l * NE, cnt, dry ? (unsigned*)(ws + WS_QR) : TOKER, dry ? (float*)(ws + WS_QR + MiB) : TOKG, dry ? ACT : XG); }
        GRID_BAR();
            }
#endif
        LAS int* tbl = (LAS int*)(F.lds + SCR_OFF + 12288);
        {   PHASE_BEGIN(); gu32* cnt = (gu32*)(ws + WS_CTL) + CW_CNT + (size_t)l * 32 * 64;
        if (threadIdx.x == 0) { int acc = 0; for (int e = 0; e < NE; ++e) { tbl[e] = acc; const unsigned c = __hip_atomic_load(cnt + 64 * e, RLX_AGENT); acc += (int)((c + 255u) >> 8); } tbl[NE] = acc; }
        __syncthreads(); }
#if (PHMASK >> 11) & 1
            _Pragma("unroll") for (int rep_ = 0; rep_ < NREP(11); ++rep_) { if (rep_) GRID_BAR();
        {   PHASE_BEGIN(); pg8::Gemm g{(const bf16_t*)XG, (const bf16_t*)(ws + WS_W1 + (size_t)l * NE * 2 * DE * DM), DM / 2, DM / 2}; pg8::MoeOrder S{tbl, 8, Fp.G, Fp.vcu};
            pg8::EpiSwiglu E{ACT, B1P + (size_t)l * NE * 2048};
            pg8::gemm_phase<pg8::EpiSwiglu, pg8::MoeOrder, true>(Fp.lds + RING_OFF, g, S, E); }
            }
#endif
        GRID_BAR();
#if (PHMASK >> 12) & 1
            _Pragma("unroll") for (int rep_ = 0; rep_ < NREP(12); ++rep_) { if (rep_) GRID_BAR();
        {   PHASE_BEGIN(); pg8::Gemm g{(const bf16_t*)ACT, (const bf16_t*)(ws + WS_W2 + (size_t)l * NE * DM * DE), DE / 2, DE / 2}; pg8::MoeOrder S{tbl, 4, Fp.G, Fp.vcu};
            pg8::EpiDown E{YB, IN(I_B2) + (size_t)l * NE * DM};
            pg8::gemm_phase<pg8::EpiDown, pg8::MoeOrder, true>(Fp.lds + RING_OFF, g, S, E); }
            }
#endif
        GRID_BAR();
#if (PHMASK >> 13) & 1
            _Pragma("unroll") for (int rep_ = 0; rep_ < NREP(13); ++rep_) {
        {   PHASE_BEGIN(); const bool dry = rep_ + 1 < NREP(13);
            combine_phase(Fp, X, dry ? (float*)ACT : X, TOKER, TOKG, YB, (l + 1 < DEPTH) ? IN(I_MIXN) + (l + 1) * DM : nullptr, dry ? (bf16_t*)(ACT + (size_t)64 * MiB) : XN); }
        GRID_BAR();
            }
#endif
    }
#undef GRID_BAR
}

extern "C" void kernel_launch(void* const* d_in, const int* in_sizes, int n_in, void* d_out, int out_size, void* d_ws, size_t ws_size, hipStream_t stream) {
    static int grid = 0;
    if (grid == 0) {
        if (n_in != 24 || in_sizes[0] != M * DM || out_size != M * DM || ws_size < WS_END) {
            fprintf(stderr, "kernel_launch: unexpected shapes (n_in %d, in0 %d, out %d, ws %zu, need %zu)\n", n_in, n_in > 0 ? in_sizes[0] : -1, out_size, ws_size, (size_t)WS_END); grid = -1; return; }
        int dev = 0, cus = 0, per_cu = 0;
        if (hipGetDevice(&dev) != hipSuccess || hipDeviceGetAttribute(&cus, hipDeviceAttributeMultiprocessorCount, dev) != hipSuccess) { grid = -1; return; }
        if (hipFuncSetAttribute((const void*)trunk_fwd, hipFuncAttributeMaxDynamicSharedMemorySize, LDS_BYTES) != hipSuccess) { fprintf(stderr, "kernel_launch: hipFuncSetAttribute failed\n"); grid = -1; return; }
        if (hipOccupancyMaxActiveBlocksPerMultiprocessor(&per_cu, (const void*)trunk_fwd, NWAVES * 64, LDS_BYTES) != hipSuccess || per_cu < 1)
            fprintf(stderr, "kernel_launch: occupancy query reports %d workgroups per CU\n", per_cu);
        (void)hipGetLastError();
        grid = cus;
    }
    if (grid < 0) return;
    if (hipMemsetAsync((char*)d_ws + WS_CTL, 0, CTL_ZERO_BYTES, stream) != hipSuccess) return;
    Args a{};
    for (int i = 0; i < 24; ++i) a.in[i] = (const float*)d_in[i];
    a.out = (float*)d_out; a.ws = (unsigned char*)d_ws; a.stage_limit = STAGE_LIMIT; a.pad = 0;
    hipLaunchKernelGGL(trunk_fwd, dim3(grid), dim3(NWAVES * 64), LDS_BYTES, stream, a);
}
```

```cpp
#include <hip/hip_runtime.h>
#include <hip/hip_bf16.h>
#include <cstdio>
#include <cstdint>

#define LAS __attribute__((address_space(3)))
#define GAS __attribute__((address_space(1)))
typedef unsigned short bf16_t;
typedef short bf16x8 __attribute__((ext_vector_type(8)));
typedef short s16x4 __attribute__((ext_vector_type(4)));
typedef float f32x2 __attribute__((ext_vector_type(2)));
typedef float f32x4 __attribute__((ext_vector_type(4)));
typedef float f32x16 __attribute__((ext_vector_type(16)));
typedef unsigned u32x2 __attribute__((ext_vector_type(2)));
typedef unsigned u32x4 __attribute__((ext_vector_type(4)));
typedef int i32x4 __attribute__((ext_vector_type(4)));
typedef int i32x8 __attribute__((ext_vector_type(8)));

constexpr int BATCH = 2, SEQ = 8192, DM = 1024, M = BATCH * SEQ, DEPTH = 4;
constexpr int EVEN_IN = 2560, ODD_IN = 832, ODD_INP = 1024;
constexpr int NE = 32, DE = 1024, ECAP = 16384;
constexpr float EPS = 1e-6f;
constexpr float LOG2E = 1.4426950408889634f;
constexpr float C2_B = 0.125f * LOG2E;
constexpr float C2_C = 0.07216878364870322f * LOG2E;

__device__ __forceinline__ unsigned cvt_pk_bf16(float lo, float hi) { unsigned r; asm volatile("v_cvt_pk_bf16_f32 %0, %1, %2" : "=v"(r) : "v"(lo), "v"(hi)); return r; }
__device__ __forceinline__ float bf2f(bf16_t v) { return __uint_as_float(((unsigned)v) << 16); }
__device__ __forceinline__ float bflo(unsigned w) { return __uint_as_float(w << 16); }
__device__ __forceinline__ float bfhi(unsigned w) { return __uint_as_float(w & 0xffff0000u); }
__device__ __forceinline__ bf16_t f2bf(float f) { return (bf16_t)(cvt_pk_bf16(f, 0.f) & 0xffffu); }

__device__ __forceinline__ unsigned pk4_fp8(float a, float b, float c, float d) { int w = 0; w = __builtin_amdgcn_cvt_pk_fp8_f32(a, b, w, false); w = __builtin_amdgcn_cvt_pk_fp8_f32(c, d, w, true); return (unsigned)w; }
constexpr float W8_SCALE = 64.0f, W8_INV = 1.0f / 64.0f;

namespace pg8 {
constexpr int BM = 256, BK = 64, HALF = 128, HTB = HALF * BK * 2, STAGE_BYTES = 8 * HTB, NXCD = 8, WGM = 8;
__host__ __device__ __forceinline__ int lds_byte(int r, int c) { const int st = (r >> 4) * 2 + (c >> 5), rr = r & 15, cc = c & 31, ob = rr * 64 + cc * 2; return st * 1024 + (ob ^ (((ob >> 9) & 1) << 5)); }
__host__ __device__ __forceinline__ void stage_rc(int b, int& R, int& C) { const int st = b / 1024, sb = b % 1024, swz = sb ^ (((sb >> 9) & 1) << 5); R = (st >> 1) * 16 + swz / 64; C = (st & 1) * 32 + (swz % 64) / 2; }
__host__ __device__ __forceinline__ int perm32(int rho) { const int n = rho >> 4, i = rho & 15; return 8 * (i >> 2) + 4 * n + (i & 3); }

struct Unit { int pm, pn, pb; };
struct Gemm { const bf16_t* A; const bf16_t* Bt; int lda, K; };

struct StaticOrder {
    int nM, nN, nwg, G, c;
    __device__ void init(int M_, int N_, int G_, int c_) { nM = M_ / BM; nN = N_ / BM; nwg = nM * nN; G = G_; c = c_; }
    __device__ bool next(int i, Unit& u) const {
        const long L = (long)i * G + c; if (L >= nwg) return false;
        int wgid = (int)L; { const int q = nwg / NXCD, r = nwg % NXCD, xcd = wgid % NXCD, off = wgid / NXCD; wgid = (xcd < r ? xcd * (q + 1) : r * (q + 1) + (xcd - r) * q) + off; }
        const int nig = WGM * nN, gid = wgid / nig, fm = gid * WGM, gsz = (nM - fm) < WGM ? (nM - fm) : WGM;
        u.pm = fm + ((wgid % nig) % gsz); u.pn = (wgid % nig) / gsz; u.pb = u.pn; return true;
    }
};

__device__ __forceinline__ f32x2 gelu_pk(f32x2 v) {
    const f32x2 av = __builtin_elementwise_abs(v), d = av * 0.2316418882f + 1.0f;
    f32x2 t; t.x = __builtin_amdgcn_rcpf(d.x); t.y = __builtin_amdgcn_rcpf(d.y);
    f32x2 q = t * 0.5307027145f + (-0.7265760135f); q = q * t + 0.7107068705f; q = q * t + (-0.142248368f); q = q * t + 0.127414796f; q = q * t;
    const f32x2 s = (v * v) * (-0.72134752044f);
    f32x2 e; e.x = __builtin_amdgcn_exp2f(s.x); e.y = __builtin_amdgcn_exp2f(s.y);
    const f32x2 m = v * (q * e), r = v - m;
    f32x2 o; o.x = v.x < 0.f ? m.x : r.x; o.y = v.y < 0.f ? m.y : r.y; return o;
}
__device__ __forceinline__ f32x4 gelu4(f32x4 v) { const f32x2 a = gelu_pk((f32x2){v[0], v[1]}), b = gelu_pk((f32x2){v[2], v[3]}); return (f32x4){a.x, a.y, b.x, b.y}; }

template <class Epi, class Sched, bool FP8 = false>
__device__ __forceinline__ void gemm_phase(LAS unsigned char* lds, const Gemm g, const Sched& S, const Epi& E) {
    int tid_ = threadIdx.x; asm volatile("" : "+v"(tid_));
    const int tid = tid_, wid = __builtin_amdgcn_readfirstlane(tid >> 6), lane = tid & 63, wr = wid >> 2, wc = wid & 3, fr = lane & 15, fq = lane >> 4;
    const int K = g.K, nt = K / BK;
    unsigned voffA[2], voffB[2];
#pragma unroll
    for (int i = 0; i < 2; ++i) { int R, C; stage_rc(tid * 16 + i * 8192, R, C); const int Rb = Epi::PERM ? ((R & ~31) + perm32(R & 31)) : R;
        voffA[i] = (unsigned)(R * g.lda + C) * 2u; voffB[i] = (unsigned)(Rb * K + C) * 2u; }
    const size_t kstep = (size_t)(BK * 2);
    const size_t hstepA = (size_t)HALF * g.lda * 2, tstepA = 2 * hstepA;
    const size_t hstepB = (size_t)HALF * K * 2, tstepB = 2 * hstepB;
    const unsigned ldsw = (unsigned)wid * 1024u;
    const int aoff = lds_byte(wr * 64 + fr, fq * 8), boff = lds_byte(wc * 32 + fr, fq * 8);
#define PG8_SA(b, h) (((b) * 2 + (h)) * HTB)
#define PG8_SB(b, h) ((4 + (b) * 2 + (h)) * HTB)
#define PG8_STAGE(bufoff, gbase, voff) do { _Pragma("unroll") for (int _i = 0; _i < 2; ++_i) \
        __builtin_amdgcn_global_load_lds((const unsigned*)((const char*)(gbase) + (voff)[_i]), (LAS unsigned*)(lds + (bufoff) + ldsw + _i * 8192), 16, 0, 0); } while (0)
#define PG8_LDA(dst, b, h) do { _Pragma("unroll") for (int m = 0; m < 4; ++m) { if constexpr (FP8) { const i32x4 lo_ = *(const LAS i32x4*)(lds + PG8_SA(b, h) + aoff + m * 2048), hi_ = *(const LAS i32x4*)(lds + PG8_SA(b, h) + aoff + m * 2048 + 1024); dst##8[m] = __builtin_shufflevector(lo_, hi_, 0, 1, 2, 3, 4, 5, 6, 7); } \
        else { _Pragma("unroll") for (int k = 0; k < 2; ++k) dst[m][k] = *(const LAS bf16x8*)(lds + PG8_SA(b, h) + aoff + m * 2048 + k * 1024); } } } while (0)
#define PG8_LDB(dst, b, h) do { _Pragma("unroll") for (int n = 0; n < 2; ++n) { if constexpr (FP8) { const i32x4 lo_ = *(const LAS i32x4*)(lds + PG8_SB(b, h) + boff + n * 2048), hi_ = *(const LAS i32x4*)(lds + PG8_SB(b, h) + boff + n * 2048 + 1024); dst##8[n] = __builtin_shufflevector(lo_, hi_, 0, 1, 2, 3, 4, 5, 6, 7); } \
        else { _Pragma("unroll") for (int k = 0; k < 2; ++k) dst[n][k] = *(const LAS bf16x8*)(lds + PG8_SB(b, h) + boff + n * 2048 + k * 1024); } } } while (0)
#define PG8_MMA(ai, bj, At, Bt) do { __builtin_amdgcn_s_setprio(1); _Pragma("unroll") for (int m = 0; m < 4; ++m) _Pragma("unroll") for (int n = 0; n < 2; ++n) { \
        if constexpr (FP8) asm volatile("s_nop 1\n\tv_mfma_f32_16x16x128_f8f6f4 %0, %1, %2, %0" : "+v"(acc[ai][bj][m][n]) : "v"(Bt##8[n]), "v"(At##8[m])); \
        else { _Pragma("unroll") for (int k = 0; k < 2; ++k) acc[ai][bj][m][n] = __builtin_amdgcn_mfma_f32_16x16x32_bf16(Bt[n][k], At[m][k], acc[ai][bj][m][n], 0, 0, 0); } } \
        __builtin_amdgcn_s_setprio(0); } while (0)
#define PG8_WAIT_V(n) asm volatile("s_waitcnt vmcnt(" #n ")" ::: "memory")
#define PG8_WAIT_L(n) asm volatile("s_waitcnt lgkmcnt(" #n ")" ::: "memory")
#define PG8_BAR __builtin_amdgcn_s_barrier()
#define PG8_SCHED __builtin_amdgcn_sched_barrier(0)
    Unit cur, nxt; int ui = 0;
    if (!S.next(0, cur)) return;
    f32x4 acc[2][2][4][2];
#pragma unroll
    for (int a = 0; a < 2; ++a)
#pragma unroll
        for (int b = 0; b < 2; ++b)
#pragma unroll
            for (int m = 0; m < 4; ++m)
#pragma unroll
                for (int n = 0; n < 2; ++n) acc[a][b][m][n] = (f32x4){0.f, 0.f, 0.f, 0.f};
    bf16x8 At[4][2], B0[2][2], B1[2][2]; i32x8 At8[4], B08[2], B18[2];
    const char* cA = (const char*)g.A + (size_t)cur.pm * tstepA; const char* cB = (const char*)g.Bt + (size_t)cur.pb * tstepB;
    PG8_STAGE(PG8_SB(0, 0), cB, voffB); PG8_STAGE(PG8_SB(0, 1), cB + hstepB, voffB); PG8_STAGE(PG8_SA(0, 0), cA, voffA); PG8_STAGE(PG8_SA(0, 1), cA + hstepA, voffA);
    if (wr == 1) PG8_BAR;
    PG8_WAIT_V(2); PG8_BAR;
    PG8_STAGE(PG8_SB(1, 0), cB + kstep, voffB); PG8_STAGE(PG8_SA(1, 0), cA + kstep, voffA); PG8_STAGE(PG8_SB(1, 1), cB + hstepB + kstep, voffB);
    PG8_WAIT_V(6); PG8_BAR;
    for (;;) {
        const bool has_next = S.next(ui + 1, nxt);
        const char* nA = has_next ? (const char*)g.A + (size_t)nxt.pm * tstepA : cA; const char* nB = has_next ? (const char*)g.Bt + (size_t)nxt.pb * tstepB : cB;
#pragma unroll 1
        for (int t = 0; t < nt; t += 2) {
            const bool last = (t == nt - 2);
            const char* a1 = cA + (size_t)(t + 1) * kstep;
            const char* a2 = last ? nA : cA + (size_t)(t + 2) * kstep; const char* b2 = last ? nB : cB + (size_t)(t + 2) * kstep;
            const char* a3 = a2 + kstep; const char* b3 = b2 + kstep;
            PG8_LDB(B0, 0, 0); PG8_LDB(B1, 0, 1); PG8_SCHED; PG8_LDA(At, 0, 0); PG8_STAGE(PG8_SA(1, 1), a1 + hstepA, voffA);
            PG8_WAIT_V(8); PG8_WAIT_L(0); PG8_BAR; PG8_MMA(0, 0, At, B0); PG8_MMA(0, 1, At, B1); PG8_BAR; PG8_SCHED;
            PG8_LDA(At, 0, 1); PG8_STAGE(PG8_SB(0, 0), b2, voffB); PG8_STAGE(PG8_SB(0, 1), b2 + hstepB, voffB); PG8_STAGE(PG8_SA(0, 0), a2, voffA);
            PG8_WAIT_V(8); PG8_WAIT_L(0); PG8_BAR; PG8_MMA(1, 0, At, B0); PG8_MMA(1, 1, At, B1); PG8_BAR; PG8_SCHED;
            PG8_LDB(B0, 1, 0); PG8_LDB(B1, 1, 1); PG8_SCHED; PG8_LDA(At, 1, 0); PG8_STAGE(PG8_SA(0, 1), a2 + hstepA, voffA);
            PG8_WAIT_V(8); PG8_WAIT_L(0); PG8_BAR; PG8_MMA(0, 0, At, B0); PG8_MMA(0, 1, At, B1); PG8_BAR; PG8_SCHED;
            PG8_LDA(At, 1, 1); PG8_STAGE(PG8_SB(1, 0), b3, voffB); PG8_STAGE(PG8_SB(1, 1), b3 + hstepB, voffB); PG8_STAGE(PG8_SA(1, 0), a3, voffA);
            PG8_WAIT_V(8); PG8_WAIT_L(0); PG8_BAR; PG8_MMA(1, 0, At, B0); PG8_MMA(1, 1, At, B1); PG8_BAR; PG8_SCHED;
        }
        if (wr == 0) PG8_BAR;
        if constexpr (FP8) asm volatile("s_nop 15\n\ts_nop 7" ::: "memory");
        { int te_ = threadIdx.x; asm volatile("" : "+v"(te_));
          E(acc, cur, wr, wc, te_ & 15, (te_ & 63) >> 4); }
        if (!has_next) break;
#pragma unroll
        for (int a = 0; a < 2; ++a)
#pragma unroll
            for (int b = 0; b < 2; ++b)
#pragma unroll
                for (int m = 0; m < 4; ++m)
#pragma unroll
                    for (int n = 0; n < 2; ++n) acc[a][b][m][n] = (f32x4){0.f, 0.f, 0.f, 0.f};
        cur = nxt; cA = nA; cB = nB; ++ui;
        if (wr == 1) PG8_BAR;
    }
    PG8_WAIT_V(0);
    PG8_BAR;
#undef PG8_SA
#undef PG8_SB
#undef PG8_STAGE
#undef PG8_LDA
#undef PG8_LDB
#undef PG8_MMA
#undef PG8_WAIT_V
#undef PG8_WAIT_L
#undef PG8_BAR
#undef PG8_SCHED
}
}
constexpr int STAGE_LIMIT = 8;

namespace att {
__device__ __forceinline__ int crow(int r, int hi) { return (r & 3) + 8 * (r >> 2) + 4 * hi; }
__device__ __forceinline__ int v_rd_base(int lane) { return ((lane & 3) << 3) | (((lane >> 2) & 3) << 6) | (((lane >> 4) & 1) << 5) | (((lane >> 5) & 1) << 8); }
constexpr int LUTN = 2052;

template <int DQK, int DV, int MODE>
struct Cfg {
    static constexpr int KP = DQK * 2 + 16;
    static constexpr int KB = 64 * KP, VB = 64 * DV * 2;
    static constexpr int NBUF = 3;
    static constexpr int OFF_K = 0, OFF_V = NBUF * KB, OFF_WS = NBUF * (KB + VB), OFF_LUT = OFF_WS + 8 * 256, BYTES = OFF_LUT + (MODE == 1 ? LUTN * 4 : 0);
    static_assert(BYTES <= 131072, "attention LDS image fits the ring");
    static constexpr int CPR = KP / 16;
    static constexpr int NKP = KB / 1024, KPW = (NKP + 7) / 8;
    static constexpr int NVP = VB / 1024, VPW = NVP / 8;
    static_assert(KB % 1024 == 0 && NVP % 8 == 0, "tile images are whole DMA pieces");
};

template <int DQK, int DV, int MODE>
__device__ __forceinline__ void attn_unit(const bf16_t* __restrict__ Qh, int qp, const bf16_t* __restrict__ Kh, int kp, const bf16_t* __restrict__ Vh, int vp,
                                          bf16_t* __restrict__ Oh, int op, int q0, LAS unsigned char* lds) {
    typedef Cfg<DQK, DV, MODE> C;
    constexpr int NCB = DV / 32;
    int tid_ = threadIdx.x; asm volatile("" : "+v"(tid_));
    const int tid = tid_, wid = __builtin_amdgcn_readfirstlane(tid >> 6), lane = tid & 63, r32 = lane & 31, hi = lane >> 5;
    const int qlo = q0 + wid * 32, qpos = qlo + r32;
    LAS float* wsf = (LAS float*)(lds + C::OFF_WS) + wid * 64;
    const LAS float* lut = (const LAS float*)(lds + C::OFF_LUT);
    int j_lo = 0; if (MODE == 1) { const int lo = q0 - 2048; j_lo = lo > 0 ? lo / 64 : 0; }
    const int j_hi = (q0 + 256) / 64, NT = j_hi - j_lo;
    unsigned kso[C::KPW], vso[C::VPW];
#pragma unroll
    for (int i = 0; i < C::KPW; ++i) { const int c = (wid + 8 * i) * 64 + lane, row = c / C::CPR; int cc = c % C::CPR; if (cc > C::CPR - 2) cc = C::CPR - 2;
        kso[i] = (unsigned)((row & 63) * kp + cc * 8); }
#pragma unroll
    for (int i = 0; i < C::VPW; ++i) { const int off = ((wid + 8 * i) * 64 + lane) * 16, st = off >> 9, within = off & 511, kk = (st / NCB) * 8 + (within >> 6);
        const int k = (kk & ~0xC) | ((kk & 4) << 1) | ((kk & 8) >> 1), col = (st % NCB) * 32 + ((within & 63) >> 1);
        vso[i] = (unsigned)(k * vp + col); }
#define ATT_DMA(j, bf) do { const bf16_t* kt_ = Kh + (size_t)(j) * 64 * kp; const bf16_t* vt_ = Vh + (size_t)(j) * 64 * vp; \
        _Pragma("unroll") for (int i = 0; i < C::KPW; ++i) if (wid + 8 * i < C::NKP) \
            __builtin_amdgcn_global_load_lds((const unsigned*)(kt_ + kso[i]), (LAS unsigned*)(lds + C::OFF_K + (bf) * C::KB + (wid + 8 * i) * 1024), 16, 0, 0); \
        _Pragma("unroll") for (int i = 0; i < C::VPW; ++i) \
            __builtin_amdgcn_global_load_lds((const unsigned*)(vt_ + vso[i]), (LAS unsigned*)(lds + C::OFF_V + (bf) * C::VB + (wid + 8 * i) * 1024), 16, 0, 0); } while (0)
    ATT_DMA(j_lo, 0);
    if (NT > 1) ATT_DMA(j_lo + 1, 1);
    bf16x8 qr[DQK / 16];
#pragma unroll
    for (int d0 = 0; d0 < DQK / 16; ++d0) qr[d0] = *(const bf16x8*)(Qh + (size_t)qpos * qp + d0 * 16 + hi * 8);
    float m_reg = -1e30f, l_reg = 0.f;
    f32x16 o[NCB];
#pragma unroll
    for (int d = 0; d < NCB; ++d) o[d] = f32x16{};
    const int koff = r32 * C::KP + hi * 16;
    const unsigned vb0 = (unsigned)(uintptr_t)(lds + C::OFF_V) + (unsigned)v_rd_base(lane);
    asm volatile("s_waitcnt vmcnt(0)" ::: "memory");
    __syncthreads();
    constexpr int ND = DQK / 16;
#define ATT_ACT(kb2_) ((kb2_) <= qlo + 31 && (MODE == 0 || (qlo - (kb2_) - 31 <= 2048)))
#define ATT_QK(P, bufi, hf_) do { const LAS unsigned char* kb_ = lds + C::OFF_K + (bufi) * C::KB + (hf_) * 32 * C::KP + koff; P = f32x16{}; \
        bf16x8 kw_[4]; _Pragma("unroll") for (int d0 = 0; d0 < 4; ++d0) kw_[d0] = *(const LAS bf16x8*)(kb_ + d0 * 32); \
        _Pragma("unroll") for (int d0 = 0; d0 < ND; ++d0) { P = __builtin_amdgcn_mfma_f32_32x32x16_bf16(kw_[d0 & 3], qr[d0], P, 0, 0, 0); \
            if (d0 + 4 < ND) kw_[d0 & 3] = *(const LAS bf16x8*)(kb_ + (d0 + 4) * 32); } } while (0)
#define ATT_PK4(P, B_, OUT) do { unsigned a0 = cvt_pk_bf16(P[B_+0], P[B_+1]), a1 = cvt_pk_bf16(P[B_+2], P[B_+3]);                          \
        unsigned b0_ = cvt_pk_bf16(P[B_+4], P[B_+5]), b1_ = cvt_pk_bf16(P[B_+6], P[B_+7]);                                             \
        auto r0 = __builtin_amdgcn_permlane32_swap(a0, b0_, false, false); auto r1 = __builtin_amdgcn_permlane32_swap(a1, b1_, false, false); \
        u32x4 w = {r0[0], r1[0], r0[1], r1[1]}; OUT = __builtin_bit_cast(bf16x8, w); } while (0)
#define ATT_VRD(d0) do { \
                asm volatile("ds_read_b64_tr_b16 %0, %1 offset:%2" : "=&v"(vl0[(d0) & (VG - 1)]) : "v"(vb), "i"((d0) * 512 + KO) : "memory"); \
                asm volatile("ds_read_b64_tr_b16 %0, %1 offset:%2" : "=&v"(vh0[(d0) & (VG - 1)]) : "v"(vb), "i"((d0) * 512 + KO + HF) : "memory"); \
                asm volatile("ds_read_b64_tr_b16 %0, %1 offset:%2" : "=&v"(vl1[(d0) & (VG - 1)]) : "v"(vb), "i"((d0) * 512 + KO + KS) : "memory"); \
                asm volatile("ds_read_b64_tr_b16 %0, %1 offset:%2" : "=&v"(vh1[(d0) & (VG - 1)]) : "v"(vb), "i"((d0) * 512 + KO + KS + HF) : "memory"); } while (0)
#define ATT_PVD(d0) do { const int g_ = (d0) & (VG - 1); \
                o[d0] = __builtin_amdgcn_mfma_f32_32x32x16_bf16(pa0, (bf16x8){vl0[g_][0], vl0[g_][1], vl0[g_][2], vl0[g_][3], vh0[g_][0], vh0[g_][1], vh0[g_][2], vh0[g_][3]}, o[d0], 0, 0, 0); \
                o[d0] = __builtin_amdgcn_mfma_f32_32x32x16_bf16(pa1, (bf16x8){vl1[g_][0], vl1[g_][1], vl1[g_][2], vl1[g_][3], vh1[g_][0], vh1[g_][1], vh1[g_][2], vh1[g_][3]}, o[d0], 0, 0, 0); } while (0)
#define ATT_SMPV(P, kb2, vbuf, hf) do { \
            const unsigned vb = vb0 + (unsigned)((vbuf) * C::VB); \
            constexpr int KS = NCB * 1024, HF = NCB * 512, KO = 2 * (hf) * KS, VG = 2;         \
            s16x4 vl0[VG], vh0[VG], vl1[VG], vh1[VG]; \
            ATT_VRD(0); ATT_VRD(1); \
            const int dq = qpos - (kb2) - 4 * hi; \
            if (MODE == 0) { if ((kb2) + 31 > qlo) { const float NEG = -__builtin_inff(); \
                    _Pragma("unroll") for (int r = 0; r < 16; ++r) { const int c = (r & 3) + 8 * (r >> 2); if (dq - c < 0) P[r] = NEG; } } } \
            else { _Pragma("unroll") for (int r = 0; r < 16; ++r) { const int c = (r & 3) + 8 * (r >> 2); unsigned i0 = (unsigned)(dq - c); i0 = i0 < 2049u ? i0 : 2049u; P[r] += lut[i0]; } } \
            float pmax = P[0]; \
            _Pragma("unroll") for (int r = 1; r < 16; ++r) pmax = fmaxf(pmax, P[r]); \
            { auto rr = __builtin_amdgcn_permlane32_swap(__float_as_uint(pmax), __float_as_uint(pmax), false, false); pmax = fmaxf(__uint_as_float(rr[0]), __uint_as_float(rr[1])); } \
            const float mn = fmaxf(m_reg, pmax); const float alpha = __builtin_amdgcn_exp2f(m_reg - mn); m_reg = mn; \
            float ps = 0.f; \
            _Pragma("unroll") for (int r = 0; r < 16; ++r) { P[r] = __builtin_amdgcn_exp2f(P[r] - mn); ps += P[r]; } \
            { auto rr = __builtin_amdgcn_permlane32_swap(__float_as_uint(ps), __float_as_uint(ps), false, false); ps = __uint_as_float(rr[0]) + __uint_as_float(rr[1]); } \
            l_reg = l_reg * alpha + ps; \
            bf16x8 pa0, pa1; ATT_PK4(P, 0, pa0); ATT_PK4(P, 8, pa1); \
            if (__any(alpha < 1.f)) { if (hi == 0) wsf[r32] = alpha; asm volatile("s_waitcnt lgkmcnt(0)" ::: "memory"); \
                _Pragma("unroll") for (int r = 0; r < 16; ++r) { const float a = wsf[crow(r, hi)]; _Pragma("unroll") for (int d = 0; d < NCB; ++d) o[d][r] *= a; } } \
            asm volatile("s_waitcnt lgkmcnt(0)" ::: "memory"); __builtin_amdgcn_sched_barrier(0);     \
            ATT_PVD(0); ATT_PVD(1); \
            if (NCB > 2) { __builtin_amdgcn_sched_barrier(0); ATT_VRD(2); ATT_VRD(3); asm volatile("s_waitcnt lgkmcnt(0)" ::: "memory"); __builtin_amdgcn_sched_barrier(0); ATT_PVD(2); ATT_PVD(3); } \
    } while (0)
    f32x16 pA, pB;
    int buf = 0;
    { const int kb0 = j_lo * 64; if (ATT_ACT(kb0)) ATT_QK(pA, 0, 0); }
    for (int t = 0; t < NT; ++t) {
        if (t + 2 < NT) { const int b2 = buf == 0 ? 2 : buf - 1; ATT_DMA(j_lo + t + 2, b2); }
        const int kb = (j_lo + t) * 64;
        const int nb = buf == 2 ? 0 : buf + 1;
        { const bool a0 = ATT_ACT(kb), a1 = ATT_ACT(kb + 32);
          if (a1) ATT_QK(pB, buf, 1);
          if (a0) ATT_SMPV(pA, kb, buf, 0);
          const bool a2 = (t + 1 < NT) && ATT_ACT(kb + 64);
          if (a2) ATT_QK(pA, nb, 0);
          if (a1) ATT_SMPV(pB, kb + 32, buf, 1); }
        asm volatile("s_waitcnt vmcnt(0)" ::: "memory");
        __syncthreads();
        buf = nb;
    }
#undef ATT_SMPV
#undef ATT_VRD
#undef ATT_PVD
#undef ATT_PK4
#undef ATT_QK
#undef ATT_ACT
#undef ATT_DMA
    if (hi == 0) wsf[32 + r32] = l_reg;
    asm volatile("s_waitcnt lgkmcnt(0)" ::: "memory");
    bf16_t* Ow = Oh + (size_t)qlo * op;
#pragma unroll
    for (int r = 0; r < 16; ++r) { const int orow = crow(r, hi); const float rl = __builtin_amdgcn_rcpf(wsf[32 + orow]);
#pragma unroll
        for (int d0 = 0; d0 < NCB; ++d0) { const float v = o[d0][r] * rl; const float vn = __shfl_xor(v, 1);
            if ((r32 & 1) == 0) *(unsigned*)(Ow + (size_t)orow * op + d0 * 32 + r32) = cvt_pk_bf16(v, vn); } }
    __syncthreads();
}
}

constexpr int NWAVES = 8;
constexpr size_t MiB = 1u << 20;
constexpr size_t WS_CTL = 0, CTL_ZERO_BYTES = 1 * MiB;
constexpr size_t WS_WEIN = 2 * MiB;
constexpr size_t WS_WEOUT = 12 * MiB;
constexpr size_t WS_WOIN = 16 * MiB;
constexpr size_t WS_WUQ = 20 * MiB;
constexpr size_t WS_WUKV = 23 * MiB;
constexpr size_t WS_WOOUT = 25 * MiB;
constexpr size_t WS_B1P = 29 * MiB;
constexpr size_t WS_SSQ = 30 * MiB;
constexpr size_t WS_TOKER = 31 * MiB;
constexpr size_t WS_TOKG = 31 * MiB + 512 * 1024;
constexpr size_t WS_XN = 32 * MiB;
constexpr size_t WS_Z = 64 * MiB;
constexpr size_t WS_MIX = 144 * MiB;
constexpr size_t WS_QR = 176 * MiB;
constexpr size_t WS_KVR = 224 * MiB;
constexpr size_t WS_QF = 288 * MiB;
constexpr size_t WS_KF = 336 * MiB;
constexpr size_t WS_W1 = 384 * MiB;
constexpr size_t WS_W2 = 896 * MiB;
constexpr size_t WS_XG = 1152 * MiB;
constexpr size_t WS_ACT = 2176 * MiB;
constexpr size_t WS_END = 3200 * MiB;
constexpr int CW_TMO = 0, CW_CODE = 1, CW_BAR = 4096, CW_CNT = 16384;
constexpr int RING_OFF = 0, RING_BYTES = 131072;
constexpr int LDSCTL_OFF = RING_BYTES, MISC_OFF = LDSCTL_OFF + 320;
constexpr int SCR_OFF = RING_BYTES + 1024;
constexpr int LDS_BYTES = 155648;
constexpr int SCR_BYTES = LDS_BYTES - SCR_OFF;

typedef GAS unsigned gu32;
#define RLX_AGENT __ATOMIC_RELAXED, __HIP_MEMORY_SCOPE_AGENT

#define XB_TMO      128
#define XB_XCNT(j)  (256  + 64 * (j))
#define XB_XSUB(j)  (1280 + 64 * (j))
#define XB_XGEN(j)  (2304 + 64 * (j))
#define XB_TOP      3328
#define XB_TOPGEN   3392
#define XCD_BAR_WORDS 3456
#define XB_SPIN_CAP (1u << 18)
__device__ __forceinline__ unsigned xb_ld(unsigned* p)              { return __hip_atomic_load(p, __ATOMIC_RELAXED, __HIP_MEMORY_SCOPE_AGENT); }
__device__ __forceinline__ unsigned xb_add(unsigned* p, unsigned v) { return __hip_atomic_fetch_add(p, v, __ATOMIC_RELAXED, __HIP_MEMORY_SCOPE_AGENT); }
__device__ __forceinline__ unsigned xb_xcc_id() { return (unsigned)__builtin_amdgcn_s_getreg((3 << 11) | 20) & 0xFu; }
#define XB_SPIN(cond, bar) do { unsigned _sp = 0; while (cond) { __builtin_amdgcn_s_sleep(1); \
    if ((++_sp & 255u) == 0u) { if (xb_ld(&(bar)[XB_TMO])) break; if (_sp > XB_SPIN_CAP) { atomicAdd(&(bar)[XB_TMO], 1u); break; } } } } while (0)
struct XcdBarrier { unsigned* bar; unsigned x; volatile LAS unsigned* st; };
__device__ __forceinline__ XcdBarrier xcd_barrier_post(unsigned* bar, volatile LAS unsigned* st) {
    XcdBarrier b; b.bar = bar; b.x = xb_xcc_id(); b.st = st;
    if (threadIdx.x == 0) (void)xb_add(&bar[XB_XCNT(b.x)], 1u);
    return b;
}
__device__ __forceinline__ void xcd_barrier_complete(unsigned* bar, unsigned x, unsigned& nloc, unsigned& nx) {
    const unsigned G = gridDim.x * gridDim.y * gridDim.z;
    unsigned sum, cnt, mine, sp = 0u;
    for (;;) {
        sum = 0u; cnt = 0u; mine = 0u;
#pragma unroll
        for (unsigned j = 0; j < 16; ++j) { const unsigned c = xb_ld(&bar[XB_XCNT(j)]); sum += c; cnt += (c > 0u) ? 1u : 0u; mine = (j == x) ? c : mine; }
        if (sum == G) break;
        __builtin_amdgcn_s_sleep(1);
        if ((++sp & 255u) == 0u) { if (xb_ld(&bar[XB_TMO])) break; if (sp > XB_SPIN_CAP) { atomicAdd(&bar[XB_TMO], 1u); break; } }
    }
    nloc = mine > 0u ? mine : 1u; nx = cnt > 0u ? cnt : 1u;
}
__device__ __forceinline__ void xcd_barrier(const XcdBarrier& b) {
    asm volatile("s_waitcnt vmcnt(0)" ::: "memory");
    __syncthreads();
    if (threadIdx.x == 0) {
        unsigned* bar = b.bar;
        __builtin_amdgcn_s_waitcnt(0);
        unsigned nloc = b.st[0], nx = b.st[1];
        if (nloc == 0u) { xcd_barrier_complete(bar, b.x, nloc, nx); b.st[0] = nloc; b.st[1] = nx; }
        const unsigned old = xb_add(&bar[XB_XSUB(b.x)], 1u);
        const unsigned gen = old / nloc;
        if (old + 1u == (gen + 1u) * nloc) {
            __builtin_amdgcn_fence(__ATOMIC_RELEASE, "agent");
            asm volatile("s_waitcnt vmcnt(0)" ::: "memory");
            const unsigned og = xb_add(&bar[XB_TOP], 1u);
            const unsigned tg = og / nx;
            if (og + 1u == (tg + 1u) * nx) xb_add(&bar[XB_TOPGEN], 1u);
            else XB_SPIN(xb_ld(&bar[XB_TOPGEN]) == tg, bar);
            __builtin_amdgcn_fence(__ATOMIC_ACQUIRE, "agent");
            xb_add(&bar[XB_XGEN(b.x)], 1u);
            asm volatile("s_waitcnt vmcnt(0)" ::: "memory");
        } else {
            XB_SPIN(xb_ld(&bar[XB_XGEN(b.x)]) == gen, bar);
            __builtin_amdgcn_fence(__ATOMIC_ACQUIRE, "agent");
            asm volatile("s_waitcnt vmcnt(0)" ::: "memory");
        }
    }
    __syncthreads();
}

struct Args {
    const float* in[24]; float* out; unsigned char* ws; int stage_limit; int pad;
};
enum { I_X = 0, I_MIXN, I_FFNN, I_EWIN, I_EWS, I_EBS, I_EGV, I_EGQ, I_EGK, I_EWOUT, I_OWIN, I_OGCQ, I_OGCKV, I_OWUQ, I_OWUKV, I_OGQ, I_OGK, I_OWOUT,
       I_RW, I_RB, I_W1, I_B1, I_W2, I_B2 };

struct Frame {
    LAS unsigned char* lds;
    int vcu, G;
};

__device__ __forceinline__ float wave_sum(float v) {
#pragma unroll
    for (int o = 1; o < 64; o <<= 1) v += __shfl_xor(v, o);
    return v;
}
#define LDS_WAIT() asm volatile("s_waitcnt lgkmcnt(0)" ::: "memory")

template <int MODE> __device__ __forceinline__ int dst_row(int o) {
    if (MODE == 1) { if (o >= 1024 && o < 2048) return (o & ~255) | (((o >> 5) & 1) << 7) | (((o >> 6) & 3) << 5) | (o & 31); return o; }
    if (MODE == 2) return ((o >> 8) << 8) | ((o & 1) << 7) | ((o & 255) >> 1);
    return o;
}
template <int MODE>
__device__ __forceinline__ void transpose_item(const float* __restrict__ W, int K, int N, bf16_t* __restrict__ WT, const float* __restrict__ gain, LAS float* scr, int item, int lane) {
    const int nblk = N / 32, kb = item / nblk, nb = item % nblk, k0 = 64 * kb, n0 = 32 * nb;
#pragma unroll 8
    for (int i = 0; i < 32; ++i) { const int kk = 2 * i + (lane >> 5); float w = W[(size_t)(k0 + kk) * N + n0 + (lane & 31)]; if (gain) w *= gain[k0 + kk]; scr[kk * 33 + (lane & 31)] = w; }
    LDS_WAIT(); asm volatile("" ::: "memory");
    const int c = lane & 7;
#pragma unroll
    for (int j = 0; j < 4; ++j) { const int n = (lane >> 3) + 8 * j; const LAS float* s = scr + (8 * c) * 33 + n;
        u32x4 o; o.x = cvt_pk_bf16(s[0 * 33], s[1 * 33]); o.y = cvt_pk_bf16(s[2 * 33], s[3 * 33]); o.z = cvt_pk_bf16(s[4 * 33], s[5 * 33]); o.w = cvt_pk_bf16(s[6 * 33], s[7 * 33]);
        *(u32x4*)(WT + (size_t)dst_row<MODE>(n0 + n) * K + k0 + 8 * c) = o; }
    LDS_WAIT(); asm volatile("" ::: "memory");
}
template <int MODE>
__device__ __forceinline__ void transpose_job(Frame& F, const float* W, int K, int N, int nmat, size_t src_stride, bf16_t* WT, size_t dst_stride, const float* gain, int gain_stride) {
    int tid_ = threadIdx.x; asm volatile("" : "+v"(tid_));
    const int wave = __builtin_amdgcn_readfirstlane(tid_ >> 6), lane = tid_ & 63;
    LAS float* scr = (LAS float*)(F.lds + RING_OFF + wave * 16384);
    const int gw = F.vcu * NWAVES + wave, NGW = F.G * NWAVES;
    const int per = (K / 64) * (N / 32), total = per * nmat;
    for (int it = gw; it < total; it += NGW) { const int mi = it / per, item = it - mi * per;
        transpose_item<MODE>(W + (size_t)mi * src_stride, K, N, WT + (size_t)mi * dst_stride, gain ? gain + (size_t)mi * gain_stride : nullptr, scr, item, lane); }
}


__device__ __forceinline__ void tr8_load(f32x4 (&v)[8], const float* __restrict__ W, int N, int item, int lane) {
    const int nblk = N / 32, kb = item / nblk, nb = item % nblk, k0 = 64 * kb, n0 = 32 * nb;
#pragma unroll
    for (int i = 0; i < 8; ++i) v[i] = __builtin_nontemporal_load((const f32x4*)(W + (size_t)(k0 + 8 * i + (lane >> 3)) * N + n0 + 4 * (lane & 7)));
}
template <int MODE>
__device__ __forceinline__ void tr8_store(const f32x4 (&v)[8], int K, int N, unsigned char* __restrict__ WT, LAS float* scr, int item, int lane) {
    const int nblk = N / 32, kb = item / nblk, nb = item % nblk, k0 = 64 * kb, n0 = 32 * nb;
#pragma unroll
    for (int i = 0; i < 8; ++i) { LAS float* d = scr + (8 * i + (lane >> 3)) * 33 + 4 * (lane & 7);
        d[0] = v[i].x * W8_SCALE; d[1] = v[i].y * W8_SCALE; d[2] = v[i].z * W8_SCALE; d[3] = v[i].w * W8_SCALE; }
    LDS_WAIT(); asm volatile("" ::: "memory");
    const int c = lane & 3;
#pragma unroll
    for (int j = 0; j < 2; ++j) { const int n = (lane >> 2) + 16 * j; const LAS float* s = scr + (16 * c) * 33 + n;
        u32x4 o; o.x = pk4_fp8(s[0 * 33], s[1 * 33], s[2 * 33], s[3 * 33]); o.y = pk4_fp8(s[4 * 33], s[5 * 33], s[6 * 33], s[7 * 33]);
        o.z = pk4_fp8(s[8 * 33], s[9 * 33], s[10 * 33], s[11 * 33]); o.w = pk4_fp8(s[12 * 33], s[13 * 33], s[14 * 33], s[15 * 33]);
        *(u32x4*)(WT + (size_t)dst_row<MODE>(n0 + n) * K + k0 + 16 * c) = o; }
    LDS_WAIT(); asm volatile("" ::: "memory");
}
template <int MODE>
__device__ __forceinline__ void transpose_job_fp8(Frame& F, const float* W, int K, int N, int nmat, size_t src_stride, unsigned char* WT, size_t dst_stride) {
    int tid_ = threadIdx.x; asm volatile("" : "+v"(tid_));
    const int wave = __builtin_amdgcn_readfirstlane(tid_ >> 6), lane = tid_ & 63;
    LAS float* scr = (LAS float*)(F.lds + RING_OFF + wave * 16384);
    const int gw = F.vcu * NWAVES + wave, NGW = F.G * NWAVES;
    const int per = (K / 64) * (N / 32), total = per * nmat;
    f32x4 cur[8], nxt[8];
    int it = gw;
    if (it < total) { const int mi = it / per; tr8_load(cur, W + (size_t)mi * src_stride, N, it - mi * per, lane); }
    for (; it < total; it += NGW) {
        const int itn = it + NGW;
        if (itn < total) { const int mn = itn / per; tr8_load(nxt, W + (size_t)mn * src_stride, N, itn - mn * per, lane); }
        const int mi = it / per;
        tr8_store<MODE>(cur, K, N, WT + (size_t)mi * dst_stride, scr, it - mi * per, lane);
#pragma unroll
        for (int i = 0; i < 8; ++i) cur[i] = nxt[i];
    }
}

__device__ __forceinline__ void rms_row_to_bf16(int lane, const float* xrow, const float* g, bf16_t* orow, float* copy) {
    const f32x4* xr = (const f32x4*)xrow + lane; const f32x4* gr = (const f32x4*)g + lane;
    f32x4 v[4]; float s = 0.f;
#pragma unroll
    for (int j = 0; j < 4; ++j) { v[j] = xr[64 * j]; s += (v[j].x * v[j].x + v[j].y * v[j].y) + (v[j].z * v[j].z + v[j].w * v[j].w); }
    const float rstd = 1.0f / sqrtf(wave_sum(s) * (1.f / DM) + EPS);
    u32x2* o8 = (u32x2*)orow + lane;
#pragma unroll
    for (int j = 0; j < 4; ++j) { const f32x4 gg = gr[64 * j]; if (copy) ((f32x4*)copy + lane)[64 * j] = v[j];
        u32x2 w; w.x = cvt_pk_bf16(v[j].x * rstd * gg.x, v[j].y * rstd * gg.y); w.y = cvt_pk_bf16(v[j].z * rstd * gg.z, v[j].w * rstd * gg.w); o8[64 * j] = w; }
}

namespace pg8 {
struct EpiEvenIn {
    static constexpr bool PERM = false;
    bf16_t* Z; const float* gq; const float* gk;
    __device__ __forceinline__ void operator()(const f32x4 (&acc)[2][2][4][2], const Unit& u, int wr, int wc, int fr, int fq) const {
        const int row0 = u.pm * BM + wr * 64 + fr, pn = u.pn;
        if (pn >= 4 && pn < 8) {
            const float* g = pn < 6 ? gq : gk; const float sc = pn < 6 ? C2_B : 1.0f;
            f32x4 gv[2][2];
#pragma unroll
            for (int bj = 0; bj < 2; ++bj)
#pragma unroll
                for (int n = 0; n < 2; ++n) gv[bj][n] = *(const f32x4*)(g + 32 * bj + 16 * n + 4 * fq);
#pragma unroll
            for (int ai = 0; ai < 2; ++ai)
#pragma unroll
                for (int m = 0; m < 4; ++m) {
                    float ss = 0.f;
#pragma unroll
                    for (int bj = 0; bj < 2; ++bj)
#pragma unroll
                        for (int n = 0; n < 2; ++n) { const f32x4 v = acc[ai][bj][m][n]; ss += (v[0] * v[0] + v[1] * v[1]) + (v[2] * v[2] + v[3] * v[3]); }
                    ss += __shfl_xor(ss, 16); ss += __shfl_xor(ss, 32);
                    const float rstd = sc / sqrtf(ss * (1.0f / 64.0f) + EPS);
                    bf16_t* rowp = Z + (size_t)(row0 + ai * HALF + m * 16) * EVEN_IN + pn * BM + wc * 64 + 4 * fq;
#pragma unroll
                    for (int bj = 0; bj < 2; ++bj)
#pragma unroll
                        for (int n = 0; n < 2; ++n) { const f32x4 v = acc[ai][bj][m][n] * rstd * gv[bj][n];
                            u32x2 w; w.x = cvt_pk_bf16(v[0], v[1]); w.y = cvt_pk_bf16(v[2], v[3]); *(u32x2*)(rowp + 32 * bj + 16 * n) = w; }
                }
        } else {
            const bool act = pn < 4;
#pragma unroll
            for (int ai = 0; ai < 2; ++ai)
#pragma unroll
                for (int m = 0; m < 4; ++m) { bf16_t* rowp = Z + (size_t)(row0 + ai * HALF + m * 16) * EVEN_IN + pn * BM + wc * 32 + 4 * fq;
#pragma unroll
                    for (int bj = 0; bj < 2; ++bj)
#pragma unroll
                        for (int n = 0; n < 2; ++n) { f32x4 v = acc[ai][bj][m][n]; if (act) v = gelu4(v);
                            u32x2 w; w.x = cvt_pk_bf16(v[0], v[1]); w.y = cvt_pk_bf16(v[2], v[3]); *(u32x2*)(rowp + bj * HALF + 16 * n) = w; } }
        }
    }
};
struct EpiResid {
    static constexpr bool PERM = false;
    float* out;
    __device__ __forceinline__ void operator()(const f32x4 (&acc)[2][2][4][2], const Unit& u, int wr, int wc, int fr, int fq) const {
        const int row0 = u.pm * BM + wr * 64 + fr;
#pragma unroll
        for (int ai = 0; ai < 2; ++ai)
#pragma unroll
            for (int m = 0; m < 4; ++m) { float* rowp = out + (size_t)(row0 + ai * HALF + m * 16) * DM + u.pn * BM + wc * 32 + 4 * fq;
#pragma unroll
                for (int bj = 0; bj < 2; ++bj)
#pragma unroll
                    for (int n = 0; n < 2; ++n) { f32x4* p = (f32x4*)(rowp + bj * HALF + 16 * n); *p = *p + acc[ai][bj][m][n]; }
                if (m & 1) asm volatile("" ::: "memory"); }
    }
};
struct EpiOddIn {
    static constexpr bool PERM = false;
    bf16_t* Z; float* ssq;
    __device__ __forceinline__ void operator()(const f32x4 (&acc)[2][2][4][2], const Unit& u, int wr, int wc, int fr, int fq) const {
        const int row0 = u.pm * BM + wr * 64 + fr, pn = u.pn;
#pragma unroll
        for (int ai = 0; ai < 2; ++ai)
#pragma unroll
            for (int m = 0; m < 4; ++m) { const int row = row0 + ai * HALF + m * 16; bf16_t* rowp = Z + (size_t)row * ODD_INP + pn * BM + wc * 32 + 4 * fq;
                float ss = 0.f;
#pragma unroll
                for (int bj = 0; bj < 2; ++bj)
#pragma unroll
                    for (int n = 0; n < 2; ++n) { const f32x4 v = acc[ai][bj][m][n]; ss += (v[0] * v[0] + v[1] * v[1]) + (v[2] * v[2] + v[3] * v[3]);
                        u32x2 w; w.x = cvt_pk_bf16(v[0], v[1]); w.y = cvt_pk_bf16(v[2], v[3]); *(u32x2*)(rowp + bj * HALF + 16 * n) = w; }
                ss += __shfl_xor(ss, 16); ss += __shfl_xor(ss, 32);
                if (fq == 0) ssq[(size_t)row * 16 + pn * 4 + wc] = ss; }
    }
};
template <int NS> struct EpiRowScale {
    static constexpr bool PERM = true;
    bf16_t* O; int ldc; const float* ssq; int s0; float inv_cols;
    __device__ __forceinline__ void operator()(const f32x4 (&acc)[2][2][4][2], const Unit& u, int wr, int wc, int fr, int fq) const {
        const int row0 = u.pm * BM + wr * 64 + fr; const int col0 = u.pn * BM + wc * 32 + 8 * fq;
#pragma unroll
        for (int ai = 0; ai < 2; ++ai)
#pragma unroll
            for (int m = 0; m < 4; ++m) { const int row = row0 + ai * HALF + m * 16;
                float ss = 0.f; const f32x4* sp = (const f32x4*)(ssq + (size_t)row * 16 + s0);
#pragma unroll
                for (int q = 0; q < NS; ++q) { const f32x4 t = sp[q]; ss += (t[0] + t[1]) + (t[2] + t[3]); }
                const float rstd = 1.0f / sqrtf(ss * inv_cols + EPS);
                bf16_t* rowp = O + (size_t)row * ldc + col0;
#pragma unroll
                for (int bj = 0; bj < 2; ++bj) { const f32x4 v0 = acc[ai][bj][m][0] * rstd, v1 = acc[ai][bj][m][1] * rstd;
                    u32x4 w; w.x = cvt_pk_bf16(v0[0], v0[1]); w.y = cvt_pk_bf16(v0[2], v0[3]); w.z = cvt_pk_bf16(v1[0], v1[1]); w.w = cvt_pk_bf16(v1[2], v1[3]);
                    *(u32x4*)(rowp + bj * HALF) = w; }
                asm volatile("" ::: "memory"); }
    }
};
struct EpiSwiglu {
    static constexpr bool PERM = true;
    unsigned char* ACT; const float* b1p;
    __device__ __forceinline__ void operator()(const f32x4 (&acc)[2][2][4][2], const Unit& u, int wr, int wc, int fr, int fq) const {
        const int row0 = u.pm * BM + wr * 64 + fr, e = u.pb >> 3, pn = u.pn;
        const float* bp = b1p + (size_t)e * 2048 + pn * BM + wc * 32 + 8 * fq;
        f32x4 bg[2], bl[2];
#pragma unroll
        for (int n = 0; n < 2; ++n) { bg[n] = *(const f32x4*)(bp + 4 * n); bl[n] = *(const f32x4*)(bp + HALF + 4 * n); }
#pragma unroll
        for (int ai = 0; ai < 2; ++ai)
#pragma unroll
            for (int m = 0; m < 4; ++m) { unsigned char* rowp = ACT + (size_t)(row0 + ai * HALF + m * 16) * DE + pn * HALF + wc * 32 + 8 * fq;
                float a[8];
#pragma unroll
                for (int n = 0; n < 2; ++n) { const f32x4 gv = acc[ai][0][m][n] * W8_INV + bg[n], lv = acc[ai][1][m][n] * W8_INV + bl[n];
#pragma unroll
                    for (int i = 0; i < 4; ++i) { const float gl = fminf(gv[i], 7.0f), li = fminf(fmaxf(lv[i], -7.0f), 7.0f);
                        const float sg = __builtin_amdgcn_rcpf(1.0f + __builtin_amdgcn_exp2f(-1.702f * LOG2E * gl));
                        a[4 * n + i] = gl * sg * (li + 1.0f); } }
                u32x2 w; w.x = pk4_fp8(a[0], a[1], a[2], a[3]); w.y = pk4_fp8(a[4], a[5], a[6], a[7]);
                *(u32x2*)rowp = w; }
    }
};
struct EpiDown {
    static constexpr bool PERM = true;
    bf16_t* Y; const float* b2;
    __device__ __forceinline__ void operator()(const f32x4 (&acc)[2][2][4][2], const Unit& u, int wr, int wc, int fr, int fq) const {
        const int row0 = u.pm * BM + wr * 64 + fr, e = u.pb >> 2, pn = u.pn;
        const float* bp = b2 + (size_t)e * DM + pn * BM + wc * 32 + 8 * fq;
        f32x4 bv[2][2];
#pragma unroll
        for (int bj = 0; bj < 2; ++bj)
#pragma unroll
            for (int n = 0; n < 2; ++n) bv[bj][n] = *(const f32x4*)(bp + bj * HALF + 4 * n);
#pragma unroll
        for (int ai = 0; ai < 2; ++ai)
#pragma unroll
            for (int m = 0; m < 4; ++m) { bf16_t* rowp = Y + (size_t)(row0 + ai * HALF + m * 16) * DM + pn * BM + wc * 32 + 8 * fq;
#pragma unroll
                for (int bj = 0; bj < 2; ++bj) { const f32x4 v0 = acc[ai][bj][m][0] * W8_INV + bv[bj][0], v1 = acc[ai][bj][m][1] * W8_INV + bv[bj][1];
                    u32x4 w; w.x = cvt_pk_bf16(v0[0], v0[1]); w.y = cvt_pk_bf16(v0[2], v0[3]); w.z = cvt_pk_bf16(v1[0], v1[1]); w.w = cvt_pk_bf16(v1[2], v1[3]);
                    *(u32x4*)(rowp + bj * HALF) = w; } }
    }
};
struct MoeOrder {
    const LAS int* tbl; int nN, G, c;
    __device__ bool next(int i, Unit& u) const {
        const long L = (long)i * G + c; const int rb = (int)(L / nN);
        if (rb >= __builtin_amdgcn_readfirstlane(tbl[32])) return false;
        int e = 0;
#pragma unroll
        for (int k = 1; k < 32; ++k) e += (tbl[k] <= rb) ? 1 : 0;
        e = __builtin_amdgcn_readfirstlane(e); const int rbl = __builtin_amdgcn_readfirstlane(rb - tbl[e]);
        u.pm = e * (ECAP / BM) + rbl; u.pn = (int)(L % nN); u.pb = e * nN + u.pn; return true;
    }
};
}

__device__ __forceinline__ void gmlp_unit(Frame& F, const bf16_t* Z, bf16_t* MIX, const float* Ws, const float* bs, const float* gv, int unit) {
    constexpr int VP = 272;
    LAS unsigned char* VT = F.lds + RING_OFF;
    const int h = unit & 3, chunk = unit >> 2;
    int tid_ = threadIdx.x; asm volatile("" : "+v"(tid_));
    const int t0 = chunk * 128, tid = tid_, lane = tid & 63, w = __builtin_amdgcn_readfirstlane(tid >> 6);
    {
        const int s = tid >> 2, dq = (tid & 3) * 32;
        const bf16_t* vp = Z + (size_t)(t0 + s) * EVEN_IN + 512 + h * 128 + dq;
        u32x4 raw[4]; float ss = 0.f;
#pragma unroll
        for (int i = 0; i < 4; ++i) { raw[i] = *(const u32x4*)(vp + 8 * i);
#pragma unroll
            for (int j = 0; j < 4; ++j) { const float a = bflo(raw[i][j]), b = bfhi(raw[i][j]); ss += a * a + b * b; } }
        ss += __shfl_xor(ss, 1); ss += __shfl_xor(ss, 2);
        const float rstd = 1.0f / sqrtf(ss * (1.0f / 128.0f) + EPS);
#pragma unroll
        for (int i = 0; i < 4; ++i)
#pragma unroll
            for (int j = 0; j < 4; ++j) { const int d = dq + 8 * i + 2 * j;
                *(LAS bf16_t*)(VT + (d) * VP + s * 2) = f2bf(bflo(raw[i][j]) * rstd);
                *(LAS bf16_t*)(VT + (d + 1) * VP + s * 2) = f2bf(bfhi(raw[i][j]) * rstd); }
    }
    __syncthreads();
    const int fr = lane & 15, fq = lane >> 4;
    f32x4 acc[8];
#pragma unroll
    for (int nb = 0; nb < 8; ++nb) acc[nb] = (f32x4){0.f, 0.f, 0.f, 0.f};
    const int trow = 16 * w + fr;
    const float* wrow = Ws + ((size_t)h * 128 + trow) * 128;
#pragma unroll
    for (int ks = 0; ks < 4; ++ks) {
        if (32 * ks <= 16 * w + 15) {
            const int s0 = 32 * ks + 8 * fq;
            const f32x4 wa = *(const f32x4*)(wrow + s0), wb = *(const f32x4*)(wrow + s0 + 4);
            float wv[8] = {wa[0], wa[1], wa[2], wa[3], wb[0], wb[1], wb[2], wb[3]};
#pragma unroll
            for (int j = 0; j < 8; ++j) if (s0 + j > trow) wv[j] = 0.f;
            u32x4 aw; aw.x = cvt_pk_bf16(wv[0], wv[1]); aw.y = cvt_pk_bf16(wv[2], wv[3]); aw.z = cvt_pk_bf16(wv[4], wv[5]); aw.w = cvt_pk_bf16(wv[6], wv[7]);
            const bf16x8 af = __builtin_bit_cast(bf16x8, aw);
#pragma unroll
            for (int nb = 0; nb < 8; ++nb) { const bf16x8 bfr = *(const LAS bf16x8*)(VT + (16 * nb + fr) * VP + s0 * 2);
                acc[nb] = __builtin_amdgcn_mfma_f32_16x16x32_bf16(af, bfr, acc[nb], 0, 0, 0); }
        }
    }
#pragma unroll
    for (int i = 0; i < 4; ++i) { const int tl = 16 * w + 4 * fq + i; const float bt = bs[h * 128 + tl];
        const bf16_t* up = Z + (size_t)(t0 + tl) * EVEN_IN + h * 128 + fr; bf16_t* op = MIX + (size_t)(t0 + tl) * DM + h * 128 + fr;
#pragma unroll
        for (int nb = 0; nb < 8; ++nb) { const float uu = bf2f(up[16 * nb]); op[16 * nb] = f2bf(uu * (gv[h * 128 + 16 * nb + fr] * acc[nb][i] + bt)); } }
    __syncthreads();
}

__device__ __forceinline__ void router_phase(Frame& F, const float* x, const float* gain, const float* Wr, const float* br, gu32* cnt  ,
                                             unsigned* tok_er, float* tok_g, unsigned char* XG) {
    LAS float* WrT = (LAS float*)(F.lds + RING_OFF);
    LAS float* lg = (LAS float*)(F.lds + SCR_OFF);
    LAS unsigned* hist = (LAS unsigned*)(F.lds + SCR_OFF + 64 * 33 * 4);
    LAS unsigned* base = hist + 32;
    LAS unsigned* ers = base + 32;
    int tid_ = threadIdx.x; asm volatile("" : "+v"(tid_));
    const int tid = tid_, lane = tid & 63, w = __builtin_amdgcn_readfirstlane(tid >> 6);
#ifndef RTR_REP_A
#define RTR_REP_A 1
#define RTR_REP_B 1
#define RTR_REP_C 1
#endif
    for (int ra_ = 0; ra_ < RTR_REP_A; ++ra_)
    for (int idx = tid; idx < 8192; idx += 512) { const int e4 = idx >> 10, k = idx & 1023; const f32x4 v = *(const f32x4*)(Wr + (size_t)k * 32 + 4 * e4);
        WrT[(4 * e4 + 0) * 1024 + k] = v[0]; WrT[(4 * e4 + 1) * 1024 + k] = v[1]; WrT[(4 * e4 + 2) * 1024 + k] = v[2]; WrT[(4 * e4 + 3) * 1024 + k] = v[3]; }
    __syncthreads();
    f32x4 gg[4];
#pragma unroll
    for (int j = 0; j < 4; ++j) gg[j] = ((const f32x4*)gain + lane)[64 * j];
    const float brl = br[lane & 31];
    {   const int tg = F.vcu;
    const int tokb = tg * 64;
    if (tid < 32) hist[tid] = 0u;
    for (int rb_ = 0; rb_ < RTR_REP_B; ++rb_)
#pragma unroll 1
    for (int tp = 0; tp < 4; ++tp) {
        f32x4 ha[4], hb[4];
        {   const float* r0 = x + (size_t)(tokb + w * 8 + 2 * tp) * DM;
#pragma unroll
            for (int j = 0; j < 4; ++j) { ha[j] = ((const f32x4*)r0 + lane)[64 * j]; hb[j] = ((const f32x4*)(r0 + DM) + lane)[64 * j]; } }
        float sa = 0.f, sb = 0.f;
#pragma unroll
        for (int j = 0; j < 4; ++j) { sa += (ha[j].x * ha[j].x + ha[j].y * ha[j].y) + (ha[j].z * ha[j].z + ha[j].w * ha[j].w); sb += (hb[j].x * hb[j].x + hb[j].y * hb[j].y) + (hb[j].z * hb[j].z + hb[j].w * hb[j].w); }
        const float ra = 1.0f / sqrtf(wave_sum(sa) * (1.f / DM) + EPS), rb = 1.0f / sqrtf(wave_sum(sb) * (1.f / DM) + EPS);
#pragma unroll
        for (int j = 0; j < 4; ++j) { ha[j] = ha[j] * ra * gg[j]; hb[j] = hb[j] * rb * gg[j]; }
        float a[32], b[32];
#pragma unroll
        for (int e = 0; e < 32; ++e) { f32x2 ta = {0.f, 0.f}, tb = {0.f, 0.f};
#pragma unroll
            for (int j = 0; j < 4; ++j) { const f32x4 wv = *(const LAS f32x4*)(WrT + e * 1024 + 256 * j + 4 * lane);
                const f32x2 w01 = {wv.x, wv.y}, w23 = {wv.z, wv.w};
                ta = (f32x2){ha[j].x, ha[j].y} * w01 + ta; ta = (f32x2){ha[j].z, ha[j].w} * w23 + ta;
                tb = (f32x2){hb[j].x, hb[j].y} * w01 + tb; tb = (f32x2){hb[j].z, hb[j].w} * w23 + tb; }
            a[e] = ta.x + ta.y; b[e] = tb.x + tb.y; if ((e & 3) == 3) __builtin_amdgcn_sched_barrier(0); }
#define RSTEP(N, BIT) _Pragma("unroll") for (int i = 0; i < N; ++i) { const bool up = (lane & BIT) != 0; \
            { const float keep = up ? a[2 * i + 1] : a[2 * i], send = up ? a[2 * i] : a[2 * i + 1]; a[i] = keep + __shfl_xor(send, BIT); } \
            { const float keep = up ? b[2 * i + 1] : b[2 * i], send = up ? b[2 * i] : b[2 * i + 1]; b[i] = keep + __shfl_xor(send, BIT); } }
        RSTEP(16, 1) RSTEP(8, 2) RSTEP(4, 4) RSTEP(2, 8) RSTEP(1, 16)
#undef RSTEP
        const float la = a[0] + __shfl_xor(a[0], 32) + brl, lb = b[0] + __shfl_xor(b[0], 32) + brl;
        if (lane < 32) { lg[(w * 8 + 2 * tp) * 33 + lane] = la; lg[(w * 8 + 2 * tp + 1) * 33 + lane] = lb; }
        asm volatile("" ::: "memory"); __builtin_amdgcn_sched_barrier(0);
    }
    __syncthreads();
    unsigned my_e[4] = {0, 0, 0, 0}, my_lr[4] = {0, 0, 0, 0}; float my_g[4] = {0, 0, 0, 0};
    if (tid < 64) {
        float v[32];
#pragma unroll
        for (int e = 0; e < 32; ++e) v[e] = lg[tid * 33 + e];
        int c0 = -1, c1 = -1, c2 = -1; float tv[4];
#pragma unroll
        for (int r = 0; r < 4; ++r) { float best = -__builtin_inff(); int bi = 0;
#pragma unroll
            for (int e = 0; e < 32; ++e) { const bool ok = (e != c0) && (e != c1) && (e != c2); if (ok && v[e] > best) { best = v[e]; bi = e; } }
            tv[r] = best; my_e[r] = (unsigned)bi; if (r == 0) c0 = bi; else if (r == 1) c1 = bi; else if (r == 2) c2 = bi; }
        const float p1 = __expf(tv[1] - tv[0]), p2 = __expf(tv[2] - tv[0]), p3 = __expf(tv[3] - tv[0]); const float inv = 1.0f / (1.0f + p1 + p2 + p3);
        my_g[0] = inv; my_g[1] = p1 * inv; my_g[2] = p2 * inv; my_g[3] = p3 * inv;
#pragma unroll
        for (int r = 0; r < 4; ++r) my_lr[r] = __hip_atomic_fetch_add(hist + my_e[r], 1u, __ATOMIC_RELAXED, __HIP_MEMORY_SCOPE_WORKGROUP);
    }
    __syncthreads();
    if (tid < 32) { const unsigned hc = hist[tid]; base[tid] = hc ? __hip_atomic_fetch_add(cnt + 64 * tid, hc, RLX_AGENT) : 0u; }
    __syncthreads();
    if (tid < 64) {
        u32x4 er; f32x4 gt;
#pragma unroll
        for (int r = 0; r < 4; ++r) { const unsigned rank = base[my_e[r]] + my_lr[r]; er[r] = (my_e[r] << 16) | rank; gt[r] = my_g[r]; ers[tid * 4 + r] = er[r]; }
        *(u32x4*)(tok_er + (size_t)(tokb + tid) * 4) = er; *(f32x4*)(tok_g + (size_t)(tokb + tid) * 4) = gt;
    }
    __syncthreads();
    for (int rc_ = 0; rc_ < RTR_REP_C; ++rc_)
#pragma unroll 2
    for (int tt = 0; tt < 8; ++tt) {
        const int tl = w * 8 + tt; const float* xrow = x + (size_t)(tokb + tl) * DM;
        f32x4 hv[4]; float s = 0.f;
#pragma unroll
        for (int j = 0; j < 4; ++j) { hv[j] = ((const f32x4*)xrow + lane)[64 * j]; s += (hv[j].x * hv[j].x + hv[j].y * hv[j].y) + (hv[j].z * hv[j].z + hv[j].w * hv[j].w); }
        const float rstd = 1.0f / sqrtf(wave_sum(s) * (1.f / DM) + EPS);
        unsigned wv[4];
#pragma unroll
        for (int j = 0; j < 4; ++j) { const f32x4 t = hv[j] * rstd * gg[j]; wv[j] = pk4_fp8(t.x, t.y, t.z, t.w); }
#pragma unroll
        for (int r = 0; r < 4; ++r) { const unsigned er = ers[tl * 4 + r]; const size_t slot = (size_t)(er >> 16) * ECAP + (er & 0xffffu);
            unsigned* o4 = (unsigned*)(XG + slot * DM) + lane;
#pragma unroll
            for (int j = 0; j < 4; ++j) o4[64 * j] = wv[j]; }
    }
    __syncthreads();
    }
}

__device__ __forceinline__ void combine_phase(Frame& F, const float* x, float* xout, const unsigned* tok_er, const float* tok_g, const bf16_t* Y, const float* g_next, bf16_t* XN) {
    int tid_ = threadIdx.x; asm volatile("" : "+v"(tid_));
    const int gw = F.vcu * NWAVES + __builtin_amdgcn_readfirstlane(tid_ >> 6), NGW = F.G * NWAVES, lane = tid_ & 63;
    for (int m = gw; m < M; m += NGW) {
        const u32x4 er = *(const u32x4*)(tok_er + (size_t)m * 4); const f32x4 gt = *(const f32x4*)(tok_g + (size_t)m * 4);
        f32x4 v[4]; const float* xrow = x + (size_t)m * DM; float* xorow = xout + (size_t)m * DM;
#pragma unroll
        for (int j = 0; j < 4; ++j) v[j] = ((const f32x4*)xrow + lane)[64 * j];
#pragma unroll
        for (int r = 0; r < 4; ++r) { const size_t slot = (size_t)(er[r] >> 16) * ECAP + (er[r] & 0xffffu); const u32x2* yp = (const u32x2*)(Y + slot * DM) + lane; const float g = gt[r];
#pragma unroll
            for (int j = 0; j < 4; ++j) { const u32x2 yv = yp[64 * j]; v[j].x += g * bflo(yv.x); v[j].y += g * bfhi(yv.x); v[j].z += g * bflo(yv.y); v[j].w += g * bfhi(yv.y); } }
#pragma unroll
        for (int j = 0; j < 4; ++j) ((f32x4*)xorow + lane)[64 * j] = v[j];
        if (g_next) {
            float s = 0.f;
#pragma unroll
            for (int j = 0; j < 4; ++j) s += (v[j].x * v[j].x + v[j].y * v[j].y) + (v[j].z * v[j].z + v[j].w * v[j].w);
            const float rstd = 1.0f / sqrtf(wave_sum(s) * (1.f / DM) + EPS);
            u32x2* o8 = (u32x2*)(XN + (size_t)m * DM) + lane;
#pragma unroll
            for (int j = 0; j < 4; ++j) { const f32x4 gg = ((const f32x4*)g_next + lane)[64 * j];
                u32x2 w; w.x = cvt_pk_bf16(v[j].x * rstd * gg.x, v[j].y * rstd * gg.y); w.y = cvt_pk_bf16(v[j].z * rstd * gg.z, v[j].w * rstd * gg.w); o8[64 * j] = w; }
        }
    }
}

__device__ __forceinline__ void mla_finalize_phase(Frame& F, const bf16_t* QR, const bf16_t* KVR, const bf16_t* Z, const float* gq, const float* gk, bf16_t* QF, bf16_t* KF) {
    int tid_ = threadIdx.x; asm volatile("" : "+v"(tid_));
    const int gw = F.vcu * NWAVES + __builtin_amdgcn_readfirstlane(tid_ >> 6), NGW = F.G * NWAVES, lane = tid_ & 63;
    const int fi = lane & 31;
    const float invf = __builtin_amdgcn_exp2f(-(float)fi * (13.287712379549449f / 32.0f));
    const float gq0 = gq[lane], gq1 = gq[64 + lane], gq2 = gq[128 + lane], gk0 = gk[lane], gk1 = gk[64 + lane], gk2 = gk[128 + lane];
    for (int m = gw; m < M; m += NGW) {
        const int pos = m & (SEQ - 1);
        const double rev = (double)pos * (double)invf * 0.15915494309189535;
        const float fr = (float)(rev - __builtin_rint(rev));
        const float sn = __builtin_amdgcn_sinf(fr), cs = __builtin_amdgcn_cosf(fr);
        const float kr = bf2f(Z[(size_t)m * ODD_INP + 768 + lane]);
#pragma unroll
        for (int h = 0; h < 8; ++h) {
            {   const bf16_t* qp = QR + (size_t)m * 1536 + h * 192;
                float a = bf2f(qp[lane]), b = bf2f(qp[64 + lane]), c = bf2f(qp[128 + lane]);
                const float rstd = 1.0f / sqrtf(wave_sum(a * a + b * b + c * c) * (1.0f / 192.0f) + EPS);
                a *= rstd * gq0; b *= rstd * gq1; c *= rstd * gq2;
                const float pc = __shfl_xor(c, 32);
                const float rc = lane < 32 ? (c * cs - pc * sn) : (pc * sn + c * cs);
                bf16_t* op = QF + (size_t)m * 1536 + h * 192;
                op[lane] = f2bf(a * C2_C); op[64 + lane] = f2bf(b * C2_C); op[128 + lane] = f2bf(rc * C2_C); }
            {   const bf16_t* kp = KVR + (size_t)m * 2048 + h * 256;
                float a = bf2f(kp[lane]), b = bf2f(kp[64 + lane]), c = kr;
                const float rstd = 1.0f / sqrtf(wave_sum(a * a + b * b + c * c) * (1.0f / 192.0f) + EPS);
                a *= rstd * gk0; b *= rstd * gk1; c *= rstd * gk2;
                const float pc = __shfl_xor(c, 32);
                const float rc = lane < 32 ? (c * cs - pc * sn) : (pc * sn + c * cs);
                bf16_t* op = KF + (size_t)m * 1536 + h * 192;
                op[lane] = f2bf(a); op[64 + lane] = f2bf(b); op[128 + lane] = f2bf(rc); }
        }
    }
}

#ifndef PHMASK
#define PHMASK 0xFFFF
#endif
#ifndef REPMASK
#define REPMASK 0
#endif
#ifndef REPCNT
#define REPCNT 3
#endif
#define NREP(k) ((((REPMASK) >> (k)) & 1) ? (REPCNT) : 1)

#define LAUNDER_S(x) asm volatile("" : "+s"(x))
__device__ __forceinline__ const float* in_ptr(const Args& a, int i) { LAUNDER_S(i); return a.in[i]; }
#define PHASE_BEGIN() unsigned wso_ = 0u; LAUNDER_S(wso_); unsigned char* ws = args.ws + wso_; Frame Fp = F; Fp.vcu = __builtin_amdgcn_readfirstlane(Fp.vcu); Fp.G = __builtin_amdgcn_readfirstlane(Fp.G); LAUNDER_S(Fp.vcu); LAUNDER_S(Fp.G); \
    int bx_ = __builtin_amdgcn_readfirstlane((int)blockIdx.x); LAUNDER_S(bx_); (void)bx_; (void)ws
#define XN  ((bf16_t*)(ws + WS_XN))
#define Z   ((bf16_t*)(ws + WS_Z))
#define MIX ((bf16_t*)(ws + WS_MIX))
#define QR  ((bf16_t*)(ws + WS_QR))
#define KVR ((bf16_t*)(ws + WS_KVR))
#define QF  ((bf16_t*)(ws + WS_QF))
#define KF  ((bf16_t*)(ws + WS_KF))
#define XG  ((unsigned char*)(ws + WS_XG))
#define ACT ((unsigned char*)(ws + WS_ACT))
#define YB  ((bf16_t*)(ws + WS_XG))
#define SSQ ((float*)(ws + WS_SSQ))
#define TOKER ((unsigned*)(ws + WS_TOKER))
#define TOKG ((float*)(ws + WS_TOKG))
#define B1P ((float*)(ws + WS_B1P))
#define IN(i) in_ptr(args, (i))
__global__ void __launch_bounds__(NWAVES * 64, 2) trunk_fwd(Args args) {
    extern __shared__ __attribute__((aligned(16))) unsigned char lds_raw[];
    Frame F;
    F.lds = (LAS unsigned char*)lds_raw;
    F.G = gridDim.x; { const int bx = blockIdx.x; F.vcu = (F.G % 8 == 0) ? (bx % 8) * (F.G / 8) + bx / 8 : bx; }
    for (int u = threadIdx.x; u < (SCR_OFF - LDSCTL_OFF) / 4; u += NWAVES * 64) ((LAS unsigned*)(F.lds + LDSCTL_OFF))[u] = 0u;
    __syncthreads();
    (void)xcd_barrier_post((unsigned*)((gu32*)(args.ws + WS_CTL) + CW_BAR), (volatile LAS unsigned*)(F.lds + MISC_OFF) + 8);
#define GRID_BAR() do { unsigned wsb_ = 0u; LAUNDER_S(wsb_); XcdBarrier bar_; bar_.bar = (unsigned*)((gu32*)(args.ws + wsb_ + WS_CTL) + CW_BAR); bar_.x = xb_xcc_id(); \
        bar_.st = (volatile LAS unsigned*)(F.lds + MISC_OFF) + 8; xcd_barrier(bar_); } while (0)
    float* const X = args.out;
    const int stage_limit = args.stage_limit;

#if (PHMASK >> 0) & 1
            _Pragma("unroll") for (int rep_ = 0; rep_ < NREP(0); ++rep_) { if (rep_) GRID_BAR();
    {   PHASE_BEGIN(); const int ptid = threadIdx.x, gw = Fp.vcu * NWAVES + __builtin_amdgcn_readfirstlane(ptid >> 6), NGW = Fp.G * NWAVES;
        transpose_job<1>(Fp, IN(I_EWIN), DM, EVEN_IN, 2, (size_t)DM * EVEN_IN, (bf16_t*)(ws + WS_WEIN), (size_t)EVEN_IN * DM, nullptr, 0);
        transpose_job<0>(Fp, IN(I_EWOUT), DM, DM, 2, (size_t)DM * DM, (bf16_t*)(ws + WS_WEOUT), (size_t)DM * DM, nullptr, 0);
        transpose_job<0>(Fp, IN(I_OWIN), DM, ODD_IN, 2, (size_t)DM * ODD_IN, (bf16_t*)(ws + WS_WOIN), (size_t)ODD_INP * DM, nullptr, 0);
        transpose_job<0>(Fp, IN(I_OWUQ), 512, 1536, 2, (size_t)512 * 1536, (bf16_t*)(ws + WS_WUQ), (size_t)1536 * 512, IN(I_OGCQ), 512);
        transpose_job<0>(Fp, IN(I_OWUKV), 256, 2048, 2, (size_t)256 * 2048, (bf16_t*)(ws + WS_WUKV), (size_t)2048 * 256, IN(I_OGCKV), 256);
        transpose_job<0>(Fp, IN(I_OWOUT), DM, DM, 2, (size_t)DM * DM, (bf16_t*)(ws + WS_WOOUT), (size_t)DM * DM, nullptr, 0);
        transpose_job_fp8<2>(Fp, IN(I_W1), DM, 2 * DE, DEPTH * NE, (size_t)DM * 2 * DE, ws + WS_W1, (size_t)2 * DE * DM);
        transpose_job_fp8<0>(Fp, IN(I_W2), DE, DM, DEPTH * NE, (size_t)DE * DM, ws + WS_W2, (size_t)DM * DE);
        for (int i = bx_ * 512 + ptid; i < 2 * 24576; i += Fp.G * 512) { const int mi = i / 24576, r = i % 24576;
            *(u32x4*)((bf16_t*)(ws + WS_WOIN) + (size_t)mi * ODD_INP * DM + (size_t)ODD_IN * DM + (size_t)r * 8) = (u32x4){0u, 0u, 0u, 0u}; }
        for (int i = bx_ * 512 + ptid; i < DEPTH * NE * 2048; i += Fp.G * 512) { const int c = i & 2047, o = 2 * (128 * (c >> 8) + (c & 127)) + ((c >> 7) & 1);
            B1P[i] = IN(I_B1)[(size_t)(i & ~2047) + o]; }
        for (int m = gw; m < M; m += NGW) rms_row_to_bf16(ptid & 63, IN(I_X) + (size_t)m * DM, IN(I_MIXN), XN + (size_t)m * DM, X + (size_t)m * DM);
    }
            }
#endif
    GRID_BAR();

    for (int l = 0; l < DEPTH; ++l) {
        const int li = l >> 1;
        if (2 * l + 1 > stage_limit) break;
        if ((l & 1) == 0) {
#if (PHMASK >> 1) & 1
            _Pragma("unroll") for (int rep_ = 0; rep_ < NREP(1); ++rep_) { if (rep_) GRID_BAR();
            {   PHASE_BEGIN(); pg8::Gemm g{XN, (const bf16_t*)(ws + WS_WEIN) + (size_t)li * EVEN_IN * DM, DM, DM}; pg8::StaticOrder S; S.init(M, EVEN_IN, Fp.G, bx_);
                pg8::EpiEvenIn E{Z, IN(I_EGQ) + li * 64, IN(I_EGK) + li * 64};
                pg8::gemm_phase<pg8::EpiEvenIn, pg8::StaticOrder>(Fp.lds + RING_OFF, g, S, E); }
            }
#endif
            GRID_BAR();
            {   PHASE_BEGIN();
#if (PHMASK >> 2) & 1
            _Pragma("unroll") for (int rep_ = 0; rep_ < NREP(2); ++rep_) { if (rep_) GRID_BAR();
                for (int u = Fp.vcu; u < 512; u += Fp.G)
                    gmlp_unit(Fp, Z, MIX, IN(I_EWS) + (size_t)li * 4 * 128 * 128, IN(I_EBS) + li * 512, IN(I_EGV) + li * 512, u);
            }
#endif
#if (PHMASK >> 3) & 1
            _Pragma("unroll") for (int rep_ = 0; rep_ < NREP(3); ++rep_) { if (rep_) GRID_BAR();
                typedef att::Cfg<64, 64, 1> C;
                LAS float* lut = (LAS float*)(Fp.lds + RING_OFF + C::OFF_LUT);
                int tl_ = threadIdx.x; asm volatile("" : "+v"(tl_));
                for (int d = tl_; d < att::LUTN; d += 512) { const int c = (d <= 128 ? 1 : 0) + ((d <= 512 && (d & 3) == 0) ? 1 : 0) + ((d <= 2048 && (d & 15) == 0) ? 1 : 0);
                    lut[d] = c == 0 ? -__builtin_inff() : (c == 1 ? 0.f : (c == 2 ? 1.f : 1.5849625007211562f)); }
                __syncthreads();
                for (int u = Fp.vcu; u < 256; u += Fp.G) { const int bh = u >> 4, s = u & 15, b = bh >> 3, h = bh & 7;
                    for (int pass = 0; pass < 2; ++pass) { const int qb = pass ? 31 - s : s;
                        const bf16_t* zb = Z + (size_t)b * SEQ * EVEN_IN;
                        att::attn_unit<64, 64, 1>(zb + 1024 + 64 * h, EVEN_IN, zb + 1536 + 64 * h, EVEN_IN, zb + 2048 + 64 * h, EVEN_IN,
                                                  MIX + (size_t)b * SEQ * DM + 512 + 64 * h, DM, qb * 256, Fp.lds + RING_OFF); } }
            }
#endif
            }
            GRID_BAR();
#if (PHMASK >> 4) & 1
            _Pragma("unroll") for (int rep_ = 0; rep_ < NREP(4); ++rep_) { if (rep_) GRID_BAR();
            {   PHASE_BEGIN(); pg8::Gemm g{MIX, (const bf16_t*)(ws + WS_WEOUT) + (size_t)li * DM * DM, DM, DM}; pg8::StaticOrder S; S.init(M, DM, Fp.G, bx_);
                pg8::EpiResid E{X};
                pg8::gemm_phase<pg8::EpiResid, pg8::StaticOrder>(Fp.lds + RING_OFF, g, S, E); }
            }
#endif
            GRID_BAR();
        } else {
#if (PHMASK >> 5) & 1
            _Pragma("unroll") for (int rep_ = 0; rep_ < NREP(5); ++rep_) { if (rep_) GRID_BAR();
            {   PHASE_BEGIN(); pg8::Gemm g{XN, (const bf16_t*)(ws + WS_WOIN) + (size_t)li * ODD_INP * DM, DM, DM}; pg8::StaticOrder S; S.init(M, ODD_INP, Fp.G, bx_);
                pg8::EpiOddIn E{Z, SSQ};
                pg8::gemm_phase<pg8::EpiOddIn, pg8::StaticOrder>(Fp.lds + RING_OFF, g, S, E); }
            }
#endif
            GRID_BAR();
#if (PHMASK >> 6) & 1
            _Pragma("unroll") for (int rep_ = 0; rep_ < NREP(6); ++rep_) { if (rep_) GRID_BAR();
            {   PHASE_BEGIN(); pg8::Gemm g{Z + 512, (const bf16_t*)(ws + WS_WUKV) + (size_t)li * 2048 * 256, ODD_INP, 256}; pg8::StaticOrder S; S.init(M, 2048, Fp.G, bx_);
                pg8::EpiRowScale<1> E{KVR, 2048, SSQ, 8, 1.0f / 256.0f};
                pg8::gemm_phase<pg8::EpiRowScale<1>, pg8::StaticOrder>(Fp.lds + RING_OFF, g, S, E); }
            {   PHASE_BEGIN(); pg8::Gemm g{Z, (const bf16_t*)(ws + WS_WUQ) + (size_t)li * 1536 * 512, ODD_INP, 512}; pg8::StaticOrder S; S.init(M, 1536, Fp.G, bx_);
                pg8::EpiRowScale<2> E{QR, 1536, SSQ, 0, 1.0f / 512.0f};
                pg8::gemm_phase<pg8::EpiRowScale<2>, pg8::StaticOrder>(Fp.lds + RING_OFF, g, S, E); }
            }
#endif
            GRID_BAR();
#if (PHMASK >> 7) & 1
            _Pragma("unroll") for (int rep_ = 0; rep_ < NREP(7); ++rep_) { if (rep_) GRID_BAR();
            {   PHASE_BEGIN(); mla_finalize_phase(Fp, QR, KVR, Z, IN(I_OGQ) + li * 192, IN(I_OGK) + li * 192, QF, KF); }
            }
#endif
            GRID_BAR();
#if (PHMASK >> 8) & 1
            _Pragma("unroll") for (int rep_ = 0; rep_ < NREP(8); ++rep_) { if (rep_) GRID_BAR();
            {   PHASE_BEGIN();
                for (int u = Fp.vcu; u < 256; u += Fp.G) { const int bh = u >> 4, s = u & 15, b = bh >> 3, h = bh & 7;
                    for (int pass = 0; pass < 2; ++pass) { const int qb = pass ? 31 - s : s;
                        att::attn_unit<192, 128, 0>(QF + (size_t)b * SEQ * 1536 + 192 * h, 1536, KF + (size_t)b * SEQ * 1536 + 192 * h, 1536, KVR + (size_t)b * SEQ * 2048 + 256 * h + 128, 2048,
                                                    MIX + (size_t)b * SEQ * DM + 128 * h, DM, qb * 256, Fp.lds + RING_OFF); } }
            }
            }
#endif
            GRID_BAR();
#if (PHMASK >> 9) & 1
            _Pragma("unroll") for (int rep_ = 0; rep_ < NREP(9); ++rep_) { if (rep_) GRID_BAR();
            {   PHASE_BEGIN(); pg8::Gemm g{MIX, (const bf16_t*)(ws + WS_WOOUT) + (size_t)li * DM * DM, DM, DM}; pg8::StaticOrder S; S.init(M, DM, Fp.G, bx_);
                pg8::EpiResid E{X};
                pg8::gemm_phase<pg8::EpiResid, pg8::StaticOrder>(Fp.lds + RING_OFF, g, S, E); }
            }
#endif
            GRID_BAR();
        }
        if (2 * l + 2 > stage_limit) break;
#if (PHMASK >> 10) & 1
            _Pragma("unroll") for (int rep_ = 0; rep_ < NREP(10); ++rep_) {
        {   PHASE_BEGIN(); const bool dry = rep_ + 1 < NREP(10);
            gu32* cnt = (gu32*)(ws + WS_CTL) + CW_CNT + (size_t)(dry ? 8 + 4 * rep_ + l : l) * 32 * 64;
        router_phase(Fp, X, IN(I_FFNN) + l * DM, IN(I_RW) + (size_t)l * DM * NE, IN(I_RB) + l * NE, cnt, dry ? (unsigned*)(ws + WS_QR) : TOKER, dry ? (float*)(ws + WS_QR + MiB) : TOKG, dry ? ACT : XG); }
        GRID_BAR();
            }
#endif
        LAS int* tbl = (LAS int*)(F.lds + SCR_OFF + 12288);
        {   PHASE_BEGIN(); gu32* cnt = (gu32*)(ws + WS_CTL) + CW_CNT + (size_t)l * 32 * 64;
        if (threadIdx.x == 0) { int acc = 0; for (int e = 0; e < NE; ++e) { tbl[e] = acc; const unsigned c = __hip_atomic_load(cnt + 64 * e, RLX_AGENT); acc += (int)((c + 255u) >> 8); } tbl[NE] = acc; }
        __syncthreads(); }
#if (PHMASK >> 11) & 1
            _Pragma("unroll") for (int rep_ = 0; rep_ < NREP(11); ++rep_) { if (rep_) GRID_BAR();
        {   PHASE_BEGIN(); pg8::Gemm g{(const bf16_t*)XG, (const bf16_t*)(ws + WS_W1 + (size_t)l * NE * 2 * DE * DM), DM / 2, DM / 2}; pg8::MoeOrder S{tbl, 8, Fp.G, Fp.vcu};
            pg8::EpiSwiglu E{ACT, B1P + (size_t)l * NE * 2048};
            pg8::gemm_phase<pg8::EpiSwiglu, pg8::MoeOrder, true>(Fp.lds + RING_OFF, g, S, E); }
            }
#endif
        GRID_BAR();
#if (PHMASK >> 12) & 1
            _Pragma("unroll") for (int rep_ = 0; rep_ < NREP(12); ++rep_) { if (rep_) GRID_BAR();
        {   PHASE_BEGIN(); pg8::Gemm g{(const bf16_t*)ACT, (const bf16_t*)(ws + WS_W2 + (size_t)l * NE * DM * DE), DE / 2, DE / 2}; pg8::MoeOrder S{tbl, 4, Fp.G, Fp.vcu};
            pg8::EpiDown E{YB, IN(I_B2) + (size_t)l * NE * DM};
            pg8::gemm_phase<pg8::EpiDown, pg8::MoeOrder, true>(Fp.lds + RING_OFF, g, S, E); }
            }
#endif
        GRID_BAR();
#if (PHMASK >> 13) & 1
            _Pragma("unroll") for (int rep_ = 0; rep_ < NREP(13); ++rep_) {
        {   PHASE_BEGIN(); const bool dry = rep_ + 1 < NREP(13);
            combine_phase(Fp, X, dry ? (float*)ACT : X, TOKER, TOKG, YB, (l + 1 < DEPTH) ? IN(I_MIXN) + (l + 1) * DM : nullptr, dry ? (bf16_t*)(ACT + (size_t)64 * MiB) : XN); }
        GRID_BAR();
            }
#endif
    }
#undef GRID_BAR
}

extern "C" void kernel_launch(void* const* d_in, const int* in_sizes, int n_in, void* d_out, int out_size, void* d_ws, size_t ws_size, hipStream_t stream) {
    static int grid = 0;
    if (grid == 0) {
        if (n_in != 24 || in_sizes[0] != M * DM || out_size != M * DM || ws_size < WS_END) {
            fprintf(stderr, "kernel_launch: unexpected shapes (n_in %d, in0 %d, out %d, ws %zu, need %zu)\n", n_in, n_in > 0 ? in_sizes[0] : -1, out_size, ws_size, (size_t)WS_END); grid = -1; return; }
        int dev = 0, cus = 0, per_cu = 0;
        if (hipGetDevice(&dev) != hipSuccess || hipDeviceGetAttribute(&cus, hipDeviceAttributeMultiprocessorCount, dev) != hipSuccess) { grid = -1; return; }
        if (hipFuncSetAttribute((const void*)trunk_fwd, hipFuncAttributeMaxDynamicSharedMemorySize, LDS_BYTES) != hipSuccess) { fprintf(stderr, "kernel_launch: hipFuncSetAttribute failed\n"); grid = -1; return; }
        if (hipOccupancyMaxActiveBlocksPerMultiprocessor(&per_cu, (const void*)trunk_fwd, NWAVES * 64, LDS_BYTES) != hipSuccess || per_cu < 1)
            fprintf(stderr, "kernel_launch: occupancy query reports %d workgroups per CU\n", per_cu);
        (void)hipGetLastError();
        if (cus < 256) { fprintf(stderr, "kernel_launch: needs 256 CUs, device has %d\n", cus); grid = -1; return; }
        grid = 256;
    }
    if (grid < 0) return;
    if (hipMemsetAsync((char*)d_ws + WS_CTL, 0, CTL_ZERO_BYTES, stream) != hipSuccess) return;
    Args a{};
    for (int i = 0; i < 24; ++i) a.in[i] = (const float*)d_in[i];
    a.out = (float*)d_out; a.ws = (unsigned char*)d_ws; a.stage_limit = STAGE_LIMIT; a.pad = 0;
    hipLaunchKernelGGL(trunk_fwd, dim3(grid), dim3(NWAVES * 64), LDS_BYTES, stream, a);
}
```

```cpp
#include <hip/hip_runtime.h>
#include <hip/hip_bf16.h>
#include <cstdio>
#include <cstdint>

#define LAS __attribute__((address_space(3)))
#define GAS __attribute__((address_space(1)))
typedef unsigned short bf16_t;
typedef short bf16x8 __attribute__((ext_vector_type(8)));
typedef short s16x4 __attribute__((ext_vector_type(4)));
typedef float f32x2 __attribute__((ext_vector_type(2)));
typedef float f32x4 __attribute__((ext_vector_type(4)));
typedef float f32x16 __attribute__((ext_vector_type(16)));
typedef unsigned u32x2 __attribute__((ext_vector_type(2)));
typedef unsigned u32x4 __attribute__((ext_vector_type(4)));
typedef int i32x4 __attribute__((ext_vector_type(4)));
typedef int i32x8 __attribute__((ext_vector_type(8)));

constexpr int BATCH = 2, SEQ = 8192, DM = 1024, M = BATCH * SEQ, DEPTH = 4;
constexpr int EVEN_IN = 2560, ODD_IN = 832, ODD_INP = 1024;
constexpr int NE = 32, DE = 1024, ECAP = 16384;
constexpr float EPS = 1e-6f;
constexpr float LOG2E = 1.4426950408889634f;
constexpr float C2_B = 0.125f * LOG2E;
constexpr float C2_C = 0.07216878364870322f * LOG2E;

__device__ __forceinline__ unsigned cvt_pk_bf16(float lo, float hi) { unsigned r; asm volatile("v_cvt_pk_bf16_f32 %0, %1, %2" : "=v"(r) : "v"(lo), "v"(hi)); return r; }
__device__ __forceinline__ float bf2f(bf16_t v) { return __uint_as_float(((unsigned)v) << 16); }
__device__ __forceinline__ float bflo(unsigned w) { return __uint_as_float(w << 16); }
__device__ __forceinline__ float bfhi(unsigned w) { return __uint_as_float(w & 0xffff0000u); }
__device__ __forceinline__ bf16_t f2bf(float f) { return (bf16_t)(cvt_pk_bf16(f, 0.f) & 0xffffu); }

__device__ __forceinline__ unsigned pk4_fp8(float a, float b, float c, float d) { int w = 0; w = __builtin_amdgcn_cvt_pk_fp8_f32(a, b, w, false); w = __builtin_amdgcn_cvt_pk_fp8_f32(c, d, w, true); return (unsigned)w; }
constexpr float W8_SCALE = 64.0f, W8_INV = 1.0f / 64.0f;

namespace pg8 {
constexpr int BM = 256, BK = 64, HALF = 128, HTB = HALF * BK * 2, STAGE_BYTES = 8 * HTB, NXCD = 8, WGM = 8;
__host__ __device__ __forceinline__ int lds_byte(int r, int c) { const int st = (r >> 4) * 2 + (c >> 5), rr = r & 15, cc = c & 31, ob = rr * 64 + cc * 2; return st * 1024 + (ob ^ (((ob >> 9) & 1) << 5)); }
__host__ __device__ __forceinline__ void stage_rc(int b, int& R, int& C) { const int st = b / 1024, sb = b % 1024, swz = sb ^ (((sb >> 9) & 1) << 5); R = (st >> 1) * 16 + swz / 64; C = (st & 1) * 32 + (swz % 64) / 2; }
__host__ __device__ __forceinline__ int perm32(int rho) { const int n = rho >> 4, i = rho & 15; return 8 * (i >> 2) + 4 * n + (i & 3); }

struct Unit { int pm, pn, pb, kind, rb; };
struct Gemm { const bf16_t* A; const bf16_t* Bt; int lda, K; const bf16_t* A2; const bf16_t* Bt2; };

struct StaticOrder {
    int nM, nN, nwg, G, c;
    __device__ void init(int M_, int N_, int G_, int c_) { nM = M_ / BM; nN = N_ / BM; nwg = nM * nN; G = G_; c = c_; }
    __device__ bool next(int i, Unit& u) const {
        const long L = (long)i * G + c; if (L >= nwg) return false;
        int wgid = (int)L; { const int q = nwg / NXCD, r = nwg % NXCD, xcd = wgid % NXCD, off = wgid / NXCD; wgid = (xcd < r ? xcd * (q + 1) : r * (q + 1) + (xcd - r) * q) + off; }
        const int nig = WGM * nN, gid = wgid / nig, fm = gid * WGM, gsz = (nM - fm) < WGM ? (nM - fm) : WGM;
        u.pm = fm + ((wgid % nig) % gsz); u.pn = (wgid % nig) / gsz; u.pb = u.pn; u.kind = 0; u.rb = 0; return true;
    }
    __device__ __forceinline__ void a_ready(const Unit&) const {}
    __device__ __forceinline__ void pre_epi() const {}
    __device__ __forceinline__ void done(const Unit&) const {}
    __device__ __forceinline__ void finish() const {}
};

__device__ __forceinline__ f32x2 gelu_pk(f32x2 v) {
    const f32x2 av = __builtin_elementwise_abs(v), d = av * 0.2316418882f + 1.0f;
    f32x2 t; t.x = __builtin_amdgcn_rcpf(d.x); t.y = __builtin_amdgcn_rcpf(d.y);
    f32x2 q = t * 0.5307027145f + (-0.7265760135f); q = q * t + 0.7107068705f; q = q * t + (-0.142248368f); q = q * t + 0.127414796f; q = q * t;
    const f32x2 s = (v * v) * (-0.72134752044f);
    f32x2 e; e.x = __builtin_amdgcn_exp2f(s.x); e.y = __builtin_amdgcn_exp2f(s.y);
    const f32x2 m = v * (q * e), r = v - m;
    f32x2 o; o.x = v.x < 0.f ? m.x : r.x; o.y = v.y < 0.f ? m.y : r.y; return o;
}
__device__ __forceinline__ f32x4 gelu4(f32x4 v) { const f32x2 a = gelu_pk((f32x2){v[0], v[1]}), b = gelu_pk((f32x2){v[2], v[3]}); return (f32x4){a.x, a.y, b.x, b.y}; }

template <class Epi, class Sched, bool FP8 = false>
__device__ __forceinline__ void gemm_phase(LAS unsigned char* lds, const Gemm g, const Sched& S, const Epi& E) {
    int tid_ = threadIdx.x; asm volatile("" : "+v"(tid_));
    const int tid = tid_, wid = __builtin_amdgcn_readfirstlane(tid >> 6), lane = tid & 63, wr = wid >> 2, wc = wid & 3, fr = lane & 15, fq = lane >> 4;
    const int K = g.K, nt = K / BK;
    unsigned voffA[2], voffB[2];
#pragma unroll
    for (int i = 0; i < 2; ++i) { int R, C; stage_rc(tid * 16 + i * 8192, R, C); const int Rb = Epi::PERM ? ((R & ~31) + perm32(R & 31)) : R;
        voffA[i] = (unsigned)(R * g.lda + C) * 2u; voffB[i] = (unsigned)(Rb * K + C) * 2u; }
    const size_t kstep = (size_t)(BK * 2);
    const size_t hstepA = (size_t)HALF * g.lda * 2, tstepA = 2 * hstepA;
    const size_t hstepB = (size_t)HALF * K * 2, tstepB = 2 * hstepB;
    const unsigned ldsw = (unsigned)wid * 1024u;
    const int aoff = lds_byte(wr * 64 + fr, fq * 8), boff = lds_byte(wc * 32 + fr, fq * 8);
#define PG8_SA(b, h) (((b) * 2 + (h)) * HTB)
#define PG8_SB(b, h) ((4 + (b) * 2 + (h)) * HTB)
#define PG8_STAGE(bufoff, gbase, voff) do { _Pragma("unroll") for (int _i = 0; _i < 2; ++_i) \
        __builtin_amdgcn_global_load_lds((const unsigned*)((const char*)(gbase) + (voff)[_i]), (LAS unsigned*)(lds + (bufoff) + ldsw + _i * 8192), 16, 0, 0); } while (0)
#define PG8_LDA(dst, b, h) do { _Pragma("unroll") for (int m = 0; m < 4; ++m) { if constexpr (FP8) { const i32x4 lo_ = *(const LAS i32x4*)(lds + PG8_SA(b, h) + aoff + m * 2048), hi_ = *(const LAS i32x4*)(lds + PG8_SA(b, h) + aoff + m * 2048 + 1024); dst##8[m] = __builtin_shufflevector(lo_, hi_, 0, 1, 2, 3, 4, 5, 6, 7); } \
        else { _Pragma("unroll") for (int k = 0; k < 2; ++k) dst[m][k] = *(const LAS bf16x8*)(lds + PG8_SA(b, h) + aoff + m * 2048 + k * 1024); } } } while (0)
#define PG8_LDB(dst, b, h) do { _Pragma("unroll") for (int n = 0; n < 2; ++n) { if constexpr (FP8) { const i32x4 lo_ = *(const LAS i32x4*)(lds + PG8_SB(b, h) + boff + n * 2048), hi_ = *(const LAS i32x4*)(lds + PG8_SB(b, h) + boff + n * 2048 + 1024); dst##8[n] = __builtin_shufflevector(lo_, hi_, 0, 1, 2, 3, 4, 5, 6, 7); } \
        else { _Pragma("unroll") for (int k = 0; k < 2; ++k) dst[n][k] = *(const LAS bf16x8*)(lds + PG8_SB(b, h) + boff + n * 2048 + k * 1024); } } } while (0)
#define PG8_MMA(ai, bj, At, Bt) do { __builtin_amdgcn_s_setprio(1); _Pragma("unroll") for (int m = 0; m < 4; ++m) _Pragma("unroll") for (int n = 0; n < 2; ++n) { \
        if constexpr (FP8) asm volatile("s_nop 1\n\tv_mfma_f32_16x16x128_f8f6f4 %0, %1, %2, %0" : "+v"(acc[ai][bj][m][n]) : "v"(Bt##8[n]), "v"(At##8[m])); \
        else { _Pragma("unroll") for (int k = 0; k < 2; ++k) acc[ai][bj][m][n] = __builtin_amdgcn_mfma_f32_16x16x32_bf16(Bt[n][k], At[m][k], acc[ai][bj][m][n], 0, 0, 0); } } \
        __builtin_amdgcn_s_setprio(0); } while (0)
#define PG8_WAIT_V(n) asm volatile("s_waitcnt vmcnt(" #n ")" ::: "memory")
#define PG8_WAIT_L(n) asm volatile("s_waitcnt lgkmcnt(" #n ")" ::: "memory")
#define PG8_BAR __builtin_amdgcn_s_barrier()
#define PG8_SCHED __builtin_amdgcn_sched_barrier(0)
    Unit cur, nxt; int ui = 0;
    if (!S.next(0, cur)) return;
    f32x4 acc[2][2][4][2];
#pragma unroll
    for (int a = 0; a < 2; ++a)
#pragma unroll
        for (int b = 0; b < 2; ++b)
#pragma unroll
            for (int m = 0; m < 4; ++m)
#pragma unroll
                for (int n = 0; n < 2; ++n) acc[a][b][m][n] = (f32x4){0.f, 0.f, 0.f, 0.f};
    bf16x8 At[4][2], B0[2][2], B1[2][2]; i32x8 At8[4], B08[2], B18[2];
    const char* cA = (const char*)(cur.kind ? g.A2 : g.A) + (size_t)cur.pm * tstepA; const char* cB = (const char*)(cur.kind ? g.Bt2 : g.Bt) + (size_t)cur.pb * tstepB;
    S.a_ready(cur);
    PG8_STAGE(PG8_SB(0, 0), cB, voffB); PG8_STAGE(PG8_SB(0, 1), cB + hstepB, voffB); PG8_STAGE(PG8_SA(0, 0), cA, voffA); PG8_STAGE(PG8_SA(0, 1), cA + hstepA, voffA);
    if (wr == 1) PG8_BAR;
    PG8_WAIT_V(2); PG8_BAR;
    PG8_STAGE(PG8_SB(1, 0), cB + kstep, voffB); PG8_STAGE(PG8_SA(1, 0), cA + kstep, voffA); PG8_STAGE(PG8_SB(1, 1), cB + hstepB + kstep, voffB);
    PG8_WAIT_V(6); PG8_BAR;
    for (;;) {
        const bool has_next = S.next(ui + 1, nxt);
        const char* nA = has_next ? (const char*)(nxt.kind ? g.A2 : g.A) + (size_t)nxt.pm * tstepA : cA; const char* nB = has_next ? (const char*)(nxt.kind ? g.Bt2 : g.Bt) + (size_t)nxt.pb * tstepB : cB;
#pragma unroll 1
        for (int t = 0; t < nt; t += 2) {
            const bool last = (t == nt - 2);
            const char* a1 = cA + (size_t)(t + 1) * kstep;
            const char* a2 = last ? nA : cA + (size_t)(t + 2) * kstep; const char* b2 = last ? nB : cB + (size_t)(t + 2) * kstep;
            const char* a3 = a2 + kstep; const char* b3 = b2 + kstep;
            if (last && has_next) S.a_ready(nxt);
            PG8_LDB(B0, 0, 0); PG8_LDB(B1, 0, 1); PG8_SCHED; PG8_LDA(At, 0, 0); PG8_STAGE(PG8_SA(1, 1), a1 + hstepA, voffA);
            PG8_WAIT_V(8); PG8_WAIT_L(0); PG8_BAR; PG8_MMA(0, 0, At, B0); PG8_MMA(0, 1, At, B1); PG8_BAR; PG8_SCHED;
            PG8_LDA(At, 0, 1); PG8_STAGE(PG8_SB(0, 0), b2, voffB); PG8_STAGE(PG8_SB(0, 1), b2 + hstepB, voffB); PG8_STAGE(PG8_SA(0, 0), a2, voffA);
            PG8_WAIT_V(8); PG8_WAIT_L(0); PG8_BAR; PG8_MMA(1, 0, At, B0); PG8_MMA(1, 1, At, B1); PG8_BAR; PG8_SCHED;
            PG8_LDB(B0, 1, 0); PG8_LDB(B1, 1, 1); PG8_SCHED; PG8_LDA(At, 1, 0); PG8_STAGE(PG8_SA(0, 1), a2 + hstepA, voffA);
            PG8_WAIT_V(8); PG8_WAIT_L(0); PG8_BAR; PG8_MMA(0, 0, At, B0); PG8_MMA(0, 1, At, B1); PG8_BAR; PG8_SCHED;
            PG8_LDA(At, 1, 1); PG8_STAGE(PG8_SB(1, 0), b3, voffB); PG8_STAGE(PG8_SB(1, 1), b3 + hstepB, voffB); PG8_STAGE(PG8_SA(1, 0), a3, voffA);
            PG8_WAIT_V(8); PG8_WAIT_L(0); PG8_BAR; PG8_MMA(1, 0, At, B0); PG8_MMA(1, 1, At, B1); PG8_BAR; PG8_SCHED;
        }
        if (wr == 0) PG8_BAR;
        if constexpr (FP8) asm volatile("s_nop 15\n\ts_nop 7" ::: "memory");
        S.pre_epi();
        { int te_ = threadIdx.x; asm volatile("" : "+v"(te_));
          E(acc, cur, wr, wc, te_ & 15, (te_ & 63) >> 4); }
        S.done(cur);
        if (!has_next) break;
#pragma unroll
        for (int a = 0; a < 2; ++a)
#pragma unroll
            for (int b = 0; b < 2; ++b)
#pragma unroll
                for (int m = 0; m < 4; ++m)
#pragma unroll
                    for (int n = 0; n < 2; ++n) acc[a][b][m][n] = (f32x4){0.f, 0.f, 0.f, 0.f};
        cur = nxt; cA = nA; cB = nB; ++ui;
        if (wr == 1) PG8_BAR;
    }
    PG8_WAIT_V(0);
    S.finish();
    PG8_BAR;
#undef PG8_SA
#undef PG8_SB
#undef PG8_STAGE
#undef PG8_LDA
#undef PG8_LDB
#undef PG8_MMA
#undef PG8_WAIT_V
#undef PG8_WAIT_L
#undef PG8_BAR
#undef PG8_SCHED
}
}
constexpr int STAGE_LIMIT = 8;

namespace att {
__device__ __forceinline__ int crow(int r, int hi) { return (r & 3) + 8 * (r >> 2) + 4 * hi; }
__device__ __forceinline__ int v_rd_base(int lane) { return ((lane & 3) << 3) | (((lane >> 2) & 3) << 6) | (((lane >> 4) & 1) << 5) | (((lane >> 5) & 1) << 8); }
constexpr int LUTN = 2052;

template <int DQK, int DV, int MODE>
struct Cfg {
    static constexpr int KP = DQK * 2 + 16;
    static constexpr int KB = 64 * KP, VB = 64 * DV * 2;
    static constexpr int NBUF = 3;
    static constexpr int OFF_K = 0, OFF_V = NBUF * KB, OFF_WS = NBUF * (KB + VB), OFF_LUT = OFF_WS + 8 * 256, BYTES = OFF_LUT + (MODE == 1 ? LUTN * 4 : 0);
    static_assert(BYTES <= 131072, "attention LDS image fits the ring");
    static constexpr int CPR = KP / 16;
    static constexpr int NKP = KB / 1024, KPW = (NKP + 7) / 8;
    static constexpr int NVP = VB / 1024, VPW = NVP / 8;
    static_assert(KB % 1024 == 0 && NVP % 8 == 0, "tile images are whole DMA pieces");
};

template <int DQK, int DV, int MODE>
__device__ __forceinline__ void attn_unit(const bf16_t* __restrict__ Qh, int qp, const bf16_t* __restrict__ Kh, int kp, const bf16_t* __restrict__ Vh, int vp,
                                          bf16_t* __restrict__ Oh, int op, int q0, LAS unsigned char* lds) {
    typedef Cfg<DQK, DV, MODE> C;
    constexpr int NCB = DV / 32;
    int tid_ = threadIdx.x; asm volatile("" : "+v"(tid_));
    const int tid = tid_, wid = __builtin_amdgcn_readfirstlane(tid >> 6), lane = tid & 63, r32 = lane & 31, hi = lane >> 5;
    const int qlo = q0 + wid * 32, qpos = qlo + r32;
    LAS float* wsf = (LAS float*)(lds + C::OFF_WS) + wid * 64;
    const LAS float* lut = (const LAS float*)(lds + C::OFF_LUT);
    int j_lo = 0; if (MODE == 1) { const int lo = q0 - 2048; j_lo = lo > 0 ? lo / 64 : 0; }
    const int j_hi = (q0 + 256) / 64, NT = j_hi - j_lo;
    unsigned kso[C::KPW], vso[C::VPW];
#pragma unroll
    for (int i = 0; i < C::KPW; ++i) { const int c = (wid + 8 * i) * 64 + lane, row = c / C::CPR; int cc = c % C::CPR; if (cc > C::CPR - 2) cc = C::CPR - 2;
        kso[i] = (unsigned)((row & 63) * kp + cc * 8); }
#pragma unroll
    for (int i = 0; i < C::VPW; ++i) { const int off = ((wid + 8 * i) * 64 + lane) * 16, st = off >> 9, within = off & 511, kk = (st / NCB) * 8 + (within >> 6);
        const int k = (kk & ~0xC) | ((kk & 4) << 1) | ((kk & 8) >> 1), col = (st % NCB) * 32 + ((within & 63) >> 1);
        vso[i] = (unsigned)(k * vp + col); }
#define ATT_DMA(j, bf) do { const bf16_t* kt_ = Kh + (size_t)(j) * 64 * kp; const bf16_t* vt_ = Vh + (size_t)(j) * 64 * vp; \
        _Pragma("unroll") for (int i = 0; i < C::KPW; ++i) if (wid + 8 * i < C::NKP) \
            __builtin_amdgcn_global_load_lds((const unsigned*)(kt_ + kso[i]), (LAS unsigned*)(lds + C::OFF_K + (bf) * C::KB + (wid + 8 * i) * 1024), 16, 0, 0); \
        _Pragma("unroll") for (int i = 0; i < C::VPW; ++i) \
            __builtin_amdgcn_global_load_lds((const unsigned*)(vt_ + vso[i]), (LAS unsigned*)(lds + C::OFF_V + (bf) * C::VB + (wid + 8 * i) * 1024), 16, 0, 0); } while (0)
    ATT_DMA(j_lo, 0);
    if (NT > 1) ATT_DMA(j_lo + 1, 1);
    bf16x8 qr[DQK / 16];
#pragma unroll
    for (int d0 = 0; d0 < DQK / 16; ++d0) qr[d0] = *(const bf16x8*)(Qh + (size_t)qpos * qp + d0 * 16 + hi * 8);
    float m_reg = -1e30f, l_reg = 0.f;
    f32x16 o[NCB];
#pragma unroll
    for (int d = 0; d < NCB; ++d) o[d] = f32x16{};
    const int koff = r32 * C::KP + hi * 16;
    const unsigned vb0 = (unsigned)(uintptr_t)(lds + C::OFF_V) + (unsigned)v_rd_base(lane);
    asm volatile("s_waitcnt vmcnt(0)" ::: "memory");
    __syncthreads();
    constexpr int ND = DQK / 16;
#define ATT_ACT(kb2_) ((kb2_) <= qlo + 31 && (MODE == 0 || (qlo - (kb2_) - 31 <= 2048)))
#define ATT_QK(P, bufi, hf_) do { const LAS unsigned char* kb_ = lds + C::OFF_K + (bufi) * C::KB + (hf_) * 32 * C::KP + koff; P = f32x16{}; \
        bf16x8 kw_[4]; _Pragma("unroll") for (int d0 = 0; d0 < 4; ++d0) kw_[d0] = *(const LAS bf16x8*)(kb_ + d0 * 32); \
        _Pragma("unroll") for (int d0 = 0; d0 < ND; ++d0) { P = __builtin_amdgcn_mfma_f32_32x32x16_bf16(kw_[d0 & 3], qr[d0], P, 0, 0, 0); \
            if (d0 + 4 < ND) kw_[d0 & 3] = *(const LAS bf16x8*)(kb_ + (d0 + 4) * 32); } } while (0)
#define ATT_PK4(P, B_, OUT) do { unsigned a0 = cvt_pk_bf16(P[B_+0], P[B_+1]), a1 = cvt_pk_bf16(P[B_+2], P[B_+3]);                          \
        unsigned b0_ = cvt_pk_bf16(P[B_+4], P[B_+5]), b1_ = cvt_pk_bf16(P[B_+6], P[B_+7]);                                             \
        auto r0 = __builtin_amdgcn_permlane32_swap(a0, b0_, false, false); auto r1 = __builtin_amdgcn_permlane32_swap(a1, b1_, false, false); \
        u32x4 w = {r0[0], r1[0], r0[1], r1[1]}; OUT = __builtin_bit_cast(bf16x8, w); } while (0)
#define ATT_VRD(d0) do { \
                asm volatile("ds_read_b64_tr_b16 %0, %1 offset:%2" : "=&v"(vl0[(d0) & (VG - 1)]) : "v"(vb), "i"((d0) * 512 + KO) : "memory"); \
                asm volatile("ds_read_b64_tr_b16 %0, %1 offset:%2" : "=&v"(vh0[(d0) & (VG - 1)]) : "v"(vb), "i"((d0) * 512 + KO + HF) : "memory"); \
                asm volatile("ds_read_b64_tr_b16 %0, %1 offset:%2" : "=&v"(vl1[(d0) & (VG - 1)]) : "v"(vb), "i"((d0) * 512 + KO + KS) : "memory"); \
                asm volatile("ds_read_b64_tr_b16 %0, %1 offset:%2" : "=&v"(vh1[(d0) & (VG - 1)]) : "v"(vb), "i"((d0) * 512 + KO + KS + HF) : "memory"); } while (0)
#define ATT_PVD(d0) do { const int g_ = (d0) & (VG - 1); \
                o[d0] = __builtin_amdgcn_mfma_f32_32x32x16_bf16(pa0, (bf16x8){vl0[g_][0], vl0[g_][1], vl0[g_][2], vl0[g_][3], vh0[g_][0], vh0[g_][1], vh0[g_][2], vh0[g_][3]}, o[d0], 0, 0, 0); \
                o[d0] = __builtin_amdgcn_mfma_f32_32x32x16_bf16(pa1, (bf16x8){vl1[g_][0], vl1[g_][1], vl1[g_][2], vl1[g_][3], vh1[g_][0], vh1[g_][1], vh1[g_][2], vh1[g_][3]}, o[d0], 0, 0, 0); } while (0)
#define ATT_SMPV(P, kb2, vbuf, hf) do { \
            const unsigned vb = vb0 + (unsigned)((vbuf) * C::VB); \
            constexpr int KS = NCB * 1024, HF = NCB * 512, KO = 2 * (hf) * KS, VG = 2;         \
            s16x4 vl0[VG], vh0[VG], vl1[VG], vh1[VG]; \
            ATT_VRD(0); ATT_VRD(1); \
            const int dq = qpos - (kb2) - 4 * hi; \
            if (MODE == 0) { if ((kb2) + 31 > qlo) { const float NEG = -__builtin_inff(); \
                    _Pragma("unroll") for (int r = 0; r < 16; ++r) { const int c = (r & 3) + 8 * (r >> 2); if (dq - c < 0) P[r] = NEG; } } } \
            else { _Pragma("unroll") for (int r = 0; r < 16; ++r) { const int c = (r & 3) + 8 * (r >> 2); unsigned i0 = (unsigned)(dq - c); i0 = i0 < 2049u ? i0 : 2049u; P[r] += lut[i0]; } } \
            float pmax = P[0]; \
            _Pragma("unroll") for (int r = 1; r < 16; ++r) pmax = fmaxf(pmax, P[r]); \
            { auto rr = __builtin_amdgcn_permlane32_swap(__float_as_uint(pmax), __float_as_uint(pmax), false, false); pmax = fmaxf(__uint_as_float(rr[0]), __uint_as_float(rr[1])); } \
            const float mn = fmaxf(m_reg, pmax); const float alpha = __builtin_amdgcn_exp2f(m_reg - mn); m_reg = mn; \
            float ps = 0.f; \
            _Pragma("unroll") for (int r = 0; r < 16; ++r) { P[r] = __builtin_amdgcn_exp2f(P[r] - mn); ps += P[r]; } \
            { auto rr = __builtin_amdgcn_permlane32_swap(__float_as_uint(ps), __float_as_uint(ps), false, false); ps = __uint_as_float(rr[0]) + __uint_as_float(rr[1]); } \
            l_reg = l_reg * alpha + ps; \
            bf16x8 pa0, pa1; ATT_PK4(P, 0, pa0); ATT_PK4(P, 8, pa1); \
            if (__any(alpha < 1.f)) { if (hi == 0) wsf[r32] = alpha; asm volatile("s_waitcnt lgkmcnt(0)" ::: "memory"); \
                _Pragma("unroll") for (int r = 0; r < 16; ++r) { const float a = wsf[crow(r, hi)]; _Pragma("unroll") for (int d = 0; d < NCB; ++d) o[d][r] *= a; } } \
            asm volatile("s_waitcnt lgkmcnt(0)" ::: "memory"); __builtin_amdgcn_sched_barrier(0);     \
            ATT_PVD(0); ATT_PVD(1); \
            if (NCB > 2) { __builtin_amdgcn_sched_barrier(0); ATT_VRD(2); ATT_VRD(3); asm volatile("s_waitcnt lgkmcnt(0)" ::: "memory"); __builtin_amdgcn_sched_barrier(0); ATT_PVD(2); ATT_PVD(3); } \
    } while (0)
    f32x16 pA, pB;
    int buf = 0;
    { const int kb0 = j_lo * 64; if (ATT_ACT(kb0)) ATT_QK(pA, 0, 0); }
    for (int t = 0; t < NT; ++t) {
        if (t + 2 < NT) { const int b2 = buf == 0 ? 2 : buf - 1; ATT_DMA(j_lo + t + 2, b2); }
        const int kb = (j_lo + t) * 64;
        const int nb = buf == 2 ? 0 : buf + 1;
        { const bool a0 = ATT_ACT(kb), a1 = ATT_ACT(kb + 32);
          if (a1) ATT_QK(pB, buf, 1);
          if (a0) ATT_SMPV(pA, kb, buf, 0);
          const bool a2 = (t + 1 < NT) && ATT_ACT(kb + 64);
          if (a2) ATT_QK(pA, nb, 0);
          if (a1) ATT_SMPV(pB, kb + 32, buf, 1); }
        asm volatile("s_waitcnt vmcnt(0)" ::: "memory");
        __syncthreads();
        buf = nb;
    }
#undef ATT_SMPV
#undef ATT_VRD
#undef ATT_PVD
#undef ATT_PK4
#undef ATT_QK
#undef ATT_ACT
#undef ATT_DMA
    if (hi == 0) wsf[32 + r32] = l_reg;
    asm volatile("s_waitcnt lgkmcnt(0)" ::: "memory");
    bf16_t* Ow = Oh + (size_t)qlo * op;
#pragma unroll
    for (int r = 0; r < 16; ++r) { const int orow = crow(r, hi); const float rl = __builtin_amdgcn_rcpf(wsf[32 + orow]);
#pragma unroll
        for (int d0 = 0; d0 < NCB; ++d0) { const float v = o[d0][r] * rl; const float vn = __shfl_xor(v, 1);
            if ((r32 & 1) == 0) *(unsigned*)(Ow + (size_t)orow * op + d0 * 32 + r32) = cvt_pk_bf16(v, vn); } }
    __syncthreads();
}
}

namespace dil {
using att::crow; using att::v_rd_base;
constexpr int OFF_O = 0, OFF_V = 65536, VWAVE = 8192;
template <int S_>
__device__ __forceinline__ void pass(const bf16_t* __restrict__ Qh, const bf16_t* __restrict__ Kh, const bf16_t* __restrict__ Vh, int pitch, int q0, LAS unsigned char* lds, LAS float* scr, int wid, int lane) {
    const int r32 = lane & 31, hi = lane >> 5;
    LAS float* Oacc = (LAS float*)(lds + OFF_O); LAS float* macc = scr; LAS float* lacc = scr + 256; LAS float* wsf = scr + 512 + wid * 64;
    LAS unsigned char* vbuf = lds + OFF_V + wid * VWAVE;
    constexpr int NG = (S_ == 16) ? 2 : 1, VR = (S_ == 16) ? 16 : 32;
    int vk[4], vc[4];
#pragma unroll
    for (int i = 0; i < 4; ++i) { const int off = (i * 64 + lane) * 16, st = off >> 9, within = off & 511, kk = (st >> 1) * 8 + (within >> 6);
        vk[i] = (kk & ~0xC) | ((kk & 4) << 1) | ((kk & 8) >> 1); vc[i] = (st & 1) * 32 + ((within & 63) >> 1); }
    const unsigned vb0 = (unsigned)(uintptr_t)vbuf + (unsigned)v_rd_base(lane);
#pragma unroll
    for (int gi = 0; gi < NG; ++gi) {
        const int rho = (S_ == 1) ? 0 : (S_ == 4) ? (wid & 3) : (2 * wid + gi);
        const int i0 = (S_ == 1) ? 32 * wid : (S_ == 4) ? 32 * (wid >> 2) : 0;
        const int qi = i0 + (r32 < VR ? r32 : r32 - VR);
        const int ql = rho + S_ * qi;
        bf16x8 qr[4];
#pragma unroll
        for (int d0 = 0; d0 < 4; ++d0) qr[d0] = *(const bf16x8*)(Qh + (size_t)(q0 + ql) * pitch + d0 * 16 + hi * 8);
        const int j0 = i0 - 128;
        const int tokb = q0 + rho + S_ * j0;
        bf16x8 kfA[4], kfB[4];
#define DIL_KLOAD(dst, c) do { int tk_ = tokb + S_ * (32 * (c) + r32); tk_ = tk_ < 0 ? 0 : (tk_ > SEQ - 1 ? SEQ - 1 : tk_);     \
            _Pragma("unroll") for (int d0 = 0; d0 < 4; ++d0) dst[d0] = *(const bf16x8*)(Kh + (size_t)tk_ * pitch + d0 * 16 + hi * 8); } while (0)
#define DIL_VDMA(c, bf) do { _Pragma("unroll") for (int i = 0; i < 4; ++i) { int tk_ = tokb + S_ * (32 * (c) + vk[i]); tk_ = tk_ < 0 ? 0 : (tk_ > SEQ - 1 ? SEQ - 1 : tk_); \
            __builtin_amdgcn_global_load_lds((const unsigned*)(Vh + (size_t)tk_ * pitch + vc[i]), (LAS unsigned*)(vbuf + (bf) * 4096 + i * 1024), 16, 0, 0); } } while (0)
        float m_reg = -1e30f, l_reg = 0.f; f32x16 o[2]; o[0] = f32x16{}; o[1] = f32x16{};
        DIL_KLOAD(kfA, 0); DIL_VDMA(0, 0);
#define DIL_STEP(KF, KN, c) do { \
            if ((c) < 4) { DIL_KLOAD(KN, (c) + 1); DIL_VDMA((c) + 1, ((c) + 1) & 1); asm volatile("s_waitcnt vmcnt(8)" ::: "memory"); } \
            else { asm volatile("s_waitcnt vmcnt(0)" ::: "memory"); } \
            f32x16 p = f32x16{}; \
            _Pragma("unroll") for (int d0 = 0; d0 < 4; ++d0) p = __builtin_amdgcn_mfma_f32_32x32x16_bf16(KF[d0], qr[d0], p, 0, 0, 0); \
            const unsigned vb = vb0 + (unsigned)(((c) & 1) * 4096); \
            s16x4 vl0[2], vh0[2], vl1[2], vh1[2]; \
            _Pragma("unroll") for (int d0 = 0; d0 < 2; ++d0) { \
                asm volatile("ds_read_b64_tr_b16 %0, %1 offset:%2" : "=&v"(vl0[d0]) : "v"(vb), "i"(d0 * 512) : "memory"); \
                asm volatile("ds_read_b64_tr_b16 %0, %1 offset:%2" : "=&v"(vh0[d0]) : "v"(vb), "i"(d0 * 512 + 1024) : "memory"); \
                asm volatile("ds_read_b64_tr_b16 %0, %1 offset:%2" : "=&v"(vl1[d0]) : "v"(vb), "i"(d0 * 512 + 2048) : "memory"); \
                asm volatile("ds_read_b64_tr_b16 %0, %1 offset:%2" : "=&v"(vh1[d0]) : "v"(vb), "i"(d0 * 512 + 3072) : "memory"); } \
              \
            { const float NEG = -__builtin_inff(); const int db = qi - j0 - 32 * (c) - 4 * hi; const int tb = tokb + S_ * (32 * (c) + 4 * hi); \
              if ((c) == 0 || (c) == 4 || tokb < 0) { \
                _Pragma("unroll") for (int r = 0; r < 16; ++r) { const int cr = (r & 3) + 8 * (r >> 2); \
                    const bool ok = ((unsigned)(db - cr) <= 128u) && (tb + S_ * cr >= 0); p[r] = ok ? p[r] : NEG; } } } \
            float pmax = p[0]; \
            _Pragma("unroll") for (int r = 1; r < 16; ++r) pmax = fmaxf(pmax, p[r]); \
            { auto rr = __builtin_amdgcn_permlane32_swap(__float_as_uint(pmax), __float_as_uint(pmax), false, false); pmax = fmaxf(__uint_as_float(rr[0]), __uint_as_float(rr[1])); } \
            const float mn = fmaxf(m_reg, pmax); const float alpha = __builtin_amdgcn_exp2f(m_reg - mn); m_reg = mn; \
            float ps = 0.f; \
            _Pragma("unroll") for (int r = 0; r < 16; ++r) { p[r] = __builtin_amdgcn_exp2f(p[r] - mn); ps += p[r]; } \
            { auto rr = __builtin_amdgcn_permlane32_swap(__float_as_uint(ps), __float_as_uint(ps), false, false); ps = __uint_as_float(rr[0]) + __uint_as_float(rr[1]); } \
            l_reg = l_reg * alpha + ps; \
            bf16x8 pa0, pa1; DIL_PK4(p, 0, pa0); DIL_PK4(p, 8, pa1); \
            if (__any(alpha < 1.f)) { if (hi == 0) wsf[r32] = alpha; asm volatile("s_waitcnt lgkmcnt(0)" ::: "memory"); \
                _Pragma("unroll") for (int r = 0; r < 16; ++r) { const float a = wsf[crow(r, hi)]; o[0][r] *= a; o[1][r] *= a; } } \
            asm volatile("s_waitcnt lgkmcnt(0)" ::: "memory"); __builtin_amdgcn_sched_barrier(0); \
            _Pragma("unroll") for (int d0 = 0; d0 < 2; ++d0) { \
                o[d0] = __builtin_amdgcn_mfma_f32_32x32x16_bf16(pa0, (bf16x8){vl0[d0][0], vl0[d0][1], vl0[d0][2], vl0[d0][3], vh0[d0][0], vh0[d0][1], vh0[d0][2], vh0[d0][3]}, o[d0], 0, 0, 0); \
                o[d0] = __builtin_amdgcn_mfma_f32_32x32x16_bf16(pa1, (bf16x8){vl1[d0][0], vl1[d0][1], vl1[d0][2], vl1[d0][3], vh1[d0][0], vh1[d0][1], vh1[d0][2], vh1[d0][3]}, o[d0], 0, 0, 0); } \
        } while (0)
#define DIL_PK4(P, B_, OUT) do { unsigned a0 = cvt_pk_bf16(P[B_+0], P[B_+1]), a1 = cvt_pk_bf16(P[B_+2], P[B_+3]);                          \
            unsigned b0_ = cvt_pk_bf16(P[B_+4], P[B_+5]), b1_ = cvt_pk_bf16(P[B_+6], P[B_+7]);                                             \
            auto r0 = __builtin_amdgcn_permlane32_swap(a0, b0_, false, false); auto r1 = __builtin_amdgcn_permlane32_swap(a1, b1_, false, false); \
            u32x4 w = {r0[0], r1[0], r0[1], r1[1]}; OUT = __builtin_bit_cast(bf16x8, w); } while (0)
        DIL_STEP(kfA, kfB, 0); DIL_STEP(kfB, kfA, 1); DIL_STEP(kfA, kfB, 2); DIL_STEP(kfB, kfA, 3); DIL_STEP(kfA, kfB, 4);
#undef DIL_STEP
#undef DIL_PK4
#undef DIL_KLOAD
#undef DIL_VDMA
        float fo = 0.f, fc = 1.f;
        if (S_ != 1) { const float mo = macc[ql], lo = lacc[ql]; const float mnew = fmaxf(mo, m_reg); fo = __builtin_amdgcn_exp2f(mo - mnew); fc = __builtin_amdgcn_exp2f(m_reg - mnew);
            l_reg = lo * fo + l_reg * fc; m_reg = mnew; }
        if (hi == 0 && r32 < VR) { macc[ql] = m_reg; lacc[ql] = l_reg; wsf[r32] = fo; wsf[32 + r32] = fc; }
        asm volatile("s_waitcnt lgkmcnt(0)" ::: "memory");
#pragma unroll
        for (int r = 0; r < 16; ++r) { const int row = crow(r, hi);
            if (row < VR) { const int qrow = rho + S_ * (i0 + row); LAS float* op = Oacc + qrow * 64 + r32;
                if (S_ == 1) { op[0] = o[0][r]; op[32] = o[1][r]; }
                else { const float a = wsf[row], b = wsf[32 + row]; op[0] = op[0] * a + o[0][r] * b; op[32] = op[32] * a + o[1][r] * b; } } }
        asm volatile("s_waitcnt lgkmcnt(0)" ::: "memory");
    }
}
__device__ __forceinline__ void unit(const bf16_t* Qh, const bf16_t* Kh, const bf16_t* Vh, int pitch, bf16_t* Oh, int op, int q0, LAS unsigned char* lds, LAS float* scr) {
    int tid_ = threadIdx.x; asm volatile("" : "+v"(tid_));
    const int tid = tid_, wid = __builtin_amdgcn_readfirstlane(tid >> 6), lane = tid & 63;
    pass<1>(Qh, Kh, Vh, pitch, q0, lds, scr, wid, lane);
    __syncthreads();
    pass<4>(Qh, Kh, Vh, pitch, q0, lds, scr, wid, lane);
    __syncthreads();
    pass<16>(Qh, Kh, Vh, pitch, q0, lds, scr, wid, lane);
    __syncthreads();
    {   const int q = tid >> 1, hf = tid & 1; const LAS f32x4* src = (const LAS f32x4*)(lds + OFF_O + (q * 64 + 32 * hf) * 4); const float rl = 1.0f / scr[256 + q];
        bf16_t* dst = Oh + (size_t)(q0 + q) * op + 32 * hf;
#pragma unroll
        for (int i = 0; i < 4; ++i) { const f32x4 a = src[2 * i] * rl, b = src[2 * i + 1] * rl;
            u32x4 w; w.x = cvt_pk_bf16(a[0], a[1]); w.y = cvt_pk_bf16(a[2], a[3]); w.z = cvt_pk_bf16(b[0], b[1]); w.w = cvt_pk_bf16(b[2], b[3]); *(u32x4*)(dst + 8 * i) = w; } }
    __syncthreads();
}
}

constexpr int NWAVES = 8;
constexpr size_t MiB = 1u << 20;
constexpr size_t WS_CTL = 0, CTL_ZERO_BYTES = 1 * MiB;
constexpr size_t WS_WEIN = 2 * MiB;
constexpr size_t WS_WEOUT = 12 * MiB;
constexpr size_t WS_WOIN = 16 * MiB;
constexpr size_t WS_WUQ = 20 * MiB;
constexpr size_t WS_WUKV = 23 * MiB;
constexpr size_t WS_WOOUT = 25 * MiB;
constexpr size_t WS_B1P = 29 * MiB;
constexpr size_t WS_SSQ = 30 * MiB;
constexpr size_t WS_TOKER = 31 * MiB;
constexpr size_t WS_TOKG = 31 * MiB + 512 * 1024;
constexpr size_t WS_XN = 32 * MiB;
constexpr size_t WS_Z = 64 * MiB;
constexpr size_t WS_MIX = 144 * MiB;
constexpr size_t WS_QR = 176 * MiB;
constexpr size_t WS_KVR = 224 * MiB;
constexpr size_t WS_QF = 288 * MiB;
constexpr size_t WS_KF = 336 * MiB;
constexpr size_t WS_W1 = 384 * MiB;
constexpr size_t WS_W2 = 896 * MiB;
constexpr size_t WS_XG = 1152 * MiB;
constexpr size_t WS_ACT = 1664 * MiB;
constexpr size_t WS_Y = 2176 * MiB;
constexpr size_t WS_END = 3200 * MiB;
constexpr int CW_MOE = 65536;
constexpr int CW_TMO = 0, CW_CODE = 1, CW_BAR = 4096, CW_CNT = 16384;
constexpr int RING_OFF = 0, RING_BYTES = 131072;
constexpr int LDSCTL_OFF = RING_BYTES, MISC_OFF = LDSCTL_OFF + 320;
constexpr int SCR_OFF = RING_BYTES + 1024;
constexpr int LDS_BYTES = 155648;
constexpr int SCR_BYTES = LDS_BYTES - SCR_OFF;

typedef GAS unsigned gu32;
#define RLX_AGENT __ATOMIC_RELAXED, __HIP_MEMORY_SCOPE_AGENT

#define XB_TMO      128
#define XB_XCNT(j)  (256  + 64 * (j))
#define XB_XSUB(j)  (1280 + 64 * (j))
#define XB_XGEN(j)  (2304 + 64 * (j))
#define XB_TOP      3328
#define XB_TOPGEN   3392
#define XCD_BAR_WORDS 3456
#define XB_SPIN_CAP (1u << 18)
__device__ __forceinline__ unsigned xb_ld(unsigned* p)              { return __hip_atomic_load(p, __ATOMIC_RELAXED, __HIP_MEMORY_SCOPE_AGENT); }
__device__ __forceinline__ unsigned xb_add(unsigned* p, unsigned v) { return __hip_atomic_fetch_add(p, v, __ATOMIC_RELAXED, __HIP_MEMORY_SCOPE_AGENT); }
__device__ __forceinline__ unsigned xb_xcc_id() { return (unsigned)__builtin_amdgcn_s_getreg((3 << 11) | 20) & 0xFu; }
#define XB_SPIN(cond, bar) do { unsigned _sp = 0; while (cond) { __builtin_amdgcn_s_sleep(1); \
    if ((++_sp & 255u) == 0u) { if (xb_ld(&(bar)[XB_TMO])) break; if (_sp > XB_SPIN_CAP) { atomicAdd(&(bar)[XB_TMO], 1u); break; } } } } while (0)
struct XcdBarrier { unsigned* bar; unsigned x; volatile LAS unsigned* st; };
__device__ __forceinline__ XcdBarrier xcd_barrier_post(unsigned* bar, volatile LAS unsigned* st) {
    XcdBarrier b; b.bar = bar; b.x = xb_xcc_id(); b.st = st;
    if (threadIdx.x == 0) (void)xb_add(&bar[XB_XCNT(b.x)], 1u);
    return b;
}
__device__ __forceinline__ void xcd_barrier_complete(unsigned* bar, unsigned x, unsigned& nloc, unsigned& nx) {
    const unsigned G = gridDim.x * gridDim.y * gridDim.z;
    unsigned sum, cnt, mine, sp = 0u;
    for (;;) {
        sum = 0u; cnt = 0u; mine = 0u;
#pragma unroll
        for (unsigned j = 0; j < 16; ++j) { const unsigned c = xb_ld(&bar[XB_XCNT(j)]); sum += c; cnt += (c > 0u) ? 1u : 0u; mine = (j == x) ? c : mine; }
        if (sum == G) break;
        __builtin_amdgcn_s_sleep(1);
        if ((++sp & 255u) == 0u) { if (xb_ld(&bar[XB_TMO])) break; if (sp > XB_SPIN_CAP) { atomicAdd(&bar[XB_TMO], 1u); break; } }
    }
    nloc = mine > 0u ? mine : 1u; nx = cnt > 0u ? cnt : 1u;
}
__device__ __forceinline__ void xcd_barrier(const XcdBarrier& b) {
    asm volatile("s_waitcnt vmcnt(0)" ::: "memory");
    __syncthreads();
    if (threadIdx.x == 0) {
        unsigned* bar = b.bar;
        __builtin_amdgcn_s_waitcnt(0);
        unsigned nloc = b.st[0], nx = b.st[1];
        if (nloc == 0u) { xcd_barrier_complete(bar, b.x, nloc, nx); b.st[0] = nloc; b.st[1] = nx; }
        const unsigned old = xb_add(&bar[XB_XSUB(b.x)], 1u);
        const unsigned gen = old / nloc;
        if (old + 1u == (gen + 1u) * nloc) {
            __builtin_amdgcn_fence(__ATOMIC_RELEASE, "agent");
            asm volatile("s_waitcnt vmcnt(0)" ::: "memory");
            const unsigned og = xb_add(&bar[XB_TOP], 1u);
            const unsigned tg = og / nx;
            if (og + 1u == (tg + 1u) * nx) xb_add(&bar[XB_TOPGEN], 1u);
            else XB_SPIN(xb_ld(&bar[XB_TOPGEN]) == tg, bar);
            __builtin_amdgcn_fence(__ATOMIC_ACQUIRE, "agent");
            xb_add(&bar[XB_XGEN(b.x)], 1u);
            asm volatile("s_waitcnt vmcnt(0)" ::: "memory");
        } else {
            XB_SPIN(xb_ld(&bar[XB_XGEN(b.x)]) == gen, bar);
            __builtin_amdgcn_fence(__ATOMIC_ACQUIRE, "agent");
            asm volatile("s_waitcnt vmcnt(0)" ::: "memory");
        }
    }
    __syncthreads();
}

struct Args {
    const float* in[24]; float* out; unsigned char* ws; int stage_limit; int pad;
};
enum { I_X = 0, I_MIXN, I_FFNN, I_EWIN, I_EWS, I_EBS, I_EGV, I_EGQ, I_EGK, I_EWOUT, I_OWIN, I_OGCQ, I_OGCKV, I_OWUQ, I_OWUKV, I_OGQ, I_OGK, I_OWOUT,
       I_RW, I_RB, I_W1, I_B1, I_W2, I_B2 };

struct Frame {
    LAS unsigned char* lds;
    int vcu, G;
};

__device__ __forceinline__ float wave_sum(float v) {
#pragma unroll
    for (int o = 1; o < 64; o <<= 1) v += __shfl_xor(v, o);
    return v;
}
#define LDS_WAIT() asm volatile("s_waitcnt lgkmcnt(0)" ::: "memory")

template <int MODE> __device__ __forceinline__ int dst_row(int o) {
    if (MODE == 1) { if (o >= 1024 && o < 2048) return (o & ~255) | (((o >> 5) & 1) << 7) | (((o >> 6) & 3) << 5) | (o & 31); return o; }
    if (MODE == 2) return ((o >> 8) << 8) | ((o & 1) << 7) | ((o & 255) >> 1);
    return o;
}
template <int MODE>
__device__ __forceinline__ void transpose_item(const float* __restrict__ W, int K, int N, bf16_t* __restrict__ WT, const float* __restrict__ gain, LAS float* scr, int item, int lane) {
    const int nblk = N / 32, kb = item / nblk, nb = item % nblk, k0 = 64 * kb, n0 = 32 * nb;
#pragma unroll 8
    for (int i = 0; i < 32; ++i) { const int kk = 2 * i + (lane >> 5); float w = W[(size_t)(k0 + kk) * N + n0 + (lane & 31)]; if (gain) w *= gain[k0 + kk]; scr[kk * 33 + (lane & 31)] = w; }
    LDS_WAIT(); asm volatile("" ::: "memory");
    const int c = lane & 7;
#pragma unroll
    for (int j = 0; j < 4; ++j) { const int n = (lane >> 3) + 8 * j; const LAS float* s = scr + (8 * c) * 33 + n;
        u32x4 o; o.x = cvt_pk_bf16(s[0 * 33], s[1 * 33]); o.y = cvt_pk_bf16(s[2 * 33], s[3 * 33]); o.z = cvt_pk_bf16(s[4 * 33], s[5 * 33]); o.w = cvt_pk_bf16(s[6 * 33], s[7 * 33]);
        *(u32x4*)(WT + (size_t)dst_row<MODE>(n0 + n) * K + k0 + 8 * c) = o; }
    LDS_WAIT(); asm volatile("" ::: "memory");
}
template <int MODE>
__device__ __forceinline__ void transpose_job(Frame& F, const float* W, int K, int N, int nmat, size_t src_stride, bf16_t* WT, size_t dst_stride, const float* gain, int gain_stride) {
    int tid_ = threadIdx.x; asm volatile("" : "+v"(tid_));
    const int wave = __builtin_amdgcn_readfirstlane(tid_ >> 6), lane = tid_ & 63;
    LAS float* scr = (LAS float*)(F.lds + RING_OFF + wave * 16384);
    const int gw = F.vcu * NWAVES + wave, NGW = F.G * NWAVES;
    const int per = (K / 64) * (N / 32), total = per * nmat;
    for (int it = gw; it < total; it += NGW) { const int mi = it / per, item = it - mi * per;
        transpose_item<MODE>(W + (size_t)mi * src_stride, K, N, WT + (size_t)mi * dst_stride, gain ? gain + (size_t)mi * gain_stride : nullptr, scr, item, lane); }
}


__device__ __forceinline__ void tr8_load(f32x4 (&v)[8], const float* __restrict__ W, int N, int item, int lane) {
    const int nblk = N / 32, kb = item / nblk, nb = item % nblk, k0 = 64 * kb, n0 = 32 * nb;
#pragma unroll
    for (int i = 0; i < 8; ++i) v[i] = __builtin_nontemporal_load((const f32x4*)(W + (size_t)(k0 + 8 * i + (lane >> 3)) * N + n0 + 4 * (lane & 7)));
}
template <int MODE>
__device__ __forceinline__ void tr8_store(const f32x4 (&v)[8], int K, int N, unsigned char* __restrict__ WT, LAS float* scr, int item, int lane) {
    const int nblk = N / 32, kb = item / nblk, nb = item % nblk, k0 = 64 * kb, n0 = 32 * nb;
#pragma unroll
    for (int i = 0; i < 8; ++i) { LAS float* d = scr + (8 * i + (lane >> 3)) * 33 + 4 * (lane & 7);
        d[0] = v[i].x * W8_SCALE; d[1] = v[i].y * W8_SCALE; d[2] = v[i].z * W8_SCALE; d[3] = v[i].w * W8_SCALE; }
    LDS_WAIT(); asm volatile("" ::: "memory");
    const int c = lane & 3;
#pragma unroll
    for (int j = 0; j < 2; ++j) { const int n = (lane >> 2) + 16 * j; const LAS float* s = scr + (16 * c) * 33 + n;
        u32x4 o; o.x = pk4_fp8(s[0 * 33], s[1 * 33], s[2 * 33], s[3 * 33]); o.y = pk4_fp8(s[4 * 33], s[5 * 33], s[6 * 33], s[7 * 33]);
        o.z = pk4_fp8(s[8 * 33], s[9 * 33], s[10 * 33], s[11 * 33]); o.w = pk4_fp8(s[12 * 33], s[13 * 33], s[14 * 33], s[15 * 33]);
        __builtin_nontemporal_store(o, (u32x4*)(WT + (size_t)dst_row<MODE>(n0 + n) * K + k0 + 16 * c)); }
    LDS_WAIT(); asm volatile("" ::: "memory");
}
template <int MODE>
__device__ __forceinline__ void transpose_job_fp8(Frame& F, const float* W, int K, int N, int nmat, size_t src_stride, unsigned char* WT, size_t dst_stride) {
    int tid_ = threadIdx.x; asm volatile("" : "+v"(tid_));
    const int wave = __builtin_amdgcn_readfirstlane(tid_ >> 6), lane = tid_ & 63;
    LAS float* scr = (LAS float*)(F.lds + RING_OFF + wave * 16384);
    const int gw = F.vcu * NWAVES + wave, NGW = F.G * NWAVES;
    const int per = (K / 64) * (N / 32), total = per * nmat;
    f32x4 cur[8], nxt[8];
    int it = gw;
    if (it < total) { const int mi = it / per; tr8_load(cur, W + (size_t)mi * src_stride, N, it - mi * per, lane); }
    for (; it < total; it += NGW) {
        const int itn = it + NGW;
        if (itn < total) { const int mn = itn / per; tr8_load(nxt, W + (size_t)mn * src_stride, N, itn - mn * per, lane); }
        const int mi = it / per;
        tr8_store<MODE>(cur, K, N, WT + (size_t)mi * dst_stride, scr, it - mi * per, lane);
#pragma unroll
        for (int i = 0; i < 8; ++i) cur[i] = nxt[i];
    }
}

__device__ __forceinline__ void rms_row_to_fp8(int lane, const float* xrow, const float* g, unsigned char* orow, float* copy) {
    const f32x4* xr = (const f32x4*)xrow + lane; const f32x4* gr = (const f32x4*)g + lane;
    f32x4 v[4]; float s = 0.f;
#pragma unroll
    for (int j = 0; j < 4; ++j) { v[j] = xr[64 * j]; s += (v[j].x * v[j].x + v[j].y * v[j].y) + (v[j].z * v[j].z + v[j].w * v[j].w); }
    const float rstd = 1.0f / sqrtf(wave_sum(s) * (1.f / DM) + EPS);
    unsigned* o4 = (unsigned*)orow + lane;
#pragma unroll
    for (int j = 0; j < 4; ++j) { const f32x4 gg = gr[64 * j]; if (copy) ((f32x4*)copy + lane)[64 * j] = v[j];
        o4[64 * j] = pk4_fp8(v[j].x * rstd * gg.x, v[j].y * rstd * gg.y, v[j].z * rstd * gg.z, v[j].w * rstd * gg.w); }
}
__device__ __forceinline__ void rms_row_to_bf16(int lane, const float* xrow, const float* g, bf16_t* orow, float* copy) {
    const f32x4* xr = (const f32x4*)xrow + lane; const f32x4* gr = (const f32x4*)g + lane;
    f32x4 v[4]; float s = 0.f;
#pragma unroll
    for (int j = 0; j < 4; ++j) { v[j] = xr[64 * j]; s += (v[j].x * v[j].x + v[j].y * v[j].y) + (v[j].z * v[j].z + v[j].w * v[j].w); }
    const float rstd = 1.0f / sqrtf(wave_sum(s) * (1.f / DM) + EPS);
    u32x2* o8 = (u32x2*)orow + lane;
#pragma unroll
    for (int j = 0; j < 4; ++j) { const f32x4 gg = gr[64 * j]; if (copy) ((f32x4*)copy + lane)[64 * j] = v[j];
        u32x2 w; w.x = cvt_pk_bf16(v[j].x * rstd * gg.x, v[j].y * rstd * gg.y); w.y = cvt_pk_bf16(v[j].z * rstd * gg.z, v[j].w * rstd * gg.w); o8[64 * j] = w; }
}

namespace pg8 {
struct EpiEvenIn {
    static constexpr bool PERM = false;
    bf16_t* Z; const float* gq; const float* gk;
    __device__ __forceinline__ void operator()(const f32x4 (&acc)[2][2][4][2], const Unit& u, int wr, int wc, int fr, int fq) const {
        const int row0 = u.pm * BM + wr * 64 + fr, pn = u.pn;
        if (pn >= 4 && pn < 8) {
            const float* g = pn < 6 ? gq : gk; const float sc = pn < 6 ? C2_B : 1.0f;
            f32x4 gv[2][2];
#pragma unroll
            for (int bj = 0; bj < 2; ++bj)
#pragma unroll
                for (int n = 0; n < 2; ++n) gv[bj][n] = *(const f32x4*)(g + 32 * bj + 16 * n + 4 * fq);
#pragma unroll
            for (int ai = 0; ai < 2; ++ai)
#pragma unroll
                for (int m = 0; m < 4; ++m) {
                    float ss = 0.f;
#pragma unroll
                    for (int bj = 0; bj < 2; ++bj)
#pragma unroll
                        for (int n = 0; n < 2; ++n) { const f32x4 v = acc[ai][bj][m][n]; ss += (v[0] * v[0] + v[1] * v[1]) + (v[2] * v[2] + v[3] * v[3]); }
                    ss += __shfl_xor(ss, 16); ss += __shfl_xor(ss, 32);
                    const float rstd = sc / sqrtf(ss * (1.0f / 64.0f) + EPS);
                    bf16_t* rowp = Z + (size_t)(row0 + ai * HALF + m * 16) * EVEN_IN + pn * BM + wc * 64 + 4 * fq;
#pragma unroll
                    for (int bj = 0; bj < 2; ++bj)
#pragma unroll
                        for (int n = 0; n < 2; ++n) { const f32x4 v = acc[ai][bj][m][n] * rstd * gv[bj][n];
                            u32x2 w; w.x = cvt_pk_bf16(v[0], v[1]); w.y = cvt_pk_bf16(v[2], v[3]); *(u32x2*)(rowp + 32 * bj + 16 * n) = w; }
                }
        } else {
            const bool act = pn < 4;
#pragma unroll
            for (int ai = 0; ai < 2; ++ai)
#pragma unroll
                for (int m = 0; m < 4; ++m) { bf16_t* rowp = Z + (size_t)(row0 + ai * HALF + m * 16) * EVEN_IN + pn * BM + wc * 32 + 4 * fq;
#pragma unroll
                    for (int bj = 0; bj < 2; ++bj)
#pragma unroll
                        for (int n = 0; n < 2; ++n) { f32x4 v = acc[ai][bj][m][n]; if (act) v = gelu4(v);
                            u32x2 w; w.x = cvt_pk_bf16(v[0], v[1]); w.y = cvt_pk_bf16(v[2], v[3]); *(u32x2*)(rowp + bj * HALF + 16 * n) = w; } }
        }
    }
};
struct EpiResid {
    static constexpr bool PERM = false;
    float* out;
    __device__ __forceinline__ void operator()(const f32x4 (&acc)[2][2][4][2], const Unit& u, int wr, int wc, int fr, int fq) const {
        const int row0 = u.pm * BM + wr * 64 + fr;
#pragma unroll
        for (int ai = 0; ai < 2; ++ai)
#pragma unroll
            for (int m = 0; m < 4; ++m) { float* rowp = out + (size_t)(row0 + ai * HALF + m * 16) * DM + u.pn * BM + wc * 32 + 4 * fq;
#pragma unroll
                for (int bj = 0; bj < 2; ++bj)
#pragma unroll
                    for (int n = 0; n < 2; ++n) { f32x4* p = (f32x4*)(rowp + bj * HALF + 16 * n); *p = *p + acc[ai][bj][m][n]; }
                if (m & 1) asm volatile("" ::: "memory"); }
    }
};
struct EpiOddIn {
    static constexpr bool PERM = false;
    bf16_t* Z; float* ssq;
    __device__ __forceinline__ void operator()(const f32x4 (&acc)[2][2][4][2], const Unit& u, int wr, int wc, int fr, int fq) const {
        const int row0 = u.pm * BM + wr * 64 + fr, pn = u.pn;
#pragma unroll
        for (int ai = 0; ai < 2; ++ai)
#pragma unroll
            for (int m = 0; m < 4; ++m) { const int row = row0 + ai * HALF + m * 16; bf16_t* rowp = Z + (size_t)row * ODD_INP + pn * BM + wc * 32 + 4 * fq;
                float ss = 0.f;
#pragma unroll
                for (int bj = 0; bj < 2; ++bj)
#pragma unroll
                    for (int n = 0; n < 2; ++n) { const f32x4 v = acc[ai][bj][m][n] * W8_INV; ss += (v[0] * v[0] + v[1] * v[1]) + (v[2] * v[2] + v[3] * v[3]);
                        u32x2 w; w.x = cvt_pk_bf16(v[0], v[1]); w.y = cvt_pk_bf16(v[2], v[3]); *(u32x2*)(rowp + bj * HALF + 16 * n) = w; }
                ss += __shfl_xor(ss, 16); ss += __shfl_xor(ss, 32);
                if (fq == 0) ssq[(size_t)row * 16 + pn * 4 + wc] = ss; }
    }
};
template <int NS> struct EpiRowScale {
    static constexpr bool PERM = true;
    bf16_t* O; int ldc; const float* ssq; int s0; float inv_cols;
    __device__ __forceinline__ void operator()(const f32x4 (&acc)[2][2][4][2], const Unit& u, int wr, int wc, int fr, int fq) const {
        const int row0 = u.pm * BM + wr * 64 + fr; const int col0 = u.pn * BM + wc * 32 + 8 * fq;
#pragma unroll
        for (int ai = 0; ai < 2; ++ai)
#pragma unroll
            for (int m = 0; m < 4; ++m) { const int row = row0 + ai * HALF + m * 16;
                float ss = 0.f; const f32x4* sp = (const f32x4*)(ssq + (size_t)row * 16 + s0);
#pragma unroll
                for (int q = 0; q < NS; ++q) { const f32x4 t = sp[q]; ss += (t[0] + t[1]) + (t[2] + t[3]); }
                const float rstd = 1.0f / sqrtf(ss * inv_cols + EPS);
                bf16_t* rowp = O + (size_t)row * ldc + col0;
#pragma unroll
                for (int bj = 0; bj < 2; ++bj) { const f32x4 v0 = acc[ai][bj][m][0] * rstd, v1 = acc[ai][bj][m][1] * rstd;
                    u32x4 w; w.x = cvt_pk_bf16(v0[0], v0[1]); w.y = cvt_pk_bf16(v0[2], v0[3]); w.z = cvt_pk_bf16(v1[0], v1[1]); w.w = cvt_pk_bf16(v1[2], v1[3]);
                    *(u32x4*)(rowp + bj * HALF) = w; }
                asm volatile("" ::: "memory"); }
    }
};
__device__ __forceinline__ void store8_sc1(void* p, u32x2 v) { asm volatile("global_store_dwordx2 %0, %1, off sc1" :: "v"(p), "v"(v) : "memory"); }
template <bool WT = false> struct EpiSwigluT {
    static constexpr bool PERM = true;
    unsigned char* ACT; const float* b1p;
    __device__ __forceinline__ void operator()(const f32x4 (&acc)[2][2][4][2], const Unit& u, int wr, int wc, int fr, int fq) const {
        const int row0 = u.pm * BM + wr * 64 + fr, e = u.pb >> 3, pn = u.pn;
        const float* bp = b1p + (size_t)e * 2048 + pn * BM + wc * 32 + 8 * fq;
        f32x4 bg[2], bl[2];
#pragma unroll
        for (int n = 0; n < 2; ++n) { bg[n] = *(const f32x4*)(bp + 4 * n); bl[n] = *(const f32x4*)(bp + HALF + 4 * n); }
#pragma unroll
        for (int ai = 0; ai < 2; ++ai)
#pragma unroll
            for (int m = 0; m < 4; ++m) { unsigned char* rowp = ACT + (size_t)(row0 + ai * HALF + m * 16) * DE + pn * HALF + wc * 32 + 8 * fq;
                float a[8];
#pragma unroll
                for (int n = 0; n < 2; ++n) { const f32x4 gv = acc[ai][0][m][n] * W8_INV + bg[n], lv = acc[ai][1][m][n] * W8_INV + bl[n];
#pragma unroll
                    for (int i = 0; i < 4; ++i) { const float gl = fminf(gv[i], 7.0f), li = fminf(fmaxf(lv[i], -7.0f), 7.0f);
                        const float sg = __builtin_amdgcn_rcpf(1.0f + __builtin_amdgcn_exp2f(-1.702f * LOG2E * gl));
                        a[4 * n + i] = gl * sg * (li + 1.0f); } }
                u32x2 w; w.x = pk4_fp8(a[0], a[1], a[2], a[3]); w.y = pk4_fp8(a[4], a[5], a[6], a[7]);
                if (WT) store8_sc1(rowp, w); else *(u32x2*)rowp = w; }
    }
};
typedef EpiSwigluT<false> EpiSwiglu;
struct EpiDown {
    static constexpr bool PERM = true;
    bf16_t* Y; const float* b2;
    __device__ __forceinline__ void operator()(const f32x4 (&acc)[2][2][4][2], const Unit& u, int wr, int wc, int fr, int fq) const {
        const int row0 = u.pm * BM + wr * 64 + fr, e = u.pb >> 2, pn = u.pn;
        const float* bp = b2 + (size_t)e * DM + pn * BM + wc * 32 + 8 * fq;
        f32x4 bv[2][2];
#pragma unroll
        for (int bj = 0; bj < 2; ++bj)
#pragma unroll
            for (int n = 0; n < 2; ++n) bv[bj][n] = *(const f32x4*)(bp + bj * HALF + 4 * n);
#pragma unroll
        for (int ai = 0; ai < 2; ++ai)
#pragma unroll
            for (int m = 0; m < 4; ++m) { bf16_t* rowp = Y + (size_t)(row0 + ai * HALF + m * 16) * DM + pn * BM + wc * 32 + 8 * fq;
#pragma unroll
                for (int bj = 0; bj < 2; ++bj) { const f32x4 v0 = acc[ai][bj][m][0] * W8_INV + bv[bj][0], v1 = acc[ai][bj][m][1] * W8_INV + bv[bj][1];
                    u32x4 w; w.x = cvt_pk_bf16(v0[0], v0[1]); w.y = cvt_pk_bf16(v0[2], v0[3]); w.z = cvt_pk_bf16(v1[0], v1[1]); w.w = cvt_pk_bf16(v1[2], v1[3]);
                    *(u32x4*)(rowp + bj * HALF) = w; } }
    }
};
struct MoeOrder {
    const LAS int* tbl; int nN, G, c;
    __device__ bool next(int i, Unit& u) const {
        const long L = (long)i * G + c; const int rb = (int)(L / nN);
        if (rb >= __builtin_amdgcn_readfirstlane(tbl[32])) return false;
        int e = 0;
#pragma unroll
        for (int k = 1; k < 32; ++k) e += (tbl[k] <= rb) ? 1 : 0;
        e = __builtin_amdgcn_readfirstlane(e); const int rbl = __builtin_amdgcn_readfirstlane(rb - tbl[e]);
        u.pm = e * (ECAP / BM) + rbl; u.pn = (int)(L % nN); u.pb = e * nN + u.pn; u.kind = 0; u.rb = rb; return true;
    }
    __device__ __forceinline__ void a_ready(const Unit&) const {}
    __device__ __forceinline__ void pre_epi() const {}
    __device__ __forceinline__ void done(const Unit&) const {}
    __device__ __forceinline__ void finish() const {}
};

constexpr unsigned MOE_SPIN_CAP = 1u << 22;
struct MoeMergedOrder {
    const LAS int* tbl; int G, c; gu32* cnt;
    mutable int pend;
    __device__ __forceinline__ void flush() const {
        if (pend >= 0) { asm volatile("s_waitcnt vmcnt(0)" ::: "memory");
            if ((threadIdx.x & 63) == 0) __hip_atomic_fetch_add(cnt + 16 * pend, 1u, __ATOMIC_RELAXED, __HIP_MEMORY_SCOPE_AGENT);
            pend = -1; } }
    __device__ bool next(int i, Unit& u) const {
        const int nb = __builtin_amdgcn_readfirstlane(tbl[32]);
        long L = (long)i * G + c; int nN = 8, kind = 0;
        if (L >= (long)nb * 8) { L -= (long)nb * 8; nN = 4; kind = 1; if (L >= (long)nb * 4) return false; }
        const int rb = (int)(L / nN);
        int e = 0;
#pragma unroll
        for (int k = 1; k < 32; ++k) e += (tbl[k] <= rb) ? 1 : 0;
        e = __builtin_amdgcn_readfirstlane(e); const int rbl = __builtin_amdgcn_readfirstlane(rb - tbl[e]);
        u.pm = e * (ECAP / BM) + rbl; u.pn = (int)(L % nN); u.pb = e * nN + u.pn; u.kind = kind; u.rb = rb; return true;
    }
    __device__ __forceinline__ void a_ready(const Unit& u) const {
        if (u.kind == 1) {
            flush();
            if (threadIdx.x < 64) {
                unsigned sp = 0;
                while ((unsigned)__builtin_amdgcn_readfirstlane(__hip_atomic_load(cnt + 16 * u.rb, __ATOMIC_RELAXED, __HIP_MEMORY_SCOPE_AGENT)) < 64u) { __builtin_amdgcn_s_sleep(2); if (++sp > MOE_SPIN_CAP) break; }
                __builtin_amdgcn_fence(__ATOMIC_ACQUIRE, "agent");
                asm volatile("s_waitcnt vmcnt(0)" ::: "memory");
            }
            __builtin_amdgcn_s_barrier();
        }
    }
    __device__ __forceinline__ void pre_epi() const { flush(); }
    __device__ __forceinline__ void done(const Unit& u) const { if (u.kind == 0) pend = u.rb; }
    __device__ __forceinline__ void finish() const { flush(); }
};
struct EpiMoe {
    static constexpr bool PERM = true;
    EpiSwigluT<true> up; EpiDown down;
    __device__ __forceinline__ void operator()(const f32x4 (&acc)[2][2][4][2], const Unit& u, int wr, int wc, int fr, int fq) const {
        if (u.kind == 0) up(acc, u, wr, wc, fr, fq); else down(acc, u, wr, wc, fr, fq);
    }
};
}

__device__ __forceinline__ void gmlp_unit(Frame& F, const bf16_t* Z, bf16_t* MIX, const float* Ws, const float* bs, const float* gv, int unit) {
    constexpr int VP = 272;
    LAS unsigned char* VT = F.lds + RING_OFF;
    const int h = unit & 3, chunk = unit >> 2;
    int tid_ = threadIdx.x; asm volatile("" : "+v"(tid_));
    const int t0 = chunk * 128, tid = tid_, lane = tid & 63, w = __builtin_amdgcn_readfirstlane(tid >> 6);
    {
        const int s = tid >> 2, dq = (tid & 3) * 32;
        const bf16_t* vp = Z + (size_t)(t0 + s) * EVEN_IN + 512 + h * 128 + dq;
        u32x4 raw[4]; float ss = 0.f;
#pragma unroll
        for (int i = 0; i < 4; ++i) { raw[i] = *(const u32x4*)(vp + 8 * i);
#pragma unroll
            for (int j = 0; j < 4; ++j) { const float a = bflo(raw[i][j]), b = bfhi(raw[i][j]); ss += a * a + b * b; } }
        ss += __shfl_xor(ss, 1); ss += __shfl_xor(ss, 2);
        const float rstd = 1.0f / sqrtf(ss * (1.0f / 128.0f) + EPS);
#pragma unroll
        for (int i = 0; i < 4; ++i)
#pragma unroll
            for (int j = 0; j < 4; ++j) { const int d = dq + 8 * i + 2 * j;
                *(LAS bf16_t*)(VT + (d) * VP + s * 2) = f2bf(bflo(raw[i][j]) * rstd);
                *(LAS bf16_t*)(VT + (d + 1) * VP + s * 2) = f2bf(bfhi(raw[i][j]) * rstd); }
    }
    __syncthreads();
    const int fr = lane & 15, fq = lane >> 4;
    f32x4 acc[8];
#pragma unroll
    for (int nb = 0; nb < 8; ++nb) acc[nb] = (f32x4){0.f, 0.f, 0.f, 0.f};
    const int trow = 16 * w + fr;
    const float* wrow = Ws + ((size_t)h * 128 + trow) * 128;
#pragma unroll
    for (int ks = 0; ks < 4; ++ks) {
        if (32 * ks <= 16 * w + 15) {
            const int s0 = 32 * ks + 8 * fq;
            const f32x4 wa = *(const f32x4*)(wrow + s0), wb = *(const f32x4*)(wrow + s0 + 4);
            float wv[8] = {wa[0], wa[1], wa[2], wa[3], wb[0], wb[1], wb[2], wb[3]};
#pragma unroll
            for (int j = 0; j < 8; ++j) if (s0 + j > trow) wv[j] = 0.f;
            u32x4 aw; aw.x = cvt_pk_bf16(wv[0], wv[1]); aw.y = cvt_pk_bf16(wv[2], wv[3]); aw.z = cvt_pk_bf16(wv[4], wv[5]); aw.w = cvt_pk_bf16(wv[6], wv[7]);
            const bf16x8 af = __builtin_bit_cast(bf16x8, aw);
#pragma unroll
            for (int nb = 0; nb < 8; ++nb) { const bf16x8 bfr = *(const LAS bf16x8*)(VT + (16 * nb + fr) * VP + s0 * 2);
                acc[nb] = __builtin_amdgcn_mfma_f32_16x16x32_bf16(af, bfr, acc[nb], 0, 0, 0); }
        }
    }
#pragma unroll
    for (int i = 0; i < 4; ++i) { const int tl = 16 * w + 4 * fq + i; const float bt = bs[h * 128 + tl];
        const bf16_t* up = Z + (size_t)(t0 + tl) * EVEN_IN + h * 128 + fr; bf16_t* op = MIX + (size_t)(t0 + tl) * DM + h * 128 + fr;
#pragma unroll
        for (int nb = 0; nb < 8; ++nb) { const float uu = bf2f(up[16 * nb]); op[16 * nb] = f2bf(uu * (gv[h * 128 + 16 * nb + fr] * acc[nb][i] + bt)); } }
    __syncthreads();
}

__device__ __forceinline__ void router_phase(Frame& F, const float* x, const float* gain, const float* Wr, const float* br, gu32* cnt  ,
                                             unsigned* tok_er, float* tok_g, unsigned char* XG) {
    LAS float* WrT = (LAS float*)(F.lds + RING_OFF);
    LAS float* lg = (LAS float*)(F.lds + SCR_OFF);
    LAS unsigned* hist = (LAS unsigned*)(F.lds + SCR_OFF + 64 * 33 * 4);
    LAS unsigned* base = hist + 32;
    LAS unsigned* ers = base + 32;
    int tid_ = threadIdx.x; asm volatile("" : "+v"(tid_));
    const int tid = tid_, lane = tid & 63, w = __builtin_amdgcn_readfirstlane(tid >> 6);
#ifndef RTR_REP_A
#define RTR_REP_A 1
#define RTR_REP_B 1
#define RTR_REP_C 1
#endif
    for (int ra_ = 0; ra_ < RTR_REP_A; ++ra_)
    for (int idx = tid; idx < 8192; idx += 512) { const int e4 = idx >> 10, k = idx & 1023; const f32x4 v = *(const f32x4*)(Wr + (size_t)k * 32 + 4 * e4);
        WrT[(4 * e4 + 0) * 1024 + k] = v[0]; WrT[(4 * e4 + 1) * 1024 + k] = v[1]; WrT[(4 * e4 + 2) * 1024 + k] = v[2]; WrT[(4 * e4 + 3) * 1024 + k] = v[3]; }
    __syncthreads();
    f32x4 gg[4];
#pragma unroll
    for (int j = 0; j < 4; ++j) gg[j] = ((const f32x4*)gain + lane)[64 * j];
    const float brl = br[lane & 31];
    {   const int tg = F.vcu;
    const int tokb = tg * 64;
    if (tid < 32) hist[tid] = 0u;
    for (int rb_ = 0; rb_ < RTR_REP_B; ++rb_)
#pragma unroll 1
    for (int tp = 0; tp < 4; ++tp) {
        f32x4 ha[4], hb[4];
        {   const float* r0 = x + (size_t)(tokb + w * 8 + 2 * tp) * DM;
#pragma unroll
            for (int j = 0; j < 4; ++j) { ha[j] = ((const f32x4*)r0 + lane)[64 * j]; hb[j] = ((const f32x4*)(r0 + DM) + lane)[64 * j]; } }
        float sa = 0.f, sb = 0.f;
#pragma unroll
        for (int j = 0; j < 4; ++j) { sa += (ha[j].x * ha[j].x + ha[j].y * ha[j].y) + (ha[j].z * ha[j].z + ha[j].w * ha[j].w); sb += (hb[j].x * hb[j].x + hb[j].y * hb[j].y) + (hb[j].z * hb[j].z + hb[j].w * hb[j].w); }
        const float ra = 1.0f / sqrtf(wave_sum(sa) * (1.f / DM) + EPS), rb = 1.0f / sqrtf(wave_sum(sb) * (1.f / DM) + EPS);
#pragma unroll
        for (int j = 0; j < 4; ++j) { ha[j] = ha[j] * ra * gg[j]; hb[j] = hb[j] * rb * gg[j]; }
        float a[32], b[32];
#pragma unroll
        for (int e = 0; e < 32; ++e) { f32x2 ta = {0.f, 0.f}, tb = {0.f, 0.f};
#pragma unroll
            for (int j = 0; j < 4; ++j) { const f32x4 wv = *(const LAS f32x4*)(WrT + e * 1024 + 256 * j + 4 * lane);
                const f32x2 w01 = {wv.x, wv.y}, w23 = {wv.z, wv.w};
                ta = (f32x2){ha[j].x, ha[j].y} * w01 + ta; ta = (f32x2){ha[j].z, ha[j].w} * w23 + ta;
                tb = (f32x2){hb[j].x, hb[j].y} * w01 + tb; tb = (f32x2){hb[j].z, hb[j].w} * w23 + tb; }
            a[e] = ta.x + ta.y; b[e] = tb.x + tb.y; if ((e & 3) == 3) __builtin_amdgcn_sched_barrier(0); }
#define RSTEP(N, BIT) _Pragma("unroll") for (int i = 0; i < N; ++i) { const bool up = (lane & BIT) != 0; \
            { const float keep = up ? a[2 * i + 1] : a[2 * i], send = up ? a[2 * i] : a[2 * i + 1]; a[i] = keep + __shfl_xor(send, BIT); } \
            { const float keep = up ? b[2 * i + 1] : b[2 * i], send = up ? b[2 * i] : b[2 * i + 1]; b[i] = keep + __shfl_xor(send, BIT); } }
        RSTEP(16, 1) RSTEP(8, 2) RSTEP(4, 4) RSTEP(2, 8) RSTEP(1, 16)
#undef RSTEP
        const float la = a[0] + __shfl_xor(a[0], 32) + brl, lb = b[0] + __shfl_xor(b[0], 32) + brl;
        if (lane < 32) { lg[(w * 8 + 2 * tp) * 33 + lane] = la; lg[(w * 8 + 2 * tp + 1) * 33 + lane] = lb; }
        asm volatile("" ::: "memory"); __builtin_amdgcn_sched_barrier(0);
    }
    __syncthreads();
    unsigned my_e[4] = {0, 0, 0, 0}, my_lr[4] = {0, 0, 0, 0}; float my_g[4] = {0, 0, 0, 0};
    if (tid < 64) {
        float v[32];
#pragma unroll
        for (int e = 0; e < 32; ++e) v[e] = lg[tid * 33 + e];
        int c0 = -1, c1 = -1, c2 = -1; float tv[4];
#pragma unroll
        for (int r = 0; r < 4; ++r) { float best = -__builtin_inff(); int bi = 0;
#pragma unroll
            for (int e = 0; e < 32; ++e) { const bool ok = (e != c0) && (e != c1) && (e != c2); if (ok && v[e] > best) { best = v[e]; bi = e; } }
            tv[r] = best; my_e[r] = (unsigned)bi; if (r == 0) c0 = bi; else if (r == 1) c1 = bi; else if (r == 2) c2 = bi; }
        const float p1 = __expf(tv[1] - tv[0]), p2 = __expf(tv[2] - tv[0]), p3 = __expf(tv[3] - tv[0]); const float inv = 1.0f / (1.0f + p1 + p2 + p3);
        my_g[0] = inv; my_g[1] = p1 * inv; my_g[2] = p2 * inv; my_g[3] = p3 * inv;
#pragma unroll
        for (int r = 0; r < 4; ++r) my_lr[r] = __hip_atomic_fetch_add(hist + my_e[r], 1u, __ATOMIC_RELAXED, __HIP_MEMORY_SCOPE_WORKGROUP);
    }
    __syncthreads();
    if (tid < 32) { const unsigned hc = hist[tid]; base[tid] = hc ? __hip_atomic_fetch_add(cnt + 64 * tid, hc, RLX_AGENT) : 0u; }
    __syncthreads();
    if (tid < 64) {
        u32x4 er; f32x4 gt;
#pragma unroll
        for (int r = 0; r < 4; ++r) { const unsigned rank = base[my_e[r]] + my_lr[r]; er[r] = (my_e[r] << 16) | rank; gt[r] = my_g[r]; ers[tid * 4 + r] = er[r]; }
        *(u32x4*)(tok_er + (size_t)(tokb + tid) * 4) = er; *(f32x4*)(tok_g + (size_t)(tokb + tid) * 4) = gt;
    }
    __syncthreads();
    for (int rc_ = 0; rc_ < RTR_REP_C; ++rc_)
#pragma unroll 2
    for (int tt = 0; tt < 8; ++tt) {
        const int tl = w * 8 + tt; const float* xrow = x + (size_t)(tokb + tl) * DM;
        f32x4 hv[4]; float s = 0.f;
#pragma unroll
        for (int j = 0; j < 4; ++j) { hv[j] = ((const f32x4*)xrow + lane)[64 * j]; s += (hv[j].x * hv[j].x + hv[j].y * hv[j].y) + (hv[j].z * hv[j].z + hv[j].w * hv[j].w); }
        const float rstd = 1.0f / sqrtf(wave_sum(s) * (1.f / DM) + EPS);
        unsigned wv[4];
#pragma unroll
        for (int j = 0; j < 4; ++j) { const f32x4 t = hv[j] * rstd * gg[j]; wv[j] = pk4_fp8(t.x, t.y, t.z, t.w); }
#pragma unroll
        for (int r = 0; r < 4; ++r) { const unsigned er = ers[tl * 4 + r]; const size_t slot = (size_t)(er >> 16) * ECAP + (er & 0xffffu);
            unsigned* o4 = (unsigned*)(XG + slot * DM) + lane;
#pragma unroll
            for (int j = 0; j < 4; ++j) o4[64 * j] = wv[j]; }
    }
    __syncthreads();
    }
}

__device__ __forceinline__ void combine_phase(Frame& F, const float* x, float* xout, const unsigned* tok_er, const float* tok_g, const bf16_t* Y, const float* g_next, unsigned char* XN, bool xn_fp8) {
    int tid_ = threadIdx.x; asm volatile("" : "+v"(tid_));
    const int gw = F.vcu * NWAVES + __builtin_amdgcn_readfirstlane(tid_ >> 6), NGW = F.G * NWAVES, lane = tid_ & 63;
    for (int m = gw; m < M; m += NGW) {
        const u32x4 er = *(const u32x4*)(tok_er + (size_t)m * 4); const f32x4 gt = *(const f32x4*)(tok_g + (size_t)m * 4);
        f32x4 v[4]; const float* xrow = x + (size_t)m * DM; float* xorow = xout + (size_t)m * DM;
#pragma unroll
        for (int j = 0; j < 4; ++j) v[j] = ((const f32x4*)xrow + lane)[64 * j];
#pragma unroll
        for (int r = 0; r < 4; ++r) { const size_t slot = (size_t)(er[r] >> 16) * ECAP + (er[r] & 0xffffu); const u32x2* yp = (const u32x2*)(Y + slot * DM) + lane; const float g = gt[r];
#pragma unroll
            for (int j = 0; j < 4; ++j) { const u32x2 yv = yp[64 * j]; v[j].x += g * bflo(yv.x); v[j].y += g * bfhi(yv.x); v[j].z += g * bflo(yv.y); v[j].w += g * bfhi(yv.y); } }
#pragma unroll
        for (int j = 0; j < 4; ++j) ((f32x4*)xorow + lane)[64 * j] = v[j];
        if (g_next) {
            float s = 0.f;
#pragma unroll
            for (int j = 0; j < 4; ++j) s += (v[j].x * v[j].x + v[j].y * v[j].y) + (v[j].z * v[j].z + v[j].w * v[j].w);
            const float rstd = 1.0f / sqrtf(wave_sum(s) * (1.f / DM) + EPS);
            unsigned* o4 = (unsigned*)(XN + (size_t)m * DM) + lane; u32x2* o8 = (u32x2*)(XN + (size_t)m * DM * 2) + lane;
#pragma unroll
            for (int j = 0; j < 4; ++j) { const f32x4 gg = ((const f32x4*)g_next + lane)[64 * j];
                if (xn_fp8) o4[64 * j] = pk4_fp8(v[j].x * rstd * gg.x, v[j].y * rstd * gg.y, v[j].z * rstd * gg.z, v[j].w * rstd * gg.w);
                else { u32x2 w; w.x = cvt_pk_bf16(v[j].x * rstd * gg.x, v[j].y * rstd * gg.y); w.y = cvt_pk_bf16(v[j].z * rstd * gg.z, v[j].w * rstd * gg.w); o8[64 * j] = w; } }
        }
    }
}

__device__ __forceinline__ void unpack8(const u32x4 w, float (&f)[8]) { f[0] = bflo(w.x); f[1] = bfhi(w.x); f[2] = bflo(w.y); f[3] = bfhi(w.y); f[4] = bflo(w.z); f[5] = bfhi(w.z); f[6] = bflo(w.w); f[7] = bfhi(w.w); }
__device__ __forceinline__ void unpack4(const u32x2 w, float (&f)[4]) { f[0] = bflo(w.x); f[1] = bfhi(w.x); f[2] = bflo(w.y); f[3] = bfhi(w.y); }
__device__ __forceinline__ void fin_head(const u32x4 n0, const u32x4 n1, const u32x2 r1, const u32x2 r2, const float (&g)[24], const float (&cs)[4], const float (&sn)[4], float sc, bf16_t* op, int j) {
    float a[8], b[8], x1[4], x2[4];
    unpack8(n0, a); unpack8(n1, b); unpack4(r1, x1); unpack4(r2, x2);
    float ss = 0.f;
#pragma unroll
    for (int i = 0; i < 8; ++i) ss += a[i] * a[i] + b[i] * b[i];
#pragma unroll
    for (int i = 0; i < 4; ++i) ss += x1[i] * x1[i] + x2[i] * x2[i];
    ss += __shfl_xor(ss, 1); ss += __shfl_xor(ss, 2); ss += __shfl_xor(ss, 4);
    const float rstd = sc / sqrtf(ss * (1.0f / 192.0f) + EPS);
    u32x4 o0, o1; u32x2 q1, q2;
    o0.x = cvt_pk_bf16(a[0] * rstd * g[0], a[1] * rstd * g[1]); o0.y = cvt_pk_bf16(a[2] * rstd * g[2], a[3] * rstd * g[3]);
    o0.z = cvt_pk_bf16(a[4] * rstd * g[4], a[5] * rstd * g[5]); o0.w = cvt_pk_bf16(a[6] * rstd * g[6], a[7] * rstd * g[7]);
    o1.x = cvt_pk_bf16(b[0] * rstd * g[8], b[1] * rstd * g[9]); o1.y = cvt_pk_bf16(b[2] * rstd * g[10], b[3] * rstd * g[11]);
    o1.z = cvt_pk_bf16(b[4] * rstd * g[12], b[5] * rstd * g[13]); o1.w = cvt_pk_bf16(b[6] * rstd * g[14], b[7] * rstd * g[15]);
    float y1[4], y2[4];
#pragma unroll
    for (int i = 0; i < 4; ++i) { const float u = x1[i] * rstd * g[16 + i], v = x2[i] * rstd * g[20 + i]; y1[i] = u * cs[i] - v * sn[i]; y2[i] = u * sn[i] + v * cs[i]; }
    q1.x = cvt_pk_bf16(y1[0], y1[1]); q1.y = cvt_pk_bf16(y1[2], y1[3]); q2.x = cvt_pk_bf16(y2[0], y2[1]); q2.y = cvt_pk_bf16(y2[2], y2[3]);
    *(u32x4*)(op + 16 * j) = o0; *(u32x4*)(op + 16 * j + 8) = o1; *(u32x2*)(op + 128 + 4 * j) = q1; *(u32x2*)(op + 160 + 4 * j) = q2;
}
__device__ __forceinline__ void mla_finalize_phase(Frame& F, const bf16_t* QR, const bf16_t* KVR, const bf16_t* Z, const float* gq, const float* gk, bf16_t* QF, bf16_t* KF) {
    int tid_ = threadIdx.x; asm volatile("" : "+v"(tid_));
    const int gw = F.vcu * NWAVES + __builtin_amdgcn_readfirstlane(tid_ >> 6), NGW = F.G * NWAVES, lane = tid_ & 63;
    const int h = lane >> 3, j = lane & 7;
    float gqv[24], gkv[24], invf[4];
#pragma unroll
    for (int i = 0; i < 16; ++i) { gqv[i] = gq[16 * j + i]; gkv[i] = gk[16 * j + i]; }
#pragma unroll
    for (int i = 0; i < 4; ++i) { gqv[16 + i] = gq[128 + 4 * j + i]; gqv[20 + i] = gq[160 + 4 * j + i]; gkv[16 + i] = gk[128 + 4 * j + i]; gkv[20 + i] = gk[160 + 4 * j + i];
        invf[i] = __builtin_amdgcn_exp2f(-(float)(4 * j + i) * (13.287712379549449f / 32.0f)); }
#pragma unroll 2
    for (int m = gw; m < M; m += NGW) {
        const int pos = m & (SEQ - 1);
        float cs[4], sn[4];
#pragma unroll
        for (int i = 0; i < 4; ++i) { const double rev = (double)pos * (double)invf[i] * 0.15915494309189535; const float fr = (float)(rev - __builtin_rint(rev));
            sn[i] = __builtin_amdgcn_sinf(fr); cs[i] = __builtin_amdgcn_cosf(fr); }
        const bf16_t* qp = QR + (size_t)m * 1536 + h * 192; const bf16_t* kp = KVR + (size_t)m * 2048 + h * 256; const bf16_t* zp = Z + (size_t)m * ODD_INP + 768;
        const u32x4 qn0 = *(const u32x4*)(qp + 16 * j), qn1 = *(const u32x4*)(qp + 16 * j + 8); const u32x2 qr1 = *(const u32x2*)(qp + 128 + 4 * j), qr2 = *(const u32x2*)(qp + 160 + 4 * j);
        const u32x4 kn0 = *(const u32x4*)(kp + 16 * j), kn1 = *(const u32x4*)(kp + 16 * j + 8); const u32x2 kr1 = *(const u32x2*)(zp + 4 * j), kr2 = *(const u32x2*)(zp + 32 + 4 * j);
        fin_head(qn0, qn1, qr1, qr2, gqv, cs, sn, C2_C, QF + (size_t)m * 1536 + h * 192, j);
        fin_head(kn0, kn1, kr1, kr2, gkv, cs, sn, 1.0f, KF + (size_t)m * 1536 + h * 192, j);
    }
}

#ifndef PHMASK
#define PHMASK 0xFFFF
#endif
#ifndef REPMASK
#define REPMASK 0
#endif
#ifndef REPCNT
#define REPCNT 3
#endif
#define NREP(k) ((((REPMASK) >> (k)) & 1) ? (REPCNT) : 1)

#define LAUNDER_S(x) asm volatile("" : "+s"(x))
__device__ __forceinline__ const float* in_ptr(const Args& a, int i) { LAUNDER_S(i); return a.in[i]; }
#define PHASE_BEGIN() unsigned wso_ = 0u; LAUNDER_S(wso_); unsigned char* ws = args.ws + wso_; Frame Fp = F; Fp.vcu = __builtin_amdgcn_readfirstlane(Fp.vcu); Fp.G = __builtin_amdgcn_readfirstlane(Fp.G); LAUNDER_S(Fp.vcu); LAUNDER_S(Fp.G); \
    int bx_ = __builtin_amdgcn_readfirstlane((int)blockIdx.x); LAUNDER_S(bx_); (void)bx_; (void)ws
#define XN  ((unsigned char*)(ws + WS_XN))
#define Z   ((bf16_t*)(ws + WS_Z))
#define MIX ((bf16_t*)(ws + WS_MIX))
#define QR  ((bf16_t*)(ws + WS_QR))
#define KVR ((bf16_t*)(ws + WS_KVR))
#define QF  ((bf16_t*)(ws + WS_QF))
#define KF  ((bf16_t*)(ws + WS_KF))
#define XG  ((unsigned char*)(ws + WS_XG))
#define ACT ((unsigned char*)(ws + WS_ACT))
#define YB  ((bf16_t*)(ws + WS_Y))
#define SSQ ((float*)(ws + WS_SSQ))
#define TOKER ((unsigned*)(ws + WS_TOKER))
#define TOKG ((float*)(ws + WS_TOKG))
#define B1P ((float*)(ws + WS_B1P))
#define IN(i) in_ptr(args, (i))
__global__ void __launch_bounds__(NWAVES * 64, 2) trunk_fwd(Args args) {
    extern __shared__ __attribute__((aligned(16))) unsigned char lds_raw[];
    Frame F;
    F.lds = (LAS unsigned char*)lds_raw;
    F.G = gridDim.x; { const int bx = blockIdx.x; F.vcu = (F.G % 8 == 0) ? (bx % 8) * (F.G / 8) + bx / 8 : bx; }
    for (int u = threadIdx.x; u < (SCR_OFF - LDSCTL_OFF) / 4; u += NWAVES * 64) ((LAS unsigned*)(F.lds + LDSCTL_OFF))[u] = 0u;
    __syncthreads();
    (void)xcd_barrier_post((unsigned*)((gu32*)(args.ws + WS_CTL) + CW_BAR), (volatile LAS unsigned*)(F.lds + MISC_OFF) + 8);
#define GRID_BAR() do { unsigned wsb_ = 0u; LAUNDER_S(wsb_); XcdBarrier bar_; bar_.bar = (unsigned*)((gu32*)(args.ws + wsb_ + WS_CTL) + CW_BAR); bar_.x = xb_xcc_id(); \
        bar_.st = (volatile LAS unsigned*)(F.lds + MISC_OFF) + 8; xcd_barrier(bar_); } while (0)
    float* const X = args.out;
    const int stage_limit = args.stage_limit;

#if (PHMASK >> 0) & 1
            _Pragma("unroll") for (int rep_ = 0; rep_ < NREP(0); ++rep_) { if (rep_) GRID_BAR();
    {   PHASE_BEGIN(); const int ptid = threadIdx.x, gw = Fp.vcu * NWAVES + __builtin_amdgcn_readfirstlane(ptid >> 6), NGW = Fp.G * NWAVES;
        transpose_job<1>(Fp, IN(I_EWIN), DM, EVEN_IN, 2, (size_t)DM * EVEN_IN, (bf16_t*)(ws + WS_WEIN), (size_t)EVEN_IN * DM, nullptr, 0);
        transpose_job<0>(Fp, IN(I_EWOUT), DM, DM, 2, (size_t)DM * DM, (bf16_t*)(ws + WS_WEOUT), (size_t)DM * DM, nullptr, 0);
        transpose_job_fp8<0>(Fp, IN(I_OWIN), DM, ODD_IN, 2, (size_t)DM * ODD_IN, ws + WS_WOIN, (size_t)ODD_INP * DM);
        transpose_job<0>(Fp, IN(I_OWUQ), 512, 1536, 2, (size_t)512 * 1536, (bf16_t*)(ws + WS_WUQ), (size_t)1536 * 512, IN(I_OGCQ), 512);
        transpose_job<0>(Fp, IN(I_OWUKV), 256, 2048, 2, (size_t)256 * 2048, (bf16_t*)(ws + WS_WUKV), (size_t)2048 * 256, IN(I_OGCKV), 256);
        transpose_job<0>(Fp, IN(I_OWOUT), DM, DM, 2, (size_t)DM * DM, (bf16_t*)(ws + WS_WOOUT), (size_t)DM * DM, nullptr, 0);
        transpose_job_fp8<2>(Fp, IN(I_W1), DM, 2 * DE, DEPTH * NE, (size_t)DM * 2 * DE, ws + WS_W1, (size_t)2 * DE * DM);
        transpose_job_fp8<0>(Fp, IN(I_W2), DE, DM, DEPTH * NE, (size_t)DE * DM, ws + WS_W2, (size_t)DM * DE);
        for (int i = bx_ * 512 + ptid; i < 2 * 12288; i += Fp.G * 512) { const int mi = i / 12288, r = i % 12288;
            *(u32x4*)(ws + WS_WOIN + (size_t)mi * ODD_INP * DM + (size_t)ODD_IN * DM + (size_t)r * 16) = (u32x4){0u, 0u, 0u, 0u}; }
        for (int i = bx_ * 512 + ptid; i < DEPTH * NE * 2048; i += Fp.G * 512) { const int c = i & 2047, o = 2 * (128 * (c >> 8) + (c & 127)) + ((c >> 7) & 1);
            B1P[i] = IN(I_B1)[(size_t)(i & ~2047) + o]; }
        for (int m = gw; m < M; m += NGW) rms_row_to_bf16(ptid & 63, IN(I_X) + (size_t)m * DM, IN(I_MIXN), (bf16_t*)XN + (size_t)m * DM, X + (size_t)m * DM);
    }
            }
#endif
    GRID_BAR();

#ifdef EXTRA_BARS
    for (int xb_ = 0; xb_ < EXTRA_BARS; ++xb_) GRID_BAR();
#endif
    for (int l = 0; l < DEPTH; ++l) {
        const int li = l >> 1;
        if (2 * l + 1 > stage_limit) break;
        if ((l & 1) == 0) {
#if (PHMASK >> 1) & 1
            _Pragma("unroll") for (int rep_ = 0; rep_ < NREP(1); ++rep_) { if (rep_) GRID_BAR();
            {   PHASE_BEGIN(); pg8::Gemm g{(const bf16_t*)XN, (const bf16_t*)(ws + WS_WEIN) + (size_t)li * EVEN_IN * DM, DM, DM, nullptr, nullptr}; pg8::StaticOrder S; S.init(M, EVEN_IN, Fp.G, bx_);
                pg8::EpiEvenIn E{Z, IN(I_EGQ) + li * 64, IN(I_EGK) + li * 64};
                pg8::gemm_phase<pg8::EpiEvenIn, pg8::StaticOrder>(Fp.lds + RING_OFF, g, S, E); }
            }
#endif
            GRID_BAR();
            {   PHASE_BEGIN();
#if (PHMASK >> 2) & 1
            _Pragma("unroll") for (int rep_ = 0; rep_ < NREP(2); ++rep_) { if (rep_) GRID_BAR();
                for (int u = Fp.vcu; u < 512; u += Fp.G)
                    gmlp_unit(Fp, Z, MIX, IN(I_EWS) + (size_t)li * 4 * 128 * 128, IN(I_EBS) + li * 512, IN(I_EGV) + li * 512, u);
            }
#endif
#if (PHMASK >> 3) & 1
            _Pragma("unroll") for (int rep_ = 0; rep_ < NREP(3); ++rep_) { if (rep_) GRID_BAR();
                for (int u = Fp.vcu; u < 256; u += Fp.G) { const int bh = u >> 4, s = u & 15, b = bh >> 3, h = bh & 7;
                    for (int pass = 0; pass < 2; ++pass) { const int qb = pass ? 31 - s : s;
                        const bf16_t* zb = Z + (size_t)b * SEQ * EVEN_IN;
                        dil::unit(zb + 1024 + 64 * h, zb + 1536 + 64 * h, zb + 2048 + 64 * h, EVEN_IN, MIX + (size_t)b * SEQ * DM + 512 + 64 * h, DM, qb * 256, Fp.lds + RING_OFF, (LAS float*)(Fp.lds + SCR_OFF)); } }
            }
#endif
            }
            GRID_BAR();
#if (PHMASK >> 4) & 1
            _Pragma("unroll") for (int rep_ = 0; rep_ < NREP(4); ++rep_) { if (rep_) GRID_BAR();
            {   PHASE_BEGIN(); pg8::Gemm g{MIX, (const bf16_t*)(ws + WS_WEOUT) + (size_t)li * DM * DM, DM, DM, nullptr, nullptr}; pg8::StaticOrder S; S.init(M, DM, Fp.G, bx_);
                pg8::EpiResid E{X};
                pg8::gemm_phase<pg8::EpiResid, pg8::StaticOrder>(Fp.lds + RING_OFF, g, S, E); }
            }
#endif
            GRID_BAR();
        } else {
#if (PHMASK >> 5) & 1
            _Pragma("unroll") for (int rep_ = 0; rep_ < NREP(5); ++rep_) { if (rep_) GRID_BAR();
            {   PHASE_BEGIN(); pg8::Gemm g{(const bf16_t*)XN, (const bf16_t*)(ws + WS_WOIN + (size_t)li * ODD_INP * DM), DM / 2, DM / 2, nullptr, nullptr}; pg8::StaticOrder S; S.init(M, ODD_INP, Fp.G, bx_);
                pg8::EpiOddIn E{Z, SSQ};
                pg8::gemm_phase<pg8::EpiOddIn, pg8::StaticOrder, true>(Fp.lds + RING_OFF, g, S, E); }
            }
#endif
            GRID_BAR();
#if (PHMASK >> 6) & 1
            _Pragma("unroll") for (int rep_ = 0; rep_ < NREP(6); ++rep_) { if (rep_) GRID_BAR();
            {   PHASE_BEGIN(); pg8::Gemm g{Z + 512, (const bf16_t*)(ws + WS_WUKV) + (size_t)li * 2048 * 256, ODD_INP, 256, nullptr, nullptr}; pg8::StaticOrder S; S.init(M, 2048, Fp.G, bx_);
                pg8::EpiRowScale<1> E{KVR, 2048, SSQ, 8, 1.0f / 256.0f};
                pg8::gemm_phase<pg8::EpiRowScale<1>, pg8::StaticOrder>(Fp.lds + RING_OFF, g, S, E); }
            {   PHASE_BEGIN(); pg8::Gemm g{Z, (const bf16_t*)(ws + WS_WUQ) + (size_t)li * 1536 * 512, ODD_INP, 512, nullptr, nullptr}; pg8::StaticOrder S; S.init(M, 1536, Fp.G, bx_);
                pg8::EpiRowScale<2> E{QR, 1536, SSQ, 0, 1.0f / 512.0f};
                pg8::gemm_phase<pg8::EpiRowScale<2>, pg8::StaticOrder>(Fp.lds + RING_OFF, g, S, E); }
            }
#endif
            GRID_BAR();
#if (PHMASK >> 7) & 1
            _Pragma("unroll") for (int rep_ = 0; rep_ < NREP(7); ++rep_) { if (rep_) GRID_BAR();
            {   PHASE_BEGIN(); mla_finalize_phase(Fp, QR, KVR, Z, IN(I_OGQ) + li * 192, IN(I_OGK) + li * 192, QF, KF); }
            }
#endif
            GRID_BAR();
#if (PHMASK >> 8) & 1
            _Pragma("unroll") for (int rep_ = 0; rep_ < NREP(8); ++rep_) { if (rep_) GRID_BAR();
            {   PHASE_BEGIN();
                for (int u = Fp.vcu; u < 256; u += Fp.G) { const int bh = u >> 4, s = u & 15, b = bh >> 3, h = bh & 7;
                    for (int pass = 0; pass < 2; ++pass) { const int qb = pass ? 31 - s : s;
                        att::attn_unit<192, 128, 0>(QF + (size_t)b * SEQ * 1536 + 192 * h, 1536, KF + (size_t)b * SEQ * 1536 + 192 * h, 1536, KVR + (size_t)b * SEQ * 2048 + 256 * h + 128, 2048,
                                                    MIX + (size_t)b * SEQ * DM + 128 * h, DM, qb * 256, Fp.lds + RING_OFF); } }
            }
            }
#endif
            GRID_BAR();
#if (PHMASK >> 9) & 1
            _Pragma("unroll") for (int rep_ = 0; rep_ < NREP(9); ++rep_) { if (rep_) GRID_BAR();
            {   PHASE_BEGIN(); pg8::Gemm g{MIX, (const bf16_t*)(ws + WS_WOOUT) + (size_t)li * DM * DM, DM, DM, nullptr, nullptr}; pg8::StaticOrder S; S.init(M, DM, Fp.G, bx_);
                pg8::EpiResid E{X};
                pg8::gemm_phase<pg8::EpiResid, pg8::StaticOrder>(Fp.lds + RING_OFF, g, S, E); }
            }
#endif
            GRID_BAR();
        }
        if (2 * l + 2 > stage_limit) break;
#if (PHMASK >> 10) & 1
            _Pragma("unroll") for (int rep_ = 0; rep_ < NREP(10); ++rep_) {
        {   PHASE_BEGIN(); const bool dry = rep_ + 1 < NREP(10);
            gu32* cnt = (gu32*)(ws + WS_CTL) + CW_CNT + (size_t)(dry ? 8 + 4 * rep_ + l : l) * 32 * 64;
        router_phase(Fp, X, IN(I_FFNN) + l * DM, IN(I_RW) + (size_t)l * DM * NE, IN(I_RB) + l * NE, cnt, dry ? (unsigned*)(ws + WS_QR) : TOKER, dry ? (float*)(ws + WS_QR + MiB) : TOKG, dry ? ACT : XG); }
        GRID_BAR();
            }
#endif
        LAS int* tbl = (LAS int*)(F.lds + SCR_OFF + 12288);
        {   PHASE_BEGIN(); gu32* cnt = (gu32*)(ws + WS_CTL) + CW_CNT + (size_t)l * 32 * 64;
        if (threadIdx.x == 0) { int acc = 0; for (int e = 0; e < NE; ++e) { tbl[e] = acc; const unsigned c = __hip_atomic_load(cnt + 64 * e, RLX_AGENT); acc += (int)((c + 255u) >> 8); } tbl[NE] = acc; }
        __syncthreads(); }
#if (PHMASK >> 11) & 1
            _Pragma("unroll") for (int rep_ = 0; rep_ < NREP(11); ++rep_) { if (rep_) GRID_BAR();
        {   PHASE_BEGIN();
            pg8::Gemm g{(const bf16_t*)XG, (const bf16_t*)(ws + WS_W1 + (size_t)l * NE * 2 * DE * DM), DM / 2, DM / 2, (const bf16_t*)ACT, (const bf16_t*)(ws + WS_W2 + (size_t)l * NE * DM * DE)};
            pg8::MoeMergedOrder S{tbl, Fp.G, Fp.vcu, (gu32*)(ws + WS_CTL) + CW_MOE + (size_t)(l * 320 + 1280 * rep_) * 16, -1};
            pg8::EpiMoe E{{ACT, B1P + (size_t)l * NE * 2048}, {YB, IN(I_B2) + (size_t)l * NE * DM}};
            pg8::gemm_phase<pg8::EpiMoe, pg8::MoeMergedOrder, true>(Fp.lds + RING_OFF, g, S, E); }
            }
#endif
        GRID_BAR();
#if (PHMASK >> 13) & 1
            _Pragma("unroll") for (int rep_ = 0; rep_ < NREP(13); ++rep_) {
        {   PHASE_BEGIN(); const bool dry = rep_ + 1 < NREP(13);
            combine_phase(Fp, X, dry ? (float*)ACT : X, TOKER, TOKG, YB, (l + 1 < DEPTH) ? IN(I_MIXN) + (l + 1) * DM : nullptr, dry ? (ACT + (size_t)64 * MiB) : XN, (l & 1) == 0); }
        GRID_BAR();
            }
#endif
    }
#undef GRID_BAR
}

extern "C" void kernel_launch(void* const* d_in, const int* in_sizes, int n_in, void* d_out, int out_size, void* d_ws, size_t ws_size, hipStream_t stream) {
    static int grid = 0;
    if (grid == 0) {
        if (n_in != 24 || in_sizes[0] != M * DM || out_size != M * DM || ws_size < WS_END) {
            fprintf(stderr, "kernel_launch: unexpected shapes (n_in %d, in0 %d, out %d, ws %zu, need %zu)\n", n_in, n_in > 0 ? in_sizes[0] : -1, out_size, ws_size, (size_t)WS_END); grid = -1; return; }
        int dev = 0, cus = 0, per_cu = 0;
        if (hipGetDevice(&dev) != hipSuccess || hipDeviceGetAttribute(&cus, hipDeviceAttributeMultiprocessorCount, dev) != hipSuccess) { grid = -1; return; }
        if (hipFuncSetAttribute((const void*)trunk_fwd, hipFuncAttributeMaxDynamicSharedMemorySize, LDS_BYTES) != hipSuccess) { fprintf(stderr, "kernel_launch: hipFuncSetAttribute failed\n"); grid = -1; return; }
        if (hipOccupancyMaxActiveBlocksPerMultiprocessor(&per_cu, (const void*)trunk_fwd, NWAVES * 64, LDS_BYTES) != hipSuccess || per_cu < 1)
            fprintf(stderr, "kernel_launch: occupancy query reports %d workgroups per CU\n", per_cu);
        (void)hipGetLastError();
        if (cus < 256) { fprintf(stderr, "kernel_launch: needs 256 CUs, device has %d\n", cus); grid = -1; return; }
        grid = 256;
    }
    if (grid < 0) return;
    if (hipMemsetAsync((char*)d_ws + WS_CTL, 0, CTL_ZERO_BYTES, stream) != hipSuccess) return;
    Args a{};
    for (int i = 0; i < 24; ++i) a.in[i] = (const float*)d_in[i];
    a.out = (float*)d_out; a.ws = (unsigned char*)d_ws; a.stage_limit = STAGE_LIMIT; a.pad = 0;
    hipLaunchKernelGGL(trunk_fwd, dim3(grid), dim3(NWAVES * 64), LDS_BYTES, stream, a);
}
```

```cpp
#include <hip/hip_runtime.h>
#include <hip/hip_bf16.h>
#include <cstdio>
#include <cstdint>

#define LAS __attribute__((address_space(3)))
#define GAS __attribute__((address_space(1)))
typedef unsigned short bf16_t;
typedef short bf16x8 __attribute__((ext_vector_type(8)));
typedef short s16x4 __attribute__((ext_vector_type(4)));
typedef float f32x2 __attribute__((ext_vector_type(2)));
typedef float f32x4 __attribute__((ext_vector_type(4)));
typedef float f32x16 __attribute__((ext_vector_type(16)));
typedef unsigned u32x2 __attribute__((ext_vector_type(2)));
typedef unsigned u32x4 __attribute__((ext_vector_type(4)));
typedef int i32x4 __attribute__((ext_vector_type(4)));
typedef int i32x8 __attribute__((ext_vector_type(8)));

constexpr int BATCH = 2, SEQ = 8192, DM = 1024, M = BATCH * SEQ, DEPTH = 4;
constexpr int EVEN_IN = 2560, ODD_IN = 832, ODD_INP = 1024;
constexpr int NE = 32, DE = 1024, ECAP = 16384;
constexpr float EPS = 1e-6f;
constexpr float LOG2E = 1.4426950408889634f;
constexpr float C2_B = 0.125f * LOG2E;
constexpr float C2_C = 0.07216878364870322f * LOG2E;

__device__ __forceinline__ unsigned cvt_pk_bf16(float lo, float hi) { unsigned r; asm volatile("v_cvt_pk_bf16_f32 %0, %1, %2" : "=v"(r) : "v"(lo), "v"(hi)); return r; }
__device__ __forceinline__ float bf2f(bf16_t v) { return __uint_as_float(((unsigned)v) << 16); }
__device__ __forceinline__ float bflo(unsigned w) { return __uint_as_float(w << 16); }
__device__ __forceinline__ float bfhi(unsigned w) { return __uint_as_float(w & 0xffff0000u); }
__device__ __forceinline__ bf16_t f2bf(float f) { return (bf16_t)(cvt_pk_bf16(f, 0.f) & 0xffffu); }

__device__ __forceinline__ unsigned pk4_fp8(float a, float b, float c, float d) { int w = 0; w = __builtin_amdgcn_cvt_pk_fp8_f32(a, b, w, false); w = __builtin_amdgcn_cvt_pk_fp8_f32(c, d, w, true); return (unsigned)w; }
constexpr float W8_SCALE = 64.0f, W8_INV = 1.0f / 64.0f;

namespace pg8 {
constexpr int BM = 256, BK = 64, HALF = 128, HTB = HALF * BK * 2, STAGE_BYTES = 8 * HTB, NXCD = 8, WGM = 8;
__host__ __device__ __forceinline__ int lds_byte(int r, int c) { const int st = (r >> 4) * 2 + (c >> 5), rr = r & 15, cc = c & 31, ob = rr * 64 + cc * 2; return st * 1024 + (ob ^ (((ob >> 9) & 1) << 5)); }
__host__ __device__ __forceinline__ void stage_rc(int b, int& R, int& C) { const int st = b / 1024, sb = b % 1024, swz = sb ^ (((sb >> 9) & 1) << 5); R = (st >> 1) * 16 + swz / 64; C = (st & 1) * 32 + (swz % 64) / 2; }
__host__ __device__ __forceinline__ int perm32(int rho) { const int n = rho >> 4, i = rho & 15; return 8 * (i >> 2) + 4 * n + (i & 3); }

struct Unit { int pm, pn, pb, kind, rb; };
struct Gemm { const bf16_t* A; const bf16_t* Bt; int lda, K; const bf16_t* A2; const bf16_t* Bt2; };

struct StaticOrder {
    int nM, nN, nwg, G, c;
    __device__ void init(int M_, int N_, int G_, int c_) { nM = M_ / BM; nN = N_ / BM; nwg = nM * nN; G = G_; c = c_; }
    __device__ bool next(int i, Unit& u) const {
        const long L = (long)i * G + c; if (L >= nwg) return false;
        int wgid = (int)L; { const int q = nwg / NXCD, r = nwg % NXCD, xcd = wgid % NXCD, off = wgid / NXCD; wgid = (xcd < r ? xcd * (q + 1) : r * (q + 1) + (xcd - r) * q) + off; }
        const int nig = WGM * nN, gid = wgid / nig, fm = gid * WGM, gsz = (nM - fm) < WGM ? (nM - fm) : WGM;
        u.pm = fm + ((wgid % nig) % gsz); u.pn = (wgid % nig) / gsz; u.pb = u.pn; u.kind = 0; u.rb = 0; return true;
    }
    __device__ __forceinline__ void a_ready(const Unit&) const {}
    __device__ __forceinline__ void pre_epi() const {}
    __device__ __forceinline__ void done(const Unit&) const {}
    __device__ __forceinline__ void finish() const {}
};

__device__ __forceinline__ f32x2 gelu_pk(f32x2 v) {
    const f32x2 av = __builtin_elementwise_abs(v), d = av * 0.2316418882f + 1.0f;
    f32x2 t; t.x = __builtin_amdgcn_rcpf(d.x); t.y = __builtin_amdgcn_rcpf(d.y);
    f32x2 q = t * 0.5307027145f + (-0.7265760135f); q = q * t + 0.7107068705f; q = q * t + (-0.142248368f); q = q * t + 0.127414796f; q = q * t;
    const f32x2 s = (v * v) * (-0.72134752044f);
    f32x2 e; e.x = __builtin_amdgcn_exp2f(s.x); e.y = __builtin_amdgcn_exp2f(s.y);
    const f32x2 m = v * (q * e), r = v - m;
    f32x2 o; o.x = v.x < 0.f ? m.x : r.x; o.y = v.y < 0.f ? m.y : r.y; return o;
}
__device__ __forceinline__ f32x4 gelu4(f32x4 v) { const f32x2 a = gelu_pk((f32x2){v[0], v[1]}), b = gelu_pk((f32x2){v[2], v[3]}); return (f32x4){a.x, a.y, b.x, b.y}; }

template <class Epi, class Sched, bool FP8 = false>
__device__ __forceinline__ void gemm_phase(LAS unsigned char* lds, const Gemm g, const Sched& S, const Epi& E) {
    int tid_ = threadIdx.x; asm volatile("" : "+v"(tid_));
    const int tid = tid_, wid = __builtin_amdgcn_readfirstlane(tid >> 6), lane = tid & 63, wr = wid >> 2, wc = wid & 3, fr = lane & 15, fq = lane >> 4;
    const int K = g.K, nt = K / BK;
    unsigned voffA[2], voffB[2];
#pragma unroll
    for (int i = 0; i < 2; ++i) { int R, C; stage_rc(tid * 16 + i * 8192, R, C); const int Rb = Epi::PERM ? ((R & ~31) + perm32(R & 31)) : R;
        voffA[i] = (unsigned)(R * g.lda + C) * 2u; voffB[i] = (unsigned)(Rb * K + C) * 2u; }
    const size_t kstep = (size_t)(BK * 2);
    const size_t hstepA = (size_t)HALF * g.lda * 2, tstepA = 2 * hstepA;
    const size_t hstepB = (size_t)HALF * K * 2, tstepB = 2 * hstepB;
    const unsigned ldsw = (unsigned)wid * 1024u;
    const int aoff = lds_byte(wr * 64 + fr, fq * 8), boff = lds_byte(wc * 32 + fr, fq * 8);
#define PG8_SA(b, h) (((b) * 2 + (h)) * HTB)
#define PG8_SB(b, h) ((4 + (b) * 2 + (h)) * HTB)
#define PG8_STAGE(bufoff, gbase, voff) do { _Pragma("unroll") for (int _i = 0; _i < 2; ++_i) \
        __builtin_amdgcn_global_load_lds((const unsigned*)((const char*)(gbase) + (voff)[_i]), (LAS unsigned*)(lds + (bufoff) + ldsw + _i * 8192), 16, 0, 0); } while (0)
#define PG8_LDA(dst, b, h) do { _Pragma("unroll") for (int m = 0; m < 4; ++m) { if constexpr (FP8) { const i32x4 lo_ = *(const LAS i32x4*)(lds + PG8_SA(b, h) + aoff + m * 2048), hi_ = *(const LAS i32x4*)(lds + PG8_SA(b, h) + aoff + m * 2048 + 1024); dst##8[m] = __builtin_shufflevector(lo_, hi_, 0, 1, 2, 3, 4, 5, 6, 7); } \
        else { _Pragma("unroll") for (int k = 0; k < 2; ++k) dst[m][k] = *(const LAS bf16x8*)(lds + PG8_SA(b, h) + aoff + m * 2048 + k * 1024); } } } while (0)
#define PG8_LDB(dst, b, h) do { _Pragma("unroll") for (int n = 0; n < 2; ++n) { if constexpr (FP8) { const i32x4 lo_ = *(const LAS i32x4*)(lds + PG8_SB(b, h) + boff + n * 2048), hi_ = *(const LAS i32x4*)(lds + PG8_SB(b, h) + boff + n * 2048 + 1024); dst##8[n] = __builtin_shufflevector(lo_, hi_, 0, 1, 2, 3, 4, 5, 6, 7); } \
        else { _Pragma("unroll") for (int k = 0; k < 2; ++k) dst[n][k] = *(const LAS bf16x8*)(lds + PG8_SB(b, h) + boff + n * 2048 + k * 1024); } } } while (0)
#define PG8_MMA(ai, bj, At, Bt) do { __builtin_amdgcn_s_setprio(1); _Pragma("unroll") for (int m = 0; m < 4; ++m) _Pragma("unroll") for (int n = 0; n < 2; ++n) { \
        if constexpr (FP8) asm volatile("s_nop 1\n\tv_mfma_f32_16x16x128_f8f6f4 %0, %1, %2, %0" : "+v"(acc[ai][bj][m][n]) : "v"(Bt##8[n]), "v"(At##8[m])); \
        else { _Pragma("unroll") for (int k = 0; k < 2; ++k) acc[ai][bj][m][n] = __builtin_amdgcn_mfma_f32_16x16x32_bf16(Bt[n][k], At[m][k], acc[ai][bj][m][n], 0, 0, 0); } } \
        __builtin_amdgcn_s_setprio(0); } while (0)
#define PG8_WAIT_V(n) asm volatile("s_waitcnt vmcnt(" #n ")" ::: "memory")
#define PG8_WAIT_L(n) asm volatile("s_waitcnt lgkmcnt(" #n ")" ::: "memory")
#define PG8_BAR __builtin_amdgcn_s_barrier()
#define PG8_SCHED __builtin_amdgcn_sched_barrier(0)
    Unit cur, nxt; int ui = 0;
    if (!S.next(0, cur)) return;
    f32x4 acc[2][2][4][2];
#pragma unroll
    for (int a = 0; a < 2; ++a)
#pragma unroll
        for (int b = 0; b < 2; ++b)
#pragma unroll
            for (int m = 0; m < 4; ++m)
#pragma unroll
                for (int n = 0; n < 2; ++n) acc[a][b][m][n] = (f32x4){0.f, 0.f, 0.f, 0.f};
    bf16x8 At[4][2], B0[2][2], B1[2][2]; i32x8 At8[4], B08[2], B18[2];
    const char* cA = (const char*)(cur.kind ? g.A2 : g.A) + (size_t)cur.pm * tstepA; const char* cB = (const char*)(cur.kind ? g.Bt2 : g.Bt) + (size_t)cur.pb * tstepB;
    S.a_ready(cur);
    PG8_STAGE(PG8_SB(0, 0), cB, voffB); PG8_STAGE(PG8_SB(0, 1), cB + hstepB, voffB); PG8_STAGE(PG8_SA(0, 0), cA, voffA); PG8_STAGE(PG8_SA(0, 1), cA + hstepA, voffA);
    if (wr == 1) PG8_BAR;
    PG8_WAIT_V(2); PG8_BAR;
    PG8_STAGE(PG8_SB(1, 0), cB + kstep, voffB); PG8_STAGE(PG8_SA(1, 0), cA + kstep, voffA); PG8_STAGE(PG8_SB(1, 1), cB + hstepB + kstep, voffB);
    PG8_WAIT_V(6); PG8_BAR;
    for (;;) {
        const bool has_next = S.next(ui + 1, nxt);
        const char* nA = has_next ? (const char*)(nxt.kind ? g.A2 : g.A) + (size_t)nxt.pm * tstepA : cA; const char* nB = has_next ? (const char*)(nxt.kind ? g.Bt2 : g.Bt) + (size_t)nxt.pb * tstepB : cB;
#pragma unroll 1
        for (int t = 0; t < nt; t += 2) {
            const bool last = (t == nt - 2);
            const char* a1 = cA + (size_t)(t + 1) * kstep;
            const char* a2 = last ? nA : cA + (size_t)(t + 2) * kstep; const char* b2 = last ? nB : cB + (size_t)(t + 2) * kstep;
            const char* a3 = a2 + kstep; const char* b3 = b2 + kstep;
            if (last && has_next) S.a_ready(nxt);
            PG8_LDB(B0, 0, 0); PG8_LDB(B1, 0, 1); PG8_SCHED; PG8_LDA(At, 0, 0); PG8_STAGE(PG8_SA(1, 1), a1 + hstepA, voffA);
            PG8_WAIT_V(8); PG8_WAIT_L(0); PG8_BAR; PG8_MMA(0, 0, At, B0); PG8_MMA(0, 1, At, B1); PG8_BAR; PG8_SCHED;
            PG8_LDA(At, 0, 1); PG8_STAGE(PG8_SB(0, 0), b2, voffB); PG8_STAGE(PG8_SB(0, 1), b2 + hstepB, voffB); PG8_STAGE(PG8_SA(0, 0), a2, voffA);
            PG8_WAIT_V(8); PG8_WAIT_L(0); PG8_BAR; PG8_MMA(1, 0, At, B0); PG8_MMA(1, 1, At, B1); PG8_BAR; PG8_SCHED;
            PG8_LDB(B0, 1, 0); PG8_LDB(B1, 1, 1); PG8_SCHED; PG8_LDA(At, 1, 0); PG8_STAGE(PG8_SA(0, 1), a2 + hstepA, voffA);
            PG8_WAIT_V(8); PG8_WAIT_L(0); PG8_BAR; PG8_MMA(0, 0, At, B0); PG8_MMA(0, 1, At, B1); PG8_BAR; PG8_SCHED;
            PG8_LDA(At, 1, 1); PG8_STAGE(PG8_SB(1, 0), b3, voffB); PG8_STAGE(PG8_SB(1, 1), b3 + hstepB, voffB); PG8_STAGE(PG8_SA(1, 0), a3, voffA);
            PG8_WAIT_V(8); PG8_WAIT_L(0); PG8_BAR; PG8_MMA(1, 0, At, B0); PG8_MMA(1, 1, At, B1); PG8_BAR; PG8_SCHED;
        }
        if (wr == 0) PG8_BAR;
        if constexpr (FP8) asm volatile("s_nop 15\n\ts_nop 7" ::: "memory");
        S.pre_epi();
        { int te_ = threadIdx.x; asm volatile("" : "+v"(te_));
          E(acc, cur, wr, wc, te_ & 15, (te_ & 63) >> 4); }
        S.done(cur);
        if (!has_next) break;
#pragma unroll
        for (int a = 0; a < 2; ++a)
#pragma unroll
            for (int b = 0; b < 2; ++b)
#pragma unroll
                for (int m = 0; m < 4; ++m)
#pragma unroll
                    for (int n = 0; n < 2; ++n) acc[a][b][m][n] = (f32x4){0.f, 0.f, 0.f, 0.f};
        cur = nxt; cA = nA; cB = nB; ++ui;
        if (wr == 1) PG8_BAR;
    }
    PG8_WAIT_V(0);
    S.finish();
    PG8_BAR;
#undef PG8_SA
#undef PG8_SB
#undef PG8_STAGE
#undef PG8_LDA
#undef PG8_LDB
#undef PG8_MMA
#undef PG8_WAIT_V
#undef PG8_WAIT_L
#undef PG8_BAR
#undef PG8_SCHED
}
}
constexpr int STAGE_LIMIT = 8;

namespace att {
__device__ __forceinline__ int crow(int r, int hi) { return (r & 3) + 8 * (r >> 2) + 4 * hi; }
__device__ __forceinline__ int v_rd_base(int lane) { return ((lane & 3) << 3) | (((lane >> 2) & 3) << 6) | (((lane >> 4) & 1) << 5) | (((lane >> 5) & 1) << 8); }
constexpr int LUTN = 2052;

template <int DQK, int DV, int MODE>
struct Cfg {
    static constexpr int KP = DQK * 2 + 16;
    static constexpr int KB = 64 * KP, VB = 64 * DV * 2;
    static constexpr int NBUF = 3;
    static constexpr int OFF_K = 0, OFF_V = NBUF * KB, OFF_WS = NBUF * (KB + VB), OFF_LUT = OFF_WS + 8 * 256, BYTES = OFF_LUT + (MODE == 1 ? LUTN * 4 : 0);
    static_assert(BYTES <= 131072, "attention LDS image fits the ring");
    static constexpr int CPR = KP / 16;
    static constexpr int NKP = KB / 1024, KPW = (NKP + 7) / 8;
    static constexpr int NVP = VB / 1024, VPW = NVP / 8;
    static_assert(KB % 1024 == 0 && NVP % 8 == 0, "tile images are whole DMA pieces");
};

template <int DQK, int DV, int MODE>
__device__ __forceinline__ void attn_unit(const bf16_t* __restrict__ Qh, int qp, const bf16_t* __restrict__ Kh, int kp, const bf16_t* __restrict__ Vh, int vp,
                                          bf16_t* __restrict__ Oh, int op, int q0, LAS unsigned char* lds) {
    typedef Cfg<DQK, DV, MODE> C;
    constexpr int NCB = DV / 32;
    int tid_ = threadIdx.x; asm volatile("" : "+v"(tid_));
    const int tid = tid_, wid = __builtin_amdgcn_readfirstlane(tid >> 6), lane = tid & 63, r32 = lane & 31, hi = lane >> 5;
    const int qlo = q0 + wid * 32, qpos = qlo + r32;
    LAS float* wsf = (LAS float*)(lds + C::OFF_WS) + wid * 64;
    const LAS float* lut = (const LAS float*)(lds + C::OFF_LUT);
    int j_lo = 0; if (MODE == 1) { const int lo = q0 - 2048; j_lo = lo > 0 ? lo / 64 : 0; }
    const int j_hi = (q0 + 256) / 64, NT = j_hi - j_lo;
    unsigned kso[C::KPW], vso[C::VPW];
#pragma unroll
    for (int i = 0; i < C::KPW; ++i) { const int c = (wid + 8 * i) * 64 + lane, row = c / C::CPR; int cc = c % C::CPR; if (cc > C::CPR - 2) cc = C::CPR - 2;
        kso[i] = (unsigned)((row & 63) * kp + cc * 8); }
#pragma unroll
    for (int i = 0; i < C::VPW; ++i) { const int off = ((wid + 8 * i) * 64 + lane) * 16, st = off >> 9, within = off & 511, kk = (st / NCB) * 8 + (within >> 6);
        const int k = (kk & ~0xC) | ((kk & 4) << 1) | ((kk & 8) >> 1), col = (st % NCB) * 32 + ((within & 63) >> 1);
        vso[i] = (unsigned)(k * vp + col); }
#define ATT_DMA(j, bf) do { const bf16_t* kt_ = Kh + (size_t)(j) * 64 * kp; const bf16_t* vt_ = Vh + (size_t)(j) * 64 * vp; \
        _Pragma("unroll") for (int i = 0; i < C::KPW; ++i) if (wid + 8 * i < C::NKP) \
            __builtin_amdgcn_global_load_lds((const unsigned*)(kt_ + kso[i]), (LAS unsigned*)(lds + C::OFF_K + (bf) * C::KB + (wid + 8 * i) * 1024), 16, 0, 0); \
        _Pragma("unroll") for (int i = 0; i < C::VPW; ++i) \
            __builtin_amdgcn_global_load_lds((const unsigned*)(vt_ + vso[i]), (LAS unsigned*)(lds + C::OFF_V + (bf) * C::VB + (wid + 8 * i) * 1024), 16, 0, 0); } while (0)
    ATT_DMA(j_lo, 0);
    if (NT > 1) ATT_DMA(j_lo + 1, 1);
    bf16x8 qr[DQK / 16];
#pragma unroll
    for (int d0 = 0; d0 < DQK / 16; ++d0) qr[d0] = *(const bf16x8*)(Qh + (size_t)qpos * qp + d0 * 16 + hi * 8);
    float m_reg = -1e30f, l_reg = 0.f;
    f32x16 o[NCB];
#pragma unroll
    for (int d = 0; d < NCB; ++d) o[d] = f32x16{};
    const int koff = r32 * C::KP + hi * 16;
    const unsigned vb0 = (unsigned)(uintptr_t)(lds + C::OFF_V) + (unsigned)v_rd_base(lane);
    asm volatile("s_waitcnt vmcnt(0)" ::: "memory");
    __syncthreads();
    constexpr int ND = DQK / 16;
#define ATT_ACT(kb2_) ((kb2_) <= qlo + 31 && (MODE == 0 || (qlo - (kb2_) - 31 <= 2048)))
#define ATT_QK(P, bufi, hf_) do { const LAS unsigned char* kb_ = lds + C::OFF_K + (bufi) * C::KB + (hf_) * 32 * C::KP + koff; P = f32x16{}; \
        bf16x8 kw_[4]; _Pragma("unroll") for (int d0 = 0; d0 < 4; ++d0) kw_[d0] = *(const LAS bf16x8*)(kb_ + d0 * 32); \
        _Pragma("unroll") for (int d0 = 0; d0 < ND; ++d0) { P = __builtin_amdgcn_mfma_f32_32x32x16_bf16(kw_[d0 & 3], qr[d0], P, 0, 0, 0); \
            if (d0 + 4 < ND) kw_[d0 & 3] = *(const LAS bf16x8*)(kb_ + (d0 + 4) * 32); } } while (0)
#define ATT_PK4(P, B_, OUT) do { unsigned a0 = cvt_pk_bf16(P[B_+0], P[B_+1]), a1 = cvt_pk_bf16(P[B_+2], P[B_+3]);                          \
        unsigned b0_ = cvt_pk_bf16(P[B_+4], P[B_+5]), b1_ = cvt_pk_bf16(P[B_+6], P[B_+7]);                                             \
        auto r0 = __builtin_amdgcn_permlane32_swap(a0, b0_, false, false); auto r1 = __builtin_amdgcn_permlane32_swap(a1, b1_, false, false); \
        u32x4 w = {r0[0], r1[0], r0[1], r1[1]}; OUT = __builtin_bit_cast(bf16x8, w); } while (0)
#define ATT_VRD(d0) do { \
                asm volatile("ds_read_b64_tr_b16 %0, %1 offset:%2" : "=&v"(vl0[(d0) & (VG - 1)]) : "v"(vb), "i"((d0) * 512 + KO) : "memory"); \
                asm volatile("ds_read_b64_tr_b16 %0, %1 offset:%2" : "=&v"(vh0[(d0) & (VG - 1)]) : "v"(vb), "i"((d0) * 512 + KO + HF) : "memory"); \
                asm volatile("ds_read_b64_tr_b16 %0, %1 offset:%2" : "=&v"(vl1[(d0) & (VG - 1)]) : "v"(vb), "i"((d0) * 512 + KO + KS) : "memory"); \
                asm volatile("ds_read_b64_tr_b16 %0, %1 offset:%2" : "=&v"(vh1[(d0) & (VG - 1)]) : "v"(vb), "i"((d0) * 512 + KO + KS + HF) : "memory"); } while (0)
#define ATT_PVD(d0) do { const int g_ = (d0) & (VG - 1); \
                o[d0] = __builtin_amdgcn_mfma_f32_32x32x16_bf16(pa0, (bf16x8){vl0[g_][0], vl0[g_][1], vl0[g_][2], vl0[g_][3], vh0[g_][0], vh0[g_][1], vh0[g_][2], vh0[g_][3]}, o[d0], 0, 0, 0); \
                o[d0] = __builtin_amdgcn_mfma_f32_32x32x16_bf16(pa1, (bf16x8){vl1[g_][0], vl1[g_][1], vl1[g_][2], vl1[g_][3], vh1[g_][0], vh1[g_][1], vh1[g_][2], vh1[g_][3]}, o[d0], 0, 0, 0); } while (0)
#define ATT_SMPV(P, kb2, vbuf, hf) do { \
            const unsigned vb = vb0 + (unsigned)((vbuf) * C::VB); \
            constexpr int KS = NCB * 1024, HF = NCB * 512, KO = 2 * (hf) * KS, VG = 2;         \
            s16x4 vl0[VG], vh0[VG], vl1[VG], vh1[VG]; \
            ATT_VRD(0); ATT_VRD(1); \
            const int dq = qpos - (kb2) - 4 * hi; \
            if (MODE == 0) { if ((kb2) + 31 > qlo) { const float NEG = -__builtin_inff(); \
                    _Pragma("unroll") for (int r = 0; r < 16; ++r) { const int c = (r & 3) + 8 * (r >> 2); if (dq - c < 0) P[r] = NEG; } } } \
            else { _Pragma("unroll") for (int r = 0; r < 16; ++r) { const int c = (r & 3) + 8 * (r >> 2); unsigned i0 = (unsigned)(dq - c); i0 = i0 < 2049u ? i0 : 2049u; P[r] += lut[i0]; } } \
            float pmax = P[0]; \
            _Pragma("unroll") for (int r = 1; r < 16; ++r) pmax = fmaxf(pmax, P[r]); \
            { auto rr = __builtin_amdgcn_permlane32_swap(__float_as_uint(pmax), __float_as_uint(pmax), false, false); pmax = fmaxf(__uint_as_float(rr[0]), __uint_as_float(rr[1])); } \
            const float mn = fmaxf(m_reg, pmax); const float alpha = __builtin_amdgcn_exp2f(m_reg - mn); m_reg = mn; \
            float ps = 0.f; \
            _Pragma("unroll") for (int r = 0; r < 16; ++r) { P[r] = __builtin_amdgcn_exp2f(P[r] - mn); ps += P[r]; } \
            { auto rr = __builtin_amdgcn_permlane32_swap(__float_as_uint(ps), __float_as_uint(ps), false, false); ps = __uint_as_float(rr[0]) + __uint_as_float(rr[1]); } \
            l_reg = l_reg * alpha + ps; \
            bf16x8 pa0, pa1; ATT_PK4(P, 0, pa0); ATT_PK4(P, 8, pa1); \
            if (__any(alpha < 1.f)) { if (hi == 0) wsf[r32] = alpha; asm volatile("s_waitcnt lgkmcnt(0)" ::: "memory"); \
                _Pragma("unroll") for (int r = 0; r < 16; ++r) { const float a = wsf[crow(r, hi)]; _Pragma("unroll") for (int d = 0; d < NCB; ++d) o[d][r] *= a; } } \
            asm volatile("s_waitcnt lgkmcnt(0)" ::: "memory"); __builtin_amdgcn_sched_barrier(0);     \
            ATT_PVD(0); ATT_PVD(1); \
            if (NCB > 2) { __builtin_amdgcn_sched_barrier(0); ATT_VRD(2); ATT_VRD(3); asm volatile("s_waitcnt lgkmcnt(0)" ::: "memory"); __builtin_amdgcn_sched_barrier(0); ATT_PVD(2); ATT_PVD(3); } \
    } while (0)
    f32x16 pA, pB;
    int buf = 0;
    { const int kb0 = j_lo * 64; if (ATT_ACT(kb0)) ATT_QK(pA, 0, 0); }
    for (int t = 0; t < NT; ++t) {
        if (t + 2 < NT) { const int b2 = buf == 0 ? 2 : buf - 1; ATT_DMA(j_lo + t + 2, b2); }
        const int kb = (j_lo + t) * 64;
        const int nb = buf == 2 ? 0 : buf + 1;
        { const bool a0 = ATT_ACT(kb), a1 = ATT_ACT(kb + 32);
          if (a1) ATT_QK(pB, buf, 1);
          if (a0) ATT_SMPV(pA, kb, buf, 0);
          const bool a2 = (t + 1 < NT) && ATT_ACT(kb + 64);
          if (a2) ATT_QK(pA, nb, 0);
          if (a1) ATT_SMPV(pB, kb + 32, buf, 1); }
        asm volatile("s_waitcnt vmcnt(0)" ::: "memory");
        __syncthreads();
        buf = nb;
    }
#undef ATT_SMPV
#undef ATT_VRD
#undef ATT_PVD
#undef ATT_PK4
#undef ATT_QK
#undef ATT_ACT
#undef ATT_DMA
    if (hi == 0) wsf[32 + r32] = l_reg;
    asm volatile("s_waitcnt lgkmcnt(0)" ::: "memory");
    bf16_t* Ow = Oh + (size_t)qlo * op;
#pragma unroll
    for (int r = 0; r < 16; ++r) { const int orow = crow(r, hi); const float rl = __builtin_amdgcn_rcpf(wsf[32 + orow]);
#pragma unroll
        for (int d0 = 0; d0 < NCB; ++d0) { const float v = o[d0][r] * rl; const float vn = __shfl_xor(v, 1);
            if ((r32 & 1) == 0) *(unsigned*)(Ow + (size_t)orow * op + d0 * 32 + r32) = cvt_pk_bf16(v, vn); } }
    __syncthreads();
}
template <int DQK, int DV>
struct Cfg8 {
    static constexpr int KP = DQK + 16;
    static constexpr int KB = 64 * KP, VB = 64 * DV * 2;
    static constexpr int NBUF = 3;
    static constexpr int OFF_K = 0, OFF_V = NBUF * KB, OFF_WS = NBUF * (KB + VB), OFF_LUT = OFF_WS + 8 * 256, BYTES = OFF_LUT;
    static_assert(BYTES <= 131072, "attention LDS image fits the ring");
    static constexpr int CPR = KP / 16;
    static constexpr int NKP = KB / 1024, KPW = (NKP + 7) / 8;
    static constexpr int NVP = VB / 1024, VPW = NVP / 8;
    static_assert(KB % 1024 == 0 && NVP % 8 == 0, "tile images are whole DMA pieces");
};
template <int DQK, int DV, int MODE>
__device__ __forceinline__ void attn_unit8(const unsigned char* __restrict__ Qh, int qp, const unsigned char* __restrict__ Kh, int kp, const bf16_t* __restrict__ Vh, int vp,
                                          bf16_t* __restrict__ Oh, int op, int q0, LAS unsigned char* lds) {
    typedef Cfg8<DQK, DV> C; constexpr float SC = C2_C;
    constexpr int NCB = DV / 32;
    int tid_ = threadIdx.x; asm volatile("" : "+v"(tid_));
    const int tid = tid_, wid = __builtin_amdgcn_readfirstlane(tid >> 6), lane = tid & 63, r32 = lane & 31, hi = lane >> 5;
    const int qlo = q0 + wid * 32, qpos = qlo + r32;
    LAS float* wsf = (LAS float*)(lds + C::OFF_WS) + wid * 64;
    const LAS float* lut = (const LAS float*)(lds + C::OFF_LUT);
    int j_lo = 0; if (MODE == 1) { const int lo = q0 - 2048; j_lo = lo > 0 ? lo / 64 : 0; }
    const int j_hi = (q0 + 256) / 64, NT = j_hi - j_lo;
    unsigned kso[C::KPW], vso[C::VPW];
#pragma unroll
    for (int i = 0; i < C::KPW; ++i) { const int c = (wid + 8 * i) * 64 + lane, row = c / C::CPR; int cc = c % C::CPR; if (cc > C::CPR - 2) cc = C::CPR - 2;
        kso[i] = (unsigned)((row & 63) * kp + cc * 16); }
#pragma unroll
    for (int i = 0; i < C::VPW; ++i) { const int off = ((wid + 8 * i) * 64 + lane) * 16, st = off >> 9, within = off & 511, kk = (st / NCB) * 8 + (within >> 6);
        const int k = (kk & ~0xC) | ((kk & 4) << 1) | ((kk & 8) >> 1), col = (st % NCB) * 32 + ((within & 63) >> 1);
        vso[i] = (unsigned)(k * vp + col); }
#define ATT_DMA(j, bf) do { const unsigned char* kt_ = Kh + (size_t)(j) * 64 * kp; const bf16_t* vt_ = Vh + (size_t)(j) * 64 * vp; \
        _Pragma("unroll") for (int i = 0; i < C::KPW; ++i) if (wid + 8 * i < C::NKP) \
            __builtin_amdgcn_global_load_lds((const unsigned*)(kt_ + kso[i]), (LAS unsigned*)(lds + C::OFF_K + (bf) * C::KB + (wid + 8 * i) * 1024), 16, 0, 0); \
        _Pragma("unroll") for (int i = 0; i < C::VPW; ++i) \
            __builtin_amdgcn_global_load_lds((const unsigned*)(vt_ + vso[i]), (LAS unsigned*)(lds + C::OFF_V + (bf) * C::VB + (wid + 8 * i) * 1024), 16, 0, 0); } while (0)
    ATT_DMA(j_lo, 0);
    if (NT > 1) ATT_DMA(j_lo + 1, 1);
    i32x8 qr[DQK / 64];
#pragma unroll
    for (int s = 0; s < DQK / 64; ++s) { const i32x4 lo_ = *(const i32x4*)(Qh + (size_t)qpos * qp + 64 * s + 32 * hi), hi_ = *(const i32x4*)(Qh + (size_t)qpos * qp + 64 * s + 32 * hi + 16);
        qr[s] = __builtin_shufflevector(lo_, hi_, 0, 1, 2, 3, 4, 5, 6, 7); }
    float m_reg = -1e30f, l_reg = 0.f;
    f32x16 o[NCB];
#pragma unroll
    for (int d = 0; d < NCB; ++d) o[d] = f32x16{};
    const int koff = r32 * C::KP + hi * 32;
    const unsigned vb0 = (unsigned)(uintptr_t)(lds + C::OFF_V) + (unsigned)v_rd_base(lane);
    asm volatile("s_waitcnt vmcnt(0)" ::: "memory");
    __syncthreads();
    constexpr int ND = DQK / 64;
#define ATT_ACT(kb2_) ((kb2_) <= qlo + 31 && (MODE == 0 || (qlo - (kb2_) - 31 <= 2048)))
#define ATT_QK(P, bufi, hf_) do { const LAS unsigned char* kb_ = lds + C::OFF_K + (bufi) * C::KB + (hf_) * 32 * C::KP + koff; P = f32x16{}; \
        i32x8 kw_[ND]; _Pragma("unroll") for (int s = 0; s < ND; ++s) { const i32x4 lo_ = *(const LAS i32x4*)(kb_ + 64 * s), hi_ = *(const LAS i32x4*)(kb_ + 64 * s + 16); kw_[s] = __builtin_shufflevector(lo_, hi_, 0, 1, 2, 3, 4, 5, 6, 7); } \
        _Pragma("unroll") for (int s = 0; s < ND; ++s) P = __builtin_amdgcn_mfma_scale_f32_32x32x64_f8f6f4(kw_[s], qr[s], P, 0, 0, 0, 0, 0, 0); } while (0)
#define ATT_PK4(P, B_, OUT) do { unsigned a0 = cvt_pk_bf16(P[B_+0], P[B_+1]), a1 = cvt_pk_bf16(P[B_+2], P[B_+3]);                          \
        unsigned b0_ = cvt_pk_bf16(P[B_+4], P[B_+5]), b1_ = cvt_pk_bf16(P[B_+6], P[B_+7]);                                             \
        auto r0 = __builtin_amdgcn_permlane32_swap(a0, b0_, false, false); auto r1 = __builtin_amdgcn_permlane32_swap(a1, b1_, false, false); \
        u32x4 w = {r0[0], r1[0], r0[1], r1[1]}; OUT = __builtin_bit_cast(bf16x8, w); } while (0)
#define ATT_VRD(d0) do { \
                asm volatile("ds_read_b64_tr_b16 %0, %1 offset:%2" : "=&v"(vl0[(d0) & (VG - 1)]) : "v"(vb), "i"((d0) * 512 + KO) : "memory"); \
                asm volatile("ds_read_b64_tr_b16 %0, %1 offset:%2" : "=&v"(vh0[(d0) & (VG - 1)]) : "v"(vb), "i"((d0) * 512 + KO + HF) : "memory"); \
                asm volatile("ds_read_b64_tr_b16 %0, %1 offset:%2" : "=&v"(vl1[(d0) & (VG - 1)]) : "v"(vb), "i"((d0) * 512 + KO + KS) : "memory"); \
                asm volatile("ds_read_b64_tr_b16 %0, %1 offset:%2" : "=&v"(vh1[(d0) & (VG - 1)]) : "v"(vb), "i"((d0) * 512 + KO + KS + HF) : "memory"); } while (0)
#define ATT_PVD(d0) do { const int g_ = (d0) & (VG - 1); \
                o[d0] = __builtin_amdgcn_mfma_f32_32x32x16_bf16(pa0, (bf16x8){vl0[g_][0], vl0[g_][1], vl0[g_][2], vl0[g_][3], vh0[g_][0], vh0[g_][1], vh0[g_][2], vh0[g_][3]}, o[d0], 0, 0, 0); \
                o[d0] = __builtin_amdgcn_mfma_f32_32x32x16_bf16(pa1, (bf16x8){vl1[g_][0], vl1[g_][1], vl1[g_][2], vl1[g_][3], vh1[g_][0], vh1[g_][1], vh1[g_][2], vh1[g_][3]}, o[d0], 0, 0, 0); } while (0)
#define ATT_SMPV(P, kb2, vbuf, hf) do { \
            const unsigned vb = vb0 + (unsigned)((vbuf) * C::VB); \
            constexpr int KS = NCB * 1024, HF = NCB * 512, KO = 2 * (hf) * KS, VG = 2;         \
            s16x4 vl0[VG], vh0[VG], vl1[VG], vh1[VG]; \
            ATT_VRD(0); ATT_VRD(1); \
            const int dq = qpos - (kb2) - 4 * hi; \
            if (MODE == 0) { if ((kb2) + 31 > qlo) { const float NEG = -__builtin_inff(); \
                    _Pragma("unroll") for (int r = 0; r < 16; ++r) { const int c = (r & 3) + 8 * (r >> 2); if (dq - c < 0) P[r] = NEG; } } } \
            else { _Pragma("unroll") for (int r = 0; r < 16; ++r) { const int c = (r & 3) + 8 * (r >> 2); unsigned i0 = (unsigned)(dq - c); i0 = i0 < 2049u ? i0 : 2049u; P[r] += lut[i0]; } } \
            float pmax = P[0]; \
            _Pragma("unroll") for (int r = 1; r < 16; ++r) pmax = fmaxf(pmax, P[r]); \
            { auto rr = __builtin_amdgcn_permlane32_swap(__float_as_uint(pmax), __float_as_uint(pmax), false, false); pmax = fmaxf(__uint_as_float(rr[0]), __uint_as_float(rr[1])); } \
            const float mn = fmaxf(m_reg, pmax * SC); const float alpha = __builtin_amdgcn_exp2f(m_reg - mn); m_reg = mn; \
            float ps = 0.f; \
            _Pragma("unroll") for (int r = 0; r < 16; ++r) { P[r] = __builtin_amdgcn_exp2f(__builtin_fmaf(P[r], SC, -mn)); ps += P[r]; } \
            { auto rr = __builtin_amdgcn_permlane32_swap(__float_as_uint(ps), __float_as_uint(ps), false, false); ps = __uint_as_float(rr[0]) + __uint_as_float(rr[1]); } \
            l_reg = l_reg * alpha + ps; \
            bf16x8 pa0, pa1; ATT_PK4(P, 0, pa0); ATT_PK4(P, 8, pa1); \
            if (__any(alpha < 1.f)) { if (hi == 0) wsf[r32] = alpha; asm volatile("s_waitcnt lgkmcnt(0)" ::: "memory"); \
                _Pragma("unroll") for (int r = 0; r < 16; ++r) { const float a = wsf[crow(r, hi)]; _Pragma("unroll") for (int d = 0; d < NCB; ++d) o[d][r] *= a; } } \
            asm volatile("s_waitcnt lgkmcnt(0)" ::: "memory"); __builtin_amdgcn_sched_barrier(0);     \
            ATT_PVD(0); ATT_PVD(1); \
            if (NCB > 2) { __builtin_amdgcn_sched_barrier(0); ATT_VRD(2); ATT_VRD(3); asm volatile("s_waitcnt lgkmcnt(0)" ::: "memory"); __builtin_amdgcn_sched_barrier(0); ATT_PVD(2); ATT_PVD(3); } \
    } while (0)
    f32x16 pA, pB;
    int buf = 0;
    { const int kb0 = j_lo * 64; if (ATT_ACT(kb0)) ATT_QK(pA, 0, 0); }
    for (int t = 0; t < NT; ++t) {
        if (t + 2 < NT) { const int b2 = buf == 0 ? 2 : buf - 1; ATT_DMA(j_lo + t + 2, b2); }
        const int kb = (j_lo + t) * 64;
        const int nb = buf == 2 ? 0 : buf + 1;
        { const bool a0 = ATT_ACT(kb), a1 = ATT_ACT(kb + 32);
          if (a1) ATT_QK(pB, buf, 1);
          if (a0) ATT_SMPV(pA, kb, buf, 0);
          const bool a2 = (t + 1 < NT) && ATT_ACT(kb + 64);
          if (a2) ATT_QK(pA, nb, 0);
          if (a1) ATT_SMPV(pB, kb + 32, buf, 1); }
        asm volatile("s_waitcnt vmcnt(0)" ::: "memory");
        __syncthreads();
        buf = nb;
    }
#undef ATT_SMPV
#undef ATT_VRD
#undef ATT_PVD
#undef ATT_PK4
#undef ATT_QK
#undef ATT_ACT
#undef ATT_DMA
    if (hi == 0) wsf[32 + r32] = l_reg;
    asm volatile("s_waitcnt lgkmcnt(0)" ::: "memory");
    bf16_t* Ow = Oh + (size_t)qlo * op;
#pragma unroll
    for (int r = 0; r < 16; ++r) { const int orow = crow(r, hi); const float rl = __builtin_amdgcn_rcpf(wsf[32 + orow]);
#pragma unroll
        for (int d0 = 0; d0 < NCB; ++d0) { const float v = o[d0][r] * rl; const float vn = __shfl_xor(v, 1);
            if ((r32 & 1) == 0) *(unsigned*)(Ow + (size_t)orow * op + d0 * 32 + r32) = cvt_pk_bf16(v, vn); } }
    __syncthreads();
}
}

namespace dil {
using att::crow; using att::v_rd_base;
constexpr int OFF_O = 0, OFF_V = 65536, VWAVE = 8192;
template <int S_>
__device__ __forceinline__ void pass(const bf16_t* __restrict__ Qh, const bf16_t* __restrict__ Kh, const bf16_t* __restrict__ Vh, int pitch, int q0, LAS unsigned char* lds, LAS float* scr, int wid, int lane) {
    const int r32 = lane & 31, hi = lane >> 5;
    LAS float* Oacc = (LAS float*)(lds + OFF_O); LAS float* macc = scr; LAS float* lacc = scr + 256; LAS float* wsf = scr + 512 + wid * 64;
    LAS unsigned char* vbuf = lds + OFF_V + wid * VWAVE;
    constexpr int NG = (S_ == 16) ? 2 : 1, VR = (S_ == 16) ? 16 : 32;
    int vk[4], vc[4];
#pragma unroll
    for (int i = 0; i < 4; ++i) { const int off = (i * 64 + lane) * 16, st = off >> 9, within = off & 511, kk = (st >> 1) * 8 + (within >> 6);
        vk[i] = (kk & ~0xC) | ((kk & 4) << 1) | ((kk & 8) >> 1); vc[i] = (st & 1) * 32 + ((within & 63) >> 1); }
    const unsigned vb0 = (unsigned)(uintptr_t)vbuf + (unsigned)v_rd_base(lane);
#pragma unroll
    for (int gi = 0; gi < NG; ++gi) {
        const int rho = (S_ == 1) ? 0 : (S_ == 4) ? (wid & 3) : (2 * wid + gi);
        const int i0 = (S_ == 1) ? 32 * wid : (S_ == 4) ? 32 * (wid >> 2) : 0;
        const int qi = i0 + (r32 < VR ? r32 : r32 - VR);
        const int ql = rho + S_ * qi;
        bf16x8 qr[4];
#pragma unroll
        for (int d0 = 0; d0 < 4; ++d0) qr[d0] = *(const bf16x8*)(Qh + (size_t)(q0 + ql) * pitch + d0 * 16 + hi * 8);
        const int j0 = i0 - 128;
        const int tokb = q0 + rho + S_ * j0;
        bf16x8 kfA[4], kfB[4];
#define DIL_KLOAD(dst, c) do { int tk_ = tokb + S_ * (32 * (c) + r32); tk_ = tk_ < 0 ? 0 : (tk_ > SEQ - 1 ? SEQ - 1 : tk_);     \
            _Pragma("unroll") for (int d0 = 0; d0 < 4; ++d0) dst[d0] = *(const bf16x8*)(Kh + (size_t)tk_ * pitch + d0 * 16 + hi * 8); } while (0)
#define DIL_VDMA(c, bf) do { _Pragma("unroll") for (int i = 0; i < 4; ++i) { int tk_ = tokb + S_ * (32 * (c) + vk[i]); tk_ = tk_ < 0 ? 0 : (tk_ > SEQ - 1 ? SEQ - 1 : tk_); \
            __builtin_amdgcn_global_load_lds((const unsigned*)(Vh + (size_t)tk_ * pitch + vc[i]), (LAS unsigned*)(vbuf + (bf) * 4096 + i * 1024), 16, 0, 0); } } while (0)
        float m_reg = -1e30f, l_reg = 0.f; f32x16 o[2]; o[0] = f32x16{}; o[1] = f32x16{};
        DIL_KLOAD(kfA, 0); DIL_VDMA(0, 0);
#define DIL_STEP(KF, KN, c) do { \
            if ((c) < 4) { DIL_KLOAD(KN, (c) + 1); DIL_VDMA((c) + 1, ((c) + 1) & 1); asm volatile("s_waitcnt vmcnt(8)" ::: "memory"); } \
            else { asm volatile("s_waitcnt vmcnt(0)" ::: "memory"); } \
            f32x16 p = f32x16{}; \
            _Pragma("unroll") for (int d0 = 0; d0 < 4; ++d0) p = __builtin_amdgcn_mfma_f32_32x32x16_bf16(KF[d0], qr[d0], p, 0, 0, 0); \
            const unsigned vb = vb0 + (unsigned)(((c) & 1) * 4096); \
            s16x4 vl0[2], vh0[2], vl1[2], vh1[2]; \
            _Pragma("unroll") for (int d0 = 0; d0 < 2; ++d0) { \
                asm volatile("ds_read_b64_tr_b16 %0, %1 offset:%2" : "=&v"(vl0[d0]) : "v"(vb), "i"(d0 * 512) : "memory"); \
                asm volatile("ds_read_b64_tr_b16 %0, %1 offset:%2" : "=&v"(vh0[d0]) : "v"(vb), "i"(d0 * 512 + 1024) : "memory"); \
                asm volatile("ds_read_b64_tr_b16 %0, %1 offset:%2" : "=&v"(vl1[d0]) : "v"(vb), "i"(d0 * 512 + 2048) : "memory"); \
                asm volatile("ds_read_b64_tr_b16 %0, %1 offset:%2" : "=&v"(vh1[d0]) : "v"(vb), "i"(d0 * 512 + 3072) : "memory"); } \
              \
            { const float NEG = -__builtin_inff(); const int db = qi - j0 - 32 * (c) - 4 * hi; const int tb = tokb + S_ * (32 * (c) + 4 * hi); \
              if ((c) == 0 || (c) == 4 || tokb < 0) { \
                _Pragma("unroll") for (int r = 0; r < 16; ++r) { const int cr = (r & 3) + 8 * (r >> 2); \
                    const bool ok = ((unsigned)(db - cr) <= 128u) && (tb + S_ * cr >= 0); p[r] = ok ? p[r] : NEG; } } } \
            float pmax = p[0]; \
            _Pragma("unroll") for (int r = 1; r < 16; ++r) pmax = fmaxf(pmax, p[r]); \
            { auto rr = __builtin_amdgcn_permlane32_swap(__float_as_uint(pmax), __float_as_uint(pmax), false, false); pmax = fmaxf(__uint_as_float(rr[0]), __uint_as_float(rr[1])); } \
            const float mn = fmaxf(m_reg, pmax); const float alpha = __builtin_amdgcn_exp2f(m_reg - mn); m_reg = mn; \
            float ps = 0.f; \
            _Pragma("unroll") for (int r = 0; r < 16; ++r) { p[r] = __builtin_amdgcn_exp2f(p[r] - mn); ps += p[r]; } \
            { auto rr = __builtin_amdgcn_permlane32_swap(__float_as_uint(ps), __float_as_uint(ps), false, false); ps = __uint_as_float(rr[0]) + __uint_as_float(rr[1]); } \
            l_reg = l_reg * alpha + ps; \
            bf16x8 pa0, pa1; DIL_PK4(p, 0, pa0); DIL_PK4(p, 8, pa1); \
            if (__any(alpha < 1.f)) { if (hi == 0) wsf[r32] = alpha; asm volatile("s_waitcnt lgkmcnt(0)" ::: "memory"); \
                _Pragma("unroll") for (int r = 0; r < 16; ++r) { const float a = wsf[crow(r, hi)]; o[0][r] *= a; o[1][r] *= a; } } \
            asm volatile("s_waitcnt lgkmcnt(0)" ::: "memory"); __builtin_amdgcn_sched_barrier(0); \
            _Pragma("unroll") for (int d0 = 0; d0 < 2; ++d0) { \
                o[d0] = __builtin_amdgcn_mfma_f32_32x32x16_bf16(pa0, (bf16x8){vl0[d0][0], vl0[d0][1], vl0[d0][2], vl0[d0][3], vh0[d0][0], vh0[d0][1], vh0[d0][2], vh0[d0][3]}, o[d0], 0, 0, 0); \
                o[d0] = __builtin_amdgcn_mfma_f32_32x32x16_bf16(pa1, (bf16x8){vl1[d0][0], vl1[d0][1], vl1[d0][2], vl1[d0][3], vh1[d0][0], vh1[d0][1], vh1[d0][2], vh1[d0][3]}, o[d0], 0, 0, 0); } \
        } while (0)
#define DIL_PK4(P, B_, OUT) do { unsigned a0 = cvt_pk_bf16(P[B_+0], P[B_+1]), a1 = cvt_pk_bf16(P[B_+2], P[B_+3]);                          \
            unsigned b0_ = cvt_pk_bf16(P[B_+4], P[B_+5]), b1_ = cvt_pk_bf16(P[B_+6], P[B_+7]);                                             \
            auto r0 = __builtin_amdgcn_permlane32_swap(a0, b0_, false, false); auto r1 = __builtin_amdgcn_permlane32_swap(a1, b1_, false, false); \
            u32x4 w = {r0[0], r1[0], r0[1], r1[1]}; OUT = __builtin_bit_cast(bf16x8, w); } while (0)
        DIL_STEP(kfA, kfB, 0); DIL_STEP(kfB, kfA, 1); DIL_STEP(kfA, kfB, 2); DIL_STEP(kfB, kfA, 3); DIL_STEP(kfA, kfB, 4);
#undef DIL_STEP
#undef DIL_PK4
#undef DIL_KLOAD
#undef DIL_VDMA
        float fo = 0.f, fc = 1.f;
        if (S_ != 1) { const float mo = macc[ql], lo = lacc[ql]; const float mnew = fmaxf(mo, m_reg); fo = __builtin_amdgcn_exp2f(mo - mnew); fc = __builtin_amdgcn_exp2f(m_reg - mnew);
            l_reg = lo * fo + l_reg * fc; m_reg = mnew; }
        if (hi == 0 && r32 < VR) { macc[ql] = m_reg; lacc[ql] = l_reg; wsf[r32] = fo; wsf[32 + r32] = fc; }
        asm volatile("s_waitcnt lgkmcnt(0)" ::: "memory");
#pragma unroll
        for (int r = 0; r < 16; ++r) { const int row = crow(r, hi);
            if (row < VR) { const int qrow = rho + S_ * (i0 + row); LAS float* op = Oacc + qrow * 64 + r32;
                if (S_ == 1) { op[0] = o[0][r]; op[32] = o[1][r]; }
                else { const float a = wsf[row], b = wsf[32 + row]; op[0] = op[0] * a + o[0][r] * b; op[32] = op[32] * a + o[1][r] * b; } } }
        asm volatile("s_waitcnt lgkmcnt(0)" ::: "memory");
    }
}
__device__ __forceinline__ void unit(const bf16_t* Qh, const bf16_t* Kh, const bf16_t* Vh, int pitch, bf16_t* Oh, int op, int q0, LAS unsigned char* lds, LAS float* scr) {
    int tid_ = threadIdx.x; asm volatile("" : "+v"(tid_));
    const int tid = tid_, wid = __builtin_amdgcn_readfirstlane(tid >> 6), lane = tid & 63;
    pass<1>(Qh, Kh, Vh, pitch, q0, lds, scr, wid, lane);
    __syncthreads();
    pass<4>(Qh, Kh, Vh, pitch, q0, lds, scr, wid, lane);
    __syncthreads();
    pass<16>(Qh, Kh, Vh, pitch, q0, lds, scr, wid, lane);
    __syncthreads();
    {   const int q = tid >> 1, hf = tid & 1; const LAS f32x4* src = (const LAS f32x4*)(lds + OFF_O + (q * 64 + 32 * hf) * 4); const float rl = 1.0f / scr[256 + q];
        bf16_t* dst = Oh + (size_t)(q0 + q) * op + 32 * hf;
#pragma unroll
        for (int i = 0; i < 4; ++i) { const f32x4 a = src[2 * i] * rl, b = src[2 * i + 1] * rl;
            u32x4 w; w.x = cvt_pk_bf16(a[0], a[1]); w.y = cvt_pk_bf16(a[2], a[3]); w.z = cvt_pk_bf16(b[0], b[1]); w.w = cvt_pk_bf16(b[2], b[3]); *(u32x4*)(dst + 8 * i) = w; } }
    __syncthreads();
}
}

constexpr int NWAVES = 8;
constexpr size_t MiB = 1u << 20;
constexpr size_t WS_CTL = 0, CTL_ZERO_BYTES = 1 * MiB;
constexpr size_t WS_WEIN = 2 * MiB;
constexpr size_t WS_WEOUT = 12 * MiB;
constexpr size_t WS_WOIN = 16 * MiB;
constexpr size_t WS_WUQ = 20 * MiB;
constexpr size_t WS_WUKV = 23 * MiB;
constexpr size_t WS_WOOUT = 25 * MiB;
constexpr size_t WS_B1P = 29 * MiB;
constexpr size_t WS_SSQ = 30 * MiB;
constexpr size_t WS_TOKER = 31 * MiB;
constexpr size_t WS_TOKG = 31 * MiB + 512 * 1024;
constexpr size_t WS_XN = 32 * MiB;
constexpr size_t WS_Z = 64 * MiB;
constexpr size_t WS_MIX = 144 * MiB;
constexpr size_t WS_QR = 176 * MiB;
constexpr size_t WS_KVR = 224 * MiB;
constexpr size_t WS_QF = 288 * MiB;
constexpr size_t WS_KF = 336 * MiB;
constexpr size_t WS_W1 = 384 * MiB;
constexpr size_t WS_W2 = 896 * MiB;
constexpr size_t WS_XG = 1152 * MiB;
constexpr size_t WS_ACT = 1664 * MiB;
constexpr size_t WS_Y = 2176 * MiB;
constexpr size_t WS_END = 3200 * MiB;
constexpr int CW_MOE = 65536;
constexpr int CW_TMO = 0, CW_CODE = 1, CW_BAR = 4096, CW_CNT = 16384;
constexpr int RING_OFF = 0, RING_BYTES = 131072;
constexpr int LDSCTL_OFF = RING_BYTES, MISC_OFF = LDSCTL_OFF + 320;
constexpr int SCR_OFF = RING_BYTES + 1024;
constexpr int LDS_BYTES = 155648;
constexpr int SCR_BYTES = LDS_BYTES - SCR_OFF;

typedef GAS unsigned gu32;
#define RLX_AGENT __ATOMIC_RELAXED, __HIP_MEMORY_SCOPE_AGENT

#define XB_TMO      128
#define XB_XCNT(j)  (256  + 64 * (j))
#define XB_XSUB(j)  (1280 + 64 * (j))
#define XB_XGEN(j)  (2304 + 64 * (j))
#define XB_TOP      3328
#define XB_TOPGEN   3392
#define XCD_BAR_WORDS 3456
#define XB_SPIN_CAP (1u << 18)
__device__ __forceinline__ unsigned xb_ld(unsigned* p)              { return __hip_atomic_load(p, __ATOMIC_RELAXED, __HIP_MEMORY_SCOPE_AGENT); }
__device__ __forceinline__ unsigned xb_add(unsigned* p, unsigned v) { return __hip_atomic_fetch_add(p, v, __ATOMIC_RELAXED, __HIP_MEMORY_SCOPE_AGENT); }
__device__ __forceinline__ unsigned xb_xcc_id() { return (unsigned)__builtin_amdgcn_s_getreg((3 << 11) | 20) & 0xFu; }
#define XB_SPIN(cond, bar) do { unsigned _sp = 0; while (cond) { __builtin_amdgcn_s_sleep(1); \
    if ((++_sp & 255u) == 0u) { if (xb_ld(&(bar)[XB_TMO])) break; if (_sp > XB_SPIN_CAP) { atomicAdd(&(bar)[XB_TMO], 1u); break; } } } } while (0)
struct XcdBarrier { unsigned* bar; unsigned x; volatile LAS unsigned* st; };
__device__ __forceinline__ XcdBarrier xcd_barrier_post(unsigned* bar, volatile LAS unsigned* st) {
    XcdBarrier b; b.bar = bar; b.x = xb_xcc_id(); b.st = st;
    if (threadIdx.x == 0) (void)xb_add(&bar[XB_XCNT(b.x)], 1u);
    return b;
}
__device__ __forceinline__ void xcd_barrier_complete(unsigned* bar, unsigned x, unsigned& nloc, unsigned& nx) {
    const unsigned G = gridDim.x * gridDim.y * gridDim.z;
    unsigned sum, cnt, mine, sp = 0u;
    for (;;) {
        sum = 0u; cnt = 0u; mine = 0u;
#pragma unroll
        for (unsigned j = 0; j < 16; ++j) { const unsigned c = xb_ld(&bar[XB_XCNT(j)]); sum += c; cnt += (c > 0u) ? 1u : 0u; mine = (j == x) ? c : mine; }
        if (sum == G) break;
        __builtin_amdgcn_s_sleep(1);
        if ((++sp & 255u) == 0u) { if (xb_ld(&bar[XB_TMO])) break; if (sp > XB_SPIN_CAP) { atomicAdd(&bar[XB_TMO], 1u); break; } }
    }
    nloc = mine > 0u ? mine : 1u; nx = cnt > 0u ? cnt : 1u;
}
__device__ __forceinline__ void xcd_barrier(const XcdBarrier& b) {
    asm volatile("s_waitcnt vmcnt(0)" ::: "memory");
    __syncthreads();
    if (threadIdx.x == 0) {
        unsigned* bar = b.bar;
        __builtin_amdgcn_s_waitcnt(0);
        unsigned nloc = b.st[0], nx = b.st[1];
        if (nloc == 0u) { xcd_barrier_complete(bar, b.x, nloc, nx); b.st[0] = nloc; b.st[1] = nx; }
        const unsigned old = xb_add(&bar[XB_XSUB(b.x)], 1u);
        const unsigned gen = old / nloc;
        if (old + 1u == (gen + 1u) * nloc) {
            __builtin_amdgcn_fence(__ATOMIC_RELEASE, "agent");
            asm volatile("s_waitcnt vmcnt(0)" ::: "memory");
            const unsigned og = xb_add(&bar[XB_TOP], 1u);
            const unsigned tg = og / nx;
            if (og + 1u == (tg + 1u) * nx) xb_add(&bar[XB_TOPGEN], 1u);
            else XB_SPIN(xb_ld(&bar[XB_TOPGEN]) == tg, bar);
            __builtin_amdgcn_fence(__ATOMIC_ACQUIRE, "agent");
            xb_add(&bar[XB_XGEN(b.x)], 1u);
            asm volatile("s_waitcnt vmcnt(0)" ::: "memory");
        } else {
            XB_SPIN(xb_ld(&bar[XB_XGEN(b.x)]) == gen, bar);
            __builtin_amdgcn_fence(__ATOMIC_ACQUIRE, "agent");
            asm volatile("s_waitcnt vmcnt(0)" ::: "memory");
        }
    }
    __syncthreads();
}

struct Args {
    const float* in[24]; float* out; unsigned char* ws; int stage_limit; int pad;
};
enum { I_X = 0, I_MIXN, I_FFNN, I_EWIN, I_EWS, I_EBS, I_EGV, I_EGQ, I_EGK, I_EWOUT, I_OWIN, I_OGCQ, I_OGCKV, I_OWUQ, I_OWUKV, I_OGQ, I_OGK, I_OWOUT,
       I_RW, I_RB, I_W1, I_B1, I_W2, I_B2 };

struct Frame {
    LAS unsigned char* lds;
    int vcu, G;
};

__device__ __forceinline__ float wave_sum(float v) {
#pragma unroll
    for (int o = 1; o < 64; o <<= 1) v += __shfl_xor(v, o);
    return v;
}
#define LDS_WAIT() asm volatile("s_waitcnt lgkmcnt(0)" ::: "memory")

template <int MODE> __device__ __forceinline__ int dst_row(int o) {
    if (MODE == 1) { if (o >= 1024 && o < 2048) return (o & ~255) | (((o >> 5) & 1) << 7) | (((o >> 6) & 3) << 5) | (o & 31); return o; }
    if (MODE == 2) return ((o >> 8) << 8) | ((o & 1) << 7) | ((o & 255) >> 1);
    return o;
}
template <int MODE>
__device__ __forceinline__ void transpose_item(const float* __restrict__ W, int K, int N, bf16_t* __restrict__ WT, const float* __restrict__ gain, LAS float* scr, int item, int lane) {
    const int nblk = N / 32, kb = item / nblk, nb = item % nblk, k0 = 64 * kb, n0 = 32 * nb;
#pragma unroll 8
    for (int i = 0; i < 32; ++i) { const int kk = 2 * i + (lane >> 5); float w = W[(size_t)(k0 + kk) * N + n0 + (lane & 31)]; if (gain) w *= gain[k0 + kk]; scr[kk * 33 + (lane & 31)] = w; }
    LDS_WAIT(); asm volatile("" ::: "memory");
    const int c = lane & 7;
#pragma unroll
    for (int j = 0; j < 4; ++j) { const int n = (lane >> 3) + 8 * j; const LAS float* s = scr + (8 * c) * 33 + n;
        u32x4 o; o.x = cvt_pk_bf16(s[0 * 33], s[1 * 33]); o.y = cvt_pk_bf16(s[2 * 33], s[3 * 33]); o.z = cvt_pk_bf16(s[4 * 33], s[5 * 33]); o.w = cvt_pk_bf16(s[6 * 33], s[7 * 33]);
        *(u32x4*)(WT + (size_t)dst_row<MODE>(n0 + n) * K + k0 + 8 * c) = o; }
    LDS_WAIT(); asm volatile("" ::: "memory");
}
template <int MODE>
__device__ __forceinline__ void transpose_job(Frame& F, const float* W, int K, int N, int nmat, size_t src_stride, bf16_t* WT, size_t dst_stride, const float* gain, int gain_stride) {
    int tid_ = threadIdx.x; asm volatile("" : "+v"(tid_));
    const int wave = __builtin_amdgcn_readfirstlane(tid_ >> 6), lane = tid_ & 63;
    LAS float* scr = (LAS float*)(F.lds + RING_OFF + wave * 16384);
    const int gw = F.vcu * NWAVES + wave, NGW = F.G * NWAVES;
    const int per = (K / 64) * (N / 32), total = per * nmat;
    for (int it = gw; it < total; it += NGW) { const int mi = it / per, item = it - mi * per;
        transpose_item<MODE>(W + (size_t)mi * src_stride, K, N, WT + (size_t)mi * dst_stride, gain ? gain + (size_t)mi * gain_stride : nullptr, scr, item, lane); }
}


__device__ __forceinline__ void tr8_load(f32x4 (&v)[8], const float* __restrict__ W, int N, int item, int lane) {
    const int nblk = N / 32, kb = item / nblk, nb = item % nblk, k0 = 64 * kb, n0 = 32 * nb;
#pragma unroll
    for (int i = 0; i < 8; ++i) v[i] = __builtin_nontemporal_load((const f32x4*)(W + (size_t)(k0 + 8 * i + (lane >> 3)) * N + n0 + 4 * (lane & 7)));
}
template <int MODE>
__device__ __forceinline__ void tr8_store(const f32x4 (&v)[8], int K, int N, unsigned char* __restrict__ WT, LAS float* scr, int item, int lane) {
    const int nblk = N / 32, kb = item / nblk, nb = item % nblk, k0 = 64 * kb, n0 = 32 * nb;
#pragma unroll
    for (int i = 0; i < 8; ++i) { LAS float* d = scr + (8 * i + (lane >> 3)) * 33 + 4 * (lane & 7);
        d[0] = v[i].x * W8_SCALE; d[1] = v[i].y * W8_SCALE; d[2] = v[i].z * W8_SCALE; d[3] = v[i].w * W8_SCALE; }
    LDS_WAIT(); asm volatile("" ::: "memory");
    const int c = lane & 3;
#pragma unroll
    for (int j = 0; j < 2; ++j) { const int n = (lane >> 2) + 16 * j; const LAS float* s = scr + (16 * c) * 33 + n;
        u32x4 o; o.x = pk4_fp8(s[0 * 33], s[1 * 33], s[2 * 33], s[3 * 33]); o.y = pk4_fp8(s[4 * 33], s[5 * 33], s[6 * 33], s[7 * 33]);
        o.z = pk4_fp8(s[8 * 33], s[9 * 33], s[10 * 33], s[11 * 33]); o.w = pk4_fp8(s[12 * 33], s[13 * 33], s[14 * 33], s[15 * 33]);
        __builtin_nontemporal_store(o, (u32x4*)(WT + (size_t)dst_row<MODE>(n0 + n) * K + k0 + 16 * c)); }
    LDS_WAIT(); asm volatile("" ::: "memory");
}
template <int MODE>
__device__ __forceinline__ void transpose_job_fp8(Frame& F, const float* W, int K, int N, int nmat, size_t src_stride, unsigned char* WT, size_t dst_stride) {
    int tid_ = threadIdx.x; asm volatile("" : "+v"(tid_));
    const int wave = __builtin_amdgcn_readfirstlane(tid_ >> 6), lane = tid_ & 63;
    LAS float* scr = (LAS float*)(F.lds + RING_OFF + wave * 16384);
    const int gw = F.vcu * NWAVES + wave, NGW = F.G * NWAVES;
    const int per = (K / 64) * (N / 32), total = per * nmat;
    f32x4 cur[8], nxt[8];
    int it = gw;
    if (it < total) { const int mi = it / per; tr8_load(cur, W + (size_t)mi * src_stride, N, it - mi * per, lane); }
    for (; it < total; it += NGW) {
        const int itn = it + NGW;
        if (itn < total) { const int mn = itn / per; tr8_load(nxt, W + (size_t)mn * src_stride, N, itn - mn * per, lane); }
        const int mi = it / per;
        tr8_store<MODE>(cur, K, N, WT + (size_t)mi * dst_stride, scr, it - mi * per, lane);
#pragma unroll
        for (int i = 0; i < 8; ++i) cur[i] = nxt[i];
    }
}

__device__ __forceinline__ void rms_row_to_fp8(int lane, const float* xrow, const float* g, unsigned char* orow, float* copy) {
    const f32x4* xr = (const f32x4*)xrow + lane; const f32x4* gr = (const f32x4*)g + lane;
    f32x4 v[4]; float s = 0.f;
#pragma unroll
    for (int j = 0; j < 4; ++j) { v[j] = xr[64 * j]; s += (v[j].x * v[j].x + v[j].y * v[j].y) + (v[j].z * v[j].z + v[j].w * v[j].w); }
    const float rstd = 1.0f / sqrtf(wave_sum(s) * (1.f / DM) + EPS);
    unsigned* o4 = (unsigned*)orow + lane;
#pragma unroll
    for (int j = 0; j < 4; ++j) { const f32x4 gg = gr[64 * j]; if (copy) ((f32x4*)copy + lane)[64 * j] = v[j];
        o4[64 * j] = pk4_fp8(v[j].x * rstd * gg.x, v[j].y * rstd * gg.y, v[j].z * rstd * gg.z, v[j].w * rstd * gg.w); }
}
__device__ __forceinline__ void rms_row_to_bf16(int lane, const float* xrow, const float* g, bf16_t* orow, float* copy) {
    const f32x4* xr = (const f32x4*)xrow + lane; const f32x4* gr = (const f32x4*)g + lane;
    f32x4 v[4]; float s = 0.f;
#pragma unroll
    for (int j = 0; j < 4; ++j) { v[j] = xr[64 * j]; s += (v[j].x * v[j].x + v[j].y * v[j].y) + (v[j].z * v[j].z + v[j].w * v[j].w); }
    const float rstd = 1.0f / sqrtf(wave_sum(s) * (1.f / DM) + EPS);
    u32x2* o8 = (u32x2*)orow + lane;
#pragma unroll
    for (int j = 0; j < 4; ++j) { const f32x4 gg = gr[64 * j]; if (copy) ((f32x4*)copy + lane)[64 * j] = v[j];
        u32x2 w; w.x = cvt_pk_bf16(v[j].x * rstd * gg.x, v[j].y * rstd * gg.y); w.y = cvt_pk_bf16(v[j].z * rstd * gg.z, v[j].w * rstd * gg.w); o8[64 * j] = w; }
}

namespace pg8 {
struct EpiEvenIn {
    static constexpr bool PERM = false;
    bf16_t* Z; const float* gq; const float* gk;
    __device__ __forceinline__ void operator()(const f32x4 (&acc)[2][2][4][2], const Unit& u, int wr, int wc, int fr, int fq) const {
        const int row0 = u.pm * BM + wr * 64 + fr, pn = u.pn;
        if (pn >= 4 && pn < 8) {
            const float* g = pn < 6 ? gq : gk; const float sc = pn < 6 ? C2_B : 1.0f;
            f32x4 gv[2][2];
#pragma unroll
            for (int bj = 0; bj < 2; ++bj)
#pragma unroll
                for (int n = 0; n < 2; ++n) gv[bj][n] = *(const f32x4*)(g + 32 * bj + 16 * n + 4 * fq);
#pragma unroll
            for (int ai = 0; ai < 2; ++ai)
#pragma unroll
                for (int m = 0; m < 4; ++m) {
                    float ss = 0.f;
#pragma unroll
                    for (int bj = 0; bj < 2; ++bj)
#pragma unroll
                        for (int n = 0; n < 2; ++n) { const f32x4 v = acc[ai][bj][m][n]; ss += (v[0] * v[0] + v[1] * v[1]) + (v[2] * v[2] + v[3] * v[3]); }
                    ss += __shfl_xor(ss, 16); ss += __shfl_xor(ss, 32);
                    const float rstd = sc / sqrtf(ss * (1.0f / 64.0f) + EPS);
                    bf16_t* rowp = Z + (size_t)(row0 + ai * HALF + m * 16) * EVEN_IN + pn * BM + wc * 64 + 4 * fq;
#pragma unroll
                    for (int bj = 0; bj < 2; ++bj)
#pragma unroll
                        for (int n = 0; n < 2; ++n) { const f32x4 v = acc[ai][bj][m][n] * rstd * gv[bj][n];
                            u32x2 w; w.x = cvt_pk_bf16(v[0], v[1]); w.y = cvt_pk_bf16(v[2], v[3]); *(u32x2*)(rowp + 32 * bj + 16 * n) = w; }
                }
        } else {
            const bool act = pn < 4;
#pragma unroll
            for (int ai = 0; ai < 2; ++ai)
#pragma unroll
                for (int m = 0; m < 4; ++m) { bf16_t* rowp = Z + (size_t)(row0 + ai * HALF + m * 16) * EVEN_IN + pn * BM + wc * 32 + 4 * fq;
#pragma unroll
                    for (int bj = 0; bj < 2; ++bj)
#pragma unroll
                        for (int n = 0; n < 2; ++n) { f32x4 v = acc[ai][bj][m][n]; if (act) v = gelu4(v);
                            u32x2 w; w.x = cvt_pk_bf16(v[0], v[1]); w.y = cvt_pk_bf16(v[2], v[3]); *(u32x2*)(rowp + bj * HALF + 16 * n) = w; } }
        }
    }
};
struct EpiResid {
    static constexpr bool PERM = false;
    float* out;
    __device__ __forceinline__ void operator()(const f32x4 (&acc)[2][2][4][2], const Unit& u, int wr, int wc, int fr, int fq) const {
        const int row0 = u.pm * BM + wr * 64 + fr;
#pragma unroll
        for (int ai = 0; ai < 2; ++ai)
#pragma unroll
            for (int m = 0; m < 4; ++m) { float* rowp = out + (size_t)(row0 + ai * HALF + m * 16) * DM + u.pn * BM + wc * 32 + 4 * fq;
#pragma unroll
                for (int bj = 0; bj < 2; ++bj)
#pragma unroll
                    for (int n = 0; n < 2; ++n) { f32x4* p = (f32x4*)(rowp + bj * HALF + 16 * n); *p = *p + acc[ai][bj][m][n]; }
                if (m & 1) asm volatile("" ::: "memory"); }
    }
};
struct EpiOddIn {
    static constexpr bool PERM = false;
    bf16_t* Z; float* ssq;
    __device__ __forceinline__ void operator()(const f32x4 (&acc)[2][2][4][2], const Unit& u, int wr, int wc, int fr, int fq) const {
        const int row0 = u.pm * BM + wr * 64 + fr, pn = u.pn;
#pragma unroll
        for (int ai = 0; ai < 2; ++ai)
#pragma unroll
            for (int m = 0; m < 4; ++m) { const int row = row0 + ai * HALF + m * 16; bf16_t* rowp = Z + (size_t)row * ODD_INP + pn * BM + wc * 32 + 4 * fq;
                float ss = 0.f;
#pragma unroll
                for (int bj = 0; bj < 2; ++bj)
#pragma unroll
                    for (int n = 0; n < 2; ++n) { const f32x4 v = acc[ai][bj][m][n] * W8_INV; ss += (v[0] * v[0] + v[1] * v[1]) + (v[2] * v[2] + v[3] * v[3]);
                        u32x2 w; w.x = cvt_pk_bf16(v[0], v[1]); w.y = cvt_pk_bf16(v[2], v[3]); *(u32x2*)(rowp + bj * HALF + 16 * n) = w; }
                ss += __shfl_xor(ss, 16); ss += __shfl_xor(ss, 32);
                if (fq == 0) ssq[(size_t)row * 16 + pn * 4 + wc] = ss; }
    }
};
template <int NS> struct EpiRowScale {
    static constexpr bool PERM = true;
    bf16_t* O; int ldc; const float* ssq; int s0; float inv_cols;
    __device__ __forceinline__ void operator()(const f32x4 (&acc)[2][2][4][2], const Unit& u, int wr, int wc, int fr, int fq) const {
        const int row0 = u.pm * BM + wr * 64 + fr; const int col0 = u.pn * BM + wc * 32 + 8 * fq;
#pragma unroll
        for (int ai = 0; ai < 2; ++ai)
#pragma unroll
            for (int m = 0; m < 4; ++m) { const int row = row0 + ai * HALF + m * 16;
                float ss = 0.f; const f32x4* sp = (const f32x4*)(ssq + (size_t)row * 16 + s0);
#pragma unroll
                for (int q = 0; q < NS; ++q) { const f32x4 t = sp[q]; ss += (t[0] + t[1]) + (t[2] + t[3]); }
                const float rstd = 1.0f / sqrtf(ss * inv_cols + EPS);
                bf16_t* rowp = O + (size_t)row * ldc + col0;
#pragma unroll
                for (int bj = 0; bj < 2; ++bj) { const f32x4 v0 = acc[ai][bj][m][0] * rstd, v1 = acc[ai][bj][m][1] * rstd;
                    u32x4 w; w.x = cvt_pk_bf16(v0[0], v0[1]); w.y = cvt_pk_bf16(v0[2], v0[3]); w.z = cvt_pk_bf16(v1[0], v1[1]); w.w = cvt_pk_bf16(v1[2], v1[3]);
                    *(u32x4*)(rowp + bj * HALF) = w; }
                asm volatile("" ::: "memory"); }
    }
};
__device__ __forceinline__ void store8_sc1(void* p, u32x2 v) { asm volatile("global_store_dwordx2 %0, %1, off sc1" :: "v"(p), "v"(v) : "memory"); }
template <bool WT = false> struct EpiSwigluT {
    static constexpr bool PERM = true;
    unsigned char* ACT; const float* b1p;
    __device__ __forceinline__ void operator()(const f32x4 (&acc)[2][2][4][2], const Unit& u, int wr, int wc, int fr, int fq) const {
        const int row0 = u.pm * BM + wr * 64 + fr, e = u.pb >> 3, pn = u.pn;
        const float* bp = b1p + (size_t)e * 2048 + pn * BM + wc * 32 + 8 * fq;
        f32x4 bg[2], bl[2];
#pragma unroll
        for (int n = 0; n < 2; ++n) { bg[n] = *(const f32x4*)(bp + 4 * n); bl[n] = *(const f32x4*)(bp + HALF + 4 * n); }
#pragma unroll
        for (int ai = 0; ai < 2; ++ai)
#pragma unroll
            for (int m = 0; m < 4; ++m) { unsigned char* rowp = ACT + (size_t)(row0 + ai * HALF + m * 16) * DE + pn * HALF + wc * 32 + 8 * fq;
                float a[8];
#pragma unroll
                for (int n = 0; n < 2; ++n) { const f32x4 gv = acc[ai][0][m][n] * W8_INV + bg[n], lv = acc[ai][1][m][n] * W8_INV + bl[n];
#pragma unroll
                    for (int i = 0; i < 4; ++i) { const float gl = fminf(gv[i], 7.0f), li = fminf(fmaxf(lv[i], -7.0f), 7.0f);
                        const float sg = __builtin_amdgcn_rcpf(1.0f + __builtin_amdgcn_exp2f(-1.702f * LOG2E * gl));
                        a[4 * n + i] = gl * sg * (li + 1.0f); } }
                u32x2 w; w.x = pk4_fp8(a[0], a[1], a[2], a[3]); w.y = pk4_fp8(a[4], a[5], a[6], a[7]);
                if (WT) store8_sc1(rowp, w); else *(u32x2*)rowp = w; }
    }
};
typedef EpiSwigluT<false> EpiSwiglu;
struct EpiDown {
    static constexpr bool PERM = true;
    bf16_t* Y; const float* b2;
    __device__ __forceinline__ void operator()(const f32x4 (&acc)[2][2][4][2], const Unit& u, int wr, int wc, int fr, int fq) const {
        const int row0 = u.pm * BM + wr * 64 + fr, e = u.pb >> 2, pn = u.pn;
        const float* bp = b2 + (size_t)e * DM + pn * BM + wc * 32 + 8 * fq;
        f32x4 bv[2][2];
#pragma unroll
        for (int bj = 0; bj < 2; ++bj)
#pragma unroll
            for (int n = 0; n < 2; ++n) bv[bj][n] = *(const f32x4*)(bp + bj * HALF + 4 * n);
#pragma unroll
        for (int ai = 0; ai < 2; ++ai)
#pragma unroll
            for (int m = 0; m < 4; ++m) { bf16_t* rowp = Y + (size_t)(row0 + ai * HALF + m * 16) * DM + pn * BM + wc * 32 + 8 * fq;
#pragma unroll
                for (int bj = 0; bj < 2; ++bj) { const f32x4 v0 = acc[ai][bj][m][0] * W8_INV + bv[bj][0], v1 = acc[ai][bj][m][1] * W8_INV + bv[bj][1];
                    u32x4 w; w.x = cvt_pk_bf16(v0[0], v0[1]); w.y = cvt_pk_bf16(v0[2], v0[3]); w.z = cvt_pk_bf16(v1[0], v1[1]); w.w = cvt_pk_bf16(v1[2], v1[3]);
                    *(u32x4*)(rowp + bj * HALF) = w; } }
    }
};
struct MoeOrder {
    const LAS int* tbl; int nN, G, c;
    __device__ bool next(int i, Unit& u) const {
        const long L = (long)i * G + c; const int rb = (int)(L / nN);
        if (rb >= __builtin_amdgcn_readfirstlane(tbl[32])) return false;
        int e = 0;
#pragma unroll
        for (int k = 1; k < 32; ++k) e += (tbl[k] <= rb) ? 1 : 0;
        e = __builtin_amdgcn_readfirstlane(e); const int rbl = __builtin_amdgcn_readfirstlane(rb - tbl[e]);
        u.pm = e * (ECAP / BM) + rbl; u.pn = (int)(L % nN); u.pb = e * nN + u.pn; u.kind = 0; u.rb = rb; return true;
    }
    __device__ __forceinline__ void a_ready(const Unit&) const {}
    __device__ __forceinline__ void pre_epi() const {}
    __device__ __forceinline__ void done(const Unit&) const {}
    __device__ __forceinline__ void finish() const {}
};

constexpr unsigned MOE_SPIN_CAP = 1u << 22;
struct MoeMergedOrder {
    const LAS int* tbl; int G, c; gu32* cnt;
    mutable int pend;
    __device__ __forceinline__ void flush() const {
        if (pend >= 0) { asm volatile("s_waitcnt vmcnt(0)" ::: "memory");
            if ((threadIdx.x & 63) == 0) __hip_atomic_fetch_add(cnt + 16 * pend, 1u, __ATOMIC_RELAXED, __HIP_MEMORY_SCOPE_AGENT);
            pend = -1; } }
    __device__ bool next(int i, Unit& u) const {
        const int nb = __builtin_amdgcn_readfirstlane(tbl[32]);
        long L = (long)i * G + c; int nN = 8, kind = 0;
        if (L >= (long)nb * 8) { L -= (long)nb * 8; nN = 4; kind = 1; if (L >= (long)nb * 4) return false; }
        const int rb = (int)(L / nN);
        int e = 0;
#pragma unroll
        for (int k = 1; k < 32; ++k) e += (tbl[k] <= rb) ? 1 : 0;
        e = __builtin_amdgcn_readfirstlane(e); const int rbl = __builtin_amdgcn_readfirstlane(rb - tbl[e]);
        u.pm = e * (ECAP / BM) + rbl; u.pn = (int)(L % nN); u.pb = e * nN + u.pn; u.kind = kind; u.rb = rb; return true;
    }
    __device__ __forceinline__ void a_ready(const Unit& u) const {
        if (u.kind == 1) {
            flush();
            if (threadIdx.x < 64) {
                unsigned sp = 0;
                while ((unsigned)__builtin_amdgcn_readfirstlane(__hip_atomic_load(cnt + 16 * u.rb, __ATOMIC_RELAXED, __HIP_MEMORY_SCOPE_AGENT)) < 64u) { __builtin_amdgcn_s_sleep(2); if (++sp > MOE_SPIN_CAP) break; }
                __builtin_amdgcn_fence(__ATOMIC_ACQUIRE, "agent");
                asm volatile("s_waitcnt vmcnt(0)" ::: "memory");
            }
            __builtin_amdgcn_s_barrier();
        }
    }
    __device__ __forceinline__ void pre_epi() const { flush(); }
    __device__ __forceinline__ void done(const Unit& u) const { if (u.kind == 0) pend = u.rb; }
    __device__ __forceinline__ void finish() const { flush(); }
};
struct EpiMoe {
    static constexpr bool PERM = true;
    EpiSwigluT<true> up; EpiDown down;
    __device__ __forceinline__ void operator()(const f32x4 (&acc)[2][2][4][2], const Unit& u, int wr, int wc, int fr, int fq) const {
        if (u.kind == 0) up(acc, u, wr, wc, fr, fq); else down(acc, u, wr, wc, fr, fq);
    }
};
}

__device__ __forceinline__ void gmlp_unit(Frame& F, const bf16_t* Z, bf16_t* MIX, const float* Ws, const float* bs, const float* gv, int unit) {
    constexpr int VP = 272;
    LAS unsigned char* VT = F.lds + RING_OFF;
    const int h = unit & 3, chunk = unit >> 2;
    int tid_ = threadIdx.x; asm volatile("" : "+v"(tid_));
    const int t0 = chunk * 128, tid = tid_, lane = tid & 63, w = __builtin_amdgcn_readfirstlane(tid >> 6);
    {
        const int s = tid >> 2, dq = (tid & 3) * 32;
        const bf16_t* vp = Z + (size_t)(t0 + s) * EVEN_IN + 512 + h * 128 + dq;
        u32x4 raw[4]; float ss = 0.f;
#pragma unroll
        for (int i = 0; i < 4; ++i) { raw[i] = *(const u32x4*)(vp + 8 * i);
#pragma unroll
            for (int j = 0; j < 4; ++j) { const float a = bflo(raw[i][j]), b = bfhi(raw[i][j]); ss += a * a + b * b; } }
        ss += __shfl_xor(ss, 1); ss += __shfl_xor(ss, 2);
        const float rstd = 1.0f / sqrtf(ss * (1.0f / 128.0f) + EPS);
#pragma unroll
        for (int i = 0; i < 4; ++i)
#pragma unroll
            for (int j = 0; j < 4; ++j) { const int d = dq + 8 * i + 2 * j;
                *(LAS bf16_t*)(VT + (d) * VP + s * 2) = f2bf(bflo(raw[i][j]) * rstd);
                *(LAS bf16_t*)(VT + (d + 1) * VP + s * 2) = f2bf(bfhi(raw[i][j]) * rstd); }
    }
    __syncthreads();
    const int fr = lane & 15, fq = lane >> 4;
    f32x4 acc[8];
#pragma unroll
    for (int nb = 0; nb < 8; ++nb) acc[nb] = (f32x4){0.f, 0.f, 0.f, 0.f};
    const int trow = 16 * w + fr;
    const float* wrow = Ws + ((size_t)h * 128 + trow) * 128;
#pragma unroll
    for (int ks = 0; ks < 4; ++ks) {
        if (32 * ks <= 16 * w + 15) {
            const int s0 = 32 * ks + 8 * fq;
            const f32x4 wa = *(const f32x4*)(wrow + s0), wb = *(const f32x4*)(wrow + s0 + 4);
            float wv[8] = {wa[0], wa[1], wa[2], wa[3], wb[0], wb[1], wb[2], wb[3]};
#pragma unroll
            for (int j = 0; j < 8; ++j) if (s0 + j > trow) wv[j] = 0.f;
            u32x4 aw; aw.x = cvt_pk_bf16(wv[0], wv[1]); aw.y = cvt_pk_bf16(wv[2], wv[3]); aw.z = cvt_pk_bf16(wv[4], wv[5]); aw.w = cvt_pk_bf16(wv[6], wv[7]);
            const bf16x8 af = __builtin_bit_cast(bf16x8, aw);
#pragma unroll
            for (int nb = 0; nb < 8; ++nb) { const bf16x8 bfr = *(const LAS bf16x8*)(VT + (16 * nb + fr) * VP + s0 * 2);
                acc[nb] = __builtin_amdgcn_mfma_f32_16x16x32_bf16(af, bfr, acc[nb], 0, 0, 0); }
        }
    }
#pragma unroll
    for (int i = 0; i < 4; ++i) { const int tl = 16 * w + 4 * fq + i; const float bt = bs[h * 128 + tl];
        const bf16_t* up = Z + (size_t)(t0 + tl) * EVEN_IN + h * 128 + fr; bf16_t* op = MIX + (size_t)(t0 + tl) * DM + h * 128 + fr;
#pragma unroll
        for (int nb = 0; nb < 8; ++nb) { const float uu = bf2f(up[16 * nb]); op[16 * nb] = f2bf(uu * (gv[h * 128 + 16 * nb + fr] * acc[nb][i] + bt)); } }
    __syncthreads();
}

__device__ __forceinline__ void router_phase(Frame& F, const float* x, const float* gain, const float* Wr, const float* br, gu32* cnt  ,
                                             unsigned* tok_er, float* tok_g, unsigned char* XG) {
    LAS float* WrT = (LAS float*)(F.lds + RING_OFF);
    LAS float* lg = (LAS float*)(F.lds + SCR_OFF);
    LAS unsigned* hist = (LAS unsigned*)(F.lds + SCR_OFF + 64 * 33 * 4);
    LAS unsigned* base = hist + 32;
    LAS unsigned* ers = base + 32;
    int tid_ = threadIdx.x; asm volatile("" : "+v"(tid_));
    const int tid = tid_, lane = tid & 63, w = __builtin_amdgcn_readfirstlane(tid >> 6);
#ifndef RTR_REP_A
#define RTR_REP_A 1
#define RTR_REP_B 1
#define RTR_REP_C 1
#endif
    for (int ra_ = 0; ra_ < RTR_REP_A; ++ra_)
    for (int idx = tid; idx < 8192; idx += 512) { const int e4 = idx >> 10, k = idx & 1023; const f32x4 v = *(const f32x4*)(Wr + (size_t)k * 32 + 4 * e4);
        WrT[(4 * e4 + 0) * 1024 + k] = v[0]; WrT[(4 * e4 + 1) * 1024 + k] = v[1]; WrT[(4 * e4 + 2) * 1024 + k] = v[2]; WrT[(4 * e4 + 3) * 1024 + k] = v[3]; }
    __syncthreads();
    f32x4 gg[4];
#pragma unroll
    for (int j = 0; j < 4; ++j) gg[j] = ((const f32x4*)gain + lane)[64 * j];
    const float brl = br[lane & 31];
    {   const int tg = F.vcu;
    const int tokb = tg * 64;
    if (tid < 32) hist[tid] = 0u;
    for (int rb_ = 0; rb_ < RTR_REP_B; ++rb_)
#pragma unroll 1
    for (int tp = 0; tp < 4; ++tp) {
        f32x4 ha[4], hb[4];
        {   const float* r0 = x + (size_t)(tokb + w * 8 + 2 * tp) * DM;
#pragma unroll
            for (int j = 0; j < 4; ++j) { ha[j] = ((const f32x4*)r0 + lane)[64 * j]; hb[j] = ((const f32x4*)(r0 + DM) + lane)[64 * j]; } }
        float sa = 0.f, sb = 0.f;
#pragma unroll
        for (int j = 0; j < 4; ++j) { sa += (ha[j].x * ha[j].x + ha[j].y * ha[j].y) + (ha[j].z * ha[j].z + ha[j].w * ha[j].w); sb += (hb[j].x * hb[j].x + hb[j].y * hb[j].y) + (hb[j].z * hb[j].z + hb[j].w * hb[j].w); }
        const float ra = 1.0f / sqrtf(wave_sum(sa) * (1.f / DM) + EPS), rb = 1.0f / sqrtf(wave_sum(sb) * (1.f / DM) + EPS);
#pragma unroll
        for (int j = 0; j < 4; ++j) { ha[j] = ha[j] * ra * gg[j]; hb[j] = hb[j] * rb * gg[j]; }
        float a[32], b[32];
#pragma unroll
        for (int e = 0; e < 32; ++e) { f32x2 ta = {0.f, 0.f}, tb = {0.f, 0.f};
#pragma unroll
            for (int j = 0; j < 4; ++j) { const f32x4 wv = *(const LAS f32x4*)(WrT + e * 1024 + 256 * j + 4 * lane);
                const f32x2 w01 = {wv.x, wv.y}, w23 = {wv.z, wv.w};
                ta = (f32x2){ha[j].x, ha[j].y} * w01 + ta; ta = (f32x2){ha[j].z, ha[j].w} * w23 + ta;
                tb = (f32x2){hb[j].x, hb[j].y} * w01 + tb; tb = (f32x2){hb[j].z, hb[j].w} * w23 + tb; }
            a[e] = ta.x + ta.y; b[e] = tb.x + tb.y; if ((e & 3) == 3) __builtin_amdgcn_sched_barrier(0); }
#define RSTEP(N, BIT) _Pragma("unroll") for (int i = 0; i < N; ++i) { const bool up = (lane & BIT) != 0; \
            { const float keep = up ? a[2 * i + 1] : a[2 * i], send = up ? a[2 * i] : a[2 * i + 1]; a[i] = keep + __shfl_xor(send, BIT); } \
            { const float keep = up ? b[2 * i + 1] : b[2 * i], send = up ? b[2 * i] : b[2 * i + 1]; b[i] = keep + __shfl_xor(send, BIT); } }
        RSTEP(16, 1) RSTEP(8, 2) RSTEP(4, 4) RSTEP(2, 8) RSTEP(1, 16)
#undef RSTEP
        const float la = a[0] + __shfl_xor(a[0], 32) + brl, lb = b[0] + __shfl_xor(b[0], 32) + brl;
        if (lane < 32) { lg[(w * 8 + 2 * tp) * 33 + lane] = la; lg[(w * 8 + 2 * tp + 1) * 33 + lane] = lb; }
        asm volatile("" ::: "memory"); __builtin_amdgcn_sched_barrier(0);
    }
    __syncthreads();
    unsigned my_e[4] = {0, 0, 0, 0}, my_lr[4] = {0, 0, 0, 0}; float my_g[4] = {0, 0, 0, 0};
    if (tid < 64) {
        float v[32];
#pragma unroll
        for (int e = 0; e < 32; ++e) v[e] = lg[tid * 33 + e];
        int c0 = -1, c1 = -1, c2 = -1; float tv[4];
#pragma unroll
        for (int r = 0; r < 4; ++r) { float best = -__builtin_inff(); int bi = 0;
#pragma unroll
            for (int e = 0; e < 32; ++e) { const bool ok = (e != c0) && (e != c1) && (e != c2); if (ok && v[e] > best) { best = v[e]; bi = e; } }
            tv[r] = best; my_e[r] = (unsigned)bi; if (r == 0) c0 = bi; else if (r == 1) c1 = bi; else if (r == 2) c2 = bi; }
        const float p1 = __expf(tv[1] - tv[0]), p2 = __expf(tv[2] - tv[0]), p3 = __expf(tv[3] - tv[0]); const float inv = 1.0f / (1.0f + p1 + p2 + p3);
        my_g[0] = inv; my_g[1] = p1 * inv; my_g[2] = p2 * inv; my_g[3] = p3 * inv;
#pragma unroll
        for (int r = 0; r < 4; ++r) my_lr[r] = __hip_atomic_fetch_add(hist + my_e[r], 1u, __ATOMIC_RELAXED, __HIP_MEMORY_SCOPE_WORKGROUP);
    }
    __syncthreads();
    if (tid < 32) { const unsigned hc = hist[tid]; base[tid] = hc ? __hip_atomic_fetch_add(cnt + 64 * tid, hc, RLX_AGENT) : 0u; }
    __syncthreads();
    if (tid < 64) {
        u32x4 er; f32x4 gt;
#pragma unroll
        for (int r = 0; r < 4; ++r) { const unsigned rank = base[my_e[r]] + my_lr[r]; er[r] = (my_e[r] << 16) | rank; gt[r] = my_g[r]; ers[tid * 4 + r] = er[r]; }
        *(u32x4*)(tok_er + (size_t)(tokb + tid) * 4) = er; *(f32x4*)(tok_g + (size_t)(tokb + tid) * 4) = gt;
    }
    __syncthreads();
    for (int rc_ = 0; rc_ < RTR_REP_C; ++rc_)
#pragma unroll 2
    for (int tt = 0; tt < 8; ++tt) {
        const int tl = w * 8 + tt; const float* xrow = x + (size_t)(tokb + tl) * DM;
        f32x4 hv[4]; float s = 0.f;
#pragma unroll
        for (int j = 0; j < 4; ++j) { hv[j] = ((const f32x4*)xrow + lane)[64 * j]; s += (hv[j].x * hv[j].x + hv[j].y * hv[j].y) + (hv[j].z * hv[j].z + hv[j].w * hv[j].w); }
        const float rstd = 1.0f / sqrtf(wave_sum(s) * (1.f / DM) + EPS);
        unsigned wv[4];
#pragma unroll
        for (int j = 0; j < 4; ++j) { const f32x4 t = hv[j] * rstd * gg[j]; wv[j] = pk4_fp8(t.x, t.y, t.z, t.w); }
#pragma unroll
        for (int r = 0; r < 4; ++r) { const unsigned er = ers[tl * 4 + r]; const size_t slot = (size_t)(er >> 16) * ECAP + (er & 0xffffu);
            unsigned* o4 = (unsigned*)(XG + slot * DM) + lane;
#pragma unroll
            for (int j = 0; j < 4; ++j) o4[64 * j] = wv[j]; }
    }
    __syncthreads();
    }
}

__device__ __forceinline__ void combine_phase(Frame& F, const float* x, float* xout, const unsigned* tok_er, const float* tok_g, const bf16_t* Y, const float* g_next, unsigned char* XN, bool xn_fp8) {
    int tid_ = threadIdx.x; asm volatile("" : "+v"(tid_));
    const int gw = F.vcu * NWAVES + __builtin_amdgcn_readfirstlane(tid_ >> 6), NGW = F.G * NWAVES, lane = tid_ & 63;
    for (int m = gw; m < M; m += NGW) {
        const u32x4 er = *(const u32x4*)(tok_er + (size_t)m * 4); const f32x4 gt = *(const f32x4*)(tok_g + (size_t)m * 4);
        f32x4 v[4]; const float* xrow = x + (size_t)m * DM; float* xorow = xout + (size_t)m * DM;
#pragma unroll
        for (int j = 0; j < 4; ++j) v[j] = ((const f32x4*)xrow + lane)[64 * j];
#pragma unroll
        for (int r = 0; r < 4; ++r) { const size_t slot = (size_t)(er[r] >> 16) * ECAP + (er[r] & 0xffffu); const u32x2* yp = (const u32x2*)(Y + slot * DM) + lane; const float g = gt[r];
#pragma unroll
            for (int j = 0; j < 4; ++j) { const u32x2 yv = yp[64 * j]; v[j].x += g * bflo(yv.x); v[j].y += g * bfhi(yv.x); v[j].z += g * bflo(yv.y); v[j].w += g * bfhi(yv.y); } }
#pragma unroll
        for (int j = 0; j < 4; ++j) ((f32x4*)xorow + lane)[64 * j] = v[j];
        if (g_next) {
            float s = 0.f;
#pragma unroll
            for (int j = 0; j < 4; ++j) s += (v[j].x * v[j].x + v[j].y * v[j].y) + (v[j].z * v[j].z + v[j].w * v[j].w);
            const float rstd = 1.0f / sqrtf(wave_sum(s) * (1.f / DM) + EPS);
            unsigned* o4 = (unsigned*)(XN + (size_t)m * DM) + lane; u32x2* o8 = (u32x2*)(XN + (size_t)m * DM * 2) + lane;
#pragma unroll
            for (int j = 0; j < 4; ++j) { const f32x4 gg = ((const f32x4*)g_next + lane)[64 * j];
                if (xn_fp8) o4[64 * j] = pk4_fp8(v[j].x * rstd * gg.x, v[j].y * rstd * gg.y, v[j].z * rstd * gg.z, v[j].w * rstd * gg.w);
                else { u32x2 w; w.x = cvt_pk_bf16(v[j].x * rstd * gg.x, v[j].y * rstd * gg.y); w.y = cvt_pk_bf16(v[j].z * rstd * gg.z, v[j].w * rstd * gg.w); o8[64 * j] = w; } }
        }
    }
}

__device__ __forceinline__ void unpack8(const u32x4 w, float (&f)[8]) { f[0] = bflo(w.x); f[1] = bfhi(w.x); f[2] = bflo(w.y); f[3] = bfhi(w.y); f[4] = bflo(w.z); f[5] = bfhi(w.z); f[6] = bflo(w.w); f[7] = bfhi(w.w); }
__device__ __forceinline__ void unpack4(const u32x2 w, float (&f)[4]) { f[0] = bflo(w.x); f[1] = bfhi(w.x); f[2] = bflo(w.y); f[3] = bfhi(w.y); }
__device__ __forceinline__ void fin_head(const u32x4 n0, const u32x4 n1, const u32x2 r1, const u32x2 r2, const float (&g)[24], const float (&cs)[4], const float (&sn)[4], unsigned char* op, int j) {
    float a[8], b[8], x1[4], x2[4];
    unpack8(n0, a); unpack8(n1, b); unpack4(r1, x1); unpack4(r2, x2);
    float ss = 0.f;
#pragma unroll
    for (int i = 0; i < 8; ++i) ss += a[i] * a[i] + b[i] * b[i];
#pragma unroll
    for (int i = 0; i < 4; ++i) ss += x1[i] * x1[i] + x2[i] * x2[i];
    ss += __shfl_xor(ss, 1); ss += __shfl_xor(ss, 2); ss += __shfl_xor(ss, 4);
    const float rstd = 1.0f / sqrtf(ss * (1.0f / 192.0f) + EPS);
    u32x4 o0;
    o0.x = pk4_fp8(a[0] * rstd * g[0], a[1] * rstd * g[1], a[2] * rstd * g[2], a[3] * rstd * g[3]); o0.y = pk4_fp8(a[4] * rstd * g[4], a[5] * rstd * g[5], a[6] * rstd * g[6], a[7] * rstd * g[7]);
    o0.z = pk4_fp8(b[0] * rstd * g[8], b[1] * rstd * g[9], b[2] * rstd * g[10], b[3] * rstd * g[11]); o0.w = pk4_fp8(b[4] * rstd * g[12], b[5] * rstd * g[13], b[6] * rstd * g[14], b[7] * rstd * g[15]);
    float y1[4], y2[4];
#pragma unroll
    for (int i = 0; i < 4; ++i) { const float u = x1[i] * rstd * g[16 + i], v = x2[i] * rstd * g[20 + i]; y1[i] = u * cs[i] - v * sn[i]; y2[i] = u * sn[i] + v * cs[i]; }
    *(u32x4*)(op + 16 * j) = o0; *(unsigned*)(op + 128 + 4 * j) = pk4_fp8(y1[0], y1[1], y1[2], y1[3]); *(unsigned*)(op + 160 + 4 * j) = pk4_fp8(y2[0], y2[1], y2[2], y2[3]);
}
__device__ __forceinline__ void mla_finalize_phase(Frame& F, const bf16_t* QR, const bf16_t* KVR, const bf16_t* Z, const float* gq, const float* gk, unsigned char* QF, unsigned char* KF) {
    int tid_ = threadIdx.x; asm volatile("" : "+v"(tid_));
    const int gw = F.vcu * NWAVES + __builtin_amdgcn_readfirstlane(tid_ >> 6), NGW = F.G * NWAVES, lane = tid_ & 63;
    const int h = lane >> 3, j = lane & 7;
    float gqv[24], gkv[24], invf[4];
#pragma unroll
    for (int i = 0; i < 16; ++i) { gqv[i] = gq[16 * j + i]; gkv[i] = gk[16 * j + i]; }
#pragma unroll
    for (int i = 0; i < 4; ++i) { gqv[16 + i] = gq[128 + 4 * j + i]; gqv[20 + i] = gq[160 + 4 * j + i]; gkv[16 + i] = gk[128 + 4 * j + i]; gkv[20 + i] = gk[160 + 4 * j + i];
        invf[i] = __builtin_amdgcn_exp2f(-(float)(4 * j + i) * (13.287712379549449f / 32.0f)); }
#pragma unroll 2
    for (int m = gw; m < M; m += NGW) {
        const int pos = m & (SEQ - 1);
        float cs[4], sn[4];
#pragma unroll
        for (int i = 0; i < 4; ++i) { const double rev = (double)pos * (double)invf[i] * 0.15915494309189535; const float fr = (float)(rev - __builtin_rint(rev));
            sn[i] = __builtin_amdgcn_sinf(fr); cs[i] = __builtin_amdgcn_cosf(fr); }
        const bf16_t* qp = QR + (size_t)m * 1536 + h * 192; const bf16_t* kp = KVR + (size_t)m * 2048 + h * 256; const bf16_t* zp = Z + (size_t)m * ODD_INP + 768;
        const u32x4 qn0 = *(const u32x4*)(qp + 16 * j), qn1 = *(const u32x4*)(qp + 16 * j + 8); const u32x2 qr1 = *(const u32x2*)(qp + 128 + 4 * j), qr2 = *(const u32x2*)(qp + 160 + 4 * j);
        const u32x4 kn0 = *(const u32x4*)(kp + 16 * j), kn1 = *(const u32x4*)(kp + 16 * j + 8); const u32x2 kr1 = *(const u32x2*)(zp + 4 * j), kr2 = *(const u32x2*)(zp + 32 + 4 * j);
        fin_head(qn0, qn1, qr1, qr2, gqv, cs, sn, QF + (size_t)m * 1536 + h * 192, j);
        fin_head(kn0, kn1, kr1, kr2, gkv, cs, sn, KF + (size_t)m * 1536 + h * 192, j);
    }
}

#ifndef PHMASK
#define PHMASK 0xFFFF
#endif
#ifndef REPMASK
#define REPMASK 0
#endif
#ifndef REPCNT
#define REPCNT 3
#endif
#define NREP(k) ((((REPMASK) >> (k)) & 1) ? (REPCNT) : 1)

#define LAUNDER_S(x) asm volatile("" : "+s"(x))
__device__ __forceinline__ const float* in_ptr(const Args& a, int i) { LAUNDER_S(i); return a.in[i]; }
#define PHASE_BEGIN() unsigned wso_ = 0u; LAUNDER_S(wso_); unsigned char* ws = args.ws + wso_; Frame Fp = F; Fp.vcu = __builtin_amdgcn_readfirstlane(Fp.vcu); Fp.G = __builtin_amdgcn_readfirstlane(Fp.G); LAUNDER_S(Fp.vcu); LAUNDER_S(Fp.G); \
    int bx_ = __builtin_amdgcn_readfirstlane((int)blockIdx.x); LAUNDER_S(bx_); (void)bx_; (void)ws
#define XN  ((unsigned char*)(ws + WS_XN))
#define Z   ((bf16_t*)(ws + WS_Z))
#define MIX ((bf16_t*)(ws + WS_MIX))
#define QR  ((bf16_t*)(ws + WS_QR))
#define KVR ((bf16_t*)(ws + WS_KVR))
#define QF  ((unsigned char*)(ws + WS_QF))
#define KF  ((unsigned char*)(ws + WS_KF))
#define XG  ((unsigned char*)(ws + WS_XG))
#define ACT ((unsigned char*)(ws + WS_ACT))
#define YB  ((bf16_t*)(ws + WS_Y))
#define SSQ ((float*)(ws + WS_SSQ))
#define TOKER ((unsigned*)(ws + WS_TOKER))
#define TOKG ((float*)(ws + WS_TOKG))
#define B1P ((float*)(ws + WS_B1P))
#define IN(i) in_ptr(args, (i))
__global__ void __launch_bounds__(NWAVES * 64, 2) trunk_fwd(Args args) {
    extern __shared__ __attribute__((aligned(16))) unsigned char lds_raw[];
    Frame F;
    F.lds = (LAS unsigned char*)lds_raw;
    F.G = gridDim.x; { const int bx = blockIdx.x; F.vcu = (F.G % 8 == 0) ? (bx % 8) * (F.G / 8) + bx / 8 : bx; }
    for (int u = threadIdx.x; u < (SCR_OFF - LDSCTL_OFF) / 4; u += NWAVES * 64) ((LAS unsigned*)(F.lds + LDSCTL_OFF))[u] = 0u;
    __syncthreads();
    (void)xcd_barrier_post((unsigned*)((gu32*)(args.ws + WS_CTL) + CW_BAR), (volatile LAS unsigned*)(F.lds + MISC_OFF) + 8);
#define GRID_BAR() do { unsigned wsb_ = 0u; LAUNDER_S(wsb_); XcdBarrier bar_; bar_.bar = (unsigned*)((gu32*)(args.ws + wsb_ + WS_CTL) + CW_BAR); bar_.x = xb_xcc_id(); \
        bar_.st = (volatile LAS unsigned*)(F.lds + MISC_OFF) + 8; xcd_barrier(bar_); } while (0)
    float* const X = args.out;
    const int stage_limit = args.stage_limit;

#if (PHMASK >> 0) & 1
            _Pragma("unroll") for (int rep_ = 0; rep_ < NREP(0); ++rep_) { if (rep_) GRID_BAR();
    {   PHASE_BEGIN(); const int ptid = threadIdx.x, gw = Fp.vcu * NWAVES + __builtin_amdgcn_readfirstlane(ptid >> 6), NGW = Fp.G * NWAVES;
        transpose_job<1>(Fp, IN(I_EWIN), DM, EVEN_IN, 2, (size_t)DM * EVEN_IN, (bf16_t*)(ws + WS_WEIN), (size_t)EVEN_IN * DM, nullptr, 0);
        transpose_job<0>(Fp, IN(I_EWOUT), DM, DM, 2, (size_t)DM * DM, (bf16_t*)(ws + WS_WEOUT), (size_t)DM * DM, nullptr, 0);
        transpose_job_fp8<0>(Fp, IN(I_OWIN), DM, ODD_IN, 2, (size_t)DM * ODD_IN, ws + WS_WOIN, (size_t)ODD_INP * DM);
        transpose_job<0>(Fp, IN(I_OWUQ), 512, 1536, 2, (size_t)512 * 1536, (bf16_t*)(ws + WS_WUQ), (size_t)1536 * 512, IN(I_OGCQ), 512);
        transpose_job<0>(Fp, IN(I_OWUKV), 256, 2048, 2, (size_t)256 * 2048, (bf16_t*)(ws + WS_WUKV), (size_t)2048 * 256, IN(I_OGCKV), 256);
        transpose_job<0>(Fp, IN(I_OWOUT), DM, DM, 2, (size_t)DM * DM, (bf16_t*)(ws + WS_WOOUT), (size_t)DM * DM, nullptr, 0);
        transpose_job_fp8<2>(Fp, IN(I_W1), DM, 2 * DE, DEPTH * NE, (size_t)DM * 2 * DE, ws + WS_W1, (size_t)2 * DE * DM);
        transpose_job_fp8<0>(Fp, IN(I_W2), DE, DM, DEPTH * NE, (size_t)DE * DM, ws + WS_W2, (size_t)DM * DE);
        for (int i = bx_ * 512 + ptid; i < 2 * 12288; i += Fp.G * 512) { const int mi = i / 12288, r = i % 12288;
            *(u32x4*)(ws + WS_WOIN + (size_t)mi * ODD_INP * DM + (size_t)ODD_IN * DM + (size_t)r * 16) = (u32x4){0u, 0u, 0u, 0u}; }
        for (int i = bx_ * 512 + ptid; i < DEPTH * NE * 2048; i += Fp.G * 512) { const int c = i & 2047, o = 2 * (128 * (c >> 8) + (c & 127)) + ((c >> 7) & 1);
            B1P[i] = IN(I_B1)[(size_t)(i & ~2047) + o]; }
        for (int m = gw; m < M; m += NGW) rms_row_to_bf16(ptid & 63, IN(I_X) + (size_t)m * DM, IN(I_MIXN), (bf16_t*)XN + (size_t)m * DM, X + (size_t)m * DM);
    }
            }
#endif
    GRID_BAR();

#ifdef EXTRA_BARS
    for (int xb_ = 0; xb_ < EXTRA_BARS; ++xb_) GRID_BAR();
#endif
    for (int l = 0; l < DEPTH; ++l) {
        const int li = l >> 1;
        if (2 * l + 1 > stage_limit) break;
        if ((l & 1) == 0) {
#if (PHMASK >> 1) & 1
            _Pragma("unroll") for (int rep_ = 0; rep_ < NREP(1); ++rep_) { if (rep_) GRID_BAR();
            {   PHASE_BEGIN(); pg8::Gemm g{(const bf16_t*)XN, (const bf16_t*)(ws + WS_WEIN) + (size_t)li * EVEN_IN * DM, DM, DM, nullptr, nullptr}; pg8::StaticOrder S; S.init(M, EVEN_IN, Fp.G, bx_);
                pg8::EpiEvenIn E{Z, IN(I_EGQ) + li * 64, IN(I_EGK) + li * 64};
                pg8::gemm_phase<pg8::EpiEvenIn, pg8::StaticOrder>(Fp.lds + RING_OFF, g, S, E); }
            }
#endif
            GRID_BAR();
            {   PHASE_BEGIN();
#if (PHMASK >> 2) & 1
            _Pragma("unroll") for (int rep_ = 0; rep_ < NREP(2); ++rep_) { if (rep_) GRID_BAR();
                for (int u = Fp.vcu; u < 512; u += Fp.G)
                    gmlp_unit(Fp, Z, MIX, IN(I_EWS) + (size_t)li * 4 * 128 * 128, IN(I_EBS) + li * 512, IN(I_EGV) + li * 512, u);
            }
#endif
#if (PHMASK >> 3) & 1
            _Pragma("unroll") for (int rep_ = 0; rep_ < NREP(3); ++rep_) { if (rep_) GRID_BAR();
                for (int u = Fp.vcu; u < 256; u += Fp.G) { const int bh = u >> 4, s = u & 15, b = bh >> 3, h = bh & 7;
                    for (int pass = 0; pass < 2; ++pass) { const int qb = pass ? 31 - s : s;
                        const bf16_t* zb = Z + (size_t)b * SEQ * EVEN_IN;
                        dil::unit(zb + 1024 + 64 * h, zb + 1536 + 64 * h, zb + 2048 + 64 * h, EVEN_IN, MIX + (size_t)b * SEQ * DM + 512 + 64 * h, DM, qb * 256, Fp.lds + RING_OFF, (LAS float*)(Fp.lds + SCR_OFF)); } }
            }
#endif
            }
            GRID_BAR();
#if (PHMASK >> 4) & 1
            _Pragma("unroll") for (int rep_ = 0; rep_ < NREP(4); ++rep_) { if (rep_) GRID_BAR();
            {   PHASE_BEGIN(); pg8::Gemm g{MIX, (const bf16_t*)(ws + WS_WEOUT) + (size_t)li * DM * DM, DM, DM, nullptr, nullptr}; pg8::StaticOrder S; S.init(M, DM, Fp.G, bx_);
                pg8::EpiResid E{X};
                pg8::gemm_phase<pg8::EpiResid, pg8::StaticOrder>(Fp.lds + RING_OFF, g, S, E); }
            }
#endif
            GRID_BAR();
        } else {
#if (PHMASK >> 5) & 1
            _Pragma("unroll") for (int rep_ = 0; rep_ < NREP(5); ++rep_) { if (rep_) GRID_BAR();
            {   PHASE_BEGIN(); pg8::Gemm g{(const bf16_t*)XN, (const bf16_t*)(ws + WS_WOIN + (size_t)li * ODD_INP * DM), DM / 2, DM / 2, nullptr, nullptr}; pg8::StaticOrder S; S.init(M, ODD_INP, Fp.G, bx_);
                pg8::EpiOddIn E{Z, SSQ};
                pg8::gemm_phase<pg8::EpiOddIn, pg8::StaticOrder, true>(Fp.lds + RING_OFF, g, S, E); }
            }
#endif
            GRID_BAR();
#if (PHMASK >> 6) & 1
            _Pragma("unroll") for (int rep_ = 0; rep_ < NREP(6); ++rep_) { if (rep_) GRID_BAR();
            {   PHASE_BEGIN(); pg8::Gemm g{Z + 512, (const bf16_t*)(ws + WS_WUKV) + (size_t)li * 2048 * 256, ODD_INP, 256, nullptr, nullptr}; pg8::StaticOrder S; S.init(M, 2048, Fp.G, bx_);
                pg8::EpiRowScale<1> E{KVR, 2048, SSQ, 8, 1.0f / 256.0f};
                pg8::gemm_phase<pg8::EpiRowScale<1>, pg8::StaticOrder>(Fp.lds + RING_OFF, g, S, E); }
            {   PHASE_BEGIN(); pg8::Gemm g{Z, (const bf16_t*)(ws + WS_WUQ) + (size_t)li * 1536 * 512, ODD_INP, 512, nullptr, nullptr}; pg8::StaticOrder S; S.init(M, 1536, Fp.G, bx_);
                pg8::EpiRowScale<2> E{QR, 1536, SSQ, 0, 1.0f / 512.0f};
                pg8::gemm_phase<pg8::EpiRowScale<2>, pg8::StaticOrder>(Fp.lds + RING_OFF, g, S, E); }
            }
#endif
            GRID_BAR();
#if (PHMASK >> 7) & 1
            _Pragma("unroll") for (int rep_ = 0; rep_ < NREP(7); ++rep_) { if (rep_) GRID_BAR();
            {   PHASE_BEGIN(); mla_finalize_phase(Fp, QR, KVR, Z, IN(I_OGQ) + li * 192, IN(I_OGK) + li * 192, QF, KF); }
            }
#endif
            GRID_BAR();
#if (PHMASK >> 8) & 1
            _Pragma("unroll") for (int rep_ = 0; rep_ < NREP(8); ++rep_) { if (rep_) GRID_BAR();
            {   PHASE_BEGIN();
                for (int u = Fp.vcu; u < 256; u += Fp.G) { const int bh = u >> 4, s = u & 15, b = bh >> 3, h = bh & 7;
                    for (int pass = 0; pass < 2; ++pass) { const int qb = pass ? 31 - s : s;
                        att::attn_unit8<192, 128, 0>(QF + (size_t)b * SEQ * 1536 + 192 * h, 1536, KF + (size_t)b * SEQ * 1536 + 192 * h, 1536, KVR + (size_t)b * SEQ * 2048 + 256 * h + 128, 2048,
                                                    MIX + (size_t)b * SEQ * DM + 128 * h, DM, qb * 256, Fp.lds + RING_OFF); } }
            }
            }
#endif
            GRID_BAR();
#if (PHMASK >> 9) & 1
            _Pragma("unroll") for (int rep_ = 0; rep_ < NREP(9); ++rep_) { if (rep_) GRID_BAR();
            {   PHASE_BEGIN(); pg8::Gemm g{MIX, (const bf16_t*)(ws + WS_WOOUT) + (size_t)li * DM * DM, DM, DM, nullptr, nullptr}; pg8::StaticOrder S; S.init(M, DM, Fp.G, bx_);
                pg8::EpiResid E{X};
                pg8::gemm_phase<pg8::EpiResid, pg8::StaticOrder>(Fp.lds + RING_OFF, g, S, E); }
            }
#endif
            GRID_BAR();
        }
        if (2 * l + 2 > stage_limit) break;
#if (PHMASK >> 10) & 1
            _Pragma("unroll") for (int rep_ = 0; rep_ < NREP(10); ++rep_) {
        {   PHASE_BEGIN(); const bool dry = rep_ + 1 < NREP(10);
            gu32* cnt = (gu32*)(ws + WS_CTL) + CW_CNT + (size_t)(dry ? 8 + 4 * rep_ + l : l) * 32 * 64;
        router_phase(Fp, X, IN(I_FFNN) + l * DM, IN(I_RW) + (size_t)l * DM * NE, IN(I_RB) + l * NE, cnt, dry ? (unsigned*)(ws + WS_QR) : TOKER, dry ? (float*)(ws + WS_QR + MiB) : TOKG, dry ? ACT : XG); }
        GRID_BAR();
            }
#endif
        LAS int* tbl = (LAS int*)(F.lds + SCR_OFF + 12288);
        {   PHASE_BEGIN(); gu32* cnt = (gu32*)(ws + WS_CTL) + CW_CNT + (size_t)l * 32 * 64;
        if (threadIdx.x == 0) { int acc = 0; for (int e = 0; e < NE; ++e) { tbl[e] = acc; const unsigned c = __hip_atomic_load(cnt + 64 * e, RLX_AGENT); acc += (int)((c + 255u) >> 8); } tbl[NE] = acc; }
        __syncthreads(); }
#if (PHMASK >> 11) & 1
            _Pragma("unroll") for (int rep_ = 0; rep_ < NREP(11); ++rep_) { if (rep_) GRID_BAR();
        {   PHASE_BEGIN();
            pg8::Gemm g{(const bf16_t*)XG, (const bf16_t*)(ws + WS_W1 + (size_t)l * NE * 2 * DE * DM), DM / 2, DM / 2, (const bf16_t*)ACT, (const bf16_t*)(ws + WS_W2 + (size_t)l * NE * DM * DE)};
            pg8::MoeMergedOrder S{tbl, Fp.G, Fp.vcu, (gu32*)(ws + WS_CTL) + CW_MOE + (size_t)(l * 320 + 1280 * rep_) * 16, -1};
            pg8::EpiMoe E{{ACT, B1P + (size_t)l * NE * 2048}, {YB, IN(I_B2) + (size_t)l * NE * DM}};
            pg8::gemm_phase<pg8::EpiMoe, pg8::MoeMergedOrder, true>(Fp.lds + RING_OFF, g, S, E); }
            }
#endif
        GRID_BAR();
#if (PHMASK >> 13) & 1
            _Pragma("unroll") for (int rep_ = 0; rep_ < NREP(13); ++rep_) {
        {   PHASE_BEGIN(); const bool dry = rep_ + 1 < NREP(13);
            combine_phase(Fp, X, dry ? (float*)ACT : X, TOKER, TOKG, YB, (l + 1 < DEPTH) ? IN(I_MIXN) + (l + 1) * DM : nullptr, dry ? (ACT + (size_t)64 * MiB) : XN, (l & 1) == 0); }
        GRID_BAR();
            }
#endif
    }
#undef GRID_BAR
}

extern "C" void kernel_launch(void* const* d_in, const int* in_sizes, int n_in, void* d_out, int out_size, void* d_ws, size_t ws_size, hipStream_t stream) {
    static int grid = 0;
    if (grid == 0) {
        if (n_in != 24 || in_sizes[0] != M * DM || out_size != M * DM || ws_size < WS_END) {
            fprintf(stderr, "kernel_launch: unexpected shapes (n_in %d, in0 %d, out %d, ws %zu, need %zu)\n", n_in, n_in > 0 ? in_sizes[0] : -1, out_size, ws_size, (size_t)WS_END); grid = -1; return; }
        int dev = 0, cus = 0, per_cu = 0;
        if (hipGetDevice(&dev) != hipSuccess || hipDeviceGetAttribute(&cus, hipDeviceAttributeMultiprocessorCount, dev) != hipSuccess) { grid = -1; return; }
        if (hipFuncSetAttribute((const void*)trunk_fwd, hipFuncAttributeMaxDynamicSharedMemorySize, LDS_BYTES) != hipSuccess) { fprintf(stderr, "kernel_launch: hipFuncSetAttribute failed\n"); grid = -1; return; }
        if (hipOccupancyMaxActiveBlocksPerMultiprocessor(&per_cu, (const void*)trunk_fwd, NWAVES * 64, LDS_BYTES) != hipSuccess || per_cu < 1)
            fprintf(stderr, "kernel_launch: occupancy query reports %d workgroups per CU\n", per_cu);
        (void)hipGetLastError();
        if (cus < 256) { fprintf(stderr, "kernel_launch: needs 256 CUs, device has %d\n", cus); grid = -1; return; }
        grid = 256;
    }
    if (grid < 0) return;
    if (hipMemsetAsync((char*)d_ws + WS_CTL, 0, CTL_ZERO_BYTES, stream) != hipSuccess) return;
    Args a{};
    for (int i = 0; i < 24; ++i) a.in[i] = (const float*)d_in[i];
    a.out = (float*)d_out; a.ws = (unsigned char*)d_ws; a.stage_limit = STAGE_LIMIT; a.pad = 0;
    hipLaunchKernelGGL(trunk_fwd, dim3(grid), dim3(NWAVES * 64), LDS_BYTES, stream, a);
}
```

```cpp
#include <hip/hip_runtime.h>
#include <hip/hip_bf16.h>
#include <cstdio>
#include <cstdint>

#define LAS __attribute__((address_space(3)))
#define GAS __attribute__((address_space(1)))
typedef unsigned short bf16_t;
typedef short bf16x8 __attribute__((ext_vector_type(8)));
typedef short s16x4 __attribute__((ext_vector_type(4)));
typedef float f32x2 __attribute__((ext_vector_type(2)));
typedef float f32x4 __attribute__((ext_vector_type(4)));
typedef float f32x16 __attribute__((ext_vector_type(16)));
typedef unsigned u32x2 __attribute__((ext_vector_type(2)));
typedef unsigned u32x4 __attribute__((ext_vector_type(4)));
typedef int i32x4 __attribute__((ext_vector_type(4)));
typedef int i32x8 __attribute__((ext_vector_type(8)));

constexpr int BATCH = 2, SEQ = 8192, DM = 1024, M = BATCH * SEQ, DEPTH = 4;
constexpr int EVEN_IN = 2560, ODD_IN = 832, ODD_INP = 1024;
constexpr int NE = 32, DE = 1024, ECAP = 16384;
constexpr float EPS = 1e-6f;
constexpr float LOG2E = 1.4426950408889634f;
constexpr float C2_B = 0.125f * LOG2E;
constexpr float C2_C = 0.07216878364870322f * LOG2E;

__device__ __forceinline__ unsigned cvt_pk_bf16(float lo, float hi) { unsigned r; asm volatile("v_cvt_pk_bf16_f32 %0, %1, %2" : "=v"(r) : "v"(lo), "v"(hi)); return r; }
__device__ __forceinline__ float bf2f(bf16_t v) { return __uint_as_float(((unsigned)v) << 16); }
__device__ __forceinline__ float bflo(unsigned w) { return __uint_as_float(w << 16); }
__device__ __forceinline__ float bfhi(unsigned w) { return __uint_as_float(w & 0xffff0000u); }
__device__ __forceinline__ bf16_t f2bf(float f) { return (bf16_t)(cvt_pk_bf16(f, 0.f) & 0xffffu); }

__device__ __forceinline__ unsigned pk4_fp8(float a, float b, float c, float d) { int w = 0; w = __builtin_amdgcn_cvt_pk_fp8_f32(a, b, w, false); w = __builtin_amdgcn_cvt_pk_fp8_f32(c, d, w, true); return (unsigned)w; }
constexpr float W8_SCALE = 64.0f, W8_INV = 1.0f / 64.0f;

namespace pg8 {
constexpr int BM = 256, BK = 64, HALF = 128, HTB = HALF * BK * 2, STAGE_BYTES = 8 * HTB, NXCD = 8, WGM = 8;
__host__ __device__ __forceinline__ int lds_byte(int r, int c) { const int st = (r >> 4) * 2 + (c >> 5), rr = r & 15, cc = c & 31, ob = rr * 64 + cc * 2; return st * 1024 + (ob ^ (((ob >> 9) & 1) << 5)); }
__host__ __device__ __forceinline__ void stage_rc(int b, int& R, int& C) { const int st = b / 1024, sb = b % 1024, swz = sb ^ (((sb >> 9) & 1) << 5); R = (st >> 1) * 16 + swz / 64; C = (st & 1) * 32 + (swz % 64) / 2; }
__host__ __device__ __forceinline__ int perm32(int rho) { const int n = rho >> 4, i = rho & 15; return 8 * (i >> 2) + 4 * n + (i & 3); }

struct Unit { int pm, pn, pb, kind, rb; };
struct Gemm { const bf16_t* A; const bf16_t* Bt; int lda, K; const bf16_t* A2; const bf16_t* Bt2; };

struct StaticOrder {
    int nM, nN, nwg, G, c;
    __device__ void init(int M_, int N_, int G_, int c_) { nM = M_ / BM; nN = N_ / BM; nwg = nM * nN; G = G_; c = c_; }
    __device__ bool next(int i, Unit& u) const {
        const long L = (long)i * G + c; if (L >= nwg) return false;
        int wgid = (int)L; { const int q = nwg / NXCD, r = nwg % NXCD, xcd = wgid % NXCD, off = wgid / NXCD; wgid = (xcd < r ? xcd * (q + 1) : r * (q + 1) + (xcd - r) * q) + off; }
        const int nig = WGM * nN, gid = wgid / nig, fm = gid * WGM, gsz = (nM - fm) < WGM ? (nM - fm) : WGM;
        u.pm = fm + ((wgid % nig) % gsz); u.pn = (wgid % nig) / gsz; u.pb = u.pn; u.kind = 0; u.rb = 0; return true;
    }
    __device__ __forceinline__ void a_ready(const Unit&) const {}
    __device__ __forceinline__ void pre_epi() const {}
    __device__ __forceinline__ void done(const Unit&) const {}
    __device__ __forceinline__ void finish() const {}
};

__device__ __forceinline__ f32x2 gelu_pk(f32x2 v) {
    const f32x2 av = __builtin_elementwise_abs(v), d = av * 0.2316418882f + 1.0f;
    f32x2 t; t.x = __builtin_amdgcn_rcpf(d.x); t.y = __builtin_amdgcn_rcpf(d.y);
    f32x2 q = t * 0.5307027145f + (-0.7265760135f); q = q * t + 0.7107068705f; q = q * t + (-0.142248368f); q = q * t + 0.127414796f; q = q * t;
    const f32x2 s = (v * v) * (-0.72134752044f);
    f32x2 e; e.x = __builtin_amdgcn_exp2f(s.x); e.y = __builtin_amdgcn_exp2f(s.y);
    const f32x2 m = v * (q * e), r = v - m;
    f32x2 o; o.x = v.x < 0.f ? m.x : r.x; o.y = v.y < 0.f ? m.y : r.y; return o;
}
__device__ __forceinline__ f32x4 gelu4(f32x4 v) { const f32x2 a = gelu_pk((f32x2){v[0], v[1]}), b = gelu_pk((f32x2){v[2], v[3]}); return (f32x4){a.x, a.y, b.x, b.y}; }

template <class Epi, class Sched, bool FP8 = false>
__device__ __forceinline__ void gemm_phase(LAS unsigned char* lds, const Gemm g, const Sched& S, const Epi& E) {
    int tid_ = threadIdx.x; asm volatile("" : "+v"(tid_));
    const int tid = tid_, wid = __builtin_amdgcn_readfirstlane(tid >> 6), lane = tid & 63, wr = wid >> 2, wc = wid & 3, fr = lane & 15, fq = lane >> 4;
    const int K = g.K, nt = K / BK;
    unsigned voffA[2], voffB[2];
#pragma unroll
    for (int i = 0; i < 2; ++i) { int R, C; stage_rc(tid * 16 + i * 8192, R, C); const int Rb = Epi::PERM ? ((R & ~31) + perm32(R & 31)) : R;
        voffA[i] = (unsigned)(R * g.lda + C) * 2u; voffB[i] = (unsigned)(Rb * K + C) * 2u; }
    const size_t kstep = (size_t)(BK * 2);
    const size_t hstepA = (size_t)HALF * g.lda * 2, tstepA = 2 * hstepA;
    const size_t hstepB = (size_t)HALF * K * 2, tstepB = 2 * hstepB;
    const unsigned ldsw = (unsigned)wid * 1024u;
    const int aoff = lds_byte(wr * 64 + fr, fq * 8), boff = lds_byte(wc * 32 + fr, fq * 8);
#define PG8_SA(b, h) (((b) * 2 + (h)) * HTB)
#define PG8_SB(b, h) ((4 + (b) * 2 + (h)) * HTB)
#define PG8_STAGE(bufoff, gbase, voff) do { _Pragma("unroll") for (int _i = 0; _i < 2; ++_i) \
        __builtin_amdgcn_global_load_lds((const unsigned*)((const char*)(gbase) + (voff)[_i]), (LAS unsigned*)(lds + (bufoff) + ldsw + _i * 8192), 16, 0, 0); } while (0)
#define PG8_LDA(dst, b, h) do { _Pragma("unroll") for (int m = 0; m < 4; ++m) { if constexpr (FP8) { const i32x4 lo_ = *(const LAS i32x4*)(lds + PG8_SA(b, h) + aoff + m * 2048), hi_ = *(const LAS i32x4*)(lds + PG8_SA(b, h) + aoff + m * 2048 + 1024); dst##8[m] = __builtin_shufflevector(lo_, hi_, 0, 1, 2, 3, 4, 5, 6, 7); } \
        else { _Pragma("unroll") for (int k = 0; k < 2; ++k) dst[m][k] = *(const LAS bf16x8*)(lds + PG8_SA(b, h) + aoff + m * 2048 + k * 1024); } } } while (0)
#define PG8_LDB(dst, b, h) do { _Pragma("unroll") for (int n = 0; n < 2; ++n) { if constexpr (FP8) { const i32x4 lo_ = *(const LAS i32x4*)(lds + PG8_SB(b, h) + boff + n * 2048), hi_ = *(const LAS i32x4*)(lds + PG8_SB(b, h) + boff + n * 2048 + 1024); dst##8[n] = __builtin_shufflevector(lo_, hi_, 0, 1, 2, 3, 4, 5, 6, 7); } \
        else { _Pragma("unroll") for (int k = 0; k < 2; ++k) dst[n][k] = *(const LAS bf16x8*)(lds + PG8_SB(b, h) + boff + n * 2048 + k * 1024); } } } while (0)
#define PG8_MMA(ai, bj, At, Bt) do { __builtin_amdgcn_s_setprio(1); _Pragma("unroll") for (int m = 0; m < 4; ++m) _Pragma("unroll") for (int n = 0; n < 2; ++n) { \
        if constexpr (FP8) asm volatile("s_nop 1\n\tv_mfma_f32_16x16x128_f8f6f4 %0, %1, %2, %0" : "+v"(acc[ai][bj][m][n]) : "v"(Bt##8[n]), "v"(At##8[m])); \
        else { _Pragma("unroll") for (int k = 0; k < 2; ++k) acc[ai][bj][m][n] = __builtin_amdgcn_mfma_f32_16x16x32_bf16(Bt[n][k], At[m][k], acc[ai][bj][m][n], 0, 0, 0); } } \
        __builtin_amdgcn_s_setprio(0); } while (0)
#define PG8_WAIT_V(n) asm volatile("s_waitcnt vmcnt(" #n ")" ::: "memory")
#define PG8_WAIT_L(n) asm volatile("s_waitcnt lgkmcnt(" #n ")" ::: "memory")
#define PG8_BAR __builtin_amdgcn_s_barrier()
#define PG8_SCHED __builtin_amdgcn_sched_barrier(0)
    Unit cur, nxt; int ui = 0;
    if (!S.next(0, cur)) return;
    f32x4 acc[2][2][4][2];
#pragma unroll
    for (int a = 0; a < 2; ++a)
#pragma unroll
        for (int b = 0; b < 2; ++b)
#pragma unroll
            for (int m = 0; m < 4; ++m)
#pragma unroll
                for (int n = 0; n < 2; ++n) acc[a][b][m][n] = (f32x4){0.f, 0.f, 0.f, 0.f};
    bf16x8 At[4][2], B0[2][2], B1[2][2]; i32x8 At8[4], B08[2], B18[2];
    const char* cA = (const char*)(cur.kind ? g.A2 : g.A) + (size_t)cur.pm * tstepA; const char* cB = (const char*)(cur.kind ? g.Bt2 : g.Bt) + (size_t)cur.pb * tstepB;
    S.a_ready(cur);
    PG8_STAGE(PG8_SB(0, 0), cB, voffB); PG8_STAGE(PG8_SB(0, 1), cB + hstepB, voffB); PG8_STAGE(PG8_SA(0, 0), cA, voffA); PG8_STAGE(PG8_SA(0, 1), cA + hstepA, voffA);
    if (wr == 1) PG8_BAR;
    PG8_WAIT_V(2); PG8_BAR;
    PG8_STAGE(PG8_SB(1, 0), cB + kstep, voffB); PG8_STAGE(PG8_SA(1, 0), cA + kstep, voffA); PG8_STAGE(PG8_SB(1, 1), cB + hstepB + kstep, voffB);
    PG8_WAIT_V(6); PG8_BAR;
    for (;;) {
        const bool has_next = S.next(ui + 1, nxt);
        const char* nA = has_next ? (const char*)(nxt.kind ? g.A2 : g.A) + (size_t)nxt.pm * tstepA : cA; const char* nB = has_next ? (const char*)(nxt.kind ? g.Bt2 : g.Bt) + (size_t)nxt.pb * tstepB : cB;
#pragma unroll 1
        for (int t = 0; t < nt; t += 2) {
            const bool last = (t == nt - 2);
            const char* a1 = cA + (size_t)(t + 1) * kstep;
            const char* a2 = last ? nA : cA + (size_t)(t + 2) * kstep; const char* b2 = last ? nB : cB + (size_t)(t + 2) * kstep;
            const char* a3 = a2 + kstep; const char* b3 = b2 + kstep;
            if (last && has_next) S.a_ready(nxt);
            PG8_LDB(B0, 0, 0); PG8_LDB(B1, 0, 1); PG8_SCHED; PG8_LDA(At, 0, 0); PG8_STAGE(PG8_SA(1, 1), a1 + hstepA, voffA);
            PG8_WAIT_V(8); PG8_WAIT_L(0); PG8_BAR; PG8_MMA(0, 0, At, B0); PG8_MMA(0, 1, At, B1); PG8_BAR; PG8_SCHED;
            PG8_LDA(At, 0, 1); PG8_STAGE(PG8_SB(0, 0), b2, voffB); PG8_STAGE(PG8_SB(0, 1), b2 + hstepB, voffB); PG8_STAGE(PG8_SA(0, 0), a2, voffA);
            PG8_WAIT_V(8); PG8_WAIT_L(0); PG8_BAR; PG8_MMA(1, 0, At, B0); PG8_MMA(1, 1, At, B1); PG8_BAR; PG8_SCHED;
            PG8_LDB(B0, 1, 0); PG8_LDB(B1, 1, 1); PG8_SCHED; PG8_LDA(At, 1, 0); PG8_STAGE(PG8_SA(0, 1), a2 + hstepA, voffA);
            PG8_WAIT_V(8); PG8_WAIT_L(0); PG8_BAR; PG8_MMA(0, 0, At, B0); PG8_MMA(0, 1, At, B1); PG8_BAR; PG8_SCHED;
            PG8_LDA(At, 1, 1); PG8_STAGE(PG8_SB(1, 0), b3, voffB); PG8_STAGE(PG8_SB(1, 1), b3 + hstepB, voffB); PG8_STAGE(PG8_SA(1, 0), a3, voffA);
            PG8_WAIT_V(8); PG8_WAIT_L(0); PG8_BAR; PG8_MMA(1, 0, At, B0); PG8_MMA(1, 1, At, B1); PG8_BAR; PG8_SCHED;
        }
        if (wr == 0) PG8_BAR;
        if constexpr (FP8) asm volatile("s_nop 15\n\ts_nop 7" ::: "memory");
        S.pre_epi();
        { int te_ = threadIdx.x; asm volatile("" : "+v"(te_));
          E(acc, cur, wr, wc, te_ & 15, (te_ & 63) >> 4); }
        S.done(cur);
        if (!has_next) break;
#pragma unroll
        for (int a = 0; a < 2; ++a)
#pragma unroll
            for (int b = 0; b < 2; ++b)
#pragma unroll
                for (int m = 0; m < 4; ++m)
#pragma unroll
                    for (int n = 0; n < 2; ++n) acc[a][b][m][n] = (f32x4){0.f, 0.f, 0.f, 0.f};
        cur = nxt; cA = nA; cB = nB; ++ui;
        if (wr == 1) PG8_BAR;
    }
    PG8_WAIT_V(0);
    S.finish();
    PG8_BAR;
#undef PG8_SA
#undef PG8_SB
#undef PG8_STAGE
#undef PG8_LDA
#undef PG8_LDB
#undef PG8_MMA
#undef PG8_WAIT_V
#undef PG8_WAIT_L
#undef PG8_BAR
#undef PG8_SCHED
}
}
constexpr int STAGE_LIMIT = 8;

namespace att {
__device__ __forceinline__ int crow(int r, int hi) { return (r & 3) + 8 * (r >> 2) + 4 * hi; }
__device__ __forceinline__ int v_rd_base(int lane) { return ((lane & 3) << 3) | (((lane >> 2) & 3) << 6) | (((lane >> 4) & 1) << 5) | (((lane >> 5) & 1) << 8); }
}

namespace dil {
using att::crow; using att::v_rd_base;
constexpr int OFF_O = 0, OFF_V = 65536, VWAVE = 8192;
template <int S_>
__device__ __forceinline__ void pass(const bf16_t* __restrict__ Qh, const bf16_t* __restrict__ Kh, const bf16_t* __restrict__ Vh, int pitch, int q0, LAS unsigned char* lds, LAS float* scr, int wid, int lane) {
    const int r32 = lane & 31, hi = lane >> 5;
    LAS float* Oacc = (LAS float*)(lds + OFF_O); LAS float* macc = scr; LAS float* lacc = scr + 256; LAS float* wsf = scr + 512 + wid * 64;
    LAS unsigned char* vbuf = lds + OFF_V + wid * VWAVE;
    constexpr int NG = (S_ == 16) ? 2 : 1, VR = (S_ == 16) ? 16 : 32;
    int vk[4], vc[4];
#pragma unroll
    for (int i = 0; i < 4; ++i) { const int off = (i * 64 + lane) * 16, st = off >> 9, within = off & 511, kk = (st >> 1) * 8 + (within >> 6);
        vk[i] = (kk & ~0xC) | ((kk & 4) << 1) | ((kk & 8) >> 1); vc[i] = (st & 1) * 32 + ((within & 63) >> 1); }
    const unsigned vb0 = (unsigned)(uintptr_t)vbuf + (unsigned)v_rd_base(lane);
#pragma unroll
    for (int gi = 0; gi < NG; ++gi) {
        const int rho = (S_ == 1) ? 0 : (S_ == 4) ? (wid & 3) : (2 * wid + gi);
        const int i0 = (S_ == 1) ? 32 * wid : (S_ == 4) ? 32 * (wid >> 2) : 0;
        const int qi = i0 + (r32 < VR ? r32 : r32 - VR);
        const int ql = rho + S_ * qi;
        bf16x8 qr[4];
#pragma unroll
        for (int d0 = 0; d0 < 4; ++d0) qr[d0] = *(const bf16x8*)(Qh + (size_t)(q0 + ql) * pitch + d0 * 16 + hi * 8);
        const int j0 = i0 - 128;
        const int tokb = q0 + rho + S_ * j0;
        bf16x8 kfA[4], kfB[4];
#define DIL_KLOAD(dst, c) do { int tk_ = tokb + S_ * (32 * (c) + r32); tk_ = tk_ < 0 ? 0 : (tk_ > SEQ - 1 ? SEQ - 1 : tk_);     \
            _Pragma("unroll") for (int d0 = 0; d0 < 4; ++d0) dst[d0] = *(const bf16x8*)(Kh + (size_t)tk_ * pitch + d0 * 16 + hi * 8); } while (0)
#define DIL_VDMA(c, bf) do { _Pragma("unroll") for (int i = 0; i < 4; ++i) { int tk_ = tokb + S_ * (32 * (c) + vk[i]); tk_ = tk_ < 0 ? 0 : (tk_ > SEQ - 1 ? SEQ - 1 : tk_); \
            __builtin_amdgcn_global_load_lds((const unsigned*)(Vh + (size_t)tk_ * pitch + vc[i]), (LAS unsigned*)(vbuf + (bf) * 4096 + i * 1024), 16, 0, 0); } } while (0)
        float m_reg = -1e30f, l_reg = 0.f; f32x16 o[2]; o[0] = f32x16{}; o[1] = f32x16{};
        DIL_KLOAD(kfA, 0); DIL_VDMA(0, 0);
#define DIL_STEP(KF, KN, c) do { \
            if ((c) < 4) { DIL_KLOAD(KN, (c) + 1); DIL_VDMA((c) + 1, ((c) + 1) & 1); asm volatile("s_waitcnt vmcnt(8)" ::: "memory"); } \
            else { asm volatile("s_waitcnt vmcnt(0)" ::: "memory"); } \
            f32x16 p = f32x16{}; \
            _Pragma("unroll") for (int d0 = 0; d0 < 4; ++d0) p = __builtin_amdgcn_mfma_f32_32x32x16_bf16(KF[d0], qr[d0], p, 0, 0, 0); \
            const unsigned vb = vb0 + (unsigned)(((c) & 1) * 4096); \
            s16x4 vl0[2], vh0[2], vl1[2], vh1[2]; \
            _Pragma("unroll") for (int d0 = 0; d0 < 2; ++d0) { \
                asm volatile("ds_read_b64_tr_b16 %0, %1 offset:%2" : "=&v"(vl0[d0]) : "v"(vb), "i"(d0 * 512) : "memory"); \
                asm volatile("ds_read_b64_tr_b16 %0, %1 offset:%2" : "=&v"(vh0[d0]) : "v"(vb), "i"(d0 * 512 + 1024) : "memory"); \
                asm volatile("ds_read_b64_tr_b16 %0, %1 offset:%2" : "=&v"(vl1[d0]) : "v"(vb), "i"(d0 * 512 + 2048) : "memory"); \
                asm volatile("ds_read_b64_tr_b16 %0, %1 offset:%2" : "=&v"(vh1[d0]) : "v"(vb), "i"(d0 * 512 + 3072) : "memory"); } \
              \
            { const float NEG = -__builtin_inff(); const int db = qi - j0 - 32 * (c) - 4 * hi; const int tb = tokb + S_ * (32 * (c) + 4 * hi); \
              if ((c) == 0 || (c) == 4 || tokb < 0) { \
                _Pragma("unroll") for (int r = 0; r < 16; ++r) { const int cr = (r & 3) + 8 * (r >> 2); \
                    const bool ok = ((unsigned)(db - cr) <= 128u) && (tb + S_ * cr >= 0); p[r] = ok ? p[r] : NEG; } } } \
            float pmax = p[0]; \
            _Pragma("unroll") for (int r = 1; r < 16; ++r) pmax = fmaxf(pmax, p[r]); \
            { auto rr = __builtin_amdgcn_permlane32_swap(__float_as_uint(pmax), __float_as_uint(pmax), false, false); pmax = fmaxf(__uint_as_float(rr[0]), __uint_as_float(rr[1])); } \
            const float mn = fmaxf(m_reg, pmax); const float alpha = __builtin_amdgcn_exp2f(m_reg - mn); m_reg = mn; \
            float ps = 0.f; \
            _Pragma("unroll") for (int r = 0; r < 16; ++r) { p[r] = __builtin_amdgcn_exp2f(p[r] - mn); ps += p[r]; } \
            { auto rr = __builtin_amdgcn_permlane32_swap(__float_as_uint(ps), __float_as_uint(ps), false, false); ps = __uint_as_float(rr[0]) + __uint_as_float(rr[1]); } \
            l_reg = l_reg * alpha + ps; \
            bf16x8 pa0, pa1; DIL_PK4(p, 0, pa0); DIL_PK4(p, 8, pa1); \
            if (__any(alpha < 1.f)) { if (hi == 0) wsf[r32] = alpha; asm volatile("s_waitcnt lgkmcnt(0)" ::: "memory"); \
                _Pragma("unroll") for (int r = 0; r < 16; ++r) { const float a = wsf[crow(r, hi)]; o[0][r] *= a; o[1][r] *= a; } } \
            asm volatile("s_waitcnt lgkmcnt(0)" ::: "memory"); __builtin_amdgcn_sched_barrier(0); \
            _Pragma("unroll") for (int d0 = 0; d0 < 2; ++d0) { \
                o[d0] = __builtin_amdgcn_mfma_f32_32x32x16_bf16(pa0, (bf16x8){vl0[d0][0], vl0[d0][1], vl0[d0][2], vl0[d0][3], vh0[d0][0], vh0[d0][1], vh0[d0][2], vh0[d0][3]}, o[d0], 0, 0, 0); \
                o[d0] = __builtin_amdgcn_mfma_f32_32x32x16_bf16(pa1, (bf16x8){vl1[d0][0], vl1[d0][1], vl1[d0][2], vl1[d0][3], vh1[d0][0], vh1[d0][1], vh1[d0][2], vh1[d0][3]}, o[d0], 0, 0, 0); } \
        } while (0)
#define DIL_PK4(P, B_, OUT) do { unsigned a0 = cvt_pk_bf16(P[B_+0], P[B_+1]), a1 = cvt_pk_bf16(P[B_+2], P[B_+3]);                          \
            unsigned b0_ = cvt_pk_bf16(P[B_+4], P[B_+5]), b1_ = cvt_pk_bf16(P[B_+6], P[B_+7]);                                             \
            auto r0 = __builtin_amdgcn_permlane32_swap(a0, b0_, false, false); auto r1 = __builtin_amdgcn_permlane32_swap(a1, b1_, false, false); \
            u32x4 w = {r0[0], r1[0], r0[1], r1[1]}; OUT = __builtin_bit_cast(bf16x8, w); } while (0)
        DIL_STEP(kfA, kfB, 0); DIL_STEP(kfB, kfA, 1); DIL_STEP(kfA, kfB, 2); DIL_STEP(kfB, kfA, 3); DIL_STEP(kfA, kfB, 4);
#undef DIL_STEP
#undef DIL_PK4
#undef DIL_KLOAD
#undef DIL_VDMA
        float fo = 0.f, fc = 1.f;
        if (S_ != 1) { const float mo = macc[ql], lo = lacc[ql]; const float mnew = fmaxf(mo, m_reg); fo = __builtin_amdgcn_exp2f(mo - mnew); fc = __builtin_amdgcn_exp2f(m_reg - mnew);
            l_reg = lo * fo + l_reg * fc; m_reg = mnew; }
        if (hi == 0 && r32 < VR) { macc[ql] = m_reg; lacc[ql] = l_reg; wsf[r32] = fo; wsf[32 + r32] = fc; }
        asm volatile("s_waitcnt lgkmcnt(0)" ::: "memory");
#pragma unroll
        for (int r = 0; r < 16; ++r) { const int row = crow(r, hi);
            if (row < VR) { const int qrow = rho + S_ * (i0 + row); LAS float* op = Oacc + qrow * 64 + r32;
                if (S_ == 1) { op[0] = o[0][r]; op[32] = o[1][r]; }
                else { const float a = wsf[row], b = wsf[32 + row]; op[0] = op[0] * a + o[0][r] * b; op[32] = op[32] * a + o[1][r] * b; } } }
        asm volatile("s_waitcnt lgkmcnt(0)" ::: "memory");
    }
}
__device__ __forceinline__ void unit(const bf16_t* Qh, const bf16_t* Kh, const bf16_t* Vh, int pitch, bf16_t* Oh, int op, int q0, LAS unsigned char* lds, LAS float* scr) {
    int tid_ = threadIdx.x; asm volatile("" : "+v"(tid_));
    const int tid = tid_, wid = __builtin_amdgcn_readfirstlane(tid >> 6), lane = tid & 63;
    pass<1>(Qh, Kh, Vh, pitch, q0, lds, scr, wid, lane);
    __syncthreads();
    pass<4>(Qh, Kh, Vh, pitch, q0, lds, scr, wid, lane);
    __syncthreads();
    pass<16>(Qh, Kh, Vh, pitch, q0, lds, scr, wid, lane);
    __syncthreads();
    {   const int q = tid >> 1, hf = tid & 1; const LAS f32x4* src = (const LAS f32x4*)(lds + OFF_O + (q * 64 + 32 * hf) * 4); const float rl = 1.0f / scr[256 + q];
        bf16_t* dst = Oh + (size_t)(q0 + q) * op + 32 * hf;
#pragma unroll
        for (int i = 0; i < 4; ++i) { const f32x4 a = src[2 * i] * rl, b = src[2 * i + 1] * rl;
            u32x4 w; w.x = cvt_pk_bf16(a[0], a[1]); w.y = cvt_pk_bf16(a[2], a[3]); w.z = cvt_pk_bf16(b[0], b[1]); w.w = cvt_pk_bf16(b[2], b[3]); *(u32x4*)(dst + 8 * i) = w; } }
    __syncthreads();
}
}

namespace mla {
using att::crow;
constexpr int DQ = 192, DV_ = 128;
constexpr int KP = DQ + 16, KB = 64 * KP;
constexpr int VP = 80, VB = DV_ * VP;
constexpr int NBUF = 3;
constexpr int OFF_K = 0, OFF_V = NBUF * KB, OFF_WS = NBUF * (KB + VB), BYTES = OFF_WS + 8 * 256;
constexpr int KCPR = KP / 16, NKP = KB / 1024, KPW = (NKP + 7) / 8;
constexpr int NVP = VB / 256, VPW = NVP / 8;
static_assert(BYTES <= 131072 && KB % 1024 == 0 && VB % 256 == 0 && NVP % 8 == 0, "mla LDS image");
constexpr float PSHIFT = 8.0f;

__device__ __forceinline__ void unit(const unsigned char* __restrict__ Qh, const unsigned char* __restrict__ Kh, int pitch, const unsigned char* __restrict__ VTh  ,
                                     bf16_t* __restrict__ Oh, int op, int q0, LAS unsigned char* lds) {
    constexpr float SC = C2_C;
    int tid_ = threadIdx.x; asm volatile("" : "+v"(tid_));
    const int tid = tid_, wid = __builtin_amdgcn_readfirstlane(tid >> 6), lane = tid & 63, r32 = lane & 31, hi = lane >> 5;
    const int qlo = q0 + wid * 32, qpos = qlo + r32;
    LAS float* wsf = (LAS float*)(lds + OFF_WS) + wid * 64;
    const int NT = (q0 + 256) / 64;
    unsigned kso[KPW], vso[VPW];
#pragma unroll
    for (int i = 0; i < KPW; ++i) { const int c = (wid + 8 * i) * 64 + lane, row = c / KCPR; int cc = c % KCPR; if (cc > KCPR - 2) cc = KCPR - 2; kso[i] = (unsigned)((row & 63) * pitch + cc * 16); }
#pragma unroll
    for (int i = 0; i < VPW; ++i) { const int off = ((wid + 8 * i) * 64 + lane) * 4, d = off / VP; int w = off % VP; if (w >= 64) w = 0;
        const int hh = w >> 5, g = (w & 31) >> 2; vso[i] = (unsigned)(d * SEQ + 32 * (g >> 2) + 8 * (g & 3) + 4 * hh); }
#define MLA_DMA(j, bf) do { const unsigned char* kt_ = Kh + (size_t)(j) * 64 * pitch; const unsigned char* vt_ = VTh + (size_t)(j) * 64; \
        _Pragma("unroll") for (int i = 0; i < KPW; ++i) if (wid + 8 * i < NKP) \
            __builtin_amdgcn_global_load_lds((const unsigned*)(kt_ + kso[i]), (LAS unsigned*)(lds + OFF_K + (bf) * KB + (wid + 8 * i) * 1024), 16, 0, 0); \
        _Pragma("unroll") for (int i = 0; i < VPW; ++i) \
            __builtin_amdgcn_global_load_lds((const unsigned*)(vt_ + vso[i]), (LAS unsigned*)(lds + OFF_V + (bf) * VB + (wid + 8 * i) * 256), 4, 0, 0); } while (0)
    MLA_DMA(0, 0);
    if (NT > 1) MLA_DMA(1, 1);
    i32x8 qr[3];
#pragma unroll
    for (int s = 0; s < 3; ++s) { const i32x4 lo_ = *(const i32x4*)(Qh + (size_t)qpos * pitch + 64 * s + 32 * hi), hi_ = *(const i32x4*)(Qh + (size_t)qpos * pitch + 64 * s + 32 * hi + 16);
        qr[s] = __builtin_shufflevector(lo_, hi_, 0, 1, 2, 3, 4, 5, 6, 7); }
    float m_reg = -1e30f;
    f32x16 o[4], ol = f32x16{};
    const i32x8 ones8 = {0x38383838, 0x38383838, 0x38383838, 0x38383838, 0x38383838, 0x38383838, 0x38383838, 0x38383838};
#pragma unroll
    for (int d = 0; d < 4; ++d) o[d] = f32x16{};
    const int koff = r32 * KP + hi * 32, voff = r32 * VP + hi * 32;
    asm volatile("s_waitcnt vmcnt(0)" ::: "memory");
    __syncthreads();
#define MLA_QK(P, bufi, hf_) do { const LAS unsigned char* kb_ = lds + OFF_K + (bufi) * KB + (hf_) * 32 * KP + koff; P = f32x16{}; \
        i32x8 kw_[3]; _Pragma("unroll") for (int s = 0; s < 3; ++s) { const i32x4 lo_ = *(const LAS i32x4*)(kb_ + 64 * s), hi_ = *(const LAS i32x4*)(kb_ + 64 * s + 16); kw_[s] = __builtin_shufflevector(lo_, hi_, 0, 1, 2, 3, 4, 5, 6, 7); } \
        _Pragma("unroll") for (int s = 0; s < 3; ++s) P = __builtin_amdgcn_mfma_scale_f32_32x32x64_f8f6f4(kw_[s], qr[s], P, 0, 0, 0, 0, 0, 0); } while (0)
    f32x16 pA, pB, pC, pD;
    int buf = 0;
    { if (0 <= qlo + 31) { MLA_QK(pA, 0, 0); } if (32 <= qlo + 31) { MLA_QK(pB, 0, 1); } }
#define MLA_SMPV(P0, P1, kb, vbuf) do { \
        const bool a0_ = (kb) <= qlo + 31, a1_ = (kb) + 32 <= qlo + 31; \
        if (a0_) { \
            const float NEG = -__builtin_inff(); const int dq = qpos - (kb) - 4 * hi; \
            if (!a1_) { _Pragma("unroll") for (int r = 0; r < 16; ++r) P1[r] = NEG; } \
            if ((kb) + 63 > qlo) { _Pragma("unroll") for (int r = 0; r < 16; ++r) { const int c = (r & 3) + 8 * (r >> 2); if (dq - c < 0) P0[r] = NEG; if (dq - c - 32 < 0) P1[r] = NEG; } } \
            float pmax = fmaxf(P0[0], P1[0]); \
            _Pragma("unroll") for (int r = 1; r < 16; ++r) pmax = fmaxf(pmax, fmaxf(P0[r], P1[r])); \
            { auto rr = __builtin_amdgcn_permlane32_swap(__float_as_uint(pmax), __float_as_uint(pmax), false, false); pmax = fmaxf(__uint_as_float(rr[0]), __uint_as_float(rr[1])); } \
            const float mn = fmaxf(m_reg, pmax * SC); const float alpha = __builtin_amdgcn_exp2f(m_reg - mn); m_reg = mn; \
              \
              \
            const float c8 = 8.0f * SC, b8 = 8.0f * (PSHIFT + 7.0f - mn); \
            i32x8 pa; \
            _Pragma("unroll") for (int g = 0; g < 4; ++g) { unsigned w0 = 0u, w1 = 0u; \
                _Pragma("unroll") for (int b_ = 0; b_ < 4; ++b_) { w0 = __builtin_amdgcn_cvt_pk_u8_f32(__builtin_fmaf(P0[4 * g + b_], c8, b8), b_, w0); w1 = __builtin_amdgcn_cvt_pk_u8_f32(__builtin_fmaf(P1[4 * g + b_], c8, b8), b_, w1); } \
                pa[g] = (int)w0; pa[4 + g] = (int)w1; } \
            if (__any(alpha < 1.f)) { if (hi == 0) wsf[r32] = alpha; asm volatile("s_waitcnt lgkmcnt(0)" ::: "memory"); \
                _Pragma("unroll") for (int r = 0; r < 16; ++r) { const float a = wsf[crow(r, hi)]; ol[r] *= a; _Pragma("unroll") for (int d = 0; d < 4; ++d) o[d][r] *= a; } } \
            ol = __builtin_amdgcn_mfma_scale_f32_32x32x64_f8f6f4(pa, ones8, ol, 0, 0, 0, 0, 0, 0); \
            const LAS unsigned char* vb_ = lds + OFF_V + (vbuf) * VB + voff; \
            _Pragma("unroll") for (int d0 = 0; d0 < 4; ++d0) { const i32x4 lo_ = *(const LAS i32x4*)(vb_ + d0 * 32 * VP), hi_ = *(const LAS i32x4*)(vb_ + d0 * 32 * VP + 16); \
                o[d0] = __builtin_amdgcn_mfma_scale_f32_32x32x64_f8f6f4(pa, __builtin_shufflevector(lo_, hi_, 0, 1, 2, 3, 4, 5, 6, 7), o[d0], 0, 0, 0, 0, 0, 0); } \
        } } while (0)
    for (int t = 0; t < NT; t += 2) {
        {   if (t + 2 < NT) { const int b2 = buf == 0 ? 2 : buf - 1; MLA_DMA(t + 2, b2); }
            const int kb = t * 64, nb = buf == 2 ? 0 : buf + 1;
            if (kb + 64 <= qlo + 31) MLA_QK(pC, nb, 0);
            if (kb + 96 <= qlo + 31) MLA_QK(pD, nb, 1);
            MLA_SMPV(pA, pB, kb, buf);
            asm volatile("s_waitcnt vmcnt(0)" ::: "memory"); __syncthreads(); buf = nb; }
        {   if (t + 3 < NT) { const int b2 = buf == 0 ? 2 : buf - 1; MLA_DMA(t + 3, b2); }
            const int kb = (t + 1) * 64, nb = buf == 2 ? 0 : buf + 1;
            if (t + 2 < NT) { if (kb + 64 <= qlo + 31) MLA_QK(pA, nb, 0); if (kb + 96 <= qlo + 31) MLA_QK(pB, nb, 1); }
            MLA_SMPV(pC, pD, kb, buf);
            asm volatile("s_waitcnt vmcnt(0)" ::: "memory"); __syncthreads(); buf = nb; }
    }
#undef MLA_SMPV
#undef MLA_QK
#undef MLA_DMA
    bf16_t* Ow = Oh + (size_t)qlo * op;
#pragma unroll
    for (int r = 0; r < 16; ++r) { const int orow = crow(r, hi); const float rl = __builtin_amdgcn_rcpf(ol[r]);
#pragma unroll
        for (int d0 = 0; d0 < 4; ++d0) { const float v = o[d0][r] * rl; const float vn = __shfl_xor(v, 1);
            if ((r32 & 1) == 0) *(unsigned*)(Ow + (size_t)orow * op + d0 * 32 + r32) = cvt_pk_bf16(v, vn); } }
    __syncthreads();
}
}

constexpr int NWAVES = 8;
constexpr size_t MiB = 1u << 20;
constexpr size_t WS_CTL = 0, CTL_ZERO_BYTES = 1 * MiB;
constexpr size_t WS_WEIN = 2 * MiB;
constexpr size_t WS_WEOUT = 12 * MiB;
constexpr size_t WS_WOIN = 16 * MiB;
constexpr size_t WS_WUQ = 20 * MiB;
constexpr size_t WS_WUKV = 23 * MiB;
constexpr size_t WS_WOOUT = 25 * MiB;
constexpr size_t WS_B1P = 29 * MiB;
constexpr size_t WS_SSQ = 30 * MiB;
constexpr size_t WS_TOKER = 31 * MiB;
constexpr size_t WS_TOKG = 31 * MiB + 512 * 1024;
constexpr size_t WS_XN = 32 * MiB;
constexpr size_t WS_Z = 64 * MiB;
constexpr size_t WS_MIX = 144 * MiB;
constexpr size_t WS_QR = 176 * MiB;
constexpr size_t WS_KVR = 224 * MiB;
constexpr size_t WS_QF = 288 * MiB;
constexpr size_t WS_KF = 336 * MiB;
constexpr size_t WS_VT = 3200 * MiB;
constexpr size_t WS_W1 = 384 * MiB;
constexpr size_t WS_W2 = 896 * MiB;
constexpr size_t WS_XG = 1152 * MiB;
constexpr size_t WS_ACT = 1664 * MiB;
constexpr size_t WS_Y = 2176 * MiB;
constexpr size_t WS_END = 3216 * MiB;
constexpr int CW_MOE = 65536;
constexpr int CW_TMO = 0, CW_CODE = 1, CW_BAR = 4096, CW_CNT = 16384;
constexpr int RING_OFF = 0, RING_BYTES = 131072;
constexpr int LDSCTL_OFF = RING_BYTES, MISC_OFF = LDSCTL_OFF + 320;
constexpr int SCR_OFF = RING_BYTES + 1024;
constexpr int LDS_BYTES = 155648;
constexpr int SCR_BYTES = LDS_BYTES - SCR_OFF;

typedef GAS unsigned gu32;
#define RLX_AGENT __ATOMIC_RELAXED, __HIP_MEMORY_SCOPE_AGENT

#define XB_TMO      128
#define XB_XCNT(j)  (256  + 64 * (j))
#define XB_XSUB(j)  (1280 + 64 * (j))
#define XB_XGEN(j)  (2304 + 64 * (j))
#define XB_TOP      3328
#define XB_TOPGEN   3392
#define XCD_BAR_WORDS 3456
#define XB_SPIN_CAP (1u << 18)
__device__ __forceinline__ unsigned xb_ld(unsigned* p)              { return __hip_atomic_load(p, __ATOMIC_RELAXED, __HIP_MEMORY_SCOPE_AGENT); }
__device__ __forceinline__ unsigned xb_add(unsigned* p, unsigned v) { return __hip_atomic_fetch_add(p, v, __ATOMIC_RELAXED, __HIP_MEMORY_SCOPE_AGENT); }
__device__ __forceinline__ unsigned xb_xcc_id() { return (unsigned)__builtin_amdgcn_s_getreg((3 << 11) | 20) & 0xFu; }
#define XB_SPIN(cond, bar) do { unsigned _sp = 0; while (cond) { __builtin_amdgcn_s_sleep(1); \
    if ((++_sp & 255u) == 0u) { if (xb_ld(&(bar)[XB_TMO])) break; if (_sp > XB_SPIN_CAP) { atomicAdd(&(bar)[XB_TMO], 1u); break; } } } } while (0)
struct XcdBarrier { unsigned* bar; unsigned x; volatile LAS unsigned* st; };
__device__ __forceinline__ XcdBarrier xcd_barrier_post(unsigned* bar, volatile LAS unsigned* st) {
    XcdBarrier b; b.bar = bar; b.x = xb_xcc_id(); b.st = st;
    if (threadIdx.x == 0) (void)xb_add(&bar[XB_XCNT(b.x)], 1u);
    return b;
}
__device__ __forceinline__ void xcd_barrier_complete(unsigned* bar, unsigned x, unsigned& nloc, unsigned& nx) {
    const unsigned G = gridDim.x * gridDim.y * gridDim.z;
    unsigned sum, cnt, mine, sp = 0u;
    for (;;) {
        sum = 0u; cnt = 0u; mine = 0u;
#pragma unroll
        for (unsigned j = 0; j < 16; ++j) { const unsigned c = xb_ld(&bar[XB_XCNT(j)]); sum += c; cnt += (c > 0u) ? 1u : 0u; mine = (j == x) ? c : mine; }
        if (sum == G) break;
        __builtin_amdgcn_s_sleep(1);
        if ((++sp & 255u) == 0u) { if (xb_ld(&bar[XB_TMO])) break; if (sp > XB_SPIN_CAP) { atomicAdd(&bar[XB_TMO], 1u); break; } }
    }
    nloc = mine > 0u ? mine : 1u; nx = cnt > 0u ? cnt : 1u;
}
__device__ __forceinline__ void xcd_barrier(const XcdBarrier& b) {
    asm volatile("s_waitcnt vmcnt(0)" ::: "memory");
    __syncthreads();
    if (threadIdx.x == 0) {
        unsigned* bar = b.bar;
        __builtin_amdgcn_s_waitcnt(0);
        unsigned nloc = b.st[0], nx = b.st[1];
        if (nloc == 0u) { xcd_barrier_complete(bar, b.x, nloc, nx); b.st[0] = nloc; b.st[1] = nx; }
        const unsigned old = xb_add(&bar[XB_XSUB(b.x)], 1u);
        const unsigned gen = old / nloc;
        if (old + 1u == (gen + 1u) * nloc) {
            __builtin_amdgcn_fence(__ATOMIC_RELEASE, "agent");
            asm volatile("s_waitcnt vmcnt(0)" ::: "memory");
            const unsigned og = xb_add(&bar[XB_TOP], 1u);
            const unsigned tg = og / nx;
            if (og + 1u == (tg + 1u) * nx) xb_add(&bar[XB_TOPGEN], 1u);
            else XB_SPIN(xb_ld(&bar[XB_TOPGEN]) == tg, bar);
            __builtin_amdgcn_fence(__ATOMIC_ACQUIRE, "agent");
            xb_add(&bar[XB_XGEN(b.x)], 1u);
            asm volatile("s_waitcnt vmcnt(0)" ::: "memory");
        } else {
            XB_SPIN(xb_ld(&bar[XB_XGEN(b.x)]) == gen, bar);
            __builtin_amdgcn_fence(__ATOMIC_ACQUIRE, "agent");
            asm volatile("s_waitcnt vmcnt(0)" ::: "memory");
        }
    }
    __syncthreads();
}

struct Args {
    const float* in[24]; float* out; unsigned char* ws; int stage_limit; int pad;
};
enum { I_X = 0, I_MIXN, I_FFNN, I_EWIN, I_EWS, I_EBS, I_EGV, I_EGQ, I_EGK, I_EWOUT, I_OWIN, I_OGCQ, I_OGCKV, I_OWUQ, I_OWUKV, I_OGQ, I_OGK, I_OWOUT,
       I_RW, I_RB, I_W1, I_B1, I_W2, I_B2 };

struct Frame {
    LAS unsigned char* lds;
    int vcu, G;
};

__device__ __forceinline__ float wave_sum(float v) {
#pragma unroll
    for (int o = 1; o < 64; o <<= 1) v += __shfl_xor(v, o);
    return v;
}
#define LDS_WAIT() asm volatile("s_waitcnt lgkmcnt(0)" ::: "memory")

template <int MODE> __device__ __forceinline__ int dst_row(int o) {
    if (MODE == 1) { if (o >= 1024 && o < 2048) return (o & ~255) | (((o >> 5) & 1) << 7) | (((o >> 6) & 3) << 5) | (o & 31); return o; }
    if (MODE == 2) return ((o >> 8) << 8) | ((o & 1) << 7) | ((o & 255) >> 1);
    return o;
}
template <int MODE>
__device__ __forceinline__ void transpose_item(const float* __restrict__ W, int K, int N, bf16_t* __restrict__ WT, const float* __restrict__ gain, LAS float* scr, int item, int lane) {
    const int nblk = N / 32, kb = item / nblk, nb = item % nblk, k0 = 64 * kb, n0 = 32 * nb;
#pragma unroll 8
    for (int i = 0; i < 32; ++i) { const int kk = 2 * i + (lane >> 5); float w = W[(size_t)(k0 + kk) * N + n0 + (lane & 31)]; if (gain) w *= gain[k0 + kk]; scr[kk * 33 + (lane & 31)] = w; }
    LDS_WAIT(); asm volatile("" ::: "memory");
    const int c = lane & 7;
#pragma unroll
    for (int j = 0; j < 4; ++j) { const int n = (lane >> 3) + 8 * j; const LAS float* s = scr + (8 * c) * 33 + n;
        u32x4 o; o.x = cvt_pk_bf16(s[0 * 33], s[1 * 33]); o.y = cvt_pk_bf16(s[2 * 33], s[3 * 33]); o.z = cvt_pk_bf16(s[4 * 33], s[5 * 33]); o.w = cvt_pk_bf16(s[6 * 33], s[7 * 33]);
        *(u32x4*)(WT + (size_t)dst_row<MODE>(n0 + n) * K + k0 + 8 * c) = o; }
    LDS_WAIT(); asm volatile("" ::: "memory");
}
template <int MODE>
__device__ __forceinline__ void transpose_job(Frame& F, const float* W, int K, int N, int nmat, size_t src_stride, bf16_t* WT, size_t dst_stride, const float* gain, int gain_stride) {
    int tid_ = threadIdx.x; asm volatile("" : "+v"(tid_));
    const int wave = __builtin_amdgcn_readfirstlane(tid_ >> 6), lane = tid_ & 63;
    LAS float* scr = (LAS float*)(F.lds + RING_OFF + wave * 16384);
    const int gw = F.vcu * NWAVES + wave, NGW = F.G * NWAVES;
    const int per = (K / 64) * (N / 32), total = per * nmat;
    for (int it = gw; it < total; it += NGW) { const int mi = it / per, item = it - mi * per;
        transpose_item<MODE>(W + (size_t)mi * src_stride, K, N, WT + (size_t)mi * dst_stride, gain ? gain + (size_t)mi * gain_stride : nullptr, scr, item, lane); }
}


__device__ __forceinline__ void tr8_load(f32x4 (&v)[8], const float* __restrict__ W, int N, int item, int lane) {
    const int nblk = N / 32, kb = item / nblk, nb = item % nblk, k0 = 64 * kb, n0 = 32 * nb;
#pragma unroll
    for (int i = 0; i < 8; ++i) v[i] = __builtin_nontemporal_load((const f32x4*)(W + (size_t)(k0 + 8 * i + (lane >> 3)) * N + n0 + 4 * (lane & 7)));
}
template <int MODE>
__device__ __forceinline__ void tr8_store(const f32x4 (&v)[8], int K, int N, unsigned char* __restrict__ WT, LAS float* scr, int item, int lane) {
    const int nblk = N / 32, kb = item / nblk, nb = item % nblk, k0 = 64 * kb, n0 = 32 * nb;
#pragma unroll
    for (int i = 0; i < 8; ++i) { LAS float* d = scr + (8 * i + (lane >> 3)) * 33 + 4 * (lane & 7);
        d[0] = v[i].x * W8_SCALE; d[1] = v[i].y * W8_SCALE; d[2] = v[i].z * W8_SCALE; d[3] = v[i].w * W8_SCALE; }
    LDS_WAIT(); asm volatile("" ::: "memory");
    const int c = lane & 3;
#pragma unroll
    for (int j = 0; j < 2; ++j) { const int n = (lane >> 2) + 16 * j; const LAS float* s = scr + (16 * c) * 33 + n;
        u32x4 o; o.x = pk4_fp8(s[0 * 33], s[1 * 33], s[2 * 33], s[3 * 33]); o.y = pk4_fp8(s[4 * 33], s[5 * 33], s[6 * 33], s[7 * 33]);
        o.z = pk4_fp8(s[8 * 33], s[9 * 33], s[10 * 33], s[11 * 33]); o.w = pk4_fp8(s[12 * 33], s[13 * 33], s[14 * 33], s[15 * 33]);
        __builtin_nontemporal_store(o, (u32x4*)(WT + (size_t)dst_row<MODE>(n0 + n) * K + k0 + 16 * c)); }
    LDS_WAIT(); asm volatile("" ::: "memory");
}
template <int MODE>
__device__ __forceinline__ void transpose_job_fp8(Frame& F, const float* W, int K, int N, int nmat, size_t src_stride, unsigned char* WT, size_t dst_stride) {
    int tid_ = threadIdx.x; asm volatile("" : "+v"(tid_));
    const int wave = __builtin_amdgcn_readfirstlane(tid_ >> 6), lane = tid_ & 63;
    LAS float* scr = (LAS float*)(F.lds + RING_OFF + wave * 16384);
    const int gw = F.vcu * NWAVES + wave, NGW = F.G * NWAVES;
    const int per = (K / 64) * (N / 32), total = per * nmat;
    f32x4 cur[8], nxt[8];
    int it = gw;
    if (it < total) { const int mi = it / per; tr8_load(cur, W + (size_t)mi * src_stride, N, it - mi * per, lane); }
    for (; it < total; it += NGW) {
        const int itn = it + NGW;
        if (itn < total) { const int mn = itn / per; tr8_load(nxt, W + (size_t)mn * src_stride, N, itn - mn * per, lane); }
        const int mi = it / per;
        tr8_store<MODE>(cur, K, N, WT + (size_t)mi * dst_stride, scr, it - mi * per, lane);
#pragma unroll
        for (int i = 0; i < 8; ++i) cur[i] = nxt[i];
    }
}

__device__ __forceinline__ void rms_row_to_fp8(int lane, const float* xrow, const float* g, unsigned char* orow, float* copy) {
    const f32x4* xr = (const f32x4*)xrow + lane; const f32x4* gr = (const f32x4*)g + lane;
    f32x4 v[4]; float s = 0.f;
#pragma unroll
    for (int j = 0; j < 4; ++j) { v[j] = xr[64 * j]; s += (v[j].x * v[j].x + v[j].y * v[j].y) + (v[j].z * v[j].z + v[j].w * v[j].w); }
    const float rstd = 1.0f / sqrtf(wave_sum(s) * (1.f / DM) + EPS);
    unsigned* o4 = (unsigned*)orow + lane;
#pragma unroll
    for (int j = 0; j < 4; ++j) { const f32x4 gg = gr[64 * j]; if (copy) ((f32x4*)copy + lane)[64 * j] = v[j];
        o4[64 * j] = pk4_fp8(v[j].x * rstd * gg.x, v[j].y * rstd * gg.y, v[j].z * rstd * gg.z, v[j].w * rstd * gg.w); }
}
__device__ __forceinline__ void rms_row_to_bf16(int lane, const float* xrow, const float* g, bf16_t* orow, float* copy) {
    const f32x4* xr = (const f32x4*)xrow + lane; const f32x4* gr = (const f32x4*)g + lane;
    f32x4 v[4]; float s = 0.f;
#pragma unroll
    for (int j = 0; j < 4; ++j) { v[j] = xr[64 * j]; s += (v[j].x * v[j].x + v[j].y * v[j].y) + (v[j].z * v[j].z + v[j].w * v[j].w); }
    const float rstd = 1.0f / sqrtf(wave_sum(s) * (1.f / DM) + EPS);
    u32x2* o8 = (u32x2*)orow + lane;
#pragma unroll
    for (int j = 0; j < 4; ++j) { const f32x4 gg = gr[64 * j]; if (copy) ((f32x4*)copy + lane)[64 * j] = v[j];
        u32x2 w; w.x = cvt_pk_bf16(v[j].x * rstd * gg.x, v[j].y * rstd * gg.y); w.y = cvt_pk_bf16(v[j].z * rstd * gg.z, v[j].w * rstd * gg.w); o8[64 * j] = w; }
}

namespace pg8 {
struct EpiEvenIn {
    static constexpr bool PERM = false;
    bf16_t* Z; const float* gq; const float* gk;
    __device__ __forceinline__ void operator()(const f32x4 (&acc)[2][2][4][2], const Unit& u, int wr, int wc, int fr, int fq) const {
        const int row0 = u.pm * BM + wr * 64 + fr, pn = u.pn;
        if (pn >= 4 && pn < 8) {
            const float* g = pn < 6 ? gq : gk; const float sc = pn < 6 ? C2_B : 1.0f;
            f32x4 gv[2][2];
#pragma unroll
            for (int bj = 0; bj < 2; ++bj)
#pragma unroll
                for (int n = 0; n < 2; ++n) gv[bj][n] = *(const f32x4*)(g + 32 * bj + 16 * n + 4 * fq);
#pragma unroll
            for (int ai = 0; ai < 2; ++ai)
#pragma unroll
                for (int m = 0; m < 4; ++m) {
                    float ss = 0.f;
#pragma unroll
                    for (int bj = 0; bj < 2; ++bj)
#pragma unroll
                        for (int n = 0; n < 2; ++n) { const f32x4 v = acc[ai][bj][m][n]; ss += (v[0] * v[0] + v[1] * v[1]) + (v[2] * v[2] + v[3] * v[3]); }
                    ss += __shfl_xor(ss, 16); ss += __shfl_xor(ss, 32);
                    const float rstd = sc / sqrtf(ss * (1.0f / 64.0f) + EPS);
                    bf16_t* rowp = Z + (size_t)(row0 + ai * HALF + m * 16) * EVEN_IN + pn * BM + wc * 64 + 4 * fq;
#pragma unroll
                    for (int bj = 0; bj < 2; ++bj)
#pragma unroll
                        for (int n = 0; n < 2; ++n) { const f32x4 v = acc[ai][bj][m][n] * rstd * gv[bj][n];
                            u32x2 w; w.x = cvt_pk_bf16(v[0], v[1]); w.y = cvt_pk_bf16(v[2], v[3]); *(u32x2*)(rowp + 32 * bj + 16 * n) = w; }
                }
        } else {
            const bool act = pn < 4;
#pragma unroll
            for (int ai = 0; ai < 2; ++ai)
#pragma unroll
                for (int m = 0; m < 4; ++m) { bf16_t* rowp = Z + (size_t)(row0 + ai * HALF + m * 16) * EVEN_IN + pn * BM + wc * 32 + 4 * fq;
#pragma unroll
                    for (int bj = 0; bj < 2; ++bj)
#pragma unroll
                        for (int n = 0; n < 2; ++n) { f32x4 v = acc[ai][bj][m][n]; if (act) v = gelu4(v);
                            u32x2 w; w.x = cvt_pk_bf16(v[0], v[1]); w.y = cvt_pk_bf16(v[2], v[3]); *(u32x2*)(rowp + bj * HALF + 16 * n) = w; } }
        }
    }
};
struct EpiResid {
    static constexpr bool PERM = false;
    float* out;
    __device__ __forceinline__ void operator()(const f32x4 (&acc)[2][2][4][2], const Unit& u, int wr, int wc, int fr, int fq) const {
        const int row0 = u.pm * BM + wr * 64 + fr;
#pragma unroll
        for (int ai = 0; ai < 2; ++ai)
#pragma unroll
            for (int m = 0; m < 4; ++m) { float* rowp = out + (size_t)(row0 + ai * HALF + m * 16) * DM + u.pn * BM + wc * 32 + 4 * fq;
#pragma unroll
                for (int bj = 0; bj < 2; ++bj)
#pragma unroll
                    for (int n = 0; n < 2; ++n) { f32x4* p = (f32x4*)(rowp + bj * HALF + 16 * n); *p = *p + acc[ai][bj][m][n]; }
                if (m & 1) asm volatile("" ::: "memory"); }
    }
};
struct EpiOddIn {
    static constexpr bool PERM = false;
    bf16_t* Z; float* ssq;
    __device__ __forceinline__ void operator()(const f32x4 (&acc)[2][2][4][2], const Unit& u, int wr, int wc, int fr, int fq) const {
        const int row0 = u.pm * BM + wr * 64 + fr, pn = u.pn;
#pragma unroll
        for (int ai = 0; ai < 2; ++ai)
#pragma unroll
            for (int m = 0; m < 4; ++m) { const int row = row0 + ai * HALF + m * 16; bf16_t* rowp = Z + (size_t)row * ODD_INP + pn * BM + wc * 32 + 4 * fq;
                float ss = 0.f;
#pragma unroll
                for (int bj = 0; bj < 2; ++bj)
#pragma unroll
                    for (int n = 0; n < 2; ++n) { const f32x4 v = acc[ai][bj][m][n] * W8_INV; ss += (v[0] * v[0] + v[1] * v[1]) + (v[2] * v[2] + v[3] * v[3]);
                        u32x2 w; w.x = cvt_pk_bf16(v[0], v[1]); w.y = cvt_pk_bf16(v[2], v[3]); *(u32x2*)(rowp + bj * HALF + 16 * n) = w; }
                ss += __shfl_xor(ss, 16); ss += __shfl_xor(ss, 32);
                if (fq == 0) ssq[(size_t)row * 16 + pn * 4 + wc] = ss; }
    }
};
template <int NS> struct EpiRowScale {
    static constexpr bool PERM = true;
    bf16_t* O; int ldc; const float* ssq; int s0; float inv_cols;
    __device__ __forceinline__ void operator()(const f32x4 (&acc)[2][2][4][2], const Unit& u, int wr, int wc, int fr, int fq) const {
        const int row0 = u.pm * BM + wr * 64 + fr; const int col0 = u.pn * BM + wc * 32 + 8 * fq;
#pragma unroll
        for (int ai = 0; ai < 2; ++ai)
#pragma unroll
            for (int m = 0; m < 4; ++m) { const int row = row0 + ai * HALF + m * 16;
                float ss = 0.f; const f32x4* sp = (const f32x4*)(ssq + (size_t)row * 16 + s0);
#pragma unroll
                for (int q = 0; q < NS; ++q) { const f32x4 t = sp[q]; ss += (t[0] + t[1]) + (t[2] + t[3]); }
                const float rstd = 1.0f / sqrtf(ss * inv_cols + EPS);
                bf16_t* rowp = O + (size_t)row * ldc + col0;
#pragma unroll
                for (int bj = 0; bj < 2; ++bj) { const f32x4 v0 = acc[ai][bj][m][0] * rstd, v1 = acc[ai][bj][m][1] * rstd;
                    u32x4 w; w.x = cvt_pk_bf16(v0[0], v0[1]); w.y = cvt_pk_bf16(v0[2], v0[3]); w.z = cvt_pk_bf16(v1[0], v1[1]); w.w = cvt_pk_bf16(v1[2], v1[3]);
                    *(u32x4*)(rowp + bj * HALF) = w; }
                asm volatile("" ::: "memory"); }
    }
};
__device__ __forceinline__ void store8_sc1(void* p, u32x2 v) { asm volatile("global_store_dwordx2 %0, %1, off sc1" :: "v"(p), "v"(v) : "memory"); }
template <bool WT = false> struct EpiSwigluT {
    static constexpr bool PERM = true;
    unsigned char* ACT; const float* b1p;
    __device__ __forceinline__ void operator()(const f32x4 (&acc)[2][2][4][2], const Unit& u, int wr, int wc, int fr, int fq) const {
        const int row0 = u.pm * BM + wr * 64 + fr, e = u.pb >> 3, pn = u.pn;
        const float* bp = b1p + (size_t)e * 2048 + pn * BM + wc * 32 + 8 * fq;
        f32x4 bg[2], bl[2];
#pragma unroll
        for (int n = 0; n < 2; ++n) { bg[n] = *(const f32x4*)(bp + 4 * n); bl[n] = *(const f32x4*)(bp + HALF + 4 * n); }
#pragma unroll
        for (int ai = 0; ai < 2; ++ai)
#pragma unroll
            for (int m = 0; m < 4; ++m) { unsigned char* rowp = ACT + (size_t)(row0 + ai * HALF + m * 16) * DE + pn * HALF + wc * 32 + 8 * fq;
                float a[8];
#pragma unroll
                for (int n = 0; n < 2; ++n) { const f32x4 gv = acc[ai][0][m][n] * W8_INV + bg[n], lv = acc[ai][1][m][n] * W8_INV + bl[n];
#pragma unroll
                    for (int i = 0; i < 4; ++i) { const float gl = fminf(gv[i], 7.0f), li = fminf(fmaxf(lv[i], -7.0f), 7.0f);
                        const float sg = __builtin_amdgcn_rcpf(1.0f + __builtin_amdgcn_exp2f(-1.702f * LOG2E * gl));
                        a[4 * n + i] = gl * sg * (li + 1.0f); } }
                u32x2 w; w.x = pk4_fp8(a[0], a[1], a[2], a[3]); w.y = pk4_fp8(a[4], a[5], a[6], a[7]);
                if (WT) store8_sc1(rowp, w); else *(u32x2*)rowp = w; }
    }
};
typedef EpiSwigluT<false> EpiSwiglu;
struct EpiDown {
    static constexpr bool PERM = true;
    bf16_t* Y; const float* b2;
    __device__ __forceinline__ void operator()(const f32x4 (&acc)[2][2][4][2], const Unit& u, int wr, int wc, int fr, int fq) const {
        const int row0 = u.pm * BM + wr * 64 + fr, e = u.pb >> 2, pn = u.pn;
        const float* bp = b2 + (size_t)e * DM + pn * BM + wc * 32 + 8 * fq;
        f32x4 bv[2][2];
#pragma unroll
        for (int bj = 0; bj < 2; ++bj)
#pragma unroll
            for (int n = 0; n < 2; ++n) bv[bj][n] = *(const f32x4*)(bp + bj * HALF + 4 * n);
#pragma unroll
        for (int ai = 0; ai < 2; ++ai)
#pragma unroll
            for (int m = 0; m < 4; ++m) { bf16_t* rowp = Y + (size_t)(row0 + ai * HALF + m * 16) * DM + pn * BM + wc * 32 + 8 * fq;
#pragma unroll
                for (int bj = 0; bj < 2; ++bj) { const f32x4 v0 = acc[ai][bj][m][0] * W8_INV + bv[bj][0], v1 = acc[ai][bj][m][1] * W8_INV + bv[bj][1];
                    u32x4 w; w.x = cvt_pk_bf16(v0[0], v0[1]); w.y = cvt_pk_bf16(v0[2], v0[3]); w.z = cvt_pk_bf16(v1[0], v1[1]); w.w = cvt_pk_bf16(v1[2], v1[3]);
                    *(u32x4*)(rowp + bj * HALF) = w; } }
    }
};
struct MoeOrder {
    const LAS int* tbl; int nN, G, c;
    __device__ bool next(int i, Unit& u) const {
        const long L = (long)i * G + c; const int rb = (int)(L / nN);
        if (rb >= __builtin_amdgcn_readfirstlane(tbl[32])) return false;
        int e = 0;
#pragma unroll
        for (int k = 1; k < 32; ++k) e += (tbl[k] <= rb) ? 1 : 0;
        e = __builtin_amdgcn_readfirstlane(e); const int rbl = __builtin_amdgcn_readfirstlane(rb - tbl[e]);
        u.pm = e * (ECAP / BM) + rbl; u.pn = (int)(L % nN); u.pb = e * nN + u.pn; u.kind = 0; u.rb = rb; return true;
    }
    __device__ __forceinline__ void a_ready(const Unit&) const {}
    __device__ __forceinline__ void pre_epi() const {}
    __device__ __forceinline__ void done(const Unit&) const {}
    __device__ __forceinline__ void finish() const {}
};

constexpr unsigned MOE_SPIN_CAP = 1u << 22;
struct MoeMergedOrder {
    const LAS int* tbl; int G, c; gu32* cnt;
    mutable int pend;
    __device__ __forceinline__ void flush() const {
        if (pend >= 0) { asm volatile("s_waitcnt vmcnt(0)" ::: "memory");
            if ((threadIdx.x & 63) == 0) __hip_atomic_fetch_add(cnt + 16 * pend, 1u, __ATOMIC_RELAXED, __HIP_MEMORY_SCOPE_AGENT);
            pend = -1; } }
    __device__ bool next(int i, Unit& u) const {
        const int nb = __builtin_amdgcn_readfirstlane(tbl[32]);
        long L = (long)i * G + c; int nN = 8, kind = 0;
        if (L >= (long)nb * 8) { L -= (long)nb * 8; nN = 4; kind = 1; if (L >= (long)nb * 4) return false; }
        const int rb = (int)(L / nN);
        int e = 0;
#pragma unroll
        for (int k = 1; k < 32; ++k) e += (tbl[k] <= rb) ? 1 : 0;
        e = __builtin_amdgcn_readfirstlane(e); const int rbl = __builtin_amdgcn_readfirstlane(rb - tbl[e]);
        u.pm = e * (ECAP / BM) + rbl; u.pn = (int)(L % nN); u.pb = e * nN + u.pn; u.kind = kind; u.rb = rb; return true;
    }
    __device__ __forceinline__ void a_ready(const Unit& u) const {
        if (u.kind == 1) {
            flush();
            if (threadIdx.x < 64) {
                unsigned sp = 0;
                while ((unsigned)__builtin_amdgcn_readfirstlane(__hip_atomic_load(cnt + 16 * u.rb, __ATOMIC_RELAXED, __HIP_MEMORY_SCOPE_AGENT)) < 64u) { __builtin_amdgcn_s_sleep(2); if (++sp > MOE_SPIN_CAP) break; }
                __builtin_amdgcn_fence(__ATOMIC_ACQUIRE, "agent");
                asm volatile("s_waitcnt vmcnt(0)" ::: "memory");
            }
            __builtin_amdgcn_s_barrier();
        }
    }
    __device__ __forceinline__ void pre_epi() const { flush(); }
    __device__ __forceinline__ void done(const Unit& u) const { if (u.kind == 0) pend = u.rb; }
    __device__ __forceinline__ void finish() const { flush(); }
};
struct EpiMoe {
    static constexpr bool PERM = true;
    EpiSwigluT<true> up; EpiDown down;
    __device__ __forceinline__ void operator()(const f32x4 (&acc)[2][2][4][2], const Unit& u, int wr, int wc, int fr, int fq) const {
        if (u.kind == 0) up(acc, u, wr, wc, fr, fq); else down(acc, u, wr, wc, fr, fq);
    }
};
}

__device__ __forceinline__ void gmlp_unit(Frame& F, const bf16_t* Z, bf16_t* MIX, const float* Ws, const float* bs, const float* gv, int unit) {
    constexpr int VP = 272;
    LAS unsigned char* VT = F.lds + RING_OFF;
    const int h = unit & 3, chunk = unit >> 2;
    int tid_ = threadIdx.x; asm volatile("" : "+v"(tid_));
    const int t0 = chunk * 128, tid = tid_, lane = tid & 63, w = __builtin_amdgcn_readfirstlane(tid >> 6);
    {
        const int s = tid >> 2, dq = (tid & 3) * 32;
        const bf16_t* vp = Z + (size_t)(t0 + s) * EVEN_IN + 512 + h * 128 + dq;
        u32x4 raw[4]; float ss = 0.f;
#pragma unroll
        for (int i = 0; i < 4; ++i) { raw[i] = *(const u32x4*)(vp + 8 * i);
#pragma unroll
            for (int j = 0; j < 4; ++j) { const float a = bflo(raw[i][j]), b = bfhi(raw[i][j]); ss += a * a + b * b; } }
        ss += __shfl_xor(ss, 1); ss += __shfl_xor(ss, 2);
        const float rstd = 1.0f / sqrtf(ss * (1.0f / 128.0f) + EPS);
#pragma unroll
        for (int i = 0; i < 4; ++i)
#pragma unroll
            for (int j = 0; j < 4; ++j) { const int d = dq + 8 * i + 2 * j;
                *(LAS bf16_t*)(VT + (d) * VP + s * 2) = f2bf(bflo(raw[i][j]) * rstd);
                *(LAS bf16_t*)(VT + (d + 1) * VP + s * 2) = f2bf(bfhi(raw[i][j]) * rstd); }
    }
    __syncthreads();
    const int fr = lane & 15, fq = lane >> 4;
    f32x4 acc[8];
#pragma unroll
    for (int nb = 0; nb < 8; ++nb) acc[nb] = (f32x4){0.f, 0.f, 0.f, 0.f};
    const int trow = 16 * w + fr;
    const float* wrow = Ws + ((size_t)h * 128 + trow) * 128;
#pragma unroll
    for (int ks = 0; ks < 4; ++ks) {
        if (32 * ks <= 16 * w + 15) {
            const int s0 = 32 * ks + 8 * fq;
            const f32x4 wa = *(const f32x4*)(wrow + s0), wb = *(const f32x4*)(wrow + s0 + 4);
            float wv[8] = {wa[0], wa[1], wa[2], wa[3], wb[0], wb[1], wb[2], wb[3]};
#pragma unroll
            for (int j = 0; j < 8; ++j) if (s0 + j > trow) wv[j] = 0.f;
            u32x4 aw; aw.x = cvt_pk_bf16(wv[0], wv[1]); aw.y = cvt_pk_bf16(wv[2], wv[3]); aw.z = cvt_pk_bf16(wv[4], wv[5]); aw.w = cvt_pk_bf16(wv[6], wv[7]);
            const bf16x8 af = __builtin_bit_cast(bf16x8, aw);
#pragma unroll
            for (int nb = 0; nb < 8; ++nb) { const bf16x8 bfr = *(const LAS bf16x8*)(VT + (16 * nb + fr) * VP + s0 * 2);
                acc[nb] = __builtin_amdgcn_mfma_f32_16x16x32_bf16(af, bfr, acc[nb], 0, 0, 0); }
        }
    }
#pragma unroll
    for (int i = 0; i < 4; ++i) { const int tl = 16 * w + 4 * fq + i; const float bt = bs[h * 128 + tl];
        const bf16_t* up = Z + (size_t)(t0 + tl) * EVEN_IN + h * 128 + fr; bf16_t* op = MIX + (size_t)(t0 + tl) * DM + h * 128 + fr;
#pragma unroll
        for (int nb = 0; nb < 8; ++nb) { const float uu = bf2f(up[16 * nb]); op[16 * nb] = f2bf(uu * (gv[h * 128 + 16 * nb + fr] * acc[nb][i] + bt)); } }
    __syncthreads();
}

__device__ __forceinline__ void router_phase(Frame& F, const float* x, const float* gain, const float* Wr, const float* br, gu32* cnt  ,
                                             unsigned* tok_er, float* tok_g, unsigned char* XG) {
    LAS float* WrT = (LAS float*)(F.lds + RING_OFF);
    LAS float* lg = (LAS float*)(F.lds + SCR_OFF);
    LAS unsigned* hist = (LAS unsigned*)(F.lds + SCR_OFF + 64 * 33 * 4);
    LAS unsigned* base = hist + 32;
    LAS unsigned* ers = base + 32;
    int tid_ = threadIdx.x; asm volatile("" : "+v"(tid_));
    const int tid = tid_, lane = tid & 63, w = __builtin_amdgcn_readfirstlane(tid >> 6);
#ifndef RTR_REP_A
#define RTR_REP_A 1
#define RTR_REP_B 1
#define RTR_REP_C 1
#endif
    for (int ra_ = 0; ra_ < RTR_REP_A; ++ra_)
    for (int idx = tid; idx < 8192; idx += 512) { const int e4 = idx >> 10, k = idx & 1023; const f32x4 v = *(const f32x4*)(Wr + (size_t)k * 32 + 4 * e4);
        WrT[(4 * e4 + 0) * 1024 + k] = v[0]; WrT[(4 * e4 + 1) * 1024 + k] = v[1]; WrT[(4 * e4 + 2) * 1024 + k] = v[2]; WrT[(4 * e4 + 3) * 1024 + k] = v[3]; }
    __syncthreads();
    f32x4 gg[4];
#pragma unroll
    for (int j = 0; j < 4; ++j) gg[j] = ((const f32x4*)gain + lane)[64 * j];
    const float brl = br[lane & 31];
    {   const int tg = F.vcu;
    const int tokb = tg * 64;
    if (tid < 32) hist[tid] = 0u;
    for (int rb_ = 0; rb_ < RTR_REP_B; ++rb_)
#pragma unroll 1
    for (int tp = 0; tp < 4; ++tp) {
        f32x4 ha[4], hb[4];
        {   const float* r0 = x + (size_t)(tokb + w * 8 + 2 * tp) * DM;
#pragma unroll
            for (int j = 0; j < 4; ++j) { ha[j] = ((const f32x4*)r0 + lane)[64 * j]; hb[j] = ((const f32x4*)(r0 + DM) + lane)[64 * j]; } }
        float sa = 0.f, sb = 0.f;
#pragma unroll
        for (int j = 0; j < 4; ++j) { sa += (ha[j].x * ha[j].x + ha[j].y * ha[j].y) + (ha[j].z * ha[j].z + ha[j].w * ha[j].w); sb += (hb[j].x * hb[j].x + hb[j].y * hb[j].y) + (hb[j].z * hb[j].z + hb[j].w * hb[j].w); }
        const float ra = 1.0f / sqrtf(wave_sum(sa) * (1.f / DM) + EPS), rb = 1.0f / sqrtf(wave_sum(sb) * (1.f / DM) + EPS);
#pragma unroll
        for (int j = 0; j < 4; ++j) { ha[j] = ha[j] * ra * gg[j]; hb[j] = hb[j] * rb * gg[j]; }
        float a[32], b[32];
#pragma unroll
        for (int e = 0; e < 32; ++e) { f32x2 ta = {0.f, 0.f}, tb = {0.f, 0.f};
#pragma unroll
            for (int j = 0; j < 4; ++j) { const f32x4 wv = *(const LAS f32x4*)(WrT + e * 1024 + 256 * j + 4 * lane);
                const f32x2 w01 = {wv.x, wv.y}, w23 = {wv.z, wv.w};
                ta = (f32x2){ha[j].x, ha[j].y} * w01 + ta; ta = (f32x2){ha[j].z, ha[j].w} * w23 + ta;
                tb = (f32x2){hb[j].x, hb[j].y} * w01 + tb; tb = (f32x2){hb[j].z, hb[j].w} * w23 + tb; }
            a[e] = ta.x + ta.y; b[e] = tb.x + tb.y; if ((e & 3) == 3) __builtin_amdgcn_sched_barrier(0); }
#define RSTEP(N, BIT) _Pragma("unroll") for (int i = 0; i < N; ++i) { const bool up = (lane & BIT) != 0; \
            { const float keep = up ? a[2 * i + 1] : a[2 * i], send = up ? a[2 * i] : a[2 * i + 1]; a[i] = keep + __shfl_xor(send, BIT); } \
            { const float keep = up ? b[2 * i + 1] : b[2 * i], send = up ? b[2 * i] : b[2 * i + 1]; b[i] = keep + __shfl_xor(send, BIT); } }
        RSTEP(16, 1) RSTEP(8, 2) RSTEP(4, 4) RSTEP(2, 8) RSTEP(1, 16)
#undef RSTEP
        const float la = a[0] + __shfl_xor(a[0], 32) + brl, lb = b[0] + __shfl_xor(b[0], 32) + brl;
        if (lane < 32) { lg[(w * 8 + 2 * tp) * 33 + lane] = la; lg[(w * 8 + 2 * tp + 1) * 33 + lane] = lb; }
        asm volatile("" ::: "memory"); __builtin_amdgcn_sched_barrier(0);
    }
    __syncthreads();
    unsigned my_e[4] = {0, 0, 0, 0}, my_lr[4] = {0, 0, 0, 0}; float my_g[4] = {0, 0, 0, 0};
    if (tid < 64) {
        float v[32];
#pragma unroll
        for (int e = 0; e < 32; ++e) v[e] = lg[tid * 33 + e];
        int c0 = -1, c1 = -1, c2 = -1; float tv[4];
#pragma unroll
        for (int r = 0; r < 4; ++r) { float best = -__builtin_inff(); int bi = 0;
#pragma unroll
            for (int e = 0; e < 32; ++e) { const bool ok = (e != c0) && (e != c1) && (e != c2); if (ok && v[e] > best) { best = v[e]; bi = e; } }
            tv[r] = best; my_e[r] = (unsigned)bi; if (r == 0) c0 = bi; else if (r == 1) c1 = bi; else if (r == 2) c2 = bi; }
        const float p1 = __expf(tv[1] - tv[0]), p2 = __expf(tv[2] - tv[0]), p3 = __expf(tv[3] - tv[0]); const float inv = 1.0f / (1.0f + p1 + p2 + p3);
        my_g[0] = inv; my_g[1] = p1 * inv; my_g[2] = p2 * inv; my_g[3] = p3 * inv;
#pragma unroll
        for (int r = 0; r < 4; ++r) my_lr[r] = __hip_atomic_fetch_add(hist + my_e[r], 1u, __ATOMIC_RELAXED, __HIP_MEMORY_SCOPE_WORKGROUP);
    }
    __syncthreads();
    if (tid < 32) { const unsigned hc = hist[tid]; base[tid] = hc ? __hip_atomic_fetch_add(cnt + 64 * tid, hc, RLX_AGENT) : 0u; }
    __syncthreads();
    if (tid < 64) {
        u32x4 er; f32x4 gt;
#pragma unroll
        for (int r = 0; r < 4; ++r) { const unsigned rank = base[my_e[r]] + my_lr[r]; er[r] = (my_e[r] << 16) | rank; gt[r] = my_g[r]; ers[tid * 4 + r] = er[r]; }
        *(u32x4*)(tok_er + (size_t)(tokb + tid) * 4) = er; *(f32x4*)(tok_g + (size_t)(tokb + tid) * 4) = gt;
    }
    __syncthreads();
    for (int rc_ = 0; rc_ < RTR_REP_C; ++rc_)
#pragma unroll 2
    for (int tt = 0; tt < 8; ++tt) {
        const int tl = w * 8 + tt; const float* xrow = x + (size_t)(tokb + tl) * DM;
        f32x4 hv[4]; float s = 0.f;
#pragma unroll
        for (int j = 0; j < 4; ++j) { hv[j] = ((const f32x4*)xrow + lane)[64 * j]; s += (hv[j].x * hv[j].x + hv[j].y * hv[j].y) + (hv[j].z * hv[j].z + hv[j].w * hv[j].w); }
        const float rstd = 1.0f / sqrtf(wave_sum(s) * (1.f / DM) + EPS);
        unsigned wv[4];
#pragma unroll
        for (int j = 0; j < 4; ++j) { const f32x4 t = hv[j] * rstd * gg[j]; wv[j] = pk4_fp8(t.x, t.y, t.z, t.w); }
#pragma unroll
        for (int r = 0; r < 4; ++r) { const unsigned er = ers[tl * 4 + r]; const size_t slot = (size_t)(er >> 16) * ECAP + (er & 0xffffu);
            unsigned* o4 = (unsigned*)(XG + slot * DM) + lane;
#pragma unroll
            for (int j = 0; j < 4; ++j) o4[64 * j] = wv[j]; }
    }
    __syncthreads();
    }
}

__device__ __forceinline__ void combine_phase(Frame& F, const float* x, float* xout, const unsigned* tok_er, const float* tok_g, const bf16_t* Y, const float* g_next, unsigned char* XN, bool xn_fp8) {
    int tid_ = threadIdx.x; asm volatile("" : "+v"(tid_));
    const int gw = F.vcu * NWAVES + __builtin_amdgcn_readfirstlane(tid_ >> 6), NGW = F.G * NWAVES, lane = tid_ & 63;
    for (int m = gw; m < M; m += NGW) {
        const u32x4 er = *(const u32x4*)(tok_er + (size_t)m * 4); const f32x4 gt = *(const f32x4*)(tok_g + (size_t)m * 4);
        f32x4 v[4]; const float* xrow = x + (size_t)m * DM; float* xorow = xout + (size_t)m * DM;
#pragma unroll
        for (int j = 0; j < 4; ++j) v[j] = ((const f32x4*)xrow + lane)[64 * j];
#pragma unroll
        for (int r = 0; r < 4; ++r) { const size_t slot = (size_t)(er[r] >> 16) * ECAP + (er[r] & 0xffffu); const u32x2* yp = (const u32x2*)(Y + slot * DM) + lane; const float g = gt[r];
#pragma unroll
            for (int j = 0; j < 4; ++j) { const u32x2 yv = yp[64 * j]; v[j].x += g * bflo(yv.x); v[j].y += g * bfhi(yv.x); v[j].z += g * bflo(yv.y); v[j].w += g * bfhi(yv.y); } }
#pragma unroll
        for (int j = 0; j < 4; ++j) ((f32x4*)xorow + lane)[64 * j] = v[j];
        if (g_next) {
            float s = 0.f;
#pragma unroll
            for (int j = 0; j < 4; ++j) s += (v[j].x * v[j].x + v[j].y * v[j].y) + (v[j].z * v[j].z + v[j].w * v[j].w);
            const float rstd = 1.0f / sqrtf(wave_sum(s) * (1.f / DM) + EPS);
            unsigned* o4 = (unsigned*)(XN + (size_t)m * DM) + lane; u32x2* o8 = (u32x2*)(XN + (size_t)m * DM * 2) + lane;
#pragma unroll
            for (int j = 0; j < 4; ++j) { const f32x4 gg = ((const f32x4*)g_next + lane)[64 * j];
                if (xn_fp8) o4[64 * j] = pk4_fp8(v[j].x * rstd * gg.x, v[j].y * rstd * gg.y, v[j].z * rstd * gg.z, v[j].w * rstd * gg.w);
                else { u32x2 w; w.x = cvt_pk_bf16(v[j].x * rstd * gg.x, v[j].y * rstd * gg.y); w.y = cvt_pk_bf16(v[j].z * rstd * gg.z, v[j].w * rstd * gg.w); o8[64 * j] = w; } }
        }
    }
}

__device__ __forceinline__ void unpack8(const u32x4 w, float (&f)[8]) { f[0] = bflo(w.x); f[1] = bfhi(w.x); f[2] = bflo(w.y); f[3] = bfhi(w.y); f[4] = bflo(w.z); f[5] = bfhi(w.z); f[6] = bflo(w.w); f[7] = bfhi(w.w); }
__device__ __forceinline__ void unpack4(const u32x2 w, float (&f)[4]) { f[0] = bflo(w.x); f[1] = bfhi(w.x); f[2] = bflo(w.y); f[3] = bfhi(w.y); }
__device__ __forceinline__ void fin_head(const u32x4 n0, const u32x4 n1, const u32x2 r1, const u32x2 r2, const float (&g)[24], const float (&cs)[4], const float (&sn)[4], unsigned char* op, int j) {
    float a[8], b[8], x1[4], x2[4];
    unpack8(n0, a); unpack8(n1, b); unpack4(r1, x1); unpack4(r2, x2);
    float ss = 0.f;
#pragma unroll
    for (int i = 0; i < 8; ++i) ss += a[i] * a[i] + b[i] * b[i];
#pragma unroll
    for (int i = 0; i < 4; ++i) ss += x1[i] * x1[i] + x2[i] * x2[i];
    ss += __shfl_xor(ss, 1); ss += __shfl_xor(ss, 2); ss += __shfl_xor(ss, 4);
    const float rstd = 1.0f / sqrtf(ss * (1.0f / 192.0f) + EPS);
    u32x4 o0;
    o0.x = pk4_fp8(a[0] * rstd * g[0], a[1] * rstd * g[1], a[2] * rstd * g[2], a[3] * rstd * g[3]); o0.y = pk4_fp8(a[4] * rstd * g[4], a[5] * rstd * g[5], a[6] * rstd * g[6], a[7] * rstd * g[7]);
    o0.z = pk4_fp8(b[0] * rstd * g[8], b[1] * rstd * g[9], b[2] * rstd * g[10], b[3] * rstd * g[11]); o0.w = pk4_fp8(b[4] * rstd * g[12], b[5] * rstd * g[13], b[6] * rstd * g[14], b[7] * rstd * g[15]);
    float y1[4], y2[4];
#pragma unroll
    for (int i = 0; i < 4; ++i) { const float u = x1[i] * rstd * g[16 + i], v = x2[i] * rstd * g[20 + i]; y1[i] = u * cs[i] - v * sn[i]; y2[i] = u * sn[i] + v * cs[i]; }
    *(u32x4*)(op + 16 * j) = o0; *(unsigned*)(op + 128 + 4 * j) = pk4_fp8(y1[0], y1[1], y1[2], y1[3]); *(unsigned*)(op + 160 + 4 * j) = pk4_fp8(y2[0], y2[1], y2[2], y2[3]);
}
__device__ __forceinline__ void mla_finalize_phase(Frame& F, const bf16_t* QR, const bf16_t* KVR, const bf16_t* Z, const float* gq, const float* gk, unsigned char* QF, unsigned char* KF) {
    int tid_ = threadIdx.x; asm volatile("" : "+v"(tid_));
    const int gw = F.vcu * NWAVES + __builtin_amdgcn_readfirstlane(tid_ >> 6), NGW = F.G * NWAVES, lane = tid_ & 63;
    const int h = lane >> 3, j = lane & 7;
    float gqv[24], gkv[24], invf[4];
#pragma unroll
    for (int i = 0; i < 16; ++i) { gqv[i] = gq[16 * j + i]; gkv[i] = gk[16 * j + i]; }
#pragma unroll
    for (int i = 0; i < 4; ++i) { gqv[16 + i] = gq[128 + 4 * j + i]; gqv[20 + i] = gq[160 + 4 * j + i]; gkv[16 + i] = gk[128 + 4 * j + i]; gkv[20 + i] = gk[160 + 4 * j + i];
        invf[i] = __builtin_amdgcn_exp2f(-(float)(4 * j + i) * (13.287712379549449f / 32.0f)); }
#pragma unroll 2
    for (int m = gw; m < M; m += NGW) {
        const int pos = m & (SEQ - 1);
        float cs[4], sn[4];
#pragma unroll
        for (int i = 0; i < 4; ++i) { const double rev = (double)pos * (double)invf[i] * 0.15915494309189535; const float fr = (float)(rev - __builtin_rint(rev));
            sn[i] = __builtin_amdgcn_sinf(fr); cs[i] = __builtin_amdgcn_cosf(fr); }
        const bf16_t* qp = QR + (size_t)m * 1536 + h * 192; const bf16_t* kp = KVR + (size_t)m * 2048 + h * 256; const bf16_t* zp = Z + (size_t)m * ODD_INP + 768;
        const u32x4 qn0 = *(const u32x4*)(qp + 16 * j), qn1 = *(const u32x4*)(qp + 16 * j + 8); const u32x2 qr1 = *(const u32x2*)(qp + 128 + 4 * j), qr2 = *(const u32x2*)(qp + 160 + 4 * j);
        const u32x4 kn0 = *(const u32x4*)(kp + 16 * j), kn1 = *(const u32x4*)(kp + 16 * j + 8); const u32x2 kr1 = *(const u32x2*)(zp + 4 * j), kr2 = *(const u32x2*)(zp + 32 + 4 * j);
        fin_head(qn0, qn1, qr1, qr2, gqv, cs, sn, QF + (size_t)m * 1536 + h * 192, j);
        fin_head(kn0, kn1, kr1, kr2, gkv, cs, sn, KF + (size_t)m * 1536 + h * 192, j);
    }
}

__device__ __forceinline__ void vt_phase(Frame& F, const bf16_t* KVR, unsigned char* VT8) {
    int tid_ = threadIdx.x; asm volatile("" : "+v"(tid_));
    const int tid = tid_;
    LAS unsigned char* T = F.lds + RING_OFF;
    for (int it = F.vcu; it < M / 64; it += F.G) {
        const int m0 = it * 64, b = m0 / SEQ, tok0 = m0 % SEQ;
#pragma unroll 4
        for (int k = 0; k < 16; ++k) { const int idx = tid + 512 * k, tok = idx >> 7, grp = idx & 127, h = grp >> 4, d8 = (grp & 15) * 8;
            const u32x4 w = *(const u32x4*)(KVR + (size_t)(m0 + tok) * 2048 + h * 256 + 128 + d8);
            const unsigned lo = pk4_fp8(bflo(w.x), bfhi(w.x), bflo(w.y), bfhi(w.y)), hi = pk4_fp8(bflo(w.z), bfhi(w.z), bflo(w.w), bfhi(w.w));
            LAS unsigned char* tp = T + (h * 128 + d8) * 80 + tok;
            tp[0] = (unsigned char)lo; tp[80] = (unsigned char)(lo >> 8); tp[160] = (unsigned char)(lo >> 16); tp[240] = (unsigned char)(lo >> 24);
            tp[320] = (unsigned char)hi; tp[400] = (unsigned char)(hi >> 8); tp[480] = (unsigned char)(hi >> 16); tp[560] = (unsigned char)(hi >> 24); }
        __syncthreads();
#pragma unroll 4
        for (int k = 0; k < 8; ++k) { const int idx = tid + 512 * k, row = idx >> 2, q = idx & 3;
            const u32x4 v = *(const LAS u32x4*)(T + row * 80 + 16 * q);
            *(u32x4*)(VT8 + ((size_t)b * 1024 + row) * SEQ + tok0 + 16 * q) = v; }
        __syncthreads();
    }
}

#ifndef PHMASK
#define PHMASK 0xFFFF
#endif
#ifndef REPMASK
#define REPMASK 0
#endif
#ifndef REPCNT
#define REPCNT 3
#endif
#define NREP(k) ((((REPMASK) >> (k)) & 1) ? (REPCNT) : 1)

#define LAUNDER_S(x) asm volatile("" : "+s"(x))
__device__ __forceinline__ const float* in_ptr(const Args& a, int i) { LAUNDER_S(i); return a.in[i]; }
#define PHASE_BEGIN() unsigned wso_ = 0u; LAUNDER_S(wso_); unsigned char* ws = args.ws + wso_; Frame Fp = F; Fp.vcu = __builtin_amdgcn_readfirstlane(Fp.vcu); Fp.G = __builtin_amdgcn_readfirstlane(Fp.G); LAUNDER_S(Fp.vcu); LAUNDER_S(Fp.G); \
    int bx_ = __builtin_amdgcn_readfirstlane((int)blockIdx.x); LAUNDER_S(bx_); (void)bx_; (void)ws
#define XN  ((unsigned char*)(ws + WS_XN))
#define Z   ((bf16_t*)(ws + WS_Z))
#define MIX ((bf16_t*)(ws + WS_MIX))
#define QR  ((bf16_t*)(ws + WS_QR))
#define KVR ((bf16_t*)(ws + WS_KVR))
#define QF  ((unsigned char*)(ws + WS_QF))
#define KF  ((unsigned char*)(ws + WS_KF))
#define XG  ((unsigned char*)(ws + WS_XG))
#define ACT ((unsigned char*)(ws + WS_ACT))
#define YB  ((bf16_t*)(ws + WS_Y))
#define SSQ ((float*)(ws + WS_SSQ))
#define TOKER ((unsigned*)(ws + WS_TOKER))
#define TOKG ((float*)(ws + WS_TOKG))
#define B1P ((float*)(ws + WS_B1P))
#define IN(i) in_ptr(args, (i))
__global__ void __launch_bounds__(NWAVES * 64, 2) trunk_fwd(Args args) {
    extern __shared__ __attribute__((aligned(16))) unsigned char lds_raw[];
    Frame F;
    F.lds = (LAS unsigned char*)lds_raw;
    F.G = gridDim.x; { const int bx = blockIdx.x; F.vcu = (F.G % 8 == 0) ? (bx % 8) * (F.G / 8) + bx / 8 : bx; }
    for (int u = threadIdx.x; u < (SCR_OFF - LDSCTL_OFF) / 4; u += NWAVES * 64) ((LAS unsigned*)(F.lds + LDSCTL_OFF))[u] = 0u;
    __syncthreads();
    (void)xcd_barrier_post((unsigned*)((gu32*)(args.ws + WS_CTL) + CW_BAR), (volatile LAS unsigned*)(F.lds + MISC_OFF) + 8);
#define GRID_BAR() do { unsigned wsb_ = 0u; LAUNDER_S(wsb_); XcdBarrier bar_; bar_.bar = (unsigned*)((gu32*)(args.ws + wsb_ + WS_CTL) + CW_BAR); bar_.x = xb_xcc_id(); \
        bar_.st = (volatile LAS unsigned*)(F.lds + MISC_OFF) + 8; xcd_barrier(bar_); } while (0)
    float* const X = args.out;
    const int stage_limit = args.stage_limit;

#if (PHMASK >> 0) & 1
            _Pragma("unroll") for (int rep_ = 0; rep_ < NREP(0); ++rep_) { if (rep_) GRID_BAR();
    {   PHASE_BEGIN(); const int ptid = threadIdx.x, gw = Fp.vcu * NWAVES + __builtin_amdgcn_readfirstlane(ptid >> 6), NGW = Fp.G * NWAVES;
        transpose_job<1>(Fp, IN(I_EWIN), DM, EVEN_IN, 2, (size_t)DM * EVEN_IN, (bf16_t*)(ws + WS_WEIN), (size_t)EVEN_IN * DM, nullptr, 0);
        transpose_job<0>(Fp, IN(I_EWOUT), DM, DM, 2, (size_t)DM * DM, (bf16_t*)(ws + WS_WEOUT), (size_t)DM * DM, nullptr, 0);
        transpose_job_fp8<0>(Fp, IN(I_OWIN), DM, ODD_IN, 2, (size_t)DM * ODD_IN, ws + WS_WOIN, (size_t)ODD_INP * DM);
        transpose_job<0>(Fp, IN(I_OWUQ), 512, 1536, 2, (size_t)512 * 1536, (bf16_t*)(ws + WS_WUQ), (size_t)1536 * 512, IN(I_OGCQ), 512);
        transpose_job<0>(Fp, IN(I_OWUKV), 256, 2048, 2, (size_t)256 * 2048, (bf16_t*)(ws + WS_WUKV), (size_t)2048 * 256, IN(I_OGCKV), 256);
        transpose_job<0>(Fp, IN(I_OWOUT), DM, DM, 2, (size_t)DM * DM, (bf16_t*)(ws + WS_WOOUT), (size_t)DM * DM, nullptr, 0);
        transpose_job_fp8<2>(Fp, IN(I_W1), DM, 2 * DE, DEPTH * NE, (size_t)DM * 2 * DE, ws + WS_W1, (size_t)2 * DE * DM);
        transpose_job_fp8<0>(Fp, IN(I_W2), DE, DM, DEPTH * NE, (size_t)DE * DM, ws + WS_W2, (size_t)DM * DE);
        for (int i = bx_ * 512 + ptid; i < 2 * 12288; i += Fp.G * 512) { const int mi = i / 12288, r = i % 12288;
            *(u32x4*)(ws + WS_WOIN + (size_t)mi * ODD_INP * DM + (size_t)ODD_IN * DM + (size_t)r * 16) = (u32x4){0u, 0u, 0u, 0u}; }
        for (int i = bx_ * 512 + ptid; i < DEPTH * NE * 2048; i += Fp.G * 512) { const int c = i & 2047, o = 2 * (128 * (c >> 8) + (c & 127)) + ((c >> 7) & 1);
            B1P[i] = IN(I_B1)[(size_t)(i & ~2047) + o]; }
        for (int m = gw; m < M; m += NGW) rms_row_to_bf16(ptid & 63, IN(I_X) + (size_t)m * DM, IN(I_MIXN), (bf16_t*)XN + (size_t)m * DM, X + (size_t)m * DM);
    }
            }
#endif
    GRID_BAR();

#ifdef EXTRA_BARS
    for (int xb_ = 0; xb_ < EXTRA_BARS; ++xb_) GRID_BAR();
#endif
    for (int l = 0; l < DEPTH; ++l) {
        const int li = l >> 1;
        if (2 * l + 1 > stage_limit) break;
        if ((l & 1) == 0) {
#if (PHMASK >> 1) & 1
            _Pragma("unroll") for (int rep_ = 0; rep_ < NREP(1); ++rep_) { if (rep_) GRID_BAR();
            {   PHASE_BEGIN(); pg8::Gemm g{(const bf16_t*)XN, (const bf16_t*)(ws + WS_WEIN) + (size_t)li * EVEN_IN * DM, DM, DM, nullptr, nullptr}; pg8::StaticOrder S; S.init(M, EVEN_IN, Fp.G, bx_);
                pg8::EpiEvenIn E{Z, IN(I_EGQ) + li * 64, IN(I_EGK) + li * 64};
                pg8::gemm_phase<pg8::EpiEvenIn, pg8::StaticOrder>(Fp.lds + RING_OFF, g, S, E); }
            }
#endif
            GRID_BAR();
            {   PHASE_BEGIN();
#if (PHMASK >> 2) & 1
            _Pragma("unroll") for (int rep_ = 0; rep_ < NREP(2); ++rep_) { if (rep_) GRID_BAR();
                for (int u = Fp.vcu; u < 512; u += Fp.G)
                    gmlp_unit(Fp, Z, MIX, IN(I_EWS) + (size_t)li * 4 * 128 * 128, IN(I_EBS) + li * 512, IN(I_EGV) + li * 512, u);
            }
#endif
#if (PHMASK >> 3) & 1
            _Pragma("unroll") for (int rep_ = 0; rep_ < NREP(3); ++rep_) { if (rep_) GRID_BAR();
                for (int u = Fp.vcu; u < 256; u += Fp.G) { const int bh = u >> 4, s = u & 15, b = bh >> 3, h = bh & 7;
                    for (int pass = 0; pass < 2; ++pass) { const int qb = pass ? 31 - s : s;
                        const bf16_t* zb = Z + (size_t)b * SEQ * EVEN_IN;
                        dil::unit(zb + 1024 + 64 * h, zb + 1536 + 64 * h, zb + 2048 + 64 * h, EVEN_IN, MIX + (size_t)b * SEQ * DM + 512 + 64 * h, DM, qb * 256, Fp.lds + RING_OFF, (LAS float*)(Fp.lds + SCR_OFF)); } }
            }
#endif
            }
            GRID_BAR();
#if (PHMASK >> 4) & 1
            _Pragma("unroll") for (int rep_ = 0; rep_ < NREP(4); ++rep_) { if (rep_) GRID_BAR();
            {   PHASE_BEGIN(); pg8::Gemm g{MIX, (const bf16_t*)(ws + WS_WEOUT) + (size_t)li * DM * DM, DM, DM, nullptr, nullptr}; pg8::StaticOrder S; S.init(M, DM, Fp.G, bx_);
                pg8::EpiResid E{X};
                pg8::gemm_phase<pg8::EpiResid, pg8::StaticOrder>(Fp.lds + RING_OFF, g, S, E); }
            }
#endif
            GRID_BAR();
        } else {
#if (PHMASK >> 5) & 1
            _Pragma("unroll") for (int rep_ = 0; rep_ < NREP(5); ++rep_) { if (rep_) GRID_BAR();
            {   PHASE_BEGIN(); pg8::Gemm g{(const bf16_t*)XN, (const bf16_t*)(ws + WS_WOIN + (size_t)li * ODD_INP * DM), DM / 2, DM / 2, nullptr, nullptr}; pg8::StaticOrder S; S.init(M, ODD_INP, Fp.G, bx_);
                pg8::EpiOddIn E{Z, SSQ};
                pg8::gemm_phase<pg8::EpiOddIn, pg8::StaticOrder, true>(Fp.lds + RING_OFF, g, S, E); }
            }
#endif
            GRID_BAR();
#if (PHMASK >> 6) & 1
            _Pragma("unroll") for (int rep_ = 0; rep_ < NREP(6); ++rep_) { if (rep_) GRID_BAR();
            {   PHASE_BEGIN(); pg8::Gemm g{Z + 512, (const bf16_t*)(ws + WS_WUKV) + (size_t)li * 2048 * 256, ODD_INP, 256, nullptr, nullptr}; pg8::StaticOrder S; S.init(M, 2048, Fp.G, bx_);
                pg8::EpiRowScale<1> E{KVR, 2048, SSQ, 8, 1.0f / 256.0f};
                pg8::gemm_phase<pg8::EpiRowScale<1>, pg8::StaticOrder>(Fp.lds + RING_OFF, g, S, E); }
            {   PHASE_BEGIN(); pg8::Gemm g{Z, (const bf16_t*)(ws + WS_WUQ) + (size_t)li * 1536 * 512, ODD_INP, 512, nullptr, nullptr}; pg8::StaticOrder S; S.init(M, 1536, Fp.G, bx_);
                pg8::EpiRowScale<2> E{QR, 1536, SSQ, 0, 1.0f / 512.0f};
                pg8::gemm_phase<pg8::EpiRowScale<2>, pg8::StaticOrder>(Fp.lds + RING_OFF, g, S, E); }
            }
#endif
            GRID_BAR();
#if (PHMASK >> 7) & 1
            _Pragma("unroll") for (int rep_ = 0; rep_ < NREP(7); ++rep_) { if (rep_) GRID_BAR();
            {   PHASE_BEGIN(); mla_finalize_phase(Fp, QR, KVR, Z, IN(I_OGQ) + li * 192, IN(I_OGK) + li * 192, QF, KF); vt_phase(Fp, KVR, ws + WS_VT); }
            }
#endif
            GRID_BAR();
#if (PHMASK >> 8) & 1
            _Pragma("unroll") for (int rep_ = 0; rep_ < NREP(8); ++rep_) { if (rep_) GRID_BAR();
            {   PHASE_BEGIN();
                for (int u = Fp.vcu; u < 256; u += Fp.G) { const int bh = u >> 4, s = u & 15, b = bh >> 3, h = bh & 7;
                    for (int pass = 0; pass < 2; ++pass) { const int qb = pass ? 31 - s : s;
                        mla::unit(QF + (size_t)b * SEQ * 1536 + 192 * h, KF + (size_t)b * SEQ * 1536 + 192 * h, 1536, ws + WS_VT + ((size_t)(b * 8 + h) * 128) * SEQ,
                                  MIX + (size_t)b * SEQ * DM + 128 * h, DM, qb * 256, Fp.lds + RING_OFF); } }
            }
            }
#endif
            GRID_BAR();
#if (PHMASK >> 9) & 1
            _Pragma("unroll") for (int rep_ = 0; rep_ < NREP(9); ++rep_) { if (rep_) GRID_BAR();
            {   PHASE_BEGIN(); pg8::Gemm g{MIX, (const bf16_t*)(ws + WS_WOOUT) + (size_t)li * DM * DM, DM, DM, nullptr, nullptr}; pg8::StaticOrder S; S.init(M, DM, Fp.G, bx_);
                pg8::EpiResid E{X};
                pg8::gemm_phase<pg8::EpiResid, pg8::StaticOrder>(Fp.lds + RING_OFF, g, S, E); }
            }
#endif
            GRID_BAR();
        }
        if (2 * l + 2 > stage_limit) break;
#if (PHMASK >> 10) & 1
            _Pragma("unroll") for (int rep_ = 0; rep_ < NREP(10); ++rep_) {
        {   PHASE_BEGIN(); const bool dry = rep_ + 1 < NREP(10);
            gu32* cnt = (gu32*)(ws + WS_CTL) + CW_CNT + (size_t)(dry ? 8 + 4 * rep_ + l : l) * 32 * 64;
        router_phase(Fp, X, IN(I_FFNN) + l * DM, IN(I_RW) + (size_t)l * DM * NE, IN(I_RB) + l * NE, cnt, dry ? (unsigned*)(ws + WS_QR) : TOKER, dry ? (float*)(ws + WS_QR + MiB) : TOKG, dry ? ACT : XG); }
        GRID_BAR();
            }
#endif
        LAS int* tbl = (LAS int*)(F.lds + SCR_OFF + 12288);
        {   PHASE_BEGIN(); gu32* cnt = (gu32*)(ws + WS_CTL) + CW_CNT + (size_t)l * 32 * 64;
        if (threadIdx.x == 0) { int acc = 0; for (int e = 0; e < NE; ++e) { tbl[e] = acc; const unsigned c = __hip_atomic_load(cnt + 64 * e, RLX_AGENT); acc += (int)((c + 255u) >> 8); } tbl[NE] = acc; }
        __syncthreads(); }
#if (PHMASK >> 11) & 1
            _Pragma("unroll") for (int rep_ = 0; rep_ < NREP(11); ++rep_) { if (rep_) GRID_BAR();
        {   PHASE_BEGIN();
            pg8::Gemm g{(const bf16_t*)XG, (const bf16_t*)(ws + WS_W1 + (size_t)l * NE * 2 * DE * DM), DM / 2, DM / 2, (const bf16_t*)ACT, (const bf16_t*)(ws + WS_W2 + (size_t)l * NE * DM * DE)};
            pg8::MoeMergedOrder S{tbl, Fp.G, Fp.vcu, (gu32*)(ws + WS_CTL) + CW_MOE + (size_t)(l * 320 + 1280 * rep_) * 16, -1};
            pg8::EpiMoe E{{ACT, B1P + (size_t)l * NE * 2048}, {YB, IN(I_B2) + (size_t)l * NE * DM}};
            pg8::gemm_phase<pg8::EpiMoe, pg8::MoeMergedOrder, true>(Fp.lds + RING_OFF, g, S, E); }
            }
#endif
        GRID_BAR();
#if (PHMASK >> 13) & 1
            _Pragma("unroll") for (int rep_ = 0; rep_ < NREP(13); ++rep_) {
        {   PHASE_BEGIN(); const bool dry = rep_ + 1 < NREP(13);
            combine_phase(Fp, X, dry ? (float*)ACT : X, TOKER, TOKG, YB, (l + 1 < DEPTH) ? IN(I_MIXN) + (l + 1) * DM : nullptr, dry ? (ACT + (size_t)64 * MiB) : XN, (l & 1) == 0); }
        GRID_BAR();
            }
#endif
    }
#undef GRID_BAR
}

extern "C" void kernel_launch(void* const* d_in, const int* in_sizes, int n_in, void* d_out, int out_size, void* d_ws, size_t ws_size, hipStream_t stream) {
    static int grid = 0;
    if (grid == 0) {
        if (n_in != 24 || in_sizes[0] != M * DM || out_size != M * DM || ws_size < WS_END) {
            fprintf(stderr, "kernel_launch: unexpected shapes (n_in %d, in0 %d, out %d, ws %zu, need %zu)\n", n_in, n_in > 0 ? in_sizes[0] : -1, out_size, ws_size, (size_t)WS_END); grid = -1; return; }
        int dev = 0, cus = 0, per_cu = 0;
        if (hipGetDevice(&dev) != hipSuccess || hipDeviceGetAttribute(&cus, hipDeviceAttributeMultiprocessorCount, dev) != hipSuccess) { grid = -1; return; }
        if (hipFuncSetAttribute((const void*)trunk_fwd, hipFuncAttributeMaxDynamicSharedMemorySize, LDS_BYTES) != hipSuccess) { fprintf(stderr, "kernel_launch: hipFuncSetAttribute failed\n"); grid = -1; return; }
        if (hipOccupancyMaxActiveBlocksPerMultiprocessor(&per_cu, (const void*)trunk_fwd, NWAVES * 64, LDS_BYTES) != hipSuccess || per_cu < 1)
            fprintf(stderr, "kernel_launch: occupancy query reports %d workgroups per CU\n", per_cu);
        (void)hipGetLastError();
        if (cus < 256) { fprintf(stderr, "kernel_launch: needs 256 CUs, device has %d\n", cus); grid = -1; return; }
        grid = 256;
    }
    if (grid < 0) return;
    if (hipMemsetAsync((char*)d_ws + WS_CTL, 0, CTL_ZERO_BYTES, stream) != hipSuccess) return;
    Args a{};
    for (int i = 0; i < 24; ++i) a.in[i] = (const float*)d_in[i];
    a.out = (float*)d_out; a.ws = (unsigned char*)d_ws; a.stage_limit = STAGE_LIMIT; a.pad = 0;
    hipLaunchKernelGGL(trunk_fwd, dim3(grid), dim3(NWAVES * 64), LDS_BYTES, stream, a);
}
```

```cpp
#include <hip/hip_runtime.h>
#include <hip/hip_bf16.h>
#include <cstdio>
#include <cstdint>

#define LAS __attribute__((address_space(3)))
#define GAS __attribute__((address_space(1)))
typedef unsigned short bf16_t;
typedef short bf16x8 __attribute__((ext_vector_type(8)));
typedef short s16x4 __attribute__((ext_vector_type(4)));
typedef float f32x2 __attribute__((ext_vector_type(2)));
typedef float f32x4 __attribute__((ext_vector_type(4)));
typedef float f32x16 __attribute__((ext_vector_type(16)));
typedef unsigned u32x2 __attribute__((ext_vector_type(2)));
typedef unsigned u32x4 __attribute__((ext_vector_type(4)));
typedef int i32x4 __attribute__((ext_vector_type(4)));
typedef int i32x8 __attribute__((ext_vector_type(8)));

constexpr int BATCH = 2, SEQ = 8192, DM = 1024, M = BATCH * SEQ, DEPTH = 4;
constexpr int EVEN_IN = 2560, ODD_IN = 832, ODD_INP = 1024;
constexpr int NE = 32, DE = 1024, ECAP = 16384;
constexpr float EPS = 1e-6f;
constexpr float LOG2E = 1.4426950408889634f;
constexpr float C2_B = 0.125f * LOG2E;
constexpr float C2_C = 0.07216878364870322f * LOG2E;

__device__ __forceinline__ unsigned cvt_pk_bf16(float lo, float hi) { unsigned r; asm volatile("v_cvt_pk_bf16_f32 %0, %1, %2" : "=v"(r) : "v"(lo), "v"(hi)); return r; }
__device__ __forceinline__ float bf2f(bf16_t v) { return __uint_as_float(((unsigned)v) << 16); }
__device__ __forceinline__ float bflo(unsigned w) { return __uint_as_float(w << 16); }
__device__ __forceinline__ float bfhi(unsigned w) { return __uint_as_float(w & 0xffff0000u); }
__device__ __forceinline__ bf16_t f2bf(float f) { return (bf16_t)(cvt_pk_bf16(f, 0.f) & 0xffffu); }

__device__ __forceinline__ unsigned pk4_fp8(float a, float b, float c, float d) { int w = 0; w = __builtin_amdgcn_cvt_pk_fp8_f32(a, b, w, false); w = __builtin_amdgcn_cvt_pk_fp8_f32(c, d, w, true); return (unsigned)w; }
constexpr float W8_SCALE = 64.0f, W8_INV = 1.0f / 64.0f;

namespace pg8 {
constexpr int BM = 256, BK = 64, HALF = 128, HTB = HALF * BK * 2, STAGE_BYTES = 8 * HTB, NXCD = 8, WGM = 8;
__host__ __device__ __forceinline__ int lds_byte(int r, int c) { const int st = (r >> 4) * 2 + (c >> 5), rr = r & 15, cc = c & 31, ob = rr * 64 + cc * 2; return st * 1024 + (ob ^ (((ob >> 9) & 1) << 5)); }
__host__ __device__ __forceinline__ void stage_rc(int b, int& R, int& C) { const int st = b / 1024, sb = b % 1024, swz = sb ^ (((sb >> 9) & 1) << 5); R = (st >> 1) * 16 + swz / 64; C = (st & 1) * 32 + (swz % 64) / 2; }
__host__ __device__ __forceinline__ int perm32(int rho) { const int n = rho >> 4, i = rho & 15; return 8 * (i >> 2) + 4 * n + (i & 3); }

struct Unit { int pm, pn, pb, kind, rb; };
struct Gemm { const bf16_t* A; const bf16_t* Bt; int lda, K; const bf16_t* A2; const bf16_t* Bt2; };

struct StaticOrder {
    int nM, nN, nwg, G, c;
    __device__ void init(int M_, int N_, int G_, int c_) { nM = M_ / BM; nN = N_ / BM; nwg = nM * nN; G = G_; c = c_; }
    __device__ bool next(int i, Unit& u) const {
        const long L = (long)i * G + c; if (L >= nwg) return false;
        int wgid = (int)L; { const int q = nwg / NXCD, r = nwg % NXCD, xcd = wgid % NXCD, off = wgid / NXCD; wgid = (xcd < r ? xcd * (q + 1) : r * (q + 1) + (xcd - r) * q) + off; }
        const int nig = WGM * nN, gid = wgid / nig, fm = gid * WGM, gsz = (nM - fm) < WGM ? (nM - fm) : WGM;
        u.pm = fm + ((wgid % nig) % gsz); u.pn = (wgid % nig) / gsz; u.pb = u.pn; u.kind = 0; u.rb = 0; return true;
    }
    __device__ __forceinline__ void a_ready(const Unit&) const {}
    __device__ __forceinline__ void pre_epi() const {}
    __device__ __forceinline__ void done(const Unit&) const {}
    __device__ __forceinline__ void finish() const {}
};

__device__ __forceinline__ f32x2 gelu_pk(f32x2 v) {
    const f32x2 av = __builtin_elementwise_abs(v), d = av * 0.2316418882f + 1.0f;
    f32x2 t; t.x = __builtin_amdgcn_rcpf(d.x); t.y = __builtin_amdgcn_rcpf(d.y);
    f32x2 q = t * 0.5307027145f + (-0.7265760135f); q = q * t + 0.7107068705f; q = q * t + (-0.142248368f); q = q * t + 0.127414796f; q = q * t;
    const f32x2 s = (v * v) * (-0.72134752044f);
    f32x2 e; e.x = __builtin_amdgcn_exp2f(s.x); e.y = __builtin_amdgcn_exp2f(s.y);
    const f32x2 m = v * (q * e), r = v - m;
    f32x2 o; o.x = v.x < 0.f ? m.x : r.x; o.y = v.y < 0.f ? m.y : r.y; return o;
}
__device__ __forceinline__ f32x4 gelu4(f32x4 v) { const f32x2 a = gelu_pk((f32x2){v[0], v[1]}), b = gelu_pk((f32x2){v[2], v[3]}); return (f32x4){a.x, a.y, b.x, b.y}; }

template <class Epi, class Sched, bool FP8 = false>
__device__ __forceinline__ void gemm_phase(LAS unsigned char* lds, const Gemm g, const Sched& S, const Epi& E) {
    int tid_ = threadIdx.x; asm volatile("" : "+v"(tid_));
    const int tid = tid_, wid = __builtin_amdgcn_readfirstlane(tid >> 6), lane = tid & 63, wr = wid >> 2, wc = wid & 3, fr = lane & 15, fq = lane >> 4;
    const int K = g.K, nt = K / BK;
    unsigned voffA[2], voffB[2];
#pragma unroll
    for (int i = 0; i < 2; ++i) { int R, C; stage_rc(tid * 16 + i * 8192, R, C); const int Rb = Epi::PERM ? ((R & ~31) + perm32(R & 31)) : R;
        voffA[i] = (unsigned)(R * g.lda + C) * 2u; voffB[i] = (unsigned)(Rb * K + C) * 2u; }
    const size_t kstep = (size_t)(BK * 2);
    const size_t hstepA = (size_t)HALF * g.lda * 2, tstepA = 2 * hstepA;
    const size_t hstepB = (size_t)HALF * K * 2, tstepB = 2 * hstepB;
    const unsigned ldsw = (unsigned)wid * 1024u;
    const int aoff = lds_byte(wr * 64 + fr, fq * 8), boff = lds_byte(wc * 32 + fr, fq * 8);
#define PG8_SA(b, h) (((b) * 2 + (h)) * HTB)
#define PG8_SB(b, h) ((4 + (b) * 2 + (h)) * HTB)
#define PG8_STAGE(bufoff, gbase, voff) do { _Pragma("unroll") for (int _i = 0; _i < 2; ++_i) \
        __builtin_amdgcn_global_load_lds((const unsigned*)((const char*)(gbase) + (voff)[_i]), (LAS unsigned*)(lds + (bufoff) + ldsw + _i * 8192), 16, 0, 0); } while (0)
#define PG8_LDA(dst, b, h) do { _Pragma("unroll") for (int m = 0; m < 4; ++m) { if constexpr (FP8) { const i32x4 lo_ = *(const LAS i32x4*)(lds + PG8_SA(b, h) + aoff + m * 2048), hi_ = *(const LAS i32x4*)(lds + PG8_SA(b, h) + aoff + m * 2048 + 1024); dst##8[m] = __builtin_shufflevector(lo_, hi_, 0, 1, 2, 3, 4, 5, 6, 7); } \
        else { _Pragma("unroll") for (int k = 0; k < 2; ++k) dst[m][k] = *(const LAS bf16x8*)(lds + PG8_SA(b, h) + aoff + m * 2048 + k * 1024); } } } while (0)
#define PG8_LDB(dst, b, h) do { _Pragma("unroll") for (int n = 0; n < 2; ++n) { if constexpr (FP8) { const i32x4 lo_ = *(const LAS i32x4*)(lds + PG8_SB(b, h) + boff + n * 2048), hi_ = *(const LAS i32x4*)(lds + PG8_SB(b, h) + boff + n * 2048 + 1024); dst##8[n] = __builtin_shufflevector(lo_, hi_, 0, 1, 2, 3, 4, 5, 6, 7); } \
        else { _Pragma("unroll") for (int k = 0; k < 2; ++k) dst[n][k] = *(const LAS bf16x8*)(lds + PG8_SB(b, h) + boff + n * 2048 + k * 1024); } } } while (0)
#define PG8_MMA(ai, bj, At, Bt) do { __builtin_amdgcn_s_setprio(1); _Pragma("unroll") for (int m = 0; m < 4; ++m) _Pragma("unroll") for (int n = 0; n < 2; ++n) { \
        if constexpr (FP8) asm volatile("s_nop 1\n\tv_mfma_f32_16x16x128_f8f6f4 %0, %1, %2, %0" : "+v"(acc[ai][bj][m][n]) : "v"(Bt##8[n]), "v"(At##8[m])); \
        else { _Pragma("unroll") for (int k = 0; k < 2; ++k) acc[ai][bj][m][n] = __builtin_amdgcn_mfma_f32_16x16x32_bf16(Bt[n][k], At[m][k], acc[ai][bj][m][n], 0, 0, 0); } } \
        __builtin_amdgcn_s_setprio(0); } while (0)
#define PG8_WAIT_V(n) asm volatile("s_waitcnt vmcnt(" #n ")" ::: "memory")
#define PG8_WAIT_L(n) asm volatile("s_waitcnt lgkmcnt(" #n ")" ::: "memory")
#define PG8_BAR __builtin_amdgcn_s_barrier()
#define PG8_SCHED __builtin_amdgcn_sched_barrier(0)
    Unit cur, nxt; int ui = 0;
    if (!S.next(0, cur)) return;
    f32x4 acc[2][2][4][2];
#pragma unroll
    for (int a = 0; a < 2; ++a)
#pragma unroll
        for (int b = 0; b < 2; ++b)
#pragma unroll
            for (int m = 0; m < 4; ++m)
#pragma unroll
                for (int n = 0; n < 2; ++n) acc[a][b][m][n] = (f32x4){0.f, 0.f, 0.f, 0.f};
    bf16x8 At[4][2], B0[2][2], B1[2][2]; i32x8 At8[4], B08[2], B18[2];
    const char* cA = (const char*)(cur.kind ? g.A2 : g.A) + (size_t)cur.pm * tstepA; const char* cB = (const char*)(cur.kind ? g.Bt2 : g.Bt) + (size_t)cur.pb * tstepB;
    S.a_ready(cur);
    PG8_STAGE(PG8_SB(0, 0), cB, voffB); PG8_STAGE(PG8_SB(0, 1), cB + hstepB, voffB); PG8_STAGE(PG8_SA(0, 0), cA, voffA); PG8_STAGE(PG8_SA(0, 1), cA + hstepA, voffA);
    if (wr == 1) PG8_BAR;
    PG8_WAIT_V(2); PG8_BAR;
    PG8_STAGE(PG8_SB(1, 0), cB + kstep, voffB); PG8_STAGE(PG8_SA(1, 0), cA + kstep, voffA); PG8_STAGE(PG8_SB(1, 1), cB + hstepB + kstep, voffB);
    PG8_WAIT_V(6); PG8_BAR;
    for (;;) {
        const bool has_next = S.next(ui + 1, nxt);
        const char* nA = has_next ? (const char*)(nxt.kind ? g.A2 : g.A) + (size_t)nxt.pm * tstepA : cA; const char* nB = has_next ? (const char*)(nxt.kind ? g.Bt2 : g.Bt) + (size_t)nxt.pb * tstepB : cB;
#pragma unroll 1
        for (int t = 0; t < nt; t += 2) {
            const bool last = (t == nt - 2);
            const char* a1 = cA + (size_t)(t + 1) * kstep;
            const char* a2 = last ? nA : cA + (size_t)(t + 2) * kstep; const char* b2 = last ? nB : cB + (size_t)(t + 2) * kstep;
            const char* a3 = a2 + kstep; const char* b3 = b2 + kstep;
            if (last && has_next) S.a_ready(nxt);
            PG8_LDB(B0, 0, 0); PG8_LDB(B1, 0, 1); PG8_SCHED; PG8_LDA(At, 0, 0); PG8_STAGE(PG8_SA(1, 1), a1 + hstepA, voffA);
            PG8_WAIT_V(8); PG8_WAIT_L(0); PG8_BAR; PG8_MMA(0, 0, At, B0); PG8_MMA(0, 1, At, B1); PG8_BAR; PG8_SCHED;
            PG8_LDA(At, 0, 1); PG8_STAGE(PG8_SB(0, 0), b2, voffB); PG8_STAGE(PG8_SB(0, 1), b2 + hstepB, voffB); PG8_STAGE(PG8_SA(0, 0), a2, voffA);
            PG8_WAIT_V(8); PG8_WAIT_L(0); PG8_BAR; PG8_MMA(1, 0, At, B0); PG8_MMA(1, 1, At, B1); PG8_BAR; PG8_SCHED;
            PG8_LDB(B0, 1, 0); PG8_LDB(B1, 1, 1); PG8_SCHED; PG8_LDA(At, 1, 0); PG8_STAGE(PG8_SA(0, 1), a2 + hstepA, voffA);
            PG8_WAIT_V(8); PG8_WAIT_L(0); PG8_BAR; PG8_MMA(0, 0, At, B0); PG8_MMA(0, 1, At, B1); PG8_BAR; PG8_SCHED;
            PG8_LDA(At, 1, 1); PG8_STAGE(PG8_SB(1, 0), b3, voffB); PG8_STAGE(PG8_SB(1, 1), b3 + hstepB, voffB); PG8_STAGE(PG8_SA(1, 0), a3, voffA);
            PG8_WAIT_V(8); PG8_WAIT_L(0); PG8_BAR; PG8_MMA(1, 0, At, B0); PG8_MMA(1, 1, At, B1); PG8_BAR; PG8_SCHED;
        }
        if (wr == 0) PG8_BAR;
        if constexpr (FP8) asm volatile("s_nop 15\n\ts_nop 7" ::: "memory");
        S.pre_epi();
        { int te_ = threadIdx.x; asm volatile("" : "+v"(te_));
          E(acc, cur, wr, wc, te_ & 15, (te_ & 63) >> 4); }
        S.done(cur);
        if (!has_next) break;
#pragma unroll
        for (int a = 0; a < 2; ++a)
#pragma unroll
            for (int b = 0; b < 2; ++b)
#pragma unroll
                for (int m = 0; m < 4; ++m)
#pragma unroll
                    for (int n = 0; n < 2; ++n) acc[a][b][m][n] = (f32x4){0.f, 0.f, 0.f, 0.f};
        cur = nxt; cA = nA; cB = nB; ++ui;
        if (wr == 1) PG8_BAR;
    }
    PG8_WAIT_V(0);
    S.finish();
    PG8_BAR;
#undef PG8_SA
#undef PG8_SB
#undef PG8_STAGE
#undef PG8_LDA
#undef PG8_LDB
#undef PG8_MMA
#undef PG8_WAIT_V
#undef PG8_WAIT_L
#undef PG8_BAR
#undef PG8_SCHED
}
}
constexpr int STAGE_LIMIT = 8;

namespace att {
__device__ __forceinline__ int crow(int r, int hi) { return (r & 3) + 8 * (r >> 2) + 4 * hi; }
__device__ __forceinline__ int v_rd_base(int lane) { return ((lane & 3) << 3) | (((lane >> 2) & 3) << 6) | (((lane >> 4) & 1) << 5) | (((lane >> 5) & 1) << 8); }
}

namespace dil {
using att::crow; using att::v_rd_base;
constexpr int OFF_O = 0, OFF_V = 65536, VWAVE = 8192;
template <int S_>
__device__ __forceinline__ void pass(const bf16_t* __restrict__ Qh, const bf16_t* __restrict__ Kh, const bf16_t* __restrict__ Vh, int pitch, int q0, LAS unsigned char* lds, LAS float* scr, int wid, int lane) {
    const int r32 = lane & 31, hi = lane >> 5;
    LAS float* Oacc = (LAS float*)(lds + OFF_O); LAS float* macc = scr; LAS float* lacc = scr + 256; LAS float* wsf = scr + 512 + wid * 64;
    LAS unsigned char* vbuf = lds + OFF_V + wid * VWAVE;
    constexpr int NG = (S_ == 16) ? 2 : 1, VR = (S_ == 16) ? 16 : 32;
    int vk[4], vc[4];
#pragma unroll
    for (int i = 0; i < 4; ++i) { const int off = (i * 64 + lane) * 16, st = off >> 9, within = off & 511, kk = (st >> 1) * 8 + (within >> 6);
        vk[i] = (kk & ~0xC) | ((kk & 4) << 1) | ((kk & 8) >> 1); vc[i] = (st & 1) * 32 + ((within & 63) >> 1); }
    const unsigned vb0 = (unsigned)(uintptr_t)vbuf + (unsigned)v_rd_base(lane);
#pragma unroll
    for (int gi = 0; gi < NG; ++gi) {
        const int rho = (S_ == 1) ? 0 : (S_ == 4) ? (wid & 3) : (2 * wid + gi);
        const int i0 = (S_ == 1) ? 32 * wid : (S_ == 4) ? 32 * (wid >> 2) : 0;
        const int qi = i0 + (r32 < VR ? r32 : r32 - VR);
        const int ql = rho + S_ * qi;
        bf16x8 qr[4];
#pragma unroll
        for (int d0 = 0; d0 < 4; ++d0) qr[d0] = *(const bf16x8*)(Qh + (size_t)(q0 + ql) * pitch + d0 * 16 + hi * 8);
        const int j0 = i0 - 128;
        const int tokb = q0 + rho + S_ * j0;
        bf16x8 kfA[4], kfB[4];
#define DIL_KLOAD(dst, c) do { int tk_ = tokb + S_ * (32 * (c) + r32); tk_ = tk_ < 0 ? 0 : (tk_ > SEQ - 1 ? SEQ - 1 : tk_);     \
            _Pragma("unroll") for (int d0 = 0; d0 < 4; ++d0) dst[d0] = *(const bf16x8*)(Kh + (size_t)tk_ * pitch + d0 * 16 + hi * 8); } while (0)
#define DIL_VDMA(c, bf) do { _Pragma("unroll") for (int i = 0; i < 4; ++i) { int tk_ = tokb + S_ * (32 * (c) + vk[i]); tk_ = tk_ < 0 ? 0 : (tk_ > SEQ - 1 ? SEQ - 1 : tk_); \
            __builtin_amdgcn_global_load_lds((const unsigned*)(Vh + (size_t)tk_ * pitch + vc[i]), (LAS unsigned*)(vbuf + (bf) * 4096 + i * 1024), 16, 0, 0); } } while (0)
        float m_reg = -1e30f, l_reg = 0.f; f32x16 o[2]; o[0] = f32x16{}; o[1] = f32x16{};
        DIL_KLOAD(kfA, 0); DIL_VDMA(0, 0);
#define DIL_STEP(KF, KN, c) do { \
            if ((c) < 4) { DIL_KLOAD(KN, (c) + 1); DIL_VDMA((c) + 1, ((c) + 1) & 1); asm volatile("s_waitcnt vmcnt(8)" ::: "memory"); } \
            else { asm volatile("s_waitcnt vmcnt(0)" ::: "memory"); } \
            f32x16 p = f32x16{}; \
            _Pragma("unroll") for (int d0 = 0; d0 < 4; ++d0) p = __builtin_amdgcn_mfma_f32_32x32x16_bf16(KF[d0], qr[d0], p, 0, 0, 0); \
            const unsigned vb = vb0 + (unsigned)(((c) & 1) * 4096); \
            s16x4 vl0[2], vh0[2], vl1[2], vh1[2]; \
            _Pragma("unroll") for (int d0 = 0; d0 < 2; ++d0) { \
                asm volatile("ds_read_b64_tr_b16 %0, %1 offset:%2" : "=&v"(vl0[d0]) : "v"(vb), "i"(d0 * 512) : "memory"); \
                asm volatile("ds_read_b64_tr_b16 %0, %1 offset:%2" : "=&v"(vh0[d0]) : "v"(vb), "i"(d0 * 512 + 1024) : "memory"); \
                asm volatile("ds_read_b64_tr_b16 %0, %1 offset:%2" : "=&v"(vl1[d0]) : "v"(vb), "i"(d0 * 512 + 2048) : "memory"); \
                asm volatile("ds_read_b64_tr_b16 %0, %1 offset:%2" : "=&v"(vh1[d0]) : "v"(vb), "i"(d0 * 512 + 3072) : "memory"); } \
              \
            { const float NEG = -__builtin_inff(); const int db = qi - j0 - 32 * (c) - 4 * hi; const int tb = tokb + S_ * (32 * (c) + 4 * hi); \
              if ((c) == 0 || (c) == 4 || tokb < 0) { \
                _Pragma("unroll") for (int r = 0; r < 16; ++r) { const int cr = (r & 3) + 8 * (r >> 2); \
                    const bool ok = ((unsigned)(db - cr) <= 128u) && (tb + S_ * cr >= 0); p[r] = ok ? p[r] : NEG; } } } \
            float pmax = p[0]; \
            _Pragma("unroll") for (int r = 1; r < 16; ++r) pmax = fmaxf(pmax, p[r]); \
            { auto rr = __builtin_amdgcn_permlane32_swap(__float_as_uint(pmax), __float_as_uint(pmax), false, false); pmax = fmaxf(__uint_as_float(rr[0]), __uint_as_float(rr[1])); } \
            const float mn = fmaxf(m_reg, pmax); const float alpha = __builtin_amdgcn_exp2f(m_reg - mn); m_reg = mn; \
            float ps = 0.f; \
            _Pragma("unroll") for (int r = 0; r < 16; ++r) { p[r] = __builtin_amdgcn_exp2f(p[r] - mn); ps += p[r]; } \
            { auto rr = __builtin_amdgcn_permlane32_swap(__float_as_uint(ps), __float_as_uint(ps), false, false); ps = __uint_as_float(rr[0]) + __uint_as_float(rr[1]); } \
            l_reg = l_reg * alpha + ps; \
            bf16x8 pa0, pa1; DIL_PK4(p, 0, pa0); DIL_PK4(p, 8, pa1); \
            if (__any(alpha < 1.f)) { if (hi == 0) wsf[r32] = alpha; asm volatile("s_waitcnt lgkmcnt(0)" ::: "memory"); \
                _Pragma("unroll") for (int r = 0; r < 16; ++r) { const float a = wsf[crow(r, hi)]; o[0][r] *= a; o[1][r] *= a; } } \
            asm volatile("s_waitcnt lgkmcnt(0)" ::: "memory"); __builtin_amdgcn_sched_barrier(0); \
            _Pragma("unroll") for (int d0 = 0; d0 < 2; ++d0) { \
                o[d0] = __builtin_amdgcn_mfma_f32_32x32x16_bf16(pa0, (bf16x8){vl0[d0][0], vl0[d0][1], vl0[d0][2], vl0[d0][3], vh0[d0][0], vh0[d0][1], vh0[d0][2], vh0[d0][3]}, o[d0], 0, 0, 0); \
                o[d0] = __builtin_amdgcn_mfma_f32_32x32x16_bf16(pa1, (bf16x8){vl1[d0][0], vl1[d0][1], vl1[d0][2], vl1[d0][3], vh1[d0][0], vh1[d0][1], vh1[d0][2], vh1[d0][3]}, o[d0], 0, 0, 0); } \
        } while (0)
#define DIL_PK4(P, B_, OUT) do { unsigned a0 = cvt_pk_bf16(P[B_+0], P[B_+1]), a1 = cvt_pk_bf16(P[B_+2], P[B_+3]);                          \
            unsigned b0_ = cvt_pk_bf16(P[B_+4], P[B_+5]), b1_ = cvt_pk_bf16(P[B_+6], P[B_+7]);                                             \
            auto r0 = __builtin_amdgcn_permlane32_swap(a0, b0_, false, false); auto r1 = __builtin_amdgcn_permlane32_swap(a1, b1_, false, false); \
            u32x4 w = {r0[0], r1[0], r0[1], r1[1]}; OUT = __builtin_bit_cast(bf16x8, w); } while (0)
        DIL_STEP(kfA, kfB, 0); DIL_STEP(kfB, kfA, 1); DIL_STEP(kfA, kfB, 2); DIL_STEP(kfB, kfA, 3); DIL_STEP(kfA, kfB, 4);
#undef DIL_STEP
#undef DIL_PK4
#undef DIL_KLOAD
#undef DIL_VDMA
        float fo = 0.f, fc = 1.f;
        if (S_ != 1) { const float mo = macc[ql], lo = lacc[ql]; const float mnew = fmaxf(mo, m_reg); fo = __builtin_amdgcn_exp2f(mo - mnew); fc = __builtin_amdgcn_exp2f(m_reg - mnew);
            l_reg = lo * fo + l_reg * fc; m_reg = mnew; }
        if (hi == 0 && r32 < VR) { macc[ql] = m_reg; lacc[ql] = l_reg; wsf[r32] = fo; wsf[32 + r32] = fc; }
        asm volatile("s_waitcnt lgkmcnt(0)" ::: "memory");
#pragma unroll
        for (int r = 0; r < 16; ++r) { const int row = crow(r, hi);
            if (row < VR) { const int qrow = rho + S_ * (i0 + row); LAS float* op = Oacc + qrow * 64 + r32;
                if (S_ == 1) { op[0] = o[0][r]; op[32] = o[1][r]; }
                else { const float a = wsf[row], b = wsf[32 + row]; op[0] = op[0] * a + o[0][r] * b; op[32] = op[32] * a + o[1][r] * b; } } }
        asm volatile("s_waitcnt lgkmcnt(0)" ::: "memory");
    }
}
__device__ __forceinline__ void unit(const bf16_t* Qh, const bf16_t* Kh, const bf16_t* Vh, int pitch, bf16_t* Oh, int op, int q0, LAS unsigned char* lds, LAS float* scr) {
    int tid_ = threadIdx.x; asm volatile("" : "+v"(tid_));
    const int tid = tid_, wid = __builtin_amdgcn_readfirstlane(tid >> 6), lane = tid & 63;
    pass<1>(Qh, Kh, Vh, pitch, q0, lds, scr, wid, lane);
    __syncthreads();
    pass<4>(Qh, Kh, Vh, pitch, q0, lds, scr, wid, lane);
    __syncthreads();
    pass<16>(Qh, Kh, Vh, pitch, q0, lds, scr, wid, lane);
    __syncthreads();
    {   const int q = tid >> 1, hf = tid & 1; const LAS f32x4* src = (const LAS f32x4*)(lds + OFF_O + (q * 64 + 32 * hf) * 4); const float rl = 1.0f / scr[256 + q];
        bf16_t* dst = Oh + (size_t)(q0 + q) * op + 32 * hf;
#pragma unroll
        for (int i = 0; i < 4; ++i) { const f32x4 a = src[2 * i] * rl, b = src[2 * i + 1] * rl;
            u32x4 w; w.x = cvt_pk_bf16(a[0], a[1]); w.y = cvt_pk_bf16(a[2], a[3]); w.z = cvt_pk_bf16(b[0], b[1]); w.w = cvt_pk_bf16(b[2], b[3]); *(u32x4*)(dst + 8 * i) = w; } }
    __syncthreads();
}
}

namespace mla {
using att::crow;
constexpr int DQ = 192, DV_ = 128;
constexpr int KP = DQ + 16, KB = 64 * KP;
constexpr int VP = 80, VB = DV_ * VP;
constexpr int NBUF = 3;
constexpr int OFF_K = 0, OFF_V = NBUF * KB, OFF_WS = NBUF * (KB + VB), BYTES = OFF_WS + 8 * 256;
constexpr int KCPR = KP / 16, NKP = KB / 1024, KPW = (NKP + 7) / 8;
constexpr int NVP = VB / 256, VPW = NVP / 8;
static_assert(BYTES <= 131072 && KB % 1024 == 0 && VB % 256 == 0 && NVP % 8 == 0, "mla LDS image");
constexpr float PSHIFT = 8.0f;

__device__ __forceinline__ void unit(const unsigned char* __restrict__ Qh, const unsigned char* __restrict__ Kh, int pitch, const unsigned char* __restrict__ VTh  ,
                                     unsigned char* __restrict__ Oh, int op, int q0, LAS unsigned char* lds) {
    constexpr float SC = C2_C;
    int tid_ = threadIdx.x; asm volatile("" : "+v"(tid_));
    const int tid = tid_, wid = __builtin_amdgcn_readfirstlane(tid >> 6), lane = tid & 63, r32 = lane & 31, hi = lane >> 5;
    const int qlo = q0 + wid * 32, qpos = qlo + r32;
    LAS float* wsf = (LAS float*)(lds + OFF_WS) + wid * 64;
    const int NT = (q0 + 256) / 64;
    unsigned kso[KPW], vso[VPW];
#pragma unroll
    for (int i = 0; i < KPW; ++i) { const int c = (wid + 8 * i) * 64 + lane, row = c / KCPR; int cc = c % KCPR; if (cc > KCPR - 2) cc = KCPR - 2; kso[i] = (unsigned)((row & 63) * pitch + cc * 16); }
#pragma unroll
    for (int i = 0; i < VPW; ++i) { const int off = ((wid + 8 * i) * 64 + lane) * 4, d = off / VP; int w = off % VP; if (w >= 64) w = 0;
        const int hh = w >> 5, g = (w & 31) >> 2; vso[i] = (unsigned)(d * SEQ + 32 * (g >> 2) + 8 * (g & 3) + 4 * hh); }
#define MLA_DMA(j, bf) do { const unsigned char* kt_ = Kh + (size_t)(j) * 64 * pitch; const unsigned char* vt_ = VTh + (size_t)(j) * 64; \
        _Pragma("unroll") for (int i = 0; i < KPW; ++i) if (wid + 8 * i < NKP) \
            __builtin_amdgcn_global_load_lds((const unsigned*)(kt_ + kso[i]), (LAS unsigned*)(lds + OFF_K + (bf) * KB + (wid + 8 * i) * 1024), 16, 0, 0); \
        _Pragma("unroll") for (int i = 0; i < VPW; ++i) \
            __builtin_amdgcn_global_load_lds((const unsigned*)(vt_ + vso[i]), (LAS unsigned*)(lds + OFF_V + (bf) * VB + (wid + 8 * i) * 256), 4, 0, 0); } while (0)
    MLA_DMA(0, 0);
    if (NT > 1) MLA_DMA(1, 1);
    i32x8 qr[3];
#pragma unroll
    for (int s = 0; s < 3; ++s) { const i32x4 lo_ = *(const i32x4*)(Qh + (size_t)qpos * pitch + 64 * s + 32 * hi), hi_ = *(const i32x4*)(Qh + (size_t)qpos * pitch + 64 * s + 32 * hi + 16);
        qr[s] = __builtin_shufflevector(lo_, hi_, 0, 1, 2, 3, 4, 5, 6, 7); }
    float m_reg = -1e30f;
    f32x16 o[4], ol = f32x16{};
    const i32x8 ones8 = {0x38383838, 0x38383838, 0x38383838, 0x38383838, 0x38383838, 0x38383838, 0x38383838, 0x38383838};
#pragma unroll
    for (int d = 0; d < 4; ++d) o[d] = f32x16{};
    const int koff = r32 * KP + hi * 32, voff = r32 * VP + hi * 32;
    asm volatile("s_waitcnt vmcnt(0)" ::: "memory");
    __syncthreads();
#define MLA_QK(P, bufi, hf_) do { const LAS unsigned char* kb_ = lds + OFF_K + (bufi) * KB + (hf_) * 32 * KP + koff; P = f32x16{}; \
        i32x8 kw_[3]; _Pragma("unroll") for (int s = 0; s < 3; ++s) { const i32x4 lo_ = *(const LAS i32x4*)(kb_ + 64 * s), hi_ = *(const LAS i32x4*)(kb_ + 64 * s + 16); kw_[s] = __builtin_shufflevector(lo_, hi_, 0, 1, 2, 3, 4, 5, 6, 7); } \
        _Pragma("unroll") for (int s = 0; s < 3; ++s) P = __builtin_amdgcn_mfma_scale_f32_32x32x64_f8f6f4(kw_[s], qr[s], P, 0, 0, 0, 0, 0, 0); } while (0)
    f32x16 pA, pB, pC, pD;
    int buf = 0;
    { if (0 <= qlo + 31) { MLA_QK(pA, 0, 0); } if (32 <= qlo + 31) { MLA_QK(pB, 0, 1); } }
#define MLA_SMPV(P0, P1, kb, vbuf) do { \
        const bool a0_ = (kb) <= qlo + 31, a1_ = (kb) + 32 <= qlo + 31; \
        if (a0_) { \
            const float NEG = -__builtin_inff(); const int dq = qpos - (kb) - 4 * hi; \
            if (!a1_) { _Pragma("unroll") for (int r = 0; r < 16; ++r) P1[r] = NEG; } \
            if ((kb) + 63 > qlo) { _Pragma("unroll") for (int r = 0; r < 16; ++r) { const int c = (r & 3) + 8 * (r >> 2); if (dq - c < 0) P0[r] = NEG; if (dq - c - 32 < 0) P1[r] = NEG; } } \
            float pmax = fmaxf(P0[0], P1[0]); \
            _Pragma("unroll") for (int r = 1; r < 16; ++r) pmax = fmaxf(pmax, fmaxf(P0[r], P1[r])); \
            { auto rr = __builtin_amdgcn_permlane32_swap(__float_as_uint(pmax), __float_as_uint(pmax), false, false); pmax = fmaxf(__uint_as_float(rr[0]), __uint_as_float(rr[1])); } \
            const float mn = fmaxf(m_reg, pmax * SC); const float alpha = __builtin_amdgcn_exp2f(m_reg - mn); m_reg = mn; \
              \
              \
            const float c8 = 8.0f * SC, b8 = 8.0f * (PSHIFT + 7.0f - mn); \
            i32x8 pa; \
            _Pragma("unroll") for (int g = 0; g < 4; ++g) { unsigned w0 = 0u, w1 = 0u; \
                _Pragma("unroll") for (int b_ = 0; b_ < 4; ++b_) { w0 = __builtin_amdgcn_cvt_pk_u8_f32(__builtin_fmaf(P0[4 * g + b_], c8, b8), b_, w0); w1 = __builtin_amdgcn_cvt_pk_u8_f32(__builtin_fmaf(P1[4 * g + b_], c8, b8), b_, w1); } \
                pa[g] = (int)w0; pa[4 + g] = (int)w1; } \
            if (__any(alpha < 1.f)) { if (hi == 0) wsf[r32] = alpha; asm volatile("s_waitcnt lgkmcnt(0)" ::: "memory"); \
                _Pragma("unroll") for (int r = 0; r < 16; ++r) { const float a = wsf[crow(r, hi)]; ol[r] *= a; _Pragma("unroll") for (int d = 0; d < 4; ++d) o[d][r] *= a; } } \
            ol = __builtin_amdgcn_mfma_scale_f32_32x32x64_f8f6f4(pa, ones8, ol, 0, 0, 0, 0, 0, 0); \
            const LAS unsigned char* vb_ = lds + OFF_V + (vbuf) * VB + voff; \
            _Pragma("unroll") for (int d0 = 0; d0 < 4; ++d0) { const i32x4 lo_ = *(const LAS i32x4*)(vb_ + d0 * 32 * VP), hi_ = *(const LAS i32x4*)(vb_ + d0 * 32 * VP + 16); \
                o[d0] = __builtin_amdgcn_mfma_scale_f32_32x32x64_f8f6f4(pa, __builtin_shufflevector(lo_, hi_, 0, 1, 2, 3, 4, 5, 6, 7), o[d0], 0, 0, 0, 0, 0, 0); } \
        } } while (0)
    for (int t = 0; t < NT; t += 2) {
        {   if (t + 2 < NT) { const int b2 = buf == 0 ? 2 : buf - 1; MLA_DMA(t + 2, b2); }
            const int kb = t * 64, nb = buf == 2 ? 0 : buf + 1;
            if (kb + 64 <= qlo + 31) MLA_QK(pC, nb, 0);
            if (kb + 96 <= qlo + 31) MLA_QK(pD, nb, 1);
            MLA_SMPV(pA, pB, kb, buf);
            asm volatile("s_waitcnt vmcnt(0)" ::: "memory"); __syncthreads(); buf = nb; }
        {   if (t + 3 < NT) { const int b2 = buf == 0 ? 2 : buf - 1; MLA_DMA(t + 3, b2); }
            const int kb = (t + 1) * 64, nb = buf == 2 ? 0 : buf + 1;
            if (t + 2 < NT) { if (kb + 64 <= qlo + 31) MLA_QK(pA, nb, 0); if (kb + 96 <= qlo + 31) MLA_QK(pB, nb, 1); }
            MLA_SMPV(pC, pD, kb, buf);
            asm volatile("s_waitcnt vmcnt(0)" ::: "memory"); __syncthreads(); buf = nb; }
    }
#undef MLA_SMPV
#undef MLA_QK
#undef MLA_DMA
    unsigned char* Ow = Oh + (size_t)qlo * op;
#pragma unroll
    for (int r = 0; r < 16; ++r) { const int orow = crow(r, hi); const float rl = __builtin_amdgcn_rcpf(ol[r]);
#pragma unroll
        for (int d0 = 0; d0 < 4; ++d0) { const float v = o[d0][r] * rl; const float v1 = __shfl_down(v, 1), v2 = __shfl_down(v, 2), v3 = __shfl_down(v, 3);
            if ((r32 & 3) == 0) *(unsigned*)(Ow + (size_t)orow * op + d0 * 32 + r32) = pk4_fp8(v, v1, v2, v3); } }
    __syncthreads();
}
}

constexpr int NWAVES = 8;
constexpr size_t MiB = 1u << 20;
constexpr size_t WS_CTL = 0, CTL_ZERO_BYTES = 1 * MiB;
constexpr size_t WS_WEIN = 2 * MiB;
constexpr size_t WS_WEOUT = 12 * MiB;
constexpr size_t WS_WOIN = 16 * MiB;
constexpr size_t WS_WUQ = 20 * MiB;
constexpr size_t WS_WUKV = 23 * MiB;
constexpr size_t WS_WOOUT = 25 * MiB;
constexpr size_t WS_B1P = 29 * MiB;
constexpr size_t WS_SSQ = 30 * MiB;
constexpr size_t WS_TOKER = 31 * MiB;
constexpr size_t WS_TOKG = 31 * MiB + 512 * 1024;
constexpr size_t WS_XN = 32 * MiB;
constexpr size_t WS_Z = 64 * MiB;
constexpr size_t WS_MIX = 144 * MiB;
constexpr size_t WS_QR = 176 * MiB;
constexpr size_t WS_KVR = 224 * MiB;
constexpr size_t WS_QF = 288 * MiB;
constexpr size_t WS_KF = 336 * MiB;
constexpr size_t WS_Z8 = 104 * MiB;
constexpr size_t WS_MIX8 = 160 * MiB;
constexpr size_t WS_VT = 3200 * MiB;
constexpr size_t WS_W1 = 384 * MiB;
constexpr size_t WS_W2 = 896 * MiB;
constexpr size_t WS_XG = 1152 * MiB;
constexpr size_t WS_ACT = 1664 * MiB;
constexpr size_t WS_Y = 2176 * MiB;
constexpr size_t WS_END = 3216 * MiB;
constexpr int CW_MOE = 65536;
constexpr int CW_TMO = 0, CW_CODE = 1, CW_BAR = 4096, CW_CNT = 16384;
constexpr int RING_OFF = 0, RING_BYTES = 131072;
constexpr int LDSCTL_OFF = RING_BYTES, MISC_OFF = LDSCTL_OFF + 320;
constexpr int SCR_OFF = RING_BYTES + 1024;
constexpr int LDS_BYTES = 155648;
constexpr int SCR_BYTES = LDS_BYTES - SCR_OFF;

typedef GAS unsigned gu32;
#define RLX_AGENT __ATOMIC_RELAXED, __HIP_MEMORY_SCOPE_AGENT

#define XB_TMO      128
#define XB_XCNT(j)  (256  + 64 * (j))
#define XB_XSUB(j)  (1280 + 64 * (j))
#define XB_XGEN(j)  (2304 + 64 * (j))
#define XB_TOP      3328
#define XB_TOPGEN   3392
#define XCD_BAR_WORDS 3456
#define XB_SPIN_CAP (1u << 18)
__device__ __forceinline__ unsigned xb_ld(unsigned* p)              { return __hip_atomic_load(p, __ATOMIC_RELAXED, __HIP_MEMORY_SCOPE_AGENT); }
__device__ __forceinline__ unsigned xb_add(unsigned* p, unsigned v) { return __hip_atomic_fetch_add(p, v, __ATOMIC_RELAXED, __HIP_MEMORY_SCOPE_AGENT); }
__device__ __forceinline__ unsigned xb_xcc_id() { return (unsigned)__builtin_amdgcn_s_getreg((3 << 11) | 20) & 0xFu; }
#define XB_SPIN(cond, bar) do { unsigned _sp = 0; while (cond) { __builtin_amdgcn_s_sleep(1); \
    if ((++_sp & 255u) == 0u) { if (xb_ld(&(bar)[XB_TMO])) break; if (_sp > XB_SPIN_CAP) { atomicAdd(&(bar)[XB_TMO], 1u); break; } } } } while (0)
struct XcdBarrier { unsigned* bar; unsigned x; volatile LAS unsigned* st; };
__device__ __forceinline__ XcdBarrier xcd_barrier_post(unsigned* bar, volatile LAS unsigned* st) {
    XcdBarrier b; b.bar = bar; b.x = xb_xcc_id(); b.st = st;
    if (threadIdx.x == 0) (void)xb_add(&bar[XB_XCNT(b.x)], 1u);
    return b;
}
__device__ __forceinline__ void xcd_barrier_complete(unsigned* bar, unsigned x, unsigned& nloc, unsigned& nx) {
    const unsigned G = gridDim.x * gridDim.y * gridDim.z;
    unsigned sum, cnt, mine, sp = 0u;
    for (;;) {
        sum = 0u; cnt = 0u; mine = 0u;
#pragma unroll
        for (unsigned j = 0; j < 16; ++j) { const unsigned c = xb_ld(&bar[XB_XCNT(j)]); sum += c; cnt += (c > 0u) ? 1u : 0u; mine = (j == x) ? c : mine; }
        if (sum == G) break;
        __builtin_amdgcn_s_sleep(1);
        if ((++sp & 255u) == 0u) { if (xb_ld(&bar[XB_TMO])) break; if (sp > XB_SPIN_CAP) { atomicAdd(&bar[XB_TMO], 1u); break; } }
    }
    nloc = mine > 0u ? mine : 1u; nx = cnt > 0u ? cnt : 1u;
}
__device__ __forceinline__ void xcd_barrier(const XcdBarrier& b) {
    asm volatile("s_waitcnt vmcnt(0)" ::: "memory");
    __syncthreads();
    if (threadIdx.x == 0) {
        unsigned* bar = b.bar;
        __builtin_amdgcn_s_waitcnt(0);
        unsigned nloc = b.st[0], nx = b.st[1];
        if (nloc == 0u) { xcd_barrier_complete(bar, b.x, nloc, nx); b.st[0] = nloc; b.st[1] = nx; }
        const unsigned old = xb_add(&bar[XB_XSUB(b.x)], 1u);
        const unsigned gen = old / nloc;
        if (old + 1u == (gen + 1u) * nloc) {
            __builtin_amdgcn_fence(__ATOMIC_RELEASE, "agent");
            asm volatile("s_waitcnt vmcnt(0)" ::: "memory");
            const unsigned og = xb_add(&bar[XB_TOP], 1u);
            const unsigned tg = og / nx;
            if (og + 1u == (tg + 1u) * nx) xb_add(&bar[XB_TOPGEN], 1u);
            else XB_SPIN(xb_ld(&bar[XB_TOPGEN]) == tg, bar);
            __builtin_amdgcn_fence(__ATOMIC_ACQUIRE, "agent");
            xb_add(&bar[XB_XGEN(b.x)], 1u);
            asm volatile("s_waitcnt vmcnt(0)" ::: "memory");
        } else {
            XB_SPIN(xb_ld(&bar[XB_XGEN(b.x)]) == gen, bar);
            __builtin_amdgcn_fence(__ATOMIC_ACQUIRE, "agent");
            asm volatile("s_waitcnt vmcnt(0)" ::: "memory");
        }
    }
    __syncthreads();
}

struct Args {
    const float* in[24]; float* out; unsigned char* ws; int stage_limit; int pad;
};
enum { I_X = 0, I_MIXN, I_FFNN, I_EWIN, I_EWS, I_EBS, I_EGV, I_EGQ, I_EGK, I_EWOUT, I_OWIN, I_OGCQ, I_OGCKV, I_OWUQ, I_OWUKV, I_OGQ, I_OGK, I_OWOUT,
       I_RW, I_RB, I_W1, I_B1, I_W2, I_B2 };

struct Frame {
    LAS unsigned char* lds;
    int vcu, G;
};

__device__ __forceinline__ float wave_sum(float v) {
#pragma unroll
    for (int o = 1; o < 64; o <<= 1) v += __shfl_xor(v, o);
    return v;
}
#define LDS_WAIT() asm volatile("s_waitcnt lgkmcnt(0)" ::: "memory")

template <int MODE> __device__ __forceinline__ int dst_row(int o) {
    if (MODE == 1) { if (o >= 1024 && o < 2048) return (o & ~255) | (((o >> 5) & 1) << 7) | (((o >> 6) & 3) << 5) | (o & 31); return o; }
    if (MODE == 2) return ((o >> 8) << 8) | ((o & 1) << 7) | ((o & 255) >> 1);
    return o;
}
template <int MODE>
__device__ __forceinline__ void transpose_item(const float* __restrict__ W, int K, int N, bf16_t* __restrict__ WT, const float* __restrict__ gain, LAS float* scr, int item, int lane) {
    const int nblk = N / 32, kb = item / nblk, nb = item % nblk, k0 = 64 * kb, n0 = 32 * nb;
#pragma unroll 8
    for (int i = 0; i < 32; ++i) { const int kk = 2 * i + (lane >> 5); float w = W[(size_t)(k0 + kk) * N + n0 + (lane & 31)]; if (gain) w *= gain[k0 + kk]; scr[kk * 33 + (lane & 31)] = w; }
    LDS_WAIT(); asm volatile("" ::: "memory");
    const int c = lane & 7;
#pragma unroll
    for (int j = 0; j < 4; ++j) { const int n = (lane >> 3) + 8 * j; const LAS float* s = scr + (8 * c) * 33 + n;
        u32x4 o; o.x = cvt_pk_bf16(s[0 * 33], s[1 * 33]); o.y = cvt_pk_bf16(s[2 * 33], s[3 * 33]); o.z = cvt_pk_bf16(s[4 * 33], s[5 * 33]); o.w = cvt_pk_bf16(s[6 * 33], s[7 * 33]);
        *(u32x4*)(WT + (size_t)dst_row<MODE>(n0 + n) * K + k0 + 8 * c) = o; }
    LDS_WAIT(); asm volatile("" ::: "memory");
}
template <int MODE>
__device__ __forceinline__ void transpose_job(Frame& F, const float* W, int K, int N, int nmat, size_t src_stride, bf16_t* WT, size_t dst_stride, const float* gain, int gain_stride) {
    int tid_ = threadIdx.x; asm volatile("" : "+v"(tid_));
    const int wave = __builtin_amdgcn_readfirstlane(tid_ >> 6), lane = tid_ & 63;
    LAS float* scr = (LAS float*)(F.lds + RING_OFF + wave * 16384);
    const int gw = F.vcu * NWAVES + wave, NGW = F.G * NWAVES;
    const int per = (K / 64) * (N / 32), total = per * nmat;
    for (int it = gw; it < total; it += NGW) { const int mi = it / per, item = it - mi * per;
        transpose_item<MODE>(W + (size_t)mi * src_stride, K, N, WT + (size_t)mi * dst_stride, gain ? gain + (size_t)mi * gain_stride : nullptr, scr, item, lane); }
}


__device__ __forceinline__ void tr8_load(f32x4 (&v)[8], const float* __restrict__ W, int N, int item, int lane) {
    const int nblk = N / 32, kb = item / nblk, nb = item % nblk, k0 = 64 * kb, n0 = 32 * nb;
#pragma unroll
    for (int i = 0; i < 8; ++i) v[i] = __builtin_nontemporal_load((const f32x4*)(W + (size_t)(k0 + 8 * i + (lane >> 3)) * N + n0 + 4 * (lane & 7)));
}
template <int MODE>
__device__ __forceinline__ void tr8_store(const f32x4 (&v)[8], int K, int N, unsigned char* __restrict__ WT, const float* __restrict__ gain, LAS float* scr, int item, int lane) {
    const int nblk = N / 32, kb = item / nblk, nb = item % nblk, k0 = 64 * kb, n0 = 32 * nb;
#pragma unroll
    for (int i = 0; i < 8; ++i) { LAS float* d = scr + (8 * i + (lane >> 3)) * 33 + 4 * (lane & 7); const float sc = gain ? W8_SCALE * gain[k0 + 8 * i + (lane >> 3)] : W8_SCALE;
        d[0] = v[i].x * sc; d[1] = v[i].y * sc; d[2] = v[i].z * sc; d[3] = v[i].w * sc; }
    LDS_WAIT(); asm volatile("" ::: "memory");
    const int c = lane & 3;
#pragma unroll
    for (int j = 0; j < 2; ++j) { const int n = (lane >> 2) + 16 * j; const LAS float* s = scr + (16 * c) * 33 + n;
        u32x4 o; o.x = pk4_fp8(s[0 * 33], s[1 * 33], s[2 * 33], s[3 * 33]); o.y = pk4_fp8(s[4 * 33], s[5 * 33], s[6 * 33], s[7 * 33]);
        o.z = pk4_fp8(s[8 * 33], s[9 * 33], s[10 * 33], s[11 * 33]); o.w = pk4_fp8(s[12 * 33], s[13 * 33], s[14 * 33], s[15 * 33]);
        __builtin_nontemporal_store(o, (u32x4*)(WT + (size_t)dst_row<MODE>(n0 + n) * K + k0 + 16 * c)); }
    LDS_WAIT(); asm volatile("" ::: "memory");
}
template <int MODE>
__device__ __forceinline__ void transpose_job_fp8(Frame& F, const float* W, int K, int N, int nmat, size_t src_stride, unsigned char* WT, size_t dst_stride, const float* gain = nullptr, int gain_stride = 0) {
    int tid_ = threadIdx.x; asm volatile("" : "+v"(tid_));
    const int wave = __builtin_amdgcn_readfirstlane(tid_ >> 6), lane = tid_ & 63;
    LAS float* scr = (LAS float*)(F.lds + RING_OFF + wave * 16384);
    const int gw = F.vcu * NWAVES + wave, NGW = F.G * NWAVES;
    const int per = (K / 64) * (N / 32), total = per * nmat;
    f32x4 cur[8], nxt[8];
    int it = gw;
    if (it < total) { const int mi = it / per; tr8_load(cur, W + (size_t)mi * src_stride, N, it - mi * per, lane); }
    for (; it < total; it += NGW) {
        const int itn = it + NGW;
        if (itn < total) { const int mn = itn / per; tr8_load(nxt, W + (size_t)mn * src_stride, N, itn - mn * per, lane); }
        const int mi = it / per;
        tr8_store<MODE>(cur, K, N, WT + (size_t)mi * dst_stride, gain ? gain + (size_t)mi * gain_stride : nullptr, scr, it - mi * per, lane);
#pragma unroll
        for (int i = 0; i < 8; ++i) cur[i] = nxt[i];
    }
}

__device__ __forceinline__ void rms_row_to_fp8(int lane, const float* xrow, const float* g, unsigned char* orow, float* copy) {
    const f32x4* xr = (const f32x4*)xrow + lane; const f32x4* gr = (const f32x4*)g + lane;
    f32x4 v[4]; float s = 0.f;
#pragma unroll
    for (int j = 0; j < 4; ++j) { v[j] = xr[64 * j]; s += (v[j].x * v[j].x + v[j].y * v[j].y) + (v[j].z * v[j].z + v[j].w * v[j].w); }
    const float rstd = 1.0f / sqrtf(wave_sum(s) * (1.f / DM) + EPS);
    unsigned* o4 = (unsigned*)orow + lane;
#pragma unroll
    for (int j = 0; j < 4; ++j) { const f32x4 gg = gr[64 * j]; if (copy) ((f32x4*)copy + lane)[64 * j] = v[j];
        o4[64 * j] = pk4_fp8(v[j].x * rstd * gg.x, v[j].y * rstd * gg.y, v[j].z * rstd * gg.z, v[j].w * rstd * gg.w); }
}
__device__ __forceinline__ void rms_row_to_bf16(int lane, const float* xrow, const float* g, bf16_t* orow, float* copy) {
    const f32x4* xr = (const f32x4*)xrow + lane; const f32x4* gr = (const f32x4*)g + lane;
    f32x4 v[4]; float s = 0.f;
#pragma unroll
    for (int j = 0; j < 4; ++j) { v[j] = xr[64 * j]; s += (v[j].x * v[j].x + v[j].y * v[j].y) + (v[j].z * v[j].z + v[j].w * v[j].w); }
    const float rstd = 1.0f / sqrtf(wave_sum(s) * (1.f / DM) + EPS);
    u32x2* o8 = (u32x2*)orow + lane;
#pragma unroll
    for (int j = 0; j < 4; ++j) { const f32x4 gg = gr[64 * j]; if (copy) ((f32x4*)copy + lane)[64 * j] = v[j];
        u32x2 w; w.x = cvt_pk_bf16(v[j].x * rstd * gg.x, v[j].y * rstd * gg.y); w.y = cvt_pk_bf16(v[j].z * rstd * gg.z, v[j].w * rstd * gg.w); o8[64 * j] = w; }
}

namespace pg8 {
struct EpiEvenIn {
    static constexpr bool PERM = false;
    bf16_t* Z; const float* gq; const float* gk;
    __device__ __forceinline__ void operator()(const f32x4 (&acc)[2][2][4][2], const Unit& u, int wr, int wc, int fr, int fq) const {
        const int row0 = u.pm * BM + wr * 64 + fr, pn = u.pn;
        if (pn >= 4 && pn < 8) {
            const float* g = pn < 6 ? gq : gk; const float sc = pn < 6 ? C2_B : 1.0f;
            f32x4 gv[2][2];
#pragma unroll
            for (int bj = 0; bj < 2; ++bj)
#pragma unroll
                for (int n = 0; n < 2; ++n) gv[bj][n] = *(const f32x4*)(g + 32 * bj + 16 * n + 4 * fq);
#pragma unroll
            for (int ai = 0; ai < 2; ++ai)
#pragma unroll
                for (int m = 0; m < 4; ++m) {
                    float ss = 0.f;
#pragma unroll
                    for (int bj = 0; bj < 2; ++bj)
#pragma unroll
                        for (int n = 0; n < 2; ++n) { const f32x4 v = acc[ai][bj][m][n]; ss += (v[0] * v[0] + v[1] * v[1]) + (v[2] * v[2] + v[3] * v[3]); }
                    ss += __shfl_xor(ss, 16); ss += __shfl_xor(ss, 32);
                    const float rstd = sc / sqrtf(ss * (1.0f / 64.0f) + EPS);
                    bf16_t* rowp = Z + (size_t)(row0 + ai * HALF + m * 16) * EVEN_IN + pn * BM + wc * 64 + 4 * fq;
#pragma unroll
                    for (int bj = 0; bj < 2; ++bj)
#pragma unroll
                        for (int n = 0; n < 2; ++n) { const f32x4 v = acc[ai][bj][m][n] * rstd * gv[bj][n];
                            u32x2 w; w.x = cvt_pk_bf16(v[0], v[1]); w.y = cvt_pk_bf16(v[2], v[3]); *(u32x2*)(rowp + 32 * bj + 16 * n) = w; }
                }
        } else {
            const bool act = pn < 4;
#pragma unroll
            for (int ai = 0; ai < 2; ++ai)
#pragma unroll
                for (int m = 0; m < 4; ++m) { bf16_t* rowp = Z + (size_t)(row0 + ai * HALF + m * 16) * EVEN_IN + pn * BM + wc * 32 + 4 * fq;
#pragma unroll
                    for (int bj = 0; bj < 2; ++bj)
#pragma unroll
                        for (int n = 0; n < 2; ++n) { f32x4 v = acc[ai][bj][m][n]; if (act) v = gelu4(v);
                            u32x2 w; w.x = cvt_pk_bf16(v[0], v[1]); w.y = cvt_pk_bf16(v[2], v[3]); *(u32x2*)(rowp + bj * HALF + 16 * n) = w; } }
        }
    }
};
template <bool F8 = false> struct EpiResidT {
    static constexpr bool PERM = false;
    float* out;
    __device__ __forceinline__ void operator()(const f32x4 (&acc)[2][2][4][2], const Unit& u, int wr, int wc, int fr, int fq) const {
        const int row0 = u.pm * BM + wr * 64 + fr;
#pragma unroll
        for (int ai = 0; ai < 2; ++ai)
#pragma unroll
            for (int m = 0; m < 4; ++m) { float* rowp = out + (size_t)(row0 + ai * HALF + m * 16) * DM + u.pn * BM + wc * 32 + 4 * fq;
#pragma unroll
                for (int bj = 0; bj < 2; ++bj)
#pragma unroll
                    for (int n = 0; n < 2; ++n) { f32x4* p = (f32x4*)(rowp + bj * HALF + 16 * n); *p = *p + (F8 ? acc[ai][bj][m][n] * W8_INV : acc[ai][bj][m][n]); }
                if (m & 1) asm volatile("" ::: "memory"); }
    }
};
typedef EpiResidT<false> EpiResid;
struct EpiOddIn {
    static constexpr bool PERM = false;
    bf16_t* Z; unsigned char* Z8; float* ssq;
    __device__ __forceinline__ void operator()(const f32x4 (&acc)[2][2][4][2], const Unit& u, int wr, int wc, int fr, int fq) const {
        const int row0 = u.pm * BM + wr * 64 + fr, pn = u.pn;
#pragma unroll
        for (int ai = 0; ai < 2; ++ai)
#pragma unroll
            for (int m = 0; m < 4; ++m) { const int row = row0 + ai * HALF + m * 16; bf16_t* rowp = Z + (size_t)row * ODD_INP + pn * BM + wc * 32 + 4 * fq;
                float ss = 0.f;
#pragma unroll
                for (int bj = 0; bj < 2; ++bj)
#pragma unroll
                    for (int n = 0; n < 2; ++n) { const f32x4 v = acc[ai][bj][m][n] * W8_INV; ss += (v[0] * v[0] + v[1] * v[1]) + (v[2] * v[2] + v[3] * v[3]);
                        if (pn < 3) *(unsigned*)(Z8 + (size_t)row * ODD_INP + pn * BM + wc * 32 + 4 * fq + bj * HALF + 16 * n) = pk4_fp8(v[0], v[1], v[2], v[3]);
                        else { u32x2 w; w.x = cvt_pk_bf16(v[0], v[1]); w.y = cvt_pk_bf16(v[2], v[3]); *(u32x2*)(rowp + bj * HALF + 16 * n) = w; } }
                ss += __shfl_xor(ss, 16); ss += __shfl_xor(ss, 32);
                if (fq == 0) ssq[(size_t)row * 16 + pn * 4 + wc] = ss; }
    }
};
template <int NS> struct EpiRowScale {
    static constexpr bool PERM = true;
    bf16_t* O; int ldc; const float* ssq; int s0; float inv_cols;
    __device__ __forceinline__ void operator()(const f32x4 (&acc)[2][2][4][2], const Unit& u, int wr, int wc, int fr, int fq) const {
        const int row0 = u.pm * BM + wr * 64 + fr; const int col0 = u.pn * BM + wc * 32 + 8 * fq;
#pragma unroll
        for (int ai = 0; ai < 2; ++ai)
#pragma unroll
            for (int m = 0; m < 4; ++m) { const int row = row0 + ai * HALF + m * 16;
                float ss = 0.f; const f32x4* sp = (const f32x4*)(ssq + (size_t)row * 16 + s0);
#pragma unroll
                for (int q = 0; q < NS; ++q) { const f32x4 t = sp[q]; ss += (t[0] + t[1]) + (t[2] + t[3]); }
                const float rstd = W8_INV / sqrtf(ss * inv_cols + EPS);
                bf16_t* rowp = O + (size_t)row * ldc + col0;
#pragma unroll
                for (int bj = 0; bj < 2; ++bj) { const f32x4 v0 = acc[ai][bj][m][0] * rstd, v1 = acc[ai][bj][m][1] * rstd;
                    u32x4 w; w.x = cvt_pk_bf16(v0[0], v0[1]); w.y = cvt_pk_bf16(v0[2], v0[3]); w.z = cvt_pk_bf16(v1[0], v1[1]); w.w = cvt_pk_bf16(v1[2], v1[3]);
                    *(u32x4*)(rowp + bj * HALF) = w; }
                asm volatile("" ::: "memory"); }
    }
};
__device__ __forceinline__ void store8_sc1(void* p, u32x2 v) { asm volatile("global_store_dwordx2 %0, %1, off sc1" :: "v"(p), "v"(v) : "memory"); }
template <bool WT = false> struct EpiSwigluT {
    static constexpr bool PERM = true;
    unsigned char* ACT; const float* b1p;
    __device__ __forceinline__ void operator()(const f32x4 (&acc)[2][2][4][2], const Unit& u, int wr, int wc, int fr, int fq) const {
        const int row0 = u.pm * BM + wr * 64 + fr, e = u.pb >> 3, pn = u.pn;
        const float* bp = b1p + (size_t)e * 2048 + pn * BM + wc * 32 + 8 * fq;
        f32x4 bg[2], bl[2];
#pragma unroll
        for (int n = 0; n < 2; ++n) { bg[n] = *(const f32x4*)(bp + 4 * n); bl[n] = *(const f32x4*)(bp + HALF + 4 * n); }
#pragma unroll
        for (int ai = 0; ai < 2; ++ai)
#pragma unroll
            for (int m = 0; m < 4; ++m) { unsigned char* rowp = ACT + (size_t)(row0 + ai * HALF + m * 16) * DE + pn * HALF + wc * 32 + 8 * fq;
                float a[8];
#pragma unroll
                for (int n = 0; n < 2; ++n) { const f32x4 gv = acc[ai][0][m][n] * W8_INV + bg[n], lv = acc[ai][1][m][n] * W8_INV + bl[n];
#pragma unroll
                    for (int i = 0; i < 4; ++i) { const float gl = fminf(gv[i], 7.0f), li = fminf(fmaxf(lv[i], -7.0f), 7.0f);
                        const float sg = __builtin_amdgcn_rcpf(1.0f + __builtin_amdgcn_exp2f(-1.702f * LOG2E * gl));
                        a[4 * n + i] = gl * sg * (li + 1.0f); } }
                u32x2 w; w.x = pk4_fp8(a[0], a[1], a[2], a[3]); w.y = pk4_fp8(a[4], a[5], a[6], a[7]);
                if (WT) store8_sc1(rowp, w); else *(u32x2*)rowp = w; }
    }
};
typedef EpiSwigluT<false> EpiSwiglu;
struct EpiDown {
    static constexpr bool PERM = true;
    bf16_t* Y; const float* b2;
    __device__ __forceinline__ void operator()(const f32x4 (&acc)[2][2][4][2], const Unit& u, int wr, int wc, int fr, int fq) const {
        const int row0 = u.pm * BM + wr * 64 + fr, e = u.pb >> 2, pn = u.pn;
        const float* bp = b2 + (size_t)e * DM + pn * BM + wc * 32 + 8 * fq;
        f32x4 bv[2][2];
#pragma unroll
        for (int bj = 0; bj < 2; ++bj)
#pragma unroll
            for (int n = 0; n < 2; ++n) bv[bj][n] = *(const f32x4*)(bp + bj * HALF + 4 * n);
#pragma unroll
        for (int ai = 0; ai < 2; ++ai)
#pragma unroll
            for (int m = 0; m < 4; ++m) { bf16_t* rowp = Y + (size_t)(row0 + ai * HALF + m * 16) * DM + pn * BM + wc * 32 + 8 * fq;
#pragma unroll
                for (int bj = 0; bj < 2; ++bj) { const f32x4 v0 = acc[ai][bj][m][0] * W8_INV + bv[bj][0], v1 = acc[ai][bj][m][1] * W8_INV + bv[bj][1];
                    u32x4 w; w.x = cvt_pk_bf16(v0[0], v0[1]); w.y = cvt_pk_bf16(v0[2], v0[3]); w.z = cvt_pk_bf16(v1[0], v1[1]); w.w = cvt_pk_bf16(v1[2], v1[3]);
                    *(u32x4*)(rowp + bj * HALF) = w; } }
    }
};
struct MoeOrder {
    const LAS int* tbl; int nN, G, c;
    __device__ bool next(int i, Unit& u) const {
        const long L = (long)i * G + c; const int rb = (int)(L / nN);
        if (rb >= __builtin_amdgcn_readfirstlane(tbl[32])) return false;
        int e = 0;
#pragma unroll
        for (int k = 1; k < 32; ++k) e += (tbl[k] <= rb) ? 1 : 0;
        e = __builtin_amdgcn_readfirstlane(e); const int rbl = __builtin_amdgcn_readfirstlane(rb - tbl[e]);
        u.pm = e * (ECAP / BM) + rbl; u.pn = (int)(L % nN); u.pb = e * nN + u.pn; u.kind = 0; u.rb = rb; return true;
    }
    __device__ __forceinline__ void a_ready(const Unit&) const {}
    __device__ __forceinline__ void pre_epi() const {}
    __device__ __forceinline__ void done(const Unit&) const {}
    __device__ __forceinline__ void finish() const {}
};

constexpr unsigned MOE_SPIN_CAP = 1u << 22;
struct MoeMergedOrder {
    const LAS int* tbl; int G, c; gu32* cnt;
    mutable int pend;
    __device__ __forceinline__ void flush() const {
        if (pend >= 0) { asm volatile("s_waitcnt vmcnt(0)" ::: "memory");
            if ((threadIdx.x & 63) == 0) __hip_atomic_fetch_add(cnt + 16 * pend, 1u, __ATOMIC_RELAXED, __HIP_MEMORY_SCOPE_AGENT);
            pend = -1; } }
    __device__ bool next(int i, Unit& u) const {
        const int nb = __builtin_amdgcn_readfirstlane(tbl[32]);
        long L = (long)i * G + c; int nN = 8, kind = 0;
        if (L >= (long)nb * 8) { L -= (long)nb * 8; nN = 4; kind = 1; if (L >= (long)nb * 4) return false; }
        const int rb = (int)(L / nN);
        int e = 0;
#pragma unroll
        for (int k = 1; k < 32; ++k) e += (tbl[k] <= rb) ? 1 : 0;
        e = __builtin_amdgcn_readfirstlane(e); const int rbl = __builtin_amdgcn_readfirstlane(rb - tbl[e]);
        u.pm = e * (ECAP / BM) + rbl; u.pn = (int)(L % nN); u.pb = e * nN + u.pn; u.kind = kind; u.rb = rb; return true;
    }
    __device__ __forceinline__ void a_ready(const Unit& u) const {
        if (u.kind == 1) {
            flush();
            if (threadIdx.x < 64) {
                unsigned sp = 0;
                while ((unsigned)__builtin_amdgcn_readfirstlane(__hip_atomic_load(cnt + 16 * u.rb, __ATOMIC_RELAXED, __HIP_MEMORY_SCOPE_AGENT)) < 64u) { __builtin_amdgcn_s_sleep(2); if (++sp > MOE_SPIN_CAP) break; }
                __builtin_amdgcn_fence(__ATOMIC_ACQUIRE, "agent");
                asm volatile("s_waitcnt vmcnt(0)" ::: "memory");
            }
            __builtin_amdgcn_s_barrier();
        }
    }
    __device__ __forceinline__ void pre_epi() const { flush(); }
    __device__ __forceinline__ void done(const Unit& u) const { if (u.kind == 0) pend = u.rb; }
    __device__ __forceinline__ void finish() const { flush(); }
};
struct EpiMoe {
    static constexpr bool PERM = true;
    EpiSwigluT<true> up; EpiDown down;
    __device__ __forceinline__ void operator()(const f32x4 (&acc)[2][2][4][2], const Unit& u, int wr, int wc, int fr, int fq) const {
        if (u.kind == 0) up(acc, u, wr, wc, fr, fq); else down(acc, u, wr, wc, fr, fq);
    }
};
}

__device__ __forceinline__ void gmlp_unit(Frame& F, const bf16_t* Z, bf16_t* MIX, const float* Ws, const float* bs, const float* gv, int unit) {
    constexpr int VP = 272;
    LAS unsigned char* VT = F.lds + RING_OFF;
    const int h = unit & 3, chunk = unit >> 2;
    int tid_ = threadIdx.x; asm volatile("" : "+v"(tid_));
    const int t0 = chunk * 128, tid = tid_, lane = tid & 63, w = __builtin_amdgcn_readfirstlane(tid >> 6);
    {
        const int s = tid >> 2, dq = (tid & 3) * 32;
        const bf16_t* vp = Z + (size_t)(t0 + s) * EVEN_IN + 512 + h * 128 + dq;
        u32x4 raw[4]; float ss = 0.f;
#pragma unroll
        for (int i = 0; i < 4; ++i) { raw[i] = *(const u32x4*)(vp + 8 * i);
#pragma unroll
            for (int j = 0; j < 4; ++j) { const float a = bflo(raw[i][j]), b = bfhi(raw[i][j]); ss += a * a + b * b; } }
        ss += __shfl_xor(ss, 1); ss += __shfl_xor(ss, 2);
        const float rstd = 1.0f / sqrtf(ss * (1.0f / 128.0f) + EPS);
#pragma unroll
        for (int i = 0; i < 4; ++i)
#pragma unroll
            for (int j = 0; j < 4; ++j) { const int d = dq + 8 * i + 2 * j;
                *(LAS bf16_t*)(VT + (d) * VP + s * 2) = f2bf(bflo(raw[i][j]) * rstd);
                *(LAS bf16_t*)(VT + (d + 1) * VP + s * 2) = f2bf(bfhi(raw[i][j]) * rstd); }
    }
    __syncthreads();
    const int fr = lane & 15, fq = lane >> 4;
    f32x4 acc[8];
#pragma unroll
    for (int nb = 0; nb < 8; ++nb) acc[nb] = (f32x4){0.f, 0.f, 0.f, 0.f};
    const int trow = 16 * w + fr;
    const float* wrow = Ws + ((size_t)h * 128 + trow) * 128;
#pragma unroll
    for (int ks = 0; ks < 4; ++ks) {
        if (32 * ks <= 16 * w + 15) {
            const int s0 = 32 * ks + 8 * fq;
            const f32x4 wa = *(const f32x4*)(wrow + s0), wb = *(const f32x4*)(wrow + s0 + 4);
            float wv[8] = {wa[0], wa[1], wa[2], wa[3], wb[0], wb[1], wb[2], wb[3]};
#pragma unroll
            for (int j = 0; j < 8; ++j) if (s0 + j > trow) wv[j] = 0.f;
            u32x4 aw; aw.x = cvt_pk_bf16(wv[0], wv[1]); aw.y = cvt_pk_bf16(wv[2], wv[3]); aw.z = cvt_pk_bf16(wv[4], wv[5]); aw.w = cvt_pk_bf16(wv[6], wv[7]);
            const bf16x8 af = __builtin_bit_cast(bf16x8, aw);
#pragma unroll
            for (int nb = 0; nb < 8; ++nb) { const bf16x8 bfr = *(const LAS bf16x8*)(VT + (16 * nb + fr) * VP + s0 * 2);
                acc[nb] = __builtin_amdgcn_mfma_f32_16x16x32_bf16(af, bfr, acc[nb], 0, 0, 0); }
        }
    }
#pragma unroll
    for (int i = 0; i < 4; ++i) { const int tl = 16 * w + 4 * fq + i; const float bt = bs[h * 128 + tl];
        const bf16_t* up = Z + (size_t)(t0 + tl) * EVEN_IN + h * 128 + fr; bf16_t* op = MIX + (size_t)(t0 + tl) * DM + h * 128 + fr;
#pragma unroll
        for (int nb = 0; nb < 8; ++nb) { const float uu = bf2f(up[16 * nb]); op[16 * nb] = f2bf(uu * (gv[h * 128 + 16 * nb + fr] * acc[nb][i] + bt)); } }
    __syncthreads();
}

__device__ __forceinline__ void router_phase(Frame& F, const float* x, const float* gain, const float* Wr, const float* br, gu32* cnt  ,
                                             unsigned* tok_er, float* tok_g, unsigned char* XG) {
    LAS float* WrT = (LAS float*)(F.lds + RING_OFF);
    LAS float* lg = (LAS float*)(F.lds + SCR_OFF);
    LAS unsigned* hist = (LAS unsigned*)(F.lds + SCR_OFF + 64 * 33 * 4);
    LAS unsigned* base = hist + 32;
    LAS unsigned* ers = base + 32;
    int tid_ = threadIdx.x; asm volatile("" : "+v"(tid_));
    const int tid = tid_, lane = tid & 63, w = __builtin_amdgcn_readfirstlane(tid >> 6);
#ifndef RTR_REP_A
#define RTR_REP_A 1
#define RTR_REP_B 1
#define RTR_REP_C 1
#endif
    for (int ra_ = 0; ra_ < RTR_REP_A; ++ra_)
    for (int idx = tid; idx < 8192; idx += 512) { const int e4 = idx >> 10, k = idx & 1023; const f32x4 v = *(const f32x4*)(Wr + (size_t)k * 32 + 4 * e4);
        WrT[(4 * e4 + 0) * 1024 + k] = v[0]; WrT[(4 * e4 + 1) * 1024 + k] = v[1]; WrT[(4 * e4 + 2) * 1024 + k] = v[2]; WrT[(4 * e4 + 3) * 1024 + k] = v[3]; }
    __syncthreads();
    f32x4 gg[4];
#pragma unroll
    for (int j = 0; j < 4; ++j) gg[j] = ((const f32x4*)gain + lane)[64 * j];
    const float brl = br[lane & 31];
    {   const int tg = F.vcu;
    const int tokb = tg * 64;
    if (tid < 32) hist[tid] = 0u;
    for (int rb_ = 0; rb_ < RTR_REP_B; ++rb_)
#pragma unroll 1
    for (int tp = 0; tp < 4; ++tp) {
        f32x4 ha[4], hb[4];
        {   const float* r0 = x + (size_t)(tokb + w * 8 + 2 * tp) * DM;
#pragma unroll
            for (int j = 0; j < 4; ++j) { ha[j] = ((const f32x4*)r0 + lane)[64 * j]; hb[j] = ((const f32x4*)(r0 + DM) + lane)[64 * j]; } }
        float sa = 0.f, sb = 0.f;
#pragma unroll
        for (int j = 0; j < 4; ++j) { sa += (ha[j].x * ha[j].x + ha[j].y * ha[j].y) + (ha[j].z * ha[j].z + ha[j].w * ha[j].w); sb += (hb[j].x * hb[j].x + hb[j].y * hb[j].y) + (hb[j].z * hb[j].z + hb[j].w * hb[j].w); }
        const float ra = 1.0f / sqrtf(wave_sum(sa) * (1.f / DM) + EPS), rb = 1.0f / sqrtf(wave_sum(sb) * (1.f / DM) + EPS);
#pragma unroll
        for (int j = 0; j < 4; ++j) { ha[j] = ha[j] * ra * gg[j]; hb[j] = hb[j] * rb * gg[j]; }
        float a[32], b[32];
#pragma unroll
        for (int e = 0; e < 32; ++e) { f32x2 ta = {0.f, 0.f}, tb = {0.f, 0.f};
#pragma unroll
            for (int j = 0; j < 4; ++j) { const f32x4 wv = *(const LAS f32x4*)(WrT + e * 1024 + 256 * j + 4 * lane);
                const f32x2 w01 = {wv.x, wv.y}, w23 = {wv.z, wv.w};
                ta = (f32x2){ha[j].x, ha[j].y} * w01 + ta; ta = (f32x2){ha[j].z, ha[j].w} * w23 + ta;
                tb = (f32x2){hb[j].x, hb[j].y} * w01 + tb; tb = (f32x2){hb[j].z, hb[j].w} * w23 + tb; }
            a[e] = ta.x + ta.y; b[e] = tb.x + tb.y; if ((e & 3) == 3) __builtin_amdgcn_sched_barrier(0); }
#define RSTEP(N, BIT) _Pragma("unroll") for (int i = 0; i < N; ++i) { const bool up = (lane & BIT) != 0; \
            { const float keep = up ? a[2 * i + 1] : a[2 * i], send = up ? a[2 * i] : a[2 * i + 1]; a[i] = keep + __shfl_xor(send, BIT); } \
            { const float keep = up ? b[2 * i + 1] : b[2 * i], send = up ? b[2 * i] : b[2 * i + 1]; b[i] = keep + __shfl_xor(send, BIT); } }
        RSTEP(16, 1) RSTEP(8, 2) RSTEP(4, 4) RSTEP(2, 8) RSTEP(1, 16)
#undef RSTEP
        const float la = a[0] + __shfl_xor(a[0], 32) + brl, lb = b[0] + __shfl_xor(b[0], 32) + brl;
        if (lane < 32) { lg[(w * 8 + 2 * tp) * 33 + lane] = la; lg[(w * 8 + 2 * tp + 1) * 33 + lane] = lb; }
        asm volatile("" ::: "memory"); __builtin_amdgcn_sched_barrier(0);
    }
    __syncthreads();
    unsigned my_e[4] = {0, 0, 0, 0}, my_lr[4] = {0, 0, 0, 0}; float my_g[4] = {0, 0, 0, 0};
    if (tid < 64) {
        float v[32];
#pragma unroll
        for (int e = 0; e < 32; ++e) v[e] = lg[tid * 33 + e];
        int c0 = -1, c1 = -1, c2 = -1; float tv[4];
#pragma unroll
        for (int r = 0; r < 4; ++r) { float best = -__builtin_inff(); int bi = 0;
#pragma unroll
            for (int e = 0; e < 32; ++e) { const bool ok = (e != c0) && (e != c1) && (e != c2); if (ok && v[e] > best) { best = v[e]; bi = e; } }
            tv[r] = best; my_e[r] = (unsigned)bi; if (r == 0) c0 = bi; else if (r == 1) c1 = bi; else if (r == 2) c2 = bi; }
        const float p1 = __expf(tv[1] - tv[0]), p2 = __expf(tv[2] - tv[0]), p3 = __expf(tv[3] - tv[0]); const float inv = 1.0f / (1.0f + p1 + p2 + p3);
        my_g[0] = inv; my_g[1] = p1 * inv; my_g[2] = p2 * inv; my_g[3] = p3 * inv;
#pragma unroll
        for (int r = 0; r < 4; ++r) my_lr[r] = __hip_atomic_fetch_add(hist + my_e[r], 1u, __ATOMIC_RELAXED, __HIP_MEMORY_SCOPE_WORKGROUP);
    }
    __syncthreads();
    if (tid < 32) { const unsigned hc = hist[tid]; base[tid] = hc ? __hip_atomic_fetch_add(cnt + 64 * tid, hc, RLX_AGENT) : 0u; }
    __syncthreads();
    if (tid < 64) {
        u32x4 er; f32x4 gt;
#pragma unroll
        for (int r = 0; r < 4; ++r) { const unsigned rank = base[my_e[r]] + my_lr[r]; er[r] = (my_e[r] << 16) | rank; gt[r] = my_g[r]; ers[tid * 4 + r] = er[r]; }
        *(u32x4*)(tok_er + (size_t)(tokb + tid) * 4) = er; *(f32x4*)(tok_g + (size_t)(tokb + tid) * 4) = gt;
    }
    __syncthreads();
    for (int rc_ = 0; rc_ < RTR_REP_C; ++rc_)
#pragma unroll 2
    for (int tt = 0; tt < 8; ++tt) {
        const int tl = w * 8 + tt; const float* xrow = x + (size_t)(tokb + tl) * DM;
        f32x4 hv[4]; float s = 0.f;
#pragma unroll
        for (int j = 0; j < 4; ++j) { hv[j] = ((const f32x4*)xrow + lane)[64 * j]; s += (hv[j].x * hv[j].x + hv[j].y * hv[j].y) + (hv[j].z * hv[j].z + hv[j].w * hv[j].w); }
        const float rstd = 1.0f / sqrtf(wave_sum(s) * (1.f / DM) + EPS);
        unsigned wv[4];
#pragma unroll
        for (int j = 0; j < 4; ++j) { const f32x4 t = hv[j] * rstd * gg[j]; wv[j] = pk4_fp8(t.x, t.y, t.z, t.w); }
#pragma unroll
        for (int r = 0; r < 4; ++r) { const unsigned er = ers[tl * 4 + r]; const size_t slot = (size_t)(er >> 16) * ECAP + (er & 0xffffu);
            unsigned* o4 = (unsigned*)(XG + slot * DM) + lane;
#pragma unroll
            for (int j = 0; j < 4; ++j) o4[64 * j] = wv[j]; }
    }
    __syncthreads();
    }
}

__device__ __forceinline__ void combine_phase(Frame& F, const float* x, float* xout, const unsigned* tok_er, const float* tok_g, const bf16_t* Y, const float* g_next, unsigned char* XN, bool xn_fp8) {
    int tid_ = threadIdx.x; asm volatile("" : "+v"(tid_));
    const int gw = F.vcu * NWAVES + __builtin_amdgcn_readfirstlane(tid_ >> 6), NGW = F.G * NWAVES, lane = tid_ & 63;
    for (int m = gw; m < M; m += NGW) {
        const u32x4 er = *(const u32x4*)(tok_er + (size_t)m * 4); const f32x4 gt = *(const f32x4*)(tok_g + (size_t)m * 4);
        f32x4 v[4]; const float* xrow = x + (size_t)m * DM; float* xorow = xout + (size_t)m * DM;
#pragma unroll
        for (int j = 0; j < 4; ++j) v[j] = ((const f32x4*)xrow + lane)[64 * j];
#pragma unroll
        for (int r = 0; r < 4; ++r) { const size_t slot = (size_t)(er[r] >> 16) * ECAP + (er[r] & 0xffffu); const u32x2* yp = (const u32x2*)(Y + slot * DM) + lane; const float g = gt[r];
#pragma unroll
            for (int j = 0; j < 4; ++j) { const u32x2 yv = yp[64 * j]; v[j].x += g * bflo(yv.x); v[j].y += g * bfhi(yv.x); v[j].z += g * bflo(yv.y); v[j].w += g * bfhi(yv.y); } }
#pragma unroll
        for (int j = 0; j < 4; ++j) ((f32x4*)xorow + lane)[64 * j] = v[j];
        if (g_next) {
            float s = 0.f;
#pragma unroll
            for (int j = 0; j < 4; ++j) s += (v[j].x * v[j].x + v[j].y * v[j].y) + (v[j].z * v[j].z + v[j].w * v[j].w);
            const float rstd = 1.0f / sqrtf(wave_sum(s) * (1.f / DM) + EPS);
            unsigned* o4 = (unsigned*)(XN + (size_t)m * DM) + lane; u32x2* o8 = (u32x2*)(XN + (size_t)m * DM * 2) + lane;
#pragma unroll
            for (int j = 0; j < 4; ++j) { const f32x4 gg = ((const f32x4*)g_next + lane)[64 * j];
                if (xn_fp8) o4[64 * j] = pk4_fp8(v[j].x * rstd * gg.x, v[j].y * rstd * gg.y, v[j].z * rstd * gg.z, v[j].w * rstd * gg.w);
                else { u32x2 w; w.x = cvt_pk_bf16(v[j].x * rstd * gg.x, v[j].y * rstd * gg.y); w.y = cvt_pk_bf16(v[j].z * rstd * gg.z, v[j].w * rstd * gg.w); o8[64 * j] = w; } }
        }
    }
}

__device__ __forceinline__ void unpack8(const u32x4 w, float (&f)[8]) { f[0] = bflo(w.x); f[1] = bfhi(w.x); f[2] = bflo(w.y); f[3] = bfhi(w.y); f[4] = bflo(w.z); f[5] = bfhi(w.z); f[6] = bflo(w.w); f[7] = bfhi(w.w); }
__device__ __forceinline__ void unpack4(const u32x2 w, float (&f)[4]) { f[0] = bflo(w.x); f[1] = bfhi(w.x); f[2] = bflo(w.y); f[3] = bfhi(w.y); }
__device__ __forceinline__ void fin_head(const u32x4 n0, const u32x4 n1, const u32x2 r1, const u32x2 r2, const float (&g)[24], const float (&cs)[4], const float (&sn)[4], unsigned char* op, int j) {
    float a[8], b[8], x1[4], x2[4];
    unpack8(n0, a); unpack8(n1, b); unpack4(r1, x1); unpack4(r2, x2);
    float ss = 0.f;
#pragma unroll
    for (int i = 0; i < 8; ++i) ss += a[i] * a[i] + b[i] * b[i];
#pragma unroll
    for (int i = 0; i < 4; ++i) ss += x1[i] * x1[i] + x2[i] * x2[i];
    ss += __shfl_xor(ss, 1); ss += __shfl_xor(ss, 2); ss += __shfl_xor(ss, 4);
    const float rstd = 1.0f / sqrtf(ss * (1.0f / 192.0f) + EPS);
    u32x4 o0;
    o0.x = pk4_fp8(a[0] * rstd * g[0], a[1] * rstd * g[1], a[2] * rstd * g[2], a[3] * rstd * g[3]); o0.y = pk4_fp8(a[4] * rstd * g[4], a[5] * rstd * g[5], a[6] * rstd * g[6], a[7] * rstd * g[7]);
    o0.z = pk4_fp8(b[0] * rstd * g[8], b[1] * rstd * g[9], b[2] * rstd * g[10], b[3] * rstd * g[11]); o0.w = pk4_fp8(b[4] * rstd * g[12], b[5] * rstd * g[13], b[6] * rstd * g[14], b[7] * rstd * g[15]);
    float y1[4], y2[4];
#pragma unroll
    for (int i = 0; i < 4; ++i) { const float u = x1[i] * rstd * g[16 + i], v = x2[i] * rstd * g[20 + i]; y1[i] = u * cs[i] - v * sn[i]; y2[i] = u * sn[i] + v * cs[i]; }
    *(u32x4*)(op + 16 * j) = o0; *(unsigned*)(op + 128 + 4 * j) = pk4_fp8(y1[0], y1[1], y1[2], y1[3]); *(unsigned*)(op + 160 + 4 * j) = pk4_fp8(y2[0], y2[1], y2[2], y2[3]);
}
__device__ __forceinline__ void mla_finalize_phase(Frame& F, const bf16_t* QR, const bf16_t* KVR, const bf16_t* Z, const float* gq, const float* gk, unsigned char* QF, unsigned char* KF) {
    int tid_ = threadIdx.x; asm volatile("" : "+v"(tid_));
    const int gw = F.vcu * NWAVES + __builtin_amdgcn_readfirstlane(tid_ >> 6), NGW = F.G * NWAVES, lane = tid_ & 63;
    const int h = lane >> 3, j = lane & 7;
    float gqv[24], gkv[24], invf[4];
#pragma unroll
    for (int i = 0; i < 16; ++i) { gqv[i] = gq[16 * j + i]; gkv[i] = gk[16 * j + i]; }
#pragma unroll
    for (int i = 0; i < 4; ++i) { gqv[16 + i] = gq[128 + 4 * j + i]; gqv[20 + i] = gq[160 + 4 * j + i]; gkv[16 + i] = gk[128 + 4 * j + i]; gkv[20 + i] = gk[160 + 4 * j + i];
        invf[i] = __builtin_amdgcn_exp2f(-(float)(4 * j + i) * (13.287712379549449f / 32.0f)); }
#pragma unroll 2
    for (int m = gw; m < M; m += NGW) {
        const int pos = m & (SEQ - 1);
        float cs[4], sn[4];
#pragma unroll
        for (int i = 0; i < 4; ++i) { const double rev = (double)pos * (double)invf[i] * 0.15915494309189535; const float fr = (float)(rev - __builtin_rint(rev));
            sn[i] = __builtin_amdgcn_sinf(fr); cs[i] = __builtin_amdgcn_cosf(fr); }
        const bf16_t* qp = QR + (size_t)m * 1536 + h * 192; const bf16_t* kp = KVR + (size_t)m * 2048 + h * 256; const bf16_t* zp = Z + (size_t)m * ODD_INP + 768;
        const u32x4 qn0 = *(const u32x4*)(qp + 16 * j), qn1 = *(const u32x4*)(qp + 16 * j + 8); const u32x2 qr1 = *(const u32x2*)(qp + 128 + 4 * j), qr2 = *(const u32x2*)(qp + 160 + 4 * j);
        const u32x4 kn0 = *(const u32x4*)(kp + 16 * j), kn1 = *(const u32x4*)(kp + 16 * j + 8); const u32x2 kr1 = *(const u32x2*)(zp + 4 * j), kr2 = *(const u32x2*)(zp + 32 + 4 * j);
        fin_head(qn0, qn1, qr1, qr2, gqv, cs, sn, QF + (size_t)m * 1536 + h * 192, j);
        fin_head(kn0, kn1, kr1, kr2, gkv, cs, sn, KF + (size_t)m * 1536 + h * 192, j);
    }
}

__device__ __forceinline__ void vt_phase(Frame& F, const bf16_t* KVR, unsigned char* VT8) {
    int tid_ = threadIdx.x; asm volatile("" : "+v"(tid_));
    const int tid = tid_;
    LAS unsigned char* T = F.lds + RING_OFF;
    for (int it = F.vcu; it < M / 64; it += F.G) {
        const int m0 = it * 64, b = m0 / SEQ, tok0 = m0 % SEQ;
#pragma unroll 4
        for (int k = 0; k < 16; ++k) { const int idx = tid + 512 * k, tok = idx >> 7, grp = idx & 127, h = grp >> 4, d8 = (grp & 15) * 8;
            const u32x4 w = *(const u32x4*)(KVR + (size_t)(m0 + tok) * 2048 + h * 256 + 128 + d8);
            const unsigned lo = pk4_fp8(bflo(w.x), bfhi(w.x), bflo(w.y), bfhi(w.y)), hi = pk4_fp8(bflo(w.z), bfhi(w.z), bflo(w.w), bfhi(w.w));
            LAS unsigned char* tp = T + (h * 128 + d8) * 80 + tok;
            tp[0] = (unsigned char)lo; tp[80] = (unsigned char)(lo >> 8); tp[160] = (unsigned char)(lo >> 16); tp[240] = (unsigned char)(lo >> 24);
            tp[320] = (unsigned char)hi; tp[400] = (unsigned char)(hi >> 8); tp[480] = (unsigned char)(hi >> 16); tp[560] = (unsigned char)(hi >> 24); }
        __syncthreads();
#pragma unroll 4
        for (int k = 0; k < 8; ++k) { const int idx = tid + 512 * k, row = idx >> 2, q = idx & 3;
            const u32x4 v = *(const LAS u32x4*)(T + row * 80 + 16 * q);
            *(u32x4*)(VT8 + ((size_t)b * 1024 + row) * SEQ + tok0 + 16 * q) = v; }
        __syncthreads();
    }
}

#ifndef PHMASK
#define PHMASK 0xFFFF
#endif
#ifndef REPMASK
#define REPMASK 0
#endif
#ifndef REPCNT
#define REPCNT 3
#endif
#define NREP(k) ((((REPMASK) >> (k)) & 1) ? (REPCNT) : 1)

#define LAUNDER_S(x) asm volatile("" : "+s"(x))
__device__ __forceinline__ const float* in_ptr(const Args& a, int i) { LAUNDER_S(i); return a.in[i]; }
#define PHASE_BEGIN() unsigned wso_ = 0u; LAUNDER_S(wso_); unsigned char* ws = args.ws + wso_; Frame Fp = F; Fp.vcu = __builtin_amdgcn_readfirstlane(Fp.vcu); Fp.G = __builtin_amdgcn_readfirstlane(Fp.G); LAUNDER_S(Fp.vcu); LAUNDER_S(Fp.G); \
    int bx_ = __builtin_amdgcn_readfirstlane((int)blockIdx.x); LAUNDER_S(bx_); (void)bx_; (void)ws
#define XN  ((unsigned char*)(ws + WS_XN))
#define Z   ((bf16_t*)(ws + WS_Z))
#define MIX ((bf16_t*)(ws + WS_MIX))
#define QR  ((bf16_t*)(ws + WS_QR))
#define KVR ((bf16_t*)(ws + WS_KVR))
#define QF  ((unsigned char*)(ws + WS_QF))
#define KF  ((unsigned char*)(ws + WS_KF))
#define XG  ((unsigned char*)(ws + WS_XG))
#define ACT ((unsigned char*)(ws + WS_ACT))
#define YB  ((bf16_t*)(ws + WS_Y))
#define SSQ ((float*)(ws + WS_SSQ))
#define TOKER ((unsigned*)(ws + WS_TOKER))
#define TOKG ((float*)(ws + WS_TOKG))
#define B1P ((float*)(ws + WS_B1P))
#define IN(i) in_ptr(args, (i))
__global__ void __launch_bounds__(NWAVES * 64, 2) trunk_fwd(Args args) {
    extern __shared__ __attribute__((aligned(16))) unsigned char lds_raw[];
    Frame F;
    F.lds = (LAS unsigned char*)lds_raw;
    F.G = gridDim.x; { const int bx = blockIdx.x; F.vcu = (F.G % 8 == 0) ? (bx % 8) * (F.G / 8) + bx / 8 : bx; }
    for (int u = threadIdx.x; u < (SCR_OFF - LDSCTL_OFF) / 4; u += NWAVES * 64) ((LAS unsigned*)(F.lds + LDSCTL_OFF))[u] = 0u;
    __syncthreads();
    (void)xcd_barrier_post((unsigned*)((gu32*)(args.ws + WS_CTL) + CW_BAR), (volatile LAS unsigned*)(F.lds + MISC_OFF) + 8);
#define GRID_BAR() do { unsigned wsb_ = 0u; LAUNDER_S(wsb_); XcdBarrier bar_; bar_.bar = (unsigned*)((gu32*)(args.ws + wsb_ + WS_CTL) + CW_BAR); bar_.x = xb_xcc_id(); \
        bar_.st = (volatile LAS unsigned*)(F.lds + MISC_OFF) + 8; xcd_barrier(bar_); } while (0)
    float* const X = args.out;
    const int stage_limit = args.stage_limit;

#if (PHMASK >> 0) & 1
            _Pragma("unroll") for (int rep_ = 0; rep_ < NREP(0); ++rep_) { if (rep_) GRID_BAR();
    {   PHASE_BEGIN(); const int ptid = threadIdx.x, gw = Fp.vcu * NWAVES + __builtin_amdgcn_readfirstlane(ptid >> 6), NGW = Fp.G * NWAVES;
        transpose_job<1>(Fp, IN(I_EWIN), DM, EVEN_IN, 2, (size_t)DM * EVEN_IN, (bf16_t*)(ws + WS_WEIN), (size_t)EVEN_IN * DM, nullptr, 0);
        transpose_job<0>(Fp, IN(I_EWOUT), DM, DM, 2, (size_t)DM * DM, (bf16_t*)(ws + WS_WEOUT), (size_t)DM * DM, nullptr, 0);
        transpose_job_fp8<0>(Fp, IN(I_OWIN), DM, ODD_IN, 2, (size_t)DM * ODD_IN, ws + WS_WOIN, (size_t)ODD_INP * DM);
        transpose_job_fp8<0>(Fp, IN(I_OWUQ), 512, 1536, 2, (size_t)512 * 1536, ws + WS_WUQ, (size_t)1536 * 512, IN(I_OGCQ), 512);
        transpose_job_fp8<0>(Fp, IN(I_OWUKV), 256, 2048, 2, (size_t)256 * 2048, ws + WS_WUKV, (size_t)2048 * 256, IN(I_OGCKV), 256);
        transpose_job_fp8<0>(Fp, IN(I_OWOUT), DM, DM, 2, (size_t)DM * DM, ws + WS_WOOUT, (size_t)DM * DM);
        transpose_job_fp8<2>(Fp, IN(I_W1), DM, 2 * DE, DEPTH * NE, (size_t)DM * 2 * DE, ws + WS_W1, (size_t)2 * DE * DM);
        transpose_job_fp8<0>(Fp, IN(I_W2), DE, DM, DEPTH * NE, (size_t)DE * DM, ws + WS_W2, (size_t)DM * DE);
        for (int i = bx_ * 512 + ptid; i < 2 * 12288; i += Fp.G * 512) { const int mi = i / 12288, r = i % 12288;
            *(u32x4*)(ws + WS_WOIN + (size_t)mi * ODD_INP * DM + (size_t)ODD_IN * DM + (size_t)r * 16) = (u32x4){0u, 0u, 0u, 0u}; }
        for (int i = bx_ * 512 + ptid; i < DEPTH * NE * 2048; i += Fp.G * 512) { const int c = i & 2047, o = 2 * (128 * (c >> 8) + (c & 127)) + ((c >> 7) & 1);
            B1P[i] = IN(I_B1)[(size_t)(i & ~2047) + o]; }
        for (int m = gw; m < M; m += NGW) rms_row_to_bf16(ptid & 63, IN(I_X) + (size_t)m * DM, IN(I_MIXN), (bf16_t*)XN + (size_t)m * DM, X + (size_t)m * DM);
    }
            }
#endif
    GRID_BAR();

#ifdef EXTRA_BARS
    for (int xb_ = 0; xb_ < EXTRA_BARS; ++xb_) GRID_BAR();
#endif
    for (int l = 0; l < DEPTH; ++l) {
        const int li = l >> 1;
        if (2 * l + 1 > stage_limit) break;
        if ((l & 1) == 0) {
#if (PHMASK >> 1) & 1
            _Pragma("unroll") for (int rep_ = 0; rep_ < NREP(1); ++rep_) { if (rep_) GRID_BAR();
            {   PHASE_BEGIN(); pg8::Gemm g{(const bf16_t*)XN, (const bf16_t*)(ws + WS_WEIN) + (size_t)li * EVEN_IN * DM, DM, DM, nullptr, nullptr}; pg8::StaticOrder S; S.init(M, EVEN_IN, Fp.G, bx_);
                pg8::EpiEvenIn E{Z, IN(I_EGQ) + li * 64, IN(I_EGK) + li * 64};
                pg8::gemm_phase<pg8::EpiEvenIn, pg8::StaticOrder>(Fp.lds + RING_OFF, g, S, E); }
            }
#endif
            GRID_BAR();
            {   PHASE_BEGIN();
#if (PHMASK >> 2) & 1
            _Pragma("unroll") for (int rep_ = 0; rep_ < NREP(2); ++rep_) { if (rep_) GRID_BAR();
                for (int u = Fp.vcu; u < 512; u += Fp.G)
                    gmlp_unit(Fp, Z, MIX, IN(I_EWS) + (size_t)li * 4 * 128 * 128, IN(I_EBS) + li * 512, IN(I_EGV) + li * 512, u);
            }
#endif
#if (PHMASK >> 3) & 1
            _Pragma("unroll") for (int rep_ = 0; rep_ < NREP(3); ++rep_) { if (rep_) GRID_BAR();
                for (int u = Fp.vcu; u < 256; u += Fp.G) { const int bh = u >> 4, s = u & 15, b = bh >> 3, h = bh & 7;
                    for (int pass = 0; pass < 2; ++pass) { const int qb = pass ? 31 - s : s;
                        const bf16_t* zb = Z + (size_t)b * SEQ * EVEN_IN;
                        dil::unit(zb + 1024 + 64 * h, zb + 1536 + 64 * h, zb + 2048 + 64 * h, EVEN_IN, MIX + (size_t)b * SEQ * DM + 512 + 64 * h, DM, qb * 256, Fp.lds + RING_OFF, (LAS float*)(Fp.lds + SCR_OFF)); } }
            }
#endif
            }
            GRID_BAR();
#if (PHMASK >> 4) & 1
            _Pragma("unroll") for (int rep_ = 0; rep_ < NREP(4); ++rep_) { if (rep_) GRID_BAR();
            {   PHASE_BEGIN(); pg8::Gemm g{MIX, (const bf16_t*)(ws + WS_WEOUT) + (size_t)li * DM * DM, DM, DM, nullptr, nullptr}; pg8::StaticOrder S; S.init(M, DM, Fp.G, bx_);
                pg8::EpiResid E{X};
                pg8::gemm_phase<pg8::EpiResid, pg8::StaticOrder>(Fp.lds + RING_OFF, g, S, E); }
            }
#endif
            GRID_BAR();
        } else {
#if (PHMASK >> 5) & 1
            _Pragma("unroll") for (int rep_ = 0; rep_ < NREP(5); ++rep_) { if (rep_) GRID_BAR();
            {   PHASE_BEGIN(); pg8::Gemm g{(const bf16_t*)XN, (const bf16_t*)(ws + WS_WOIN + (size_t)li * ODD_INP * DM), DM / 2, DM / 2, nullptr, nullptr}; pg8::StaticOrder S; S.init(M, ODD_INP, Fp.G, bx_);
                pg8::EpiOddIn E{Z, ws + WS_Z8, SSQ};
                pg8::gemm_phase<pg8::EpiOddIn, pg8::StaticOrder, true>(Fp.lds + RING_OFF, g, S, E); }
            }
#endif
            GRID_BAR();
#if (PHMASK >> 6) & 1
            _Pragma("unroll") for (int rep_ = 0; rep_ < NREP(6); ++rep_) { if (rep_) GRID_BAR();
            {   PHASE_BEGIN(); pg8::Gemm g{(const bf16_t*)(ws + WS_Z8 + 512), (const bf16_t*)(ws + WS_WUKV + (size_t)li * 2048 * 256), ODD_INP / 2, 128, nullptr, nullptr}; pg8::StaticOrder S; S.init(M, 2048, Fp.G, bx_);
                pg8::EpiRowScale<1> E{KVR, 2048, SSQ, 8, 1.0f / 256.0f};
                pg8::gemm_phase<pg8::EpiRowScale<1>, pg8::StaticOrder, true>(Fp.lds + RING_OFF, g, S, E); }
            {   PHASE_BEGIN(); pg8::Gemm g{(const bf16_t*)(ws + WS_Z8), (const bf16_t*)(ws + WS_WUQ + (size_t)li * 1536 * 512), ODD_INP / 2, 256, nullptr, nullptr}; pg8::StaticOrder S; S.init(M, 1536, Fp.G, bx_);
                pg8::EpiRowScale<2> E{QR, 1536, SSQ, 0, 1.0f / 512.0f};
                pg8::gemm_phase<pg8::EpiRowScale<2>, pg8::StaticOrder, true>(Fp.lds + RING_OFF, g, S, E); }
            }
#endif
            GRID_BAR();
#if (PHMASK >> 7) & 1
            _Pragma("unroll") for (int rep_ = 0; rep_ < NREP(7); ++rep_) { if (rep_) GRID_BAR();
            {   PHASE_BEGIN(); mla_finalize_phase(Fp, QR, KVR, Z, IN(I_OGQ) + li * 192, IN(I_OGK) + li * 192, QF, KF); vt_phase(Fp, KVR, ws + WS_VT); }
            }
#endif
            GRID_BAR();
#if (PHMASK >> 8) & 1
            _Pragma("unroll") for (int rep_ = 0; rep_ < NREP(8); ++rep_) { if (rep_) GRID_BAR();
            {   PHASE_BEGIN();
                for (int u = Fp.vcu; u < 256; u += Fp.G) { const int bh = u >> 4, s = u & 15, b = bh >> 3, h = bh & 7;
                    for (int pass = 0; pass < 2; ++pass) { const int qb = pass ? 31 - s : s;
                        mla::unit(QF + (size_t)b * SEQ * 1536 + 192 * h, KF + (size_t)b * SEQ * 1536 + 192 * h, 1536, ws + WS_VT + ((size_t)(b * 8 + h) * 128) * SEQ,
                                  ws + WS_MIX8 + (size_t)b * SEQ * DM + 128 * h, DM, qb * 256, Fp.lds + RING_OFF); } }
            }
            }
#endif
            GRID_BAR();
#if (PHMASK >> 9) & 1
            _Pragma("unroll") for (int rep_ = 0; rep_ < NREP(9); ++rep_) { if (rep_) GRID_BAR();
            {   PHASE_BEGIN(); pg8::Gemm g{(const bf16_t*)(ws + WS_MIX8), (const bf16_t*)(ws + WS_WOOUT + (size_t)li * DM * DM), DM / 2, DM / 2, nullptr, nullptr}; pg8::StaticOrder S; S.init(M, DM, Fp.G, bx_);
                pg8::EpiResidT<true> E{X};
                pg8::gemm_phase<pg8::EpiResidT<true>, pg8::StaticOrder, true>(Fp.lds + RING_OFF, g, S, E); }
            }
#endif
            GRID_BAR();
        }
        if (2 * l + 2 > stage_limit) break;
#if (PHMASK >> 10) & 1
            _Pragma("unroll") for (int rep_ = 0; rep_ < NREP(10); ++rep_) {
        {   PHASE_BEGIN(); const bool dry = rep_ + 1 < NREP(10);
            gu32* cnt = (gu32*)(ws + WS_CTL) + CW_CNT + (size_t)(dry ? 8 + 4 * rep_ + l : l) * 32 * 64;
        router_phase(Fp, X, IN(I_FFNN) + l * DM, IN(I_RW) + (size_t)l * DM * NE, IN(I_RB) + l * NE, cnt, dry ? (unsigned*)(ws + WS_QR) : TOKER, dry ? (float*)(ws + WS_QR + MiB) : TOKG, dry ? ACT : XG); }
        GRID_BAR();
            }
#endif
        LAS int* tbl = (LAS int*)(F.lds + SCR_OFF + 12288);
        {   PHASE_BEGIN(); gu32* cnt = (gu32*)(ws + WS_CTL) + CW_CNT + (size_t)l * 32 * 64;
        if (threadIdx.x == 0) { int acc = 0; for (int e = 0; e < NE; ++e) { tbl[e] = acc; const unsigned c = __hip_atomic_load(cnt + 64 * e, RLX_AGENT); acc += (int)((c + 255u) >> 8); } tbl[NE] = acc; }
        __syncthreads(); }
#if (PHMASK >> 11) & 1
            _Pragma("unroll") for (int rep_ = 0; rep_ < NREP(11); ++rep_) { if (rep_) GRID_BAR();
        {   PHASE_BEGIN();
            pg8::Gemm g{(const bf16_t*)XG, (const bf16_t*)(ws + WS_W1 + (size_t)l * NE * 2 * DE * DM), DM / 2, DM / 2, (const bf16_t*)ACT, (const bf16_t*)(ws + WS_W2 + (size_t)l * NE * DM * DE)};
            pg8::MoeMergedOrder S{tbl, Fp.G, Fp.vcu, (gu32*)(ws + WS_CTL) + CW_MOE + (size_t)(l * 320 + 1280 * rep_) * 16, -1};
            pg8::EpiMoe E{{ACT, B1P + (size_t)l * NE * 2048}, {YB, IN(I_B2) + (size_t)l * NE * DM}};
            pg8::gemm_phase<pg8::EpiMoe, pg8::MoeMergedOrder, true>(Fp.lds + RING_OFF, g, S, E); }
            }
#endif
        GRID_BAR();
#if (PHMASK >> 13) & 1
            _Pragma("unroll") for (int rep_ = 0; rep_ < NREP(13); ++rep_) {
        {   PHASE_BEGIN(); const bool dry = rep_ + 1 < NREP(13);
            combine_phase(Fp, X, dry ? (float*)ACT : X, TOKER, TOKG, YB, (l + 1 < DEPTH) ? IN(I_MIXN) + (l + 1) * DM : nullptr, dry ? (ACT + (size_t)64 * MiB) : XN, (l & 1) == 0); }
        GRID_BAR();
            }
#endif
    }
#undef GRID_BAR
}

extern "C" void kernel_launch(void* const* d_in, const int* in_sizes, int n_in, void* d_out, int out_size, void* d_ws, size_t ws_size, hipStream_t stream) {
    static int grid = 0;
    if (grid == 0) {
        if (n_in != 24 || in_sizes[0] != M * DM || out_size != M * DM || ws_size < WS_END) {
            fprintf(stderr, "kernel_launch: unexpected shapes (n_in %d, in0 %d, out %d, ws %zu, need %zu)\n", n_in, n_in > 0 ? in_sizes[0] : -1, out_size, ws_size, (size_t)WS_END); grid = -1; return; }
        int dev = 0, cus = 0, per_cu = 0;
        if (hipGetDevice(&dev) != hipSuccess || hipDeviceGetAttribute(&cus, hipDeviceAttributeMultiprocessorCount, dev) != hipSuccess) { grid = -1; return; }
        if (hipFuncSetAttribute((const void*)trunk_fwd, hipFuncAttributeMaxDynamicSharedMemorySize, LDS_BYTES) != hipSuccess) { fprintf(stderr, "kernel_launch: hipFuncSetAttribute failed\n"); grid = -1; return; }
        if (hipOccupancyMaxActiveBlocksPerMultiprocessor(&per_cu, (const void*)trunk_fwd, NWAVES * 64, LDS_BYTES) != hipSuccess || per_cu < 1)
            fprintf(stderr, "kernel_launch: occupancy query reports %d workgroups per CU\n", per_cu);
        (void)hipGetLastError();
        if (cus < 256) { fprintf(stderr, "kernel_launch: needs 256 CUs, device has %d\n", cus); grid = -1; return; }
        grid = 256;
    }
    if (grid < 0) return;
    if (hipMemsetAsync((char*)d_ws + WS_CTL, 0, CTL_ZERO_BYTES, stream) != hipSuccess) return;
    Args a{};
    for (int i = 0; i < 24; ++i) a.in[i] = (const float*)d_in[i];
    a.out = (float*)d_out; a.ws = (unsigned char*)d_ws; a.stage_limit = STAGE_LIMIT; a.pad = 0;
    hipLaunchKernelGGL(trunk_fwd, dim3(grid), dim3(NWAVES * 64), LDS_BYTES, stream, a);
}
```

```cpp
#include <hip/hip_runtime.h>
#include <hip/hip_bf16.h>
#include <cstdio>
#include <cstdint>

#define LAS __attribute__((address_space(3)))
#define GAS __attribute__((address_space(1)))
typedef unsigned short bf16_t;
typedef short bf16x8 __attribute__((ext_vector_type(8)));
typedef short s16x4 __attribute__((ext_vector_type(4)));
typedef float f32x2 __attribute__((ext_vector_type(2)));
typedef float f32x4 __attribute__((ext_vector_type(4)));
typedef float f32x16 __attribute__((ext_vector_type(16)));
typedef unsigned u32x2 __attribute__((ext_vector_type(2)));
typedef unsigned u32x4 __attribute__((ext_vector_type(4)));
typedef int i32x4 __attribute__((ext_vector_type(4)));
typedef int i32x8 __attribute__((ext_vector_type(8)));

constexpr int BATCH = 2, SEQ = 8192, DM = 1024, M = BATCH * SEQ, DEPTH = 4;
constexpr int EVEN_IN = 2560, ODD_IN = 832, ODD_INP = 1024;
constexpr int NE = 32, DE = 1024, ECAP = 16384;
constexpr float EPS = 1e-6f;
constexpr float LOG2E = 1.4426950408889634f;
constexpr float C2_B = 0.125f * LOG2E;
constexpr float C2_C = 0.07216878364870322f * LOG2E;

__device__ __forceinline__ unsigned cvt_pk_bf16(float lo, float hi) { unsigned r; asm volatile("v_cvt_pk_bf16_f32 %0, %1, %2" : "=v"(r) : "v"(lo), "v"(hi)); return r; }
__device__ __forceinline__ float bf2f(bf16_t v) { return __uint_as_float(((unsigned)v) << 16); }
__device__ __forceinline__ float bflo(unsigned w) { return __uint_as_float(w << 16); }
__device__ __forceinline__ float bfhi(unsigned w) { return __uint_as_float(w & 0xffff0000u); }
__device__ __forceinline__ bf16_t f2bf(float f) { return (bf16_t)(cvt_pk_bf16(f, 0.f) & 0xffffu); }

__device__ __forceinline__ unsigned pk4_fp8(float a, float b, float c, float d) { int w = 0; w = __builtin_amdgcn_cvt_pk_fp8_f32(a, b, w, false); w = __builtin_amdgcn_cvt_pk_fp8_f32(c, d, w, true); return (unsigned)w; }
constexpr float W8_SCALE = 64.0f, W8_INV = 1.0f / 64.0f;

namespace pg8 {
constexpr int BM = 256, BK = 64, HALF = 128, HTB = HALF * BK * 2, STAGE_BYTES = 8 * HTB, NXCD = 8, WGM = 8;
__host__ __device__ __forceinline__ int lds_byte(int r, int c) { const int st = (r >> 4) * 2 + (c >> 5), rr = r & 15, cc = c & 31, ob = rr * 64 + cc * 2; return st * 1024 + (ob ^ (((ob >> 9) & 1) << 5)); }
__host__ __device__ __forceinline__ void stage_rc(int b, int& R, int& C) { const int st = b / 1024, sb = b % 1024, swz = sb ^ (((sb >> 9) & 1) << 5); R = (st >> 1) * 16 + swz / 64; C = (st & 1) * 32 + (swz % 64) / 2; }
__host__ __device__ __forceinline__ int perm32(int rho) { const int n = rho >> 4, i = rho & 15; return 8 * (i >> 2) + 4 * n + (i & 3); }

struct Unit { int pm, pn, pb, kind, rb; };
struct Gemm { const bf16_t* A; const bf16_t* Bt; int lda, K; const bf16_t* A2; const bf16_t* Bt2; };

struct StaticOrder {
    int nM, nN, nwg, G, c;
    __device__ void init(int M_, int N_, int G_, int c_) { nM = M_ / BM; nN = N_ / BM; nwg = nM * nN; G = G_; c = c_; }
    __device__ bool next(int i, Unit& u) const {
        const long L = (long)i * G + c; if (L >= nwg) return false;
        int wgid = (int)L; { const int q = nwg / NXCD, r = nwg % NXCD, xcd = wgid % NXCD, off = wgid / NXCD; wgid = (xcd < r ? xcd * (q + 1) : r * (q + 1) + (xcd - r) * q) + off; }
        const int nig = WGM * nN, gid = wgid / nig, fm = gid * WGM, gsz = (nM - fm) < WGM ? (nM - fm) : WGM;
        u.pm = fm + ((wgid % nig) % gsz); u.pn = (wgid % nig) / gsz; u.pb = u.pn; u.kind = 0; u.rb = 0; return true;
    }
    __device__ __forceinline__ void a_ready(const Unit&) const {}
    __device__ __forceinline__ void pre_epi() const {}
    __device__ __forceinline__ void done(const Unit&) const {}
    __device__ __forceinline__ void finish() const {}
};

__device__ __forceinline__ f32x2 gelu_pk(f32x2 v) {
    const f32x2 av = __builtin_elementwise_abs(v), d = av * 0.2316418882f + 1.0f;
    f32x2 t; t.x = __builtin_amdgcn_rcpf(d.x); t.y = __builtin_amdgcn_rcpf(d.y);
    f32x2 q = t * 0.5307027145f + (-0.7265760135f); q = q * t + 0.7107068705f; q = q * t + (-0.142248368f); q = q * t + 0.127414796f; q = q * t;
    const f32x2 s = (v * v) * (-0.72134752044f);
    f32x2 e; e.x = __builtin_amdgcn_exp2f(s.x); e.y = __builtin_amdgcn_exp2f(s.y);
    const f32x2 m = v * (q * e), r = v - m;
    f32x2 o; o.x = v.x < 0.f ? m.x : r.x; o.y = v.y < 0.f ? m.y : r.y; return o;
}
__device__ __forceinline__ f32x4 gelu4(f32x4 v) { const f32x2 a = gelu_pk((f32x2){v[0], v[1]}), b = gelu_pk((f32x2){v[2], v[3]}); return (f32x4){a.x, a.y, b.x, b.y}; }

template <class Epi, class Sched, bool FP8 = false>
__device__ __forceinline__ void gemm_phase(LAS unsigned char* lds, const Gemm g, const Sched& S, const Epi& E) {
    int tid_ = threadIdx.x; asm volatile("" : "+v"(tid_));
    const int tid = tid_, wid = __builtin_amdgcn_readfirstlane(tid >> 6), lane = tid & 63, wr = wid >> 2, wc = wid & 3, fr = lane & 15, fq = lane >> 4;
    const int K = g.K, nt = K / BK;
    unsigned voffA[2], voffB[2];
#pragma unroll
    for (int i = 0; i < 2; ++i) { int R, C; stage_rc(tid * 16 + i * 8192, R, C); const int Rb = Epi::PERM ? ((R & ~31) + perm32(R & 31)) : R;
        voffA[i] = (unsigned)(R * g.lda + C) * 2u; voffB[i] = (unsigned)(Rb * K + C) * 2u; }
    const size_t kstep = (size_t)(BK * 2);
    const size_t hstepA = (size_t)HALF * g.lda * 2, tstepA = 2 * hstepA;
    const size_t hstepB = (size_t)HALF * K * 2, tstepB = 2 * hstepB;
    const unsigned ldsw = (unsigned)wid * 1024u;
    const int aoff = lds_byte(wr * 64 + fr, fq * 8), boff = lds_byte(wc * 32 + fr, fq * 8);
#define PG8_SA(b, h) (((b) * 2 + (h)) * HTB)
#define PG8_SB(b, h) ((4 + (b) * 2 + (h)) * HTB)
#define PG8_STAGE(bufoff, gbase, voff) do { _Pragma("unroll") for (int _i = 0; _i < 2; ++_i) \
        __builtin_amdgcn_global_load_lds((const unsigned*)((const char*)(gbase) + (voff)[_i]), (LAS unsigned*)(lds + (bufoff) + ldsw + _i * 8192), 16, 0, 0); } while (0)
#define PG8_LDA(dst, b, h) do { _Pragma("unroll") for (int m = 0; m < 4; ++m) { if constexpr (FP8) { const i32x4 lo_ = *(const LAS i32x4*)(lds + PG8_SA(b, h) + aoff + m * 2048), hi_ = *(const LAS i32x4*)(lds + PG8_SA(b, h) + aoff + m * 2048 + 1024); dst##8[m] = __builtin_shufflevector(lo_, hi_, 0, 1, 2, 3, 4, 5, 6, 7); } \
        else { _Pragma("unroll") for (int k = 0; k < 2; ++k) dst[m][k] = *(const LAS bf16x8*)(lds + PG8_SA(b, h) + aoff + m * 2048 + k * 1024); } } } while (0)
#define PG8_LDB(dst, b, h) do { _Pragma("unroll") for (int n = 0; n < 2; ++n) { if constexpr (FP8) { const i32x4 lo_ = *(const LAS i32x4*)(lds + PG8_SB(b, h) + boff + n * 2048), hi_ = *(const LAS i32x4*)(lds + PG8_SB(b, h) + boff + n * 2048 + 1024); dst##8[n] = __builtin_shufflevector(lo_, hi_, 0, 1, 2, 3, 4, 5, 6, 7); } \
        else { _Pragma("unroll") for (int k = 0; k < 2; ++k) dst[n][k] = *(const LAS bf16x8*)(lds + PG8_SB(b, h) + boff + n * 2048 + k * 1024); } } } while (0)
#define PG8_MMA(ai, bj, At, Bt) do { __builtin_amdgcn_s_setprio(1); _Pragma("unroll") for (int m = 0; m < 4; ++m) _Pragma("unroll") for (int n = 0; n < 2; ++n) { \
        if constexpr (FP8) asm volatile("s_nop 1\n\tv_mfma_f32_16x16x128_f8f6f4 %0, %1, %2, %0" : "+v"(acc[ai][bj][m][n]) : "v"(Bt##8[n]), "v"(At##8[m])); \
        else { _Pragma("unroll") for (int k = 0; k < 2; ++k) acc[ai][bj][m][n] = __builtin_amdgcn_mfma_f32_16x16x32_bf16(Bt[n][k], At[m][k], acc[ai][bj][m][n], 0, 0, 0); } } \
        __builtin_amdgcn_s_setprio(0); } while (0)
#define PG8_WAIT_V(n) asm volatile("s_waitcnt vmcnt(" #n ")" ::: "memory")
#define PG8_WAIT_L(n) asm volatile("s_waitcnt lgkmcnt(" #n ")" ::: "memory")
#define PG8_BAR __builtin_amdgcn_s_barrier()
#define PG8_SCHED __builtin_amdgcn_sched_barrier(0)
    Unit cur, nxt; int ui = 0;
    if (!S.next(0, cur)) return;
    f32x4 acc[2][2][4][2];
#pragma unroll
    for (int a = 0; a < 2; ++a)
#pragma unroll
        for (int b = 0; b < 2; ++b)
#pragma unroll
            for (int m = 0; m < 4; ++m)
#pragma unroll
                for (int n = 0; n < 2; ++n) acc[a][b][m][n] = (f32x4){0.f, 0.f, 0.f, 0.f};
    bf16x8 At[4][2], B0[2][2], B1[2][2]; i32x8 At8[4], B08[2], B18[2];
    const char* cA = (const char*)(cur.kind ? g.A2 : g.A) + (size_t)cur.pm * tstepA; const char* cB = (const char*)(cur.kind ? g.Bt2 : g.Bt) + (size_t)cur.pb * tstepB;
    S.a_ready(cur);
    PG8_STAGE(PG8_SB(0, 0), cB, voffB); PG8_STAGE(PG8_SB(0, 1), cB + hstepB, voffB); PG8_STAGE(PG8_SA(0, 0), cA, voffA); PG8_STAGE(PG8_SA(0, 1), cA + hstepA, voffA);
    if (wr == 1) PG8_BAR;
    PG8_WAIT_V(2); PG8_BAR;
    PG8_STAGE(PG8_SB(1, 0), cB + kstep, voffB); PG8_STAGE(PG8_SA(1, 0), cA + kstep, voffA); PG8_STAGE(PG8_SB(1, 1), cB + hstepB + kstep, voffB);
    PG8_WAIT_V(6); PG8_BAR;
    for (;;) {
        const bool has_next = S.next(ui + 1, nxt);
        const char* nA = has_next ? (const char*)(nxt.kind ? g.A2 : g.A) + (size_t)nxt.pm * tstepA : cA; const char* nB = has_next ? (const char*)(nxt.kind ? g.Bt2 : g.Bt) + (size_t)nxt.pb * tstepB : cB;
#pragma unroll 1
        for (int t = 0; t < nt; t += 2) {
            const bool last = (t == nt - 2);
            const char* a1 = cA + (size_t)(t + 1) * kstep;
            const char* a2 = last ? nA : cA + (size_t)(t + 2) * kstep; const char* b2 = last ? nB : cB + (size_t)(t + 2) * kstep;
            const char* a3 = a2 + kstep; const char* b3 = b2 + kstep;
            if (last && has_next) S.a_ready(nxt);
            PG8_LDB(B0, 0, 0); PG8_LDB(B1, 0, 1); PG8_SCHED; PG8_LDA(At, 0, 0); PG8_STAGE(PG8_SA(1, 1), a1 + hstepA, voffA);
            PG8_WAIT_V(8); PG8_WAIT_L(0); PG8_BAR; PG8_MMA(0, 0, At, B0); PG8_MMA(0, 1, At, B1); PG8_BAR; PG8_SCHED;
            PG8_LDA(At, 0, 1); PG8_STAGE(PG8_SB(0, 0), b2, voffB); PG8_STAGE(PG8_SB(0, 1), b2 + hstepB, voffB); PG8_STAGE(PG8_SA(0, 0), a2, voffA);
            PG8_WAIT_V(8); PG8_WAIT_L(0); PG8_BAR; PG8_MMA(1, 0, At, B0); PG8_MMA(1, 1, At, B1); PG8_BAR; PG8_SCHED;
            PG8_LDB(B0, 1, 0); PG8_LDB(B1, 1, 1); PG8_SCHED; PG8_LDA(At, 1, 0); PG8_STAGE(PG8_SA(0, 1), a2 + hstepA, voffA);
            PG8_WAIT_V(8); PG8_WAIT_L(0); PG8_BAR; PG8_MMA(0, 0, At, B0); PG8_MMA(0, 1, At, B1); PG8_BAR; PG8_SCHED;
            PG8_LDA(At, 1, 1); PG8_STAGE(PG8_SB(1, 0), b3, voffB); PG8_STAGE(PG8_SB(1, 1), b3 + hstepB, voffB); PG8_STAGE(PG8_SA(1, 0), a3, voffA);
            PG8_WAIT_V(8); PG8_WAIT_L(0); PG8_BAR; PG8_MMA(1, 0, At, B0); PG8_MMA(1, 1, At, B1); PG8_BAR; PG8_SCHED;
        }
        if (wr == 0) PG8_BAR;
        if constexpr (FP8) asm volatile("s_nop 15\n\ts_nop 7" ::: "memory");
        S.pre_epi();
        { int te_ = threadIdx.x; asm volatile("" : "+v"(te_));
          E(acc, cur, wr, wc, te_ & 15, (te_ & 63) >> 4); }
        S.done(cur);
        if (!has_next) break;
#pragma unroll
        for (int a = 0; a < 2; ++a)
#pragma unroll
            for (int b = 0; b < 2; ++b)
#pragma unroll
                for (int m = 0; m < 4; ++m)
#pragma unroll
                    for (int n = 0; n < 2; ++n) acc[a][b][m][n] = (f32x4){0.f, 0.f, 0.f, 0.f};
        cur = nxt; cA = nA; cB = nB; ++ui;
        if (wr == 1) PG8_BAR;
    }
    PG8_WAIT_V(0);
    S.finish();
    PG8_BAR;
#undef PG8_SA
#undef PG8_SB
#undef PG8_STAGE
#undef PG8_LDA
#undef PG8_LDB
#undef PG8_MMA
#undef PG8_WAIT_V
#undef PG8_WAIT_L
#undef PG8_BAR
#undef PG8_SCHED
}
}
constexpr int STAGE_LIMIT = 8;

namespace att {
__device__ __forceinline__ int crow(int r, int hi) { return (r & 3) + 8 * (r >> 2) + 4 * hi; }
__device__ __forceinline__ int v_rd_base(int lane) { return ((lane & 3) << 3) | (((lane >> 2) & 3) << 6) | (((lane >> 4) & 1) << 5) | (((lane >> 5) & 1) << 8); }
}

namespace dil {
using att::crow; using att::v_rd_base;
constexpr int OFF_O = 0, OFF_V = 65536, VWAVE = 8192;
template <int S_>
__device__ __forceinline__ void pass(const bf16_t* __restrict__ Qh, const bf16_t* __restrict__ Kh, const bf16_t* __restrict__ Vh, int pitch, int q0, LAS unsigned char* lds, LAS float* scr, int wid, int lane) {
    const int r32 = lane & 31, hi = lane >> 5;
    LAS float* Oacc = (LAS float*)(lds + OFF_O); LAS float* macc = scr; LAS float* lacc = scr + 256; LAS float* wsf = scr + 512 + wid * 64;
    LAS unsigned char* vbuf = lds + OFF_V + wid * VWAVE;
    constexpr int NG = (S_ == 16) ? 2 : 1, VR = (S_ == 16) ? 16 : 32;
    int vk[4], vc[4];
#pragma unroll
    for (int i = 0; i < 4; ++i) { const int off = (i * 64 + lane) * 16, st = off >> 9, within = off & 511, kk = (st >> 1) * 8 + (within >> 6);
        vk[i] = (kk & ~0xC) | ((kk & 4) << 1) | ((kk & 8) >> 1); vc[i] = (st & 1) * 32 + ((within & 63) >> 1); }
    const unsigned vb0 = (unsigned)(uintptr_t)vbuf + (unsigned)v_rd_base(lane);
#pragma unroll
    for (int gi = 0; gi < NG; ++gi) {
        const int rho = (S_ == 1) ? 0 : (S_ == 4) ? (wid & 3) : (2 * wid + gi);
        const int i0 = (S_ == 1) ? 32 * wid : (S_ == 4) ? 32 * (wid >> 2) : 0;
        const int qi = i0 + (r32 < VR ? r32 : r32 - VR);
        const int ql = rho + S_ * qi;
        bf16x8 qr[4];
#pragma unroll
        for (int d0 = 0; d0 < 4; ++d0) qr[d0] = *(const bf16x8*)(Qh + (size_t)(q0 + ql) * pitch + d0 * 16 + hi * 8);
        const int j0 = i0 - 128;
        const int tokb = q0 + rho + S_ * j0;
        bf16x8 kfA[4], kfB[4];
#define DIL_KLOAD(dst, c) do { int tk_ = tokb + S_ * (32 * (c) + r32); tk_ = tk_ < 0 ? 0 : (tk_ > SEQ - 1 ? SEQ - 1 : tk_);     \
            _Pragma("unroll") for (int d0 = 0; d0 < 4; ++d0) dst[d0] = *(const bf16x8*)(Kh + (size_t)tk_ * pitch + d0 * 16 + hi * 8); } while (0)
#define DIL_VDMA(c, bf) do { _Pragma("unroll") for (int i = 0; i < 4; ++i) { int tk_ = tokb + S_ * (32 * (c) + vk[i]); tk_ = tk_ < 0 ? 0 : (tk_ > SEQ - 1 ? SEQ - 1 : tk_); \
            __builtin_amdgcn_global_load_lds((const unsigned*)(Vh + (size_t)tk_ * pitch + vc[i]), (LAS unsigned*)(vbuf + (bf) * 4096 + i * 1024), 16, 0, 0); } } while (0)
        float m_reg = -1e30f, l_reg = 0.f; f32x16 o[2]; o[0] = f32x16{}; o[1] = f32x16{};
        DIL_KLOAD(kfA, 0); DIL_VDMA(0, 0);
#define DIL_STEP(KF, KN, c) do { \
            if ((c) < 4) { DIL_KLOAD(KN, (c) + 1); DIL_VDMA((c) + 1, ((c) + 1) & 1); asm volatile("s_waitcnt vmcnt(8)" ::: "memory"); } \
            else { asm volatile("s_waitcnt vmcnt(0)" ::: "memory"); } \
            f32x16 p = f32x16{}; \
            _Pragma("unroll") for (int d0 = 0; d0 < 4; ++d0) p = __builtin_amdgcn_mfma_f32_32x32x16_bf16(KF[d0], qr[d0], p, 0, 0, 0); \
            const unsigned vb = vb0 + (unsigned)(((c) & 1) * 4096); \
            s16x4 vl0[2], vh0[2], vl1[2], vh1[2]; \
            _Pragma("unroll") for (int d0 = 0; d0 < 2; ++d0) { \
                asm volatile("ds_read_b64_tr_b16 %0, %1 offset:%2" : "=&v"(vl0[d0]) : "v"(vb), "i"(d0 * 512) : "memory"); \
                asm volatile("ds_read_b64_tr_b16 %0, %1 offset:%2" : "=&v"(vh0[d0]) : "v"(vb), "i"(d0 * 512 + 1024) : "memory"); \
                asm volatile("ds_read_b64_tr_b16 %0, %1 offset:%2" : "=&v"(vl1[d0]) : "v"(vb), "i"(d0 * 512 + 2048) : "memory"); \
                asm volatile("ds_read_b64_tr_b16 %0, %1 offset:%2" : "=&v"(vh1[d0]) : "v"(vb), "i"(d0 * 512 + 3072) : "memory"); } \
              \
            { const float NEG = -__builtin_inff(); const int db = qi - j0 - 32 * (c) - 4 * hi; const int tb = tokb + S_ * (32 * (c) + 4 * hi); \
              if ((c) == 0 || (c) == 4 || tokb < 0) { \
                _Pragma("unroll") for (int r = 0; r < 16; ++r) { const int cr = (r & 3) + 8 * (r >> 2); \
                    const bool ok = ((unsigned)(db - cr) <= 128u) && (tb + S_ * cr >= 0); p[r] = ok ? p[r] : NEG; } } } \
            float pmax = p[0]; \
            _Pragma("unroll") for (int r = 1; r < 16; ++r) pmax = fmaxf(pmax, p[r]); \
            { auto rr = __builtin_amdgcn_permlane32_swap(__float_as_uint(pmax), __float_as_uint(pmax), false, false); pmax = fmaxf(__uint_as_float(rr[0]), __uint_as_float(rr[1])); } \
            const float mn = fmaxf(m_reg, pmax); const float alpha = __builtin_amdgcn_exp2f(m_reg - mn); m_reg = mn; \
            float ps = 0.f; \
            _Pragma("unroll") for (int r = 0; r < 16; ++r) { p[r] = __builtin_amdgcn_exp2f(p[r] - mn); ps += p[r]; } \
            { auto rr = __builtin_amdgcn_permlane32_swap(__float_as_uint(ps), __float_as_uint(ps), false, false); ps = __uint_as_float(rr[0]) + __uint_as_float(rr[1]); } \
            l_reg = l_reg * alpha + ps; \
            bf16x8 pa0, pa1; DIL_PK4(p, 0, pa0); DIL_PK4(p, 8, pa1); \
            if (__any(alpha < 1.f)) { if (hi == 0) wsf[r32] = alpha; asm volatile("s_waitcnt lgkmcnt(0)" ::: "memory"); \
                _Pragma("unroll") for (int r = 0; r < 16; ++r) { const float a = wsf[crow(r, hi)]; o[0][r] *= a; o[1][r] *= a; } } \
            asm volatile("s_waitcnt lgkmcnt(0)" ::: "memory"); __builtin_amdgcn_sched_barrier(0); \
            _Pragma("unroll") for (int d0 = 0; d0 < 2; ++d0) { \
                o[d0] = __builtin_amdgcn_mfma_f32_32x32x16_bf16(pa0, (bf16x8){vl0[d0][0], vl0[d0][1], vl0[d0][2], vl0[d0][3], vh0[d0][0], vh0[d0][1], vh0[d0][2], vh0[d0][3]}, o[d0], 0, 0, 0); \
                o[d0] = __builtin_amdgcn_mfma_f32_32x32x16_bf16(pa1, (bf16x8){vl1[d0][0], vl1[d0][1], vl1[d0][2], vl1[d0][3], vh1[d0][0], vh1[d0][1], vh1[d0][2], vh1[d0][3]}, o[d0], 0, 0, 0); } \
        } while (0)
#define DIL_PK4(P, B_, OUT) do { unsigned a0 = cvt_pk_bf16(P[B_+0], P[B_+1]), a1 = cvt_pk_bf16(P[B_+2], P[B_+3]);                          \
            unsigned b0_ = cvt_pk_bf16(P[B_+4], P[B_+5]), b1_ = cvt_pk_bf16(P[B_+6], P[B_+7]);                                             \
            auto r0 = __builtin_amdgcn_permlane32_swap(a0, b0_, false, false); auto r1 = __builtin_amdgcn_permlane32_swap(a1, b1_, false, false); \
            u32x4 w = {r0[0], r1[0], r0[1], r1[1]}; OUT = __builtin_bit_cast(bf16x8, w); } while (0)
        DIL_STEP(kfA, kfB, 0); DIL_STEP(kfB, kfA, 1); DIL_STEP(kfA, kfB, 2); DIL_STEP(kfB, kfA, 3); DIL_STEP(kfA, kfB, 4);
#undef DIL_STEP
#undef DIL_PK4
#undef DIL_KLOAD
#undef DIL_VDMA
        float fo = 0.f, fc = 1.f;
        if (S_ != 1) { const float mo = macc[ql], lo = lacc[ql]; const float mnew = fmaxf(mo, m_reg); fo = __builtin_amdgcn_exp2f(mo - mnew); fc = __builtin_amdgcn_exp2f(m_reg - mnew);
            l_reg = lo * fo + l_reg * fc; m_reg = mnew; }
        if (hi == 0 && r32 < VR) { macc[ql] = m_reg; lacc[ql] = l_reg; wsf[r32] = fo; wsf[32 + r32] = fc; }
        asm volatile("s_waitcnt lgkmcnt(0)" ::: "memory");
#pragma unroll
        for (int r = 0; r < 16; ++r) { const int row = crow(r, hi);
            if (row < VR) { const int qrow = rho + S_ * (i0 + row); LAS float* op = Oacc + qrow * 64 + r32;
                if (S_ == 1) { op[0] = o[0][r]; op[32] = o[1][r]; }
                else { const float a = wsf[row], b = wsf[32 + row]; op[0] = op[0] * a + o[0][r] * b; op[32] = op[32] * a + o[1][r] * b; } } }
        asm volatile("s_waitcnt lgkmcnt(0)" ::: "memory");
    }
}
__device__ __forceinline__ void unit(const bf16_t* Qh, const bf16_t* Kh, const bf16_t* Vh, int pitch, bf16_t* Oh, int op, int q0, LAS unsigned char* lds, LAS float* scr) {
    int tid_ = threadIdx.x; asm volatile("" : "+v"(tid_));
    const int tid = tid_, wid = __builtin_amdgcn_readfirstlane(tid >> 6), lane = tid & 63;
    pass<1>(Qh, Kh, Vh, pitch, q0, lds, scr, wid, lane);
    __syncthreads();
    pass<4>(Qh, Kh, Vh, pitch, q0, lds, scr, wid, lane);
    __syncthreads();
    pass<16>(Qh, Kh, Vh, pitch, q0, lds, scr, wid, lane);
    __syncthreads();
    {   const int q = tid >> 1, hf = tid & 1; const LAS f32x4* src = (const LAS f32x4*)(lds + OFF_O + (q * 64 + 32 * hf) * 4); const float rl = 1.0f / scr[256 + q];
        bf16_t* dst = Oh + (size_t)(q0 + q) * op + 32 * hf;
#pragma unroll
        for (int i = 0; i < 4; ++i) { const f32x4 a = src[2 * i] * rl, b = src[2 * i + 1] * rl;
            u32x4 w; w.x = cvt_pk_bf16(a[0], a[1]); w.y = cvt_pk_bf16(a[2], a[3]); w.z = cvt_pk_bf16(b[0], b[1]); w.w = cvt_pk_bf16(b[2], b[3]); *(u32x4*)(dst + 8 * i) = w; } }
    __syncthreads();
}
}

namespace mla {
using att::crow;
constexpr int DQ = 192, DV_ = 128;
constexpr int KP = DQ + 16, KB = 64 * KP;
constexpr int VP = 80, VB = DV_ * VP;
constexpr int NBUF = 3;
constexpr int OFF_K = 0, OFF_V = NBUF * KB, OFF_WS = NBUF * (KB + VB), BYTES = OFF_WS + 8 * 256;
constexpr int KCPR = KP / 16, NKP = KB / 1024, KPW = (NKP + 7) / 8;
constexpr int NVP = VB / 256, VPW = NVP / 8;
static_assert(BYTES <= 131072 && KB % 1024 == 0 && VB % 256 == 0 && NVP % 8 == 0, "mla LDS image");
constexpr float PSHIFT = 8.0f;

__device__ __forceinline__ void unit(const unsigned char* __restrict__ Qh, const unsigned char* __restrict__ Kh, int pitch, const unsigned char* __restrict__ VTh  ,
                                     unsigned char* __restrict__ Oh, int op, int q0, LAS unsigned char* lds) {
    constexpr float SC = C2_C;
    int tid_ = threadIdx.x; asm volatile("" : "+v"(tid_));
    const int tid = tid_, wid = __builtin_amdgcn_readfirstlane(tid >> 6), lane = tid & 63, r32 = lane & 31, hi = lane >> 5;
    const int qlo = q0 + wid * 32, qpos = qlo + r32;
    LAS float* wsf = (LAS float*)(lds + OFF_WS) + wid * 64;
    const int NT = (q0 + 256) / 64;
    unsigned kso[KPW], vso[VPW];
#pragma unroll
    for (int i = 0; i < KPW; ++i) { const int c = (wid + 8 * i) * 64 + lane, row = c / KCPR; int cc = c % KCPR; if (cc > KCPR - 2) cc = KCPR - 2; kso[i] = (unsigned)((row & 63) * pitch + cc * 16); }
#pragma unroll
    for (int i = 0; i < VPW; ++i) { const int off = ((wid + 8 * i) * 64 + lane) * 4, d = off / VP; int w = off % VP; if (w >= 64) w = 0;
        const int hh = w >> 5, g = (w & 31) >> 2; vso[i] = (unsigned)(d * SEQ + 32 * (g >> 2) + 8 * (g & 3) + 4 * hh); }
#define MLA_DMA(j, bf) do { const unsigned char* kt_ = Kh + (size_t)(j) * 64 * pitch; const unsigned char* vt_ = VTh + (size_t)(j) * 64; \
        _Pragma("unroll") for (int i = 0; i < KPW; ++i) if (wid + 8 * i < NKP) \
            __builtin_amdgcn_global_load_lds((const unsigned*)(kt_ + kso[i]), (LAS unsigned*)(lds + OFF_K + (bf) * KB + (wid + 8 * i) * 1024), 16, 0, 0); \
        _Pragma("unroll") for (int i = 0; i < VPW; ++i) \
            __builtin_amdgcn_global_load_lds((const unsigned*)(vt_ + vso[i]), (LAS unsigned*)(lds + OFF_V + (bf) * VB + (wid + 8 * i) * 256), 4, 0, 0); } while (0)
    MLA_DMA(0, 0);
    if (NT > 1) MLA_DMA(1, 1);
    i32x8 qr[3];
#pragma unroll
    for (int s = 0; s < 3; ++s) { const i32x4 lo_ = *(const i32x4*)(Qh + (size_t)qpos * pitch + 64 * s + 32 * hi), hi_ = *(const i32x4*)(Qh + (size_t)qpos * pitch + 64 * s + 32 * hi + 16);
        qr[s] = __builtin_shufflevector(lo_, hi_, 0, 1, 2, 3, 4, 5, 6, 7); }
    float m_reg = -1e30f;
    f32x16 o[4], ol = f32x16{};
    const i32x8 ones8 = {0x38383838, 0x38383838, 0x38383838, 0x38383838, 0x38383838, 0x38383838, 0x38383838, 0x38383838};
#pragma unroll
    for (int d = 0; d < 4; ++d) o[d] = f32x16{};
    const int koff = r32 * KP + hi * 32, voff = r32 * VP + hi * 32;
    asm volatile("s_waitcnt vmcnt(0)" ::: "memory");
    __syncthreads();
#define MLA_QK(P, bufi, hf_) do { const LAS unsigned char* kb_ = lds + OFF_K + (bufi) * KB + (hf_) * 32 * KP + koff; P = f32x16{}; \
        i32x8 kw_[3]; _Pragma("unroll") for (int s = 0; s < 3; ++s) { const i32x4 lo_ = *(const LAS i32x4*)(kb_ + 64 * s), hi_ = *(const LAS i32x4*)(kb_ + 64 * s + 16); kw_[s] = __builtin_shufflevector(lo_, hi_, 0, 1, 2, 3, 4, 5, 6, 7); } \
        _Pragma("unroll") for (int s = 0; s < 3; ++s) P = __builtin_amdgcn_mfma_scale_f32_32x32x64_f8f6f4(kw_[s], qr[s], P, 0, 0, 0, 0, 0, 0); } while (0)
    f32x16 pA, pB, pC, pD;
    int buf = 0;
    { if (0 <= qlo + 31) { MLA_QK(pA, 0, 0); } if (32 <= qlo + 31) { MLA_QK(pB, 0, 1); } }
#define MLA_SMPV(P0, P1, kb, vbuf) do { \
        const bool a0_ = (kb) <= qlo + 31, a1_ = (kb) + 32 <= qlo + 31; \
        if (a0_) { \
            const float NEG = -__builtin_inff(); const int dq = qpos - (kb) - 4 * hi; \
            if (!a1_) { _Pragma("unroll") for (int r = 0; r < 16; ++r) P1[r] = NEG; } \
            if ((kb) + 63 > qlo) { _Pragma("unroll") for (int r = 0; r < 16; ++r) { const int c = (r & 3) + 8 * (r >> 2); if (dq - c < 0) P0[r] = NEG; if (dq - c - 32 < 0) P1[r] = NEG; } } \
            float pmax = fmaxf(P0[0], P1[0]); \
            _Pragma("unroll") for (int r = 1; r < 16; ++r) pmax = fmaxf(pmax, fmaxf(P0[r], P1[r])); \
            { auto rr = __builtin_amdgcn_permlane32_swap(__float_as_uint(pmax), __float_as_uint(pmax), false, false); pmax = fmaxf(__uint_as_float(rr[0]), __uint_as_float(rr[1])); } \
            const float mn = fmaxf(m_reg, pmax * SC); const float alpha = __builtin_amdgcn_exp2f(m_reg - mn); m_reg = mn; \
              \
              \
            const float c8 = 8.0f * SC, b8 = 8.0f * (PSHIFT + 7.0f - mn); \
            i32x8 pa; \
            _Pragma("unroll") for (int g = 0; g < 4; ++g) { unsigned w0 = 0u, w1 = 0u; \
                _Pragma("unroll") for (int b_ = 0; b_ < 4; ++b_) { w0 = __builtin_amdgcn_cvt_pk_u8_f32(__builtin_fmaf(P0[4 * g + b_], c8, b8), b_, w0); w1 = __builtin_amdgcn_cvt_pk_u8_f32(__builtin_fmaf(P1[4 * g + b_], c8, b8), b_, w1); } \
                pa[g] = (int)w0; pa[4 + g] = (int)w1; } \
            if (__any(alpha < 1.f)) { if (hi == 0) wsf[r32] = alpha; asm volatile("s_waitcnt lgkmcnt(0)" ::: "memory"); \
                _Pragma("unroll") for (int r = 0; r < 16; ++r) { const float a = wsf[crow(r, hi)]; ol[r] *= a; _Pragma("unroll") for (int d = 0; d < 4; ++d) o[d][r] *= a; } } \
            ol = __builtin_amdgcn_mfma_scale_f32_32x32x64_f8f6f4(pa, ones8, ol, 0, 0, 0, 0, 0, 0); \
            const LAS unsigned char* vb_ = lds + OFF_V + (vbuf) * VB + voff; \
            _Pragma("unroll") for (int d0 = 0; d0 < 4; ++d0) { const i32x4 lo_ = *(const LAS i32x4*)(vb_ + d0 * 32 * VP), hi_ = *(const LAS i32x4*)(vb_ + d0 * 32 * VP + 16); \
                o[d0] = __builtin_amdgcn_mfma_scale_f32_32x32x64_f8f6f4(pa, __builtin_shufflevector(lo_, hi_, 0, 1, 2, 3, 4, 5, 6, 7), o[d0], 0, 0, 0, 0, 0, 0); } \
        } } while (0)
    for (int t = 0; t < NT; t += 2) {
        {   if (t + 2 < NT) { const int b2 = buf == 0 ? 2 : buf - 1; MLA_DMA(t + 2, b2); }
            const int kb = t * 64, nb = buf == 2 ? 0 : buf + 1;
            if (kb + 64 <= qlo + 31) MLA_QK(pC, nb, 0);
            if (kb + 96 <= qlo + 31) MLA_QK(pD, nb, 1);
            MLA_SMPV(pA, pB, kb, buf);
            asm volatile("s_waitcnt vmcnt(0)" ::: "memory"); __syncthreads(); buf = nb; }
        {   if (t + 3 < NT) { const int b2 = buf == 0 ? 2 : buf - 1; MLA_DMA(t + 3, b2); }
            const int kb = (t + 1) * 64, nb = buf == 2 ? 0 : buf + 1;
            if (t + 2 < NT) { if (kb + 64 <= qlo + 31) MLA_QK(pA, nb, 0); if (kb + 96 <= qlo + 31) MLA_QK(pB, nb, 1); }
            MLA_SMPV(pC, pD, kb, buf);
            asm volatile("s_waitcnt vmcnt(0)" ::: "memory"); __syncthreads(); buf = nb; }
    }
#undef MLA_SMPV
#undef MLA_QK
#undef MLA_DMA
    unsigned char* Ow = Oh + (size_t)qlo * op;
#pragma unroll
    for (int r = 0; r < 16; ++r) { const int orow = crow(r, hi); const float rl = __builtin_amdgcn_rcpf(ol[r]);
#pragma unroll
        for (int d0 = 0; d0 < 4; ++d0) { const float v = o[d0][r] * rl; const float v1 = __shfl_down(v, 1), v2 = __shfl_down(v, 2), v3 = __shfl_down(v, 3);
            if ((r32 & 3) == 0) *(unsigned*)(Ow + (size_t)orow * op + d0 * 32 + r32) = pk4_fp8(v, v1, v2, v3); } }
    __syncthreads();
}
}

constexpr int NWAVES = 8;
constexpr size_t MiB = 1u << 20;
constexpr size_t WS_CTL = 0, CTL_ZERO_BYTES = 1 * MiB;
constexpr size_t WS_WEIN = 2 * MiB;
constexpr size_t WS_WEOUT = 12 * MiB;
constexpr size_t WS_WOIN = 16 * MiB;
constexpr size_t WS_WUQ = 20 * MiB;
constexpr size_t WS_WUKV = 23 * MiB;
constexpr size_t WS_WOOUT = 25 * MiB;
constexpr size_t WS_B1P = 29 * MiB;
constexpr size_t WS_SSQ = 30 * MiB;
constexpr size_t WS_TOKER = 31 * MiB;
constexpr size_t WS_TOKG = 31 * MiB + 512 * 1024;
constexpr size_t WS_XN = 32 * MiB;
constexpr size_t WS_Z = 64 * MiB;
constexpr size_t WS_MIX = 144 * MiB;
constexpr size_t WS_QR = 176 * MiB;
constexpr size_t WS_KVR = 224 * MiB;
constexpr size_t WS_QF = 288 * MiB;
constexpr size_t WS_KF = 336 * MiB;
constexpr size_t WS_Z8 = 104 * MiB;
constexpr size_t WS_MIX8 = 160 * MiB;
constexpr size_t WS_VT = 3200 * MiB;
constexpr size_t WS_W1 = 384 * MiB;
constexpr size_t WS_W2 = 896 * MiB;
constexpr size_t WS_XG = 1152 * MiB;
constexpr size_t WS_ACT = 1664 * MiB;
constexpr size_t WS_Y = 2176 * MiB;
constexpr size_t WS_END = 3216 * MiB;
constexpr int CW_MOE = 65536;
constexpr int CW_TMO = 0, CW_CODE = 1, CW_BAR = 4096, CW_CNT = 16384;
constexpr int RING_OFF = 0, RING_BYTES = 131072;
constexpr int LDSCTL_OFF = RING_BYTES, MISC_OFF = LDSCTL_OFF + 320;
constexpr int SCR_OFF = RING_BYTES + 1024;
constexpr int LDS_BYTES = 155648;
constexpr int SCR_BYTES = LDS_BYTES - SCR_OFF;

typedef GAS unsigned gu32;
#define RLX_AGENT __ATOMIC_RELAXED, __HIP_MEMORY_SCOPE_AGENT

#define XB_TMO      128
#define XB_XCNT(j)  (256  + 64 * (j))
#define XB_XSUB(j)  (1280 + 64 * (j))
#define XB_XGEN(j)  (2304 + 64 * (j))
#define XB_TOP      3328
#define XB_TOPGEN   3392
#define XCD_BAR_WORDS 3456
#define XB_SPIN_CAP (1u << 18)
__device__ __forceinline__ unsigned xb_ld(unsigned* p)              { return __hip_atomic_load(p, __ATOMIC_RELAXED, __HIP_MEMORY_SCOPE_AGENT); }
__device__ __forceinline__ unsigned xb_add(unsigned* p, unsigned v) { return __hip_atomic_fetch_add(p, v, __ATOMIC_RELAXED, __HIP_MEMORY_SCOPE_AGENT); }
__device__ __forceinline__ unsigned xb_xcc_id() { return (unsigned)__builtin_amdgcn_s_getreg((3 << 11) | 20) & 0xFu; }
#define XB_SPIN(cond, bar) do { unsigned _sp = 0; while (cond) { __builtin_amdgcn_s_sleep(1); \
    if ((++_sp & 255u) == 0u) { if (xb_ld(&(bar)[XB_TMO])) break; if (_sp > XB_SPIN_CAP) { atomicAdd(&(bar)[XB_TMO], 1u); break; } } } } while (0)
struct XcdBarrier { unsigned* bar; unsigned x; volatile LAS unsigned* st; };
__device__ __forceinline__ XcdBarrier xcd_barrier_post(unsigned* bar, volatile LAS unsigned* st) {
    XcdBarrier b; b.bar = bar; b.x = xb_xcc_id(); b.st = st;
    if (threadIdx.x == 0) (void)xb_add(&bar[XB_XCNT(b.x)], 1u);
    return b;
}
__device__ __forceinline__ void xcd_barrier_complete(unsigned* bar, unsigned x, unsigned& nloc, unsigned& nx) {
    const unsigned G = gridDim.x * gridDim.y * gridDim.z;
    unsigned sum, cnt, mine, sp = 0u;
    for (;;) {
        sum = 0u; cnt = 0u; mine = 0u;
#pragma unroll
        for (unsigned j = 0; j < 16; ++j) { const unsigned c = xb_ld(&bar[XB_XCNT(j)]); sum += c; cnt += (c > 0u) ? 1u : 0u; mine = (j == x) ? c : mine; }
        if (sum == G) break;
        __builtin_amdgcn_s_sleep(1);
        if ((++sp & 255u) == 0u) { if (xb_ld(&bar[XB_TMO])) break; if (sp > XB_SPIN_CAP) { atomicAdd(&bar[XB_TMO], 1u); break; } }
    }
    nloc = mine > 0u ? mine : 1u; nx = cnt > 0u ? cnt : 1u;
}
__device__ __forceinline__ void xcd_barrier(const XcdBarrier& b) {
    asm volatile("s_waitcnt vmcnt(0)" ::: "memory");
    __syncthreads();
    if (threadIdx.x == 0) {
        unsigned* bar = b.bar;
        __builtin_amdgcn_s_waitcnt(0);
        unsigned nloc = b.st[0], nx = b.st[1];
        if (nloc == 0u) { xcd_barrier_complete(bar, b.x, nloc, nx); b.st[0] = nloc; b.st[1] = nx; }
        const unsigned old = xb_add(&bar[XB_XSUB(b.x)], 1u);
        const unsigned gen = old / nloc;
        if (old + 1u == (gen + 1u) * nloc) {
            __builtin_amdgcn_fence(__ATOMIC_RELEASE, "agent");
            asm volatile("s_waitcnt vmcnt(0)" ::: "memory");
            const unsigned og = xb_add(&bar[XB_TOP], 1u);
            const unsigned tg = og / nx;
            if (og + 1u == (tg + 1u) * nx) xb_add(&bar[XB_TOPGEN], 1u);
            else XB_SPIN(xb_ld(&bar[XB_TOPGEN]) == tg, bar);
            __builtin_amdgcn_fence(__ATOMIC_ACQUIRE, "agent");
            xb_add(&bar[XB_XGEN(b.x)], 1u);
            asm volatile("s_waitcnt vmcnt(0)" ::: "memory");
        } else {
            XB_SPIN(xb_ld(&bar[XB_XGEN(b.x)]) == gen, bar);
            __builtin_amdgcn_fence(__ATOMIC_ACQUIRE, "agent");
            asm volatile("s_waitcnt vmcnt(0)" ::: "memory");
        }
    }
    __syncthreads();
}

struct Args {
    const float* in[24]; float* out; unsigned char* ws; int stage_limit; int pad;
};
enum { I_X = 0, I_MIXN, I_FFNN, I_EWIN, I_EWS, I_EBS, I_EGV, I_EGQ, I_EGK, I_EWOUT, I_OWIN, I_OGCQ, I_OGCKV, I_OWUQ, I_OWUKV, I_OGQ, I_OGK, I_OWOUT,
       I_RW, I_RB, I_W1, I_B1, I_W2, I_B2 };

struct Frame {
    LAS unsigned char* lds;
    int vcu, G;
};

__device__ __forceinline__ float wave_sum(float v) {
#pragma unroll
    for (int o = 1; o < 64; o <<= 1) v += __shfl_xor(v, o);
    return v;
}
#define LDS_WAIT() asm volatile("s_waitcnt lgkmcnt(0)" ::: "memory")

template <int MODE> __device__ __forceinline__ int dst_row(int o) {
    if (MODE == 1) { if (o >= 1024 && o < 2048) return (o & ~255) | (((o >> 5) & 1) << 7) | (((o >> 6) & 3) << 5) | (o & 31); return o; }
    if (MODE == 2) return ((o >> 8) << 8) | ((o & 1) << 7) | ((o & 255) >> 1);
    return o;
}
template <int MODE>
__device__ __forceinline__ void transpose_item(const float* __restrict__ W, int K, int N, bf16_t* __restrict__ WT, const float* __restrict__ gain, LAS float* scr, int item, int lane) {
    const int nblk = N / 32, kb = item / nblk, nb = item % nblk, k0 = 64 * kb, n0 = 32 * nb;
#pragma unroll 8
    for (int i = 0; i < 32; ++i) { const int kk = 2 * i + (lane >> 5); float w = W[(size_t)(k0 + kk) * N + n0 + (lane & 31)]; if (gain) w *= gain[k0 + kk]; scr[kk * 33 + (lane & 31)] = w; }
    LDS_WAIT(); asm volatile("" ::: "memory");
    const int c = lane & 7;
#pragma unroll
    for (int j = 0; j < 4; ++j) { const int n = (lane >> 3) + 8 * j; const LAS float* s = scr + (8 * c) * 33 + n;
        u32x4 o; o.x = cvt_pk_bf16(s[0 * 33], s[1 * 33]); o.y = cvt_pk_bf16(s[2 * 33], s[3 * 33]); o.z = cvt_pk_bf16(s[4 * 33], s[5 * 33]); o.w = cvt_pk_bf16(s[6 * 33], s[7 * 33]);
        *(u32x4*)(WT + (size_t)dst_row<MODE>(n0 + n) * K + k0 + 8 * c) = o; }
    LDS_WAIT(); asm volatile("" ::: "memory");
}
template <int MODE>
__device__ __forceinline__ void transpose_job(Frame& F, const float* W, int K, int N, int nmat, size_t src_stride, bf16_t* WT, size_t dst_stride, const float* gain, int gain_stride) {
    int tid_ = threadIdx.x; asm volatile("" : "+v"(tid_));
    const int wave = __builtin_amdgcn_readfirstlane(tid_ >> 6), lane = tid_ & 63;
    LAS float* scr = (LAS float*)(F.lds + RING_OFF + wave * 16384);
    const int gw = F.vcu * NWAVES + wave, NGW = F.G * NWAVES;
    const int per = (K / 64) * (N / 32), total = per * nmat;
    for (int it = gw; it < total; it += NGW) { const int mi = it / per, item = it - mi * per;
        transpose_item<MODE>(W + (size_t)mi * src_stride, K, N, WT + (size_t)mi * dst_stride, gain ? gain + (size_t)mi * gain_stride : nullptr, scr, item, lane); }
}


__device__ __forceinline__ void tr8_load(f32x4 (&v)[8], const float* __restrict__ W, int N, int item, int lane) {
    const int nblk = N / 32, kb = item / nblk, nb = item % nblk, k0 = 64 * kb, n0 = 32 * nb;
#pragma unroll
    for (int i = 0; i < 8; ++i) v[i] = __builtin_nontemporal_load((const f32x4*)(W + (size_t)(k0 + 8 * i + (lane >> 3)) * N + n0 + 4 * (lane & 7)));
}
template <int MODE>
__device__ __forceinline__ void tr8_store(const f32x4 (&v)[8], int K, int N, unsigned char* __restrict__ WT, const float* __restrict__ gain, LAS float* scr, int item, int lane) {
    const int nblk = N / 32, kb = item / nblk, nb = item % nblk, k0 = 64 * kb, n0 = 32 * nb;
#pragma unroll
    for (int i = 0; i < 8; ++i) { LAS float* d = scr + (8 * i + (lane >> 3)) * 33 + 4 * (lane & 7); const float sc = gain ? W8_SCALE * gain[k0 + 8 * i + (lane >> 3)] : W8_SCALE;
        d[0] = v[i].x * sc; d[1] = v[i].y * sc; d[2] = v[i].z * sc; d[3] = v[i].w * sc; }
    LDS_WAIT(); asm volatile("" ::: "memory");
    const int c = lane & 3;
#pragma unroll
    for (int j = 0; j < 2; ++j) { const int n = (lane >> 2) + 16 * j; const LAS float* s = scr + (16 * c) * 33 + n;
        u32x4 o; o.x = pk4_fp8(s[0 * 33], s[1 * 33], s[2 * 33], s[3 * 33]); o.y = pk4_fp8(s[4 * 33], s[5 * 33], s[6 * 33], s[7 * 33]);
        o.z = pk4_fp8(s[8 * 33], s[9 * 33], s[10 * 33], s[11 * 33]); o.w = pk4_fp8(s[12 * 33], s[13 * 33], s[14 * 33], s[15 * 33]);
        __builtin_nontemporal_store(o, (u32x4*)(WT + (size_t)dst_row<MODE>(n0 + n) * K + k0 + 16 * c)); }
    LDS_WAIT(); asm volatile("" ::: "memory");
}
template <int MODE>
__device__ __forceinline__ void transpose_job_fp8(Frame& F, const float* W, int K, int N, int nmat, size_t src_stride, unsigned char* WT, size_t dst_stride, const float* gain = nullptr, int gain_stride = 0) {
    int tid_ = threadIdx.x; asm volatile("" : "+v"(tid_));
    const int wave = __builtin_amdgcn_readfirstlane(tid_ >> 6), lane = tid_ & 63;
    LAS float* scr = (LAS float*)(F.lds + RING_OFF + wave * 16384);
    const int gw = F.vcu * NWAVES + wave, NGW = F.G * NWAVES;
    const int per = (K / 64) * (N / 32), total = per * nmat;
    f32x4 cur[8], nxt[8];
    int it = gw;
    if (it < total) { const int mi = it / per; tr8_load(cur, W + (size_t)mi * src_stride, N, it - mi * per, lane); }
    for (; it < total; it += NGW) {
        const int itn = it + NGW;
        if (itn < total) { const int mn = itn / per; tr8_load(nxt, W + (size_t)mn * src_stride, N, itn - mn * per, lane); }
        const int mi = it / per;
        tr8_store<MODE>(cur, K, N, WT + (size_t)mi * dst_stride, gain ? gain + (size_t)mi * gain_stride : nullptr, scr, it - mi * per, lane);
#pragma unroll
        for (int i = 0; i < 8; ++i) cur[i] = nxt[i];
    }
}

__device__ __forceinline__ void rms_row_to_fp8(int lane, const float* xrow, const float* g, unsigned char* orow, float* copy) {
    const f32x4* xr = (const f32x4*)xrow + lane; const f32x4* gr = (const f32x4*)g + lane;
    f32x4 v[4]; float s = 0.f;
#pragma unroll
    for (int j = 0; j < 4; ++j) { v[j] = xr[64 * j]; s += (v[j].x * v[j].x + v[j].y * v[j].y) + (v[j].z * v[j].z + v[j].w * v[j].w); }
    const float rstd = 1.0f / sqrtf(wave_sum(s) * (1.f / DM) + EPS);
    unsigned* o4 = (unsigned*)orow + lane;
#pragma unroll
    for (int j = 0; j < 4; ++j) { const f32x4 gg = gr[64 * j]; if (copy) ((f32x4*)copy + lane)[64 * j] = v[j];
        o4[64 * j] = pk4_fp8(v[j].x * rstd * gg.x, v[j].y * rstd * gg.y, v[j].z * rstd * gg.z, v[j].w * rstd * gg.w); }
}
__device__ __forceinline__ void rms_row_to_bf16(int lane, const float* xrow, const float* g, bf16_t* orow, float* copy) {
    const f32x4* xr = (const f32x4*)xrow + lane; const f32x4* gr = (const f32x4*)g + lane;
    f32x4 v[4]; float s = 0.f;
#pragma unroll
    for (int j = 0; j < 4; ++j) { v[j] = xr[64 * j]; s += (v[j].x * v[j].x + v[j].y * v[j].y) + (v[j].z * v[j].z + v[j].w * v[j].w); }
    const float rstd = 1.0f / sqrtf(wave_sum(s) * (1.f / DM) + EPS);
    u32x2* o8 = (u32x2*)orow + lane;
#pragma unroll
    for (int j = 0; j < 4; ++j) { const f32x4 gg = gr[64 * j]; if (copy) ((f32x4*)copy + lane)[64 * j] = v[j];
        u32x2 w; w.x = cvt_pk_bf16(v[j].x * rstd * gg.x, v[j].y * rstd * gg.y); w.y = cvt_pk_bf16(v[j].z * rstd * gg.z, v[j].w * rstd * gg.w); o8[64 * j] = w; }
}

namespace pg8 {
struct EpiEvenIn {
    static constexpr bool PERM = false;
    bf16_t* Z; const float* gq; const float* gk;
    __device__ __forceinline__ void operator()(const f32x4 (&acc)[2][2][4][2], const Unit& u, int wr, int wc, int fr, int fq) const {
        const int row0 = u.pm * BM + wr * 64 + fr, pn = u.pn;
        if (pn >= 4 && pn < 8) {
            const float* g = pn < 6 ? gq : gk; const float sc = pn < 6 ? C2_B : 1.0f;
            f32x4 gv[2][2];
#pragma unroll
            for (int bj = 0; bj < 2; ++bj)
#pragma unroll
                for (int n = 0; n < 2; ++n) gv[bj][n] = *(const f32x4*)(g + 32 * bj + 16 * n + 4 * fq);
#pragma unroll
            for (int ai = 0; ai < 2; ++ai)
#pragma unroll
                for (int m = 0; m < 4; ++m) {
                    float ss = 0.f;
#pragma unroll
                    for (int bj = 0; bj < 2; ++bj)
#pragma unroll
                        for (int n = 0; n < 2; ++n) { const f32x4 v = acc[ai][bj][m][n]; ss += (v[0] * v[0] + v[1] * v[1]) + (v[2] * v[2] + v[3] * v[3]); }
                    ss += __shfl_xor(ss, 16); ss += __shfl_xor(ss, 32);
                    const float rstd = sc / sqrtf(ss * (1.0f / 64.0f) + EPS);
                    bf16_t* rowp = Z + (size_t)(row0 + ai * HALF + m * 16) * EVEN_IN + pn * BM + wc * 64 + 4 * fq;
#pragma unroll
                    for (int bj = 0; bj < 2; ++bj)
#pragma unroll
                        for (int n = 0; n < 2; ++n) { const f32x4 v = acc[ai][bj][m][n] * rstd * gv[bj][n];
                            u32x2 w; w.x = cvt_pk_bf16(v[0], v[1]); w.y = cvt_pk_bf16(v[2], v[3]); *(u32x2*)(rowp + 32 * bj + 16 * n) = w; }
                }
        } else {
            const bool act = pn < 4;
#pragma unroll
            for (int ai = 0; ai < 2; ++ai)
#pragma unroll
                for (int m = 0; m < 4; ++m) { bf16_t* rowp = Z + (size_t)(row0 + ai * HALF + m * 16) * EVEN_IN + pn * BM + wc * 32 + 4 * fq;
#pragma unroll
                    for (int bj = 0; bj < 2; ++bj)
#pragma unroll
                        for (int n = 0; n < 2; ++n) { f32x4 v = acc[ai][bj][m][n]; if (act) v = gelu4(v);
                            u32x2 w; w.x = cvt_pk_bf16(v[0], v[1]); w.y = cvt_pk_bf16(v[2], v[3]); *(u32x2*)(rowp + bj * HALF + 16 * n) = w; } }
        }
    }
};
template <bool F8 = false> struct EpiResidT {
    static constexpr bool PERM = false;
    float* out;
    __device__ __forceinline__ void operator()(const f32x4 (&acc)[2][2][4][2], const Unit& u, int wr, int wc, int fr, int fq) const {
        const int row0 = u.pm * BM + wr * 64 + fr;
#pragma unroll
        for (int ai = 0; ai < 2; ++ai)
#pragma unroll
            for (int m = 0; m < 4; ++m) { float* rowp = out + (size_t)(row0 + ai * HALF + m * 16) * DM + u.pn * BM + wc * 32 + 4 * fq;
#pragma unroll
                for (int bj = 0; bj < 2; ++bj)
#pragma unroll
                    for (int n = 0; n < 2; ++n) { f32x4* p = (f32x4*)(rowp + bj * HALF + 16 * n); *p = *p + (F8 ? acc[ai][bj][m][n] * W8_INV : acc[ai][bj][m][n]); }
                if (m & 1) asm volatile("" ::: "memory"); }
    }
};
typedef EpiResidT<false> EpiResid;
struct EpiOddIn {
    static constexpr bool PERM = false;
    bf16_t* Z; unsigned char* Z8; float* ssq;
    __device__ __forceinline__ void operator()(const f32x4 (&acc)[2][2][4][2], const Unit& u, int wr, int wc, int fr, int fq) const {
        const int row0 = u.pm * BM + wr * 64 + fr, pn = u.pn;
#pragma unroll
        for (int ai = 0; ai < 2; ++ai)
#pragma unroll
            for (int m = 0; m < 4; ++m) { const int row = row0 + ai * HALF + m * 16; bf16_t* rowp = Z + (size_t)row * ODD_INP + pn * BM + wc * 32 + 4 * fq;
                float ss = 0.f;
#pragma unroll
                for (int bj = 0; bj < 2; ++bj)
#pragma unroll
                    for (int n = 0; n < 2; ++n) { const f32x4 v = acc[ai][bj][m][n] * W8_INV; ss += (v[0] * v[0] + v[1] * v[1]) + (v[2] * v[2] + v[3] * v[3]);
                        if (pn < 3) *(unsigned*)(Z8 + (size_t)row * ODD_INP + pn * BM + wc * 32 + 4 * fq + bj * HALF + 16 * n) = pk4_fp8(v[0], v[1], v[2], v[3]);
                        else { u32x2 w; w.x = cvt_pk_bf16(v[0], v[1]); w.y = cvt_pk_bf16(v[2], v[3]); *(u32x2*)(rowp + bj * HALF + 16 * n) = w; } }
                ss += __shfl_xor(ss, 16); ss += __shfl_xor(ss, 32);
                if (fq == 0) ssq[(size_t)row * 16 + pn * 4 + wc] = ss; }
    }
};
template <int NS> struct EpiRowScale {
    static constexpr bool PERM = true;
    bf16_t* O; int ldc; const float* ssq; int s0; float inv_cols;
    __device__ __forceinline__ void operator()(const f32x4 (&acc)[2][2][4][2], const Unit& u, int wr, int wc, int fr, int fq) const {
        const int row0 = u.pm * BM + wr * 64 + fr; const int col0 = u.pn * BM + wc * 32 + 8 * fq;
#pragma unroll
        for (int ai = 0; ai < 2; ++ai)
#pragma unroll
            for (int m = 0; m < 4; ++m) { const int row = row0 + ai * HALF + m * 16;
                float ss = 0.f; const f32x4* sp = (const f32x4*)(ssq + (size_t)row * 16 + s0);
#pragma unroll
                for (int q = 0; q < NS; ++q) { const f32x4 t = sp[q]; ss += (t[0] + t[1]) + (t[2] + t[3]); }
                const float rstd = W8_INV / sqrtf(ss * inv_cols + EPS);
                bf16_t* rowp = O + (size_t)row * ldc + col0;
#pragma unroll
                for (int bj = 0; bj < 2; ++bj) { const f32x4 v0 = acc[ai][bj][m][0] * rstd, v1 = acc[ai][bj][m][1] * rstd;
                    u32x4 w; w.x = cvt_pk_bf16(v0[0], v0[1]); w.y = cvt_pk_bf16(v0[2], v0[3]); w.z = cvt_pk_bf16(v1[0], v1[1]); w.w = cvt_pk_bf16(v1[2], v1[3]);
                    *(u32x4*)(rowp + bj * HALF) = w; }
                asm volatile("" ::: "memory"); }
    }
};
__device__ __forceinline__ void store8_sc1(void* p, u32x2 v) { asm volatile("global_store_dwordx2 %0, %1, off sc1" :: "v"(p), "v"(v) : "memory"); }
template <bool WT = false> struct EpiSwigluT {
    static constexpr bool PERM = true;
    unsigned char* ACT; const float* b1p;
    __device__ __forceinline__ void operator()(const f32x4 (&acc)[2][2][4][2], const Unit& u, int wr, int wc, int fr, int fq) const {
        const int row0 = u.pm * BM + wr * 64 + fr, e = u.pb >> 3, pn = u.pn;
        const float* bp = b1p + (size_t)e * 2048 + pn * BM + wc * 32 + 8 * fq;
        f32x4 bg[2], bl[2];
#pragma unroll
        for (int n = 0; n < 2; ++n) { bg[n] = *(const f32x4*)(bp + 4 * n); bl[n] = *(const f32x4*)(bp + HALF + 4 * n); }
#pragma unroll
        for (int ai = 0; ai < 2; ++ai)
#pragma unroll
            for (int m = 0; m < 4; ++m) { unsigned char* rowp = ACT + (size_t)(row0 + ai * HALF + m * 16) * DE + pn * HALF + wc * 32 + 8 * fq;
                float a[8];
#pragma unroll
                for (int n = 0; n < 2; ++n) { const f32x4 gv = acc[ai][0][m][n] * W8_INV + bg[n], lv = acc[ai][1][m][n] * W8_INV + bl[n];
#pragma unroll
                    for (int i = 0; i < 4; ++i) { const float gl = fminf(gv[i], 7.0f), li = fminf(fmaxf(lv[i], -7.0f), 7.0f);
                        const float sg = __builtin_amdgcn_rcpf(1.0f + __builtin_amdgcn_exp2f(-1.702f * LOG2E * gl));
                        a[4 * n + i] = gl * sg * (li + 1.0f); } }
                u32x2 w; w.x = pk4_fp8(a[0], a[1], a[2], a[3]); w.y = pk4_fp8(a[4], a[5], a[6], a[7]);
                if (WT) store8_sc1(rowp, w); else *(u32x2*)rowp = w; }
    }
};
typedef EpiSwigluT<false> EpiSwiglu;
struct EpiDown {
    static constexpr bool PERM = true;
    bf16_t* Y; const float* b2;
    __device__ __forceinline__ void operator()(const f32x4 (&acc)[2][2][4][2], const Unit& u, int wr, int wc, int fr, int fq) const {
        const int row0 = u.pm * BM + wr * 64 + fr, e = u.pb >> 2, pn = u.pn;
        const float* bp = b2 + (size_t)e * DM + pn * BM + wc * 32 + 8 * fq;
        f32x4 bv[2][2];
#pragma unroll
        for (int bj = 0; bj < 2; ++bj)
#pragma unroll
            for (int n = 0; n < 2; ++n) bv[bj][n] = *(const f32x4*)(bp + bj * HALF + 4 * n);
#pragma unroll
        for (int ai = 0; ai < 2; ++ai)
#pragma unroll
            for (int m = 0; m < 4; ++m) { bf16_t* rowp = Y + (size_t)(row0 + ai * HALF + m * 16) * DM + pn * BM + wc * 32 + 8 * fq;
#pragma unroll
                for (int bj = 0; bj < 2; ++bj) { const f32x4 v0 = acc[ai][bj][m][0] * W8_INV + bv[bj][0], v1 = acc[ai][bj][m][1] * W8_INV + bv[bj][1];
                    u32x4 w; w.x = cvt_pk_bf16(v0[0], v0[1]); w.y = cvt_pk_bf16(v0[2], v0[3]); w.z = cvt_pk_bf16(v1[0], v1[1]); w.w = cvt_pk_bf16(v1[2], v1[3]);
                    *(u32x4*)(rowp + bj * HALF) = w; } }
    }
};
struct MoeOrder {
    const LAS int* tbl; int nN, G, c;
    __device__ bool next(int i, Unit& u) const {
        const long L = (long)i * G + c; const int rb = (int)(L / nN);
        if (rb >= __builtin_amdgcn_readfirstlane(tbl[32])) return false;
        int e = 0;
#pragma unroll
        for (int k = 1; k < 32; ++k) e += (tbl[k] <= rb) ? 1 : 0;
        e = __builtin_amdgcn_readfirstlane(e); const int rbl = __builtin_amdgcn_readfirstlane(rb - tbl[e]);
        u.pm = e * (ECAP / BM) + rbl; u.pn = (int)(L % nN); u.pb = e * nN + u.pn; u.kind = 0; u.rb = rb; return true;
    }
    __device__ __forceinline__ void a_ready(const Unit&) const {}
    __device__ __forceinline__ void pre_epi() const {}
    __device__ __forceinline__ void done(const Unit&) const {}
    __device__ __forceinline__ void finish() const {}
};

constexpr unsigned MOE_SPIN_CAP = 1u << 22;
struct MoeMergedOrder {
    const LAS int* tbl; int G, c; gu32* cnt;
    mutable int pend;
    __device__ __forceinline__ void flush() const {
        if (pend >= 0) { asm volatile("s_waitcnt vmcnt(0)" ::: "memory");
            if ((threadIdx.x & 63) == 0) __hip_atomic_fetch_add(cnt + 16 * pend, 1u, __ATOMIC_RELAXED, __HIP_MEMORY_SCOPE_AGENT);
            pend = -1; } }
    __device__ bool next(int i, Unit& u) const {
        const int nb = __builtin_amdgcn_readfirstlane(tbl[32]);
        long L = (long)i * G + c; int nN = 8, kind = 0;
        if (L >= (long)nb * 8) { L -= (long)nb * 8; nN = 4; kind = 1; if (L >= (long)nb * 4) return false; }
        const int rb = (int)(L / nN);
        int e = 0;
#pragma unroll
        for (int k = 1; k < 32; ++k) e += (tbl[k] <= rb) ? 1 : 0;
        e = __builtin_amdgcn_readfirstlane(e); const int rbl = __builtin_amdgcn_readfirstlane(rb - tbl[e]);
        u.pm = e * (ECAP / BM) + rbl; u.pn = (int)(L % nN); u.pb = e * nN + u.pn; u.kind = kind; u.rb = rb; return true;
    }
    __device__ __forceinline__ void a_ready(const Unit& u) const {
        if (u.kind == 1) {
            flush();
            if (threadIdx.x < 64) {
                unsigned sp = 0;
                while ((unsigned)__builtin_amdgcn_readfirstlane(__hip_atomic_load(cnt + 16 * u.rb, __ATOMIC_RELAXED, __HIP_MEMORY_SCOPE_AGENT)) < 64u) { __builtin_amdgcn_s_sleep(2); if (++sp > MOE_SPIN_CAP) break; }
                __builtin_amdgcn_fence(__ATOMIC_ACQUIRE, "agent");
                asm volatile("s_waitcnt vmcnt(0)" ::: "memory");
            }
            __builtin_amdgcn_s_barrier();
        }
    }
    __device__ __forceinline__ void pre_epi() const { flush(); }
    __device__ __forceinline__ void done(const Unit& u) const { if (u.kind == 0) pend = u.rb; }
    __device__ __forceinline__ void finish() const { flush(); }
};
struct EpiMoe {
    static constexpr bool PERM = true;
    EpiSwigluT<true> up; EpiDown down;
    __device__ __forceinline__ void operator()(const f32x4 (&acc)[2][2][4][2], const Unit& u, int wr, int wc, int fr, int fq) const {
        if (u.kind == 0) up(acc, u, wr, wc, fr, fq); else down(acc, u, wr, wc, fr, fq);
    }
};
}

__device__ __forceinline__ void gmlp_unit(Frame& F, const bf16_t* Z, bf16_t* MIX, const float* Ws, const float* bs, const float* gv, int unit) {
    constexpr int VP = 272;
    LAS unsigned char* VT = F.lds + RING_OFF;
    const int h = unit & 3, chunk = unit >> 2;
    int tid_ = threadIdx.x; asm volatile("" : "+v"(tid_));
    const int t0 = chunk * 128, tid = tid_, lane = tid & 63, w = __builtin_amdgcn_readfirstlane(tid >> 6);
    {
        const int s = tid >> 2, dq = (tid & 3) * 32;
        const bf16_t* vp = Z + (size_t)(t0 + s) * EVEN_IN + 512 + h * 128 + dq;
        u32x4 raw[4]; float ss = 0.f;
#pragma unroll
        for (int i = 0; i < 4; ++i) { raw[i] = *(const u32x4*)(vp + 8 * i);
#pragma unroll
            for (int j = 0; j < 4; ++j) { const float a = bflo(raw[i][j]), b = bfhi(raw[i][j]); ss += a * a + b * b; } }
        ss += __shfl_xor(ss, 1); ss += __shfl_xor(ss, 2);
        const float rstd = 1.0f / sqrtf(ss * (1.0f / 128.0f) + EPS);
#pragma unroll
        for (int i = 0; i < 4; ++i)
#pragma unroll
            for (int j = 0; j < 4; ++j) { const int d = dq + 8 * i + 2 * j;
                *(LAS bf16_t*)(VT + (d) * VP + s * 2) = f2bf(bflo(raw[i][j]) * rstd);
                *(LAS bf16_t*)(VT + (d + 1) * VP + s * 2) = f2bf(bfhi(raw[i][j]) * rstd); }
    }
    __syncthreads();
    const int fr = lane & 15, fq = lane >> 4;
    f32x4 acc[8];
#pragma unroll
    for (int nb = 0; nb < 8; ++nb) acc[nb] = (f32x4){0.f, 0.f, 0.f, 0.f};
    const int trow = 16 * w + fr;
    const float* wrow = Ws + ((size_t)h * 128 + trow) * 128;
#pragma unroll
    for (int ks = 0; ks < 4; ++ks) {
        if (32 * ks <= 16 * w + 15) {
            const int s0 = 32 * ks + 8 * fq;
            const f32x4 wa = *(const f32x4*)(wrow + s0), wb = *(const f32x4*)(wrow + s0 + 4);
            float wv[8] = {wa[0], wa[1], wa[2], wa[3], wb[0], wb[1], wb[2], wb[3]};
#pragma unroll
            for (int j = 0; j < 8; ++j) if (s0 + j > trow) wv[j] = 0.f;
            u32x4 aw; aw.x = cvt_pk_bf16(wv[0], wv[1]); aw.y = cvt_pk_bf16(wv[2], wv[3]); aw.z = cvt_pk_bf16(wv[4], wv[5]); aw.w = cvt_pk_bf16(wv[6], wv[7]);
            const bf16x8 af = __builtin_bit_cast(bf16x8, aw);
#pragma unroll
            for (int nb = 0; nb < 8; ++nb) { const bf16x8 bfr = *(const LAS bf16x8*)(VT + (16 * nb + fr) * VP + s0 * 2);
                acc[nb] = __builtin_amdgcn_mfma_f32_16x16x32_bf16(af, bfr, acc[nb], 0, 0, 0); }
        }
    }
    LAS bf16_t* DT = (LAS bf16_t*)(F.lds + RING_OFF + 36864);
#pragma unroll
    for (int i = 0; i < 4; ++i) { const int tl = 16 * w + 4 * fq + i; const float bt = bs[h * 128 + tl];
#pragma unroll
        for (int nb = 0; nb < 8; ++nb) DT[tl * 136 + 16 * nb + fr] = f2bf(gv[h * 128 + 16 * nb + fr] * acc[nb][i] + bt); }
    __syncthreads();
#pragma unroll
    for (int k = 0; k < 4; ++k) { const int idx = tid + 512 * k, tl = idx >> 4, c8 = (idx & 15) * 8;
        const u32x4 mv = *(const LAS u32x4*)(DT + tl * 136 + c8); const u32x4 uv = *(const u32x4*)(Z + (size_t)(t0 + tl) * EVEN_IN + h * 128 + c8);
        u32x4 o; o.x = cvt_pk_bf16(bflo(uv.x) * bflo(mv.x), bfhi(uv.x) * bfhi(mv.x)); o.y = cvt_pk_bf16(bflo(uv.y) * bflo(mv.y), bfhi(uv.y) * bfhi(mv.y));
        o.z = cvt_pk_bf16(bflo(uv.z) * bflo(mv.z), bfhi(uv.z) * bfhi(mv.z)); o.w = cvt_pk_bf16(bflo(uv.w) * bflo(mv.w), bfhi(uv.w) * bfhi(mv.w));
        *(u32x4*)(MIX + (size_t)(t0 + tl) * DM + h * 128 + c8) = o; }
    __syncthreads();
}

__device__ __forceinline__ void router_phase(Frame& F, const float* x, const float* gain, const float* Wr, const float* br, gu32* cnt  ,
                                             unsigned* tok_er, float* tok_g, unsigned char* XG) {
    LAS float* part = (LAS float*)(F.lds + RING_OFF);
    LAS float* ssqp = (LAS float*)(F.lds + RING_OFF + 8 * 64 * 33 * 4);
    LAS float* lg = (LAS float*)(F.lds + SCR_OFF);
    LAS unsigned* hist = (LAS unsigned*)(F.lds + SCR_OFF + 64 * 33 * 4);
    LAS unsigned* base = hist + 32;
    LAS unsigned* ers = base + 32;
    int tid_ = threadIdx.x; asm volatile("" : "+v"(tid_));
    const int tid = tid_, lane = tid & 63, w = __builtin_amdgcn_readfirstlane(tid >> 6), r32 = lane & 31, hi = lane >> 5;
#ifndef RTR_REP_A
#define RTR_REP_A 1
#define RTR_REP_B 1
#define RTR_REP_C 1
#endif
    f32x4 gg[4];
#pragma unroll
    for (int j = 0; j < 4; ++j) gg[j] = ((const f32x4*)gain + lane)[64 * j];
    {   const int tg = F.vcu;
    const int tokb = tg * 64;
    if (tid < 32) hist[tid] = 0u;
    for (int rb_ = 0; rb_ < RTR_REP_B; ++rb_) {
        bf16x8 wh[8], wl[8];
#pragma unroll
        for (int ks = 0; ks < 8; ++ks) { float wv[8];
#pragma unroll
            for (int j = 0; j < 8; ++j) { const int k = 128 * w + 16 * ks + 8 * hi + j; wv[j] = Wr[(size_t)k * NE + r32] * gain[k]; }
            u32x4 h4, l4;
#pragma unroll
            for (int j = 0; j < 4; ++j) { const unsigned hp = cvt_pk_bf16(wv[2 * j], wv[2 * j + 1]); h4[j] = hp; l4[j] = cvt_pk_bf16(wv[2 * j] - bflo(hp), wv[2 * j + 1] - bfhi(hp)); }
            wh[ks] = __builtin_bit_cast(bf16x8, h4); wl[ks] = __builtin_bit_cast(bf16x8, l4); }
#pragma unroll
        for (int g2 = 0; g2 < 2; ++g2) {
            const float* xr = x + (size_t)(tokb + 32 * g2 + r32) * DM + 128 * w + 8 * hi;
            f32x16 d = f32x16{}; float ss = 0.f;
#pragma unroll
            for (int ks = 0; ks < 8; ++ks) { const f32x4 xa = *(const f32x4*)(xr + 16 * ks), xb = *(const f32x4*)(xr + 16 * ks + 4);
                ss += (xa.x * xa.x + xa.y * xa.y) + (xa.z * xa.z + xa.w * xa.w) + (xb.x * xb.x + xb.y * xb.y) + (xb.z * xb.z + xb.w * xb.w);
                u32x4 h4, l4;
                h4.x = cvt_pk_bf16(xa.x, xa.y); h4.y = cvt_pk_bf16(xa.z, xa.w); h4.z = cvt_pk_bf16(xb.x, xb.y); h4.w = cvt_pk_bf16(xb.z, xb.w);
                l4.x = cvt_pk_bf16(xa.x - bflo(h4.x), xa.y - bfhi(h4.x)); l4.y = cvt_pk_bf16(xa.z - bflo(h4.y), xa.w - bfhi(h4.y));
                l4.z = cvt_pk_bf16(xb.x - bflo(h4.z), xb.y - bfhi(h4.z)); l4.w = cvt_pk_bf16(xb.z - bflo(h4.w), xb.w - bfhi(h4.w));
                const bf16x8 xh = __builtin_bit_cast(bf16x8, h4), xl = __builtin_bit_cast(bf16x8, l4);
                d = __builtin_amdgcn_mfma_f32_32x32x16_bf16(wh[ks], xh, d, 0, 0, 0);
                d = __builtin_amdgcn_mfma_f32_32x32x16_bf16(wh[ks], xl, d, 0, 0, 0);
                d = __builtin_amdgcn_mfma_f32_32x32x16_bf16(wl[ks], xh, d, 0, 0, 0); }
            { auto rr = __builtin_amdgcn_permlane32_swap(__float_as_uint(ss), __float_as_uint(ss), false, false); ss = __uint_as_float(rr[0]) + __uint_as_float(rr[1]); }
            if (hi == 0) ssqp[w * 64 + 32 * g2 + r32] = ss;
#pragma unroll
            for (int r = 0; r < 16; ++r) part[(w * 64 + 32 * g2 + r32) * 33 + (r & 3) + 8 * (r >> 2) + 4 * hi] = d[r];
        }
    }
    __syncthreads();
    {   const int t = tid >> 3, q4 = (tid & 7) * 4; float s = 0.f;
#pragma unroll
        for (int ww = 0; ww < 8; ++ww) s += ssqp[ww * 64 + t];
        const float rstd = 1.0f / sqrtf(s * (1.f / DM) + EPS);
#pragma unroll
        for (int i = 0; i < 4; ++i) { float a = 0.f;
#pragma unroll
            for (int ww = 0; ww < 8; ++ww) a += part[(ww * 64 + t) * 33 + q4 + i];
            lg[t * 33 + q4 + i] = a * rstd + br[q4 + i]; } }
    __syncthreads();
    unsigned my_e[4] = {0, 0, 0, 0}, my_lr[4] = {0, 0, 0, 0}; float my_g[4] = {0, 0, 0, 0};
    if (tid < 64) {
        float v[32];
#pragma unroll
        for (int e = 0; e < 32; ++e) v[e] = lg[tid * 33 + e];
        int c0 = -1, c1 = -1, c2 = -1; float tv[4];
#pragma unroll
        for (int r = 0; r < 4; ++r) { float best = -__builtin_inff(); int bi = 0;
#pragma unroll
            for (int e = 0; e < 32; ++e) { const bool ok = (e != c0) && (e != c1) && (e != c2); if (ok && v[e] > best) { best = v[e]; bi = e; } }
            tv[r] = best; my_e[r] = (unsigned)bi; if (r == 0) c0 = bi; else if (r == 1) c1 = bi; else if (r == 2) c2 = bi; }
        const float p1 = __expf(tv[1] - tv[0]), p2 = __expf(tv[2] - tv[0]), p3 = __expf(tv[3] - tv[0]); const float inv = 1.0f / (1.0f + p1 + p2 + p3);
        my_g[0] = inv; my_g[1] = p1 * inv; my_g[2] = p2 * inv; my_g[3] = p3 * inv;
#pragma unroll
        for (int r = 0; r < 4; ++r) my_lr[r] = __hip_atomic_fetch_add(hist + my_e[r], 1u, __ATOMIC_RELAXED, __HIP_MEMORY_SCOPE_WORKGROUP);
    }
    __syncthreads();
    if (tid < 32) { const unsigned hc = hist[tid]; base[tid] = hc ? __hip_atomic_fetch_add(cnt + 64 * tid, hc, RLX_AGENT) : 0u; }
    __syncthreads();
    if (tid < 64) {
        u32x4 er; f32x4 gt;
#pragma unroll
        for (int r = 0; r < 4; ++r) { const unsigned rank = base[my_e[r]] + my_lr[r]; er[r] = (my_e[r] << 16) | rank; gt[r] = my_g[r]; ers[tid * 4 + r] = er[r]; }
        *(u32x4*)(tok_er + (size_t)(tokb + tid) * 4) = er; *(f32x4*)(tok_g + (size_t)(tokb + tid) * 4) = gt;
    }
    __syncthreads();
    for (int rc_ = 0; rc_ < RTR_REP_C; ++rc_)
#pragma unroll 2
    for (int tt = 0; tt < 8; ++tt) {
        const int tl = w * 8 + tt; const float* xrow = x + (size_t)(tokb + tl) * DM;
        f32x4 hv[4]; float s = 0.f;
#pragma unroll
        for (int j = 0; j < 4; ++j) { hv[j] = ((const f32x4*)xrow + lane)[64 * j]; s += (hv[j].x * hv[j].x + hv[j].y * hv[j].y) + (hv[j].z * hv[j].z + hv[j].w * hv[j].w); }
        const float rstd = 1.0f / sqrtf(wave_sum(s) * (1.f / DM) + EPS);
        unsigned wv[4];
#pragma unroll
        for (int j = 0; j < 4; ++j) { const f32x4 t = hv[j] * rstd * gg[j]; wv[j] = pk4_fp8(t.x, t.y, t.z, t.w); }
#pragma unroll
        for (int r = 0; r < 4; ++r) { const unsigned er = ers[tl * 4 + r]; const size_t slot = (size_t)(er >> 16) * ECAP + (er & 0xffffu);
            unsigned* o4 = (unsigned*)(XG + slot * DM) + lane;
#pragma unroll
            for (int j = 0; j < 4; ++j) o4[64 * j] = wv[j]; }
    }
    __syncthreads();
    }
}

__device__ __forceinline__ void combine_phase(Frame& F, const float* x, float* xout, const unsigned* tok_er, const float* tok_g, const bf16_t* Y, const float* g_next, unsigned char* XN, bool xn_fp8) {
    int tid_ = threadIdx.x; asm volatile("" : "+v"(tid_));
    const int gw = F.vcu * NWAVES + __builtin_amdgcn_readfirstlane(tid_ >> 6), NGW = F.G * NWAVES, lane = tid_ & 63;
    for (int m = gw; m < M; m += NGW) {
        const u32x4 er = *(const u32x4*)(tok_er + (size_t)m * 4); const f32x4 gt = *(const f32x4*)(tok_g + (size_t)m * 4);
        f32x4 v[4]; const float* xrow = x + (size_t)m * DM; float* xorow = xout + (size_t)m * DM;
#pragma unroll
        for (int j = 0; j < 4; ++j) v[j] = ((const f32x4*)xrow + lane)[64 * j];
#pragma unroll
        for (int r = 0; r < 4; ++r) { const size_t slot = (size_t)(er[r] >> 16) * ECAP + (er[r] & 0xffffu); const u32x2* yp = (const u32x2*)(Y + slot * DM) + lane; const float g = gt[r];
#pragma unroll
            for (int j = 0; j < 4; ++j) { const u32x2 yv = yp[64 * j]; v[j].x += g * bflo(yv.x); v[j].y += g * bfhi(yv.x); v[j].z += g * bflo(yv.y); v[j].w += g * bfhi(yv.y); } }
#pragma unroll
        for (int j = 0; j < 4; ++j) ((f32x4*)xorow + lane)[64 * j] = v[j];
        if (g_next) {
            float s = 0.f;
#pragma unroll
            for (int j = 0; j < 4; ++j) s += (v[j].x * v[j].x + v[j].y * v[j].y) + (v[j].z * v[j].z + v[j].w * v[j].w);
            const float rstd = 1.0f / sqrtf(wave_sum(s) * (1.f / DM) + EPS);
            unsigned* o4 = (unsigned*)(XN + (size_t)m * DM) + lane; u32x2* o8 = (u32x2*)(XN + (size_t)m * DM * 2) + lane;
#pragma unroll
            for (int j = 0; j < 4; ++j) { const f32x4 gg = ((const f32x4*)g_next + lane)[64 * j];
                if (xn_fp8) o4[64 * j] = pk4_fp8(v[j].x * rstd * gg.x, v[j].y * rstd * gg.y, v[j].z * rstd * gg.z, v[j].w * rstd * gg.w);
                else { u32x2 w; w.x = cvt_pk_bf16(v[j].x * rstd * gg.x, v[j].y * rstd * gg.y); w.y = cvt_pk_bf16(v[j].z * rstd * gg.z, v[j].w * rstd * gg.w); o8[64 * j] = w; } }
        }
    }
}

__device__ __forceinline__ void unpack8(const u32x4 w, float (&f)[8]) { f[0] = bflo(w.x); f[1] = bfhi(w.x); f[2] = bflo(w.y); f[3] = bfhi(w.y); f[4] = bflo(w.z); f[5] = bfhi(w.z); f[6] = bflo(w.w); f[7] = bfhi(w.w); }
__device__ __forceinline__ void unpack4(const u32x2 w, float (&f)[4]) { f[0] = bflo(w.x); f[1] = bfhi(w.x); f[2] = bflo(w.y); f[3] = bfhi(w.y); }
__device__ __forceinline__ void fin_head(const u32x4 n0, const u32x4 n1, const u32x2 r1, const u32x2 r2, const float (&g)[24], const float (&cs)[4], const float (&sn)[4], unsigned char* op, int j) {
    float a[8], b[8], x1[4], x2[4];
    unpack8(n0, a); unpack8(n1, b); unpack4(r1, x1); unpack4(r2, x2);
    float ss = 0.f;
#pragma unroll
    for (int i = 0; i < 8; ++i) ss += a[i] * a[i] + b[i] * b[i];
#pragma unroll
    for (int i = 0; i < 4; ++i) ss += x1[i] * x1[i] + x2[i] * x2[i];
    ss += __shfl_xor(ss, 1); ss += __shfl_xor(ss, 2); ss += __shfl_xor(ss, 4);
    const float rstd = 1.0f / sqrtf(ss * (1.0f / 192.0f) + EPS);
    u32x4 o0;
    o0.x = pk4_fp8(a[0] * rstd * g[0], a[1] * rstd * g[1], a[2] * rstd * g[2], a[3] * rstd * g[3]); o0.y = pk4_fp8(a[4] * rstd * g[4], a[5] * rstd * g[5], a[6] * rstd * g[6], a[7] * rstd * g[7]);
    o0.z = pk4_fp8(b[0] * rstd * g[8], b[1] * rstd * g[9], b[2] * rstd * g[10], b[3] * rstd * g[11]); o0.w = pk4_fp8(b[4] * rstd * g[12], b[5] * rstd * g[13], b[6] * rstd * g[14], b[7] * rstd * g[15]);
    float y1[4], y2[4];
#pragma unroll
    for (int i = 0; i < 4; ++i) { const float u = x1[i] * rstd * g[16 + i], v = x2[i] * rstd * g[20 + i]; y1[i] = u * cs[i] - v * sn[i]; y2[i] = u * sn[i] + v * cs[i]; }
    *(u32x4*)(op + 16 * j) = o0; *(unsigned*)(op + 128 + 4 * j) = pk4_fp8(y1[0], y1[1], y1[2], y1[3]); *(unsigned*)(op + 160 + 4 * j) = pk4_fp8(y2[0], y2[1], y2[2], y2[3]);
}
__device__ __forceinline__ void mla_finalize_phase(Frame& F, const bf16_t* QR, const bf16_t* KVR, const bf16_t* Z, const float* gq, const float* gk, unsigned char* QF, unsigned char* KF) {
    int tid_ = threadIdx.x; asm volatile("" : "+v"(tid_));
    const int gw = F.vcu * NWAVES + __builtin_amdgcn_readfirstlane(tid_ >> 6), NGW = F.G * NWAVES, lane = tid_ & 63;
    const int h = lane >> 3, j = lane & 7;
    float gqv[24], gkv[24], invf[4];
#pragma unroll
    for (int i = 0; i < 16; ++i) { gqv[i] = gq[16 * j + i]; gkv[i] = gk[16 * j + i]; }
#pragma unroll
    for (int i = 0; i < 4; ++i) { gqv[16 + i] = gq[128 + 4 * j + i]; gqv[20 + i] = gq[160 + 4 * j + i]; gkv[16 + i] = gk[128 + 4 * j + i]; gkv[20 + i] = gk[160 + 4 * j + i];
        invf[i] = __builtin_amdgcn_exp2f(-(float)(4 * j + i) * (13.287712379549449f / 32.0f)); }
#pragma unroll 2
    for (int m = gw; m < M; m += NGW) {
        const int pos = m & (SEQ - 1);
        float cs[4], sn[4];
#pragma unroll
        for (int i = 0; i < 4; ++i) { const double rev = (double)pos * (double)invf[i] * 0.15915494309189535; const float fr = (float)(rev - __builtin_rint(rev));
            sn[i] = __builtin_amdgcn_sinf(fr); cs[i] = __builtin_amdgcn_cosf(fr); }
        const bf16_t* qp = QR + (size_t)m * 1536 + h * 192; const bf16_t* kp = KVR + (size_t)m * 2048 + h * 256; const bf16_t* zp = Z + (size_t)m * ODD_INP + 768;
        const u32x4 qn0 = *(const u32x4*)(qp + 16 * j), qn1 = *(const u32x4*)(qp + 16 * j + 8); const u32x2 qr1 = *(const u32x2*)(qp + 128 + 4 * j), qr2 = *(const u32x2*)(qp + 160 + 4 * j);
        const u32x4 kn0 = *(const u32x4*)(kp + 16 * j), kn1 = *(const u32x4*)(kp + 16 * j + 8); const u32x2 kr1 = *(const u32x2*)(zp + 4 * j), kr2 = *(const u32x2*)(zp + 32 + 4 * j);
        fin_head(qn0, qn1, qr1, qr2, gqv, cs, sn, QF + (size_t)m * 1536 + h * 192, j);
        fin_head(kn0, kn1, kr1, kr2, gkv, cs, sn, KF + (size_t)m * 1536 + h * 192, j);
    }
}

__device__ __forceinline__ void vt_phase(Frame& F, const bf16_t* KVR, unsigned char* VT8) {
    int tid_ = threadIdx.x; asm volatile("" : "+v"(tid_));
    const int tid = tid_;
    LAS unsigned char* T = F.lds + RING_OFF;
    for (int it = F.vcu; it < M / 64; it += F.G) {
        const int m0 = it * 64, b = m0 / SEQ, tok0 = m0 % SEQ;
#pragma unroll 4
        for (int k = 0; k < 16; ++k) { const int idx = tid + 512 * k, tok = idx >> 7, grp = idx & 127, h = grp >> 4, d8 = (grp & 15) * 8;
            const u32x4 w = *(const u32x4*)(KVR + (size_t)(m0 + tok) * 2048 + h * 256 + 128 + d8);
            const unsigned lo = pk4_fp8(bflo(w.x), bfhi(w.x), bflo(w.y), bfhi(w.y)), hi = pk4_fp8(bflo(w.z), bfhi(w.z), bflo(w.w), bfhi(w.w));
            LAS unsigned char* tp = T + (h * 128 + d8) * 80 + tok;
            tp[0] = (unsigned char)lo; tp[80] = (unsigned char)(lo >> 8); tp[160] = (unsigned char)(lo >> 16); tp[240] = (unsigned char)(lo >> 24);
            tp[320] = (unsigned char)hi; tp[400] = (unsigned char)(hi >> 8); tp[480] = (unsigned char)(hi >> 16); tp[560] = (unsigned char)(hi >> 24); }
        __syncthreads();
#pragma unroll 4
        for (int k = 0; k < 8; ++k) { const int idx = tid + 512 * k, row = idx >> 2, q = idx & 3;
            const u32x4 v = *(const LAS u32x4*)(T + row * 80 + 16 * q);
            *(u32x4*)(VT8 + ((size_t)b * 1024 + row) * SEQ + tok0 + 16 * q) = v; }
        __syncthreads();
    }
}

#ifndef PHMASK
#define PHMASK 0xFFFF
#endif
#ifndef REPMASK
#define REPMASK 0
#endif
#ifndef REPCNT
#define REPCNT 3
#endif
#define NREP(k) ((((REPMASK) >> (k)) & 1) ? (REPCNT) : 1)

#define LAUNDER_S(x) asm volatile("" : "+s"(x))
__device__ __forceinline__ const float* in_ptr(const Args& a, int i) { LAUNDER_S(i); return a.in[i]; }
#define PHASE_BEGIN() unsigned wso_ = 0u; LAUNDER_S(wso_); unsigned char* ws = args.ws + wso_; Frame Fp = F; Fp.vcu = __builtin_amdgcn_readfirstlane(Fp.vcu); Fp.G = __builtin_amdgcn_readfirstlane(Fp.G); LAUNDER_S(Fp.vcu); LAUNDER_S(Fp.G); \
    int bx_ = __builtin_amdgcn_readfirstlane((int)blockIdx.x); LAUNDER_S(bx_); (void)bx_; (void)ws
#define XN  ((unsigned char*)(ws + WS_XN))
#define Z   ((bf16_t*)(ws + WS_Z))
#define MIX ((bf16_t*)(ws + WS_MIX))
#define QR  ((bf16_t*)(ws + WS_QR))
#define KVR ((bf16_t*)(ws + WS_KVR))
#define QF  ((unsigned char*)(ws + WS_QF))
#define KF  ((unsigned char*)(ws + WS_KF))
#define XG  ((unsigned char*)(ws + WS_XG))
#define ACT ((unsigned char*)(ws + WS_ACT))
#define YB  ((bf16_t*)(ws + WS_Y))
#define SSQ ((float*)(ws + WS_SSQ))
#define TOKER ((unsigned*)(ws + WS_TOKER))
#define TOKG ((float*)(ws + WS_TOKG))
#define B1P ((float*)(ws + WS_B1P))
#define IN(i) in_ptr(args, (i))
__global__ void __launch_bounds__(NWAVES * 64, 2) trunk_fwd(Args args) {
    extern __shared__ __attribute__((aligned(16))) unsigned char lds_raw[];
    Frame F;
    F.lds = (LAS unsigned char*)lds_raw;
    F.G = gridDim.x; { const int bx = blockIdx.x; F.vcu = (F.G % 8 == 0) ? (bx % 8) * (F.G / 8) + bx / 8 : bx; }
    for (int u = threadIdx.x; u < (SCR_OFF - LDSCTL_OFF) / 4; u += NWAVES * 64) ((LAS unsigned*)(F.lds + LDSCTL_OFF))[u] = 0u;
    __syncthreads();
    (void)xcd_barrier_post((unsigned*)((gu32*)(args.ws + WS_CTL) + CW_BAR), (volatile LAS unsigned*)(F.lds + MISC_OFF) + 8);
#define GRID_BAR() do { unsigned wsb_ = 0u; LAUNDER_S(wsb_); XcdBarrier bar_; bar_.bar = (unsigned*)((gu32*)(args.ws + wsb_ + WS_CTL) + CW_BAR); bar_.x = xb_xcc_id(); \
        bar_.st = (volatile LAS unsigned*)(F.lds + MISC_OFF) + 8; xcd_barrier(bar_); } while (0)
    float* const X = args.out;
    const int stage_limit = args.stage_limit;

#if (PHMASK >> 0) & 1
            _Pragma("unroll") for (int rep_ = 0; rep_ < NREP(0); ++rep_) { if (rep_) GRID_BAR();
    {   PHASE_BEGIN(); const int ptid = threadIdx.x, gw = Fp.vcu * NWAVES + __builtin_amdgcn_readfirstlane(ptid >> 6), NGW = Fp.G * NWAVES;
        transpose_job<1>(Fp, IN(I_EWIN), DM, EVEN_IN, 2, (size_t)DM * EVEN_IN, (bf16_t*)(ws + WS_WEIN), (size_t)EVEN_IN * DM, nullptr, 0);
        transpose_job<0>(Fp, IN(I_EWOUT), DM, DM, 2, (size_t)DM * DM, (bf16_t*)(ws + WS_WEOUT), (size_t)DM * DM, nullptr, 0);
        transpose_job_fp8<0>(Fp, IN(I_OWIN), DM, ODD_IN, 2, (size_t)DM * ODD_IN, ws + WS_WOIN, (size_t)ODD_INP * DM);
        transpose_job_fp8<0>(Fp, IN(I_OWUQ), 512, 1536, 2, (size_t)512 * 1536, ws + WS_WUQ, (size_t)1536 * 512, IN(I_OGCQ), 512);
        transpose_job_fp8<0>(Fp, IN(I_OWUKV), 256, 2048, 2, (size_t)256 * 2048, ws + WS_WUKV, (size_t)2048 * 256, IN(I_OGCKV), 256);
        transpose_job_fp8<0>(Fp, IN(I_OWOUT), DM, DM, 2, (size_t)DM * DM, ws + WS_WOOUT, (size_t)DM * DM);
        transpose_job_fp8<2>(Fp, IN(I_W1), DM, 2 * DE, DEPTH * NE, (size_t)DM * 2 * DE, ws + WS_W1, (size_t)2 * DE * DM);
        transpose_job_fp8<0>(Fp, IN(I_W2), DE, DM, DEPTH * NE, (size_t)DE * DM, ws + WS_W2, (size_t)DM * DE);
        for (int i = bx_ * 512 + ptid; i < 2 * 12288; i += Fp.G * 512) { const int mi = i / 12288, r = i % 12288;
            *(u32x4*)(ws + WS_WOIN + (size_t)mi * ODD_INP * DM + (size_t)ODD_IN * DM + (size_t)r * 16) = (u32x4){0u, 0u, 0u, 0u}; }
        for (int i = bx_ * 512 + ptid; i < DEPTH * NE * 2048; i += Fp.G * 512) { const int c = i & 2047, o = 2 * (128 * (c >> 8) + (c & 127)) + ((c >> 7) & 1);
            B1P[i] = IN(I_B1)[(size_t)(i & ~2047) + o]; }
        for (int m = gw; m < M; m += NGW) rms_row_to_bf16(ptid & 63, IN(I_X) + (size_t)m * DM, IN(I_MIXN), (bf16_t*)XN + (size_t)m * DM, X + (size_t)m * DM);
    }
            }
#endif
    GRID_BAR();

#ifdef EXTRA_BARS
    for (int xb_ = 0; xb_ < EXTRA_BARS; ++xb_) GRID_BAR();
#endif
    for (int l = 0; l < DEPTH; ++l) {
        const int li = l >> 1;
        if (2 * l + 1 > stage_limit) break;
        if ((l & 1) == 0) {
#if (PHMASK >> 1) & 1
            _Pragma("unroll") for (int rep_ = 0; rep_ < NREP(1); ++rep_) { if (rep_) GRID_BAR();
            {   PHASE_BEGIN(); pg8::Gemm g{(const bf16_t*)XN, (const bf16_t*)(ws + WS_WEIN) + (size_t)li * EVEN_IN * DM, DM, DM, nullptr, nullptr}; pg8::StaticOrder S; S.init(M, EVEN_IN, Fp.G, bx_);
                pg8::EpiEvenIn E{Z, IN(I_EGQ) + li * 64, IN(I_EGK) + li * 64};
                pg8::gemm_phase<pg8::EpiEvenIn, pg8::StaticOrder>(Fp.lds + RING_OFF, g, S, E); }
            }
#endif
            GRID_BAR();
            {   PHASE_BEGIN();
#if (PHMASK >> 2) & 1
            _Pragma("unroll") for (int rep_ = 0; rep_ < NREP(2); ++rep_) { if (rep_) GRID_BAR();
                for (int u = Fp.vcu; u < 512; u += Fp.G)
                    gmlp_unit(Fp, Z, MIX, IN(I_EWS) + (size_t)li * 4 * 128 * 128, IN(I_EBS) + li * 512, IN(I_EGV) + li * 512, u);
            }
#endif
#if (PHMASK >> 3) & 1
            _Pragma("unroll") for (int rep_ = 0; rep_ < NREP(3); ++rep_) { if (rep_) GRID_BAR();
                for (int u = Fp.vcu; u < 256; u += Fp.G) { const int bh = u >> 4, s = u & 15, b = bh >> 3, h = bh & 7;
                    for (int pass = 0; pass < 2; ++pass) { const int qb = pass ? 31 - s : s;
                        const bf16_t* zb = Z + (size_t)b * SEQ * EVEN_IN;
                        dil::unit(zb + 1024 + 64 * h, zb + 1536 + 64 * h, zb + 2048 + 64 * h, EVEN_IN, MIX + (size_t)b * SEQ * DM + 512 + 64 * h, DM, qb * 256, Fp.lds + RING_OFF, (LAS float*)(Fp.lds + SCR_OFF)); } }
            }
#endif
            }
            GRID_BAR();
#if (PHMASK >> 4) & 1
            _Pragma("unroll") for (int rep_ = 0; rep_ < NREP(4); ++rep_) { if (rep_) GRID_BAR();
            {   PHASE_BEGIN(); pg8::Gemm g{MIX, (const bf16_t*)(ws + WS_WEOUT) + (size_t)li * DM * DM, DM, DM, nullptr, nullptr}; pg8::StaticOrder S; S.init(M, DM, Fp.G, bx_);
                pg8::EpiResid E{X};
                pg8::gemm_phase<pg8::EpiResid, pg8::StaticOrder>(Fp.lds + RING_OFF, g, S, E); }
            }
#endif
            GRID_BAR();
        } else {
#if (PHMASK >> 5) & 1
            _Pragma("unroll") for (int rep_ = 0; rep_ < NREP(5); ++rep_) { if (rep_) GRID_BAR();
            {   PHASE_BEGIN(); pg8::Gemm g{(const bf16_t*)XN, (const bf16_t*)(ws + WS_WOIN + (size_t)li * ODD_INP * DM), DM / 2, DM / 2, nullptr, nullptr}; pg8::StaticOrder S; S.init(M, ODD_INP, Fp.G, bx_);
                pg8::EpiOddIn E{Z, ws + WS_Z8, SSQ};
                pg8::gemm_phase<pg8::EpiOddIn, pg8::StaticOrder, true>(Fp.lds + RING_OFF, g, S, E); }
            }
#endif
            GRID_BAR();
#if (PHMASK >> 6) & 1
            _Pragma("unroll") for (int rep_ = 0; rep_ < NREP(6); ++rep_) { if (rep_) GRID_BAR();
            {   PHASE_BEGIN(); pg8::Gemm g{(const bf16_t*)(ws + WS_Z8 + 512), (const bf16_t*)(ws + WS_WUKV + (size_t)li * 2048 * 256), ODD_INP / 2, 128, nullptr, nullptr}; pg8::StaticOrder S; S.init(M, 2048, Fp.G, bx_);
                pg8::EpiRowScale<1> E{KVR, 2048, SSQ, 8, 1.0f / 256.0f};
                pg8::gemm_phase<pg8::EpiRowScale<1>, pg8::StaticOrder, true>(Fp.lds + RING_OFF, g, S, E); }
            {   PHASE_BEGIN(); pg8::Gemm g{(const bf16_t*)(ws + WS_Z8), (const bf16_t*)(ws + WS_WUQ + (size_t)li * 1536 * 512), ODD_INP / 2, 256, nullptr, nullptr}; pg8::StaticOrder S; S.init(M, 1536, Fp.G, bx_);
                pg8::EpiRowScale<2> E{QR, 1536, SSQ, 0, 1.0f / 512.0f};
                pg8::gemm_phase<pg8::EpiRowScale<2>, pg8::StaticOrder, true>(Fp.lds + RING_OFF, g, S, E); }
            }
#endif
            GRID_BAR();
#if (PHMASK >> 7) & 1
            _Pragma("unroll") for (int rep_ = 0; rep_ < NREP(7); ++rep_) { if (rep_) GRID_BAR();
            {   PHASE_BEGIN(); mla_finalize_phase(Fp, QR, KVR, Z, IN(I_OGQ) + li * 192, IN(I_OGK) + li * 192, QF, KF); vt_phase(Fp, KVR, ws + WS_VT); }
            }
#endif
            GRID_BAR();
#if (PHMASK >> 8) & 1
            _Pragma("unroll") for (int rep_ = 0; rep_ < NREP(8); ++rep_) { if (rep_) GRID_BAR();
            {   PHASE_BEGIN();
                for (int u = Fp.vcu; u < 256; u += Fp.G) { const int bh = u >> 4, s = u & 15, b = bh >> 3, h = bh & 7;
                    for (int pass = 0; pass < 2; ++pass) { const int qb = pass ? 31 - s : s;
                        mla::unit(QF + (size_t)b * SEQ * 1536 + 192 * h, KF + (size_t)b * SEQ * 1536 + 192 * h, 1536, ws + WS_VT + ((size_t)(b * 8 + h) * 128) * SEQ,
                                  ws + WS_MIX8 + (size_t)b * SEQ * DM + 128 * h, DM, qb * 256, Fp.lds + RING_OFF); } }
            }
            }
#endif
            GRID_BAR();
#if (PHMASK >> 9) & 1
            _Pragma("unroll") for (int rep_ = 0; rep_ < NREP(9); ++rep_) { if (rep_) GRID_BAR();
            {   PHASE_BEGIN(); pg8::Gemm g{(const bf16_t*)(ws + WS_MIX8), (const bf16_t*)(ws + WS_WOOUT + (size_t)li * DM * DM), DM / 2, DM / 2, nullptr, nullptr}; pg8::StaticOrder S; S.init(M, DM, Fp.G, bx_);
                pg8::EpiResidT<true> E{X};
                pg8::gemm_phase<pg8::EpiResidT<true>, pg8::StaticOrder, true>(Fp.lds + RING_OFF, g, S, E); }
            }
#endif
            GRID_BAR();
        }
        if (2 * l + 2 > stage_limit) break;
#if (PHMASK >> 10) & 1
            _Pragma("unroll") for (int rep_ = 0; rep_ < NREP(10); ++rep_) {
        {   PHASE_BEGIN(); const bool dry = rep_ + 1 < NREP(10);
            gu32* cnt = (gu32*)(ws + WS_CTL) + CW_CNT + (size_t)(dry ? 8 + 4 * rep_ + l : l) * 32 * 64;
        router_phase(Fp, X, IN(I_FFNN) + l * DM, IN(I_RW) + (size_t)l * DM * NE, IN(I_RB) + l * NE, cnt, dry ? (unsigned*)(ws + WS_QR) : TOKER, dry ? (float*)(ws + WS_QR + MiB) : TOKG, dry ? ACT : XG); }
        GRID_BAR();
            }
#endif
        LAS int* tbl = (LAS int*)(F.lds + SCR_OFF + 12288);
        {   PHASE_BEGIN(); gu32* cnt = (gu32*)(ws + WS_CTL) + CW_CNT + (size_t)l * 32 * 64;
        if (threadIdx.x == 0) { int acc = 0; for (int e = 0; e < NE; ++e) { tbl[e] = acc; const unsigned c = __hip_atomic_load(cnt + 64 * e, RLX_AGENT); acc += (int)((c + 255u) >> 8); } tbl[NE] = acc; }
        __syncthreads(); }
#if (PHMASK >> 11) & 1
            _Pragma("unroll") for (int rep_ = 0; rep_ < NREP(11); ++rep_) { if (rep_) GRID_BAR();
        {   PHASE_BEGIN();
            pg8::Gemm g{(const bf16_t*)XG, (const bf16_t*)(ws + WS_W1 + (size_t)l * NE * 2 * DE * DM), DM / 2, DM / 2, (const bf16_t*)ACT, (const bf16_t*)(ws + WS_W2 + (size_t)l * NE * DM * DE)};
            pg8::MoeMergedOrder S{tbl, Fp.G, Fp.vcu, (gu32*)(ws + WS_CTL) + CW_MOE + (size_t)(l * 320 + 1280 * rep_) * 16, -1};
            pg8::EpiMoe E{{ACT, B1P + (size_t)l * NE * 2048}, {YB, IN(I_B2) + (size_t)l * NE * DM}};
            pg8::gemm_phase<pg8::EpiMoe, pg8::MoeMergedOrder, true>(Fp.lds + RING_OFF, g, S, E); }
            }
#endif
        GRID_BAR();
#if (PHMASK >> 13) & 1
            _Pragma("unroll") for (int rep_ = 0; rep_ < NREP(13); ++rep_) {
        {   PHASE_BEGIN(); const bool dry = rep_ + 1 < NREP(13);
            combine_phase(Fp, X, dry ? (float*)ACT : X, TOKER, TOKG, YB, (l + 1 < DEPTH) ? IN(I_MIXN) + (l + 1) * DM : nullptr, dry ? (ACT + (size_t)64 * MiB) : XN, (l & 1) == 0); }
        GRID_BAR();
            }
#endif
    }
#undef GRID_BAR
}

extern "C" void kernel_launch(void* const* d_in, const int* in_sizes, int n_in, void* d_out, int out_size, void* d_ws, size_t ws_size, hipStream_t stream) {
    static int grid = 0;
    if (grid == 0) {
        if (n_in != 24 || in_sizes[0] != M * DM || out_size != M * DM || ws_size < WS_END) {
            fprintf(stderr, "kernel_launch: unexpected shapes (n_in %d, in0 %d, out %d, ws %zu, need %zu)\n", n_in, n_in > 0 ? in_sizes[0] : -1, out_size, ws_size, (size_t)WS_END); grid = -1; return; }
        int dev = 0, cus = 0, per_cu = 0;
        if (hipGetDevice(&dev) != hipSuccess || hipDeviceGetAttribute(&cus, hipDeviceAttributeMultiprocessorCount, dev) != hipSuccess) { grid = -1; return; }
        if (hipFuncSetAttribute((const void*)trunk_fwd, hipFuncAttributeMaxDynamicSharedMemorySize, LDS_BYTES) != hipSuccess) { fprintf(stderr, "kernel_launch: hipFuncSetAttribute failed\n"); grid = -1; return; }
        if (hipOccupancyMaxActiveBlocksPerMultiprocessor(&per_cu, (const void*)trunk_fwd, NWAVES * 64, LDS_BYTES) != hipSuccess || per_cu < 1)
            fprintf(stderr, "kernel_launch: occupancy query reports %d workgroups per CU\n", per_cu);
        (void)hipGetLastError();
        if (cus < 256) { fprintf(stderr, "kernel_launch: needs 256 CUs, device has %d\n", cus); grid = -1; return; }
        grid = 256;
    }
    if (grid < 0) return;
    if (hipMemsetAsync((char*)d_ws + WS_CTL, 0, CTL_ZERO_BYTES, stream) != hipSuccess) return;
    Args a{};
    for (int i = 0; i < 24; ++i) a.in[i] = (const float*)d_in[i];
    a.out = (float*)d_out; a.ws = (unsigned char*)d_ws; a.stage_limit = STAGE_LIMIT; a.pad = 0;
    hipLaunchKernelGGL(trunk_fwd, dim3(grid), dim3(NWAVES * 64), LDS_BYTES, stream, a);
}
```

```cpp
#include <hip/hip_runtime.h>
#include <hip/hip_bf16.h>
#include <cstdio>
#include <cstdint>

#define LAS __attribute__((address_space(3)))
#define GAS __attribute__((address_space(1)))
typedef unsigned short bf16_t;
typedef short bf16x8 __attribute__((ext_vector_type(8)));
typedef short s16x4 __attribute__((ext_vector_type(4)));
typedef float f32x2 __attribute__((ext_vector_type(2)));
typedef float f32x4 __attribute__((ext_vector_type(4)));
typedef float f32x16 __attribute__((ext_vector_type(16)));
typedef unsigned u32x2 __attribute__((ext_vector_type(2)));
typedef unsigned u32x4 __attribute__((ext_vector_type(4)));
typedef int i32x4 __attribute__((ext_vector_type(4)));
typedef int i32x8 __attribute__((ext_vector_type(8)));

constexpr int BATCH = 2, SEQ = 8192, DM = 1024, M = BATCH * SEQ, DEPTH = 4;
constexpr int EVEN_IN = 2560, ODD_IN = 832, ODD_INP = 1024;
constexpr int NE = 32, DE = 1024, ECAP = 16384;
constexpr float EPS = 1e-6f;
constexpr float LOG2E = 1.4426950408889634f;
constexpr float C2_B = 0.125f * LOG2E;
constexpr float C2_C = 0.07216878364870322f * LOG2E;

__device__ __forceinline__ unsigned cvt_pk_bf16(float lo, float hi) { unsigned r; asm volatile("v_cvt_pk_bf16_f32 %0, %1, %2" : "=v"(r) : "v"(lo), "v"(hi)); return r; }
__device__ __forceinline__ float bf2f(bf16_t v) { return __uint_as_float(((unsigned)v) << 16); }
__device__ __forceinline__ float bflo(unsigned w) { return __uint_as_float(w << 16); }
__device__ __forceinline__ float bfhi(unsigned w) { return __uint_as_float(w & 0xffff0000u); }
__device__ __forceinline__ bf16_t f2bf(float f) { return (bf16_t)(cvt_pk_bf16(f, 0.f) & 0xffffu); }

__device__ __forceinline__ unsigned pk4_fp8(float a, float b, float c, float d) { int w = 0; w = __builtin_amdgcn_cvt_pk_fp8_f32(a, b, w, false); w = __builtin_amdgcn_cvt_pk_fp8_f32(c, d, w, true); return (unsigned)w; }
constexpr float W8_SCALE = 64.0f, W8_INV = 1.0f / 64.0f;

namespace pg8 {
constexpr int BM = 256, BK = 64, HALF = 128, HTB = HALF * BK * 2, STAGE_BYTES = 8 * HTB, NXCD = 8, WGM = 8;
__host__ __device__ __forceinline__ int lds_byte(int r, int c) { const int st = (r >> 4) * 2 + (c >> 5), rr = r & 15, cc = c & 31, ob = rr * 64 + cc * 2; return st * 1024 + (ob ^ (((ob >> 9) & 1) << 5)); }
__host__ __device__ __forceinline__ void stage_rc(int b, int& R, int& C) { const int st = b / 1024, sb = b % 1024, swz = sb ^ (((sb >> 9) & 1) << 5); R = (st >> 1) * 16 + swz / 64; C = (st & 1) * 32 + (swz % 64) / 2; }
__host__ __device__ __forceinline__ int perm32(int rho) { const int n = rho >> 4, i = rho & 15; return 8 * (i >> 2) + 4 * n + (i & 3); }

struct Unit { int pm, pn, pb, kind, rb; };
struct Gemm { const bf16_t* A; const bf16_t* Bt; int lda, K; const bf16_t* A2; const bf16_t* Bt2; };

struct StaticOrder {
    int nM, nN, nwg, G, c;
    __device__ void init(int M_, int N_, int G_, int c_) { nM = M_ / BM; nN = N_ / BM; nwg = nM * nN; G = G_; c = c_; }
    __device__ bool next(int i, Unit& u) const {
        const long L = (long)i * G + c; if (L >= nwg) return false;
        int wgid = (int)L; { const int q = nwg / NXCD, r = nwg % NXCD, xcd = wgid % NXCD, off = wgid / NXCD; wgid = (xcd < r ? xcd * (q + 1) : r * (q + 1) + (xcd - r) * q) + off; }
        const int nig = WGM * nN, gid = wgid / nig, fm = gid * WGM, gsz = (nM - fm) < WGM ? (nM - fm) : WGM;
        u.pm = fm + ((wgid % nig) % gsz); u.pn = (wgid % nig) / gsz; u.pb = u.pn; u.kind = 0; u.rb = 0; return true;
    }
    __device__ __forceinline__ void a_ready(const Unit&) const {}
    __device__ __forceinline__ void pre_epi() const {}
    __device__ __forceinline__ void done(const Unit&) const {}
    __device__ __forceinline__ void finish() const {}
};

__device__ __forceinline__ f32x2 gelu_pk(f32x2 v) {
    const f32x2 av = __builtin_elementwise_abs(v), d = av * 0.2316418882f + 1.0f;
    f32x2 t; t.x = __builtin_amdgcn_rcpf(d.x); t.y = __builtin_amdgcn_rcpf(d.y);
    f32x2 q = t * 0.5307027145f + (-0.7265760135f); q = q * t + 0.7107068705f; q = q * t + (-0.142248368f); q = q * t + 0.127414796f; q = q * t;
    const f32x2 s = (v * v) * (-0.72134752044f);
    f32x2 e; e.x = __builtin_amdgcn_exp2f(s.x); e.y = __builtin_amdgcn_exp2f(s.y);
    const f32x2 m = v * (q * e), r = v - m;
    f32x2 o; o.x = v.x < 0.f ? m.x : r.x; o.y = v.y < 0.f ? m.y : r.y; return o;
}
__device__ __forceinline__ f32x4 gelu4(f32x4 v) { const f32x2 a = gelu_pk((f32x2){v[0], v[1]}), b = gelu_pk((f32x2){v[2], v[3]}); return (f32x4){a.x, a.y, b.x, b.y}; }

template <class Epi, class Sched, bool FP8 = false>
__device__ __forceinline__ void gemm_phase(LAS unsigned char* lds, const Gemm g, const Sched& S, const Epi& E) {
    int tid_ = threadIdx.x; asm volatile("" : "+v"(tid_));
    const int tid = tid_, wid = __builtin_amdgcn_readfirstlane(tid >> 6), lane = tid & 63, wr = wid >> 2, wc = wid & 3, fr = lane & 15, fq = lane >> 4;
    const int K = g.K, nt = K / BK;
    unsigned voffA[2], voffB[2];
#pragma unroll
    for (int i = 0; i < 2; ++i) { int R, C; stage_rc(tid * 16 + i * 8192, R, C); const int Rb = Epi::PERM ? ((R & ~31) + perm32(R & 31)) : R;
        voffA[i] = (unsigned)(R * g.lda + C) * 2u; voffB[i] = (unsigned)(Rb * K + C) * 2u; }
    const size_t kstep = (size_t)(BK * 2);
    const size_t hstepA = (size_t)HALF * g.lda * 2, tstepA = 2 * hstepA;
    const size_t hstepB = (size_t)HALF * K * 2, tstepB = 2 * hstepB;
    const unsigned ldsw = (unsigned)wid * 1024u;
    const int aoff = lds_byte(wr * 64 + fr, fq * 8), boff = lds_byte(wc * 32 + fr, fq * 8);
#define PG8_SA(b, h) (((b) * 2 + (h)) * HTB)
#define PG8_SB(b, h) ((4 + (b) * 2 + (h)) * HTB)
#define PG8_STAGE(bufoff, gbase, voff) do { _Pragma("unroll") for (int _i = 0; _i < 2; ++_i) \
        __builtin_amdgcn_global_load_lds((const unsigned*)((const char*)(gbase) + (voff)[_i]), (LAS unsigned*)(lds + (bufoff) + ldsw + _i * 8192), 16, 0, 0); } while (0)
#define PG8_LDA(dst, b, h) do { _Pragma("unroll") for (int m = 0; m < 4; ++m) { if constexpr (FP8) { const i32x4 lo_ = *(const LAS i32x4*)(lds + PG8_SA(b, h) + aoff + m * 2048), hi_ = *(const LAS i32x4*)(lds + PG8_SA(b, h) + aoff + m * 2048 + 1024); dst##8[m] = __builtin_shufflevector(lo_, hi_, 0, 1, 2, 3, 4, 5, 6, 7); } \
        else { _Pragma("unroll") for (int k = 0; k < 2; ++k) dst[m][k] = *(const LAS bf16x8*)(lds + PG8_SA(b, h) + aoff + m * 2048 + k * 1024); } } } while (0)
#define PG8_LDB(dst, b, h) do { _Pragma("unroll") for (int n = 0; n < 2; ++n) { if constexpr (FP8) { const i32x4 lo_ = *(const LAS i32x4*)(lds + PG8_SB(b, h) + boff + n * 2048), hi_ = *(const LAS i32x4*)(lds + PG8_SB(b, h) + boff + n * 2048 + 1024); dst##8[n] = __builtin_shufflevector(lo_, hi_, 0, 1, 2, 3, 4, 5, 6, 7); } \
        else { _Pragma("unroll") for (int k = 0; k < 2; ++k) dst[n][k] = *(const LAS bf16x8*)(lds + PG8_SB(b, h) + boff + n * 2048 + k * 1024); } } } while (0)
#define PG8_MMA(ai, bj, At, Bt) do { __builtin_amdgcn_s_setprio(1); _Pragma("unroll") for (int m = 0; m < 4; ++m) _Pragma("unroll") for (int n = 0; n < 2; ++n) { \
        if constexpr (FP8) asm volatile("s_nop 1\n\tv_mfma_f32_16x16x128_f8f6f4 %0, %1, %2, %0" : "+v"(acc[ai][bj][m][n]) : "v"(Bt##8[n]), "v"(At##8[m])); \
        else { _Pragma("unroll") for (int k = 0; k < 2; ++k) acc[ai][bj][m][n] = __builtin_amdgcn_mfma_f32_16x16x32_bf16(Bt[n][k], At[m][k], acc[ai][bj][m][n], 0, 0, 0); } } \
        __builtin_amdgcn_s_setprio(0); } while (0)
#define PG8_WAIT_V(n) asm volatile("s_waitcnt vmcnt(" #n ")" ::: "memory")
#define PG8_WAIT_L(n) asm volatile("s_waitcnt lgkmcnt(" #n ")" ::: "memory")
#define PG8_BAR __builtin_amdgcn_s_barrier()
#define PG8_SCHED __builtin_amdgcn_sched_barrier(0)
    Unit cur, nxt; int ui = 0;
    if (!S.next(0, cur)) return;
    f32x4 acc[2][2][4][2];
#pragma unroll
    for (int a = 0; a < 2; ++a)
#pragma unroll
        for (int b = 0; b < 2; ++b)
#pragma unroll
            for (int m = 0; m < 4; ++m)
#pragma unroll
                for (int n = 0; n < 2; ++n) acc[a][b][m][n] = (f32x4){0.f, 0.f, 0.f, 0.f};
    bf16x8 At[4][2], B0[2][2], B1[2][2]; i32x8 At8[4], B08[2], B18[2];
    const char* cA = (const char*)(cur.kind ? g.A2 : g.A) + (size_t)cur.pm * tstepA; const char* cB = (const char*)(cur.kind ? g.Bt2 : g.Bt) + (size_t)cur.pb * tstepB;
    S.a_ready(cur);
    PG8_STAGE(PG8_SB(0, 0), cB, voffB); PG8_STAGE(PG8_SB(0, 1), cB + hstepB, voffB); PG8_STAGE(PG8_SA(0, 0), cA, voffA); PG8_STAGE(PG8_SA(0, 1), cA + hstepA, voffA);
    if (wr == 1) PG8_BAR;
    PG8_WAIT_V(2); PG8_BAR;
    PG8_STAGE(PG8_SB(1, 0), cB + kstep, voffB); PG8_STAGE(PG8_SA(1, 0), cA + kstep, voffA); PG8_STAGE(PG8_SB(1, 1), cB + hstepB + kstep, voffB);
    PG8_WAIT_V(6); PG8_BAR;
    for (;;) {
        const bool has_next = S.next(ui + 1, nxt);
        const char* nA = has_next ? (const char*)(nxt.kind ? g.A2 : g.A) + (size_t)nxt.pm * tstepA : cA; const char* nB = has_next ? (const char*)(nxt.kind ? g.Bt2 : g.Bt) + (size_t)nxt.pb * tstepB : cB;
#pragma unroll 1
        for (int t = 0; t < nt; t += 2) {
            const bool last = (t == nt - 2);
            const char* a1 = cA + (size_t)(t + 1) * kstep;
            const char* a2 = last ? nA : cA + (size_t)(t + 2) * kstep; const char* b2 = last ? nB : cB + (size_t)(t + 2) * kstep;
            const char* a3 = a2 + kstep; const char* b3 = b2 + kstep;
            if (last && has_next) S.a_ready(nxt);
            PG8_LDB(B0, 0, 0); PG8_LDB(B1, 0, 1); PG8_SCHED; PG8_LDA(At, 0, 0); PG8_STAGE(PG8_SA(1, 1), a1 + hstepA, voffA);
            PG8_WAIT_V(8); PG8_WAIT_L(0); PG8_BAR; PG8_MMA(0, 0, At, B0); PG8_MMA(0, 1, At, B1); PG8_BAR; PG8_SCHED;
            PG8_LDA(At, 0, 1); PG8_STAGE(PG8_SB(0, 0), b2, voffB); PG8_STAGE(PG8_SB(0, 1), b2 + hstepB, voffB); PG8_STAGE(PG8_SA(0, 0), a2, voffA);
            PG8_WAIT_V(8); PG8_WAIT_L(0); PG8_BAR; PG8_MMA(1, 0, At, B0); PG8_MMA(1, 1, At, B1); PG8_BAR; PG8_SCHED;
            PG8_LDB(B0, 1, 0); PG8_LDB(B1, 1, 1); PG8_SCHED; PG8_LDA(At, 1, 0); PG8_STAGE(PG8_SA(0, 1), a2 + hstepA, voffA);
            PG8_WAIT_V(8); PG8_WAIT_L(0); PG8_BAR; PG8_MMA(0, 0, At, B0); PG8_MMA(0, 1, At, B1); PG8_BAR; PG8_SCHED;
            PG8_LDA(At, 1, 1); PG8_STAGE(PG8_SB(1, 0), b3, voffB); PG8_STAGE(PG8_SB(1, 1), b3 + hstepB, voffB); PG8_STAGE(PG8_SA(1, 0), a3, voffA);
            PG8_WAIT_V(8); PG8_WAIT_L(0); PG8_BAR; PG8_MMA(1, 0, At, B0); PG8_MMA(1, 1, At, B1); PG8_BAR; PG8_SCHED;
        }
        if (wr == 0) PG8_BAR;
        if constexpr (FP8) asm volatile("s_nop 15\n\ts_nop 7" ::: "memory");
        S.pre_epi();
        { int te_ = threadIdx.x; asm volatile("" : "+v"(te_));
          E(acc, cur, wr, wc, te_ & 15, (te_ & 63) >> 4); }
        S.done(cur);
        if (!has_next) break;
#pragma unroll
        for (int a = 0; a < 2; ++a)
#pragma unroll
            for (int b = 0; b < 2; ++b)
#pragma unroll
                for (int m = 0; m < 4; ++m)
#pragma unroll
                    for (int n = 0; n < 2; ++n) acc[a][b][m][n] = (f32x4){0.f, 0.f, 0.f, 0.f};
        cur = nxt; cA = nA; cB = nB; ++ui;
        if (wr == 1) PG8_BAR;
    }
    PG8_WAIT_V(0);
    S.finish();
    PG8_BAR;
#undef PG8_SA
#undef PG8_SB
#undef PG8_STAGE
#undef PG8_LDA
#undef PG8_LDB
#undef PG8_MMA
#undef PG8_WAIT_V
#undef PG8_WAIT_L
#undef PG8_BAR
#undef PG8_SCHED
}
}
constexpr int STAGE_LIMIT = 8;

namespace att {
__device__ __forceinline__ int crow(int r, int hi) { return (r & 3) + 8 * (r >> 2) + 4 * hi; }
__device__ __forceinline__ int v_rd_base(int lane) { return ((lane & 3) << 3) | (((lane >> 2) & 3) << 6) | (((lane >> 4) & 1) << 5) | (((lane >> 5) & 1) << 8); }
}

namespace dil {
using att::crow; using att::v_rd_base;
constexpr int OFF_O = 0, OFF_V = 65536, VWAVE = 8192;
template <int S_>
__device__ __forceinline__ void pass(const bf16_t* __restrict__ Qh, const bf16_t* __restrict__ Kh, const bf16_t* __restrict__ Vh, int pitch, int q0, LAS unsigned char* lds, LAS float* scr, int wid, int lane) {
    const int r32 = lane & 31, hi = lane >> 5;
    LAS float* Oacc = (LAS float*)(lds + OFF_O); LAS float* macc = scr; LAS float* lacc = scr + 256; LAS float* wsf = scr + 512 + wid * 64;
    LAS unsigned char* vbuf = lds + OFF_V + wid * VWAVE;
    constexpr int NG = (S_ == 16) ? 2 : 1, VR = (S_ == 16) ? 16 : 32;
    int vk[4], vc[4];
#pragma unroll
    for (int i = 0; i < 4; ++i) { const int off = (i * 64 + lane) * 16, st = off >> 9, within = off & 511, kk = (st >> 1) * 8 + (within >> 6);
        vk[i] = (kk & ~0xC) | ((kk & 4) << 1) | ((kk & 8) >> 1); vc[i] = (st & 1) * 32 + ((within & 63) >> 1); }
    const unsigned vb0 = (unsigned)(uintptr_t)vbuf + (unsigned)v_rd_base(lane);
#pragma unroll
    for (int gi = 0; gi < NG; ++gi) {
        const int rho = (S_ == 1) ? 0 : (S_ == 4) ? (wid & 3) : (2 * wid + gi);
        const int i0 = (S_ == 1) ? 32 * wid : (S_ == 4) ? 32 * (wid >> 2) : 0;
        const int qi = i0 + (r32 < VR ? r32 : r32 - VR);
        const int ql = rho + S_ * qi;
        bf16x8 qr[4];
#pragma unroll
        for (int d0 = 0; d0 < 4; ++d0) qr[d0] = *(const bf16x8*)(Qh + (size_t)(q0 + ql) * pitch + d0 * 16 + hi * 8);
        const int j0 = i0 - 128;
        const int tokb = q0 + rho + S_ * j0;
        bf16x8 kfA[4], kfB[4];
#define DIL_KLOAD(dst, c) do { int tk_ = tokb + S_ * (32 * (c) + r32); tk_ = tk_ < 0 ? 0 : (tk_ > SEQ - 1 ? SEQ - 1 : tk_);     \
            _Pragma("unroll") for (int d0 = 0; d0 < 4; ++d0) dst[d0] = *(const bf16x8*)(Kh + (size_t)tk_ * pitch + d0 * 16 + hi * 8); } while (0)
#define DIL_VDMA(c, bf) do { _Pragma("unroll") for (int i = 0; i < 4; ++i) { int tk_ = tokb + S_ * (32 * (c) + vk[i]); tk_ = tk_ < 0 ? 0 : (tk_ > SEQ - 1 ? SEQ - 1 : tk_); \
            __builtin_amdgcn_global_load_lds((const unsigned*)(Vh + (size_t)tk_ * pitch + vc[i]), (LAS unsigned*)(vbuf + (bf) * 4096 + i * 1024), 16, 0, 0); } } while (0)
        float m_reg = -1e30f, l_reg = 0.f; f32x16 o[2]; o[0] = f32x16{}; o[1] = f32x16{};
        DIL_KLOAD(kfA, 0); DIL_VDMA(0, 0);
#define DIL_STEP(KF, KN, c) do { \
            if ((c) < 4) { DIL_KLOAD(KN, (c) + 1); DIL_VDMA((c) + 1, ((c) + 1) & 1); asm volatile("s_waitcnt vmcnt(8)" ::: "memory"); } \
            else { asm volatile("s_waitcnt vmcnt(0)" ::: "memory"); } \
            f32x16 p = f32x16{}; \
            _Pragma("unroll") for (int d0 = 0; d0 < 4; ++d0) p = __builtin_amdgcn_mfma_f32_32x32x16_bf16(KF[d0], qr[d0], p, 0, 0, 0); \
            const unsigned vb = vb0 + (unsigned)(((c) & 1) * 4096); \
            s16x4 vl0[2], vh0[2], vl1[2], vh1[2]; \
            _Pragma("unroll") for (int d0 = 0; d0 < 2; ++d0) { \
                asm volatile("ds_read_b64_tr_b16 %0, %1 offset:%2" : "=&v"(vl0[d0]) : "v"(vb), "i"(d0 * 512) : "memory"); \
                asm volatile("ds_read_b64_tr_b16 %0, %1 offset:%2" : "=&v"(vh0[d0]) : "v"(vb), "i"(d0 * 512 + 1024) : "memory"); \
                asm volatile("ds_read_b64_tr_b16 %0, %1 offset:%2" : "=&v"(vl1[d0]) : "v"(vb), "i"(d0 * 512 + 2048) : "memory"); \
                asm volatile("ds_read_b64_tr_b16 %0, %1 offset:%2" : "=&v"(vh1[d0]) : "v"(vb), "i"(d0 * 512 + 3072) : "memory"); } \
              \
            { const float NEG = -__builtin_inff(); const int db = qi - j0 - 32 * (c) - 4 * hi; const int tb = tokb + S_ * (32 * (c) + 4 * hi); \
              if ((c) == 0 || (c) == 4 || tokb < 0) { \
                _Pragma("unroll") for (int r = 0; r < 16; ++r) { const int cr = (r & 3) + 8 * (r >> 2); \
                    const bool ok = ((unsigned)(db - cr) <= 128u) && (tb + S_ * cr >= 0); p[r] = ok ? p[r] : NEG; } } } \
            float pmax = p[0]; \
            _Pragma("unroll") for (int r = 1; r < 16; ++r) pmax = fmaxf(pmax, p[r]); \
            { auto rr = __builtin_amdgcn_permlane32_swap(__float_as_uint(pmax), __float_as_uint(pmax), false, false); pmax = fmaxf(__uint_as_float(rr[0]), __uint_as_float(rr[1])); } \
            const float mn = fmaxf(m_reg, pmax); const float alpha = __builtin_amdgcn_exp2f(m_reg - mn); m_reg = mn; \
            float ps = 0.f; \
            _Pragma("unroll") for (int r = 0; r < 16; ++r) { p[r] = __builtin_amdgcn_exp2f(p[r] - mn); ps += p[r]; } \
            { auto rr = __builtin_amdgcn_permlane32_swap(__float_as_uint(ps), __float_as_uint(ps), false, false); ps = __uint_as_float(rr[0]) + __uint_as_float(rr[1]); } \
            l_reg = l_reg * alpha + ps; \
            bf16x8 pa0, pa1; DIL_PK4(p, 0, pa0); DIL_PK4(p, 8, pa1); \
            if (__any(alpha < 1.f)) { if (hi == 0) wsf[r32] = alpha; asm volatile("s_waitcnt lgkmcnt(0)" ::: "memory"); \
                _Pragma("unroll") for (int r = 0; r < 16; ++r) { const float a = wsf[crow(r, hi)]; o[0][r] *= a; o[1][r] *= a; } } \
            asm volatile("s_waitcnt lgkmcnt(0)" ::: "memory"); __builtin_amdgcn_sched_barrier(0); \
            _Pragma("unroll") for (int d0 = 0; d0 < 2; ++d0) { \
                o[d0] = __builtin_amdgcn_mfma_f32_32x32x16_bf16(pa0, (bf16x8){vl0[d0][0], vl0[d0][1], vl0[d0][2], vl0[d0][3], vh0[d0][0], vh0[d0][1], vh0[d0][2], vh0[d0][3]}, o[d0], 0, 0, 0); \
                o[d0] = __builtin_amdgcn_mfma_f32_32x32x16_bf16(pa1, (bf16x8){vl1[d0][0], vl1[d0][1], vl1[d0][2], vl1[d0][3], vh1[d0][0], vh1[d0][1], vh1[d0][2], vh1[d0][3]}, o[d0], 0, 0, 0); } \
        } while (0)
#define DIL_PK4(P, B_, OUT) do { unsigned a0 = cvt_pk_bf16(P[B_+0], P[B_+1]), a1 = cvt_pk_bf16(P[B_+2], P[B_+3]);                          \
            unsigned b0_ = cvt_pk_bf16(P[B_+4], P[B_+5]), b1_ = cvt_pk_bf16(P[B_+6], P[B_+7]);                                             \
            auto r0 = __builtin_amdgcn_permlane32_swap(a0, b0_, false, false); auto r1 = __builtin_amdgcn_permlane32_swap(a1, b1_, false, false); \
            u32x4 w = {r0[0], r1[0], r0[1], r1[1]}; OUT = __builtin_bit_cast(bf16x8, w); } while (0)
        DIL_STEP(kfA, kfB, 0); DIL_STEP(kfB, kfA, 1); DIL_STEP(kfA, kfB, 2); DIL_STEP(kfB, kfA, 3); DIL_STEP(kfA, kfB, 4);
#undef DIL_STEP
#undef DIL_PK4
#undef DIL_KLOAD
#undef DIL_VDMA
        float fo = 0.f, fc = 1.f;
        if (S_ != 1) { const float mo = macc[ql], lo = lacc[ql]; const float mnew = fmaxf(mo, m_reg); fo = __builtin_amdgcn_exp2f(mo - mnew); fc = __builtin_amdgcn_exp2f(m_reg - mnew);
            l_reg = lo * fo + l_reg * fc; m_reg = mnew; }
        if (hi == 0 && r32 < VR) { macc[ql] = m_reg; lacc[ql] = l_reg; wsf[r32] = fo; wsf[32 + r32] = fc; }
        asm volatile("s_waitcnt lgkmcnt(0)" ::: "memory");
#pragma unroll
        for (int r = 0; r < 16; ++r) { const int row = crow(r, hi);
            if (row < VR) { const int qrow = rho + S_ * (i0 + row); LAS float* op = Oacc + qrow * 64 + r32;
                if (S_ == 1) { op[0] = o[0][r]; op[32] = o[1][r]; }
                else { const float a = wsf[row], b = wsf[32 + row]; op[0] = op[0] * a + o[0][r] * b; op[32] = op[32] * a + o[1][r] * b; } } }
        asm volatile("s_waitcnt lgkmcnt(0)" ::: "memory");
    }
}
__device__ __forceinline__ void unit(const bf16_t* Qh, const bf16_t* Kh, const bf16_t* Vh, int pitch, bf16_t* Oh, int op, int q0, LAS unsigned char* lds, LAS float* scr) {
    int tid_ = threadIdx.x; asm volatile("" : "+v"(tid_));
    const int tid = tid_, wid = __builtin_amdgcn_readfirstlane(tid >> 6), lane = tid & 63;
    pass<1>(Qh, Kh, Vh, pitch, q0, lds, scr, wid, lane);
    __syncthreads();
    pass<4>(Qh, Kh, Vh, pitch, q0, lds, scr, wid, lane);
    __syncthreads();
    pass<16>(Qh, Kh, Vh, pitch, q0, lds, scr, wid, lane);
    __syncthreads();
    {   const int q = tid >> 1, hf = tid & 1; const LAS f32x4* src = (const LAS f32x4*)(lds + OFF_O + (q * 64 + 32 * hf) * 4); const float rl = 1.0f / scr[256 + q];
        bf16_t* dst = Oh + (size_t)(q0 + q) * op + 32 * hf;
#pragma unroll
        for (int i = 0; i < 4; ++i) { const f32x4 a = src[2 * i] * rl, b = src[2 * i + 1] * rl;
            u32x4 w; w.x = cvt_pk_bf16(a[0], a[1]); w.y = cvt_pk_bf16(a[2], a[3]); w.z = cvt_pk_bf16(b[0], b[1]); w.w = cvt_pk_bf16(b[2], b[3]); *(u32x4*)(dst + 8 * i) = w; } }
    __syncthreads();
}
}

namespace mla {
using att::crow;
constexpr int DQ = 192, DV_ = 128;
constexpr int KP = DQ + 16, KB = 64 * KP;
constexpr int VP = 80, VB = DV_ * VP;
constexpr int NBUF = 3;
constexpr int OFF_K = 0, OFF_V = NBUF * KB, OFF_WS = NBUF * (KB + VB), BYTES = OFF_WS + 8 * 256;
constexpr int KCPR = KP / 16, NKP = KB / 1024, KPW = (NKP + 7) / 8;
constexpr int NVP = VB / 256, VPW = NVP / 8;
static_assert(BYTES <= 131072 && KB % 1024 == 0 && VB % 256 == 0 && NVP % 8 == 0, "mla LDS image");
constexpr float PSHIFT = 8.0f;

__device__ __forceinline__ void unit(const unsigned char* __restrict__ Qh, const unsigned char* __restrict__ Kh, int pitch, const unsigned char* __restrict__ VTh  ,
                                     unsigned char* __restrict__ Oh, int op, int q0, LAS unsigned char* lds) {
    constexpr float SC = C2_C;
    int tid_ = threadIdx.x; asm volatile("" : "+v"(tid_));
    const int tid = tid_, wid = __builtin_amdgcn_readfirstlane(tid >> 6), lane = tid & 63, r32 = lane & 31, hi = lane >> 5;
    const int qlo = q0 + wid * 32, qpos = qlo + r32;
    LAS float* wsf = (LAS float*)(lds + OFF_WS) + wid * 64;
    const int NT = (q0 + 256) / 64;
    unsigned kso[KPW], vso[VPW];
#pragma unroll
    for (int i = 0; i < KPW; ++i) { const int c = (wid + 8 * i) * 64 + lane, row = c / KCPR; int cc = c % KCPR; if (cc > KCPR - 2) cc = KCPR - 2; kso[i] = (unsigned)((row & 63) * pitch + cc * 16); }
#pragma unroll
    for (int i = 0; i < VPW; ++i) { const int off = ((wid + 8 * i) * 64 + lane) * 4, d = off / VP; int w = off % VP; if (w >= 64) w = 0;
        const int hh = w >> 5, g = (w & 31) >> 2; vso[i] = (unsigned)(d * SEQ + 32 * (g >> 2) + 8 * (g & 3) + 4 * hh); }
#define MLA_DMA(j, bf) do { const unsigned char* kt_ = Kh + (size_t)(j) * 64 * pitch; const unsigned char* vt_ = VTh + (size_t)(j) * 64; \
        _Pragma("unroll") for (int i = 0; i < KPW; ++i) if (wid + 8 * i < NKP) \
            __builtin_amdgcn_global_load_lds((const unsigned*)(kt_ + kso[i]), (LAS unsigned*)(lds + OFF_K + (bf) * KB + (wid + 8 * i) * 1024), 16, 0, 0); \
        _Pragma("unroll") for (int i = 0; i < VPW; ++i) \
            __builtin_amdgcn_global_load_lds((const unsigned*)(vt_ + vso[i]), (LAS unsigned*)(lds + OFF_V + (bf) * VB + (wid + 8 * i) * 256), 4, 0, 0); } while (0)
    MLA_DMA(0, 0);
    if (NT > 1) MLA_DMA(1, 1);
    i32x8 qr[3];
#pragma unroll
    for (int s = 0; s < 3; ++s) { const i32x4 lo_ = *(const i32x4*)(Qh + (size_t)qpos * pitch + 64 * s + 32 * hi), hi_ = *(const i32x4*)(Qh + (size_t)qpos * pitch + 64 * s + 32 * hi + 16);
        qr[s] = __builtin_shufflevector(lo_, hi_, 0, 1, 2, 3, 4, 5, 6, 7); }
    float m_reg = -1e30f;
    f32x16 o[4], ol = f32x16{};
    const i32x8 ones8 = {0x38383838, 0x38383838, 0x38383838, 0x38383838, 0x38383838, 0x38383838, 0x38383838, 0x38383838};
#pragma unroll
    for (int d = 0; d < 4; ++d) o[d] = f32x16{};
    const int koff = r32 * KP + hi * 32, voff = r32 * VP + hi * 32;
    asm volatile("s_waitcnt vmcnt(0)" ::: "memory");
    __syncthreads();
#define MLA_QK(P, bufi, hf_) do { const LAS unsigned char* kb_ = lds + OFF_K + (bufi) * KB + (hf_) * 32 * KP + koff; P = f32x16{}; \
        i32x8 kw_[3]; _Pragma("unroll") for (int s = 0; s < 3; ++s) { const i32x4 lo_ = *(const LAS i32x4*)(kb_ + 64 * s), hi_ = *(const LAS i32x4*)(kb_ + 64 * s + 16); kw_[s] = __builtin_shufflevector(lo_, hi_, 0, 1, 2, 3, 4, 5, 6, 7); } \
        _Pragma("unroll") for (int s = 0; s < 3; ++s) P = __builtin_amdgcn_mfma_scale_f32_32x32x64_f8f6f4(kw_[s], qr[s], P, 0, 0, 0, 0, 0, 0); } while (0)
    f32x16 pA, pB, pC, pD;
    int buf = 0;
    { if (0 <= qlo + 31) { MLA_QK(pA, 0, 0); } if (32 <= qlo + 31) { MLA_QK(pB, 0, 1); } }
#define MLA_SMPV(P0, P1, kb, vbuf) do { \
        const bool a0_ = (kb) <= qlo + 31, a1_ = (kb) + 32 <= qlo + 31; \
        if (a0_) { \
            const float NEG = -__builtin_inff(); const int dq = qpos - (kb) - 4 * hi; \
            if (!a1_) { _Pragma("unroll") for (int r = 0; r < 16; ++r) P1[r] = NEG; } \
            if ((kb) + 63 > qlo) { _Pragma("unroll") for (int r = 0; r < 16; ++r) { const int c = (r & 3) + 8 * (r >> 2); if (dq - c < 0) P0[r] = NEG; if (dq - c - 32 < 0) P1[r] = NEG; } } \
            float pmax = fmaxf(P0[0], P1[0]); \
            _Pragma("unroll") for (int r = 1; r < 16; ++r) pmax = fmaxf(pmax, fmaxf(P0[r], P1[r])); \
            { auto rr = __builtin_amdgcn_permlane32_swap(__float_as_uint(pmax), __float_as_uint(pmax), false, false); pmax = fmaxf(__uint_as_float(rr[0]), __uint_as_float(rr[1])); } \
            const float mn = fmaxf(m_reg, pmax * SC); const float alpha = __builtin_amdgcn_exp2f(m_reg - mn); m_reg = mn; \
              \
              \
            const float c8 = 8.0f * SC, b8 = 8.0f * (PSHIFT + 7.0f - mn); \
            i32x8 pa; \
            _Pragma("unroll") for (int g = 0; g < 4; ++g) { unsigned w0 = 0u, w1 = 0u; \
                _Pragma("unroll") for (int b_ = 0; b_ < 4; ++b_) { w0 = __builtin_amdgcn_cvt_pk_u8_f32(__builtin_fmaf(P0[4 * g + b_], c8, b8), b_, w0); w1 = __builtin_amdgcn_cvt_pk_u8_f32(__builtin_fmaf(P1[4 * g + b_], c8, b8), b_, w1); } \
                pa[g] = (int)w0; pa[4 + g] = (int)w1; } \
            if (__any(alpha < 1.f)) { if (hi == 0) wsf[r32] = alpha; asm volatile("s_waitcnt lgkmcnt(0)" ::: "memory"); \
                _Pragma("unroll") for (int r = 0; r < 16; ++r) { const float a = wsf[crow(r, hi)]; ol[r] *= a; _Pragma("unroll") for (int d = 0; d < 4; ++d) o[d][r] *= a; } } \
            ol = __builtin_amdgcn_mfma_scale_f32_32x32x64_f8f6f4(pa, ones8, ol, 0, 0, 0, 0, 0, 0); \
            const LAS unsigned char* vb_ = lds + OFF_V + (vbuf) * VB + voff; \
            _Pragma("unroll") for (int d0 = 0; d0 < 4; ++d0) { const i32x4 lo_ = *(const LAS i32x4*)(vb_ + d0 * 32 * VP), hi_ = *(const LAS i32x4*)(vb_ + d0 * 32 * VP + 16); \
                o[d0] = __builtin_amdgcn_mfma_scale_f32_32x32x64_f8f6f4(pa, __builtin_shufflevector(lo_, hi_, 0, 1, 2, 3, 4, 5, 6, 7), o[d0], 0, 0, 0, 0, 0, 0); } \
        } } while (0)
    for (int t = 0; t < NT; t += 2) {
        {   if (t + 2 < NT) { const int b2 = buf == 0 ? 2 : buf - 1; MLA_DMA(t + 2, b2); }
            const int kb = t * 64, nb = buf == 2 ? 0 : buf + 1;
            if (kb + 64 <= qlo + 31) MLA_QK(pC, nb, 0);
            if (kb + 96 <= qlo + 31) MLA_QK(pD, nb, 1);
            MLA_SMPV(pA, pB, kb, buf);
            asm volatile("s_waitcnt vmcnt(0)" ::: "memory"); __syncthreads(); buf = nb; }
        {   if (t + 3 < NT) { const int b2 = buf == 0 ? 2 : buf - 1; MLA_DMA(t + 3, b2); }
            const int kb = (t + 1) * 64, nb = buf == 2 ? 0 : buf + 1;
            if (t + 2 < NT) { if (kb + 64 <= qlo + 31) MLA_QK(pA, nb, 0); if (kb + 96 <= qlo + 31) MLA_QK(pB, nb, 1); }
            MLA_SMPV(pC, pD, kb, buf);
            asm volatile("s_waitcnt vmcnt(0)" ::: "memory"); __syncthreads(); buf = nb; }
    }
#undef MLA_SMPV
#undef MLA_QK
#undef MLA_DMA
    unsigned char* Ow = Oh + (size_t)qlo * op;
#pragma unroll
    for (int r = 0; r < 16; ++r) { const int orow = crow(r, hi); const float rl = __builtin_amdgcn_rcpf(ol[r]);
#pragma unroll
        for (int d0 = 0; d0 < 4; ++d0) { const float v = o[d0][r] * rl; const float v1 = __shfl_down(v, 1), v2 = __shfl_down(v, 2), v3 = __shfl_down(v, 3);
            if ((r32 & 3) == 0) *(unsigned*)(Ow + (size_t)orow * op + d0 * 32 + r32) = pk4_fp8(v, v1, v2, v3); } }
    __syncthreads();
}
}

constexpr int NWAVES = 8;
constexpr size_t MiB = 1u << 20;
constexpr size_t WS_CTL = 0, CTL_ZERO_BYTES = 1 * MiB;
constexpr size_t WS_WEIN = 2 * MiB;
constexpr size_t WS_WEOUT = 12 * MiB;
constexpr size_t WS_WOIN = 16 * MiB;
constexpr size_t WS_WUQ = 20 * MiB;
constexpr size_t WS_WUKV = 23 * MiB;
constexpr size_t WS_WOOUT = 25 * MiB;
constexpr size_t WS_B1P = 29 * MiB;
constexpr size_t WS_SSQ = 30 * MiB;
constexpr size_t WS_TOKER = 31 * MiB;
constexpr size_t WS_TOKG = 31 * MiB + 512 * 1024;
constexpr size_t WS_XN = 32 * MiB;
constexpr size_t WS_Z = 64 * MiB;
constexpr size_t WS_MIX = 144 * MiB;
constexpr size_t WS_QR = 176 * MiB;
constexpr size_t WS_KVR = 224 * MiB;
constexpr size_t WS_QF = 288 * MiB;
constexpr size_t WS_KF = 336 * MiB;
constexpr size_t WS_Z8 = 104 * MiB;
constexpr size_t WS_MIX8 = 160 * MiB;
constexpr size_t WS_VT = 3200 * MiB;
constexpr size_t WS_W1 = 384 * MiB;
constexpr size_t WS_W2 = 896 * MiB;
constexpr size_t WS_XG = 1152 * MiB;
constexpr size_t WS_ACT = 1664 * MiB;
constexpr size_t WS_Y = 2176 * MiB;
constexpr size_t WS_END = 3216 * MiB;
constexpr int CW_MOE = 65536;
constexpr int CW_TMO = 0, CW_CODE = 1, CW_BAR = 4096, CW_CNT = 16384;
constexpr int RING_OFF = 0, RING_BYTES = 131072;
constexpr int LDSCTL_OFF = RING_BYTES, MISC_OFF = LDSCTL_OFF + 320;
constexpr int SCR_OFF = RING_BYTES + 1024;
constexpr int LDS_BYTES = 155648;
constexpr int SCR_BYTES = LDS_BYTES - SCR_OFF;

typedef GAS unsigned gu32;
#define RLX_AGENT __ATOMIC_RELAXED, __HIP_MEMORY_SCOPE_AGENT

#define XB_TMO      128
#define XB_XCNT(j)  (256  + 64 * (j))
#define XB_XSUB(j)  (1280 + 64 * (j))
#define XB_XGEN(j)  (2304 + 64 * (j))
#define XB_TOP      3328
#define XB_TOPGEN   3392
#define XCD_BAR_WORDS 3456
#define XB_SPIN_CAP (1u << 18)
__device__ __forceinline__ unsigned xb_ld(unsigned* p)              { return __hip_atomic_load(p, __ATOMIC_RELAXED, __HIP_MEMORY_SCOPE_AGENT); }
__device__ __forceinline__ unsigned xb_add(unsigned* p, unsigned v) { return __hip_atomic_fetch_add(p, v, __ATOMIC_RELAXED, __HIP_MEMORY_SCOPE_AGENT); }
__device__ __forceinline__ unsigned xb_xcc_id() { return (unsigned)__builtin_amdgcn_s_getreg((3 << 11) | 20) & 0xFu; }
#define XB_SPIN(cond, bar) do { unsigned _sp = 0; while (cond) { __builtin_amdgcn_s_sleep(1); \
    if ((++_sp & 255u) == 0u) { if (xb_ld(&(bar)[XB_TMO])) break; if (_sp > XB_SPIN_CAP) { atomicAdd(&(bar)[XB_TMO], 1u); break; } } } } while (0)
struct XcdBarrier { unsigned* bar; unsigned x; volatile LAS unsigned* st; };
__device__ __forceinline__ XcdBarrier xcd_barrier_post(unsigned* bar, volatile LAS unsigned* st) {
    XcdBarrier b; b.bar = bar; b.x = xb_xcc_id(); b.st = st;
    if (threadIdx.x == 0) (void)xb_add(&bar[XB_XCNT(b.x)], 1u);
    return b;
}
__device__ __forceinline__ void xcd_barrier_complete(unsigned* bar, unsigned x, unsigned& nloc, unsigned& nx) {
    const unsigned G = gridDim.x * gridDim.y * gridDim.z;
    unsigned sum, cnt, mine, sp = 0u;
    for (;;) {
        sum = 0u; cnt = 0u; mine = 0u;
#pragma unroll
        for (unsigned j = 0; j < 16; ++j) { const unsigned c = xb_ld(&bar[XB_XCNT(j)]); sum += c; cnt += (c > 0u) ? 1u : 0u; mine = (j == x) ? c : mine; }
        if (sum == G) break;
        __builtin_amdgcn_s_sleep(1);
        if ((++sp & 255u) == 0u) { if (xb_ld(&bar[XB_TMO])) break; if (sp > XB_SPIN_CAP) { atomicAdd(&bar[XB_TMO], 1u); break; } }
    }
    nloc = mine > 0u ? mine : 1u; nx = cnt > 0u ? cnt : 1u;
}
__device__ __forceinline__ void xcd_barrier(const XcdBarrier& b) {
    asm volatile("s_waitcnt vmcnt(0)" ::: "memory");
    __syncthreads();
    if (threadIdx.x == 0) {
        unsigned* bar = b.bar;
        __builtin_amdgcn_s_waitcnt(0);
        unsigned nloc = b.st[0], nx = b.st[1];
        if (nloc == 0u) { xcd_barrier_complete(bar, b.x, nloc, nx); b.st[0] = nloc; b.st[1] = nx; }
        const unsigned old = xb_add(&bar[XB_XSUB(b.x)], 1u);
        const unsigned gen = old / nloc;
        if (old + 1u == (gen + 1u) * nloc) {
            __builtin_amdgcn_fence(__ATOMIC_RELEASE, "agent");
            asm volatile("s_waitcnt vmcnt(0)" ::: "memory");
            const unsigned og = xb_add(&bar[XB_TOP], 1u);
            const unsigned tg = og / nx;
            if (og + 1u == (tg + 1u) * nx) xb_add(&bar[XB_TOPGEN], 1u);
            else XB_SPIN(xb_ld(&bar[XB_TOPGEN]) == tg, bar);
            __builtin_amdgcn_fence(__ATOMIC_ACQUIRE, "agent");
            xb_add(&bar[XB_XGEN(b.x)], 1u);
            asm volatile("s_waitcnt vmcnt(0)" ::: "memory");
        } else {
            XB_SPIN(xb_ld(&bar[XB_XGEN(b.x)]) == gen, bar);
            __builtin_amdgcn_fence(__ATOMIC_ACQUIRE, "agent");
            asm volatile("s_waitcnt vmcnt(0)" ::: "memory");
        }
    }
    __syncthreads();
}

struct Args {
    const float* in[24]; float* out; unsigned char* ws; int stage_limit; int pad;
};
enum { I_X = 0, I_MIXN, I_FFNN, I_EWIN, I_EWS, I_EBS, I_EGV, I_EGQ, I_EGK, I_EWOUT, I_OWIN, I_OGCQ, I_OGCKV, I_OWUQ, I_OWUKV, I_OGQ, I_OGK, I_OWOUT,
       I_RW, I_RB, I_W1, I_B1, I_W2, I_B2 };

struct Frame {
    LAS unsigned char* lds;
    int vcu, G;
};

__device__ __forceinline__ float wave_sum(float v) {
#pragma unroll
    for (int o = 1; o < 64; o <<= 1) v += __shfl_xor(v, o);
    return v;
}
#define LDS_WAIT() asm volatile("s_waitcnt lgkmcnt(0)" ::: "memory")

template <int MODE> __device__ __forceinline__ int dst_row(int o) {
    if (MODE == 1) { if (o >= 1024 && o < 2048) return (o & ~255) | (((o >> 5) & 1) << 7) | (((o >> 6) & 3) << 5) | (o & 31); return o; }
    if (MODE == 2) return ((o >> 8) << 8) | ((o & 1) << 7) | ((o & 255) >> 1);
    return o;
}
template <int MODE>
__device__ __forceinline__ void transpose_item(const float* __restrict__ W, int K, int N, bf16_t* __restrict__ WT, const float* __restrict__ gain, LAS float* scr, int item, int lane) {
    const int nblk = N / 32, kb = item / nblk, nb = item % nblk, k0 = 64 * kb, n0 = 32 * nb;
#pragma unroll 8
    for (int i = 0; i < 32; ++i) { const int kk = 2 * i + (lane >> 5); float w = W[(size_t)(k0 + kk) * N + n0 + (lane & 31)]; if (gain) w *= gain[k0 + kk]; scr[kk * 33 + (lane & 31)] = w; }
    LDS_WAIT(); asm volatile("" ::: "memory");
    const int c = lane & 7;
#pragma unroll
    for (int j = 0; j < 4; ++j) { const int n = (lane >> 3) + 8 * j; const LAS float* s = scr + (8 * c) * 33 + n;
        u32x4 o; o.x = cvt_pk_bf16(s[0 * 33], s[1 * 33]); o.y = cvt_pk_bf16(s[2 * 33], s[3 * 33]); o.z = cvt_pk_bf16(s[4 * 33], s[5 * 33]); o.w = cvt_pk_bf16(s[6 * 33], s[7 * 33]);
        *(u32x4*)(WT + (size_t)dst_row<MODE>(n0 + n) * K + k0 + 8 * c) = o; }
    LDS_WAIT(); asm volatile("" ::: "memory");
}
template <int MODE>
__device__ __forceinline__ void transpose_job(Frame& F, const float* W, int K, int N, int nmat, size_t src_stride, bf16_t* WT, size_t dst_stride, const float* gain, int gain_stride) {
    int tid_ = threadIdx.x; asm volatile("" : "+v"(tid_));
    const int wave = __builtin_amdgcn_readfirstlane(tid_ >> 6), lane = tid_ & 63;
    LAS float* scr = (LAS float*)(F.lds + RING_OFF + wave * 16384);
    const int gw = F.vcu * NWAVES + wave, NGW = F.G * NWAVES;
    const int per = (K / 64) * (N / 32), total = per * nmat;
    for (int it = gw; it < total; it += NGW) { const int mi = it / per, item = it - mi * per;
        transpose_item<MODE>(W + (size_t)mi * src_stride, K, N, WT + (size_t)mi * dst_stride, gain ? gain + (size_t)mi * gain_stride : nullptr, scr, item, lane); }
}


__device__ __forceinline__ void tr8_load(f32x4 (&v)[8], const float* __restrict__ W, int N, int item, int lane) {
    const int nblk = N / 32, kb = item / nblk, nb = item % nblk, k0 = 64 * kb, n0 = 32 * nb;
#pragma unroll
    for (int i = 0; i < 8; ++i) v[i] = __builtin_nontemporal_load((const f32x4*)(W + (size_t)(k0 + 8 * i + (lane >> 3)) * N + n0 + 4 * (lane & 7)));
}
template <int MODE>
__device__ __forceinline__ void tr8_store(const f32x4 (&v)[8], int K, int N, unsigned char* __restrict__ WT, const float* __restrict__ gain, LAS float* scr, int item, int lane) {
    const int nblk = N / 32, kb = item / nblk, nb = item % nblk, k0 = 64 * kb, n0 = 32 * nb;
#pragma unroll
    for (int i = 0; i < 8; ++i) { LAS float* d = scr + (8 * i + (lane >> 3)) * 33 + 4 * (lane & 7); const float sc = gain ? W8_SCALE * gain[k0 + 8 * i + (lane >> 3)] : W8_SCALE;
        d[0] = v[i].x * sc; d[1] = v[i].y * sc; d[2] = v[i].z * sc; d[3] = v[i].w * sc; }
    LDS_WAIT(); asm volatile("" ::: "memory");
    const int c = lane & 3;
#pragma unroll
    for (int j = 0; j < 2; ++j) { const int n = (lane >> 2) + 16 * j; const LAS float* s = scr + (16 * c) * 33 + n;
        u32x4 o; o.x = pk4_fp8(s[0 * 33], s[1 * 33], s[2 * 33], s[3 * 33]); o.y = pk4_fp8(s[4 * 33], s[5 * 33], s[6 * 33], s[7 * 33]);
        o.z = pk4_fp8(s[8 * 33], s[9 * 33], s[10 * 33], s[11 * 33]); o.w = pk4_fp8(s[12 * 33], s[13 * 33], s[14 * 33], s[15 * 33]);
        __builtin_nontemporal_store(o, (u32x4*)(WT + (size_t)dst_row<MODE>(n0 + n) * K + k0 + 16 * c)); }
    LDS_WAIT(); asm volatile("" ::: "memory");
}
template <int MODE>
__device__ __forceinline__ void transpose_job_fp8(Frame& F, const float* W, int K, int N, int nmat, size_t src_stride, unsigned char* WT, size_t dst_stride, const float* gain = nullptr, int gain_stride = 0) {
    int tid_ = threadIdx.x; asm volatile("" : "+v"(tid_));
    const int wave = __builtin_amdgcn_readfirstlane(tid_ >> 6), lane = tid_ & 63;
    LAS float* scr = (LAS float*)(F.lds + RING_OFF + wave * 16384);
    const int gw = F.vcu * NWAVES + wave, NGW = F.G * NWAVES;
    const int per = (K / 64) * (N / 32), total = per * nmat;
    f32x4 cur[8], nxt[8];
    int it = gw;
    if (it < total) { const int mi = it / per; tr8_load(cur, W + (size_t)mi * src_stride, N, it - mi * per, lane); }
    for (; it < total; it += NGW) {
        const int itn = it + NGW;
        if (itn < total) { const int mn = itn / per; tr8_load(nxt, W + (size_t)mn * src_stride, N, itn - mn * per, lane); }
        const int mi = it / per;
        tr8_store<MODE>(cur, K, N, WT + (size_t)mi * dst_stride, gain ? gain + (size_t)mi * gain_stride : nullptr, scr, it - mi * per, lane);
#pragma unroll
        for (int i = 0; i < 8; ++i) cur[i] = nxt[i];
    }
}

__device__ __forceinline__ void rms_row_to_fp8(int lane, const float* xrow, const float* g, unsigned char* orow, float* copy) {
    const f32x4* xr = (const f32x4*)xrow + lane; const f32x4* gr = (const f32x4*)g + lane;
    f32x4 v[4]; float s = 0.f;
#pragma unroll
    for (int j = 0; j < 4; ++j) { v[j] = xr[64 * j]; s += (v[j].x * v[j].x + v[j].y * v[j].y) + (v[j].z * v[j].z + v[j].w * v[j].w); }
    const float rstd = 1.0f / sqrtf(wave_sum(s) * (1.f / DM) + EPS);
    unsigned* o4 = (unsigned*)orow + lane;
#pragma unroll
    for (int j = 0; j < 4; ++j) { const f32x4 gg = gr[64 * j]; if (copy) ((f32x4*)copy + lane)[64 * j] = v[j];
        o4[64 * j] = pk4_fp8(v[j].x * rstd * gg.x, v[j].y * rstd * gg.y, v[j].z * rstd * gg.z, v[j].w * rstd * gg.w); }
}
__device__ __forceinline__ void rms_row_to_bf16(int lane, const float* xrow, const float* g, bf16_t* orow, float* copy) {
    const f32x4* xr = (const f32x4*)xrow + lane; const f32x4* gr = (const f32x4*)g + lane;
    f32x4 v[4]; float s = 0.f;
#pragma unroll
    for (int j = 0; j < 4; ++j) { v[j] = xr[64 * j]; s += (v[j].x * v[j].x + v[j].y * v[j].y) + (v[j].z * v[j].z + v[j].w * v[j].w); }
    const float rstd = 1.0f / sqrtf(wave_sum(s) * (1.f / DM) + EPS);
    u32x2* o8 = (u32x2*)orow + lane;
#pragma unroll
    for (int j = 0; j < 4; ++j) { const f32x4 gg = gr[64 * j]; if (copy) ((f32x4*)copy + lane)[64 * j] = v[j];
        u32x2 w; w.x = cvt_pk_bf16(v[j].x * rstd * gg.x, v[j].y * rstd * gg.y); w.y = cvt_pk_bf16(v[j].z * rstd * gg.z, v[j].w * rstd * gg.w); o8[64 * j] = w; }
}

namespace pg8 {
struct EpiEvenIn {
    static constexpr bool PERM = false;
    bf16_t* Z; const float* gq; const float* gk;
    __device__ __forceinline__ void operator()(const f32x4 (&acc)[2][2][4][2], const Unit& u, int wr, int wc, int fr, int fq) const {
        const int row0 = u.pm * BM + wr * 64 + fr, pn = u.pn;
        if (pn >= 4 && pn < 8) {
            const float* g = pn < 6 ? gq : gk; const float sc = pn < 6 ? C2_B : 1.0f;
            f32x4 gv[2][2];
#pragma unroll
            for (int bj = 0; bj < 2; ++bj)
#pragma unroll
                for (int n = 0; n < 2; ++n) gv[bj][n] = *(const f32x4*)(g + 32 * bj + 16 * n + 4 * fq);
#pragma unroll
            for (int ai = 0; ai < 2; ++ai)
#pragma unroll
                for (int m = 0; m < 4; ++m) {
                    float ss = 0.f;
#pragma unroll
                    for (int bj = 0; bj < 2; ++bj)
#pragma unroll
                        for (int n = 0; n < 2; ++n) { const f32x4 v = acc[ai][bj][m][n]; ss += (v[0] * v[0] + v[1] * v[1]) + (v[2] * v[2] + v[3] * v[3]); }
                    ss += __shfl_xor(ss, 16); ss += __shfl_xor(ss, 32);
                    const float rstd = sc / sqrtf(ss * (1.0f / 64.0f) + EPS);
                    bf16_t* rowp = Z + (size_t)(row0 + ai * HALF + m * 16) * EVEN_IN + pn * BM + wc * 64 + 4 * fq;
#pragma unroll
                    for (int bj = 0; bj < 2; ++bj)
#pragma unroll
                        for (int n = 0; n < 2; ++n) { const f32x4 v = acc[ai][bj][m][n] * rstd * gv[bj][n];
                            u32x2 w; w.x = cvt_pk_bf16(v[0], v[1]); w.y = cvt_pk_bf16(v[2], v[3]); *(u32x2*)(rowp + 32 * bj + 16 * n) = w; }
                }
        } else {
            const bool act = pn < 4;
#pragma unroll
            for (int ai = 0; ai < 2; ++ai)
#pragma unroll
                for (int m = 0; m < 4; ++m) { bf16_t* rowp = Z + (size_t)(row0 + ai * HALF + m * 16) * EVEN_IN + pn * BM + wc * 32 + 4 * fq;
#pragma unroll
                    for (int bj = 0; bj < 2; ++bj)
#pragma unroll
                        for (int n = 0; n < 2; ++n) { f32x4 v = acc[ai][bj][m][n]; if (act) v = gelu4(v);
                            u32x2 w; w.x = cvt_pk_bf16(v[0], v[1]); w.y = cvt_pk_bf16(v[2], v[3]); *(u32x2*)(rowp + bj * HALF + 16 * n) = w; } }
        }
    }
};
template <bool F8 = false> struct EpiResidT {
    static constexpr bool PERM = false;
    const float* src; float* out;
    __device__ __forceinline__ void operator()(const f32x4 (&acc)[2][2][4][2], const Unit& u, int wr, int wc, int fr, int fq) const {
        const int row0 = u.pm * BM + wr * 64 + fr;
#pragma unroll
        for (int ai = 0; ai < 2; ++ai)
#pragma unroll
            for (int m = 0; m < 4; ++m) { const size_t ro = (size_t)(row0 + ai * HALF + m * 16) * DM + u.pn * BM + wc * 32 + 4 * fq;
#pragma unroll
                for (int bj = 0; bj < 2; ++bj)
#pragma unroll
                    for (int n = 0; n < 2; ++n) { const size_t o_ = ro + bj * HALF + 16 * n; *(f32x4*)(out + o_) = *(const f32x4*)(src + o_) + (F8 ? acc[ai][bj][m][n] * W8_INV : acc[ai][bj][m][n]); }
                if (m & 1) asm volatile("" ::: "memory"); }
    }
};
typedef EpiResidT<false> EpiResid;
struct EpiOddIn {
    static constexpr bool PERM = false;
    bf16_t* Z; unsigned char* Z8; float* ssq;
    __device__ __forceinline__ void operator()(const f32x4 (&acc)[2][2][4][2], const Unit& u, int wr, int wc, int fr, int fq) const {
        const int row0 = u.pm * BM + wr * 64 + fr, pn = u.pn;
#pragma unroll
        for (int ai = 0; ai < 2; ++ai)
#pragma unroll
            for (int m = 0; m < 4; ++m) { const int row = row0 + ai * HALF + m * 16; bf16_t* rowp = Z + (size_t)row * ODD_INP + pn * BM + wc * 32 + 4 * fq;
                float ss = 0.f;
#pragma unroll
                for (int bj = 0; bj < 2; ++bj)
#pragma unroll
                    for (int n = 0; n < 2; ++n) { const f32x4 v = acc[ai][bj][m][n] * W8_INV; ss += (v[0] * v[0] + v[1] * v[1]) + (v[2] * v[2] + v[3] * v[3]);
                        if (pn < 3) *(unsigned*)(Z8 + (size_t)row * ODD_INP + pn * BM + wc * 32 + 4 * fq + bj * HALF + 16 * n) = pk4_fp8(v[0], v[1], v[2], v[3]);
                        else { u32x2 w; w.x = cvt_pk_bf16(v[0], v[1]); w.y = cvt_pk_bf16(v[2], v[3]); *(u32x2*)(rowp + bj * HALF + 16 * n) = w; } }
                ss += __shfl_xor(ss, 16); ss += __shfl_xor(ss, 32);
                if (fq == 0) ssq[(size_t)row * 16 + pn * 4 + wc] = ss; }
    }
};
template <int NS> struct EpiRowScale {
    static constexpr bool PERM = true;
    bf16_t* O; int ldc; const float* ssq; int s0; float inv_cols;
    __device__ __forceinline__ void operator()(const f32x4 (&acc)[2][2][4][2], const Unit& u, int wr, int wc, int fr, int fq) const {
        const int row0 = u.pm * BM + wr * 64 + fr; const int col0 = u.pn * BM + wc * 32 + 8 * fq;
#pragma unroll
        for (int ai = 0; ai < 2; ++ai)
#pragma unroll
            for (int m = 0; m < 4; ++m) { const int row = row0 + ai * HALF + m * 16;
                float ss = 0.f; const f32x4* sp = (const f32x4*)(ssq + (size_t)row * 16 + s0);
#pragma unroll
                for (int q = 0; q < NS; ++q) { const f32x4 t = sp[q]; ss += (t[0] + t[1]) + (t[2] + t[3]); }
                const float rstd = W8_INV / sqrtf(ss * inv_cols + EPS);
                bf16_t* rowp = O + (size_t)row * ldc + col0;
#pragma unroll
                for (int bj = 0; bj < 2; ++bj) { const f32x4 v0 = acc[ai][bj][m][0] * rstd, v1 = acc[ai][bj][m][1] * rstd;
                    u32x4 w; w.x = cvt_pk_bf16(v0[0], v0[1]); w.y = cvt_pk_bf16(v0[2], v0[3]); w.z = cvt_pk_bf16(v1[0], v1[1]); w.w = cvt_pk_bf16(v1[2], v1[3]);
                    *(u32x4*)(rowp + bj * HALF) = w; }
                asm volatile("" ::: "memory"); }
    }
};
__device__ __forceinline__ void store8_sc1(void* p, u32x2 v) { asm volatile("global_store_dwordx2 %0, %1, off sc1" :: "v"(p), "v"(v) : "memory"); }
template <bool WT = false> struct EpiSwigluT {
    static constexpr bool PERM = true;
    unsigned char* ACT; const float* b1p;
    __device__ __forceinline__ void operator()(const f32x4 (&acc)[2][2][4][2], const Unit& u, int wr, int wc, int fr, int fq) const {
        const int row0 = u.pm * BM + wr * 64 + fr, e = u.pb >> 3, pn = u.pn;
        const float* bp = b1p + (size_t)e * 2048 + pn * BM + wc * 32 + 8 * fq;
        f32x4 bg[2], bl[2];
#pragma unroll
        for (int n = 0; n < 2; ++n) { bg[n] = *(const f32x4*)(bp + 4 * n); bl[n] = *(const f32x4*)(bp + HALF + 4 * n); }
#pragma unroll
        for (int ai = 0; ai < 2; ++ai)
#pragma unroll
            for (int m = 0; m < 4; ++m) { unsigned char* rowp = ACT + (size_t)(row0 + ai * HALF + m * 16) * DE + pn * HALF + wc * 32 + 8 * fq;
                float a[8];
#pragma unroll
                for (int n = 0; n < 2; ++n) { const f32x4 gv = acc[ai][0][m][n] * W8_INV + bg[n], lv = acc[ai][1][m][n] * W8_INV + bl[n];
#pragma unroll
                    for (int i = 0; i < 4; ++i) { const float gl = fminf(gv[i], 7.0f), li = fminf(fmaxf(lv[i], -7.0f), 7.0f);
                        const float sg = __builtin_amdgcn_rcpf(1.0f + __builtin_amdgcn_exp2f(-1.702f * LOG2E * gl));
                        a[4 * n + i] = gl * sg * (li + 1.0f); } }
                u32x2 w; w.x = pk4_fp8(a[0], a[1], a[2], a[3]); w.y = pk4_fp8(a[4], a[5], a[6], a[7]);
                if (WT) store8_sc1(rowp, w); else *(u32x2*)rowp = w; }
    }
};
typedef EpiSwigluT<false> EpiSwiglu;
struct EpiDown {
    static constexpr bool PERM = true;
    bf16_t* Y; const float* b2;
    __device__ __forceinline__ void operator()(const f32x4 (&acc)[2][2][4][2], const Unit& u, int wr, int wc, int fr, int fq) const {
        const int row0 = u.pm * BM + wr * 64 + fr, e = u.pb >> 2, pn = u.pn;
        const float* bp = b2 + (size_t)e * DM + pn * BM + wc * 32 + 8 * fq;
        f32x4 bv[2][2];
#pragma unroll
        for (int bj = 0; bj < 2; ++bj)
#pragma unroll
            for (int n = 0; n < 2; ++n) bv[bj][n] = *(const f32x4*)(bp + bj * HALF + 4 * n);
#pragma unroll
        for (int ai = 0; ai < 2; ++ai)
#pragma unroll
            for (int m = 0; m < 4; ++m) { bf16_t* rowp = Y + (size_t)(row0 + ai * HALF + m * 16) * DM + pn * BM + wc * 32 + 8 * fq;
#pragma unroll
                for (int bj = 0; bj < 2; ++bj) { const f32x4 v0 = acc[ai][bj][m][0] * W8_INV + bv[bj][0], v1 = acc[ai][bj][m][1] * W8_INV + bv[bj][1];
                    u32x4 w; w.x = cvt_pk_bf16(v0[0], v0[1]); w.y = cvt_pk_bf16(v0[2], v0[3]); w.z = cvt_pk_bf16(v1[0], v1[1]); w.w = cvt_pk_bf16(v1[2], v1[3]);
                    *(u32x4*)(rowp + bj * HALF) = w; } }
    }
};
struct MoeOrder {
    const LAS int* tbl; int nN, G, c;
    __device__ bool next(int i, Unit& u) const {
        const long L = (long)i * G + c; const int rb = (int)(L / nN);
        if (rb >= __builtin_amdgcn_readfirstlane(tbl[32])) return false;
        int e = 0;
#pragma unroll
        for (int k = 1; k < 32; ++k) e += (tbl[k] <= rb) ? 1 : 0;
        e = __builtin_amdgcn_readfirstlane(e); const int rbl = __builtin_amdgcn_readfirstlane(rb - tbl[e]);
        u.pm = e * (ECAP / BM) + rbl; u.pn = (int)(L % nN); u.pb = e * nN + u.pn; u.kind = 0; u.rb = rb; return true;
    }
    __device__ __forceinline__ void a_ready(const Unit&) const {}
    __device__ __forceinline__ void pre_epi() const {}
    __device__ __forceinline__ void done(const Unit&) const {}
    __device__ __forceinline__ void finish() const {}
};

constexpr unsigned MOE_SPIN_CAP = 1u << 22;
struct MoeMergedOrder {
    const LAS int* tbl; int G, c; gu32* cnt;
    mutable int pend;
    __device__ __forceinline__ void flush() const {
        if (pend >= 0) { asm volatile("s_waitcnt vmcnt(0)" ::: "memory");
            if ((threadIdx.x & 63) == 0) __hip_atomic_fetch_add(cnt + 16 * pend, 1u, __ATOMIC_RELAXED, __HIP_MEMORY_SCOPE_AGENT);
            pend = -1; } }
    __device__ bool next(int i, Unit& u) const {
        const int nb = __builtin_amdgcn_readfirstlane(tbl[32]);
        long L = (long)i * G + c; int nN = 8, kind = 0;
        if (L >= (long)nb * 8) { L -= (long)nb * 8; nN = 4; kind = 1; if (L >= (long)nb * 4) return false; }
        const int rb = (int)(L / nN);
        int e = 0;
#pragma unroll
        for (int k = 1; k < 32; ++k) e += (tbl[k] <= rb) ? 1 : 0;
        e = __builtin_amdgcn_readfirstlane(e); const int rbl = __builtin_amdgcn_readfirstlane(rb - tbl[e]);
        u.pm = e * (ECAP / BM) + rbl; u.pn = (int)(L % nN); u.pb = e * nN + u.pn; u.kind = kind; u.rb = rb; return true;
    }
    __device__ __forceinline__ void a_ready(const Unit& u) const {
        if (u.kind == 1) {
            flush();
            if (threadIdx.x < 64) {
                unsigned sp = 0;
                while ((unsigned)__builtin_amdgcn_readfirstlane(__hip_atomic_load(cnt + 16 * u.rb, __ATOMIC_RELAXED, __HIP_MEMORY_SCOPE_AGENT)) < 64u) { __builtin_amdgcn_s_sleep(2); if (++sp > MOE_SPIN_CAP) break; }
                __builtin_amdgcn_fence(__ATOMIC_ACQUIRE, "agent");
                asm volatile("s_waitcnt vmcnt(0)" ::: "memory");
            }
            __builtin_amdgcn_s_barrier();
        }
    }
    __device__ __forceinline__ void pre_epi() const { flush(); }
    __device__ __forceinline__ void done(const Unit& u) const { if (u.kind == 0) pend = u.rb; }
    __device__ __forceinline__ void finish() const { flush(); }
};
struct EpiMoe {
    static constexpr bool PERM = true;
    EpiSwigluT<true> up; EpiDown down;
    __device__ __forceinline__ void operator()(const f32x4 (&acc)[2][2][4][2], const Unit& u, int wr, int wc, int fr, int fq) const {
        if (u.kind == 0) up(acc, u, wr, wc, fr, fq); else down(acc, u, wr, wc, fr, fq);
    }
};
}

__device__ __forceinline__ void gmlp_unit(Frame& F, const bf16_t* Z, bf16_t* MIX, const float* Ws, const float* bs, const float* gv, int unit) {
    constexpr int VP = 272;
    LAS unsigned char* VT = F.lds + RING_OFF;
    const int h = unit & 3, chunk = unit >> 2;
    int tid_ = threadIdx.x; asm volatile("" : "+v"(tid_));
    const int t0 = chunk * 128, tid = tid_, lane = tid & 63, w = __builtin_amdgcn_readfirstlane(tid >> 6);
    {
        const int s = tid >> 2, dq = (tid & 3) * 32;
        const bf16_t* vp = Z + (size_t)(t0 + s) * EVEN_IN + 512 + h * 128 + dq;
        u32x4 raw[4]; float ss = 0.f;
#pragma unroll
        for (int i = 0; i < 4; ++i) { raw[i] = *(const u32x4*)(vp + 8 * i);
#pragma unroll
            for (int j = 0; j < 4; ++j) { const float a = bflo(raw[i][j]), b = bfhi(raw[i][j]); ss += a * a + b * b; } }
        ss += __shfl_xor(ss, 1); ss += __shfl_xor(ss, 2);
        const float rstd = 1.0f / sqrtf(ss * (1.0f / 128.0f) + EPS);
#pragma unroll
        for (int i = 0; i < 4; ++i)
#pragma unroll
            for (int j = 0; j < 4; ++j) { const int d = dq + 8 * i + 2 * j;
                *(LAS bf16_t*)(VT + (d) * VP + s * 2) = f2bf(bflo(raw[i][j]) * rstd);
                *(LAS bf16_t*)(VT + (d + 1) * VP + s * 2) = f2bf(bfhi(raw[i][j]) * rstd); }
    }
    __syncthreads();
    const int fr = lane & 15, fq = lane >> 4;
    f32x4 acc[8];
#pragma unroll
    for (int nb = 0; nb < 8; ++nb) acc[nb] = (f32x4){0.f, 0.f, 0.f, 0.f};
    const int trow = 16 * w + fr;
    const float* wrow = Ws + ((size_t)h * 128 + trow) * 128;
#pragma unroll
    for (int ks = 0; ks < 4; ++ks) {
        if (32 * ks <= 16 * w + 15) {
            const int s0 = 32 * ks + 8 * fq;
            const f32x4 wa = *(const f32x4*)(wrow + s0), wb = *(const f32x4*)(wrow + s0 + 4);
            float wv[8] = {wa[0], wa[1], wa[2], wa[3], wb[0], wb[1], wb[2], wb[3]};
#pragma unroll
            for (int j = 0; j < 8; ++j) if (s0 + j > trow) wv[j] = 0.f;
            u32x4 aw; aw.x = cvt_pk_bf16(wv[0], wv[1]); aw.y = cvt_pk_bf16(wv[2], wv[3]); aw.z = cvt_pk_bf16(wv[4], wv[5]); aw.w = cvt_pk_bf16(wv[6], wv[7]);
            const bf16x8 af = __builtin_bit_cast(bf16x8, aw);
#pragma unroll
            for (int nb = 0; nb < 8; ++nb) { const bf16x8 bfr = *(const LAS bf16x8*)(VT + (16 * nb + fr) * VP + s0 * 2);
                acc[nb] = __builtin_amdgcn_mfma_f32_16x16x32_bf16(af, bfr, acc[nb], 0, 0, 0); }
        }
    }
    LAS bf16_t* DT = (LAS bf16_t*)(F.lds + RING_OFF + 36864);
#pragma unroll
    for (int i = 0; i < 4; ++i) { const int tl = 16 * w + 4 * fq + i; const float bt = bs[h * 128 + tl];
#pragma unroll
        for (int nb = 0; nb < 8; ++nb) DT[tl * 136 + 16 * nb + fr] = f2bf(gv[h * 128 + 16 * nb + fr] * acc[nb][i] + bt); }
    __syncthreads();
#pragma unroll
    for (int k = 0; k < 4; ++k) { const int idx = tid + 512 * k, tl = idx >> 4, c8 = (idx & 15) * 8;
        const u32x4 mv = *(const LAS u32x4*)(DT + tl * 136 + c8); const u32x4 uv = *(const u32x4*)(Z + (size_t)(t0 + tl) * EVEN_IN + h * 128 + c8);
        u32x4 o; o.x = cvt_pk_bf16(bflo(uv.x) * bflo(mv.x), bfhi(uv.x) * bfhi(mv.x)); o.y = cvt_pk_bf16(bflo(uv.y) * bflo(mv.y), bfhi(uv.y) * bfhi(mv.y));
        o.z = cvt_pk_bf16(bflo(uv.z) * bflo(mv.z), bfhi(uv.z) * bfhi(mv.z)); o.w = cvt_pk_bf16(bflo(uv.w) * bflo(mv.w), bfhi(uv.w) * bfhi(mv.w));
        *(u32x4*)(MIX + (size_t)(t0 + tl) * DM + h * 128 + c8) = o; }
    __syncthreads();
}

__device__ __forceinline__ void router_phase(Frame& F, const float* x, const float* gain, const float* Wr, const float* br, gu32* cnt  ,
                                             unsigned* tok_er, float* tok_g, unsigned char* XG) {
    LAS float* part = (LAS float*)(F.lds + RING_OFF);
    LAS float* ssqp = (LAS float*)(F.lds + RING_OFF + 8 * 64 * 33 * 4);
    LAS float* lg = (LAS float*)(F.lds + SCR_OFF);
    LAS unsigned* hist = (LAS unsigned*)(F.lds + SCR_OFF + 64 * 33 * 4);
    LAS unsigned* base = hist + 32;
    LAS unsigned* ers = base + 32;
    int tid_ = threadIdx.x; asm volatile("" : "+v"(tid_));
    const int tid = tid_, lane = tid & 63, w = __builtin_amdgcn_readfirstlane(tid >> 6), r32 = lane & 31, hi = lane >> 5;
#ifndef RTR_REP_A
#define RTR_REP_A 1
#define RTR_REP_B 1
#define RTR_REP_C 1
#endif
    f32x4 gg[4];
#pragma unroll
    for (int j = 0; j < 4; ++j) gg[j] = ((const f32x4*)gain + lane)[64 * j];
    {   const int tg = F.vcu;
    const int tokb = tg * 64;
    if (tid < 32) hist[tid] = 0u;
    for (int rb_ = 0; rb_ < RTR_REP_B; ++rb_) {
        bf16x8 wh[8], wl[8];
#pragma unroll
        for (int ks = 0; ks < 8; ++ks) { float wv[8];
#pragma unroll
            for (int j = 0; j < 8; ++j) { const int k = 128 * w + 16 * ks + 8 * hi + j; wv[j] = Wr[(size_t)k * NE + r32] * gain[k]; }
            u32x4 h4, l4;
#pragma unroll
            for (int j = 0; j < 4; ++j) { const unsigned hp = cvt_pk_bf16(wv[2 * j], wv[2 * j + 1]); h4[j] = hp; l4[j] = cvt_pk_bf16(wv[2 * j] - bflo(hp), wv[2 * j + 1] - bfhi(hp)); }
            wh[ks] = __builtin_bit_cast(bf16x8, h4); wl[ks] = __builtin_bit_cast(bf16x8, l4); }
#pragma unroll
        for (int g2 = 0; g2 < 2; ++g2) {
            const float* xr = x + (size_t)(tokb + 32 * g2 + r32) * DM + 128 * w + 8 * hi;
            f32x16 d = f32x16{}; float ss = 0.f;
#pragma unroll
            for (int ks = 0; ks < 8; ++ks) { const f32x4 xa = *(const f32x4*)(xr + 16 * ks), xb = *(const f32x4*)(xr + 16 * ks + 4);
                ss += (xa.x * xa.x + xa.y * xa.y) + (xa.z * xa.z + xa.w * xa.w) + (xb.x * xb.x + xb.y * xb.y) + (xb.z * xb.z + xb.w * xb.w);
                u32x4 h4, l4;
                h4.x = cvt_pk_bf16(xa.x, xa.y); h4.y = cvt_pk_bf16(xa.z, xa.w); h4.z = cvt_pk_bf16(xb.x, xb.y); h4.w = cvt_pk_bf16(xb.z, xb.w);
                l4.x = cvt_pk_bf16(xa.x - bflo(h4.x), xa.y - bfhi(h4.x)); l4.y = cvt_pk_bf16(xa.z - bflo(h4.y), xa.w - bfhi(h4.y));
                l4.z = cvt_pk_bf16(xb.x - bflo(h4.z), xb.y - bfhi(h4.z)); l4.w = cvt_pk_bf16(xb.z - bflo(h4.w), xb.w - bfhi(h4.w));
                const bf16x8 xh = __builtin_bit_cast(bf16x8, h4), xl = __builtin_bit_cast(bf16x8, l4);
                d = __builtin_amdgcn_mfma_f32_32x32x16_bf16(wh[ks], xh, d, 0, 0, 0);
                d = __builtin_amdgcn_mfma_f32_32x32x16_bf16(wh[ks], xl, d, 0, 0, 0);
                d = __builtin_amdgcn_mfma_f32_32x32x16_bf16(wl[ks], xh, d, 0, 0, 0); }
            { auto rr = __builtin_amdgcn_permlane32_swap(__float_as_uint(ss), __float_as_uint(ss), false, false); ss = __uint_as_float(rr[0]) + __uint_as_float(rr[1]); }
            if (hi == 0) ssqp[w * 64 + 32 * g2 + r32] = ss;
#pragma unroll
            for (int r = 0; r < 16; ++r) part[(w * 64 + 32 * g2 + r32) * 33 + (r & 3) + 8 * (r >> 2) + 4 * hi] = d[r];
        }
    }
    __syncthreads();
    {   const int t = tid >> 3, q4 = (tid & 7) * 4; float s = 0.f;
#pragma unroll
        for (int ww = 0; ww < 8; ++ww) s += ssqp[ww * 64 + t];
        const float rstd = 1.0f / sqrtf(s * (1.f / DM) + EPS);
#pragma unroll
        for (int i = 0; i < 4; ++i) { float a = 0.f;
#pragma unroll
            for (int ww = 0; ww < 8; ++ww) a += part[(ww * 64 + t) * 33 + q4 + i];
            lg[t * 33 + q4 + i] = a * rstd + br[q4 + i]; } }
    __syncthreads();
    unsigned my_e[4] = {0, 0, 0, 0}, my_lr[4] = {0, 0, 0, 0}; float my_g[4] = {0, 0, 0, 0};
    if (tid < 64) {
        float v[32];
#pragma unroll
        for (int e = 0; e < 32; ++e) v[e] = lg[tid * 33 + e];
        int c0 = -1, c1 = -1, c2 = -1; float tv[4];
#pragma unroll
        for (int r = 0; r < 4; ++r) { float best = -__builtin_inff(); int bi = 0;
#pragma unroll
            for (int e = 0; e < 32; ++e) { const bool ok = (e != c0) && (e != c1) && (e != c2); if (ok && v[e] > best) { best = v[e]; bi = e; } }
            tv[r] = best; my_e[r] = (unsigned)bi; if (r == 0) c0 = bi; else if (r == 1) c1 = bi; else if (r == 2) c2 = bi; }
        const float p1 = __expf(tv[1] - tv[0]), p2 = __expf(tv[2] - tv[0]), p3 = __expf(tv[3] - tv[0]); const float inv = 1.0f / (1.0f + p1 + p2 + p3);
        my_g[0] = inv; my_g[1] = p1 * inv; my_g[2] = p2 * inv; my_g[3] = p3 * inv;
#pragma unroll
        for (int r = 0; r < 4; ++r) my_lr[r] = __hip_atomic_fetch_add(hist + my_e[r], 1u, __ATOMIC_RELAXED, __HIP_MEMORY_SCOPE_WORKGROUP);
    }
    __syncthreads();
    if (tid < 32) { const unsigned hc = hist[tid]; base[tid] = hc ? __hip_atomic_fetch_add(cnt + 64 * tid, hc, RLX_AGENT) : 0u; }
    __syncthreads();
    if (tid < 64) {
        u32x4 er; f32x4 gt;
#pragma unroll
        for (int r = 0; r < 4; ++r) { const unsigned rank = base[my_e[r]] + my_lr[r]; er[r] = (my_e[r] << 16) | rank; gt[r] = my_g[r]; ers[tid * 4 + r] = er[r]; }
        *(u32x4*)(tok_er + (size_t)(tokb + tid) * 4) = er; *(f32x4*)(tok_g + (size_t)(tokb + tid) * 4) = gt;
    }
    __syncthreads();
    for (int rc_ = 0; rc_ < RTR_REP_C; ++rc_)
#pragma unroll 2
    for (int tt = 0; tt < 8; ++tt) {
        const int tl = w * 8 + tt; const float* xrow = x + (size_t)(tokb + tl) * DM;
        f32x4 hv[4]; float s = 0.f;
#pragma unroll
        for (int j = 0; j < 4; ++j) { hv[j] = ((const f32x4*)xrow + lane)[64 * j]; s += (hv[j].x * hv[j].x + hv[j].y * hv[j].y) + (hv[j].z * hv[j].z + hv[j].w * hv[j].w); }
        const float rstd = 1.0f / sqrtf(wave_sum(s) * (1.f / DM) + EPS);
        unsigned wv[4];
#pragma unroll
        for (int j = 0; j < 4; ++j) { const f32x4 t = hv[j] * rstd * gg[j]; wv[j] = pk4_fp8(t.x, t.y, t.z, t.w); }
#pragma unroll
        for (int r = 0; r < 4; ++r) { const unsigned er = ers[tl * 4 + r]; const size_t slot = (size_t)(er >> 16) * ECAP + (er & 0xffffu);
            unsigned* o4 = (unsigned*)(XG + slot * DM) + lane;
#pragma unroll
            for (int j = 0; j < 4; ++j) o4[64 * j] = wv[j]; }
    }
    __syncthreads();
    }
}

__device__ __forceinline__ void combine_phase(Frame& F, const float* x, float* xout, const unsigned* tok_er, const float* tok_g, const bf16_t* Y, const float* g_next, unsigned char* XN, bool xn_fp8) {
    int tid_ = threadIdx.x; asm volatile("" : "+v"(tid_));
    const int gw = F.vcu * NWAVES + __builtin_amdgcn_readfirstlane(tid_ >> 6), NGW = F.G * NWAVES, lane = tid_ & 63;
    for (int m = gw; m < M; m += NGW) {
        const u32x4 er = *(const u32x4*)(tok_er + (size_t)m * 4); const f32x4 gt = *(const f32x4*)(tok_g + (size_t)m * 4);
        f32x4 v[4]; const float* xrow = x + (size_t)m * DM; float* xorow = xout + (size_t)m * DM;
#pragma unroll
        for (int j = 0; j < 4; ++j) v[j] = ((const f32x4*)xrow + lane)[64 * j];
#pragma unroll
        for (int r = 0; r < 4; ++r) { const size_t slot = (size_t)(er[r] >> 16) * ECAP + (er[r] & 0xffffu); const u32x2* yp = (const u32x2*)(Y + slot * DM) + lane; const float g = gt[r];
#pragma unroll
            for (int j = 0; j < 4; ++j) { const u32x2 yv = yp[64 * j]; v[j].x += g * bflo(yv.x); v[j].y += g * bfhi(yv.x); v[j].z += g * bflo(yv.y); v[j].w += g * bfhi(yv.y); } }
#pragma unroll
        for (int j = 0; j < 4; ++j) ((f32x4*)xorow + lane)[64 * j] = v[j];
        if (g_next) {
            float s = 0.f;
#pragma unroll
            for (int j = 0; j < 4; ++j) s += (v[j].x * v[j].x + v[j].y * v[j].y) + (v[j].z * v[j].z + v[j].w * v[j].w);
            const float rstd = 1.0f / sqrtf(wave_sum(s) * (1.f / DM) + EPS);
            unsigned* o4 = (unsigned*)(XN + (size_t)m * DM) + lane; u32x2* o8 = (u32x2*)(XN + (size_t)m * DM * 2) + lane;
#pragma unroll
            for (int j = 0; j < 4; ++j) { const f32x4 gg = ((const f32x4*)g_next + lane)[64 * j];
                if (xn_fp8) o4[64 * j] = pk4_fp8(v[j].x * rstd * gg.x, v[j].y * rstd * gg.y, v[j].z * rstd * gg.z, v[j].w * rstd * gg.w);
                else { u32x2 w; w.x = cvt_pk_bf16(v[j].x * rstd * gg.x, v[j].y * rstd * gg.y); w.y = cvt_pk_bf16(v[j].z * rstd * gg.z, v[j].w * rstd * gg.w); o8[64 * j] = w; } }
        }
    }
}

__device__ __forceinline__ void unpack8(const u32x4 w, float (&f)[8]) { f[0] = bflo(w.x); f[1] = bfhi(w.x); f[2] = bflo(w.y); f[3] = bfhi(w.y); f[4] = bflo(w.z); f[5] = bfhi(w.z); f[6] = bflo(w.w); f[7] = bfhi(w.w); }
__device__ __forceinline__ void unpack4(const u32x2 w, float (&f)[4]) { f[0] = bflo(w.x); f[1] = bfhi(w.x); f[2] = bflo(w.y); f[3] = bfhi(w.y); }
__device__ __forceinline__ void fin_head(const u32x4 n0, const u32x4 n1, const u32x2 r1, const u32x2 r2, const float (&g)[24], const float (&cs)[4], const float (&sn)[4], unsigned char* op, int j) {
    float a[8], b[8], x1[4], x2[4];
    unpack8(n0, a); unpack8(n1, b); unpack4(r1, x1); unpack4(r2, x2);
    float ss = 0.f;
#pragma unroll
    for (int i = 0; i < 8; ++i) ss += a[i] * a[i] + b[i] * b[i];
#pragma unroll
    for (int i = 0; i < 4; ++i) ss += x1[i] * x1[i] + x2[i] * x2[i];
    ss += __shfl_xor(ss, 1); ss += __shfl_xor(ss, 2); ss += __shfl_xor(ss, 4);
    const float rstd = 1.0f / sqrtf(ss * (1.0f / 192.0f) + EPS);
    u32x4 o0;
    o0.x = pk4_fp8(a[0] * rstd * g[0], a[1] * rstd * g[1], a[2] * rstd * g[2], a[3] * rstd * g[3]); o0.y = pk4_fp8(a[4] * rstd * g[4], a[5] * rstd * g[5], a[6] * rstd * g[6], a[7] * rstd * g[7]);
    o0.z = pk4_fp8(b[0] * rstd * g[8], b[1] * rstd * g[9], b[2] * rstd * g[10], b[3] * rstd * g[11]); o0.w = pk4_fp8(b[4] * rstd * g[12], b[5] * rstd * g[13], b[6] * rstd * g[14], b[7] * rstd * g[15]);
    float y1[4], y2[4];
#pragma unroll
    for (int i = 0; i < 4; ++i) { const float u = x1[i] * rstd * g[16 + i], v = x2[i] * rstd * g[20 + i]; y1[i] = u * cs[i] - v * sn[i]; y2[i] = u * sn[i] + v * cs[i]; }
    *(u32x4*)(op + 16 * j) = o0; *(unsigned*)(op + 128 + 4 * j) = pk4_fp8(y1[0], y1[1], y1[2], y1[3]); *(unsigned*)(op + 160 + 4 * j) = pk4_fp8(y2[0], y2[1], y2[2], y2[3]);
}
__device__ __forceinline__ void mla_finalize_phase(Frame& F, const bf16_t* QR, const bf16_t* KVR, const bf16_t* Z, const float* gq, const float* gk, unsigned char* QF, unsigned char* KF) {
    int tid_ = threadIdx.x; asm volatile("" : "+v"(tid_));
    const int gw = F.vcu * NWAVES + __builtin_amdgcn_readfirstlane(tid_ >> 6), NGW = F.G * NWAVES, lane = tid_ & 63;
    const int h = lane >> 3, j = lane & 7;
    float gqv[24], gkv[24], invf[4];
#pragma unroll
    for (int i = 0; i < 16; ++i) { gqv[i] = gq[16 * j + i]; gkv[i] = gk[16 * j + i]; }
#pragma unroll
    for (int i = 0; i < 4; ++i) { gqv[16 + i] = gq[128 + 4 * j + i]; gqv[20 + i] = gq[160 + 4 * j + i]; gkv[16 + i] = gk[128 + 4 * j + i]; gkv[20 + i] = gk[160 + 4 * j + i];
        invf[i] = __builtin_amdgcn_exp2f(-(float)(4 * j + i) * (13.287712379549449f / 32.0f)); }
#pragma unroll 2
    for (int m = gw; m < M; m += NGW) {
        const int pos = m & (SEQ - 1);
        float cs[4], sn[4];
#pragma unroll
        for (int i = 0; i < 4; ++i) { const double rev = (double)pos * (double)invf[i] * 0.15915494309189535; const float fr = (float)(rev - __builtin_rint(rev));
            sn[i] = __builtin_amdgcn_sinf(fr); cs[i] = __builtin_amdgcn_cosf(fr); }
        const bf16_t* qp = QR + (size_t)m * 1536 + h * 192; const bf16_t* kp = KVR + (size_t)m * 2048 + h * 256; const bf16_t* zp = Z + (size_t)m * ODD_INP + 768;
        const u32x4 qn0 = *(const u32x4*)(qp + 16 * j), qn1 = *(const u32x4*)(qp + 16 * j + 8); const u32x2 qr1 = *(const u32x2*)(qp + 128 + 4 * j), qr2 = *(const u32x2*)(qp + 160 + 4 * j);
        const u32x4 kn0 = *(const u32x4*)(kp + 16 * j), kn1 = *(const u32x4*)(kp + 16 * j + 8); const u32x2 kr1 = *(const u32x2*)(zp + 4 * j), kr2 = *(const u32x2*)(zp + 32 + 4 * j);
        fin_head(qn0, qn1, qr1, qr2, gqv, cs, sn, QF + (size_t)m * 1536 + h * 192, j);
        fin_head(kn0, kn1, kr1, kr2, gkv, cs, sn, KF + (size_t)m * 1536 + h * 192, j);
    }
}

__device__ __forceinline__ void vt_phase(Frame& F, const bf16_t* KVR, unsigned char* VT8) {
    int tid_ = threadIdx.x; asm volatile("" : "+v"(tid_));
    const int tid = tid_;
    LAS unsigned char* T = F.lds + RING_OFF;
    for (int it = F.vcu; it < M / 64; it += F.G) {
        const int m0 = it * 64, b = m0 / SEQ, tok0 = m0 % SEQ;
#pragma unroll 4
        for (int k = 0; k < 16; ++k) { const int idx = tid + 512 * k, tok = idx >> 7, grp = idx & 127, h = grp >> 4, d8 = (grp & 15) * 8;
            const u32x4 w = *(const u32x4*)(KVR + (size_t)(m0 + tok) * 2048 + h * 256 + 128 + d8);
            const unsigned lo = pk4_fp8(bflo(w.x), bfhi(w.x), bflo(w.y), bfhi(w.y)), hi = pk4_fp8(bflo(w.z), bfhi(w.z), bflo(w.w), bfhi(w.w));
            LAS unsigned char* tp = T + (h * 128 + d8) * 80 + tok;
            tp[0] = (unsigned char)lo; tp[80] = (unsigned char)(lo >> 8); tp[160] = (unsigned char)(lo >> 16); tp[240] = (unsigned char)(lo >> 24);
            tp[320] = (unsigned char)hi; tp[400] = (unsigned char)(hi >> 8); tp[480] = (unsigned char)(hi >> 16); tp[560] = (unsigned char)(hi >> 24); }
        __syncthreads();
#pragma unroll 4
        for (int k = 0; k < 8; ++k) { const int idx = tid + 512 * k, row = idx >> 2, q = idx & 3;
            const u32x4 v = *(const LAS u32x4*)(T + row * 80 + 16 * q);
            *(u32x4*)(VT8 + ((size_t)b * 1024 + row) * SEQ + tok0 + 16 * q) = v; }
        __syncthreads();
    }
}

#ifndef PHMASK
#define PHMASK 0xFFFF
#endif
#ifndef REPMASK
#define REPMASK 0
#endif
#ifndef REPCNT
#define REPCNT 3
#endif
#define NREP(k) ((((REPMASK) >> (k)) & 1) ? (REPCNT) : 1)

#define LAUNDER_S(x) asm volatile("" : "+s"(x))
__device__ __forceinline__ const float* in_ptr(const Args& a, int i) { LAUNDER_S(i); return a.in[i]; }
#define PHASE_BEGIN() unsigned wso_ = 0u; LAUNDER_S(wso_); unsigned char* ws = args.ws + wso_; Frame Fp = F; Fp.vcu = __builtin_amdgcn_readfirstlane(Fp.vcu); Fp.G = __builtin_amdgcn_readfirstlane(Fp.G); LAUNDER_S(Fp.vcu); LAUNDER_S(Fp.G); \
    int bx_ = __builtin_amdgcn_readfirstlane((int)blockIdx.x); LAUNDER_S(bx_); (void)bx_; (void)ws
#define XN  ((unsigned char*)(ws + WS_XN))
#define Z   ((bf16_t*)(ws + WS_Z))
#define MIX ((bf16_t*)(ws + WS_MIX))
#define QR  ((bf16_t*)(ws + WS_QR))
#define KVR ((bf16_t*)(ws + WS_KVR))
#define QF  ((unsigned char*)(ws + WS_QF))
#define KF  ((unsigned char*)(ws + WS_KF))
#define XG  ((unsigned char*)(ws + WS_XG))
#define ACT ((unsigned char*)(ws + WS_ACT))
#define YB  ((bf16_t*)(ws + WS_Y))
#define SSQ ((float*)(ws + WS_SSQ))
#define TOKER ((unsigned*)(ws + WS_TOKER))
#define TOKG ((float*)(ws + WS_TOKG))
#define B1P ((float*)(ws + WS_B1P))
#define IN(i) in_ptr(args, (i))
__global__ void __launch_bounds__(NWAVES * 64, 2) trunk_fwd(Args args) {
    extern __shared__ __attribute__((aligned(16))) unsigned char lds_raw[];
    Frame F;
    F.lds = (LAS unsigned char*)lds_raw;
    F.G = gridDim.x; { const int bx = blockIdx.x; F.vcu = (F.G % 8 == 0) ? (bx % 8) * (F.G / 8) + bx / 8 : bx; }
    for (int u = threadIdx.x; u < (SCR_OFF - LDSCTL_OFF) / 4; u += NWAVES * 64) ((LAS unsigned*)(F.lds + LDSCTL_OFF))[u] = 0u;
    __syncthreads();
    (void)xcd_barrier_post((unsigned*)((gu32*)(args.ws + WS_CTL) + CW_BAR), (volatile LAS unsigned*)(F.lds + MISC_OFF) + 8);
#define GRID_BAR() do { unsigned wsb_ = 0u; LAUNDER_S(wsb_); XcdBarrier bar_; bar_.bar = (unsigned*)((gu32*)(args.ws + wsb_ + WS_CTL) + CW_BAR); bar_.x = xb_xcc_id(); \
        bar_.st = (volatile LAS unsigned*)(F.lds + MISC_OFF) + 8; xcd_barrier(bar_); } while (0)
    float* const X = args.out;
    const int stage_limit = args.stage_limit;

#if (PHMASK >> 0) & 1
            _Pragma("unroll") for (int rep_ = 0; rep_ < NREP(0); ++rep_) { if (rep_) GRID_BAR();
    {   PHASE_BEGIN(); const int ptid = threadIdx.x, gw = Fp.vcu * NWAVES + __builtin_amdgcn_readfirstlane(ptid >> 6), NGW = Fp.G * NWAVES;
        transpose_job<1>(Fp, IN(I_EWIN), DM, EVEN_IN, 2, (size_t)DM * EVEN_IN, (bf16_t*)(ws + WS_WEIN), (size_t)EVEN_IN * DM, nullptr, 0);
        transpose_job<0>(Fp, IN(I_EWOUT), DM, DM, 2, (size_t)DM * DM, (bf16_t*)(ws + WS_WEOUT), (size_t)DM * DM, nullptr, 0);
        transpose_job_fp8<0>(Fp, IN(I_OWIN), DM, ODD_IN, 2, (size_t)DM * ODD_IN, ws + WS_WOIN, (size_t)ODD_INP * DM);
        transpose_job_fp8<0>(Fp, IN(I_OWUQ), 512, 1536, 2, (size_t)512 * 1536, ws + WS_WUQ, (size_t)1536 * 512, IN(I_OGCQ), 512);
        transpose_job_fp8<0>(Fp, IN(I_OWUKV), 256, 2048, 2, (size_t)256 * 2048, ws + WS_WUKV, (size_t)2048 * 256, IN(I_OGCKV), 256);
        transpose_job_fp8<0>(Fp, IN(I_OWOUT), DM, DM, 2, (size_t)DM * DM, ws + WS_WOOUT, (size_t)DM * DM);
        transpose_job_fp8<2>(Fp, IN(I_W1), DM, 2 * DE, DEPTH * NE, (size_t)DM * 2 * DE, ws + WS_W1, (size_t)2 * DE * DM);
        transpose_job_fp8<0>(Fp, IN(I_W2), DE, DM, DEPTH * NE, (size_t)DE * DM, ws + WS_W2, (size_t)DM * DE);
        for (int i = bx_ * 512 + ptid; i < 2 * 12288; i += Fp.G * 512) { const int mi = i / 12288, r = i % 12288;
            *(u32x4*)(ws + WS_WOIN + (size_t)mi * ODD_INP * DM + (size_t)ODD_IN * DM + (size_t)r * 16) = (u32x4){0u, 0u, 0u, 0u}; }
        for (int i = bx_ * 512 + ptid; i < DEPTH * NE * 2048; i += Fp.G * 512) { const int c = i & 2047, o = 2 * (128 * (c >> 8) + (c & 127)) + ((c >> 7) & 1);
            B1P[i] = IN(I_B1)[(size_t)(i & ~2047) + o]; }
        for (int m = gw; m < M; m += NGW) rms_row_to_bf16(ptid & 63, IN(I_X) + (size_t)m * DM, IN(I_MIXN), (bf16_t*)XN + (size_t)m * DM, nullptr);
    }
            }
#endif
    GRID_BAR();

#ifdef EXTRA_BARS
    for (int xb_ = 0; xb_ < EXTRA_BARS; ++xb_) GRID_BAR();
#endif
    for (int l = 0; l < DEPTH; ++l) {
        const int li = l >> 1;
        if (2 * l + 1 > stage_limit) break;
        if ((l & 1) == 0) {
#if (PHMASK >> 1) & 1
            _Pragma("unroll") for (int rep_ = 0; rep_ < NREP(1); ++rep_) { if (rep_) GRID_BAR();
            {   PHASE_BEGIN(); pg8::Gemm g{(const bf16_t*)XN, (const bf16_t*)(ws + WS_WEIN) + (size_t)li * EVEN_IN * DM, DM, DM, nullptr, nullptr}; pg8::StaticOrder S; S.init(M, EVEN_IN, Fp.G, bx_);
                pg8::EpiEvenIn E{Z, IN(I_EGQ) + li * 64, IN(I_EGK) + li * 64};
                pg8::gemm_phase<pg8::EpiEvenIn, pg8::StaticOrder>(Fp.lds + RING_OFF, g, S, E); }
            }
#endif
            GRID_BAR();
            {   PHASE_BEGIN();
#if (PHMASK >> 2) & 1
            _Pragma("unroll") for (int rep_ = 0; rep_ < NREP(2); ++rep_) { if (rep_) GRID_BAR();
                for (int u = Fp.vcu; u < 512; u += Fp.G)
                    gmlp_unit(Fp, Z, MIX, IN(I_EWS) + (size_t)li * 4 * 128 * 128, IN(I_EBS) + li * 512, IN(I_EGV) + li * 512, u);
            }
#endif
#if (PHMASK >> 3) & 1
            _Pragma("unroll") for (int rep_ = 0; rep_ < NREP(3); ++rep_) { if (rep_) GRID_BAR();
                for (int u = Fp.vcu; u < 256; u += Fp.G) { const int bh = u >> 4, s = u & 15, b = bh >> 3, h = bh & 7;
                    for (int pass = 0; pass < 2; ++pass) { const int qb = pass ? 31 - s : s;
                        const bf16_t* zb = Z + (size_t)b * SEQ * EVEN_IN;
                        dil::unit(zb + 1024 + 64 * h, zb + 1536 + 64 * h, zb + 2048 + 64 * h, EVEN_IN, MIX + (size_t)b * SEQ * DM + 512 + 64 * h, DM, qb * 256, Fp.lds + RING_OFF, (LAS float*)(Fp.lds + SCR_OFF)); } }
            }
#endif
            }
            GRID_BAR();
#if (PHMASK >> 4) & 1
            _Pragma("unroll") for (int rep_ = 0; rep_ < NREP(4); ++rep_) { if (rep_) GRID_BAR();
            {   PHASE_BEGIN(); pg8::Gemm g{MIX, (const bf16_t*)(ws + WS_WEOUT) + (size_t)li * DM * DM, DM, DM, nullptr, nullptr}; pg8::StaticOrder S; S.init(M, DM, Fp.G, bx_);
                pg8::EpiResid E{l == 0 ? IN(I_X) : (const float*)X, X};
                pg8::gemm_phase<pg8::EpiResid, pg8::StaticOrder>(Fp.lds + RING_OFF, g, S, E); }
            }
#endif
            GRID_BAR();
        } else {
#if (PHMASK >> 5) & 1
            _Pragma("unroll") for (int rep_ = 0; rep_ < NREP(5); ++rep_) { if (rep_) GRID_BAR();
            {   PHASE_BEGIN(); pg8::Gemm g{(const bf16_t*)XN, (const bf16_t*)(ws + WS_WOIN + (size_t)li * ODD_INP * DM), DM / 2, DM / 2, nullptr, nullptr}; pg8::StaticOrder S; S.init(M, ODD_INP, Fp.G, bx_);
                pg8::EpiOddIn E{Z, ws + WS_Z8, SSQ};
                pg8::gemm_phase<pg8::EpiOddIn, pg8::StaticOrder, true>(Fp.lds + RING_OFF, g, S, E); }
            }
#endif
            GRID_BAR();
#if (PHMASK >> 6) & 1
            _Pragma("unroll") for (int rep_ = 0; rep_ < NREP(6); ++rep_) { if (rep_) GRID_BAR();
            {   PHASE_BEGIN(); pg8::Gemm g{(const bf16_t*)(ws + WS_Z8 + 512), (const bf16_t*)(ws + WS_WUKV + (size_t)li * 2048 * 256), ODD_INP / 2, 128, nullptr, nullptr}; pg8::StaticOrder S; S.init(M, 2048, Fp.G, bx_);
                pg8::EpiRowScale<1> E{KVR, 2048, SSQ, 8, 1.0f / 256.0f};
                pg8::gemm_phase<pg8::EpiRowScale<1>, pg8::StaticOrder, true>(Fp.lds + RING_OFF, g, S, E); }
            {   PHASE_BEGIN(); pg8::Gemm g{(const bf16_t*)(ws + WS_Z8), (const bf16_t*)(ws + WS_WUQ + (size_t)li * 1536 * 512), ODD_INP / 2, 256, nullptr, nullptr}; pg8::StaticOrder S; S.init(M, 1536, Fp.G, bx_);
                pg8::EpiRowScale<2> E{QR, 1536, SSQ, 0, 1.0f / 512.0f};
                pg8::gemm_phase<pg8::EpiRowScale<2>, pg8::StaticOrder, true>(Fp.lds + RING_OFF, g, S, E); }
            }
#endif
            GRID_BAR();
#if (PHMASK >> 7) & 1
            _Pragma("unroll") for (int rep_ = 0; rep_ < NREP(7); ++rep_) { if (rep_) GRID_BAR();
            {   PHASE_BEGIN(); mla_finalize_phase(Fp, QR, KVR, Z, IN(I_OGQ) + li * 192, IN(I_OGK) + li * 192, QF, KF); vt_phase(Fp, KVR, ws + WS_VT); }
            }
#endif
            GRID_BAR();
#if (PHMASK >> 8) & 1
            _Pragma("unroll") for (int rep_ = 0; rep_ < NREP(8); ++rep_) { if (rep_) GRID_BAR();
            {   PHASE_BEGIN();
                for (int u = Fp.vcu; u < 256; u += Fp.G) { const int bh = u >> 4, s = u & 15, b = bh >> 3, h = bh & 7;
                    for (int pass = 0; pass < 2; ++pass) { const int qb = pass ? 31 - s : s;
                        mla::unit(QF + (size_t)b * SEQ * 1536 + 192 * h, KF + (size_t)b * SEQ * 1536 + 192 * h, 1536, ws + WS_VT + ((size_t)(b * 8 + h) * 128) * SEQ,
                                  ws + WS_MIX8 + (size_t)b * SEQ * DM + 128 * h, DM, qb * 256, Fp.lds + RING_OFF); } }
            }
            }
#endif
            GRID_BAR();
#if (PHMASK >> 9) & 1
            _Pragma("unroll") for (int rep_ = 0; rep_ < NREP(9); ++rep_) { if (rep_) GRID_BAR();
            {   PHASE_BEGIN(); pg8::Gemm g{(const bf16_t*)(ws + WS_MIX8), (const bf16_t*)(ws + WS_WOOUT + (size_t)li * DM * DM), DM / 2, DM / 2, nullptr, nullptr}; pg8::StaticOrder S; S.init(M, DM, Fp.G, bx_);
                pg8::EpiResidT<true> E{(const float*)X, X};
                pg8::gemm_phase<pg8::EpiResidT<true>, pg8::StaticOrder, true>(Fp.lds + RING_OFF, g, S, E); }
            }
#endif
            GRID_BAR();
        }
        if (2 * l + 2 > stage_limit) break;
#if (PHMASK >> 10) & 1
            _Pragma("unroll") for (int rep_ = 0; rep_ < NREP(10); ++rep_) {
        {   PHASE_BEGIN(); const bool dry = rep_ + 1 < NREP(10);
            gu32* cnt = (gu32*)(ws + WS_CTL) + CW_CNT + (size_t)(dry ? 8 + 4 * rep_ + l : l) * 32 * 64;
        router_phase(Fp, X, IN(I_FFNN) + l * DM, IN(I_RW) + (size_t)l * DM * NE, IN(I_RB) + l * NE, cnt, dry ? (unsigned*)(ws + WS_QR) : TOKER, dry ? (float*)(ws + WS_QR + MiB) : TOKG, dry ? ACT : XG); }
        GRID_BAR();
            }
#endif
        LAS int* tbl = (LAS int*)(F.lds + SCR_OFF + 12288);
        {   PHASE_BEGIN(); gu32* cnt = (gu32*)(ws + WS_CTL) + CW_CNT + (size_t)l * 32 * 64;
        if (threadIdx.x == 0) { int acc = 0; for (int e = 0; e < NE; ++e) { tbl[e] = acc; const unsigned c = __hip_atomic_load(cnt + 64 * e, RLX_AGENT); acc += (int)((c + 255u) >> 8); } tbl[NE] = acc; }
        __syncthreads(); }
#if (PHMASK >> 11) & 1
            _Pragma("unroll") for (int rep_ = 0; rep_ < NREP(11); ++rep_) { if (rep_) GRID_BAR();
        {   PHASE_BEGIN();
            pg8::Gemm g{(const bf16_t*)XG, (const bf16_t*)(ws + WS_W1 + (size_t)l * NE * 2 * DE * DM), DM / 2, DM / 2, (const bf16_t*)ACT, (const bf16_t*)(ws + WS_W2 + (size_t)l * NE * DM * DE)};
            pg8::MoeMergedOrder S{tbl, Fp.G, Fp.vcu, (gu32*)(ws + WS_CTL) + CW_MOE + (size_t)(l * 320 + 1280 * rep_) * 16, -1};
            pg8::EpiMoe E{{ACT, B1P + (size_t)l * NE * 2048}, {YB, IN(I_B2) + (size_t)l * NE * DM}};
            pg8::gemm_phase<pg8::EpiMoe, pg8::MoeMergedOrder, true>(Fp.lds + RING_OFF, g, S, E); }
            }
#endif
        GRID_BAR();
#if (PHMASK >> 13) & 1
            _Pragma("unroll") for (int rep_ = 0; rep_ < NREP(13); ++rep_) {
        {   PHASE_BEGIN(); const bool dry = rep_ + 1 < NREP(13);
            combine_phase(Fp, X, dry ? (float*)ACT : X, TOKER, TOKG, YB, (l + 1 < DEPTH) ? IN(I_MIXN) + (l + 1) * DM : nullptr, dry ? (ACT + (size_t)64 * MiB) : XN, (l & 1) == 0); }
        GRID_BAR();
            }
#endif
    }
#undef GRID_BAR
}

extern "C" void kernel_launch(void* const* d_in, const int* in_sizes, int n_in, void* d_out, int out_size, void* d_ws, size_t ws_size, hipStream_t stream) {
    static int grid = 0;
    if (grid == 0) {
        if (n_in != 24 || in_sizes[0] != M * DM || out_size != M * DM || ws_size < WS_END) {
            fprintf(stderr, "kernel_launch: unexpected shapes (n_in %d, in0 %d, out %d, ws %zu, need %zu)\n", n_in, n_in > 0 ? in_sizes[0] : -1, out_size, ws_size, (size_t)WS_END); grid = -1; return; }
        int dev = 0, cus = 0, per_cu = 0;
        if (hipGetDevice(&dev) != hipSuccess || hipDeviceGetAttribute(&cus, hipDeviceAttributeMultiprocessorCount, dev) != hipSuccess) { grid = -1; return; }
        if (hipFuncSetAttribute((const void*)trunk_fwd, hipFuncAttributeMaxDynamicSharedMemorySize, LDS_BYTES) != hipSuccess) { fprintf(stderr, "kernel_launch: hipFuncSetAttribute failed\n"); grid = -1; return; }
        if (hipOccupancyMaxActiveBlocksPerMultiprocessor(&per_cu, (const void*)trunk_fwd, NWAVES * 64, LDS_BYTES) != hipSuccess || per_cu < 1)
            fprintf(stderr, "kernel_launch: occupancy query reports %d workgroups per CU\n", per_cu);
        (void)hipGetLastError();
        if (cus < 256) { fprintf(stderr, "kernel_launch: needs 256 CUs, device has %d\n", cus); grid = -1; return; }
        grid = 256;
    }
    if (grid < 0) return;
    if (hipMemsetAsync((char*)d_ws + WS_CTL, 0, CTL_ZERO_BYTES, stream) != hipSuccess) return;
    Args a{};
    for (int i = 0; i < 24; ++i) a.in[i] = (const float*)d_in[i];
    a.out = (float*)d_out; a.ws = (unsigned char*)d_ws; a.stage_limit = STAGE_LIMIT; a.pad = 0;
    hipLaunchKernelGGL(trunk_fwd, dim3(grid), dim3(NWAVES * 64), LDS_BYTES, stream, a);
}
```

```cpp
#include <hip/hip_runtime.h>
#include <hip/hip_bf16.h>
#include <cstdio>
#include <cstdint>

#define LAS __attribute__((address_space(3)))
#define GAS __attribute__((address_space(1)))
typedef unsigned short bf16_t;
typedef short bf16x8 __attribute__((ext_vector_type(8)));
typedef short s16x4 __attribute__((ext_vector_type(4)));
typedef float f32x2 __attribute__((ext_vector_type(2)));
typedef float f32x4 __attribute__((ext_vector_type(4)));
typedef float f32x16 __attribute__((ext_vector_type(16)));
typedef unsigned u32x2 __attribute__((ext_vector_type(2)));
typedef unsigned u32x4 __attribute__((ext_vector_type(4)));
typedef int i32x4 __attribute__((ext_vector_type(4)));
typedef int i32x8 __attribute__((ext_vector_type(8)));

constexpr int BATCH = 2, SEQ = 8192, DM = 1024, M = BATCH * SEQ, DEPTH = 4;
constexpr int EVEN_IN = 2560, ODD_IN = 832, ODD_INP = 1024;
constexpr int NE = 32, DE = 1024, ECAP = 16384;
constexpr float EPS = 1e-6f;
constexpr float LOG2E = 1.4426950408889634f;
constexpr float C2_B = 0.125f * LOG2E;
constexpr float C2_C = 0.07216878364870322f * LOG2E;

__device__ __forceinline__ unsigned cvt_pk_bf16(float lo, float hi) { unsigned r; asm volatile("v_cvt_pk_bf16_f32 %0, %1, %2" : "=v"(r) : "v"(lo), "v"(hi)); return r; }
__device__ __forceinline__ float bf2f(bf16_t v) { return __uint_as_float(((unsigned)v) << 16); }
__device__ __forceinline__ float bflo(unsigned w) { return __uint_as_float(w << 16); }
__device__ __forceinline__ float bfhi(unsigned w) { return __uint_as_float(w & 0xffff0000u); }
__device__ __forceinline__ bf16_t f2bf(float f) { return (bf16_t)(cvt_pk_bf16(f, 0.f) & 0xffffu); }

__device__ __forceinline__ unsigned pk4_fp8(float a, float b, float c, float d) { int w = 0; w = __builtin_amdgcn_cvt_pk_fp8_f32(a, b, w, false); w = __builtin_amdgcn_cvt_pk_fp8_f32(c, d, w, true); return (unsigned)w; }
constexpr float W8_SCALE = 64.0f, W8_INV = 1.0f / 64.0f;

namespace pg8 {
constexpr int BM = 256, BK = 64, HALF = 128, HTB = HALF * BK * 2, STAGE_BYTES = 8 * HTB, NXCD = 8, WGM = 8;
__host__ __device__ __forceinline__ int lds_byte(int r, int c) { const int st = (r >> 4) * 2 + (c >> 5), rr = r & 15, cc = c & 31, ob = rr * 64 + cc * 2; return st * 1024 + (ob ^ (((ob >> 9) & 1) << 5)); }
__host__ __device__ __forceinline__ void stage_rc(int b, int& R, int& C) { const int st = b / 1024, sb = b % 1024, swz = sb ^ (((sb >> 9) & 1) << 5); R = (st >> 1) * 16 + swz / 64; C = (st & 1) * 32 + (swz % 64) / 2; }
__host__ __device__ __forceinline__ int perm32(int rho) { const int n = rho >> 4, i = rho & 15; return 8 * (i >> 2) + 4 * n + (i & 3); }

struct Unit { int pm, pn, pb, kind, rb; };
struct Gemm { const bf16_t* A; const bf16_t* Bt; int lda, K; const bf16_t* A2; const bf16_t* Bt2; };

struct StaticOrder {
    int nM, nN, nwg, G, c;
    __device__ void init(int M_, int N_, int G_, int c_) { nM = M_ / BM; nN = N_ / BM; nwg = nM * nN; G = G_; c = c_; }
    __device__ bool next(int i, Unit& u) const {
        const long L = (long)i * G + c; if (L >= nwg) return false;
        int wgid = (int)L; { const int q = nwg / NXCD, r = nwg % NXCD, xcd = wgid % NXCD, off = wgid / NXCD; wgid = (xcd < r ? xcd * (q + 1) : r * (q + 1) + (xcd - r) * q) + off; }
        const int nig = WGM * nN, gid = wgid / nig, fm = gid * WGM, gsz = (nM - fm) < WGM ? (nM - fm) : WGM;
        u.pm = fm + ((wgid % nig) % gsz); u.pn = (wgid % nig) / gsz; u.pb = u.pn; u.kind = 0; u.rb = 0; return true;
    }
    __device__ __forceinline__ void a_ready(const Unit&) const {}
    __device__ __forceinline__ void pre_epi() const {}
    __device__ __forceinline__ void done(const Unit&) const {}
    __device__ __forceinline__ void finish() const {}
};

__device__ __forceinline__ f32x2 gelu_pk(f32x2 v) {
    const f32x2 av = __builtin_elementwise_abs(v), d = av * 0.2316418882f + 1.0f;
    f32x2 t; t.x = __builtin_amdgcn_rcpf(d.x); t.y = __builtin_amdgcn_rcpf(d.y);
    f32x2 q = t * 0.5307027145f + (-0.7265760135f); q = q * t + 0.7107068705f; q = q * t + (-0.142248368f); q = q * t + 0.127414796f; q = q * t;
    const f32x2 s = (v * v) * (-0.72134752044f);
    f32x2 e; e.x = __builtin_amdgcn_exp2f(s.x); e.y = __builtin_amdgcn_exp2f(s.y);
    const f32x2 m = v * (q * e), r = v - m;
    f32x2 o; o.x = v.x < 0.f ? m.x : r.x; o.y = v.y < 0.f ? m.y : r.y; return o;
}
__device__ __forceinline__ f32x4 gelu4(f32x4 v) { const f32x2 a = gelu_pk((f32x2){v[0], v[1]}), b = gelu_pk((f32x2){v[2], v[3]}); return (f32x4){a.x, a.y, b.x, b.y}; }

template <class Epi, class Sched, bool FP8 = false>
__device__ __forceinline__ void gemm_phase(LAS unsigned char* lds, const Gemm g, const Sched& S, const Epi& E) {
    int tid_ = threadIdx.x; asm volatile("" : "+v"(tid_));
    const int tid = tid_, wid = __builtin_amdgcn_readfirstlane(tid >> 6), lane = tid & 63, wr = wid >> 2, wc = wid & 3, fr = lane & 15, fq = lane >> 4;
    const int K = g.K, nt = K / BK;
    unsigned voffA[2], voffB[2];
#pragma unroll
    for (int i = 0; i < 2; ++i) { int R, C; stage_rc(tid * 16 + i * 8192, R, C); const int Rb = Epi::PERM ? ((R & ~31) + perm32(R & 31)) : R;
        voffA[i] = (unsigned)(R * g.lda + C) * 2u; voffB[i] = (unsigned)(Rb * K + C) * 2u; }
    const size_t kstep = (size_t)(BK * 2);
    const size_t hstepA = (size_t)HALF * g.lda * 2, tstepA = 2 * hstepA;
    const size_t hstepB = (size_t)HALF * K * 2, tstepB = 2 * hstepB;
    const unsigned ldsw = (unsigned)wid * 1024u;
    const int aoff = lds_byte(wr * 64 + fr, fq * 8), boff = lds_byte(wc * 32 + fr, fq * 8);
#define PG8_SA(b, h) (((b) * 2 + (h)) * HTB)
#define PG8_SB(b, h) ((4 + (b) * 2 + (h)) * HTB)
#define PG8_STAGE(bufoff, gbase, voff) do { _Pragma("unroll") for (int _i = 0; _i < 2; ++_i) \
        __builtin_amdgcn_global_load_lds((const unsigned*)((const char*)(gbase) + (voff)[_i]), (LAS unsigned*)(lds + (bufoff) + ldsw + _i * 8192), 16, 0, 0); } while (0)
#define PG8_LDA(dst, b, h) do { _Pragma("unroll") for (int m = 0; m < 4; ++m) { if constexpr (FP8) { const i32x4 lo_ = *(const LAS i32x4*)(lds + PG8_SA(b, h) + aoff + m * 2048), hi_ = *(const LAS i32x4*)(lds + PG8_SA(b, h) + aoff + m * 2048 + 1024); dst##8[m] = __builtin_shufflevector(lo_, hi_, 0, 1, 2, 3, 4, 5, 6, 7); } \
        else { _Pragma("unroll") for (int k = 0; k < 2; ++k) dst[m][k] = *(const LAS bf16x8*)(lds + PG8_SA(b, h) + aoff + m * 2048 + k * 1024); } } } while (0)
#define PG8_LDB(dst, b, h) do { _Pragma("unroll") for (int n = 0; n < 2; ++n) { if constexpr (FP8) { const i32x4 lo_ = *(const LAS i32x4*)(lds + PG8_SB(b, h) + boff + n * 2048), hi_ = *(const LAS i32x4*)(lds + PG8_SB(b, h) + boff + n * 2048 + 1024); dst##8[n] = __builtin_shufflevector(lo_, hi_, 0, 1, 2, 3, 4, 5, 6, 7); } \
        else { _Pragma("unroll") for (int k = 0; k < 2; ++k) dst[n][k] = *(const LAS bf16x8*)(lds + PG8_SB(b, h) + boff + n * 2048 + k * 1024); } } } while (0)
#define PG8_MMA(ai, bj, At, Bt) do { __builtin_amdgcn_s_setprio(1); _Pragma("unroll") for (int m = 0; m < 4; ++m) _Pragma("unroll") for (int n = 0; n < 2; ++n) { \
        if constexpr (FP8) asm volatile("s_nop 1\n\tv_mfma_f32_16x16x128_f8f6f4 %0, %1, %2, %0" : "+v"(acc[ai][bj][m][n]) : "v"(Bt##8[n]), "v"(At##8[m])); \
        else { _Pragma("unroll") for (int k = 0; k < 2; ++k) acc[ai][bj][m][n] = __builtin_amdgcn_mfma_f32_16x16x32_bf16(Bt[n][k], At[m][k], acc[ai][bj][m][n], 0, 0, 0); } } \
        __builtin_amdgcn_s_setprio(0); } while (0)
#define PG8_WAIT_V(n) asm volatile("s_waitcnt vmcnt(" #n ")" ::: "memory")
#define PG8_WAIT_L(n) asm volatile("s_waitcnt lgkmcnt(" #n ")" ::: "memory")
#define PG8_BAR __builtin_amdgcn_s_barrier()
#define PG8_SCHED __builtin_amdgcn_sched_barrier(0)
    Unit cur, nxt; int ui = 0;
    if (!S.next(0, cur)) return;
    f32x4 acc[2][2][4][2];
#pragma unroll
    for (int a = 0; a < 2; ++a)
#pragma unroll
        for (int b = 0; b < 2; ++b)
#pragma unroll
            for (int m = 0; m < 4; ++m)
#pragma unroll
                for (int n = 0; n < 2; ++n) acc[a][b][m][n] = (f32x4){0.f, 0.f, 0.f, 0.f};
    bf16x8 At[4][2], B0[2][2], B1[2][2]; i32x8 At8[4], B08[2], B18[2];
    const char* cA = (const char*)(cur.kind ? g.A2 : g.A) + (size_t)cur.pm * tstepA; const char* cB = (const char*)(cur.kind ? g.Bt2 : g.Bt) + (size_t)cur.pb * tstepB;
    S.a_ready(cur);
    PG8_STAGE(PG8_SB(0, 0), cB, voffB); PG8_STAGE(PG8_SB(0, 1), cB + hstepB, voffB); PG8_STAGE(PG8_SA(0, 0), cA, voffA); PG8_STAGE(PG8_SA(0, 1), cA + hstepA, voffA);
    if (wr == 1) PG8_BAR;
    PG8_WAIT_V(2); PG8_BAR;
    PG8_STAGE(PG8_SB(1, 0), cB + kstep, voffB); PG8_STAGE(PG8_SA(1, 0), cA + kstep, voffA); PG8_STAGE(PG8_SB(1, 1), cB + hstepB + kstep, voffB);
    PG8_WAIT_V(6); PG8_BAR;
    for (;;) {
        const bool has_next = S.next(ui + 1, nxt);
        const char* nA = has_next ? (const char*)(nxt.kind ? g.A2 : g.A) + (size_t)nxt.pm * tstepA : cA; const char* nB = has_next ? (const char*)(nxt.kind ? g.Bt2 : g.Bt) + (size_t)nxt.pb * tstepB : cB;
#pragma unroll 1
        for (int t = 0; t < nt; t += 2) {
            const bool last = (t == nt - 2);
            const char* a1 = cA + (size_t)(t + 1) * kstep;
            const char* a2 = last ? nA : cA + (size_t)(t + 2) * kstep; const char* b2 = last ? nB : cB + (size_t)(t + 2) * kstep;
            const char* a3 = a2 + kstep; const char* b3 = b2 + kstep;
            if (last && has_next) S.a_ready(nxt);
            PG8_LDB(B0, 0, 0); PG8_LDB(B1, 0, 1); PG8_SCHED; PG8_LDA(At, 0, 0); PG8_STAGE(PG8_SA(1, 1), a1 + hstepA, voffA);
            PG8_WAIT_V(8); PG8_WAIT_L(0); PG8_BAR; PG8_MMA(0, 0, At, B0); PG8_MMA(0, 1, At, B1); PG8_BAR; PG8_SCHED;
            PG8_LDA(At, 0, 1); PG8_STAGE(PG8_SB(0, 0), b2, voffB); PG8_STAGE(PG8_SB(0, 1), b2 + hstepB, voffB); PG8_STAGE(PG8_SA(0, 0), a2, voffA);
            PG8_WAIT_V(8); PG8_WAIT_L(0); PG8_BAR; PG8_MMA(1, 0, At, B0); PG8_MMA(1, 1, At, B1); PG8_BAR; PG8_SCHED;
            PG8_LDB(B0, 1, 0); PG8_LDB(B1, 1, 1); PG8_SCHED; PG8_LDA(At, 1, 0); PG8_STAGE(PG8_SA(0, 1), a2 + hstepA, voffA);
            PG8_WAIT_V(8); PG8_WAIT_L(0); PG8_BAR; PG8_MMA(0, 0, At, B0); PG8_MMA(0, 1, At, B1); PG8_BAR; PG8_SCHED;
            PG8_LDA(At, 1, 1); PG8_STAGE(PG8_SB(1, 0), b3, voffB); PG8_STAGE(PG8_SB(1, 1), b3 + hstepB, voffB); PG8_STAGE(PG8_SA(1, 0), a3, voffA);
            PG8_WAIT_V(8); PG8_WAIT_L(0); PG8_BAR; PG8_MMA(1, 0, At, B0); PG8_MMA(1, 1, At, B1); PG8_BAR; PG8_SCHED;
        }
        if (wr == 0) PG8_BAR;
        if constexpr (FP8) asm volatile("s_nop 15\n\ts_nop 7" ::: "memory");
        S.pre_epi();
        { int te_ = threadIdx.x; asm volatile("" : "+v"(te_));
          E(acc, cur, wr, wc, te_ & 15, (te_ & 63) >> 4); }
        S.done(cur);
        if (!has_next) break;
#pragma unroll
        for (int a = 0; a < 2; ++a)
#pragma unroll
            for (int b = 0; b < 2; ++b)
#pragma unroll
                for (int m = 0; m < 4; ++m)
#pragma unroll
                    for (int n = 0; n < 2; ++n) acc[a][b][m][n] = (f32x4){0.f, 0.f, 0.f, 0.f};
        cur = nxt; cA = nA; cB = nB; ++ui;
        if (wr == 1) PG8_BAR;
    }
    PG8_WAIT_V(0);
    S.finish();
    PG8_BAR;
#undef PG8_SA
#undef PG8_SB
#undef PG8_STAGE
#undef PG8_LDA
#undef PG8_LDB
#undef PG8_MMA
#undef PG8_WAIT_V
#undef PG8_WAIT_L
#undef PG8_BAR
#undef PG8_SCHED
}
}
constexpr int STAGE_LIMIT = 8;

namespace att {
__device__ __forceinline__ int crow(int r, int hi) { return (r & 3) + 8 * (r >> 2) + 4 * hi; }
__device__ __forceinline__ int v_rd_base(int lane) { return ((lane & 3) << 3) | (((lane >> 2) & 3) << 6) | (((lane >> 4) & 1) << 5) | (((lane >> 5) & 1) << 8); }
}

namespace dil {
using att::crow; using att::v_rd_base;
constexpr int OFF_O = 0, OFF_V = 65536, VWAVE = 8192;
template <int S_>
__device__ __forceinline__ void pass(const bf16_t* __restrict__ Qh, const bf16_t* __restrict__ Kh, const bf16_t* __restrict__ Vh, int pitch, int q0, LAS unsigned char* lds, LAS float* scr, int wid, int lane) {
    const int r32 = lane & 31, hi = lane >> 5;
    LAS float* Oacc = (LAS float*)(lds + OFF_O); LAS float* macc = scr; LAS float* lacc = scr + 256; LAS float* wsf = scr + 512 + wid * 64;
    LAS unsigned char* vbuf = lds + OFF_V + wid * VWAVE;
    constexpr int NG = (S_ == 16) ? 2 : 1, VR = (S_ == 16) ? 16 : 32;
    int vk[4], vc[4];
#pragma unroll
    for (int i = 0; i < 4; ++i) { const int off = (i * 64 + lane) * 16, st = off >> 9, within = off & 511, kk = (st >> 1) * 8 + (within >> 6);
        vk[i] = (kk & ~0xC) | ((kk & 4) << 1) | ((kk & 8) >> 1); vc[i] = (st & 1) * 32 + ((within & 63) >> 1); }
    const unsigned vb0 = (unsigned)(uintptr_t)vbuf + (unsigned)v_rd_base(lane);
#pragma unroll
    for (int gi = 0; gi < NG; ++gi) {
        const int rho = (S_ == 1) ? 0 : (S_ == 4) ? (wid & 3) : (2 * wid + gi);
        const int i0 = (S_ == 1) ? 32 * wid : (S_ == 4) ? 32 * (wid >> 2) : 0;
        const int qi = i0 + (r32 < VR ? r32 : r32 - VR);
        const int ql = rho + S_ * qi;
        bf16x8 qr[4];
#pragma unroll
        for (int d0 = 0; d0 < 4; ++d0) qr[d0] = *(const bf16x8*)(Qh + (size_t)(q0 + ql) * pitch + d0 * 16 + hi * 8);
        const int j0 = i0 - 128;
        const int tokb = q0 + rho + S_ * j0;
        bf16x8 kfA[4], kfB[4];
#define DIL_KLOAD(dst, c) do { int tk_ = tokb + S_ * (32 * (c) + r32); tk_ = tk_ < 0 ? 0 : (tk_ > SEQ - 1 ? SEQ - 1 : tk_);     \
            _Pragma("unroll") for (int d0 = 0; d0 < 4; ++d0) dst[d0] = *(const bf16x8*)(Kh + (size_t)tk_ * pitch + d0 * 16 + hi * 8); } while (0)
#define DIL_VDMA(c, bf) do { _Pragma("unroll") for (int i = 0; i < 4; ++i) { int tk_ = tokb + S_ * (32 * (c) + vk[i]); tk_ = tk_ < 0 ? 0 : (tk_ > SEQ - 1 ? SEQ - 1 : tk_); \
            __builtin_amdgcn_global_load_lds((const unsigned*)(Vh + (size_t)tk_ * pitch + vc[i]), (LAS unsigned*)(vbuf + (bf) * 4096 + i * 1024), 16, 0, 0); } } while (0)
        float m_reg = -1e30f, l_reg = 0.f; f32x16 o[2]; o[0] = f32x16{}; o[1] = f32x16{};
        DIL_KLOAD(kfA, 0); DIL_VDMA(0, 0);
#define DIL_STEP(KF, KN, c) do { \
            if ((c) < 4) { DIL_KLOAD(KN, (c) + 1); DIL_VDMA((c) + 1, ((c) + 1) & 1); asm volatile("s_waitcnt vmcnt(8)" ::: "memory"); } \
            else { asm volatile("s_waitcnt vmcnt(0)" ::: "memory"); } \
            f32x16 p = f32x16{}; \
            _Pragma("unroll") for (int d0 = 0; d0 < 4; ++d0) p = __builtin_amdgcn_mfma_f32_32x32x16_bf16(KF[d0], qr[d0], p, 0, 0, 0); \
            const unsigned vb = vb0 + (unsigned)(((c) & 1) * 4096); \
            s16x4 vl0[2], vh0[2], vl1[2], vh1[2]; \
            _Pragma("unroll") for (int d0 = 0; d0 < 2; ++d0) { \
                asm volatile("ds_read_b64_tr_b16 %0, %1 offset:%2" : "=&v"(vl0[d0]) : "v"(vb), "i"(d0 * 512) : "memory"); \
                asm volatile("ds_read_b64_tr_b16 %0, %1 offset:%2" : "=&v"(vh0[d0]) : "v"(vb), "i"(d0 * 512 + 1024) : "memory"); \
                asm volatile("ds_read_b64_tr_b16 %0, %1 offset:%2" : "=&v"(vl1[d0]) : "v"(vb), "i"(d0 * 512 + 2048) : "memory"); \
                asm volatile("ds_read_b64_tr_b16 %0, %1 offset:%2" : "=&v"(vh1[d0]) : "v"(vb), "i"(d0 * 512 + 3072) : "memory"); } \
              \
            { const float NEG = -__builtin_inff(); const int db = qi - j0 - 32 * (c) - 4 * hi; const int tb = tokb + S_ * (32 * (c) + 4 * hi); \
              if ((c) == 0 || (c) == 4 || tokb < 0) { \
                _Pragma("unroll") for (int r = 0; r < 16; ++r) { const int cr = (r & 3) + 8 * (r >> 2); \
                    const bool ok = ((unsigned)(db - cr) <= 128u) && (tb + S_ * cr >= 0); p[r] = ok ? p[r] : NEG; } } } \
            float pmax = p[0]; \
            _Pragma("unroll") for (int r = 1; r < 16; ++r) pmax = fmaxf(pmax, p[r]); \
            { auto rr = __builtin_amdgcn_permlane32_swap(__float_as_uint(pmax), __float_as_uint(pmax), false, false); pmax = fmaxf(__uint_as_float(rr[0]), __uint_as_float(rr[1])); } \
            const float mn = fmaxf(m_reg, pmax); const float alpha = __builtin_amdgcn_exp2f(m_reg - mn); m_reg = mn; \
            float ps = 0.f; \
            _Pragma("unroll") for (int r = 0; r < 16; ++r) { p[r] = __builtin_amdgcn_exp2f(p[r] - mn); ps += p[r]; } \
            { auto rr = __builtin_amdgcn_permlane32_swap(__float_as_uint(ps), __float_as_uint(ps), false, false); ps = __uint_as_float(rr[0]) + __uint_as_float(rr[1]); } \
            l_reg = l_reg * alpha + ps; \
            bf16x8 pa0, pa1; DIL_PK4(p, 0, pa0); DIL_PK4(p, 8, pa1); \
            if (__any(alpha < 1.f)) { if (hi == 0) wsf[r32] = alpha; asm volatile("s_waitcnt lgkmcnt(0)" ::: "memory"); \
                _Pragma("unroll") for (int r = 0; r < 16; ++r) { const float a = wsf[crow(r, hi)]; o[0][r] *= a; o[1][r] *= a; } } \
            asm volatile("s_waitcnt lgkmcnt(0)" ::: "memory"); __builtin_amdgcn_sched_barrier(0); \
            _Pragma("unroll") for (int d0 = 0; d0 < 2; ++d0) { \
                o[d0] = __builtin_amdgcn_mfma_f32_32x32x16_bf16(pa0, (bf16x8){vl0[d0][0], vl0[d0][1], vl0[d0][2], vl0[d0][3], vh0[d0][0], vh0[d0][1], vh0[d0][2], vh0[d0][3]}, o[d0], 0, 0, 0); \
                o[d0] = __builtin_amdgcn_mfma_f32_32x32x16_bf16(pa1, (bf16x8){vl1[d0][0], vl1[d0][1], vl1[d0][2], vl1[d0][3], vh1[d0][0], vh1[d0][1], vh1[d0][2], vh1[d0][3]}, o[d0], 0, 0, 0); } \
        } while (0)
#define DIL_PK4(P, B_, OUT) do { unsigned a0 = cvt_pk_bf16(P[B_+0], P[B_+1]), a1 = cvt_pk_bf16(P[B_+2], P[B_+3]);                          \
            unsigned b0_ = cvt_pk_bf16(P[B_+4], P[B_+5]), b1_ = cvt_pk_bf16(P[B_+6], P[B_+7]);                                             \
            auto r0 = __builtin_amdgcn_permlane32_swap(a0, b0_, false, false); auto r1 = __builtin_amdgcn_permlane32_swap(a1, b1_, false, false); \
            u32x4 w = {r0[0], r1[0], r0[1], r1[1]}; OUT = __builtin_bit_cast(bf16x8, w); } while (0)
        DIL_STEP(kfA, kfB, 0); DIL_STEP(kfB, kfA, 1); DIL_STEP(kfA, kfB, 2); DIL_STEP(kfB, kfA, 3); DIL_STEP(kfA, kfB, 4);
#undef DIL_STEP
#undef DIL_PK4
#undef DIL_KLOAD
#undef DIL_VDMA
        float fo = 0.f, fc = 1.f;
        if (S_ != 1) { const float mo = macc[ql], lo = lacc[ql]; const float mnew = fmaxf(mo, m_reg); fo = __builtin_amdgcn_exp2f(mo - mnew); fc = __builtin_amdgcn_exp2f(m_reg - mnew);
            l_reg = lo * fo + l_reg * fc; m_reg = mnew; }
        if (hi == 0 && r32 < VR) { macc[ql] = m_reg; lacc[ql] = l_reg; wsf[r32] = fo; wsf[32 + r32] = fc; }
        asm volatile("s_waitcnt lgkmcnt(0)" ::: "memory");
#pragma unroll
        for (int r = 0; r < 16; ++r) { const int row = crow(r, hi);
            if (row < VR) { const int qrow = rho + S_ * (i0 + row); LAS float* op = Oacc + qrow * 64 + r32;
                if (S_ == 1) { op[0] = o[0][r]; op[32] = o[1][r]; }
                else { const float a = wsf[row], b = wsf[32 + row]; op[0] = op[0] * a + o[0][r] * b; op[32] = op[32] * a + o[1][r] * b; } } }
        asm volatile("s_waitcnt lgkmcnt(0)" ::: "memory");
    }
}
__device__ __forceinline__ void unit(const bf16_t* Qh, const bf16_t* Kh, const bf16_t* Vh, int pitch, bf16_t* Oh, int op, int q0, LAS unsigned char* lds, LAS float* scr) {
    int tid_ = threadIdx.x; asm volatile("" : "+v"(tid_));
    const int tid = tid_, wid = __builtin_amdgcn_readfirstlane(tid >> 6), lane = tid & 63;
    pass<1>(Qh, Kh, Vh, pitch, q0, lds, scr, wid, lane);
    __syncthreads();
    pass<4>(Qh, Kh, Vh, pitch, q0, lds, scr, wid, lane);
    __syncthreads();
    pass<16>(Qh, Kh, Vh, pitch, q0, lds, scr, wid, lane);
    __syncthreads();
    {   const int q = tid >> 1, hf = tid & 1; const LAS f32x4* src = (const LAS f32x4*)(lds + OFF_O + (q * 64 + 32 * hf) * 4); const float rl = 1.0f / scr[256 + q];
        bf16_t* dst = Oh + (size_t)(q0 + q) * op + 32 * hf;
#pragma unroll
        for (int i = 0; i < 4; ++i) { const f32x4 a = src[2 * i] * rl, b = src[2 * i + 1] * rl;
            u32x4 w; w.x = cvt_pk_bf16(a[0], a[1]); w.y = cvt_pk_bf16(a[2], a[3]); w.z = cvt_pk_bf16(b[0], b[1]); w.w = cvt_pk_bf16(b[2], b[3]); *(u32x4*)(dst + 8 * i) = w; } }
    __syncthreads();
}
}

namespace mla {
using att::crow;
constexpr int DQ = 192, DV_ = 128;
constexpr int KP = DQ + 16, KB = 64 * KP;
constexpr int VP = 80, VB = DV_ * VP;
constexpr int NBUF = 3;
constexpr int OFF_K = 0, OFF_V = NBUF * KB, OFF_WS = NBUF * (KB + VB), BYTES = OFF_WS + 8 * 256;
constexpr int KCPR = KP / 16, NKP = KB / 1024, KPW = (NKP + 7) / 8;
constexpr int NVP = VB / 256, VPW = NVP / 8;
static_assert(BYTES <= 131072 && KB % 1024 == 0 && VB % 256 == 0 && NVP % 8 == 0, "mla LDS image");
constexpr float PSHIFT = 8.0f;

__device__ __forceinline__ void unit(const unsigned char* __restrict__ Qh, const unsigned char* __restrict__ Kh, int pitch, const unsigned char* __restrict__ VTh  ,
                                     unsigned char* __restrict__ Oh, int op, int q0, LAS unsigned char* lds) {
    constexpr float SC = C2_C;
    int tid_ = threadIdx.x; asm volatile("" : "+v"(tid_));
    const int tid = tid_, wid = __builtin_amdgcn_readfirstlane(tid >> 6), lane = tid & 63, r32 = lane & 31, hi = lane >> 5;
    const int qlo = q0 + wid * 32, qpos = qlo + r32;
    LAS float* wsf = (LAS float*)(lds + OFF_WS) + wid * 64;
    const int NT = (q0 + 256) / 64;
    unsigned kso[KPW], vso[VPW];
#pragma unroll
    for (int i = 0; i < KPW; ++i) { const int c = (wid + 8 * i) * 64 + lane, row = c / KCPR; int cc = c % KCPR; if (cc > KCPR - 2) cc = KCPR - 2; kso[i] = (unsigned)((row & 63) * pitch + cc * 16); }
#pragma unroll
    for (int i = 0; i < VPW; ++i) { const int off = ((wid + 8 * i) * 64 + lane) * 4, d = off / VP; int w = off % VP; if (w >= 64) w = 0;
        const int hh = w >> 5, g = (w & 31) >> 2; vso[i] = (unsigned)(d * SEQ + 32 * (g >> 2) + 8 * (g & 3) + 4 * hh); }
#define MLA_DMA(j, bf) do { const unsigned char* kt_ = Kh + (size_t)(j) * 64 * pitch; const unsigned char* vt_ = VTh + (size_t)(j) * 64; \
        _Pragma("unroll") for (int i = 0; i < KPW; ++i) if (wid + 8 * i < NKP) \
            __builtin_amdgcn_global_load_lds((const unsigned*)(kt_ + kso[i]), (LAS unsigned*)(lds + OFF_K + (bf) * KB + (wid + 8 * i) * 1024), 16, 0, 0); \
        _Pragma("unroll") for (int i = 0; i < VPW; ++i) \
            __builtin_amdgcn_global_load_lds((const unsigned*)(vt_ + vso[i]), (LAS unsigned*)(lds + OFF_V + (bf) * VB + (wid + 8 * i) * 256), 4, 0, 0); } while (0)
    MLA_DMA(0, 0);
    if (NT > 1) MLA_DMA(1, 1);
    i32x8 qr[3];
#pragma unroll
    for (int s = 0; s < 3; ++s) { const i32x4 lo_ = *(const i32x4*)(Qh + (size_t)qpos * pitch + 64 * s + 32 * hi), hi_ = *(const i32x4*)(Qh + (size_t)qpos * pitch + 64 * s + 32 * hi + 16);
        qr[s] = __builtin_shufflevector(lo_, hi_, 0, 1, 2, 3, 4, 5, 6, 7); }
    float m_reg = -1e30f;
    f32x16 o[4], ol = f32x16{};
    const i32x8 ones8 = {0x38383838, 0x38383838, 0x38383838, 0x38383838, 0x38383838, 0x38383838, 0x38383838, 0x38383838};
#pragma unroll
    for (int d = 0; d < 4; ++d) o[d] = f32x16{};
    const int koff = r32 * KP + hi * 32, voff = r32 * VP + hi * 32;
    asm volatile("s_waitcnt vmcnt(0)" ::: "memory");
    __syncthreads();
#define MLA_QK(P, bufi, hf_) do { const LAS unsigned char* kb_ = lds + OFF_K + (bufi) * KB + (hf_) * 32 * KP + koff; P = f32x16{}; \
        i32x8 kw_[3]; _Pragma("unroll") for (int s = 0; s < 3; ++s) { const i32x4 lo_ = *(const LAS i32x4*)(kb_ + 64 * s), hi_ = *(const LAS i32x4*)(kb_ + 64 * s + 16); kw_[s] = __builtin_shufflevector(lo_, hi_, 0, 1, 2, 3, 4, 5, 6, 7); } \
        _Pragma("unroll") for (int s = 0; s < 3; ++s) P = __builtin_amdgcn_mfma_scale_f32_32x32x64_f8f6f4(kw_[s], qr[s], P, 0, 0, 0, 0, 0, 0); } while (0)
    f32x16 pA, pB, pC, pD;
    int buf = 0;
    { if (0 <= qlo + 31) { MLA_QK(pA, 0, 0); } if (32 <= qlo + 31) { MLA_QK(pB, 0, 1); } }
#define MLA_SMPV(P0, P1, kb, vbuf) do { \
        const bool a0_ = (kb) <= qlo + 31, a1_ = (kb) + 32 <= qlo + 31; \
        if (a0_) { \
            const float NEG = -__builtin_inff(); const int dq = qpos - (kb) - 4 * hi; \
            if (!a1_) { _Pragma("unroll") for (int r = 0; r < 16; ++r) P1[r] = NEG; } \
            if ((kb) + 63 > qlo) { _Pragma("unroll") for (int r = 0; r < 16; ++r) { const int c = (r & 3) + 8 * (r >> 2); if (dq - c < 0) P0[r] = NEG; if (dq - c - 32 < 0) P1[r] = NEG; } } \
            float pmax = fmaxf(P0[0], P1[0]); \
            _Pragma("unroll") for (int r = 1; r < 16; ++r) pmax = fmaxf(pmax, fmaxf(P0[r], P1[r])); \
            { auto rr = __builtin_amdgcn_permlane32_swap(__float_as_uint(pmax), __float_as_uint(pmax), false, false); pmax = fmaxf(__uint_as_float(rr[0]), __uint_as_float(rr[1])); } \
            const float mn = fmaxf(m_reg, pmax * SC); const float alpha = __builtin_amdgcn_exp2f(m_reg - mn); m_reg = mn; \
              \
              \
            const float c8 = 8.0f * SC, b8 = 8.0f * (PSHIFT + 7.0f - mn); \
            i32x8 pa; \
            _Pragma("unroll") for (int g = 0; g < 4; ++g) { unsigned w0 = 0u, w1 = 0u; \
                _Pragma("unroll") for (int b_ = 0; b_ < 4; ++b_) { w0 = __builtin_amdgcn_cvt_pk_u8_f32(__builtin_fmaf(P0[4 * g + b_], c8, b8), b_, w0); w1 = __builtin_amdgcn_cvt_pk_u8_f32(__builtin_fmaf(P1[4 * g + b_], c8, b8), b_, w1); } \
                pa[g] = (int)w0; pa[4 + g] = (int)w1; } \
            if (__any(alpha < 1.f)) { if (hi == 0) wsf[r32] = alpha; asm volatile("s_waitcnt lgkmcnt(0)" ::: "memory"); \
                _Pragma("unroll") for (int r = 0; r < 16; ++r) { const float a = wsf[crow(r, hi)]; ol[r] *= a; _Pragma("unroll") for (int d = 0; d < 4; ++d) o[d][r] *= a; } } \
            ol = __builtin_amdgcn_mfma_scale_f32_32x32x64_f8f6f4(pa, ones8, ol, 0, 0, 0, 0, 0, 0); \
            const LAS unsigned char* vb_ = lds + OFF_V + (vbuf) * VB + voff; \
            _Pragma("unroll") for (int d0 = 0; d0 < 4; ++d0) { const i32x4 lo_ = *(const LAS i32x4*)(vb_ + d0 * 32 * VP), hi_ = *(const LAS i32x4*)(vb_ + d0 * 32 * VP + 16); \
                o[d0] = __builtin_amdgcn_mfma_scale_f32_32x32x64_f8f6f4(pa, __builtin_shufflevector(lo_, hi_, 0, 1, 2, 3, 4, 5, 6, 7), o[d0], 0, 0, 0, 0, 0, 0); } \
        } } while (0)
    for (int t = 0; t < NT; t += 2) {
        {   if (t + 2 < NT) { const int b2 = buf == 0 ? 2 : buf - 1; MLA_DMA(t + 2, b2); }
            const int kb = t * 64, nb = buf == 2 ? 0 : buf + 1;
            if (kb + 64 <= qlo + 31) MLA_QK(pC, nb, 0);
            if (kb + 96 <= qlo + 31) MLA_QK(pD, nb, 1);
            MLA_SMPV(pA, pB, kb, buf);
            asm volatile("s_waitcnt vmcnt(0)" ::: "memory"); __syncthreads(); buf = nb; }
        {   if (t + 3 < NT) { const int b2 = buf == 0 ? 2 : buf - 1; MLA_DMA(t + 3, b2); }
            const int kb = (t + 1) * 64, nb = buf == 2 ? 0 : buf + 1;
            if (t + 2 < NT) { if (kb + 64 <= qlo + 31) MLA_QK(pA, nb, 0); if (kb + 96 <= qlo + 31) MLA_QK(pB, nb, 1); }
            MLA_SMPV(pC, pD, kb, buf);
            asm volatile("s_waitcnt vmcnt(0)" ::: "memory"); __syncthreads(); buf = nb; }
    }
#undef MLA_SMPV
#undef MLA_QK
#undef MLA_DMA
    unsigned char* Ow = Oh + (size_t)qlo * op;
#pragma unroll
    for (int r = 0; r < 16; ++r) { const int orow = crow(r, hi); const float rl = __builtin_amdgcn_rcpf(ol[r]);
#pragma unroll
        for (int d0 = 0; d0 < 4; ++d0) { const float v = o[d0][r] * rl; const float v1 = __shfl_down(v, 1), v2 = __shfl_down(v, 2), v3 = __shfl_down(v, 3);
            if ((r32 & 3) == 0) *(unsigned*)(Ow + (size_t)orow * op + d0 * 32 + r32) = pk4_fp8(v, v1, v2, v3); } }
    __syncthreads();
}
}

constexpr int NWAVES = 8;
constexpr size_t MiB = 1u << 20;
constexpr size_t WS_CTL = 0, CTL_ZERO_BYTES = 1 * MiB;
constexpr size_t WS_WEIN = 2 * MiB;
constexpr size_t WS_WEOUT = 12 * MiB;
constexpr size_t WS_WOIN = 16 * MiB;
constexpr size_t WS_WUQ = 20 * MiB;
constexpr size_t WS_WUKV = 23 * MiB;
constexpr size_t WS_WOOUT = 25 * MiB;
constexpr size_t WS_B1P = 29 * MiB;
constexpr size_t WS_SSQ = 30 * MiB;
constexpr size_t WS_TOKER = 31 * MiB;
constexpr size_t WS_TOKG = 31 * MiB + 512 * 1024;
constexpr size_t WS_XN = 32 * MiB;
constexpr size_t WS_Z = 64 * MiB;
constexpr size_t WS_MIX = 144 * MiB;
constexpr size_t WS_QR = 176 * MiB;
constexpr size_t WS_KVR = 224 * MiB;
constexpr size_t WS_QF = 288 * MiB;
constexpr size_t WS_KF = 336 * MiB;
constexpr size_t WS_Z8 = 104 * MiB;
constexpr size_t WS_MIX8 = 160 * MiB;
constexpr size_t WS_VT = 3200 * MiB;
constexpr size_t WS_W1 = 384 * MiB;
constexpr size_t WS_W2 = 896 * MiB;
constexpr size_t WS_XG = 1152 * MiB;
constexpr size_t WS_ACT = 1664 * MiB;
constexpr size_t WS_Y = 2176 * MiB;
constexpr size_t WS_END = 3216 * MiB;
constexpr int CW_MOE = 65536;
constexpr int CW_TMO = 0, CW_CODE = 1, CW_BAR = 4096, CW_CNT = 16384;
constexpr int RING_OFF = 0, RING_BYTES = 131072;
constexpr int LDSCTL_OFF = RING_BYTES, MISC_OFF = LDSCTL_OFF + 320;
constexpr int SCR_OFF = RING_BYTES + 1024;
constexpr int LDS_BYTES = 155648;
constexpr int SCR_BYTES = LDS_BYTES - SCR_OFF;

typedef GAS unsigned gu32;
#define RLX_AGENT __ATOMIC_RELAXED, __HIP_MEMORY_SCOPE_AGENT

#define XB_TMO      128
#define XB_XCNT(j)  (256  + 64 * (j))
#define XB_XSUB(j)  (1280 + 64 * (j))
#define XB_XGEN(j)  (2304 + 64 * (j))
#define XB_TOP      3328
#define XB_TOPGEN   3392
#define XCD_BAR_WORDS 3456
#define XB_SPIN_CAP (1u << 18)
__device__ __forceinline__ unsigned xb_ld(unsigned* p)              { return __hip_atomic_load(p, __ATOMIC_RELAXED, __HIP_MEMORY_SCOPE_AGENT); }
__device__ __forceinline__ unsigned xb_add(unsigned* p, unsigned v) { return __hip_atomic_fetch_add(p, v, __ATOMIC_RELAXED, __HIP_MEMORY_SCOPE_AGENT); }
__device__ __forceinline__ unsigned xb_xcc_id() { return (unsigned)__builtin_amdgcn_s_getreg((3 << 11) | 20) & 0xFu; }
#define XB_SPIN(cond, bar) do { unsigned _sp = 0; while (cond) { __builtin_amdgcn_s_sleep(1); \
    if ((++_sp & 255u) == 0u) { if (xb_ld(&(bar)[XB_TMO])) break; if (_sp > XB_SPIN_CAP) { atomicAdd(&(bar)[XB_TMO], 1u); break; } } } } while (0)
struct XcdBarrier { unsigned* bar; unsigned x; volatile LAS unsigned* st; };
__device__ __forceinline__ XcdBarrier xcd_barrier_post(unsigned* bar, volatile LAS unsigned* st) {
    XcdBarrier b; b.bar = bar; b.x = xb_xcc_id(); b.st = st;
    if (threadIdx.x == 0) (void)xb_add(&bar[XB_XCNT(b.x)], 1u);
    return b;
}
__device__ __forceinline__ void xcd_barrier_complete(unsigned* bar, unsigned x, unsigned& nloc, unsigned& nx) {
    const unsigned G = gridDim.x * gridDim.y * gridDim.z;
    unsigned sum, cnt, mine, sp = 0u;
    for (;;) {
        sum = 0u; cnt = 0u; mine = 0u;
#pragma unroll
        for (unsigned j = 0; j < 16; ++j) { const unsigned c = xb_ld(&bar[XB_XCNT(j)]); sum += c; cnt += (c > 0u) ? 1u : 0u; mine = (j == x) ? c : mine; }
        if (sum == G) break;
        __builtin_amdgcn_s_sleep(1);
        if ((++sp & 255u) == 0u) { if (xb_ld(&bar[XB_TMO])) break; if (sp > XB_SPIN_CAP) { atomicAdd(&bar[XB_TMO], 1u); break; } }
    }
    nloc = mine > 0u ? mine : 1u; nx = cnt > 0u ? cnt : 1u;
}
__device__ __forceinline__ void xcd_barrier(const XcdBarrier& b) {
    asm volatile("s_waitcnt vmcnt(0)" ::: "memory");
    __syncthreads();
    if (threadIdx.x == 0) {
        unsigned* bar = b.bar;
        __builtin_amdgcn_s_waitcnt(0);
        unsigned nloc = b.st[0], nx = b.st[1];
        if (nloc == 0u) { xcd_barrier_complete(bar, b.x, nloc, nx); b.st[0] = nloc; b.st[1] = nx; }
        const unsigned old = xb_add(&bar[XB_XSUB(b.x)], 1u);
        const unsigned gen = old / nloc;
        if (old + 1u == (gen + 1u) * nloc) {
            __builtin_amdgcn_fence(__ATOMIC_RELEASE, "agent");
            asm volatile("s_waitcnt vmcnt(0)" ::: "memory");
            const unsigned og = xb_add(&bar[XB_TOP], 1u);
            const unsigned tg = og / nx;
            if (og + 1u == (tg + 1u) * nx) xb_add(&bar[XB_TOPGEN], 1u);
            else XB_SPIN(xb_ld(&bar[XB_TOPGEN]) == tg, bar);
            __builtin_amdgcn_fence(__ATOMIC_ACQUIRE, "agent");
            xb_add(&bar[XB_XGEN(b.x)], 1u);
            asm volatile("s_waitcnt vmcnt(0)" ::: "memory");
        } else {
            XB_SPIN(xb_ld(&bar[XB_XGEN(b.x)]) == gen, bar);
            __builtin_amdgcn_fence(__ATOMIC_ACQUIRE, "agent");
            asm volatile("s_waitcnt vmcnt(0)" ::: "memory");
        }
    }
    __syncthreads();
}

struct Args {
    const float* in[24]; float* out; unsigned char* ws; int stage_limit; int pad;
};
enum { I_X = 0, I_MIXN, I_FFNN, I_EWIN, I_EWS, I_EBS, I_EGV, I_EGQ, I_EGK, I_EWOUT, I_OWIN, I_OGCQ, I_OGCKV, I_OWUQ, I_OWUKV, I_OGQ, I_OGK, I_OWOUT,
       I_RW, I_RB, I_W1, I_B1, I_W2, I_B2 };

struct Frame {
    LAS unsigned char* lds;
    int vcu, G;
};

__device__ __forceinline__ float wave_sum(float v) {
#pragma unroll
    for (int o = 1; o < 64; o <<= 1) v += __shfl_xor(v, o);
    return v;
}
#define LDS_WAIT() asm volatile("s_waitcnt lgkmcnt(0)" ::: "memory")

template <int MODE> __device__ __forceinline__ int dst_row(int o) {
    if (MODE == 1) { if (o >= 1024 && o < 2048) return (o & ~255) | (((o >> 5) & 1) << 7) | (((o >> 6) & 3) << 5) | (o & 31); return o; }
    if (MODE == 2) return ((o >> 8) << 8) | ((o & 1) << 7) | ((o & 255) >> 1);
    return o;
}
template <int MODE>
__device__ __forceinline__ void transpose_item(const float* __restrict__ W, int K, int N, bf16_t* __restrict__ WT, const float* __restrict__ gain, LAS float* scr, int item, int lane) {
    const int nblk = N / 32, kb = item / nblk, nb = item % nblk, k0 = 64 * kb, n0 = 32 * nb;
#pragma unroll 8
    for (int i = 0; i < 32; ++i) { const int kk = 2 * i + (lane >> 5); float w = W[(size_t)(k0 + kk) * N + n0 + (lane & 31)]; if (gain) w *= gain[k0 + kk]; scr[kk * 33 + (lane & 31)] = w; }
    LDS_WAIT(); asm volatile("" ::: "memory");
    const int c = lane & 7;
#pragma unroll
    for (int j = 0; j < 4; ++j) { const int n = (lane >> 3) + 8 * j; const LAS float* s = scr + (8 * c) * 33 + n;
        u32x4 o; o.x = cvt_pk_bf16(s[0 * 33], s[1 * 33]); o.y = cvt_pk_bf16(s[2 * 33], s[3 * 33]); o.z = cvt_pk_bf16(s[4 * 33], s[5 * 33]); o.w = cvt_pk_bf16(s[6 * 33], s[7 * 33]);
        *(u32x4*)(WT + (size_t)dst_row<MODE>(n0 + n) * K + k0 + 8 * c) = o; }
    LDS_WAIT(); asm volatile("" ::: "memory");
}
template <int MODE>
__device__ __forceinline__ void transpose_job(Frame& F, const float* W, int K, int N, int nmat, size_t src_stride, bf16_t* WT, size_t dst_stride, const float* gain, int gain_stride) {
    int tid_ = threadIdx.x; asm volatile("" : "+v"(tid_));
    const int wave = __builtin_amdgcn_readfirstlane(tid_ >> 6), lane = tid_ & 63;
    LAS float* scr = (LAS float*)(F.lds + RING_OFF + wave * 16384);
    const int gw = F.vcu * NWAVES + wave, NGW = F.G * NWAVES;
    const int per = (K / 64) * (N / 32), total = per * nmat;
    for (int it = gw; it < total; it += NGW) { const int mi = it / per, item = it - mi * per;
        transpose_item<MODE>(W + (size_t)mi * src_stride, K, N, WT + (size_t)mi * dst_stride, gain ? gain + (size_t)mi * gain_stride : nullptr, scr, item, lane); }
}


__device__ __forceinline__ void tr8_load(f32x4 (&v)[16], const float* __restrict__ W, int N, int item, int lane) {
    const int nblk = N / 32, kb = item / nblk, nb = item % nblk, k0 = 128 * kb, n0 = 32 * nb;
#pragma unroll
    for (int i = 0; i < 16; ++i) v[i] = __builtin_nontemporal_load((const f32x4*)(W + (size_t)(k0 + 8 * i + (lane >> 3)) * N + n0 + 4 * (lane & 7)));
}
template <int MODE>
__device__ __forceinline__ void tr8_store(const f32x4 (&v)[16], int K, int N, unsigned char* __restrict__ WT, const float* __restrict__ gain, LAS unsigned char* scr, int item, int lane) {
    const int nblk = N / 32, kb = item / nblk, nb = item % nblk, k0 = 128 * kb, n0 = 32 * nb;
    constexpr int TP = 144;
#pragma unroll
    for (int i = 0; i < 16; ++i) { const int kl = 8 * i + (lane >> 3); const float sc = gain ? W8_SCALE * gain[k0 + kl] : W8_SCALE;
        const unsigned w = pk4_fp8(v[i].x * sc, v[i].y * sc, v[i].z * sc, v[i].w * sc); LAS unsigned char* d = scr + (4 * (lane & 7)) * TP + kl;
        d[0] = (unsigned char)w; d[TP] = (unsigned char)(w >> 8); d[2 * TP] = (unsigned char)(w >> 16); d[3 * TP] = (unsigned char)(w >> 24); }
    LDS_WAIT(); asm volatile("" ::: "memory");
#pragma unroll
    for (int m = 0; m < 4; ++m) { const int q = lane + 64 * m, n = q >> 3, kc = q & 7;
        const u32x4 o = *(const LAS u32x4*)(scr + n * TP + 16 * kc);
        __builtin_nontemporal_store(o, (u32x4*)(WT + (size_t)dst_row<MODE>(n0 + n) * K + k0 + 16 * kc)); }
    LDS_WAIT(); asm volatile("" ::: "memory");
}
template <int MODE>
__device__ __forceinline__ void transpose_job_fp8(Frame& F, const float* W, int K, int N, int nmat, size_t src_stride, unsigned char* WT, size_t dst_stride, const float* gain = nullptr, int gain_stride = 0) {
    int tid_ = threadIdx.x; asm volatile("" : "+v"(tid_));
    const int wave = __builtin_amdgcn_readfirstlane(tid_ >> 6), lane = tid_ & 63;
    LAS unsigned char* scr = F.lds + RING_OFF + wave * 16384;
    const int gw = F.vcu * NWAVES + wave, NGW = F.G * NWAVES;
    const int per = (K / 128) * (N / 32), total = per * nmat;
    f32x4 cur[16], nxt[16];
    int it = gw;
    if (it < total) { const int mi = it / per; tr8_load(cur, W + (size_t)mi * src_stride, N, it - mi * per, lane); }
    for (; it < total; it += NGW) {
        const int itn = it + NGW;
        if (itn < total) { const int mn = itn / per; tr8_load(nxt, W + (size_t)mn * src_stride, N, itn - mn * per, lane); }
        const int mi = it / per;
        tr8_store<MODE>(cur, K, N, WT + (size_t)mi * dst_stride, gain ? gain + (size_t)mi * gain_stride : nullptr, scr, it - mi * per, lane);
#pragma unroll
        for (int i = 0; i < 16; ++i) cur[i] = nxt[i];
    }
}

__device__ __forceinline__ void rms_row_to_fp8(int lane, const float* xrow, const float* g, unsigned char* orow, float* copy) {
    const f32x4* xr = (const f32x4*)xrow + lane; const f32x4* gr = (const f32x4*)g + lane;
    f32x4 v[4]; float s = 0.f;
#pragma unroll
    for (int j = 0; j < 4; ++j) { v[j] = xr[64 * j]; s += (v[j].x * v[j].x + v[j].y * v[j].y) + (v[j].z * v[j].z + v[j].w * v[j].w); }
    const float rstd = 1.0f / sqrtf(wave_sum(s) * (1.f / DM) + EPS);
    unsigned* o4 = (unsigned*)orow + lane;
#pragma unroll
    for (int j = 0; j < 4; ++j) { const f32x4 gg = gr[64 * j]; if (copy) ((f32x4*)copy + lane)[64 * j] = v[j];
        o4[64 * j] = pk4_fp8(v[j].x * rstd * gg.x, v[j].y * rstd * gg.y, v[j].z * rstd * gg.z, v[j].w * rstd * gg.w); }
}
__device__ __forceinline__ void rms_row_to_bf16(int lane, const float* xrow, const float* g, bf16_t* orow, float* copy) {
    const f32x4* xr = (const f32x4*)xrow + lane; const f32x4* gr = (const f32x4*)g + lane;
    f32x4 v[4]; float s = 0.f;
#pragma unroll
    for (int j = 0; j < 4; ++j) { v[j] = xr[64 * j]; s += (v[j].x * v[j].x + v[j].y * v[j].y) + (v[j].z * v[j].z + v[j].w * v[j].w); }
    const float rstd = 1.0f / sqrtf(wave_sum(s) * (1.f / DM) + EPS);
    u32x2* o8 = (u32x2*)orow + lane;
#pragma unroll
    for (int j = 0; j < 4; ++j) { const f32x4 gg = gr[64 * j]; if (copy) ((f32x4*)copy + lane)[64 * j] = v[j];
        u32x2 w; w.x = cvt_pk_bf16(v[j].x * rstd * gg.x, v[j].y * rstd * gg.y); w.y = cvt_pk_bf16(v[j].z * rstd * gg.z, v[j].w * rstd * gg.w); o8[64 * j] = w; }
}

namespace pg8 {
struct EpiEvenIn {
    static constexpr bool PERM = false;
    bf16_t* Z; const float* gq; const float* gk;
    __device__ __forceinline__ void operator()(const f32x4 (&acc)[2][2][4][2], const Unit& u, int wr, int wc, int fr, int fq) const {
        const int row0 = u.pm * BM + wr * 64 + fr, pn = u.pn;
        if (pn >= 4 && pn < 8) {
            const float* g = pn < 6 ? gq : gk; const float sc = pn < 6 ? C2_B : 1.0f;
            f32x4 gv[2][2];
#pragma unroll
            for (int bj = 0; bj < 2; ++bj)
#pragma unroll
                for (int n = 0; n < 2; ++n) gv[bj][n] = *(const f32x4*)(g + 32 * bj + 16 * n + 4 * fq);
#pragma unroll
            for (int ai = 0; ai < 2; ++ai)
#pragma unroll
                for (int m = 0; m < 4; ++m) {
                    float ss = 0.f;
#pragma unroll
                    for (int bj = 0; bj < 2; ++bj)
#pragma unroll
                        for (int n = 0; n < 2; ++n) { const f32x4 v = acc[ai][bj][m][n]; ss += (v[0] * v[0] + v[1] * v[1]) + (v[2] * v[2] + v[3] * v[3]); }
                    ss += __shfl_xor(ss, 16); ss += __shfl_xor(ss, 32);
                    const float rstd = sc / sqrtf(ss * (1.0f / 64.0f) + EPS);
                    bf16_t* rowp = Z + (size_t)(row0 + ai * HALF + m * 16) * EVEN_IN + pn * BM + wc * 64 + 4 * fq;
#pragma unroll
                    for (int bj = 0; bj < 2; ++bj)
#pragma unroll
                        for (int n = 0; n < 2; ++n) { const f32x4 v = acc[ai][bj][m][n] * rstd * gv[bj][n];
                            u32x2 w; w.x = cvt_pk_bf16(v[0], v[1]); w.y = cvt_pk_bf16(v[2], v[3]); *(u32x2*)(rowp + 32 * bj + 16 * n) = w; }
                }
        } else {
            const bool act = pn < 4;
#pragma unroll
            for (int ai = 0; ai < 2; ++ai)
#pragma unroll
                for (int m = 0; m < 4; ++m) { bf16_t* rowp = Z + (size_t)(row0 + ai * HALF + m * 16) * EVEN_IN + pn * BM + wc * 32 + 4 * fq;
#pragma unroll
                    for (int bj = 0; bj < 2; ++bj)
#pragma unroll
                        for (int n = 0; n < 2; ++n) { f32x4 v = acc[ai][bj][m][n]; if (act) v = gelu4(v);
                            u32x2 w; w.x = cvt_pk_bf16(v[0], v[1]); w.y = cvt_pk_bf16(v[2], v[3]); *(u32x2*)(rowp + bj * HALF + 16 * n) = w; } }
        }
    }
};
template <bool F8 = false> struct EpiResidT {
    static constexpr bool PERM = false;
    const float* src; float* out;
    __device__ __forceinline__ void operator()(const f32x4 (&acc)[2][2][4][2], const Unit& u, int wr, int wc, int fr, int fq) const {
        const int row0 = u.pm * BM + wr * 64 + fr;
#pragma unroll
        for (int ai = 0; ai < 2; ++ai)
#pragma unroll
            for (int m = 0; m < 4; ++m) { const size_t ro = (size_t)(row0 + ai * HALF + m * 16) * DM + u.pn * BM + wc * 32 + 4 * fq;
#pragma unroll
                for (int bj = 0; bj < 2; ++bj)
#pragma unroll
                    for (int n = 0; n < 2; ++n) { const size_t o_ = ro + bj * HALF + 16 * n; *(f32x4*)(out + o_) = *(const f32x4*)(src + o_) + (F8 ? acc[ai][bj][m][n] * W8_INV : acc[ai][bj][m][n]); }
                if (m & 1) asm volatile("" ::: "memory"); }
    }
};
typedef EpiResidT<false> EpiResid;
struct EpiOddIn {
    static constexpr bool PERM = false;
    bf16_t* Z; unsigned char* Z8; float* ssq;
    __device__ __forceinline__ void operator()(const f32x4 (&acc)[2][2][4][2], const Unit& u, int wr, int wc, int fr, int fq) const {
        const int row0 = u.pm * BM + wr * 64 + fr, pn = u.pn;
#pragma unroll
        for (int ai = 0; ai < 2; ++ai)
#pragma unroll
            for (int m = 0; m < 4; ++m) { const int row = row0 + ai * HALF + m * 16; bf16_t* rowp = Z + (size_t)row * ODD_INP + pn * BM + wc * 32 + 4 * fq;
                float ss = 0.f;
#pragma unroll
                for (int bj = 0; bj < 2; ++bj)
#pragma unroll
                    for (int n = 0; n < 2; ++n) { const f32x4 v = acc[ai][bj][m][n] * W8_INV; ss += (v[0] * v[0] + v[1] * v[1]) + (v[2] * v[2] + v[3] * v[3]);
                        if (pn < 3) *(unsigned*)(Z8 + (size_t)row * ODD_INP + pn * BM + wc * 32 + 4 * fq + bj * HALF + 16 * n) = pk4_fp8(v[0], v[1], v[2], v[3]);
                        else { u32x2 w; w.x = cvt_pk_bf16(v[0], v[1]); w.y = cvt_pk_bf16(v[2], v[3]); *(u32x2*)(rowp + bj * HALF + 16 * n) = w; } }
                ss += __shfl_xor(ss, 16); ss += __shfl_xor(ss, 32);
                if (fq == 0) ssq[(size_t)row * 16 + pn * 4 + wc] = ss; }
    }
};
template <int NS> struct EpiRowScale {
    static constexpr bool PERM = true;
    bf16_t* O; int ldc; const float* ssq; int s0; float inv_cols;
    __device__ __forceinline__ void operator()(const f32x4 (&acc)[2][2][4][2], const Unit& u, int wr, int wc, int fr, int fq) const {
        const int row0 = u.pm * BM + wr * 64 + fr; const int col0 = u.pn * BM + wc * 32 + 8 * fq;
#pragma unroll
        for (int ai = 0; ai < 2; ++ai)
#pragma unroll
            for (int m = 0; m < 4; ++m) { const int row = row0 + ai * HALF + m * 16;
                float ss = 0.f; const f32x4* sp = (const f32x4*)(ssq + (size_t)row * 16 + s0);
#pragma unroll
                for (int q = 0; q < NS; ++q) { const f32x4 t = sp[q]; ss += (t[0] + t[1]) + (t[2] + t[3]); }
                const float rstd = W8_INV / sqrtf(ss * inv_cols + EPS);
                bf16_t* rowp = O + (size_t)row * ldc + col0;
#pragma unroll
                for (int bj = 0; bj < 2; ++bj) { const f32x4 v0 = acc[ai][bj][m][0] * rstd, v1 = acc[ai][bj][m][1] * rstd;
                    u32x4 w; w.x = cvt_pk_bf16(v0[0], v0[1]); w.y = cvt_pk_bf16(v0[2], v0[3]); w.z = cvt_pk_bf16(v1[0], v1[1]); w.w = cvt_pk_bf16(v1[2], v1[3]);
                    *(u32x4*)(rowp + bj * HALF) = w; }
                asm volatile("" ::: "memory"); }
    }
};
__device__ __forceinline__ void store8_sc1(void* p, u32x2 v) { asm volatile("global_store_dwordx2 %0, %1, off sc1" :: "v"(p), "v"(v) : "memory"); }
template <bool WT = false> struct EpiSwigluT {
    static constexpr bool PERM = true;
    unsigned char* ACT; const float* b1p;
    __device__ __forceinline__ void operator()(const f32x4 (&acc)[2][2][4][2], const Unit& u, int wr, int wc, int fr, int fq) const {
        const int row0 = u.pm * BM + wr * 64 + fr, e = u.pb >> 3, pn = u.pn;
        const float* bp = b1p + (size_t)e * 2048 + pn * BM + wc * 32 + 8 * fq;
        f32x4 bg[2], bl[2];
#pragma unroll
        for (int n = 0; n < 2; ++n) { bg[n] = *(const f32x4*)(bp + 4 * n); bl[n] = *(const f32x4*)(bp + HALF + 4 * n); }
#pragma unroll
        for (int ai = 0; ai < 2; ++ai)
#pragma unroll
            for (int m = 0; m < 4; ++m) { unsigned char* rowp = ACT + (size_t)(row0 + ai * HALF + m * 16) * DE + pn * HALF + wc * 32 + 8 * fq;
                float a[8];
#pragma unroll
                for (int n = 0; n < 2; ++n) { const f32x4 gv = acc[ai][0][m][n] * W8_INV + bg[n], lv = acc[ai][1][m][n] * W8_INV + bl[n];
#pragma unroll
                    for (int i = 0; i < 4; ++i) { const float gl = fminf(gv[i], 7.0f), li = fminf(fmaxf(lv[i], -7.0f), 7.0f);
                        const float sg = __builtin_amdgcn_rcpf(1.0f + __builtin_amdgcn_exp2f(-1.702f * LOG2E * gl));
                        a[4 * n + i] = gl * sg * (li + 1.0f); } }
                u32x2 w; w.x = pk4_fp8(a[0], a[1], a[2], a[3]); w.y = pk4_fp8(a[4], a[5], a[6], a[7]);
                if (WT) store8_sc1(rowp, w); else *(u32x2*)rowp = w; }
    }
};
typedef EpiSwigluT<false> EpiSwiglu;
struct EpiDown {
    static constexpr bool PERM = true;
    bf16_t* Y; const float* b2;
    __device__ __forceinline__ void operator()(const f32x4 (&acc)[2][2][4][2], const Unit& u, int wr, int wc, int fr, int fq) const {
        const int row0 = u.pm * BM + wr * 64 + fr, e = u.pb >> 2, pn = u.pn;
        const float* bp = b2 + (size_t)e * DM + pn * BM + wc * 32 + 8 * fq;
        f32x4 bv[2][2];
#pragma unroll
        for (int bj = 0; bj < 2; ++bj)
#pragma unroll
            for (int n = 0; n < 2; ++n) bv[bj][n] = *(const f32x4*)(bp + bj * HALF + 4 * n);
#pragma unroll
        for (int ai = 0; ai < 2; ++ai)
#pragma unroll
            for (int m = 0; m < 4; ++m) { bf16_t* rowp = Y + (size_t)(row0 + ai * HALF + m * 16) * DM + pn * BM + wc * 32 + 8 * fq;
#pragma unroll
                for (int bj = 0; bj < 2; ++bj) { const f32x4 v0 = acc[ai][bj][m][0] * W8_INV + bv[bj][0], v1 = acc[ai][bj][m][1] * W8_INV + bv[bj][1];
                    u32x4 w; w.x = cvt_pk_bf16(v0[0], v0[1]); w.y = cvt_pk_bf16(v0[2], v0[3]); w.z = cvt_pk_bf16(v1[0], v1[1]); w.w = cvt_pk_bf16(v1[2], v1[3]);
                    *(u32x4*)(rowp + bj * HALF) = w; } }
    }
};
struct MoeOrder {
    const LAS int* tbl; int nN, G, c;
    __device__ bool next(int i, Unit& u) const {
        const long L = (long)i * G + c; const int rb = (int)(L / nN);
        if (rb >= __builtin_amdgcn_readfirstlane(tbl[32])) return false;
        int e = 0;
#pragma unroll
        for (int k = 1; k < 32; ++k) e += (tbl[k] <= rb) ? 1 : 0;
        e = __builtin_amdgcn_readfirstlane(e); const int rbl = __builtin_amdgcn_readfirstlane(rb - tbl[e]);
        u.pm = e * (ECAP / BM) + rbl; u.pn = (int)(L % nN); u.pb = e * nN + u.pn; u.kind = 0; u.rb = rb; return true;
    }
    __device__ __forceinline__ void a_ready(const Unit&) const {}
    __device__ __forceinline__ void pre_epi() const {}
    __device__ __forceinline__ void done(const Unit&) const {}
    __device__ __forceinline__ void finish() const {}
};

constexpr unsigned MOE_SPIN_CAP = 1u << 22;
struct MoeMergedOrder {
    const LAS int* tbl; int G, c; gu32* cnt;
    mutable int pend;
    __device__ __forceinline__ void flush() const {
        if (pend >= 0) { asm volatile("s_waitcnt vmcnt(0)" ::: "memory");
            if ((threadIdx.x & 63) == 0) __hip_atomic_fetch_add(cnt + 16 * pend, 1u, __ATOMIC_RELAXED, __HIP_MEMORY_SCOPE_AGENT);
            pend = -1; } }
    __device__ bool next(int i, Unit& u) const {
        const int nb = __builtin_amdgcn_readfirstlane(tbl[32]);
        long L = (long)i * G + c; int nN = 8, kind = 0;
        if (L >= (long)nb * 8) { L -= (long)nb * 8; nN = 4; kind = 1; if (L >= (long)nb * 4) return false; }
        const int rb = (int)(L / nN);
        int e = 0;
#pragma unroll
        for (int k = 1; k < 32; ++k) e += (tbl[k] <= rb) ? 1 : 0;
        e = __builtin_amdgcn_readfirstlane(e); const int rbl = __builtin_amdgcn_readfirstlane(rb - tbl[e]);
        u.pm = e * (ECAP / BM) + rbl; u.pn = (int)(L % nN); u.pb = e * nN + u.pn; u.kind = kind; u.rb = rb; return true;
    }
    __device__ __forceinline__ void a_ready(const Unit& u) const {
        if (u.kind == 1) {
            flush();
            if (threadIdx.x < 64) {
                unsigned sp = 0;
                while ((unsigned)__builtin_amdgcn_readfirstlane(__hip_atomic_load(cnt + 16 * u.rb, __ATOMIC_RELAXED, __HIP_MEMORY_SCOPE_AGENT)) < 64u) { __builtin_amdgcn_s_sleep(2); if (++sp > MOE_SPIN_CAP) break; }
                __builtin_amdgcn_fence(__ATOMIC_ACQUIRE, "agent");
                asm volatile("s_waitcnt vmcnt(0)" ::: "memory");
            }
            __builtin_amdgcn_s_barrier();
        }
    }
    __device__ __forceinline__ void pre_epi() const { flush(); }
    __device__ __forceinline__ void done(const Unit& u) const { if (u.kind == 0) pend = u.rb; }
    __device__ __forceinline__ void finish() const { flush(); }
};
struct EpiMoe {
    static constexpr bool PERM = true;
    EpiSwigluT<true> up; EpiDown down;
    __device__ __forceinline__ void operator()(const f32x4 (&acc)[2][2][4][2], const Unit& u, int wr, int wc, int fr, int fq) const {
        if (u.kind == 0) up(acc, u, wr, wc, fr, fq); else down(acc, u, wr, wc, fr, fq);
    }
};
}

__device__ __forceinline__ void gmlp_unit(Frame& F, const bf16_t* Z, bf16_t* MIX, const float* Ws, const float* bs, const float* gv, int unit) {
    constexpr int VP = 272;
    LAS unsigned char* VT = F.lds + RING_OFF;
    const int h = unit & 3, chunk = unit >> 2;
    int tid_ = threadIdx.x; asm volatile("" : "+v"(tid_));
    const int t0 = chunk * 128, tid = tid_, lane = tid & 63, w = __builtin_amdgcn_readfirstlane(tid >> 6);
    {
        const int s = tid >> 2, dq = (tid & 3) * 32;
        const bf16_t* vp = Z + (size_t)(t0 + s) * EVEN_IN + 512 + h * 128 + dq;
        u32x4 raw[4]; float ss = 0.f;
#pragma unroll
        for (int i = 0; i < 4; ++i) { raw[i] = *(const u32x4*)(vp + 8 * i);
#pragma unroll
            for (int j = 0; j < 4; ++j) { const float a = bflo(raw[i][j]), b = bfhi(raw[i][j]); ss += a * a + b * b; } }
        ss += __shfl_xor(ss, 1); ss += __shfl_xor(ss, 2);
        const float rstd = 1.0f / sqrtf(ss * (1.0f / 128.0f) + EPS);
#pragma unroll
        for (int i = 0; i < 4; ++i)
#pragma unroll
            for (int j = 0; j < 4; ++j) { const int d = dq + 8 * i + 2 * j;
                *(LAS bf16_t*)(VT + (d) * VP + s * 2) = f2bf(bflo(raw[i][j]) * rstd);
                *(LAS bf16_t*)(VT + (d + 1) * VP + s * 2) = f2bf(bfhi(raw[i][j]) * rstd); }
    }
    __syncthreads();
    const int fr = lane & 15, fq = lane >> 4;
    f32x4 acc[8];
#pragma unroll
    for (int nb = 0; nb < 8; ++nb) acc[nb] = (f32x4){0.f, 0.f, 0.f, 0.f};
    const int trow = 16 * w + fr;
    const float* wrow = Ws + ((size_t)h * 128 + trow) * 128;
#pragma unroll
    for (int ks = 0; ks < 4; ++ks) {
        if (32 * ks <= 16 * w + 15) {
            const int s0 = 32 * ks + 8 * fq;
            const f32x4 wa = *(const f32x4*)(wrow + s0), wb = *(const f32x4*)(wrow + s0 + 4);
            float wv[8] = {wa[0], wa[1], wa[2], wa[3], wb[0], wb[1], wb[2], wb[3]};
#pragma unroll
            for (int j = 0; j < 8; ++j) if (s0 + j > trow) wv[j] = 0.f;
            u32x4 aw; aw.x = cvt_pk_bf16(wv[0], wv[1]); aw.y = cvt_pk_bf16(wv[2], wv[3]); aw.z = cvt_pk_bf16(wv[4], wv[5]); aw.w = cvt_pk_bf16(wv[6], wv[7]);
            const bf16x8 af = __builtin_bit_cast(bf16x8, aw);
#pragma unroll
            for (int nb = 0; nb < 8; ++nb) { const bf16x8 bfr = *(const LAS bf16x8*)(VT + (16 * nb + fr) * VP + s0 * 2);
                acc[nb] = __builtin_amdgcn_mfma_f32_16x16x32_bf16(af, bfr, acc[nb], 0, 0, 0); }
        }
    }
    LAS bf16_t* DT = (LAS bf16_t*)(F.lds + RING_OFF + 36864);
#pragma unroll
    for (int i = 0; i < 4; ++i) { const int tl = 16 * w + 4 * fq + i; const float bt = bs[h * 128 + tl];
#pragma unroll
        for (int nb = 0; nb < 8; ++nb) DT[tl * 136 + 16 * nb + fr] = f2bf(gv[h * 128 + 16 * nb + fr] * acc[nb][i] + bt); }
    __syncthreads();
#pragma unroll
    for (int k = 0; k < 4; ++k) { const int idx = tid + 512 * k, tl = idx >> 4, c8 = (idx & 15) * 8;
        const u32x4 mv = *(const LAS u32x4*)(DT + tl * 136 + c8); const u32x4 uv = *(const u32x4*)(Z + (size_t)(t0 + tl) * EVEN_IN + h * 128 + c8);
        u32x4 o; o.x = cvt_pk_bf16(bflo(uv.x) * bflo(mv.x), bfhi(uv.x) * bfhi(mv.x)); o.y = cvt_pk_bf16(bflo(uv.y) * bflo(mv.y), bfhi(uv.y) * bfhi(mv.y));
        o.z = cvt_pk_bf16(bflo(uv.z) * bflo(mv.z), bfhi(uv.z) * bfhi(mv.z)); o.w = cvt_pk_bf16(bflo(uv.w) * bflo(mv.w), bfhi(uv.w) * bfhi(mv.w));
        *(u32x4*)(MIX + (size_t)(t0 + tl) * DM + h * 128 + c8) = o; }
    __syncthreads();
}

__device__ __forceinline__ void router_phase(Frame& F, const float* x, const float* gain, const float* Wr, const float* br, gu32* cnt  ,
                                             unsigned* tok_er, float* tok_g, unsigned char* XG) {
    LAS float* part = (LAS float*)(F.lds + RING_OFF);
    LAS float* ssqp = (LAS float*)(F.lds + RING_OFF + 8 * 64 * 33 * 4);
    LAS float* lg = (LAS float*)(F.lds + SCR_OFF);
    LAS unsigned* hist = (LAS unsigned*)(F.lds + SCR_OFF + 64 * 33 * 4);
    LAS unsigned* base = hist + 32;
    LAS unsigned* ers = base + 32;
    int tid_ = threadIdx.x; asm volatile("" : "+v"(tid_));
    const int tid = tid_, lane = tid & 63, w = __builtin_amdgcn_readfirstlane(tid >> 6), r32 = lane & 31, hi = lane >> 5;
#ifndef RTR_REP_A
#define RTR_REP_A 1
#define RTR_REP_B 1
#define RTR_REP_C 1
#endif
    f32x4 gg[4];
#pragma unroll
    for (int j = 0; j < 4; ++j) gg[j] = ((const f32x4*)gain + lane)[64 * j];
    {   const int tg = F.vcu;
    const int tokb = tg * 64;
    if (tid < 32) hist[tid] = 0u;
    for (int rb_ = 0; rb_ < RTR_REP_B; ++rb_) {
        bf16x8 wh[8], wl[8];
#pragma unroll
        for (int ks = 0; ks < 8; ++ks) { float wv[8];
#pragma unroll
            for (int j = 0; j < 8; ++j) { const int k = 128 * w + 16 * ks + 8 * hi + j; wv[j] = Wr[(size_t)k * NE + r32] * gain[k]; }
            u32x4 h4, l4;
#pragma unroll
            for (int j = 0; j < 4; ++j) { const unsigned hp = cvt_pk_bf16(wv[2 * j], wv[2 * j + 1]); h4[j] = hp; l4[j] = cvt_pk_bf16(wv[2 * j] - bflo(hp), wv[2 * j + 1] - bfhi(hp)); }
            wh[ks] = __builtin_bit_cast(bf16x8, h4); wl[ks] = __builtin_bit_cast(bf16x8, l4); }
#pragma unroll
        for (int g2 = 0; g2 < 2; ++g2) {
            const float* xr = x + (size_t)(tokb + 32 * g2 + r32) * DM + 128 * w + 8 * hi;
            f32x16 d = f32x16{}; float ss = 0.f;
#pragma unroll
            for (int ks = 0; ks < 8; ++ks) { const f32x4 xa = *(const f32x4*)(xr + 16 * ks), xb = *(const f32x4*)(xr + 16 * ks + 4);
                ss += (xa.x * xa.x + xa.y * xa.y) + (xa.z * xa.z + xa.w * xa.w) + (xb.x * xb.x + xb.y * xb.y) + (xb.z * xb.z + xb.w * xb.w);
                u32x4 h4, l4;
                h4.x = cvt_pk_bf16(xa.x, xa.y); h4.y = cvt_pk_bf16(xa.z, xa.w); h4.z = cvt_pk_bf16(xb.x, xb.y); h4.w = cvt_pk_bf16(xb.z, xb.w);
                l4.x = cvt_pk_bf16(xa.x - bflo(h4.x), xa.y - bfhi(h4.x)); l4.y = cvt_pk_bf16(xa.z - bflo(h4.y), xa.w - bfhi(h4.y));
                l4.z = cvt_pk_bf16(xb.x - bflo(h4.z), xb.y - bfhi(h4.z)); l4.w = cvt_pk_bf16(xb.z - bflo(h4.w), xb.w - bfhi(h4.w));
                const bf16x8 xh = __builtin_bit_cast(bf16x8, h4), xl = __builtin_bit_cast(bf16x8, l4);
                d = __builtin_amdgcn_mfma_f32_32x32x16_bf16(wh[ks], xh, d, 0, 0, 0);
                d = __builtin_amdgcn_mfma_f32_32x32x16_bf16(wh[ks], xl, d, 0, 0, 0);
                d = __builtin_amdgcn_mfma_f32_32x32x16_bf16(wl[ks], xh, d, 0, 0, 0); }
            { auto rr = __builtin_amdgcn_permlane32_swap(__float_as_uint(ss), __float_as_uint(ss), false, false); ss = __uint_as_float(rr[0]) + __uint_as_float(rr[1]); }
            if (hi == 0) ssqp[w * 64 + 32 * g2 + r32] = ss;
#pragma unroll
            for (int r = 0; r < 16; ++r) part[(w * 64 + 32 * g2 + r32) * 33 + (r & 3) + 8 * (r >> 2) + 4 * hi] = d[r];
        }
    }
    __syncthreads();
    {   const int t = tid >> 3, q4 = (tid & 7) * 4; float s = 0.f;
#pragma unroll
        for (int ww = 0; ww < 8; ++ww) s += ssqp[ww * 64 + t];
        const float rstd = 1.0f / sqrtf(s * (1.f / DM) + EPS);
#pragma unroll
        for (int i = 0; i < 4; ++i) { float a = 0.f;
#pragma unroll
            for (int ww = 0; ww < 8; ++ww) a += part[(ww * 64 + t) * 33 + q4 + i];
            lg[t * 33 + q4 + i] = a * rstd + br[q4 + i]; } }
    __syncthreads();
    unsigned my_e[4] = {0, 0, 0, 0}, my_lr[4] = {0, 0, 0, 0}; float my_g[4] = {0, 0, 0, 0};
    if (tid < 64) {
        float v[32];
#pragma unroll
        for (int e = 0; e < 32; ++e) v[e] = lg[tid * 33 + e];
        int c0 = -1, c1 = -1, c2 = -1; float tv[4];
#pragma unroll
        for (int r = 0; r < 4; ++r) { float best = -__builtin_inff(); int bi = 0;
#pragma unroll
            for (int e = 0; e < 32; ++e) { const bool ok = (e != c0) && (e != c1) && (e != c2); if (ok && v[e] > best) { best = v[e]; bi = e; } }
            tv[r] = best; my_e[r] = (unsigned)bi; if (r == 0) c0 = bi; else if (r == 1) c1 = bi; else if (r == 2) c2 = bi; }
        const float p1 = __expf(tv[1] - tv[0]), p2 = __expf(tv[2] - tv[0]), p3 = __expf(tv[3] - tv[0]); const float inv = 1.0f / (1.0f + p1 + p2 + p3);
        my_g[0] = inv; my_g[1] = p1 * inv; my_g[2] = p2 * inv; my_g[3] = p3 * inv;
#pragma unroll
        for (int r = 0; r < 4; ++r) my_lr[r] = __hip_atomic_fetch_add(hist + my_e[r], 1u, __ATOMIC_RELAXED, __HIP_MEMORY_SCOPE_WORKGROUP);
    }
    __syncthreads();
    if (tid < 32) { const unsigned hc = hist[tid]; base[tid] = hc ? __hip_atomic_fetch_add(cnt + 64 * tid, hc, RLX_AGENT) : 0u; }
    __syncthreads();
    if (tid < 64) {
        u32x4 er; f32x4 gt;
#pragma unroll
        for (int r = 0; r < 4; ++r) { const unsigned rank = base[my_e[r]] + my_lr[r]; er[r] = (my_e[r] << 16) | rank; gt[r] = my_g[r]; ers[tid * 4 + r] = er[r]; }
        *(u32x4*)(tok_er + (size_t)(tokb + tid) * 4) = er; *(f32x4*)(tok_g + (size_t)(tokb + tid) * 4) = gt;
    }
    __syncthreads();
    for (int rc_ = 0; rc_ < RTR_REP_C; ++rc_)
#pragma unroll 2
    for (int tt = 0; tt < 8; ++tt) {
        const int tl = w * 8 + tt; const float* xrow = x + (size_t)(tokb + tl) * DM;
        f32x4 hv[4]; float s = 0.f;
#pragma unroll
        for (int j = 0; j < 4; ++j) { hv[j] = ((const f32x4*)xrow + lane)[64 * j]; s += (hv[j].x * hv[j].x + hv[j].y * hv[j].y) + (hv[j].z * hv[j].z + hv[j].w * hv[j].w); }
        const float rstd = 1.0f / sqrtf(wave_sum(s) * (1.f / DM) + EPS);
        unsigned wv[4];
#pragma unroll
        for (int j = 0; j < 4; ++j) { const f32x4 t = hv[j] * rstd * gg[j]; wv[j] = pk4_fp8(t.x, t.y, t.z, t.w); }
#pragma unroll
        for (int r = 0; r < 4; ++r) { const unsigned er = ers[tl * 4 + r]; const size_t slot = (size_t)(er >> 16) * ECAP + (er & 0xffffu);
            unsigned* o4 = (unsigned*)(XG + slot * DM) + lane;
#pragma unroll
            for (int j = 0; j < 4; ++j) o4[64 * j] = wv[j]; }
    }
    __syncthreads();
    }
}

__device__ __forceinline__ void combine_phase(Frame& F, const float* x, float* xout, const unsigned* tok_er, const float* tok_g, const bf16_t* Y, const float* g_next, unsigned char* XN, bool xn_fp8) {
    int tid_ = threadIdx.x; asm volatile("" : "+v"(tid_));
    const int gw = F.vcu * NWAVES + __builtin_amdgcn_readfirstlane(tid_ >> 6), NGW = F.G * NWAVES, lane = tid_ & 63;
    for (int m = gw; m < M; m += NGW) {
        const u32x4 er = *(const u32x4*)(tok_er + (size_t)m * 4); const f32x4 gt = *(const f32x4*)(tok_g + (size_t)m * 4);
        f32x4 v[4]; const float* xrow = x + (size_t)m * DM; float* xorow = xout + (size_t)m * DM;
#pragma unroll
        for (int j = 0; j < 4; ++j) v[j] = ((const f32x4*)xrow + lane)[64 * j];
#pragma unroll
        for (int r = 0; r < 4; ++r) { const size_t slot = (size_t)(er[r] >> 16) * ECAP + (er[r] & 0xffffu); const u32x2* yp = (const u32x2*)(Y + slot * DM) + lane; const float g = gt[r];
#pragma unroll
            for (int j = 0; j < 4; ++j) { const u32x2 yv = yp[64 * j]; v[j].x += g * bflo(yv.x); v[j].y += g * bfhi(yv.x); v[j].z += g * bflo(yv.y); v[j].w += g * bfhi(yv.y); } }
#pragma unroll
        for (int j = 0; j < 4; ++j) ((f32x4*)xorow + lane)[64 * j] = v[j];
        if (g_next) {
            float s = 0.f;
#pragma unroll
            for (int j = 0; j < 4; ++j) s += (v[j].x * v[j].x + v[j].y * v[j].y) + (v[j].z * v[j].z + v[j].w * v[j].w);
            const float rstd = 1.0f / sqrtf(wave_sum(s) * (1.f / DM) + EPS);
            unsigned* o4 = (unsigned*)(XN + (size_t)m * DM) + lane; u32x2* o8 = (u32x2*)(XN + (size_t)m * DM * 2) + lane;
#pragma unroll
            for (int j = 0; j < 4; ++j) { const f32x4 gg = ((const f32x4*)g_next + lane)[64 * j];
                if (xn_fp8) o4[64 * j] = pk4_fp8(v[j].x * rstd * gg.x, v[j].y * rstd * gg.y, v[j].z * rstd * gg.z, v[j].w * rstd * gg.w);
                else { u32x2 w; w.x = cvt_pk_bf16(v[j].x * rstd * gg.x, v[j].y * rstd * gg.y); w.y = cvt_pk_bf16(v[j].z * rstd * gg.z, v[j].w * rstd * gg.w); o8[64 * j] = w; } }
        }
    }
}

__device__ __forceinline__ void unpack8(const u32x4 w, float (&f)[8]) { f[0] = bflo(w.x); f[1] = bfhi(w.x); f[2] = bflo(w.y); f[3] = bfhi(w.y); f[4] = bflo(w.z); f[5] = bfhi(w.z); f[6] = bflo(w.w); f[7] = bfhi(w.w); }
__device__ __forceinline__ void unpack4(const u32x2 w, float (&f)[4]) { f[0] = bflo(w.x); f[1] = bfhi(w.x); f[2] = bflo(w.y); f[3] = bfhi(w.y); }
__device__ __forceinline__ void fin_head(const u32x4 n0, const u32x4 n1, const u32x2 r1, const u32x2 r2, const float (&g)[24], const float (&cs)[4], const float (&sn)[4], unsigned char* op, int j) {
    float a[8], b[8], x1[4], x2[4];
    unpack8(n0, a); unpack8(n1, b); unpack4(r1, x1); unpack4(r2, x2);
    float ss = 0.f;
#pragma unroll
    for (int i = 0; i < 8; ++i) ss += a[i] * a[i] + b[i] * b[i];
#pragma unroll
    for (int i = 0; i < 4; ++i) ss += x1[i] * x1[i] + x2[i] * x2[i];
    ss += __shfl_xor(ss, 1); ss += __shfl_xor(ss, 2); ss += __shfl_xor(ss, 4);
    const float rstd = 1.0f / sqrtf(ss * (1.0f / 192.0f) + EPS);
    u32x4 o0;
    o0.x = pk4_fp8(a[0] * rstd * g[0], a[1] * rstd * g[1], a[2] * rstd * g[2], a[3] * rstd * g[3]); o0.y = pk4_fp8(a[4] * rstd * g[4], a[5] * rstd * g[5], a[6] * rstd * g[6], a[7] * rstd * g[7]);
    o0.z = pk4_fp8(b[0] * rstd * g[8], b[1] * rstd * g[9], b[2] * rstd * g[10], b[3] * rstd * g[11]); o0.w = pk4_fp8(b[4] * rstd * g[12], b[5] * rstd * g[13], b[6] * rstd * g[14], b[7] * rstd * g[15]);
    float y1[4], y2[4];
#pragma unroll
    for (int i = 0; i < 4; ++i) { const float u = x1[i] * rstd * g[16 + i], v = x2[i] * rstd * g[20 + i]; y1[i] = u * cs[i] - v * sn[i]; y2[i] = u * sn[i] + v * cs[i]; }
    *(u32x4*)(op + 16 * j) = o0; *(unsigned*)(op + 128 + 4 * j) = pk4_fp8(y1[0], y1[1], y1[2], y1[3]); *(unsigned*)(op + 160 + 4 * j) = pk4_fp8(y2[0], y2[1], y2[2], y2[3]);
}
__device__ __forceinline__ void mla_finalize_phase(Frame& F, const bf16_t* QR, const bf16_t* KVR, const bf16_t* Z, const float* gq, const float* gk, unsigned char* QF, unsigned char* KF) {
    int tid_ = threadIdx.x; asm volatile("" : "+v"(tid_));
    const int gw = F.vcu * NWAVES + __builtin_amdgcn_readfirstlane(tid_ >> 6), NGW = F.G * NWAVES, lane = tid_ & 63;
    const int h = lane >> 3, j = lane & 7;
    float gqv[24], gkv[24], invf[4];
#pragma unroll
    for (int i = 0; i < 16; ++i) { gqv[i] = gq[16 * j + i]; gkv[i] = gk[16 * j + i]; }
#pragma unroll
    for (int i = 0; i < 4; ++i) { gqv[16 + i] = gq[128 + 4 * j + i]; gqv[20 + i] = gq[160 + 4 * j + i]; gkv[16 + i] = gk[128 + 4 * j + i]; gkv[20 + i] = gk[160 + 4 * j + i];
        invf[i] = __builtin_amdgcn_exp2f(-(float)(4 * j + i) * (13.287712379549449f / 32.0f)); }
#pragma unroll 2
    for (int m = gw; m < M; m += NGW) {
        const int pos = m & (SEQ - 1);
        float cs[4], sn[4];
#pragma unroll
        for (int i = 0; i < 4; ++i) { const double rev = (double)pos * (double)invf[i] * 0.15915494309189535; const float fr = (float)(rev - __builtin_rint(rev));
            sn[i] = __builtin_amdgcn_sinf(fr); cs[i] = __builtin_amdgcn_cosf(fr); }
        const bf16_t* qp = QR + (size_t)m * 1536 + h * 192; const bf16_t* kp = KVR + (size_t)m * 2048 + h * 256; const bf16_t* zp = Z + (size_t)m * ODD_INP + 768;
        const u32x4 qn0 = *(const u32x4*)(qp + 16 * j), qn1 = *(const u32x4*)(qp + 16 * j + 8); const u32x2 qr1 = *(const u32x2*)(qp + 128 + 4 * j), qr2 = *(const u32x2*)(qp + 160 + 4 * j);
        const u32x4 kn0 = *(const u32x4*)(kp + 16 * j), kn1 = *(const u32x4*)(kp + 16 * j + 8); const u32x2 kr1 = *(const u32x2*)(zp + 4 * j), kr2 = *(const u32x2*)(zp + 32 + 4 * j);
        fin_head(qn0, qn1, qr1, qr2, gqv, cs, sn, QF + (size_t)m * 1536 + h * 192, j);
        fin_head(kn0, kn1, kr1, kr2, gkv, cs, sn, KF + (size_t)m * 1536 + h * 192, j);
    }
}

__device__ __forceinline__ void vt_phase(Frame& F, const bf16_t* KVR, unsigned char* VT8) {
    int tid_ = threadIdx.x; asm volatile("" : "+v"(tid_));
    const int tid = tid_;
    LAS unsigned char* T = F.lds + RING_OFF;
    for (int it = F.vcu; it < M / 64; it += F.G) {
        const int m0 = it * 64, b = m0 / SEQ, tok0 = m0 % SEQ;
#pragma unroll 4
        for (int k = 0; k < 16; ++k) { const int idx = tid + 512 * k, tok = idx >> 7, grp = idx & 127, h = grp >> 4, d8 = (grp & 15) * 8;
            const u32x4 w = *(const u32x4*)(KVR + (size_t)(m0 + tok) * 2048 + h * 256 + 128 + d8);
            const unsigned lo = pk4_fp8(bflo(w.x), bfhi(w.x), bflo(w.y), bfhi(w.y)), hi = pk4_fp8(bflo(w.z), bfhi(w.z), bflo(w.w), bfhi(w.w));
            LAS unsigned char* tp = T + (h * 128 + d8) * 80 + tok;
            tp[0] = (unsigned char)lo; tp[80] = (unsigned char)(lo >> 8); tp[160] = (unsigned char)(lo >> 16); tp[240] = (unsigned char)(lo >> 24);
            tp[320] = (unsigned char)hi; tp[400] = (unsigned char)(hi >> 8); tp[480] = (unsigned char)(hi >> 16); tp[560] = (unsigned char)(hi >> 24); }
        __syncthreads();
#pragma unroll 4
        for (int k = 0; k < 8; ++k) { const int idx = tid + 512 * k, row = idx >> 2, q = idx & 3;
            const u32x4 v = *(const LAS u32x4*)(T + row * 80 + 16 * q);
            *(u32x4*)(VT8 + ((size_t)b * 1024 + row) * SEQ + tok0 + 16 * q) = v; }
        __syncthreads();
    }
}

#ifndef PHMASK
#define PHMASK 0xFFFF
#endif
#ifndef REPMASK
#define REPMASK 0
#endif
#ifndef REPCNT
#define REPCNT 3
#endif
#define NREP(k) ((((REPMASK) >> (k)) & 1) ? (REPCNT) : 1)

#define LAUNDER_S(x) asm volatile("" : "+s"(x))
__device__ __forceinline__ const float* in_ptr(const Args& a, int i) { LAUNDER_S(i); return a.in[i]; }
#define PHASE_BEGIN() unsigned wso_ = 0u; LAUNDER_S(wso_); unsigned char* ws = args.ws + wso_; Frame Fp = F; Fp.vcu = __builtin_amdgcn_readfirstlane(Fp.vcu); Fp.G = __builtin_amdgcn_readfirstlane(Fp.G); LAUNDER_S(Fp.vcu); LAUNDER_S(Fp.G); \
    int bx_ = __builtin_amdgcn_readfirstlane((int)blockIdx.x); LAUNDER_S(bx_); (void)bx_; (void)ws
#define XN  ((unsigned char*)(ws + WS_XN))
#define Z   ((bf16_t*)(ws + WS_Z))
#define MIX ((bf16_t*)(ws + WS_MIX))
#define QR  ((bf16_t*)(ws + WS_QR))
#define KVR ((bf16_t*)(ws + WS_KVR))
#define QF  ((unsigned char*)(ws + WS_QF))
#define KF  ((unsigned char*)(ws + WS_KF))
#define XG  ((unsigned char*)(ws + WS_XG))
#define ACT ((unsigned char*)(ws + WS_ACT))
#define YB  ((bf16_t*)(ws + WS_Y))
#define SSQ ((float*)(ws + WS_SSQ))
#define TOKER ((unsigned*)(ws + WS_TOKER))
#define TOKG ((float*)(ws + WS_TOKG))
#define B1P ((float*)(ws + WS_B1P))
#define IN(i) in_ptr(args, (i))
__global__ void __launch_bounds__(NWAVES * 64, 2) trunk_fwd(Args args) {
    extern __shared__ __attribute__((aligned(16))) unsigned char lds_raw[];
    Frame F;
    F.lds = (LAS unsigned char*)lds_raw;
    F.G = gridDim.x; { const int bx = blockIdx.x; F.vcu = (F.G % 8 == 0) ? (bx % 8) * (F.G / 8) + bx / 8 : bx; }
    for (int u = threadIdx.x; u < (SCR_OFF - LDSCTL_OFF) / 4; u += NWAVES * 64) ((LAS unsigned*)(F.lds + LDSCTL_OFF))[u] = 0u;
    __syncthreads();
    (void)xcd_barrier_post((unsigned*)((gu32*)(args.ws + WS_CTL) + CW_BAR), (volatile LAS unsigned*)(F.lds + MISC_OFF) + 8);
#define GRID_BAR() do { unsigned wsb_ = 0u; LAUNDER_S(wsb_); XcdBarrier bar_; bar_.bar = (unsigned*)((gu32*)(args.ws + wsb_ + WS_CTL) + CW_BAR); bar_.x = xb_xcc_id(); \
        bar_.st = (volatile LAS unsigned*)(F.lds + MISC_OFF) + 8; xcd_barrier(bar_); } while (0)
    float* const X = args.out;
    const int stage_limit = args.stage_limit;

#if (PHMASK >> 0) & 1
            _Pragma("unroll") for (int rep_ = 0; rep_ < NREP(0); ++rep_) { if (rep_) GRID_BAR();
    {   PHASE_BEGIN(); const int ptid = threadIdx.x, gw = Fp.vcu * NWAVES + __builtin_amdgcn_readfirstlane(ptid >> 6), NGW = Fp.G * NWAVES;
        transpose_job<1>(Fp, IN(I_EWIN), DM, EVEN_IN, 2, (size_t)DM * EVEN_IN, (bf16_t*)(ws + WS_WEIN), (size_t)EVEN_IN * DM, nullptr, 0);
        transpose_job<0>(Fp, IN(I_EWOUT), DM, DM, 2, (size_t)DM * DM, (bf16_t*)(ws + WS_WEOUT), (size_t)DM * DM, nullptr, 0);
        transpose_job_fp8<0>(Fp, IN(I_OWIN), DM, ODD_IN, 2, (size_t)DM * ODD_IN, ws + WS_WOIN, (size_t)ODD_INP * DM);
        transpose_job_fp8<0>(Fp, IN(I_OWUQ), 512, 1536, 2, (size_t)512 * 1536, ws + WS_WUQ, (size_t)1536 * 512, IN(I_OGCQ), 512);
        transpose_job_fp8<0>(Fp, IN(I_OWUKV), 256, 2048, 2, (size_t)256 * 2048, ws + WS_WUKV, (size_t)2048 * 256, IN(I_OGCKV), 256);
        transpose_job_fp8<0>(Fp, IN(I_OWOUT), DM, DM, 2, (size_t)DM * DM, ws + WS_WOOUT, (size_t)DM * DM);
        transpose_job_fp8<2>(Fp, IN(I_W1), DM, 2 * DE, DEPTH * NE, (size_t)DM * 2 * DE, ws + WS_W1, (size_t)2 * DE * DM);
        transpose_job_fp8<0>(Fp, IN(I_W2), DE, DM, DEPTH * NE, (size_t)DE * DM, ws + WS_W2, (size_t)DM * DE);
        for (int i = bx_ * 512 + ptid; i < 2 * 12288; i += Fp.G * 512) { const int mi = i / 12288, r = i % 12288;
            *(u32x4*)(ws + WS_WOIN + (size_t)mi * ODD_INP * DM + (size_t)ODD_IN * DM + (size_t)r * 16) = (u32x4){0u, 0u, 0u, 0u}; }
        for (int i = bx_ * 512 + ptid; i < DEPTH * NE * 2048; i += Fp.G * 512) { const int c = i & 2047, o = 2 * (128 * (c >> 8) + (c & 127)) + ((c >> 7) & 1);
            B1P[i] = IN(I_B1)[(size_t)(i & ~2047) + o]; }
        for (int m = gw; m < M; m += NGW) rms_row_to_bf16(ptid & 63, IN(I_X) + (size_t)m * DM, IN(I_MIXN), (bf16_t*)XN + (size_t)m * DM, nullptr);
    }
            }
#endif
    GRID_BAR();

#ifdef EXTRA_BARS
    for (int xb_ = 0; xb_ < EXTRA_BARS; ++xb_) GRID_BAR();
#endif
    for (int l = 0; l < DEPTH; ++l) {
        const int li = l >> 1;
        if (2 * l + 1 > stage_limit) break;
        if ((l & 1) == 0) {
#if (PHMASK >> 1) & 1
            _Pragma("unroll") for (int rep_ = 0; rep_ < NREP(1); ++rep_) { if (rep_) GRID_BAR();
            {   PHASE_BEGIN(); pg8::Gemm g{(const bf16_t*)XN, (const bf16_t*)(ws + WS_WEIN) + (size_t)li * EVEN_IN * DM, DM, DM, nullptr, nullptr}; pg8::StaticOrder S; S.init(M, EVEN_IN, Fp.G, bx_);
                pg8::EpiEvenIn E{Z, IN(I_EGQ) + li * 64, IN(I_EGK) + li * 64};
                pg8::gemm_phase<pg8::EpiEvenIn, pg8::StaticOrder>(Fp.lds + RING_OFF, g, S, E); }
            }
#endif
            GRID_BAR();
            {   PHASE_BEGIN();
#if (PHMASK >> 2) & 1
            _Pragma("unroll") for (int rep_ = 0; rep_ < NREP(2); ++rep_) { if (rep_) GRID_BAR();
                for (int u = Fp.vcu; u < 512; u += Fp.G)
                    gmlp_unit(Fp, Z, MIX, IN(I_EWS) + (size_t)li * 4 * 128 * 128, IN(I_EBS) + li * 512, IN(I_EGV) + li * 512, u);
            }
#endif
#if (PHMASK >> 3) & 1
            _Pragma("unroll") for (int rep_ = 0; rep_ < NREP(3); ++rep_) { if (rep_) GRID_BAR();
                for (int u = Fp.vcu; u < 256; u += Fp.G) { const int bh = u >> 4, s = u & 15, b = bh >> 3, h = bh & 7;
                    for (int pass = 0; pass < 2; ++pass) { const int qb = pass ? 31 - s : s;
                        const bf16_t* zb = Z + (size_t)b * SEQ * EVEN_IN;
                        dil::unit(zb + 1024 + 64 * h, zb + 1536 + 64 * h, zb + 2048 + 64 * h, EVEN_IN, MIX + (size_t)b * SEQ * DM + 512 + 64 * h, DM, qb * 256, Fp.lds + RING_OFF, (LAS float*)(Fp.lds + SCR_OFF)); } }
            }
#endif
            }
            GRID_BAR();
#if (PHMASK >> 4) & 1
            _Pragma("unroll") for (int rep_ = 0; rep_ < NREP(4); ++rep_) { if (rep_) GRID_BAR();
            {   PHASE_BEGIN(); pg8::Gemm g{MIX, (const bf16_t*)(ws + WS_WEOUT) + (size_t)li * DM * DM, DM, DM, nullptr, nullptr}; pg8::StaticOrder S; S.init(M, DM, Fp.G, bx_);
                pg8::EpiResid E{l == 0 ? IN(I_X) : (const float*)X, X};
                pg8::gemm_phase<pg8::EpiResid, pg8::StaticOrder>(Fp.lds + RING_OFF, g, S, E); }
            }
#endif
            GRID_BAR();
        } else {
#if (PHMASK >> 5) & 1
            _Pragma("unroll") for (int rep_ = 0; rep_ < NREP(5); ++rep_) { if (rep_) GRID_BAR();
            {   PHASE_BEGIN(); pg8::Gemm g{(const bf16_t*)XN, (const bf16_t*)(ws + WS_WOIN + (size_t)li * ODD_INP * DM), DM / 2, DM / 2, nullptr, nullptr}; pg8::StaticOrder S; S.init(M, ODD_INP, Fp.G, bx_);
                pg8::EpiOddIn E{Z, ws + WS_Z8, SSQ};
                pg8::gemm_phase<pg8::EpiOddIn, pg8::StaticOrder, true>(Fp.lds + RING_OFF, g, S, E); }
            }
#endif
            GRID_BAR();
#if (PHMASK >> 6) & 1
            _Pragma("unroll") for (int rep_ = 0; rep_ < NREP(6); ++rep_) { if (rep_) GRID_BAR();
            {   PHASE_BEGIN(); pg8::Gemm g{(const bf16_t*)(ws + WS_Z8 + 512), (const bf16_t*)(ws + WS_WUKV + (size_t)li * 2048 * 256), ODD_INP / 2, 128, nullptr, nullptr}; pg8::StaticOrder S; S.init(M, 2048, Fp.G, bx_);
                pg8::EpiRowScale<1> E{KVR, 2048, SSQ, 8, 1.0f / 256.0f};
                pg8::gemm_phase<pg8::EpiRowScale<1>, pg8::StaticOrder, true>(Fp.lds + RING_OFF, g, S, E); }
            {   PHASE_BEGIN(); pg8::Gemm g{(const bf16_t*)(ws + WS_Z8), (const bf16_t*)(ws + WS_WUQ + (size_t)li * 1536 * 512), ODD_INP / 2, 256, nullptr, nullptr}; pg8::StaticOrder S; S.init(M, 1536, Fp.G, bx_);
                pg8::EpiRowScale<2> E{QR, 1536, SSQ, 0, 1.0f / 512.0f};
                pg8::gemm_phase<pg8::EpiRowScale<2>, pg8::StaticOrder, true>(Fp.lds + RING_OFF, g, S, E); }
            }
#endif
            GRID_BAR();
#if (PHMASK >> 7) & 1
            _Pragma("unroll") for (int rep_ = 0; rep_ < NREP(7); ++rep_) { if (rep_) GRID_BAR();
            {   PHASE_BEGIN(); mla_finalize_phase(Fp, QR, KVR, Z, IN(I_OGQ) + li * 192, IN(I_OGK) + li * 192, QF, KF); vt_phase(Fp, KVR, ws + WS_VT); }
            }
#endif
            GRID_BAR();
#if (PHMASK >> 8) & 1
            _Pragma("unroll") for (int rep_ = 0; rep_ < NREP(8); ++rep_) { if (rep_) GRID_BAR();
            {   PHASE_BEGIN();
                for (int u = Fp.vcu; u < 256; u += Fp.G) { const int bh = u >> 4, s = u & 15, b = bh >> 3, h = bh & 7;
                    for (int pass = 0; pass < 2; ++pass) { const int qb = pass ? 31 - s : s;
                        mla::unit(QF + (size_t)b * SEQ * 1536 + 192 * h, KF + (size_t)b * SEQ * 1536 + 192 * h, 1536, ws + WS_VT + ((size_t)(b * 8 + h) * 128) * SEQ,
                                  ws + WS_MIX8 + (size_t)b * SEQ * DM + 128 * h, DM, qb * 256, Fp.lds + RING_OFF); } }
            }
            }
#endif
            GRID_BAR();
#if (PHMASK >> 9) & 1
            _Pragma("unroll") for (int rep_ = 0; rep_ < NREP(9); ++rep_) { if (rep_) GRID_BAR();
            {   PHASE_BEGIN(); pg8::Gemm g{(const bf16_t*)(ws + WS_MIX8), (const bf16_t*)(ws + WS_WOOUT + (size_t)li * DM * DM), DM / 2, DM / 2, nullptr, nullptr}; pg8::StaticOrder S; S.init(M, DM, Fp.G, bx_);
                pg8::EpiResidT<true> E{(const float*)X, X};
                pg8::gemm_phase<pg8::EpiResidT<true>, pg8::StaticOrder, true>(Fp.lds + RING_OFF, g, S, E); }
            }
#endif
            GRID_BAR();
        }
        if (2 * l + 2 > stage_limit) break;
#if (PHMASK >> 10) & 1
            _Pragma("unroll") for (int rep_ = 0; rep_ < NREP(10); ++rep_) {
        {   PHASE_BEGIN(); const bool dry = rep_ + 1 < NREP(10);
            gu32* cnt = (gu32*)(ws + WS_CTL) + CW_CNT + (size_t)(dry ? 8 + 4 * rep_ + l : l) * 32 * 64;
        router_phase(Fp, X, IN(I_FFNN) + l * DM, IN(I_RW) + (size_t)l * DM * NE, IN(I_RB) + l * NE, cnt, dry ? (unsigned*)(ws + WS_QR) : TOKER, dry ? (float*)(ws + WS_QR + MiB) : TOKG, dry ? ACT : XG); }
        GRID_BAR();
            }
#endif
        LAS int* tbl = (LAS int*)(F.lds + SCR_OFF + 12288);
        {   PHASE_BEGIN(); gu32* cnt = (gu32*)(ws + WS_CTL) + CW_CNT + (size_t)l * 32 * 64;
        if (threadIdx.x == 0) { int acc = 0; for (int e = 0; e < NE; ++e) { tbl[e] = acc; const unsigned c = __hip_atomic_load(cnt + 64 * e, RLX_AGENT); acc += (int)((c + 255u) >> 8); } tbl[NE] = acc; }
        __syncthreads(); }
#if (PHMASK >> 11) & 1
            _Pragma("unroll") for (int rep_ = 0; rep_ < NREP(11); ++rep_) { if (rep_) GRID_BAR();
        {   PHASE_BEGIN();
            pg8::Gemm g{(const bf16_t*)XG, (const bf16_t*)(ws + WS_W1 + (size_t)l * NE * 2 * DE * DM), DM / 2, DM / 2, (const bf16_t*)ACT, (const bf16_t*)(ws + WS_W2 + (size_t)l * NE * DM * DE)};
            pg8::MoeMergedOrder S{tbl, Fp.G, Fp.vcu, (gu32*)(ws + WS_CTL) + CW_MOE + (size_t)(l * 320 + 1280 * rep_) * 16, -1};
            pg8::EpiMoe E{{ACT, B1P + (size_t)l * NE * 2048}, {YB, IN(I_B2) + (size_t)l * NE * DM}};
            pg8::gemm_phase<pg8::EpiMoe, pg8::MoeMergedOrder, true>(Fp.lds + RING_OFF, g, S, E); }
            }
#endif
        GRID_BAR();
#if (PHMASK >> 13) & 1
            _Pragma("unroll") for (int rep_ = 0; rep_ < NREP(13); ++rep_) {
        {   PHASE_BEGIN(); const bool dry = rep_ + 1 < NREP(13);
            combine_phase(Fp, X, dry ? (float*)ACT : X, TOKER, TOKG, YB, (l + 1 < DEPTH) ? IN(I_MIXN) + (l + 1) * DM : nullptr, dry ? (ACT + (size_t)64 * MiB) : XN, (l & 1) == 0); }
        GRID_BAR();
            }
#endif
    }
#undef GRID_BAR
}

extern "C" void kernel_launch(void* const* d_in, const int* in_sizes, int n_in, void* d_out, int out_size, void* d_ws, size_t ws_size, hipStream_t stream) {
    static int grid = 0;
    if (grid == 0) {
        if (n_in != 24 || in_sizes[0] != M * DM || out_size != M * DM || ws_size < WS_END) {
            fprintf(stderr, "kernel_launch: unexpected shapes (n_in %d, in0 %d, out %d, ws %zu, need %zu)\n", n_in, n_in > 0 ? in_sizes[0] : -1, out_size, ws_size, (size_t)WS_END); grid = -1; return; }
        int dev = 0, cus = 0, per_cu = 0;
        if (hipGetDevice(&dev) != hipSuccess || hipDeviceGetAttribute(&cus, hipDeviceAttributeMultiprocessorCount, dev) != hipSuccess) { grid = -1; return; }
        if (hipFuncSetAttribute((const void*)trunk_fwd, hipFuncAttributeMaxDynamicSharedMemorySize, LDS_BYTES) != hipSuccess) { fprintf(stderr, "kernel_launch: hipFuncSetAttribute failed\n"); grid = -1; return; }
        if (hipOccupancyMaxActiveBlocksPerMultiprocessor(&per_cu, (const void*)trunk_fwd, NWAVES * 64, LDS_BYTES) != hipSuccess || per_cu < 1)
            fprintf(stderr, "kernel_launch: occupancy query reports %d workgroups per CU\n", per_cu);
        (void)hipGetLastError();
        if (cus < 256) { fprintf(stderr, "kernel_launch: needs 256 CUs, device has %d\n", cus); grid = -1; return; }
        grid = 256;
    }
    if (grid < 0) return;
    if (hipMemsetAsync((char*)d_ws + WS_CTL, 0, CTL_ZERO_BYTES, stream) != hipSuccess) return;
    Args a{};
    for (int i = 0; i < 24; ++i) a.in[i] = (const float*)d_in[i];
    a.out = (float*)d_out; a.ws = (unsigned char*)d_ws; a.stage_limit = STAGE_LIMIT; a.pad = 0;
    hipLaunchKernelGGL(trunk_fwd, dim3(grid), dim3(NWAVES * 64), LDS_BYTES, stream, a);
}
```

```cpp
#include <hip/hip_runtime.h>
#include <hip/hip_bf16.h>
#include <cstdio>
#include <cstdint>

#define LAS __attribute__((address_space(3)))
#define GAS __attribute__((address_space(1)))
typedef unsigned short bf16_t;
typedef short bf16x8 __attribute__((ext_vector_type(8)));
typedef short s16x4 __attribute__((ext_vector_type(4)));
typedef float f32x2 __attribute__((ext_vector_type(2)));
typedef float f32x4 __attribute__((ext_vector_type(4)));
typedef float f32x16 __attribute__((ext_vector_type(16)));
typedef unsigned u32x2 __attribute__((ext_vector_type(2)));
typedef unsigned u32x4 __attribute__((ext_vector_type(4)));
typedef int i32x4 __attribute__((ext_vector_type(4)));
typedef int i32x8 __attribute__((ext_vector_type(8)));

constexpr int BATCH = 2, SEQ = 8192, DM = 1024, M = BATCH * SEQ, DEPTH = 4;
constexpr int EVEN_IN = 2560, ODD_IN = 832, ODD_INP = 1024;
constexpr int NE = 32, DE = 1024, ECAP = 16384;
constexpr float EPS = 1e-6f;
constexpr float LOG2E = 1.4426950408889634f;
constexpr float C2_B = 0.125f * LOG2E;
constexpr float C2_C = 0.07216878364870322f * LOG2E;

__device__ __forceinline__ unsigned cvt_pk_bf16(float lo, float hi) { unsigned r; asm volatile("v_cvt_pk_bf16_f32 %0, %1, %2" : "=v"(r) : "v"(lo), "v"(hi)); return r; }
__device__ __forceinline__ float bf2f(bf16_t v) { return __uint_as_float(((unsigned)v) << 16); }
__device__ __forceinline__ float bflo(unsigned w) { return __uint_as_float(w << 16); }
__device__ __forceinline__ float bfhi(unsigned w) { return __uint_as_float(w & 0xffff0000u); }
__device__ __forceinline__ bf16_t f2bf(float f) { return (bf16_t)(cvt_pk_bf16(f, 0.f) & 0xffffu); }

__device__ __forceinline__ unsigned pk4_fp8(float a, float b, float c, float d) { int w = 0; w = __builtin_amdgcn_cvt_pk_fp8_f32(a, b, w, false); w = __builtin_amdgcn_cvt_pk_fp8_f32(c, d, w, true); return (unsigned)w; }
constexpr float W8_SCALE = 64.0f, W8_INV = 1.0f / 64.0f;

namespace pg8 {
constexpr int BM = 256, BK = 64, HALF = 128, HTB = HALF * BK * 2, STAGE_BYTES = 8 * HTB, NXCD = 8, WGM = 8;
__host__ __device__ __forceinline__ int lds_byte(int r, int c) { const int st = (r >> 4) * 2 + (c >> 5), rr = r & 15, cc = c & 31, ob = rr * 64 + cc * 2; return st * 1024 + (ob ^ (((ob >> 9) & 1) << 5)); }
__host__ __device__ __forceinline__ void stage_rc(int b, int& R, int& C) { const int st = b / 1024, sb = b % 1024, swz = sb ^ (((sb >> 9) & 1) << 5); R = (st >> 1) * 16 + swz / 64; C = (st & 1) * 32 + (swz % 64) / 2; }
__host__ __device__ __forceinline__ int perm32(int rho) { const int n = rho >> 4, i = rho & 15; return 8 * (i >> 2) + 4 * n + (i & 3); }

struct Unit { int pm, pn, pb, kind, rb; };
struct Gemm { const bf16_t* A; const bf16_t* Bt; int lda, K; const bf16_t* A2; const bf16_t* Bt2; };

struct StaticOrder {
    int nM, nN, nwg, G, c;
    __device__ void init(int M_, int N_, int G_, int c_) { nM = M_ / BM; nN = N_ / BM; nwg = nM * nN; G = G_; c = c_; }
    __device__ bool next(int i, Unit& u) const {
        const long L = (long)i * G + c; if (L >= nwg) return false;
        int wgid = (int)L; { const int q = nwg / NXCD, r = nwg % NXCD, xcd = wgid % NXCD, off = wgid / NXCD; wgid = (xcd < r ? xcd * (q + 1) : r * (q + 1) + (xcd - r) * q) + off; }
        const int nig = WGM * nN, gid = wgid / nig, fm = gid * WGM, gsz = (nM - fm) < WGM ? (nM - fm) : WGM;
        u.pm = fm + ((wgid % nig) % gsz); u.pn = (wgid % nig) / gsz; u.pb = u.pn; u.kind = 0; u.rb = 0; return true;
    }
    __device__ __forceinline__ void a_ready(const Unit&) const {}
    __device__ __forceinline__ void pre_epi() const {}
    __device__ __forceinline__ void done(const Unit&) const {}
    __device__ __forceinline__ void finish() const {}
};

__device__ __forceinline__ f32x2 gelu_pk(f32x2 v) {
    const f32x2 av = __builtin_elementwise_abs(v), d = av * 0.2316418882f + 1.0f;
    f32x2 t; t.x = __builtin_amdgcn_rcpf(d.x); t.y = __builtin_amdgcn_rcpf(d.y);
    f32x2 q = t * 0.5307027145f + (-0.7265760135f); q = q * t + 0.7107068705f; q = q * t + (-0.142248368f); q = q * t + 0.127414796f; q = q * t;
    const f32x2 s = (v * v) * (-0.72134752044f);
    f32x2 e; e.x = __builtin_amdgcn_exp2f(s.x); e.y = __builtin_amdgcn_exp2f(s.y);
    const f32x2 m = v * (q * e), r = v - m;
    f32x2 o; o.x = v.x < 0.f ? m.x : r.x; o.y = v.y < 0.f ? m.y : r.y; return o;
}
__device__ __forceinline__ f32x4 gelu4(f32x4 v) { const f32x2 a = gelu_pk((f32x2){v[0], v[1]}), b = gelu_pk((f32x2){v[2], v[3]}); return (f32x4){a.x, a.y, b.x, b.y}; }

template <class Epi, class Sched, bool FP8 = false>
__device__ __forceinline__ void gemm_phase(LAS unsigned char* lds, const Gemm g, const Sched& S, const Epi& E) {
    int tid_ = threadIdx.x; asm volatile("" : "+v"(tid_));
    const int tid = tid_, wid = __builtin_amdgcn_readfirstlane(tid >> 6), lane = tid & 63, wr = wid >> 2, wc = wid & 3, fr = lane & 15, fq = lane >> 4;
    const int K = g.K, nt = K / BK;
    unsigned voffA[2], voffB[2];
#pragma unroll
    for (int i = 0; i < 2; ++i) { int R, C; stage_rc(tid * 16 + i * 8192, R, C); const int Rb = Epi::PERM ? ((R & ~31) + perm32(R & 31)) : R;
        voffA[i] = (unsigned)(R * g.lda + C) * 2u; voffB[i] = (unsigned)(Rb * K + C) * 2u; }
    const size_t kstep = (size_t)(BK * 2);
    const size_t hstepA = (size_t)HALF * g.lda * 2, tstepA = 2 * hstepA;
    const size_t hstepB = (size_t)HALF * K * 2, tstepB = 2 * hstepB;
    const unsigned ldsw = (unsigned)wid * 1024u;
    const int aoff = lds_byte(wr * 64 + fr, fq * 8), boff = lds_byte(wc * 32 + fr, fq * 8);
#define PG8_SA(b, h) (((b) * 2 + (h)) * HTB)
#define PG8_SB(b, h) ((4 + (b) * 2 + (h)) * HTB)
#define PG8_STAGE(bufoff, gbase, voff) do { _Pragma("unroll") for (int _i = 0; _i < 2; ++_i) \
        __builtin_amdgcn_global_load_lds((const unsigned*)((const char*)(gbase) + (voff)[_i]), (LAS unsigned*)(lds + (bufoff) + ldsw + _i * 8192), 16, 0, 0); } while (0)
#define PG8_LDA(dst, b, h) do { _Pragma("unroll") for (int m = 0; m < 4; ++m) { if constexpr (FP8) { const i32x4 lo_ = *(const LAS i32x4*)(lds + PG8_SA(b, h) + aoff + m * 2048), hi_ = *(const LAS i32x4*)(lds + PG8_SA(b, h) + aoff + m * 2048 + 1024); dst##8[m] = __builtin_shufflevector(lo_, hi_, 0, 1, 2, 3, 4, 5, 6, 7); } \
        else { _Pragma("unroll") for (int k = 0; k < 2; ++k) dst[m][k] = *(const LAS bf16x8*)(lds + PG8_SA(b, h) + aoff + m * 2048 + k * 1024); } } } while (0)
#define PG8_LDB(dst, b, h) do { _Pragma("unroll") for (int n = 0; n < 2; ++n) { if constexpr (FP8) { const i32x4 lo_ = *(const LAS i32x4*)(lds + PG8_SB(b, h) + boff + n * 2048), hi_ = *(const LAS i32x4*)(lds + PG8_SB(b, h) + boff + n * 2048 + 1024); dst##8[n] = __builtin_shufflevector(lo_, hi_, 0, 1, 2, 3, 4, 5, 6, 7); } \
        else { _Pragma("unroll") for (int k = 0; k < 2; ++k) dst[n][k] = *(const LAS bf16x8*)(lds + PG8_SB(b, h) + boff + n * 2048 + k * 1024); } } } while (0)
#define PG8_MMA(ai, bj, At, Bt) do { __builtin_amdgcn_s_setprio(1); _Pragma("unroll") for (int m = 0; m < 4; ++m) _Pragma("unroll") for (int n = 0; n < 2; ++n) { \
        if constexpr (FP8) asm volatile("s_nop 1\n\tv_mfma_f32_16x16x128_f8f6f4 %0, %1, %2, %0" : "+v"(acc[ai][bj][m][n]) : "v"(Bt##8[n]), "v"(At##8[m])); \
        else { _Pragma("unroll") for (int k = 0; k < 2; ++k) acc[ai][bj][m][n] = __builtin_amdgcn_mfma_f32_16x16x32_bf16(Bt[n][k], At[m][k], acc[ai][bj][m][n], 0, 0, 0); } } \
        __builtin_amdgcn_s_setprio(0); } while (0)
#define PG8_WAIT_V(n) asm volatile("s_waitcnt vmcnt(" #n ")" ::: "memory")
#define PG8_WAIT_L(n) asm volatile("s_waitcnt lgkmcnt(" #n ")" ::: "memory")
#define PG8_BAR __builtin_amdgcn_s_barrier()
#define PG8_SCHED __builtin_amdgcn_sched_barrier(0)
    Unit cur, nxt; int ui = 0;
    if (!S.next(0, cur)) return;
    f32x4 acc[2][2][4][2];
#pragma unroll
    for (int a = 0; a < 2; ++a)
#pragma unroll
        for (int b = 0; b < 2; ++b)
#pragma unroll
            for (int m = 0; m < 4; ++m)
#pragma unroll
                for (int n = 0; n < 2; ++n) acc[a][b][m][n] = (f32x4){0.f, 0.f, 0.f, 0.f};
    bf16x8 At[4][2], B0[2][2], B1[2][2]; i32x8 At8[4], B08[2], B18[2];
    const char* cA = (const char*)(cur.kind ? g.A2 : g.A) + (size_t)cur.pm * tstepA; const char* cB = (const char*)(cur.kind ? g.Bt2 : g.Bt) + (size_t)cur.pb * tstepB;
    S.a_ready(cur);
    PG8_STAGE(PG8_SB(0, 0), cB, voffB); PG8_STAGE(PG8_SB(0, 1), cB + hstepB, voffB); PG8_STAGE(PG8_SA(0, 0), cA, voffA); PG8_STAGE(PG8_SA(0, 1), cA + hstepA, voffA);
    if (wr == 1) PG8_BAR;
    PG8_WAIT_V(2); PG8_BAR;
    PG8_STAGE(PG8_SB(1, 0), cB + kstep, voffB); PG8_STAGE(PG8_SA(1, 0), cA + kstep, voffA); PG8_STAGE(PG8_SB(1, 1), cB + hstepB + kstep, voffB);
    PG8_WAIT_V(6); PG8_BAR;
    for (;;) {
        const bool has_next = S.next(ui + 1, nxt);
        const char* nA = has_next ? (const char*)(nxt.kind ? g.A2 : g.A) + (size_t)nxt.pm * tstepA : cA; const char* nB = has_next ? (const char*)(nxt.kind ? g.Bt2 : g.Bt) + (size_t)nxt.pb * tstepB : cB;
#pragma unroll 1
        for (int t = 0; t < nt; t += 2) {
            const bool last = (t == nt - 2);
            const char* a1 = cA + (size_t)(t + 1) * kstep;
            const char* a2 = last ? nA : cA + (size_t)(t + 2) * kstep; const char* b2 = last ? nB : cB + (size_t)(t + 2) * kstep;
            const char* a3 = a2 + kstep; const char* b3 = b2 + kstep;
            if (last && has_next) S.a_ready(nxt);
            PG8_LDB(B0, 0, 0); PG8_LDB(B1, 0, 1); PG8_SCHED; PG8_LDA(At, 0, 0); PG8_STAGE(PG8_SA(1, 1), a1 + hstepA, voffA);
            PG8_WAIT_V(8); PG8_WAIT_L(0); PG8_BAR; PG8_MMA(0, 0, At, B0); PG8_MMA(0, 1, At, B1); PG8_BAR; PG8_SCHED;
            PG8_LDA(At, 0, 1); PG8_STAGE(PG8_SB(0, 0), b2, voffB); PG8_STAGE(PG8_SB(0, 1), b2 + hstepB, voffB); PG8_STAGE(PG8_SA(0, 0), a2, voffA);
            PG8_WAIT_V(8); PG8_WAIT_L(0); PG8_BAR; PG8_MMA(1, 0, At, B0); PG8_MMA(1, 1, At, B1); PG8_BAR; PG8_SCHED;
            PG8_LDB(B0, 1, 0); PG8_LDB(B1, 1, 1); PG8_SCHED; PG8_LDA(At, 1, 0); PG8_STAGE(PG8_SA(0, 1), a2 + hstepA, voffA);
            PG8_WAIT_V(8); PG8_WAIT_L(0); PG8_BAR; PG8_MMA(0, 0, At, B0); PG8_MMA(0, 1, At, B1); PG8_BAR; PG8_SCHED;
            PG8_LDA(At, 1, 1); PG8_STAGE(PG8_SB(1, 0), b3, voffB); PG8_STAGE(PG8_SB(1, 1), b3 + hstepB, voffB); PG8_STAGE(PG8_SA(1, 0), a3, voffA);
            PG8_WAIT_V(8); PG8_WAIT_L(0); PG8_BAR; PG8_MMA(1, 0, At, B0); PG8_MMA(1, 1, At, B1); PG8_BAR; PG8_SCHED;
        }
        if (wr == 0) PG8_BAR;
        if constexpr (FP8) asm volatile("s_nop 15\n\ts_nop 7" ::: "memory");
        S.pre_epi();
        { int te_ = threadIdx.x; asm volatile("" : "+v"(te_));
          E(acc, cur, wr, wc, te_ & 15, (te_ & 63) >> 4); }
        S.done(cur);
        if (!has_next) break;
#pragma unroll
        for (int a = 0; a < 2; ++a)
#pragma unroll
            for (int b = 0; b < 2; ++b)
#pragma unroll
                for (int m = 0; m < 4; ++m)
#pragma unroll
                    for (int n = 0; n < 2; ++n) acc[a][b][m][n] = (f32x4){0.f, 0.f, 0.f, 0.f};
        cur = nxt; cA = nA; cB = nB; ++ui;
        if (wr == 1) PG8_BAR;
    }
    PG8_WAIT_V(0);
    S.finish();
    PG8_BAR;
#undef PG8_SA
#undef PG8_SB
#undef PG8_STAGE
#undef PG8_LDA
#undef PG8_LDB
#undef PG8_MMA
#undef PG8_WAIT_V
#undef PG8_WAIT_L
#undef PG8_BAR
#undef PG8_SCHED
}
}
constexpr int STAGE_LIMIT = 8;

namespace att {
__device__ __forceinline__ int crow(int r, int hi) { return (r & 3) + 8 * (r >> 2) + 4 * hi; }
__device__ __forceinline__ int v_rd_base(int lane) { return ((lane & 3) << 3) | (((lane >> 2) & 3) << 6) | (((lane >> 4) & 1) << 5) | (((lane >> 5) & 1) << 8); }
}

namespace dil {
using att::crow; using att::v_rd_base;
constexpr int OFF_O = 0, OFF_V = 65536, VWAVE = 8192;
template <int S_>
__device__ __forceinline__ void pass(const bf16_t* __restrict__ Qh, const bf16_t* __restrict__ Kh, const bf16_t* __restrict__ Vh, int pitch, int q0, LAS unsigned char* lds, LAS float* scr, int wid, int lane) {
    const int r32 = lane & 31, hi = lane >> 5;
    LAS float* Oacc = (LAS float*)(lds + OFF_O); LAS float* macc = scr; LAS float* lacc = scr + 256; LAS float* wsf = scr + 512 + wid * 64;
    LAS unsigned char* vbuf = lds + OFF_V + wid * VWAVE;
    constexpr int NG = (S_ == 16) ? 2 : 1, VR = (S_ == 16) ? 16 : 32;
    int vk[4], vc[4];
#pragma unroll
    for (int i = 0; i < 4; ++i) { const int off = (i * 64 + lane) * 16, st = off >> 9, within = off & 511, kk = (st >> 1) * 8 + (within >> 6);
        vk[i] = (kk & ~0xC) | ((kk & 4) << 1) | ((kk & 8) >> 1); vc[i] = (st & 1) * 32 + ((within & 63) >> 1); }
    const unsigned vb0 = (unsigned)(uintptr_t)vbuf + (unsigned)v_rd_base(lane);
#pragma unroll
    for (int gi = 0; gi < NG; ++gi) {
        const int rho = (S_ == 1) ? 0 : (S_ == 4) ? (wid & 3) : (2 * wid + gi);
        const int i0 = (S_ == 1) ? 32 * wid : (S_ == 4) ? 32 * (wid >> 2) : 0;
        const int qi = i0 + (r32 < VR ? r32 : r32 - VR);
        const int ql = rho + S_ * qi;
        bf16x8 qr[4];
#pragma unroll
        for (int d0 = 0; d0 < 4; ++d0) qr[d0] = *(const bf16x8*)(Qh + (size_t)(q0 + ql) * pitch + d0 * 16 + hi * 8);
        const int j0 = i0 - 128;
        const int tokb = q0 + rho + S_ * j0;
        bf16x8 kfA[4], kfB[4];
#define DIL_KLOAD(dst, c) do { int tk_ = tokb + S_ * (32 * (c) + r32); tk_ = tk_ < 0 ? 0 : (tk_ > SEQ - 1 ? SEQ - 1 : tk_);     \
            _Pragma("unroll") for (int d0 = 0; d0 < 4; ++d0) dst[d0] = *(const bf16x8*)(Kh + (size_t)tk_ * pitch + d0 * 16 + hi * 8); } while (0)
#define DIL_VDMA(c, bf) do { _Pragma("unroll") for (int i = 0; i < 4; ++i) { int tk_ = tokb + S_ * (32 * (c) + vk[i]); tk_ = tk_ < 0 ? 0 : (tk_ > SEQ - 1 ? SEQ - 1 : tk_); \
            __builtin_amdgcn_global_load_lds((const unsigned*)(Vh + (size_t)tk_ * pitch + vc[i]), (LAS unsigned*)(vbuf + (bf) * 4096 + i * 1024), 16, 0, 0); } } while (0)
        float m_reg = -1e30f, l_reg = 0.f; f32x16 o[2]; o[0] = f32x16{}; o[1] = f32x16{};
        DIL_KLOAD(kfA, 0); DIL_VDMA(0, 0);
#define DIL_STEP(KF, KN, c) do { \
            if ((c) < 4) { DIL_KLOAD(KN, (c) + 1); DIL_VDMA((c) + 1, ((c) + 1) & 1); asm volatile("s_waitcnt vmcnt(8)" ::: "memory"); } \
            else { asm volatile("s_waitcnt vmcnt(0)" ::: "memory"); } \
            f32x16 p = f32x16{}; \
            _Pragma("unroll") for (int d0 = 0; d0 < 4; ++d0) p = __builtin_amdgcn_mfma_f32_32x32x16_bf16(KF[d0], qr[d0], p, 0, 0, 0); \
            const unsigned vb = vb0 + (unsigned)(((c) & 1) * 4096); \
            s16x4 vl0[2], vh0[2], vl1[2], vh1[2]; \
            _Pragma("unroll") for (int d0 = 0; d0 < 2; ++d0) { \
                asm volatile("ds_read_b64_tr_b16 %0, %1 offset:%2" : "=&v"(vl0[d0]) : "v"(vb), "i"(d0 * 512) : "memory"); \
                asm volatile("ds_read_b64_tr_b16 %0, %1 offset:%2" : "=&v"(vh0[d0]) : "v"(vb), "i"(d0 * 512 + 1024) : "memory"); \
                asm volatile("ds_read_b64_tr_b16 %0, %1 offset:%2" : "=&v"(vl1[d0]) : "v"(vb), "i"(d0 * 512 + 2048) : "memory"); \
                asm volatile("ds_read_b64_tr_b16 %0, %1 offset:%2" : "=&v"(vh1[d0]) : "v"(vb), "i"(d0 * 512 + 3072) : "memory"); } \
              \
            { const float NEG = -__builtin_inff(); const int db = qi - j0 - 32 * (c) - 4 * hi; const int tb = tokb + S_ * (32 * (c) + 4 * hi); \
              if ((c) == 0 || (c) == 4 || tokb < 0) { \
                _Pragma("unroll") for (int r = 0; r < 16; ++r) { const int cr = (r & 3) + 8 * (r >> 2); \
                    const bool ok = ((unsigned)(db - cr) <= 128u) && (tb + S_ * cr >= 0); p[r] = ok ? p[r] : NEG; } } } \
            float pmax = p[0]; \
            _Pragma("unroll") for (int r = 1; r < 16; ++r) pmax = fmaxf(pmax, p[r]); \
            { auto rr = __builtin_amdgcn_permlane32_swap(__float_as_uint(pmax), __float_as_uint(pmax), false, false); pmax = fmaxf(__uint_as_float(rr[0]), __uint_as_float(rr[1])); } \
            const float mn = fmaxf(m_reg, pmax); const float alpha = __builtin_amdgcn_exp2f(m_reg - mn); m_reg = mn; \
            float ps = 0.f; \
            _Pragma("unroll") for (int r = 0; r < 16; ++r) { p[r] = __builtin_amdgcn_exp2f(p[r] - mn); ps += p[r]; } \
            { auto rr = __builtin_amdgcn_permlane32_swap(__float_as_uint(ps), __float_as_uint(ps), false, false); ps = __uint_as_float(rr[0]) + __uint_as_float(rr[1]); } \
            l_reg = l_reg * alpha + ps; \
            bf16x8 pa0, pa1; DIL_PK4(p, 0, pa0); DIL_PK4(p, 8, pa1); \
            if (__any(alpha < 1.f)) { if (hi == 0) wsf[r32] = alpha; asm volatile("s_waitcnt lgkmcnt(0)" ::: "memory"); \
                _Pragma("unroll") for (int r = 0; r < 16; ++r) { const float a = wsf[crow(r, hi)]; o[0][r] *= a; o[1][r] *= a; } } \
            asm volatile("s_waitcnt lgkmcnt(0)" ::: "memory"); __builtin_amdgcn_sched_barrier(0); \
            _Pragma("unroll") for (int d0 = 0; d0 < 2; ++d0) { \
                o[d0] = __builtin_amdgcn_mfma_f32_32x32x16_bf16(pa0, (bf16x8){vl0[d0][0], vl0[d0][1], vl0[d0][2], vl0[d0][3], vh0[d0][0], vh0[d0][1], vh0[d0][2], vh0[d0][3]}, o[d0], 0, 0, 0); \
                o[d0] = __builtin_amdgcn_mfma_f32_32x32x16_bf16(pa1, (bf16x8){vl1[d0][0], vl1[d0][1], vl1[d0][2], vl1[d0][3], vh1[d0][0], vh1[d0][1], vh1[d0][2], vh1[d0][3]}, o[d0], 0, 0, 0); } \
        } while (0)
#define DIL_PK4(P, B_, OUT) do { unsigned a0 = cvt_pk_bf16(P[B_+0], P[B_+1]), a1 = cvt_pk_bf16(P[B_+2], P[B_+3]);                          \
            unsigned b0_ = cvt_pk_bf16(P[B_+4], P[B_+5]), b1_ = cvt_pk_bf16(P[B_+6], P[B_+7]);                                             \
            auto r0 = __builtin_amdgcn_permlane32_swap(a0, b0_, false, false); auto r1 = __builtin_amdgcn_permlane32_swap(a1, b1_, false, false); \
            u32x4 w = {r0[0], r1[0], r0[1], r1[1]}; OUT = __builtin_bit_cast(bf16x8, w); } while (0)
        DIL_STEP(kfA, kfB, 0); DIL_STEP(kfB, kfA, 1); DIL_STEP(kfA, kfB, 2); DIL_STEP(kfB, kfA, 3); DIL_STEP(kfA, kfB, 4);
#undef DIL_STEP
#undef DIL_PK4
#undef DIL_KLOAD
#undef DIL_VDMA
        float fo = 0.f, fc = 1.f;
        if (S_ != 1) { const float mo = macc[ql], lo = lacc[ql]; const float mnew = fmaxf(mo, m_reg); fo = __builtin_amdgcn_exp2f(mo - mnew); fc = __builtin_amdgcn_exp2f(m_reg - mnew);
            l_reg = lo * fo + l_reg * fc; m_reg = mnew; }
        if (hi == 0 && r32 < VR) { macc[ql] = m_reg; lacc[ql] = l_reg; wsf[r32] = fo; wsf[32 + r32] = fc; }
        asm volatile("s_waitcnt lgkmcnt(0)" ::: "memory");
#pragma unroll
        for (int r = 0; r < 16; ++r) { const int row = crow(r, hi);
            if (row < VR) { const int qrow = rho + S_ * (i0 + row); LAS float* op = Oacc + qrow * 64 + r32;
                if (S_ == 1) { op[0] = o[0][r]; op[32] = o[1][r]; }
                else { const float a = wsf[row], b = wsf[32 + row]; op[0] = op[0] * a + o[0][r] * b; op[32] = op[32] * a + o[1][r] * b; } } }
        asm volatile("s_waitcnt lgkmcnt(0)" ::: "memory");
    }
}
__device__ __forceinline__ void unit(const bf16_t* Qh, const bf16_t* Kh, const bf16_t* Vh, int pitch, bf16_t* Oh, int op, int q0, LAS unsigned char* lds, LAS float* scr) {
    int tid_ = threadIdx.x; asm volatile("" : "+v"(tid_));
    const int tid = tid_, wid = __builtin_amdgcn_readfirstlane(tid >> 6), lane = tid & 63;
    pass<1>(Qh, Kh, Vh, pitch, q0, lds, scr, wid, lane);
    __syncthreads();
    pass<4>(Qh, Kh, Vh, pitch, q0, lds, scr, wid, lane);
    __syncthreads();
    pass<16>(Qh, Kh, Vh, pitch, q0, lds, scr, wid, lane);
    __syncthreads();
    {   const int q = tid >> 1, hf = tid & 1; const LAS f32x4* src = (const LAS f32x4*)(lds + OFF_O + (q * 64 + 32 * hf) * 4); const float rl = 1.0f / scr[256 + q];
        bf16_t* dst = Oh + (size_t)(q0 + q) * op + 32 * hf;
#pragma unroll
        for (int i = 0; i < 4; ++i) { const f32x4 a = src[2 * i] * rl, b = src[2 * i + 1] * rl;
            u32x4 w; w.x = cvt_pk_bf16(a[0], a[1]); w.y = cvt_pk_bf16(a[2], a[3]); w.z = cvt_pk_bf16(b[0], b[1]); w.w = cvt_pk_bf16(b[2], b[3]); *(u32x4*)(dst + 8 * i) = w; } }
    __syncthreads();
}
}

namespace mla {
using att::crow;
constexpr int DQ = 192, DV_ = 128;
constexpr int KP = DQ + 16, KB = 64 * KP;
constexpr int VP = 80, VB = DV_ * VP;
constexpr int NBUF = 3;
constexpr int OFF_K = 0, OFF_V = NBUF * KB, OFF_WS = NBUF * (KB + VB), BYTES = OFF_WS + 8 * 256;
constexpr int KCPR = KP / 16, NKP = KB / 1024, KPW = (NKP + 7) / 8;
constexpr int NVP = VB / 256, VPW = NVP / 8;
static_assert(BYTES <= 131072 && KB % 1024 == 0 && VB % 256 == 0 && NVP % 8 == 0, "mla LDS image");
constexpr float PSHIFT = 8.0f;

__device__ __forceinline__ void unit(const unsigned char* __restrict__ Qh, const unsigned char* __restrict__ Kh, int pitch, const unsigned char* __restrict__ VTh  ,
                                     unsigned char* __restrict__ Oh, int op, int q0, LAS unsigned char* lds) {
    constexpr float SC = C2_C;
    int tid_ = threadIdx.x; asm volatile("" : "+v"(tid_));
    const int tid = tid_, wid = __builtin_amdgcn_readfirstlane(tid >> 6), lane = tid & 63, r32 = lane & 31, hi = lane >> 5;
    const int qlo = q0 + wid * 32, qpos = qlo + r32;
    LAS float* wsf = (LAS float*)(lds + OFF_WS) + wid * 64;
    const int NT = (q0 + 256) / 64;
    unsigned kso[KPW], vso[VPW];
#pragma unroll
    for (int i = 0; i < KPW; ++i) { const int c = (wid + 8 * i) * 64 + lane, row = c / KCPR; int cc = c % KCPR; if (cc > KCPR - 2) cc = KCPR - 2; kso[i] = (unsigned)((row & 63) * pitch + cc * 16); }
#pragma unroll
    for (int i = 0; i < VPW; ++i) { const int off = ((wid + 8 * i) * 64 + lane) * 4, d = off / VP; int w = off % VP; if (w >= 64) w = 0;
        const int hh = w >> 5, g = (w & 31) >> 2; vso[i] = (unsigned)(d * SEQ + 32 * (g >> 2) + 8 * (g & 3) + 4 * hh); }
#define MLA_DMA(j, bf) do { const unsigned char* kt_ = Kh + (size_t)(j) * 64 * pitch; const unsigned char* vt_ = VTh + (size_t)(j) * 64; \
        _Pragma("unroll") for (int i = 0; i < KPW; ++i) if (wid + 8 * i < NKP) \
            __builtin_amdgcn_global_load_lds((const unsigned*)(kt_ + kso[i]), (LAS unsigned*)(lds + OFF_K + (bf) * KB + (wid + 8 * i) * 1024), 16, 0, 0); \
        _Pragma("unroll") for (int i = 0; i < VPW; ++i) \
            __builtin_amdgcn_global_load_lds((const unsigned*)(vt_ + vso[i]), (LAS unsigned*)(lds + OFF_V + (bf) * VB + (wid + 8 * i) * 256), 4, 0, 0); } while (0)
    MLA_DMA(0, 0);
    if (NT > 1) MLA_DMA(1, 1);
    i32x8 qr[3];
#pragma unroll
    for (int s = 0; s < 3; ++s) { const i32x4 lo_ = *(const i32x4*)(Qh + (size_t)qpos * pitch + 64 * s + 32 * hi), hi_ = *(const i32x4*)(Qh + (size_t)qpos * pitch + 64 * s + 32 * hi + 16);
        qr[s] = __builtin_shufflevector(lo_, hi_, 0, 1, 2, 3, 4, 5, 6, 7); }
    float m_reg = -1e30f;
    f32x16 o[4], ol = f32x16{};
    const i32x8 ones8 = {0x38383838, 0x38383838, 0x38383838, 0x38383838, 0x38383838, 0x38383838, 0x38383838, 0x38383838};
#pragma unroll
    for (int d = 0; d < 4; ++d) o[d] = f32x16{};
    const int koff = r32 * KP + hi * 32, voff = r32 * VP + hi * 32;
    asm volatile("s_waitcnt vmcnt(0)" ::: "memory");
    __syncthreads();
#define MLA_QK(P, bufi, hf_) do { const LAS unsigned char* kb_ = lds + OFF_K + (bufi) * KB + (hf_) * 32 * KP + koff; P = f32x16{}; \
        i32x8 kw_[3]; _Pragma("unroll") for (int s = 0; s < 3; ++s) { const i32x4 lo_ = *(const LAS i32x4*)(kb_ + 64 * s), hi_ = *(const LAS i32x4*)(kb_ + 64 * s + 16); kw_[s] = __builtin_shufflevector(lo_, hi_, 0, 1, 2, 3, 4, 5, 6, 7); } \
        _Pragma("unroll") for (int s = 0; s < 3; ++s) P = __builtin_amdgcn_mfma_scale_f32_32x32x64_f8f6f4(kw_[s], qr[s], P, 0, 0, 0, 0, 0, 0); } while (0)
    f32x16 pA, pB, pC, pD;
    int buf = 0;
    { if (0 <= qlo + 31) { MLA_QK(pA, 0, 0); } if (32 <= qlo + 31) { MLA_QK(pB, 0, 1); } }
#define MLA_SMPV(P0, P1, kb, vbuf) do { \
        const bool a0_ = (kb) <= qlo + 31, a1_ = (kb) + 32 <= qlo + 31; \
        if (a0_) { \
            const float NEG = -__builtin_inff(); const int dq = qpos - (kb) - 4 * hi; \
            if (!a1_) { _Pragma("unroll") for (int r = 0; r < 16; ++r) P1[r] = NEG; } \
            if ((kb) + 63 > qlo) { _Pragma("unroll") for (int r = 0; r < 16; ++r) { const int c = (r & 3) + 8 * (r >> 2); if (dq - c < 0) P0[r] = NEG; if (dq - c - 32 < 0) P1[r] = NEG; } } \
            float pmax = fmaxf(P0[0], P1[0]); \
            _Pragma("unroll") for (int r = 1; r < 16; ++r) pmax = fmaxf(pmax, fmaxf(P0[r], P1[r])); \
            { auto rr = __builtin_amdgcn_permlane32_swap(__float_as_uint(pmax), __float_as_uint(pmax), false, false); pmax = fmaxf(__uint_as_float(rr[0]), __uint_as_float(rr[1])); } \
            const float mn = fmaxf(m_reg, pmax * SC); const float alpha = __builtin_amdgcn_exp2f(m_reg - mn); m_reg = mn; \
              \
              \
            const float c8 = 8.0f * SC, b8 = 8.0f * (PSHIFT + 7.0f - mn); \
            i32x8 pa; \
            _Pragma("unroll") for (int g = 0; g < 4; ++g) { unsigned w0 = 0u, w1 = 0u; \
                _Pragma("unroll") for (int b_ = 0; b_ < 4; ++b_) { w0 = __builtin_amdgcn_cvt_pk_u8_f32(__builtin_fmaf(P0[4 * g + b_], c8, b8), b_, w0); w1 = __builtin_amdgcn_cvt_pk_u8_f32(__builtin_fmaf(P1[4 * g + b_], c8, b8), b_, w1); } \
                pa[g] = (int)w0; pa[4 + g] = (int)w1; } \
            if (__any(alpha < 1.f)) { if (hi == 0) wsf[r32] = alpha; asm volatile("s_waitcnt lgkmcnt(0)" ::: "memory"); \
                _Pragma("unroll") for (int r = 0; r < 16; ++r) { const float a = wsf[crow(r, hi)]; ol[r] *= a; _Pragma("unroll") for (int d = 0; d < 4; ++d) o[d][r] *= a; } } \
            ol = __builtin_amdgcn_mfma_scale_f32_32x32x64_f8f6f4(pa, ones8, ol, 0, 0, 0, 0, 0, 0); \
            const LAS unsigned char* vb_ = lds + OFF_V + (vbuf) * VB + voff; \
            _Pragma("unroll") for (int d0 = 0; d0 < 4; ++d0) { const i32x4 lo_ = *(const LAS i32x4*)(vb_ + d0 * 32 * VP), hi_ = *(const LAS i32x4*)(vb_ + d0 * 32 * VP + 16); \
                o[d0] = __builtin_amdgcn_mfma_scale_f32_32x32x64_f8f6f4(pa, __builtin_shufflevector(lo_, hi_, 0, 1, 2, 3, 4, 5, 6, 7), o[d0], 0, 0, 0, 0, 0, 0); } \
        } } while (0)
    for (int t = 0; t < NT; t += 2) {
        {   if (t + 2 < NT) { const int b2 = buf == 0 ? 2 : buf - 1; MLA_DMA(t + 2, b2); }
            const int kb = t * 64, nb = buf == 2 ? 0 : buf + 1;
            if (kb + 64 <= qlo + 31) MLA_QK(pC, nb, 0);
            if (kb + 96 <= qlo + 31) MLA_QK(pD, nb, 1);
            MLA_SMPV(pA, pB, kb, buf);
            asm volatile("s_waitcnt vmcnt(0)" ::: "memory"); __syncthreads(); buf = nb; }
        {   if (t + 3 < NT) { const int b2 = buf == 0 ? 2 : buf - 1; MLA_DMA(t + 3, b2); }
            const int kb = (t + 1) * 64, nb = buf == 2 ? 0 : buf + 1;
            if (t + 2 < NT) { if (kb + 64 <= qlo + 31) MLA_QK(pA, nb, 0); if (kb + 96 <= qlo + 31) MLA_QK(pB, nb, 1); }
            MLA_SMPV(pC, pD, kb, buf);
            asm volatile("s_waitcnt vmcnt(0)" ::: "memory"); __syncthreads(); buf = nb; }
    }
#undef MLA_SMPV
#undef MLA_QK
#undef MLA_DMA
    unsigned char* Ow = Oh + (size_t)qlo * op;
#pragma unroll
    for (int r = 0; r < 16; ++r) { const int orow = crow(r, hi); const float rl = __builtin_amdgcn_rcpf(ol[r]);
#pragma unroll
        for (int d0 = 0; d0 < 4; ++d0) { const float v = o[d0][r] * rl; const float v1 = __shfl_down(v, 1), v2 = __shfl_down(v, 2), v3 = __shfl_down(v, 3);
            if ((r32 & 3) == 0) *(unsigned*)(Ow + (size_t)orow * op + d0 * 32 + r32) = pk4_fp8(v, v1, v2, v3); } }
    __syncthreads();
}
}

constexpr int NWAVES = 8;
constexpr size_t MiB = 1u << 20;
constexpr size_t WS_CTL = 0, CTL_ZERO_BYTES = 1 * MiB;
constexpr size_t WS_WEIN = 2 * MiB;
constexpr size_t WS_WEOUT = 12 * MiB;
constexpr size_t WS_WOIN = 16 * MiB;
constexpr size_t WS_WUQ = 20 * MiB;
constexpr size_t WS_WUKV = 23 * MiB;
constexpr size_t WS_WOOUT = 25 * MiB;
constexpr size_t WS_B1P = 29 * MiB;
constexpr size_t WS_SSQ = 30 * MiB;
constexpr size_t WS_TOKER = 31 * MiB;
constexpr size_t WS_TOKG = 31 * MiB + 512 * 1024;
constexpr size_t WS_XN = 32 * MiB;
constexpr size_t WS_Z = 64 * MiB;
constexpr size_t WS_MIX = 144 * MiB;
constexpr size_t WS_QR = 176 * MiB;
constexpr size_t WS_KVR = 224 * MiB;
constexpr size_t WS_QF = 288 * MiB;
constexpr size_t WS_KF = 336 * MiB;
constexpr size_t WS_Z8 = 104 * MiB;
constexpr size_t WS_MIX8 = 160 * MiB;
constexpr size_t WS_VT = 3200 * MiB;
constexpr size_t WS_W1 = 384 * MiB;
constexpr size_t WS_W2 = 896 * MiB;
constexpr size_t WS_XG = 1152 * MiB;
constexpr size_t WS_ACT = 1664 * MiB;
constexpr size_t WS_Y = 2176 * MiB;
constexpr size_t WS_X16 = 3216 * MiB;
constexpr size_t WS_END = 3248 * MiB;
constexpr int CW_MOE = 65536;
constexpr int CW_TMO = 0, CW_CODE = 1, CW_BAR = 4096, CW_CNT = 16384;
constexpr int RING_OFF = 0, RING_BYTES = 131072;
constexpr int LDSCTL_OFF = RING_BYTES, MISC_OFF = LDSCTL_OFF + 320;
constexpr int SCR_OFF = RING_BYTES + 1024;
constexpr int LDS_BYTES = 155648;
constexpr int SCR_BYTES = LDS_BYTES - SCR_OFF;

typedef GAS unsigned gu32;
#define RLX_AGENT __ATOMIC_RELAXED, __HIP_MEMORY_SCOPE_AGENT

#define XB_TMO      128
#define XB_XCNT(j)  (256  + 64 * (j))
#define XB_XSUB(j)  (1280 + 64 * (j))
#define XB_XGEN(j)  (2304 + 64 * (j))
#define XB_TOP      3328
#define XB_TOPGEN   3392
#define XCD_BAR_WORDS 3456
#define XB_SPIN_CAP (1u << 18)
__device__ __forceinline__ unsigned xb_ld(unsigned* p)              { return __hip_atomic_load(p, __ATOMIC_RELAXED, __HIP_MEMORY_SCOPE_AGENT); }
__device__ __forceinline__ unsigned xb_add(unsigned* p, unsigned v) { return __hip_atomic_fetch_add(p, v, __ATOMIC_RELAXED, __HIP_MEMORY_SCOPE_AGENT); }
__device__ __forceinline__ unsigned xb_xcc_id() { return (unsigned)__builtin_amdgcn_s_getreg((3 << 11) | 20) & 0xFu; }
#define XB_SPIN(cond, bar) do { unsigned _sp = 0; while (cond) { __builtin_amdgcn_s_sleep(1); \
    if ((++_sp & 255u) == 0u) { if (xb_ld(&(bar)[XB_TMO])) break; if (_sp > XB_SPIN_CAP) { atomicAdd(&(bar)[XB_TMO], 1u); break; } } } } while (0)
struct XcdBarrier { unsigned* bar; unsigned x; volatile LAS unsigned* st; };
__device__ __forceinline__ XcdBarrier xcd_barrier_post(unsigned* bar, volatile LAS unsigned* st) {
    XcdBarrier b; b.bar = bar; b.x = xb_xcc_id(); b.st = st;
    if (threadIdx.x == 0) (void)xb_add(&bar[XB_XCNT(b.x)], 1u);
    return b;
}
__device__ __forceinline__ void xcd_barrier_complete(unsigned* bar, unsigned x, unsigned& nloc, unsigned& nx) {
    const unsigned G = gridDim.x * gridDim.y * gridDim.z;
    unsigned sum, cnt, mine, sp = 0u;
    for (;;) {
        sum = 0u; cnt = 0u; mine = 0u;
#pragma unroll
        for (unsigned j = 0; j < 16; ++j) { const unsigned c = xb_ld(&bar[XB_XCNT(j)]); sum += c; cnt += (c > 0u) ? 1u : 0u; mine = (j == x) ? c : mine; }
        if (sum == G) break;
        __builtin_amdgcn_s_sleep(1);
        if ((++sp & 255u) == 0u) { if (xb_ld(&bar[XB_TMO])) break; if (sp > XB_SPIN_CAP) { atomicAdd(&bar[XB_TMO], 1u); break; } }
    }
    nloc = mine > 0u ? mine : 1u; nx = cnt > 0u ? cnt : 1u;
}
__device__ __forceinline__ void xcd_barrier(const XcdBarrier& b) {
    asm volatile("s_waitcnt vmcnt(0)" ::: "memory");
    __syncthreads();
    if (threadIdx.x == 0) {
        unsigned* bar = b.bar;
        __builtin_amdgcn_s_waitcnt(0);
        unsigned nloc = b.st[0], nx = b.st[1];
        if (nloc == 0u) { xcd_barrier_complete(bar, b.x, nloc, nx); b.st[0] = nloc; b.st[1] = nx; }
        const unsigned old = xb_add(&bar[XB_XSUB(b.x)], 1u);
        const unsigned gen = old / nloc;
        if (old + 1u == (gen + 1u) * nloc) {
            __builtin_amdgcn_fence(__ATOMIC_RELEASE, "agent");
            asm volatile("s_waitcnt vmcnt(0)" ::: "memory");
            const unsigned og = xb_add(&bar[XB_TOP], 1u);
            const unsigned tg = og / nx;
            if (og + 1u == (tg + 1u) * nx) xb_add(&bar[XB_TOPGEN], 1u);
            else XB_SPIN(xb_ld(&bar[XB_TOPGEN]) == tg, bar);
            __builtin_amdgcn_fence(__ATOMIC_ACQUIRE, "agent");
            xb_add(&bar[XB_XGEN(b.x)], 1u);
            asm volatile("s_waitcnt vmcnt(0)" ::: "memory");
        } else {
            XB_SPIN(xb_ld(&bar[XB_XGEN(b.x)]) == gen, bar);
            __builtin_amdgcn_fence(__ATOMIC_ACQUIRE, "agent");
            asm volatile("s_waitcnt vmcnt(0)" ::: "memory");
        }
    }
    __syncthreads();
}

struct Args {
    const float* in[24]; float* out; unsigned char* ws; int stage_limit; int pad;
};
enum { I_X = 0, I_MIXN, I_FFNN, I_EWIN, I_EWS, I_EBS, I_EGV, I_EGQ, I_EGK, I_EWOUT, I_OWIN, I_OGCQ, I_OGCKV, I_OWUQ, I_OWUKV, I_OGQ, I_OGK, I_OWOUT,
       I_RW, I_RB, I_W1, I_B1, I_W2, I_B2 };

struct Frame {
    LAS unsigned char* lds;
    int vcu, G;
};

__device__ __forceinline__ float wave_sum(float v) {
#pragma unroll
    for (int o = 1; o < 64; o <<= 1) v += __shfl_xor(v, o);
    return v;
}
#define LDS_WAIT() asm volatile("s_waitcnt lgkmcnt(0)" ::: "memory")

template <int MODE> __device__ __forceinline__ int dst_row(int o) {
    if (MODE == 1) { if (o >= 1024 && o < 2048) return (o & ~255) | (((o >> 5) & 1) << 7) | (((o >> 6) & 3) << 5) | (o & 31); return o; }
    if (MODE == 2) return ((o >> 8) << 8) | ((o & 1) << 7) | ((o & 255) >> 1);
    return o;
}
template <int MODE>
__device__ __forceinline__ void transpose_item(const float* __restrict__ W, int K, int N, bf16_t* __restrict__ WT, const float* __restrict__ gain, LAS float* scr, int item, int lane) {
    const int nblk = N / 32, kb = item / nblk, nb = item % nblk, k0 = 64 * kb, n0 = 32 * nb;
#pragma unroll 8
    for (int i = 0; i < 32; ++i) { const int kk = 2 * i + (lane >> 5); float w = W[(size_t)(k0 + kk) * N + n0 + (lane & 31)]; if (gain) w *= gain[k0 + kk]; scr[kk * 33 + (lane & 31)] = w; }
    LDS_WAIT(); asm volatile("" ::: "memory");
    const int c = lane & 7;
#pragma unroll
    for (int j = 0; j < 4; ++j) { const int n = (lane >> 3) + 8 * j; const LAS float* s = scr + (8 * c) * 33 + n;
        u32x4 o; o.x = cvt_pk_bf16(s[0 * 33], s[1 * 33]); o.y = cvt_pk_bf16(s[2 * 33], s[3 * 33]); o.z = cvt_pk_bf16(s[4 * 33], s[5 * 33]); o.w = cvt_pk_bf16(s[6 * 33], s[7 * 33]);
        *(u32x4*)(WT + (size_t)dst_row<MODE>(n0 + n) * K + k0 + 8 * c) = o; }
    LDS_WAIT(); asm volatile("" ::: "memory");
}
template <int MODE>
__device__ __forceinline__ void transpose_job(Frame& F, const float* W, int K, int N, int nmat, size_t src_stride, bf16_t* WT, size_t dst_stride, const float* gain, int gain_stride) {
    int tid_ = threadIdx.x; asm volatile("" : "+v"(tid_));
    const int wave = __builtin_amdgcn_readfirstlane(tid_ >> 6), lane = tid_ & 63;
    LAS float* scr = (LAS float*)(F.lds + RING_OFF + wave * 16384);
    const int gw = F.vcu * NWAVES + wave, NGW = F.G * NWAVES;
    const int per = (K / 64) * (N / 32), total = per * nmat;
    for (int it = gw; it < total; it += NGW) { const int mi = it / per, item = it - mi * per;
        transpose_item<MODE>(W + (size_t)mi * src_stride, K, N, WT + (size_t)mi * dst_stride, gain ? gain + (size_t)mi * gain_stride : nullptr, scr, item, lane); }
}


__device__ __forceinline__ void tr8_load(f32x4 (&v)[16], const float* __restrict__ W, int N, int item, int lane) {
    const int nblk = N / 32, kb = item / nblk, nb = item % nblk, k0 = 128 * kb, n0 = 32 * nb;
#pragma unroll
    for (int i = 0; i < 16; ++i) v[i] = __builtin_nontemporal_load((const f32x4*)(W + (size_t)(k0 + 8 * i + (lane >> 3)) * N + n0 + 4 * (lane & 7)));
}
template <int MODE>
__device__ __forceinline__ void tr8_store(const f32x4 (&v)[16], int K, int N, unsigned char* __restrict__ WT, const float* __restrict__ gain, LAS unsigned char* scr, int item, int lane) {
    const int nblk = N / 32, kb = item / nblk, nb = item % nblk, k0 = 128 * kb, n0 = 32 * nb;
    constexpr int TP = 144;
#pragma unroll
    for (int i = 0; i < 16; ++i) { const int kl = 8 * i + (lane >> 3); const float sc = gain ? W8_SCALE * gain[k0 + kl] : W8_SCALE;
        const unsigned w = pk4_fp8(v[i].x * sc, v[i].y * sc, v[i].z * sc, v[i].w * sc); LAS unsigned char* d = scr + (4 * (lane & 7)) * TP + kl;
        d[0] = (unsigned char)w; d[TP] = (unsigned char)(w >> 8); d[2 * TP] = (unsigned char)(w >> 16); d[3 * TP] = (unsigned char)(w >> 24); }
    LDS_WAIT(); asm volatile("" ::: "memory");
#pragma unroll
    for (int m = 0; m < 4; ++m) { const int q = lane + 64 * m, n = q >> 3, kc = q & 7;
        const u32x4 o = *(const LAS u32x4*)(scr + n * TP + 16 * kc);
        __builtin_nontemporal_store(o, (u32x4*)(WT + (size_t)dst_row<MODE>(n0 + n) * K + k0 + 16 * kc)); }
    LDS_WAIT(); asm volatile("" ::: "memory");
}
template <int MODE>
__device__ __forceinline__ void transpose_job_fp8(Frame& F, const float* W, int K, int N, int nmat, size_t src_stride, unsigned char* WT, size_t dst_stride, const float* gain = nullptr, int gain_stride = 0) {
    int tid_ = threadIdx.x; asm volatile("" : "+v"(tid_));
    const int wave = __builtin_amdgcn_readfirstlane(tid_ >> 6), lane = tid_ & 63;
    LAS unsigned char* scr = F.lds + RING_OFF + wave * 16384;
    const int gw = F.vcu * NWAVES + wave, NGW = F.G * NWAVES;
    const int per = (K / 128) * (N / 32), total = per * nmat;
    f32x4 cur[16], nxt[16];
    int it = gw;
    if (it < total) { const int mi = it / per; tr8_load(cur, W + (size_t)mi * src_stride, N, it - mi * per, lane); }
    for (; it < total; it += NGW) {
        const int itn = it + NGW;
        if (itn < total) { const int mn = itn / per; tr8_load(nxt, W + (size_t)mn * src_stride, N, itn - mn * per, lane); }
        const int mi = it / per;
        tr8_store<MODE>(cur, K, N, WT + (size_t)mi * dst_stride, gain ? gain + (size_t)mi * gain_stride : nullptr, scr, it - mi * per, lane);
#pragma unroll
        for (int i = 0; i < 16; ++i) cur[i] = nxt[i];
    }
}

__device__ __forceinline__ void rms_row_to_fp8(int lane, const float* xrow, const float* g, unsigned char* orow, float* copy) {
    const f32x4* xr = (const f32x4*)xrow + lane; const f32x4* gr = (const f32x4*)g + lane;
    f32x4 v[4]; float s = 0.f;
#pragma unroll
    for (int j = 0; j < 4; ++j) { v[j] = xr[64 * j]; s += (v[j].x * v[j].x + v[j].y * v[j].y) + (v[j].z * v[j].z + v[j].w * v[j].w); }
    const float rstd = 1.0f / sqrtf(wave_sum(s) * (1.f / DM) + EPS);
    unsigned* o4 = (unsigned*)orow + lane;
#pragma unroll
    for (int j = 0; j < 4; ++j) { const f32x4 gg = gr[64 * j]; if (copy) ((f32x4*)copy + lane)[64 * j] = v[j];
        o4[64 * j] = pk4_fp8(v[j].x * rstd * gg.x, v[j].y * rstd * gg.y, v[j].z * rstd * gg.z, v[j].w * rstd * gg.w); }
}
__device__ __forceinline__ void rms_row_to_bf16(int lane, const float* xrow, const float* g, bf16_t* orow, float* copy) {
    const f32x4* xr = (const f32x4*)xrow + lane; const f32x4* gr = (const f32x4*)g + lane;
    f32x4 v[4]; float s = 0.f;
#pragma unroll
    for (int j = 0; j < 4; ++j) { v[j] = xr[64 * j]; s += (v[j].x * v[j].x + v[j].y * v[j].y) + (v[j].z * v[j].z + v[j].w * v[j].w); }
    const float rstd = 1.0f / sqrtf(wave_sum(s) * (1.f / DM) + EPS);
    u32x2* o8 = (u32x2*)orow + lane;
#pragma unroll
    for (int j = 0; j < 4; ++j) { const f32x4 gg = gr[64 * j]; if (copy) ((f32x4*)copy + lane)[64 * j] = v[j];
        u32x2 w; w.x = cvt_pk_bf16(v[j].x * rstd * gg.x, v[j].y * rstd * gg.y); w.y = cvt_pk_bf16(v[j].z * rstd * gg.z, v[j].w * rstd * gg.w); o8[64 * j] = w; }
}

namespace pg8 {
struct EpiEvenIn {
    static constexpr bool PERM = false;
    bf16_t* Z; const float* gq; const float* gk;
    __device__ __forceinline__ void operator()(const f32x4 (&acc)[2][2][4][2], const Unit& u, int wr, int wc, int fr, int fq) const {
        const int row0 = u.pm * BM + wr * 64 + fr, pn = u.pn;
        if (pn >= 4 && pn < 8) {
            const float* g = pn < 6 ? gq : gk; const float sc = pn < 6 ? C2_B : 1.0f;
            f32x4 gv[2][2];
#pragma unroll
            for (int bj = 0; bj < 2; ++bj)
#pragma unroll
                for (int n = 0; n < 2; ++n) gv[bj][n] = *(const f32x4*)(g + 32 * bj + 16 * n + 4 * fq);
#pragma unroll
            for (int ai = 0; ai < 2; ++ai)
#pragma unroll
                for (int m = 0; m < 4; ++m) {
                    float ss = 0.f;
#pragma unroll
                    for (int bj = 0; bj < 2; ++bj)
#pragma unroll
                        for (int n = 0; n < 2; ++n) { const f32x4 v = acc[ai][bj][m][n]; ss += (v[0] * v[0] + v[1] * v[1]) + (v[2] * v[2] + v[3] * v[3]); }
                    ss += __shfl_xor(ss, 16); ss += __shfl_xor(ss, 32);
                    const float rstd = sc / sqrtf(ss * (1.0f / 64.0f) + EPS);
                    bf16_t* rowp = Z + (size_t)(row0 + ai * HALF + m * 16) * EVEN_IN + pn * BM + wc * 64 + 4 * fq;
#pragma unroll
                    for (int bj = 0; bj < 2; ++bj)
#pragma unroll
                        for (int n = 0; n < 2; ++n) { const f32x4 v = acc[ai][bj][m][n] * rstd * gv[bj][n];
                            u32x2 w; w.x = cvt_pk_bf16(v[0], v[1]); w.y = cvt_pk_bf16(v[2], v[3]); *(u32x2*)(rowp + 32 * bj + 16 * n) = w; }
                }
        } else {
            const bool act = pn < 4;
#pragma unroll
            for (int ai = 0; ai < 2; ++ai)
#pragma unroll
                for (int m = 0; m < 4; ++m) { bf16_t* rowp = Z + (size_t)(row0 + ai * HALF + m * 16) * EVEN_IN + pn * BM + wc * 32 + 4 * fq;
#pragma unroll
                    for (int bj = 0; bj < 2; ++bj)
#pragma unroll
                        for (int n = 0; n < 2; ++n) { f32x4 v = acc[ai][bj][m][n]; if (act) v = gelu4(v);
                            u32x2 w; w.x = cvt_pk_bf16(v[0], v[1]); w.y = cvt_pk_bf16(v[2], v[3]); *(u32x2*)(rowp + bj * HALF + 16 * n) = w; } }
        }
    }
};
template <bool F8 = false> struct EpiResidT {
    static constexpr bool PERM = false;
    const float* src32; bf16_t* X;
    __device__ __forceinline__ void operator()(const f32x4 (&acc)[2][2][4][2], const Unit& u, int wr, int wc, int fr, int fq) const {
        const int row0 = u.pm * BM + wr * 64 + fr;
#pragma unroll
        for (int ai = 0; ai < 2; ++ai)
#pragma unroll
            for (int m = 0; m < 4; ++m) { const size_t ro = (size_t)(row0 + ai * HALF + m * 16) * DM + u.pn * BM + wc * 32 + 4 * fq;
#pragma unroll
                for (int bj = 0; bj < 2; ++bj)
#pragma unroll
                    for (int n = 0; n < 2; ++n) { const size_t o_ = ro + bj * HALF + 16 * n; f32x4 b;
                        if (src32) b = *(const f32x4*)(src32 + o_); else { const u32x2 t = *(const u32x2*)(X + o_); b = (f32x4){bflo(t.x), bfhi(t.x), bflo(t.y), bfhi(t.y)}; }
                        const f32x4 r = b + (F8 ? acc[ai][bj][m][n] * W8_INV : acc[ai][bj][m][n]);
                        u32x2 w; w.x = cvt_pk_bf16(r[0], r[1]); w.y = cvt_pk_bf16(r[2], r[3]); *(u32x2*)(X + o_) = w; }
                if (m & 1) asm volatile("" ::: "memory"); }
    }
};
typedef EpiResidT<false> EpiResid;
struct EpiOddIn {
    static constexpr bool PERM = false;
    bf16_t* Z; unsigned char* Z8; float* ssq;
    __device__ __forceinline__ void operator()(const f32x4 (&acc)[2][2][4][2], const Unit& u, int wr, int wc, int fr, int fq) const {
        const int row0 = u.pm * BM + wr * 64 + fr, pn = u.pn;
#pragma unroll
        for (int ai = 0; ai < 2; ++ai)
#pragma unroll
            for (int m = 0; m < 4; ++m) { const int row = row0 + ai * HALF + m * 16; bf16_t* rowp = Z + (size_t)row * ODD_INP + pn * BM + wc * 32 + 4 * fq;
                float ss = 0.f;
#pragma unroll
                for (int bj = 0; bj < 2; ++bj)
#pragma unroll
                    for (int n = 0; n < 2; ++n) { const f32x4 v = acc[ai][bj][m][n] * W8_INV; ss += (v[0] * v[0] + v[1] * v[1]) + (v[2] * v[2] + v[3] * v[3]);
                        if (pn < 3) *(unsigned*)(Z8 + (size_t)row * ODD_INP + pn * BM + wc * 32 + 4 * fq + bj * HALF + 16 * n) = pk4_fp8(v[0], v[1], v[2], v[3]);
                        else { u32x2 w; w.x = cvt_pk_bf16(v[0], v[1]); w.y = cvt_pk_bf16(v[2], v[3]); *(u32x2*)(rowp + bj * HALF + 16 * n) = w; } }
                ss += __shfl_xor(ss, 16); ss += __shfl_xor(ss, 32);
                if (fq == 0) ssq[(size_t)row * 16 + pn * 4 + wc] = ss; }
    }
};
template <int NS> struct EpiRowScale {
    static constexpr bool PERM = true;
    bf16_t* O; int ldc; const float* ssq; int s0; float inv_cols;
    __device__ __forceinline__ void operator()(const f32x4 (&acc)[2][2][4][2], const Unit& u, int wr, int wc, int fr, int fq) const {
        const int row0 = u.pm * BM + wr * 64 + fr; const int col0 = u.pn * BM + wc * 32 + 8 * fq;
#pragma unroll
        for (int ai = 0; ai < 2; ++ai)
#pragma unroll
            for (int m = 0; m < 4; ++m) { const int row = row0 + ai * HALF + m * 16;
                float ss = 0.f; const f32x4* sp = (const f32x4*)(ssq + (size_t)row * 16 + s0);
#pragma unroll
                for (int q = 0; q < NS; ++q) { const f32x4 t = sp[q]; ss += (t[0] + t[1]) + (t[2] + t[3]); }
                const float rstd = W8_INV / sqrtf(ss * inv_cols + EPS);
                bf16_t* rowp = O + (size_t)row * ldc + col0;
#pragma unroll
                for (int bj = 0; bj < 2; ++bj) { const f32x4 v0 = acc[ai][bj][m][0] * rstd, v1 = acc[ai][bj][m][1] * rstd;
                    u32x4 w; w.x = cvt_pk_bf16(v0[0], v0[1]); w.y = cvt_pk_bf16(v0[2], v0[3]); w.z = cvt_pk_bf16(v1[0], v1[1]); w.w = cvt_pk_bf16(v1[2], v1[3]);
                    *(u32x4*)(rowp + bj * HALF) = w; }
                asm volatile("" ::: "memory"); }
    }
};
__device__ __forceinline__ void store8_sc1(void* p, u32x2 v) { asm volatile("global_store_dwordx2 %0, %1, off sc1" :: "v"(p), "v"(v) : "memory"); }
template <bool WT = false> struct EpiSwigluT {
    static constexpr bool PERM = true;
    unsigned char* ACT; const float* b1p;
    __device__ __forceinline__ void operator()(const f32x4 (&acc)[2][2][4][2], const Unit& u, int wr, int wc, int fr, int fq) const {
        const int row0 = u.pm * BM + wr * 64 + fr, e = u.pb >> 3, pn = u.pn;
        const float* bp = b1p + (size_t)e * 2048 + pn * BM + wc * 32 + 8 * fq;
        f32x4 bg[2], bl[2];
#pragma unroll
        for (int n = 0; n < 2; ++n) { bg[n] = *(const f32x4*)(bp + 4 * n); bl[n] = *(const f32x4*)(bp + HALF + 4 * n); }
#pragma unroll
        for (int ai = 0; ai < 2; ++ai)
#pragma unroll
            for (int m = 0; m < 4; ++m) { unsigned char* rowp = ACT + (size_t)(row0 + ai * HALF + m * 16) * DE + pn * HALF + wc * 32 + 8 * fq;
                float a[8];
#pragma unroll
                for (int n = 0; n < 2; ++n) { const f32x4 gv = acc[ai][0][m][n] * W8_INV + bg[n], lv = acc[ai][1][m][n] * W8_INV + bl[n];
#pragma unroll
                    for (int i = 0; i < 4; ++i) { const float gl = fminf(gv[i], 7.0f), li = fminf(fmaxf(lv[i], -7.0f), 7.0f);
                        const float sg = __builtin_amdgcn_rcpf(1.0f + __builtin_amdgcn_exp2f(-1.702f * LOG2E * gl));
                        a[4 * n + i] = gl * sg * (li + 1.0f); } }
                u32x2 w; w.x = pk4_fp8(a[0], a[1], a[2], a[3]); w.y = pk4_fp8(a[4], a[5], a[6], a[7]);
                if (WT) store8_sc1(rowp, w); else *(u32x2*)rowp = w; }
    }
};
typedef EpiSwigluT<false> EpiSwiglu;
struct EpiDown {
    static constexpr bool PERM = true;
    bf16_t* Y; const float* b2;
    __device__ __forceinline__ void operator()(const f32x4 (&acc)[2][2][4][2], const Unit& u, int wr, int wc, int fr, int fq) const {
        const int row0 = u.pm * BM + wr * 64 + fr, e = u.pb >> 2, pn = u.pn;
        const float* bp = b2 + (size_t)e * DM + pn * BM + wc * 32 + 8 * fq;
        f32x4 bv[2][2];
#pragma unroll
        for (int bj = 0; bj < 2; ++bj)
#pragma unroll
            for (int n = 0; n < 2; ++n) bv[bj][n] = *(const f32x4*)(bp + bj * HALF + 4 * n);
#pragma unroll
        for (int ai = 0; ai < 2; ++ai)
#pragma unroll
            for (int m = 0; m < 4; ++m) { bf16_t* rowp = Y + (size_t)(row0 + ai * HALF + m * 16) * DM + pn * BM + wc * 32 + 8 * fq;
#pragma unroll
                for (int bj = 0; bj < 2; ++bj) { const f32x4 v0 = acc[ai][bj][m][0] * W8_INV + bv[bj][0], v1 = acc[ai][bj][m][1] * W8_INV + bv[bj][1];
                    u32x4 w; w.x = cvt_pk_bf16(v0[0], v0[1]); w.y = cvt_pk_bf16(v0[2], v0[3]); w.z = cvt_pk_bf16(v1[0], v1[1]); w.w = cvt_pk_bf16(v1[2], v1[3]);
                    *(u32x4*)(rowp + bj * HALF) = w; } }
    }
};
struct MoeOrder {
    const LAS int* tbl; int nN, G, c;
    __device__ bool next(int i, Unit& u) const {
        const long L = (long)i * G + c; const int rb = (int)(L / nN);
        if (rb >= __builtin_amdgcn_readfirstlane(tbl[32])) return false;
        int e = 0;
#pragma unroll
        for (int k = 1; k < 32; ++k) e += (tbl[k] <= rb) ? 1 : 0;
        e = __builtin_amdgcn_readfirstlane(e); const int rbl = __builtin_amdgcn_readfirstlane(rb - tbl[e]);
        u.pm = e * (ECAP / BM) + rbl; u.pn = (int)(L % nN); u.pb = e * nN + u.pn; u.kind = 0; u.rb = rb; return true;
    }
    __device__ __forceinline__ void a_ready(const Unit&) const {}
    __device__ __forceinline__ void pre_epi() const {}
    __device__ __forceinline__ void done(const Unit&) const {}
    __device__ __forceinline__ void finish() const {}
};

constexpr unsigned MOE_SPIN_CAP = 1u << 22;
struct MoeMergedOrder {
    const LAS int* tbl; int G, c; gu32* cnt;
    mutable int pend;
    __device__ __forceinline__ void flush() const {
        if (pend >= 0) { asm volatile("s_waitcnt vmcnt(0)" ::: "memory");
            if ((threadIdx.x & 63) == 0) __hip_atomic_fetch_add(cnt + 16 * pend, 1u, __ATOMIC_RELAXED, __HIP_MEMORY_SCOPE_AGENT);
            pend = -1; } }
    __device__ bool next(int i, Unit& u) const {
        const int nb = __builtin_amdgcn_readfirstlane(tbl[32]);
        long L = (long)i * G + c; int nN = 8, kind = 0;
        if (L >= (long)nb * 8) { L -= (long)nb * 8; nN = 4; kind = 1; if (L >= (long)nb * 4) return false; }
        const int rb = (int)(L / nN);
        int e = 0;
#pragma unroll
        for (int k = 1; k < 32; ++k) e += (tbl[k] <= rb) ? 1 : 0;
        e = __builtin_amdgcn_readfirstlane(e); const int rbl = __builtin_amdgcn_readfirstlane(rb - tbl[e]);
        u.pm = e * (ECAP / BM) + rbl; u.pn = (int)(L % nN); u.pb = e * nN + u.pn; u.kind = kind; u.rb = rb; return true;
    }
    __device__ __forceinline__ void a_ready(const Unit& u) const {
        if (u.kind == 1) {
            flush();
            if (threadIdx.x < 64) {
                unsigned sp = 0;
                while ((unsigned)__builtin_amdgcn_readfirstlane(__hip_atomic_load(cnt + 16 * u.rb, __ATOMIC_RELAXED, __HIP_MEMORY_SCOPE_AGENT)) < 64u) { __builtin_amdgcn_s_sleep(2); if (++sp > MOE_SPIN_CAP) break; }
                __builtin_amdgcn_fence(__ATOMIC_ACQUIRE, "agent");
                asm volatile("s_waitcnt vmcnt(0)" ::: "memory");
            }
            __builtin_amdgcn_s_barrier();
        }
    }
    __device__ __forceinline__ void pre_epi() const { flush(); }
    __device__ __forceinline__ void done(const Unit& u) const { if (u.kind == 0) pend = u.rb; }
    __device__ __forceinline__ void finish() const { flush(); }
};
struct EpiMoe {
    static constexpr bool PERM = true;
    EpiSwigluT<true> up; EpiDown down;
    __device__ __forceinline__ void operator()(const f32x4 (&acc)[2][2][4][2], const Unit& u, int wr, int wc, int fr, int fq) const {
        if (u.kind == 0) up(acc, u, wr, wc, fr, fq); else down(acc, u, wr, wc, fr, fq);
    }
};
}

__device__ __forceinline__ void gmlp_unit(Frame& F, const bf16_t* Z, bf16_t* MIX, const float* Ws, const float* bs, const float* gv, int unit) {
    constexpr int VP = 272;
    LAS unsigned char* VT = F.lds + RING_OFF;
    const int h = unit & 3, chunk = unit >> 2;
    int tid_ = threadIdx.x; asm volatile("" : "+v"(tid_));
    const int t0 = chunk * 128, tid = tid_, lane = tid & 63, w = __builtin_amdgcn_readfirstlane(tid >> 6);
    {
        const int s = tid >> 2, dq = (tid & 3) * 32;
        const bf16_t* vp = Z + (size_t)(t0 + s) * EVEN_IN + 512 + h * 128 + dq;
        u32x4 raw[4]; float ss = 0.f;
#pragma unroll
        for (int i = 0; i < 4; ++i) { raw[i] = *(const u32x4*)(vp + 8 * i);
#pragma unroll
            for (int j = 0; j < 4; ++j) { const float a = bflo(raw[i][j]), b = bfhi(raw[i][j]); ss += a * a + b * b; } }
        ss += __shfl_xor(ss, 1); ss += __shfl_xor(ss, 2);
        const float rstd = 1.0f / sqrtf(ss * (1.0f / 128.0f) + EPS);
#pragma unroll
        for (int i = 0; i < 4; ++i)
#pragma unroll
            for (int j = 0; j < 4; ++j) { const int d = dq + 8 * i + 2 * j;
                *(LAS bf16_t*)(VT + (d) * VP + s * 2) = f2bf(bflo(raw[i][j]) * rstd);
                *(LAS bf16_t*)(VT + (d + 1) * VP + s * 2) = f2bf(bfhi(raw[i][j]) * rstd); }
    }
    __syncthreads();
    const int fr = lane & 15, fq = lane >> 4;
    f32x4 acc[8];
#pragma unroll
    for (int nb = 0; nb < 8; ++nb) acc[nb] = (f32x4){0.f, 0.f, 0.f, 0.f};
    const int trow = 16 * w + fr;
    const float* wrow = Ws + ((size_t)h * 128 + trow) * 128;
#pragma unroll
    for (int ks = 0; ks < 4; ++ks) {
        if (32 * ks <= 16 * w + 15) {
            const int s0 = 32 * ks + 8 * fq;
            const f32x4 wa = *(const f32x4*)(wrow + s0), wb = *(const f32x4*)(wrow + s0 + 4);
            float wv[8] = {wa[0], wa[1], wa[2], wa[3], wb[0], wb[1], wb[2], wb[3]};
#pragma unroll
            for (int j = 0; j < 8; ++j) if (s0 + j > trow) wv[j] = 0.f;
            u32x4 aw; aw.x = cvt_pk_bf16(wv[0], wv[1]); aw.y = cvt_pk_bf16(wv[2], wv[3]); aw.z = cvt_pk_bf16(wv[4], wv[5]); aw.w = cvt_pk_bf16(wv[6], wv[7]);
            const bf16x8 af = __builtin_bit_cast(bf16x8, aw);
#pragma unroll
            for (int nb = 0; nb < 8; ++nb) { const bf16x8 bfr = *(const LAS bf16x8*)(VT + (16 * nb + fr) * VP + s0 * 2);
                acc[nb] = __builtin_amdgcn_mfma_f32_16x16x32_bf16(af, bfr, acc[nb], 0, 0, 0); }
        }
    }
    LAS bf16_t* DT = (LAS bf16_t*)(F.lds + RING_OFF + 36864);
#pragma unroll
    for (int i = 0; i < 4; ++i) { const int tl = 16 * w + 4 * fq + i; const float bt = bs[h * 128 + tl];
#pragma unroll
        for (int nb = 0; nb < 8; ++nb) DT[tl * 136 + 16 * nb + fr] = f2bf(gv[h * 128 + 16 * nb + fr] * acc[nb][i] + bt); }
    __syncthreads();
#pragma unroll
    for (int k = 0; k < 4; ++k) { const int idx = tid + 512 * k, tl = idx >> 4, c8 = (idx & 15) * 8;
        const u32x4 mv = *(const LAS u32x4*)(DT + tl * 136 + c8); const u32x4 uv = *(const u32x4*)(Z + (size_t)(t0 + tl) * EVEN_IN + h * 128 + c8);
        u32x4 o; o.x = cvt_pk_bf16(bflo(uv.x) * bflo(mv.x), bfhi(uv.x) * bfhi(mv.x)); o.y = cvt_pk_bf16(bflo(uv.y) * bflo(mv.y), bfhi(uv.y) * bfhi(mv.y));
        o.z = cvt_pk_bf16(bflo(uv.z) * bflo(mv.z), bfhi(uv.z) * bfhi(mv.z)); o.w = cvt_pk_bf16(bflo(uv.w) * bflo(mv.w), bfhi(uv.w) * bfhi(mv.w));
        *(u32x4*)(MIX + (size_t)(t0 + tl) * DM + h * 128 + c8) = o; }
    __syncthreads();
}

__device__ __forceinline__ void router_phase(Frame& F, const bf16_t* x, const float* gain, const float* Wr, const float* br, gu32* cnt  ,
                                             unsigned* tok_er, float* tok_g, unsigned char* XG) {
    LAS float* part = (LAS float*)(F.lds + RING_OFF);
    LAS float* ssqp = (LAS float*)(F.lds + RING_OFF + 8 * 64 * 33 * 4);
    LAS float* lg = (LAS float*)(F.lds + SCR_OFF);
    LAS unsigned* hist = (LAS unsigned*)(F.lds + SCR_OFF + 64 * 33 * 4);
    LAS unsigned* base = hist + 32;
    LAS unsigned* ers = base + 32;
    int tid_ = threadIdx.x; asm volatile("" : "+v"(tid_));
    const int tid = tid_, lane = tid & 63, w = __builtin_amdgcn_readfirstlane(tid >> 6), r32 = lane & 31, hi = lane >> 5;
#ifndef RTR_REP_A
#define RTR_REP_A 1
#define RTR_REP_B 1
#define RTR_REP_C 1
#endif
    f32x4 gg[4];
#pragma unroll
    for (int j = 0; j < 4; ++j) gg[j] = ((const f32x4*)gain + lane)[64 * j];
    {   const int tg = F.vcu;
    const int tokb = tg * 64;
    if (tid < 32) hist[tid] = 0u;
    for (int rb_ = 0; rb_ < RTR_REP_B; ++rb_) {
        bf16x8 wh[8], wl[8];
#pragma unroll
        for (int ks = 0; ks < 8; ++ks) { float wv[8];
#pragma unroll
            for (int j = 0; j < 8; ++j) { const int k = 128 * w + 16 * ks + 8 * hi + j; wv[j] = Wr[(size_t)k * NE + r32] * gain[k]; }
            u32x4 h4, l4;
#pragma unroll
            for (int j = 0; j < 4; ++j) { const unsigned hp = cvt_pk_bf16(wv[2 * j], wv[2 * j + 1]); h4[j] = hp; l4[j] = cvt_pk_bf16(wv[2 * j] - bflo(hp), wv[2 * j + 1] - bfhi(hp)); }
            wh[ks] = __builtin_bit_cast(bf16x8, h4); wl[ks] = __builtin_bit_cast(bf16x8, l4); }
#pragma unroll
        for (int g2 = 0; g2 < 2; ++g2) {
            const bf16_t* xr = x + (size_t)(tokb + 32 * g2 + r32) * DM + 128 * w + 8 * hi;
            f32x16 d = f32x16{}; float ss = 0.f;
#pragma unroll
            for (int ks = 0; ks < 8; ++ks) { const u32x4 xw = *(const u32x4*)(xr + 16 * ks);
#pragma unroll
                for (int j = 0; j < 4; ++j) { const float a = bflo(xw[j]), b = bfhi(xw[j]); ss += a * a + b * b; }
                const bf16x8 xh = __builtin_bit_cast(bf16x8, xw);
                d = __builtin_amdgcn_mfma_f32_32x32x16_bf16(wh[ks], xh, d, 0, 0, 0);
                d = __builtin_amdgcn_mfma_f32_32x32x16_bf16(wl[ks], xh, d, 0, 0, 0); }
            { auto rr = __builtin_amdgcn_permlane32_swap(__float_as_uint(ss), __float_as_uint(ss), false, false); ss = __uint_as_float(rr[0]) + __uint_as_float(rr[1]); }
            if (hi == 0) ssqp[w * 64 + 32 * g2 + r32] = ss;
#pragma unroll
            for (int r = 0; r < 16; ++r) part[(w * 64 + 32 * g2 + r32) * 33 + (r & 3) + 8 * (r >> 2) + 4 * hi] = d[r];
        }
    }
    __syncthreads();
    {   const int t = tid >> 3, q4 = (tid & 7) * 4; float s = 0.f;
#pragma unroll
        for (int ww = 0; ww < 8; ++ww) s += ssqp[ww * 64 + t];
        const float rstd = 1.0f / sqrtf(s * (1.f / DM) + EPS);
#pragma unroll
        for (int i = 0; i < 4; ++i) { float a = 0.f;
#pragma unroll
            for (int ww = 0; ww < 8; ++ww) a += part[(ww * 64 + t) * 33 + q4 + i];
            lg[t * 33 + q4 + i] = a * rstd + br[q4 + i]; } }
    __syncthreads();
    unsigned my_e[4] = {0, 0, 0, 0}, my_lr[4] = {0, 0, 0, 0}; float my_g[4] = {0, 0, 0, 0};
    if (tid < 64) {
        float v[32];
#pragma unroll
        for (int e = 0; e < 32; ++e) v[e] = lg[tid * 33 + e];
        int c0 = -1, c1 = -1, c2 = -1; float tv[4];
#pragma unroll
        for (int r = 0; r < 4; ++r) { float best = -__builtin_inff(); int bi = 0;
#pragma unroll
            for (int e = 0; e < 32; ++e) { const bool ok = (e != c0) && (e != c1) && (e != c2); if (ok && v[e] > best) { best = v[e]; bi = e; } }
            tv[r] = best; my_e[r] = (unsigned)bi; if (r == 0) c0 = bi; else if (r == 1) c1 = bi; else if (r == 2) c2 = bi; }
        const float p1 = __expf(tv[1] - tv[0]), p2 = __expf(tv[2] - tv[0]), p3 = __expf(tv[3] - tv[0]); const float inv = 1.0f / (1.0f + p1 + p2 + p3);
        my_g[0] = inv; my_g[1] = p1 * inv; my_g[2] = p2 * inv; my_g[3] = p3 * inv;
#pragma unroll
        for (int r = 0; r < 4; ++r) my_lr[r] = __hip_atomic_fetch_add(hist + my_e[r], 1u, __ATOMIC_RELAXED, __HIP_MEMORY_SCOPE_WORKGROUP);
    }
    __syncthreads();
    if (tid < 32) { const unsigned hc = hist[tid]; base[tid] = hc ? __hip_atomic_fetch_add(cnt + 64 * tid, hc, RLX_AGENT) : 0u; }
    __syncthreads();
    if (tid < 64) {
        u32x4 er; f32x4 gt;
#pragma unroll
        for (int r = 0; r < 4; ++r) { const unsigned rank = base[my_e[r]] + my_lr[r]; er[r] = (my_e[r] << 16) | rank; gt[r] = my_g[r]; ers[tid * 4 + r] = er[r]; }
        *(u32x4*)(tok_er + (size_t)(tokb + tid) * 4) = er; *(f32x4*)(tok_g + (size_t)(tokb + tid) * 4) = gt;
    }
    __syncthreads();
    for (int rc_ = 0; rc_ < RTR_REP_C; ++rc_)
#pragma unroll 2
    for (int tt = 0; tt < 8; ++tt) {
        const int tl = w * 8 + tt; const bf16_t* xrow = x + (size_t)(tokb + tl) * DM;
        f32x4 hv[4]; float s = 0.f;
#pragma unroll
        for (int j = 0; j < 4; ++j) { const u32x2 t = ((const u32x2*)xrow + lane)[64 * j]; hv[j] = (f32x4){bflo(t.x), bfhi(t.x), bflo(t.y), bfhi(t.y)}; s += (hv[j].x * hv[j].x + hv[j].y * hv[j].y) + (hv[j].z * hv[j].z + hv[j].w * hv[j].w); }
        const float rstd = 1.0f / sqrtf(wave_sum(s) * (1.f / DM) + EPS);
        unsigned wv[4];
#pragma unroll
        for (int j = 0; j < 4; ++j) { const f32x4 t = hv[j] * rstd * gg[j]; wv[j] = pk4_fp8(t.x, t.y, t.z, t.w); }
#pragma unroll
        for (int r = 0; r < 4; ++r) { const unsigned er = ers[tl * 4 + r]; const size_t slot = (size_t)(er >> 16) * ECAP + (er & 0xffffu);
            unsigned* o4 = (unsigned*)(XG + slot * DM) + lane;
#pragma unroll
            for (int j = 0; j < 4; ++j) o4[64 * j] = wv[j]; }
    }
    __syncthreads();
    }
}

__device__ __forceinline__ void combine_phase(Frame& F, bf16_t* x, float* out32  , const unsigned* tok_er, const float* tok_g, const bf16_t* Y, const float* g_next, unsigned char* XN, bool xn_fp8) {
    int tid_ = threadIdx.x; asm volatile("" : "+v"(tid_));
    const int gw = F.vcu * NWAVES + __builtin_amdgcn_readfirstlane(tid_ >> 6), NGW = F.G * NWAVES, lane = tid_ & 63;
    for (int m = gw; m < M; m += NGW) {
        const u32x4 er = *(const u32x4*)(tok_er + (size_t)m * 4); const f32x4 gt = *(const f32x4*)(tok_g + (size_t)m * 4);
        f32x4 v[4]; bf16_t* xrow = x + (size_t)m * DM;
#pragma unroll
        for (int j = 0; j < 4; ++j) { const u32x2 t = ((const u32x2*)xrow + lane)[64 * j]; v[j] = (f32x4){bflo(t.x), bfhi(t.x), bflo(t.y), bfhi(t.y)}; }
#pragma unroll
        for (int r = 0; r < 4; ++r) { const size_t slot = (size_t)(er[r] >> 16) * ECAP + (er[r] & 0xffffu); const u32x2* yp = (const u32x2*)(Y + slot * DM) + lane; const float g = gt[r];
#pragma unroll
            for (int j = 0; j < 4; ++j) { const u32x2 yv = yp[64 * j]; v[j].x += g * bflo(yv.x); v[j].y += g * bfhi(yv.x); v[j].z += g * bflo(yv.y); v[j].w += g * bfhi(yv.y); } }
#pragma unroll
        for (int j = 0; j < 4; ++j) { if (out32) ((f32x4*)(out32 + (size_t)m * DM) + lane)[64 * j] = v[j];
            else { u32x2 t; t.x = cvt_pk_bf16(v[j].x, v[j].y); t.y = cvt_pk_bf16(v[j].z, v[j].w); ((u32x2*)xrow + lane)[64 * j] = t; } }
        if (g_next) {
            float s = 0.f;
#pragma unroll
            for (int j = 0; j < 4; ++j) s += (v[j].x * v[j].x + v[j].y * v[j].y) + (v[j].z * v[j].z + v[j].w * v[j].w);
            const float rstd = 1.0f / sqrtf(wave_sum(s) * (1.f / DM) + EPS);
            unsigned* o4 = (unsigned*)(XN + (size_t)m * DM) + lane; u32x2* o8 = (u32x2*)(XN + (size_t)m * DM * 2) + lane;
#pragma unroll
            for (int j = 0; j < 4; ++j) { const f32x4 gg = ((const f32x4*)g_next + lane)[64 * j];
                if (xn_fp8) o4[64 * j] = pk4_fp8(v[j].x * rstd * gg.x, v[j].y * rstd * gg.y, v[j].z * rstd * gg.z, v[j].w * rstd * gg.w);
                else { u32x2 w; w.x = cvt_pk_bf16(v[j].x * rstd * gg.x, v[j].y * rstd * gg.y); w.y = cvt_pk_bf16(v[j].z * rstd * gg.z, v[j].w * rstd * gg.w); o8[64 * j] = w; } }
        }
    }
}

__device__ __forceinline__ void unpack8(const u32x4 w, float (&f)[8]) { f[0] = bflo(w.x); f[1] = bfhi(w.x); f[2] = bflo(w.y); f[3] = bfhi(w.y); f[4] = bflo(w.z); f[5] = bfhi(w.z); f[6] = bflo(w.w); f[7] = bfhi(w.w); }
__device__ __forceinline__ void unpack4(const u32x2 w, float (&f)[4]) { f[0] = bflo(w.x); f[1] = bfhi(w.x); f[2] = bflo(w.y); f[3] = bfhi(w.y); }
__device__ __forceinline__ void fin_head(const u32x4 n0, const u32x4 n1, const u32x2 r1, const u32x2 r2, const float (&g)[24], const float (&cs)[4], const float (&sn)[4], unsigned char* op, int j) {
    float a[8], b[8], x1[4], x2[4];
    unpack8(n0, a); unpack8(n1, b); unpack4(r1, x1); unpack4(r2, x2);
    float ss = 0.f;
#pragma unroll
    for (int i = 0; i < 8; ++i) ss += a[i] * a[i] + b[i] * b[i];
#pragma unroll
    for (int i = 0; i < 4; ++i) ss += x1[i] * x1[i] + x2[i] * x2[i];
    ss += __shfl_xor(ss, 1); ss += __shfl_xor(ss, 2); ss += __shfl_xor(ss, 4);
    const float rstd = 1.0f / sqrtf(ss * (1.0f / 192.0f) + EPS);
    u32x4 o0;
    o0.x = pk4_fp8(a[0] * rstd * g[0], a[1] * rstd * g[1], a[2] * rstd * g[2], a[3] * rstd * g[3]); o0.y = pk4_fp8(a[4] * rstd * g[4], a[5] * rstd * g[5], a[6] * rstd * g[6], a[7] * rstd * g[7]);
    o0.z = pk4_fp8(b[0] * rstd * g[8], b[1] * rstd * g[9], b[2] * rstd * g[10], b[3] * rstd * g[11]); o0.w = pk4_fp8(b[4] * rstd * g[12], b[5] * rstd * g[13], b[6] * rstd * g[14], b[7] * rstd * g[15]);
    float y1[4], y2[4];
#pragma unroll
    for (int i = 0; i < 4; ++i) { const float u = x1[i] * rstd * g[16 + i], v = x2[i] * rstd * g[20 + i]; y1[i] = u * cs[i] - v * sn[i]; y2[i] = u * sn[i] + v * cs[i]; }
    *(u32x4*)(op + 16 * j) = o0; *(unsigned*)(op + 128 + 4 * j) = pk4_fp8(y1[0], y1[1], y1[2], y1[3]); *(unsigned*)(op + 160 + 4 * j) = pk4_fp8(y2[0], y2[1], y2[2], y2[3]);
}
__device__ __forceinline__ void mla_finalize_phase(Frame& F, const bf16_t* QR, const bf16_t* KVR, const bf16_t* Z, const float* gq, const float* gk, unsigned char* QF, unsigned char* KF) {
    int tid_ = threadIdx.x; asm volatile("" : "+v"(tid_));
    const int gw = F.vcu * NWAVES + __builtin_amdgcn_readfirstlane(tid_ >> 6), NGW = F.G * NWAVES, lane = tid_ & 63;
    const int h = lane >> 3, j = lane & 7;
    float gqv[24], gkv[24], invf[4];
#pragma unroll
    for (int i = 0; i < 16; ++i) { gqv[i] = gq[16 * j + i]; gkv[i] = gk[16 * j + i]; }
#pragma unroll
    for (int i = 0; i < 4; ++i) { gqv[16 + i] = gq[128 + 4 * j + i]; gqv[20 + i] = gq[160 + 4 * j + i]; gkv[16 + i] = gk[128 + 4 * j + i]; gkv[20 + i] = gk[160 + 4 * j + i];
        invf[i] = __builtin_amdgcn_exp2f(-(float)(4 * j + i) * (13.287712379549449f / 32.0f)); }
#pragma unroll 2
    for (int m = gw; m < M; m += NGW) {
        const int pos = m & (SEQ - 1);
        float cs[4], sn[4];
#pragma unroll
        for (int i = 0; i < 4; ++i) { const double rev = (double)pos * (double)invf[i] * 0.15915494309189535; const float fr = (float)(rev - __builtin_rint(rev));
            sn[i] = __builtin_amdgcn_sinf(fr); cs[i] = __builtin_amdgcn_cosf(fr); }
        const bf16_t* qp = QR + (size_t)m * 1536 + h * 192; const bf16_t* kp = KVR + (size_t)m * 2048 + h * 256; const bf16_t* zp = Z + (size_t)m * ODD_INP + 768;
        const u32x4 qn0 = *(const u32x4*)(qp + 16 * j), qn1 = *(const u32x4*)(qp + 16 * j + 8); const u32x2 qr1 = *(const u32x2*)(qp + 128 + 4 * j), qr2 = *(const u32x2*)(qp + 160 + 4 * j);
        const u32x4 kn0 = *(const u32x4*)(kp + 16 * j), kn1 = *(const u32x4*)(kp + 16 * j + 8); const u32x2 kr1 = *(const u32x2*)(zp + 4 * j), kr2 = *(const u32x2*)(zp + 32 + 4 * j);
        fin_head(qn0, qn1, qr1, qr2, gqv, cs, sn, QF + (size_t)m * 1536 + h * 192, j);
        fin_head(kn0, kn1, kr1, kr2, gkv, cs, sn, KF + (size_t)m * 1536 + h * 192, j);
    }
}

__device__ __forceinline__ void vt_phase(Frame& F, const bf16_t* KVR, unsigned char* VT8) {
    int tid_ = threadIdx.x; asm volatile("" : "+v"(tid_));
    const int tid = tid_;
    LAS unsigned char* T = F.lds + RING_OFF;
    for (int it = F.vcu; it < M / 64; it += F.G) {
        const int m0 = it * 64, b = m0 / SEQ, tok0 = m0 % SEQ;
#pragma unroll 4
        for (int k = 0; k < 16; ++k) { const int idx = tid + 512 * k, tok = idx >> 7, grp = idx & 127, h = grp >> 4, d8 = (grp & 15) * 8;
            const u32x4 w = *(const u32x4*)(KVR + (size_t)(m0 + tok) * 2048 + h * 256 + 128 + d8);
            const unsigned lo = pk4_fp8(bflo(w.x), bfhi(w.x), bflo(w.y), bfhi(w.y)), hi = pk4_fp8(bflo(w.z), bfhi(w.z), bflo(w.w), bfhi(w.w));
            LAS unsigned char* tp = T + (h * 128 + d8) * 80 + tok;
            tp[0] = (unsigned char)lo; tp[80] = (unsigned char)(lo >> 8); tp[160] = (unsigned char)(lo >> 16); tp[240] = (unsigned char)(lo >> 24);
            tp[320] = (unsigned char)hi; tp[400] = (unsigned char)(hi >> 8); tp[480] = (unsigned char)(hi >> 16); tp[560] = (unsigned char)(hi >> 24); }
        __syncthreads();
#pragma unroll 4
        for (int k = 0; k < 8; ++k) { const int idx = tid + 512 * k, row = idx >> 2, q = idx & 3;
            const u32x4 v = *(const LAS u32x4*)(T + row * 80 + 16 * q);
            *(u32x4*)(VT8 + ((size_t)b * 1024 + row) * SEQ + tok0 + 16 * q) = v; }
        __syncthreads();
    }
}

#ifndef PHMASK
#define PHMASK 0xFFFF
#endif
#ifndef REPMASK
#define REPMASK 0
#endif
#ifndef REPCNT
#define REPCNT 3
#endif
#define NREP(k) ((((REPMASK) >> (k)) & 1) ? (REPCNT) : 1)

#define LAUNDER_S(x) asm volatile("" : "+s"(x))
__device__ __forceinline__ const float* in_ptr(const Args& a, int i) { LAUNDER_S(i); return a.in[i]; }
#define PHASE_BEGIN() unsigned wso_ = 0u; LAUNDER_S(wso_); unsigned char* ws = args.ws + wso_; Frame Fp = F; Fp.vcu = __builtin_amdgcn_readfirstlane(Fp.vcu); Fp.G = __builtin_amdgcn_readfirstlane(Fp.G); LAUNDER_S(Fp.vcu); LAUNDER_S(Fp.G); \
    int bx_ = __builtin_amdgcn_readfirstlane((int)blockIdx.x); LAUNDER_S(bx_); (void)bx_; (void)ws
#define XN  ((unsigned char*)(ws + WS_XN))
#define Z   ((bf16_t*)(ws + WS_Z))
#define MIX ((bf16_t*)(ws + WS_MIX))
#define QR  ((bf16_t*)(ws + WS_QR))
#define KVR ((bf16_t*)(ws + WS_KVR))
#define QF  ((unsigned char*)(ws + WS_QF))
#define KF  ((unsigned char*)(ws + WS_KF))
#define XG  ((unsigned char*)(ws + WS_XG))
#define ACT ((unsigned char*)(ws + WS_ACT))
#define YB  ((bf16_t*)(ws + WS_Y))
#define SSQ ((float*)(ws + WS_SSQ))
#define TOKER ((unsigned*)(ws + WS_TOKER))
#define TOKG ((float*)(ws + WS_TOKG))
#define B1P ((float*)(ws + WS_B1P))
#define IN(i) in_ptr(args, (i))
__global__ void __launch_bounds__(NWAVES * 64, 2) trunk_fwd(Args args) {
    extern __shared__ __attribute__((aligned(16))) unsigned char lds_raw[];
    Frame F;
    F.lds = (LAS unsigned char*)lds_raw;
    F.G = gridDim.x; { const int bx = blockIdx.x; F.vcu = (F.G % 8 == 0) ? (bx % 8) * (F.G / 8) + bx / 8 : bx; }
    for (int u = threadIdx.x; u < (SCR_OFF - LDSCTL_OFF) / 4; u += NWAVES * 64) ((LAS unsigned*)(F.lds + LDSCTL_OFF))[u] = 0u;
    __syncthreads();
    (void)xcd_barrier_post((unsigned*)((gu32*)(args.ws + WS_CTL) + CW_BAR), (volatile LAS unsigned*)(F.lds + MISC_OFF) + 8);
#define GRID_BAR() do { unsigned wsb_ = 0u; LAUNDER_S(wsb_); XcdBarrier bar_; bar_.bar = (unsigned*)((gu32*)(args.ws + wsb_ + WS_CTL) + CW_BAR); bar_.x = xb_xcc_id(); \
        bar_.st = (volatile LAS unsigned*)(F.lds + MISC_OFF) + 8; xcd_barrier(bar_); } while (0)
#define X16 ((bf16_t*)(ws + WS_X16))
    const int stage_limit = args.stage_limit;

#if (PHMASK >> 0) & 1
            _Pragma("unroll") for (int rep_ = 0; rep_ < NREP(0); ++rep_) { if (rep_) GRID_BAR();
    {   PHASE_BEGIN(); const int ptid = threadIdx.x, gw = Fp.vcu * NWAVES + __builtin_amdgcn_readfirstlane(ptid >> 6), NGW = Fp.G * NWAVES;
        transpose_job<1>(Fp, IN(I_EWIN), DM, EVEN_IN, 2, (size_t)DM * EVEN_IN, (bf16_t*)(ws + WS_WEIN), (size_t)EVEN_IN * DM, nullptr, 0);
        transpose_job<0>(Fp, IN(I_EWOUT), DM, DM, 2, (size_t)DM * DM, (bf16_t*)(ws + WS_WEOUT), (size_t)DM * DM, nullptr, 0);
        transpose_job_fp8<0>(Fp, IN(I_OWIN), DM, ODD_IN, 2, (size_t)DM * ODD_IN, ws + WS_WOIN, (size_t)ODD_INP * DM);
        transpose_job_fp8<0>(Fp, IN(I_OWUQ), 512, 1536, 2, (size_t)512 * 1536, ws + WS_WUQ, (size_t)1536 * 512, IN(I_OGCQ), 512);
        transpose_job_fp8<0>(Fp, IN(I_OWUKV), 256, 2048, 2, (size_t)256 * 2048, ws + WS_WUKV, (size_t)2048 * 256, IN(I_OGCKV), 256);
        transpose_job_fp8<0>(Fp, IN(I_OWOUT), DM, DM, 2, (size_t)DM * DM, ws + WS_WOOUT, (size_t)DM * DM);
        transpose_job_fp8<2>(Fp, IN(I_W1), DM, 2 * DE, DEPTH * NE, (size_t)DM * 2 * DE, ws + WS_W1, (size_t)2 * DE * DM);
        transpose_job_fp8<0>(Fp, IN(I_W2), DE, DM, DEPTH * NE, (size_t)DE * DM, ws + WS_W2, (size_t)DM * DE);
        for (int i = bx_ * 512 + ptid; i < 2 * 12288; i += Fp.G * 512) { const int mi = i / 12288, r = i % 12288;
            *(u32x4*)(ws + WS_WOIN + (size_t)mi * ODD_INP * DM + (size_t)ODD_IN * DM + (size_t)r * 16) = (u32x4){0u, 0u, 0u, 0u}; }
        for (int i = bx_ * 512 + ptid; i < DEPTH * NE * 2048; i += Fp.G * 512) { const int c = i & 2047, o = 2 * (128 * (c >> 8) + (c & 127)) + ((c >> 7) & 1);
            B1P[i] = IN(I_B1)[(size_t)(i & ~2047) + o]; }
        for (int m = gw; m < M; m += NGW) rms_row_to_bf16(ptid & 63, IN(I_X) + (size_t)m * DM, IN(I_MIXN), (bf16_t*)XN + (size_t)m * DM, nullptr);
    }
            }
#endif
    GRID_BAR();

#ifdef EXTRA_BARS
    for (int xb_ = 0; xb_ < EXTRA_BARS; ++xb_) GRID_BAR();
#endif
    for (int l = 0; l < DEPTH; ++l) {
        const int li = l >> 1;
        if (2 * l + 1 > stage_limit) break;
        if ((l & 1) == 0) {
#if (PHMASK >> 1) & 1
            _Pragma("unroll") for (int rep_ = 0; rep_ < NREP(1); ++rep_) { if (rep_) GRID_BAR();
            {   PHASE_BEGIN(); pg8::Gemm g{(const bf16_t*)XN, (const bf16_t*)(ws + WS_WEIN) + (size_t)li * EVEN_IN * DM, DM, DM, nullptr, nullptr}; pg8::StaticOrder S; S.init(M, EVEN_IN, Fp.G, bx_);
                pg8::EpiEvenIn E{Z, IN(I_EGQ) + li * 64, IN(I_EGK) + li * 64};
                pg8::gemm_phase<pg8::EpiEvenIn, pg8::StaticOrder>(Fp.lds + RING_OFF, g, S, E); }
            }
#endif
            GRID_BAR();
            {   PHASE_BEGIN();
#if (PHMASK >> 2) & 1
            _Pragma("unroll") for (int rep_ = 0; rep_ < NREP(2); ++rep_) { if (rep_) GRID_BAR();
                for (int u = Fp.vcu; u < 512; u += Fp.G)
                    gmlp_unit(Fp, Z, MIX, IN(I_EWS) + (size_t)li * 4 * 128 * 128, IN(I_EBS) + li * 512, IN(I_EGV) + li * 512, u);
            }
#endif
#if (PHMASK >> 3) & 1
            _Pragma("unroll") for (int rep_ = 0; rep_ < NREP(3); ++rep_) { if (rep_) GRID_BAR();
                for (int u = Fp.vcu; u < 256; u += Fp.G) { const int bh = u >> 4, s = u & 15, b = bh >> 3, h = bh & 7;
                    for (int pass = 0; pass < 2; ++pass) { const int qb = pass ? 31 - s : s;
                        const bf16_t* zb = Z + (size_t)b * SEQ * EVEN_IN;
                        dil::unit(zb + 1024 + 64 * h, zb + 1536 + 64 * h, zb + 2048 + 64 * h, EVEN_IN, MIX + (size_t)b * SEQ * DM + 512 + 64 * h, DM, qb * 256, Fp.lds + RING_OFF, (LAS float*)(Fp.lds + SCR_OFF)); } }
            }
#endif
            }
            GRID_BAR();
#if (PHMASK >> 4) & 1
            _Pragma("unroll") for (int rep_ = 0; rep_ < NREP(4); ++rep_) { if (rep_) GRID_BAR();
            {   PHASE_BEGIN(); pg8::Gemm g{MIX, (const bf16_t*)(ws + WS_WEOUT) + (size_t)li * DM * DM, DM, DM, nullptr, nullptr}; pg8::StaticOrder S; S.init(M, DM, Fp.G, bx_);
                pg8::EpiResid E{l == 0 ? IN(I_X) : nullptr, X16};
                pg8::gemm_phase<pg8::EpiResid, pg8::StaticOrder>(Fp.lds + RING_OFF, g, S, E); }
            }
#endif
            GRID_BAR();
        } else {
#if (PHMASK >> 5) & 1
            _Pragma("unroll") for (int rep_ = 0; rep_ < NREP(5); ++rep_) { if (rep_) GRID_BAR();
            {   PHASE_BEGIN(); pg8::Gemm g{(const bf16_t*)XN, (const bf16_t*)(ws + WS_WOIN + (size_t)li * ODD_INP * DM), DM / 2, DM / 2, nullptr, nullptr}; pg8::StaticOrder S; S.init(M, ODD_INP, Fp.G, bx_);
                pg8::EpiOddIn E{Z, ws + WS_Z8, SSQ};
                pg8::gemm_phase<pg8::EpiOddIn, pg8::StaticOrder, true>(Fp.lds + RING_OFF, g, S, E); }
            }
#endif
            GRID_BAR();
#if (PHMASK >> 6) & 1
            _Pragma("unroll") for (int rep_ = 0; rep_ < NREP(6); ++rep_) { if (rep_) GRID_BAR();
            {   PHASE_BEGIN(); pg8::Gemm g{(const bf16_t*)(ws + WS_Z8 + 512), (const bf16_t*)(ws + WS_WUKV + (size_t)li * 2048 * 256), ODD_INP / 2, 128, nullptr, nullptr}; pg8::StaticOrder S; S.init(M, 2048, Fp.G, bx_);
                pg8::EpiRowScale<1> E{KVR, 2048, SSQ, 8, 1.0f / 256.0f};
                pg8::gemm_phase<pg8::EpiRowScale<1>, pg8::StaticOrder, true>(Fp.lds + RING_OFF, g, S, E); }
            {   PHASE_BEGIN(); pg8::Gemm g{(const bf16_t*)(ws + WS_Z8), (const bf16_t*)(ws + WS_WUQ + (size_t)li * 1536 * 512), ODD_INP / 2, 256, nullptr, nullptr}; pg8::StaticOrder S; S.init(M, 1536, Fp.G, bx_);
                pg8::EpiRowScale<2> E{QR, 1536, SSQ, 0, 1.0f / 512.0f};
                pg8::gemm_phase<pg8::EpiRowScale<2>, pg8::StaticOrder, true>(Fp.lds + RING_OFF, g, S, E); }
            }
#endif
            GRID_BAR();
#if (PHMASK >> 7) & 1
            _Pragma("unroll") for (int rep_ = 0; rep_ < NREP(7); ++rep_) { if (rep_) GRID_BAR();
            {   PHASE_BEGIN(); mla_finalize_phase(Fp, QR, KVR, Z, IN(I_OGQ) + li * 192, IN(I_OGK) + li * 192, QF, KF); vt_phase(Fp, KVR, ws + WS_VT); }
            }
#endif
            GRID_BAR();
#if (PHMASK >> 8) & 1
            _Pragma("unroll") for (int rep_ = 0; rep_ < NREP(8); ++rep_) { if (rep_) GRID_BAR();
            {   PHASE_BEGIN();
                for (int u = Fp.vcu; u < 256; u += Fp.G) { const int bh = u >> 4, s = u & 15, b = bh >> 3, h = bh & 7;
                    for (int pass = 0; pass < 2; ++pass) { const int qb = pass ? 31 - s : s;
                        mla::unit(QF + (size_t)b * SEQ * 1536 + 192 * h, KF + (size_t)b * SEQ * 1536 + 192 * h, 1536, ws + WS_VT + ((size_t)(b * 8 + h) * 128) * SEQ,
                                  ws + WS_MIX8 + (size_t)b * SEQ * DM + 128 * h, DM, qb * 256, Fp.lds + RING_OFF); } }
            }
            }
#endif
            GRID_BAR();
#if (PHMASK >> 9) & 1
            _Pragma("unroll") for (int rep_ = 0; rep_ < NREP(9); ++rep_) { if (rep_) GRID_BAR();
            {   PHASE_BEGIN(); pg8::Gemm g{(const bf16_t*)(ws + WS_MIX8), (const bf16_t*)(ws + WS_WOOUT + (size_t)li * DM * DM), DM / 2, DM / 2, nullptr, nullptr}; pg8::StaticOrder S; S.init(M, DM, Fp.G, bx_);
                pg8::EpiResidT<true> E{nullptr, X16};
                pg8::gemm_phase<pg8::EpiResidT<true>, pg8::StaticOrder, true>(Fp.lds + RING_OFF, g, S, E); }
            }
#endif
            GRID_BAR();
        }
        if (2 * l + 2 > stage_limit) break;
#if (PHMASK >> 10) & 1
            _Pragma("unroll") for (int rep_ = 0; rep_ < NREP(10); ++rep_) {
        {   PHASE_BEGIN(); const bool dry = rep_ + 1 < NREP(10);
            gu32* cnt = (gu32*)(ws + WS_CTL) + CW_CNT + (size_t)(dry ? 8 + 4 * rep_ + l : l) * 32 * 64;
        router_phase(Fp, X16, IN(I_FFNN) + l * DM, IN(I_RW) + (size_t)l * DM * NE, IN(I_RB) + l * NE, cnt, dry ? (unsigned*)(ws + WS_QR) : TOKER, dry ? (float*)(ws + WS_QR + MiB) : TOKG, dry ? ACT : XG); }
        GRID_BAR();
            }
#endif
        LAS int* tbl = (LAS int*)(F.lds + SCR_OFF + 12288);
        {   PHASE_BEGIN(); gu32* cnt = (gu32*)(ws + WS_CTL) + CW_CNT + (size_t)l * 32 * 64;
        if (threadIdx.x == 0) { int acc = 0; for (int e = 0; e < NE; ++e) { tbl[e] = acc; const unsigned c = __hip_atomic_load(cnt + 64 * e, RLX_AGENT); acc += (int)((c + 255u) >> 8); } tbl[NE] = acc; }
        __syncthreads(); }
#if (PHMASK >> 11) & 1
            _Pragma("unroll") for (int rep_ = 0; rep_ < NREP(11); ++rep_) { if (rep_) GRID_BAR();
        {   PHASE_BEGIN();
            pg8::Gemm g{(const bf16_t*)XG, (const bf16_t*)(ws + WS_W1 + (size_t)l * NE * 2 * DE * DM), DM / 2, DM / 2, (const bf16_t*)ACT, (const bf16_t*)(ws + WS_W2 + (size_t)l * NE * DM * DE)};
            pg8::MoeMergedOrder S{tbl, Fp.G, Fp.vcu, (gu32*)(ws + WS_CTL) + CW_MOE + (size_t)(l * 320 + 1280 * rep_) * 16, -1};
            pg8::EpiMoe E{{ACT, B1P + (size_t)l * NE * 2048}, {YB, IN(I_B2) + (size_t)l * NE * DM}};
            pg8::gemm_phase<pg8::EpiMoe, pg8::MoeMergedOrder, true>(Fp.lds + RING_OFF, g, S, E); }
            }
#endif
        GRID_BAR();
#if (PHMASK >> 13) & 1
            _Pragma("unroll") for (int rep_ = 0; rep_ < NREP(13); ++rep_) {
        {   PHASE_BEGIN(); const bool dry = rep_ + 1 < NREP(13);
            combine_phase(Fp, dry ? (bf16_t*)(ACT + (size_t)128 * MiB) : X16, (!dry && l + 1 == DEPTH) ? args.out : nullptr, TOKER, TOKG, YB, (l + 1 < DEPTH) ? IN(I_MIXN) + (l + 1) * DM : nullptr, dry ? (ACT + (size_t)64 * MiB) : XN, (l & 1) == 0); }
        GRID_BAR();
            }
#endif
    }
#undef GRID_BAR
}

extern "C" void kernel_launch(void* const* d_in, const int* in_sizes, int n_in, void* d_out, int out_size, void* d_ws, size_t ws_size, hipStream_t stream) {
    static int grid = 0;
    if (grid == 0) {
        if (n_in != 24 || in_sizes[0] != M * DM || out_size != M * DM || ws_size < WS_END) {
            fprintf(stderr, "kernel_launch: unexpected shapes (n_in %d, in0 %d, out %d, ws %zu, need %zu)\n", n_in, n_in > 0 ? in_sizes[0] : -1, out_size, ws_size, (size_t)WS_END); grid = -1; return; }
        int dev = 0, cus = 0, per_cu = 0;
        if (hipGetDevice(&dev) != hipSuccess || hipDeviceGetAttribute(&cus, hipDeviceAttributeMultiprocessorCount, dev) != hipSuccess) { grid = -1; return; }
        if (hipFuncSetAttribute((const void*)trunk_fwd, hipFuncAttributeMaxDynamicSharedMemorySize, LDS_BYTES) != hipSuccess) { fprintf(stderr, "kernel_launch: hipFuncSetAttribute failed\n"); grid = -1; return; }
        if (hipOccupancyMaxActiveBlocksPerMultiprocessor(&per_cu, (const void*)trunk_fwd, NWAVES * 64, LDS_BYTES) != hipSuccess || per_cu < 1)
            fprintf(stderr, "kernel_launch: occupancy query reports %d workgroups per CU\n", per_cu);
        (void)hipGetLastError();
        if (cus < 256) { fprintf(stderr, "kernel_launch: needs 256 CUs, device has %d\n", cus); grid = -1; return; }
        grid = 256;
    }
    if (grid < 0) return;
    if (hipMemsetAsync((char*)d_ws + WS_CTL, 0, CTL_ZERO_BYTES, stream) != hipSuccess) return;
    Args a{};
    for (int i = 0; i < 24; ++i) a.in[i] = (const float*)d_in[i];
    a.out = (float*)d_out; a.ws = (unsigned char*)d_ws; a.stage_limit = STAGE_LIMIT; a.pad = 0;
    hipLaunchKernelGGL(trunk_fwd, dim3(grid), dim3(NWAVES * 64), LDS_BYTES, stream, a);
}
```

```cpp
#include <hip/hip_runtime.h>
#include <hip/hip_bf16.h>
#include <cstdio>
#include <cstdint>

#define LAS __attribute__((address_space(3)))
#define GAS __attribute__((address_space(1)))
typedef unsigned short bf16_t;
typedef short bf16x8 __attribute__((ext_vector_type(8)));
typedef short s16x4 __attribute__((ext_vector_type(4)));
typedef float f32x2 __attribute__((ext_vector_type(2)));
typedef float f32x4 __attribute__((ext_vector_type(4)));
typedef float f32x16 __attribute__((ext_vector_type(16)));
typedef unsigned u32x2 __attribute__((ext_vector_type(2)));
typedef unsigned u32x4 __attribute__((ext_vector_type(4)));
typedef int i32x4 __attribute__((ext_vector_type(4)));
typedef int i32x8 __attribute__((ext_vector_type(8)));

constexpr int BATCH = 2, SEQ = 8192, DM = 1024, M = BATCH * SEQ, DEPTH = 4;
constexpr int EVEN_IN = 2560, ODD_IN = 832, ODD_INP = 1024;
constexpr int NE = 32, DE = 1024, ECAP = 16384;
constexpr float EPS = 1e-6f;
constexpr float LOG2E = 1.4426950408889634f;
constexpr float C2_B = 0.125f * LOG2E;
constexpr float C2_C = 0.07216878364870322f * LOG2E;

__device__ __forceinline__ unsigned cvt_pk_bf16(float lo, float hi) { unsigned r; asm volatile("v_cvt_pk_bf16_f32 %0, %1, %2" : "=v"(r) : "v"(lo), "v"(hi)); return r; }
__device__ __forceinline__ float bf2f(bf16_t v) { return __uint_as_float(((unsigned)v) << 16); }
__device__ __forceinline__ float bflo(unsigned w) { return __uint_as_float(w << 16); }
__device__ __forceinline__ float bfhi(unsigned w) { return __uint_as_float(w & 0xffff0000u); }
__device__ __forceinline__ bf16_t f2bf(float f) { return (bf16_t)(cvt_pk_bf16(f, 0.f) & 0xffffu); }

__device__ __forceinline__ unsigned pk4_fp8(float a, float b, float c, float d) { int w = 0; w = __builtin_amdgcn_cvt_pk_fp8_f32(a, b, w, false); w = __builtin_amdgcn_cvt_pk_fp8_f32(c, d, w, true); return (unsigned)w; }
constexpr float W8_SCALE = 64.0f, W8_INV = 1.0f / 64.0f;

namespace pg8 {
constexpr int BM = 256, BK = 64, HALF = 128, HTB = HALF * BK * 2, STAGE_BYTES = 8 * HTB, NXCD = 8, WGM = 8;
__host__ __device__ __forceinline__ int lds_byte(int r, int c) { const int st = (r >> 4) * 2 + (c >> 5), rr = r & 15, cc = c & 31, ob = rr * 64 + cc * 2; return st * 1024 + (ob ^ (((ob >> 9) & 1) << 5)); }
__host__ __device__ __forceinline__ void stage_rc(int b, int& R, int& C) { const int st = b / 1024, sb = b % 1024, swz = sb ^ (((sb >> 9) & 1) << 5); R = (st >> 1) * 16 + swz / 64; C = (st & 1) * 32 + (swz % 64) / 2; }
__host__ __device__ __forceinline__ int perm32(int rho) { const int n = rho >> 4, i = rho & 15; return 8 * (i >> 2) + 4 * n + (i & 3); }

struct Unit { int pm, pn, pb, kind, rb; };
struct Gemm { const bf16_t* A; const bf16_t* Bt; int lda, K; const bf16_t* A2; const bf16_t* Bt2; };

struct StaticOrder {
    int nM, nN, nwg, G, c;
    __device__ void init(int M_, int N_, int G_, int c_) { nM = M_ / BM; nN = N_ / BM; nwg = nM * nN; G = G_; c = c_; }
    __device__ bool next(int i, Unit& u) const {
        const long L = (long)i * G + c; if (L >= nwg) return false;
        int wgid = (int)L; { const int q = nwg / NXCD, r = nwg % NXCD, xcd = wgid % NXCD, off = wgid / NXCD; wgid = (xcd < r ? xcd * (q + 1) : r * (q + 1) + (xcd - r) * q) + off; }
        const int nig = WGM * nN, gid = wgid / nig, fm = gid * WGM, gsz = (nM - fm) < WGM ? (nM - fm) : WGM;
        u.pm = fm + ((wgid % nig) % gsz); u.pn = (wgid % nig) / gsz; u.pb = u.pn; u.kind = 0; u.rb = 0; return true;
    }
    __device__ __forceinline__ void a_ready(const Unit&) const {}
    __device__ __forceinline__ void pre_epi() const {}
    __device__ __forceinline__ void done(const Unit&) const {}
    __device__ __forceinline__ void finish() const {}
};

__device__ __forceinline__ f32x2 gelu_pk(f32x2 v) {
    const f32x2 av = __builtin_elementwise_abs(v), d = av * 0.2316418882f + 1.0f;
    f32x2 t; t.x = __builtin_amdgcn_rcpf(d.x); t.y = __builtin_amdgcn_rcpf(d.y);
    f32x2 q = t * 0.5307027145f + (-0.7265760135f); q = q * t + 0.7107068705f; q = q * t + (-0.142248368f); q = q * t + 0.127414796f; q = q * t;
    const f32x2 s = (v * v) * (-0.72134752044f);
    f32x2 e; e.x = __builtin_amdgcn_exp2f(s.x); e.y = __builtin_amdgcn_exp2f(s.y);
    const f32x2 m = v * (q * e), r = v - m;
    f32x2 o; o.x = v.x < 0.f ? m.x : r.x; o.y = v.y < 0.f ? m.y : r.y; return o;
}
__device__ __forceinline__ f32x4 gelu4(f32x4 v) { const f32x2 a = gelu_pk((f32x2){v[0], v[1]}), b = gelu_pk((f32x2){v[2], v[3]}); return (f32x4){a.x, a.y, b.x, b.y}; }

template <class Epi, class Sched, bool FP8 = false>
__device__ __forceinline__ void gemm_phase(LAS unsigned char* lds, const Gemm g, const Sched& S, const Epi& E) {
    int tid_ = threadIdx.x; asm volatile("" : "+v"(tid_));
    const int tid = tid_, wid = __builtin_amdgcn_readfirstlane(tid >> 6), lane = tid & 63, wr = wid >> 2, wc = wid & 3, fr = lane & 15, fq = lane >> 4;
    const int K = g.K, nt = K / BK;
    unsigned voffA[2], voffB[2];
#pragma unroll
    for (int i = 0; i < 2; ++i) { int R, C; stage_rc(tid * 16 + i * 8192, R, C); const int Rb = Epi::PERM ? ((R & ~31) + perm32(R & 31)) : R;
        voffA[i] = (unsigned)(R * g.lda + C) * 2u; voffB[i] = (unsigned)(Rb * K + C) * 2u; }
    const size_t kstep = (size_t)(BK * 2);
    const size_t hstepA = (size_t)HALF * g.lda * 2, tstepA = 2 * hstepA;
    const size_t hstepB = (size_t)HALF * K * 2, tstepB = 2 * hstepB;
    const unsigned ldsw = (unsigned)wid * 1024u;
    const int aoff = lds_byte(wr * 64 + fr, fq * 8), boff = lds_byte(wc * 32 + fr, fq * 8);
#define PG8_SA(b, h) (((b) * 2 + (h)) * HTB)
#define PG8_SB(b, h) ((4 + (b) * 2 + (h)) * HTB)
#define PG8_STAGE(bufoff, gbase, voff) do { _Pragma("unroll") for (int _i = 0; _i < 2; ++_i) \
        __builtin_amdgcn_global_load_lds((const unsigned*)((const char*)(gbase) + (voff)[_i]), (LAS unsigned*)(lds + (bufoff) + ldsw + _i * 8192), 16, 0, 0); } while (0)
#define PG8_LDA(dst, b, h) do { _Pragma("unroll") for (int m = 0; m < 4; ++m) { if constexpr (FP8) { const i32x4 lo_ = *(const LAS i32x4*)(lds + PG8_SA(b, h) + aoff + m * 2048), hi_ = *(const LAS i32x4*)(lds + PG8_SA(b, h) + aoff + m * 2048 + 1024); dst##8[m] = __builtin_shufflevector(lo_, hi_, 0, 1, 2, 3, 4, 5, 6, 7); } \
        else { _Pragma("unroll") for (int k = 0; k < 2; ++k) dst[m][k] = *(const LAS bf16x8*)(lds + PG8_SA(b, h) + aoff + m * 2048 + k * 1024); } } } while (0)
#define PG8_LDB(dst, b, h) do { _Pragma("unroll") for (int n = 0; n < 2; ++n) { if constexpr (FP8) { const i32x4 lo_ = *(const LAS i32x4*)(lds + PG8_SB(b, h) + boff + n * 2048), hi_ = *(const LAS i32x4*)(lds + PG8_SB(b, h) + boff + n * 2048 + 1024); dst##8[n] = __builtin_shufflevector(lo_, hi_, 0, 1, 2, 3, 4, 5, 6, 7); } \
        else { _Pragma("unroll") for (int k = 0; k < 2; ++k) dst[n][k] = *(const LAS bf16x8*)(lds + PG8_SB(b, h) + boff + n * 2048 + k * 1024); } } } while (0)
#define PG8_MMA(ai, bj, At, Bt) do { __builtin_amdgcn_s_setprio(1); _Pragma("unroll") for (int m = 0; m < 4; ++m) _Pragma("unroll") for (int n = 0; n < 2; ++n) { \
        if constexpr (FP8) asm volatile("s_nop 1\n\tv_mfma_f32_16x16x128_f8f6f4 %0, %1, %2, %0" : "+v"(acc[ai][bj][m][n]) : "v"(Bt##8[n]), "v"(At##8[m])); \
        else { _Pragma("unroll") for (int k = 0; k < 2; ++k) acc[ai][bj][m][n] = __builtin_amdgcn_mfma_f32_16x16x32_bf16(Bt[n][k], At[m][k], acc[ai][bj][m][n], 0, 0, 0); } } \
        __builtin_amdgcn_s_setprio(0); } while (0)
#define PG8_WAIT_V(n) asm volatile("s_waitcnt vmcnt(" #n ")" ::: "memory")
#define PG8_WAIT_L(n) asm volatile("s_waitcnt lgkmcnt(" #n ")" ::: "memory")
#define PG8_BAR __builtin_amdgcn_s_barrier()
#define PG8_SCHED __builtin_amdgcn_sched_barrier(0)
    Unit cur, nxt; int ui = 0;
    if (!S.next(0, cur)) return;
    f32x4 acc[2][2][4][2];
#pragma unroll
    for (int a = 0; a < 2; ++a)
#pragma unroll
        for (int b = 0; b < 2; ++b)
#pragma unroll
            for (int m = 0; m < 4; ++m)
#pragma unroll
                for (int n = 0; n < 2; ++n) acc[a][b][m][n] = (f32x4){0.f, 0.f, 0.f, 0.f};
    bf16x8 At[4][2], B0[2][2], B1[2][2]; i32x8 At8[4], B08[2], B18[2];
    const char* cA = (const char*)(cur.kind ? g.A2 : g.A) + (size_t)cur.pm * tstepA; const char* cB = (const char*)(cur.kind ? g.Bt2 : g.Bt) + (size_t)cur.pb * tstepB;
    S.a_ready(cur);
    PG8_STAGE(PG8_SB(0, 0), cB, voffB); PG8_STAGE(PG8_SB(0, 1), cB + hstepB, voffB); PG8_STAGE(PG8_SA(0, 0), cA, voffA); PG8_STAGE(PG8_SA(0, 1), cA + hstepA, voffA);
    if (wr == 1) PG8_BAR;
    PG8_WAIT_V(2); PG8_BAR;
    PG8_STAGE(PG8_SB(1, 0), cB + kstep, voffB); PG8_STAGE(PG8_SA(1, 0), cA + kstep, voffA); PG8_STAGE(PG8_SB(1, 1), cB + hstepB + kstep, voffB);
    PG8_WAIT_V(6); PG8_BAR;
    for (;;) {
        const bool has_next = S.next(ui + 1, nxt);
        const char* nA = has_next ? (const char*)(nxt.kind ? g.A2 : g.A) + (size_t)nxt.pm * tstepA : cA; const char* nB = has_next ? (const char*)(nxt.kind ? g.Bt2 : g.Bt) + (size_t)nxt.pb * tstepB : cB;
#pragma unroll 1
        for (int t = 0; t < nt; t += 2) {
            const bool last = (t == nt - 2);
            const char* a1 = cA + (size_t)(t + 1) * kstep;
            const char* a2 = last ? nA : cA + (size_t)(t + 2) * kstep; const char* b2 = last ? nB : cB + (size_t)(t + 2) * kstep;
            const char* a3 = a2 + kstep; const char* b3 = b2 + kstep;
            if (last && has_next) S.a_ready(nxt);
            PG8_LDB(B0, 0, 0); PG8_LDB(B1, 0, 1); PG8_SCHED; PG8_LDA(At, 0, 0); PG8_STAGE(PG8_SA(1, 1), a1 + hstepA, voffA);
            PG8_WAIT_V(8); PG8_WAIT_L(0); PG8_BAR; PG8_MMA(0, 0, At, B0); PG8_MMA(0, 1, At, B1); PG8_BAR; PG8_SCHED;
            PG8_LDA(At, 0, 1); PG8_STAGE(PG8_SB(0, 0), b2, voffB); PG8_STAGE(PG8_SB(0, 1), b2 + hstepB, voffB); PG8_STAGE(PG8_SA(0, 0), a2, voffA);
            PG8_WAIT_V(8); PG8_WAIT_L(0); PG8_BAR; PG8_MMA(1, 0, At, B0); PG8_MMA(1, 1, At, B1); PG8_BAR; PG8_SCHED;
            PG8_LDB(B0, 1, 0); PG8_LDB(B1, 1, 1); PG8_SCHED; PG8_LDA(At, 1, 0); PG8_STAGE(PG8_SA(0, 1), a2 + hstepA, voffA);
            PG8_WAIT_V(8); PG8_WAIT_L(0); PG8_BAR; PG8_MMA(0, 0, At, B0); PG8_MMA(0, 1, At, B1); PG8_BAR; PG8_SCHED;
            PG8_LDA(At, 1, 1); PG8_STAGE(PG8_SB(1, 0), b3, voffB); PG8_STAGE(PG8_SB(1, 1), b3 + hstepB, voffB); PG8_STAGE(PG8_SA(1, 0), a3, voffA);
            PG8_WAIT_V(8); PG8_WAIT_L(0); PG8_BAR; PG8_MMA(1, 0, At, B0); PG8_MMA(1, 1, At, B1); PG8_BAR; PG8_SCHED;
        }
        if (wr == 0) PG8_BAR;
        if constexpr (FP8) asm volatile("s_nop 15\n\ts_nop 7" ::: "memory");
        S.pre_epi();
        { int te_ = threadIdx.x; asm volatile("" : "+v"(te_));
          E(acc, cur, wr, wc, te_ & 15, (te_ & 63) >> 4); }
        S.done(cur);
        if (!has_next) break;
#pragma unroll
        for (int a = 0; a < 2; ++a)
#pragma unroll
            for (int b = 0; b < 2; ++b)
#pragma unroll
                for (int m = 0; m < 4; ++m)
#pragma unroll
                    for (int n = 0; n < 2; ++n) acc[a][b][m][n] = (f32x4){0.f, 0.f, 0.f, 0.f};
        cur = nxt; cA = nA; cB = nB; ++ui;
        if (wr == 1) PG8_BAR;
    }
    PG8_WAIT_V(0);
    S.finish();
    PG8_BAR;
#undef PG8_SA
#undef PG8_SB
#undef PG8_STAGE
#undef PG8_LDA
#undef PG8_LDB
#undef PG8_MMA
#undef PG8_WAIT_V
#undef PG8_WAIT_L
#undef PG8_BAR
#undef PG8_SCHED
}
}
constexpr int STAGE_LIMIT = 8;

namespace att {
__device__ __forceinline__ int crow(int r, int hi) { return (r & 3) + 8 * (r >> 2) + 4 * hi; }
__device__ __forceinline__ int v_rd_base(int lane) { return ((lane & 3) << 3) | (((lane >> 2) & 3) << 6) | (((lane >> 4) & 1) << 5) | (((lane >> 5) & 1) << 8); }
}

namespace dil {
using att::crow; using att::v_rd_base;
constexpr int OFF_O = 0, OFF_V = 65536, VWAVE = 8192;
template <int S_>
__device__ __forceinline__ void pass(const bf16_t* __restrict__ Qh, const bf16_t* __restrict__ Kh, const bf16_t* __restrict__ Vh, int pitch, int q0, LAS unsigned char* lds, LAS float* scr, int wid, int lane) {
    const int r32 = lane & 31, hi = lane >> 5;
    LAS float* Oacc = (LAS float*)(lds + OFF_O); LAS float* macc = scr; LAS float* lacc = scr + 256; LAS float* wsf = scr + 512 + wid * 64;
    LAS unsigned char* vbuf = lds + OFF_V + wid * VWAVE;
    constexpr int NG = (S_ == 16) ? 2 : 1, VR = (S_ == 16) ? 16 : 32;
    int vk[4], vc[4];
#pragma unroll
    for (int i = 0; i < 4; ++i) { const int off = (i * 64 + lane) * 16, st = off >> 9, within = off & 511, kk = (st >> 1) * 8 + (within >> 6);
        vk[i] = (kk & ~0xC) | ((kk & 4) << 1) | ((kk & 8) >> 1); vc[i] = (st & 1) * 32 + ((within & 63) >> 1); }
    const unsigned vb0 = (unsigned)(uintptr_t)vbuf + (unsigned)v_rd_base(lane);
#pragma unroll
    for (int gi = 0; gi < NG; ++gi) {
        const int rho = (S_ == 1) ? 0 : (S_ == 4) ? (wid & 3) : (2 * wid + gi);
        const int i0 = (S_ == 1) ? 32 * wid : (S_ == 4) ? 32 * (wid >> 2) : 0;
        const int qi = i0 + (r32 < VR ? r32 : r32 - VR);
        const int ql = rho + S_ * qi;
        bf16x8 qr[4];
#pragma unroll
        for (int d0 = 0; d0 < 4; ++d0) qr[d0] = *(const bf16x8*)(Qh + (size_t)(q0 + ql) * pitch + d0 * 16 + hi * 8);
        const int j0 = i0 - 128;
        const int tokb = q0 + rho + S_ * j0;
        bf16x8 kfA[4], kfB[4];
#define DIL_KLOAD(dst, c) do { int tk_ = tokb + S_ * (32 * (c) + r32); tk_ = tk_ < 0 ? 0 : (tk_ > SEQ - 1 ? SEQ - 1 : tk_);     \
            _Pragma("unroll") for (int d0 = 0; d0 < 4; ++d0) dst[d0] = *(const bf16x8*)(Kh + (size_t)tk_ * pitch + d0 * 16 + hi * 8); } while (0)
#define DIL_VDMA(c, bf) do { _Pragma("unroll") for (int i = 0; i < 4; ++i) { int tk_ = tokb + S_ * (32 * (c) + vk[i]); tk_ = tk_ < 0 ? 0 : (tk_ > SEQ - 1 ? SEQ - 1 : tk_); \
            __builtin_amdgcn_global_load_lds((const unsigned*)(Vh + (size_t)tk_ * pitch + vc[i]), (LAS unsigned*)(vbuf + (bf) * 4096 + i * 1024), 16, 0, 0); } } while (0)
        float m_reg = -1e30f, l_reg = 0.f; f32x16 o[2]; o[0] = f32x16{}; o[1] = f32x16{};
        DIL_KLOAD(kfA, 0); DIL_VDMA(0, 0);
#define DIL_STEP(KF, KN, c) do { \
            if ((c) < 4) { DIL_KLOAD(KN, (c) + 1); DIL_VDMA((c) + 1, ((c) + 1) & 1); asm volatile("s_waitcnt vmcnt(8)" ::: "memory"); } \
            else { asm volatile("s_waitcnt vmcnt(0)" ::: "memory"); } \
            f32x16 p = f32x16{}; \
            _Pragma("unroll") for (int d0 = 0; d0 < 4; ++d0) p = __builtin_amdgcn_mfma_f32_32x32x16_bf16(KF[d0], qr[d0], p, 0, 0, 0); \
            const unsigned vb = vb0 + (unsigned)(((c) & 1) * 4096); \
            s16x4 vl0[2], vh0[2], vl1[2], vh1[2]; \
            _Pragma("unroll") for (int d0 = 0; d0 < 2; ++d0) { \
                asm volatile("ds_read_b64_tr_b16 %0, %1 offset:%2" : "=&v"(vl0[d0]) : "v"(vb), "i"(d0 * 512) : "memory"); \
                asm volatile("ds_read_b64_tr_b16 %0, %1 offset:%2" : "=&v"(vh0[d0]) : "v"(vb), "i"(d0 * 512 + 1024) : "memory"); \
                asm volatile("ds_read_b64_tr_b16 %0, %1 offset:%2" : "=&v"(vl1[d0]) : "v"(vb), "i"(d0 * 512 + 2048) : "memory"); \
                asm volatile("ds_read_b64_tr_b16 %0, %1 offset:%2" : "=&v"(vh1[d0]) : "v"(vb), "i"(d0 * 512 + 3072) : "memory"); } \
              \
            { const float NEG = -__builtin_inff(); const int db = qi - j0 - 32 * (c) - 4 * hi; const int tb = tokb + S_ * (32 * (c) + 4 * hi); \
              if ((c) == 0 || (c) == 4 || tokb < 0) { \
                _Pragma("unroll") for (int r = 0; r < 16; ++r) { const int cr = (r & 3) + 8 * (r >> 2); \
                    const bool ok = ((unsigned)(db - cr) <= 128u) && (tb + S_ * cr >= 0); p[r] = ok ? p[r] : NEG; } } } \
            float pmax = p[0]; \
            _Pragma("unroll") for (int r = 1; r < 16; ++r) pmax = fmaxf(pmax, p[r]); \
            { auto rr = __builtin_amdgcn_permlane32_swap(__float_as_uint(pmax), __float_as_uint(pmax), false, false); pmax = fmaxf(__uint_as_float(rr[0]), __uint_as_float(rr[1])); } \
            const float mn = fmaxf(m_reg, pmax); const float alpha = __builtin_amdgcn_exp2f(m_reg - mn); m_reg = mn; \
            float ps = 0.f; \
            _Pragma("unroll") for (int r = 0; r < 16; ++r) { p[r] = __builtin_amdgcn_exp2f(p[r] - mn); ps += p[r]; } \
            { auto rr = __builtin_amdgcn_permlane32_swap(__float_as_uint(ps), __float_as_uint(ps), false, false); ps = __uint_as_float(rr[0]) + __uint_as_float(rr[1]); } \
            l_reg = l_reg * alpha + ps; \
            bf16x8 pa0, pa1; DIL_PK4(p, 0, pa0); DIL_PK4(p, 8, pa1); \
            if (__any(alpha < 1.f)) { if (hi == 0) wsf[r32] = alpha; asm volatile("s_waitcnt lgkmcnt(0)" ::: "memory"); \
                _Pragma("unroll") for (int r = 0; r < 16; ++r) { const float a = wsf[crow(r, hi)]; o[0][r] *= a; o[1][r] *= a; } } \
            asm volatile("s_waitcnt lgkmcnt(0)" ::: "memory"); __builtin_amdgcn_sched_barrier(0); \
            _Pragma("unroll") for (int d0 = 0; d0 < 2; ++d0) { \
                o[d0] = __builtin_amdgcn_mfma_f32_32x32x16_bf16(pa0, (bf16x8){vl0[d0][0], vl0[d0][1], vl0[d0][2], vl0[d0][3], vh0[d0][0], vh0[d0][1], vh0[d0][2], vh0[d0][3]}, o[d0], 0, 0, 0); \
                o[d0] = __builtin_amdgcn_mfma_f32_32x32x16_bf16(pa1, (bf16x8){vl1[d0][0], vl1[d0][1], vl1[d0][2], vl1[d0][3], vh1[d0][0], vh1[d0][1], vh1[d0][2], vh1[d0][3]}, o[d0], 0, 0, 0); } \
        } while (0)
#define DIL_PK4(P, B_, OUT) do { unsigned a0 = cvt_pk_bf16(P[B_+0], P[B_+1]), a1 = cvt_pk_bf16(P[B_+2], P[B_+3]);                          \
            unsigned b0_ = cvt_pk_bf16(P[B_+4], P[B_+5]), b1_ = cvt_pk_bf16(P[B_+6], P[B_+7]);                                             \
            auto r0 = __builtin_amdgcn_permlane32_swap(a0, b0_, false, false); auto r1 = __builtin_amdgcn_permlane32_swap(a1, b1_, false, false); \
            u32x4 w = {r0[0], r1[0], r0[1], r1[1]}; OUT = __builtin_bit_cast(bf16x8, w); } while (0)
        DIL_STEP(kfA, kfB, 0); DIL_STEP(kfB, kfA, 1); DIL_STEP(kfA, kfB, 2); DIL_STEP(kfB, kfA, 3); DIL_STEP(kfA, kfB, 4);
#undef DIL_STEP
#undef DIL_PK4
#undef DIL_KLOAD
#undef DIL_VDMA
        float fo = 0.f, fc = 1.f;
        if (S_ != 1) { const float mo = macc[ql], lo = lacc[ql]; const float mnew = fmaxf(mo, m_reg); fo = __builtin_amdgcn_exp2f(mo - mnew); fc = __builtin_amdgcn_exp2f(m_reg - mnew);
            l_reg = lo * fo + l_reg * fc; m_reg = mnew; }
        if (hi == 0 && r32 < VR) { macc[ql] = m_reg; lacc[ql] = l_reg; wsf[r32] = fo; wsf[32 + r32] = fc; }
        asm volatile("s_waitcnt lgkmcnt(0)" ::: "memory");
#pragma unroll
        for (int r = 0; r < 16; ++r) { const int row = crow(r, hi);
            if (row < VR) { const int qrow = rho + S_ * (i0 + row); LAS float* op = Oacc + qrow * 64 + r32;
                if (S_ == 1) { op[0] = o[0][r]; op[32] = o[1][r]; }
                else { const float a = wsf[row], b = wsf[32 + row]; op[0] = op[0] * a + o[0][r] * b; op[32] = op[32] * a + o[1][r] * b; } } }
        asm volatile("s_waitcnt lgkmcnt(0)" ::: "memory");
    }
}
__device__ __forceinline__ void unit(const bf16_t* Qh, const bf16_t* Kh, const bf16_t* Vh, int pitch, bf16_t* Oh, int op, int q0, LAS unsigned char* lds, LAS float* scr) {
    int tid_ = threadIdx.x; asm volatile("" : "+v"(tid_));
    const int tid = tid_, wid = __builtin_amdgcn_readfirstlane(tid >> 6), lane = tid & 63;
    pass<1>(Qh, Kh, Vh, pitch, q0, lds, scr, wid, lane);
    __syncthreads();
    pass<4>(Qh, Kh, Vh, pitch, q0, lds, scr, wid, lane);
    __syncthreads();
    pass<16>(Qh, Kh, Vh, pitch, q0, lds, scr, wid, lane);
    __syncthreads();
    {   const int q = tid >> 1, hf = tid & 1; const LAS f32x4* src = (const LAS f32x4*)(lds + OFF_O + (q * 64 + 32 * hf) * 4); const float rl = 1.0f / scr[256 + q];
        bf16_t* dst = Oh + (size_t)(q0 + q) * op + 32 * hf;
#pragma unroll
        for (int i = 0; i < 4; ++i) { const f32x4 a = src[2 * i] * rl, b = src[2 * i + 1] * rl;
            u32x4 w; w.x = cvt_pk_bf16(a[0], a[1]); w.y = cvt_pk_bf16(a[2], a[3]); w.z = cvt_pk_bf16(b[0], b[1]); w.w = cvt_pk_bf16(b[2], b[3]); *(u32x4*)(dst + 8 * i) = w; } }
    __syncthreads();
}
}

namespace mla {
using att::crow;
constexpr int DQ = 192, DV_ = 128;
constexpr int KP = DQ + 16, KB = 64 * KP;
constexpr int VP = 80, VB = DV_ * VP;
constexpr int NBUF = 3;
constexpr int OFF_K = 0, OFF_V = NBUF * KB, OFF_WS = NBUF * (KB + VB), BYTES = OFF_WS + 8 * 256;
constexpr int KCPR = KP / 16, NKP = KB / 1024, KPW = (NKP + 7) / 8;
constexpr int NVP = VB / 256, VPW = NVP / 8;
static_assert(BYTES <= 131072 && KB % 1024 == 0 && VB % 256 == 0 && NVP % 8 == 0, "mla LDS image");
constexpr float PSHIFT = 8.0f;

__device__ __forceinline__ void unit(const unsigned char* __restrict__ Qh, const unsigned char* __restrict__ Kh, int pitch, const unsigned char* __restrict__ VTh  ,
                                     unsigned char* __restrict__ Oh, int op, int q0, LAS unsigned char* lds) {
    constexpr float SC = C2_C;
    int tid_ = threadIdx.x; asm volatile("" : "+v"(tid_));
    const int tid = tid_, wid = __builtin_amdgcn_readfirstlane(tid >> 6), lane = tid & 63, r32 = lane & 31, hi = lane >> 5;
    const int qlo = q0 + wid * 32, qpos = qlo + r32;
    LAS float* wsf = (LAS float*)(lds + OFF_WS) + wid * 64;
    const int NT = (q0 + 256) / 64;
    unsigned kso[KPW], vso[VPW];
#pragma unroll
    for (int i = 0; i < KPW; ++i) { const int c = (wid + 8 * i) * 64 + lane, row = c / KCPR; int cc = c % KCPR; if (cc > KCPR - 2) cc = KCPR - 2; kso[i] = (unsigned)((row & 63) * pitch + cc * 16); }
#pragma unroll
    for (int i = 0; i < VPW; ++i) { const int off = ((wid + 8 * i) * 64 + lane) * 4, d = off / VP; int w = off % VP; if (w >= 64) w = 0;
        const int hh = w >> 5, g = (w & 31) >> 2; vso[i] = (unsigned)(d * SEQ + 32 * (g >> 2) + 8 * (g & 3) + 4 * hh); }
#define MLA_DMA(j, bf) do { const unsigned char* kt_ = Kh + (size_t)(j) * 64 * pitch; const unsigned char* vt_ = VTh + (size_t)(j) * 64; \
        _Pragma("unroll") for (int i = 0; i < KPW; ++i) if (wid + 8 * i < NKP) \
            __builtin_amdgcn_global_load_lds((const unsigned*)(kt_ + kso[i]), (LAS unsigned*)(lds + OFF_K + (bf) * KB + (wid + 8 * i) * 1024), 16, 0, 0); \
        _Pragma("unroll") for (int i = 0; i < VPW; ++i) \
            __builtin_amdgcn_global_load_lds((const unsigned*)(vt_ + vso[i]), (LAS unsigned*)(lds + OFF_V + (bf) * VB + (wid + 8 * i) * 256), 4, 0, 0); } while (0)
    MLA_DMA(0, 0);
    if (NT > 1) MLA_DMA(1, 1);
    i32x8 qr[3];
#pragma unroll
    for (int s = 0; s < 3; ++s) { const i32x4 lo_ = *(const i32x4*)(Qh + (size_t)qpos * pitch + 64 * s + 32 * hi), hi_ = *(const i32x4*)(Qh + (size_t)qpos * pitch + 64 * s + 32 * hi + 16);
        qr[s] = __builtin_shufflevector(lo_, hi_, 0, 1, 2, 3, 4, 5, 6, 7); }
    float m_reg = -1e30f;
    f32x16 o[4], ol = f32x16{};
    const i32x8 ones8 = {0x38383838, 0x38383838, 0x38383838, 0x38383838, 0x38383838, 0x38383838, 0x38383838, 0x38383838};
#pragma unroll
    for (int d = 0; d < 4; ++d) o[d] = f32x16{};
    const int koff = r32 * KP + hi * 32, voff = r32 * VP + hi * 32;
    asm volatile("s_waitcnt vmcnt(0)" ::: "memory");
    __syncthreads();
#define MLA_QK(P, bufi, hf_) do { const LAS unsigned char* kb_ = lds + OFF_K + (bufi) * KB + (hf_) * 32 * KP + koff; P = f32x16{}; \
        i32x8 kw_[3]; _Pragma("unroll") for (int s = 0; s < 3; ++s) { const i32x4 lo_ = *(const LAS i32x4*)(kb_ + 64 * s), hi_ = *(const LAS i32x4*)(kb_ + 64 * s + 16); kw_[s] = __builtin_shufflevector(lo_, hi_, 0, 1, 2, 3, 4, 5, 6, 7); } \
        _Pragma("unroll") for (int s = 0; s < 3; ++s) P = __builtin_amdgcn_mfma_scale_f32_32x32x64_f8f6f4(kw_[s], qr[s], P, 0, 0, 0, 0, 0, 0); } while (0)
    f32x16 pA, pB, pC, pD;
    int buf = 0;
    { if (0 <= qlo + 31) { MLA_QK(pA, 0, 0); } if (32 <= qlo + 31) { MLA_QK(pB, 0, 1); } }
#define MLA_SMPV(P0, P1, kb, vbuf) do { \
        const bool a0_ = (kb) <= qlo + 31, a1_ = (kb) + 32 <= qlo + 31; \
        if (a0_) { \
            const float NEG = -__builtin_inff(); const int dq = qpos - (kb) - 4 * hi; \
            if (!a1_) { _Pragma("unroll") for (int r = 0; r < 16; ++r) P1[r] = NEG; } \
            if ((kb) + 63 > qlo) { _Pragma("unroll") for (int r = 0; r < 16; ++r) { const int c = (r & 3) + 8 * (r >> 2); if (dq - c < 0) P0[r] = NEG; if (dq - c - 32 < 0) P1[r] = NEG; } } \
            float pmax = fmaxf(P0[0], P1[0]); \
            _Pragma("unroll") for (int r = 1; r < 16; ++r) pmax = fmaxf(pmax, fmaxf(P0[r], P1[r])); \
            { auto rr = __builtin_amdgcn_permlane32_swap(__float_as_uint(pmax), __float_as_uint(pmax), false, false); pmax = fmaxf(__uint_as_float(rr[0]), __uint_as_float(rr[1])); } \
            const float mn = fmaxf(m_reg, pmax * SC); const float alpha = __builtin_amdgcn_exp2f(m_reg - mn); m_reg = mn; \
              \
              \
            const float c8 = 8.0f * SC, b8 = 8.0f * (PSHIFT + 7.0f - mn); \
            i32x8 pa; \
            _Pragma("unroll") for (int g = 0; g < 4; ++g) { unsigned w0 = 0u, w1 = 0u; \
                _Pragma("unroll") for (int b_ = 0; b_ < 4; ++b_) { w0 = __builtin_amdgcn_cvt_pk_u8_f32(__builtin_fmaf(P0[4 * g + b_], c8, b8), b_, w0); w1 = __builtin_amdgcn_cvt_pk_u8_f32(__builtin_fmaf(P1[4 * g + b_], c8, b8), b_, w1); } \
                pa[g] = (int)w0; pa[4 + g] = (int)w1; } \
            if (__any(alpha < 1.f)) { if (hi == 0) wsf[r32] = alpha; asm volatile("s_waitcnt lgkmcnt(0)" ::: "memory"); \
                _Pragma("unroll") for (int r = 0; r < 16; ++r) { const float a = wsf[crow(r, hi)]; ol[r] *= a; _Pragma("unroll") for (int d = 0; d < 4; ++d) o[d][r] *= a; } } \
            ol = __builtin_amdgcn_mfma_scale_f32_32x32x64_f8f6f4(pa, ones8, ol, 0, 0, 0, 0, 0, 0); \
            const LAS unsigned char* vb_ = lds + OFF_V + (vbuf) * VB + voff; \
            _Pragma("unroll") for (int d0 = 0; d0 < 4; ++d0) { const i32x4 lo_ = *(const LAS i32x4*)(vb_ + d0 * 32 * VP), hi_ = *(const LAS i32x4*)(vb_ + d0 * 32 * VP + 16); \
                o[d0] = __builtin_amdgcn_mfma_scale_f32_32x32x64_f8f6f4(pa, __builtin_shufflevector(lo_, hi_, 0, 1, 2, 3, 4, 5, 6, 7), o[d0], 0, 0, 0, 0, 0, 0); } \
        } } while (0)
    for (int t = 0; t < NT; t += 2) {
        {   if (t + 2 < NT) { const int b2 = buf == 0 ? 2 : buf - 1; MLA_DMA(t + 2, b2); }
            const int kb = t * 64, nb = buf == 2 ? 0 : buf + 1;
            if (kb + 64 <= qlo + 31) MLA_QK(pC, nb, 0);
            if (kb + 96 <= qlo + 31) MLA_QK(pD, nb, 1);
            MLA_SMPV(pA, pB, kb, buf);
            asm volatile("s_waitcnt vmcnt(0)" ::: "memory"); __syncthreads(); buf = nb; }
        {   if (t + 3 < NT) { const int b2 = buf == 0 ? 2 : buf - 1; MLA_DMA(t + 3, b2); }
            const int kb = (t + 1) * 64, nb = buf == 2 ? 0 : buf + 1;
            if (t + 2 < NT) { if (kb + 64 <= qlo + 31) MLA_QK(pA, nb, 0); if (kb + 96 <= qlo + 31) MLA_QK(pB, nb, 1); }
            MLA_SMPV(pC, pD, kb, buf);
            asm volatile("s_waitcnt vmcnt(0)" ::: "memory"); __syncthreads(); buf = nb; }
    }
#undef MLA_SMPV
#undef MLA_QK
#undef MLA_DMA
    unsigned char* Ow = Oh + (size_t)qlo * op;
#pragma unroll
    for (int r = 0; r < 16; ++r) { const int orow = crow(r, hi); const float rl = __builtin_amdgcn_rcpf(ol[r]);
#pragma unroll
        for (int d0 = 0; d0 < 4; ++d0) { const float v = o[d0][r] * rl; const float v1 = __shfl_down(v, 1), v2 = __shfl_down(v, 2), v3 = __shfl_down(v, 3);
            if ((r32 & 3) == 0) *(unsigned*)(Ow + (size_t)orow * op + d0 * 32 + r32) = pk4_fp8(v, v1, v2, v3); } }
    __syncthreads();
}
}

constexpr int NWAVES = 8;
constexpr size_t MiB = 1u << 20;
constexpr size_t WS_CTL = 0, CTL_ZERO_BYTES = 1 * MiB;
constexpr size_t WS_WEIN = 2 * MiB;
constexpr size_t WS_WEOUT = 12 * MiB;
constexpr size_t WS_WOIN = 16 * MiB;
constexpr size_t WS_WUQ = 20 * MiB;
constexpr size_t WS_WUKV = 23 * MiB;
constexpr size_t WS_WOOUT = 25 * MiB;
constexpr size_t WS_B1P = 29 * MiB;
constexpr size_t WS_SSQ = 30 * MiB;
constexpr size_t WS_TOKER = 31 * MiB;
constexpr size_t WS_TOKG = 31 * MiB + 512 * 1024;
constexpr size_t WS_XN = 32 * MiB;
constexpr size_t WS_Z = 64 * MiB;
constexpr size_t WS_MIX = 144 * MiB;
constexpr size_t WS_QR = 176 * MiB;
constexpr size_t WS_KVR = 224 * MiB;
constexpr size_t WS_QF = 288 * MiB;
constexpr size_t WS_KF = 336 * MiB;
constexpr size_t WS_Z8 = 104 * MiB;
constexpr size_t WS_MIX8 = 160 * MiB;
constexpr size_t WS_VT = 3200 * MiB;
constexpr size_t WS_W1 = 384 * MiB;
constexpr size_t WS_W2 = 896 * MiB;
constexpr size_t WS_XG = 1152 * MiB;
constexpr size_t WS_ACT = 1664 * MiB;
constexpr size_t WS_Y = 2176 * MiB;
constexpr size_t WS_X16 = 3216 * MiB;
constexpr size_t WS_END = 3248 * MiB;
constexpr int CW_MOE = 65536;
constexpr int CW_TMO = 0, CW_CODE = 1, CW_BAR = 4096, CW_CNT = 16384;
constexpr int RING_OFF = 0, RING_BYTES = 131072;
constexpr int LDSCTL_OFF = RING_BYTES, MISC_OFF = LDSCTL_OFF + 320;
constexpr int SCR_OFF = RING_BYTES + 1024;
constexpr int LDS_BYTES = 155648;
constexpr int SCR_BYTES = LDS_BYTES - SCR_OFF;

typedef GAS unsigned gu32;
#define RLX_AGENT __ATOMIC_RELAXED, __HIP_MEMORY_SCOPE_AGENT

#define XB_TMO      128
#define XB_XCNT(j)  (256  + 64 * (j))
#define XB_XSUB(j)  (1280 + 64 * (j))
#define XB_XGEN(j)  (2304 + 64 * (j))
#define XB_TOP      3328
#define XB_TOPGEN   3392
#define XCD_BAR_WORDS 3456
#define XB_SPIN_CAP (1u << 18)
__device__ __forceinline__ unsigned xb_ld(unsigned* p)              { return __hip_atomic_load(p, __ATOMIC_RELAXED, __HIP_MEMORY_SCOPE_AGENT); }
__device__ __forceinline__ unsigned xb_add(unsigned* p, unsigned v) { return __hip_atomic_fetch_add(p, v, __ATOMIC_RELAXED, __HIP_MEMORY_SCOPE_AGENT); }
__device__ __forceinline__ unsigned xb_xcc_id() { return (unsigned)__builtin_amdgcn_s_getreg((3 << 11) | 20) & 0xFu; }
#define XB_SPIN(cond, bar) do { unsigned _sp = 0; while (cond) { __builtin_amdgcn_s_sleep(1); \
    if ((++_sp & 255u) == 0u) { if (xb_ld(&(bar)[XB_TMO])) break; if (_sp > XB_SPIN_CAP) { atomicAdd(&(bar)[XB_TMO], 1u); break; } } } } while (0)
struct XcdBarrier { unsigned* bar; unsigned x; volatile LAS unsigned* st; };
__device__ __forceinline__ XcdBarrier xcd_barrier_post(unsigned* bar, volatile LAS unsigned* st) {
    XcdBarrier b; b.bar = bar; b.x = xb_xcc_id(); b.st = st;
    if (threadIdx.x == 0) (void)xb_add(&bar[XB_XCNT(b.x)], 1u);
    return b;
}
__device__ __forceinline__ void xcd_barrier_complete(unsigned* bar, unsigned x, unsigned& nloc, unsigned& nx) {
    const unsigned G = gridDim.x * gridDim.y * gridDim.z;
    unsigned sum, cnt, mine, sp = 0u;
    for (;;) {
        sum = 0u; cnt = 0u; mine = 0u;
#pragma unroll
        for (unsigned j = 0; j < 16; ++j) { const unsigned c = xb_ld(&bar[XB_XCNT(j)]); sum += c; cnt += (c > 0u) ? 1u : 0u; mine = (j == x) ? c : mine; }
        if (sum == G) break;
        __builtin_amdgcn_s_sleep(1);
        if ((++sp & 255u) == 0u) { if (xb_ld(&bar[XB_TMO])) break; if (sp > XB_SPIN_CAP) { atomicAdd(&bar[XB_TMO], 1u); break; } }
    }
    nloc = mine > 0u ? mine : 1u; nx = cnt > 0u ? cnt : 1u;
}
__device__ __forceinline__ void xcd_barrier(const XcdBarrier& b) {
    asm volatile("s_waitcnt vmcnt(0)" ::: "memory");
    __syncthreads();
    if (threadIdx.x == 0) {
        unsigned* bar = b.bar;
        __builtin_amdgcn_s_waitcnt(0);
        unsigned nloc = b.st[0], nx = b.st[1];
        if (nloc == 0u) { xcd_barrier_complete(bar, b.x, nloc, nx); b.st[0] = nloc; b.st[1] = nx; }
        const unsigned old = xb_add(&bar[XB_XSUB(b.x)], 1u);
        const unsigned gen = old / nloc;
        if (old + 1u == (gen + 1u) * nloc) {
            __builtin_amdgcn_fence(__ATOMIC_RELEASE, "agent");
            asm volatile("s_waitcnt vmcnt(0)" ::: "memory");
            const unsigned og = xb_add(&bar[XB_TOP], 1u);
            const unsigned tg = og / nx;
            if (og + 1u == (tg + 1u) * nx) xb_add(&bar[XB_TOPGEN], 1u);
            else XB_SPIN(xb_ld(&bar[XB_TOPGEN]) == tg, bar);
            __builtin_amdgcn_fence(__ATOMIC_ACQUIRE, "agent");
            xb_add(&bar[XB_XGEN(b.x)], 1u);
            asm volatile("s_waitcnt vmcnt(0)" ::: "memory");
        } else {
            XB_SPIN(xb_ld(&bar[XB_XGEN(b.x)]) == gen, bar);
            __builtin_amdgcn_fence(__ATOMIC_ACQUIRE, "agent");
            asm volatile("s_waitcnt vmcnt(0)" ::: "memory");
        }
    }
    __syncthreads();
}

struct Args {
    const float* in[24]; float* out; unsigned char* ws; int stage_limit; int pad;
};
enum { I_X = 0, I_MIXN, I_FFNN, I_EWIN, I_EWS, I_EBS, I_EGV, I_EGQ, I_EGK, I_EWOUT, I_OWIN, I_OGCQ, I_OGCKV, I_OWUQ, I_OWUKV, I_OGQ, I_OGK, I_OWOUT,
       I_RW, I_RB, I_W1, I_B1, I_W2, I_B2 };

struct Frame {
    LAS unsigned char* lds;
    int vcu, G;
};

__device__ __forceinline__ float wave_sum(float v) {
#pragma unroll
    for (int o = 1; o < 64; o <<= 1) v += __shfl_xor(v, o);
    return v;
}
#define LDS_WAIT() asm volatile("s_waitcnt lgkmcnt(0)" ::: "memory")

template <int MODE> __device__ __forceinline__ int dst_row(int o) {
    if (MODE == 1) { if (o >= 1024 && o < 2048) return (o & ~255) | (((o >> 5) & 1) << 7) | (((o >> 6) & 3) << 5) | (o & 31); return o; }
    if (MODE == 2) return ((o >> 8) << 8) | ((o & 1) << 7) | ((o & 255) >> 1);
    return o;
}
template <int MODE>
__device__ __forceinline__ void transpose_item(const float* __restrict__ W, int K, int N, bf16_t* __restrict__ WT, const float* __restrict__ gain, LAS float* scr, int item, int lane) {
    const int nblk = N / 32, kb = item / nblk, nb = item % nblk, k0 = 64 * kb, n0 = 32 * nb;
#pragma unroll 8
    for (int i = 0; i < 32; ++i) { const int kk = 2 * i + (lane >> 5); float w = W[(size_t)(k0 + kk) * N + n0 + (lane & 31)]; if (gain) w *= gain[k0 + kk]; scr[kk * 33 + (lane & 31)] = w; }
    LDS_WAIT(); asm volatile("" ::: "memory");
    const int c = lane & 7;
#pragma unroll
    for (int j = 0; j < 4; ++j) { const int n = (lane >> 3) + 8 * j; const LAS float* s = scr + (8 * c) * 33 + n;
        u32x4 o; o.x = cvt_pk_bf16(s[0 * 33], s[1 * 33]); o.y = cvt_pk_bf16(s[2 * 33], s[3 * 33]); o.z = cvt_pk_bf16(s[4 * 33], s[5 * 33]); o.w = cvt_pk_bf16(s[6 * 33], s[7 * 33]);
        *(u32x4*)(WT + (size_t)dst_row<MODE>(n0 + n) * K + k0 + 8 * c) = o; }
    LDS_WAIT(); asm volatile("" ::: "memory");
}
template <int MODE>
__device__ __forceinline__ void transpose_job(Frame& F, const float* W, int K, int N, int nmat, size_t src_stride, bf16_t* WT, size_t dst_stride, const float* gain, int gain_stride) {
    int tid_ = threadIdx.x; asm volatile("" : "+v"(tid_));
    const int wave = __builtin_amdgcn_readfirstlane(tid_ >> 6), lane = tid_ & 63;
    LAS float* scr = (LAS float*)(F.lds + RING_OFF + wave * 16384);
    const int gw = F.vcu * NWAVES + wave, NGW = F.G * NWAVES;
    const int per = (K / 64) * (N / 32), total = per * nmat;
    for (int it = gw; it < total; it += NGW) { const int mi = it / per, item = it - mi * per;
        transpose_item<MODE>(W + (size_t)mi * src_stride, K, N, WT + (size_t)mi * dst_stride, gain ? gain + (size_t)mi * gain_stride : nullptr, scr, item, lane); }
}


__device__ __forceinline__ void tr8_load(f32x4 (&v)[16], const float* __restrict__ W, int N, int item, int lane) {
    const int nblk = N / 32, kb = item / nblk, nb = item % nblk, k0 = 128 * kb, n0 = 32 * nb;
#pragma unroll
    for (int i = 0; i < 16; ++i) v[i] = __builtin_nontemporal_load((const f32x4*)(W + (size_t)(k0 + 8 * i + (lane >> 3)) * N + n0 + 4 * (lane & 7)));
}
template <int MODE>
__device__ __forceinline__ void tr8_store(const f32x4 (&v)[16], int K, int N, unsigned char* __restrict__ WT, const float* __restrict__ gain, LAS unsigned char* scr, int item, int lane) {
    const int nblk = N / 32, kb = item / nblk, nb = item % nblk, k0 = 128 * kb, n0 = 32 * nb;
    constexpr int TP = 144;
#pragma unroll
    for (int i = 0; i < 16; ++i) { const int kl = 8 * i + (lane >> 3); const float sc = gain ? W8_SCALE * gain[k0 + kl] : W8_SCALE;
        const unsigned w = pk4_fp8(v[i].x * sc, v[i].y * sc, v[i].z * sc, v[i].w * sc); LAS unsigned char* d = scr + (4 * (lane & 7)) * TP + kl;
        d[0] = (unsigned char)w; d[TP] = (unsigned char)(w >> 8); d[2 * TP] = (unsigned char)(w >> 16); d[3 * TP] = (unsigned char)(w >> 24); }
    LDS_WAIT(); asm volatile("" ::: "memory");
#pragma unroll
    for (int m = 0; m < 4; ++m) { const int q = lane + 64 * m, n = q >> 3, kc = q & 7;
        const u32x4 o = *(const LAS u32x4*)(scr + n * TP + 16 * kc);
        __builtin_nontemporal_store(o, (u32x4*)(WT + (size_t)dst_row<MODE>(n0 + n) * K + k0 + 16 * kc)); }
    LDS_WAIT(); asm volatile("" ::: "memory");
}
template <int MODE>
__device__ __forceinline__ void transpose_job_fp8(Frame& F, const float* W, int K, int N, int nmat, size_t src_stride, unsigned char* WT, size_t dst_stride, const float* gain = nullptr, int gain_stride = 0) {
    int tid_ = threadIdx.x; asm volatile("" : "+v"(tid_));
    const int wave = __builtin_amdgcn_readfirstlane(tid_ >> 6), lane = tid_ & 63;
    LAS unsigned char* scr = F.lds + RING_OFF + wave * 16384;
    const int gw = F.vcu * NWAVES + wave, NGW = F.G * NWAVES;
    const int per = (K / 128) * (N / 32), total = per * nmat;
    f32x4 cur[16], nxt[16];
    int it = gw;
    if (it < total) { const int mi = it / per; tr8_load(cur, W + (size_t)mi * src_stride, N, it - mi * per, lane); }
    for (; it < total; it += NGW) {
        const int itn = it + NGW;
        if (itn < total) { const int mn = itn / per; tr8_load(nxt, W + (size_t)mn * src_stride, N, itn - mn * per, lane); }
        const int mi = it / per;
        tr8_store<MODE>(cur, K, N, WT + (size_t)mi * dst_stride, gain ? gain + (size_t)mi * gain_stride : nullptr, scr, it - mi * per, lane);
#pragma unroll
        for (int i = 0; i < 16; ++i) cur[i] = nxt[i];
    }
}

__device__ __forceinline__ void rms_row_to_fp8(int lane, const float* xrow, const float* g, unsigned char* orow, float* copy) {
    const f32x4* xr = (const f32x4*)xrow + lane; const f32x4* gr = (const f32x4*)g + lane;
    f32x4 v[4]; float s = 0.f;
#pragma unroll
    for (int j = 0; j < 4; ++j) { v[j] = xr[64 * j]; s += (v[j].x * v[j].x + v[j].y * v[j].y) + (v[j].z * v[j].z + v[j].w * v[j].w); }
    const float rstd = 1.0f / sqrtf(wave_sum(s) * (1.f / DM) + EPS);
    unsigned* o4 = (unsigned*)orow + lane;
#pragma unroll
    for (int j = 0; j < 4; ++j) { const f32x4 gg = gr[64 * j]; if (copy) ((f32x4*)copy + lane)[64 * j] = v[j];
        o4[64 * j] = pk4_fp8(v[j].x * rstd * gg.x, v[j].y * rstd * gg.y, v[j].z * rstd * gg.z, v[j].w * rstd * gg.w); }
}
__device__ __forceinline__ void rms_row_to_bf16(int lane, const float* xrow, const float* g, bf16_t* orow, float* copy) {
    const f32x4* xr = (const f32x4*)xrow + lane; const f32x4* gr = (const f32x4*)g + lane;
    f32x4 v[4]; float s = 0.f;
#pragma unroll
    for (int j = 0; j < 4; ++j) { v[j] = xr[64 * j]; s += (v[j].x * v[j].x + v[j].y * v[j].y) + (v[j].z * v[j].z + v[j].w * v[j].w); }
    const float rstd = 1.0f / sqrtf(wave_sum(s) * (1.f / DM) + EPS);
    u32x2* o8 = (u32x2*)orow + lane;
#pragma unroll
    for (int j = 0; j < 4; ++j) { const f32x4 gg = gr[64 * j]; if (copy) ((f32x4*)copy + lane)[64 * j] = v[j];
        u32x2 w; w.x = cvt_pk_bf16(v[j].x * rstd * gg.x, v[j].y * rstd * gg.y); w.y = cvt_pk_bf16(v[j].z * rstd * gg.z, v[j].w * rstd * gg.w); o8[64 * j] = w; }
}

namespace pg8 {
struct EpiEvenIn {
    static constexpr bool PERM = false;
    bf16_t* Z; const float* gq; const float* gk;
    __device__ __forceinline__ void operator()(const f32x4 (&acc)[2][2][4][2], const Unit& u, int wr, int wc, int fr, int fq) const {
        const int row0 = u.pm * BM + wr * 64 + fr, pn = u.pn;
        if (pn >= 4 && pn < 8) {
            const float* g = pn < 6 ? gq : gk; const float sc = pn < 6 ? C2_B : 1.0f;
            f32x4 gv[2][2];
#pragma unroll
            for (int bj = 0; bj < 2; ++bj)
#pragma unroll
                for (int n = 0; n < 2; ++n) gv[bj][n] = *(const f32x4*)(g + 32 * bj + 16 * n + 4 * fq);
#pragma unroll
            for (int ai = 0; ai < 2; ++ai)
#pragma unroll
                for (int m = 0; m < 4; ++m) {
                    float ss = 0.f;
#pragma unroll
                    for (int bj = 0; bj < 2; ++bj)
#pragma unroll
                        for (int n = 0; n < 2; ++n) { const f32x4 v = acc[ai][bj][m][n]; ss += (v[0] * v[0] + v[1] * v[1]) + (v[2] * v[2] + v[3] * v[3]); }
                    ss += __shfl_xor(ss, 16); ss += __shfl_xor(ss, 32);
                    const float rstd = sc / sqrtf(ss * (1.0f / 64.0f) + EPS);
                    bf16_t* rowp = Z + (size_t)(row0 + ai * HALF + m * 16) * EVEN_IN + pn * BM + wc * 64 + 4 * fq;
#pragma unroll
                    for (int bj = 0; bj < 2; ++bj)
#pragma unroll
                        for (int n = 0; n < 2; ++n) { const f32x4 v = acc[ai][bj][m][n] * rstd * gv[bj][n];
                            u32x2 w; w.x = cvt_pk_bf16(v[0], v[1]); w.y = cvt_pk_bf16(v[2], v[3]); *(u32x2*)(rowp + 32 * bj + 16 * n) = w; }
                }
        } else {
            const bool act = pn < 4;
#pragma unroll
            for (int ai = 0; ai < 2; ++ai)
#pragma unroll
                for (int m = 0; m < 4; ++m) { bf16_t* rowp = Z + (size_t)(row0 + ai * HALF + m * 16) * EVEN_IN + pn * BM + wc * 32 + 4 * fq;
#pragma unroll
                    for (int bj = 0; bj < 2; ++bj)
#pragma unroll
                        for (int n = 0; n < 2; ++n) { f32x4 v = acc[ai][bj][m][n]; if (act) v = gelu4(v);
                            u32x2 w; w.x = cvt_pk_bf16(v[0], v[1]); w.y = cvt_pk_bf16(v[2], v[3]); *(u32x2*)(rowp + bj * HALF + 16 * n) = w; } }
        }
    }
};
template <bool F8 = false> struct EpiResidT {
    static constexpr bool PERM = false;
    const float* src32; bf16_t* X;
    __device__ __forceinline__ void operator()(const f32x4 (&acc)[2][2][4][2], const Unit& u, int wr, int wc, int fr, int fq) const {
        const int row0 = u.pm * BM + wr * 64 + fr;
#pragma unroll
        for (int ai = 0; ai < 2; ++ai)
#pragma unroll
            for (int m = 0; m < 4; ++m) { const size_t ro = (size_t)(row0 + ai * HALF + m * 16) * DM + u.pn * BM + wc * 32 + 4 * fq;
#pragma unroll
                for (int bj = 0; bj < 2; ++bj)
#pragma unroll
                    for (int n = 0; n < 2; ++n) { const size_t o_ = ro + bj * HALF + 16 * n; f32x4 b;
                        if (src32) b = *(const f32x4*)(src32 + o_); else { const u32x2 t = *(const u32x2*)(X + o_); b = (f32x4){bflo(t.x), bfhi(t.x), bflo(t.y), bfhi(t.y)}; }
                        const f32x4 r = b + (F8 ? acc[ai][bj][m][n] * W8_INV : acc[ai][bj][m][n]);
                        u32x2 w; w.x = cvt_pk_bf16(r[0], r[1]); w.y = cvt_pk_bf16(r[2], r[3]); *(u32x2*)(X + o_) = w; }
                if (m & 1) asm volatile("" ::: "memory"); }
    }
};
typedef EpiResidT<false> EpiResid;
struct EpiOddIn {
    static constexpr bool PERM = false;
    bf16_t* Z; unsigned char* Z8; float* ssq;
    __device__ __forceinline__ void operator()(const f32x4 (&acc)[2][2][4][2], const Unit& u, int wr, int wc, int fr, int fq) const {
        const int row0 = u.pm * BM + wr * 64 + fr, pn = u.pn;
#pragma unroll
        for (int ai = 0; ai < 2; ++ai)
#pragma unroll
            for (int m = 0; m < 4; ++m) { const int row = row0 + ai * HALF + m * 16; bf16_t* rowp = Z + (size_t)row * ODD_INP + pn * BM + wc * 32 + 4 * fq;
                float ss = 0.f;
#pragma unroll
                for (int bj = 0; bj < 2; ++bj)
#pragma unroll
                    for (int n = 0; n < 2; ++n) { const f32x4 v = acc[ai][bj][m][n] * W8_INV; ss += (v[0] * v[0] + v[1] * v[1]) + (v[2] * v[2] + v[3] * v[3]);
                        if (pn < 3) *(unsigned*)(Z8 + (size_t)row * ODD_INP + pn * BM + wc * 32 + 4 * fq + bj * HALF + 16 * n) = pk4_fp8(v[0], v[1], v[2], v[3]);
                        else { u32x2 w; w.x = cvt_pk_bf16(v[0], v[1]); w.y = cvt_pk_bf16(v[2], v[3]); *(u32x2*)(rowp + bj * HALF + 16 * n) = w; } }
                ss += __shfl_xor(ss, 16); ss += __shfl_xor(ss, 32);
                if (fq == 0) ssq[(size_t)row * 16 + pn * 4 + wc] = ss; }
    }
};
template <int NS> struct EpiRowScale {
    static constexpr bool PERM = true;
    unsigned char* O; int ldc; const float* ssq; int s0; float inv_cols;
    __device__ __forceinline__ void operator()(const f32x4 (&acc)[2][2][4][2], const Unit& u, int wr, int wc, int fr, int fq) const {
        const int row0 = u.pm * BM + wr * 64 + fr; const int col0 = u.pn * BM + wc * 32 + 8 * fq;
#pragma unroll
        for (int ai = 0; ai < 2; ++ai)
#pragma unroll
            for (int m = 0; m < 4; ++m) { const int row = row0 + ai * HALF + m * 16;
                float ss = 0.f; const f32x4* sp = (const f32x4*)(ssq + (size_t)row * 16 + s0);
#pragma unroll
                for (int q = 0; q < NS; ++q) { const f32x4 t = sp[q]; ss += (t[0] + t[1]) + (t[2] + t[3]); }
                const float rstd = W8_INV / sqrtf(ss * inv_cols + EPS);
                unsigned char* rowp = O + (size_t)row * ldc + col0;
#pragma unroll
                for (int bj = 0; bj < 2; ++bj) { const f32x4 v0 = acc[ai][bj][m][0] * rstd, v1 = acc[ai][bj][m][1] * rstd;
                    u32x2 w; w.x = pk4_fp8(v0[0], v0[1], v0[2], v0[3]); w.y = pk4_fp8(v1[0], v1[1], v1[2], v1[3]);
                    *(u32x2*)(rowp + bj * HALF) = w; }
                asm volatile("" ::: "memory"); }
    }
};
__device__ __forceinline__ void store8_sc1(void* p, u32x2 v) { asm volatile("global_store_dwordx2 %0, %1, off sc1" :: "v"(p), "v"(v) : "memory"); }
template <bool WT = false> struct EpiSwigluT {
    static constexpr bool PERM = true;
    unsigned char* ACT; const float* b1p;
    __device__ __forceinline__ void operator()(const f32x4 (&acc)[2][2][4][2], const Unit& u, int wr, int wc, int fr, int fq) const {
        const int row0 = u.pm * BM + wr * 64 + fr, e = u.pb >> 3, pn = u.pn;
        const float* bp = b1p + (size_t)e * 2048 + pn * BM + wc * 32 + 8 * fq;
        f32x4 bg[2], bl[2];
#pragma unroll
        for (int n = 0; n < 2; ++n) { bg[n] = *(const f32x4*)(bp + 4 * n); bl[n] = *(const f32x4*)(bp + HALF + 4 * n); }
#pragma unroll
        for (int ai = 0; ai < 2; ++ai)
#pragma unroll
            for (int m = 0; m < 4; ++m) { unsigned char* rowp = ACT + (size_t)(row0 + ai * HALF + m * 16) * DE + pn * HALF + wc * 32 + 8 * fq;
                float a[8];
#pragma unroll
                for (int n = 0; n < 2; ++n) { const f32x4 gv = acc[ai][0][m][n] * W8_INV + bg[n], lv = acc[ai][1][m][n] * W8_INV + bl[n];
#pragma unroll
                    for (int i = 0; i < 4; ++i) { const float gl = fminf(gv[i], 7.0f), li = fminf(fmaxf(lv[i], -7.0f), 7.0f);
                        const float sg = __builtin_amdgcn_rcpf(1.0f + __builtin_amdgcn_exp2f(-1.702f * LOG2E * gl));
                        a[4 * n + i] = gl * sg * (li + 1.0f); } }
                u32x2 w; w.x = pk4_fp8(a[0], a[1], a[2], a[3]); w.y = pk4_fp8(a[4], a[5], a[6], a[7]);
                if (WT) store8_sc1(rowp, w); else *(u32x2*)rowp = w; }
    }
};
typedef EpiSwigluT<false> EpiSwiglu;
struct EpiDown {
    static constexpr bool PERM = true;
    bf16_t* Y; const float* b2;
    __device__ __forceinline__ void operator()(const f32x4 (&acc)[2][2][4][2], const Unit& u, int wr, int wc, int fr, int fq) const {
        const int row0 = u.pm * BM + wr * 64 + fr, e = u.pb >> 2, pn = u.pn;
        const float* bp = b2 + (size_t)e * DM + pn * BM + wc * 32 + 8 * fq;
        f32x4 bv[2][2];
#pragma unroll
        for (int bj = 0; bj < 2; ++bj)
#pragma unroll
            for (int n = 0; n < 2; ++n) bv[bj][n] = *(const f32x4*)(bp + bj * HALF + 4 * n);
#pragma unroll
        for (int ai = 0; ai < 2; ++ai)
#pragma unroll
            for (int m = 0; m < 4; ++m) { bf16_t* rowp = Y + (size_t)(row0 + ai * HALF + m * 16) * DM + pn * BM + wc * 32 + 8 * fq;
#pragma unroll
                for (int bj = 0; bj < 2; ++bj) { const f32x4 v0 = acc[ai][bj][m][0] * W8_INV + bv[bj][0], v1 = acc[ai][bj][m][1] * W8_INV + bv[bj][1];
                    u32x4 w; w.x = cvt_pk_bf16(v0[0], v0[1]); w.y = cvt_pk_bf16(v0[2], v0[3]); w.z = cvt_pk_bf16(v1[0], v1[1]); w.w = cvt_pk_bf16(v1[2], v1[3]);
                    *(u32x4*)(rowp + bj * HALF) = w; } }
    }
};
struct MoeOrder {
    const LAS int* tbl; int nN, G, c;
    __device__ bool next(int i, Unit& u) const {
        const long L = (long)i * G + c; const int rb = (int)(L / nN);
        if (rb >= __builtin_amdgcn_readfirstlane(tbl[32])) return false;
        int e = 0;
#pragma unroll
        for (int k = 1; k < 32; ++k) e += (tbl[k] <= rb) ? 1 : 0;
        e = __builtin_amdgcn_readfirstlane(e); const int rbl = __builtin_amdgcn_readfirstlane(rb - tbl[e]);
        u.pm = e * (ECAP / BM) + rbl; u.pn = (int)(L % nN); u.pb = e * nN + u.pn; u.kind = 0; u.rb = rb; return true;
    }
    __device__ __forceinline__ void a_ready(const Unit&) const {}
    __device__ __forceinline__ void pre_epi() const {}
    __device__ __forceinline__ void done(const Unit&) const {}
    __device__ __forceinline__ void finish() const {}
};

constexpr unsigned MOE_SPIN_CAP = 1u << 22;
struct MoeMergedOrder {
    const LAS int* tbl; int G, c; gu32* cnt;
    mutable int pend;
    __device__ __forceinline__ void flush() const {
        if (pend >= 0) { asm volatile("s_waitcnt vmcnt(0)" ::: "memory");
            if ((threadIdx.x & 63) == 0) __hip_atomic_fetch_add(cnt + 16 * pend, 1u, __ATOMIC_RELAXED, __HIP_MEMORY_SCOPE_AGENT);
            pend = -1; } }
    __device__ bool next(int i, Unit& u) const {
        const int nb = __builtin_amdgcn_readfirstlane(tbl[32]);
        long L = (long)i * G + c; int nN = 8, kind = 0;
        if (L >= (long)nb * 8) { L -= (long)nb * 8; nN = 4; kind = 1; if (L >= (long)nb * 4) return false; }
        const int rb = (int)(L / nN);
        int e = 0;
#pragma unroll
        for (int k = 1; k < 32; ++k) e += (tbl[k] <= rb) ? 1 : 0;
        e = __builtin_amdgcn_readfirstlane(e); const int rbl = __builtin_amdgcn_readfirstlane(rb - tbl[e]);
        u.pm = e * (ECAP / BM) + rbl; u.pn = (int)(L % nN); u.pb = e * nN + u.pn; u.kind = kind; u.rb = rb; return true;
    }
    __device__ __forceinline__ void a_ready(const Unit& u) const {
        if (u.kind == 1) {
            flush();
            if (threadIdx.x < 64) {
                unsigned sp = 0;
                while ((unsigned)__builtin_amdgcn_readfirstlane(__hip_atomic_load(cnt + 16 * u.rb, __ATOMIC_RELAXED, __HIP_MEMORY_SCOPE_AGENT)) < 64u) { __builtin_amdgcn_s_sleep(2); if (++sp > MOE_SPIN_CAP) break; }
                __builtin_amdgcn_fence(__ATOMIC_ACQUIRE, "agent");
                asm volatile("s_waitcnt vmcnt(0)" ::: "memory");
            }
            __builtin_amdgcn_s_barrier();
        }
    }
    __device__ __forceinline__ void pre_epi() const { flush(); }
    __device__ __forceinline__ void done(const Unit& u) const { if (u.kind == 0) pend = u.rb; }
    __device__ __forceinline__ void finish() const { flush(); }
};
struct EpiMoe {
    static constexpr bool PERM = true;
    EpiSwigluT<true> up; EpiDown down;
    __device__ __forceinline__ void operator()(const f32x4 (&acc)[2][2][4][2], const Unit& u, int wr, int wc, int fr, int fq) const {
        if (u.kind == 0) up(acc, u, wr, wc, fr, fq); else down(acc, u, wr, wc, fr, fq);
    }
};
}

__device__ __forceinline__ void gmlp_unit(Frame& F, const bf16_t* Z, bf16_t* MIX, const float* Ws, const float* bs, const float* gv, int unit) {
    constexpr int VP = 272;
    LAS unsigned char* VT = F.lds + RING_OFF;
    const int h = unit & 3, chunk = unit >> 2;
    int tid_ = threadIdx.x; asm volatile("" : "+v"(tid_));
    const int t0 = chunk * 128, tid = tid_, lane = tid & 63, w = __builtin_amdgcn_readfirstlane(tid >> 6);
    {
        const int s = tid >> 2, dq = (tid & 3) * 32;
        const bf16_t* vp = Z + (size_t)(t0 + s) * EVEN_IN + 512 + h * 128 + dq;
        u32x4 raw[4]; float ss = 0.f;
#pragma unroll
        for (int i = 0; i < 4; ++i) { raw[i] = *(const u32x4*)(vp + 8 * i);
#pragma unroll
            for (int j = 0; j < 4; ++j) { const float a = bflo(raw[i][j]), b = bfhi(raw[i][j]); ss += a * a + b * b; } }
        ss += __shfl_xor(ss, 1); ss += __shfl_xor(ss, 2);
        const float rstd = 1.0f / sqrtf(ss * (1.0f / 128.0f) + EPS);
#pragma unroll
        for (int i = 0; i < 4; ++i)
#pragma unroll
            for (int j = 0; j < 4; ++j) { const int d = dq + 8 * i + 2 * j;
                *(LAS bf16_t*)(VT + (d) * VP + s * 2) = f2bf(bflo(raw[i][j]) * rstd);
                *(LAS bf16_t*)(VT + (d + 1) * VP + s * 2) = f2bf(bfhi(raw[i][j]) * rstd); }
    }
    __syncthreads();
    const int fr = lane & 15, fq = lane >> 4;
    f32x4 acc[8];
#pragma unroll
    for (int nb = 0; nb < 8; ++nb) acc[nb] = (f32x4){0.f, 0.f, 0.f, 0.f};
    const int trow = 16 * w + fr;
    const float* wrow = Ws + ((size_t)h * 128 + trow) * 128;
#pragma unroll
    for (int ks = 0; ks < 4; ++ks) {
        if (32 * ks <= 16 * w + 15) {
            const int s0 = 32 * ks + 8 * fq;
            const f32x4 wa = *(const f32x4*)(wrow + s0), wb = *(const f32x4*)(wrow + s0 + 4);
            float wv[8] = {wa[0], wa[1], wa[2], wa[3], wb[0], wb[1], wb[2], wb[3]};
#pragma unroll
            for (int j = 0; j < 8; ++j) if (s0 + j > trow) wv[j] = 0.f;
            u32x4 aw; aw.x = cvt_pk_bf16(wv[0], wv[1]); aw.y = cvt_pk_bf16(wv[2], wv[3]); aw.z = cvt_pk_bf16(wv[4], wv[5]); aw.w = cvt_pk_bf16(wv[6], wv[7]);
            const bf16x8 af = __builtin_bit_cast(bf16x8, aw);
#pragma unroll
            for (int nb = 0; nb < 8; ++nb) { const bf16x8 bfr = *(const LAS bf16x8*)(VT + (16 * nb + fr) * VP + s0 * 2);
                acc[nb] = __builtin_amdgcn_mfma_f32_16x16x32_bf16(af, bfr, acc[nb], 0, 0, 0); }
        }
    }
    LAS bf16_t* DT = (LAS bf16_t*)(F.lds + RING_OFF + 36864);
#pragma unroll
    for (int i = 0; i < 4; ++i) { const int tl = 16 * w + 4 * fq + i; const float bt = bs[h * 128 + tl];
#pragma unroll
        for (int nb = 0; nb < 8; ++nb) DT[tl * 136 + 16 * nb + fr] = f2bf(gv[h * 128 + 16 * nb + fr] * acc[nb][i] + bt); }
    __syncthreads();
#pragma unroll
    for (int k = 0; k < 4; ++k) { const int idx = tid + 512 * k, tl = idx >> 4, c8 = (idx & 15) * 8;
        const u32x4 mv = *(const LAS u32x4*)(DT + tl * 136 + c8); const u32x4 uv = *(const u32x4*)(Z + (size_t)(t0 + tl) * EVEN_IN + h * 128 + c8);
        u32x4 o; o.x = cvt_pk_bf16(bflo(uv.x) * bflo(mv.x), bfhi(uv.x) * bfhi(mv.x)); o.y = cvt_pk_bf16(bflo(uv.y) * bflo(mv.y), bfhi(uv.y) * bfhi(mv.y));
        o.z = cvt_pk_bf16(bflo(uv.z) * bflo(mv.z), bfhi(uv.z) * bfhi(mv.z)); o.w = cvt_pk_bf16(bflo(uv.w) * bflo(mv.w), bfhi(uv.w) * bfhi(mv.w));
        *(u32x4*)(MIX + (size_t)(t0 + tl) * DM + h * 128 + c8) = o; }
    __syncthreads();
}

__device__ __forceinline__ void router_phase(Frame& F, const bf16_t* x, const float* gain, const float* Wr, const float* br, gu32* cnt  ,
                                             unsigned* tok_er, float* tok_g, unsigned char* XG) {
    LAS float* part = (LAS float*)(F.lds + RING_OFF);
    LAS float* ssqp = (LAS float*)(F.lds + RING_OFF + 8 * 64 * 33 * 4);
    LAS float* lg = (LAS float*)(F.lds + SCR_OFF);
    LAS unsigned* hist = (LAS unsigned*)(F.lds + SCR_OFF + 64 * 33 * 4);
    LAS unsigned* base = hist + 32;
    LAS unsigned* ers = base + 32;
    int tid_ = threadIdx.x; asm volatile("" : "+v"(tid_));
    const int tid = tid_, lane = tid & 63, w = __builtin_amdgcn_readfirstlane(tid >> 6), r32 = lane & 31, hi = lane >> 5;
#ifndef RTR_REP_A
#define RTR_REP_A 1
#define RTR_REP_B 1
#define RTR_REP_C 1
#endif
    f32x4 gg[4];
#pragma unroll
    for (int j = 0; j < 4; ++j) gg[j] = ((const f32x4*)gain + lane)[64 * j];
    {   const int tg = F.vcu;
    const int tokb = tg * 64;
    if (tid < 32) hist[tid] = 0u;
    for (int rb_ = 0; rb_ < RTR_REP_B; ++rb_) {
        bf16x8 wh[8], wl[8];
#pragma unroll
        for (int ks = 0; ks < 8; ++ks) { float wv[8];
#pragma unroll
            for (int j = 0; j < 8; ++j) { const int k = 128 * w + 16 * ks + 8 * hi + j; wv[j] = Wr[(size_t)k * NE + r32] * gain[k]; }
            u32x4 h4, l4;
#pragma unroll
            for (int j = 0; j < 4; ++j) { const unsigned hp = cvt_pk_bf16(wv[2 * j], wv[2 * j + 1]); h4[j] = hp; l4[j] = cvt_pk_bf16(wv[2 * j] - bflo(hp), wv[2 * j + 1] - bfhi(hp)); }
            wh[ks] = __builtin_bit_cast(bf16x8, h4); wl[ks] = __builtin_bit_cast(bf16x8, l4); }
#pragma unroll
        for (int g2 = 0; g2 < 2; ++g2) {
            const bf16_t* xr = x + (size_t)(tokb + 32 * g2 + r32) * DM + 128 * w + 8 * hi;
            f32x16 d = f32x16{}; float ss = 0.f;
#pragma unroll
            for (int ks = 0; ks < 8; ++ks) { const u32x4 xw = *(const u32x4*)(xr + 16 * ks);
#pragma unroll
                for (int j = 0; j < 4; ++j) { const float a = bflo(xw[j]), b = bfhi(xw[j]); ss += a * a + b * b; }
                const bf16x8 xh = __builtin_bit_cast(bf16x8, xw);
                d = __builtin_amdgcn_mfma_f32_32x32x16_bf16(wh[ks], xh, d, 0, 0, 0);
                d = __builtin_amdgcn_mfma_f32_32x32x16_bf16(wl[ks], xh, d, 0, 0, 0); }
            { auto rr = __builtin_amdgcn_permlane32_swap(__float_as_uint(ss), __float_as_uint(ss), false, false); ss = __uint_as_float(rr[0]) + __uint_as_float(rr[1]); }
            if (hi == 0) ssqp[w * 64 + 32 * g2 + r32] = ss;
#pragma unroll
            for (int r = 0; r < 16; ++r) part[(w * 64 + 32 * g2 + r32) * 33 + (r & 3) + 8 * (r >> 2) + 4 * hi] = d[r];
        }
    }
    __syncthreads();
    {   const int t = tid >> 3, q4 = (tid & 7) * 4; float s = 0.f;
#pragma unroll
        for (int ww = 0; ww < 8; ++ww) s += ssqp[ww * 64 + t];
        const float rstd = 1.0f / sqrtf(s * (1.f / DM) + EPS);
#pragma unroll
        for (int i = 0; i < 4; ++i) { float a = 0.f;
#pragma unroll
            for (int ww = 0; ww < 8; ++ww) a += part[(ww * 64 + t) * 33 + q4 + i];
            lg[t * 33 + q4 + i] = a * rstd + br[q4 + i]; } }
    __syncthreads();
    unsigned my_e[4] = {0, 0, 0, 0}, my_lr[4] = {0, 0, 0, 0}; float my_g[4] = {0, 0, 0, 0};
    if (tid < 64) {
        float v[32];
#pragma unroll
        for (int e = 0; e < 32; ++e) v[e] = lg[tid * 33 + e];
        int c0 = -1, c1 = -1, c2 = -1; float tv[4];
#pragma unroll
        for (int r = 0; r < 4; ++r) { float best = -__builtin_inff(); int bi = 0;
#pragma unroll
            for (int e = 0; e < 32; ++e) { const bool ok = (e != c0) && (e != c1) && (e != c2); if (ok && v[e] > best) { best = v[e]; bi = e; } }
            tv[r] = best; my_e[r] = (unsigned)bi; if (r == 0) c0 = bi; else if (r == 1) c1 = bi; else if (r == 2) c2 = bi; }
        const float p1 = __expf(tv[1] - tv[0]), p2 = __expf(tv[2] - tv[0]), p3 = __expf(tv[3] - tv[0]); const float inv = 1.0f / (1.0f + p1 + p2 + p3);
        my_g[0] = inv; my_g[1] = p1 * inv; my_g[2] = p2 * inv; my_g[3] = p3 * inv;
#pragma unroll
        for (int r = 0; r < 4; ++r) my_lr[r] = __hip_atomic_fetch_add(hist + my_e[r], 1u, __ATOMIC_RELAXED, __HIP_MEMORY_SCOPE_WORKGROUP);
    }
    __syncthreads();
    if (tid < 32) { const unsigned hc = hist[tid]; base[tid] = hc ? __hip_atomic_fetch_add(cnt + 64 * tid, hc, RLX_AGENT) : 0u; }
    __syncthreads();
    if (tid < 64) {
        u32x4 er; f32x4 gt;
#pragma unroll
        for (int r = 0; r < 4; ++r) { const unsigned rank = base[my_e[r]] + my_lr[r]; er[r] = (my_e[r] << 16) | rank; gt[r] = my_g[r]; ers[tid * 4 + r] = er[r]; }
        *(u32x4*)(tok_er + (size_t)(tokb + tid) * 4) = er; *(f32x4*)(tok_g + (size_t)(tokb + tid) * 4) = gt;
    }
    __syncthreads();
    for (int rc_ = 0; rc_ < RTR_REP_C; ++rc_)
#pragma unroll 2
    for (int tt = 0; tt < 8; ++tt) {
        const int tl = w * 8 + tt; const bf16_t* xrow = x + (size_t)(tokb + tl) * DM;
        f32x4 hv[4]; float s = 0.f;
#pragma unroll
        for (int j = 0; j < 4; ++j) { const u32x2 t = ((const u32x2*)xrow + lane)[64 * j]; hv[j] = (f32x4){bflo(t.x), bfhi(t.x), bflo(t.y), bfhi(t.y)}; s += (hv[j].x * hv[j].x + hv[j].y * hv[j].y) + (hv[j].z * hv[j].z + hv[j].w * hv[j].w); }
        const float rstd = 1.0f / sqrtf(wave_sum(s) * (1.f / DM) + EPS);
        unsigned wv[4];
#pragma unroll
        for (int j = 0; j < 4; ++j) { const f32x4 t = hv[j] * rstd * gg[j]; wv[j] = pk4_fp8(t.x, t.y, t.z, t.w); }
#pragma unroll
        for (int r = 0; r < 4; ++r) { const unsigned er = ers[tl * 4 + r]; const size_t slot = (size_t)(er >> 16) * ECAP + (er & 0xffffu);
            unsigned* o4 = (unsigned*)(XG + slot * DM) + lane;
#pragma unroll
            for (int j = 0; j < 4; ++j) o4[64 * j] = wv[j]; }
    }
    __syncthreads();
    }
}

__device__ __forceinline__ void combine_phase(Frame& F, bf16_t* x, float* out32  , const unsigned* tok_er, const float* tok_g, const bf16_t* Y, const float* g_next, unsigned char* XN, bool xn_fp8) {
    int tid_ = threadIdx.x; asm volatile("" : "+v"(tid_));
    const int gw = F.vcu * NWAVES + __builtin_amdgcn_readfirstlane(tid_ >> 6), NGW = F.G * NWAVES, lane = tid_ & 63;
    for (int m = gw; m < M; m += NGW) {
        const u32x4 er = *(const u32x4*)(tok_er + (size_t)m * 4); const f32x4 gt = *(const f32x4*)(tok_g + (size_t)m * 4);
        f32x4 v[4]; bf16_t* xrow = x + (size_t)m * DM;
#pragma unroll
        for (int j = 0; j < 4; ++j) { const u32x2 t = ((const u32x2*)xrow + lane)[64 * j]; v[j] = (f32x4){bflo(t.x), bfhi(t.x), bflo(t.y), bfhi(t.y)}; }
#pragma unroll
        for (int r = 0; r < 4; ++r) { const size_t slot = (size_t)(er[r] >> 16) * ECAP + (er[r] & 0xffffu); const u32x2* yp = (const u32x2*)(Y + slot * DM) + lane; const float g = gt[r];
#pragma unroll
            for (int j = 0; j < 4; ++j) { const u32x2 yv = yp[64 * j]; v[j].x += g * bflo(yv.x); v[j].y += g * bfhi(yv.x); v[j].z += g * bflo(yv.y); v[j].w += g * bfhi(yv.y); } }
#pragma unroll
        for (int j = 0; j < 4; ++j) { if (out32) ((f32x4*)(out32 + (size_t)m * DM) + lane)[64 * j] = v[j];
            else { u32x2 t; t.x = cvt_pk_bf16(v[j].x, v[j].y); t.y = cvt_pk_bf16(v[j].z, v[j].w); ((u32x2*)xrow + lane)[64 * j] = t; } }
        if (g_next) {
            float s = 0.f;
#pragma unroll
            for (int j = 0; j < 4; ++j) s += (v[j].x * v[j].x + v[j].y * v[j].y) + (v[j].z * v[j].z + v[j].w * v[j].w);
            const float rstd = 1.0f / sqrtf(wave_sum(s) * (1.f / DM) + EPS);
            unsigned* o4 = (unsigned*)(XN + (size_t)m * DM) + lane; u32x2* o8 = (u32x2*)(XN + (size_t)m * DM * 2) + lane;
#pragma unroll
            for (int j = 0; j < 4; ++j) { const f32x4 gg = ((const f32x4*)g_next + lane)[64 * j];
                if (xn_fp8) o4[64 * j] = pk4_fp8(v[j].x * rstd * gg.x, v[j].y * rstd * gg.y, v[j].z * rstd * gg.z, v[j].w * rstd * gg.w);
                else { u32x2 w; w.x = cvt_pk_bf16(v[j].x * rstd * gg.x, v[j].y * rstd * gg.y); w.y = cvt_pk_bf16(v[j].z * rstd * gg.z, v[j].w * rstd * gg.w); o8[64 * j] = w; } }
        }
    }
}

__device__ __forceinline__ void unpack8f8(const u32x2 w, float (&f)[8]) { const f32x2 a = __builtin_amdgcn_cvt_pk_f32_fp8((int)w.x, false), b = __builtin_amdgcn_cvt_pk_f32_fp8((int)w.x, true),
    c = __builtin_amdgcn_cvt_pk_f32_fp8((int)w.y, false), d = __builtin_amdgcn_cvt_pk_f32_fp8((int)w.y, true); f[0] = a.x; f[1] = a.y; f[2] = b.x; f[3] = b.y; f[4] = c.x; f[5] = c.y; f[6] = d.x; f[7] = d.y; }
__device__ __forceinline__ void unpack4f8(const unsigned w, float (&f)[4]) { const f32x2 a = __builtin_amdgcn_cvt_pk_f32_fp8((int)w, false), b = __builtin_amdgcn_cvt_pk_f32_fp8((int)w, true); f[0] = a.x; f[1] = a.y; f[2] = b.x; f[3] = b.y; }
__device__ __forceinline__ void unpack8(const u32x4 w, float (&f)[8]) { f[0] = bflo(w.x); f[1] = bfhi(w.x); f[2] = bflo(w.y); f[3] = bfhi(w.y); f[4] = bflo(w.z); f[5] = bfhi(w.z); f[6] = bflo(w.w); f[7] = bfhi(w.w); }
__device__ __forceinline__ void unpack4(const u32x2 w, float (&f)[4]) { f[0] = bflo(w.x); f[1] = bfhi(w.x); f[2] = bflo(w.y); f[3] = bfhi(w.y); }
__device__ __forceinline__ void fin_head(const float (&a)[8], const float (&b)[8], const float (&x1)[4], const float (&x2)[4], const float (&g)[24], const float (&cs)[4], const float (&sn)[4], unsigned char* op, int j) {
    float ss = 0.f;
#pragma unroll
    for (int i = 0; i < 8; ++i) ss += a[i] * a[i] + b[i] * b[i];
#pragma unroll
    for (int i = 0; i < 4; ++i) ss += x1[i] * x1[i] + x2[i] * x2[i];
    ss += __shfl_xor(ss, 1); ss += __shfl_xor(ss, 2); ss += __shfl_xor(ss, 4);
    const float rstd = 1.0f / sqrtf(ss * (1.0f / 192.0f) + EPS);
    u32x4 o0;
    o0.x = pk4_fp8(a[0] * rstd * g[0], a[1] * rstd * g[1], a[2] * rstd * g[2], a[3] * rstd * g[3]); o0.y = pk4_fp8(a[4] * rstd * g[4], a[5] * rstd * g[5], a[6] * rstd * g[6], a[7] * rstd * g[7]);
    o0.z = pk4_fp8(b[0] * rstd * g[8], b[1] * rstd * g[9], b[2] * rstd * g[10], b[3] * rstd * g[11]); o0.w = pk4_fp8(b[4] * rstd * g[12], b[5] * rstd * g[13], b[6] * rstd * g[14], b[7] * rstd * g[15]);
    float y1[4], y2[4];
#pragma unroll
    for (int i = 0; i < 4; ++i) { const float u = x1[i] * rstd * g[16 + i], v = x2[i] * rstd * g[20 + i]; y1[i] = u * cs[i] - v * sn[i]; y2[i] = u * sn[i] + v * cs[i]; }
    *(u32x4*)(op + 16 * j) = o0; *(unsigned*)(op + 128 + 4 * j) = pk4_fp8(y1[0], y1[1], y1[2], y1[3]); *(unsigned*)(op + 160 + 4 * j) = pk4_fp8(y2[0], y2[1], y2[2], y2[3]);
}
__device__ __forceinline__ void mla_finalize_phase(Frame& F, const unsigned char* QR, const unsigned char* KVR, const bf16_t* Z, const float* gq, const float* gk, unsigned char* QF, unsigned char* KF) {
    int tid_ = threadIdx.x; asm volatile("" : "+v"(tid_));
    const int gw = F.vcu * NWAVES + __builtin_amdgcn_readfirstlane(tid_ >> 6), NGW = F.G * NWAVES, lane = tid_ & 63;
    const int h = lane >> 3, j = lane & 7;
    float gqv[24], gkv[24], invf[4];
#pragma unroll
    for (int i = 0; i < 16; ++i) { gqv[i] = gq[16 * j + i]; gkv[i] = gk[16 * j + i]; }
#pragma unroll
    for (int i = 0; i < 4; ++i) { gqv[16 + i] = gq[128 + 4 * j + i]; gqv[20 + i] = gq[160 + 4 * j + i]; gkv[16 + i] = gk[128 + 4 * j + i]; gkv[20 + i] = gk[160 + 4 * j + i];
        invf[i] = __builtin_amdgcn_exp2f(-(float)(4 * j + i) * (13.287712379549449f / 32.0f)); }
#pragma unroll 2
    for (int m = gw; m < M; m += NGW) {
        const int pos = m & (SEQ - 1);
        float cs[4], sn[4];
#pragma unroll
        for (int i = 0; i < 4; ++i) { const double rev = (double)pos * (double)invf[i] * 0.15915494309189535; const float fr = (float)(rev - __builtin_rint(rev));
            sn[i] = __builtin_amdgcn_sinf(fr); cs[i] = __builtin_amdgcn_cosf(fr); }
        const unsigned char* qp = QR + (size_t)m * 1536 + h * 192; const unsigned char* kp = KVR + (size_t)m * 2048 + h * 256; const bf16_t* zp = Z + (size_t)m * ODD_INP + 768;
        const u32x4 qn = *(const u32x4*)(qp + 16 * j); const unsigned qr1 = *(const unsigned*)(qp + 128 + 4 * j), qr2 = *(const unsigned*)(qp + 160 + 4 * j);
        const u32x4 kn = *(const u32x4*)(kp + 16 * j); const u32x2 kr1 = *(const u32x2*)(zp + 4 * j), kr2 = *(const u32x2*)(zp + 32 + 4 * j);
        float a[8], b[8], x1[4], x2[4];
        unpack8f8((u32x2){qn.x, qn.y}, a); unpack8f8((u32x2){qn.z, qn.w}, b); unpack4f8(qr1, x1); unpack4f8(qr2, x2);
        fin_head(a, b, x1, x2, gqv, cs, sn, QF + (size_t)m * 1536 + h * 192, j);
        unpack8f8((u32x2){kn.x, kn.y}, a); unpack8f8((u32x2){kn.z, kn.w}, b); unpack4(kr1, x1); unpack4(kr2, x2);
        fin_head(a, b, x1, x2, gkv, cs, sn, KF + (size_t)m * 1536 + h * 192, j);
    }
}

__device__ __forceinline__ void vt_phase(Frame& F, const unsigned char* KVR, unsigned char* VT8) {
    int tid_ = threadIdx.x; asm volatile("" : "+v"(tid_));
    const int tid = tid_;
    LAS unsigned char* T = F.lds + RING_OFF;
    for (int it = F.vcu; it < M / 64; it += F.G) {
        const int m0 = it * 64, b = m0 / SEQ, tok0 = m0 % SEQ;
#pragma unroll 4
        for (int k = 0; k < 8; ++k) { const int idx = tid + 512 * k, tok = idx >> 6, grp = idx & 63, h = grp >> 3, d16 = (grp & 7) * 16;
            const u32x4 w = *(const u32x4*)(KVR + (size_t)(m0 + tok) * 2048 + h * 256 + 128 + d16);
            LAS unsigned char* tp = T + (h * 128 + d16) * 80 + tok;
#pragma unroll
            for (int i = 0; i < 4; ++i) { const unsigned x = w[i]; tp[(4 * i) * 80] = (unsigned char)x; tp[(4 * i + 1) * 80] = (unsigned char)(x >> 8); tp[(4 * i + 2) * 80] = (unsigned char)(x >> 16); tp[(4 * i + 3) * 80] = (unsigned char)(x >> 24); } }
        __syncthreads();
#pragma unroll 4
        for (int k = 0; k < 8; ++k) { const int idx = tid + 512 * k, row = idx >> 2, q = idx & 3;
            const u32x4 v = *(const LAS u32x4*)(T + row * 80 + 16 * q);
            *(u32x4*)(VT8 + ((size_t)b * 1024 + row) * SEQ + tok0 + 16 * q) = v; }
        __syncthreads();
    }
}

#ifndef PHMASK
#define PHMASK 0xFFFF
#endif
#ifndef REPMASK
#define REPMASK 0
#endif
#ifndef REPCNT
#define REPCNT 3
#endif
#define NREP(k) ((((REPMASK) >> (k)) & 1) ? (REPCNT) : 1)

#define LAUNDER_S(x) asm volatile("" : "+s"(x))
__device__ __forceinline__ const float* in_ptr(const Args& a, int i) { LAUNDER_S(i); return a.in[i]; }
#define PHASE_BEGIN() unsigned wso_ = 0u; LAUNDER_S(wso_); unsigned char* ws = args.ws + wso_; Frame Fp = F; Fp.vcu = __builtin_amdgcn_readfirstlane(Fp.vcu); Fp.G = __builtin_amdgcn_readfirstlane(Fp.G); LAUNDER_S(Fp.vcu); LAUNDER_S(Fp.G); \
    int bx_ = __builtin_amdgcn_readfirstlane((int)blockIdx.x); LAUNDER_S(bx_); (void)bx_; (void)ws
#define XN  ((unsigned char*)(ws + WS_XN))
#define Z   ((bf16_t*)(ws + WS_Z))
#define MIX ((bf16_t*)(ws + WS_MIX))
#define QR  ((unsigned char*)(ws + WS_QR))
#define KVR ((unsigned char*)(ws + WS_KVR))
#define QF  ((unsigned char*)(ws + WS_QF))
#define KF  ((unsigned char*)(ws + WS_KF))
#define XG  ((unsigned char*)(ws + WS_XG))
#define ACT ((unsigned char*)(ws + WS_ACT))
#define YB  ((bf16_t*)(ws + WS_Y))
#define SSQ ((float*)(ws + WS_SSQ))
#define TOKER ((unsigned*)(ws + WS_TOKER))
#define TOKG ((float*)(ws + WS_TOKG))
#define B1P ((float*)(ws + WS_B1P))
#define IN(i) in_ptr(args, (i))
__global__ void __launch_bounds__(NWAVES * 64, 2) trunk_fwd(Args args) {
    extern __shared__ __attribute__((aligned(16))) unsigned char lds_raw[];
    Frame F;
    F.lds = (LAS unsigned char*)lds_raw;
    F.G = gridDim.x; { const int bx = blockIdx.x; F.vcu = (F.G % 8 == 0) ? (bx % 8) * (F.G / 8) + bx / 8 : bx; }
    for (int u = threadIdx.x; u < (SCR_OFF - LDSCTL_OFF) / 4; u += NWAVES * 64) ((LAS unsigned*)(F.lds + LDSCTL_OFF))[u] = 0u;
    __syncthreads();
    (void)xcd_barrier_post((unsigned*)((gu32*)(args.ws + WS_CTL) + CW_BAR), (volatile LAS unsigned*)(F.lds + MISC_OFF) + 8);
#define GRID_BAR() do { unsigned wsb_ = 0u; LAUNDER_S(wsb_); XcdBarrier bar_; bar_.bar = (unsigned*)((gu32*)(args.ws + wsb_ + WS_CTL) + CW_BAR); bar_.x = xb_xcc_id(); \
        bar_.st = (volatile LAS unsigned*)(F.lds + MISC_OFF) + 8; xcd_barrier(bar_); } while (0)
#define X16 ((bf16_t*)(ws + WS_X16))
    const int stage_limit = args.stage_limit;

#if (PHMASK >> 0) & 1
            _Pragma("unroll") for (int rep_ = 0; rep_ < NREP(0); ++rep_) { if (rep_) GRID_BAR();
    {   PHASE_BEGIN(); const int ptid = threadIdx.x, gw = Fp.vcu * NWAVES + __builtin_amdgcn_readfirstlane(ptid >> 6), NGW = Fp.G * NWAVES;
        transpose_job<1>(Fp, IN(I_EWIN), DM, EVEN_IN, 2, (size_t)DM * EVEN_IN, (bf16_t*)(ws + WS_WEIN), (size_t)EVEN_IN * DM, nullptr, 0);
        transpose_job<0>(Fp, IN(I_EWOUT), DM, DM, 2, (size_t)DM * DM, (bf16_t*)(ws + WS_WEOUT), (size_t)DM * DM, nullptr, 0);
        transpose_job_fp8<0>(Fp, IN(I_OWIN), DM, ODD_IN, 2, (size_t)DM * ODD_IN, ws + WS_WOIN, (size_t)ODD_INP * DM);
        transpose_job_fp8<0>(Fp, IN(I_OWUQ), 512, 1536, 2, (size_t)512 * 1536, ws + WS_WUQ, (size_t)1536 * 512, IN(I_OGCQ), 512);
        transpose_job_fp8<0>(Fp, IN(I_OWUKV), 256, 2048, 2, (size_t)256 * 2048, ws + WS_WUKV, (size_t)2048 * 256, IN(I_OGCKV), 256);
        transpose_job_fp8<0>(Fp, IN(I_OWOUT), DM, DM, 2, (size_t)DM * DM, ws + WS_WOOUT, (size_t)DM * DM);
        transpose_job_fp8<2>(Fp, IN(I_W1), DM, 2 * DE, DEPTH * NE, (size_t)DM * 2 * DE, ws + WS_W1, (size_t)2 * DE * DM);
        transpose_job_fp8<0>(Fp, IN(I_W2), DE, DM, DEPTH * NE, (size_t)DE * DM, ws + WS_W2, (size_t)DM * DE);
        for (int i = bx_ * 512 + ptid; i < 2 * 12288; i += Fp.G * 512) { const int mi = i / 12288, r = i % 12288;
            *(u32x4*)(ws + WS_WOIN + (size_t)mi * ODD_INP * DM + (size_t)ODD_IN * DM + (size_t)r * 16) = (u32x4){0u, 0u, 0u, 0u}; }
        for (int i = bx_ * 512 + ptid; i < DEPTH * NE * 2048; i += Fp.G * 512) { const int c = i & 2047, o = 2 * (128 * (c >> 8) + (c & 127)) + ((c >> 7) & 1);
            B1P[i] = IN(I_B1)[(size_t)(i & ~2047) + o]; }
        for (int m = gw; m < M; m += NGW) rms_row_to_bf16(ptid & 63, IN(I_X) + (size_t)m * DM, IN(I_MIXN), (bf16_t*)XN + (size_t)m * DM, nullptr);
    }
            }
#endif
    GRID_BAR();

#ifdef EXTRA_BARS
    for (int xb_ = 0; xb_ < EXTRA_BARS; ++xb_) GRID_BAR();
#endif
    for (int l = 0; l < DEPTH; ++l) {
        const int li = l >> 1;
        if (2 * l + 1 > stage_limit) break;
        if ((l & 1) == 0) {
#if (PHMASK >> 1) & 1
            _Pragma("unroll") for (int rep_ = 0; rep_ < NREP(1); ++rep_) { if (rep_) GRID_BAR();
            {   PHASE_BEGIN(); pg8::Gemm g{(const bf16_t*)XN, (const bf16_t*)(ws + WS_WEIN) + (size_t)li * EVEN_IN * DM, DM, DM, nullptr, nullptr}; pg8::StaticOrder S; S.init(M, EVEN_IN, Fp.G, bx_);
                pg8::EpiEvenIn E{Z, IN(I_EGQ) + li * 64, IN(I_EGK) + li * 64};
                pg8::gemm_phase<pg8::EpiEvenIn, pg8::StaticOrder>(Fp.lds + RING_OFF, g, S, E); }
            }
#endif
            GRID_BAR();
            {   PHASE_BEGIN();
#if (PHMASK >> 2) & 1
            _Pragma("unroll") for (int rep_ = 0; rep_ < NREP(2); ++rep_) { if (rep_) GRID_BAR();
                for (int u = Fp.vcu; u < 512; u += Fp.G)
                    gmlp_unit(Fp, Z, MIX, IN(I_EWS) + (size_t)li * 4 * 128 * 128, IN(I_EBS) + li * 512, IN(I_EGV) + li * 512, u);
            }
#endif
#if (PHMASK >> 3) & 1
            _Pragma("unroll") for (int rep_ = 0; rep_ < NREP(3); ++rep_) { if (rep_) GRID_BAR();
                for (int u = Fp.vcu; u < 256; u += Fp.G) { const int bh = u >> 4, s = u & 15, b = bh >> 3, h = bh & 7;
                    for (int pass = 0; pass < 2; ++pass) { const int qb = pass ? 31 - s : s;
                        const bf16_t* zb = Z + (size_t)b * SEQ * EVEN_IN;
                        dil::unit(zb + 1024 + 64 * h, zb + 1536 + 64 * h, zb + 2048 + 64 * h, EVEN_IN, MIX + (size_t)b * SEQ * DM + 512 + 64 * h, DM, qb * 256, Fp.lds + RING_OFF, (LAS float*)(Fp.lds + SCR_OFF)); } }
            }
#endif
            }
            GRID_BAR();
#if (PHMASK >> 4) & 1
            _Pragma("unroll") for (int rep_ = 0; rep_ < NREP(4); ++rep_) { if (rep_) GRID_BAR();
            {   PHASE_BEGIN(); pg8::Gemm g{MIX, (const bf16_t*)(ws + WS_WEOUT) + (size_t)li * DM * DM, DM, DM, nullptr, nullptr}; pg8::StaticOrder S; S.init(M, DM, Fp.G, bx_);
                pg8::EpiResid E{l == 0 ? IN(I_X) : nullptr, X16};
                pg8::gemm_phase<pg8::EpiResid, pg8::StaticOrder>(Fp.lds + RING_OFF, g, S, E); }
            }
#endif
            GRID_BAR();
        } else {
#if (PHMASK >> 5) & 1
            _Pragma("unroll") for (int rep_ = 0; rep_ < NREP(5); ++rep_) { if (rep_) GRID_BAR();
            {   PHASE_BEGIN(); pg8::Gemm g{(const bf16_t*)XN, (const bf16_t*)(ws + WS_WOIN + (size_t)li * ODD_INP * DM), DM / 2, DM / 2, nullptr, nullptr}; pg8::StaticOrder S; S.init(M, ODD_INP, Fp.G, bx_);
                pg8::EpiOddIn E{Z, ws + WS_Z8, SSQ};
                pg8::gemm_phase<pg8::EpiOddIn, pg8::StaticOrder, true>(Fp.lds + RING_OFF, g, S, E); }
            }
#endif
            GRID_BAR();
#if (PHMASK >> 6) & 1
            _Pragma("unroll") for (int rep_ = 0; rep_ < NREP(6); ++rep_) { if (rep_) GRID_BAR();
            {   PHASE_BEGIN(); pg8::Gemm g{(const bf16_t*)(ws + WS_Z8 + 512), (const bf16_t*)(ws + WS_WUKV + (size_t)li * 2048 * 256), ODD_INP / 2, 128, nullptr, nullptr}; pg8::StaticOrder S; S.init(M, 2048, Fp.G, bx_);
                pg8::EpiRowScale<1> E{KVR, 2048, SSQ, 8, 1.0f / 256.0f};
                pg8::gemm_phase<pg8::EpiRowScale<1>, pg8::StaticOrder, true>(Fp.lds + RING_OFF, g, S, E); }
            {   PHASE_BEGIN(); pg8::Gemm g{(const bf16_t*)(ws + WS_Z8), (const bf16_t*)(ws + WS_WUQ + (size_t)li * 1536 * 512), ODD_INP / 2, 256, nullptr, nullptr}; pg8::StaticOrder S; S.init(M, 1536, Fp.G, bx_);
                pg8::EpiRowScale<2> E{QR, 1536, SSQ, 0, 1.0f / 512.0f};
                pg8::gemm_phase<pg8::EpiRowScale<2>, pg8::StaticOrder, true>(Fp.lds + RING_OFF, g, S, E); }
            }
#endif
            GRID_BAR();
#if (PHMASK >> 7) & 1
            _Pragma("unroll") for (int rep_ = 0; rep_ < NREP(7); ++rep_) { if (rep_) GRID_BAR();
            {   PHASE_BEGIN(); mla_finalize_phase(Fp, QR, KVR, Z, IN(I_OGQ) + li * 192, IN(I_OGK) + li * 192, QF, KF); vt_phase(Fp, KVR, ws + WS_VT); }
            }
#endif
            GRID_BAR();
#if (PHMASK >> 8) & 1
            _Pragma("unroll") for (int rep_ = 0; rep_ < NREP(8); ++rep_) { if (rep_) GRID_BAR();
            {   PHASE_BEGIN();
                for (int u = Fp.vcu; u < 256; u += Fp.G) { const int bh = u >> 4, s = u & 15, b = bh >> 3, h = bh & 7;
                    for (int pass = 0; pass < 2; ++pass) { const int qb = pass ? 31 - s : s;
                        mla::unit(QF + (size_t)b * SEQ * 1536 + 192 * h, KF + (size_t)b * SEQ * 1536 + 192 * h, 1536, ws + WS_VT + ((size_t)(b * 8 + h) * 128) * SEQ,
                                  ws + WS_MIX8 + (size_t)b * SEQ * DM + 128 * h, DM, qb * 256, Fp.lds + RING_OFF); } }
            }
            }
#endif
            GRID_BAR();
#if (PHMASK >> 9) & 1
            _Pragma("unroll") for (int rep_ = 0; rep_ < NREP(9); ++rep_) { if (rep_) GRID_BAR();
            {   PHASE_BEGIN(); pg8::Gemm g{(const bf16_t*)(ws + WS_MIX8), (const bf16_t*)(ws + WS_WOOUT + (size_t)li * DM * DM), DM / 2, DM / 2, nullptr, nullptr}; pg8::StaticOrder S; S.init(M, DM, Fp.G, bx_);
                pg8::EpiResidT<true> E{nullptr, X16};
                pg8::gemm_phase<pg8::EpiResidT<true>, pg8::StaticOrder, true>(Fp.lds + RING_OFF, g, S, E); }
            }
#endif
            GRID_BAR();
        }
        if (2 * l + 2 > stage_limit) break;
#if (PHMASK >> 10) & 1
            _Pragma("unroll") for (int rep_ = 0; rep_ < NREP(10); ++rep_) {
        {   PHASE_BEGIN(); const bool dry = rep_ + 1 < NREP(10);
            gu32* cnt = (gu32*)(ws + WS_CTL) + CW_CNT + (size_t)(dry ? 8 + 4 * rep_ + l : l) * 32 * 64;
        router_phase(Fp, X16, IN(I_FFNN) + l * DM, IN(I_RW) + (size_t)l * DM * NE, IN(I_RB) + l * NE, cnt, dry ? (unsigned*)(ws + WS_QR) : TOKER, dry ? (float*)(ws + WS_QR + MiB) : TOKG, dry ? ACT : XG); }
        GRID_BAR();
            }
#endif
        LAS int* tbl = (LAS int*)(F.lds + SCR_OFF + 12288);
        {   PHASE_BEGIN(); gu32* cnt = (gu32*)(ws + WS_CTL) + CW_CNT + (size_t)l * 32 * 64;
        if (threadIdx.x == 0) { int acc = 0; for (int e = 0; e < NE; ++e) { tbl[e] = acc; const unsigned c = __hip_atomic_load(cnt + 64 * e, RLX_AGENT); acc += (int)((c + 255u) >> 8); } tbl[NE] = acc; }
        __syncthreads(); }
#if (PHMASK >> 11) & 1
            _Pragma("unroll") for (int rep_ = 0; rep_ < NREP(11); ++rep_) { if (rep_) GRID_BAR();
        {   PHASE_BEGIN();
            pg8::Gemm g{(const bf16_t*)XG, (const bf16_t*)(ws + WS_W1 + (size_t)l * NE * 2 * DE * DM), DM / 2, DM / 2, (const bf16_t*)ACT, (const bf16_t*)(ws + WS_W2 + (size_t)l * NE * DM * DE)};
            pg8::MoeMergedOrder S{tbl, Fp.G, Fp.vcu, (gu32*)(ws + WS_CTL) + CW_MOE + (size_t)(l * 320 + 1280 * rep_) * 16, -1};
            pg8::EpiMoe E{{ACT, B1P + (size_t)l * NE * 2048}, {YB, IN(I_B2) + (size_t)l * NE * DM}};
            pg8::gemm_phase<pg8::EpiMoe, pg8::MoeMergedOrder, true>(Fp.lds + RING_OFF, g, S, E); }
            }
#endif
        GRID_BAR();
#if (PHMASK >> 13) & 1
            _Pragma("unroll") for (int rep_ = 0; rep_ < NREP(13); ++rep_) {
        {   PHASE_BEGIN(); const bool dry = rep_ + 1 < NREP(13);
            combine_phase(Fp, dry ? (bf16_t*)(ACT + (size_t)128 * MiB) : X16, (!dry && l + 1 == DEPTH) ? args.out : nullptr, TOKER, TOKG, YB, (l + 1 < DEPTH) ? IN(I_MIXN) + (l + 1) * DM : nullptr, dry ? (ACT + (size_t)64 * MiB) : XN, (l & 1) == 0); }
        GRID_BAR();
            }
#endif
    }
#undef GRID_BAR
}

extern "C" void kernel_launch(void* const* d_in, const int* in_sizes, int n_in, void* d_out, int out_size, void* d_ws, size_t ws_size, hipStream_t stream) {
    static int grid = 0;
    if (grid == 0) {
        if (n_in != 24 || in_sizes[0] != M * DM || out_size != M * DM || ws_size < WS_END) {
            fprintf(stderr, "kernel_launch: unexpected shapes (n_in %d, in0 %d, out %d, ws %zu, need %zu)\n", n_in, n_in > 0 ? in_sizes[0] : -1, out_size, ws_size, (size_t)WS_END); grid = -1; return; }
        int dev = 0, cus = 0, per_cu = 0;
        if (hipGetDevice(&dev) != hipSuccess || hipDeviceGetAttribute(&cus, hipDeviceAttributeMultiprocessorCount, dev) != hipSuccess) { grid = -1; return; }
        if (hipFuncSetAttribute((const void*)trunk_fwd, hipFuncAttributeMaxDynamicSharedMemorySize, LDS_BYTES) != hipSuccess) { fprintf(stderr, "kernel_launch: hipFuncSetAttribute failed\n"); grid = -1; return; }
        if (hipOccupancyMaxActiveBlocksPerMultiprocessor(&per_cu, (const void*)trunk_fwd, NWAVES * 64, LDS_BYTES) != hipSuccess || per_cu < 1)
            fprintf(stderr, "kernel_launch: occupancy query reports %d workgroups per CU\n", per_cu);
        (void)hipGetLastError();
        if (cus < 256) { fprintf(stderr, "kernel_launch: needs 256 CUs, device has %d\n", cus); grid = -1; return; }
        grid = 256;
    }
    if (grid < 0) return;
    if (hipMemsetAsync((char*)d_ws + WS_CTL, 0, CTL_ZERO_BYTES, stream) != hipSuccess) return;
    Args a{};
    for (int i = 0; i < 24; ++i) a.in[i] = (const float*)d_in[i];
    a.out = (float*)d_out; a.ws = (unsigned char*)d_ws; a.stage_limit = STAGE_LIMIT; a.pad = 0;
    hipLaunchKernelGGL(trunk_fwd, dim3(grid), dim3(NWAVES * 64), LDS_BYTES, stream, a);
}
```

```cpp
#include <hip/hip_runtime.h>
#include <hip/hip_bf16.h>
#include <cstdio>
#include <cstdint>

#define LAS __attribute__((address_space(3)))
#define GAS __attribute__((address_space(1)))
typedef unsigned short bf16_t;
typedef short bf16x8 __attribute__((ext_vector_type(8)));
typedef short s16x4 __attribute__((ext_vector_type(4)));
typedef float f32x2 __attribute__((ext_vector_type(2)));
typedef float f32x4 __attribute__((ext_vector_type(4)));
typedef float f32x16 __attribute__((ext_vector_type(16)));
typedef unsigned u32x2 __attribute__((ext_vector_type(2)));
typedef unsigned u32x4 __attribute__((ext_vector_type(4)));
typedef int i32x4 __attribute__((ext_vector_type(4)));
typedef int i32x8 __attribute__((ext_vector_type(8)));

constexpr int BATCH = 2, SEQ = 8192, DM = 1024, M = BATCH * SEQ, DEPTH = 4;
constexpr int EVEN_IN = 2560, ODD_IN = 832, ODD_INP = 1024;
constexpr int NE = 32, DE = 1024, ECAP = 16384;
constexpr float EPS = 1e-6f;
constexpr float LOG2E = 1.4426950408889634f;
constexpr float C2_B = 0.125f * LOG2E;
constexpr float C2_C = 0.07216878364870322f * LOG2E;

__device__ __forceinline__ unsigned cvt_pk_bf16(float lo, float hi) { unsigned r; asm volatile("v_cvt_pk_bf16_f32 %0, %1, %2" : "=v"(r) : "v"(lo), "v"(hi)); return r; }
__device__ __forceinline__ float bf2f(bf16_t v) { return __uint_as_float(((unsigned)v) << 16); }
__device__ __forceinline__ float bflo(unsigned w) { return __uint_as_float(w << 16); }
__device__ __forceinline__ float bfhi(unsigned w) { return __uint_as_float(w & 0xffff0000u); }
__device__ __forceinline__ bf16_t f2bf(float f) { return (bf16_t)(cvt_pk_bf16(f, 0.f) & 0xffffu); }

__device__ __forceinline__ unsigned pk4_fp8(float a, float b, float c, float d) { int w = 0; w = __builtin_amdgcn_cvt_pk_fp8_f32(a, b, w, false); w = __builtin_amdgcn_cvt_pk_fp8_f32(c, d, w, true); return (unsigned)w; }
constexpr float W8_SCALE = 64.0f, W8_INV = 1.0f / 64.0f;

namespace pg8 {
constexpr int BM = 256, BK = 64, HALF = 128, HTB = HALF * BK * 2, STAGE_BYTES = 8 * HTB, NXCD = 8, WGM = 8;
__host__ __device__ __forceinline__ int lds_byte(int r, int c) { const int st = (r >> 4) * 2 + (c >> 5), rr = r & 15, cc = c & 31, ob = rr * 64 + cc * 2; return st * 1024 + (ob ^ (((ob >> 9) & 1) << 5)); }
__host__ __device__ __forceinline__ void stage_rc(int b, int& R, int& C) { const int st = b / 1024, sb = b % 1024, swz = sb ^ (((sb >> 9) & 1) << 5); R = (st >> 1) * 16 + swz / 64; C = (st & 1) * 32 + (swz % 64) / 2; }
__host__ __device__ __forceinline__ int perm32(int rho) { const int n = rho >> 4, i = rho & 15; return 8 * (i >> 2) + 4 * n + (i & 3); }

struct Unit { int pm, pn, pb, kind, rb; };
struct Gemm { const bf16_t* A; const bf16_t* Bt; int lda, K; const bf16_t* A2; const bf16_t* Bt2; };

struct StaticOrder {
    int nM, nN, nwg, G, c;
    __device__ void init(int M_, int N_, int G_, int c_) { nM = M_ / BM; nN = N_ / BM; nwg = nM * nN; G = G_; c = c_; }
    __device__ bool next(int i, Unit& u) const {
        const long L = (long)i * G + c; if (L >= nwg) return false;
        int wgid = (int)L; { const int q = nwg / NXCD, r = nwg % NXCD, xcd = wgid % NXCD, off = wgid / NXCD; wgid = (xcd < r ? xcd * (q + 1) : r * (q + 1) + (xcd - r) * q) + off; }
        const int nig = WGM * nN, gid = wgid / nig, fm = gid * WGM, gsz = (nM - fm) < WGM ? (nM - fm) : WGM;
        u.pm = fm + ((wgid % nig) % gsz); u.pn = (wgid % nig) / gsz; u.pb = u.pn; u.kind = 0; u.rb = 0; return true;
    }
    __device__ __forceinline__ void a_ready(const Unit&) const {}
    __device__ __forceinline__ void pre_epi() const {}
    __device__ __forceinline__ void done(const Unit&) const {}
    __device__ __forceinline__ void finish() const {}
};

__device__ __forceinline__ f32x2 gelu_pk(f32x2 v) {
    const f32x2 av = __builtin_elementwise_abs(v), d = av * 0.2316418882f + 1.0f;
    f32x2 t; t.x = __builtin_amdgcn_rcpf(d.x); t.y = __builtin_amdgcn_rcpf(d.y);
    f32x2 q = t * 0.5307027145f + (-0.7265760135f); q = q * t + 0.7107068705f; q = q * t + (-0.142248368f); q = q * t + 0.127414796f; q = q * t;
    const f32x2 s = (v * v) * (-0.72134752044f);
    f32x2 e; e.x = __builtin_amdgcn_exp2f(s.x); e.y = __builtin_amdgcn_exp2f(s.y);
    const f32x2 m = v * (q * e), r = v - m;
    f32x2 o; o.x = v.x < 0.f ? m.x : r.x; o.y = v.y < 0.f ? m.y : r.y; return o;
}
__device__ __forceinline__ f32x4 gelu4(f32x4 v) { const f32x2 a = gelu_pk((f32x2){v[0], v[1]}), b = gelu_pk((f32x2){v[2], v[3]}); return (f32x4){a.x, a.y, b.x, b.y}; }

template <class Epi, class Sched, bool FP8 = false>
__device__ __forceinline__ void gemm_phase(LAS unsigned char* lds, const Gemm g, const Sched& S, const Epi& E) {
    int tid_ = threadIdx.x; asm volatile("" : "+v"(tid_));
    const int tid = tid_, wid = __builtin_amdgcn_readfirstlane(tid >> 6), lane = tid & 63, wr = wid >> 2, wc = wid & 3, fr = lane & 15, fq = lane >> 4;
    const int K = g.K, nt = K / BK;
    unsigned voffA[2], voffB[2];
#pragma unroll
    for (int i = 0; i < 2; ++i) { int R, C; stage_rc(tid * 16 + i * 8192, R, C); const int Rb = Epi::PERM ? ((R & ~31) + perm32(R & 31)) : R;
        voffA[i] = (unsigned)(R * g.lda + C) * 2u; voffB[i] = (unsigned)(Rb * K + C) * 2u; }
    const size_t kstep = (size_t)(BK * 2);
    const size_t hstepA = (size_t)HALF * g.lda * 2, tstepA = 2 * hstepA;
    const size_t hstepB = (size_t)HALF * K * 2, tstepB = 2 * hstepB;
    const unsigned ldsw = (unsigned)wid * 1024u;
    const int aoff = lds_byte(wr * 64 + fr, fq * 8), boff = lds_byte(wc * 32 + fr, fq * 8);
#define PG8_SA(b, h) (((b) * 2 + (h)) * HTB)
#define PG8_SB(b, h) ((4 + (b) * 2 + (h)) * HTB)
#define PG8_STAGE(bufoff, gbase, voff) do { _Pragma("unroll") for (int _i = 0; _i < 2; ++_i) \
        __builtin_amdgcn_global_load_lds((const unsigned*)((const char*)(gbase) + (voff)[_i]), (LAS unsigned*)(lds + (bufoff) + ldsw + _i * 8192), 16, 0, 0); } while (0)
#define PG8_LDA(dst, b, h) do { _Pragma("unroll") for (int m = 0; m < 4; ++m) { if constexpr (FP8) { const i32x4 lo_ = *(const LAS i32x4*)(lds + PG8_SA(b, h) + aoff + m * 2048), hi_ = *(const LAS i32x4*)(lds + PG8_SA(b, h) + aoff + m * 2048 + 1024); dst##8[m] = __builtin_shufflevector(lo_, hi_, 0, 1, 2, 3, 4, 5, 6, 7); } \
        else { _Pragma("unroll") for (int k = 0; k < 2; ++k) dst[m][k] = *(const LAS bf16x8*)(lds + PG8_SA(b, h) + aoff + m * 2048 + k * 1024); } } } while (0)
#define PG8_LDB(dst, b, h) do { _Pragma("unroll") for (int n = 0; n < 2; ++n) { if constexpr (FP8) { const i32x4 lo_ = *(const LAS i32x4*)(lds + PG8_SB(b, h) + boff + n * 2048), hi_ = *(const LAS i32x4*)(lds + PG8_SB(b, h) + boff + n * 2048 + 1024); dst##8[n] = __builtin_shufflevector(lo_, hi_, 0, 1, 2, 3, 4, 5, 6, 7); } \
        else { _Pragma("unroll") for (int k = 0; k < 2; ++k) dst[n][k] = *(const LAS bf16x8*)(lds + PG8_SB(b, h) + boff + n * 2048 + k * 1024); } } } while (0)
#define PG8_MMA(ai, bj, At, Bt) do { __builtin_amdgcn_s_setprio(1); _Pragma("unroll") for (int m = 0; m < 4; ++m) _Pragma("unroll") for (int n = 0; n < 2; ++n) { \
        if constexpr (FP8) asm volatile("s_nop 1\n\tv_mfma_f32_16x16x128_f8f6f4 %0, %1, %2, %0" : "+v"(acc[ai][bj][m][n]) : "v"(Bt##8[n]), "v"(At##8[m])); \
        else { _Pragma("unroll") for (int k = 0; k < 2; ++k) acc[ai][bj][m][n] = __builtin_amdgcn_mfma_f32_16x16x32_bf16(Bt[n][k], At[m][k], acc[ai][bj][m][n], 0, 0, 0); } } \
        __builtin_amdgcn_s_setprio(0); } while (0)
#define PG8_WAIT_V(n) asm volatile("s_waitcnt vmcnt(" #n ")" ::: "memory")
#define PG8_WAIT_L(n) asm volatile("s_waitcnt lgkmcnt(" #n ")" ::: "memory")
#define PG8_BAR __builtin_amdgcn_s_barrier()
#define PG8_SCHED __builtin_amdgcn_sched_barrier(0)
    Unit cur, nxt; int ui = 0;
    if (!S.next(0, cur)) return;
    f32x4 acc[2][2][4][2];
#pragma unroll
    for (int a = 0; a < 2; ++a)
#pragma unroll
        for (int b = 0; b < 2; ++b)
#pragma unroll
            for (int m = 0; m < 4; ++m)
#pragma unroll
                for (int n = 0; n < 2; ++n) acc[a][b][m][n] = (f32x4){0.f, 0.f, 0.f, 0.f};
    bf16x8 At[4][2], B0[2][2], B1[2][2]; i32x8 At8[4], B08[2], B18[2];
    const char* cA = (const char*)(cur.kind ? g.A2 : g.A) + (size_t)cur.pm * tstepA; const char* cB = (const char*)(cur.kind ? g.Bt2 : g.Bt) + (size_t)cur.pb * tstepB;
    S.a_ready(cur);
    PG8_STAGE(PG8_SB(0, 0), cB, voffB); PG8_STAGE(PG8_SB(0, 1), cB + hstepB, voffB); PG8_STAGE(PG8_SA(0, 0), cA, voffA); PG8_STAGE(PG8_SA(0, 1), cA + hstepA, voffA);
    if (wr == 1) PG8_BAR;
    PG8_WAIT_V(2); PG8_BAR;
    PG8_STAGE(PG8_SB(1, 0), cB + kstep, voffB); PG8_STAGE(PG8_SA(1, 0), cA + kstep, voffA); PG8_STAGE(PG8_SB(1, 1), cB + hstepB + kstep, voffB);
    PG8_WAIT_V(6); PG8_BAR;
    for (;;) {
        const bool has_next = S.next(ui + 1, nxt);
        const char* nA = has_next ? (const char*)(nxt.kind ? g.A2 : g.A) + (size_t)nxt.pm * tstepA : cA; const char* nB = has_next ? (const char*)(nxt.kind ? g.Bt2 : g.Bt) + (size_t)nxt.pb * tstepB : cB;
#pragma unroll 1
        for (int t = 0; t < nt; t += 2) {
            const bool last = (t == nt - 2);
            const char* a1 = cA + (size_t)(t + 1) * kstep;
            const char* a2 = last ? nA : cA + (size_t)(t + 2) * kstep; const char* b2 = last ? nB : cB + (size_t)(t + 2) * kstep;
            const char* a3 = a2 + kstep; const char* b3 = b2 + kstep;
            if (last && has_next) S.a_ready(nxt);
            PG8_LDB(B0, 0, 0); PG8_LDB(B1, 0, 1); PG8_SCHED; PG8_LDA(At, 0, 0); PG8_STAGE(PG8_SA(1, 1), a1 + hstepA, voffA);
            PG8_WAIT_V(8); PG8_WAIT_L(0); PG8_BAR; PG8_MMA(0, 0, At, B0); PG8_MMA(0, 1, At, B1); PG8_BAR; PG8_SCHED;
            PG8_LDA(At, 0, 1); PG8_STAGE(PG8_SB(0, 0), b2, voffB); PG8_STAGE(PG8_SB(0, 1), b2 + hstepB, voffB); PG8_STAGE(PG8_SA(0, 0), a2, voffA);
            PG8_WAIT_V(8); PG8_WAIT_L(0); PG8_BAR; PG8_MMA(1, 0, At, B0); PG8_MMA(1, 1, At, B1); PG8_BAR; PG8_SCHED;
            PG8_LDB(B0, 1, 0); PG8_LDB(B1, 1, 1); PG8_SCHED; PG8_LDA(At, 1, 0); PG8_STAGE(PG8_SA(0, 1), a2 + hstepA, voffA);
            PG8_WAIT_V(8); PG8_WAIT_L(0); PG8_BAR; PG8_MMA(0, 0, At, B0); PG8_MMA(0, 1, At, B1); PG8_BAR; PG8_SCHED;
            PG8_LDA(At, 1, 1); PG8_STAGE(PG8_SB(1, 0), b3, voffB); PG8_STAGE(PG8_SB(1, 1), b3 + hstepB, voffB); PG8_STAGE(PG8_SA(1, 0), a3, voffA);
            PG8_WAIT_V(8); PG8_WAIT_L(0); PG8_BAR; PG8_MMA(1, 0, At, B0); PG8_MMA(1, 1, At, B1); PG8_BAR; PG8_SCHED;
        }
        if (wr == 0) PG8_BAR;
        if constexpr (FP8) asm volatile("s_nop 15\n\ts_nop 7" ::: "memory");
        S.pre_epi();
        { int te_ = threadIdx.x; asm volatile("" : "+v"(te_));
          E(acc, cur, wr, wc, te_ & 15, (te_ & 63) >> 4); }
        S.done(cur);
        if (!has_next) break;
#pragma unroll
        for (int a = 0; a < 2; ++a)
#pragma unroll
            for (int b = 0; b < 2; ++b)
#pragma unroll
                for (int m = 0; m < 4; ++m)
#pragma unroll
                    for (int n = 0; n < 2; ++n) acc[a][b][m][n] = (f32x4){0.f, 0.f, 0.f, 0.f};
        cur = nxt; cA = nA; cB = nB; ++ui;
        if (wr == 1) PG8_BAR;
    }
    PG8_WAIT_V(0);
    S.finish();
    PG8_BAR;
#undef PG8_SA
#undef PG8_SB
#undef PG8_STAGE
#undef PG8_LDA
#undef PG8_LDB
#undef PG8_MMA
#undef PG8_WAIT_V
#undef PG8_WAIT_L
#undef PG8_BAR
#undef PG8_SCHED
}
}
constexpr int STAGE_LIMIT = 8;

namespace att {
__device__ __forceinline__ int crow(int r, int hi) { return (r & 3) + 8 * (r >> 2) + 4 * hi; }
__device__ __forceinline__ int v_rd_base(int lane) { return ((lane & 3) << 3) | (((lane >> 2) & 3) << 6) | (((lane >> 4) & 1) << 5) | (((lane >> 5) & 1) << 8); }
}

namespace dil {
using att::crow; using att::v_rd_base;
constexpr int OFF_O = 0, OFF_V = 65536, VWAVE = 8192;
template <int S_>
__device__ __forceinline__ void pass(const bf16_t* __restrict__ Qh, const bf16_t* __restrict__ Kh, const bf16_t* __restrict__ Vh, int pitch, int q0, LAS unsigned char* lds, LAS float* scr, int wid, int lane) {
    const int r32 = lane & 31, hi = lane >> 5;
    LAS float* Oacc = (LAS float*)(lds + OFF_O); LAS float* macc = scr; LAS float* lacc = scr + 256; LAS float* wsf = scr + 512 + wid * 64;
    LAS unsigned char* vbuf = lds + OFF_V + wid * VWAVE;
    constexpr int NG = (S_ == 16) ? 2 : 1, VR = (S_ == 16) ? 16 : 32;
    int vk[4], vc[4];
#pragma unroll
    for (int i = 0; i < 4; ++i) { const int off = (i * 64 + lane) * 16, st = off >> 9, within = off & 511, kk = (st >> 1) * 8 + (within >> 6);
        vk[i] = (kk & ~0xC) | ((kk & 4) << 1) | ((kk & 8) >> 1); vc[i] = (st & 1) * 32 + ((within & 63) >> 1); }
    const unsigned vb0 = (unsigned)(uintptr_t)vbuf + (unsigned)v_rd_base(lane);
#pragma unroll
    for (int gi = 0; gi < NG; ++gi) {
        const int rho = (S_ == 1) ? 0 : (S_ == 4) ? (wid & 3) : (2 * wid + gi);
        const int i0 = (S_ == 1) ? 32 * wid : (S_ == 4) ? 32 * (wid >> 2) : 0;
        const int qi = i0 + (r32 < VR ? r32 : r32 - VR);
        const int ql = rho + S_ * qi;
        bf16x8 qr[4];
#pragma unroll
        for (int d0 = 0; d0 < 4; ++d0) qr[d0] = *(const bf16x8*)(Qh + (size_t)(q0 + ql) * pitch + d0 * 16 + hi * 8);
        const int j0 = i0 - 128;
        const int tokb = q0 + rho + S_ * j0;
        bf16x8 kfA[4], kfB[4];
#define DIL_KLOAD(dst, c) do { int tk_ = tokb + S_ * (32 * (c) + r32); tk_ = tk_ < 0 ? 0 : (tk_ > SEQ - 1 ? SEQ - 1 : tk_);     \
            _Pragma("unroll") for (int d0 = 0; d0 < 4; ++d0) dst[d0] = *(const bf16x8*)(Kh + (size_t)tk_ * pitch + d0 * 16 + hi * 8); } while (0)
#define DIL_VDMA(c, bf) do { _Pragma("unroll") for (int i = 0; i < 4; ++i) { int tk_ = tokb + S_ * (32 * (c) + vk[i]); tk_ = tk_ < 0 ? 0 : (tk_ > SEQ - 1 ? SEQ - 1 : tk_); \
            __builtin_amdgcn_global_load_lds((const unsigned*)(Vh + (size_t)tk_ * pitch + vc[i]), (LAS unsigned*)(vbuf + (bf) * 4096 + i * 1024), 16, 0, 0); } } while (0)
        float m_reg = -1e30f, l_reg = 0.f; f32x16 o[2]; o[0] = f32x16{}; o[1] = f32x16{};
        DIL_KLOAD(kfA, 0); DIL_VDMA(0, 0);
#define DIL_STEP(KF, KN, c) do { \
            if ((c) < 4) { DIL_KLOAD(KN, (c) + 1); DIL_VDMA((c) + 1, ((c) + 1) & 1); asm volatile("s_waitcnt vmcnt(8)" ::: "memory"); } \
            else { asm volatile("s_waitcnt vmcnt(0)" ::: "memory"); } \
            f32x16 p = f32x16{}; \
            _Pragma("unroll") for (int d0 = 0; d0 < 4; ++d0) p = __builtin_amdgcn_mfma_f32_32x32x16_bf16(KF[d0], qr[d0], p, 0, 0, 0); \
            const unsigned vb = vb0 + (unsigned)(((c) & 1) * 4096); \
            s16x4 vl0[2], vh0[2], vl1[2], vh1[2]; \
            _Pragma("unroll") for (int d0 = 0; d0 < 2; ++d0) { \
                asm volatile("ds_read_b64_tr_b16 %0, %1 offset:%2" : "=&v"(vl0[d0]) : "v"(vb), "i"(d0 * 512) : "memory"); \
                asm volatile("ds_read_b64_tr_b16 %0, %1 offset:%2" : "=&v"(vh0[d0]) : "v"(vb), "i"(d0 * 512 + 1024) : "memory"); \
                asm volatile("ds_read_b64_tr_b16 %0, %1 offset:%2" : "=&v"(vl1[d0]) : "v"(vb), "i"(d0 * 512 + 2048) : "memory"); \
                asm volatile("ds_read_b64_tr_b16 %0, %1 offset:%2" : "=&v"(vh1[d0]) : "v"(vb), "i"(d0 * 512 + 3072) : "memory"); } \
              \
            { const float NEG = -__builtin_inff(); const int db = qi - j0 - 32 * (c) - 4 * hi; const int tb = tokb + S_ * (32 * (c) + 4 * hi); \
              if ((c) == 0 || (c) == 4 || tokb < 0) { \
                _Pragma("unroll") for (int r = 0; r < 16; ++r) { const int cr = (r & 3) + 8 * (r >> 2); \
                    const bool ok = ((unsigned)(db - cr) <= 128u) && (tb + S_ * cr >= 0); p[r] = ok ? p[r] : NEG; } } } \
            float pmax = p[0]; \
            _Pragma("unroll") for (int r = 1; r < 16; ++r) pmax = fmaxf(pmax, p[r]); \
            { auto rr = __builtin_amdgcn_permlane32_swap(__float_as_uint(pmax), __float_as_uint(pmax), false, false); pmax = fmaxf(__uint_as_float(rr[0]), __uint_as_float(rr[1])); } \
            const float mn = fmaxf(m_reg, pmax); const float alpha = __builtin_amdgcn_exp2f(m_reg - mn); m_reg = mn; \
            float ps = 0.f; \
            _Pragma("unroll") for (int r = 0; r < 16; ++r) { p[r] = __builtin_amdgcn_exp2f(p[r] - mn); ps += p[r]; } \
            { auto rr = __builtin_amdgcn_permlane32_swap(__float_as_uint(ps), __float_as_uint(ps), false, false); ps = __uint_as_float(rr[0]) + __uint_as_float(rr[1]); } \
            l_reg = l_reg * alpha + ps; \
            bf16x8 pa0, pa1; DIL_PK4(p, 0, pa0); DIL_PK4(p, 8, pa1); \
            if (__any(alpha < 1.f)) { if (hi == 0) wsf[r32] = alpha; asm volatile("s_waitcnt lgkmcnt(0)" ::: "memory"); \
                _Pragma("unroll") for (int r = 0; r < 16; ++r) { const float a = wsf[crow(r, hi)]; o[0][r] *= a; o[1][r] *= a; } } \
            asm volatile("s_waitcnt lgkmcnt(0)" ::: "memory"); __builtin_amdgcn_sched_barrier(0); \
            _Pragma("unroll") for (int d0 = 0; d0 < 2; ++d0) { \
                o[d0] = __builtin_amdgcn_mfma_f32_32x32x16_bf16(pa0, (bf16x8){vl0[d0][0], vl0[d0][1], vl0[d0][2], vl0[d0][3], vh0[d0][0], vh0[d0][1], vh0[d0][2], vh0[d0][3]}, o[d0], 0, 0, 0); \
                o[d0] = __builtin_amdgcn_mfma_f32_32x32x16_bf16(pa1, (bf16x8){vl1[d0][0], vl1[d0][1], vl1[d0][2], vl1[d0][3], vh1[d0][0], vh1[d0][1], vh1[d0][2], vh1[d0][3]}, o[d0], 0, 0, 0); } \
        } while (0)
#define DIL_PK4(P, B_, OUT) do { unsigned a0 = cvt_pk_bf16(P[B_+0], P[B_+1]), a1 = cvt_pk_bf16(P[B_+2], P[B_+3]);                          \
            unsigned b0_ = cvt_pk_bf16(P[B_+4], P[B_+5]), b1_ = cvt_pk_bf16(P[B_+6], P[B_+7]);                                             \
            auto r0 = __builtin_amdgcn_permlane32_swap(a0, b0_, false, false); auto r1 = __builtin_amdgcn_permlane32_swap(a1, b1_, false, false); \
            u32x4 w = {r0[0], r1[0], r0[1], r1[1]}; OUT = __builtin_bit_cast(bf16x8, w); } while (0)
        DIL_STEP(kfA, kfB, 0); DIL_STEP(kfB, kfA, 1); DIL_STEP(kfA, kfB, 2); DIL_STEP(kfB, kfA, 3); DIL_STEP(kfA, kfB, 4);
#undef DIL_STEP
#undef DIL_PK4
#undef DIL_KLOAD
#undef DIL_VDMA
        float fo = 0.f, fc = 1.f;
        if (S_ != 1) { const float mo = macc[ql], lo = lacc[ql]; const float mnew = fmaxf(mo, m_reg); fo = __builtin_amdgcn_exp2f(mo - mnew); fc = __builtin_amdgcn_exp2f(m_reg - mnew);
            l_reg = lo * fo + l_reg * fc; m_reg = mnew; }
        if (hi == 0 && r32 < VR) { macc[ql] = m_reg; lacc[ql] = l_reg; wsf[r32] = fo; wsf[32 + r32] = fc; }
        asm volatile("s_waitcnt lgkmcnt(0)" ::: "memory");
#pragma unroll
        for (int r = 0; r < 16; ++r) { const int row = crow(r, hi);
            if (row < VR) { const int qrow = rho + S_ * (i0 + row); LAS float* op = Oacc + qrow * 64 + r32;
                if (S_ == 1) { op[0] = o[0][r]; op[32] = o[1][r]; }
                else { const float a = wsf[row], b = wsf[32 + row]; op[0] = op[0] * a + o[0][r] * b; op[32] = op[32] * a + o[1][r] * b; } } }
        asm volatile("s_waitcnt lgkmcnt(0)" ::: "memory");
    }
}
__device__ __forceinline__ void unit(const bf16_t* Qh, const bf16_t* Kh, const bf16_t* Vh, int pitch, bf16_t* Oh, int op, int q0, LAS unsigned char* lds, LAS float* scr) {
    int tid_ = threadIdx.x; asm volatile("" : "+v"(tid_));
    const int tid = tid_, wid = __builtin_amdgcn_readfirstlane(tid >> 6), lane = tid & 63;
    pass<1>(Qh, Kh, Vh, pitch, q0, lds, scr, wid, lane);
    __syncthreads();
    pass<4>(Qh, Kh, Vh, pitch, q0, lds, scr, wid, lane);
    __syncthreads();
    pass<16>(Qh, Kh, Vh, pitch, q0, lds, scr, wid, lane);
    __syncthreads();
    {   const int q = tid >> 1, hf = tid & 1; const LAS f32x4* src = (const LAS f32x4*)(lds + OFF_O + (q * 64 + 32 * hf) * 4); const float rl = 1.0f / scr[256 + q];
        bf16_t* dst = Oh + (size_t)(q0 + q) * op + 32 * hf;
#pragma unroll
        for (int i = 0; i < 4; ++i) { const f32x4 a = src[2 * i] * rl, b = src[2 * i + 1] * rl;
            u32x4 w; w.x = cvt_pk_bf16(a[0], a[1]); w.y = cvt_pk_bf16(a[2], a[3]); w.z = cvt_pk_bf16(b[0], b[1]); w.w = cvt_pk_bf16(b[2], b[3]); *(u32x4*)(dst + 8 * i) = w; } }
    __syncthreads();
}
}

namespace mla {
using att::crow;
constexpr int DQ = 192, DV_ = 128;
constexpr int KP = DQ + 16, KB = 64 * KP;
constexpr int VP = 80, VB = DV_ * VP;
constexpr int NBUF = 3;
constexpr int OFF_K = 0, OFF_V = NBUF * KB, OFF_WS = NBUF * (KB + VB), BYTES = OFF_WS + 8 * 256;
constexpr int KCPR = KP / 16, NKP = KB / 1024, KPW = (NKP + 7) / 8;
constexpr int NVP = VB / 256, VPW = NVP / 8;
static_assert(BYTES <= 131072 && KB % 1024 == 0 && VB % 256 == 0 && NVP % 8 == 0, "mla LDS image");
constexpr float PSHIFT = 8.0f;

__device__ __forceinline__ void unit(const unsigned char* __restrict__ Qh, const unsigned char* __restrict__ Kh, int pitch, const unsigned char* __restrict__ VTh  ,
                                     unsigned char* __restrict__ Oh, int op, int q0, LAS unsigned char* lds) {
    constexpr float SC = C2_C;
    int tid_ = threadIdx.x; asm volatile("" : "+v"(tid_));
    const int tid = tid_, wid = __builtin_amdgcn_readfirstlane(tid >> 6), lane = tid & 63, r32 = lane & 31, hi = lane >> 5;
    const int qlo = q0 + wid * 32, qpos = qlo + r32;
    LAS float* wsf = (LAS float*)(lds + OFF_WS) + wid * 64;
    const int NT = (q0 + 256) / 64;
    unsigned kso[KPW], vso[VPW];
#pragma unroll
    for (int i = 0; i < KPW; ++i) { const int c = (wid + 8 * i) * 64 + lane, row = c / KCPR; int cc = c % KCPR; if (cc > KCPR - 2) cc = KCPR - 2; kso[i] = (unsigned)((row & 63) * pitch + cc * 16); }
#pragma unroll
    for (int i = 0; i < VPW; ++i) { const int off = ((wid + 8 * i) * 64 + lane) * 4, d = off / VP; int w = off % VP; if (w >= 64) w = 0;
        const int hh = w >> 5, g = (w & 31) >> 2; vso[i] = (unsigned)(d * SEQ + 32 * (g >> 2) + 8 * (g & 3) + 4 * hh); }
#define MLA_DMA(j, bf) do { const unsigned char* kt_ = Kh + (size_t)(j) * 64 * pitch; const unsigned char* vt_ = VTh + (size_t)(j) * 64; \
        _Pragma("unroll") for (int i = 0; i < KPW; ++i) if (wid + 8 * i < NKP) \
            __builtin_amdgcn_global_load_lds((const unsigned*)(kt_ + kso[i]), (LAS unsigned*)(lds + OFF_K + (bf) * KB + (wid + 8 * i) * 1024), 16, 0, 0); \
        _Pragma("unroll") for (int i = 0; i < VPW; ++i) \
            __builtin_amdgcn_global_load_lds((const unsigned*)(vt_ + vso[i]), (LAS unsigned*)(lds + OFF_V + (bf) * VB + (wid + 8 * i) * 256), 4, 0, 0); } while (0)
    MLA_DMA(0, 0);
    if (NT > 1) MLA_DMA(1, 1);
    i32x8 qr[3];
#pragma unroll
    for (int s = 0; s < 3; ++s) { const i32x4 lo_ = *(const i32x4*)(Qh + (size_t)qpos * pitch + 64 * s + 32 * hi), hi_ = *(const i32x4*)(Qh + (size_t)qpos * pitch + 64 * s + 32 * hi + 16);
        qr[s] = __builtin_shufflevector(lo_, hi_, 0, 1, 2, 3, 4, 5, 6, 7); }
    float m_reg = -1e30f;
    f32x16 o[4], ol = f32x16{};
    const i32x8 ones8 = {0x38383838, 0x38383838, 0x38383838, 0x38383838, 0x38383838, 0x38383838, 0x38383838, 0x38383838};
#pragma unroll
    for (int d = 0; d < 4; ++d) o[d] = f32x16{};
    const int koff = r32 * KP + hi * 32, voff = r32 * VP + hi * 32;
    asm volatile("s_waitcnt vmcnt(0)" ::: "memory");
    __syncthreads();
#define MLA_QK(P, bufi, hf_) do { const LAS unsigned char* kb_ = lds + OFF_K + (bufi) * KB + (hf_) * 32 * KP + koff; P = f32x16{}; \
        i32x8 kw_[3]; _Pragma("unroll") for (int s = 0; s < 3; ++s) { const i32x4 lo_ = *(const LAS i32x4*)(kb_ + 64 * s), hi_ = *(const LAS i32x4*)(kb_ + 64 * s + 16); kw_[s] = __builtin_shufflevector(lo_, hi_, 0, 1, 2, 3, 4, 5, 6, 7); } \
        _Pragma("unroll") for (int s = 0; s < 3; ++s) P = __builtin_amdgcn_mfma_scale_f32_32x32x64_f8f6f4(kw_[s], qr[s], P, 0, 0, 0, 0, 0, 0); } while (0)
    f32x16 pA, pB, pC, pD;
    int buf = 0;
    { if (0 <= qlo + 31) { MLA_QK(pA, 0, 0); } if (32 <= qlo + 31) { MLA_QK(pB, 0, 1); } }
#define MLA_SMPV(P0, P1, kb, vbuf) do { \
        const bool a0_ = (kb) <= qlo + 31, a1_ = (kb) + 32 <= qlo + 31; \
        if (a0_) { \
            const float NEG = -__builtin_inff(); const int dq = qpos - (kb) - 4 * hi; \
            if (!a1_) { _Pragma("unroll") for (int r = 0; r < 16; ++r) P1[r] = NEG; } \
            if ((kb) + 63 > qlo) { _Pragma("unroll") for (int r = 0; r < 16; ++r) { const int c = (r & 3) + 8 * (r >> 2); if (dq - c < 0) P0[r] = NEG; if (dq - c - 32 < 0) P1[r] = NEG; } } \
            float pmax = fmaxf(P0[0], P1[0]); \
            _Pragma("unroll") for (int r = 1; r < 16; ++r) pmax = fmaxf(pmax, fmaxf(P0[r], P1[r])); \
            { auto rr = __builtin_amdgcn_permlane32_swap(__float_as_uint(pmax), __float_as_uint(pmax), false, false); pmax = fmaxf(__uint_as_float(rr[0]), __uint_as_float(rr[1])); } \
            const float mn = fmaxf(m_reg, pmax * SC); const float alpha = __builtin_amdgcn_exp2f(m_reg - mn); m_reg = mn; \
              \
              \
            const float c8 = 8.0f * SC, b8 = 8.0f * (PSHIFT + 7.0f - mn); \
            i32x8 pa; \
            _Pragma("unroll") for (int g = 0; g < 4; ++g) { unsigned w0 = 0u, w1 = 0u; \
                _Pragma("unroll") for (int b_ = 0; b_ < 4; ++b_) { w0 = __builtin_amdgcn_cvt_pk_u8_f32(__builtin_fmaf(P0[4 * g + b_], c8, b8), b_, w0); w1 = __builtin_amdgcn_cvt_pk_u8_f32(__builtin_fmaf(P1[4 * g + b_], c8, b8), b_, w1); } \
                pa[g] = (int)w0; pa[4 + g] = (int)w1; } \
            if (__any(alpha < 1.f)) { if (hi == 0) wsf[r32] = alpha; asm volatile("s_waitcnt lgkmcnt(0)" ::: "memory"); \
                _Pragma("unroll") for (int r = 0; r < 16; ++r) { const float a = wsf[crow(r, hi)]; ol[r] *= a; _Pragma("unroll") for (int d = 0; d < 4; ++d) o[d][r] *= a; } } \
            ol = __builtin_amdgcn_mfma_scale_f32_32x32x64_f8f6f4(pa, ones8, ol, 0, 0, 0, 0, 0, 0); \
            const LAS unsigned char* vb_ = lds + OFF_V + (vbuf) * VB + voff; \
            _Pragma("unroll") for (int d0 = 0; d0 < 4; ++d0) { const i32x4 lo_ = *(const LAS i32x4*)(vb_ + d0 * 32 * VP), hi_ = *(const LAS i32x4*)(vb_ + d0 * 32 * VP + 16); \
                o[d0] = __builtin_amdgcn_mfma_scale_f32_32x32x64_f8f6f4(pa, __builtin_shufflevector(lo_, hi_, 0, 1, 2, 3, 4, 5, 6, 7), o[d0], 0, 0, 0, 0, 0, 0); } \
        } } while (0)
    for (int t = 0; t < NT; t += 2) {
        {   if (t + 2 < NT) { const int b2 = buf == 0 ? 2 : buf - 1; MLA_DMA(t + 2, b2); }
            const int kb = t * 64, nb = buf == 2 ? 0 : buf + 1;
            if (kb + 64 <= qlo + 31) MLA_QK(pC, nb, 0);
            if (kb + 96 <= qlo + 31) MLA_QK(pD, nb, 1);
            MLA_SMPV(pA, pB, kb, buf);
            asm volatile("s_waitcnt vmcnt(0)" ::: "memory"); __syncthreads(); buf = nb; }
        {   if (t + 3 < NT) { const int b2 = buf == 0 ? 2 : buf - 1; MLA_DMA(t + 3, b2); }
            const int kb = (t + 1) * 64, nb = buf == 2 ? 0 : buf + 1;
            if (t + 2 < NT) { if (kb + 64 <= qlo + 31) MLA_QK(pA, nb, 0); if (kb + 96 <= qlo + 31) MLA_QK(pB, nb, 1); }
            MLA_SMPV(pC, pD, kb, buf);
            asm volatile("s_waitcnt vmcnt(0)" ::: "memory"); __syncthreads(); buf = nb; }
    }
#undef MLA_SMPV
#undef MLA_QK
#undef MLA_DMA
    unsigned char* Ow = Oh + (size_t)qlo * op;
#pragma unroll
    for (int r = 0; r < 16; ++r) { const int orow = crow(r, hi); const float rl = __builtin_amdgcn_rcpf(ol[r]);
#pragma unroll
        for (int d0 = 0; d0 < 4; ++d0) { const float v = o[d0][r] * rl; const float v1 = __shfl_down(v, 1), v2 = __shfl_down(v, 2), v3 = __shfl_down(v, 3);
            if ((r32 & 3) == 0) *(unsigned*)(Ow + (size_t)orow * op + d0 * 32 + r32) = pk4_fp8(v, v1, v2, v3); } }
    __syncthreads();
}
}

constexpr int NWAVES = 8;
constexpr size_t MiB = 1u << 20;
constexpr size_t WS_CTL = 0, CTL_ZERO_BYTES = 1 * MiB;
constexpr size_t WS_WEIN = 2 * MiB;
constexpr size_t WS_WEOUT = 12 * MiB;
constexpr size_t WS_WOIN = 16 * MiB;
constexpr size_t WS_WUQ = 20 * MiB;
constexpr size_t WS_WUKV = 23 * MiB;
constexpr size_t WS_WOOUT = 25 * MiB;
constexpr size_t WS_B1P = 29 * MiB;
constexpr size_t WS_SSQ = 30 * MiB;
constexpr size_t WS_TOKER = 31 * MiB;
constexpr size_t WS_TOKG = 31 * MiB + 512 * 1024;
constexpr size_t WS_XN = 32 * MiB;
constexpr size_t WS_Z = 64 * MiB;
constexpr size_t WS_MIX = 144 * MiB;
constexpr size_t WS_QR = 176 * MiB;
constexpr size_t WS_KVR = 224 * MiB;
constexpr size_t WS_QF = 288 * MiB;
constexpr size_t WS_KF = 336 * MiB;
constexpr size_t WS_Z8 = 104 * MiB;
constexpr size_t WS_MIX8 = 160 * MiB;
constexpr size_t WS_VT = 3200 * MiB;
constexpr size_t WS_W1 = 384 * MiB;
constexpr size_t WS_W2 = 896 * MiB;
constexpr size_t WS_XG = 1152 * MiB;
constexpr size_t WS_ACT = 1664 * MiB;
constexpr size_t WS_Y = 2176 * MiB;
constexpr size_t WS_X16 = 3216 * MiB;
constexpr size_t WS_END = 3248 * MiB;
constexpr int CW_MOE = 65536;
constexpr int CW_TMO = 0, CW_CODE = 1, CW_BAR = 4096, CW_CNT = 16384;
constexpr int RING_OFF = 0, RING_BYTES = 131072;
constexpr int LDSCTL_OFF = RING_BYTES, MISC_OFF = LDSCTL_OFF + 320;
constexpr int SCR_OFF = RING_BYTES + 1024;
constexpr int LDS_BYTES = 155648;
constexpr int SCR_BYTES = LDS_BYTES - SCR_OFF;

typedef GAS unsigned gu32;
#define RLX_AGENT __ATOMIC_RELAXED, __HIP_MEMORY_SCOPE_AGENT

#define XB_TMO      128
#define XB_XCNT(j)  (256  + 64 * (j))
#define XB_XSUB(j)  (1280 + 64 * (j))
#define XB_XGEN(j)  (2304 + 64 * (j))
#define XB_TOP      3328
#define XB_TOPGEN   3392
#define XCD_BAR_WORDS 3456
#define XB_SPIN_CAP (1u << 18)
__device__ __forceinline__ unsigned xb_ld(unsigned* p)              { return __hip_atomic_load(p, __ATOMIC_RELAXED, __HIP_MEMORY_SCOPE_AGENT); }
__device__ __forceinline__ unsigned xb_add(unsigned* p, unsigned v) { return __hip_atomic_fetch_add(p, v, __ATOMIC_RELAXED, __HIP_MEMORY_SCOPE_AGENT); }
__device__ __forceinline__ unsigned xb_xcc_id() { return (unsigned)__builtin_amdgcn_s_getreg((3 << 11) | 20) & 0xFu; }
#define XB_SPIN(cond, bar) do { unsigned _sp = 0; while (cond) { __builtin_amdgcn_s_sleep(1); \
    if ((++_sp & 255u) == 0u) { if (xb_ld(&(bar)[XB_TMO])) break; if (_sp > XB_SPIN_CAP) { atomicAdd(&(bar)[XB_TMO], 1u); break; } } } } while (0)
struct XcdBarrier { unsigned* bar; unsigned x; volatile LAS unsigned* st; };
__device__ __forceinline__ XcdBarrier xcd_barrier_post(unsigned* bar, volatile LAS unsigned* st) {
    XcdBarrier b; b.bar = bar; b.x = xb_xcc_id(); b.st = st;
    if (threadIdx.x == 0) (void)xb_add(&bar[XB_XCNT(b.x)], 1u);
    return b;
}
__device__ __forceinline__ void xcd_barrier_complete(unsigned* bar, unsigned x, unsigned& nloc, unsigned& nx) {
    const unsigned G = gridDim.x * gridDim.y * gridDim.z;
    unsigned sum, cnt, mine, sp = 0u;
    for (;;) {
        sum = 0u; cnt = 0u; mine = 0u;
#pragma unroll
        for (unsigned j = 0; j < 16; ++j) { const unsigned c = xb_ld(&bar[XB_XCNT(j)]); sum += c; cnt += (c > 0u) ? 1u : 0u; mine = (j == x) ? c : mine; }
        if (sum == G) break;
        __builtin_amdgcn_s_sleep(1);
        if ((++sp & 255u) == 0u) { if (xb_ld(&bar[XB_TMO])) break; if (sp > XB_SPIN_CAP) { atomicAdd(&bar[XB_TMO], 1u); break; } }
    }
    nloc = mine > 0u ? mine : 1u; nx = cnt > 0u ? cnt : 1u;
}
__device__ __forceinline__ void xcd_barrier(const XcdBarrier& b) {
    asm volatile("s_waitcnt vmcnt(0)" ::: "memory");
    __syncthreads();
    if (threadIdx.x == 0) {
        unsigned* bar = b.bar;
        __builtin_amdgcn_s_waitcnt(0);
        unsigned nloc = b.st[0], nx = b.st[1];
        if (nloc == 0u) { xcd_barrier_complete(bar, b.x, nloc, nx); b.st[0] = nloc; b.st[1] = nx; }
        const unsigned old = xb_add(&bar[XB_XSUB(b.x)], 1u);
        const unsigned gen = old / nloc;
        if (old + 1u == (gen + 1u) * nloc) {
            __builtin_amdgcn_fence(__ATOMIC_RELEASE, "agent");
            asm volatile("s_waitcnt vmcnt(0)" ::: "memory");
            const unsigned og = xb_add(&bar[XB_TOP], 1u);
            const unsigned tg = og / nx;
            if (og + 1u == (tg + 1u) * nx) xb_add(&bar[XB_TOPGEN], 1u);
            else XB_SPIN(xb_ld(&bar[XB_TOPGEN]) == tg, bar);
            __builtin_amdgcn_fence(__ATOMIC_ACQUIRE, "agent");
            xb_add(&bar[XB_XGEN(b.x)], 1u);
            asm volatile("s_waitcnt vmcnt(0)" ::: "memory");
        } else {
            XB_SPIN(xb_ld(&bar[XB_XGEN(b.x)]) == gen, bar);
            __builtin_amdgcn_fence(__ATOMIC_ACQUIRE, "agent");
            asm volatile("s_waitcnt vmcnt(0)" ::: "memory");
        }
    }
    __syncthreads();
}

struct Args {
    const float* in[24]; float* out; unsigned char* ws; int stage_limit; int pad;
};
enum { I_X = 0, I_MIXN, I_FFNN, I_EWIN, I_EWS, I_EBS, I_EGV, I_EGQ, I_EGK, I_EWOUT, I_OWIN, I_OGCQ, I_OGCKV, I_OWUQ, I_OWUKV, I_OGQ, I_OGK, I_OWOUT,
       I_RW, I_RB, I_W1, I_B1, I_W2, I_B2 };

struct Frame {
    LAS unsigned char* lds;
    int vcu, G;
};

__device__ __forceinline__ float wave_sum(float v) {
#pragma unroll
    for (int o = 1; o < 64; o <<= 1) v += __shfl_xor(v, o);
    return v;
}
#define LDS_WAIT() asm volatile("s_waitcnt lgkmcnt(0)" ::: "memory")

template <int MODE> __device__ __forceinline__ int dst_row(int o) {
    if (MODE == 1) { if (o >= 1024 && o < 2048) return (o & ~255) | (((o >> 5) & 1) << 7) | (((o >> 6) & 3) << 5) | (o & 31); return o; }
    if (MODE == 2) return ((o >> 8) << 8) | ((o & 1) << 7) | ((o & 255) >> 1);
    return o;
}
template <int MODE>
__device__ __forceinline__ void transpose_item(const float* __restrict__ W, int K, int N, bf16_t* __restrict__ WT, const float* __restrict__ gain, LAS float* scr, int item, int lane) {
    const int nblk = N / 32, kb = item / nblk, nb = item % nblk, k0 = 64 * kb, n0 = 32 * nb;
#pragma unroll 8
    for (int i = 0; i < 32; ++i) { const int kk = 2 * i + (lane >> 5); float w = W[(size_t)(k0 + kk) * N + n0 + (lane & 31)]; if (gain) w *= gain[k0 + kk]; scr[kk * 33 + (lane & 31)] = w; }
    LDS_WAIT(); asm volatile("" ::: "memory");
    const int c = lane & 7;
#pragma unroll
    for (int j = 0; j < 4; ++j) { const int n = (lane >> 3) + 8 * j; const LAS float* s = scr + (8 * c) * 33 + n;
        u32x4 o; o.x = cvt_pk_bf16(s[0 * 33], s[1 * 33]); o.y = cvt_pk_bf16(s[2 * 33], s[3 * 33]); o.z = cvt_pk_bf16(s[4 * 33], s[5 * 33]); o.w = cvt_pk_bf16(s[6 * 33], s[7 * 33]);
        *(u32x4*)(WT + (size_t)dst_row<MODE>(n0 + n) * K + k0 + 8 * c) = o; }
    LDS_WAIT(); asm volatile("" ::: "memory");
}
template <int MODE>
__device__ __forceinline__ void transpose_job(Frame& F, const float* W, int K, int N, int nmat, size_t src_stride, bf16_t* WT, size_t dst_stride, const float* gain, int gain_stride) {
    int tid_ = threadIdx.x; asm volatile("" : "+v"(tid_));
    const int wave = __builtin_amdgcn_readfirstlane(tid_ >> 6), lane = tid_ & 63;
    LAS float* scr = (LAS float*)(F.lds + RING_OFF + wave * 16384);
    const int gw = F.vcu * NWAVES + wave, NGW = F.G * NWAVES;
    const int per = (K / 64) * (N / 32), total = per * nmat;
    for (int it = gw; it < total; it += NGW) { const int mi = it / per, item = it - mi * per;
        transpose_item<MODE>(W + (size_t)mi * src_stride, K, N, WT + (size_t)mi * dst_stride, gain ? gain + (size_t)mi * gain_stride : nullptr, scr, item, lane); }
}


__device__ __forceinline__ void tr8_load(f32x4 (&v)[16], const float* __restrict__ W, int N, int item, int lane) {
    const int nblk = N / 32, kb = item / nblk, nb = item % nblk, k0 = 128 * kb, n0 = 32 * nb;
#pragma unroll
    for (int i = 0; i < 16; ++i) v[i] = __builtin_nontemporal_load((const f32x4*)(W + (size_t)(k0 + 8 * i + (lane >> 3)) * N + n0 + 4 * (lane & 7)));
}
template <int MODE>
__device__ __forceinline__ void tr8_store(const f32x4 (&v)[16], int K, int N, unsigned char* __restrict__ WT, const float* __restrict__ gain, LAS unsigned char* scr, int item, int lane) {
    const int nblk = N / 32, kb = item / nblk, nb = item % nblk, k0 = 128 * kb, n0 = 32 * nb;
    constexpr int TP = 144;
#pragma unroll
    for (int i = 0; i < 16; ++i) { const int kl = 8 * i + (lane >> 3); const float sc = gain ? W8_SCALE * gain[k0 + kl] : W8_SCALE;
        const unsigned w = pk4_fp8(v[i].x * sc, v[i].y * sc, v[i].z * sc, v[i].w * sc); LAS unsigned char* d = scr + (4 * (lane & 7)) * TP + kl;
        d[0] = (unsigned char)w; d[TP] = (unsigned char)(w >> 8); d[2 * TP] = (unsigned char)(w >> 16); d[3 * TP] = (unsigned char)(w >> 24); }
    LDS_WAIT(); asm volatile("" ::: "memory");
#pragma unroll
    for (int m = 0; m < 4; ++m) { const int q = lane + 64 * m, n = q >> 3, kc = q & 7;
        const u32x4 o = *(const LAS u32x4*)(scr + n * TP + 16 * kc);
        __builtin_nontemporal_store(o, (u32x4*)(WT + (size_t)dst_row<MODE>(n0 + n) * K + k0 + 16 * kc)); }
    LDS_WAIT(); asm volatile("" ::: "memory");
}
template <int MODE>
__device__ __forceinline__ void transpose_job_fp8(Frame& F, const float* W, int K, int N, int nmat, size_t src_stride, unsigned char* WT, size_t dst_stride, const float* gain = nullptr, int gain_stride = 0) {
    int tid_ = threadIdx.x; asm volatile("" : "+v"(tid_));
    const int wave = __builtin_amdgcn_readfirstlane(tid_ >> 6), lane = tid_ & 63;
    LAS unsigned char* scr = F.lds + RING_OFF + wave * 16384;
    const int gw = F.vcu * NWAVES + wave, NGW = F.G * NWAVES;
    const int per = (K / 128) * (N / 32), total = per * nmat;
    f32x4 cur[16], nxt[16];
    int it = gw;
    if (it < total) { const int mi = it / per; tr8_load(cur, W + (size_t)mi * src_stride, N, it - mi * per, lane); }
    for (; it < total; it += NGW) {
        const int itn = it + NGW;
        if (itn < total) { const int mn = itn / per; tr8_load(nxt, W + (size_t)mn * src_stride, N, itn - mn * per, lane); }
        const int mi = it / per;
        tr8_store<MODE>(cur, K, N, WT + (size_t)mi * dst_stride, gain ? gain + (size_t)mi * gain_stride : nullptr, scr, it - mi * per, lane);
#pragma unroll
        for (int i = 0; i < 16; ++i) cur[i] = nxt[i];
    }
}

__device__ __forceinline__ void rms_row_to_fp8(int lane, const float* xrow, const float* g, unsigned char* orow, float* copy) {
    const f32x4* xr = (const f32x4*)xrow + lane; const f32x4* gr = (const f32x4*)g + lane;
    f32x4 v[4]; float s = 0.f;
#pragma unroll
    for (int j = 0; j < 4; ++j) { v[j] = xr[64 * j]; s += (v[j].x * v[j].x + v[j].y * v[j].y) + (v[j].z * v[j].z + v[j].w * v[j].w); }
    const float rstd = 1.0f / sqrtf(wave_sum(s) * (1.f / DM) + EPS);
    unsigned* o4 = (unsigned*)orow + lane;
#pragma unroll
    for (int j = 0; j < 4; ++j) { const f32x4 gg = gr[64 * j]; if (copy) ((f32x4*)copy + lane)[64 * j] = v[j];
        o4[64 * j] = pk4_fp8(v[j].x * rstd * gg.x, v[j].y * rstd * gg.y, v[j].z * rstd * gg.z, v[j].w * rstd * gg.w); }
}
__device__ __forceinline__ void rms_row_to_bf16(int lane, const float* xrow, const float* g, bf16_t* orow, float* copy) {
    const f32x4* xr = (const f32x4*)xrow + lane; const f32x4* gr = (const f32x4*)g + lane;
    f32x4 v[4]; float s = 0.f;
#pragma unroll
    for (int j = 0; j < 4; ++j) { v[j] = xr[64 * j]; s += (v[j].x * v[j].x + v[j].y * v[j].y) + (v[j].z * v[j].z + v[j].w * v[j].w); }
    const float rstd = 1.0f / sqrtf(wave_sum(s) * (1.f / DM) + EPS);
    u32x2* o8 = (u32x2*)orow + lane;
#pragma unroll
    for (int j = 0; j < 4; ++j) { const f32x4 gg = gr[64 * j]; if (copy) ((f32x4*)copy + lane)[64 * j] = v[j];
        u32x2 w; w.x = cvt_pk_bf16(v[j].x * rstd * gg.x, v[j].y * rstd * gg.y); w.y = cvt_pk_bf16(v[j].z * rstd * gg.z, v[j].w * rstd * gg.w); o8[64 * j] = w; }
}

namespace pg8 {
struct EpiEvenIn {
    static constexpr bool PERM = false;
    bf16_t* Z; const float* gq; const float* gk;
    __device__ __forceinline__ void operator()(const f32x4 (&acc)[2][2][4][2], const Unit& u, int wr, int wc, int fr, int fq) const {
        const int row0 = u.pm * BM + wr * 64 + fr, pn = u.pn;
        if (pn >= 4 && pn < 8) {
            const float* g = pn < 6 ? gq : gk; const float sc = pn < 6 ? C2_B : 1.0f;
            f32x4 gv[2][2];
#pragma unroll
            for (int bj = 0; bj < 2; ++bj)
#pragma unroll
                for (int n = 0; n < 2; ++n) gv[bj][n] = *(const f32x4*)(g + 32 * bj + 16 * n + 4 * fq);
#pragma unroll
            for (int ai = 0; ai < 2; ++ai)
#pragma unroll
                for (int m = 0; m < 4; ++m) {
                    float ss = 0.f;
#pragma unroll
                    for (int bj = 0; bj < 2; ++bj)
#pragma unroll
                        for (int n = 0; n < 2; ++n) { const f32x4 v = acc[ai][bj][m][n]; ss += (v[0] * v[0] + v[1] * v[1]) + (v[2] * v[2] + v[3] * v[3]); }
                    ss += __shfl_xor(ss, 16); ss += __shfl_xor(ss, 32);
                    const float rstd = sc / sqrtf(ss * (1.0f / 64.0f) + EPS);
                    bf16_t* rowp = Z + (size_t)(row0 + ai * HALF + m * 16) * EVEN_IN + pn * BM + wc * 64 + 4 * fq;
#pragma unroll
                    for (int bj = 0; bj < 2; ++bj)
#pragma unroll
                        for (int n = 0; n < 2; ++n) { const f32x4 v = acc[ai][bj][m][n] * rstd * gv[bj][n];
                            u32x2 w; w.x = cvt_pk_bf16(v[0], v[1]); w.y = cvt_pk_bf16(v[2], v[3]); *(u32x2*)(rowp + 32 * bj + 16 * n) = w; }
                }
        } else {
            const bool act = pn < 4;
#pragma unroll
            for (int ai = 0; ai < 2; ++ai)
#pragma unroll
                for (int m = 0; m < 4; ++m) { bf16_t* rowp = Z + (size_t)(row0 + ai * HALF + m * 16) * EVEN_IN + pn * BM + wc * 32 + 4 * fq;
#pragma unroll
                    for (int bj = 0; bj < 2; ++bj)
#pragma unroll
                        for (int n = 0; n < 2; ++n) { f32x4 v = acc[ai][bj][m][n]; if (act) v = gelu4(v);
                            u32x2 w; w.x = cvt_pk_bf16(v[0], v[1]); w.y = cvt_pk_bf16(v[2], v[3]); *(u32x2*)(rowp + bj * HALF + 16 * n) = w; } }
        }
    }
};
template <bool F8 = false> struct EpiResidT {
    static constexpr bool PERM = false;
    const float* src32; bf16_t* X;
    __device__ __forceinline__ void operator()(const f32x4 (&acc)[2][2][4][2], const Unit& u, int wr, int wc, int fr, int fq) const {
        const int row0 = u.pm * BM + wr * 64 + fr;
#pragma unroll
        for (int ai = 0; ai < 2; ++ai)
#pragma unroll
            for (int m = 0; m < 4; ++m) { const size_t ro = (size_t)(row0 + ai * HALF + m * 16) * DM + u.pn * BM + wc * 32 + 4 * fq;
#pragma unroll
                for (int bj = 0; bj < 2; ++bj)
#pragma unroll
                    for (int n = 0; n < 2; ++n) { const size_t o_ = ro + bj * HALF + 16 * n; f32x4 b;
                        if (src32) b = *(const f32x4*)(src32 + o_); else { const u32x2 t = *(const u32x2*)(X + o_); b = (f32x4){bflo(t.x), bfhi(t.x), bflo(t.y), bfhi(t.y)}; }
                        const f32x4 r = b + (F8 ? acc[ai][bj][m][n] * W8_INV : acc[ai][bj][m][n]);
                        u32x2 w; w.x = cvt_pk_bf16(r[0], r[1]); w.y = cvt_pk_bf16(r[2], r[3]); *(u32x2*)(X + o_) = w; }
                if (m & 1) asm volatile("" ::: "memory"); }
    }
};
typedef EpiResidT<false> EpiResid;
struct EpiOddIn {
    static constexpr bool PERM = false;
    bf16_t* Z; unsigned char* Z8; float* ssq;
    __device__ __forceinline__ void operator()(const f32x4 (&acc)[2][2][4][2], const Unit& u, int wr, int wc, int fr, int fq) const {
        const int row0 = u.pm * BM + wr * 64 + fr, pn = u.pn;
#pragma unroll
        for (int ai = 0; ai < 2; ++ai)
#pragma unroll
            for (int m = 0; m < 4; ++m) { const int row = row0 + ai * HALF + m * 16; bf16_t* rowp = Z + (size_t)row * ODD_INP + pn * BM + wc * 32 + 4 * fq;
                float ss = 0.f;
#pragma unroll
                for (int bj = 0; bj < 2; ++bj)
#pragma unroll
                    for (int n = 0; n < 2; ++n) { const f32x4 v = acc[ai][bj][m][n] * W8_INV; ss += (v[0] * v[0] + v[1] * v[1]) + (v[2] * v[2] + v[3] * v[3]);
                        if (pn < 3) *(unsigned*)(Z8 + (size_t)row * ODD_INP + pn * BM + wc * 32 + 4 * fq + bj * HALF + 16 * n) = pk4_fp8(v[0], v[1], v[2], v[3]);
                        else { u32x2 w; w.x = cvt_pk_bf16(v[0], v[1]); w.y = cvt_pk_bf16(v[2], v[3]); *(u32x2*)(rowp + bj * HALF + 16 * n) = w; } }
                ss += __shfl_xor(ss, 16); ss += __shfl_xor(ss, 32);
                if (fq == 0) ssq[(size_t)row * 16 + pn * 4 + wc] = ss; }
    }
};
template <int NS> struct EpiRowScale {
    static constexpr bool PERM = true;
    unsigned char* O; int ldc; const float* ssq; int s0; float inv_cols;
    __device__ __forceinline__ void operator()(const f32x4 (&acc)[2][2][4][2], const Unit& u, int wr, int wc, int fr, int fq) const {
        const int row0 = u.pm * BM + wr * 64 + fr; const int col0 = u.pn * BM + wc * 32 + 8 * fq;
#pragma unroll
        for (int ai = 0; ai < 2; ++ai)
#pragma unroll
            for (int m = 0; m < 4; ++m) { const int row = row0 + ai * HALF + m * 16;
                float ss = 0.f; const f32x4* sp = (const f32x4*)(ssq + (size_t)row * 16 + s0);
#pragma unroll
                for (int q = 0; q < NS; ++q) { const f32x4 t = sp[q]; ss += (t[0] + t[1]) + (t[2] + t[3]); }
                const float rstd = W8_INV / sqrtf(ss * inv_cols + EPS);
                unsigned char* rowp = O + (size_t)row * ldc + col0;
#pragma unroll
                for (int bj = 0; bj < 2; ++bj) { const f32x4 v0 = acc[ai][bj][m][0] * rstd, v1 = acc[ai][bj][m][1] * rstd;
                    u32x2 w; w.x = pk4_fp8(v0[0], v0[1], v0[2], v0[3]); w.y = pk4_fp8(v1[0], v1[1], v1[2], v1[3]);
                    *(u32x2*)(rowp + bj * HALF) = w; }
                asm volatile("" ::: "memory"); }
    }
};
__device__ __forceinline__ void store8_sc1(void* p, u32x2 v) { asm volatile("global_store_dwordx2 %0, %1, off sc1" :: "v"(p), "v"(v) : "memory"); }
template <bool WT = false> struct EpiSwigluT {
    static constexpr bool PERM = true;
    unsigned char* ACT; const float* b1p;
    __device__ __forceinline__ void operator()(const f32x4 (&acc)[2][2][4][2], const Unit& u, int wr, int wc, int fr, int fq) const {
        const int row0 = u.pm * BM + wr * 64 + fr, e = u.pb >> 3, pn = u.pn;
        const float* bp = b1p + (size_t)e * 2048 + pn * BM + wc * 32 + 8 * fq;
        f32x4 bg[2], bl[2];
#pragma unroll
        for (int n = 0; n < 2; ++n) { bg[n] = *(const f32x4*)(bp + 4 * n); bl[n] = *(const f32x4*)(bp + HALF + 4 * n); }
#pragma unroll
        for (int ai = 0; ai < 2; ++ai)
#pragma unroll
            for (int m = 0; m < 4; ++m) { unsigned char* rowp = ACT + (size_t)(row0 + ai * HALF + m * 16) * DE + pn * HALF + wc * 32 + 8 * fq;
                float a[8];
#pragma unroll
                for (int n = 0; n < 2; ++n) { const f32x4 gv = acc[ai][0][m][n] * W8_INV + bg[n], lv = acc[ai][1][m][n] * W8_INV + bl[n];
#pragma unroll
                    for (int i = 0; i < 4; ++i) { const float gl = fminf(gv[i], 7.0f), li = fminf(fmaxf(lv[i], -7.0f), 7.0f);
                        const float sg = __builtin_amdgcn_rcpf(1.0f + __builtin_amdgcn_exp2f(-1.702f * LOG2E * gl));
                        a[4 * n + i] = gl * sg * (li + 1.0f); } }
                u32x2 w; w.x = pk4_fp8(a[0], a[1], a[2], a[3]); w.y = pk4_fp8(a[4], a[5], a[6], a[7]);
                if (WT) store8_sc1(rowp, w); else *(u32x2*)rowp = w; }
    }
};
typedef EpiSwigluT<false> EpiSwiglu;
struct EpiDown {
    static constexpr bool PERM = true;
    bf16_t* Y; const float* b2;
    __device__ __forceinline__ void operator()(const f32x4 (&acc)[2][2][4][2], const Unit& u, int wr, int wc, int fr, int fq) const {
        const int row0 = u.pm * BM + wr * 64 + fr, e = u.pb >> 2, pn = u.pn;
        const float* bp = b2 + (size_t)e * DM + pn * BM + wc * 32 + 8 * fq;
        f32x4 bv[2][2];
#pragma unroll
        for (int bj = 0; bj < 2; ++bj)
#pragma unroll
            for (int n = 0; n < 2; ++n) bv[bj][n] = *(const f32x4*)(bp + bj * HALF + 4 * n);
#pragma unroll
        for (int ai = 0; ai < 2; ++ai)
#pragma unroll
            for (int m = 0; m < 4; ++m) { bf16_t* rowp = Y + (size_t)(row0 + ai * HALF + m * 16) * DM + pn * BM + wc * 32 + 8 * fq;
#pragma unroll
                for (int bj = 0; bj < 2; ++bj) { const f32x4 v0 = acc[ai][bj][m][0] * W8_INV + bv[bj][0], v1 = acc[ai][bj][m][1] * W8_INV + bv[bj][1];
                    u32x4 w; w.x = cvt_pk_bf16(v0[0], v0[1]); w.y = cvt_pk_bf16(v0[2], v0[3]); w.z = cvt_pk_bf16(v1[0], v1[1]); w.w = cvt_pk_bf16(v1[2], v1[3]);
                    *(u32x4*)(rowp + bj * HALF) = w; } }
    }
};
struct MoeOrder {
    const LAS int* tbl; int nN, G, c;
    __device__ bool next(int i, Unit& u) const {
        const long L = (long)i * G + c; const int rb = (int)(L / nN);
        if (rb >= __builtin_amdgcn_readfirstlane(tbl[32])) return false;
        int e = 0;
#pragma unroll
        for (int k = 1; k < 32; ++k) e += (tbl[k] <= rb) ? 1 : 0;
        e = __builtin_amdgcn_readfirstlane(e); const int rbl = __builtin_amdgcn_readfirstlane(rb - tbl[e]);
        u.pm = e * (ECAP / BM) + rbl; u.pn = (int)(L % nN); u.pb = e * nN + u.pn; u.kind = 0; u.rb = rb; return true;
    }
    __device__ __forceinline__ void a_ready(const Unit&) const {}
    __device__ __forceinline__ void pre_epi() const {}
    __device__ __forceinline__ void done(const Unit&) const {}
    __device__ __forceinline__ void finish() const {}
};

constexpr unsigned MOE_SPIN_CAP = 1u << 22;
struct MoeMergedOrder {
    const LAS int* tbl; int G, c; gu32* cnt;
    mutable int pend;
    __device__ __forceinline__ void flush() const {
        if (pend >= 0) { asm volatile("s_waitcnt vmcnt(0)" ::: "memory");
            if ((threadIdx.x & 63) == 0) __hip_atomic_fetch_add(cnt + 16 * pend, 1u, __ATOMIC_RELAXED, __HIP_MEMORY_SCOPE_AGENT);
            pend = -1; } }
    __device__ bool next(int i, Unit& u) const {
        const int nb = __builtin_amdgcn_readfirstlane(tbl[32]);
        long L = (long)i * G + c; int nN = 8, kind = 0;
        if (L >= (long)nb * 8) { L -= (long)nb * 8; nN = 4; kind = 1; if (L >= (long)nb * 4) return false; }
        const int rb = (int)(L / nN);
        int e = 0;
#pragma unroll
        for (int k = 1; k < 32; ++k) e += (tbl[k] <= rb) ? 1 : 0;
        e = __builtin_amdgcn_readfirstlane(e); const int rbl = __builtin_amdgcn_readfirstlane(rb - tbl[e]);
        u.pm = e * (ECAP / BM) + rbl; u.pn = (int)(L % nN); u.pb = e * nN + u.pn; u.kind = kind; u.rb = rb; return true;
    }
    __device__ __forceinline__ void a_ready(const Unit& u) const {
        if (u.kind == 1) {
            flush();
            if (threadIdx.x < 64) {
                unsigned sp = 0;
                while ((unsigned)__builtin_amdgcn_readfirstlane(__hip_atomic_load(cnt + 16 * u.rb, __ATOMIC_RELAXED, __HIP_MEMORY_SCOPE_AGENT)) < 64u) { __builtin_amdgcn_s_sleep(2); if (++sp > MOE_SPIN_CAP) break; }
                __builtin_amdgcn_fence(__ATOMIC_ACQUIRE, "agent");
                asm volatile("s_waitcnt vmcnt(0)" ::: "memory");
            }
            __builtin_amdgcn_s_barrier();
        }
    }
    __device__ __forceinline__ void pre_epi() const { flush(); }
    __device__ __forceinline__ void done(const Unit& u) const { if (u.kind == 0) pend = u.rb; }
    __device__ __forceinline__ void finish() const { flush(); }
};
struct EpiMoe {
    static constexpr bool PERM = true;
    EpiSwigluT<true> up; EpiDown down;
    __device__ __forceinline__ void operator()(const f32x4 (&acc)[2][2][4][2], const Unit& u, int wr, int wc, int fr, int fq) const {
        if (u.kind == 0) up(acc, u, wr, wc, fr, fq); else down(acc, u, wr, wc, fr, fq);
    }
};
}

__device__ __forceinline__ void gmlp_unit(Frame& F, const bf16_t* Z, bf16_t* MIX, const float* Ws, const float* bs, const float* gv, int unit) {
    constexpr int VP = 272;
    LAS unsigned char* VT = F.lds + RING_OFF;
    const int h = unit & 3, chunk = unit >> 2;
    int tid_ = threadIdx.x; asm volatile("" : "+v"(tid_));
    const int t0 = chunk * 128, tid = tid_, lane = tid & 63, w = __builtin_amdgcn_readfirstlane(tid >> 6);
    {
        const int s = tid >> 2, dq = (tid & 3) * 32;
        const bf16_t* vp = Z + (size_t)(t0 + s) * EVEN_IN + 512 + h * 128 + dq;
        u32x4 raw[4]; float ss = 0.f;
#pragma unroll
        for (int i = 0; i < 4; ++i) { raw[i] = *(const u32x4*)(vp + 8 * i);
#pragma unroll
            for (int j = 0; j < 4; ++j) { const float a = bflo(raw[i][j]), b = bfhi(raw[i][j]); ss += a * a + b * b; } }
        ss += __shfl_xor(ss, 1); ss += __shfl_xor(ss, 2);
        const float rstd = 1.0f / sqrtf(ss * (1.0f / 128.0f) + EPS);
#pragma unroll
        for (int i = 0; i < 4; ++i)
#pragma unroll
            for (int j = 0; j < 4; ++j) { const int d = dq + 8 * i + 2 * j;
                *(LAS bf16_t*)(VT + (d) * VP + s * 2) = f2bf(bflo(raw[i][j]) * rstd);
                *(LAS bf16_t*)(VT + (d + 1) * VP + s * 2) = f2bf(bfhi(raw[i][j]) * rstd); }
    }
    __syncthreads();
    const int fr = lane & 15, fq = lane >> 4;
    f32x4 acc[8];
#pragma unroll
    for (int nb = 0; nb < 8; ++nb) acc[nb] = (f32x4){0.f, 0.f, 0.f, 0.f};
    const int trow = 16 * w + fr;
    const float* wrow = Ws + ((size_t)h * 128 + trow) * 128;
#pragma unroll
    for (int ks = 0; ks < 4; ++ks) {
        if (32 * ks <= 16 * w + 15) {
            const int s0 = 32 * ks + 8 * fq;
            const f32x4 wa = *(const f32x4*)(wrow + s0), wb = *(const f32x4*)(wrow + s0 + 4);
            float wv[8] = {wa[0], wa[1], wa[2], wa[3], wb[0], wb[1], wb[2], wb[3]};
#pragma unroll
            for (int j = 0; j < 8; ++j) if (s0 + j > trow) wv[j] = 0.f;
            u32x4 aw; aw.x = cvt_pk_bf16(wv[0], wv[1]); aw.y = cvt_pk_bf16(wv[2], wv[3]); aw.z = cvt_pk_bf16(wv[4], wv[5]); aw.w = cvt_pk_bf16(wv[6], wv[7]);
            const bf16x8 af = __builtin_bit_cast(bf16x8, aw);
#pragma unroll
            for (int nb = 0; nb < 8; ++nb) { const bf16x8 bfr = *(const LAS bf16x8*)(VT + (16 * nb + fr) * VP + s0 * 2);
                acc[nb] = __builtin_amdgcn_mfma_f32_16x16x32_bf16(af, bfr, acc[nb], 0, 0, 0); }
        }
    }
    LAS bf16_t* DT = (LAS bf16_t*)(F.lds + RING_OFF + 36864);
#pragma unroll
    for (int i = 0; i < 4; ++i) { const int tl = 16 * w + 4 * fq + i; const float bt = bs[h * 128 + tl];
#pragma unroll
        for (int nb = 0; nb < 8; ++nb) DT[tl * 136 + 16 * nb + fr] = f2bf(gv[h * 128 + 16 * nb + fr] * acc[nb][i] + bt); }
    __syncthreads();
#pragma unroll
    for (int k = 0; k < 4; ++k) { const int idx = tid + 512 * k, tl = idx >> 4, c8 = (idx & 15) * 8;
        const u32x4 mv = *(const LAS u32x4*)(DT + tl * 136 + c8); const u32x4 uv = *(const u32x4*)(Z + (size_t)(t0 + tl) * EVEN_IN + h * 128 + c8);
        u32x4 o; o.x = cvt_pk_bf16(bflo(uv.x) * bflo(mv.x), bfhi(uv.x) * bfhi(mv.x)); o.y = cvt_pk_bf16(bflo(uv.y) * bflo(mv.y), bfhi(uv.y) * bfhi(mv.y));
        o.z = cvt_pk_bf16(bflo(uv.z) * bflo(mv.z), bfhi(uv.z) * bfhi(mv.z)); o.w = cvt_pk_bf16(bflo(uv.w) * bflo(mv.w), bfhi(uv.w) * bfhi(mv.w));
        *(u32x4*)(MIX + (size_t)(t0 + tl) * DM + h * 128 + c8) = o; }
    __syncthreads();
}

__device__ __forceinline__ void router_phase(Frame& F, const bf16_t* x, const float* gain, const float* Wr, const float* br, gu32* cnt  ,
                                             unsigned* tok_er, float* tok_g, unsigned char* XG) {
    LAS float* part = (LAS float*)(F.lds + RING_OFF);
    LAS float* ssqp = (LAS float*)(F.lds + RING_OFF + 8 * 64 * 33 * 4);
    LAS float* lg = (LAS float*)(F.lds + SCR_OFF);
    LAS unsigned* hist = (LAS unsigned*)(F.lds + SCR_OFF + 64 * 33 * 4);
    LAS unsigned* base = hist + 32;
    LAS unsigned* ers = base + 32;
    int tid_ = threadIdx.x; asm volatile("" : "+v"(tid_));
    const int tid = tid_, lane = tid & 63, w = __builtin_amdgcn_readfirstlane(tid >> 6), r32 = lane & 31, hi = lane >> 5;
#ifndef RTR_REP_A
#define RTR_REP_A 1
#define RTR_REP_B 1
#define RTR_REP_C 1
#endif
    f32x4 gg[4];
#pragma unroll
    for (int j = 0; j < 4; ++j) gg[j] = ((const f32x4*)gain + lane)[64 * j];
    {   const int tg = F.vcu;
    const int tokb = tg * 64;
    if (tid < 32) hist[tid] = 0u;
    for (int rb_ = 0; rb_ < RTR_REP_B; ++rb_) {
        bf16x8 wh[8], wl[8];
#pragma unroll
        for (int ks = 0; ks < 8; ++ks) { float wv[8];
#pragma unroll
            for (int j = 0; j < 8; ++j) { const int k = 128 * w + 16 * ks + 8 * hi + j; wv[j] = Wr[(size_t)k * NE + r32] * gain[k]; }
            u32x4 h4, l4;
#pragma unroll
            for (int j = 0; j < 4; ++j) { const unsigned hp = cvt_pk_bf16(wv[2 * j], wv[2 * j + 1]); h4[j] = hp; l4[j] = cvt_pk_bf16(wv[2 * j] - bflo(hp), wv[2 * j + 1] - bfhi(hp)); }
            wh[ks] = __builtin_bit_cast(bf16x8, h4); wl[ks] = __builtin_bit_cast(bf16x8, l4); }
#pragma unroll
        for (int g2 = 0; g2 < 2; ++g2) {
            const bf16_t* xr = x + (size_t)(tokb + 32 * g2 + r32) * DM + 128 * w + 8 * hi;
            f32x16 d = f32x16{}; float ss = 0.f;
#pragma unroll
            for (int ks = 0; ks < 8; ++ks) { const u32x4 xw = *(const u32x4*)(xr + 16 * ks);
#pragma unroll
                for (int j = 0; j < 4; ++j) { const float a = bflo(xw[j]), b = bfhi(xw[j]); ss += a * a + b * b; }
                const bf16x8 xh = __builtin_bit_cast(bf16x8, xw);
                d = __builtin_amdgcn_mfma_f32_32x32x16_bf16(wh[ks], xh, d, 0, 0, 0);
                d = __builtin_amdgcn_mfma_f32_32x32x16_bf16(wl[ks], xh, d, 0, 0, 0); }
            { auto rr = __builtin_amdgcn_permlane32_swap(__float_as_uint(ss), __float_as_uint(ss), false, false); ss = __uint_as_float(rr[0]) + __uint_as_float(rr[1]); }
            if (hi == 0) ssqp[w * 64 + 32 * g2 + r32] = ss;
#pragma unroll
            for (int r = 0; r < 16; ++r) part[(w * 64 + 32 * g2 + r32) * 33 + (r & 3) + 8 * (r >> 2) + 4 * hi] = d[r];
        }
    }
    __syncthreads();
    {   const int t = tid >> 3, q4 = (tid & 7) * 4; float s = 0.f;
#pragma unroll
        for (int ww = 0; ww < 8; ++ww) s += ssqp[ww * 64 + t];
        const float rstd = 1.0f / sqrtf(s * (1.f / DM) + EPS);
#pragma unroll
        for (int i = 0; i < 4; ++i) { float a = 0.f;
#pragma unroll
            for (int ww = 0; ww < 8; ++ww) a += part[(ww * 64 + t) * 33 + q4 + i];
            lg[t * 33 + q4 + i] = a * rstd + br[q4 + i]; } }
    __syncthreads();
    unsigned my_e[4] = {0, 0, 0, 0}, my_lr[4] = {0, 0, 0, 0}; float my_g[4] = {0, 0, 0, 0};
    if (tid < 64) {
        float v[32];
#pragma unroll
        for (int e = 0; e < 32; ++e) v[e] = lg[tid * 33 + e];
        int c0 = -1, c1 = -1, c2 = -1; float tv[4];
#pragma unroll
        for (int r = 0; r < 4; ++r) { float best = -__builtin_inff(); int bi = 0;
#pragma unroll
            for (int e = 0; e < 32; ++e) { const bool ok = (e != c0) && (e != c1) && (e != c2); if (ok && v[e] > best) { best = v[e]; bi = e; } }
            tv[r] = best; my_e[r] = (unsigned)bi; if (r == 0) c0 = bi; else if (r == 1) c1 = bi; else if (r == 2) c2 = bi; }
        const float p1 = __expf(tv[1] - tv[0]), p2 = __expf(tv[2] - tv[0]), p3 = __expf(tv[3] - tv[0]); const float inv = 1.0f / (1.0f + p1 + p2 + p3);
        my_g[0] = inv; my_g[1] = p1 * inv; my_g[2] = p2 * inv; my_g[3] = p3 * inv;
#pragma unroll
        for (int r = 0; r < 4; ++r) my_lr[r] = __hip_atomic_fetch_add(hist + my_e[r], 1u, __ATOMIC_RELAXED, __HIP_MEMORY_SCOPE_WORKGROUP);
    }
    __syncthreads();
    if (tid < 32) { const unsigned hc = hist[tid]; base[tid] = hc ? __hip_atomic_fetch_add(cnt + 64 * tid, hc, RLX_AGENT) : 0u; }
    __syncthreads();
    if (tid < 64) {
        u32x4 er; f32x4 gt;
#pragma unroll
        for (int r = 0; r < 4; ++r) { const unsigned rank = base[my_e[r]] + my_lr[r]; er[r] = (my_e[r] << 16) | rank; gt[r] = my_g[r]; ers[tid * 4 + r] = er[r]; }
        *(u32x4*)(tok_er + (size_t)(tokb + tid) * 4) = er; *(f32x4*)(tok_g + (size_t)(tokb + tid) * 4) = gt;
    }
    __syncthreads();
    for (int rc_ = 0; rc_ < RTR_REP_C; ++rc_)
#pragma unroll 2
    for (int tt = 0; tt < 8; ++tt) {
        const int tl = w * 8 + tt; const bf16_t* xrow = x + (size_t)(tokb + tl) * DM;
        f32x4 hv[4]; float s = 0.f;
#pragma unroll
        for (int j = 0; j < 4; ++j) { const u32x2 t = ((const u32x2*)xrow + lane)[64 * j]; hv[j] = (f32x4){bflo(t.x), bfhi(t.x), bflo(t.y), bfhi(t.y)}; s += (hv[j].x * hv[j].x + hv[j].y * hv[j].y) + (hv[j].z * hv[j].z + hv[j].w * hv[j].w); }
        const float rstd = 1.0f / sqrtf(wave_sum(s) * (1.f / DM) + EPS);
        unsigned wv[4];
#pragma unroll
        for (int j = 0; j < 4; ++j) { const f32x4 t = hv[j] * rstd * gg[j]; wv[j] = pk4_fp8(t.x, t.y, t.z, t.w); }
#pragma unroll
        for (int r = 0; r < 4; ++r) { const unsigned er = ers[tl * 4 + r]; const size_t slot = (size_t)(er >> 16) * ECAP + (er & 0xffffu);
            unsigned* o4 = (unsigned*)(XG + slot * DM) + lane;
#pragma unroll
            for (int j = 0; j < 4; ++j) o4[64 * j] = wv[j]; }
    }
    __syncthreads();
    }
}

__device__ __forceinline__ void combine_phase(Frame& F, bf16_t* x, float* out32  , const unsigned* tok_er, const float* tok_g, const bf16_t* Y, const float* g_next, unsigned char* XN, bool xn_fp8) {
    int tid_ = threadIdx.x; asm volatile("" : "+v"(tid_));
    const int gw = F.vcu * NWAVES + __builtin_amdgcn_readfirstlane(tid_ >> 6), NGW = F.G * NWAVES, lane = tid_ & 63;
    u32x4 erA, erB, erAn, erBn; f32x4 gtA, gtB, gtAn, gtBn;
    { const int ma = gw < M ? gw : 0, mb0 = gw + NGW < M ? gw + NGW : ma;
      erAn = *(const u32x4*)(tok_er + (size_t)ma * 4); erBn = *(const u32x4*)(tok_er + (size_t)mb0 * 4); gtAn = *(const f32x4*)(tok_g + (size_t)ma * 4); gtBn = *(const f32x4*)(tok_g + (size_t)mb0 * 4); }
    for (int m0 = gw; m0 < M; m0 += 2 * NGW) {
        const int m1 = m0 + NGW; const bool two = m1 < M; const int mb = two ? m1 : m0;
        erA = erAn; erB = erBn; gtA = gtAn; gtB = gtBn;
        { const int na = m0 + 2 * NGW < M ? m0 + 2 * NGW : m0, nb2 = m0 + 3 * NGW < M ? m0 + 3 * NGW : na;
          erAn = *(const u32x4*)(tok_er + (size_t)na * 4); erBn = *(const u32x4*)(tok_er + (size_t)nb2 * 4); gtAn = *(const f32x4*)(tok_g + (size_t)na * 4); gtBn = *(const f32x4*)(tok_g + (size_t)nb2 * 4); }
        bf16_t* xrA = x + (size_t)m0 * DM; bf16_t* xrB = x + (size_t)mb * DM;
        u32x2 xa[4], xb[4], ya[4][4], yb[4][4];
#pragma unroll
        for (int j = 0; j < 4; ++j) { xa[j] = ((const u32x2*)xrA + lane)[64 * j]; xb[j] = ((const u32x2*)xrB + lane)[64 * j]; }
#pragma unroll
        for (int r = 0; r < 4; ++r) { const size_t sA = (size_t)(erA[r] >> 16) * ECAP + (erA[r] & 0xffffu), sB = (size_t)(erB[r] >> 16) * ECAP + (erB[r] & 0xffffu);
#pragma unroll
            for (int j = 0; j < 4; ++j) { ya[r][j] = ((const u32x2*)(Y + sA * DM) + lane)[64 * j]; yb[r][j] = ((const u32x2*)(Y + sB * DM) + lane)[64 * j]; } }
#pragma unroll
        for (int t = 0; t < 2; ++t) {
            if (t == 1 && !two) break;
            const int m = t ? m1 : m0; bf16_t* xrow = t ? xrB : xrA; const f32x4 gt = t ? gtB : gtA;
            f32x4 v[4];
#pragma unroll
            for (int j = 0; j < 4; ++j) { const u32x2 q = t ? xb[j] : xa[j]; v[j] = (f32x4){bflo(q.x), bfhi(q.x), bflo(q.y), bfhi(q.y)}; }
#pragma unroll
            for (int r = 0; r < 4; ++r) { const float g = gt[r];
#pragma unroll
                for (int j = 0; j < 4; ++j) { const u32x2 yv = t ? yb[r][j] : ya[r][j]; v[j].x += g * bflo(yv.x); v[j].y += g * bfhi(yv.x); v[j].z += g * bflo(yv.y); v[j].w += g * bfhi(yv.y); } }
#pragma unroll
            for (int j = 0; j < 4; ++j) { if (out32) ((f32x4*)(out32 + (size_t)m * DM) + lane)[64 * j] = v[j];
                else { u32x2 q; q.x = cvt_pk_bf16(v[j].x, v[j].y); q.y = cvt_pk_bf16(v[j].z, v[j].w); ((u32x2*)xrow + lane)[64 * j] = q; } }
            if (g_next) {
                float s = 0.f;
#pragma unroll
                for (int j = 0; j < 4; ++j) s += (v[j].x * v[j].x + v[j].y * v[j].y) + (v[j].z * v[j].z + v[j].w * v[j].w);
                const float rstd = 1.0f / sqrtf(wave_sum(s) * (1.f / DM) + EPS);
                unsigned* o4 = (unsigned*)(XN + (size_t)m * DM) + lane; u32x2* o8 = (u32x2*)(XN + (size_t)m * DM * 2) + lane;
#pragma unroll
                for (int j = 0; j < 4; ++j) { const f32x4 gg = ((const f32x4*)g_next + lane)[64 * j];
                    if (xn_fp8) o4[64 * j] = pk4_fp8(v[j].x * rstd * gg.x, v[j].y * rstd * gg.y, v[j].z * rstd * gg.z, v[j].w * rstd * gg.w);
                    else { u32x2 w; w.x = cvt_pk_bf16(v[j].x * rstd * gg.x, v[j].y * rstd * gg.y); w.y = cvt_pk_bf16(v[j].z * rstd * gg.z, v[j].w * rstd * gg.w); o8[64 * j] = w; } }
            }
        }
    }
}

__device__ __forceinline__ void unpack8f8(const u32x2 w, float (&f)[8]) { const f32x2 a = __builtin_amdgcn_cvt_pk_f32_fp8((int)w.x, false), b = __builtin_amdgcn_cvt_pk_f32_fp8((int)w.x, true),
    c = __builtin_amdgcn_cvt_pk_f32_fp8((int)w.y, false), d = __builtin_amdgcn_cvt_pk_f32_fp8((int)w.y, true); f[0] = a.x; f[1] = a.y; f[2] = b.x; f[3] = b.y; f[4] = c.x; f[5] = c.y; f[6] = d.x; f[7] = d.y; }
__device__ __forceinline__ void unpack4f8(const unsigned w, float (&f)[4]) { const f32x2 a = __builtin_amdgcn_cvt_pk_f32_fp8((int)w, false), b = __builtin_amdgcn_cvt_pk_f32_fp8((int)w, true); f[0] = a.x; f[1] = a.y; f[2] = b.x; f[3] = b.y; }
__device__ __forceinline__ void unpack8(const u32x4 w, float (&f)[8]) { f[0] = bflo(w.x); f[1] = bfhi(w.x); f[2] = bflo(w.y); f[3] = bfhi(w.y); f[4] = bflo(w.z); f[5] = bfhi(w.z); f[6] = bflo(w.w); f[7] = bfhi(w.w); }
__device__ __forceinline__ void unpack4(const u32x2 w, float (&f)[4]) { f[0] = bflo(w.x); f[1] = bfhi(w.x); f[2] = bflo(w.y); f[3] = bfhi(w.y); }
__device__ __forceinline__ void fin_head(const float (&a)[8], const float (&b)[8], const float (&x1)[4], const float (&x2)[4], const float (&g)[24], const float (&cs)[4], const float (&sn)[4], unsigned char* op, int j) {
    float ss = 0.f;
#pragma unroll
    for (int i = 0; i < 8; ++i) ss += a[i] * a[i] + b[i] * b[i];
#pragma unroll
    for (int i = 0; i < 4; ++i) ss += x1[i] * x1[i] + x2[i] * x2[i];
    ss += __shfl_xor(ss, 1); ss += __shfl_xor(ss, 2); ss += __shfl_xor(ss, 4);
    const float rstd = 1.0f / sqrtf(ss * (1.0f / 192.0f) + EPS);
    u32x4 o0;
    o0.x = pk4_fp8(a[0] * rstd * g[0], a[1] * rstd * g[1], a[2] * rstd * g[2], a[3] * rstd * g[3]); o0.y = pk4_fp8(a[4] * rstd * g[4], a[5] * rstd * g[5], a[6] * rstd * g[6], a[7] * rstd * g[7]);
    o0.z = pk4_fp8(b[0] * rstd * g[8], b[1] * rstd * g[9], b[2] * rstd * g[10], b[3] * rstd * g[11]); o0.w = pk4_fp8(b[4] * rstd * g[12], b[5] * rstd * g[13], b[6] * rstd * g[14], b[7] * rstd * g[15]);
    float y1[4], y2[4];
#pragma unroll
    for (int i = 0; i < 4; ++i) { const float u = x1[i] * rstd * g[16 + i], v = x2[i] * rstd * g[20 + i]; y1[i] = u * cs[i] - v * sn[i]; y2[i] = u * sn[i] + v * cs[i]; }
    *(u32x4*)(op + 16 * j) = o0; *(unsigned*)(op + 128 + 4 * j) = pk4_fp8(y1[0], y1[1], y1[2], y1[3]); *(unsigned*)(op + 160 + 4 * j) = pk4_fp8(y2[0], y2[1], y2[2], y2[3]);
}
__device__ __forceinline__ void mla_finalize_phase(Frame& F, const unsigned char* QR, const unsigned char* KVR, const bf16_t* Z, const float* gq, const float* gk, unsigned char* QF, unsigned char* KF) {
    int tid_ = threadIdx.x; asm volatile("" : "+v"(tid_));
    const int gw = F.vcu * NWAVES + __builtin_amdgcn_readfirstlane(tid_ >> 6), NGW = F.G * NWAVES, lane = tid_ & 63;
    const int h = lane >> 3, j = lane & 7;
    float gqv[24], gkv[24], invf[4];
#pragma unroll
    for (int i = 0; i < 16; ++i) { gqv[i] = gq[16 * j + i]; gkv[i] = gk[16 * j + i]; }
#pragma unroll
    for (int i = 0; i < 4; ++i) { gqv[16 + i] = gq[128 + 4 * j + i]; gqv[20 + i] = gq[160 + 4 * j + i]; gkv[16 + i] = gk[128 + 4 * j + i]; gkv[20 + i] = gk[160 + 4 * j + i];
        invf[i] = __builtin_amdgcn_exp2f(-(float)(4 * j + i) * (13.287712379549449f / 32.0f)); }
#pragma unroll 2
    for (int m = gw; m < M; m += NGW) {
        const int pos = m & (SEQ - 1);
        float cs[4], sn[4];
#pragma unroll
        for (int i = 0; i < 4; ++i) { const double rev = (double)pos * (double)invf[i] * 0.15915494309189535; const float fr = (float)(rev - __builtin_rint(rev));
            sn[i] = __builtin_amdgcn_sinf(fr); cs[i] = __builtin_amdgcn_cosf(fr); }
        const unsigned char* qp = QR + (size_t)m * 1536 + h * 192; const unsigned char* kp = KVR + (size_t)m * 2048 + h * 256; const bf16_t* zp = Z + (size_t)m * ODD_INP + 768;
        const u32x4 qn = *(const u32x4*)(qp + 16 * j); const unsigned qr1 = *(const unsigned*)(qp + 128 + 4 * j), qr2 = *(const unsigned*)(qp + 160 + 4 * j);
        const u32x4 kn = *(const u32x4*)(kp + 16 * j); const u32x2 kr1 = *(const u32x2*)(zp + 4 * j), kr2 = *(const u32x2*)(zp + 32 + 4 * j);
        float a[8], b[8], x1[4], x2[4];
        unpack8f8((u32x2){qn.x, qn.y}, a); unpack8f8((u32x2){qn.z, qn.w}, b); unpack4f8(qr1, x1); unpack4f8(qr2, x2);
        fin_head(a, b, x1, x2, gqv, cs, sn, QF + (size_t)m * 1536 + h * 192, j);
        unpack8f8((u32x2){kn.x, kn.y}, a); unpack8f8((u32x2){kn.z, kn.w}, b); unpack4(kr1, x1); unpack4(kr2, x2);
        fin_head(a, b, x1, x2, gkv, cs, sn, KF + (size_t)m * 1536 + h * 192, j);
    }
}

__device__ __forceinline__ void vt_phase(Frame& F, const unsigned char* KVR, unsigned char* VT8) {
    int tid_ = threadIdx.x; asm volatile("" : "+v"(tid_));
    const int tid = tid_;
    LAS unsigned char* T = F.lds + RING_OFF;
    for (int it = F.vcu; it < M / 64; it += F.G) {
        const int m0 = it * 64, b = m0 / SEQ, tok0 = m0 % SEQ;
#pragma unroll 4
        for (int k = 0; k < 8; ++k) { const int idx = tid + 512 * k, tok = idx >> 6, grp = idx & 63, h = grp >> 3, d16 = (grp & 7) * 16;
            const u32x4 w = *(const u32x4*)(KVR + (size_t)(m0 + tok) * 2048 + h * 256 + 128 + d16);
            LAS unsigned char* tp = T + (h * 128 + d16) * 80 + tok;
#pragma unroll
            for (int i = 0; i < 4; ++i) { const unsigned x = w[i]; tp[(4 * i) * 80] = (unsigned char)x; tp[(4 * i + 1) * 80] = (unsigned char)(x >> 8); tp[(4 * i + 2) * 80] = (unsigned char)(x >> 16); tp[(4 * i + 3) * 80] = (unsigned char)(x >> 24); } }
        __syncthreads();
#pragma unroll 4
        for (int k = 0; k < 8; ++k) { const int idx = tid + 512 * k, row = idx >> 2, q = idx & 3;
            const u32x4 v = *(const LAS u32x4*)(T + row * 80 + 16 * q);
            *(u32x4*)(VT8 + ((size_t)b * 1024 + row) * SEQ + tok0 + 16 * q) = v; }
        __syncthreads();
    }
}

#ifndef PHMASK
#define PHMASK 0xFFFF
#endif
#ifndef REPMASK
#define REPMASK 0
#endif
#ifndef REPCNT
#define REPCNT 3
#endif
#define NREP(k) ((((REPMASK) >> (k)) & 1) ? (REPCNT) : 1)

#define LAUNDER_S(x) asm volatile("" : "+s"(x))
__device__ __forceinline__ const float* in_ptr(const Args& a, int i) { LAUNDER_S(i); return a.in[i]; }
#define PHASE_BEGIN() unsigned wso_ = 0u; LAUNDER_S(wso_); unsigned char* ws = args.ws + wso_; Frame Fp = F; Fp.vcu = __builtin_amdgcn_readfirstlane(Fp.vcu); Fp.G = __builtin_amdgcn_readfirstlane(Fp.G); LAUNDER_S(Fp.vcu); LAUNDER_S(Fp.G); \
    int bx_ = __builtin_amdgcn_readfirstlane((int)blockIdx.x); LAUNDER_S(bx_); (void)bx_; (void)ws
#define XN  ((unsigned char*)(ws + WS_XN))
#define Z   ((bf16_t*)(ws + WS_Z))
#define MIX ((bf16_t*)(ws + WS_MIX))
#define QR  ((unsigned char*)(ws + WS_QR))
#define KVR ((unsigned char*)(ws + WS_KVR))
#define QF  ((unsigned char*)(ws + WS_QF))
#define KF  ((unsigned char*)(ws + WS_KF))
#define XG  ((unsigned char*)(ws + WS_XG))
#define ACT ((unsigned char*)(ws + WS_ACT))
#define YB  ((bf16_t*)(ws + WS_Y))
#define SSQ ((float*)(ws + WS_SSQ))
#define TOKER ((unsigned*)(ws + WS_TOKER))
#define TOKG ((float*)(ws + WS_TOKG))
#define B1P ((float*)(ws + WS_B1P))
#define IN(i) in_ptr(args, (i))
__global__ void __launch_bounds__(NWAVES * 64, 2) trunk_fwd(Args args) {
    extern __shared__ __attribute__((aligned(16))) unsigned char lds_raw[];
    Frame F;
    F.lds = (LAS unsigned char*)lds_raw;
    F.G = gridDim.x; { const int bx = blockIdx.x; F.vcu = (F.G % 8 == 0) ? (bx % 8) * (F.G / 8) + bx / 8 : bx; }
    for (int u = threadIdx.x; u < (SCR_OFF - LDSCTL_OFF) / 4; u += NWAVES * 64) ((LAS unsigned*)(F.lds + LDSCTL_OFF))[u] = 0u;
    __syncthreads();
    (void)xcd_barrier_post((unsigned*)((gu32*)(args.ws + WS_CTL) + CW_BAR), (volatile LAS unsigned*)(F.lds + MISC_OFF) + 8);
#define GRID_BAR() do { unsigned wsb_ = 0u; LAUNDER_S(wsb_); XcdBarrier bar_; bar_.bar = (unsigned*)((gu32*)(args.ws + wsb_ + WS_CTL) + CW_BAR); bar_.x = xb_xcc_id(); \
        bar_.st = (volatile LAS unsigned*)(F.lds + MISC_OFF) + 8; xcd_barrier(bar_); } while (0)
#define X16 ((bf16_t*)(ws + WS_X16))
    const int stage_limit = args.stage_limit;

#if (PHMASK >> 0) & 1
            _Pragma("unroll") for (int rep_ = 0; rep_ < NREP(0); ++rep_) { if (rep_) GRID_BAR();
    {   PHASE_BEGIN(); const int ptid = threadIdx.x, gw = Fp.vcu * NWAVES + __builtin_amdgcn_readfirstlane(ptid >> 6), NGW = Fp.G * NWAVES;
        transpose_job<1>(Fp, IN(I_EWIN), DM, EVEN_IN, 2, (size_t)DM * EVEN_IN, (bf16_t*)(ws + WS_WEIN), (size_t)EVEN_IN * DM, nullptr, 0);
        transpose_job<0>(Fp, IN(I_EWOUT), DM, DM, 2, (size_t)DM * DM, (bf16_t*)(ws + WS_WEOUT), (size_t)DM * DM, nullptr, 0);
        transpose_job_fp8<0>(Fp, IN(I_OWIN), DM, ODD_IN, 2, (size_t)DM * ODD_IN, ws + WS_WOIN, (size_t)ODD_INP * DM);
        transpose_job_fp8<0>(Fp, IN(I_OWUQ), 512, 1536, 2, (size_t)512 * 1536, ws + WS_WUQ, (size_t)1536 * 512, IN(I_OGCQ), 512);
        transpose_job_fp8<0>(Fp, IN(I_OWUKV), 256, 2048, 2, (size_t)256 * 2048, ws + WS_WUKV, (size_t)2048 * 256, IN(I_OGCKV), 256);
        transpose_job_fp8<0>(Fp, IN(I_OWOUT), DM, DM, 2, (size_t)DM * DM, ws + WS_WOOUT, (size_t)DM * DM);
        transpose_job_fp8<2>(Fp, IN(I_W1), DM, 2 * DE, DEPTH * NE, (size_t)DM * 2 * DE, ws + WS_W1, (size_t)2 * DE * DM);
        transpose_job_fp8<0>(Fp, IN(I_W2), DE, DM, DEPTH * NE, (size_t)DE * DM, ws + WS_W2, (size_t)DM * DE);
        for (int i = bx_ * 512 + ptid; i < 2 * 12288; i += Fp.G * 512) { const int mi = i / 12288, r = i % 12288;
            *(u32x4*)(ws + WS_WOIN + (size_t)mi * ODD_INP * DM + (size_t)ODD_IN * DM + (size_t)r * 16) = (u32x4){0u, 0u, 0u, 0u}; }
        for (int i = bx_ * 512 + ptid; i < DEPTH * NE * 2048; i += Fp.G * 512) { const int c = i & 2047, o = 2 * (128 * (c >> 8) + (c & 127)) + ((c >> 7) & 1);
            B1P[i] = IN(I_B1)[(size_t)(i & ~2047) + o]; }
        for (int m = gw; m < M; m += NGW) rms_row_to_bf16(ptid & 63, IN(I_X) + (size_t)m * DM, IN(I_MIXN), (bf16_t*)XN + (size_t)m * DM, nullptr);
    }
            }
#endif
    GRID_BAR();

#ifdef EXTRA_BARS
    for (int xb_ = 0; xb_ < EXTRA_BARS; ++xb_) GRID_BAR();
#endif
    for (int l = 0; l < DEPTH; ++l) {
        const int li = l >> 1;
        if (2 * l + 1 > stage_limit) break;
        if ((l & 1) == 0) {
#if (PHMASK >> 1) & 1
            _Pragma("unroll") for (int rep_ = 0; rep_ < NREP(1); ++rep_) { if (rep_) GRID_BAR();
            {   PHASE_BEGIN(); pg8::Gemm g{(const bf16_t*)XN, (const bf16_t*)(ws + WS_WEIN) + (size_t)li * EVEN_IN * DM, DM, DM, nullptr, nullptr}; pg8::StaticOrder S; S.init(M, EVEN_IN, Fp.G, bx_);
                pg8::EpiEvenIn E{Z, IN(I_EGQ) + li * 64, IN(I_EGK) + li * 64};
                pg8::gemm_phase<pg8::EpiEvenIn, pg8::StaticOrder>(Fp.lds + RING_OFF, g, S, E); }
            }
#endif
            GRID_BAR();
            {   PHASE_BEGIN();
#if (PHMASK >> 2) & 1
            _Pragma("unroll") for (int rep_ = 0; rep_ < NREP(2); ++rep_) { if (rep_) GRID_BAR();
                for (int u = Fp.vcu; u < 512; u += Fp.G)
                    gmlp_unit(Fp, Z, MIX, IN(I_EWS) + (size_t)li * 4 * 128 * 128, IN(I_EBS) + li * 512, IN(I_EGV) + li * 512, u);
            }
#endif
#if (PHMASK >> 3) & 1
            _Pragma("unroll") for (int rep_ = 0; rep_ < NREP(3); ++rep_) { if (rep_) GRID_BAR();
                for (int u = Fp.vcu; u < 256; u += Fp.G) { const int bh = u >> 4, s = u & 15, b = bh >> 3, h = bh & 7;
                    for (int pass = 0; pass < 2; ++pass) { const int qb = pass ? 31 - s : s;
                        const bf16_t* zb = Z + (size_t)b * SEQ * EVEN_IN;
                        dil::unit(zb + 1024 + 64 * h, zb + 1536 + 64 * h, zb + 2048 + 64 * h, EVEN_IN, MIX + (size_t)b * SEQ * DM + 512 + 64 * h, DM, qb * 256, Fp.lds + RING_OFF, (LAS float*)(Fp.lds + SCR_OFF)); } }
            }
#endif
            }
            GRID_BAR();
#if (PHMASK >> 4) & 1
            _Pragma("unroll") for (int rep_ = 0; rep_ < NREP(4); ++rep_) { if (rep_) GRID_BAR();
            {   PHASE_BEGIN(); pg8::Gemm g{MIX, (const bf16_t*)(ws + WS_WEOUT) + (size_t)li * DM * DM, DM, DM, nullptr, nullptr}; pg8::StaticOrder S; S.init(M, DM, Fp.G, bx_);
                pg8::EpiResid E{l == 0 ? IN(I_X) : nullptr, X16};
                pg8::gemm_phase<pg8::EpiResid, pg8::StaticOrder>(Fp.lds + RING_OFF, g, S, E); }
            }
#endif
            GRID_BAR();
        } else {
#if (PHMASK >> 5) & 1
            _Pragma("unroll") for (int rep_ = 0; rep_ < NREP(5); ++rep_) { if (rep_) GRID_BAR();
            {   PHASE_BEGIN(); pg8::Gemm g{(const bf16_t*)XN, (const bf16_t*)(ws + WS_WOIN + (size_t)li * ODD_INP * DM), DM / 2, DM / 2, nullptr, nullptr}; pg8::StaticOrder S; S.init(M, ODD_INP, Fp.G, bx_);
                pg8::EpiOddIn E{Z, ws + WS_Z8, SSQ};
                pg8::gemm_phase<pg8::EpiOddIn, pg8::StaticOrder, true>(Fp.lds + RING_OFF, g, S, E); }
            }
#endif
            GRID_BAR();
#if (PHMASK >> 6) & 1
            _Pragma("unroll") for (int rep_ = 0; rep_ < NREP(6); ++rep_) { if (rep_) GRID_BAR();
            {   PHASE_BEGIN(); pg8::Gemm g{(const bf16_t*)(ws + WS_Z8 + 512), (const bf16_t*)(ws + WS_WUKV + (size_t)li * 2048 * 256), ODD_INP / 2, 128, nullptr, nullptr}; pg8::StaticOrder S; S.init(M, 2048, Fp.G, bx_);
                pg8::EpiRowScale<1> E{KVR, 2048, SSQ, 8, 1.0f / 256.0f};
                pg8::gemm_phase<pg8::EpiRowScale<1>, pg8::StaticOrder, true>(Fp.lds + RING_OFF, g, S, E); }
            {   PHASE_BEGIN(); pg8::Gemm g{(const bf16_t*)(ws + WS_Z8), (const bf16_t*)(ws + WS_WUQ + (size_t)li * 1536 * 512), ODD_INP / 2, 256, nullptr, nullptr}; pg8::StaticOrder S; S.init(M, 1536, Fp.G, bx_);
                pg8::EpiRowScale<2> E{QR, 1536, SSQ, 0, 1.0f / 512.0f};
                pg8::gemm_phase<pg8::EpiRowScale<2>, pg8::StaticOrder, true>(Fp.lds + RING_OFF, g, S, E); }
            }
#endif
            GRID_BAR();
#if (PHMASK >> 7) & 1
            _Pragma("unroll") for (int rep_ = 0; rep_ < NREP(7); ++rep_) { if (rep_) GRID_BAR();
            {   PHASE_BEGIN(); mla_finalize_phase(Fp, QR, KVR, Z, IN(I_OGQ) + li * 192, IN(I_OGK) + li * 192, QF, KF); vt_phase(Fp, KVR, ws + WS_VT); }
            }
#endif
            GRID_BAR();
#if (PHMASK >> 8) & 1
            _Pragma("unroll") for (int rep_ = 0; rep_ < NREP(8); ++rep_) { if (rep_) GRID_BAR();
            {   PHASE_BEGIN();
                for (int u = Fp.vcu; u < 256; u += Fp.G) { const int bh = u >> 4, s = u & 15, b = bh >> 3, h = bh & 7;
                    for (int pass = 0; pass < 2; ++pass) { const int qb = pass ? 31 - s : s;
                        mla::unit(QF + (size_t)b * SEQ * 1536 + 192 * h, KF + (size_t)b * SEQ * 1536 + 192 * h, 1536, ws + WS_VT + ((size_t)(b * 8 + h) * 128) * SEQ,
                                  ws + WS_MIX8 + (size_t)b * SEQ * DM + 128 * h, DM, qb * 256, Fp.lds + RING_OFF); } }
            }
            }
#endif
            GRID_BAR();
#if (PHMASK >> 9) & 1
            _Pragma("unroll") for (int rep_ = 0; rep_ < NREP(9); ++rep_) { if (rep_) GRID_BAR();
            {   PHASE_BEGIN(); pg8::Gemm g{(const bf16_t*)(ws + WS_MIX8), (const bf16_t*)(ws + WS_WOOUT + (size_t)li * DM * DM), DM / 2, DM / 2, nullptr, nullptr}; pg8::StaticOrder S; S.init(M, DM, Fp.G, bx_);
                pg8::EpiResidT<true> E{nullptr, X16};
                pg8::gemm_phase<pg8::EpiResidT<true>, pg8::StaticOrder, true>(Fp.lds + RING_OFF, g, S, E); }
            }
#endif
            GRID_BAR();
        }
        if (2 * l + 2 > stage_limit) break;
#if (PHMASK >> 10) & 1
            _Pragma("unroll") for (int rep_ = 0; rep_ < NREP(10); ++rep_) {
        {   PHASE_BEGIN(); const bool dry = rep_ + 1 < NREP(10);
            gu32* cnt = (gu32*)(ws + WS_CTL) + CW_CNT + (size_t)(dry ? 8 + 4 * rep_ + l : l) * 32 * 64;
        router_phase(Fp, X16, IN(I_FFNN) + l * DM, IN(I_RW) + (size_t)l * DM * NE, IN(I_RB) + l * NE, cnt, dry ? (unsigned*)(ws + WS_QR) : TOKER, dry ? (float*)(ws + WS_QR + MiB) : TOKG, dry ? ACT : XG); }
        GRID_BAR();
            }
#endif
        LAS int* tbl = (LAS int*)(F.lds + SCR_OFF + 12288);
        {   PHASE_BEGIN(); gu32* cnt = (gu32*)(ws + WS_CTL) + CW_CNT + (size_t)l * 32 * 64;
        if (threadIdx.x == 0) { int acc = 0; for (int e = 0; e < NE; ++e) { tbl[e] = acc; const unsigned c = __hip_atomic_load(cnt + 64 * e, RLX_AGENT); acc += (int)((c + 255u) >> 8); } tbl[NE] = acc; }
        __syncthreads(); }
#if (PHMASK >> 11) & 1
            _Pragma("unroll") for (int rep_ = 0; rep_ < NREP(11); ++rep_) { if (rep_) GRID_BAR();
        {   PHASE_BEGIN();
            pg8::Gemm g{(const bf16_t*)XG, (const bf16_t*)(ws + WS_W1 + (size_t)l * NE * 2 * DE * DM), DM / 2, DM / 2, (const bf16_t*)ACT, (const bf16_t*)(ws + WS_W2 + (size_t)l * NE * DM * DE)};
            pg8::MoeMergedOrder S{tbl, Fp.G, Fp.vcu, (gu32*)(ws + WS_CTL) + CW_MOE + (size_t)(l * 320 + 1280 * rep_) * 16, -1};
            pg8::EpiMoe E{{ACT, B1P + (size_t)l * NE * 2048}, {YB, IN(I_B2) + (size_t)l * NE * DM}};
            pg8::gemm_phase<pg8::EpiMoe, pg8::MoeMergedOrder, true>(Fp.lds + RING_OFF, g, S, E); }
            }
#endif
        GRID_BAR();
#if (PHMASK >> 13) & 1
            _Pragma("unroll") for (int rep_ = 0; rep_ < NREP(13); ++rep_) {
        {   PHASE_BEGIN(); const bool dry = rep_ + 1 < NREP(13);
            combine_phase(Fp, dry ? (bf16_t*)(ACT + (size_t)128 * MiB) : X16, (!dry && l + 1 == DEPTH) ? args.out : nullptr, TOKER, TOKG, YB, (l + 1 < DEPTH) ? IN(I_MIXN) + (l + 1) * DM : nullptr, dry ? (ACT + (size_t)64 * MiB) : XN, (l & 1) == 0); }
        GRID_BAR();
            }
#endif
    }
#undef GRID_BAR
}

extern "C" void kernel_launch(void* const* d_in, const int* in_sizes, int n_in, void* d_out, int out_size, void* d_ws, size_t ws_size, hipStream_t stream) {
    static int grid = 0;
    if (grid == 0) {
        if (n_in != 24 || in_sizes[0] != M * DM || out_size != M * DM || ws_size < WS_END) {
            fprintf(stderr, "kernel_launch: unexpected shapes (n_in %d, in0 %d, out %d, ws %zu, need %zu)\n", n_in, n_in > 0 ? in_sizes[0] : -1, out_size, ws_size, (size_t)WS_END); grid = -1; return; }
        int dev = 0, cus = 0, per_cu = 0;
        if (hipGetDevice(&dev) != hipSuccess || hipDeviceGetAttribute(&cus, hipDeviceAttributeMultiprocessorCount, dev) != hipSuccess) { grid = -1; return; }
        if (hipFuncSetAttribute((const void*)trunk_fwd, hipFuncAttributeMaxDynamicSharedMemorySize, LDS_BYTES) != hipSuccess) { fprintf(stderr, "kernel_launch: hipFuncSetAttribute failed\n"); grid = -1; return; }
        if (hipOccupancyMaxActiveBlocksPerMultiprocessor(&per_cu, (const void*)trunk_fwd, NWAVES * 64, LDS_BYTES) != hipSuccess || per_cu < 1)
            fprintf(stderr, "kernel_launch: occupancy query reports %d workgroups per CU\n", per_cu);
        (void)hipGetLastError();
        if (cus < 256) { fprintf(stderr, "kernel_launch: needs 256 CUs, device has %d\n", cus); grid = -1; return; }
        grid = 256;
    }
    if (grid < 0) return;
    if (hipMemsetAsync((char*)d_ws + WS_CTL, 0, CTL_ZERO_BYTES, stream) != hipSuccess) return;
    Args a{};
    for (int i = 0; i < 24; ++i) a.in[i] = (const float*)d_in[i];
    a.out = (float*)d_out; a.ws = (unsigned char*)d_ws; a.stage_limit = STAGE_LIMIT; a.pad = 0;
    hipLaunchKernelGGL(trunk_fwd, dim3(grid), dim3(NWAVES * 64), LDS_BYTES, stream, a);
}
```

```cpp
#include <hip/hip_runtime.h>
#include <hip/hip_bf16.h>
#include <cstdio>
#include <cstdint>

#define LAS __attribute__((address_space(3)))
#define GAS __attribute__((address_space(1)))
typedef unsigned short bf16_t;
typedef short bf16x8 __attribute__((ext_vector_type(8)));
typedef short s16x4 __attribute__((ext_vector_type(4)));
typedef float f32x2 __attribute__((ext_vector_type(2)));
typedef float f32x4 __attribute__((ext_vector_type(4)));
typedef float f32x16 __attribute__((ext_vector_type(16)));
typedef unsigned u32x2 __attribute__((ext_vector_type(2)));
typedef unsigned u32x4 __attribute__((ext_vector_type(4)));
typedef int i32x4 __attribute__((ext_vector_type(4)));
typedef int i32x8 __attribute__((ext_vector_type(8)));

constexpr int BATCH = 2, SEQ = 8192, DM = 1024, M = BATCH * SEQ, DEPTH = 4;
constexpr int EVEN_IN = 2560, ODD_IN = 832, ODD_INP = 1024;
constexpr int NE = 32, DE = 1024, ECAP = 16384;
constexpr float EPS = 1e-6f;
constexpr float LOG2E = 1.4426950408889634f;
constexpr float C2_B = 0.125f * LOG2E;
constexpr float C2_C = 0.07216878364870322f * LOG2E;

__device__ __forceinline__ unsigned cvt_pk_bf16(float lo, float hi) { unsigned r; asm volatile("v_cvt_pk_bf16_f32 %0, %1, %2" : "=v"(r) : "v"(lo), "v"(hi)); return r; }
__device__ __forceinline__ float bf2f(bf16_t v) { return __uint_as_float(((unsigned)v) << 16); }
__device__ __forceinline__ float bflo(unsigned w) { return __uint_as_float(w << 16); }
__device__ __forceinline__ float bfhi(unsigned w) { return __uint_as_float(w & 0xffff0000u); }
__device__ __forceinline__ bf16_t f2bf(float f) { return (bf16_t)(cvt_pk_bf16(f, 0.f) & 0xffffu); }

__device__ __forceinline__ unsigned pk4_fp8(float a, float b, float c, float d) { int w = 0; w = __builtin_amdgcn_cvt_pk_fp8_f32(a, b, w, false); w = __builtin_amdgcn_cvt_pk_fp8_f32(c, d, w, true); return (unsigned)w; }
constexpr float W8_SCALE = 64.0f, W8_INV = 1.0f / 64.0f;

namespace pg8 {
constexpr int BM = 256, BK = 64, HALF = 128, HTB = HALF * BK * 2, STAGE_BYTES = 8 * HTB, NXCD = 8, WGM = 8;
__host__ __device__ __forceinline__ int lds_byte(int r, int c) { const int st = (r >> 4) * 2 + (c >> 5), rr = r & 15, cc = c & 31, ob = rr * 64 + cc * 2; return st * 1024 + (ob ^ (((ob >> 9) & 1) << 5)); }
__host__ __device__ __forceinline__ void stage_rc(int b, int& R, int& C) { const int st = b / 1024, sb = b % 1024, swz = sb ^ (((sb >> 9) & 1) << 5); R = (st >> 1) * 16 + swz / 64; C = (st & 1) * 32 + (swz % 64) / 2; }
__host__ __device__ __forceinline__ int perm32(int rho) { const int n = rho >> 4, i = rho & 15; return 8 * (i >> 2) + 4 * n + (i & 3); }

struct Unit { int pm, pn, pb, kind, rb; };
struct Gemm { const bf16_t* A; const bf16_t* Bt; int lda, K; const bf16_t* A2; const bf16_t* Bt2; };

struct StaticOrder {
    int nM, nN, nwg, G, c;
    __device__ void init(int M_, int N_, int G_, int c_) { nM = M_ / BM; nN = N_ / BM; nwg = nM * nN; G = G_; c = c_; }
    __device__ bool next(int i, Unit& u) const {
        const long L = (long)i * G + c; if (L >= nwg) return false;
        int wgid = (int)L; { const int q = nwg / NXCD, r = nwg % NXCD, xcd = wgid % NXCD, off = wgid / NXCD; wgid = (xcd < r ? xcd * (q + 1) : r * (q + 1) + (xcd - r) * q) + off; }
        const int nig = WGM * nN, gid = wgid / nig, fm = gid * WGM, gsz = (nM - fm) < WGM ? (nM - fm) : WGM;
        u.pm = fm + ((wgid % nig) % gsz); u.pn = (wgid % nig) / gsz; u.pb = u.pn; u.kind = 0; u.rb = 0; return true;
    }
    __device__ __forceinline__ void a_ready(const Unit&) const {}
    __device__ __forceinline__ void pre_epi() const {}
    __device__ __forceinline__ void done(const Unit&) const {}
    __device__ __forceinline__ void finish() const {}
};

__device__ __forceinline__ f32x2 gelu_pk(f32x2 v) {
    const f32x2 av = __builtin_elementwise_abs(v), d = av * 0.2316418882f + 1.0f;
    f32x2 t; t.x = __builtin_amdgcn_rcpf(d.x); t.y = __builtin_amdgcn_rcpf(d.y);
    f32x2 q = t * 0.5307027145f + (-0.7265760135f); q = q * t + 0.7107068705f; q = q * t + (-0.142248368f); q = q * t + 0.127414796f; q = q * t;
    const f32x2 s = (v * v) * (-0.72134752044f);
    f32x2 e; e.x = __builtin_amdgcn_exp2f(s.x); e.y = __builtin_amdgcn_exp2f(s.y);
    const f32x2 m = v * (q * e), r = v - m;
    f32x2 o; o.x = v.x < 0.f ? m.x : r.x; o.y = v.y < 0.f ? m.y : r.y; return o;
}
__device__ __forceinline__ f32x4 gelu4(f32x4 v) { const f32x2 a = gelu_pk((f32x2){v[0], v[1]}), b = gelu_pk((f32x2){v[2], v[3]}); return (f32x4){a.x, a.y, b.x, b.y}; }

template <class Epi, class Sched, bool FP8 = false>
__device__ __forceinline__ void gemm_phase(LAS unsigned char* lds, const Gemm g, const Sched& S, const Epi& E) {
    int tid_ = threadIdx.x; asm volatile("" : "+v"(tid_));
    const int tid = tid_, wid = __builtin_amdgcn_readfirstlane(tid >> 6), lane = tid & 63, wr = wid >> 2, wc = wid & 3, fr = lane & 15, fq = lane >> 4;
    const int K = g.K, nt = K / BK;
    unsigned voffA[2], voffB[2];
#pragma unroll
    for (int i = 0; i < 2; ++i) { int R, C; stage_rc(tid * 16 + i * 8192, R, C); const int Rb = Epi::PERM ? ((R & ~31) + perm32(R & 31)) : R;
        voffA[i] = (unsigned)(R * g.lda + C) * 2u; voffB[i] = (unsigned)(Rb * K + C) * 2u; }
    const size_t kstep = (size_t)(BK * 2);
    const size_t hstepA = (size_t)HALF * g.lda * 2, tstepA = 2 * hstepA;
    const size_t hstepB = (size_t)HALF * K * 2, tstepB = 2 * hstepB;
    const unsigned ldsw = (unsigned)wid * 1024u;
    const int aoff = lds_byte(wr * 64 + fr, fq * 8), boff = lds_byte(wc * 32 + fr, fq * 8);
#define PG8_SA(b, h) (((b) * 2 + (h)) * HTB)
#define PG8_SB(b, h) ((4 + (b) * 2 + (h)) * HTB)
#define PG8_STAGE(bufoff, gbase, voff) do { _Pragma("unroll") for (int _i = 0; _i < 2; ++_i) \
        __builtin_amdgcn_global_load_lds((const unsigned*)((const char*)(gbase) + (voff)[_i]), (LAS unsigned*)(lds + (bufoff) + ldsw + _i * 8192), 16, 0, 0); } while (0)
#define PG8_LDA(dst, b, h) do { _Pragma("unroll") for (int m = 0; m < 4; ++m) { if constexpr (FP8) { const i32x4 lo_ = *(const LAS i32x4*)(lds + PG8_SA(b, h) + aoff + m * 2048), hi_ = *(const LAS i32x4*)(lds + PG8_SA(b, h) + aoff + m * 2048 + 1024); dst##8[m] = __builtin_shufflevector(lo_, hi_, 0, 1, 2, 3, 4, 5, 6, 7); } \
        else { _Pragma("unroll") for (int k = 0; k < 2; ++k) dst[m][k] = *(const LAS bf16x8*)(lds + PG8_SA(b, h) + aoff + m * 2048 + k * 1024); } } } while (0)
#define PG8_LDB(dst, b, h) do { _Pragma("unroll") for (int n = 0; n < 2; ++n) { if constexpr (FP8) { const i32x4 lo_ = *(const LAS i32x4*)(lds + PG8_SB(b, h) + boff + n * 2048), hi_ = *(const LAS i32x4*)(lds + PG8_SB(b, h) + boff + n * 2048 + 1024); dst##8[n] = __builtin_shufflevector(lo_, hi_, 0, 1, 2, 3, 4, 5, 6, 7); } \
        else { _Pragma("unroll") for (int k = 0; k < 2; ++k) dst[n][k] = *(const LAS bf16x8*)(lds + PG8_SB(b, h) + boff + n * 2048 + k * 1024); } } } while (0)
#define PG8_MMA(ai, bj, At, Bt) do { __builtin_amdgcn_s_setprio(1); _Pragma("unroll") for (int m = 0; m < 4; ++m) _Pragma("unroll") for (int n = 0; n < 2; ++n) { \
        if constexpr (FP8) asm volatile("s_nop 1\n\tv_mfma_f32_16x16x128_f8f6f4 %0, %1, %2, %0" : "+v"(acc[ai][bj][m][n]) : "v"(Bt##8[n]), "v"(At##8[m])); \
        else { _Pragma("unroll") for (int k = 0; k < 2; ++k) acc[ai][bj][m][n] = __builtin_amdgcn_mfma_f32_16x16x32_bf16(Bt[n][k], At[m][k], acc[ai][bj][m][n], 0, 0, 0); } } \
        __builtin_amdgcn_s_setprio(0); } while (0)
#define PG8_WAIT_V(n) asm volatile("s_waitcnt vmcnt(" #n ")" ::: "memory")
#define PG8_WAIT_L(n) asm volatile("s_waitcnt lgkmcnt(" #n ")" ::: "memory")
#define PG8_BAR __builtin_amdgcn_s_barrier()
#define PG8_SCHED __builtin_amdgcn_sched_barrier(0)
    Unit cur, nxt; int ui = 0;
    if (!S.next(0, cur)) return;
    f32x4 acc[2][2][4][2];
#pragma unroll
    for (int a = 0; a < 2; ++a)
#pragma unroll
        for (int b = 0; b < 2; ++b)
#pragma unroll
            for (int m = 0; m < 4; ++m)
#pragma unroll
                for (int n = 0; n < 2; ++n) acc[a][b][m][n] = (f32x4){0.f, 0.f, 0.f, 0.f};
    bf16x8 At[4][2], B0[2][2], B1[2][2]; i32x8 At8[4], B08[2], B18[2];
    const char* cA = (const char*)(cur.kind ? g.A2 : g.A) + (size_t)cur.pm * tstepA; const char* cB = (const char*)(cur.kind ? g.Bt2 : g.Bt) + (size_t)cur.pb * tstepB;
    S.a_ready(cur);
    PG8_STAGE(PG8_SB(0, 0), cB, voffB); PG8_STAGE(PG8_SB(0, 1), cB + hstepB, voffB); PG8_STAGE(PG8_SA(0, 0), cA, voffA); PG8_STAGE(PG8_SA(0, 1), cA + hstepA, voffA);
    if (wr == 1) PG8_BAR;
    PG8_WAIT_V(2); PG8_BAR;
    PG8_STAGE(PG8_SB(1, 0), cB + kstep, voffB); PG8_STAGE(PG8_SA(1, 0), cA + kstep, voffA); PG8_STAGE(PG8_SB(1, 1), cB + hstepB + kstep, voffB);
    PG8_WAIT_V(6); PG8_BAR;
    for (;;) {
        const bool has_next = S.next(ui + 1, nxt);
        const char* nA = has_next ? (const char*)(nxt.kind ? g.A2 : g.A) + (size_t)nxt.pm * tstepA : cA; const char* nB = has_next ? (const char*)(nxt.kind ? g.Bt2 : g.Bt) + (size_t)nxt.pb * tstepB : cB;
#pragma unroll 1
        for (int t = 0; t < nt; t += 2) {
            const bool last = (t == nt - 2);
            const char* a1 = cA + (size_t)(t + 1) * kstep;
            const char* a2 = last ? nA : cA + (size_t)(t + 2) * kstep; const char* b2 = last ? nB : cB + (size_t)(t + 2) * kstep;
            const char* a3 = a2 + kstep; const char* b3 = b2 + kstep;
            if (last && has_next) S.a_ready(nxt);
            PG8_LDB(B0, 0, 0); PG8_LDB(B1, 0, 1); PG8_SCHED; PG8_LDA(At, 0, 0); PG8_STAGE(PG8_SA(1, 1), a1 + hstepA, voffA);
            PG8_WAIT_V(8); PG8_WAIT_L(0); PG8_BAR; PG8_MMA(0, 0, At, B0); PG8_MMA(0, 1, At, B1); PG8_BAR; PG8_SCHED;
            PG8_LDA(At, 0, 1); PG8_STAGE(PG8_SB(0, 0), b2, voffB); PG8_STAGE(PG8_SB(0, 1), b2 + hstepB, voffB); PG8_STAGE(PG8_SA(0, 0), a2, voffA);
            PG8_WAIT_V(8); PG8_WAIT_L(0); PG8_BAR; PG8_MMA(1, 0, At, B0); PG8_MMA(1, 1, At, B1); PG8_BAR; PG8_SCHED;
            PG8_LDB(B0, 1, 0); PG8_LDB(B1, 1, 1); PG8_SCHED; PG8_LDA(At, 1, 0); PG8_STAGE(PG8_SA(0, 1), a2 + hstepA, voffA);
            PG8_WAIT_V(8); PG8_WAIT_L(0); PG8_BAR; PG8_MMA(0, 0, At, B0); PG8_MMA(0, 1, At, B1); PG8_BAR; PG8_SCHED;
            PG8_LDA(At, 1, 1); PG8_STAGE(PG8_SB(1, 0), b3, voffB); PG8_STAGE(PG8_SB(1, 1), b3 + hstepB, voffB); PG8_STAGE(PG8_SA(1, 0), a3, voffA);
            PG8_WAIT_V(8); PG8_WAIT_L(0); PG8_BAR; PG8_MMA(1, 0, At, B0); PG8_MMA(1, 1, At, B1); PG8_BAR; PG8_SCHED;
        }
        if (wr == 0) PG8_BAR;
        if constexpr (FP8) asm volatile("s_nop 15\n\ts_nop 7" ::: "memory");
        S.pre_epi();
        { int te_ = threadIdx.x; asm volatile("" : "+v"(te_));
          E(acc, cur, wr, wc, te_ & 15, (te_ & 63) >> 4); }
        S.done(cur);
        if (!has_next) break;
#pragma unroll
        for (int a = 0; a < 2; ++a)
#pragma unroll
            for (int b = 0; b < 2; ++b)
#pragma unroll
                for (int m = 0; m < 4; ++m)
#pragma unroll
                    for (int n = 0; n < 2; ++n) acc[a][b][m][n] = (f32x4){0.f, 0.f, 0.f, 0.f};
        cur = nxt; cA = nA; cB = nB; ++ui;
        if (wr == 1) PG8_BAR;
    }
    PG8_WAIT_V(0);
    S.finish();
    PG8_BAR;
#undef PG8_SA
#undef PG8_SB
#undef PG8_STAGE
#undef PG8_LDA
#undef PG8_LDB
#undef PG8_MMA
#undef PG8_WAIT_V
#undef PG8_WAIT_L
#undef PG8_BAR
#undef PG8_SCHED
}
}
constexpr int STAGE_LIMIT = 8;

namespace att {
__device__ __forceinline__ int crow(int r, int hi) { return (r & 3) + 8 * (r >> 2) + 4 * hi; }
__device__ __forceinline__ int v_rd_base(int lane) { return ((lane & 3) << 3) | (((lane >> 2) & 3) << 6) | (((lane >> 4) & 1) << 5) | (((lane >> 5) & 1) << 8); }
}

namespace dil {
using att::crow; using att::v_rd_base;
constexpr int OFF_O = 0, OFF_V = 65536, VWAVE = 8192;
template <int S_>
__device__ __forceinline__ void pass(const bf16_t* __restrict__ Qh, const bf16_t* __restrict__ Kh, const bf16_t* __restrict__ Vh, int pitch, int q0, LAS unsigned char* lds, LAS float* scr, int wid, int lane) {
    const int r32 = lane & 31, hi = lane >> 5;
    LAS float* Oacc = (LAS float*)(lds + OFF_O); LAS float* macc = scr; LAS float* lacc = scr + 256; LAS float* wsf = scr + 512 + wid * 64;
    LAS unsigned char* vbuf = lds + OFF_V + wid * VWAVE;
    constexpr int NG = (S_ == 16) ? 2 : 1, VR = (S_ == 16) ? 16 : 32;
    int vk[4], vc[4];
#pragma unroll
    for (int i = 0; i < 4; ++i) { const int off = (i * 64 + lane) * 16, st = off >> 9, within = off & 511, kk = (st >> 1) * 8 + (within >> 6);
        vk[i] = (kk & ~0xC) | ((kk & 4) << 1) | ((kk & 8) >> 1); vc[i] = (st & 1) * 32 + ((within & 63) >> 1); }
    const unsigned vb0 = (unsigned)(uintptr_t)vbuf + (unsigned)v_rd_base(lane);
#pragma unroll
    for (int gi = 0; gi < NG; ++gi) {
        const int rho = (S_ == 1) ? 0 : (S_ == 4) ? (wid & 3) : (2 * wid + gi);
        const int i0 = (S_ == 1) ? 32 * wid : (S_ == 4) ? 32 * (wid >> 2) : 0;
        const int qi = i0 + (r32 < VR ? r32 : r32 - VR);
        const int ql = rho + S_ * qi;
        bf16x8 qr[4];
#pragma unroll
        for (int d0 = 0; d0 < 4; ++d0) qr[d0] = *(const bf16x8*)(Qh + (size_t)(q0 + ql) * pitch + d0 * 16 + hi * 8);
        const int j0 = i0 - 128;
        const int tokb = q0 + rho + S_ * j0;
        bf16x8 kfA[4], kfB[4];
#define DIL_KLOAD(dst, c) do { int tk_ = tokb + S_ * (32 * (c) + r32); tk_ = tk_ < 0 ? 0 : (tk_ > SEQ - 1 ? SEQ - 1 : tk_);     \
            _Pragma("unroll") for (int d0 = 0; d0 < 4; ++d0) dst[d0] = *(const bf16x8*)(Kh + (size_t)tk_ * pitch + d0 * 16 + hi * 8); } while (0)
#define DIL_VDMA(c, bf) do { _Pragma("unroll") for (int i = 0; i < 4; ++i) { int tk_ = tokb + S_ * (32 * (c) + vk[i]); tk_ = tk_ < 0 ? 0 : (tk_ > SEQ - 1 ? SEQ - 1 : tk_); \
            __builtin_amdgcn_global_load_lds((const unsigned*)(Vh + (size_t)tk_ * pitch + vc[i]), (LAS unsigned*)(vbuf + (bf) * 4096 + i * 1024), 16, 0, 0); } } while (0)
        float m_reg = -1e30f, l_reg = 0.f; f32x16 o[2]; o[0] = f32x16{}; o[1] = f32x16{};
        DIL_KLOAD(kfA, 0); DIL_VDMA(0, 0);
#define DIL_STEP(KF, KN, c) do { \
            if ((c) < 4) { DIL_KLOAD(KN, (c) + 1); DIL_VDMA((c) + 1, ((c) + 1) & 1); asm volatile("s_waitcnt vmcnt(8)" ::: "memory"); } \
            else { asm volatile("s_waitcnt vmcnt(0)" ::: "memory"); } \
            f32x16 p = f32x16{}; \
            _Pragma("unroll") for (int d0 = 0; d0 < 4; ++d0) p = __builtin_amdgcn_mfma_f32_32x32x16_bf16(KF[d0], qr[d0], p, 0, 0, 0); \
            const unsigned vb = vb0 + (unsigned)(((c) & 1) * 4096); \
            s16x4 vl0[2], vh0[2], vl1[2], vh1[2]; \
            _Pragma("unroll") for (int d0 = 0; d0 < 2; ++d0) { \
                asm volatile("ds_read_b64_tr_b16 %0, %1 offset:%2" : "=&v"(vl0[d0]) : "v"(vb), "i"(d0 * 512) : "memory"); \
                asm volatile("ds_read_b64_tr_b16 %0, %1 offset:%2" : "=&v"(vh0[d0]) : "v"(vb), "i"(d0 * 512 + 1024) : "memory"); \
                asm volatile("ds_read_b64_tr_b16 %0, %1 offset:%2" : "=&v"(vl1[d0]) : "v"(vb), "i"(d0 * 512 + 2048) : "memory"); \
                asm volatile("ds_read_b64_tr_b16 %0, %1 offset:%2" : "=&v"(vh1[d0]) : "v"(vb), "i"(d0 * 512 + 3072) : "memory"); } \
              \
            { const float NEG = -__builtin_inff(); const int db = qi - j0 - 32 * (c) - 4 * hi; const int tb = tokb + S_ * (32 * (c) + 4 * hi); \
              if ((c) == 0 || (c) == 4 || tokb < 0) { \
                _Pragma("unroll") for (int r = 0; r < 16; ++r) { const int cr = (r & 3) + 8 * (r >> 2); \
                    const bool ok = ((unsigned)(db - cr) <= 128u) && (tb + S_ * cr >= 0); p[r] = ok ? p[r] : NEG; } } } \
            float pmax = p[0]; \
            _Pragma("unroll") for (int r = 1; r < 16; ++r) pmax = fmaxf(pmax, p[r]); \
            { auto rr = __builtin_amdgcn_permlane32_swap(__float_as_uint(pmax), __float_as_uint(pmax), false, false); pmax = fmaxf(__uint_as_float(rr[0]), __uint_as_float(rr[1])); } \
            const float mn = fmaxf(m_reg, pmax); const float alpha = __builtin_amdgcn_exp2f(m_reg - mn); m_reg = mn; \
            float ps = 0.f; \
            _Pragma("unroll") for (int r = 0; r < 16; ++r) { p[r] = __builtin_amdgcn_exp2f(p[r] - mn); ps += p[r]; } \
            { auto rr = __builtin_amdgcn_permlane32_swap(__float_as_uint(ps), __float_as_uint(ps), false, false); ps = __uint_as_float(rr[0]) + __uint_as_float(rr[1]); } \
            l_reg = l_reg * alpha + ps; \
            bf16x8 pa0, pa1; DIL_PK4(p, 0, pa0); DIL_PK4(p, 8, pa1); \
            if (__any(alpha < 1.f)) { if (hi == 0) wsf[r32] = alpha; asm volatile("s_waitcnt lgkmcnt(0)" ::: "memory"); \
                _Pragma("unroll") for (int r = 0; r < 16; ++r) { const float a = wsf[crow(r, hi)]; o[0][r] *= a; o[1][r] *= a; } } \
            asm volatile("s_waitcnt lgkmcnt(0)" ::: "memory"); __builtin_amdgcn_sched_barrier(0); \
            _Pragma("unroll") for (int d0 = 0; d0 < 2; ++d0) { \
                o[d0] = __builtin_amdgcn_mfma_f32_32x32x16_bf16(pa0, (bf16x8){vl0[d0][0], vl0[d0][1], vl0[d0][2], vl0[d0][3], vh0[d0][0], vh0[d0][1], vh0[d0][2], vh0[d0][3]}, o[d0], 0, 0, 0); \
                o[d0] = __builtin_amdgcn_mfma_f32_32x32x16_bf16(pa1, (bf16x8){vl1[d0][0], vl1[d0][1], vl1[d0][2], vl1[d0][3], vh1[d0][0], vh1[d0][1], vh1[d0][2], vh1[d0][3]}, o[d0], 0, 0, 0); } \
        } while (0)
#define DIL_PK4(P, B_, OUT) do { unsigned a0 = cvt_pk_bf16(P[B_+0], P[B_+1]), a1 = cvt_pk_bf16(P[B_+2], P[B_+3]);                          \
            unsigned b0_ = cvt_pk_bf16(P[B_+4], P[B_+5]), b1_ = cvt_pk_bf16(P[B_+6], P[B_+7]);                                             \
            auto r0 = __builtin_amdgcn_permlane32_swap(a0, b0_, false, false); auto r1 = __builtin_amdgcn_permlane32_swap(a1, b1_, false, false); \
            u32x4 w = {r0[0], r1[0], r0[1], r1[1]}; OUT = __builtin_bit_cast(bf16x8, w); } while (0)
        DIL_STEP(kfA, kfB, 0); DIL_STEP(kfB, kfA, 1); DIL_STEP(kfA, kfB, 2); DIL_STEP(kfB, kfA, 3); DIL_STEP(kfA, kfB, 4);
#undef DIL_STEP
#undef DIL_PK4
#undef DIL_KLOAD
#undef DIL_VDMA
        float fo = 0.f, fc = 1.f;
        if (S_ != 1) { const float mo = macc[ql], lo = lacc[ql]; const float mnew = fmaxf(mo, m_reg); fo = __builtin_amdgcn_exp2f(mo - mnew); fc = __builtin_amdgcn_exp2f(m_reg - mnew);
            l_reg = lo * fo + l_reg * fc; m_reg = mnew; }
        if (hi == 0 && r32 < VR) { macc[ql] = m_reg; lacc[ql] = l_reg; wsf[r32] = fo; wsf[32 + r32] = fc; }
        asm volatile("s_waitcnt lgkmcnt(0)" ::: "memory");
#pragma unroll
        for (int r = 0; r < 16; ++r) { const int row = crow(r, hi);
            if (row < VR) { const int qrow = rho + S_ * (i0 + row); LAS float* op = Oacc + qrow * 64 + r32;
                if (S_ == 1) { op[0] = o[0][r]; op[32] = o[1][r]; }
                else { const float a = wsf[row], b = wsf[32 + row]; op[0] = op[0] * a + o[0][r] * b; op[32] = op[32] * a + o[1][r] * b; } } }
        asm volatile("s_waitcnt lgkmcnt(0)" ::: "memory");
    }
}
__device__ __forceinline__ void unit(const bf16_t* Qh, const bf16_t* Kh, const bf16_t* Vh, int pitch, bf16_t* Oh, int op, int q0, LAS unsigned char* lds, LAS float* scr) {
    int tid_ = threadIdx.x; asm volatile("" : "+v"(tid_));
    const int tid = tid_, wid = __builtin_amdgcn_readfirstlane(tid >> 6), lane = tid & 63;
    pass<1>(Qh, Kh, Vh, pitch, q0, lds, scr, wid, lane);
    __syncthreads();
    pass<4>(Qh, Kh, Vh, pitch, q0, lds, scr, wid, lane);
    __syncthreads();
    pass<16>(Qh, Kh, Vh, pitch, q0, lds, scr, wid, lane);
    __syncthreads();
    {   const int q = tid >> 1, hf = tid & 1; const LAS f32x4* src = (const LAS f32x4*)(lds + OFF_O + (q * 64 + 32 * hf) * 4); const float rl = 1.0f / scr[256 + q];
        bf16_t* dst = Oh + (size_t)(q0 + q) * op + 32 * hf;
#pragma unroll
        for (int i = 0; i < 4; ++i) { const f32x4 a = src[2 * i] * rl, b = src[2 * i + 1] * rl;
            u32x4 w; w.x = cvt_pk_bf16(a[0], a[1]); w.y = cvt_pk_bf16(a[2], a[3]); w.z = cvt_pk_bf16(b[0], b[1]); w.w = cvt_pk_bf16(b[2], b[3]); *(u32x4*)(dst + 8 * i) = w; } }
    __syncthreads();
}
}

namespace mla {
using att::crow;
constexpr int DQ = 192, DV_ = 128;
constexpr int KB = 64 * DQ;
constexpr int VB = DV_ * 64;
constexpr int NBUF = 3;
constexpr int OFF_K = 0, OFF_V = NBUF * KB, OFF_WS = NBUF * (KB + VB), BYTES = OFF_WS + 8 * 256;
constexpr int NKP = KB / 1024, KPW = (NKP + 7) / 8;
constexpr int NVP = VB / 1024;
static_assert(BYTES <= 131072 && NKP == 12 && NVP == 8, "mla LDS image");
constexpr float PSHIFT = 8.0f;

__device__ __forceinline__ void unit(const unsigned char* __restrict__ Qh, const unsigned char* __restrict__ Kh, int pitch, const unsigned char* __restrict__ VTh  ,
                                     unsigned char* __restrict__ Oh, int op, int q0, LAS unsigned char* lds) {
    int tid_ = threadIdx.x; asm volatile("" : "+v"(tid_));
    const int tid = tid_, wid = __builtin_amdgcn_readfirstlane(tid >> 6), lane = tid & 63, r32 = lane & 31, hi = lane >> 5;
    const int qlo = q0 + wid * 32, qpos = qlo + r32;
    LAS float* wsf = (LAS float*)(lds + OFF_WS) + wid * 64;
    const int NT = (q0 + 256) / 64;
    unsigned kso[KPW], vso;
#pragma unroll
    for (int i = 0; i < KPW; ++i) { const int G = ((wid + 8 * i) * 64 + lane) % (NKP * 64), R = G / 12, rem = G % 12, sg = rem >> 2, qq = rem & 3, f = (R >> 2) & 3;
        const int key = 32 * ((R >> 2) & 1) + 16 * (R >> 5) + 4 * ((R >> 3) & 3) + (R & 3);
        kso[i] = (unsigned)(key * pitch + 64 * sg + 16 * (qq ^ f)); }
    {   const int G = wid * 64 + lane, d = G >> 2, qq = G & 3, f = (d >> 2) & 3; vso = (unsigned)(d * SEQ + 16 * (qq ^ f)); }
#define MLA_DMA(j, bf) do { const unsigned char* kt_ = Kh + (size_t)(j) * 64 * pitch; const unsigned char* vt_ = VTh + (size_t)(j) * 64; \
        _Pragma("unroll") for (int i = 0; i < KPW; ++i) if (wid + 8 * i < NKP) \
            __builtin_amdgcn_global_load_lds((const unsigned*)(kt_ + kso[i]), (LAS unsigned*)(lds + OFF_K + (bf) * KB + (wid + 8 * i) * 1024), 16, 0, 0); \
        __builtin_amdgcn_global_load_lds((const unsigned*)(vt_ + vso), (LAS unsigned*)(lds + OFF_V + (bf) * VB + wid * 1024), 16, 0, 0); } while (0)
#define MLA_MFMA(acc, a, b) asm volatile("v_mfma_f32_32x32x64_f8f6f4 %0, %1, %2, %0" : "+v"(acc) : "v"(a), "v"(b))
#define MLA_MFMA0(acc, a, b) asm volatile("v_mfma_f32_32x32x64_f8f6f4 %0, %1, %2, 0" : "=v"(acc) : "v"(a), "v"(b))
#define MLA_MFMA_DRAIN2(a, b) asm volatile("s_nop 15\n\ts_nop 3" : "+v"(a), "+v"(b) :: "memory")
    i32x8 qr[3];
#pragma unroll
    for (int s = 0; s < 3; ++s) { const i32x4 lo_ = *(const i32x4*)(Qh + (size_t)qpos * pitch + 64 * s + 32 * hi), hi_ = *(const i32x4*)(Qh + (size_t)qpos * pitch + 64 * s + 32 * hi + 16);
        qr[s] = __builtin_shufflevector(lo_, hi_, 0, 1, 2, 3, 4, 5, 6, 7); }
    MLA_DMA(0, 0); MLA_DMA(1, 1);
#define MLA_WAIT_OLDER() do { if (wid < NKP - 8) asm volatile("s_waitcnt vmcnt(%0)" :: "n"(KPW + 1) : "memory"); else asm volatile("s_waitcnt vmcnt(%0)" :: "n"(KPW) : "memory"); } while (0)
    float m_reg = -1e30f;
    f32x16 o[4], ol = f32x16{};
#pragma unroll
    for (int d = 0; d < 4; ++d) o[d] = f32x16{};
    const int fsw = (r32 >> 2) & 3;
    const int koff = r32 * DQ + 16 * ((2 * hi) ^ fsw), voff = r32 * 64 + 16 * ((2 * hi) ^ fsw);
    MLA_WAIT_OLDER();
    asm volatile("" :: "v"(qr[0]), "v"(qr[1]), "v"(qr[2]));
    __builtin_amdgcn_s_barrier();
#define MLA_LD8(dst, base, off) do { const i32x4 lo_ = *(const LAS i32x4*)((base) + (off)), hi_ = *(const LAS i32x4*)((base) + ((off) ^ 16)); dst = __builtin_shufflevector(lo_, hi_, 0, 1, 2, 3, 4, 5, 6, 7); } while (0)
    int buf = 0;
    for (int t = 0; t < NT; ++t) {
        const int kb = t * 64;
        if (kb <= qlo + 31) {
            const LAS unsigned char* kp_ = lds + OFF_K + buf * KB;
            const LAS unsigned char* vp_ = lds + OFF_V + buf * VB;
            f32x16 s0, s1;
            if (kb + 63 <= qlo) {
                i32x8 k0[3], k1[3];
#pragma unroll
                for (int s = 0; s < 3; ++s) MLA_LD8(k0[s], kp_ + 64 * s, koff);
                MLA_MFMA0(s0, k0[0], qr[0]);
#pragma unroll
                for (int s = 0; s < 3; ++s) MLA_LD8(k1[s], kp_ + 32 * DQ + 64 * s, koff);
                MLA_MFMA(s0, k0[1], qr[1]); MLA_MFMA(s0, k0[2], qr[2]);
                MLA_MFMA0(s1, k1[0], qr[0]); MLA_MFMA(s1, k1[1], qr[1]); MLA_MFMA(s1, k1[2], qr[2]);
            } else {
                const float NEG = -__builtin_inff(); const int dq = qpos - kb - 32 * hi;
                int kq_ = koff; asm volatile("" : "+v"(kq_));
                {   i32x8 k0[3];
#pragma unroll
                    for (int s = 0; s < 3; ++s) MLA_LD8(k0[s], kp_ + 64 * s, kq_);
                    MLA_MFMA0(s0, k0[0], qr[0]); MLA_MFMA(s0, k0[1], qr[1]); MLA_MFMA(s0, k0[2], qr[2]);
                }
                {   i32x8 k1[3];
#pragma unroll
                    for (int s = 0; s < 3; ++s) MLA_LD8(k1[s], kp_ + 32 * DQ + 64 * s, kq_);
                    MLA_MFMA0(s1, k1[0], qr[0]); MLA_MFMA(s1, k1[1], qr[1]); MLA_MFMA(s1, k1[2], qr[2]);
                }
                MLA_MFMA_DRAIN2(s0, s1);
#pragma unroll
                for (int r = 0; r < 16; ++r) { if (r > dq) s0[r] = NEG; if (r + 16 > dq) s1[r] = NEG; }
            }

            i32x8 vv[4];
#pragma unroll
            for (int d0 = 0; d0 < 4; ++d0) MLA_LD8(vv[d0], vp_ + d0 * 32 * 64, voff);
            MLA_MFMA_DRAIN2(s0, s1);
            __builtin_amdgcn_sched_barrier(0);
            float pm0 = s0[0], pm1 = s0[8];
#define MLA_MAX8(pm, B_) asm("v_max3_f32 %0, %0, %1, %2\n\tv_max3_f32 %0, %0, %3, %4\n\tv_max3_f32 %0, %0, %5, %6\n\tv_max3_f32 %0, %0, %7, %8\n\tv_max3_f32 %0, %0, %9, %10\n\tv_max3_f32 %0, %0, %11, %12\n\tv_max3_f32 %0, %0, %13, %14\n\tv_max3_f32 %0, %0, %15, %16" \
                : "+v"(pm) : "v"(s0[B_ + 0]), "v"(s1[B_ + 0]), "v"(s0[B_ + 1]), "v"(s1[B_ + 1]), "v"(s0[B_ + 2]), "v"(s1[B_ + 2]), "v"(s0[B_ + 3]), "v"(s1[B_ + 3]), \
                              "v"(s0[B_ + 4]), "v"(s1[B_ + 4]), "v"(s0[B_ + 5]), "v"(s1[B_ + 5]), "v"(s0[B_ + 6]), "v"(s1[B_ + 6]), "v"(s0[B_ + 7]), "v"(s1[B_ + 7]))
            MLA_MAX8(pm0, 0); MLA_MAX8(pm1, 8);
#undef MLA_MAX8
            float pmax = fmaxf(pm0, pm1);
            { auto rr = __builtin_amdgcn_permlane32_swap(__float_as_uint(pmax), __float_as_uint(pmax), false, false); pmax = fmaxf(__uint_as_float(rr[0]), __uint_as_float(rr[1])); }
            const float mn = fmaxf(m_reg, pmax); const float alpha = __builtin_amdgcn_exp2f((m_reg - mn) * 0.125f); m_reg = mn;
            const float b8 = 8.0f * (PSHIFT + 7.0f) - mn;
            i32x8 pa;
            const float b8n = b8 * (1.0f / 256.0f);
            const f32x16 t0 = s0 * (1.0f / 256.0f) + b8n, t1 = s1 * (1.0f / 256.0f) + b8n;
#pragma unroll
            for (int g = 0; g < 4; ++g) {
                const unsigned a0 = __builtin_bit_cast(unsigned, __builtin_amdgcn_cvt_pknorm_u16(t0[4 * g], t0[4 * g + 1])), a1 = __builtin_bit_cast(unsigned, __builtin_amdgcn_cvt_pknorm_u16(t0[4 * g + 2], t0[4 * g + 3]));
                const unsigned c0 = __builtin_bit_cast(unsigned, __builtin_amdgcn_cvt_pknorm_u16(t1[4 * g], t1[4 * g + 1])), c1 = __builtin_bit_cast(unsigned, __builtin_amdgcn_cvt_pknorm_u16(t1[4 * g + 2], t1[4 * g + 3]));
                pa[g] = (int)__builtin_amdgcn_perm(a1, a0, 0x07050301u); pa[4 + g] = (int)__builtin_amdgcn_perm(c1, c0, 0x07050301u); }
            if (__any(alpha < 1.f)) { if (hi == 0) wsf[r32] = alpha; asm volatile("s_waitcnt lgkmcnt(0)" ::: "memory");
#pragma unroll
                for (int r = 0; r < 16; ++r) { const float a = wsf[crow(r, hi)]; ol[r] *= a;
#pragma unroll
                    for (int d = 0; d < 4; ++d) o[d][r] *= a; } }
            int one_ = 0x38383838; asm volatile("" : "+v"(one_));
            const i32x8 ones8 = {one_, one_, one_, one_, one_, one_, one_, one_};
            asm volatile("s_nop 1" ::: "memory");
            MLA_MFMA(ol, pa, ones8);
#pragma unroll
            for (int d0 = 0; d0 < 4; ++d0) MLA_MFMA(o[d0], pa, vv[d0]);
        }
        if (t + 2 < NT) { const int b2 = buf == 0 ? 2 : buf - 1; MLA_DMA(t + 2, b2); }
        if (t + 2 < NT) { MLA_WAIT_OLDER(); } else { asm volatile("s_waitcnt vmcnt(0)" ::: "memory"); }
        asm volatile("s_waitcnt lgkmcnt(0)" ::: "memory");
        __builtin_amdgcn_s_barrier();
        buf = buf == 2 ? 0 : buf + 1;
    }
    MLA_MFMA_DRAIN2(o[0], o[1]); MLA_MFMA_DRAIN2(o[2], o[3]); MLA_MFMA_DRAIN2(ol, o[0]);
#undef MLA_MFMA_DRAIN2
#undef MLA_MFMA0
#undef MLA_MFMA
#undef MLA_LD8
#undef MLA_WAIT_OLDER
#undef MLA_DMA
    unsigned char* Ow = Oh + (size_t)qlo * op;
#pragma unroll
    for (int r = 0; r < 16; ++r) { const int orow = crow(r, hi); const float rl = __builtin_amdgcn_rcpf(ol[r]);
#pragma unroll
        for (int d0 = 0; d0 < 4; ++d0) { const float v = o[d0][r] * rl; const float v1 = __shfl_down(v, 1), v2 = __shfl_down(v, 2), v3 = __shfl_down(v, 3);
            if ((r32 & 3) == 0) *(unsigned*)(Ow + (size_t)orow * op + d0 * 32 + r32) = pk4_fp8(v, v1, v2, v3); } }
    __syncthreads();
}
}

constexpr int NWAVES = 8;
constexpr size_t MiB = 1u << 20;
constexpr size_t WS_CTL = 0, CTL_ZERO_BYTES = 1 * MiB;
constexpr size_t WS_WEIN = 2 * MiB;
constexpr size_t WS_WEOUT = 12 * MiB;
constexpr size_t WS_WOIN = 16 * MiB;
constexpr size_t WS_WUQ = 20 * MiB;
constexpr size_t WS_WUKV = 23 * MiB;
constexpr size_t WS_WOOUT = 25 * MiB;
constexpr size_t WS_B1P = 29 * MiB;
constexpr size_t WS_SSQ = 30 * MiB;
constexpr size_t WS_TOKER = 31 * MiB;
constexpr size_t WS_TOKG = 31 * MiB + 512 * 1024;
constexpr size_t WS_XN = 32 * MiB;
constexpr size_t WS_Z = 64 * MiB;
constexpr size_t WS_MIX = 144 * MiB;
constexpr size_t WS_QR = 176 * MiB;
constexpr size_t WS_KVR = 224 * MiB;
constexpr size_t WS_QF = 288 * MiB;
constexpr size_t WS_KF = 336 * MiB;
constexpr size_t WS_Z8 = 104 * MiB;
constexpr size_t WS_MIX8 = 160 * MiB;
constexpr size_t WS_VT = 3200 * MiB;
constexpr size_t WS_W1 = 384 * MiB;
constexpr size_t WS_W2 = 896 * MiB;
constexpr size_t WS_XG = 1152 * MiB;
constexpr size_t WS_ACT = 1664 * MiB;
constexpr size_t WS_Y = 2176 * MiB;
constexpr size_t WS_X16 = 3216 * MiB;
constexpr size_t WS_END = 3248 * MiB;
constexpr int CW_MOE = 65536;
constexpr int CW_TMO = 0, CW_CODE = 1, CW_BAR = 4096, CW_CNT = 16384;
constexpr int RING_OFF = 0, RING_BYTES = 131072;
constexpr int LDSCTL_OFF = RING_BYTES, MISC_OFF = LDSCTL_OFF + 320;
constexpr int SCR_OFF = RING_BYTES + 1024;
constexpr int LDS_BYTES = 155648;
constexpr int SCR_BYTES = LDS_BYTES - SCR_OFF;

typedef GAS unsigned gu32;
#define RLX_AGENT __ATOMIC_RELAXED, __HIP_MEMORY_SCOPE_AGENT

#define XB_TMO      128
#define XB_XCNT(j)  (256  + 64 * (j))
#define XB_XSUB(j)  (1280 + 64 * (j))
#define XB_XGEN(j)  (2304 + 64 * (j))
#define XB_TOP      3328
#define XB_TOPGEN   3392
#define XCD_BAR_WORDS 3456
#define XB_SPIN_CAP (1u << 18)
__device__ __forceinline__ unsigned xb_ld(unsigned* p)              { return __hip_atomic_load(p, __ATOMIC_RELAXED, __HIP_MEMORY_SCOPE_AGENT); }
__device__ __forceinline__ unsigned xb_add(unsigned* p, unsigned v) { return __hip_atomic_fetch_add(p, v, __ATOMIC_RELAXED, __HIP_MEMORY_SCOPE_AGENT); }
__device__ __forceinline__ unsigned xb_xcc_id() { return (unsigned)__builtin_amdgcn_s_getreg((3 << 11) | 20) & 0xFu; }
#define XB_SPIN(cond, bar) do { unsigned _sp = 0; while (cond) { __builtin_amdgcn_s_sleep(1); \
    if ((++_sp & 255u) == 0u) { if (xb_ld(&(bar)[XB_TMO])) break; if (_sp > XB_SPIN_CAP) { atomicAdd(&(bar)[XB_TMO], 1u); break; } } } } while (0)
struct XcdBarrier { unsigned* bar; unsigned x; volatile LAS unsigned* st; };
__device__ __forceinline__ XcdBarrier xcd_barrier_post(unsigned* bar, volatile LAS unsigned* st) {
    XcdBarrier b; b.bar = bar; b.x = xb_xcc_id(); b.st = st;
    if (threadIdx.x == 0) (void)xb_add(&bar[XB_XCNT(b.x)], 1u);
    return b;
}
__device__ __forceinline__ void xcd_barrier_complete(unsigned* bar, unsigned x, unsigned& nloc, unsigned& nx) {
    const unsigned G = gridDim.x * gridDim.y * gridDim.z;
    unsigned sum, cnt, mine, sp = 0u;
    for (;;) {
        sum = 0u; cnt = 0u; mine = 0u;
#pragma unroll
        for (unsigned j = 0; j < 16; ++j) { const unsigned c = xb_ld(&bar[XB_XCNT(j)]); sum += c; cnt += (c > 0u) ? 1u : 0u; mine = (j == x) ? c : mine; }
        if (sum == G) break;
        __builtin_amdgcn_s_sleep(1);
        if ((++sp & 255u) == 0u) { if (xb_ld(&bar[XB_TMO])) break; if (sp > XB_SPIN_CAP) { atomicAdd(&bar[XB_TMO], 1u); break; } }
    }
    nloc = mine > 0u ? mine : 1u; nx = cnt > 0u ? cnt : 1u;
}
__device__ __forceinline__ void xcd_barrier(const XcdBarrier& b) {
    asm volatile("s_waitcnt vmcnt(0)" ::: "memory");
    __syncthreads();
    if (threadIdx.x == 0) {
        unsigned* bar = b.bar;
        __builtin_amdgcn_s_waitcnt(0);
        unsigned nloc = b.st[0], nx = b.st[1];
        if (nloc == 0u) { xcd_barrier_complete(bar, b.x, nloc, nx); b.st[0] = nloc; b.st[1] = nx; }
        const unsigned old = xb_add(&bar[XB_XSUB(b.x)], 1u);
        const unsigned gen = old / nloc;
        if (old + 1u == (gen + 1u) * nloc) {
            __builtin_amdgcn_fence(__ATOMIC_RELEASE, "agent");
            asm volatile("s_waitcnt vmcnt(0)" ::: "memory");
            const unsigned og = xb_add(&bar[XB_TOP], 1u);
            const unsigned tg = og / nx;
            if (og + 1u == (tg + 1u) * nx) xb_add(&bar[XB_TOPGEN], 1u);
            else XB_SPIN(xb_ld(&bar[XB_TOPGEN]) == tg, bar);
            __builtin_amdgcn_fence(__ATOMIC_ACQUIRE, "agent");
            xb_add(&bar[XB_XGEN(b.x)], 1u);
            asm volatile("s_waitcnt vmcnt(0)" ::: "memory");
        } else {
            XB_SPIN(xb_ld(&bar[XB_XGEN(b.x)]) == gen, bar);
            __builtin_amdgcn_fence(__ATOMIC_ACQUIRE, "agent");
            asm volatile("s_waitcnt vmcnt(0)" ::: "memory");
        }
    }
    __syncthreads();
}

struct Args {
    const float* in[24]; float* out; unsigned char* ws; int stage_limit; int pad;
};
enum { I_X = 0, I_MIXN, I_FFNN, I_EWIN, I_EWS, I_EBS, I_EGV, I_EGQ, I_EGK, I_EWOUT, I_OWIN, I_OGCQ, I_OGCKV, I_OWUQ, I_OWUKV, I_OGQ, I_OGK, I_OWOUT,
       I_RW, I_RB, I_W1, I_B1, I_W2, I_B2 };

struct Frame {
    LAS unsigned char* lds;
    int vcu, G;
};

__device__ __forceinline__ float wave_sum(float v) {
#pragma unroll
    for (int o = 1; o < 64; o <<= 1) v += __shfl_xor(v, o);
    return v;
}
#define LDS_WAIT() asm volatile("s_waitcnt lgkmcnt(0)" ::: "memory")

template <int MODE> __device__ __forceinline__ int dst_row(int o) {
    if (MODE == 1) { if (o >= 1024 && o < 2048) return (o & ~255) | (((o >> 5) & 1) << 7) | (((o >> 6) & 3) << 5) | (o & 31); return o; }
    if (MODE == 2) return ((o >> 8) << 8) | ((o & 1) << 7) | ((o & 255) >> 1);
    return o;
}
template <int MODE>
__device__ __forceinline__ void transpose_item(const float* __restrict__ W, int K, int N, bf16_t* __restrict__ WT, const float* __restrict__ gain, LAS float* scr, int item, int lane) {
    const int nblk = N / 32, kb = item / nblk, nb = item % nblk, k0 = 64 * kb, n0 = 32 * nb;
#pragma unroll 8
    for (int i = 0; i < 32; ++i) { const int kk = 2 * i + (lane >> 5); float w = W[(size_t)(k0 + kk) * N + n0 + (lane & 31)]; if (gain) w *= gain[k0 + kk]; scr[kk * 33 + (lane & 31)] = w; }
    LDS_WAIT(); asm volatile("" ::: "memory");
    const int c = lane & 7;
#pragma unroll
    for (int j = 0; j < 4; ++j) { const int n = (lane >> 3) + 8 * j; const LAS float* s = scr + (8 * c) * 33 + n;
        u32x4 o; o.x = cvt_pk_bf16(s[0 * 33], s[1 * 33]); o.y = cvt_pk_bf16(s[2 * 33], s[3 * 33]); o.z = cvt_pk_bf16(s[4 * 33], s[5 * 33]); o.w = cvt_pk_bf16(s[6 * 33], s[7 * 33]);
        *(u32x4*)(WT + (size_t)dst_row<MODE>(n0 + n) * K + k0 + 8 * c) = o; }
    LDS_WAIT(); asm volatile("" ::: "memory");
}
template <int MODE>
__device__ __forceinline__ void transpose_job(Frame& F, const float* W, int K, int N, int nmat, size_t src_stride, bf16_t* WT, size_t dst_stride, const float* gain, int gain_stride) {
    int tid_ = threadIdx.x; asm volatile("" : "+v"(tid_));
    const int wave = __builtin_amdgcn_readfirstlane(tid_ >> 6), lane = tid_ & 63;
    LAS float* scr = (LAS float*)(F.lds + RING_OFF + wave * 16384);
    const int gw = F.vcu * NWAVES + wave, NGW = F.G * NWAVES;
    const int per = (K / 64) * (N / 32), total = per * nmat;
    for (int it = gw; it < total; it += NGW) { const int mi = it / per, item = it - mi * per;
        transpose_item<MODE>(W + (size_t)mi * src_stride, K, N, WT + (size_t)mi * dst_stride, gain ? gain + (size_t)mi * gain_stride : nullptr, scr, item, lane); }
}


__device__ __forceinline__ void tr8_load(f32x4 (&v)[16], const float* __restrict__ W, int N, int item, int lane) {
    const int nblk = N / 32, kb = item / nblk, nb = item % nblk, k0 = 128 * kb, n0 = 32 * nb;
#pragma unroll
    for (int i = 0; i < 16; ++i) v[i] = __builtin_nontemporal_load((const f32x4*)(W + (size_t)(k0 + 8 * i + (lane >> 3)) * N + n0 + 4 * (lane & 7)));
}
template <int MODE>
__device__ __forceinline__ void tr8_store(const f32x4 (&v)[16], int K, int N, unsigned char* __restrict__ WT, const float* __restrict__ gain, LAS unsigned char* scr, int item, int lane) {
    const int nblk = N / 32, kb = item / nblk, nb = item % nblk, k0 = 128 * kb, n0 = 32 * nb;
    constexpr int TP = 144;
#pragma unroll
    for (int i = 0; i < 16; ++i) { const int kl = 8 * i + (lane >> 3); const float sc = gain ? W8_SCALE * gain[k0 + kl] : W8_SCALE;
        const unsigned w = pk4_fp8(v[i].x * sc, v[i].y * sc, v[i].z * sc, v[i].w * sc); LAS unsigned char* d = scr + (4 * (lane & 7)) * TP + kl;
        d[0] = (unsigned char)w; d[TP] = (unsigned char)(w >> 8); d[2 * TP] = (unsigned char)(w >> 16); d[3 * TP] = (unsigned char)(w >> 24); }
    LDS_WAIT(); asm volatile("" ::: "memory");
#pragma unroll
    for (int m = 0; m < 4; ++m) { const int q = lane + 64 * m, n = q >> 3, kc = q & 7;
        const u32x4 o = *(const LAS u32x4*)(scr + n * TP + 16 * kc);
        __builtin_nontemporal_store(o, (u32x4*)(WT + (size_t)dst_row<MODE>(n0 + n) * K + k0 + 16 * kc)); }
    LDS_WAIT(); asm volatile("" ::: "memory");
}
template <int MODE>
__device__ __forceinline__ void transpose_job_fp8(Frame& F, const float* W, int K, int N, int nmat, size_t src_stride, unsigned char* WT, size_t dst_stride, const float* gain = nullptr, int gain_stride = 0) {
    int tid_ = threadIdx.x; asm volatile("" : "+v"(tid_));
    const int wave = __builtin_amdgcn_readfirstlane(tid_ >> 6), lane = tid_ & 63;
    LAS unsigned char* scr = F.lds + RING_OFF + wave * 16384;
    const int gw = F.vcu * NWAVES + wave, NGW = F.G * NWAVES;
    const int per = (K / 128) * (N / 32), total = per * nmat;
    f32x4 cur[16], nxt[16];
    int it = gw;
    if (it < total) { const int mi = it / per; tr8_load(cur, W + (size_t)mi * src_stride, N, it - mi * per, lane); }
    for (; it < total; it += NGW) {
        const int itn = it + NGW;
        if (itn < total) { const int mn = itn / per; tr8_load(nxt, W + (size_t)mn * src_stride, N, itn - mn * per, lane); }
        const int mi = it / per;
        tr8_store<MODE>(cur, K, N, WT + (size_t)mi * dst_stride, gain ? gain + (size_t)mi * gain_stride : nullptr, scr, it - mi * per, lane);
#pragma unroll
        for (int i = 0; i < 16; ++i) cur[i] = nxt[i];
    }
}

__device__ __forceinline__ void rms_row_to_fp8(int lane, const float* xrow, const float* g, unsigned char* orow, float* copy) {
    const f32x4* xr = (const f32x4*)xrow + lane; const f32x4* gr = (const f32x4*)g + lane;
    f32x4 v[4]; float s = 0.f;
#pragma unroll
    for (int j = 0; j < 4; ++j) { v[j] = xr[64 * j]; s += (v[j].x * v[j].x + v[j].y * v[j].y) + (v[j].z * v[j].z + v[j].w * v[j].w); }
    const float rstd = 1.0f / sqrtf(wave_sum(s) * (1.f / DM) + EPS);
    unsigned* o4 = (unsigned*)orow + lane;
#pragma unroll
    for (int j = 0; j < 4; ++j) { const f32x4 gg = gr[64 * j]; if (copy) ((f32x4*)copy + lane)[64 * j] = v[j];
        o4[64 * j] = pk4_fp8(v[j].x * rstd * gg.x, v[j].y * rstd * gg.y, v[j].z * rstd * gg.z, v[j].w * rstd * gg.w); }
}
__device__ __forceinline__ void rms_row_to_bf16(int lane, const float* xrow, const float* g, bf16_t* orow, float* copy) {
    const f32x4* xr = (const f32x4*)xrow + lane; const f32x4* gr = (const f32x4*)g + lane;
    f32x4 v[4]; float s = 0.f;
#pragma unroll
    for (int j = 0; j < 4; ++j) { v[j] = xr[64 * j]; s += (v[j].x * v[j].x + v[j].y * v[j].y) + (v[j].z * v[j].z + v[j].w * v[j].w); }
    const float rstd = 1.0f / sqrtf(wave_sum(s) * (1.f / DM) + EPS);
    u32x2* o8 = (u32x2*)orow + lane;
#pragma unroll
    for (int j = 0; j < 4; ++j) { const f32x4 gg = gr[64 * j]; if (copy) ((f32x4*)copy + lane)[64 * j] = v[j];
        u32x2 w; w.x = cvt_pk_bf16(v[j].x * rstd * gg.x, v[j].y * rstd * gg.y); w.y = cvt_pk_bf16(v[j].z * rstd * gg.z, v[j].w * rstd * gg.w); o8[64 * j] = w; }
}

namespace pg8 {
struct EpiEvenIn {
    static constexpr bool PERM = false;
    bf16_t* Z; const float* gq; const float* gk;
    __device__ __forceinline__ void operator()(const f32x4 (&acc)[2][2][4][2], const Unit& u, int wr, int wc, int fr, int fq) const {
        const int row0 = u.pm * BM + wr * 64 + fr, pn = u.pn;
        if (pn >= 4 && pn < 8) {
            const float* g = pn < 6 ? gq : gk; const float sc = pn < 6 ? C2_B : 1.0f;
            f32x4 gv[2][2];
#pragma unroll
            for (int bj = 0; bj < 2; ++bj)
#pragma unroll
                for (int n = 0; n < 2; ++n) gv[bj][n] = *(const f32x4*)(g + 32 * bj + 16 * n + 4 * fq);
#pragma unroll
            for (int ai = 0; ai < 2; ++ai)
#pragma unroll
                for (int m = 0; m < 4; ++m) {
                    float ss = 0.f;
#pragma unroll
                    for (int bj = 0; bj < 2; ++bj)
#pragma unroll
                        for (int n = 0; n < 2; ++n) { const f32x4 v = acc[ai][bj][m][n]; ss += (v[0] * v[0] + v[1] * v[1]) + (v[2] * v[2] + v[3] * v[3]); }
                    ss += __shfl_xor(ss, 16); ss += __shfl_xor(ss, 32);
                    const float rstd = sc / sqrtf(ss * (1.0f / 64.0f) + EPS);
                    bf16_t* rowp = Z + (size_t)(row0 + ai * HALF + m * 16) * EVEN_IN + pn * BM + wc * 64 + 4 * fq;
#pragma unroll
                    for (int bj = 0; bj < 2; ++bj)
#pragma unroll
                        for (int n = 0; n < 2; ++n) { const f32x4 v = acc[ai][bj][m][n] * rstd * gv[bj][n];
                            u32x2 w; w.x = cvt_pk_bf16(v[0], v[1]); w.y = cvt_pk_bf16(v[2], v[3]); *(u32x2*)(rowp + 32 * bj + 16 * n) = w; }
                }
        } else {
            const bool act = pn < 4;
#pragma unroll
            for (int ai = 0; ai < 2; ++ai)
#pragma unroll
                for (int m = 0; m < 4; ++m) { bf16_t* rowp = Z + (size_t)(row0 + ai * HALF + m * 16) * EVEN_IN + pn * BM + wc * 32 + 4 * fq;
#pragma unroll
                    for (int bj = 0; bj < 2; ++bj)
#pragma unroll
                        for (int n = 0; n < 2; ++n) { f32x4 v = acc[ai][bj][m][n]; if (act) v = gelu4(v);
                            u32x2 w; w.x = cvt_pk_bf16(v[0], v[1]); w.y = cvt_pk_bf16(v[2], v[3]); *(u32x2*)(rowp + bj * HALF + 16 * n) = w; } }
        }
    }
};
template <bool F8 = false> struct EpiResidT {
    static constexpr bool PERM = false;
    const float* src32; bf16_t* X;
    __device__ __forceinline__ void operator()(const f32x4 (&acc)[2][2][4][2], const Unit& u, int wr, int wc, int fr, int fq) const {
        const int row0 = u.pm * BM + wr * 64 + fr;
#pragma unroll
        for (int ai = 0; ai < 2; ++ai)
#pragma unroll
            for (int m = 0; m < 4; ++m) { const size_t ro = (size_t)(row0 + ai * HALF + m * 16) * DM + u.pn * BM + wc * 32 + 4 * fq;
#pragma unroll
                for (int bj = 0; bj < 2; ++bj)
#pragma unroll
                    for (int n = 0; n < 2; ++n) { const size_t o_ = ro + bj * HALF + 16 * n; f32x4 b;
                        if (src32) b = *(const f32x4*)(src32 + o_); else { const u32x2 t = *(const u32x2*)(X + o_); b = (f32x4){bflo(t.x), bfhi(t.x), bflo(t.y), bfhi(t.y)}; }
                        const f32x4 r = b + (F8 ? acc[ai][bj][m][n] * W8_INV : acc[ai][bj][m][n]);
                        u32x2 w; w.x = cvt_pk_bf16(r[0], r[1]); w.y = cvt_pk_bf16(r[2], r[3]); *(u32x2*)(X + o_) = w; }
                if (m & 1) asm volatile("" ::: "memory"); }
    }
};
typedef EpiResidT<false> EpiResid;
struct EpiOddIn {
    static constexpr bool PERM = false;
    bf16_t* Z; unsigned char* Z8; float* ssq;
    __device__ __forceinline__ void operator()(const f32x4 (&acc)[2][2][4][2], const Unit& u, int wr, int wc, int fr, int fq) const {
        const int row0 = u.pm * BM + wr * 64 + fr, pn = u.pn;
#pragma unroll
        for (int ai = 0; ai < 2; ++ai)
#pragma unroll
            for (int m = 0; m < 4; ++m) { const int row = row0 + ai * HALF + m * 16; bf16_t* rowp = Z + (size_t)row * ODD_INP + pn * BM + wc * 32 + 4 * fq;
                float ss = 0.f;
#pragma unroll
                for (int bj = 0; bj < 2; ++bj)
#pragma unroll
                    for (int n = 0; n < 2; ++n) { const f32x4 v = acc[ai][bj][m][n] * W8_INV; ss += (v[0] * v[0] + v[1] * v[1]) + (v[2] * v[2] + v[3] * v[3]);
                        if (pn < 3) *(unsigned*)(Z8 + (size_t)row * ODD_INP + pn * BM + wc * 32 + 4 * fq + bj * HALF + 16 * n) = pk4_fp8(v[0], v[1], v[2], v[3]);
                        else { u32x2 w; w.x = cvt_pk_bf16(v[0], v[1]); w.y = cvt_pk_bf16(v[2], v[3]); *(u32x2*)(rowp + bj * HALF + 16 * n) = w; } }
                ss += __shfl_xor(ss, 16); ss += __shfl_xor(ss, 32);
                if (fq == 0) ssq[(size_t)row * 16 + pn * 4 + wc] = ss; }
    }
};
template <int NS> struct EpiRowScale {
    static constexpr bool PERM = true;
    unsigned char* O; int ldc; const float* ssq; int s0; float inv_cols;
    __device__ __forceinline__ void operator()(const f32x4 (&acc)[2][2][4][2], const Unit& u, int wr, int wc, int fr, int fq) const {
        const int row0 = u.pm * BM + wr * 64 + fr; const int col0 = u.pn * BM + wc * 32 + 8 * fq;
#pragma unroll
        for (int ai = 0; ai < 2; ++ai)
#pragma unroll
            for (int m = 0; m < 4; ++m) { const int row = row0 + ai * HALF + m * 16;
                float ss = 0.f; const f32x4* sp = (const f32x4*)(ssq + (size_t)row * 16 + s0);
#pragma unroll
                for (int q = 0; q < NS; ++q) { const f32x4 t = sp[q]; ss += (t[0] + t[1]) + (t[2] + t[3]); }
                const float rstd = W8_INV / sqrtf(ss * inv_cols + EPS);
                unsigned char* rowp = O + (size_t)row * ldc + col0;
#pragma unroll
                for (int bj = 0; bj < 2; ++bj) { const f32x4 v0 = acc[ai][bj][m][0] * rstd, v1 = acc[ai][bj][m][1] * rstd;
                    u32x2 w; w.x = pk4_fp8(v0[0], v0[1], v0[2], v0[3]); w.y = pk4_fp8(v1[0], v1[1], v1[2], v1[3]);
                    *(u32x2*)(rowp + bj * HALF) = w; }
                asm volatile("" ::: "memory"); }
    }
};
__device__ __forceinline__ void store8_sc1(void* p, u32x2 v) { asm volatile("global_store_dwordx2 %0, %1, off sc1" :: "v"(p), "v"(v) : "memory"); }
template <bool WT = false> struct EpiSwigluT {
    static constexpr bool PERM = true;
    unsigned char* ACT; const float* b1p;
    __device__ __forceinline__ void operator()(const f32x4 (&acc)[2][2][4][2], const Unit& u, int wr, int wc, int fr, int fq) const {
        const int row0 = u.pm * BM + wr * 64 + fr, e = u.pb >> 3, pn = u.pn;
        const float* bp = b1p + (size_t)e * 2048 + pn * BM + wc * 32 + 8 * fq;
        f32x4 bg[2], bl[2];
#pragma unroll
        for (int n = 0; n < 2; ++n) { bg[n] = *(const f32x4*)(bp + 4 * n); bl[n] = *(const f32x4*)(bp + HALF + 4 * n) + 1.0f; }
#pragma unroll
        for (int ai = 0; ai < 2; ++ai)
#pragma unroll
            for (int m = 0; m < 4; ++m) { unsigned char* rowp = ACT + (size_t)(row0 + ai * HALF + m * 16) * DE + pn * HALF + wc * 32 + 8 * fq;
                float a[8];
#pragma unroll
                for (int n = 0; n < 2; ++n) { const f32x4 gv = acc[ai][0][m][n] * W8_INV + bg[n], lv = acc[ai][1][m][n] * W8_INV + bl[n];
#pragma unroll
                    for (int i = 0; i < 4; ++i) { const float gl = fminf(gv[i], 7.0f), li1 = __builtin_amdgcn_fmed3f(lv[i], -6.0f, 8.0f);
                        const float sg = __builtin_amdgcn_rcpf(1.0f + __builtin_amdgcn_exp2f(-1.702f * LOG2E * gl));
                        a[4 * n + i] = gl * sg * li1; } }
                u32x2 w; w.x = pk4_fp8(a[0], a[1], a[2], a[3]); w.y = pk4_fp8(a[4], a[5], a[6], a[7]);
                if (WT) store8_sc1(rowp, w); else *(u32x2*)rowp = w; }
    }
};
typedef EpiSwigluT<false> EpiSwiglu;
struct EpiDown {
    static constexpr bool PERM = true;
    bf16_t* Y; const float* b2;
    __device__ __forceinline__ void operator()(const f32x4 (&acc)[2][2][4][2], const Unit& u, int wr, int wc, int fr, int fq) const {
        const int row0 = u.pm * BM + wr * 64 + fr, e = u.pb >> 2, pn = u.pn;
        const float* bp = b2 + (size_t)e * DM + pn * BM + wc * 32 + 8 * fq;
        f32x4 bv[2][2];
#pragma unroll
        for (int bj = 0; bj < 2; ++bj)
#pragma unroll
            for (int n = 0; n < 2; ++n) bv[bj][n] = *(const f32x4*)(bp + bj * HALF + 4 * n);
#pragma unroll
        for (int ai = 0; ai < 2; ++ai)
#pragma unroll
            for (int m = 0; m < 4; ++m) { bf16_t* rowp = Y + (size_t)(row0 + ai * HALF + m * 16) * DM + pn * BM + wc * 32 + 8 * fq;
#pragma unroll
                for (int bj = 0; bj < 2; ++bj) { const f32x4 v0 = acc[ai][bj][m][0] * W8_INV + bv[bj][0], v1 = acc[ai][bj][m][1] * W8_INV + bv[bj][1];
                    u32x4 w; w.x = cvt_pk_bf16(v0[0], v0[1]); w.y = cvt_pk_bf16(v0[2], v0[3]); w.z = cvt_pk_bf16(v1[0], v1[1]); w.w = cvt_pk_bf16(v1[2], v1[3]);
                    *(u32x4*)(rowp + bj * HALF) = w; } }
    }
};
struct MoeOrder {
    const LAS int* tbl; int nN, G, c;
    __device__ bool next(int i, Unit& u) const {
        const long L = (long)i * G + c; const int rb = (int)(L / nN);
        if (rb >= __builtin_amdgcn_readfirstlane(tbl[32])) return false;
        int e = 0;
#pragma unroll
        for (int k = 1; k < 32; ++k) e += (tbl[k] <= rb) ? 1 : 0;
        e = __builtin_amdgcn_readfirstlane(e); const int rbl = __builtin_amdgcn_readfirstlane(rb - tbl[e]);
        u.pm = e * (ECAP / BM) + rbl; u.pn = (int)(L % nN); u.pb = e * nN + u.pn; u.kind = 0; u.rb = rb; return true;
    }
    __device__ __forceinline__ void a_ready(const Unit&) const {}
    __device__ __forceinline__ void pre_epi() const {}
    __device__ __forceinline__ void done(const Unit&) const {}
    __device__ __forceinline__ void finish() const {}
};

constexpr unsigned MOE_SPIN_CAP = 1u << 22;
struct MoeMergedOrder {
    const LAS int* tbl; int G, c; gu32* cnt;
    mutable int pend;
    __device__ __forceinline__ void flush() const {
        if (pend >= 0) { asm volatile("s_waitcnt vmcnt(0)" ::: "memory");
            if ((threadIdx.x & 63) == 0) __hip_atomic_fetch_add(cnt + 16 * pend, 1u, __ATOMIC_RELAXED, __HIP_MEMORY_SCOPE_AGENT);
            pend = -1; } }
    __device__ bool next(int i, Unit& u) const {
        const int nb = __builtin_amdgcn_readfirstlane(tbl[32]);
        long L = (long)i * G + c; int nN = 8, kind = 0;
        if (L >= (long)nb * 8) { L -= (long)nb * 8; nN = 4; kind = 1; if (L >= (long)nb * 4) return false; }
        const int rb = (int)(L / nN);
        int e = 0;
#pragma unroll
        for (int k = 1; k < 32; ++k) e += (tbl[k] <= rb) ? 1 : 0;
        e = __builtin_amdgcn_readfirstlane(e); const int rbl = __builtin_amdgcn_readfirstlane(rb - tbl[e]);
        u.pm = e * (ECAP / BM) + rbl; u.pn = (int)(L % nN); u.pb = e * nN + u.pn; u.kind = kind; u.rb = rb; return true;
    }
    __device__ __forceinline__ void a_ready(const Unit& u) const {
        if (u.kind == 1) {
            flush();
            if (threadIdx.x < 64) {
                unsigned sp = 0;
                while ((unsigned)__builtin_amdgcn_readfirstlane(__hip_atomic_load(cnt + 16 * u.rb, __ATOMIC_RELAXED, __HIP_MEMORY_SCOPE_AGENT)) < 64u) { __builtin_amdgcn_s_sleep(2); if (++sp > MOE_SPIN_CAP) break; }
                __builtin_amdgcn_fence(__ATOMIC_ACQUIRE, "agent");
                asm volatile("s_waitcnt vmcnt(0)" ::: "memory");
            }
            __builtin_amdgcn_s_barrier();
        }
    }
    __device__ __forceinline__ void pre_epi() const { flush(); }
    __device__ __forceinline__ void done(const Unit& u) const { if (u.kind == 0) pend = u.rb; }
    __device__ __forceinline__ void finish() const { flush(); }
};
struct EpiMoe {
    static constexpr bool PERM = true;
    EpiSwigluT<true> up; EpiDown down;
    __device__ __forceinline__ void operator()(const f32x4 (&acc)[2][2][4][2], const Unit& u, int wr, int wc, int fr, int fq) const {
        if (u.kind == 0) up(acc, u, wr, wc, fr, fq); else down(acc, u, wr, wc, fr, fq);
    }
};
}

__device__ __forceinline__ void gmlp_unit(Frame& F, const bf16_t* Z, bf16_t* MIX, const float* Ws, const float* bs, const float* gv, int unit) {
    constexpr int VP = 272;
    LAS unsigned char* VT = F.lds + RING_OFF;
    const int h = unit & 3, chunk = unit >> 2;
    int tid_ = threadIdx.x; asm volatile("" : "+v"(tid_));
    const int t0 = chunk * 128, tid = tid_, lane = tid & 63, w = __builtin_amdgcn_readfirstlane(tid >> 6);
    {
        const int s = tid >> 2, dq = (tid & 3) * 32;
        const bf16_t* vp = Z + (size_t)(t0 + s) * EVEN_IN + 512 + h * 128 + dq;
        u32x4 raw[4]; float ss = 0.f;
#pragma unroll
        for (int i = 0; i < 4; ++i) { raw[i] = *(const u32x4*)(vp + 8 * i);
#pragma unroll
            for (int j = 0; j < 4; ++j) { const float a = bflo(raw[i][j]), b = bfhi(raw[i][j]); ss += a * a + b * b; } }
        ss += __shfl_xor(ss, 1); ss += __shfl_xor(ss, 2);
        const float rstd = 1.0f / sqrtf(ss * (1.0f / 128.0f) + EPS);
#pragma unroll
        for (int i = 0; i < 4; ++i)
#pragma unroll
            for (int j = 0; j < 4; ++j) { const int d = dq + 8 * i + 2 * j;
                *(LAS bf16_t*)(VT + (d) * VP + s * 2) = f2bf(bflo(raw[i][j]) * rstd);
                *(LAS bf16_t*)(VT + (d + 1) * VP + s * 2) = f2bf(bfhi(raw[i][j]) * rstd); }
    }
    __syncthreads();
    const int fr = lane & 15, fq = lane >> 4;
    f32x4 acc[8];
#pragma unroll
    for (int nb = 0; nb < 8; ++nb) acc[nb] = (f32x4){0.f, 0.f, 0.f, 0.f};
    const int trow = 16 * w + fr;
    const float* wrow = Ws + ((size_t)h * 128 + trow) * 128;
#pragma unroll
    for (int ks = 0; ks < 4; ++ks) {
        if (32 * ks <= 16 * w + 15) {
            const int s0 = 32 * ks + 8 * fq;
            const f32x4 wa = *(const f32x4*)(wrow + s0), wb = *(const f32x4*)(wrow + s0 + 4);
            float wv[8] = {wa[0], wa[1], wa[2], wa[3], wb[0], wb[1], wb[2], wb[3]};
#pragma unroll
            for (int j = 0; j < 8; ++j) if (s0 + j > trow) wv[j] = 0.f;
            u32x4 aw; aw.x = cvt_pk_bf16(wv[0], wv[1]); aw.y = cvt_pk_bf16(wv[2], wv[3]); aw.z = cvt_pk_bf16(wv[4], wv[5]); aw.w = cvt_pk_bf16(wv[6], wv[7]);
            const bf16x8 af = __builtin_bit_cast(bf16x8, aw);
#pragma unroll
            for (int nb = 0; nb < 8; ++nb) { const bf16x8 bfr = *(const LAS bf16x8*)(VT + (16 * nb + fr) * VP + s0 * 2);
                acc[nb] = __builtin_amdgcn_mfma_f32_16x16x32_bf16(af, bfr, acc[nb], 0, 0, 0); }
        }
    }
    LAS bf16_t* DT = (LAS bf16_t*)(F.lds + RING_OFF + 36864);
#pragma unroll
    for (int i = 0; i < 4; ++i) { const int tl = 16 * w + 4 * fq + i; const float bt = bs[h * 128 + tl];
#pragma unroll
        for (int nb = 0; nb < 8; ++nb) DT[tl * 136 + 16 * nb + fr] = f2bf(gv[h * 128 + 16 * nb + fr] * acc[nb][i] + bt); }
    __syncthreads();
#pragma unroll
    for (int k = 0; k < 4; ++k) { const int idx = tid + 512 * k, tl = idx >> 4, c8 = (idx & 15) * 8;
        const u32x4 mv = *(const LAS u32x4*)(DT + tl * 136 + c8); const u32x4 uv = *(const u32x4*)(Z + (size_t)(t0 + tl) * EVEN_IN + h * 128 + c8);
        u32x4 o; o.x = cvt_pk_bf16(bflo(uv.x) * bflo(mv.x), bfhi(uv.x) * bfhi(mv.x)); o.y = cvt_pk_bf16(bflo(uv.y) * bflo(mv.y), bfhi(uv.y) * bfhi(mv.y));
        o.z = cvt_pk_bf16(bflo(uv.z) * bflo(mv.z), bfhi(uv.z) * bfhi(mv.z)); o.w = cvt_pk_bf16(bflo(uv.w) * bflo(mv.w), bfhi(uv.w) * bfhi(mv.w));
        *(u32x4*)(MIX + (size_t)(t0 + tl) * DM + h * 128 + c8) = o; }
    __syncthreads();
}

__device__ __forceinline__ void router_phase(Frame& F, const bf16_t* x, const float* gain, const float* Wr, const float* br, gu32* cnt  ,
                                             unsigned* tok_er, float* tok_g, unsigned char* XG) {
    LAS float* part = (LAS float*)(F.lds + RING_OFF);
    LAS float* ssqp = (LAS float*)(F.lds + RING_OFF + 8 * 64 * 33 * 4);
    LAS float* lg = (LAS float*)(F.lds + SCR_OFF);
    LAS unsigned* hist = (LAS unsigned*)(F.lds + SCR_OFF + 64 * 33 * 4);
    LAS unsigned* base = hist + 32;
    LAS unsigned* ers = base + 32;
    int tid_ = threadIdx.x; asm volatile("" : "+v"(tid_));
    const int tid = tid_, lane = tid & 63, w = __builtin_amdgcn_readfirstlane(tid >> 6), r32 = lane & 31, hi = lane >> 5;
#ifndef RTR_REP_A
#define RTR_REP_A 1
#define RTR_REP_B 1
#define RTR_REP_C 1
#endif
    f32x4 gg[4];
#pragma unroll
    for (int j = 0; j < 4; ++j) gg[j] = ((const f32x4*)gain + lane)[64 * j];
    {   const int tg = F.vcu;
    const int tokb = tg * 64;
    if (tid < 32) hist[tid] = 0u;
    for (int rb_ = 0; rb_ < RTR_REP_B; ++rb_) {
        bf16x8 wh[8], wl[8];
#pragma unroll
        for (int ks = 0; ks < 8; ++ks) { float wv[8];
#pragma unroll
            for (int j = 0; j < 8; ++j) { const int k = 128 * w + 16 * ks + 8 * hi + j; wv[j] = Wr[(size_t)k * NE + r32] * gain[k]; }
            u32x4 h4, l4;
#pragma unroll
            for (int j = 0; j < 4; ++j) { const unsigned hp = cvt_pk_bf16(wv[2 * j], wv[2 * j + 1]); h4[j] = hp; l4[j] = cvt_pk_bf16(wv[2 * j] - bflo(hp), wv[2 * j + 1] - bfhi(hp)); }
            wh[ks] = __builtin_bit_cast(bf16x8, h4); wl[ks] = __builtin_bit_cast(bf16x8, l4); }
#pragma unroll
        for (int g2 = 0; g2 < 2; ++g2) {
            const bf16_t* xr = x + (size_t)(tokb + 32 * g2 + r32) * DM + 128 * w + 8 * hi;
            f32x16 d = f32x16{}; float ss = 0.f;
#pragma unroll
            for (int ks = 0; ks < 8; ++ks) { const u32x4 xw = *(const u32x4*)(xr + 16 * ks);
#pragma unroll
                for (int j = 0; j < 4; ++j) { const float a = bflo(xw[j]), b = bfhi(xw[j]); ss += a * a + b * b; }
                const bf16x8 xh = __builtin_bit_cast(bf16x8, xw);
                d = __builtin_amdgcn_mfma_f32_32x32x16_bf16(wh[ks], xh, d, 0, 0, 0);
                d = __builtin_amdgcn_mfma_f32_32x32x16_bf16(wl[ks], xh, d, 0, 0, 0); }
            { auto rr = __builtin_amdgcn_permlane32_swap(__float_as_uint(ss), __float_as_uint(ss), false, false); ss = __uint_as_float(rr[0]) + __uint_as_float(rr[1]); }
            if (hi == 0) ssqp[w * 64 + 32 * g2 + r32] = ss;
#pragma unroll
            for (int r = 0; r < 16; ++r) part[(w * 64 + 32 * g2 + r32) * 33 + (r & 3) + 8 * (r >> 2) + 4 * hi] = d[r];
        }
    }
    __syncthreads();
    {   const int t = tid >> 3, q4 = (tid & 7) * 4; float s = 0.f;
#pragma unroll
        for (int ww = 0; ww < 8; ++ww) s += ssqp[ww * 64 + t];
        const float rstd = 1.0f / sqrtf(s * (1.f / DM) + EPS);
#pragma unroll
        for (int i = 0; i < 4; ++i) { float a = 0.f;
#pragma unroll
            for (int ww = 0; ww < 8; ++ww) a += part[(ww * 64 + t) * 33 + q4 + i];
            lg[t * 33 + q4 + i] = a * rstd + br[q4 + i]; } }
    __syncthreads();
    unsigned my_e[4] = {0, 0, 0, 0}, my_lr[4] = {0, 0, 0, 0}; float my_g[4] = {0, 0, 0, 0};
    if (tid < 64) {
        float v[32];
#pragma unroll
        for (int e = 0; e < 32; ++e) v[e] = lg[tid * 33 + e];
        int c0 = -1, c1 = -1, c2 = -1; float tv[4];
#pragma unroll
        for (int r = 0; r < 4; ++r) { float best = -__builtin_inff(); int bi = 0;
#pragma unroll
            for (int e = 0; e < 32; ++e) { const bool ok = (e != c0) && (e != c1) && (e != c2); if (ok && v[e] > best) { best = v[e]; bi = e; } }
            tv[r] = best; my_e[r] = (unsigned)bi; if (r == 0) c0 = bi; else if (r == 1) c1 = bi; else if (r == 2) c2 = bi; }
        const float p1 = __expf(tv[1] - tv[0]), p2 = __expf(tv[2] - tv[0]), p3 = __expf(tv[3] - tv[0]); const float inv = 1.0f / (1.0f + p1 + p2 + p3);
        my_g[0] = inv; my_g[1] = p1 * inv; my_g[2] = p2 * inv; my_g[3] = p3 * inv;
#pragma unroll
        for (int r = 0; r < 4; ++r) my_lr[r] = __hip_atomic_fetch_add(hist + my_e[r], 1u, __ATOMIC_RELAXED, __HIP_MEMORY_SCOPE_WORKGROUP);
    }
    __syncthreads();
    if (tid < 32) { const unsigned hc = hist[tid]; base[tid] = hc ? __hip_atomic_fetch_add(cnt + 64 * tid, hc, RLX_AGENT) : 0u; }
    __syncthreads();
    if (tid < 64) {
        u32x4 er; f32x4 gt;
#pragma unroll
        for (int r = 0; r < 4; ++r) { const unsigned rank = base[my_e[r]] + my_lr[r]; er[r] = (my_e[r] << 16) | rank; gt[r] = my_g[r]; ers[tid * 4 + r] = er[r]; }
        *(u32x4*)(tok_er + (size_t)(tokb + tid) * 4) = er; *(f32x4*)(tok_g + (size_t)(tokb + tid) * 4) = gt;
    }
    __syncthreads();
    for (int rc_ = 0; rc_ < RTR_REP_C; ++rc_)
#pragma unroll 2
    for (int tt = 0; tt < 8; ++tt) {
        const int tl = w * 8 + tt; const bf16_t* xrow = x + (size_t)(tokb + tl) * DM;
        f32x4 hv[4]; float s = 0.f;
#pragma unroll
        for (int j = 0; j < 4; ++j) { const u32x2 t = ((const u32x2*)xrow + lane)[64 * j]; hv[j] = (f32x4){bflo(t.x), bfhi(t.x), bflo(t.y), bfhi(t.y)}; s += (hv[j].x * hv[j].x + hv[j].y * hv[j].y) + (hv[j].z * hv[j].z + hv[j].w * hv[j].w); }
        const float rstd = 1.0f / sqrtf(wave_sum(s) * (1.f / DM) + EPS);
        unsigned wv[4];
#pragma unroll
        for (int j = 0; j < 4; ++j) { const f32x4 t = hv[j] * rstd * gg[j]; wv[j] = pk4_fp8(t.x, t.y, t.z, t.w); }
#pragma unroll
        for (int r = 0; r < 4; ++r) { const unsigned er = ers[tl * 4 + r]; const size_t slot = (size_t)(er >> 16) * ECAP + (er & 0xffffu);
            unsigned* o4 = (unsigned*)(XG + slot * DM) + lane;
#pragma unroll
            for (int j = 0; j < 4; ++j) o4[64 * j] = wv[j]; }
    }
    __syncthreads();
    }
}

__device__ __forceinline__ void combine_phase(Frame& F, bf16_t* x, float* out32  , const unsigned* tok_er, const float* tok_g, const bf16_t* Y, const float* g_next, unsigned char* XN, bool xn_fp8) {
    int tid_ = threadIdx.x; asm volatile("" : "+v"(tid_));
    const int gw = F.vcu * NWAVES + __builtin_amdgcn_readfirstlane(tid_ >> 6), NGW = F.G * NWAVES, lane = tid_ & 63;
    u32x4 erA, erB, erAn, erBn; f32x4 gtA, gtB, gtAn, gtBn;
    { const int ma = gw < M ? gw : 0, mb0 = gw + NGW < M ? gw + NGW : ma;
      erAn = *(const u32x4*)(tok_er + (size_t)ma * 4); erBn = *(const u32x4*)(tok_er + (size_t)mb0 * 4); gtAn = *(const f32x4*)(tok_g + (size_t)ma * 4); gtBn = *(const f32x4*)(tok_g + (size_t)mb0 * 4); }
    for (int m0 = gw; m0 < M; m0 += 2 * NGW) {
        const int m1 = m0 + NGW; const bool two = m1 < M; const int mb = two ? m1 : m0;
        erA = erAn; erB = erBn; gtA = gtAn; gtB = gtBn;
        { const int na = m0 + 2 * NGW < M ? m0 + 2 * NGW : m0, nb2 = m0 + 3 * NGW < M ? m0 + 3 * NGW : na;
          erAn = *(const u32x4*)(tok_er + (size_t)na * 4); erBn = *(const u32x4*)(tok_er + (size_t)nb2 * 4); gtAn = *(const f32x4*)(tok_g + (size_t)na * 4); gtBn = *(const f32x4*)(tok_g + (size_t)nb2 * 4); }
        bf16_t* xrA = x + (size_t)m0 * DM; bf16_t* xrB = x + (size_t)mb * DM;
        u32x2 xa[4], xb[4], ya[4][4], yb[4][4];
#pragma unroll
        for (int j = 0; j < 4; ++j) { xa[j] = ((const u32x2*)xrA + lane)[64 * j]; xb[j] = ((const u32x2*)xrB + lane)[64 * j]; }
#pragma unroll
        for (int r = 0; r < 4; ++r) { const size_t sA = (size_t)(erA[r] >> 16) * ECAP + (erA[r] & 0xffffu), sB = (size_t)(erB[r] >> 16) * ECAP + (erB[r] & 0xffffu);
#pragma unroll
            for (int j = 0; j < 4; ++j) { ya[r][j] = ((const u32x2*)(Y + sA * DM) + lane)[64 * j]; yb[r][j] = ((const u32x2*)(Y + sB * DM) + lane)[64 * j]; } }
#pragma unroll
        for (int t = 0; t < 2; ++t) {
            if (t == 1 && !two) break;
            const int m = t ? m1 : m0; bf16_t* xrow = t ? xrB : xrA; const f32x4 gt = t ? gtB : gtA;
            f32x4 v[4];
#pragma unroll
            for (int j = 0; j < 4; ++j) { const u32x2 q = t ? xb[j] : xa[j]; v[j] = (f32x4){bflo(q.x), bfhi(q.x), bflo(q.y), bfhi(q.y)}; }
#pragma unroll
            for (int r = 0; r < 4; ++r) { const float g = gt[r];
#pragma unroll
                for (int j = 0; j < 4; ++j) { const u32x2 yv = t ? yb[r][j] : ya[r][j]; v[j].x += g * bflo(yv.x); v[j].y += g * bfhi(yv.x); v[j].z += g * bflo(yv.y); v[j].w += g * bfhi(yv.y); } }
#pragma unroll
            for (int j = 0; j < 4; ++j) { if (out32) ((f32x4*)(out32 + (size_t)m * DM) + lane)[64 * j] = v[j];
                else { u32x2 q; q.x = cvt_pk_bf16(v[j].x, v[j].y); q.y = cvt_pk_bf16(v[j].z, v[j].w); ((u32x2*)xrow + lane)[64 * j] = q; } }
            if (g_next) {
                float s = 0.f;
#pragma unroll
                for (int j = 0; j < 4; ++j) s += (v[j].x * v[j].x + v[j].y * v[j].y) + (v[j].z * v[j].z + v[j].w * v[j].w);
                const float rstd = 1.0f / sqrtf(wave_sum(s) * (1.f / DM) + EPS);
                unsigned* o4 = (unsigned*)(XN + (size_t)m * DM) + lane; u32x2* o8 = (u32x2*)(XN + (size_t)m * DM * 2) + lane;
#pragma unroll
                for (int j = 0; j < 4; ++j) { const f32x4 gg = ((const f32x4*)g_next + lane)[64 * j];
                    if (xn_fp8) o4[64 * j] = pk4_fp8(v[j].x * rstd * gg.x, v[j].y * rstd * gg.y, v[j].z * rstd * gg.z, v[j].w * rstd * gg.w);
                    else { u32x2 w; w.x = cvt_pk_bf16(v[j].x * rstd * gg.x, v[j].y * rstd * gg.y); w.y = cvt_pk_bf16(v[j].z * rstd * gg.z, v[j].w * rstd * gg.w); o8[64 * j] = w; } }
            }
        }
    }
}

__device__ __forceinline__ void unpack8f8(const u32x2 w, float (&f)[8]) { const f32x2 a = __builtin_amdgcn_cvt_pk_f32_fp8((int)w.x, false), b = __builtin_amdgcn_cvt_pk_f32_fp8((int)w.x, true),
    c = __builtin_amdgcn_cvt_pk_f32_fp8((int)w.y, false), d = __builtin_amdgcn_cvt_pk_f32_fp8((int)w.y, true); f[0] = a.x; f[1] = a.y; f[2] = b.x; f[3] = b.y; f[4] = c.x; f[5] = c.y; f[6] = d.x; f[7] = d.y; }
__device__ __forceinline__ void unpack4f8(const unsigned w, float (&f)[4]) { const f32x2 a = __builtin_amdgcn_cvt_pk_f32_fp8((int)w, false), b = __builtin_amdgcn_cvt_pk_f32_fp8((int)w, true); f[0] = a.x; f[1] = a.y; f[2] = b.x; f[3] = b.y; }
__device__ __forceinline__ void unpack8(const u32x4 w, float (&f)[8]) { f[0] = bflo(w.x); f[1] = bfhi(w.x); f[2] = bflo(w.y); f[3] = bfhi(w.y); f[4] = bflo(w.z); f[5] = bfhi(w.z); f[6] = bflo(w.w); f[7] = bfhi(w.w); }
__device__ __forceinline__ void unpack4(const u32x2 w, float (&f)[4]) { f[0] = bflo(w.x); f[1] = bfhi(w.x); f[2] = bflo(w.y); f[3] = bfhi(w.y); }
__device__ __forceinline__ void fin_head(const float (&a)[8], const float (&b)[8], const float (&x1)[4], const float (&x2)[4], const float (&g)[24], const float (&cs)[4], const float (&sn)[4], unsigned char* op, int j, float scale) {
    float ss = 0.f;
#pragma unroll
    for (int i = 0; i < 8; ++i) ss += a[i] * a[i] + b[i] * b[i];
#pragma unroll
    for (int i = 0; i < 4; ++i) ss += x1[i] * x1[i] + x2[i] * x2[i];
    ss += __shfl_xor(ss, 1); ss += __shfl_xor(ss, 2); ss += __shfl_xor(ss, 4);
    const float rstd = scale / sqrtf(ss * (1.0f / 192.0f) + EPS);
    u32x4 o0;
    o0.x = pk4_fp8(a[0] * rstd * g[0], a[1] * rstd * g[1], a[2] * rstd * g[2], a[3] * rstd * g[3]); o0.y = pk4_fp8(a[4] * rstd * g[4], a[5] * rstd * g[5], a[6] * rstd * g[6], a[7] * rstd * g[7]);
    o0.z = pk4_fp8(b[0] * rstd * g[8], b[1] * rstd * g[9], b[2] * rstd * g[10], b[3] * rstd * g[11]); o0.w = pk4_fp8(b[4] * rstd * g[12], b[5] * rstd * g[13], b[6] * rstd * g[14], b[7] * rstd * g[15]);
    float y1[4], y2[4];
#pragma unroll
    for (int i = 0; i < 4; ++i) { const float u = x1[i] * rstd * g[16 + i], v = x2[i] * rstd * g[20 + i]; y1[i] = u * cs[i] - v * sn[i]; y2[i] = u * sn[i] + v * cs[i]; }
    *(u32x4*)(op + 16 * j) = o0; *(unsigned*)(op + 128 + 4 * j) = pk4_fp8(y1[0], y1[1], y1[2], y1[3]); *(unsigned*)(op + 160 + 4 * j) = pk4_fp8(y2[0], y2[1], y2[2], y2[3]);
}
__device__ __forceinline__ void mla_finalize_phase(Frame& F, const unsigned char* QR, const unsigned char* KVR, const bf16_t* Z, const float* gq, const float* gk, unsigned char* QF, unsigned char* KF) {
    int tid_ = threadIdx.x; asm volatile("" : "+v"(tid_));
    const int gw = F.vcu * NWAVES + __builtin_amdgcn_readfirstlane(tid_ >> 6), NGW = F.G * NWAVES, lane = tid_ & 63;
    const int h = lane >> 3, j = lane & 7;
    float gqv[24], gkv[24], invf[4];
#pragma unroll
    for (int i = 0; i < 16; ++i) { gqv[i] = gq[16 * j + i]; gkv[i] = gk[16 * j + i]; }
#pragma unroll
    for (int i = 0; i < 4; ++i) { gqv[16 + i] = gq[128 + 4 * j + i]; gqv[20 + i] = gq[160 + 4 * j + i]; gkv[16 + i] = gk[128 + 4 * j + i]; gkv[20 + i] = gk[160 + 4 * j + i];
        invf[i] = __builtin_amdgcn_exp2f(-(float)(4 * j + i) * (13.287712379549449f / 32.0f)); }
#pragma unroll 2
    for (int m = gw; m < M; m += NGW) {
        const int pos = m & (SEQ - 1);
        float cs[4], sn[4];
#pragma unroll
        for (int i = 0; i < 4; ++i) { const double rev = (double)pos * (double)invf[i] * 0.15915494309189535; const float fr = (float)(rev - __builtin_rint(rev));
            sn[i] = __builtin_amdgcn_sinf(fr); cs[i] = __builtin_amdgcn_cosf(fr); }
        const unsigned char* qp = QR + (size_t)m * 1536 + h * 192; const unsigned char* kp = KVR + (size_t)m * 2048 + h * 256; const bf16_t* zp = Z + (size_t)m * ODD_INP + 768;
        const u32x4 qn = *(const u32x4*)(qp + 16 * j); const unsigned qr1 = *(const unsigned*)(qp + 128 + 4 * j), qr2 = *(const unsigned*)(qp + 160 + 4 * j);
        const u32x4 kn = *(const u32x4*)(kp + 16 * j); const u32x2 kr1 = *(const u32x2*)(zp + 4 * j), kr2 = *(const u32x2*)(zp + 32 + 4 * j);
        float a[8], b[8], x1[4], x2[4];
        unpack8f8((u32x2){qn.x, qn.y}, a); unpack8f8((u32x2){qn.z, qn.w}, b); unpack4f8(qr1, x1); unpack4f8(qr2, x2);
        fin_head(a, b, x1, x2, gqv, cs, sn, QF + (size_t)m * 1536 + h * 192, j, 8.0f * C2_C);
        unpack8f8((u32x2){kn.x, kn.y}, a); unpack8f8((u32x2){kn.z, kn.w}, b); unpack4(kr1, x1); unpack4(kr2, x2);
        fin_head(a, b, x1, x2, gkv, cs, sn, KF + (size_t)m * 1536 + h * 192, j, 1.0f);
    }
}

__device__ __forceinline__ void vt_phase(Frame& F, const unsigned char* KVR, unsigned char* VT8) {
    int tid_ = threadIdx.x; asm volatile("" : "+v"(tid_));
    const int tid = tid_;
    LAS unsigned char* T = F.lds + RING_OFF;
    for (int it = F.vcu; it < M / 64; it += F.G) {
        const int m0 = it * 64, b = m0 / SEQ, tok0 = m0 % SEQ;
#pragma unroll 4
        for (int k = 0; k < 8; ++k) { const int idx = tid + 512 * k, tok = idx >> 6, grp = idx & 63, h = grp >> 3, d16 = (grp & 7) * 16;
            const u32x4 w = *(const u32x4*)(KVR + (size_t)(m0 + tok) * 2048 + h * 256 + 128 + d16);
            LAS unsigned char* tp = T + (h * 128 + d16) * 80 + tok;
#pragma unroll
            for (int i = 0; i < 4; ++i) { const unsigned x = w[i]; tp[(4 * i) * 80] = (unsigned char)x; tp[(4 * i + 1) * 80] = (unsigned char)(x >> 8); tp[(4 * i + 2) * 80] = (unsigned char)(x >> 16); tp[(4 * i + 3) * 80] = (unsigned char)(x >> 24); } }
        __syncthreads();
#pragma unroll 4
        for (int k = 0; k < 8; ++k) { const int idx = tid + 512 * k, row = idx >> 2, q = idx & 3;
            const u32x4 v = *(const LAS u32x4*)(T + row * 80 + 16 * q);
            *(u32x4*)(VT8 + ((size_t)b * 1024 + row) * SEQ + tok0 + 16 * q) = v; }
        __syncthreads();
    }
}

#ifndef PHMASK
#define PHMASK 0xFFFF
#endif
#ifndef REPMASK
#define REPMASK 0
#endif
#ifndef REPCNT
#define REPCNT 3
#endif
#define NREP(k) ((((REPMASK) >> (k)) & 1) ? (REPCNT) : 1)

#define LAUNDER_S(x) asm volatile("" : "+s"(x))
__device__ __forceinline__ const float* in_ptr(const Args& a, int i) { LAUNDER_S(i); return a.in[i]; }
#define PHASE_BEGIN() unsigned wso_ = 0u; LAUNDER_S(wso_); unsigned char* ws = args.ws + wso_; Frame Fp = F; Fp.vcu = __builtin_amdgcn_readfirstlane(Fp.vcu); Fp.G = __builtin_amdgcn_readfirstlane(Fp.G); LAUNDER_S(Fp.vcu); LAUNDER_S(Fp.G); \
    int bx_ = __builtin_amdgcn_readfirstlane((int)blockIdx.x); LAUNDER_S(bx_); (void)bx_; (void)ws
#define XN  ((unsigned char*)(ws + WS_XN))
#define Z   ((bf16_t*)(ws + WS_Z))
#define MIX ((bf16_t*)(ws + WS_MIX))
#define QR  ((unsigned char*)(ws + WS_QR))
#define KVR ((unsigned char*)(ws + WS_KVR))
#define QF  ((unsigned char*)(ws + WS_QF))
#define KF  ((unsigned char*)(ws + WS_KF))
#define XG  ((unsigned char*)(ws + WS_XG))
#define ACT ((unsigned char*)(ws + WS_ACT))
#define YB  ((bf16_t*)(ws + WS_Y))
#define SSQ ((float*)(ws + WS_SSQ))
#define TOKER ((unsigned*)(ws + WS_TOKER))
#define TOKG ((float*)(ws + WS_TOKG))
#define B1P ((float*)(ws + WS_B1P))
#define IN(i) in_ptr(args, (i))
__global__ void __launch_bounds__(NWAVES * 64, 2) trunk_fwd(Args args) {
    extern __shared__ __attribute__((aligned(16))) unsigned char lds_raw[];
    Frame F;
    F.lds = (LAS unsigned char*)lds_raw;
    F.G = gridDim.x; { const int bx = blockIdx.x; F.vcu = (F.G % 8 == 0) ? (bx % 8) * (F.G / 8) + bx / 8 : bx; }
    for (int u = threadIdx.x; u < (SCR_OFF - LDSCTL_OFF) / 4; u += NWAVES * 64) ((LAS unsigned*)(F.lds + LDSCTL_OFF))[u] = 0u;
    __syncthreads();
    (void)xcd_barrier_post((unsigned*)((gu32*)(args.ws + WS_CTL) + CW_BAR), (volatile LAS unsigned*)(F.lds + MISC_OFF) + 8);
#define GRID_BAR() do { unsigned wsb_ = 0u; LAUNDER_S(wsb_); XcdBarrier bar_; bar_.bar = (unsigned*)((gu32*)(args.ws + wsb_ + WS_CTL) + CW_BAR); bar_.x = xb_xcc_id(); \
        bar_.st = (volatile LAS unsigned*)(F.lds + MISC_OFF) + 8; xcd_barrier(bar_); } while (0)
#define X16 ((bf16_t*)(ws + WS_X16))
    const int stage_limit = args.stage_limit;

#if (PHMASK >> 0) & 1
            _Pragma("unroll") for (int rep_ = 0; rep_ < NREP(0); ++rep_) { if (rep_) GRID_BAR();
    {   PHASE_BEGIN(); const int ptid = threadIdx.x, gw = Fp.vcu * NWAVES + __builtin_amdgcn_readfirstlane(ptid >> 6), NGW = Fp.G * NWAVES;
        transpose_job<1>(Fp, IN(I_EWIN), DM, EVEN_IN, 2, (size_t)DM * EVEN_IN, (bf16_t*)(ws + WS_WEIN), (size_t)EVEN_IN * DM, nullptr, 0);
        transpose_job<0>(Fp, IN(I_EWOUT), DM, DM, 2, (size_t)DM * DM, (bf16_t*)(ws + WS_WEOUT), (size_t)DM * DM, nullptr, 0);
        transpose_job_fp8<0>(Fp, IN(I_OWIN), DM, ODD_IN, 2, (size_t)DM * ODD_IN, ws + WS_WOIN, (size_t)ODD_INP * DM);
        transpose_job_fp8<0>(Fp, IN(I_OWUQ), 512, 1536, 2, (size_t)512 * 1536, ws + WS_WUQ, (size_t)1536 * 512, IN(I_OGCQ), 512);
        transpose_job_fp8<0>(Fp, IN(I_OWUKV), 256, 2048, 2, (size_t)256 * 2048, ws + WS_WUKV, (size_t)2048 * 256, IN(I_OGCKV), 256);
        transpose_job_fp8<0>(Fp, IN(I_OWOUT), DM, DM, 2, (size_t)DM * DM, ws + WS_WOOUT, (size_t)DM * DM);
        transpose_job_fp8<2>(Fp, IN(I_W1), DM, 2 * DE, DEPTH * NE, (size_t)DM * 2 * DE, ws + WS_W1, (size_t)2 * DE * DM);
        transpose_job_fp8<0>(Fp, IN(I_W2), DE, DM, DEPTH * NE, (size_t)DE * DM, ws + WS_W2, (size_t)DM * DE);
        for (int i = bx_ * 512 + ptid; i < 2 * 12288; i += Fp.G * 512) { const int mi = i / 12288, r = i % 12288;
            *(u32x4*)(ws + WS_WOIN + (size_t)mi * ODD_INP * DM + (size_t)ODD_IN * DM + (size_t)r * 16) = (u32x4){0u, 0u, 0u, 0u}; }
        for (int i = bx_ * 512 + ptid; i < DEPTH * NE * 2048; i += Fp.G * 512) { const int c = i & 2047, o = 2 * (128 * (c >> 8) + (c & 127)) + ((c >> 7) & 1);
            B1P[i] = IN(I_B1)[(size_t)(i & ~2047) + o]; }
        for (int m = gw; m < M; m += NGW) rms_row_to_bf16(ptid & 63, IN(I_X) + (size_t)m * DM, IN(I_MIXN), (bf16_t*)XN + (size_t)m * DM, nullptr);
    }
            }
#endif
    GRID_BAR();

#ifdef EXTRA_BARS
    for (int xb_ = 0; xb_ < EXTRA_BARS; ++xb_) GRID_BAR();
#endif
    for (int l = 0; l < DEPTH; ++l) {
        const int li = l >> 1;
        if (2 * l + 1 > stage_limit) break;
        if ((l & 1) == 0) {
#if (PHMASK >> 1) & 1
            _Pragma("unroll") for (int rep_ = 0; rep_ < NREP(1); ++rep_) { if (rep_) GRID_BAR();
            {   PHASE_BEGIN(); pg8::Gemm g{(const bf16_t*)XN, (const bf16_t*)(ws + WS_WEIN) + (size_t)li * EVEN_IN * DM, DM, DM, nullptr, nullptr}; pg8::StaticOrder S; S.init(M, EVEN_IN, Fp.G, bx_);
                pg8::EpiEvenIn E{Z, IN(I_EGQ) + li * 64, IN(I_EGK) + li * 64};
                pg8::gemm_phase<pg8::EpiEvenIn, pg8::StaticOrder>(Fp.lds + RING_OFF, g, S, E); }
            }
#endif
            GRID_BAR();
            {   PHASE_BEGIN();
#if (PHMASK >> 2) & 1
            _Pragma("unroll") for (int rep_ = 0; rep_ < NREP(2); ++rep_) { if (rep_) GRID_BAR();
                for (int u = Fp.vcu; u < 512; u += Fp.G)
                    gmlp_unit(Fp, Z, MIX, IN(I_EWS) + (size_t)li * 4 * 128 * 128, IN(I_EBS) + li * 512, IN(I_EGV) + li * 512, u);
            }
#endif
#if (PHMASK >> 3) & 1
            _Pragma("unroll") for (int rep_ = 0; rep_ < NREP(3); ++rep_) { if (rep_) GRID_BAR();
                for (int u = Fp.vcu; u < 256; u += Fp.G) { const int bh = u >> 4, s = u & 15, b = bh >> 3, h = bh & 7;
                    for (int pass = 0; pass < 2; ++pass) { const int qb = pass ? 31 - s : s;
                        const bf16_t* zb = Z + (size_t)b * SEQ * EVEN_IN;
                        dil::unit(zb + 1024 + 64 * h, zb + 1536 + 64 * h, zb + 2048 + 64 * h, EVEN_IN, MIX + (size_t)b * SEQ * DM + 512 + 64 * h, DM, qb * 256, Fp.lds + RING_OFF, (LAS float*)(Fp.lds + SCR_OFF)); } }
            }
#endif
            }
            GRID_BAR();
#if (PHMASK >> 4) & 1
            _Pragma("unroll") for (int rep_ = 0; rep_ < NREP(4); ++rep_) { if (rep_) GRID_BAR();
            {   PHASE_BEGIN(); pg8::Gemm g{MIX, (const bf16_t*)(ws + WS_WEOUT) + (size_t)li * DM * DM, DM, DM, nullptr, nullptr}; pg8::StaticOrder S; S.init(M, DM, Fp.G, bx_);
                pg8::EpiResid E{l == 0 ? IN(I_X) : nullptr, X16};
                pg8::gemm_phase<pg8::EpiResid, pg8::StaticOrder>(Fp.lds + RING_OFF, g, S, E); }
            }
#endif
            GRID_BAR();
        } else {
#if (PHMASK >> 5) & 1
            _Pragma("unroll") for (int rep_ = 0; rep_ < NREP(5); ++rep_) { if (rep_) GRID_BAR();
            {   PHASE_BEGIN(); pg8::Gemm g{(const bf16_t*)XN, (const bf16_t*)(ws + WS_WOIN + (size_t)li * ODD_INP * DM), DM / 2, DM / 2, nullptr, nullptr}; pg8::StaticOrder S; S.init(M, ODD_INP, Fp.G, bx_);
                pg8::EpiOddIn E{Z, ws + WS_Z8, SSQ};
                pg8::gemm_phase<pg8::EpiOddIn, pg8::StaticOrder, true>(Fp.lds + RING_OFF, g, S, E); }
            }
#endif
            GRID_BAR();
#if (PHMASK >> 6) & 1
            _Pragma("unroll") for (int rep_ = 0; rep_ < NREP(6); ++rep_) { if (rep_) GRID_BAR();
            {   PHASE_BEGIN(); pg8::Gemm g{(const bf16_t*)(ws + WS_Z8 + 512), (const bf16_t*)(ws + WS_WUKV + (size_t)li * 2048 * 256), ODD_INP / 2, 128, nullptr, nullptr}; pg8::StaticOrder S; S.init(M, 2048, Fp.G, bx_);
                pg8::EpiRowScale<1> E{KVR, 2048, SSQ, 8, 1.0f / 256.0f};
                pg8::gemm_phase<pg8::EpiRowScale<1>, pg8::StaticOrder, true>(Fp.lds + RING_OFF, g, S, E); }
            {   PHASE_BEGIN(); pg8::Gemm g{(const bf16_t*)(ws + WS_Z8), (const bf16_t*)(ws + WS_WUQ + (size_t)li * 1536 * 512), ODD_INP / 2, 256, nullptr, nullptr}; pg8::StaticOrder S; S.init(M, 1536, Fp.G, bx_);
                pg8::EpiRowScale<2> E{QR, 1536, SSQ, 0, 1.0f / 512.0f};
                pg8::gemm_phase<pg8::EpiRowScale<2>, pg8::StaticOrder, true>(Fp.lds + RING_OFF, g, S, E); }
            }
#endif
            GRID_BAR();
#if (PHMASK >> 7) & 1
            _Pragma("unroll") for (int rep_ = 0; rep_ < NREP(7); ++rep_) { if (rep_) GRID_BAR();
            {   PHASE_BEGIN(); mla_finalize_phase(Fp, QR, KVR, Z, IN(I_OGQ) + li * 192, IN(I_OGK) + li * 192, QF, KF); vt_phase(Fp, KVR, ws + WS_VT); }
            }
#endif
            GRID_BAR();
#if (PHMASK >> 8) & 1
            _Pragma("unroll") for (int rep_ = 0; rep_ < NREP(8); ++rep_) { if (rep_) GRID_BAR();
            {   PHASE_BEGIN();
                for (int u = Fp.vcu; u < 256; u += Fp.G) { const int bh = u >> 4, s = u & 15, b = bh >> 3, h = bh & 7;
                    for (int pass = 0; pass < 2; ++pass) { const int qb = pass ? 31 - s : s;
                        mla::unit(QF + (size_t)b * SEQ * 1536 + 192 * h, KF + (size_t)b * SEQ * 1536 + 192 * h, 1536, ws + WS_VT + ((size_t)(b * 8 + h) * 128) * SEQ,
                                  ws + WS_MIX8 + (size_t)b * SEQ * DM + 128 * h, DM, qb * 256, Fp.lds + RING_OFF); } }
            }
            }
#endif
            GRID_BAR();
#if (PHMASK >> 9) & 1
            _Pragma("unroll") for (int rep_ = 0; rep_ < NREP(9); ++rep_) { if (rep_) GRID_BAR();
            {   PHASE_BEGIN(); pg8::Gemm g{(const bf16_t*)(ws + WS_MIX8), (const bf16_t*)(ws + WS_WOOUT + (size_t)li * DM * DM), DM / 2, DM / 2, nullptr, nullptr}; pg8::StaticOrder S; S.init(M, DM, Fp.G, bx_);
                pg8::EpiResidT<true> E{nullptr, X16};
                pg8::gemm_phase<pg8::EpiResidT<true>, pg8::StaticOrder, true>(Fp.lds + RING_OFF, g, S, E); }
            }
#endif
            GRID_BAR();
        }
        if (2 * l + 2 > stage_limit) break;
#if (PHMASK >> 10) & 1
            _Pragma("unroll") for (int rep_ = 0; rep_ < NREP(10); ++rep_) {
        {   PHASE_BEGIN(); const bool dry = rep_ + 1 < NREP(10);
            gu32* cnt = (gu32*)(ws + WS_CTL) + CW_CNT + (size_t)(dry ? 8 + 4 * rep_ + l : l) * 32 * 64;
        router_phase(Fp, X16, IN(I_FFNN) + l * DM, IN(I_RW) + (size_t)l * DM * NE, IN(I_RB) + l * NE, cnt, dry ? (unsigned*)(ws + WS_QR) : TOKER, dry ? (float*)(ws + WS_QR + MiB) : TOKG, dry ? ACT : XG); }
        GRID_BAR();
            }
#endif
        LAS int* tbl = (LAS int*)(F.lds + SCR_OFF + 12288);
        {   PHASE_BEGIN(); gu32* cnt = (gu32*)(ws + WS_CTL) + CW_CNT + (size_t)l * 32 * 64;
        if (threadIdx.x == 0) { int acc = 0; for (int e = 0; e < NE; ++e) { tbl[e] = acc; const unsigned c = __hip_atomic_load(cnt + 64 * e, RLX_AGENT); acc += (int)((c + 255u) >> 8); } tbl[NE] = acc; }
        __syncthreads(); }
#if (PHMASK >> 11) & 1
            _Pragma("unroll") for (int rep_ = 0; rep_ < NREP(11); ++rep_) { if (rep_) GRID_BAR();
        {   PHASE_BEGIN();
            pg8::Gemm g{(const bf16_t*)XG, (const bf16_t*)(ws + WS_W1 + (size_t)l * NE * 2 * DE * DM), DM / 2, DM / 2, (const bf16_t*)ACT, (const bf16_t*)(ws + WS_W2 + (size_t)l * NE * DM * DE)};
            pg8::MoeMergedOrder S{tbl, Fp.G, Fp.vcu, (gu32*)(ws + WS_CTL) + CW_MOE + (size_t)(l * 320 + 1280 * rep_) * 16, -1};
            pg8::EpiMoe E{{ACT, B1P + (size_t)l * NE * 2048}, {YB, IN(I_B2) + (size_t)l * NE * DM}};
            pg8::gemm_phase<pg8::EpiMoe, pg8::MoeMergedOrder, true>(Fp.lds + RING_OFF, g, S, E); }
            }
#endif
        GRID_BAR();
#if (PHMASK >> 13) & 1
            _Pragma("unroll") for (int rep_ = 0; rep_ < NREP(13); ++rep_) {
        {   PHASE_BEGIN(); const bool dry = rep_ + 1 < NREP(13);
            combine_phase(Fp, dry ? (bf16_t*)(ACT + (size_t)128 * MiB) : X16, (!dry && l + 1 == DEPTH) ? args.out : nullptr, TOKER, TOKG, YB, (l + 1 < DEPTH) ? IN(I_MIXN) + (l + 1) * DM : nullptr, dry ? (ACT + (size_t)64 * MiB) : XN, (l & 1) == 0); }
        GRID_BAR();
            }
#endif
    }
#undef GRID_BAR
}

extern "C" void kernel_launch(void* const* d_in, const int* in_sizes, int n_in, void* d_out, int out_size, void* d_ws, size_t ws_size, hipStream_t stream) {
    static int grid = 0;
    if (grid == 0) {
        if (n_in != 24 || in_sizes[0] != M * DM || out_size != M * DM || ws_size < WS_END) {
            fprintf(stderr, "kernel_launch: unexpected shapes (n_in %d, in0 %d, out %d, ws %zu, need %zu)\n", n_in, n_in > 0 ? in_sizes[0] : -1, out_size, ws_size, (size_t)WS_END); grid = -1; return; }
        int dev = 0, cus = 0, per_cu = 0;
        if (hipGetDevice(&dev) != hipSuccess || hipDeviceGetAttribute(&cus, hipDeviceAttributeMultiprocessorCount, dev) != hipSuccess) { grid = -1; return; }
        if (hipFuncSetAttribute((const void*)trunk_fwd, hipFuncAttributeMaxDynamicSharedMemorySize, LDS_BYTES) != hipSuccess) { fprintf(stderr, "kernel_launch: hipFuncSetAttribute failed\n"); grid = -1; return; }
        if (hipOccupancyMaxActiveBlocksPerMultiprocessor(&per_cu, (const void*)trunk_fwd, NWAVES * 64, LDS_BYTES) != hipSuccess || per_cu < 1)
            fprintf(stderr, "kernel_launch: occupancy query reports %d workgroups per CU\n", per_cu);
        (void)hipGetLastError();
        if (cus < 256) { fprintf(stderr, "kernel_launch: needs 256 CUs, device has %d\n", cus); grid = -1; return; }
        grid = 256;
    }
    if (grid < 0) return;
    if (hipMemsetAsync((char*)d_ws + WS_CTL, 0, CTL_ZERO_BYTES, stream) != hipSuccess) return;
    Args a{};
    for (int i = 0; i < 24; ++i) a.in[i] = (const float*)d_in[i];
    a.out = (float*)d_out; a.ws = (unsigned char*)d_ws; a.stage_limit = STAGE_LIMIT; a.pad = 0;
    hipLaunchKernelGGL(trunk_fwd, dim3(grid), dim3(NWAVES * 64), LDS_BYTES, stream, a);
}
```

```cpp
#include <hip/hip_runtime.h>
#include <hip/hip_bf16.h>
#include <cstdio>
#include <cstdint>

#define LAS __attribute__((address_space(3)))
#define GAS __attribute__((address_space(1)))
typedef unsigned short bf16_t;
typedef short bf16x8 __attribute__((ext_vector_type(8)));
typedef short s16x4 __attribute__((ext_vector_type(4)));
typedef float f32x2 __attribute__((ext_vector_type(2)));
typedef float f32x4 __attribute__((ext_vector_type(4)));
typedef float f32x16 __attribute__((ext_vector_type(16)));
typedef unsigned u32x2 __attribute__((ext_vector_type(2)));
typedef unsigned u32x4 __attribute__((ext_vector_type(4)));
typedef int i32x4 __attribute__((ext_vector_type(4)));
typedef int i32x8 __attribute__((ext_vector_type(8)));

constexpr int BATCH = 2, SEQ = 8192, DM = 1024, M = BATCH * SEQ, DEPTH = 4;
constexpr int EVEN_IN = 2560, ODD_IN = 832, ODD_INP = 1024;
constexpr int NE = 32, DE = 1024, ECAP = 16384;
constexpr float EPS = 1e-6f;
constexpr float LOG2E = 1.4426950408889634f;
constexpr float C2_B = 0.125f * LOG2E;
constexpr float C2_C = 0.07216878364870322f * LOG2E;

__device__ __forceinline__ unsigned cvt_pk_bf16(float lo, float hi) { unsigned r; asm volatile("v_cvt_pk_bf16_f32 %0, %1, %2" : "=v"(r) : "v"(lo), "v"(hi)); return r; }
__device__ __forceinline__ float bf2f(bf16_t v) { return __uint_as_float(((unsigned)v) << 16); }
__device__ __forceinline__ float bflo(unsigned w) { return __uint_as_float(w << 16); }
__device__ __forceinline__ float bfhi(unsigned w) { return __uint_as_float(w & 0xffff0000u); }
__device__ __forceinline__ bf16_t f2bf(float f) { return (bf16_t)(cvt_pk_bf16(f, 0.f) & 0xffffu); }

__device__ __forceinline__ unsigned pk4_fp8(float a, float b, float c, float d) { int w = 0; w = __builtin_amdgcn_cvt_pk_fp8_f32(a, b, w, false); w = __builtin_amdgcn_cvt_pk_fp8_f32(c, d, w, true); return (unsigned)w; }
constexpr float W8_SCALE = 64.0f, W8_INV = 1.0f / 64.0f;

namespace pg8 {
constexpr int BM = 256, BK = 64, HALF = 128, HTB = HALF * BK * 2, STAGE_BYTES = 8 * HTB, NXCD = 8, WGM = 8;
__host__ __device__ __forceinline__ int lds_byte(int r, int c) { const int st = (r >> 4) * 2 + (c >> 5), rr = r & 15, cc = c & 31, ob = rr * 64 + cc * 2; return st * 1024 + (ob ^ (((ob >> 9) & 1) << 5)); }
__host__ __device__ __forceinline__ void stage_rc(int b, int& R, int& C) { const int st = b / 1024, sb = b % 1024, swz = sb ^ (((sb >> 9) & 1) << 5); R = (st >> 1) * 16 + swz / 64; C = (st & 1) * 32 + (swz % 64) / 2; }
__host__ __device__ __forceinline__ int perm32(int rho) { const int n = rho >> 4, i = rho & 15; return 8 * (i >> 2) + 4 * n + (i & 3); }

struct Unit { int pm, pn, pb, kind, rb; };
struct Gemm { const bf16_t* A; const bf16_t* Bt; int lda, K; const bf16_t* A2; const bf16_t* Bt2; };

struct StaticOrder {
    int nM, nN, nwg, G, c;
    __device__ void init(int M_, int N_, int G_, int c_) { nM = M_ / BM; nN = N_ / BM; nwg = nM * nN; G = G_; c = c_; }
    __device__ bool next(int i, Unit& u) const {
        const long L = (long)i * G + c; if (L >= nwg) return false;
        int wgid = (int)L; { const int q = nwg / NXCD, r = nwg % NXCD, xcd = wgid % NXCD, off = wgid / NXCD; wgid = (xcd < r ? xcd * (q + 1) : r * (q + 1) + (xcd - r) * q) + off; }
        const int nig = WGM * nN, gid = wgid / nig, fm = gid * WGM, gsz = (nM - fm) < WGM ? (nM - fm) : WGM;
        u.pm = fm + ((wgid % nig) % gsz); u.pn = (wgid % nig) / gsz; u.pb = u.pn; u.kind = 0; u.rb = 0; return true;
    }
    __device__ __forceinline__ void a_ready(const Unit&) const {}
    __device__ __forceinline__ void pre_epi() const {}
    __device__ __forceinline__ void done(const Unit&) const {}
    __device__ __forceinline__ void finish() const {}
};

__device__ __forceinline__ f32x2 gelu_pk(f32x2 v) {
    const f32x2 av = __builtin_elementwise_abs(v), d = av * 0.2316418882f + 1.0f;
    f32x2 t; t.x = __builtin_amdgcn_rcpf(d.x); t.y = __builtin_amdgcn_rcpf(d.y);
    f32x2 q = t * 0.5307027145f + (-0.7265760135f); q = q * t + 0.7107068705f; q = q * t + (-0.142248368f); q = q * t + 0.127414796f; q = q * t;
    const f32x2 s = (v * v) * (-0.72134752044f);
    f32x2 e; e.x = __builtin_amdgcn_exp2f(s.x); e.y = __builtin_amdgcn_exp2f(s.y);
    const f32x2 m = v * (q * e), r = v - m;
    f32x2 o; o.x = v.x < 0.f ? m.x : r.x; o.y = v.y < 0.f ? m.y : r.y; return o;
}
__device__ __forceinline__ f32x4 gelu4(f32x4 v) { const f32x2 a = gelu_pk((f32x2){v[0], v[1]}), b = gelu_pk((f32x2){v[2], v[3]}); return (f32x4){a.x, a.y, b.x, b.y}; }

template <class Epi, class Sched, bool FP8 = false>
__device__ __forceinline__ void gemm_phase(LAS unsigned char* lds, const Gemm g, const Sched& S, const Epi& E) {
    int tid_ = threadIdx.x; asm volatile("" : "+v"(tid_));
    const int tid = tid_, wid = __builtin_amdgcn_readfirstlane(tid >> 6), lane = tid & 63, wr = wid >> 2, wc = wid & 3, fr = lane & 15, fq = lane >> 4;
    const int K = g.K, nt = K / BK;
    unsigned voffA[2], voffB[2];
#pragma unroll
    for (int i = 0; i < 2; ++i) { int R, C; stage_rc(tid * 16 + i * 8192, R, C); const int Rb = Epi::PERM ? ((R & ~31) + perm32(R & 31)) : R;
        voffA[i] = (unsigned)(R * g.lda + C) * 2u; voffB[i] = (unsigned)(Rb * K + C) * 2u; }
    const size_t kstep = (size_t)(BK * 2);
    const size_t hstepA = (size_t)HALF * g.lda * 2, tstepA = 2 * hstepA;
    const size_t hstepB = (size_t)HALF * K * 2, tstepB = 2 * hstepB;
    const unsigned ldsw = (unsigned)wid * 1024u;
    const int aoff = lds_byte(wr * 64 + fr, fq * 8), boff = lds_byte(wc * 32 + fr, fq * 8);
#define PG8_SA(b, h) (((b) * 2 + (h)) * HTB)
#define PG8_SB(b, h) ((4 + (b) * 2 + (h)) * HTB)
#define PG8_STAGE(bufoff, gbase, voff) do { _Pragma("unroll") for (int _i = 0; _i < 2; ++_i) \
        __builtin_amdgcn_global_load_lds((const unsigned*)((const char*)(gbase) + (voff)[_i]), (LAS unsigned*)(lds + (bufoff) + ldsw + _i * 8192), 16, 0, 0); } while (0)
#define PG8_LDA(dst, b, h) do { _Pragma("unroll") for (int m = 0; m < 4; ++m) { if constexpr (FP8) { const i32x4 lo_ = *(const LAS i32x4*)(lds + PG8_SA(b, h) + aoff + m * 2048), hi_ = *(const LAS i32x4*)(lds + PG8_SA(b, h) + aoff + m * 2048 + 1024); dst##8[m] = __builtin_shufflevector(lo_, hi_, 0, 1, 2, 3, 4, 5, 6, 7); } \
        else { _Pragma("unroll") for (int k = 0; k < 2; ++k) dst[m][k] = *(const LAS bf16x8*)(lds + PG8_SA(b, h) + aoff + m * 2048 + k * 1024); } } } while (0)
#define PG8_LDB(dst, b, h) do { _Pragma("unroll") for (int n = 0; n < 2; ++n) { if constexpr (FP8) { const i32x4 lo_ = *(const LAS i32x4*)(lds + PG8_SB(b, h) + boff + n * 2048), hi_ = *(const LAS i32x4*)(lds + PG8_SB(b, h) + boff + n * 2048 + 1024); dst##8[n] = __builtin_shufflevector(lo_, hi_, 0, 1, 2, 3, 4, 5, 6, 7); } \
        else { _Pragma("unroll") for (int k = 0; k < 2; ++k) dst[n][k] = *(const LAS bf16x8*)(lds + PG8_SB(b, h) + boff + n * 2048 + k * 1024); } } } while (0)
#define PG8_MMA(ai, bj, At, Bt) do { __builtin_amdgcn_s_setprio(1); _Pragma("unroll") for (int m = 0; m < 4; ++m) _Pragma("unroll") for (int n = 0; n < 2; ++n) { \
        if constexpr (FP8) asm volatile("s_nop 1\n\tv_mfma_f32_16x16x128_f8f6f4 %0, %1, %2, %0" : "+v"(acc[ai][bj][m][n]) : "v"(Bt##8[n]), "v"(At##8[m])); \
        else { _Pragma("unroll") for (int k = 0; k < 2; ++k) acc[ai][bj][m][n] = __builtin_amdgcn_mfma_f32_16x16x32_bf16(Bt[n][k], At[m][k], acc[ai][bj][m][n], 0, 0, 0); } } \
        __builtin_amdgcn_s_setprio(0); } while (0)
#define PG8_WAIT_V(n) asm volatile("s_waitcnt vmcnt(" #n ")" ::: "memory")
#define PG8_WAIT_L(n) asm volatile("s_waitcnt lgkmcnt(" #n ")" ::: "memory")
#define PG8_BAR __builtin_amdgcn_s_barrier()
#define PG8_SCHED __builtin_amdgcn_sched_barrier(0)
    Unit cur, nxt; int ui = 0;
    if (!S.next(0, cur)) return;
    f32x4 acc[2][2][4][2];
#pragma unroll
    for (int a = 0; a < 2; ++a)
#pragma unroll
        for (int b = 0; b < 2; ++b)
#pragma unroll
            for (int m = 0; m < 4; ++m)
#pragma unroll
                for (int n = 0; n < 2; ++n) acc[a][b][m][n] = (f32x4){0.f, 0.f, 0.f, 0.f};
    bf16x8 At[4][2], B0[2][2], B1[2][2]; i32x8 At8[4], B08[2], B18[2];
    const char* cA = (const char*)(cur.kind ? g.A2 : g.A) + (size_t)cur.pm * tstepA; const char* cB = (const char*)(cur.kind ? g.Bt2 : g.Bt) + (size_t)cur.pb * tstepB;
    S.a_ready(cur);
    PG8_STAGE(PG8_SB(0, 0), cB, voffB); PG8_STAGE(PG8_SB(0, 1), cB + hstepB, voffB); PG8_STAGE(PG8_SA(0, 0), cA, voffA); PG8_STAGE(PG8_SA(0, 1), cA + hstepA, voffA);
    if (wr == 1) PG8_BAR;
    PG8_WAIT_V(2); PG8_BAR;
    PG8_STAGE(PG8_SB(1, 0), cB + kstep, voffB); PG8_STAGE(PG8_SA(1, 0), cA + kstep, voffA); PG8_STAGE(PG8_SB(1, 1), cB + hstepB + kstep, voffB);
    PG8_WAIT_V(6); PG8_BAR;
    for (;;) {
        const bool has_next = S.next(ui + 1, nxt);
        const char* nA = has_next ? (const char*)(nxt.kind ? g.A2 : g.A) + (size_t)nxt.pm * tstepA : cA; const char* nB = has_next ? (const char*)(nxt.kind ? g.Bt2 : g.Bt) + (size_t)nxt.pb * tstepB : cB;
#pragma unroll 1
        for (int t = 0; t < nt; t += 2) {
            const bool last = (t == nt - 2);
            const char* a1 = cA + (size_t)(t + 1) * kstep;
            const char* a2 = last ? nA : cA + (size_t)(t + 2) * kstep; const char* b2 = last ? nB : cB + (size_t)(t + 2) * kstep;
            const char* a3 = a2 + kstep; const char* b3 = b2 + kstep;
            if (last && has_next) S.a_ready(nxt);
            PG8_LDB(B0, 0, 0); PG8_LDB(B1, 0, 1); PG8_SCHED; PG8_LDA(At, 0, 0); PG8_STAGE(PG8_SA(1, 1), a1 + hstepA, voffA);
            PG8_WAIT_V(8); PG8_WAIT_L(0); PG8_BAR; PG8_MMA(0, 0, At, B0); PG8_MMA(0, 1, At, B1); PG8_BAR; PG8_SCHED;
            PG8_LDA(At, 0, 1); PG8_STAGE(PG8_SB(0, 0), b2, voffB); PG8_STAGE(PG8_SB(0, 1), b2 + hstepB, voffB); PG8_STAGE(PG8_SA(0, 0), a2, voffA);
            PG8_WAIT_V(8); PG8_WAIT_L(0); PG8_BAR; PG8_MMA(1, 0, At, B0); PG8_MMA(1, 1, At, B1); PG8_BAR; PG8_SCHED;
            PG8_LDB(B0, 1, 0); PG8_LDB(B1, 1, 1); PG8_SCHED; PG8_LDA(At, 1, 0); PG8_STAGE(PG8_SA(0, 1), a2 + hstepA, voffA);
            PG8_WAIT_V(8); PG8_WAIT_L(0); PG8_BAR; PG8_MMA(0, 0, At, B0); PG8_MMA(0, 1, At, B1); PG8_BAR; PG8_SCHED;
            PG8_LDA(At, 1, 1); PG8_STAGE(PG8_SB(1, 0), b3, voffB); PG8_STAGE(PG8_SB(1, 1), b3 + hstepB, voffB); PG8_STAGE(PG8_SA(1, 0), a3, voffA);
            PG8_WAIT_V(8); PG8_WAIT_L(0); PG8_BAR; PG8_MMA(1, 0, At, B0); PG8_MMA(1, 1, At, B1); PG8_BAR; PG8_SCHED;
        }
        if (wr == 0) PG8_BAR;
        if constexpr (FP8) asm volatile("s_nop 15\n\ts_nop 7" ::: "memory");
        S.pre_epi();
        { int te_ = threadIdx.x; asm volatile("" : "+v"(te_));
          E(acc, cur, wr, wc, te_ & 15, (te_ & 63) >> 4); }
        S.done(cur);
        if (!has_next) break;
#pragma unroll
        for (int a = 0; a < 2; ++a)
#pragma unroll
            for (int b = 0; b < 2; ++b)
#pragma unroll
                for (int m = 0; m < 4; ++m)
#pragma unroll
                    for (int n = 0; n < 2; ++n) acc[a][b][m][n] = (f32x4){0.f, 0.f, 0.f, 0.f};
        cur = nxt; cA = nA; cB = nB; ++ui;
        if (wr == 1) PG8_BAR;
    }
    PG8_WAIT_V(0);
    S.finish();
    PG8_BAR;
#undef PG8_SA
#undef PG8_SB
#undef PG8_STAGE
#undef PG8_LDA
#undef PG8_LDB
#undef PG8_MMA
#undef PG8_WAIT_V
#undef PG8_WAIT_L
#undef PG8_BAR
#undef PG8_SCHED
}
}
constexpr int STAGE_LIMIT = 8;

namespace att {
__device__ __forceinline__ int crow(int r, int hi) { return (r & 3) + 8 * (r >> 2) + 4 * hi; }
__device__ __forceinline__ int v_rd_base(int lane) { return ((lane & 3) << 3) | (((lane >> 2) & 3) << 6) | (((lane >> 4) & 1) << 5) | (((lane >> 5) & 1) << 8); }
}

namespace dil {
using att::crow; using att::v_rd_base;
constexpr int OFF_O = 0, OFF_V = 65536, VWAVE = 8192;
template <int S_>
__device__ __forceinline__ void pass(const bf16_t* __restrict__ Qh, const bf16_t* __restrict__ Kh, const bf16_t* __restrict__ Vh, int pitch, int q0, LAS unsigned char* lds, LAS float* scr, int wid, int lane) {
    const int r32 = lane & 31, hi = lane >> 5;
    LAS float* Oacc = (LAS float*)(lds + OFF_O); LAS float* macc = scr; LAS float* lacc = scr + 256; LAS float* wsf = scr + 512 + wid * 64;
    LAS unsigned char* vbuf = lds + OFF_V + wid * VWAVE;
    constexpr int NG = (S_ == 16) ? 2 : 1, VR = (S_ == 16) ? 16 : 32;
    int vk[4], vc[4];
#pragma unroll
    for (int i = 0; i < 4; ++i) { const int off = (i * 64 + lane) * 16, st = off >> 9, within = off & 511, kk = (st >> 1) * 8 + (within >> 6);
        vk[i] = (kk & ~0xC) | ((kk & 4) << 1) | ((kk & 8) >> 1); vc[i] = (st & 1) * 32 + ((within & 63) >> 1); }
    const unsigned vb0 = (unsigned)(uintptr_t)vbuf + (unsigned)v_rd_base(lane);
#pragma unroll
    for (int gi = 0; gi < NG; ++gi) {
        const int rho = (S_ == 1) ? 0 : (S_ == 4) ? (wid & 3) : (2 * wid + gi);
        const int i0 = (S_ == 1) ? 32 * wid : (S_ == 4) ? 32 * (wid >> 2) : 0;
        const int qi = i0 + (r32 < VR ? r32 : r32 - VR);
        const int ql = rho + S_ * qi;
        bf16x8 qr[4];
#pragma unroll
        for (int d0 = 0; d0 < 4; ++d0) qr[d0] = *(const bf16x8*)(Qh + (size_t)(q0 + ql) * pitch + d0 * 16 + hi * 8);
        const int j0 = i0 - 128;
        const int tokb = q0 + rho + S_ * j0;
        bf16x8 kfA[4], kfB[4];
#define DIL_KLOAD(dst, c) do { int tk_ = tokb + S_ * (32 * (c) + r32); tk_ = tk_ < 0 ? 0 : (tk_ > SEQ - 1 ? SEQ - 1 : tk_);     \
            _Pragma("unroll") for (int d0 = 0; d0 < 4; ++d0) dst[d0] = *(const bf16x8*)(Kh + (size_t)tk_ * pitch + d0 * 16 + hi * 8); } while (0)
#define DIL_VDMA(c, bf) do { _Pragma("unroll") for (int i = 0; i < 4; ++i) { int tk_ = tokb + S_ * (32 * (c) + vk[i]); tk_ = tk_ < 0 ? 0 : (tk_ > SEQ - 1 ? SEQ - 1 : tk_); \
            __builtin_amdgcn_global_load_lds((const unsigned*)(Vh + (size_t)tk_ * pitch + vc[i]), (LAS unsigned*)(vbuf + (bf) * 4096 + i * 1024), 16, 0, 0); } } while (0)
        float m_reg = -1e30f, l_reg = 0.f; f32x16 o[2]; o[0] = f32x16{}; o[1] = f32x16{};
        DIL_KLOAD(kfA, 0); DIL_VDMA(0, 0);
#define DIL_STEP(KF, KN, c) do { \
            if ((c) < 4) { DIL_KLOAD(KN, (c) + 1); DIL_VDMA((c) + 1, ((c) + 1) & 1); asm volatile("s_waitcnt vmcnt(8)" ::: "memory"); } \
            else { asm volatile("s_waitcnt vmcnt(0)" ::: "memory"); } \
            f32x16 p = f32x16{}; \
            _Pragma("unroll") for (int d0 = 0; d0 < 4; ++d0) p = __builtin_amdgcn_mfma_f32_32x32x16_bf16(KF[d0], qr[d0], p, 0, 0, 0); \
            const unsigned vb = vb0 + (unsigned)(((c) & 1) * 4096); \
            s16x4 vl0[2], vh0[2], vl1[2], vh1[2]; \
            _Pragma("unroll") for (int d0 = 0; d0 < 2; ++d0) { \
                asm volatile("ds_read_b64_tr_b16 %0, %1 offset:%2" : "=&v"(vl0[d0]) : "v"(vb), "i"(d0 * 512) : "memory"); \
                asm volatile("ds_read_b64_tr_b16 %0, %1 offset:%2" : "=&v"(vh0[d0]) : "v"(vb), "i"(d0 * 512 + 1024) : "memory"); \
                asm volatile("ds_read_b64_tr_b16 %0, %1 offset:%2" : "=&v"(vl1[d0]) : "v"(vb), "i"(d0 * 512 + 2048) : "memory"); \
                asm volatile("ds_read_b64_tr_b16 %0, %1 offset:%2" : "=&v"(vh1[d0]) : "v"(vb), "i"(d0 * 512 + 3072) : "memory"); } \
              \
            { const float NEG = -__builtin_inff(); const int db = qi - j0 - 32 * (c) - 4 * hi; const int tb = tokb + S_ * (32 * (c) + 4 * hi); \
              if ((c) == 0 || (c) == 4 || tokb < 0) { \
                _Pragma("unroll") for (int r = 0; r < 16; ++r) { const int cr = (r & 3) + 8 * (r >> 2); \
                    const bool ok = ((unsigned)(db - cr) <= 128u) && (tb + S_ * cr >= 0); p[r] = ok ? p[r] : NEG; } } } \
            float pmax = p[0]; \
            _Pragma("unroll") for (int r = 1; r < 16; ++r) pmax = fmaxf(pmax, p[r]); \
            { auto rr = __builtin_amdgcn_permlane32_swap(__float_as_uint(pmax), __float_as_uint(pmax), false, false); pmax = fmaxf(__uint_as_float(rr[0]), __uint_as_float(rr[1])); } \
            const float mn = fmaxf(m_reg, pmax); const float alpha = __builtin_amdgcn_exp2f(m_reg - mn); m_reg = mn; \
            float ps = 0.f; \
            _Pragma("unroll") for (int r = 0; r < 16; ++r) { p[r] = __builtin_amdgcn_exp2f(p[r] - mn); ps += p[r]; } \
            { auto rr = __builtin_amdgcn_permlane32_swap(__float_as_uint(ps), __float_as_uint(ps), false, false); ps = __uint_as_float(rr[0]) + __uint_as_float(rr[1]); } \
            l_reg = l_reg * alpha + ps; \
            bf16x8 pa0, pa1; DIL_PK4(p, 0, pa0); DIL_PK4(p, 8, pa1); \
            if (__any(alpha < 1.f)) { if (hi == 0) wsf[r32] = alpha; asm volatile("s_waitcnt lgkmcnt(0)" ::: "memory"); \
                _Pragma("unroll") for (int r = 0; r < 16; ++r) { const float a = wsf[crow(r, hi)]; o[0][r] *= a; o[1][r] *= a; } } \
            asm volatile("s_waitcnt lgkmcnt(0)" ::: "memory"); __builtin_amdgcn_sched_barrier(0); \
            _Pragma("unroll") for (int d0 = 0; d0 < 2; ++d0) { \
                o[d0] = __builtin_amdgcn_mfma_f32_32x32x16_bf16(pa0, (bf16x8){vl0[d0][0], vl0[d0][1], vl0[d0][2], vl0[d0][3], vh0[d0][0], vh0[d0][1], vh0[d0][2], vh0[d0][3]}, o[d0], 0, 0, 0); \
                o[d0] = __builtin_amdgcn_mfma_f32_32x32x16_bf16(pa1, (bf16x8){vl1[d0][0], vl1[d0][1], vl1[d0][2], vl1[d0][3], vh1[d0][0], vh1[d0][1], vh1[d0][2], vh1[d0][3]}, o[d0], 0, 0, 0); } \
        } while (0)
#define DIL_PK4(P, B_, OUT) do { unsigned a0 = cvt_pk_bf16(P[B_+0], P[B_+1]), a1 = cvt_pk_bf16(P[B_+2], P[B_+3]);                          \
            unsigned b0_ = cvt_pk_bf16(P[B_+4], P[B_+5]), b1_ = cvt_pk_bf16(P[B_+6], P[B_+7]);                                             \
            auto r0 = __builtin_amdgcn_permlane32_swap(a0, b0_, false, false); auto r1 = __builtin_amdgcn_permlane32_swap(a1, b1_, false, false); \
            u32x4 w = {r0[0], r1[0], r0[1], r1[1]}; OUT = __builtin_bit_cast(bf16x8, w); } while (0)
        DIL_STEP(kfA, kfB, 0); DIL_STEP(kfB, kfA, 1); DIL_STEP(kfA, kfB, 2); DIL_STEP(kfB, kfA, 3); DIL_STEP(kfA, kfB, 4);
#undef DIL_STEP
#undef DIL_PK4
#undef DIL_KLOAD
#undef DIL_VDMA
        float fo = 0.f, fc = 1.f;
        if (S_ != 1) { const float mo = macc[ql], lo = lacc[ql]; const float mnew = fmaxf(mo, m_reg); fo = __builtin_amdgcn_exp2f(mo - mnew); fc = __builtin_amdgcn_exp2f(m_reg - mnew);
            l_reg = lo * fo + l_reg * fc; m_reg = mnew; }
        if (hi == 0 && r32 < VR) { macc[ql] = m_reg; lacc[ql] = l_reg; wsf[r32] = fo; wsf[32 + r32] = fc; }
        asm volatile("s_waitcnt lgkmcnt(0)" ::: "memory");
#pragma unroll
        for (int r = 0; r < 16; ++r) { const int row = crow(r, hi);
            if (row < VR) { const int qrow = rho + S_ * (i0 + row); LAS float* op = Oacc + qrow * 64 + r32;
                if (S_ == 1) { op[0] = o[0][r]; op[32] = o[1][r]; }
                else { const float a = wsf[row], b = wsf[32 + row]; op[0] = op[0] * a + o[0][r] * b; op[32] = op[32] * a + o[1][r] * b; } } }
        asm volatile("s_waitcnt lgkmcnt(0)" ::: "memory");
    }
}
__device__ __forceinline__ void unit(const bf16_t* Qh, const bf16_t* Kh, const bf16_t* Vh, int pitch, bf16_t* Oh, int op, int q0, LAS unsigned char* lds, LAS float* scr) {
    int tid_ = threadIdx.x; asm volatile("" : "+v"(tid_));
    const int tid = tid_, wid = __builtin_amdgcn_readfirstlane(tid >> 6), lane = tid & 63;
    pass<1>(Qh, Kh, Vh, pitch, q0, lds, scr, wid, lane);
    __syncthreads();
    pass<4>(Qh, Kh, Vh, pitch, q0, lds, scr, wid, lane);
    __syncthreads();
    pass<16>(Qh, Kh, Vh, pitch, q0, lds, scr, wid, lane);
    __syncthreads();
    {   const int q = tid >> 1, hf = tid & 1; const LAS f32x4* src = (const LAS f32x4*)(lds + OFF_O + (q * 64 + 32 * hf) * 4); const float rl = 1.0f / scr[256 + q];
        bf16_t* dst = Oh + (size_t)(q0 + q) * op + 32 * hf;
#pragma unroll
        for (int i = 0; i < 4; ++i) { const f32x4 a = src[2 * i] * rl, b = src[2 * i + 1] * rl;
            u32x4 w; w.x = cvt_pk_bf16(a[0], a[1]); w.y = cvt_pk_bf16(a[2], a[3]); w.z = cvt_pk_bf16(b[0], b[1]); w.w = cvt_pk_bf16(b[2], b[3]); *(u32x4*)(dst + 8 * i) = w; } }
    __syncthreads();
}
}

namespace mla {
using att::crow;
constexpr int DQ = 192, DV_ = 128;
constexpr int KB = 64 * DQ;
constexpr int VB = DV_ * 64;
constexpr int NBUF = 3;
constexpr int OFF_K = 0, OFF_V = NBUF * KB, OFF_WS = NBUF * (KB + VB), BYTES = OFF_WS + 8 * 256;
constexpr int NKP = KB / 1024, KPW = (NKP + 7) / 8;
constexpr int NVP = VB / 1024;
static_assert(BYTES <= 131072 && NKP == 12 && NVP == 8, "mla LDS image");
constexpr float PSHIFT = 8.0f;

__device__ __forceinline__ void unit(const unsigned char* __restrict__ Qh, const unsigned char* __restrict__ Kh, int pitch, const unsigned char* __restrict__ VTh  ,
                                     unsigned char* __restrict__ Oh, int op, int q0, LAS unsigned char* lds) {
    int tid_ = threadIdx.x; asm volatile("" : "+v"(tid_));
    const int tid = tid_, wid = __builtin_amdgcn_readfirstlane(tid >> 6), lane = tid & 63, r32 = lane & 31, hi = lane >> 5;
    const int qlo = q0 + wid * 32, qpos = qlo + r32;
    LAS float* wsf = (LAS float*)(lds + OFF_WS) + wid * 64;
    const int NT = (q0 + 256) / 64;
    unsigned kso[KPW], vso;
#pragma unroll
    for (int i = 0; i < KPW; ++i) { const int G = ((wid + 8 * i) * 64 + lane) % (NKP * 64), R = G / 12, rem = G % 12, sg = rem >> 2, qq = rem & 3, f = (R >> 2) & 3;
        const int key = 32 * ((R >> 2) & 1) + 16 * (R >> 5) + 4 * ((R >> 3) & 3) + (R & 3);
        kso[i] = (unsigned)(key * pitch + 64 * sg + 16 * (qq ^ f)); }
    {   const int G = wid * 64 + lane, d = G >> 2, qq = G & 3, f = (d >> 2) & 3; vso = (unsigned)(d * SEQ + 16 * (qq ^ f)); }
#define MLA_DMA(j, bf) do { const unsigned char* kt_ = Kh + (size_t)(j) * 64 * pitch; const unsigned char* vt_ = VTh + (size_t)(j) * 64; \
        _Pragma("unroll") for (int i = 0; i < KPW; ++i) if (wid + 8 * i < NKP) \
            __builtin_amdgcn_global_load_lds((const unsigned*)(kt_ + kso[i]), (LAS unsigned*)(lds + OFF_K + (bf) * KB + (wid + 8 * i) * 1024), 16, 0, 0); \
        __builtin_amdgcn_global_load_lds((const unsigned*)(vt_ + vso), (LAS unsigned*)(lds + OFF_V + (bf) * VB + wid * 1024), 16, 0, 0); } while (0)
#define MLA_MFMA(acc, a, b) asm volatile("v_mfma_f32_32x32x64_f8f6f4 %0, %1, %2, %0" : "+v"(acc) : "v"(a), "v"(b))
#define MLA_MFMA0(acc, a, b) asm volatile("v_mfma_f32_32x32x64_f8f6f4 %0, %1, %2, 0" : "=v"(acc) : "v"(a), "v"(b))
#define MLA_MFMA_DRAIN2(a, b) asm volatile("s_nop 15\n\ts_nop 3" : "+v"(a), "+v"(b) :: "memory")
    i32x8 qr[3];
#pragma unroll
    for (int s = 0; s < 3; ++s) { const i32x4 lo_ = *(const i32x4*)(Qh + (size_t)qpos * pitch + 64 * s + 32 * hi), hi_ = *(const i32x4*)(Qh + (size_t)qpos * pitch + 64 * s + 32 * hi + 16);
        qr[s] = __builtin_shufflevector(lo_, hi_, 0, 1, 2, 3, 4, 5, 6, 7); }
    MLA_DMA(0, 0); MLA_DMA(1, 1);
#define MLA_WAIT_OLDER() do { if (wid < NKP - 8) asm volatile("s_waitcnt vmcnt(%0)" :: "n"(KPW + 1) : "memory"); else asm volatile("s_waitcnt vmcnt(%0)" :: "n"(KPW) : "memory"); } while (0)
    float m_reg = -1e30f;
    f32x16 o[4], ol = f32x16{};
#pragma unroll
    for (int d = 0; d < 4; ++d) o[d] = f32x16{};
    const int fsw = (r32 >> 2) & 3;
    const int koff = r32 * DQ + 16 * ((2 * hi) ^ fsw), voff = r32 * 64 + 16 * ((2 * hi) ^ fsw);
    MLA_WAIT_OLDER();
    asm volatile("" :: "v"(qr[0]), "v"(qr[1]), "v"(qr[2]));
    __builtin_amdgcn_s_barrier();
#define MLA_LD8(dst, base, off) do { const i32x4 lo_ = *(const LAS i32x4*)((base) + (off)), hi_ = *(const LAS i32x4*)((base) + ((off) ^ 16)); dst = __builtin_shufflevector(lo_, hi_, 0, 1, 2, 3, 4, 5, 6, 7); } while (0)
    int buf = 0;
    for (int t = 0; t < NT; ++t) {
        const int kb = t * 64;
        if (kb <= qlo + 31) {
            const LAS unsigned char* kp_ = lds + OFF_K + buf * KB;
            const LAS unsigned char* vp_ = lds + OFF_V + buf * VB;
            f32x16 s0, s1;
            if (kb + 63 <= qlo) {
                i32x8 k0[3], k1[3];
#pragma unroll
                for (int s = 0; s < 3; ++s) MLA_LD8(k0[s], kp_ + 64 * s, koff);
                MLA_MFMA0(s0, k0[0], qr[0]);
#pragma unroll
                for (int s = 0; s < 3; ++s) MLA_LD8(k1[s], kp_ + 32 * DQ + 64 * s, koff);
                MLA_MFMA(s0, k0[1], qr[1]); MLA_MFMA(s0, k0[2], qr[2]);
                MLA_MFMA0(s1, k1[0], qr[0]); MLA_MFMA(s1, k1[1], qr[1]); MLA_MFMA(s1, k1[2], qr[2]);
            } else {
                const float NEG = -__builtin_inff(); const int dq = qpos - kb - 32 * hi;
                int kq_ = koff; asm volatile("" : "+v"(kq_));
                {   i32x8 k0[3];
#pragma unroll
                    for (int s = 0; s < 3; ++s) MLA_LD8(k0[s], kp_ + 64 * s, kq_);
                    MLA_MFMA0(s0, k0[0], qr[0]); MLA_MFMA(s0, k0[1], qr[1]); MLA_MFMA(s0, k0[2], qr[2]);
                }
                {   i32x8 k1[3];
#pragma unroll
                    for (int s = 0; s < 3; ++s) MLA_LD8(k1[s], kp_ + 32 * DQ + 64 * s, kq_);
                    MLA_MFMA0(s1, k1[0], qr[0]); MLA_MFMA(s1, k1[1], qr[1]); MLA_MFMA(s1, k1[2], qr[2]);
                }
                MLA_MFMA_DRAIN2(s0, s1);
#pragma unroll
                for (int r = 0; r < 16; ++r) { if (r > dq) s0[r] = NEG; if (r + 16 > dq) s1[r] = NEG; }
            }

            i32x8 vv[4];
#pragma unroll
            for (int d0 = 0; d0 < 4; ++d0) MLA_LD8(vv[d0], vp_ + d0 * 32 * 64, voff);
            MLA_MFMA_DRAIN2(s0, s1);
            __builtin_amdgcn_sched_barrier(0);
            float pm0 = s0[0], pm1 = s0[8];
#define MLA_MAX8(pm, B_) asm("v_max3_f32 %0, %0, %1, %2\n\tv_max3_f32 %0, %0, %3, %4\n\tv_max3_f32 %0, %0, %5, %6\n\tv_max3_f32 %0, %0, %7, %8\n\tv_max3_f32 %0, %0, %9, %10\n\tv_max3_f32 %0, %0, %11, %12\n\tv_max3_f32 %0, %0, %13, %14\n\tv_max3_f32 %0, %0, %15, %16" \
                : "+v"(pm) : "v"(s0[B_ + 0]), "v"(s1[B_ + 0]), "v"(s0[B_ + 1]), "v"(s1[B_ + 1]), "v"(s0[B_ + 2]), "v"(s1[B_ + 2]), "v"(s0[B_ + 3]), "v"(s1[B_ + 3]), \
                              "v"(s0[B_ + 4]), "v"(s1[B_ + 4]), "v"(s0[B_ + 5]), "v"(s1[B_ + 5]), "v"(s0[B_ + 6]), "v"(s1[B_ + 6]), "v"(s0[B_ + 7]), "v"(s1[B_ + 7]))
            MLA_MAX8(pm0, 0); MLA_MAX8(pm1, 8);
#undef MLA_MAX8
            float pmax = fmaxf(pm0, pm1);
            { auto rr = __builtin_amdgcn_permlane32_swap(__float_as_uint(pmax), __float_as_uint(pmax), false, false); pmax = fmaxf(__uint_as_float(rr[0]), __uint_as_float(rr[1])); }
            const float mn = fmaxf(m_reg, pmax); const float alpha = __builtin_amdgcn_exp2f((m_reg - mn) * 0.125f); m_reg = mn;
            const float b8 = 8.0f * (PSHIFT + 7.0f) - mn;
            i32x8 pa;
            const f32x16 t0 = s0 + b8, t1 = s1 + b8;
#pragma unroll
            for (int g = 0; g < 4; ++g) { unsigned w0 = 0u, w1 = 0u;
#pragma unroll
                for (int b_ = 0; b_ < 4; ++b_) { w0 = __builtin_amdgcn_cvt_pk_u8_f32(t0[4 * g + b_], b_, w0); w1 = __builtin_amdgcn_cvt_pk_u8_f32(t1[4 * g + b_], b_, w1); }
                pa[g] = (int)w0; pa[4 + g] = (int)w1; }
            if (__any(alpha < 1.f)) { if (hi == 0) wsf[r32] = alpha; asm volatile("s_waitcnt lgkmcnt(0)" ::: "memory");
#pragma unroll
                for (int r = 0; r < 16; ++r) { const float a = wsf[crow(r, hi)]; ol[r] *= a;
#pragma unroll
                    for (int d = 0; d < 4; ++d) o[d][r] *= a; } }
            int one_ = 0x38383838; asm volatile("" : "+v"(one_));
            const i32x8 ones8 = {one_, one_, one_, one_, one_, one_, one_, one_};
            asm volatile("s_nop 1" ::: "memory");
            MLA_MFMA(ol, pa, ones8);
#pragma unroll
            for (int d0 = 0; d0 < 4; ++d0) MLA_MFMA(o[d0], pa, vv[d0]);
        }
        if (t + 2 < NT) { const int b2 = buf == 0 ? 2 : buf - 1; MLA_DMA(t + 2, b2); }
        if (t + 2 < NT) { MLA_WAIT_OLDER(); } else { asm volatile("s_waitcnt vmcnt(0)" ::: "memory"); }
        asm volatile("s_waitcnt lgkmcnt(0)" ::: "memory");
        __builtin_amdgcn_s_barrier();
        buf = buf == 2 ? 0 : buf + 1;
    }
    MLA_MFMA_DRAIN2(o[0], o[1]); MLA_MFMA_DRAIN2(o[2], o[3]); MLA_MFMA_DRAIN2(ol, o[0]);
#undef MLA_MFMA_DRAIN2
#undef MLA_MFMA0
#undef MLA_MFMA
#undef MLA_LD8
#undef MLA_WAIT_OLDER
#undef MLA_DMA
    unsigned char* Ow = Oh + (size_t)qlo * op;
#pragma unroll
    for (int r = 0; r < 16; ++r) { const int orow = crow(r, hi); const float rl = __builtin_amdgcn_rcpf(ol[r]);
#pragma unroll
        for (int d0 = 0; d0 < 4; ++d0) { const float v = o[d0][r] * rl; const float v1 = __shfl_down(v, 1), v2 = __shfl_down(v, 2), v3 = __shfl_down(v, 3);
            if ((r32 & 3) == 0) *(unsigned*)(Ow + (size_t)orow * op + d0 * 32 + r32) = pk4_fp8(v, v1, v2, v3); } }
    __syncthreads();
}
}

constexpr int NWAVES = 8;
constexpr size_t MiB = 1u << 20;
constexpr size_t WS_CTL = 0, CTL_ZERO_BYTES = 1 * MiB;
constexpr size_t WS_WEIN = 2 * MiB;
constexpr size_t WS_WEOUT = 12 * MiB;
constexpr size_t WS_WOIN = 16 * MiB;
constexpr size_t WS_WUQ = 20 * MiB;
constexpr size_t WS_WUKV = 23 * MiB;
constexpr size_t WS_WOOUT = 25 * MiB;
constexpr size_t WS_B1P = 29 * MiB;
constexpr size_t WS_SSQ = 30 * MiB;
constexpr size_t WS_TOKER = 31 * MiB;
constexpr size_t WS_TOKG = 31 * MiB + 512 * 1024;
constexpr size_t WS_XN = 32 * MiB;
constexpr size_t WS_Z = 64 * MiB;
constexpr size_t WS_MIX = 144 * MiB;
constexpr size_t WS_QR = 176 * MiB;
constexpr size_t WS_KVR = 224 * MiB;
constexpr size_t WS_QF = 288 * MiB;
constexpr size_t WS_KF = 336 * MiB;
constexpr size_t WS_Z8 = 104 * MiB;
constexpr size_t WS_MIX8 = 160 * MiB;
constexpr size_t WS_VT = 3200 * MiB;
constexpr size_t WS_W1 = 384 * MiB;
constexpr size_t WS_W2 = 896 * MiB;
constexpr size_t WS_XG = 1152 * MiB;
constexpr size_t WS_ACT = 1664 * MiB;
constexpr size_t WS_Y = 2176 * MiB;
constexpr size_t WS_X16 = 3216 * MiB;
constexpr size_t WS_END = 3248 * MiB;
constexpr int CW_MOE = 65536;
constexpr int CW_TMO = 0, CW_CODE = 1, CW_BAR = 4096, CW_CNT = 16384;
constexpr int RING_OFF = 0, RING_BYTES = 131072;
constexpr int LDSCTL_OFF = RING_BYTES, MISC_OFF = LDSCTL_OFF + 320;
constexpr int SCR_OFF = RING_BYTES + 1024;
constexpr int LDS_BYTES = 155648;
constexpr int SCR_BYTES = LDS_BYTES - SCR_OFF;

typedef GAS unsigned gu32;
#define RLX_AGENT __ATOMIC_RELAXED, __HIP_MEMORY_SCOPE_AGENT

#define XB_TMO      128
#define XB_XCNT(j)  (256  + 64 * (j))
#define XB_XSUB(j)  (1280 + 64 * (j))
#define XB_XGEN(j)  (2304 + 64 * (j))
#define XB_TOP      3328
#define XB_TOPGEN   3392
#define XCD_BAR_WORDS 3456
#define XB_SPIN_CAP (1u << 18)
__device__ __forceinline__ unsigned xb_ld(unsigned* p)              { return __hip_atomic_load(p, __ATOMIC_RELAXED, __HIP_MEMORY_SCOPE_AGENT); }
__device__ __forceinline__ unsigned xb_add(unsigned* p, unsigned v) { return __hip_atomic_fetch_add(p, v, __ATOMIC_RELAXED, __HIP_MEMORY_SCOPE_AGENT); }
__device__ __forceinline__ unsigned xb_xcc_id() { return (unsigned)__builtin_amdgcn_s_getreg((3 << 11) | 20) & 0xFu; }
#define XB_SPIN(cond, bar) do { unsigned _sp = 0; while (cond) { __builtin_amdgcn_s_sleep(1); \
    if ((++_sp & 255u) == 0u) { if (xb_ld(&(bar)[XB_TMO])) break; if (_sp > XB_SPIN_CAP) { atomicAdd(&(bar)[XB_TMO], 1u); break; } } } } while (0)
struct XcdBarrier { unsigned* bar; unsigned x; volatile LAS unsigned* st; };
__device__ __forceinline__ XcdBarrier xcd_barrier_post(unsigned* bar, volatile LAS unsigned* st) {
    XcdBarrier b; b.bar = bar; b.x = xb_xcc_id(); b.st = st;
    if (threadIdx.x == 0) (void)xb_add(&bar[XB_XCNT(b.x)], 1u);
    return b;
}
__device__ __forceinline__ void xcd_barrier_complete(unsigned* bar, unsigned x, unsigned& nloc, unsigned& nx) {
    const unsigned G = gridDim.x * gridDim.y * gridDim.z;
    unsigned sum, cnt, mine, sp = 0u;
    for (;;) {
        sum = 0u; cnt = 0u; mine = 0u;
#pragma unroll
        for (unsigned j = 0; j < 16; ++j) { const unsigned c = xb_ld(&bar[XB_XCNT(j)]); sum += c; cnt += (c > 0u) ? 1u : 0u; mine = (j == x) ? c : mine; }
        if (sum == G) break;
        __builtin_amdgcn_s_sleep(1);
        if ((++sp & 255u) == 0u) { if (xb_ld(&bar[XB_TMO])) break; if (sp > XB_SPIN_CAP) { atomicAdd(&bar[XB_TMO], 1u); break; } }
    }
    nloc = mine > 0u ? mine : 1u; nx = cnt > 0u ? cnt : 1u;
}
__device__ __forceinline__ void xcd_barrier(const XcdBarrier& b) {
    asm volatile("s_waitcnt vmcnt(0)" ::: "memory");
    __syncthreads();
    if (threadIdx.x == 0) {
        unsigned* bar = b.bar;
        __builtin_amdgcn_s_waitcnt(0);
        unsigned nloc = b.st[0], nx = b.st[1];
        if (nloc == 0u) { xcd_barrier_complete(bar, b.x, nloc, nx); b.st[0] = nloc; b.st[1] = nx; }
        const unsigned old = xb_add(&bar[XB_XSUB(b.x)], 1u);
        const unsigned gen = old / nloc;
        if (old + 1u == (gen + 1u) * nloc) {
            __builtin_amdgcn_fence(__ATOMIC_RELEASE, "agent");
            asm volatile("s_waitcnt vmcnt(0)" ::: "memory");
            const unsigned og = xb_add(&bar[XB_TOP], 1u);
            const unsigned tg = og / nx;
            if (og + 1u == (tg + 1u) * nx) xb_add(&bar[XB_TOPGEN], 1u);
            else XB_SPIN(xb_ld(&bar[XB_TOPGEN]) == tg, bar);
            __builtin_amdgcn_fence(__ATOMIC_ACQUIRE, "agent");
            xb_add(&bar[XB_XGEN(b.x)], 1u);
            asm volatile("s_waitcnt vmcnt(0)" ::: "memory");
        } else {
            XB_SPIN(xb_ld(&bar[XB_XGEN(b.x)]) == gen, bar);
            __builtin_amdgcn_fence(__ATOMIC_ACQUIRE, "agent");
            asm volatile("s_waitcnt vmcnt(0)" ::: "memory");
        }
    }
    __syncthreads();
}

struct Args {
    const float* in[24]; float* out; unsigned char* ws; int stage_limit; int pad;
};
enum { I_X = 0, I_MIXN, I_FFNN, I_EWIN, I_EWS, I_EBS, I_EGV, I_EGQ, I_EGK, I_EWOUT, I_OWIN, I_OGCQ, I_OGCKV, I_OWUQ, I_OWUKV, I_OGQ, I_OGK, I_OWOUT,
       I_RW, I_RB, I_W1, I_B1, I_W2, I_B2 };

struct Frame {
    LAS unsigned char* lds;
    int vcu, G;
};

__device__ __forceinline__ float wave_sum(float v) {
#pragma unroll
    for (int o = 1; o < 64; o <<= 1) v += __shfl_xor(v, o);
    return v;
}
#define LDS_WAIT() asm volatile("s_waitcnt lgkmcnt(0)" ::: "memory")

template <int MODE> __device__ __forceinline__ int dst_row(int o) {
    if (MODE == 1) { if (o >= 1024 && o < 2048) return (o & ~255) | (((o >> 5) & 1) << 7) | (((o >> 6) & 3) << 5) | (o & 31); return o; }
    if (MODE == 2) return ((o >> 8) << 8) | ((o & 1) << 7) | ((o & 255) >> 1);
    return o;
}
template <int MODE>
__device__ __forceinline__ void transpose_item(const float* __restrict__ W, int K, int N, bf16_t* __restrict__ WT, const float* __restrict__ gain, LAS float* scr, int item, int lane) {
    const int nblk = N / 32, kb = item / nblk, nb = item % nblk, k0 = 64 * kb, n0 = 32 * nb;
#pragma unroll 8
    for (int i = 0; i < 32; ++i) { const int kk = 2 * i + (lane >> 5); float w = W[(size_t)(k0 + kk) * N + n0 + (lane & 31)]; if (gain) w *= gain[k0 + kk]; scr[kk * 33 + (lane & 31)] = w; }
    LDS_WAIT(); asm volatile("" ::: "memory");
    const int c = lane & 7;
#pragma unroll
    for (int j = 0; j < 4; ++j) { const int n = (lane >> 3) + 8 * j; const LAS float* s = scr + (8 * c) * 33 + n;
        u32x4 o; o.x = cvt_pk_bf16(s[0 * 33], s[1 * 33]); o.y = cvt_pk_bf16(s[2 * 33], s[3 * 33]); o.z = cvt_pk_bf16(s[4 * 33], s[5 * 33]); o.w = cvt_pk_bf16(s[6 * 33], s[7 * 33]);
        *(u32x4*)(WT + (size_t)dst_row<MODE>(n0 + n) * K + k0 + 8 * c) = o; }
    LDS_WAIT(); asm volatile("" ::: "memory");
}
template <int MODE>
__device__ __forceinline__ void transpose_job(Frame& F, const float* W, int K, int N, int nmat, size_t src_stride, bf16_t* WT, size_t dst_stride, const float* gain, int gain_stride) {
    int tid_ = threadIdx.x; asm volatile("" : "+v"(tid_));
    const int wave = __builtin_amdgcn_readfirstlane(tid_ >> 6), lane = tid_ & 63;
    LAS float* scr = (LAS float*)(F.lds + RING_OFF + wave * 16384);
    const int gw = F.vcu * NWAVES + wave, NGW = F.G * NWAVES;
    const int per = (K / 64) * (N / 32), total = per * nmat;
    for (int it = gw; it < total; it += NGW) { const int mi = it / per, item = it - mi * per;
        transpose_item<MODE>(W + (size_t)mi * src_stride, K, N, WT + (size_t)mi * dst_stride, gain ? gain + (size_t)mi * gain_stride : nullptr, scr, item, lane); }
}


__device__ __forceinline__ void tr8_load(f32x4 (&v)[16], const float* __restrict__ W, int N, int item, int lane) {
    const int nblk = N / 32, kb = item / nblk, nb = item % nblk, k0 = 128 * kb, n0 = 32 * nb;
#pragma unroll
    for (int i = 0; i < 16; ++i) v[i] = __builtin_nontemporal_load((const f32x4*)(W + (size_t)(k0 + 8 * i + (lane >> 3)) * N + n0 + 4 * (lane & 7)));
}
template <int MODE>
__device__ __forceinline__ void tr8_store(const f32x4 (&v)[16], int K, int N, unsigned char* __restrict__ WT, const float* __restrict__ gain, LAS unsigned char* scr, int item, int lane) {
    const int nblk = N / 32, kb = item / nblk, nb = item % nblk, k0 = 128 * kb, n0 = 32 * nb;
    constexpr int TP = 144;
#pragma unroll
    for (int i = 0; i < 16; ++i) { const int kl = 8 * i + (lane >> 3); const float sc = gain ? W8_SCALE * gain[k0 + kl] : W8_SCALE;
        const unsigned w = pk4_fp8(v[i].x * sc, v[i].y * sc, v[i].z * sc, v[i].w * sc); LAS unsigned char* d = scr + (4 * (lane & 7)) * TP + kl;
        d[0] = (unsigned char)w; d[TP] = (unsigned char)(w >> 8); d[2 * TP] = (unsigned char)(w >> 16); d[3 * TP] = (unsigned char)(w >> 24); }
    LDS_WAIT(); asm volatile("" ::: "memory");
#pragma unroll
    for (int m = 0; m < 4; ++m) { const int q = lane + 64 * m, n = q >> 3, kc = q & 7;
        const u32x4 o = *(const LAS u32x4*)(scr + n * TP + 16 * kc);
        __builtin_nontemporal_store(o, (u32x4*)(WT + (size_t)dst_row<MODE>(n0 + n) * K + k0 + 16 * kc)); }
    LDS_WAIT(); asm volatile("" ::: "memory");
}
template <int MODE>
__device__ __forceinline__ void transpose_job_fp8(Frame& F, const float* W, int K, int N, int nmat, size_t src_stride, unsigned char* WT, size_t dst_stride, const float* gain = nullptr, int gain_stride = 0) {
    int tid_ = threadIdx.x; asm volatile("" : "+v"(tid_));
    const int wave = __builtin_amdgcn_readfirstlane(tid_ >> 6), lane = tid_ & 63;
    LAS unsigned char* scr = F.lds + RING_OFF + wave * 16384;
    const int gw = F.vcu * NWAVES + wave, NGW = F.G * NWAVES;
    const int per = (K / 128) * (N / 32), total = per * nmat;
    f32x4 cur[16], nxt[16];
    int it = gw;
    if (it < total) { const int mi = it / per; tr8_load(cur, W + (size_t)mi * src_stride, N, it - mi * per, lane); }
    for (; it < total; it += NGW) {
        const int itn = it + NGW;
        if (itn < total) { const int mn = itn / per; tr8_load(nxt, W + (size_t)mn * src_stride, N, itn - mn * per, lane); }
        const int mi = it / per;
        tr8_store<MODE>(cur, K, N, WT + (size_t)mi * dst_stride, gain ? gain + (size_t)mi * gain_stride : nullptr, scr, it - mi * per, lane);
#pragma unroll
        for (int i = 0; i < 16; ++i) cur[i] = nxt[i];
    }
}

__device__ __forceinline__ void rms_row_to_fp8(int lane, const float* xrow, const float* g, unsigned char* orow, float* copy) {
    const f32x4* xr = (const f32x4*)xrow + lane; const f32x4* gr = (const f32x4*)g + lane;
    f32x4 v[4]; float s = 0.f;
#pragma unroll
    for (int j = 0; j < 4; ++j) { v[j] = xr[64 * j]; s += (v[j].x * v[j].x + v[j].y * v[j].y) + (v[j].z * v[j].z + v[j].w * v[j].w); }
    const float rstd = 1.0f / sqrtf(wave_sum(s) * (1.f / DM) + EPS);
    unsigned* o4 = (unsigned*)orow + lane;
#pragma unroll
    for (int j = 0; j < 4; ++j) { const f32x4 gg = gr[64 * j]; if (copy) ((f32x4*)copy + lane)[64 * j] = v[j];
        o4[64 * j] = pk4_fp8(v[j].x * rstd * gg.x, v[j].y * rstd * gg.y, v[j].z * rstd * gg.z, v[j].w * rstd * gg.w); }
}
__device__ __forceinline__ void rms_row_to_bf16(int lane, const float* xrow, const float* g, bf16_t* orow, float* copy) {
    const f32x4* xr = (const f32x4*)xrow + lane; const f32x4* gr = (const f32x4*)g + lane;
    f32x4 v[4]; float s = 0.f;
#pragma unroll
    for (int j = 0; j < 4; ++j) { v[j] = xr[64 * j]; s += (v[j].x * v[j].x + v[j].y * v[j].y) + (v[j].z * v[j].z + v[j].w * v[j].w); }
    const float rstd = 1.0f / sqrtf(wave_sum(s) * (1.f / DM) + EPS);
    u32x2* o8 = (u32x2*)orow + lane;
#pragma unroll
    for (int j = 0; j < 4; ++j) { const f32x4 gg = gr[64 * j]; if (copy) ((f32x4*)copy + lane)[64 * j] = v[j];
        u32x2 w; w.x = cvt_pk_bf16(v[j].x * rstd * gg.x, v[j].y * rstd * gg.y); w.y = cvt_pk_bf16(v[j].z * rstd * gg.z, v[j].w * rstd * gg.w); o8[64 * j] = w; }
}

namespace pg8 {
struct EpiEvenIn {
    static constexpr bool PERM = false;
    bf16_t* Z; const float* gq; const float* gk;
    __device__ __forceinline__ void operator()(const f32x4 (&acc)[2][2][4][2], const Unit& u, int wr, int wc, int fr, int fq) const {
        const int row0 = u.pm * BM + wr * 64 + fr, pn = u.pn;
        if (pn >= 4 && pn < 8) {
            const float* g = pn < 6 ? gq : gk; const float sc = pn < 6 ? C2_B : 1.0f;
            f32x4 gv[2][2];
#pragma unroll
            for (int bj = 0; bj < 2; ++bj)
#pragma unroll
                for (int n = 0; n < 2; ++n) gv[bj][n] = *(const f32x4*)(g + 32 * bj + 16 * n + 4 * fq);
#pragma unroll
            for (int ai = 0; ai < 2; ++ai)
#pragma unroll
                for (int m = 0; m < 4; ++m) {
                    float ss = 0.f;
#pragma unroll
                    for (int bj = 0; bj < 2; ++bj)
#pragma unroll
                        for (int n = 0; n < 2; ++n) { const f32x4 v = acc[ai][bj][m][n]; ss += (v[0] * v[0] + v[1] * v[1]) + (v[2] * v[2] + v[3] * v[3]); }
                    ss += __shfl_xor(ss, 16); ss += __shfl_xor(ss, 32);
                    const float rstd = sc / sqrtf(ss * (1.0f / 64.0f) + EPS);
                    bf16_t* rowp = Z + (size_t)(row0 + ai * HALF + m * 16) * EVEN_IN + pn * BM + wc * 64 + 4 * fq;
#pragma unroll
                    for (int bj = 0; bj < 2; ++bj)
#pragma unroll
                        for (int n = 0; n < 2; ++n) { const f32x4 v = acc[ai][bj][m][n] * rstd * gv[bj][n];
                            u32x2 w; w.x = cvt_pk_bf16(v[0], v[1]); w.y = cvt_pk_bf16(v[2], v[3]); *(u32x2*)(rowp + 32 * bj + 16 * n) = w; }
                }
        } else {
            const bool act = pn < 4;
#pragma unroll
            for (int ai = 0; ai < 2; ++ai)
#pragma unroll
                for (int m = 0; m < 4; ++m) { bf16_t* rowp = Z + (size_t)(row0 + ai * HALF + m * 16) * EVEN_IN + pn * BM + wc * 32 + 4 * fq;
#pragma unroll
                    for (int bj = 0; bj < 2; ++bj)
#pragma unroll
                        for (int n = 0; n < 2; ++n) { f32x4 v = acc[ai][bj][m][n]; if (act) v = gelu4(v);
                            u32x2 w; w.x = cvt_pk_bf16(v[0], v[1]); w.y = cvt_pk_bf16(v[2], v[3]); *(u32x2*)(rowp + bj * HALF + 16 * n) = w; } }
        }
    }
};
template <bool F8 = false> struct EpiResidT {
    static constexpr bool PERM = false;
    const float* src32; bf16_t* X;
    __device__ __forceinline__ void operator()(const f32x4 (&acc)[2][2][4][2], const Unit& u, int wr, int wc, int fr, int fq) const {
        const int row0 = u.pm * BM + wr * 64 + fr;
#pragma unroll
        for (int ai = 0; ai < 2; ++ai)
#pragma unroll
            for (int m = 0; m < 4; ++m) { const size_t ro = (size_t)(row0 + ai * HALF + m * 16) * DM + u.pn * BM + wc * 32 + 4 * fq;
#pragma unroll
                for (int bj = 0; bj < 2; ++bj)
#pragma unroll
                    for (int n = 0; n < 2; ++n) { const size_t o_ = ro + bj * HALF + 16 * n; f32x4 b;
                        if (src32) b = *(const f32x4*)(src32 + o_); else { const u32x2 t = *(const u32x2*)(X + o_); b = (f32x4){bflo(t.x), bfhi(t.x), bflo(t.y), bfhi(t.y)}; }
                        const f32x4 r = b + (F8 ? acc[ai][bj][m][n] * W8_INV : acc[ai][bj][m][n]);
                        u32x2 w; w.x = cvt_pk_bf16(r[0], r[1]); w.y = cvt_pk_bf16(r[2], r[3]); *(u32x2*)(X + o_) = w; }
                if (m & 1) asm volatile("" ::: "memory"); }
    }
};
typedef EpiResidT<false> EpiResid;
struct EpiOddIn {
    static constexpr bool PERM = false;
    bf16_t* Z; unsigned char* Z8; float* ssq;
    __device__ __forceinline__ void operator()(const f32x4 (&acc)[2][2][4][2], const Unit& u, int wr, int wc, int fr, int fq) const {
        const int row0 = u.pm * BM + wr * 64 + fr, pn = u.pn;
#pragma unroll
        for (int ai = 0; ai < 2; ++ai)
#pragma unroll
            for (int m = 0; m < 4; ++m) { const int row = row0 + ai * HALF + m * 16; bf16_t* rowp = Z + (size_t)row * ODD_INP + pn * BM + wc * 32 + 4 * fq;
                float ss = 0.f;
#pragma unroll
                for (int bj = 0; bj < 2; ++bj)
#pragma unroll
                    for (int n = 0; n < 2; ++n) { const f32x4 v = acc[ai][bj][m][n] * W8_INV; ss += (v[0] * v[0] + v[1] * v[1]) + (v[2] * v[2] + v[3] * v[3]);
                        if (pn < 3) *(unsigned*)(Z8 + (size_t)row * ODD_INP + pn * BM + wc * 32 + 4 * fq + bj * HALF + 16 * n) = pk4_fp8(v[0], v[1], v[2], v[3]);
                        else { u32x2 w; w.x = cvt_pk_bf16(v[0], v[1]); w.y = cvt_pk_bf16(v[2], v[3]); *(u32x2*)(rowp + bj * HALF + 16 * n) = w; } }
                ss += __shfl_xor(ss, 16); ss += __shfl_xor(ss, 32);
                if (fq == 0) ssq[(size_t)row * 16 + pn * 4 + wc] = ss; }
    }
};
template <int NS> struct EpiRowScale {
    static constexpr bool PERM = true;
    unsigned char* O; int ldc; const float* ssq; int s0; float inv_cols;
    __device__ __forceinline__ void operator()(const f32x4 (&acc)[2][2][4][2], const Unit& u, int wr, int wc, int fr, int fq) const {
        const int row0 = u.pm * BM + wr * 64 + fr; const int col0 = u.pn * BM + wc * 32 + 8 * fq;
#pragma unroll
        for (int ai = 0; ai < 2; ++ai)
#pragma unroll
            for (int m = 0; m < 4; ++m) { const int row = row0 + ai * HALF + m * 16;
                float ss = 0.f; const f32x4* sp = (const f32x4*)(ssq + (size_t)row * 16 + s0);
#pragma unroll
                for (int q = 0; q < NS; ++q) { const f32x4 t = sp[q]; ss += (t[0] + t[1]) + (t[2] + t[3]); }
                const float rstd = W8_INV / sqrtf(ss * inv_cols + EPS);
                unsigned char* rowp = O + (size_t)row * ldc + col0;
#pragma unroll
                for (int bj = 0; bj < 2; ++bj) { const f32x4 v0 = acc[ai][bj][m][0] * rstd, v1 = acc[ai][bj][m][1] * rstd;
                    u32x2 w; w.x = pk4_fp8(v0[0], v0[1], v0[2], v0[3]); w.y = pk4_fp8(v1[0], v1[1], v1[2], v1[3]);
                    *(u32x2*)(rowp + bj * HALF) = w; }
                asm volatile("" ::: "memory"); }
    }
};
__device__ __forceinline__ void store8_sc1(void* p, u32x2 v) { asm volatile("global_store_dwordx2 %0, %1, off sc1" :: "v"(p), "v"(v) : "memory"); }
template <bool WT = false> struct EpiSwigluT {
    static constexpr bool PERM = true;
    unsigned char* ACT; const float* b1p;
    __device__ __forceinline__ void operator()(const f32x4 (&acc)[2][2][4][2], const Unit& u, int wr, int wc, int fr, int fq) const {
        const int row0 = u.pm * BM + wr * 64 + fr, e = u.pb >> 3, pn = u.pn;
        const float* bp = b1p + (size_t)e * 2048 + pn * BM + wc * 32 + 8 * fq;
        f32x4 bg[2], bl[2];
#pragma unroll
        for (int n = 0; n < 2; ++n) { bg[n] = *(const f32x4*)(bp + 4 * n); bl[n] = *(const f32x4*)(bp + HALF + 4 * n) + 1.0f; }
#pragma unroll
        for (int ai = 0; ai < 2; ++ai)
#pragma unroll
            for (int m = 0; m < 4; ++m) { unsigned char* rowp = ACT + (size_t)(row0 + ai * HALF + m * 16) * DE + pn * HALF + wc * 32 + 8 * fq;
                float a[8];
#pragma unroll
                for (int n = 0; n < 2; ++n) { const f32x4 gv = acc[ai][0][m][n] * W8_INV + bg[n], lv = acc[ai][1][m][n] * W8_INV + bl[n];
#pragma unroll
                    for (int i = 0; i < 4; ++i) { const float gl = fminf(gv[i], 7.0f), li1 = __builtin_amdgcn_fmed3f(lv[i], -6.0f, 8.0f);
                        const float sg = __builtin_amdgcn_rcpf(1.0f + __builtin_amdgcn_exp2f(-1.702f * LOG2E * gl));
                        a[4 * n + i] = gl * sg * li1; } }
                u32x2 w; w.x = pk4_fp8(a[0], a[1], a[2], a[3]); w.y = pk4_fp8(a[4], a[5], a[6], a[7]);
                if (WT) store8_sc1(rowp, w); else *(u32x2*)rowp = w; }
    }
};
typedef EpiSwigluT<false> EpiSwiglu;
struct EpiDown {
    static constexpr bool PERM = true;
    bf16_t* Y; const float* b2;
    __device__ __forceinline__ void operator()(const f32x4 (&acc)[2][2][4][2], const Unit& u, int wr, int wc, int fr, int fq) const {
        const int row0 = u.pm * BM + wr * 64 + fr, e = u.pb >> 2, pn = u.pn;
        const float* bp = b2 + (size_t)e * DM + pn * BM + wc * 32 + 8 * fq;
        f32x4 bv[2][2];
#pragma unroll
        for (int bj = 0; bj < 2; ++bj)
#pragma unroll
            for (int n = 0; n < 2; ++n) bv[bj][n] = *(const f32x4*)(bp + bj * HALF + 4 * n);
#pragma unroll
        for (int ai = 0; ai < 2; ++ai)
#pragma unroll
            for (int m = 0; m < 4; ++m) { bf16_t* rowp = Y + (size_t)(row0 + ai * HALF + m * 16) * DM + pn * BM + wc * 32 + 8 * fq;
#pragma unroll
                for (int bj = 0; bj < 2; ++bj) { const f32x4 v0 = acc[ai][bj][m][0] * W8_INV + bv[bj][0], v1 = acc[ai][bj][m][1] * W8_INV + bv[bj][1];
                    u32x4 w; w.x = cvt_pk_bf16(v0[0], v0[1]); w.y = cvt_pk_bf16(v0[2], v0[3]); w.z = cvt_pk_bf16(v1[0], v1[1]); w.w = cvt_pk_bf16(v1[2], v1[3]);
                    *(u32x4*)(rowp + bj * HALF) = w; } }
    }
};
struct MoeOrder {
    const LAS int* tbl; int nN, G, c;
    __device__ bool next(int i, Unit& u) const {
        const long L = (long)i * G + c; const int rb = (int)(L / nN);
        if (rb >= __builtin_amdgcn_readfirstlane(tbl[32])) return false;
        int e = 0;
#pragma unroll
        for (int k = 1; k < 32; ++k) e += (tbl[k] <= rb) ? 1 : 0;
        e = __builtin_amdgcn_readfirstlane(e); const int rbl = __builtin_amdgcn_readfirstlane(rb - tbl[e]);
        u.pm = e * (ECAP / BM) + rbl; u.pn = (int)(L % nN); u.pb = e * nN + u.pn; u.kind = 0; u.rb = rb; return true;
    }
    __device__ __forceinline__ void a_ready(const Unit&) const {}
    __device__ __forceinline__ void pre_epi() const {}
    __device__ __forceinline__ void done(const Unit&) const {}
    __device__ __forceinline__ void finish() const {}
};

constexpr unsigned MOE_SPIN_CAP = 1u << 22;
struct MoeMergedOrder {
    const LAS int* tbl; int G, c; gu32* cnt;
    mutable int pend;
    __device__ __forceinline__ void flush() const {
        if (pend >= 0) { asm volatile("s_waitcnt vmcnt(0)" ::: "memory");
            if ((threadIdx.x & 63) == 0) __hip_atomic_fetch_add(cnt + 16 * pend, 1u, __ATOMIC_RELAXED, __HIP_MEMORY_SCOPE_AGENT);
            pend = -1; } }
    __device__ bool next(int i, Unit& u) const {
        const int nb = __builtin_amdgcn_readfirstlane(tbl[32]);
        long L = (long)i * G + c; int nN = 8, kind = 0;
        if (L >= (long)nb * 8) { L -= (long)nb * 8; nN = 4; kind = 1; if (L >= (long)nb * 4) return false; }
        const int rb = (int)(L / nN);
        int e = 0;
#pragma unroll
        for (int k = 1; k < 32; ++k) e += (tbl[k] <= rb) ? 1 : 0;
        e = __builtin_amdgcn_readfirstlane(e); const int rbl = __builtin_amdgcn_readfirstlane(rb - tbl[e]);
        u.pm = e * (ECAP / BM) + rbl; u.pn = (int)(L % nN); u.pb = e * nN + u.pn; u.kind = kind; u.rb = rb; return true;
    }
    __device__ __forceinline__ void a_ready(const Unit& u) const {
        if (u.kind == 1) {
            flush();
            if (threadIdx.x < 64) {
                unsigned sp = 0;
                while ((unsigned)__builtin_amdgcn_readfirstlane(__hip_atomic_load(cnt + 16 * u.rb, __ATOMIC_RELAXED, __HIP_MEMORY_SCOPE_AGENT)) < 64u) { __builtin_amdgcn_s_sleep(2); if (++sp > MOE_SPIN_CAP) break; }
                __builtin_amdgcn_fence(__ATOMIC_ACQUIRE, "agent");
                asm volatile("s_waitcnt vmcnt(0)" ::: "memory");
            }
            __builtin_amdgcn_s_barrier();
        }
    }
    __device__ __forceinline__ void pre_epi() const { flush(); }
    __device__ __forceinline__ void done(const Unit& u) const { if (u.kind == 0) pend = u.rb; }
    __device__ __forceinline__ void finish() const { flush(); }
};
struct EpiMoe {
    static constexpr bool PERM = true;
    EpiSwigluT<true> up; EpiDown down;
    __device__ __forceinline__ void operator()(const f32x4 (&acc)[2][2][4][2], const Unit& u, int wr, int wc, int fr, int fq) const {
        if (u.kind == 0) up(acc, u, wr, wc, fr, fq); else down(acc, u, wr, wc, fr, fq);
    }
};
}

__device__ __forceinline__ void gmlp_unit(Frame& F, const bf16_t* Z, bf16_t* MIX, const float* Ws, const float* bs, const float* gv, int unit) {
    constexpr int VP = 272;
    LAS unsigned char* VT = F.lds + RING_OFF;
    const int h = unit & 3, chunk = unit >> 2;
    int tid_ = threadIdx.x; asm volatile("" : "+v"(tid_));
    const int t0 = chunk * 128, tid = tid_, lane = tid & 63, w = __builtin_amdgcn_readfirstlane(tid >> 6);
    {
        const int s = tid >> 2, dq = (tid & 3) * 32;
        const bf16_t* vp = Z + (size_t)(t0 + s) * EVEN_IN + 512 + h * 128 + dq;
        u32x4 raw[4]; float ss = 0.f;
#pragma unroll
        for (int i = 0; i < 4; ++i) { raw[i] = *(const u32x4*)(vp + 8 * i);
#pragma unroll
            for (int j = 0; j < 4; ++j) { const float a = bflo(raw[i][j]), b = bfhi(raw[i][j]); ss += a * a + b * b; } }
        ss += __shfl_xor(ss, 1); ss += __shfl_xor(ss, 2);
        const float rstd = 1.0f / sqrtf(ss * (1.0f / 128.0f) + EPS);
#pragma unroll
        for (int i = 0; i < 4; ++i)
#pragma unroll
            for (int j = 0; j < 4; ++j) { const int d = dq + 8 * i + 2 * j;
                *(LAS bf16_t*)(VT + (d) * VP + s * 2) = f2bf(bflo(raw[i][j]) * rstd);
                *(LAS bf16_t*)(VT + (d + 1) * VP + s * 2) = f2bf(bfhi(raw[i][j]) * rstd); }
    }
    __syncthreads();
    const int fr = lane & 15, fq = lane >> 4;
    f32x4 acc[8];
#pragma unroll
    for (int nb = 0; nb < 8; ++nb) acc[nb] = (f32x4){0.f, 0.f, 0.f, 0.f};
    const int trow = 16 * w + fr;
    const float* wrow = Ws + ((size_t)h * 128 + trow) * 128;
#pragma unroll
    for (int ks = 0; ks < 4; ++ks) {
        if (32 * ks <= 16 * w + 15) {
            const int s0 = 32 * ks + 8 * fq;
            const f32x4 wa = *(const f32x4*)(wrow + s0), wb = *(const f32x4*)(wrow + s0 + 4);
            float wv[8] = {wa[0], wa[1], wa[2], wa[3], wb[0], wb[1], wb[2], wb[3]};
#pragma unroll
            for (int j = 0; j < 8; ++j) if (s0 + j > trow) wv[j] = 0.f;
            u32x4 aw; aw.x = cvt_pk_bf16(wv[0], wv[1]); aw.y = cvt_pk_bf16(wv[2], wv[3]); aw.z = cvt_pk_bf16(wv[4], wv[5]); aw.w = cvt_pk_bf16(wv[6], wv[7]);
            const bf16x8 af = __builtin_bit_cast(bf16x8, aw);
#pragma unroll
            for (int nb = 0; nb < 8; ++nb) { const bf16x8 bfr = *(const LAS bf16x8*)(VT + (16 * nb + fr) * VP + s0 * 2);
                acc[nb] = __builtin_amdgcn_mfma_f32_16x16x32_bf16(af, bfr, acc[nb], 0, 0, 0); }
        }
    }
    LAS bf16_t* DT = (LAS bf16_t*)(F.lds + RING_OFF + 36864);
#pragma unroll
    for (int i = 0; i < 4; ++i) { const int tl = 16 * w + 4 * fq + i; const float bt = bs[h * 128 + tl];
#pragma unroll
        for (int nb = 0; nb < 8; ++nb) DT[tl * 136 + 16 * nb + fr] = f2bf(gv[h * 128 + 16 * nb + fr] * acc[nb][i] + bt); }
    __syncthreads();
#pragma unroll
    for (int k = 0; k < 4; ++k) { const int idx = tid + 512 * k, tl = idx >> 4, c8 = (idx & 15) * 8;
        const u32x4 mv = *(const LAS u32x4*)(DT + tl * 136 + c8); const u32x4 uv = *(const u32x4*)(Z + (size_t)(t0 + tl) * EVEN_IN + h * 128 + c8);
        u32x4 o; o.x = cvt_pk_bf16(bflo(uv.x) * bflo(mv.x), bfhi(uv.x) * bfhi(mv.x)); o.y = cvt_pk_bf16(bflo(uv.y) * bflo(mv.y), bfhi(uv.y) * bfhi(mv.y));
        o.z = cvt_pk_bf16(bflo(uv.z) * bflo(mv.z), bfhi(uv.z) * bfhi(mv.z)); o.w = cvt_pk_bf16(bflo(uv.w) * bflo(mv.w), bfhi(uv.w) * bfhi(mv.w));
        *(u32x4*)(MIX + (size_t)(t0 + tl) * DM + h * 128 + c8) = o; }
    __syncthreads();
}

__device__ __forceinline__ void router_phase(Frame& F, const bf16_t* x, const float* gain, const float* Wr, const float* br, gu32* cnt  ,
                                             unsigned* tok_er, float* tok_g, unsigned char* XG) {
    LAS float* part = (LAS float*)(F.lds + RING_OFF);
    LAS float* ssqp = (LAS float*)(F.lds + RING_OFF + 8 * 64 * 33 * 4);
    LAS float* lg = (LAS float*)(F.lds + SCR_OFF);
    LAS unsigned* hist = (LAS unsigned*)(F.lds + SCR_OFF + 64 * 33 * 4);
    LAS unsigned* base = hist + 32;
    LAS unsigned* ers = base + 32;
    int tid_ = threadIdx.x; asm volatile("" : "+v"(tid_));
    const int tid = tid_, lane = tid & 63, w = __builtin_amdgcn_readfirstlane(tid >> 6), r32 = lane & 31, hi = lane >> 5;
#ifndef RTR_REP_A
#define RTR_REP_A 1
#define RTR_REP_B 1
#define RTR_REP_C 1
#endif
    f32x4 gg[4];
#pragma unroll
    for (int j = 0; j < 4; ++j) gg[j] = ((const f32x4*)gain + lane)[64 * j];
    {   const int tg = F.vcu;
    const int tokb = tg * 64;
    if (tid < 32) hist[tid] = 0u;
    for (int rb_ = 0; rb_ < RTR_REP_B; ++rb_) {
        bf16x8 wh[8], wl[8];
#pragma unroll
        for (int ks = 0; ks < 8; ++ks) { float wv[8];
#pragma unroll
            for (int j = 0; j < 8; ++j) { const int k = 128 * w + 16 * ks + 8 * hi + j; wv[j] = Wr[(size_t)k * NE + r32] * gain[k]; }
            u32x4 h4, l4;
#pragma unroll
            for (int j = 0; j < 4; ++j) { const unsigned hp = cvt_pk_bf16(wv[2 * j], wv[2 * j + 1]); h4[j] = hp; l4[j] = cvt_pk_bf16(wv[2 * j] - bflo(hp), wv[2 * j + 1] - bfhi(hp)); }
            wh[ks] = __builtin_bit_cast(bf16x8, h4); wl[ks] = __builtin_bit_cast(bf16x8, l4); }
#pragma unroll
        for (int g2 = 0; g2 < 2; ++g2) {
            const bf16_t* xr = x + (size_t)(tokb + 32 * g2 + r32) * DM + 128 * w + 8 * hi;
            f32x16 d = f32x16{}; float ss = 0.f;
#pragma unroll
            for (int ks = 0; ks < 8; ++ks) { const u32x4 xw = *(const u32x4*)(xr + 16 * ks);
#pragma unroll
                for (int j = 0; j < 4; ++j) { const float a = bflo(xw[j]), b = bfhi(xw[j]); ss += a * a + b * b; }
                const bf16x8 xh = __builtin_bit_cast(bf16x8, xw);
                d = __builtin_amdgcn_mfma_f32_32x32x16_bf16(wh[ks], xh, d, 0, 0, 0);
                d = __builtin_amdgcn_mfma_f32_32x32x16_bf16(wl[ks], xh, d, 0, 0, 0); }
            { auto rr = __builtin_amdgcn_permlane32_swap(__float_as_uint(ss), __float_as_uint(ss), false, false); ss = __uint_as_float(rr[0]) + __uint_as_float(rr[1]); }
            if (hi == 0) ssqp[w * 64 + 32 * g2 + r32] = ss;
#pragma unroll
            for (int r = 0; r < 16; ++r) part[(w * 64 + 32 * g2 + r32) * 33 + (r & 3) + 8 * (r >> 2) + 4 * hi] = d[r];
        }
    }
    __syncthreads();
    {   const int t = tid >> 3, q4 = (tid & 7) * 4; float s = 0.f;
#pragma unroll
        for (int ww = 0; ww < 8; ++ww) s += ssqp[ww * 64 + t];
        const float rstd = 1.0f / sqrtf(s * (1.f / DM) + EPS);
#pragma unroll
        for (int i = 0; i < 4; ++i) { float a = 0.f;
#pragma unroll
            for (int ww = 0; ww < 8; ++ww) a += part[(ww * 64 + t) * 33 + q4 + i];
            lg[t * 33 + q4 + i] = a * rstd + br[q4 + i]; } }
    __syncthreads();
    unsigned my_e[4] = {0, 0, 0, 0}, my_lr[4] = {0, 0, 0, 0}; float my_g[4] = {0, 0, 0, 0};
    if (tid < 64) {
        float v[32];
#pragma unroll
        for (int e = 0; e < 32; ++e) v[e] = lg[tid * 33 + e];
        int c0 = -1, c1 = -1, c2 = -1; float tv[4];
#pragma unroll
        for (int r = 0; r < 4; ++r) { float best = -__builtin_inff(); int bi = 0;
#pragma unroll
            for (int e = 0; e < 32; ++e) { const bool ok = (e != c0) && (e != c1) && (e != c2); if (ok && v[e] > best) { best = v[e]; bi = e; } }
            tv[r] = best; my_e[r] = (unsigned)bi; if (r == 0) c0 = bi; else if (r == 1) c1 = bi; else if (r == 2) c2 = bi; }
        const float p1 = __expf(tv[1] - tv[0]), p2 = __expf(tv[2] - tv[0]), p3 = __expf(tv[3] - tv[0]); const float inv = 1.0f / (1.0f + p1 + p2 + p3);
        my_g[0] = inv; my_g[1] = p1 * inv; my_g[2] = p2 * inv; my_g[3] = p3 * inv;
#pragma unroll
        for (int r = 0; r < 4; ++r) my_lr[r] = __hip_atomic_fetch_add(hist + my_e[r], 1u, __ATOMIC_RELAXED, __HIP_MEMORY_SCOPE_WORKGROUP);
    }
    __syncthreads();
    if (tid < 32) { const unsigned hc = hist[tid]; base[tid] = hc ? __hip_atomic_fetch_add(cnt + 64 * tid, hc, RLX_AGENT) : 0u; }
    __syncthreads();
    if (tid < 64) {
        u32x4 er; f32x4 gt;
#pragma unroll
        for (int r = 0; r < 4; ++r) { const unsigned rank = base[my_e[r]] + my_lr[r]; er[r] = (my_e[r] << 16) | rank; gt[r] = my_g[r]; ers[tid * 4 + r] = er[r]; }
        *(u32x4*)(tok_er + (size_t)(tokb + tid) * 4) = er; *(f32x4*)(tok_g + (size_t)(tokb + tid) * 4) = gt;
    }
    __syncthreads();
    for (int rc_ = 0; rc_ < RTR_REP_C; ++rc_)
#pragma unroll 2
    for (int tt = 0; tt < 8; ++tt) {
        const int tl = w * 8 + tt; const bf16_t* xrow = x + (size_t)(tokb + tl) * DM;
        f32x4 hv[4]; float s = 0.f;
#pragma unroll
        for (int j = 0; j < 4; ++j) { const u32x2 t = ((const u32x2*)xrow + lane)[64 * j]; hv[j] = (f32x4){bflo(t.x), bfhi(t.x), bflo(t.y), bfhi(t.y)}; s += (hv[j].x * hv[j].x + hv[j].y * hv[j].y) + (hv[j].z * hv[j].z + hv[j].w * hv[j].w); }
        const float rstd = 1.0f / sqrtf(wave_sum(s) * (1.f / DM) + EPS);
        unsigned wv[4];
#pragma unroll
        for (int j = 0; j < 4; ++j) { const f32x4 t = hv[j] * rstd * gg[j]; wv[j] = pk4_fp8(t.x, t.y, t.z, t.w); }
#pragma unroll
        for (int r = 0; r < 4; ++r) { const unsigned er = ers[tl * 4 + r]; const size_t slot = (size_t)(er >> 16) * ECAP + (er & 0xffffu);
            unsigned* o4 = (unsigned*)(XG + slot * DM) + lane;
#pragma unroll
            for (int j = 0; j < 4; ++j) o4[64 * j] = wv[j]; }
    }
    __syncthreads();
    }
}

__device__ __forceinline__ void combine_phase(Frame& F, bf16_t* x, float* out32  , const unsigned* tok_er, const float* tok_g, const bf16_t* Y, const float* g_next, unsigned char* XN, bool xn_fp8) {
    int tid_ = threadIdx.x; asm volatile("" : "+v"(tid_));
    const int gw = F.vcu * NWAVES + __builtin_amdgcn_readfirstlane(tid_ >> 6), NGW = F.G * NWAVES, lane = tid_ & 63;
    u32x4 erA, erB, erAn, erBn; f32x4 gtA, gtB, gtAn, gtBn;
    { const int ma = gw < M ? gw : 0, mb0 = gw + NGW < M ? gw + NGW : ma;
      erAn = *(const u32x4*)(tok_er + (size_t)ma * 4); erBn = *(const u32x4*)(tok_er + (size_t)mb0 * 4); gtAn = *(const f32x4*)(tok_g + (size_t)ma * 4); gtBn = *(const f32x4*)(tok_g + (size_t)mb0 * 4); }
    for (int m0 = gw; m0 < M; m0 += 2 * NGW) {
        const int m1 = m0 + NGW; const bool two = m1 < M; const int mb = two ? m1 : m0;
        erA = erAn; erB = erBn; gtA = gtAn; gtB = gtBn;
        { const int na = m0 + 2 * NGW < M ? m0 + 2 * NGW : m0, nb2 = m0 + 3 * NGW < M ? m0 + 3 * NGW : na;
          erAn = *(const u32x4*)(tok_er + (size_t)na * 4); erBn = *(const u32x4*)(tok_er + (size_t)nb2 * 4); gtAn = *(const f32x4*)(tok_g + (size_t)na * 4); gtBn = *(const f32x4*)(tok_g + (size_t)nb2 * 4); }
        bf16_t* xrA = x + (size_t)m0 * DM; bf16_t* xrB = x + (size_t)mb * DM;
        u32x2 xa[4], xb[4], ya[4][4], yb[4][4];
#pragma unroll
        for (int j = 0; j < 4; ++j) { xa[j] = ((const u32x2*)xrA + lane)[64 * j]; xb[j] = ((const u32x2*)xrB + lane)[64 * j]; }
#pragma unroll
        for (int r = 0; r < 4; ++r) { const size_t sA = (size_t)(erA[r] >> 16) * ECAP + (erA[r] & 0xffffu), sB = (size_t)(erB[r] >> 16) * ECAP + (erB[r] & 0xffffu);
#pragma unroll
            for (int j = 0; j < 4; ++j) { ya[r][j] = ((const u32x2*)(Y + sA * DM) + lane)[64 * j]; yb[r][j] = ((const u32x2*)(Y + sB * DM) + lane)[64 * j]; } }
#pragma unroll
        for (int t = 0; t < 2; ++t) {
            if (t == 1 && !two) break;
            const int m = t ? m1 : m0; bf16_t* xrow = t ? xrB : xrA; const f32x4 gt = t ? gtB : gtA;
            f32x4 v[4];
#pragma unroll
            for (int j = 0; j < 4; ++j) { const u32x2 q = t ? xb[j] : xa[j]; v[j] = (f32x4){bflo(q.x), bfhi(q.x), bflo(q.y), bfhi(q.y)}; }
#pragma unroll
            for (int r = 0; r < 4; ++r) { const float g = gt[r];
#pragma unroll
                for (int j = 0; j < 4; ++j) { const u32x2 yv = t ? yb[r][j] : ya[r][j]; v[j].x += g * bflo(yv.x); v[j].y += g * bfhi(yv.x); v[j].z += g * bflo(yv.y); v[j].w += g * bfhi(yv.y); } }
#pragma unroll
            for (int j = 0; j < 4; ++j) { if (out32) ((f32x4*)(out32 + (size_t)m * DM) + lane)[64 * j] = v[j];
                else { u32x2 q; q.x = cvt_pk_bf16(v[j].x, v[j].y); q.y = cvt_pk_bf16(v[j].z, v[j].w); ((u32x2*)xrow + lane)[64 * j] = q; } }
            if (g_next) {
                float s = 0.f;
#pragma unroll
                for (int j = 0; j < 4; ++j) s += (v[j].x * v[j].x + v[j].y * v[j].y) + (v[j].z * v[j].z + v[j].w * v[j].w);
                const float rstd = 1.0f / sqrtf(wave_sum(s) * (1.f / DM) + EPS);
                unsigned* o4 = (unsigned*)(XN + (size_t)m * DM) + lane; u32x2* o8 = (u32x2*)(XN + (size_t)m * DM * 2) + lane;
#pragma unroll
                for (int j = 0; j < 4; ++j) { const f32x4 gg = ((const f32x4*)g_next + lane)[64 * j];
                    if (xn_fp8) o4[64 * j] = pk4_fp8(v[j].x * rstd * gg.x, v[j].y * rstd * gg.y, v[j].z * rstd * gg.z, v[j].w * rstd * gg.w);
                    else { u32x2 w; w.x = cvt_pk_bf16(v[j].x * rstd * gg.x, v[j].y * rstd * gg.y); w.y = cvt_pk_bf16(v[j].z * rstd * gg.z, v[j].w * rstd * gg.w); o8[64 * j] = w; } }
            }
        }
    }
}

__device__ __forceinline__ void unpack8f8(const u32x2 w, float (&f)[8]) { const f32x2 a = __builtin_amdgcn_cvt_pk_f32_fp8((int)w.x, false), b = __builtin_amdgcn_cvt_pk_f32_fp8((int)w.x, true),
    c = __builtin_amdgcn_cvt_pk_f32_fp8((int)w.y, false), d = __builtin_amdgcn_cvt_pk_f32_fp8((int)w.y, true); f[0] = a.x; f[1] = a.y; f[2] = b.x; f[3] = b.y; f[4] = c.x; f[5] = c.y; f[6] = d.x; f[7] = d.y; }
__device__ __forceinline__ void unpack4f8(const unsigned w, float (&f)[4]) { const f32x2 a = __builtin_amdgcn_cvt_pk_f32_fp8((int)w, false), b = __builtin_amdgcn_cvt_pk_f32_fp8((int)w, true); f[0] = a.x; f[1] = a.y; f[2] = b.x; f[3] = b.y; }
__device__ __forceinline__ void unpack8(const u32x4 w, float (&f)[8]) { f[0] = bflo(w.x); f[1] = bfhi(w.x); f[2] = bflo(w.y); f[3] = bfhi(w.y); f[4] = bflo(w.z); f[5] = bfhi(w.z); f[6] = bflo(w.w); f[7] = bfhi(w.w); }
__device__ __forceinline__ void unpack4(const u32x2 w, float (&f)[4]) { f[0] = bflo(w.x); f[1] = bfhi(w.x); f[2] = bflo(w.y); f[3] = bfhi(w.y); }
__device__ __forceinline__ void fin_head(const float (&a)[8], const float (&b)[8], const float (&x1)[4], const float (&x2)[4], const float (&g)[24], const float (&cs)[4], const float (&sn)[4], unsigned char* op, int j, float scale) {
    float ss = 0.f;
#pragma unroll
    for (int i = 0; i < 8; ++i) ss += a[i] * a[i] + b[i] * b[i];
#pragma unroll
    for (int i = 0; i < 4; ++i) ss += x1[i] * x1[i] + x2[i] * x2[i];
    ss += __shfl_xor(ss, 1); ss += __shfl_xor(ss, 2); ss += __shfl_xor(ss, 4);
    const float rstd = scale / sqrtf(ss * (1.0f / 192.0f) + EPS);
    u32x4 o0;
    o0.x = pk4_fp8(a[0] * rstd * g[0], a[1] * rstd * g[1], a[2] * rstd * g[2], a[3] * rstd * g[3]); o0.y = pk4_fp8(a[4] * rstd * g[4], a[5] * rstd * g[5], a[6] * rstd * g[6], a[7] * rstd * g[7]);
    o0.z = pk4_fp8(b[0] * rstd * g[8], b[1] * rstd * g[9], b[2] * rstd * g[10], b[3] * rstd * g[11]); o0.w = pk4_fp8(b[4] * rstd * g[12], b[5] * rstd * g[13], b[6] * rstd * g[14], b[7] * rstd * g[15]);
    float y1[4], y2[4];
#pragma unroll
    for (int i = 0; i < 4; ++i) { const float u = x1[i] * rstd * g[16 + i], v = x2[i] * rstd * g[20 + i]; y1[i] = u * cs[i] - v * sn[i]; y2[i] = u * sn[i] + v * cs[i]; }
    *(u32x4*)(op + 16 * j) = o0; *(unsigned*)(op + 128 + 4 * j) = pk4_fp8(y1[0], y1[1], y1[2], y1[3]); *(unsigned*)(op + 160 + 4 * j) = pk4_fp8(y2[0], y2[1], y2[2], y2[3]);
}
__device__ __forceinline__ void mla_finalize_phase(Frame& F, const unsigned char* QR, const unsigned char* KVR, const bf16_t* Z, const float* gq, const float* gk, unsigned char* QF, unsigned char* KF) {
    int tid_ = threadIdx.x; asm volatile("" : "+v"(tid_));
    const int gw = F.vcu * NWAVES + __builtin_amdgcn_readfirstlane(tid_ >> 6), NGW = F.G * NWAVES, lane = tid_ & 63;
    const int h = lane >> 3, j = lane & 7;
    float gqv[24], gkv[24], invf[4];
#pragma unroll
    for (int i = 0; i < 16; ++i) { gqv[i] = gq[16 * j + i]; gkv[i] = gk[16 * j + i]; }
#pragma unroll
    for (int i = 0; i < 4; ++i) { gqv[16 + i] = gq[128 + 4 * j + i]; gqv[20 + i] = gq[160 + 4 * j + i]; gkv[16 + i] = gk[128 + 4 * j + i]; gkv[20 + i] = gk[160 + 4 * j + i];
        invf[i] = __builtin_amdgcn_exp2f(-(float)(4 * j + i) * (13.287712379549449f / 32.0f)); }
#pragma unroll 2
    for (int m = gw; m < M; m += NGW) {
        const int pos = m & (SEQ - 1);
        float cs[4], sn[4];
#pragma unroll
        for (int i = 0; i < 4; ++i) { const double rev = (double)pos * (double)invf[i] * 0.15915494309189535; const float fr = (float)(rev - __builtin_rint(rev));
            sn[i] = __builtin_amdgcn_sinf(fr); cs[i] = __builtin_amdgcn_cosf(fr); }
        const unsigned char* qp = QR + (size_t)m * 1536 + h * 192; const unsigned char* kp = KVR + (size_t)m * 2048 + h * 256; const bf16_t* zp = Z + (size_t)m * ODD_INP + 768;
        const u32x4 qn = *(const u32x4*)(qp + 16 * j); const unsigned qr1 = *(const unsigned*)(qp + 128 + 4 * j), qr2 = *(const unsigned*)(qp + 160 + 4 * j);
        const u32x4 kn = *(const u32x4*)(kp + 16 * j); const u32x2 kr1 = *(const u32x2*)(zp + 4 * j), kr2 = *(const u32x2*)(zp + 32 + 4 * j);
        float a[8], b[8], x1[4], x2[4];
        unpack8f8((u32x2){qn.x, qn.y}, a); unpack8f8((u32x2){qn.z, qn.w}, b); unpack4f8(qr1, x1); unpack4f8(qr2, x2);
        fin_head(a, b, x1, x2, gqv, cs, sn, QF + (size_t)m * 1536 + h * 192, j, 8.0f * C2_C);
        unpack8f8((u32x2){kn.x, kn.y}, a); unpack8f8((u32x2){kn.z, kn.w}, b); unpack4(kr1, x1); unpack4(kr2, x2);
        fin_head(a, b, x1, x2, gkv, cs, sn, KF + (size_t)m * 1536 + h * 192, j, 1.0f);
    }
}

__device__ __forceinline__ void vt_phase(Frame& F, const unsigned char* KVR, unsigned char* VT8) {
    int tid_ = threadIdx.x; asm volatile("" : "+v"(tid_));
    const int tid = tid_;
    LAS unsigned char* T = F.lds + RING_OFF;
    for (int it = F.vcu; it < M / 64; it += F.G) {
        const int m0 = it * 64, b = m0 / SEQ, tok0 = m0 % SEQ;
#pragma unroll 4
        for (int k = 0; k < 8; ++k) { const int idx = tid + 512 * k, tok = idx >> 6, grp = idx & 63, h = grp >> 3, d16 = (grp & 7) * 16;
            const u32x4 w = *(const u32x4*)(KVR + (size_t)(m0 + tok) * 2048 + h * 256 + 128 + d16);
            LAS unsigned char* tp = T + (h * 128 + d16) * 80 + tok;
#pragma unroll
            for (int i = 0; i < 4; ++i) { const unsigned x = w[i]; tp[(4 * i) * 80] = (unsigned char)x; tp[(4 * i + 1) * 80] = (unsigned char)(x >> 8); tp[(4 * i + 2) * 80] = (unsigned char)(x >> 16); tp[(4 * i + 3) * 80] = (unsigned char)(x >> 24); } }
        __syncthreads();
#pragma unroll 4
        for (int k = 0; k < 8; ++k) { const int idx = tid + 512 * k, row = idx >> 2, q = idx & 3;
            const u32x4 v = *(const LAS u32x4*)(T + row * 80 + 16 * q);
            *(u32x4*)(VT8 + ((size_t)b * 1024 + row) * SEQ + tok0 + 16 * q) = v; }
        __syncthreads();
    }
}

#ifndef PHMASK
#define PHMASK 0xFFFF
#endif
#ifndef REPMASK
#define REPMASK 0
#endif
#ifndef REPCNT
#define REPCNT 3
#endif
#define NREP(k) ((((REPMASK) >> (k)) & 1) ? (REPCNT) : 1)

#define LAUNDER_S(x) asm volatile("" : "+s"(x))
__device__ __forceinline__ const float* in_ptr(const Args& a, int i) { LAUNDER_S(i); return a.in[i]; }
#define PHASE_BEGIN() unsigned wso_ = 0u; LAUNDER_S(wso_); unsigned char* ws = args.ws + wso_; Frame Fp = F; Fp.vcu = __builtin_amdgcn_readfirstlane(Fp.vcu); Fp.G = __builtin_amdgcn_readfirstlane(Fp.G); LAUNDER_S(Fp.vcu); LAUNDER_S(Fp.G); \
    int bx_ = __builtin_amdgcn_readfirstlane((int)blockIdx.x); LAUNDER_S(bx_); (void)bx_; (void)ws
#define XN  ((unsigned char*)(ws + WS_XN))
#define Z   ((bf16_t*)(ws + WS_Z))
#define MIX ((bf16_t*)(ws + WS_MIX))
#define QR  ((unsigned char*)(ws + WS_QR))
#define KVR ((unsigned char*)(ws + WS_KVR))
#define QF  ((unsigned char*)(ws + WS_QF))
#define KF  ((unsigned char*)(ws + WS_KF))
#define XG  ((unsigned char*)(ws + WS_XG))
#define ACT ((unsigned char*)(ws + WS_ACT))
#define YB  ((bf16_t*)(ws + WS_Y))
#define SSQ ((float*)(ws + WS_SSQ))
#define TOKER ((unsigned*)(ws + WS_TOKER))
#define TOKG ((float*)(ws + WS_TOKG))
#define B1P ((float*)(ws + WS_B1P))
#define IN(i) in_ptr(args, (i))
__global__ void __launch_bounds__(NWAVES * 64, 2) trunk_fwd(Args args) {
    extern __shared__ __attribute__((aligned(16))) unsigned char lds_raw[];
    Frame F;
    F.lds = (LAS unsigned char*)lds_raw;
    F.G = gridDim.x; { const int bx = blockIdx.x; F.vcu = (F.G % 8 == 0) ? (bx % 8) * (F.G / 8) + bx / 8 : bx; }
    for (int u = threadIdx.x; u < (SCR_OFF - LDSCTL_OFF) / 4; u += NWAVES * 64) ((LAS unsigned*)(F.lds + LDSCTL_OFF))[u] = 0u;
    __syncthreads();
    (void)xcd_barrier_post((unsigned*)((gu32*)(args.ws + WS_CTL) + CW_BAR), (volatile LAS unsigned*)(F.lds + MISC_OFF) + 8);
#define GRID_BAR() do { unsigned wsb_ = 0u; LAUNDER_S(wsb_); XcdBarrier bar_; bar_.bar = (unsigned*)((gu32*)(args.ws + wsb_ + WS_CTL) + CW_BAR); bar_.x = xb_xcc_id(); \
        bar_.st = (volatile LAS unsigned*)(F.lds + MISC_OFF) + 8; xcd_barrier(bar_); } while (0)
#define X16 ((bf16_t*)(ws + WS_X16))
    const int stage_limit = args.stage_limit;

#if (PHMASK >> 0) & 1
            _Pragma("unroll") for (int rep_ = 0; rep_ < NREP(0); ++rep_) { if (rep_) GRID_BAR();
    {   PHASE_BEGIN(); const int ptid = threadIdx.x, gw = Fp.vcu * NWAVES + __builtin_amdgcn_readfirstlane(ptid >> 6), NGW = Fp.G * NWAVES;
        transpose_job<1>(Fp, IN(I_EWIN), DM, EVEN_IN, 2, (size_t)DM * EVEN_IN, (bf16_t*)(ws + WS_WEIN), (size_t)EVEN_IN * DM, nullptr, 0);
        transpose_job<0>(Fp, IN(I_EWOUT), DM, DM, 2, (size_t)DM * DM, (bf16_t*)(ws + WS_WEOUT), (size_t)DM * DM, nullptr, 0);
        transpose_job_fp8<0>(Fp, IN(I_OWIN), DM, ODD_IN, 2, (size_t)DM * ODD_IN, ws + WS_WOIN, (size_t)ODD_INP * DM);
        transpose_job_fp8<0>(Fp, IN(I_OWUQ), 512, 1536, 2, (size_t)512 * 1536, ws + WS_WUQ, (size_t)1536 * 512, IN(I_OGCQ), 512);
        transpose_job_fp8<0>(Fp, IN(I_OWUKV), 256, 2048, 2, (size_t)256 * 2048, ws + WS_WUKV, (size_t)2048 * 256, IN(I_OGCKV), 256);
        transpose_job_fp8<0>(Fp, IN(I_OWOUT), DM, DM, 2, (size_t)DM * DM, ws + WS_WOOUT, (size_t)DM * DM);
        transpose_job_fp8<2>(Fp, IN(I_W1), DM, 2 * DE, DEPTH * NE, (size_t)DM * 2 * DE, ws + WS_W1, (size_t)2 * DE * DM);
        transpose_job_fp8<0>(Fp, IN(I_W2), DE, DM, DEPTH * NE, (size_t)DE * DM, ws + WS_W2, (size_t)DM * DE);
        for (int i = bx_ * 512 + ptid; i < 2 * 12288; i += Fp.G * 512) { const int mi = i / 12288, r = i % 12288;
            *(u32x4*)(ws + WS_WOIN + (size_t)mi * ODD_INP * DM + (size_t)ODD_IN * DM + (size_t)r * 16) = (u32x4){0u, 0u, 0u, 0u}; }
        for (int i = bx_ * 512 + ptid; i < DEPTH * NE * 2048; i += Fp.G * 512) { const int c = i & 2047, o = 2 * (128 * (c >> 8) + (c & 127)) + ((c >> 7) & 1);
            B1P[i] = IN(I_B1)[(size_t)(i & ~2047) + o]; }
        for (int m = gw; m < M; m += NGW) rms_row_to_bf16(ptid & 63, IN(I_X) + (size_t)m * DM, IN(I_MIXN), (bf16_t*)XN + (size_t)m * DM, nullptr);
    }
            }
#endif
    GRID_BAR();

#ifdef EXTRA_BARS
    for (int xb_ = 0; xb_ < EXTRA_BARS; ++xb_) GRID_BAR();
#endif
    for (int l = 0; l < DEPTH; ++l) {
        const int li = l >> 1;
        if (2 * l + 1 > stage_limit) break;
        if ((l & 1) == 0) {
#if (PHMASK >> 1) & 1
            _Pragma("unroll") for (int rep_ = 0; rep_ < NREP(1); ++rep_) { if (rep_) GRID_BAR();
            {   PHASE_BEGIN(); pg8::Gemm g{(const bf16_t*)XN, (const bf16_t*)(ws + WS_WEIN) + (size_t)li * EVEN_IN * DM, DM, DM, nullptr, nullptr}; pg8::StaticOrder S; S.init(M, EVEN_IN, Fp.G, bx_);
                pg8::EpiEvenIn E{Z, IN(I_EGQ) + li * 64, IN(I_EGK) + li * 64};
                pg8::gemm_phase<pg8::EpiEvenIn, pg8::StaticOrder>(Fp.lds + RING_OFF, g, S, E); }
            }
#endif
            GRID_BAR();
            {   PHASE_BEGIN();
#if (PHMASK >> 2) & 1
            _Pragma("unroll") for (int rep_ = 0; rep_ < NREP(2); ++rep_) { if (rep_) GRID_BAR();
                for (int u = Fp.vcu; u < 512; u += Fp.G)
                    gmlp_unit(Fp, Z, MIX, IN(I_EWS) + (size_t)li * 4 * 128 * 128, IN(I_EBS) + li * 512, IN(I_EGV) + li * 512, u);
            }
#endif
#if (PHMASK >> 3) & 1
            _Pragma("unroll") for (int rep_ = 0; rep_ < NREP(3); ++rep_) { if (rep_) GRID_BAR();
                for (int u = Fp.vcu; u < 256; u += Fp.G) { const int bh = u >> 4, s = u & 15, b = bh >> 3, h = bh & 7;
                    for (int pass = 0; pass < 2; ++pass) { const int qb = pass ? 31 - s : s;
                        const bf16_t* zb = Z + (size_t)b * SEQ * EVEN_IN;
                        dil::unit(zb + 1024 + 64 * h, zb + 1536 + 64 * h, zb + 2048 + 64 * h, EVEN_IN, MIX + (size_t)b * SEQ * DM + 512 + 64 * h, DM, qb * 256, Fp.lds + RING_OFF, (LAS float*)(Fp.lds + SCR_OFF)); } }
            }
#endif
            }
            GRID_BAR();
#if (PHMASK >> 4) & 1
            _Pragma("unroll") for (int rep_ = 0; rep_ < NREP(4); ++rep_) { if (rep_) GRID_BAR();
            {   PHASE_BEGIN(); pg8::Gemm g{MIX, (const bf16_t*)(ws + WS_WEOUT) + (size_t)li * DM * DM, DM, DM, nullptr, nullptr}; pg8::StaticOrder S; S.init(M, DM, Fp.G, bx_);
                pg8::EpiResid E{l == 0 ? IN(I_X) : nullptr, X16};
                pg8::gemm_phase<pg8::EpiResid, pg8::StaticOrder>(Fp.lds + RING_OFF, g, S, E); }
            }
#endif
            GRID_BAR();
        } else {
#if (PHMASK >> 5) & 1
            _Pragma("unroll") for (int rep_ = 0; rep_ < NREP(5); ++rep_) { if (rep_) GRID_BAR();
            {   PHASE_BEGIN(); pg8::Gemm g{(const bf16_t*)XN, (const bf16_t*)(ws + WS_WOIN + (size_t)li * ODD_INP * DM), DM / 2, DM / 2, nullptr, nullptr}; pg8::StaticOrder S; S.init(M, ODD_INP, Fp.G, bx_);
                pg8::EpiOddIn E{Z, ws + WS_Z8, SSQ};
                pg8::gemm_phase<pg8::EpiOddIn, pg8::StaticOrder, true>(Fp.lds + RING_OFF, g, S, E); }
            }
#endif
            GRID_BAR();
#if (PHMASK >> 6) & 1
            _Pragma("unroll") for (int rep_ = 0; rep_ < NREP(6); ++rep_) { if (rep_) GRID_BAR();
            {   PHASE_BEGIN(); pg8::Gemm g{(const bf16_t*)(ws + WS_Z8 + 512), (const bf16_t*)(ws + WS_WUKV + (size_t)li * 2048 * 256), ODD_INP / 2, 128, nullptr, nullptr}; pg8::StaticOrder S; S.init(M, 2048, Fp.G, bx_);
                pg8::EpiRowScale<1> E{KVR, 2048, SSQ, 8, 1.0f / 256.0f};
                pg8::gemm_phase<pg8::EpiRowScale<1>, pg8::StaticOrder, true>(Fp.lds + RING_OFF, g, S, E); }
            {   PHASE_BEGIN(); pg8::Gemm g{(const bf16_t*)(ws + WS_Z8), (const bf16_t*)(ws + WS_WUQ + (size_t)li * 1536 * 512), ODD_INP / 2, 256, nullptr, nullptr}; pg8::StaticOrder S; S.init(M, 1536, Fp.G, bx_);
                pg8::EpiRowScale<2> E{QR, 1536, SSQ, 0, 1.0f / 512.0f};
                pg8::gemm_phase<pg8::EpiRowScale<2>, pg8::StaticOrder, true>(Fp.lds + RING_OFF, g, S, E); }
            }
#endif
            GRID_BAR();
#if (PHMASK >> 7) & 1
            _Pragma("unroll") for (int rep_ = 0; rep_ < NREP(7); ++rep_) { if (rep_) GRID_BAR();
            {   PHASE_BEGIN(); mla_finalize_phase(Fp, QR, KVR, Z, IN(I_OGQ) + li * 192, IN(I_OGK) + li * 192, QF, KF); vt_phase(Fp, KVR, ws + WS_VT); }
            }
#endif
            GRID_BAR();
#if (PHMASK >> 8) & 1
            _Pragma("unroll") for (int rep_ = 0; rep_ < NREP(8); ++rep_) { if (rep_) GRID_BAR();
            {   PHASE_BEGIN();
                for (int u = Fp.vcu; u < 256; u += Fp.G) { const int bh = u >> 4, s = u & 15, b = bh >> 3, h = bh & 7;
                    for (int pass = 0; pass < 2; ++pass) { const int qb = pass ? 31 - s : s;
                        mla::unit(QF + (size_t)b * SEQ * 1536 + 192 * h, KF + (size_t)b * SEQ * 1536 + 192 * h, 1536, ws + WS_VT + ((size_t)(b * 8 + h) * 128) * SEQ,
                                  ws + WS_MIX8 + (size_t)b * SEQ * DM + 128 * h, DM, qb * 256, Fp.lds + RING_OFF); } }
            }
            }
#endif
            GRID_BAR();
#if (PHMASK >> 9) & 1
            _Pragma("unroll") for (int rep_ = 0; rep_ < NREP(9); ++rep_) { if (rep_) GRID_BAR();
            {   PHASE_BEGIN(); pg8::Gemm g{(const bf16_t*)(ws + WS_MIX8), (const bf16_t*)(ws + WS_WOOUT + (size_t)li * DM * DM), DM / 2, DM / 2, nullptr, nullptr}; pg8::StaticOrder S; S.init(M, DM, Fp.G, bx_);
                pg8::EpiResidT<true> E{nullptr, X16};
                pg8::gemm_phase<pg8::EpiResidT<true>, pg8::StaticOrder, true>(Fp.lds + RING_OFF, g, S, E); }
            }
#endif
            GRID_BAR();
        }
        if (2 * l + 2 > stage_limit) break;
#if (PHMASK >> 10) & 1
            _Pragma("unroll") for (int rep_ = 0; rep_ < NREP(10); ++rep_) {
        {   PHASE_BEGIN(); const bool dry = rep_ + 1 < NREP(10);
            gu32* cnt = (gu32*)(ws + WS_CTL) + CW_CNT + (size_t)(dry ? 8 + 4 * rep_ + l : l) * 32 * 64;
        router_phase(Fp, X16, IN(I_FFNN) + l * DM, IN(I_RW) + (size_t)l * DM * NE, IN(I_RB) + l * NE, cnt, dry ? (unsigned*)(ws + WS_QR) : TOKER, dry ? (float*)(ws + WS_QR + MiB) : TOKG, dry ? ACT : XG); }
        GRID_BAR();
            }
#endif
        LAS int* tbl = (LAS int*)(F.lds + SCR_OFF + 12288);
        {   PHASE_BEGIN(); gu32* cnt = (gu32*)(ws + WS_CTL) + CW_CNT + (size_t)l * 32 * 64;
        if (threadIdx.x == 0) { int acc = 0; for (int e = 0; e < NE; ++e) { tbl[e] = acc; const unsigned c = __hip_atomic_load(cnt + 64 * e, RLX_AGENT); acc += (int)((c + 255u) >> 8); } tbl[NE] = acc; }
        __syncthreads(); }
#if (PHMASK >> 11) & 1
            _Pragma("unroll") for (int rep_ = 0; rep_ < NREP(11); ++rep_) { if (rep_) GRID_BAR();
        {   PHASE_BEGIN();
            pg8::Gemm g{(const bf16_t*)XG, (const bf16_t*)(ws + WS_W1 + (size_t)l * NE * 2 * DE * DM), DM / 2, DM / 2, (const bf16_t*)ACT, (const bf16_t*)(ws + WS_W2 + (size_t)l * NE * DM * DE)};
            pg8::MoeMergedOrder S{tbl, Fp.G, Fp.vcu, (gu32*)(ws + WS_CTL) + CW_MOE + (size_t)(l * 320 + 1280 * rep_) * 16, -1};
            pg8::EpiMoe E{{ACT, B1P + (size_t)l * NE * 2048}, {YB, IN(I_B2) + (size_t)l * NE * DM}};
            pg8::gemm_phase<pg8::EpiMoe, pg8::MoeMergedOrder, true>(Fp.lds + RING_OFF, g, S, E); }
            }
#endif
        GRID_BAR();
#if (PHMASK >> 13) & 1
            _Pragma("unroll") for (int rep_ = 0; rep_ < NREP(13); ++rep_) {
        {   PHASE_BEGIN(); const bool dry = rep_ + 1 < NREP(13);
            combine_phase(Fp, dry ? (bf16_t*)(ACT + (size_t)128 * MiB) : X16, (!dry && l + 1 == DEPTH) ? args.out : nullptr, TOKER, TOKG, YB, (l + 1 < DEPTH) ? IN(I_MIXN) + (l + 1) * DM : nullptr, dry ? (ACT + (size_t)64 * MiB) : XN, (l & 1) == 0); }
        GRID_BAR();
            }
#endif
    }
#undef GRID_BAR
}

extern "C" void kernel_launch(void* const* d_in, const int* in_sizes, int n_in, void* d_out, int out_size, void* d_ws, size_t ws_size, hipStream_t stream) {
    static int grid = 0;
    if (grid == 0) {
        if (n_in != 24 || in_sizes[0] != M * DM || out_size != M * DM || ws_size < WS_END) {
            fprintf(stderr, "kernel_launch: unexpected shapes (n_in %d, in0 %d, out %d, ws %zu, need %zu)\n", n_in, n_in > 0 ? in_sizes[0] : -1, out_size, ws_size, (size_t)WS_END); grid = -1; return; }
        int dev = 0, cus = 0, per_cu = 0;
        if (hipGetDevice(&dev) != hipSuccess || hipDeviceGetAttribute(&cus, hipDeviceAttributeMultiprocessorCount, dev) != hipSuccess) { grid = -1; return; }
        if (hipFuncSetAttribute((const void*)trunk_fwd, hipFuncAttributeMaxDynamicSharedMemorySize, LDS_BYTES) != hipSuccess) { fprintf(stderr, "kernel_launch: hipFuncSetAttribute failed\n"); grid = -1; return; }
        if (hipOccupancyMaxActiveBlocksPerMultiprocessor(&per_cu, (const void*)trunk_fwd, NWAVES * 64, LDS_BYTES) != hipSuccess || per_cu < 1)
            fprintf(stderr, "kernel_launch: occupancy query reports %d workgroups per CU\n", per_cu);
        (void)hipGetLastError();
        if (cus < 256) { fprintf(stderr, "kernel_launch: needs 256 CUs, device has %d\n", cus); grid = -1; return; }
        grid = 256;
    }
    if (grid < 0) return;
    if (hipMemsetAsync((char*)d_ws + WS_CTL, 0, CTL_ZERO_BYTES, stream) != hipSuccess) return;
    Args a{};
    for (int i = 0; i < 24; ++i) a.in[i] = (const float*)d_in[i];
    a.out = (float*)d_out; a.ws = (unsigned char*)d_ws; a.stage_limit = STAGE_LIMIT; a.pad = 0;
    hipLaunchKernelGGL(trunk_fwd, dim3(grid), dim3(NWAVES * 64), LDS_BYTES, stream, a);
}
```

```cpp
#include <hip/hip_runtime.h>
#include <hip/hip_bf16.h>
#include <cstdio>
#include <cstdint>

#define LAS __attribute__((address_space(3)))
#define GAS __attribute__((address_space(1)))
typedef unsigned short bf16_t;
typedef short bf16x8 __attribute__((ext_vector_type(8)));
typedef short s16x4 __attribute__((ext_vector_type(4)));
typedef float f32x2 __attribute__((ext_vector_type(2)));
typedef float f32x4 __attribute__((ext_vector_type(4)));
typedef float f32x16 __attribute__((ext_vector_type(16)));
typedef unsigned u32x2 __attribute__((ext_vector_type(2)));
typedef unsigned u32x4 __attribute__((ext_vector_type(4)));
typedef int i32x4 __attribute__((ext_vector_type(4)));
typedef int i32x8 __attribute__((ext_vector_type(8)));

constexpr int BATCH = 2, SEQ = 8192, DM = 1024, M = BATCH * SEQ, DEPTH = 4;
constexpr int EVEN_IN = 2560, ODD_IN = 832, ODD_INP = 1024;
constexpr int NE = 32, DE = 1024, ECAP = 16384;
constexpr float EPS = 1e-6f;
constexpr float LOG2E = 1.4426950408889634f;
constexpr float C2_B = 0.125f * LOG2E;
constexpr float C2_C = 0.07216878364870322f * LOG2E;

__device__ __forceinline__ unsigned cvt_pk_bf16(float lo, float hi) { unsigned r; asm volatile("v_cvt_pk_bf16_f32 %0, %1, %2" : "=v"(r) : "v"(lo), "v"(hi)); return r; }
__device__ __forceinline__ float bf2f(bf16_t v) { return __uint_as_float(((unsigned)v) << 16); }
__device__ __forceinline__ float bflo(unsigned w) { return __uint_as_float(w << 16); }
__device__ __forceinline__ float bfhi(unsigned w) { return __uint_as_float(w & 0xffff0000u); }
__device__ __forceinline__ bf16_t f2bf(float f) { return (bf16_t)(cvt_pk_bf16(f, 0.f) & 0xffffu); }

__device__ __forceinline__ unsigned pk4_fp8(float a, float b, float c, float d) { int w = 0; w = __builtin_amdgcn_cvt_pk_fp8_f32(a, b, w, false); w = __builtin_amdgcn_cvt_pk_fp8_f32(c, d, w, true); return (unsigned)w; }
constexpr float W8_SCALE = 64.0f, W8_INV = 1.0f / 64.0f;
constexpr float Y8_SCALE = 16.0f, Y8_INV = 1.0f / 16.0f;

namespace pg8 {
constexpr int BM = 256, BK = 64, HALF = 128, HTB = HALF * BK * 2, STAGE_BYTES = 8 * HTB, NXCD = 8, WGM = 8;
__host__ __device__ __forceinline__ int lds_byte(int r, int c) { const int st = (r >> 4) * 2 + (c >> 5), rr = r & 15, cc = c & 31, ob = rr * 64 + cc * 2; return st * 1024 + (ob ^ (((ob >> 9) & 1) << 5)); }
__host__ __device__ __forceinline__ void stage_rc(int b, int& R, int& C) { const int st = b / 1024, sb = b % 1024, swz = sb ^ (((sb >> 9) & 1) << 5); R = (st >> 1) * 16 + swz / 64; C = (st & 1) * 32 + (swz % 64) / 2; }
__host__ __device__ __forceinline__ int perm32(int rho) { const int n = rho >> 4, i = rho & 15; return 8 * (i >> 2) + 4 * n + (i & 3); }

struct Unit { int pm, pn, pb, kind, rb; };
struct Gemm { const bf16_t* A; const bf16_t* Bt; int lda, K; const bf16_t* A2; const bf16_t* Bt2; };

struct StaticOrder {
    int nM, nN, nwg, G, c;
    __device__ void init(int M_, int N_, int G_, int c_) { nM = M_ / BM; nN = N_ / BM; nwg = nM * nN; G = G_; c = c_; }
    __device__ bool next(int i, Unit& u) const {
        const long L = (long)i * G + c; if (L >= nwg) return false;
        int wgid = (int)L; { const int q = nwg / NXCD, r = nwg % NXCD, xcd = wgid % NXCD, off = wgid / NXCD; wgid = (xcd < r ? xcd * (q + 1) : r * (q + 1) + (xcd - r) * q) + off; }
        const int nig = WGM * nN, gid = wgid / nig, fm = gid * WGM, gsz = (nM - fm) < WGM ? (nM - fm) : WGM;
        u.pm = fm + ((wgid % nig) % gsz); u.pn = (wgid % nig) / gsz; u.pb = u.pn; u.kind = 0; u.rb = 0; return true;
    }
    __device__ __forceinline__ void a_ready(const Unit&) const {}
    __device__ __forceinline__ void pre_epi() const {}
    __device__ __forceinline__ void done(const Unit&) const {}
    __device__ __forceinline__ void finish() const {}
};

__device__ __forceinline__ f32x2 gelu_pk(f32x2 v) {
    const f32x2 av = __builtin_elementwise_abs(v), d = av * 0.2316418882f + 1.0f;
    f32x2 t; t.x = __builtin_amdgcn_rcpf(d.x); t.y = __builtin_amdgcn_rcpf(d.y);
    f32x2 q = t * 0.5307027145f + (-0.7265760135f); q = q * t + 0.7107068705f; q = q * t + (-0.142248368f); q = q * t + 0.127414796f; q = q * t;
    const f32x2 s = (v * v) * (-0.72134752044f);
    f32x2 e; e.x = __builtin_amdgcn_exp2f(s.x); e.y = __builtin_amdgcn_exp2f(s.y);
    const f32x2 m = v * (q * e), r = v - m;
    f32x2 o; o.x = v.x < 0.f ? m.x : r.x; o.y = v.y < 0.f ? m.y : r.y; return o;
}
__device__ __forceinline__ f32x4 gelu4(f32x4 v) { const f32x2 a = gelu_pk((f32x2){v[0], v[1]}), b = gelu_pk((f32x2){v[2], v[3]}); return (f32x4){a.x, a.y, b.x, b.y}; }

template <class Epi, class Sched, bool FP8 = false>
__device__ __forceinline__ void gemm_phase(LAS unsigned char* lds, const Gemm g, const Sched& S, const Epi& E) {
    int tid_ = threadIdx.x; asm volatile("" : "+v"(tid_));
    const int tid = tid_, wid = __builtin_amdgcn_readfirstlane(tid >> 6), lane = tid & 63, wr = wid >> 2, wc = wid & 3, fr = lane & 15, fq = lane >> 4;
    const int K = g.K, nt = K / BK;
    unsigned voffA[2], voffB[2];
#pragma unroll
    for (int i = 0; i < 2; ++i) { int R, C; stage_rc(tid * 16 + i * 8192, R, C); const int Rb = Epi::PERM ? ((R & ~31) + perm32(R & 31)) : R;
        voffA[i] = (unsigned)(R * g.lda + C) * 2u; voffB[i] = (unsigned)(Rb * K + C) * 2u; }
    const size_t kstep = (size_t)(BK * 2);
    const size_t hstepA = (size_t)HALF * g.lda * 2, tstepA = 2 * hstepA;
    const size_t hstepB = (size_t)HALF * K * 2, tstepB = 2 * hstepB;
    const unsigned ldsw = (unsigned)wid * 1024u;
    const int aoff = lds_byte(wr * 64 + fr, fq * 8), boff = lds_byte(wc * 32 + fr, fq * 8);
#define PG8_SA(b, h) (((b) * 2 + (h)) * HTB)
#define PG8_SB(b, h) ((4 + (b) * 2 + (h)) * HTB)
#define PG8_STAGE(bufoff, gbase, voff) do { _Pragma("unroll") for (int _i = 0; _i < 2; ++_i) \
        __builtin_amdgcn_global_load_lds((const unsigned*)((const char*)(gbase) + (voff)[_i]), (LAS unsigned*)(lds + (bufoff) + ldsw + _i * 8192), 16, 0, 0); } while (0)
#define PG8_LDA(dst, b, h) do { _Pragma("unroll") for (int m = 0; m < 4; ++m) { if constexpr (FP8) { const i32x4 lo_ = *(const LAS i32x4*)(lds + PG8_SA(b, h) + aoff + m * 2048), hi_ = *(const LAS i32x4*)(lds + PG8_SA(b, h) + aoff + m * 2048 + 1024); dst##8[m] = __builtin_shufflevector(lo_, hi_, 0, 1, 2, 3, 4, 5, 6, 7); } \
        else { _Pragma("unroll") for (int k = 0; k < 2; ++k) dst[m][k] = *(const LAS bf16x8*)(lds + PG8_SA(b, h) + aoff + m * 2048 + k * 1024); } } } while (0)
#define PG8_LDB(dst, b, h) do { _Pragma("unroll") for (int n = 0; n < 2; ++n) { if constexpr (FP8) { const i32x4 lo_ = *(const LAS i32x4*)(lds + PG8_SB(b, h) + boff + n * 2048), hi_ = *(const LAS i32x4*)(lds + PG8_SB(b, h) + boff + n * 2048 + 1024); dst##8[n] = __builtin_shufflevector(lo_, hi_, 0, 1, 2, 3, 4, 5, 6, 7); } \
        else { _Pragma("unroll") for (int k = 0; k < 2; ++k) dst[n][k] = *(const LAS bf16x8*)(lds + PG8_SB(b, h) + boff + n * 2048 + k * 1024); } } } while (0)
#define PG8_MMA(ai, bj, At, Bt) do { __builtin_amdgcn_s_setprio(1); _Pragma("unroll") for (int m = 0; m < 4; ++m) _Pragma("unroll") for (int n = 0; n < 2; ++n) { \
        if constexpr (FP8) asm volatile("s_nop 1\n\tv_mfma_f32_16x16x128_f8f6f4 %0, %1, %2, %0" : "+v"(acc[ai][bj][m][n]) : "v"(Bt##8[n]), "v"(At##8[m])); \
        else { _Pragma("unroll") for (int k = 0; k < 2; ++k) acc[ai][bj][m][n] = __builtin_amdgcn_mfma_f32_16x16x32_bf16(Bt[n][k], At[m][k], acc[ai][bj][m][n], 0, 0, 0); } } \
        __builtin_amdgcn_s_setprio(0); } while (0)
#define PG8_WAIT_V(n) asm volatile("s_waitcnt vmcnt(" #n ")" ::: "memory")
#define PG8_WAIT_L(n) asm volatile("s_waitcnt lgkmcnt(" #n ")" ::: "memory")
#define PG8_BAR __builtin_amdgcn_s_barrier()
#define PG8_SCHED __builtin_amdgcn_sched_barrier(0)
    Unit cur, nxt; int ui = 0;
    if (!S.next(0, cur)) return;
    f32x4 acc[2][2][4][2];
#pragma unroll
    for (int a = 0; a < 2; ++a)
#pragma unroll
        for (int b = 0; b < 2; ++b)
#pragma unroll
            for (int m = 0; m < 4; ++m)
#pragma unroll
                for (int n = 0; n < 2; ++n) acc[a][b][m][n] = (f32x4){0.f, 0.f, 0.f, 0.f};
    bf16x8 At[4][2], B0[2][2], B1[2][2]; i32x8 At8[4], B08[2], B18[2];
    const char* cA = (const char*)(cur.kind ? g.A2 : g.A) + (size_t)cur.pm * tstepA; const char* cB = (const char*)(cur.kind ? g.Bt2 : g.Bt) + (size_t)cur.pb * tstepB;
    S.a_ready(cur);
    PG8_STAGE(PG8_SB(0, 0), cB, voffB); PG8_STAGE(PG8_SB(0, 1), cB + hstepB, voffB); PG8_STAGE(PG8_SA(0, 0), cA, voffA); PG8_STAGE(PG8_SA(0, 1), cA + hstepA, voffA);
    if (wr == 1) PG8_BAR;
    PG8_WAIT_V(2); PG8_BAR;
    PG8_STAGE(PG8_SB(1, 0), cB + kstep, voffB); PG8_STAGE(PG8_SA(1, 0), cA + kstep, voffA); PG8_STAGE(PG8_SB(1, 1), cB + hstepB + kstep, voffB);
    PG8_WAIT_V(6); PG8_BAR;
    for (;;) {
        const bool has_next = S.next(ui + 1, nxt);
        const char* nA = has_next ? (const char*)(nxt.kind ? g.A2 : g.A) + (size_t)nxt.pm * tstepA : cA; const char* nB = has_next ? (const char*)(nxt.kind ? g.Bt2 : g.Bt) + (size_t)nxt.pb * tstepB : cB;
#pragma unroll 1
        for (int t = 0; t < nt; t += 2) {
            const bool last = (t == nt - 2);
            const char* a1 = cA + (size_t)(t + 1) * kstep;
            const char* a2 = last ? nA : cA + (size_t)(t + 2) * kstep; const char* b2 = last ? nB : cB + (size_t)(t + 2) * kstep;
            const char* a3 = a2 + kstep; const char* b3 = b2 + kstep;
            if (last && has_next) S.a_ready(nxt);
            PG8_LDB(B0, 0, 0); PG8_LDB(B1, 0, 1); PG8_SCHED; PG8_LDA(At, 0, 0); PG8_STAGE(PG8_SA(1, 1), a1 + hstepA, voffA);
            PG8_WAIT_V(8); PG8_WAIT_L(0); PG8_BAR; PG8_MMA(0, 0, At, B0); PG8_MMA(0, 1, At, B1); PG8_BAR; PG8_SCHED;
            PG8_LDA(At, 0, 1); PG8_STAGE(PG8_SB(0, 0), b2, voffB); PG8_STAGE(PG8_SB(0, 1), b2 + hstepB, voffB); PG8_STAGE(PG8_SA(0, 0), a2, voffA);
            PG8_WAIT_V(8); PG8_WAIT_L(0); PG8_BAR; PG8_MMA(1, 0, At, B0); PG8_MMA(1, 1, At, B1); PG8_BAR; PG8_SCHED;
            PG8_LDB(B0, 1, 0); PG8_LDB(B1, 1, 1); PG8_SCHED; PG8_LDA(At, 1, 0); PG8_STAGE(PG8_SA(0, 1), a2 + hstepA, voffA);
            PG8_WAIT_V(8); PG8_WAIT_L(0); PG8_BAR; PG8_MMA(0, 0, At, B0); PG8_MMA(0, 1, At, B1); PG8_BAR; PG8_SCHED;
            PG8_LDA(At, 1, 1); PG8_STAGE(PG8_SB(1, 0), b3, voffB); PG8_STAGE(PG8_SB(1, 1), b3 + hstepB, voffB); PG8_STAGE(PG8_SA(1, 0), a3, voffA);
            PG8_WAIT_V(8); PG8_WAIT_L(0); PG8_BAR; PG8_MMA(1, 0, At, B0); PG8_MMA(1, 1, At, B1); PG8_BAR; PG8_SCHED;
        }
        if (wr == 0) PG8_BAR;
        if constexpr (FP8) asm volatile("s_nop 15\n\ts_nop 7" ::: "memory");
        S.pre_epi();
        { int te_ = threadIdx.x; asm volatile("" : "+v"(te_));
          E(acc, cur, wr, wc, te_ & 15, (te_ & 63) >> 4); }
        S.done(cur);
        if (!has_next) break;
#pragma unroll
        for (int a = 0; a < 2; ++a)
#pragma unroll
            for (int b = 0; b < 2; ++b)
#pragma unroll
                for (int m = 0; m < 4; ++m)
#pragma unroll
                    for (int n = 0; n < 2; ++n) acc[a][b][m][n] = (f32x4){0.f, 0.f, 0.f, 0.f};
        cur = nxt; cA = nA; cB = nB; ++ui;
        if (wr == 1) PG8_BAR;
    }
    PG8_WAIT_V(0);
    S.finish();
    PG8_BAR;
#undef PG8_SA
#undef PG8_SB
#undef PG8_STAGE
#undef PG8_LDA
#undef PG8_LDB
#undef PG8_MMA
#undef PG8_WAIT_V
#undef PG8_WAIT_L
#undef PG8_BAR
#undef PG8_SCHED
}
}
constexpr int STAGE_LIMIT = 8;
#define Y8 1

namespace att {
__device__ __forceinline__ int crow(int r, int hi) { return (r & 3) + 8 * (r >> 2) + 4 * hi; }
__device__ __forceinline__ int v_rd_base(int lane) { return ((lane & 3) << 3) | (((lane >> 2) & 3) << 6) | (((lane >> 4) & 1) << 5) | (((lane >> 5) & 1) << 8); }
}

namespace dil {
using att::crow; using att::v_rd_base;
constexpr int OFF_O = 0, OFF_V = 65536, VWAVE = 8192;
template <int S_>
__device__ __forceinline__ void pass(const bf16_t* __restrict__ Qh, const bf16_t* __restrict__ Kh, const bf16_t* __restrict__ Vh, int pitch, int q0, LAS unsigned char* lds, LAS float* scr, int wid, int lane) {
    const int r32 = lane & 31, hi = lane >> 5;
    LAS float* Oacc = (LAS float*)(lds + OFF_O); LAS float* macc = scr; LAS float* lacc = scr + 256; LAS float* wsf = scr + 512 + wid * 64;
    LAS unsigned char* vbuf = lds + OFF_V + wid * VWAVE;
    constexpr int NG = (S_ == 16) ? 2 : 1, VR = (S_ == 16) ? 16 : 32;
    int vk[4], vc[4];
#pragma unroll
    for (int i = 0; i < 4; ++i) { const int off = (i * 64 + lane) * 16, st = off >> 9, within = off & 511, kk = (st >> 1) * 8 + (within >> 6);
        vk[i] = (kk & ~0xC) | ((kk & 4) << 1) | ((kk & 8) >> 1); vc[i] = (st & 1) * 32 + ((within & 63) >> 1); }
    const unsigned vb0 = (unsigned)(uintptr_t)vbuf + (unsigned)v_rd_base(lane);
#pragma unroll
    for (int gi = 0; gi < NG; ++gi) {
        const int rho = (S_ == 1) ? 0 : (S_ == 4) ? (wid & 3) : (2 * wid + gi);
        const int i0 = (S_ == 1) ? 32 * wid : (S_ == 4) ? 32 * (wid >> 2) : 0;
        const int qi = i0 + (r32 < VR ? r32 : r32 - VR);
        const int ql = rho + S_ * qi;
        bf16x8 qr[4];
#pragma unroll
        for (int d0 = 0; d0 < 4; ++d0) qr[d0] = *(const bf16x8*)(Qh + (size_t)(q0 + ql) * pitch + d0 * 16 + hi * 8);
        const int j0 = i0 - 128;
        const int tokb = q0 + rho + S_ * j0;
        bf16x8 kfA[4], kfB[4];
#define DIL_KLOAD(dst, c) do { int tk_ = tokb + S_ * (32 * (c) + r32); tk_ = tk_ < 0 ? 0 : (tk_ > SEQ - 1 ? SEQ - 1 : tk_);     \
            _Pragma("unroll") for (int d0 = 0; d0 < 4; ++d0) dst[d0] = *(const bf16x8*)(Kh + (size_t)tk_ * pitch + d0 * 16 + hi * 8); } while (0)
#define DIL_VDMA(c, bf) do { _Pragma("unroll") for (int i = 0; i < 4; ++i) { int tk_ = tokb + S_ * (32 * (c) + vk[i]); tk_ = tk_ < 0 ? 0 : (tk_ > SEQ - 1 ? SEQ - 1 : tk_); \
            __builtin_amdgcn_global_load_lds((const unsigned*)(Vh + (size_t)tk_ * pitch + vc[i]), (LAS unsigned*)(vbuf + (bf) * 4096 + i * 1024), 16, 0, 0); } } while (0)
        float m_reg = -1e30f, l_reg = 0.f; f32x16 o[2]; o[0] = f32x16{}; o[1] = f32x16{};
        DIL_KLOAD(kfA, 0); DIL_VDMA(0, 0);
#define DIL_STEP(KF, KN, c) do { \
            if ((c) < 4) { DIL_KLOAD(KN, (c) + 1); DIL_VDMA((c) + 1, ((c) + 1) & 1); asm volatile("s_waitcnt vmcnt(8)" ::: "memory"); } \
            else { asm volatile("s_waitcnt vmcnt(0)" ::: "memory"); } \
            f32x16 p = f32x16{}; \
            _Pragma("unroll") for (int d0 = 0; d0 < 4; ++d0) p = __builtin_amdgcn_mfma_f32_32x32x16_bf16(KF[d0], qr[d0], p, 0, 0, 0); \
            const unsigned vb = vb0 + (unsigned)(((c) & 1) * 4096); \
            s16x4 vl0[2], vh0[2], vl1[2], vh1[2]; \
            _Pragma("unroll") for (int d0 = 0; d0 < 2; ++d0) { \
                asm volatile("ds_read_b64_tr_b16 %0, %1 offset:%2" : "=&v"(vl0[d0]) : "v"(vb), "i"(d0 * 512) : "memory"); \
                asm volatile("ds_read_b64_tr_b16 %0, %1 offset:%2" : "=&v"(vh0[d0]) : "v"(vb), "i"(d0 * 512 + 1024) : "memory"); \
                asm volatile("ds_read_b64_tr_b16 %0, %1 offset:%2" : "=&v"(vl1[d0]) : "v"(vb), "i"(d0 * 512 + 2048) : "memory"); \
                asm volatile("ds_read_b64_tr_b16 %0, %1 offset:%2" : "=&v"(vh1[d0]) : "v"(vb), "i"(d0 * 512 + 3072) : "memory"); } \
              \
            { const float NEG = -__builtin_inff(); const int db = qi - j0 - 32 * (c) - 4 * hi; const int tb = tokb + S_ * (32 * (c) + 4 * hi); \
              if ((c) == 0 || (c) == 4 || tokb < 0) { \
                _Pragma("unroll") for (int r = 0; r < 16; ++r) { const int cr = (r & 3) + 8 * (r >> 2); \
                    const bool ok = ((unsigned)(db - cr) <= 128u) && (tb + S_ * cr >= 0); p[r] = ok ? p[r] : NEG; } } } \
            float pmax = p[0]; \
            _Pragma("unroll") for (int r = 1; r < 16; ++r) pmax = fmaxf(pmax, p[r]); \
            { auto rr = __builtin_amdgcn_permlane32_swap(__float_as_uint(pmax), __float_as_uint(pmax), false, false); pmax = fmaxf(__uint_as_float(rr[0]), __uint_as_float(rr[1])); } \
            const float mn = fmaxf(m_reg, pmax); const float alpha = __builtin_amdgcn_exp2f(m_reg - mn); m_reg = mn; \
            float ps = 0.f; \
            _Pragma("unroll") for (int r = 0; r < 16; ++r) { p[r] = __builtin_amdgcn_exp2f(p[r] - mn); ps += p[r]; } \
            { auto rr = __builtin_amdgcn_permlane32_swap(__float_as_uint(ps), __float_as_uint(ps), false, false); ps = __uint_as_float(rr[0]) + __uint_as_float(rr[1]); } \
            l_reg = l_reg * alpha + ps; \
            bf16x8 pa0, pa1; DIL_PK4(p, 0, pa0); DIL_PK4(p, 8, pa1); \
            if (__any(alpha < 1.f)) { if (hi == 0) wsf[r32] = alpha; asm volatile("s_waitcnt lgkmcnt(0)" ::: "memory"); \
                _Pragma("unroll") for (int r = 0; r < 16; ++r) { const float a = wsf[crow(r, hi)]; o[0][r] *= a; o[1][r] *= a; } } \
            asm volatile("s_waitcnt lgkmcnt(0)" ::: "memory"); __builtin_amdgcn_sched_barrier(0); \
            _Pragma("unroll") for (int d0 = 0; d0 < 2; ++d0) { \
                o[d0] = __builtin_amdgcn_mfma_f32_32x32x16_bf16(pa0, (bf16x8){vl0[d0][0], vl0[d0][1], vl0[d0][2], vl0[d0][3], vh0[d0][0], vh0[d0][1], vh0[d0][2], vh0[d0][3]}, o[d0], 0, 0, 0); \
                o[d0] = __builtin_amdgcn_mfma_f32_32x32x16_bf16(pa1, (bf16x8){vl1[d0][0], vl1[d0][1], vl1[d0][2], vl1[d0][3], vh1[d0][0], vh1[d0][1], vh1[d0][2], vh1[d0][3]}, o[d0], 0, 0, 0); } \
        } while (0)
#define DIL_PK4(P, B_, OUT) do { unsigned a0 = cvt_pk_bf16(P[B_+0], P[B_+1]), a1 = cvt_pk_bf16(P[B_+2], P[B_+3]);                          \
            unsigned b0_ = cvt_pk_bf16(P[B_+4], P[B_+5]), b1_ = cvt_pk_bf16(P[B_+6], P[B_+7]);                                             \
            auto r0 = __builtin_amdgcn_permlane32_swap(a0, b0_, false, false); auto r1 = __builtin_amdgcn_permlane32_swap(a1, b1_, false, false); \
            u32x4 w = {r0[0], r1[0], r0[1], r1[1]}; OUT = __builtin_bit_cast(bf16x8, w); } while (0)
        DIL_STEP(kfA, kfB, 0); DIL_STEP(kfB, kfA, 1); DIL_STEP(kfA, kfB, 2); DIL_STEP(kfB, kfA, 3); DIL_STEP(kfA, kfB, 4);
#undef DIL_STEP
#undef DIL_PK4
#undef DIL_KLOAD
#undef DIL_VDMA
        float fo = 0.f, fc = 1.f;
        if (S_ != 1) { const float mo = macc[ql], lo = lacc[ql]; const float mnew = fmaxf(mo, m_reg); fo = __builtin_amdgcn_exp2f(mo - mnew); fc = __builtin_amdgcn_exp2f(m_reg - mnew);
            l_reg = lo * fo + l_reg * fc; m_reg = mnew; }
        if (hi == 0 && r32 < VR) { macc[ql] = m_reg; lacc[ql] = l_reg; wsf[r32] = fo; wsf[32 + r32] = fc; }
        asm volatile("s_waitcnt lgkmcnt(0)" ::: "memory");
#pragma unroll
        for (int r = 0; r < 16; ++r) { const int row = crow(r, hi);
            if (row < VR) { const int qrow = rho + S_ * (i0 + row); LAS float* op = Oacc + qrow * 64 + r32;
                if (S_ == 1) { op[0] = o[0][r]; op[32] = o[1][r]; }
                else { const float a = wsf[row], b = wsf[32 + row]; op[0] = op[0] * a + o[0][r] * b; op[32] = op[32] * a + o[1][r] * b; } } }
        asm volatile("s_waitcnt lgkmcnt(0)" ::: "memory");
    }
}
__device__ __forceinline__ void unit(const bf16_t* Qh, const bf16_t* Kh, const bf16_t* Vh, int pitch, bf16_t* Oh, int op, int q0, LAS unsigned char* lds, LAS float* scr) {
    int tid_ = threadIdx.x; asm volatile("" : "+v"(tid_));
    const int tid = tid_, wid = __builtin_amdgcn_readfirstlane(tid >> 6), lane = tid & 63;
    pass<1>(Qh, Kh, Vh, pitch, q0, lds, scr, wid, lane);
    __syncthreads();
    pass<4>(Qh, Kh, Vh, pitch, q0, lds, scr, wid, lane);
    __syncthreads();
    pass<16>(Qh, Kh, Vh, pitch, q0, lds, scr, wid, lane);
    __syncthreads();
    {   const int q = tid >> 1, hf = tid & 1; const LAS f32x4* src = (const LAS f32x4*)(lds + OFF_O + (q * 64 + 32 * hf) * 4); const float rl = 1.0f / scr[256 + q];
        bf16_t* dst = Oh + (size_t)(q0 + q) * op + 32 * hf;
#pragma unroll
        for (int i = 0; i < 4; ++i) { const f32x4 a = src[2 * i] * rl, b = src[2 * i + 1] * rl;
            u32x4 w; w.x = cvt_pk_bf16(a[0], a[1]); w.y = cvt_pk_bf16(a[2], a[3]); w.z = cvt_pk_bf16(b[0], b[1]); w.w = cvt_pk_bf16(b[2], b[3]); *(u32x4*)(dst + 8 * i) = w; } }
    __syncthreads();
}
}

namespace mla {
using att::crow;
constexpr int DQ = 192, DV_ = 128;
constexpr int KB = 64 * DQ;
constexpr int VB = DV_ * 64;
constexpr int NBUF = 3;
constexpr int OFF_K = 0, OFF_V = NBUF * KB, OFF_WS = NBUF * (KB + VB), BYTES = OFF_WS + 8 * 256;
constexpr int NKP = KB / 1024, KPW = (NKP + 7) / 8;
constexpr int NVP = VB / 1024;
static_assert(BYTES <= 131072 && NKP == 12 && NVP == 8, "mla LDS image");
constexpr float PSHIFT = 8.0f;

__device__ __forceinline__ void unit(const unsigned char* __restrict__ Qh, const unsigned char* __restrict__ Kh, int pitch, const unsigned char* __restrict__ VTh  ,
                                     unsigned char* __restrict__ Oh, int op, int q0, LAS unsigned char* lds) {
    int tid_ = threadIdx.x; asm volatile("" : "+v"(tid_));
    const int tid = tid_, wid = __builtin_amdgcn_readfirstlane(tid >> 6), lane = tid & 63, r32 = lane & 31, hi = lane >> 5;
    const int qlo = q0 + wid * 32, qpos = qlo + r32;
    LAS float* wsf = (LAS float*)(lds + OFF_WS) + wid * 64;
    const int NT = (q0 + 256) / 64;
    unsigned kso[KPW], vso;
#pragma unroll
    for (int i = 0; i < KPW; ++i) { const int G = ((wid + 8 * i) * 64 + lane) % (NKP * 64), R = G / 12, rem = G % 12, sg = rem >> 2, qq = rem & 3, f = (R >> 2) & 3;
        const int key = 32 * ((R >> 2) & 1) + 16 * (R >> 5) + 4 * ((R >> 3) & 3) + (R & 3);
        kso[i] = (unsigned)(key * pitch + 64 * sg + 16 * (qq ^ f)); }
    {   const int G = wid * 64 + lane, d = G >> 2, qq = G & 3, f = (d >> 2) & 3; vso = (unsigned)(d * SEQ + 16 * (qq ^ f)); }
#define MLA_DMA(j, bf) do { const unsigned char* kt_ = Kh + (size_t)(j) * 64 * pitch; const unsigned char* vt_ = VTh + (size_t)(j) * 64; \
        _Pragma("unroll") for (int i = 0; i < KPW; ++i) if (wid + 8 * i < NKP) \
            __builtin_amdgcn_global_load_lds((const unsigned*)(kt_ + kso[i]), (LAS unsigned*)(lds + OFF_K + (bf) * KB + (wid + 8 * i) * 1024), 16, 0, 0); \
        __builtin_amdgcn_global_load_lds((const unsigned*)(vt_ + vso), (LAS unsigned*)(lds + OFF_V + (bf) * VB + wid * 1024), 16, 0, 0); } while (0)
#define MLA_MFMA(acc, a, b) asm volatile("v_mfma_f32_32x32x64_f8f6f4 %0, %1, %2, %0" : "+v"(acc) : "v"(a), "v"(b))
#define MLA_MFMA0(acc, a, b) asm volatile("v_mfma_f32_32x32x64_f8f6f4 %0, %1, %2, 0" : "=v"(acc) : "v"(a), "v"(b))
#define MLA_MFMA_DRAIN2(a, b) asm volatile("s_nop 15\n\ts_nop 3" : "+v"(a), "+v"(b) :: "memory")
    i32x8 qr[3];
#pragma unroll
    for (int s = 0; s < 3; ++s) { const i32x4 lo_ = *(const i32x4*)(Qh + (size_t)qpos * pitch + 64 * s + 32 * hi), hi_ = *(const i32x4*)(Qh + (size_t)qpos * pitch + 64 * s + 32 * hi + 16);
        qr[s] = __builtin_shufflevector(lo_, hi_, 0, 1, 2, 3, 4, 5, 6, 7); }
    MLA_DMA(0, 0); MLA_DMA(1, 1);
#define MLA_WAIT_OLDER() do { if (wid < NKP - 8) asm volatile("s_waitcnt vmcnt(%0)" :: "n"(KPW + 1) : "memory"); else asm volatile("s_waitcnt vmcnt(%0)" :: "n"(KPW) : "memory"); } while (0)
    float m_reg = -1e30f;
    f32x16 o[4], ol = f32x16{};
#pragma unroll
    for (int d = 0; d < 4; ++d) o[d] = f32x16{};
    const int fsw = (r32 >> 2) & 3;
    const int koff = r32 * DQ + 16 * ((2 * hi) ^ fsw), voff = r32 * 64 + 16 * ((2 * hi) ^ fsw);
    MLA_WAIT_OLDER();
    asm volatile("" :: "v"(qr[0]), "v"(qr[1]), "v"(qr[2]));
    __builtin_amdgcn_s_barrier();
#define MLA_LD8(dst, base, off) do { const i32x4 lo_ = *(const LAS i32x4*)((base) + (off)), hi_ = *(const LAS i32x4*)((base) + ((off) ^ 16)); dst = __builtin_shufflevector(lo_, hi_, 0, 1, 2, 3, 4, 5, 6, 7); } while (0)
    int buf = 0;
    for (int t = 0; t < NT; ++t) {
        const int kb = t * 64;
        if (kb <= qlo + 31) {
            const LAS unsigned char* kp_ = lds + OFF_K + buf * KB;
            const LAS unsigned char* vp_ = lds + OFF_V + buf * VB;
            f32x16 s0, s1;
            if (kb + 63 <= qlo) {
                i32x8 k0[3], k1[3];
#pragma unroll
                for (int s = 0; s < 3; ++s) MLA_LD8(k0[s], kp_ + 64 * s, koff);
                MLA_MFMA0(s0, k0[0], qr[0]);
#pragma unroll
                for (int s = 0; s < 3; ++s) MLA_LD8(k1[s], kp_ + 32 * DQ + 64 * s, koff);
                MLA_MFMA(s0, k0[1], qr[1]); MLA_MFMA(s0, k0[2], qr[2]);
                MLA_MFMA0(s1, k1[0], qr[0]); MLA_MFMA(s1, k1[1], qr[1]); MLA_MFMA(s1, k1[2], qr[2]);
            } else {
                const float NEG = -__builtin_inff(); const int dq = qpos - kb - 32 * hi;
                int kq_ = koff; asm volatile("" : "+v"(kq_));
                {   i32x8 k0[3];
#pragma unroll
                    for (int s = 0; s < 3; ++s) MLA_LD8(k0[s], kp_ + 64 * s, kq_);
                    MLA_MFMA0(s0, k0[0], qr[0]); MLA_MFMA(s0, k0[1], qr[1]); MLA_MFMA(s0, k0[2], qr[2]);
                }
                {   i32x8 k1[3];
#pragma unroll
                    for (int s = 0; s < 3; ++s) MLA_LD8(k1[s], kp_ + 32 * DQ + 64 * s, kq_);
                    MLA_MFMA0(s1, k1[0], qr[0]); MLA_MFMA(s1, k1[1], qr[1]); MLA_MFMA(s1, k1[2], qr[2]);
                }
                MLA_MFMA_DRAIN2(s0, s1);
#pragma unroll
                for (int r = 0; r < 16; ++r) { if (r > dq) s0[r] = NEG; if (r + 16 > dq) s1[r] = NEG; }
            }

            i32x8 vv[4];
#pragma unroll
            for (int d0 = 0; d0 < 4; ++d0) MLA_LD8(vv[d0], vp_ + d0 * 32 * 64, voff);
            MLA_MFMA_DRAIN2(s0, s1);
            __builtin_amdgcn_sched_barrier(0);
            float pm0 = s0[0], pm1 = s0[8];
#define MLA_MAX8(pm, B_) asm("v_max3_f32 %0, %0, %1, %2\n\tv_max3_f32 %0, %0, %3, %4\n\tv_max3_f32 %0, %0, %5, %6\n\tv_max3_f32 %0, %0, %7, %8\n\tv_max3_f32 %0, %0, %9, %10\n\tv_max3_f32 %0, %0, %11, %12\n\tv_max3_f32 %0, %0, %13, %14\n\tv_max3_f32 %0, %0, %15, %16" \
                : "+v"(pm) : "v"(s0[B_ + 0]), "v"(s1[B_ + 0]), "v"(s0[B_ + 1]), "v"(s1[B_ + 1]), "v"(s0[B_ + 2]), "v"(s1[B_ + 2]), "v"(s0[B_ + 3]), "v"(s1[B_ + 3]), \
                              "v"(s0[B_ + 4]), "v"(s1[B_ + 4]), "v"(s0[B_ + 5]), "v"(s1[B_ + 5]), "v"(s0[B_ + 6]), "v"(s1[B_ + 6]), "v"(s0[B_ + 7]), "v"(s1[B_ + 7]))
            MLA_MAX8(pm0, 0); MLA_MAX8(pm1, 8);
#undef MLA_MAX8
            float pmax = fmaxf(pm0, pm1);
            { auto rr = __builtin_amdgcn_permlane32_swap(__float_as_uint(pmax), __float_as_uint(pmax), false, false); pmax = fmaxf(__uint_as_float(rr[0]), __uint_as_float(rr[1])); }
            const float mn = fmaxf(m_reg, pmax); const float alpha = __builtin_amdgcn_exp2f((m_reg - mn) * 0.125f); m_reg = mn;
            const float b8 = 8.0f * (PSHIFT + 7.0f) - mn;
            i32x8 pa;
            const f32x16 t0 = s0 + b8, t1 = s1 + b8;
#pragma unroll
            for (int g = 0; g < 4; ++g) { unsigned w0 = 0u, w1 = 0u;
#pragma unroll
                for (int b_ = 0; b_ < 4; ++b_) { w0 = __builtin_amdgcn_cvt_pk_u8_f32(t0[4 * g + b_], b_, w0); w1 = __builtin_amdgcn_cvt_pk_u8_f32(t1[4 * g + b_], b_, w1); }
                pa[g] = (int)w0; pa[4 + g] = (int)w1; }
            if (__any(alpha < 1.f)) { if (hi == 0) wsf[r32] = alpha; asm volatile("s_waitcnt lgkmcnt(0)" ::: "memory");
#pragma unroll
                for (int r = 0; r < 16; ++r) { const float a = wsf[crow(r, hi)]; ol[r] *= a;
#pragma unroll
                    for (int d = 0; d < 4; ++d) o[d][r] *= a; } }
            int one_ = 0x38383838; asm volatile("" : "+v"(one_));
            const i32x8 ones8 = {one_, one_, one_, one_, one_, one_, one_, one_};
            asm volatile("s_nop 1" ::: "memory");
            MLA_MFMA(ol, pa, ones8);
#pragma unroll
            for (int d0 = 0; d0 < 4; ++d0) MLA_MFMA(o[d0], pa, vv[d0]);
        }
        if (t + 2 < NT) { const int b2 = buf == 0 ? 2 : buf - 1; MLA_DMA(t + 2, b2); }
        if (t + 2 < NT) { MLA_WAIT_OLDER(); } else { asm volatile("s_waitcnt vmcnt(0)" ::: "memory"); }
        asm volatile("s_waitcnt lgkmcnt(0)" ::: "memory");
        __builtin_amdgcn_s_barrier();
        buf = buf == 2 ? 0 : buf + 1;
    }
    MLA_MFMA_DRAIN2(o[0], o[1]); MLA_MFMA_DRAIN2(o[2], o[3]); MLA_MFMA_DRAIN2(ol, o[0]);
#undef MLA_MFMA_DRAIN2
#undef MLA_MFMA0
#undef MLA_MFMA
#undef MLA_LD8
#undef MLA_WAIT_OLDER
#undef MLA_DMA
    unsigned char* Ow = Oh + (size_t)qlo * op;
#pragma unroll
    for (int r = 0; r < 16; ++r) { const int orow = crow(r, hi); const float rl = __builtin_amdgcn_rcpf(ol[r]);
#pragma unroll
        for (int d0 = 0; d0 < 4; ++d0) { const float v = o[d0][r] * rl; const float v1 = __shfl_down(v, 1), v2 = __shfl_down(v, 2), v3 = __shfl_down(v, 3);
            if ((r32 & 3) == 0) *(unsigned*)(Ow + (size_t)orow * op + d0 * 32 + r32) = pk4_fp8(v, v1, v2, v3); } }
    __syncthreads();
}
}

constexpr int NWAVES = 8;
constexpr size_t MiB = 1u << 20;
constexpr size_t WS_CTL = 0, CTL_ZERO_BYTES = 1 * MiB;
constexpr size_t WS_WEIN = 2 * MiB;
constexpr size_t WS_WEOUT = 12 * MiB;
constexpr size_t WS_WOIN = 16 * MiB;
constexpr size_t WS_WUQ = 20 * MiB;
constexpr size_t WS_WUKV = 23 * MiB;
constexpr size_t WS_WOOUT = 25 * MiB;
constexpr size_t WS_B1P = 29 * MiB;
constexpr size_t WS_SSQ = 30 * MiB;
constexpr size_t WS_TOKER = 31 * MiB;
constexpr size_t WS_TOKG = 31 * MiB + 512 * 1024;
constexpr size_t WS_XN = 32 * MiB;
constexpr size_t WS_Z = 64 * MiB;
constexpr size_t WS_MIX = 144 * MiB;
constexpr size_t WS_QR = 176 * MiB;
constexpr size_t WS_KVR = 224 * MiB;
constexpr size_t WS_QF = 288 * MiB;
constexpr size_t WS_KF = 336 * MiB;
constexpr size_t WS_Z8 = 104 * MiB;
constexpr size_t WS_MIX8 = 160 * MiB;
constexpr size_t WS_VT = 3200 * MiB;
constexpr size_t WS_W1 = 384 * MiB;
constexpr size_t WS_W2 = 896 * MiB;
constexpr size_t WS_XG = 1152 * MiB;
constexpr size_t WS_ACT = 1664 * MiB;
constexpr size_t WS_Y = 2176 * MiB;
constexpr size_t WS_X16 = 3216 * MiB;
constexpr size_t WS_END = 3248 * MiB;
constexpr int CW_MOE = 65536;
constexpr int CW_TMO = 0, CW_CODE = 1, CW_BAR = 4096, CW_CNT = 16384;
constexpr int RING_OFF = 0, RING_BYTES = 131072;
constexpr int LDSCTL_OFF = RING_BYTES, MISC_OFF = LDSCTL_OFF + 320;
constexpr int SCR_OFF = RING_BYTES + 1024;
constexpr int LDS_BYTES = 155648;
constexpr int SCR_BYTES = LDS_BYTES - SCR_OFF;

typedef GAS unsigned gu32;
#define RLX_AGENT __ATOMIC_RELAXED, __HIP_MEMORY_SCOPE_AGENT

#define XB_TMO      128
#define XB_XCNT(j)  (256  + 64 * (j))
#define XB_XSUB(j)  (1280 + 64 * (j))
#define XB_XGEN(j)  (2304 + 64 * (j))
#define XB_TOP      3328
#define XB_TOPGEN   3392
#define XCD_BAR_WORDS 3456
#define XB_SPIN_CAP (1u << 18)
__device__ __forceinline__ unsigned xb_ld(unsigned* p)              { return __hip_atomic_load(p, __ATOMIC_RELAXED, __HIP_MEMORY_SCOPE_AGENT); }
__device__ __forceinline__ unsigned xb_add(unsigned* p, unsigned v) { return __hip_atomic_fetch_add(p, v, __ATOMIC_RELAXED, __HIP_MEMORY_SCOPE_AGENT); }
__device__ __forceinline__ unsigned xb_xcc_id() { return (unsigned)__builtin_amdgcn_s_getreg((3 << 11) | 20) & 0xFu; }
#define XB_SPIN(cond, bar) do { unsigned _sp = 0; while (cond) { __builtin_amdgcn_s_sleep(1); \
    if ((++_sp & 255u) == 0u) { if (xb_ld(&(bar)[XB_TMO])) break; if (_sp > XB_SPIN_CAP) { atomicAdd(&(bar)[XB_TMO], 1u); break; } } } } while (0)
struct XcdBarrier { unsigned* bar; unsigned x; volatile LAS unsigned* st; };
__device__ __forceinline__ XcdBarrier xcd_barrier_post(unsigned* bar, volatile LAS unsigned* st) {
    XcdBarrier b; b.bar = bar; b.x = xb_xcc_id(); b.st = st;
    if (threadIdx.x == 0) (void)xb_add(&bar[XB_XCNT(b.x)], 1u);
    return b;
}
__device__ __forceinline__ void xcd_barrier_complete(unsigned* bar, unsigned x, unsigned& nloc, unsigned& nx) {
    const unsigned G = gridDim.x * gridDim.y * gridDim.z;
    unsigned sum, cnt, mine, sp = 0u;
    for (;;) {
        sum = 0u; cnt = 0u; mine = 0u;
#pragma unroll
        for (unsigned j = 0; j < 16; ++j) { const unsigned c = xb_ld(&bar[XB_XCNT(j)]); sum += c; cnt += (c > 0u) ? 1u : 0u; mine = (j == x) ? c : mine; }
        if (sum == G) break;
        __builtin_amdgcn_s_sleep(1);
        if ((++sp & 255u) == 0u) { if (xb_ld(&bar[XB_TMO])) break; if (sp > XB_SPIN_CAP) { atomicAdd(&bar[XB_TMO], 1u); break; } }
    }
    nloc = mine > 0u ? mine : 1u; nx = cnt > 0u ? cnt : 1u;
}
__device__ __forceinline__ void xcd_barrier(const XcdBarrier& b) {
    asm volatile("s_waitcnt vmcnt(0)" ::: "memory");
    __syncthreads();
    if (threadIdx.x == 0) {
        unsigned* bar = b.bar;
        __builtin_amdgcn_s_waitcnt(0);
        unsigned nloc = b.st[0], nx = b.st[1];
        if (nloc == 0u) { xcd_barrier_complete(bar, b.x, nloc, nx); b.st[0] = nloc; b.st[1] = nx; }
        const unsigned old = xb_add(&bar[XB_XSUB(b.x)], 1u);
        const unsigned gen = old / nloc;
        if (old + 1u == (gen + 1u) * nloc) {
            __builtin_amdgcn_fence(__ATOMIC_RELEASE, "agent");
            asm volatile("s_waitcnt vmcnt(0)" ::: "memory");
            const unsigned og = xb_add(&bar[XB_TOP], 1u);
            const unsigned tg = og / nx;
            if (og + 1u == (tg + 1u) * nx) xb_add(&bar[XB_TOPGEN], 1u);
            else XB_SPIN(xb_ld(&bar[XB_TOPGEN]) == tg, bar);
            __builtin_amdgcn_fence(__ATOMIC_ACQUIRE, "agent");
            xb_add(&bar[XB_XGEN(b.x)], 1u);
            asm volatile("s_waitcnt vmcnt(0)" ::: "memory");
        } else {
            XB_SPIN(xb_ld(&bar[XB_XGEN(b.x)]) == gen, bar);
            __builtin_amdgcn_fence(__ATOMIC_ACQUIRE, "agent");
            asm volatile("s_waitcnt vmcnt(0)" ::: "memory");
        }
    }
    __syncthreads();
}

struct Args {
    const float* in[24]; float* out; unsigned char* ws; int stage_limit; int pad;
};
enum { I_X = 0, I_MIXN, I_FFNN, I_EWIN, I_EWS, I_EBS, I_EGV, I_EGQ, I_EGK, I_EWOUT, I_OWIN, I_OGCQ, I_OGCKV, I_OWUQ, I_OWUKV, I_OGQ, I_OGK, I_OWOUT,
       I_RW, I_RB, I_W1, I_B1, I_W2, I_B2 };

struct Frame {
    LAS unsigned char* lds;
    int vcu, G;
};

__device__ __forceinline__ float wave_sum(float v) {
#pragma unroll
    for (int o = 1; o < 64; o <<= 1) v += __shfl_xor(v, o);
    return v;
}
#define LDS_WAIT() asm volatile("s_waitcnt lgkmcnt(0)" ::: "memory")

template <int MODE> __device__ __forceinline__ int dst_row(int o) {
    if (MODE == 1) { if (o >= 1024 && o < 2048) return (o & ~255) | (((o >> 5) & 1) << 7) | (((o >> 6) & 3) << 5) | (o & 31); return o; }
    if (MODE == 2) return ((o >> 8) << 8) | ((o & 1) << 7) | ((o & 255) >> 1);
    return o;
}
template <int MODE>
__device__ __forceinline__ void transpose_item(const float* __restrict__ W, int K, int N, bf16_t* __restrict__ WT, const float* __restrict__ gain, LAS float* scr, int item, int lane) {
    const int nblk = N / 32, kb = item / nblk, nb = item % nblk, k0 = 64 * kb, n0 = 32 * nb;
#pragma unroll 8
    for (int i = 0; i < 32; ++i) { const int kk = 2 * i + (lane >> 5); float w = W[(size_t)(k0 + kk) * N + n0 + (lane & 31)]; if (gain) w *= gain[k0 + kk]; scr[kk * 33 + (lane & 31)] = w; }
    LDS_WAIT(); asm volatile("" ::: "memory");
    const int c = lane & 7;
#pragma unroll
    for (int j = 0; j < 4; ++j) { const int n = (lane >> 3) + 8 * j; const LAS float* s = scr + (8 * c) * 33 + n;
        u32x4 o; o.x = cvt_pk_bf16(s[0 * 33], s[1 * 33]); o.y = cvt_pk_bf16(s[2 * 33], s[3 * 33]); o.z = cvt_pk_bf16(s[4 * 33], s[5 * 33]); o.w = cvt_pk_bf16(s[6 * 33], s[7 * 33]);
        *(u32x4*)(WT + (size_t)dst_row<MODE>(n0 + n) * K + k0 + 8 * c) = o; }
    LDS_WAIT(); asm volatile("" ::: "memory");
}
template <int MODE>
__device__ __forceinline__ void transpose_job(Frame& F, const float* W, int K, int N, int nmat, size_t src_stride, bf16_t* WT, size_t dst_stride, const float* gain, int gain_stride) {
    int tid_ = threadIdx.x; asm volatile("" : "+v"(tid_));
    const int wave = __builtin_amdgcn_readfirstlane(tid_ >> 6), lane = tid_ & 63;
    LAS float* scr = (LAS float*)(F.lds + RING_OFF + wave * 16384);
    const int gw = F.vcu * NWAVES + wave, NGW = F.G * NWAVES;
    const int per = (K / 64) * (N / 32), total = per * nmat;
    for (int it = gw; it < total; it += NGW) { const int mi = it / per, item = it - mi * per;
        transpose_item<MODE>(W + (size_t)mi * src_stride, K, N, WT + (size_t)mi * dst_stride, gain ? gain + (size_t)mi * gain_stride : nullptr, scr, item, lane); }
}


__device__ __forceinline__ void tr8_load(f32x4 (&v)[16], const float* __restrict__ W, int N, int item, int lane) {
    const int nblk = N / 32, kb = item / nblk, nb = item % nblk, k0 = 128 * kb, n0 = 32 * nb;
#pragma unroll
    for (int i = 0; i < 16; ++i) v[i] = __builtin_nontemporal_load((const f32x4*)(W + (size_t)(k0 + 8 * i + (lane >> 3)) * N + n0 + 4 * (lane & 7)));
}
template <int MODE>
__device__ __forceinline__ void tr8_store(const f32x4 (&v)[16], int K, int N, unsigned char* __restrict__ WT, const float* __restrict__ gain, LAS unsigned char* scr, int item, int lane) {
    const int nblk = N / 32, kb = item / nblk, nb = item % nblk, k0 = 128 * kb, n0 = 32 * nb;
    constexpr int TP = 144;
#pragma unroll
    for (int i = 0; i < 16; ++i) { const int kl = 8 * i + (lane >> 3); const float sc = gain ? W8_SCALE * gain[k0 + kl] : W8_SCALE;
        const unsigned w = pk4_fp8(v[i].x * sc, v[i].y * sc, v[i].z * sc, v[i].w * sc); LAS unsigned char* d = scr + (4 * (lane & 7)) * TP + kl;
        d[0] = (unsigned char)w; d[TP] = (unsigned char)(w >> 8); d[2 * TP] = (unsigned char)(w >> 16); d[3 * TP] = (unsigned char)(w >> 24); }
    LDS_WAIT(); asm volatile("" ::: "memory");
#pragma unroll
    for (int m = 0; m < 4; ++m) { const int q = lane + 64 * m, n = q >> 3, kc = q & 7;
        const u32x4 o = *(const LAS u32x4*)(scr + n * TP + 16 * kc);
        __builtin_nontemporal_store(o, (u32x4*)(WT + (size_t)dst_row<MODE>(n0 + n) * K + k0 + 16 * kc)); }
    LDS_WAIT(); asm volatile("" ::: "memory");
}
template <int MODE>
__device__ __forceinline__ void transpose_job_fp8(Frame& F, const float* W, int K, int N, int nmat, size_t src_stride, unsigned char* WT, size_t dst_stride, const float* gain = nullptr, int gain_stride = 0) {
    int tid_ = threadIdx.x; asm volatile("" : "+v"(tid_));
    const int wave = __builtin_amdgcn_readfirstlane(tid_ >> 6), lane = tid_ & 63;
    LAS unsigned char* scr = F.lds + RING_OFF + wave * 16384;
    const int gw = F.vcu * NWAVES + wave, NGW = F.G * NWAVES;
    const int per = (K / 128) * (N / 32), total = per * nmat;
    f32x4 cur[16], nxt[16];
    int it = gw;
    if (it < total) { const int mi = it / per; tr8_load(cur, W + (size_t)mi * src_stride, N, it - mi * per, lane); }
    for (; it < total; it += NGW) {
        const int itn = it + NGW;
        if (itn < total) { const int mn = itn / per; tr8_load(nxt, W + (size_t)mn * src_stride, N, itn - mn * per, lane); }
        const int mi = it / per;
        tr8_store<MODE>(cur, K, N, WT + (size_t)mi * dst_stride, gain ? gain + (size_t)mi * gain_stride : nullptr, scr, it - mi * per, lane);
#pragma unroll
        for (int i = 0; i < 16; ++i) cur[i] = nxt[i];
    }
}

__device__ __forceinline__ void rms_row_to_fp8(int lane, const float* xrow, const float* g, unsigned char* orow, float* copy) {
    const f32x4* xr = (const f32x4*)xrow + lane; const f32x4* gr = (const f32x4*)g + lane;
    f32x4 v[4]; float s = 0.f;
#pragma unroll
    for (int j = 0; j < 4; ++j) { v[j] = xr[64 * j]; s += (v[j].x * v[j].x + v[j].y * v[j].y) + (v[j].z * v[j].z + v[j].w * v[j].w); }
    const float rstd = 1.0f / sqrtf(wave_sum(s) * (1.f / DM) + EPS);
    unsigned* o4 = (unsigned*)orow + lane;
#pragma unroll
    for (int j = 0; j < 4; ++j) { const f32x4 gg = gr[64 * j]; if (copy) ((f32x4*)copy + lane)[64 * j] = v[j];
        o4[64 * j] = pk4_fp8(v[j].x * rstd * gg.x, v[j].y * rstd * gg.y, v[j].z * rstd * gg.z, v[j].w * rstd * gg.w); }
}
__device__ __forceinline__ void rms_row_to_bf16(int lane, const float* xrow, const float* g, bf16_t* orow, float* copy) {
    const f32x4* xr = (const f32x4*)xrow + lane; const f32x4* gr = (const f32x4*)g + lane;
    f32x4 v[4]; float s = 0.f;
#pragma unroll
    for (int j = 0; j < 4; ++j) { v[j] = xr[64 * j]; s += (v[j].x * v[j].x + v[j].y * v[j].y) + (v[j].z * v[j].z + v[j].w * v[j].w); }
    const float rstd = 1.0f / sqrtf(wave_sum(s) * (1.f / DM) + EPS);
    u32x2* o8 = (u32x2*)orow + lane;
#pragma unroll
    for (int j = 0; j < 4; ++j) { const f32x4 gg = gr[64 * j]; if (copy) ((f32x4*)copy + lane)[64 * j] = v[j];
        u32x2 w; w.x = cvt_pk_bf16(v[j].x * rstd * gg.x, v[j].y * rstd * gg.y); w.y = cvt_pk_bf16(v[j].z * rstd * gg.z, v[j].w * rstd * gg.w); o8[64 * j] = w; }
}

namespace pg8 {
struct EpiEvenIn {
    static constexpr bool PERM = false;
    bf16_t* Z; const float* gq; const float* gk;
    __device__ __forceinline__ void operator()(const f32x4 (&acc)[2][2][4][2], const Unit& u, int wr, int wc, int fr, int fq) const {
        const int row0 = u.pm * BM + wr * 64 + fr, pn = u.pn;
        if (pn >= 4 && pn < 8) {
            const float* g = pn < 6 ? gq : gk; const float sc = pn < 6 ? C2_B : 1.0f;
            f32x4 gv[2][2];
#pragma unroll
            for (int bj = 0; bj < 2; ++bj)
#pragma unroll
                for (int n = 0; n < 2; ++n) gv[bj][n] = *(const f32x4*)(g + 32 * bj + 16 * n + 4 * fq);
#pragma unroll
            for (int ai = 0; ai < 2; ++ai)
#pragma unroll
                for (int m = 0; m < 4; ++m) {
                    float ss = 0.f;
#pragma unroll
                    for (int bj = 0; bj < 2; ++bj)
#pragma unroll
                        for (int n = 0; n < 2; ++n) { const f32x4 v = acc[ai][bj][m][n]; ss += (v[0] * v[0] + v[1] * v[1]) + (v[2] * v[2] + v[3] * v[3]); }
                    ss += __shfl_xor(ss, 16); ss += __shfl_xor(ss, 32);
                    const float rstd = sc / sqrtf(ss * (1.0f / 64.0f) + EPS);
                    bf16_t* rowp = Z + (size_t)(row0 + ai * HALF + m * 16) * EVEN_IN + pn * BM + wc * 64 + 4 * fq;
#pragma unroll
                    for (int bj = 0; bj < 2; ++bj)
#pragma unroll
                        for (int n = 0; n < 2; ++n) { const f32x4 v = acc[ai][bj][m][n] * rstd * gv[bj][n];
                            u32x2 w; w.x = cvt_pk_bf16(v[0], v[1]); w.y = cvt_pk_bf16(v[2], v[3]); *(u32x2*)(rowp + 32 * bj + 16 * n) = w; }
                }
        } else {
            const bool act = pn < 4;
#pragma unroll
            for (int ai = 0; ai < 2; ++ai)
#pragma unroll
                for (int m = 0; m < 4; ++m) { bf16_t* rowp = Z + (size_t)(row0 + ai * HALF + m * 16) * EVEN_IN + pn * BM + wc * 32 + 4 * fq;
#pragma unroll
                    for (int bj = 0; bj < 2; ++bj)
#pragma unroll
                        for (int n = 0; n < 2; ++n) { f32x4 v = acc[ai][bj][m][n]; if (act) v = gelu4(v);
                            u32x2 w; w.x = cvt_pk_bf16(v[0], v[1]); w.y = cvt_pk_bf16(v[2], v[3]); *(u32x2*)(rowp + bj * HALF + 16 * n) = w; } }
        }
    }
};
template <bool F8 = false> struct EpiResidT {
    static constexpr bool PERM = false;
    const float* src32; bf16_t* X;
    __device__ __forceinline__ void operator()(const f32x4 (&acc)[2][2][4][2], const Unit& u, int wr, int wc, int fr, int fq) const {
        const int row0 = u.pm * BM + wr * 64 + fr;
#pragma unroll
        for (int ai = 0; ai < 2; ++ai)
#pragma unroll
            for (int m = 0; m < 4; ++m) { const size_t ro = (size_t)(row0 + ai * HALF + m * 16) * DM + u.pn * BM + wc * 32 + 4 * fq;
#pragma unroll
                for (int bj = 0; bj < 2; ++bj)
#pragma unroll
                    for (int n = 0; n < 2; ++n) { const size_t o_ = ro + bj * HALF + 16 * n; f32x4 b;
                        if (src32) b = *(const f32x4*)(src32 + o_); else { const u32x2 t = *(const u32x2*)(X + o_); b = (f32x4){bflo(t.x), bfhi(t.x), bflo(t.y), bfhi(t.y)}; }
                        const f32x4 r = b + (F8 ? acc[ai][bj][m][n] * W8_INV : acc[ai][bj][m][n]);
                        u32x2 w; w.x = cvt_pk_bf16(r[0], r[1]); w.y = cvt_pk_bf16(r[2], r[3]); *(u32x2*)(X + o_) = w; }
                if (m & 1) asm volatile("" ::: "memory"); }
    }
};
typedef EpiResidT<false> EpiResid;
struct EpiOddIn {
    static constexpr bool PERM = false;
    bf16_t* Z; unsigned char* Z8; float* ssq;
    __device__ __forceinline__ void operator()(const f32x4 (&acc)[2][2][4][2], const Unit& u, int wr, int wc, int fr, int fq) const {
        const int row0 = u.pm * BM + wr * 64 + fr, pn = u.pn;
#pragma unroll
        for (int ai = 0; ai < 2; ++ai)
#pragma unroll
            for (int m = 0; m < 4; ++m) { const int row = row0 + ai * HALF + m * 16; bf16_t* rowp = Z + (size_t)row * ODD_INP + pn * BM + wc * 32 + 4 * fq;
                float ss = 0.f;
#pragma unroll
                for (int bj = 0; bj < 2; ++bj)
#pragma unroll
                    for (int n = 0; n < 2; ++n) { const f32x4 v = acc[ai][bj][m][n] * W8_INV; ss += (v[0] * v[0] + v[1] * v[1]) + (v[2] * v[2] + v[3] * v[3]);
                        if (pn < 3) *(unsigned*)(Z8 + (size_t)row * ODD_INP + pn * BM + wc * 32 + 4 * fq + bj * HALF + 16 * n) = pk4_fp8(v[0], v[1], v[2], v[3]);
                        else { u32x2 w; w.x = cvt_pk_bf16(v[0], v[1]); w.y = cvt_pk_bf16(v[2], v[3]); *(u32x2*)(rowp + bj * HALF + 16 * n) = w; } }
                ss += __shfl_xor(ss, 16); ss += __shfl_xor(ss, 32);
                if (fq == 0) ssq[(size_t)row * 16 + pn * 4 + wc] = ss; }
    }
};
template <int NS> struct EpiRowScale {
    static constexpr bool PERM = true;
    unsigned char* O; int ldc; const float* ssq; int s0; float inv_cols;
    __device__ __forceinline__ void operator()(const f32x4 (&acc)[2][2][4][2], const Unit& u, int wr, int wc, int fr, int fq) const {
        const int row0 = u.pm * BM + wr * 64 + fr; const int col0 = u.pn * BM + wc * 32 + 8 * fq;
#pragma unroll
        for (int ai = 0; ai < 2; ++ai)
#pragma unroll
            for (int m = 0; m < 4; ++m) { const int row = row0 + ai * HALF + m * 16;
                float ss = 0.f; const f32x4* sp = (const f32x4*)(ssq + (size_t)row * 16 + s0);
#pragma unroll
                for (int q = 0; q < NS; ++q) { const f32x4 t = sp[q]; ss += (t[0] + t[1]) + (t[2] + t[3]); }
                const float rstd = W8_INV / sqrtf(ss * inv_cols + EPS);
                unsigned char* rowp = O + (size_t)row * ldc + col0;
#pragma unroll
                for (int bj = 0; bj < 2; ++bj) { const f32x4 v0 = acc[ai][bj][m][0] * rstd, v1 = acc[ai][bj][m][1] * rstd;
                    u32x2 w; w.x = pk4_fp8(v0[0], v0[1], v0[2], v0[3]); w.y = pk4_fp8(v1[0], v1[1], v1[2], v1[3]);
                    *(u32x2*)(rowp + bj * HALF) = w; }
                asm volatile("" ::: "memory"); }
    }
};
__device__ __forceinline__ void store8_sc1(void* p, u32x2 v) { asm volatile("global_store_dwordx2 %0, %1, off sc1" :: "v"(p), "v"(v) : "memory"); }
template <bool WT = false> struct EpiSwigluT {
    static constexpr bool PERM = true;
    unsigned char* ACT; const float* b1p;
    __device__ __forceinline__ void operator()(const f32x4 (&acc)[2][2][4][2], const Unit& u, int wr, int wc, int fr, int fq) const {
        const int row0 = u.pm * BM + wr * 64 + fr, e = u.pb >> 3, pn = u.pn;
        const float* bp = b1p + (size_t)e * 2048 + pn * BM + wc * 32 + 8 * fq;
        f32x4 bg[2], bl[2];
#pragma unroll
        for (int n = 0; n < 2; ++n) { bg[n] = *(const f32x4*)(bp + 4 * n); bl[n] = *(const f32x4*)(bp + HALF + 4 * n) + 1.0f; }
#pragma unroll
        for (int ai = 0; ai < 2; ++ai)
#pragma unroll
            for (int m = 0; m < 4; ++m) { unsigned char* rowp = ACT + (size_t)(row0 + ai * HALF + m * 16) * DE + pn * HALF + wc * 32 + 8 * fq;
                float a[8];
#pragma unroll
                for (int n = 0; n < 2; ++n) { const f32x4 gv = acc[ai][0][m][n] * W8_INV + bg[n], lv = acc[ai][1][m][n] * W8_INV + bl[n];
#pragma unroll
                    for (int i = 0; i < 4; ++i) { const float gl = fminf(gv[i], 7.0f), li1 = __builtin_amdgcn_fmed3f(lv[i], -6.0f, 8.0f);
                        const float sg = __builtin_amdgcn_rcpf(1.0f + __builtin_amdgcn_exp2f(-1.702f * LOG2E * gl));
                        a[4 * n + i] = gl * sg * li1; } }
                u32x2 w; w.x = pk4_fp8(a[0], a[1], a[2], a[3]); w.y = pk4_fp8(a[4], a[5], a[6], a[7]);
                if (WT) store8_sc1(rowp, w); else *(u32x2*)rowp = w; }
    }
};
typedef EpiSwigluT<false> EpiSwiglu;
struct EpiDown {
    static constexpr bool PERM = true;
    bf16_t* Y; const float* b2;
    __device__ __forceinline__ void operator()(const f32x4 (&acc)[2][2][4][2], const Unit& u, int wr, int wc, int fr, int fq) const {
        const int row0 = u.pm * BM + wr * 64 + fr, e = u.pb >> 2, pn = u.pn;
        const float* bp = b2 + (size_t)e * DM + pn * BM + wc * 32 + 8 * fq;
        f32x4 bv[2][2];
#pragma unroll
        for (int bj = 0; bj < 2; ++bj)
#pragma unroll
            for (int n = 0; n < 2; ++n) bv[bj][n] = *(const f32x4*)(bp + bj * HALF + 4 * n);
#pragma unroll
        for (int ai = 0; ai < 2; ++ai)
#pragma unroll
            for (int m = 0; m < 4; ++m) {
#ifdef Y8
                unsigned char* rowp = (unsigned char*)Y + (size_t)(row0 + ai * HALF + m * 16) * DM + pn * BM + wc * 32 + 8 * fq;
#pragma unroll
                for (int bj = 0; bj < 2; ++bj) { const f32x4 v0 = (acc[ai][bj][m][0] * W8_INV + bv[bj][0]) * Y8_SCALE, v1 = (acc[ai][bj][m][1] * W8_INV + bv[bj][1]) * Y8_SCALE;
                    u32x2 w; w.x = pk4_fp8(v0[0], v0[1], v0[2], v0[3]); w.y = pk4_fp8(v1[0], v1[1], v1[2], v1[3]);
                    *(u32x2*)(rowp + bj * HALF) = w; }
#else
                bf16_t* rowp = Y + (size_t)(row0 + ai * HALF + m * 16) * DM + pn * BM + wc * 32 + 8 * fq;
#pragma unroll
                for (int bj = 0; bj < 2; ++bj) { const f32x4 v0 = acc[ai][bj][m][0] * W8_INV + bv[bj][0], v1 = acc[ai][bj][m][1] * W8_INV + bv[bj][1];
                    u32x4 w; w.x = cvt_pk_bf16(v0[0], v0[1]); w.y = cvt_pk_bf16(v0[2], v0[3]); w.z = cvt_pk_bf16(v1[0], v1[1]); w.w = cvt_pk_bf16(v1[2], v1[3]);
                    *(u32x4*)(rowp + bj * HALF) = w; }
#endif
            }
    }
};
struct MoeOrder {
    const LAS int* tbl; int nN, G, c;
    __device__ bool next(int i, Unit& u) const {
        const long L = (long)i * G + c; const int rb = (int)(L / nN);
        if (rb >= __builtin_amdgcn_readfirstlane(tbl[32])) return false;
        int e = 0;
#pragma unroll
        for (int k = 1; k < 32; ++k) e += (tbl[k] <= rb) ? 1 : 0;
        e = __builtin_amdgcn_readfirstlane(e); const int rbl = __builtin_amdgcn_readfirstlane(rb - tbl[e]);
        u.pm = e * (ECAP / BM) + rbl; u.pn = (int)(L % nN); u.pb = e * nN + u.pn; u.kind = 0; u.rb = rb; return true;
    }
    __device__ __forceinline__ void a_ready(const Unit&) const {}
    __device__ __forceinline__ void pre_epi() const {}
    __device__ __forceinline__ void done(const Unit&) const {}
    __device__ __forceinline__ void finish() const {}
};

constexpr unsigned MOE_SPIN_CAP = 1u << 22;
struct MoeMergedOrder {
    const LAS int* tbl; int G, c; gu32* cnt;
    mutable int pend;
    __device__ __forceinline__ void flush() const {
        if (pend >= 0) { asm volatile("s_waitcnt vmcnt(0)" ::: "memory");
            if ((threadIdx.x & 63) == 0) __hip_atomic_fetch_add(cnt + 16 * pend, 1u, __ATOMIC_RELAXED, __HIP_MEMORY_SCOPE_AGENT);
            pend = -1; } }
    __device__ bool next(int i, Unit& u) const {
        const int nb = __builtin_amdgcn_readfirstlane(tbl[32]);
        long L = (long)i * G + c; int nN = 8, kind = 0;
        if (L >= (long)nb * 8) { L -= (long)nb * 8; nN = 4; kind = 1; if (L >= (long)nb * 4) return false; }
        const int rb = (int)(L / nN);
        int e = 0;
#pragma unroll
        for (int k = 1; k < 32; ++k) e += (tbl[k] <= rb) ? 1 : 0;
        e = __builtin_amdgcn_readfirstlane(e); const int rbl = __builtin_amdgcn_readfirstlane(rb - tbl[e]);
        u.pm = e * (ECAP / BM) + rbl; u.pn = (int)(L % nN); u.pb = e * nN + u.pn; u.kind = kind; u.rb = rb; return true;
    }
    __device__ __forceinline__ void a_ready(const Unit& u) const {
        if (u.kind == 1) {
            flush();
            if (threadIdx.x < 64) {
                unsigned sp = 0;
                while ((unsigned)__builtin_amdgcn_readfirstlane(__hip_atomic_load(cnt + 16 * u.rb, __ATOMIC_RELAXED, __HIP_MEMORY_SCOPE_AGENT)) < 64u) { __builtin_amdgcn_s_sleep(2); if (++sp > MOE_SPIN_CAP) break; }
                __builtin_amdgcn_fence(__ATOMIC_ACQUIRE, "agent");
                asm volatile("s_waitcnt vmcnt(0)" ::: "memory");
            }
            __builtin_amdgcn_s_barrier();
        }
    }
    __device__ __forceinline__ void pre_epi() const { flush(); }
    __device__ __forceinline__ void done(const Unit& u) const { if (u.kind == 0) pend = u.rb; }
    __device__ __forceinline__ void finish() const { flush(); }
};
struct EpiMoe {
    static constexpr bool PERM = true;
    EpiSwigluT<true> up; EpiDown down;
    __device__ __forceinline__ void operator()(const f32x4 (&acc)[2][2][4][2], const Unit& u, int wr, int wc, int fr, int fq) const {
        if (u.kind == 0) up(acc, u, wr, wc, fr, fq); else down(acc, u, wr, wc, fr, fq);
    }
};
}

__device__ __forceinline__ void gmlp_unit(Frame& F, const bf16_t* Z, bf16_t* MIX, const float* Ws, const float* bs, const float* gv, int unit) {
    constexpr int VP = 272;
    LAS unsigned char* VT = F.lds + RING_OFF;
    const int h = unit & 3, chunk = unit >> 2;
    int tid_ = threadIdx.x; asm volatile("" : "+v"(tid_));
    const int t0 = chunk * 128, tid = tid_, lane = tid & 63, w = __builtin_amdgcn_readfirstlane(tid >> 6);
    {
        const int s = tid >> 2, dq = (tid & 3) * 32;
        const bf16_t* vp = Z + (size_t)(t0 + s) * EVEN_IN + 512 + h * 128 + dq;
        u32x4 raw[4]; float ss = 0.f;
#pragma unroll
        for (int i = 0; i < 4; ++i) { raw[i] = *(const u32x4*)(vp + 8 * i);
#pragma unroll
            for (int j = 0; j < 4; ++j) { const float a = bflo(raw[i][j]), b = bfhi(raw[i][j]); ss += a * a + b * b; } }
        ss += __shfl_xor(ss, 1); ss += __shfl_xor(ss, 2);
        const float rstd = 1.0f / sqrtf(ss * (1.0f / 128.0f) + EPS);
#pragma unroll
        for (int i = 0; i < 4; ++i)
#pragma unroll
            for (int j = 0; j < 4; ++j) { const int d = dq + 8 * i + 2 * j;
                *(LAS bf16_t*)(VT + (d) * VP + s * 2) = f2bf(bflo(raw[i][j]) * rstd);
                *(LAS bf16_t*)(VT + (d + 1) * VP + s * 2) = f2bf(bfhi(raw[i][j]) * rstd); }
    }
    __syncthreads();
    const int fr = lane & 15, fq = lane >> 4;
    f32x4 acc[8];
#pragma unroll
    for (int nb = 0; nb < 8; ++nb) acc[nb] = (f32x4){0.f, 0.f, 0.f, 0.f};
    const int trow = 16 * w + fr;
    const float* wrow = Ws + ((size_t)h * 128 + trow) * 128;
#pragma unroll
    for (int ks = 0; ks < 4; ++ks) {
        if (32 * ks <= 16 * w + 15) {
            const int s0 = 32 * ks + 8 * fq;
            const f32x4 wa = *(const f32x4*)(wrow + s0), wb = *(const f32x4*)(wrow + s0 + 4);
            float wv[8] = {wa[0], wa[1], wa[2], wa[3], wb[0], wb[1], wb[2], wb[3]};
#pragma unroll
            for (int j = 0; j < 8; ++j) if (s0 + j > trow) wv[j] = 0.f;
            u32x4 aw; aw.x = cvt_pk_bf16(wv[0], wv[1]); aw.y = cvt_pk_bf16(wv[2], wv[3]); aw.z = cvt_pk_bf16(wv[4], wv[5]); aw.w = cvt_pk_bf16(wv[6], wv[7]);
            const bf16x8 af = __builtin_bit_cast(bf16x8, aw);
#pragma unroll
            for (int nb = 0; nb < 8; ++nb) { const bf16x8 bfr = *(const LAS bf16x8*)(VT + (16 * nb + fr) * VP + s0 * 2);
                acc[nb] = __builtin_amdgcn_mfma_f32_16x16x32_bf16(af, bfr, acc[nb], 0, 0, 0); }
        }
    }
    LAS bf16_t* DT = (LAS bf16_t*)(F.lds + RING_OFF + 36864);
#pragma unroll
    for (int i = 0; i < 4; ++i) { const int tl = 16 * w + 4 * fq + i; const float bt = bs[h * 128 + tl];
#pragma unroll
        for (int nb = 0; nb < 8; ++nb) DT[tl * 136 + 16 * nb + fr] = f2bf(gv[h * 128 + 16 * nb + fr] * acc[nb][i] + bt); }
    __syncthreads();
#pragma unroll
    for (int k = 0; k < 4; ++k) { const int idx = tid + 512 * k, tl = idx >> 4, c8 = (idx & 15) * 8;
        const u32x4 mv = *(const LAS u32x4*)(DT + tl * 136 + c8); const u32x4 uv = *(const u32x4*)(Z + (size_t)(t0 + tl) * EVEN_IN + h * 128 + c8);
        u32x4 o; o.x = cvt_pk_bf16(bflo(uv.x) * bflo(mv.x), bfhi(uv.x) * bfhi(mv.x)); o.y = cvt_pk_bf16(bflo(uv.y) * bflo(mv.y), bfhi(uv.y) * bfhi(mv.y));
        o.z = cvt_pk_bf16(bflo(uv.z) * bflo(mv.z), bfhi(uv.z) * bfhi(mv.z)); o.w = cvt_pk_bf16(bflo(uv.w) * bflo(mv.w), bfhi(uv.w) * bfhi(mv.w));
        *(u32x4*)(MIX + (size_t)(t0 + tl) * DM + h * 128 + c8) = o; }
    __syncthreads();
}

__device__ __forceinline__ void router_phase(Frame& F, const bf16_t* x, const float* gain, const float* Wr, const float* br, gu32* cnt  ,
                                             unsigned* tok_er, float* tok_g, unsigned char* XG) {
    LAS float* part = (LAS float*)(F.lds + RING_OFF);
    LAS float* ssqp = (LAS float*)(F.lds + RING_OFF + 8 * 64 * 33 * 4);
    LAS float* lg = (LAS float*)(F.lds + SCR_OFF);
    LAS unsigned* hist = (LAS unsigned*)(F.lds + SCR_OFF + 64 * 33 * 4);
    LAS unsigned* base = hist + 32;
    LAS unsigned* ers = base + 32;
    int tid_ = threadIdx.x; asm volatile("" : "+v"(tid_));
    const int tid = tid_, lane = tid & 63, w = __builtin_amdgcn_readfirstlane(tid >> 6), r32 = lane & 31, hi = lane >> 5;
#ifndef RTR_REP_A
#define RTR_REP_A 1
#define RTR_REP_B 1
#define RTR_REP_C 1
#endif
    f32x4 gg[4];
#pragma unroll
    for (int j = 0; j < 4; ++j) gg[j] = ((const f32x4*)gain + lane)[64 * j];
    {   const int tg = F.vcu;
    const int tokb = tg * 64;
    if (tid < 32) hist[tid] = 0u;
    for (int rb_ = 0; rb_ < RTR_REP_B; ++rb_) {
        bf16x8 wh[8], wl[8];
#pragma unroll
        for (int ks = 0; ks < 8; ++ks) { float wv[8];
#pragma unroll
            for (int j = 0; j < 8; ++j) { const int k = 128 * w + 16 * ks + 8 * hi + j; wv[j] = Wr[(size_t)k * NE + r32] * gain[k]; }
            u32x4 h4, l4;
#pragma unroll
            for (int j = 0; j < 4; ++j) { const unsigned hp = cvt_pk_bf16(wv[2 * j], wv[2 * j + 1]); h4[j] = hp; l4[j] = cvt_pk_bf16(wv[2 * j] - bflo(hp), wv[2 * j + 1] - bfhi(hp)); }
            wh[ks] = __builtin_bit_cast(bf16x8, h4); wl[ks] = __builtin_bit_cast(bf16x8, l4); }
#pragma unroll
        for (int g2 = 0; g2 < 2; ++g2) {
            const bf16_t* xr = x + (size_t)(tokb + 32 * g2 + r32) * DM + 128 * w + 8 * hi;
            f32x16 d = f32x16{}; float ss = 0.f;
#pragma unroll
            for (int ks = 0; ks < 8; ++ks) { const u32x4 xw = *(const u32x4*)(xr + 16 * ks);
#pragma unroll
                for (int j = 0; j < 4; ++j) { const float a = bflo(xw[j]), b = bfhi(xw[j]); ss += a * a + b * b; }
                const bf16x8 xh = __builtin_bit_cast(bf16x8, xw);
                d = __builtin_amdgcn_mfma_f32_32x32x16_bf16(wh[ks], xh, d, 0, 0, 0);
                d = __builtin_amdgcn_mfma_f32_32x32x16_bf16(wl[ks], xh, d, 0, 0, 0); }
            { auto rr = __builtin_amdgcn_permlane32_swap(__float_as_uint(ss), __float_as_uint(ss), false, false); ss = __uint_as_float(rr[0]) + __uint_as_float(rr[1]); }
            if (hi == 0) ssqp[w * 64 + 32 * g2 + r32] = ss;
#pragma unroll
            for (int r = 0; r < 16; ++r) part[(w * 64 + 32 * g2 + r32) * 33 + (r & 3) + 8 * (r >> 2) + 4 * hi] = d[r];
        }
    }
    __syncthreads();
    {   const int t = tid >> 3, q4 = (tid & 7) * 4; float s = 0.f;
#pragma unroll
        for (int ww = 0; ww < 8; ++ww) s += ssqp[ww * 64 + t];
        const float rstd = 1.0f / sqrtf(s * (1.f / DM) + EPS);
#pragma unroll
        for (int i = 0; i < 4; ++i) { float a = 0.f;
#pragma unroll
            for (int ww = 0; ww < 8; ++ww) a += part[(ww * 64 + t) * 33 + q4 + i];
            lg[t * 33 + q4 + i] = a * rstd + br[q4 + i]; } }
    __syncthreads();
    unsigned my_e[4] = {0, 0, 0, 0}, my_lr[4] = {0, 0, 0, 0}; float my_g[4] = {0, 0, 0, 0};
    if (tid < 64) {
        float v[32];
#pragma unroll
        for (int e = 0; e < 32; ++e) v[e] = lg[tid * 33 + e];
        int c0 = -1, c1 = -1, c2 = -1; float tv[4];
#pragma unroll
        for (int r = 0; r < 4; ++r) { float best = -__builtin_inff(); int bi = 0;
#pragma unroll
            for (int e = 0; e < 32; ++e) { const bool ok = (e != c0) && (e != c1) && (e != c2); if (ok && v[e] > best) { best = v[e]; bi = e; } }
            tv[r] = best; my_e[r] = (unsigned)bi; if (r == 0) c0 = bi; else if (r == 1) c1 = bi; else if (r == 2) c2 = bi; }
        const float p1 = __expf(tv[1] - tv[0]), p2 = __expf(tv[2] - tv[0]), p3 = __expf(tv[3] - tv[0]); const float inv = 1.0f / (1.0f + p1 + p2 + p3);
        my_g[0] = inv; my_g[1] = p1 * inv; my_g[2] = p2 * inv; my_g[3] = p3 * inv;
#pragma unroll
        for (int r = 0; r < 4; ++r) my_lr[r] = __hip_atomic_fetch_add(hist + my_e[r], 1u, __ATOMIC_RELAXED, __HIP_MEMORY_SCOPE_WORKGROUP);
    }
    __syncthreads();
    if (tid < 32) { const unsigned hc = hist[tid]; base[tid] = hc ? __hip_atomic_fetch_add(cnt + 64 * tid, hc, RLX_AGENT) : 0u; }
    __syncthreads();
    if (tid < 64) {
        u32x4 er; f32x4 gt;
#pragma unroll
        for (int r = 0; r < 4; ++r) { const unsigned rank = base[my_e[r]] + my_lr[r]; er[r] = (my_e[r] << 16) | rank; gt[r] = my_g[r]; ers[tid * 4 + r] = er[r]; }
        *(u32x4*)(tok_er + (size_t)(tokb + tid) * 4) = er; *(f32x4*)(tok_g + (size_t)(tokb + tid) * 4) = gt;
    }
    __syncthreads();
    for (int rc_ = 0; rc_ < RTR_REP_C; ++rc_)
#pragma unroll 2
    for (int tt = 0; tt < 8; ++tt) {
        const int tl = w * 8 + tt; const bf16_t* xrow = x + (size_t)(tokb + tl) * DM;
        f32x4 hv[4]; float s = 0.f;
#pragma unroll
        for (int j = 0; j < 4; ++j) { const u32x2 t = ((const u32x2*)xrow + lane)[64 * j]; hv[j] = (f32x4){bflo(t.x), bfhi(t.x), bflo(t.y), bfhi(t.y)}; s += (hv[j].x * hv[j].x + hv[j].y * hv[j].y) + (hv[j].z * hv[j].z + hv[j].w * hv[j].w); }
        const float rstd = 1.0f / sqrtf(wave_sum(s) * (1.f / DM) + EPS);
        unsigned wv[4];
#pragma unroll
        for (int j = 0; j < 4; ++j) { const f32x4 t = hv[j] * rstd * gg[j]; wv[j] = pk4_fp8(t.x, t.y, t.z, t.w); }
#pragma unroll
        for (int r = 0; r < 4; ++r) { const unsigned er = ers[tl * 4 + r]; const size_t slot = (size_t)(er >> 16) * ECAP + (er & 0xffffu);
            unsigned* o4 = (unsigned*)(XG + slot * DM) + lane;
#pragma unroll
            for (int j = 0; j < 4; ++j) o4[64 * j] = wv[j]; }
    }
    __syncthreads();
    }
}

__device__ __forceinline__ void combine_phase(Frame& F, bf16_t* x, float* out32  , const unsigned* tok_er, const float* tok_g, const bf16_t* Y, const float* g_next, unsigned char* XN, bool xn_fp8) {
    int tid_ = threadIdx.x; asm volatile("" : "+v"(tid_));
    const int gw = F.vcu * NWAVES + __builtin_amdgcn_readfirstlane(tid_ >> 6), NGW = F.G * NWAVES, lane = tid_ & 63;
    u32x4 erA, erB, erAn, erBn; f32x4 gtA, gtB, gtAn, gtBn;
    { const int ma = gw < M ? gw : 0, mb0 = gw + NGW < M ? gw + NGW : ma;
      erAn = *(const u32x4*)(tok_er + (size_t)ma * 4); erBn = *(const u32x4*)(tok_er + (size_t)mb0 * 4); gtAn = *(const f32x4*)(tok_g + (size_t)ma * 4); gtBn = *(const f32x4*)(tok_g + (size_t)mb0 * 4); }
    for (int m0 = gw; m0 < M; m0 += 2 * NGW) {
        const int m1 = m0 + NGW; const bool two = m1 < M; const int mb = two ? m1 : m0;
        erA = erAn; erB = erBn; gtA = gtAn; gtB = gtBn;
        { const int na = m0 + 2 * NGW < M ? m0 + 2 * NGW : m0, nb2 = m0 + 3 * NGW < M ? m0 + 3 * NGW : na;
          erAn = *(const u32x4*)(tok_er + (size_t)na * 4); erBn = *(const u32x4*)(tok_er + (size_t)nb2 * 4); gtAn = *(const f32x4*)(tok_g + (size_t)na * 4); gtBn = *(const f32x4*)(tok_g + (size_t)nb2 * 4); }
        bf16_t* xrA = x + (size_t)m0 * DM; bf16_t* xrB = x + (size_t)mb * DM;
#ifdef Y8
        u32x2 xa[4], xb[4]; unsigned ya[4][4], yb[4][4];
#else
        u32x2 xa[4], xb[4], ya[4][4], yb[4][4];
#endif
#pragma unroll
        for (int j = 0; j < 4; ++j) { xa[j] = ((const u32x2*)xrA + lane)[64 * j]; xb[j] = ((const u32x2*)xrB + lane)[64 * j]; }
#pragma unroll
        for (int r = 0; r < 4; ++r) { const size_t sA = (size_t)(erA[r] >> 16) * ECAP + (erA[r] & 0xffffu), sB = (size_t)(erB[r] >> 16) * ECAP + (erB[r] & 0xffffu);
#pragma unroll
#ifdef Y8
            for (int j = 0; j < 4; ++j) { ya[r][j] = ((const unsigned*)((const unsigned char*)Y + sA * DM) + lane)[64 * j]; yb[r][j] = ((const unsigned*)((const unsigned char*)Y + sB * DM) + lane)[64 * j]; } }
#else
            for (int j = 0; j < 4; ++j) { ya[r][j] = ((const u32x2*)(Y + sA * DM) + lane)[64 * j]; yb[r][j] = ((const u32x2*)(Y + sB * DM) + lane)[64 * j]; } }
#endif
#pragma unroll
        for (int t = 0; t < 2; ++t) {
            if (t == 1 && !two) break;
            const int m = t ? m1 : m0; bf16_t* xrow = t ? xrB : xrA; const f32x4 gt = t ? gtB : gtA;
            f32x4 v[4];
#pragma unroll
            for (int j = 0; j < 4; ++j) { const u32x2 q = t ? xb[j] : xa[j]; v[j] = (f32x4){bflo(q.x), bfhi(q.x), bflo(q.y), bfhi(q.y)}; }
#pragma unroll
#ifdef Y8
            for (int r = 0; r < 4; ++r) { const float g = gt[r] * Y8_INV;
#pragma unroll
                for (int j = 0; j < 4; ++j) { const unsigned yv = t ? yb[r][j] : ya[r][j]; const auto lo2 = __builtin_amdgcn_cvt_pk_f32_fp8((int)yv, false), hi2 = __builtin_amdgcn_cvt_pk_f32_fp8((int)yv, true);
                    v[j].x += g * lo2[0]; v[j].y += g * lo2[1]; v[j].z += g * hi2[0]; v[j].w += g * hi2[1]; } }
#else
            for (int r = 0; r < 4; ++r) { const float g = gt[r];
#pragma unroll
                for (int j = 0; j < 4; ++j) { const u32x2 yv = t ? yb[r][j] : ya[r][j]; v[j].x += g * bflo(yv.x); v[j].y += g * bfhi(yv.x); v[j].z += g * bflo(yv.y); v[j].w += g * bfhi(yv.y); } }
#endif
#pragma unroll
            for (int j = 0; j < 4; ++j) { if (out32) ((f32x4*)(out32 + (size_t)m * DM) + lane)[64 * j] = v[j];
                else { u32x2 q; q.x = cvt_pk_bf16(v[j].x, v[j].y); q.y = cvt_pk_bf16(v[j].z, v[j].w); ((u32x2*)xrow + lane)[64 * j] = q; } }
            if (g_next) {
                float s = 0.f;
#pragma unroll
                for (int j = 0; j < 4; ++j) s += (v[j].x * v[j].x + v[j].y * v[j].y) + (v[j].z * v[j].z + v[j].w * v[j].w);
                const float rstd = 1.0f / sqrtf(wave_sum(s) * (1.f / DM) + EPS);
                unsigned* o4 = (unsigned*)(XN + (size_t)m * DM) + lane; u32x2* o8 = (u32x2*)(XN + (size_t)m * DM * 2) + lane;
#pragma unroll
                for (int j = 0; j < 4; ++j) { const f32x4 gg = ((const f32x4*)g_next + lane)[64 * j];
                    if (xn_fp8) o4[64 * j] = pk4_fp8(v[j].x * rstd * gg.x, v[j].y * rstd * gg.y, v[j].z * rstd * gg.z, v[j].w * rstd * gg.w);
                    else { u32x2 w; w.x = cvt_pk_bf16(v[j].x * rstd * gg.x, v[j].y * rstd * gg.y); w.y = cvt_pk_bf16(v[j].z * rstd * gg.z, v[j].w * rstd * gg.w); o8[64 * j] = w; } }
            }
        }
    }
}

__device__ __forceinline__ void unpack8f8(const u32x2 w, float (&f)[8]) { const f32x2 a = __builtin_amdgcn_cvt_pk_f32_fp8((int)w.x, false), b = __builtin_amdgcn_cvt_pk_f32_fp8((int)w.x, true),
    c = __builtin_amdgcn_cvt_pk_f32_fp8((int)w.y, false), d = __builtin_amdgcn_cvt_pk_f32_fp8((int)w.y, true); f[0] = a.x; f[1] = a.y; f[2] = b.x; f[3] = b.y; f[4] = c.x; f[5] = c.y; f[6] = d.x; f[7] = d.y; }
__device__ __forceinline__ void unpack4f8(const unsigned w, float (&f)[4]) { const f32x2 a = __builtin_amdgcn_cvt_pk_f32_fp8((int)w, false), b = __builtin_amdgcn_cvt_pk_f32_fp8((int)w, true); f[0] = a.x; f[1] = a.y; f[2] = b.x; f[3] = b.y; }
__device__ __forceinline__ void unpack8(const u32x4 w, float (&f)[8]) { f[0] = bflo(w.x); f[1] = bfhi(w.x); f[2] = bflo(w.y); f[3] = bfhi(w.y); f[4] = bflo(w.z); f[5] = bfhi(w.z); f[6] = bflo(w.w); f[7] = bfhi(w.w); }
__device__ __forceinline__ void unpack4(const u32x2 w, float (&f)[4]) { f[0] = bflo(w.x); f[1] = bfhi(w.x); f[2] = bflo(w.y); f[3] = bfhi(w.y); }
__device__ __forceinline__ void fin_head(const float (&a)[8], const float (&b)[8], const float (&x1)[4], const float (&x2)[4], const float (&g)[24], const float (&cs)[4], const float (&sn)[4], unsigned char* op, int j, float scale) {
    float ss = 0.f;
#pragma unroll
    for (int i = 0; i < 8; ++i) ss += a[i] * a[i] + b[i] * b[i];
#pragma unroll
    for (int i = 0; i < 4; ++i) ss += x1[i] * x1[i] + x2[i] * x2[i];
    ss += __shfl_xor(ss, 1); ss += __shfl_xor(ss, 2); ss += __shfl_xor(ss, 4);
    const float rstd = scale / sqrtf(ss * (1.0f / 192.0f) + EPS);
    u32x4 o0;
    o0.x = pk4_fp8(a[0] * rstd * g[0], a[1] * rstd * g[1], a[2] * rstd * g[2], a[3] * rstd * g[3]); o0.y = pk4_fp8(a[4] * rstd * g[4], a[5] * rstd * g[5], a[6] * rstd * g[6], a[7] * rstd * g[7]);
    o0.z = pk4_fp8(b[0] * rstd * g[8], b[1] * rstd * g[9], b[2] * rstd * g[10], b[3] * rstd * g[11]); o0.w = pk4_fp8(b[4] * rstd * g[12], b[5] * rstd * g[13], b[6] * rstd * g[14], b[7] * rstd * g[15]);
    float y1[4], y2[4];
#pragma unroll
    for (int i = 0; i < 4; ++i) { const float u = x1[i] * rstd * g[16 + i], v = x2[i] * rstd * g[20 + i]; y1[i] = u * cs[i] - v * sn[i]; y2[i] = u * sn[i] + v * cs[i]; }
    *(u32x4*)(op + 16 * j) = o0; *(unsigned*)(op + 128 + 4 * j) = pk4_fp8(y1[0], y1[1], y1[2], y1[3]); *(unsigned*)(op + 160 + 4 * j) = pk4_fp8(y2[0], y2[1], y2[2], y2[3]);
}
__device__ __forceinline__ void mla_finalize_phase(Frame& F, const unsigned char* QR, const unsigned char* KVR, const bf16_t* Z, const float* gq, const float* gk, unsigned char* QF, unsigned char* KF) {
    int tid_ = threadIdx.x; asm volatile("" : "+v"(tid_));
    const int gw = F.vcu * NWAVES + __builtin_amdgcn_readfirstlane(tid_ >> 6), NGW = F.G * NWAVES, lane = tid_ & 63;
    const int h = lane >> 3, j = lane & 7;
    float gqv[24], gkv[24], invf[4];
#pragma unroll
    for (int i = 0; i < 16; ++i) { gqv[i] = gq[16 * j + i]; gkv[i] = gk[16 * j + i]; }
#pragma unroll
    for (int i = 0; i < 4; ++i) { gqv[16 + i] = gq[128 + 4 * j + i]; gqv[20 + i] = gq[160 + 4 * j + i]; gkv[16 + i] = gk[128 + 4 * j + i]; gkv[20 + i] = gk[160 + 4 * j + i];
        invf[i] = __builtin_amdgcn_exp2f(-(float)(4 * j + i) * (13.287712379549449f / 32.0f)); }
#pragma unroll 2
    for (int m = gw; m < M; m += NGW) {
        const int pos = m & (SEQ - 1);
        float cs[4], sn[4];
#pragma unroll
        for (int i = 0; i < 4; ++i) { const double rev = (double)pos * (double)invf[i] * 0.15915494309189535; const float fr = (float)(rev - __builtin_rint(rev));
            sn[i] = __builtin_amdgcn_sinf(fr); cs[i] = __builtin_amdgcn_cosf(fr); }
        const unsigned char* qp = QR + (size_t)m * 1536 + h * 192; const unsigned char* kp = KVR + (size_t)m * 2048 + h * 256; const bf16_t* zp = Z + (size_t)m * ODD_INP + 768;
        const u32x4 qn = *(const u32x4*)(qp + 16 * j); const unsigned qr1 = *(const unsigned*)(qp + 128 + 4 * j), qr2 = *(const unsigned*)(qp + 160 + 4 * j);
        const u32x4 kn = *(const u32x4*)(kp + 16 * j); const u32x2 kr1 = *(const u32x2*)(zp + 4 * j), kr2 = *(const u32x2*)(zp + 32 + 4 * j);
        float a[8], b[8], x1[4], x2[4];
        unpack8f8((u32x2){qn.x, qn.y}, a); unpack8f8((u32x2){qn.z, qn.w}, b); unpack4f8(qr1, x1); unpack4f8(qr2, x2);
        fin_head(a, b, x1, x2, gqv, cs, sn, QF + (size_t)m * 1536 + h * 192, j, 8.0f * C2_C);
        unpack8f8((u32x2){kn.x, kn.y}, a); unpack8f8((u32x2){kn.z, kn.w}, b); unpack4(kr1, x1); unpack4(kr2, x2);
        fin_head(a, b, x1, x2, gkv, cs, sn, KF + (size_t)m * 1536 + h * 192, j, 1.0f);
    }
}

__device__ __forceinline__ void vt_phase(Frame& F, const unsigned char* KVR, unsigned char* VT8) {
    int tid_ = threadIdx.x; asm volatile("" : "+v"(tid_));
    const int tid = tid_;
    LAS unsigned char* T = F.lds + RING_OFF;
    for (int it = F.vcu; it < M / 64; it += F.G) {
        const int m0 = it * 64, b = m0 / SEQ, tok0 = m0 % SEQ;
#pragma unroll 4
        for (int k = 0; k < 8; ++k) { const int idx = tid + 512 * k, tok = idx >> 6, grp = idx & 63, h = grp >> 3, d16 = (grp & 7) * 16;
            const u32x4 w = *(const u32x4*)(KVR + (size_t)(m0 + tok) * 2048 + h * 256 + 128 + d16);
            LAS unsigned char* tp = T + (h * 128 + d16) * 80 + tok;
#pragma unroll
            for (int i = 0; i < 4; ++i) { const unsigned x = w[i]; tp[(4 * i) * 80] = (unsigned char)x; tp[(4 * i + 1) * 80] = (unsigned char)(x >> 8); tp[(4 * i + 2) * 80] = (unsigned char)(x >> 16); tp[(4 * i + 3) * 80] = (unsigned char)(x >> 24); } }
        __syncthreads();
#pragma unroll 4
        for (int k = 0; k < 8; ++k) { const int idx = tid + 512 * k, row = idx >> 2, q = idx & 3;
            const u32x4 v = *(const LAS u32x4*)(T + row * 80 + 16 * q);
            *(u32x4*)(VT8 + ((size_t)b * 1024 + row) * SEQ + tok0 + 16 * q) = v; }
        __syncthreads();
    }
}

#ifndef PHMASK
#define PHMASK 0xFFFF
#endif
#ifndef REPMASK
#define REPMASK 0
#endif
#ifndef REPCNT
#define REPCNT 3
#endif
#define NREP(k) ((((REPMASK) >> (k)) & 1) ? (REPCNT) : 1)

#define LAUNDER_S(x) asm volatile("" : "+s"(x))
__device__ __forceinline__ const float* in_ptr(const Args& a, int i) { LAUNDER_S(i); return a.in[i]; }
#define PHASE_BEGIN() unsigned wso_ = 0u; LAUNDER_S(wso_); unsigned char* ws = args.ws + wso_; Frame Fp = F; Fp.vcu = __builtin_amdgcn_readfirstlane(Fp.vcu); Fp.G = __builtin_amdgcn_readfirstlane(Fp.G); LAUNDER_S(Fp.vcu); LAUNDER_S(Fp.G); \
    int bx_ = __builtin_amdgcn_readfirstlane((int)blockIdx.x); LAUNDER_S(bx_); (void)bx_; (void)ws
#define XN  ((unsigned char*)(ws + WS_XN))
#define Z   ((bf16_t*)(ws + WS_Z))
#define MIX ((bf16_t*)(ws + WS_MIX))
#define QR  ((unsigned char*)(ws + WS_QR))
#define KVR ((unsigned char*)(ws + WS_KVR))
#define QF  ((unsigned char*)(ws + WS_QF))
#define KF  ((unsigned char*)(ws + WS_KF))
#define XG  ((unsigned char*)(ws + WS_XG))
#define ACT ((unsigned char*)(ws + WS_ACT))
#define YB  ((bf16_t*)(ws + WS_Y))
#define SSQ ((float*)(ws + WS_SSQ))
#define TOKER ((unsigned*)(ws + WS_TOKER))
#define TOKG ((float*)(ws + WS_TOKG))
#define B1P ((float*)(ws + WS_B1P))
#define IN(i) in_ptr(args, (i))
__global__ void __launch_bounds__(NWAVES * 64, 2) trunk_fwd(Args args) {
    extern __shared__ __attribute__((aligned(16))) unsigned char lds_raw[];
    Frame F;
    F.lds = (LAS unsigned char*)lds_raw;
    F.G = gridDim.x; { const int bx = blockIdx.x; F.vcu = (F.G % 8 == 0) ? (bx % 8) * (F.G / 8) + bx / 8 : bx; }
    for (int u = threadIdx.x; u < (SCR_OFF - LDSCTL_OFF) / 4; u += NWAVES * 64) ((LAS unsigned*)(F.lds + LDSCTL_OFF))[u] = 0u;
    __syncthreads();
    (void)xcd_barrier_post((unsigned*)((gu32*)(args.ws + WS_CTL) + CW_BAR), (volatile LAS unsigned*)(F.lds + MISC_OFF) + 8);
#define GRID_BAR() do { unsigned wsb_ = 0u; LAUNDER_S(wsb_); XcdBarrier bar_; bar_.bar = (unsigned*)((gu32*)(args.ws + wsb_ + WS_CTL) + CW_BAR); bar_.x = xb_xcc_id(); \
        bar_.st = (volatile LAS unsigned*)(F.lds + MISC_OFF) + 8; xcd_barrier(bar_); } while (0)
#define X16 ((bf16_t*)(ws + WS_X16))
    const int stage_limit = args.stage_limit;

#if (PHMASK >> 0) & 1
            _Pragma("unroll") for (int rep_ = 0; rep_ < NREP(0); ++rep_) { if (rep_) GRID_BAR();
    {   PHASE_BEGIN(); const int ptid = threadIdx.x, gw = Fp.vcu * NWAVES + __builtin_amdgcn_readfirstlane(ptid >> 6), NGW = Fp.G * NWAVES;
        transpose_job<1>(Fp, IN(I_EWIN), DM, EVEN_IN, 2, (size_t)DM * EVEN_IN, (bf16_t*)(ws + WS_WEIN), (size_t)EVEN_IN * DM, nullptr, 0);
        transpose_job<0>(Fp, IN(I_EWOUT), DM, DM, 2, (size_t)DM * DM, (bf16_t*)(ws + WS_WEOUT), (size_t)DM * DM, nullptr, 0);
        transpose_job_fp8<0>(Fp, IN(I_OWIN), DM, ODD_IN, 2, (size_t)DM * ODD_IN, ws + WS_WOIN, (size_t)ODD_INP * DM);
        transpose_job_fp8<0>(Fp, IN(I_OWUQ), 512, 1536, 2, (size_t)512 * 1536, ws + WS_WUQ, (size_t)1536 * 512, IN(I_OGCQ), 512);
        transpose_job_fp8<0>(Fp, IN(I_OWUKV), 256, 2048, 2, (size_t)256 * 2048, ws + WS_WUKV, (size_t)2048 * 256, IN(I_OGCKV), 256);
        transpose_job_fp8<0>(Fp, IN(I_OWOUT), DM, DM, 2, (size_t)DM * DM, ws + WS_WOOUT, (size_t)DM * DM);
        transpose_job_fp8<2>(Fp, IN(I_W1), DM, 2 * DE, DEPTH * NE, (size_t)DM * 2 * DE, ws + WS_W1, (size_t)2 * DE * DM);
        transpose_job_fp8<0>(Fp, IN(I_W2), DE, DM, DEPTH * NE, (size_t)DE * DM, ws + WS_W2, (size_t)DM * DE);
        for (int i = bx_ * 512 + ptid; i < 2 * 12288; i += Fp.G * 512) { const int mi = i / 12288, r = i % 12288;
            *(u32x4*)(ws + WS_WOIN + (size_t)mi * ODD_INP * DM + (size_t)ODD_IN * DM + (size_t)r * 16) = (u32x4){0u, 0u, 0u, 0u}; }
        for (int i = bx_ * 512 + ptid; i < DEPTH * NE * 2048; i += Fp.G * 512) { const int c = i & 2047, o = 2 * (128 * (c >> 8) + (c & 127)) + ((c >> 7) & 1);
            B1P[i] = IN(I_B1)[(size_t)(i & ~2047) + o]; }
        for (int m = gw; m < M; m += NGW) rms_row_to_bf16(ptid & 63, IN(I_X) + (size_t)m * DM, IN(I_MIXN), (bf16_t*)XN + (size_t)m * DM, nullptr);
    }
            }
#endif
    GRID_BAR();

#ifdef EXTRA_BARS
    for (int xb_ = 0; xb_ < EXTRA_BARS; ++xb_) GRID_BAR();
#endif
    for (int l = 0; l < DEPTH; ++l) {
        const int li = l >> 1;
        if (2 * l + 1 > stage_limit) break;
        if ((l & 1) == 0) {
#if (PHMASK >> 1) & 1
            _Pragma("unroll") for (int rep_ = 0; rep_ < NREP(1); ++rep_) { if (rep_) GRID_BAR();
            {   PHASE_BEGIN(); pg8::Gemm g{(const bf16_t*)XN, (const bf16_t*)(ws + WS_WEIN) + (size_t)li * EVEN_IN * DM, DM, DM, nullptr, nullptr}; pg8::StaticOrder S; S.init(M, EVEN_IN, Fp.G, bx_);
                pg8::EpiEvenIn E{Z, IN(I_EGQ) + li * 64, IN(I_EGK) + li * 64};
                pg8::gemm_phase<pg8::EpiEvenIn, pg8::StaticOrder>(Fp.lds + RING_OFF, g, S, E); }
            }
#endif
            GRID_BAR();
            {   PHASE_BEGIN();
#if (PHMASK >> 2) & 1
            _Pragma("unroll") for (int rep_ = 0; rep_ < NREP(2); ++rep_) { if (rep_) GRID_BAR();
                for (int u = Fp.vcu; u < 512; u += Fp.G)
                    gmlp_unit(Fp, Z, MIX, IN(I_EWS) + (size_t)li * 4 * 128 * 128, IN(I_EBS) + li * 512, IN(I_EGV) + li * 512, u);
            }
#endif
#if (PHMASK >> 3) & 1
            _Pragma("unroll") for (int rep_ = 0; rep_ < NREP(3); ++rep_) { if (rep_) GRID_BAR();
                for (int u = Fp.vcu; u < 256; u += Fp.G) { const int bh = u >> 4, s = u & 15, b = bh >> 3, h = bh & 7;
                    for (int pass = 0; pass < 2; ++pass) { const int qb = pass ? 31 - s : s;
                        const bf16_t* zb = Z + (size_t)b * SEQ * EVEN_IN;
                        dil::unit(zb + 1024 + 64 * h, zb + 1536 + 64 * h, zb + 2048 + 64 * h, EVEN_IN, MIX + (size_t)b * SEQ * DM + 512 + 64 * h, DM, qb * 256, Fp.lds + RING_OFF, (LAS float*)(Fp.lds + SCR_OFF)); } }
            }
#endif
            }
            GRID_BAR();
#if (PHMASK >> 4) & 1
            _Pragma("unroll") for (int rep_ = 0; rep_ < NREP(4); ++rep_) { if (rep_) GRID_BAR();
            {   PHASE_BEGIN(); pg8::Gemm g{MIX, (const bf16_t*)(ws + WS_WEOUT) + (size_t)li * DM * DM, DM, DM, nullptr, nullptr}; pg8::StaticOrder S; S.init(M, DM, Fp.G, bx_);
                pg8::EpiResid E{l == 0 ? IN(I_X) : nullptr, X16};
                pg8::gemm_phase<pg8::EpiResid, pg8::StaticOrder>(Fp.lds + RING_OFF, g, S, E); }
            }
#endif
            GRID_BAR();
        } else {
#if (PHMASK >> 5) & 1
            _Pragma("unroll") for (int rep_ = 0; rep_ < NREP(5); ++rep_) { if (rep_) GRID_BAR();
            {   PHASE_BEGIN(); pg8::Gemm g{(const bf16_t*)XN, (const bf16_t*)(ws + WS_WOIN + (size_t)li * ODD_INP * DM), DM / 2, DM / 2, nullptr, nullptr}; pg8::StaticOrder S; S.init(M, ODD_INP, Fp.G, bx_);
                pg8::EpiOddIn E{Z, ws + WS_Z8, SSQ};
                pg8::gemm_phase<pg8::EpiOddIn, pg8::StaticOrder, true>(Fp.lds + RING_OFF, g, S, E); }
            }
#endif
            GRID_BAR();
#if (PHMASK >> 6) & 1
            _Pragma("unroll") for (int rep_ = 0; rep_ < NREP(6); ++rep_) { if (rep_) GRID_BAR();
            {   PHASE_BEGIN(); pg8::Gemm g{(const bf16_t*)(ws + WS_Z8 + 512), (const bf16_t*)(ws + WS_WUKV + (size_t)li * 2048 * 256), ODD_INP / 2, 128, nullptr, nullptr}; pg8::StaticOrder S; S.init(M, 2048, Fp.G, bx_);
                pg8::EpiRowScale<1> E{KVR, 2048, SSQ, 8, 1.0f / 256.0f};
                pg8::gemm_phase<pg8::EpiRowScale<1>, pg8::StaticOrder, true>(Fp.lds + RING_OFF, g, S, E); }
            {   PHASE_BEGIN(); pg8::Gemm g{(const bf16_t*)(ws + WS_Z8), (const bf16_t*)(ws + WS_WUQ + (size_t)li * 1536 * 512), ODD_INP / 2, 256, nullptr, nullptr}; pg8::StaticOrder S; S.init(M, 1536, Fp.G, bx_);
                pg8::EpiRowScale<2> E{QR, 1536, SSQ, 0, 1.0f / 512.0f};
                pg8::gemm_phase<pg8::EpiRowScale<2>, pg8::StaticOrder, true>(Fp.lds + RING_OFF, g, S, E); }
            }
#endif
            GRID_BAR();
#if (PHMASK >> 7) & 1
            _Pragma("unroll") for (int rep_ = 0; rep_ < NREP(7); ++rep_) { if (rep_) GRID_BAR();
            {   PHASE_BEGIN(); mla_finalize_phase(Fp, QR, KVR, Z, IN(I_OGQ) + li * 192, IN(I_OGK) + li * 192, QF, KF); vt_phase(Fp, KVR, ws + WS_VT); }
            }
#endif
            GRID_BAR();
#if (PHMASK >> 8) & 1
            _Pragma("unroll") for (int rep_ = 0; rep_ < NREP(8); ++rep_) { if (rep_) GRID_BAR();
            {   PHASE_BEGIN();
                for (int u = Fp.vcu; u < 256; u += Fp.G) { const int bh = u >> 4, s = u & 15, b = bh >> 3, h = bh & 7;
                    for (int pass = 0; pass < 2; ++pass) { const int qb = pass ? 31 - s : s;
                        mla::unit(QF + (size_t)b * SEQ * 1536 + 192 * h, KF + (size_t)b * SEQ * 1536 + 192 * h, 1536, ws + WS_VT + ((size_t)(b * 8 + h) * 128) * SEQ,
                                  ws + WS_MIX8 + (size_t)b * SEQ * DM + 128 * h, DM, qb * 256, Fp.lds + RING_OFF); } }
            }
            }
#endif
            GRID_BAR();
#if (PHMASK >> 9) & 1
            _Pragma("unroll") for (int rep_ = 0; rep_ < NREP(9); ++rep_) { if (rep_) GRID_BAR();
            {   PHASE_BEGIN(); pg8::Gemm g{(const bf16_t*)(ws + WS_MIX8), (const bf16_t*)(ws + WS_WOOUT + (size_t)li * DM * DM), DM / 2, DM / 2, nullptr, nullptr}; pg8::StaticOrder S; S.init(M, DM, Fp.G, bx_);
                pg8::EpiResidT<true> E{nullptr, X16};
                pg8::gemm_phase<pg8::EpiResidT<true>, pg8::StaticOrder, true>(Fp.lds + RING_OFF, g, S, E); }
            }
#endif
            GRID_BAR();
        }
        if (2 * l + 2 > stage_limit) break;
#if (PHMASK >> 10) & 1
            _Pragma("unroll") for (int rep_ = 0; rep_ < NREP(10); ++rep_) {
        {   PHASE_BEGIN(); const bool dry = rep_ + 1 < NREP(10);
            gu32* cnt = (gu32*)(ws + WS_CTL) + CW_CNT + (size_t)(dry ? 8 + 4 * rep_ + l : l) * 32 * 64;
        router_phase(Fp, X16, IN(I_FFNN) + l * DM, IN(I_RW) + (size_t)l * DM * NE, IN(I_RB) + l * NE, cnt, dry ? (unsigned*)(ws + WS_QR) : TOKER, dry ? (float*)(ws + WS_QR + MiB) : TOKG, dry ? ACT : XG); }
        GRID_BAR();
            }
#endif
        LAS int* tbl = (LAS int*)(F.lds + SCR_OFF + 12288);
        {   PHASE_BEGIN(); gu32* cnt = (gu32*)(ws + WS_CTL) + CW_CNT + (size_t)l * 32 * 64;
        if (threadIdx.x == 0) { int acc = 0; for (int e = 0; e < NE; ++e) { tbl[e] = acc; const unsigned c = __hip_atomic_load(cnt + 64 * e, RLX_AGENT); acc += (int)((c + 255u) >> 8); } tbl[NE] = acc; }
        __syncthreads(); }
#if (PHMASK >> 11) & 1
            _Pragma("unroll") for (int rep_ = 0; rep_ < NREP(11); ++rep_) { if (rep_) GRID_BAR();
        {   PHASE_BEGIN();
            pg8::Gemm g{(const bf16_t*)XG, (const bf16_t*)(ws + WS_W1 + (size_t)l * NE * 2 * DE * DM), DM / 2, DM / 2, (const bf16_t*)ACT, (const bf16_t*)(ws + WS_W2 + (size_t)l * NE * DM * DE)};
            pg8::MoeMergedOrder S{tbl, Fp.G, Fp.vcu, (gu32*)(ws + WS_CTL) + CW_MOE + (size_t)(l * 320 + 1280 * rep_) * 16, -1};
            pg8::EpiMoe E{{ACT, B1P + (size_t)l * NE * 2048}, {YB, IN(I_B2) + (size_t)l * NE * DM}};
            pg8::gemm_phase<pg8::EpiMoe, pg8::MoeMergedOrder, true>(Fp.lds + RING_OFF, g, S, E); }
            }
#endif
        GRID_BAR();
#if (PHMASK >> 13) & 1
            _Pragma("unroll") for (int rep_ = 0; rep_ < NREP(13); ++rep_) {
        {   PHASE_BEGIN(); const bool dry = rep_ + 1 < NREP(13);
            combine_phase(Fp, dry ? (bf16_t*)(ACT + (size_t)128 * MiB) : X16, (!dry && l + 1 == DEPTH) ? args.out : nullptr, TOKER, TOKG, YB, (l + 1 < DEPTH) ? IN(I_MIXN) + (l + 1) * DM : nullptr, dry ? (ACT + (size_t)64 * MiB) : XN, (l & 1) == 0); }
        GRID_BAR();
            }
#endif
    }
#undef GRID_BAR
}

extern "C" void kernel_launch(void* const* d_in, const int* in_sizes, int n_in, void* d_out, int out_size, void* d_ws, size_t ws_size, hipStream_t stream) {
    static int grid = 0;
    if (grid == 0) {
        if (n_in != 24 || in_sizes[0] != M * DM || out_size != M * DM || ws_size < WS_END) {
            fprintf(stderr, "kernel_launch: unexpected shapes (n_in %d, in0 %d, out %d, ws %zu, need %zu)\n", n_in, n_in > 0 ? in_sizes[0] : -1, out_size, ws_size, (size_t)WS_END); grid = -1; return; }
        int dev = 0, cus = 0, per_cu = 0;
        if (hipGetDevice(&dev) != hipSuccess || hipDeviceGetAttribute(&cus, hipDeviceAttributeMultiprocessorCount, dev) != hipSuccess) { grid = -1; return; }
        if (hipFuncSetAttribute((const void*)trunk_fwd, hipFuncAttributeMaxDynamicSharedMemorySize, LDS_BYTES) != hipSuccess) { fprintf(stderr, "kernel_launch: hipFuncSetAttribute failed\n"); grid = -1; return; }
        if (hipOccupancyMaxActiveBlocksPerMultiprocessor(&per_cu, (const void*)trunk_fwd, NWAVES * 64, LDS_BYTES) != hipSuccess || per_cu < 1)
            fprintf(stderr, "kernel_launch: occupancy query reports %d workgroups per CU\n", per_cu);
        (void)hipGetLastError();
        if (cus < 256) { fprintf(stderr, "kernel_launch: needs 256 CUs, device has %d\n", cus); grid = -1; return; }
        grid = 256;
    }
    if (grid < 0) return;
    if (hipMemsetAsync((char*)d_ws + WS_CTL, 0, CTL_ZERO_BYTES, stream) != hipSuccess) return;
    Args a{};
    for (int i = 0; i < 24; ++i) a.in[i] = (const float*)d_in[i];
    a.out = (float*)d_out; a.ws = (unsigned char*)d_ws; a.stage_limit = STAGE_LIMIT; a.pad = 0;
    hipLaunchKernelGGL(trunk_fwd, dim3(grid), dim3(NWAVES * 64), LDS_BYTES, stream, a);
}
```

```cpp
#include <hip/hip_runtime.h>
#include <hip/hip_bf16.h>
#include <cstdio>
#include <cstdint>

#define LAS __attribute__((address_space(3)))
#define GAS __attribute__((address_space(1)))
typedef unsigned short bf16_t;
typedef short bf16x8 __attribute__((ext_vector_type(8)));
typedef short s16x4 __attribute__((ext_vector_type(4)));
typedef float f32x2 __attribute__((ext_vector_type(2)));
typedef float f32x4 __attribute__((ext_vector_type(4)));
typedef float f32x16 __attribute__((ext_vector_type(16)));
typedef unsigned u32x2 __attribute__((ext_vector_type(2)));
typedef unsigned u32x4 __attribute__((ext_vector_type(4)));
typedef int i32x4 __attribute__((ext_vector_type(4)));
typedef int i32x8 __attribute__((ext_vector_type(8)));

constexpr int BATCH = 2, SEQ = 8192, DM = 1024, M = BATCH * SEQ, DEPTH = 4;
constexpr int EVEN_IN = 2560, ODD_IN = 832, ODD_INP = 1024;
constexpr int NE = 32, DE = 1024, ECAP = 16384;
constexpr float EPS = 1e-6f;
constexpr float LOG2E = 1.4426950408889634f;
constexpr float C2_B = 0.125f * LOG2E;
constexpr float C2_C = 0.07216878364870322f * LOG2E;

__device__ __forceinline__ unsigned cvt_pk_bf16(float lo, float hi) { unsigned r; asm volatile("v_cvt_pk_bf16_f32 %0, %1, %2" : "=v"(r) : "v"(lo), "v"(hi)); return r; }
__device__ __forceinline__ float bf2f(bf16_t v) { return __uint_as_float(((unsigned)v) << 16); }
__device__ __forceinline__ float bflo(unsigned w) { return __uint_as_float(w << 16); }
__device__ __forceinline__ float bfhi(unsigned w) { return __uint_as_float(w & 0xffff0000u); }
__device__ __forceinline__ bf16_t f2bf(float f) { return (bf16_t)(cvt_pk_bf16(f, 0.f) & 0xffffu); }

__device__ __forceinline__ unsigned pk4_fp8(float a, float b, float c, float d) { int w = 0; w = __builtin_amdgcn_cvt_pk_fp8_f32(a, b, w, false); w = __builtin_amdgcn_cvt_pk_fp8_f32(c, d, w, true); return (unsigned)w; }
constexpr float W8_SCALE = 64.0f, W8_INV = 1.0f / 64.0f;
constexpr float Y8_SCALE = 16.0f, Y8_INV = 1.0f / 16.0f;

namespace pg8 {
constexpr int BM = 256, BK = 64, HALF = 128, HTB = HALF * BK * 2, STAGE_BYTES = 8 * HTB, NXCD = 8, WGM = 8;
__host__ __device__ __forceinline__ int lds_byte(int r, int c) { const int st = (r >> 4) * 2 + (c >> 5), rr = r & 15, cc = c & 31, ob = rr * 64 + cc * 2; return st * 1024 + (ob ^ (((ob >> 9) & 1) << 5)); }
__host__ __device__ __forceinline__ void stage_rc(int b, int& R, int& C) { const int st = b / 1024, sb = b % 1024, swz = sb ^ (((sb >> 9) & 1) << 5); R = (st >> 1) * 16 + swz / 64; C = (st & 1) * 32 + (swz % 64) / 2; }
__host__ __device__ __forceinline__ int perm32(int rho) { const int n = rho >> 4, i = rho & 15; return 8 * (i >> 2) + 4 * n + (i & 3); }

struct Unit { int pm, pn, pb, kind, rb; };
struct Gemm { const bf16_t* A; const bf16_t* Bt; int lda, K; const bf16_t* A2; const bf16_t* Bt2; };

struct StaticOrder {
    int nM, nN, nwg, G, c;
    __device__ void init(int M_, int N_, int G_, int c_) { nM = M_ / BM; nN = N_ / BM; nwg = nM * nN; G = G_; c = c_; }
    __device__ bool next(int i, Unit& u) const {
        const long L = (long)i * G + c; if (L >= nwg) return false;
        int wgid = (int)L; { const int q = nwg / NXCD, r = nwg % NXCD, xcd = wgid % NXCD, off = wgid / NXCD; wgid = (xcd < r ? xcd * (q + 1) : r * (q + 1) + (xcd - r) * q) + off; }
        const int nig = WGM * nN, gid = wgid / nig, fm = gid * WGM, gsz = (nM - fm) < WGM ? (nM - fm) : WGM;
        u.pm = fm + ((wgid % nig) % gsz); u.pn = (wgid % nig) / gsz; u.pb = u.pn; u.kind = 0; u.rb = 0; return true;
    }
    __device__ __forceinline__ void a_ready(const Unit&) const {}
    __device__ __forceinline__ void pre_epi() const {}
    __device__ __forceinline__ void done(const Unit&) const {}
    __device__ __forceinline__ void finish() const {}
};

__device__ __forceinline__ f32x2 gelu_pk(f32x2 v) {
    const f32x2 av = __builtin_elementwise_abs(v), d = av * 0.2316418882f + 1.0f;
    f32x2 t; t.x = __builtin_amdgcn_rcpf(d.x); t.y = __builtin_amdgcn_rcpf(d.y);
    f32x2 q = t * 0.5307027145f + (-0.7265760135f); q = q * t + 0.7107068705f; q = q * t + (-0.142248368f); q = q * t + 0.127414796f; q = q * t;
    const f32x2 s = (v * v) * (-0.72134752044f);
    f32x2 e; e.x = __builtin_amdgcn_exp2f(s.x); e.y = __builtin_amdgcn_exp2f(s.y);
    const f32x2 m = v * (q * e), r = v - m;
    f32x2 o; o.x = v.x < 0.f ? m.x : r.x; o.y = v.y < 0.f ? m.y : r.y; return o;
}
__device__ __forceinline__ f32x4 gelu4(f32x4 v) { const f32x2 a = gelu_pk((f32x2){v[0], v[1]}), b = gelu_pk((f32x2){v[2], v[3]}); return (f32x4){a.x, a.y, b.x, b.y}; }

template <class Epi, class Sched, bool FP8 = false>
__device__ __forceinline__ void gemm_phase(LAS unsigned char* lds, const Gemm g, const Sched& S, const Epi& E) {
    int tid_ = threadIdx.x; asm volatile("" : "+v"(tid_));
    const int tid = tid_, wid = __builtin_amdgcn_readfirstlane(tid >> 6), lane = tid & 63, wr = wid >> 2, wc = wid & 3, fr = lane & 15, fq = lane >> 4;
    const int K = g.K, nt = K / BK;
    unsigned voffA[2], voffB[2];
#pragma unroll
    for (int i = 0; i < 2; ++i) { int R, C; stage_rc(tid * 16 + i * 8192, R, C); const int Rb = Epi::PERM ? ((R & ~31) + perm32(R & 31)) : R;
        voffA[i] = (unsigned)(R * g.lda + C) * 2u; voffB[i] = (unsigned)(Rb * K + C) * 2u; }
    const size_t kstep = (size_t)(BK * 2);
    const size_t hstepA = (size_t)HALF * g.lda * 2, tstepA = 2 * hstepA;
    const size_t hstepB = (size_t)HALF * K * 2, tstepB = 2 * hstepB;
    const unsigned ldsw = (unsigned)wid * 1024u;
    const int aoff = lds_byte(wr * 64 + fr, fq * 8), boff = lds_byte(wc * 32 + fr, fq * 8);
#define PG8_SA(b, h) (((b) * 2 + (h)) * HTB)
#define PG8_SB(b, h) ((4 + (b) * 2 + (h)) * HTB)
#define PG8_STAGE(bufoff, gbase, voff) do { _Pragma("unroll") for (int _i = 0; _i < 2; ++_i) \
        __builtin_amdgcn_global_load_lds((const unsigned*)((const char*)(gbase) + (voff)[_i]), (LAS unsigned*)(lds + (bufoff) + ldsw + _i * 8192), 16, 0, 0); } while (0)
#define PG8_LDA(dst, b, h) do { _Pragma("unroll") for (int m = 0; m < 4; ++m) { if constexpr (FP8) { const i32x4 lo_ = *(const LAS i32x4*)(lds + PG8_SA(b, h) + aoff + m * 2048), hi_ = *(const LAS i32x4*)(lds + PG8_SA(b, h) + aoff + m * 2048 + 1024); dst##8[m] = __builtin_shufflevector(lo_, hi_, 0, 1, 2, 3, 4, 5, 6, 7); } \
        else { _Pragma("unroll") for (int k = 0; k < 2; ++k) dst[m][k] = *(const LAS bf16x8*)(lds + PG8_SA(b, h) + aoff + m * 2048 + k * 1024); } } } while (0)
#define PG8_LDB(dst, b, h) do { _Pragma("unroll") for (int n = 0; n < 2; ++n) { if constexpr (FP8) { const i32x4 lo_ = *(const LAS i32x4*)(lds + PG8_SB(b, h) + boff + n * 2048), hi_ = *(const LAS i32x4*)(lds + PG8_SB(b, h) + boff + n * 2048 + 1024); dst##8[n] = __builtin_shufflevector(lo_, hi_, 0, 1, 2, 3, 4, 5, 6, 7); } \
        else { _Pragma("unroll") for (int k = 0; k < 2; ++k) dst[n][k] = *(const LAS bf16x8*)(lds + PG8_SB(b, h) + boff + n * 2048 + k * 1024); } } } while (0)
#define PG8_MMA(ai, bj, At, Bt) do { __builtin_amdgcn_s_setprio(1); _Pragma("unroll") for (int m = 0; m < 4; ++m) _Pragma("unroll") for (int n = 0; n < 2; ++n) { \
        if constexpr (FP8) asm volatile("s_nop 1\n\tv_mfma_f32_16x16x128_f8f6f4 %0, %1, %2, %0" : "+v"(acc[ai][bj][m][n]) : "v"(Bt##8[n]), "v"(At##8[m])); \
        else { _Pragma("unroll") for (int k = 0; k < 2; ++k) acc[ai][bj][m][n] = __builtin_amdgcn_mfma_f32_16x16x32_bf16(Bt[n][k], At[m][k], acc[ai][bj][m][n], 0, 0, 0); } } \
        __builtin_amdgcn_s_setprio(0); } while (0)
#define PG8_WAIT_V(n) asm volatile("s_waitcnt vmcnt(" #n ")" ::: "memory")
#define PG8_WAIT_L(n) asm volatile("s_waitcnt lgkmcnt(" #n ")" ::: "memory")
#define PG8_BAR __builtin_amdgcn_s_barrier()
#define PG8_SCHED __builtin_amdgcn_sched_barrier(0)
    Unit cur, nxt; int ui = 0;
    if (!S.next(0, cur)) return;
    f32x4 acc[2][2][4][2];
#pragma unroll
    for (int a = 0; a < 2; ++a)
#pragma unroll
        for (int b = 0; b < 2; ++b)
#pragma unroll
            for (int m = 0; m < 4; ++m)
#pragma unroll
                for (int n = 0; n < 2; ++n) acc[a][b][m][n] = (f32x4){0.f, 0.f, 0.f, 0.f};
    bf16x8 At[4][2], B0[2][2], B1[2][2]; i32x8 At8[4], B08[2], B18[2];
    const char* cA = (const char*)(cur.kind ? g.A2 : g.A) + (size_t)cur.pm * tstepA; const char* cB = (const char*)(cur.kind ? g.Bt2 : g.Bt) + (size_t)cur.pb * tstepB;
    S.a_ready(cur);
    PG8_STAGE(PG8_SB(0, 0), cB, voffB); PG8_STAGE(PG8_SB(0, 1), cB + hstepB, voffB); PG8_STAGE(PG8_SA(0, 0), cA, voffA); PG8_STAGE(PG8_SA(0, 1), cA + hstepA, voffA);
    if (wr == 1) PG8_BAR;
    PG8_WAIT_V(2); PG8_BAR;
    PG8_STAGE(PG8_SB(1, 0), cB + kstep, voffB); PG8_STAGE(PG8_SA(1, 0), cA + kstep, voffA); PG8_STAGE(PG8_SB(1, 1), cB + hstepB + kstep, voffB);
    PG8_WAIT_V(6); PG8_BAR;
    for (;;) {
        const bool has_next = S.next(ui + 1, nxt);
        const char* nA = has_next ? (const char*)(nxt.kind ? g.A2 : g.A) + (size_t)nxt.pm * tstepA : cA; const char* nB = has_next ? (const char*)(nxt.kind ? g.Bt2 : g.Bt) + (size_t)nxt.pb * tstepB : cB;
#pragma unroll 1
        for (int t = 0; t < nt; t += 2) {
            const bool last = (t == nt - 2);
            const char* a1 = cA + (size_t)(t + 1) * kstep;
            const char* a2 = last ? nA : cA + (size_t)(t + 2) * kstep; const char* b2 = last ? nB : cB + (size_t)(t + 2) * kstep;
            const char* a3 = a2 + kstep; const char* b3 = b2 + kstep;
            if (last && has_next) S.a_ready(nxt);
            PG8_LDB(B0, 0, 0); PG8_LDB(B1, 0, 1); PG8_SCHED; PG8_LDA(At, 0, 0); PG8_STAGE(PG8_SA(1, 1), a1 + hstepA, voffA);
            PG8_WAIT_V(8); PG8_WAIT_L(0); PG8_BAR; PG8_MMA(0, 0, At, B0); PG8_MMA(0, 1, At, B1); PG8_BAR; PG8_SCHED;
            PG8_LDA(At, 0, 1); PG8_STAGE(PG8_SB(0, 0), b2, voffB); PG8_STAGE(PG8_SB(0, 1), b2 + hstepB, voffB); PG8_STAGE(PG8_SA(0, 0), a2, voffA);
            PG8_WAIT_V(8); PG8_WAIT_L(0); PG8_BAR; PG8_MMA(1, 0, At, B0); PG8_MMA(1, 1, At, B1); PG8_BAR; PG8_SCHED;
            PG8_LDB(B0, 1, 0); PG8_LDB(B1, 1, 1); PG8_SCHED; PG8_LDA(At, 1, 0); PG8_STAGE(PG8_SA(0, 1), a2 + hstepA, voffA);
            PG8_WAIT_V(8); PG8_WAIT_L(0); PG8_BAR; PG8_MMA(0, 0, At, B0); PG8_MMA(0, 1, At, B1); PG8_BAR; PG8_SCHED;
            PG8_LDA(At, 1, 1); PG8_STAGE(PG8_SB(1, 0), b3, voffB); PG8_STAGE(PG8_SB(1, 1), b3 + hstepB, voffB); PG8_STAGE(PG8_SA(1, 0), a3, voffA);
            PG8_WAIT_V(8); PG8_WAIT_L(0); PG8_BAR; PG8_MMA(1, 0, At, B0); PG8_MMA(1, 1, At, B1); PG8_BAR; PG8_SCHED;
        }
        if (wr == 0) PG8_BAR;
        if constexpr (FP8) asm volatile("s_nop 15\n\ts_nop 7" ::: "memory");
        S.pre_epi();
        { int te_ = threadIdx.x; asm volatile("" : "+v"(te_));
          E(acc, cur, wr, wc, te_ & 15, (te_ & 63) >> 4); }
        S.done(cur);
        if (!has_next) break;
#pragma unroll
        for (int a = 0; a < 2; ++a)
#pragma unroll
            for (int b = 0; b < 2; ++b)
#pragma unroll
                for (int m = 0; m < 4; ++m)
#pragma unroll
                    for (int n = 0; n < 2; ++n) acc[a][b][m][n] = (f32x4){0.f, 0.f, 0.f, 0.f};
        cur = nxt; cA = nA; cB = nB; ++ui;
        if (wr == 1) PG8_BAR;
    }
    PG8_WAIT_V(0);
    S.finish();
    PG8_BAR;
#undef PG8_SA
#undef PG8_SB
#undef PG8_STAGE
#undef PG8_LDA
#undef PG8_LDB
#undef PG8_MMA
#undef PG8_WAIT_V
#undef PG8_WAIT_L
#undef PG8_BAR
#undef PG8_SCHED
}
}
constexpr int STAGE_LIMIT = 8;
#define Y8 1

namespace att {
__device__ __forceinline__ int crow(int r, int hi) { return (r & 3) + 8 * (r >> 2) + 4 * hi; }
__device__ __forceinline__ int v_rd_base(int lane) { return ((lane & 3) << 3) | (((lane >> 2) & 3) << 6) | (((lane >> 4) & 1) << 5) | (((lane >> 5) & 1) << 8); }
}

namespace dil {
using att::crow; using att::v_rd_base;
constexpr int OFF_O = 0, OFF_V = 65536, VWAVE = 8192;
template <int S_>
__device__ __forceinline__ void pass(const bf16_t* __restrict__ Qh, const bf16_t* __restrict__ Kh, const bf16_t* __restrict__ Vh, int pitch, int q0, LAS unsigned char* lds, LAS float* scr, int wid, int lane) {
    const int r32 = lane & 31, hi = lane >> 5;
    LAS float* Oacc = (LAS float*)(lds + OFF_O); LAS float* macc = scr; LAS float* lacc = scr + 256; LAS float* wsf = scr + 512 + wid * 64;
    LAS unsigned char* vbuf = lds + OFF_V + wid * VWAVE;
    constexpr int NG = (S_ == 16) ? 2 : 1, VR = (S_ == 16) ? 16 : 32;
    int vk[4], vc[4];
#pragma unroll
    for (int i = 0; i < 4; ++i) { const int off = (i * 64 + lane) * 16, st = off >> 9, within = off & 511, kk = (st >> 1) * 8 + (within >> 6);
        vk[i] = (kk & ~0xC) | ((kk & 4) << 1) | ((kk & 8) >> 1); vc[i] = (st & 1) * 32 + ((within & 63) >> 1); }
    const unsigned vb0 = (unsigned)(uintptr_t)vbuf + (unsigned)v_rd_base(lane);
#pragma unroll
    for (int gi = 0; gi < NG; ++gi) {
        const int rho = (S_ == 1) ? 0 : (S_ == 4) ? (wid & 3) : (2 * wid + gi);
        const int i0 = (S_ == 1) ? 32 * wid : (S_ == 4) ? 32 * (wid >> 2) : 0;
        const int qi = i0 + (r32 < VR ? r32 : r32 - VR);
        const int ql = rho + S_ * qi;
        bf16x8 qr[4];
#pragma unroll
        for (int d0 = 0; d0 < 4; ++d0) qr[d0] = *(const bf16x8*)(Qh + (size_t)(q0 + ql) * pitch + d0 * 16 + hi * 8);
        const int j0 = i0 - 128;
        const int tokb = q0 + rho + S_ * j0;
        bf16x8 kfA[4], kfB[4];
#define DIL_KLOAD(dst, c) do { int tk_ = tokb + S_ * (32 * (c) + r32); tk_ = tk_ < 0 ? 0 : (tk_ > SEQ - 1 ? SEQ - 1 : tk_);     \
            _Pragma("unroll") for (int d0 = 0; d0 < 4; ++d0) dst[d0] = *(const bf16x8*)(Kh + (size_t)tk_ * pitch + d0 * 16 + hi * 8); } while (0)
#define DIL_VDMA(c, bf) do { _Pragma("unroll") for (int i = 0; i < 4; ++i) { int tk_ = tokb + S_ * (32 * (c) + vk[i]); tk_ = tk_ < 0 ? 0 : (tk_ > SEQ - 1 ? SEQ - 1 : tk_); \
            __builtin_amdgcn_global_load_lds((const unsigned*)(Vh + (size_t)tk_ * pitch + vc[i]), (LAS unsigned*)(vbuf + (bf) * 4096 + i * 1024), 16, 0, 0); } } while (0)
        float m_reg = -1e30f, l_reg = 0.f; f32x16 o[2]; o[0] = f32x16{}; o[1] = f32x16{};
        DIL_KLOAD(kfA, 0); DIL_VDMA(0, 0);
#define DIL_STEP(KF, KN, c) do { \
            if ((c) < 4) { DIL_KLOAD(KN, (c) + 1); DIL_VDMA((c) + 1, ((c) + 1) & 1); asm volatile("s_waitcnt vmcnt(8)" ::: "memory"); } \
            else { asm volatile("s_waitcnt vmcnt(0)" ::: "memory"); } \
            f32x16 p = f32x16{}; \
            _Pragma("unroll") for (int d0 = 0; d0 < 4; ++d0) p = __builtin_amdgcn_mfma_f32_32x32x16_bf16(KF[d0], qr[d0], p, 0, 0, 0); \
            const unsigned vb = vb0 + (unsigned)(((c) & 1) * 4096); \
            s16x4 vl0[2], vh0[2], vl1[2], vh1[2]; \
            _Pragma("unroll") for (int d0 = 0; d0 < 2; ++d0) { \
                asm volatile("ds_read_b64_tr_b16 %0, %1 offset:%2" : "=&v"(vl0[d0]) : "v"(vb), "i"(d0 * 512) : "memory"); \
                asm volatile("ds_read_b64_tr_b16 %0, %1 offset:%2" : "=&v"(vh0[d0]) : "v"(vb), "i"(d0 * 512 + 1024) : "memory"); \
                asm volatile("ds_read_b64_tr_b16 %0, %1 offset:%2" : "=&v"(vl1[d0]) : "v"(vb), "i"(d0 * 512 + 2048) : "memory"); \
                asm volatile("ds_read_b64_tr_b16 %0, %1 offset:%2" : "=&v"(vh1[d0]) : "v"(vb), "i"(d0 * 512 + 3072) : "memory"); } \
              \
            { const float NEG = -__builtin_inff(); const int db = qi - j0 - 32 * (c) - 4 * hi; const int tb = tokb + S_ * (32 * (c) + 4 * hi); \
              if ((c) == 0 || (c) == 4 || tokb < 0) { \
                _Pragma("unroll") for (int r = 0; r < 16; ++r) { const int cr = (r & 3) + 8 * (r >> 2); \
                    const bool ok = ((unsigned)(db - cr) <= 128u) && (tb + S_ * cr >= 0); p[r] = ok ? p[r] : NEG; } } } \
            float pmax = p[0]; \
            _Pragma("unroll") for (int r = 1; r < 16; ++r) pmax = fmaxf(pmax, p[r]); \
            { auto rr = __builtin_amdgcn_permlane32_swap(__float_as_uint(pmax), __float_as_uint(pmax), false, false); pmax = fmaxf(__uint_as_float(rr[0]), __uint_as_float(rr[1])); } \
            const float mn = fmaxf(m_reg, pmax); const float alpha = __builtin_amdgcn_exp2f(m_reg - mn); m_reg = mn; \
            float ps = 0.f; \
            _Pragma("unroll") for (int r = 0; r < 16; ++r) { p[r] = __builtin_amdgcn_exp2f(p[r] - mn); ps += p[r]; } \
            { auto rr = __builtin_amdgcn_permlane32_swap(__float_as_uint(ps), __float_as_uint(ps), false, false); ps = __uint_as_float(rr[0]) + __uint_as_float(rr[1]); } \
            l_reg = l_reg * alpha + ps; \
            bf16x8 pa0, pa1; DIL_PK4(p, 0, pa0); DIL_PK4(p, 8, pa1); \
            if (__any(alpha < 1.f)) { if (hi == 0) wsf[r32] = alpha; asm volatile("s_waitcnt lgkmcnt(0)" ::: "memory"); \
                _Pragma("unroll") for (int r = 0; r < 16; ++r) { const float a = wsf[crow(r, hi)]; o[0][r] *= a; o[1][r] *= a; } } \
            asm volatile("s_waitcnt lgkmcnt(0)" ::: "memory"); __builtin_amdgcn_sched_barrier(0); \
            _Pragma("unroll") for (int d0 = 0; d0 < 2; ++d0) { \
                o[d0] = __builtin_amdgcn_mfma_f32_32x32x16_bf16(pa0, (bf16x8){vl0[d0][0], vl0[d0][1], vl0[d0][2], vl0[d0][3], vh0[d0][0], vh0[d0][1], vh0[d0][2], vh0[d0][3]}, o[d0], 0, 0, 0); \
                o[d0] = __builtin_amdgcn_mfma_f32_32x32x16_bf16(pa1, (bf16x8){vl1[d0][0], vl1[d0][1], vl1[d0][2], vl1[d0][3], vh1[d0][0], vh1[d0][1], vh1[d0][2], vh1[d0][3]}, o[d0], 0, 0, 0); } \
        } while (0)
#define DIL_PK4(P, B_, OUT) do { unsigned a0 = cvt_pk_bf16(P[B_+0], P[B_+1]), a1 = cvt_pk_bf16(P[B_+2], P[B_+3]);                          \
            unsigned b0_ = cvt_pk_bf16(P[B_+4], P[B_+5]), b1_ = cvt_pk_bf16(P[B_+6], P[B_+7]);                                             \
            auto r0 = __builtin_amdgcn_permlane32_swap(a0, b0_, false, false); auto r1 = __builtin_amdgcn_permlane32_swap(a1, b1_, false, false); \
            u32x4 w = {r0[0], r1[0], r0[1], r1[1]}; OUT = __builtin_bit_cast(bf16x8, w); } while (0)
        DIL_STEP(kfA, kfB, 0); DIL_STEP(kfB, kfA, 1); DIL_STEP(kfA, kfB, 2); DIL_STEP(kfB, kfA, 3); DIL_STEP(kfA, kfB, 4);
#undef DIL_STEP
#undef DIL_PK4
#undef DIL_KLOAD
#undef DIL_VDMA
        float fo = 0.f, fc = 1.f;
        if (S_ != 1) { const float mo = macc[ql], lo = lacc[ql]; const float mnew = fmaxf(mo, m_reg); fo = __builtin_amdgcn_exp2f(mo - mnew); fc = __builtin_amdgcn_exp2f(m_reg - mnew);
            l_reg = lo * fo + l_reg * fc; m_reg = mnew; }
        if (hi == 0 && r32 < VR) { macc[ql] = m_reg; lacc[ql] = l_reg; wsf[r32] = fo; wsf[32 + r32] = fc; }
        asm volatile("s_waitcnt lgkmcnt(0)" ::: "memory");
#pragma unroll
        for (int r = 0; r < 16; ++r) { const int row = crow(r, hi);
            if (row < VR) { const int qrow = rho + S_ * (i0 + row); LAS float* op = Oacc + qrow * 64 + r32;
                if (S_ == 1) { op[0] = o[0][r]; op[32] = o[1][r]; }
                else { const float a = wsf[row], b = wsf[32 + row]; op[0] = op[0] * a + o[0][r] * b; op[32] = op[32] * a + o[1][r] * b; } } }
        asm volatile("s_waitcnt lgkmcnt(0)" ::: "memory");
    }
}
__device__ __forceinline__ void unit(const bf16_t* Qh, const bf16_t* Kh, const bf16_t* Vh, int pitch, bf16_t* Oh, int op, int q0, LAS unsigned char* lds, LAS float* scr) {
    int tid_ = threadIdx.x; asm volatile("" : "+v"(tid_));
    const int tid = tid_, wid = __builtin_amdgcn_readfirstlane(tid >> 6), lane = tid & 63;
    pass<1>(Qh, Kh, Vh, pitch, q0, lds, scr, wid, lane);
    __syncthreads();
    pass<4>(Qh, Kh, Vh, pitch, q0, lds, scr, wid, lane);
    __syncthreads();
    pass<16>(Qh, Kh, Vh, pitch, q0, lds, scr, wid, lane);
    __syncthreads();
    {   const int q = tid >> 1, hf = tid & 1; const LAS f32x4* src = (const LAS f32x4*)(lds + OFF_O + (q * 64 + 32 * hf) * 4); const float rl = 1.0f / scr[256 + q];
        bf16_t* dst = Oh + (size_t)(q0 + q) * op + 32 * hf;
#pragma unroll
        for (int i = 0; i < 4; ++i) { const f32x4 a = src[2 * i] * rl, b = src[2 * i + 1] * rl;
            u32x4 w; w.x = cvt_pk_bf16(a[0], a[1]); w.y = cvt_pk_bf16(a[2], a[3]); w.z = cvt_pk_bf16(b[0], b[1]); w.w = cvt_pk_bf16(b[2], b[3]); *(u32x4*)(dst + 8 * i) = w; } }
    __syncthreads();
}
}

namespace mla {
using att::crow;
constexpr int DQ = 192, DV_ = 128;
constexpr int KB = 64 * DQ;
constexpr int VB = DV_ * 64;
constexpr int NBUF = 3;
constexpr int OFF_K = 0, OFF_V = NBUF * KB, OFF_WS = NBUF * (KB + VB), BYTES = OFF_WS + 8 * 256;
constexpr int NKP = KB / 1024, KPW = (NKP + 7) / 8;
constexpr int NVP = VB / 1024;
static_assert(BYTES <= 131072 && NKP == 12 && NVP == 8, "mla LDS image");
constexpr float PSHIFT = 8.0f;

__device__ __forceinline__ void unit(const unsigned char* __restrict__ Qh, const unsigned char* __restrict__ Kh, int pitch, const unsigned char* __restrict__ VTh  ,
                                     unsigned char* __restrict__ Oh, int op, int q0, LAS unsigned char* lds) {
    int tid_ = threadIdx.x; asm volatile("" : "+v"(tid_));
    const int tid = tid_, wid = __builtin_amdgcn_readfirstlane(tid >> 6), lane = tid & 63, r32 = lane & 31, hi = lane >> 5;
    const int qlo = q0 + wid * 32, qpos = qlo + r32;
    LAS float* wsf = (LAS float*)(lds + OFF_WS) + wid * 64;
    const int NT = (q0 + 256) / 64;
    unsigned kso[KPW], vso;
#pragma unroll
    for (int i = 0; i < KPW; ++i) { const int G = ((wid + 8 * i) * 64 + lane) % (NKP * 64), R = G / 12, rem = G % 12, sg = rem >> 2, qq = rem & 3, f = (R >> 2) & 3;
        const int key = 32 * ((R >> 2) & 1) + 16 * (R >> 5) + 4 * ((R >> 3) & 3) + (R & 3);
        kso[i] = (unsigned)(key * pitch + 64 * sg + 16 * (qq ^ f)); }
    {   const int G = wid * 64 + lane, d = G >> 2, qq = G & 3, f = (d >> 2) & 3; vso = (unsigned)(d * SEQ + 16 * (qq ^ f)); }
#define MLA_DMA(j, bf) do { const unsigned char* kt_ = Kh + (size_t)(j) * 64 * pitch; const unsigned char* vt_ = VTh + (size_t)(j) * 64; \
        _Pragma("unroll") for (int i = 0; i < KPW; ++i) if (wid + 8 * i < NKP) \
            __builtin_amdgcn_global_load_lds((const unsigned*)(kt_ + kso[i]), (LAS unsigned*)(lds + OFF_K + (bf) * KB + (wid + 8 * i) * 1024), 16, 0, 0); \
        __builtin_amdgcn_global_load_lds((const unsigned*)(vt_ + vso), (LAS unsigned*)(lds + OFF_V + (bf) * VB + wid * 1024), 16, 0, 0); } while (0)
#define MLA_MFMA(acc, a, b) asm volatile("v_mfma_f32_32x32x64_f8f6f4 %0, %1, %2, %0" : "+v"(acc) : "v"(a), "v"(b))
#define MLA_MFMA0(acc, a, b) asm volatile("v_mfma_f32_32x32x64_f8f6f4 %0, %1, %2, 0" : "=v"(acc) : "v"(a), "v"(b))
#define MLA_MFMA_DRAIN2(a, b) asm volatile("s_nop 15\n\ts_nop 3" : "+v"(a), "+v"(b) :: "memory")
    i32x8 qr[3];
#pragma unroll
    for (int s = 0; s < 3; ++s) { const i32x4 lo_ = *(const i32x4*)(Qh + (size_t)qpos * pitch + 64 * s + 32 * hi), hi_ = *(const i32x4*)(Qh + (size_t)qpos * pitch + 64 * s + 32 * hi + 16);
        qr[s] = __builtin_shufflevector(lo_, hi_, 0, 1, 2, 3, 4, 5, 6, 7); }
    MLA_DMA(0, 0); MLA_DMA(1, 1);
#define MLA_WAIT_OLDER() do { if (wid < NKP - 8) asm volatile("s_waitcnt vmcnt(%0)" :: "n"(KPW + 1) : "memory"); else asm volatile("s_waitcnt vmcnt(%0)" :: "n"(KPW) : "memory"); } while (0)
    float m_reg = -1e30f;
    f32x16 o[4], ol = f32x16{};
#pragma unroll
    for (int d = 0; d < 4; ++d) o[d] = f32x16{};
    const int fsw = (r32 >> 2) & 3;
    const int koff = r32 * DQ + 16 * ((2 * hi) ^ fsw), voff = r32 * 64 + 16 * ((2 * hi) ^ fsw);
    MLA_WAIT_OLDER();
    asm volatile("" :: "v"(qr[0]), "v"(qr[1]), "v"(qr[2]));
    __builtin_amdgcn_s_barrier();
#define MLA_LD8(dst, base, off) do { const i32x4 lo_ = *(const LAS i32x4*)((base) + (off)), hi_ = *(const LAS i32x4*)((base) + ((off) ^ 16)); dst = __builtin_shufflevector(lo_, hi_, 0, 1, 2, 3, 4, 5, 6, 7); } while (0)
    int buf = 0;
    for (int t = 0; t < NT; ++t) {
        const int kb = t * 64;
        if (kb <= qlo + 31) {
            const LAS unsigned char* kp_ = lds + OFF_K + buf * KB;
            const LAS unsigned char* vp_ = lds + OFF_V + buf * VB;
            f32x16 s0, s1;
            if (kb + 63 <= qlo) {
                i32x8 k0[3], k1[3];
#pragma unroll
                for (int s = 0; s < 3; ++s) MLA_LD8(k0[s], kp_ + 64 * s, koff);
                MLA_MFMA0(s0, k0[0], qr[0]);
#pragma unroll
                for (int s = 0; s < 3; ++s) MLA_LD8(k1[s], kp_ + 32 * DQ + 64 * s, koff);
                MLA_MFMA(s0, k0[1], qr[1]); MLA_MFMA(s0, k0[2], qr[2]);
                MLA_MFMA0(s1, k1[0], qr[0]); MLA_MFMA(s1, k1[1], qr[1]); MLA_MFMA(s1, k1[2], qr[2]);
            } else {
                const float NEG = -__builtin_inff(); const int dq = qpos - kb - 32 * hi;
                int kq_ = koff; asm volatile("" : "+v"(kq_));
                {   i32x8 k0[3];
#pragma unroll
                    for (int s = 0; s < 3; ++s) MLA_LD8(k0[s], kp_ + 64 * s, kq_);
                    MLA_MFMA0(s0, k0[0], qr[0]); MLA_MFMA(s0, k0[1], qr[1]); MLA_MFMA(s0, k0[2], qr[2]);
                }
                {   i32x8 k1[3];
#pragma unroll
                    for (int s = 0; s < 3; ++s) MLA_LD8(k1[s], kp_ + 32 * DQ + 64 * s, kq_);
                    MLA_MFMA0(s1, k1[0], qr[0]); MLA_MFMA(s1, k1[1], qr[1]); MLA_MFMA(s1, k1[2], qr[2]);
                }
                MLA_MFMA_DRAIN2(s0, s1);
#pragma unroll
                for (int r = 0; r < 16; ++r) { if (r > dq) s0[r] = NEG; if (r + 16 > dq) s1[r] = NEG; }
            }

            i32x8 vv[4];
#pragma unroll
            for (int d0 = 0; d0 < 4; ++d0) MLA_LD8(vv[d0], vp_ + d0 * 32 * 64, voff);
            MLA_MFMA_DRAIN2(s0, s1);
            __builtin_amdgcn_sched_barrier(0);
            float pm0 = s0[0], pm1 = s0[8];
#define MLA_MAX8(pm, B_) asm("v_max3_f32 %0, %0, %1, %2\n\tv_max3_f32 %0, %0, %3, %4\n\tv_max3_f32 %0, %0, %5, %6\n\tv_max3_f32 %0, %0, %7, %8\n\tv_max3_f32 %0, %0, %9, %10\n\tv_max3_f32 %0, %0, %11, %12\n\tv_max3_f32 %0, %0, %13, %14\n\tv_max3_f32 %0, %0, %15, %16" \
                : "+v"(pm) : "v"(s0[B_ + 0]), "v"(s1[B_ + 0]), "v"(s0[B_ + 1]), "v"(s1[B_ + 1]), "v"(s0[B_ + 2]), "v"(s1[B_ + 2]), "v"(s0[B_ + 3]), "v"(s1[B_ + 3]), \
                              "v"(s0[B_ + 4]), "v"(s1[B_ + 4]), "v"(s0[B_ + 5]), "v"(s1[B_ + 5]), "v"(s0[B_ + 6]), "v"(s1[B_ + 6]), "v"(s0[B_ + 7]), "v"(s1[B_ + 7]))
            MLA_MAX8(pm0, 0); MLA_MAX8(pm1, 8);
#undef MLA_MAX8
            float pmax = fmaxf(pm0, pm1);
            { auto rr = __builtin_amdgcn_permlane32_swap(__float_as_uint(pmax), __float_as_uint(pmax), false, false); pmax = fmaxf(__uint_as_float(rr[0]), __uint_as_float(rr[1])); }
            const float mn = fmaxf(m_reg, pmax); const float alpha = __builtin_amdgcn_exp2f((m_reg - mn) * 0.125f); m_reg = mn;
            const float b8 = 8.0f * (PSHIFT + 7.0f) - mn;
            i32x8 pa;
            const f32x16 t0 = s0 + b8, t1 = s1 + b8;
#pragma unroll
            for (int g = 0; g < 4; ++g) { unsigned w0 = 0u, w1 = 0u;
#pragma unroll
                for (int b_ = 0; b_ < 4; ++b_) { w0 = __builtin_amdgcn_cvt_pk_u8_f32(t0[4 * g + b_], b_, w0); w1 = __builtin_amdgcn_cvt_pk_u8_f32(t1[4 * g + b_], b_, w1); }
                pa[g] = (int)w0; pa[4 + g] = (int)w1; }
            if (__any(alpha < 1.f)) { if (hi == 0) wsf[r32] = alpha; asm volatile("s_waitcnt lgkmcnt(0)" ::: "memory");
#pragma unroll
                for (int r = 0; r < 16; ++r) { const float a = wsf[crow(r, hi)]; ol[r] *= a;
#pragma unroll
                    for (int d = 0; d < 4; ++d) o[d][r] *= a; } }
            int one_ = 0x38383838; asm volatile("" : "+v"(one_));
            const i32x8 ones8 = {one_, one_, one_, one_, one_, one_, one_, one_};
            asm volatile("s_nop 1" ::: "memory");
            MLA_MFMA(ol, pa, ones8);
#pragma unroll
            for (int d0 = 0; d0 < 4; ++d0) MLA_MFMA(o[d0], pa, vv[d0]);
        }
        if (t + 2 < NT) { const int b2 = buf == 0 ? 2 : buf - 1; MLA_DMA(t + 2, b2); }
        if (t + 2 < NT) { MLA_WAIT_OLDER(); } else { asm volatile("s_waitcnt vmcnt(0)" ::: "memory"); }
        asm volatile("s_waitcnt lgkmcnt(0)" ::: "memory");
        __builtin_amdgcn_s_barrier();
        buf = buf == 2 ? 0 : buf + 1;
    }
    MLA_MFMA_DRAIN2(o[0], o[1]); MLA_MFMA_DRAIN2(o[2], o[3]); MLA_MFMA_DRAIN2(ol, o[0]);
#undef MLA_MFMA_DRAIN2
#undef MLA_MFMA0
#undef MLA_MFMA
#undef MLA_LD8
#undef MLA_WAIT_OLDER
#undef MLA_DMA
    unsigned char* Ow = Oh + (size_t)qlo * op;
#pragma unroll
    for (int r = 0; r < 16; ++r) { const int orow = crow(r, hi); const float rl = __builtin_amdgcn_rcpf(ol[r]);
#pragma unroll
        for (int d0 = 0; d0 < 4; ++d0) { const float v = o[d0][r] * rl; const float v1 = __shfl_down(v, 1), v2 = __shfl_down(v, 2), v3 = __shfl_down(v, 3);
            if ((r32 & 3) == 0) *(unsigned*)(Ow + (size_t)orow * op + d0 * 32 + r32) = pk4_fp8(v, v1, v2, v3); } }
    __syncthreads();
}
}

constexpr int NWAVES = 8;
constexpr size_t MiB = 1u << 20;
constexpr size_t WS_CTL = 0, CTL_ZERO_BYTES = 1 * MiB;
constexpr size_t WS_WEIN = 2 * MiB;
constexpr size_t WS_WEOUT = 12 * MiB;
constexpr size_t WS_WOIN = 16 * MiB;
constexpr size_t WS_WUQ = 20 * MiB;
constexpr size_t WS_WUKV = 23 * MiB;
constexpr size_t WS_WOOUT = 25 * MiB;
constexpr size_t WS_B1P = 29 * MiB;
constexpr size_t WS_SSQ = 30 * MiB;
constexpr size_t WS_TOKER = 31 * MiB;
constexpr size_t WS_TOKG = 31 * MiB + 512 * 1024;
constexpr size_t WS_XN = 32 * MiB;
constexpr size_t WS_Z = 64 * MiB;
constexpr size_t WS_MIX = 144 * MiB;
constexpr size_t WS_QR = 176 * MiB;
constexpr size_t WS_KVR = 224 * MiB;
constexpr size_t WS_QF = 288 * MiB;
constexpr size_t WS_KF = 336 * MiB;
constexpr size_t WS_Z8 = 104 * MiB;
constexpr size_t WS_MIX8 = 160 * MiB;
constexpr size_t WS_VT = 3200 * MiB;
constexpr size_t WS_W1 = 384 * MiB;
constexpr size_t WS_W2 = 896 * MiB;
constexpr size_t WS_XG = 1152 * MiB;
constexpr size_t WS_ACT = 1664 * MiB;
constexpr size_t WS_Y = 2176 * MiB;
constexpr size_t WS_X16 = 3216 * MiB;
constexpr size_t WS_END = 3248 * MiB;
constexpr int CW_MOE = 65536;
constexpr int CW_TMO = 0, CW_CODE = 1, CW_BAR = 4096, CW_CNT = 16384;
constexpr int RING_OFF = 0, RING_BYTES = 131072;
constexpr int LDSCTL_OFF = RING_BYTES, MISC_OFF = LDSCTL_OFF + 320;
constexpr int SCR_OFF = RING_BYTES + 1024;
constexpr int LDS_BYTES = 155648;
constexpr int SCR_BYTES = LDS_BYTES - SCR_OFF;

typedef GAS unsigned gu32;
#define RLX_AGENT __ATOMIC_RELAXED, __HIP_MEMORY_SCOPE_AGENT

#define XB_TMO      128
#define XB_XCNT(j)  (256  + 64 * (j))
#define XB_XSUB(j)  (1280 + 64 * (j))
#define XB_XGEN(j)  (2304 + 64 * (j))
#define XB_TOP      3328
#define XB_TOPGEN   3392
#define XCD_BAR_WORDS 3456
#define XB_SPIN_CAP (1u << 18)
__device__ __forceinline__ unsigned xb_ld(unsigned* p)              { return __hip_atomic_load(p, __ATOMIC_RELAXED, __HIP_MEMORY_SCOPE_AGENT); }
__device__ __forceinline__ unsigned xb_add(unsigned* p, unsigned v) { return __hip_atomic_fetch_add(p, v, __ATOMIC_RELAXED, __HIP_MEMORY_SCOPE_AGENT); }
__device__ __forceinline__ unsigned xb_xcc_id() { return (unsigned)__builtin_amdgcn_s_getreg((3 << 11) | 20) & 0xFu; }
#define XB_SPIN(cond, bar) do { unsigned _sp = 0; while (cond) { __builtin_amdgcn_s_sleep(1); \
    if ((++_sp & 255u) == 0u) { if (xb_ld(&(bar)[XB_TMO])) break; if (_sp > XB_SPIN_CAP) { atomicAdd(&(bar)[XB_TMO], 1u); break; } } } } while (0)
struct XcdBarrier { unsigned* bar; unsigned x; volatile LAS unsigned* st; };
__device__ __forceinline__ XcdBarrier xcd_barrier_post(unsigned* bar, volatile LAS unsigned* st) {
    XcdBarrier b; b.bar = bar; b.x = xb_xcc_id(); b.st = st;
    if (threadIdx.x == 0) (void)xb_add(&bar[XB_XCNT(b.x)], 1u);
    return b;
}
__device__ __forceinline__ void xcd_barrier_complete(unsigned* bar, unsigned x, unsigned& nloc, unsigned& nx) {
    const unsigned G = gridDim.x * gridDim.y * gridDim.z;
    unsigned sum, cnt, mine, sp = 0u;
    for (;;) {
        sum = 0u; cnt = 0u; mine = 0u;
#pragma unroll
        for (unsigned j = 0; j < 16; ++j) { const unsigned c = xb_ld(&bar[XB_XCNT(j)]); sum += c; cnt += (c > 0u) ? 1u : 0u; mine = (j == x) ? c : mine; }
        if (sum == G) break;
        __builtin_amdgcn_s_sleep(1);
        if ((++sp & 255u) == 0u) { if (xb_ld(&bar[XB_TMO])) break; if (sp > XB_SPIN_CAP) { atomicAdd(&bar[XB_TMO], 1u); break; } }
    }
    nloc = mine > 0u ? mine : 1u; nx = cnt > 0u ? cnt : 1u;
}
__device__ __forceinline__ void xcd_barrier(const XcdBarrier& b) {
    asm volatile("s_waitcnt vmcnt(0)" ::: "memory");
    __syncthreads();
    if (threadIdx.x == 0) {
        unsigned* bar = b.bar;
        __builtin_amdgcn_s_waitcnt(0);
        unsigned nloc = b.st[0], nx = b.st[1];
        if (nloc == 0u) { xcd_barrier_complete(bar, b.x, nloc, nx); b.st[0] = nloc; b.st[1] = nx; }
        const unsigned old = xb_add(&bar[XB_XSUB(b.x)], 1u);
        const unsigned gen = old / nloc;
        if (old + 1u == (gen + 1u) * nloc) {
            __builtin_amdgcn_fence(__ATOMIC_RELEASE, "agent");
            asm volatile("s_waitcnt vmcnt(0)" ::: "memory");
            const unsigned og = xb_add(&bar[XB_TOP], 1u);
            const unsigned tg = og / nx;
            if (og + 1u == (tg + 1u) * nx) xb_add(&bar[XB_TOPGEN], 1u);
            else XB_SPIN(xb_ld(&bar[XB_TOPGEN]) == tg, bar);
            __builtin_amdgcn_fence(__ATOMIC_ACQUIRE, "agent");
            xb_add(&bar[XB_XGEN(b.x)], 1u);
            asm volatile("s_waitcnt vmcnt(0)" ::: "memory");
        } else {
            XB_SPIN(xb_ld(&bar[XB_XGEN(b.x)]) == gen, bar);
            __builtin_amdgcn_fence(__ATOMIC_ACQUIRE, "agent");
            asm volatile("s_waitcnt vmcnt(0)" ::: "memory");
        }
    }
    __syncthreads();
}

struct Args {
    const float* in[24]; float* out; unsigned char* ws; int stage_limit; int pad;
};
enum { I_X = 0, I_MIXN, I_FFNN, I_EWIN, I_EWS, I_EBS, I_EGV, I_EGQ, I_EGK, I_EWOUT, I_OWIN, I_OGCQ, I_OGCKV, I_OWUQ, I_OWUKV, I_OGQ, I_OGK, I_OWOUT,
       I_RW, I_RB, I_W1, I_B1, I_W2, I_B2 };

struct Frame {
    LAS unsigned char* lds;
    int vcu, G;
};

__device__ __forceinline__ float wave_sum(float v) {
#pragma unroll
    for (int o = 1; o < 64; o <<= 1) v += __shfl_xor(v, o);
    return v;
}
#define LDS_WAIT() asm volatile("s_waitcnt lgkmcnt(0)" ::: "memory")

template <int MODE> __device__ __forceinline__ int dst_row(int o) {
    if (MODE == 1) { if (o >= 1024 && o < 2048) return (o & ~255) | (((o >> 5) & 1) << 7) | (((o >> 6) & 3) << 5) | (o & 31); return o; }
    if (MODE == 2) return ((o >> 8) << 8) | ((o & 1) << 7) | ((o & 255) >> 1);
    return o;
}
template <int MODE>
__device__ __forceinline__ void transpose_item(const float* __restrict__ W, int K, int N, bf16_t* __restrict__ WT, const float* __restrict__ gain, LAS float* scr, int item, int lane) {
    const int nblk = N / 32, kb = item / nblk, nb = item % nblk, k0 = 64 * kb, n0 = 32 * nb;
#pragma unroll 8
    for (int i = 0; i < 32; ++i) { const int kk = 2 * i + (lane >> 5); float w = W[(size_t)(k0 + kk) * N + n0 + (lane & 31)]; if (gain) w *= gain[k0 + kk]; scr[kk * 33 + (lane & 31)] = w; }
    LDS_WAIT(); asm volatile("" ::: "memory");
    const int c = lane & 7;
#pragma unroll
    for (int j = 0; j < 4; ++j) { const int n = (lane >> 3) + 8 * j; const LAS float* s = scr + (8 * c) * 33 + n;
        u32x4 o; o.x = cvt_pk_bf16(s[0 * 33], s[1 * 33]); o.y = cvt_pk_bf16(s[2 * 33], s[3 * 33]); o.z = cvt_pk_bf16(s[4 * 33], s[5 * 33]); o.w = cvt_pk_bf16(s[6 * 33], s[7 * 33]);
        *(u32x4*)(WT + (size_t)dst_row<MODE>(n0 + n) * K + k0 + 8 * c) = o; }
    LDS_WAIT(); asm volatile("" ::: "memory");
}
template <int MODE>
__device__ __forceinline__ void transpose_job(Frame& F, const float* W, int K, int N, int nmat, size_t src_stride, bf16_t* WT, size_t dst_stride, const float* gain, int gain_stride) {
    int tid_ = threadIdx.x; asm volatile("" : "+v"(tid_));
    const int wave = __builtin_amdgcn_readfirstlane(tid_ >> 6), lane = tid_ & 63;
    LAS float* scr = (LAS float*)(F.lds + RING_OFF + wave * 16384);
    const int gw = F.vcu * NWAVES + wave, NGW = F.G * NWAVES;
    const int per = (K / 64) * (N / 32), total = per * nmat;
    for (int it = gw; it < total; it += NGW) { const int mi = it / per, item = it - mi * per;
        transpose_item<MODE>(W + (size_t)mi * src_stride, K, N, WT + (size_t)mi * dst_stride, gain ? gain + (size_t)mi * gain_stride : nullptr, scr, item, lane); }
}


__device__ __forceinline__ void tr8_load(f32x4 (&v)[16], const float* __restrict__ W, int N, int item, int lane) {
    const int nblk = N / 32, kb = item / nblk, nb = item % nblk, k0 = 128 * kb, n0 = 32 * nb;
#pragma unroll
    for (int i = 0; i < 16; ++i) v[i] = __builtin_nontemporal_load((const f32x4*)(W + (size_t)(k0 + 8 * i + (lane >> 3)) * N + n0 + 4 * (lane & 7)));
}
template <int MODE>
__device__ __forceinline__ void tr8_store(const f32x4 (&v)[16], int K, int N, unsigned char* __restrict__ WT, const float* __restrict__ gain, LAS unsigned char* scr, int item, int lane) {
    const int nblk = N / 32, kb = item / nblk, nb = item % nblk, k0 = 128 * kb, n0 = 32 * nb;
    constexpr int TP = 144;
#pragma unroll
    for (int i = 0; i < 16; ++i) { const int kl = 8 * i + (lane >> 3); const float sc = gain ? W8_SCALE * gain[k0 + kl] : W8_SCALE;
        const unsigned w = pk4_fp8(v[i].x * sc, v[i].y * sc, v[i].z * sc, v[i].w * sc); LAS unsigned char* d = scr + (4 * (lane & 7)) * TP + kl;
        d[0] = (unsigned char)w; d[TP] = (unsigned char)(w >> 8); d[2 * TP] = (unsigned char)(w >> 16); d[3 * TP] = (unsigned char)(w >> 24); }
    LDS_WAIT(); asm volatile("" ::: "memory");
#pragma unroll
    for (int m = 0; m < 4; ++m) { const int q = lane + 64 * m, n = q >> 3, kc = q & 7;
        const u32x4 o = *(const LAS u32x4*)(scr + n * TP + 16 * kc);
        __builtin_nontemporal_store(o, (u32x4*)(WT + (size_t)dst_row<MODE>(n0 + n) * K + k0 + 16 * kc)); }
    LDS_WAIT(); asm volatile("" ::: "memory");
}
template <int MODE>
__device__ __forceinline__ void transpose_job_fp8(Frame& F, const float* W, int K, int N, int nmat, size_t src_stride, unsigned char* WT, size_t dst_stride, const float* gain = nullptr, int gain_stride = 0) {
    int tid_ = threadIdx.x; asm volatile("" : "+v"(tid_));
    const int wave = __builtin_amdgcn_readfirstlane(tid_ >> 6), lane = tid_ & 63;
    LAS unsigned char* scr = F.lds + RING_OFF + wave * 16384;
    const int gw = F.vcu * NWAVES + wave, NGW = F.G * NWAVES;
    const int per = (K / 128) * (N / 32), total = per * nmat;
    f32x4 cur[16], nxt[16];
    int it = gw;
    if (it < total) { const int mi = it / per; tr8_load(cur, W + (size_t)mi * src_stride, N, it - mi * per, lane); }
    for (; it < total; it += NGW) {
        const int itn = it + NGW;
        if (itn < total) { const int mn = itn / per; tr8_load(nxt, W + (size_t)mn * src_stride, N, itn - mn * per, lane); }
        const int mi = it / per;
        tr8_store<MODE>(cur, K, N, WT + (size_t)mi * dst_stride, gain ? gain + (size_t)mi * gain_stride : nullptr, scr, it - mi * per, lane);
#pragma unroll
        for (int i = 0; i < 16; ++i) cur[i] = nxt[i];
    }
}

__device__ __forceinline__ void rms_row_to_fp8(int lane, const float* xrow, const float* g, unsigned char* orow, float* copy) {
    const f32x4* xr = (const f32x4*)xrow + lane; const f32x4* gr = (const f32x4*)g + lane;
    f32x4 v[4]; float s = 0.f;
#pragma unroll
    for (int j = 0; j < 4; ++j) { v[j] = xr[64 * j]; s += (v[j].x * v[j].x + v[j].y * v[j].y) + (v[j].z * v[j].z + v[j].w * v[j].w); }
    const float rstd = 1.0f / sqrtf(wave_sum(s) * (1.f / DM) + EPS);
    unsigned* o4 = (unsigned*)orow + lane;
#pragma unroll
    for (int j = 0; j < 4; ++j) { const f32x4 gg = gr[64 * j]; if (copy) ((f32x4*)copy + lane)[64 * j] = v[j];
        o4[64 * j] = pk4_fp8(v[j].x * rstd * gg.x, v[j].y * rstd * gg.y, v[j].z * rstd * gg.z, v[j].w * rstd * gg.w); }
}
__device__ __forceinline__ void rms_row_to_bf16(int lane, const float* xrow, const float* g, bf16_t* orow, float* copy) {
    const f32x4* xr = (const f32x4*)xrow + lane; const f32x4* gr = (const f32x4*)g + lane;
    f32x4 v[4]; float s = 0.f;
#pragma unroll
    for (int j = 0; j < 4; ++j) { v[j] = xr[64 * j]; s += (v[j].x * v[j].x + v[j].y * v[j].y) + (v[j].z * v[j].z + v[j].w * v[j].w); }
    const float rstd = 1.0f / sqrtf(wave_sum(s) * (1.f / DM) + EPS);
    u32x2* o8 = (u32x2*)orow + lane;
#pragma unroll
    for (int j = 0; j < 4; ++j) { const f32x4 gg = gr[64 * j]; if (copy) ((f32x4*)copy + lane)[64 * j] = v[j];
        u32x2 w; w.x = cvt_pk_bf16(v[j].x * rstd * gg.x, v[j].y * rstd * gg.y); w.y = cvt_pk_bf16(v[j].z * rstd * gg.z, v[j].w * rstd * gg.w); o8[64 * j] = w; }
}

namespace pg8 {
struct EpiEvenIn {
    static constexpr bool PERM = false;
    bf16_t* Z; const float* gq; const float* gk;
    __device__ __forceinline__ void operator()(const f32x4 (&acc)[2][2][4][2], const Unit& u, int wr, int wc, int fr, int fq) const {
        const int row0 = u.pm * BM + wr * 64 + fr, pn = u.pn;
        if (pn >= 4 && pn < 8) {
            const float* g = pn < 6 ? gq : gk; const float sc = pn < 6 ? C2_B : 1.0f;
            f32x4 gv[2][2];
#pragma unroll
            for (int bj = 0; bj < 2; ++bj)
#pragma unroll
                for (int n = 0; n < 2; ++n) gv[bj][n] = *(const f32x4*)(g + 32 * bj + 16 * n + 4 * fq);
#pragma unroll
            for (int ai = 0; ai < 2; ++ai)
#pragma unroll
                for (int m = 0; m < 4; ++m) {
                    float ss = 0.f;
#pragma unroll
                    for (int bj = 0; bj < 2; ++bj)
#pragma unroll
                        for (int n = 0; n < 2; ++n) { const f32x4 v = acc[ai][bj][m][n]; ss += (v[0] * v[0] + v[1] * v[1]) + (v[2] * v[2] + v[3] * v[3]); }
                    ss += __shfl_xor(ss, 16); ss += __shfl_xor(ss, 32);
                    const float rstd = sc / sqrtf(ss * (1.0f / 64.0f) + EPS);
                    bf16_t* rowp = Z + (size_t)(row0 + ai * HALF + m * 16) * EVEN_IN + pn * BM + wc * 64 + 4 * fq;
#pragma unroll
                    for (int bj = 0; bj < 2; ++bj)
#pragma unroll
                        for (int n = 0; n < 2; ++n) { const f32x4 v = acc[ai][bj][m][n] * rstd * gv[bj][n];
                            u32x2 w; w.x = cvt_pk_bf16(v[0], v[1]); w.y = cvt_pk_bf16(v[2], v[3]); *(u32x2*)(rowp + 32 * bj + 16 * n) = w; }
                }
        } else {
            const bool act = pn < 4;
#pragma unroll
            for (int ai = 0; ai < 2; ++ai)
#pragma unroll
                for (int m = 0; m < 4; ++m) { bf16_t* rowp = Z + (size_t)(row0 + ai * HALF + m * 16) * EVEN_IN + pn * BM + wc * 32 + 4 * fq;
#pragma unroll
                    for (int bj = 0; bj < 2; ++bj)
#pragma unroll
                        for (int n = 0; n < 2; ++n) { f32x4 v = acc[ai][bj][m][n]; if (act) v = gelu4(v);
                            u32x2 w; w.x = cvt_pk_bf16(v[0], v[1]); w.y = cvt_pk_bf16(v[2], v[3]); *(u32x2*)(rowp + bj * HALF + 16 * n) = w; } }
        }
    }
};
template <bool F8 = false> struct EpiResidT {
    static constexpr bool PERM = false;
    const float* src32; bf16_t* X;
    __device__ __forceinline__ void operator()(const f32x4 (&acc)[2][2][4][2], const Unit& u, int wr, int wc, int fr, int fq) const {
        const int row0 = u.pm * BM + wr * 64 + fr;
#pragma unroll
        for (int ai = 0; ai < 2; ++ai)
#pragma unroll
            for (int m = 0; m < 4; ++m) { const size_t ro = (size_t)(row0 + ai * HALF + m * 16) * DM + u.pn * BM + wc * 32 + 4 * fq;
#pragma unroll
                for (int bj = 0; bj < 2; ++bj)
#pragma unroll
                    for (int n = 0; n < 2; ++n) { const size_t o_ = ro + bj * HALF + 16 * n; f32x4 b;
                        if (src32) b = *(const f32x4*)(src32 + o_); else { const u32x2 t = *(const u32x2*)(X + o_); b = (f32x4){bflo(t.x), bfhi(t.x), bflo(t.y), bfhi(t.y)}; }
                        const f32x4 r = b + (F8 ? acc[ai][bj][m][n] * W8_INV : acc[ai][bj][m][n]);
                        u32x2 w; w.x = cvt_pk_bf16(r[0], r[1]); w.y = cvt_pk_bf16(r[2], r[3]); *(u32x2*)(X + o_) = w; }
                if (m & 1) asm volatile("" ::: "memory"); }
    }
};
typedef EpiResidT<false> EpiResid;
struct EpiOddIn {
    static constexpr bool PERM = false;
    bf16_t* Z; unsigned char* Z8; float* ssq;
    __device__ __forceinline__ void operator()(const f32x4 (&acc)[2][2][4][2], const Unit& u, int wr, int wc, int fr, int fq) const {
        const int row0 = u.pm * BM + wr * 64 + fr, pn = u.pn;
#pragma unroll
        for (int ai = 0; ai < 2; ++ai)
#pragma unroll
            for (int m = 0; m < 4; ++m) { const int row = row0 + ai * HALF + m * 16; bf16_t* rowp = Z + (size_t)row * ODD_INP + pn * BM + wc * 32 + 4 * fq;
                float ss = 0.f;
#pragma unroll
                for (int bj = 0; bj < 2; ++bj)
#pragma unroll
                    for (int n = 0; n < 2; ++n) { const f32x4 v = acc[ai][bj][m][n] * W8_INV; ss += (v[0] * v[0] + v[1] * v[1]) + (v[2] * v[2] + v[3] * v[3]);
                        if (pn < 3) *(unsigned*)(Z8 + (size_t)row * ODD_INP + pn * BM + wc * 32 + 4 * fq + bj * HALF + 16 * n) = pk4_fp8(v[0], v[1], v[2], v[3]);
                        else { u32x2 w; w.x = cvt_pk_bf16(v[0], v[1]); w.y = cvt_pk_bf16(v[2], v[3]); *(u32x2*)(rowp + bj * HALF + 16 * n) = w; } }
                ss += __shfl_xor(ss, 16); ss += __shfl_xor(ss, 32);
                if (fq == 0) ssq[(size_t)row * 16 + pn * 4 + wc] = ss; }
    }
};
template <int NS> struct EpiRowScale {
    static constexpr bool PERM = true;
    unsigned char* O; int ldc; const float* ssq; int s0; float inv_cols;
    __device__ __forceinline__ void operator()(const f32x4 (&acc)[2][2][4][2], const Unit& u, int wr, int wc, int fr, int fq) const {
        const int row0 = u.pm * BM + wr * 64 + fr; const int col0 = u.pn * BM + wc * 32 + 8 * fq;
#pragma unroll
        for (int ai = 0; ai < 2; ++ai)
#pragma unroll
            for (int m = 0; m < 4; ++m) { const int row = row0 + ai * HALF + m * 16;
                float ss = 0.f; const f32x4* sp = (const f32x4*)(ssq + (size_t)row * 16 + s0);
#pragma unroll
                for (int q = 0; q < NS; ++q) { const f32x4 t = sp[q]; ss += (t[0] + t[1]) + (t[2] + t[3]); }
                const float rstd = W8_INV / sqrtf(ss * inv_cols + EPS);
                unsigned char* rowp = O + (size_t)row * ldc + col0;
#pragma unroll
                for (int bj = 0; bj < 2; ++bj) { const f32x4 v0 = acc[ai][bj][m][0] * rstd, v1 = acc[ai][bj][m][1] * rstd;
                    u32x2 w; w.x = pk4_fp8(v0[0], v0[1], v0[2], v0[3]); w.y = pk4_fp8(v1[0], v1[1], v1[2], v1[3]);
                    *(u32x2*)(rowp + bj * HALF) = w; }
                asm volatile("" ::: "memory"); }
    }
};
__device__ __forceinline__ void store8_sc1(void* p, u32x2 v) { asm volatile("global_store_dwordx2 %0, %1, off sc1" :: "v"(p), "v"(v) : "memory"); }
template <bool WT = false> struct EpiSwigluT {
    static constexpr bool PERM = true;
    unsigned char* ACT; const float* b1p;
    __device__ __forceinline__ void operator()(const f32x4 (&acc)[2][2][4][2], const Unit& u, int wr, int wc, int fr, int fq) const {
        const int row0 = u.pm * BM + wr * 64 + fr, e = u.pb >> 3, pn = u.pn;
        const float* bp = b1p + (size_t)e * 2048 + pn * BM + wc * 32 + 8 * fq;
        f32x4 bg[2], bl[2];
#pragma unroll
        for (int n = 0; n < 2; ++n) { bg[n] = *(const f32x4*)(bp + 4 * n); bl[n] = *(const f32x4*)(bp + HALF + 4 * n) + 1.0f; }
#pragma unroll
        for (int ai = 0; ai < 2; ++ai)
#pragma unroll
            for (int m = 0; m < 4; ++m) { unsigned char* rowp = ACT + (size_t)(row0 + ai * HALF + m * 16) * DE + pn * HALF + wc * 32 + 8 * fq;
                float a[8];
#pragma unroll
                for (int n = 0; n < 2; ++n) { const f32x4 gv = acc[ai][0][m][n] * W8_INV + bg[n], lv = acc[ai][1][m][n] * W8_INV + bl[n];
#pragma unroll
                    for (int i = 0; i < 4; ++i) { const float gl = fminf(gv[i], 7.0f), li1 = __builtin_amdgcn_fmed3f(lv[i], -6.0f, 8.0f);
                        const float sg = __builtin_amdgcn_rcpf(1.0f + __builtin_amdgcn_exp2f(-1.702f * LOG2E * gl));
                        a[4 * n + i] = gl * sg * li1; } }
                u32x2 w; w.x = pk4_fp8(a[0], a[1], a[2], a[3]); w.y = pk4_fp8(a[4], a[5], a[6], a[7]);
                if (WT) store8_sc1(rowp, w); else *(u32x2*)rowp = w; }
    }
};
typedef EpiSwigluT<false> EpiSwiglu;
struct EpiDown {
    static constexpr bool PERM = true;
    bf16_t* Y; const float* b2;
    __device__ __forceinline__ void operator()(const f32x4 (&acc)[2][2][4][2], const Unit& u, int wr, int wc, int fr, int fq) const {
        const int row0 = u.pm * BM + wr * 64 + fr, e = u.pb >> 2, pn = u.pn;
        const float* bp = b2 + (size_t)e * DM + pn * BM + wc * 32 + 8 * fq;
        f32x4 bv[2][2];
#pragma unroll
        for (int bj = 0; bj < 2; ++bj)
#pragma unroll
            for (int n = 0; n < 2; ++n) bv[bj][n] = *(const f32x4*)(bp + bj * HALF + 4 * n);
#pragma unroll
        for (int ai = 0; ai < 2; ++ai)
#pragma unroll
            for (int m = 0; m < 4; ++m) {
#ifdef Y8
                unsigned char* rowp = (unsigned char*)Y + (size_t)(row0 + ai * HALF + m * 16) * DM + pn * BM + wc * 32 + 8 * fq;
#pragma unroll
                for (int bj = 0; bj < 2; ++bj) { const f32x4 v0 = (acc[ai][bj][m][0] * W8_INV + bv[bj][0]) * Y8_SCALE, v1 = (acc[ai][bj][m][1] * W8_INV + bv[bj][1]) * Y8_SCALE;
                    u32x2 w; w.x = pk4_fp8(v0[0], v0[1], v0[2], v0[3]); w.y = pk4_fp8(v1[0], v1[1], v1[2], v1[3]);
                    *(u32x2*)(rowp + bj * HALF) = w; }
#else
                bf16_t* rowp = Y + (size_t)(row0 + ai * HALF + m * 16) * DM + pn * BM + wc * 32 + 8 * fq;
#pragma unroll
                for (int bj = 0; bj < 2; ++bj) { const f32x4 v0 = acc[ai][bj][m][0] * W8_INV + bv[bj][0], v1 = acc[ai][bj][m][1] * W8_INV + bv[bj][1];
                    u32x4 w; w.x = cvt_pk_bf16(v0[0], v0[1]); w.y = cvt_pk_bf16(v0[2], v0[3]); w.z = cvt_pk_bf16(v1[0], v1[1]); w.w = cvt_pk_bf16(v1[2], v1[3]);
                    *(u32x4*)(rowp + bj * HALF) = w; }
#endif
            }
    }
};
struct MoeOrder {
    const LAS int* tbl; int nN, G, c;
    __device__ bool next(int i, Unit& u) const {
        const long L = (long)i * G + c; const int rb = (int)(L / nN);
        if (rb >= __builtin_amdgcn_readfirstlane(tbl[32])) return false;
        int e = 0;
#pragma unroll
        for (int k = 1; k < 32; ++k) e += (tbl[k] <= rb) ? 1 : 0;
        e = __builtin_amdgcn_readfirstlane(e); const int rbl = __builtin_amdgcn_readfirstlane(rb - tbl[e]);
        u.pm = e * (ECAP / BM) + rbl; u.pn = (int)(L % nN); u.pb = e * nN + u.pn; u.kind = 0; u.rb = rb; return true;
    }
    __device__ __forceinline__ void a_ready(const Unit&) const {}
    __device__ __forceinline__ void pre_epi() const {}
    __device__ __forceinline__ void done(const Unit&) const {}
    __device__ __forceinline__ void finish() const {}
};

constexpr unsigned MOE_SPIN_CAP = 1u << 22;
struct MoeMergedOrder {
    const LAS int* tbl; int G, c; gu32* cnt;
    mutable int pend;
    __device__ __forceinline__ void flush() const {
        if (pend >= 0) { asm volatile("s_waitcnt vmcnt(0)" ::: "memory");
            if ((threadIdx.x & 63) == 0) __hip_atomic_fetch_add(cnt + 16 * pend, 1u, __ATOMIC_RELAXED, __HIP_MEMORY_SCOPE_AGENT);
            pend = -1; } }
    __device__ bool next(int i, Unit& u) const {
        const int nb = __builtin_amdgcn_readfirstlane(tbl[32]);
        long L = (long)i * G + c; int nN = 8, kind = 0;
        if (L >= (long)nb * 8) { L -= (long)nb * 8; nN = 4; kind = 1; if (L >= (long)nb * 4) return false; }
        const int rb = (int)(L / nN);
        int e = 0;
#pragma unroll
        for (int k = 1; k < 32; ++k) e += (tbl[k] <= rb) ? 1 : 0;
        e = __builtin_amdgcn_readfirstlane(e); const int rbl = __builtin_amdgcn_readfirstlane(rb - tbl[e]);
        u.pm = e * (ECAP / BM) + rbl; u.pn = (int)(L % nN); u.pb = e * nN + u.pn; u.kind = kind; u.rb = rb; return true;
    }
    __device__ __forceinline__ void a_ready(const Unit& u) const {
        if (u.kind == 1) {
            flush();
            if (threadIdx.x < 64) {
                unsigned sp = 0;
                while ((unsigned)__builtin_amdgcn_readfirstlane(__hip_atomic_load(cnt + 16 * u.rb, __ATOMIC_RELAXED, __HIP_MEMORY_SCOPE_AGENT)) < 64u) { __builtin_amdgcn_s_sleep(2); if (++sp > MOE_SPIN_CAP) break; }
                __builtin_amdgcn_fence(__ATOMIC_ACQUIRE, "agent");
                asm volatile("s_waitcnt vmcnt(0)" ::: "memory");
            }
            __builtin_amdgcn_s_barrier();
        }
    }
    __device__ __forceinline__ void pre_epi() const { flush(); }
    __device__ __forceinline__ void done(const Unit& u) const { if (u.kind == 0) pend = u.rb; }
    __device__ __forceinline__ void finish() const { flush(); }
};
struct EpiMoe {
    static constexpr bool PERM = true;
    EpiSwigluT<true> up; EpiDown down;
    __device__ __forceinline__ void operator()(const f32x4 (&acc)[2][2][4][2], const Unit& u, int wr, int wc, int fr, int fq) const {
        if (u.kind == 0) up(acc, u, wr, wc, fr, fq); else down(acc, u, wr, wc, fr, fq);
    }
};
}

__device__ __forceinline__ void gmlp_unit(Frame& F, const bf16_t* Z, bf16_t* MIX, const float* Ws, const float* bs, const float* gv, int unit) {
    constexpr int VP = 272;
    LAS unsigned char* VT = F.lds + RING_OFF;
    const int h = unit & 3, chunk = unit >> 2;
    int tid_ = threadIdx.x; asm volatile("" : "+v"(tid_));
    const int t0 = chunk * 128, tid = tid_, lane = tid & 63, w = __builtin_amdgcn_readfirstlane(tid >> 6);
    {
        const int s = tid >> 2, dq = (tid & 3) * 32;
        const bf16_t* vp = Z + (size_t)(t0 + s) * EVEN_IN + 512 + h * 128 + dq;
        u32x4 raw[4]; float ss = 0.f;
#pragma unroll
        for (int i = 0; i < 4; ++i) { raw[i] = *(const u32x4*)(vp + 8 * i);
#pragma unroll
            for (int j = 0; j < 4; ++j) { const float a = bflo(raw[i][j]), b = bfhi(raw[i][j]); ss += a * a + b * b; } }
        ss += __shfl_xor(ss, 1); ss += __shfl_xor(ss, 2);
        const float rstd = 1.0f / sqrtf(ss * (1.0f / 128.0f) + EPS);
#pragma unroll
        for (int i = 0; i < 4; ++i)
#pragma unroll
            for (int j = 0; j < 4; ++j) { const int d = dq + 8 * i + 2 * j;
                *(LAS bf16_t*)(VT + (d) * VP + s * 2) = f2bf(bflo(raw[i][j]) * rstd);
                *(LAS bf16_t*)(VT + (d + 1) * VP + s * 2) = f2bf(bfhi(raw[i][j]) * rstd); }
    }
    __syncthreads();
    const int fr = lane & 15, fq = lane >> 4;
    f32x4 acc[8];
#pragma unroll
    for (int nb = 0; nb < 8; ++nb) acc[nb] = (f32x4){0.f, 0.f, 0.f, 0.f};
    const int trow = 16 * w + fr;
    const float* wrow = Ws + ((size_t)h * 128 + trow) * 128;
#pragma unroll
    for (int ks = 0; ks < 4; ++ks) {
        if (32 * ks <= 16 * w + 15) {
            const int s0 = 32 * ks + 8 * fq;
            const f32x4 wa = *(const f32x4*)(wrow + s0), wb = *(const f32x4*)(wrow + s0 + 4);
            float wv[8] = {wa[0], wa[1], wa[2], wa[3], wb[0], wb[1], wb[2], wb[3]};
#pragma unroll
            for (int j = 0; j < 8; ++j) if (s0 + j > trow) wv[j] = 0.f;
            u32x4 aw; aw.x = cvt_pk_bf16(wv[0], wv[1]); aw.y = cvt_pk_bf16(wv[2], wv[3]); aw.z = cvt_pk_bf16(wv[4], wv[5]); aw.w = cvt_pk_bf16(wv[6], wv[7]);
            const bf16x8 af = __builtin_bit_cast(bf16x8, aw);
#pragma unroll
            for (int nb = 0; nb < 8; ++nb) { const bf16x8 bfr = *(const LAS bf16x8*)(VT + (16 * nb + fr) * VP + s0 * 2);
                acc[nb] = __builtin_amdgcn_mfma_f32_16x16x32_bf16(af, bfr, acc[nb], 0, 0, 0); }
        }
    }
    LAS bf16_t* DT = (LAS bf16_t*)(F.lds + RING_OFF + 36864);
#pragma unroll
    for (int i = 0; i < 4; ++i) { const int tl = 16 * w + 4 * fq + i; const float bt = bs[h * 128 + tl];
#pragma unroll
        for (int nb = 0; nb < 8; ++nb) DT[tl * 136 + 16 * nb + fr] = f2bf(gv[h * 128 + 16 * nb + fr] * acc[nb][i] + bt); }
    __syncthreads();
#pragma unroll
    for (int k = 0; k < 4; ++k) { const int idx = tid + 512 * k, tl = idx >> 4, c8 = (idx & 15) * 8;
        const u32x4 mv = *(const LAS u32x4*)(DT + tl * 136 + c8); const u32x4 uv = *(const u32x4*)(Z + (size_t)(t0 + tl) * EVEN_IN + h * 128 + c8);
        u32x4 o; o.x = cvt_pk_bf16(bflo(uv.x) * bflo(mv.x), bfhi(uv.x) * bfhi(mv.x)); o.y = cvt_pk_bf16(bflo(uv.y) * bflo(mv.y), bfhi(uv.y) * bfhi(mv.y));
        o.z = cvt_pk_bf16(bflo(uv.z) * bflo(mv.z), bfhi(uv.z) * bfhi(mv.z)); o.w = cvt_pk_bf16(bflo(uv.w) * bflo(mv.w), bfhi(uv.w) * bfhi(mv.w));
        *(u32x4*)(MIX + (size_t)(t0 + tl) * DM + h * 128 + c8) = o; }
    __syncthreads();
}

__device__ __forceinline__ void router_phase(Frame& F, const bf16_t* x, const float* gain, const float* Wr, const float* br, gu32* cnt  ,
                                             unsigned* tok_er, float* tok_g, unsigned char* XG) {
    LAS float* part = (LAS float*)(F.lds + RING_OFF);
    LAS float* ssqp = (LAS float*)(F.lds + RING_OFF + 8 * 64 * 33 * 4);
    LAS float* lg = (LAS float*)(F.lds + SCR_OFF);
    LAS unsigned* hist = (LAS unsigned*)(F.lds + SCR_OFF + 64 * 33 * 4);
    LAS unsigned* base = hist + 32;
    LAS unsigned* ers = base + 32;
    int tid_ = threadIdx.x; asm volatile("" : "+v"(tid_));
    const int tid = tid_, lane = tid & 63, w = __builtin_amdgcn_readfirstlane(tid >> 6), r32 = lane & 31, hi = lane >> 5;
#ifndef RTR_REP_A
#define RTR_REP_A 1
#define RTR_REP_B 1
#define RTR_REP_C 1
#endif
    f32x4 gg[4];
#pragma unroll
    for (int j = 0; j < 4; ++j) gg[j] = ((const f32x4*)gain)[4 * lane + j];
    {   const int tg = F.vcu;
    const int tokb = tg * 64;
    if (tid < 32) hist[tid] = 0u;
    for (int rb_ = 0; rb_ < RTR_REP_B; ++rb_) {
        bf16x8 wh[8], wl[8];
#pragma unroll
        for (int ks = 0; ks < 8; ++ks) { float wv[8];
#pragma unroll
            for (int j = 0; j < 8; ++j) { const int k = 128 * w + 16 * ks + 8 * hi + j; wv[j] = Wr[(size_t)k * NE + r32] * gain[k]; }
            u32x4 h4, l4;
#pragma unroll
            for (int j = 0; j < 4; ++j) { const unsigned hp = cvt_pk_bf16(wv[2 * j], wv[2 * j + 1]); h4[j] = hp; l4[j] = cvt_pk_bf16(wv[2 * j] - bflo(hp), wv[2 * j + 1] - bfhi(hp)); }
            wh[ks] = __builtin_bit_cast(bf16x8, h4); wl[ks] = __builtin_bit_cast(bf16x8, l4); }
#pragma unroll
        for (int g2 = 0; g2 < 2; ++g2) {
            const bf16_t* xr = x + (size_t)(tokb + 32 * g2 + r32) * DM + 128 * w + 8 * hi;
            f32x16 d = f32x16{}; float ss = 0.f;
#pragma unroll
            for (int ks = 0; ks < 8; ++ks) { const u32x4 xw = *(const u32x4*)(xr + 16 * ks);
#pragma unroll
                for (int j = 0; j < 4; ++j) { const float a = bflo(xw[j]), b = bfhi(xw[j]); ss += a * a + b * b; }
                const bf16x8 xh = __builtin_bit_cast(bf16x8, xw);
                d = __builtin_amdgcn_mfma_f32_32x32x16_bf16(wh[ks], xh, d, 0, 0, 0);
                d = __builtin_amdgcn_mfma_f32_32x32x16_bf16(wl[ks], xh, d, 0, 0, 0); }
            { auto rr = __builtin_amdgcn_permlane32_swap(__float_as_uint(ss), __float_as_uint(ss), false, false); ss = __uint_as_float(rr[0]) + __uint_as_float(rr[1]); }
            if (hi == 0) ssqp[w * 64 + 32 * g2 + r32] = ss;
#pragma unroll
            for (int r = 0; r < 16; ++r) part[(w * 64 + 32 * g2 + r32) * 33 + (r & 3) + 8 * (r >> 2) + 4 * hi] = d[r];
        }
    }
    __syncthreads();
    {   const int t = tid >> 3, q4 = (tid & 7) * 4; float s = 0.f;
#pragma unroll
        for (int ww = 0; ww < 8; ++ww) s += ssqp[ww * 64 + t];
        const float rstd = 1.0f / sqrtf(s * (1.f / DM) + EPS);
#pragma unroll
        for (int i = 0; i < 4; ++i) { float a = 0.f;
#pragma unroll
            for (int ww = 0; ww < 8; ++ww) a += part[(ww * 64 + t) * 33 + q4 + i];
            lg[t * 33 + q4 + i] = a * rstd + br[q4 + i]; } }
    __syncthreads();
    unsigned my_e[4] = {0, 0, 0, 0}, my_lr[4] = {0, 0, 0, 0}; float my_g[4] = {0, 0, 0, 0};
    if (tid < 64) {
        float v[32];
#pragma unroll
        for (int e = 0; e < 32; ++e) v[e] = lg[tid * 33 + e];
        int c0 = -1, c1 = -1, c2 = -1; float tv[4];
#pragma unroll
        for (int r = 0; r < 4; ++r) { float best = -__builtin_inff(); int bi = 0;
#pragma unroll
            for (int e = 0; e < 32; ++e) { const bool ok = (e != c0) && (e != c1) && (e != c2); if (ok && v[e] > best) { best = v[e]; bi = e; } }
            tv[r] = best; my_e[r] = (unsigned)bi; if (r == 0) c0 = bi; else if (r == 1) c1 = bi; else if (r == 2) c2 = bi; }
        const float p1 = __expf(tv[1] - tv[0]), p2 = __expf(tv[2] - tv[0]), p3 = __expf(tv[3] - tv[0]); const float inv = 1.0f / (1.0f + p1 + p2 + p3);
        my_g[0] = inv; my_g[1] = p1 * inv; my_g[2] = p2 * inv; my_g[3] = p3 * inv;
#pragma unroll
        for (int r = 0; r < 4; ++r) my_lr[r] = __hip_atomic_fetch_add(hist + my_e[r], 1u, __ATOMIC_RELAXED, __HIP_MEMORY_SCOPE_WORKGROUP);
    }
    __syncthreads();
    if (tid < 32) { const unsigned hc = hist[tid]; base[tid] = hc ? __hip_atomic_fetch_add(cnt + 64 * tid, hc, RLX_AGENT) : 0u; }
    __syncthreads();
    if (tid < 64) {
        u32x4 er; f32x4 gt;
#pragma unroll
        for (int r = 0; r < 4; ++r) { const unsigned rank = base[my_e[r]] + my_lr[r]; er[r] = (my_e[r] << 16) | rank; gt[r] = my_g[r]; ers[tid * 4 + r] = er[r]; }
        *(u32x4*)(tok_er + (size_t)(tokb + tid) * 4) = er; *(f32x4*)(tok_g + (size_t)(tokb + tid) * 4) = gt;
    }
    __syncthreads();
    for (int rc_ = 0; rc_ < RTR_REP_C; ++rc_)
#pragma unroll 2
    for (int tt = 0; tt < 8; ++tt) {
        const int tl = w * 8 + tt; const bf16_t* xrow = x + (size_t)(tokb + tl) * DM;
        f32x4 hv[4]; float s = 0.f;
        {   const u32x4 t0 = ((const u32x4*)xrow)[2 * lane], t1 = ((const u32x4*)xrow)[2 * lane + 1];
            hv[0] = (f32x4){bflo(t0.x), bfhi(t0.x), bflo(t0.y), bfhi(t0.y)}; hv[1] = (f32x4){bflo(t0.z), bfhi(t0.z), bflo(t0.w), bfhi(t0.w)};
            hv[2] = (f32x4){bflo(t1.x), bfhi(t1.x), bflo(t1.y), bfhi(t1.y)}; hv[3] = (f32x4){bflo(t1.z), bfhi(t1.z), bflo(t1.w), bfhi(t1.w)}; }
#pragma unroll
        for (int j = 0; j < 4; ++j) s += (hv[j].x * hv[j].x + hv[j].y * hv[j].y) + (hv[j].z * hv[j].z + hv[j].w * hv[j].w);
        const float rstd = 1.0f / sqrtf(wave_sum(s) * (1.f / DM) + EPS);
        u32x4 wv;
#pragma unroll
        for (int j = 0; j < 4; ++j) { const f32x4 t = hv[j] * rstd * gg[j]; wv[j] = pk4_fp8(t.x, t.y, t.z, t.w); }
#pragma unroll
        for (int r = 0; r < 4; ++r) { const unsigned er = ers[tl * 4 + r]; const size_t slot = (size_t)(er >> 16) * ECAP + (er & 0xffffu);
            ((u32x4*)(XG + slot * DM))[lane] = wv; }
    }
    __syncthreads();
    }
}

__device__ __forceinline__ void combine_phase(Frame& F, bf16_t* x, float* out32  , const unsigned* tok_er, const float* tok_g, const bf16_t* Y, const float* g_next, unsigned char* XN, bool xn_fp8) {
    int tid_ = threadIdx.x; asm volatile("" : "+v"(tid_));
    const int gw = F.vcu * NWAVES + __builtin_amdgcn_readfirstlane(tid_ >> 6), NGW = F.G * NWAVES, lane = tid_ & 63;
    u32x4 erA, erB, erAn, erBn; f32x4 gtA, gtB, gtAn, gtBn;
    { const int ma = gw < M ? gw : 0, mb0 = gw + NGW < M ? gw + NGW : ma;
      erAn = *(const u32x4*)(tok_er + (size_t)ma * 4); erBn = *(const u32x4*)(tok_er + (size_t)mb0 * 4); gtAn = *(const f32x4*)(tok_g + (size_t)ma * 4); gtBn = *(const f32x4*)(tok_g + (size_t)mb0 * 4); }
    for (int m0 = gw; m0 < M; m0 += 2 * NGW) {
        const int m1 = m0 + NGW; const bool two = m1 < M; const int mb = two ? m1 : m0;
        erA = erAn; erB = erBn; gtA = gtAn; gtB = gtBn;
        { const int na = m0 + 2 * NGW < M ? m0 + 2 * NGW : m0, nb2 = m0 + 3 * NGW < M ? m0 + 3 * NGW : na;
          erAn = *(const u32x4*)(tok_er + (size_t)na * 4); erBn = *(const u32x4*)(tok_er + (size_t)nb2 * 4); gtAn = *(const f32x4*)(tok_g + (size_t)na * 4); gtBn = *(const f32x4*)(tok_g + (size_t)nb2 * 4); }
        bf16_t* xrA = x + (size_t)m0 * DM; bf16_t* xrB = x + (size_t)mb * DM;
        u32x4 xa[2], xb[2]; u32x2 ya[4][2], yb[4][2];
#pragma unroll
        for (int j = 0; j < 2; ++j) { xa[j] = ((const u32x4*)xrA)[64 * j + lane]; xb[j] = ((const u32x4*)xrB)[64 * j + lane]; }
#pragma unroll
        for (int r = 0; r < 4; ++r) { const size_t sA = (size_t)(erA[r] >> 16) * ECAP + (erA[r] & 0xffffu), sB = (size_t)(erB[r] >> 16) * ECAP + (erB[r] & 0xffffu);
#pragma unroll
            for (int j = 0; j < 2; ++j) { ya[r][j] = ((const u32x2*)((const unsigned char*)Y + sA * DM))[64 * j + lane]; yb[r][j] = ((const u32x2*)((const unsigned char*)Y + sB * DM))[64 * j + lane]; } }
#pragma unroll
        for (int t = 0; t < 2; ++t) {
            if (t == 1 && !two) break;
            const int m = t ? m1 : m0; bf16_t* xrow = t ? xrB : xrA; const f32x4 gt = t ? gtB : gtA;
            float v[16];
#pragma unroll
            for (int j = 0; j < 2; ++j) { const u32x4 q = t ? xb[j] : xa[j];
#pragma unroll
                for (int i = 0; i < 4; ++i) { v[8 * j + 2 * i] = bflo(q[i]); v[8 * j + 2 * i + 1] = bfhi(q[i]); } }
#pragma unroll
            for (int r = 0; r < 4; ++r) { const float g = gt[r] * Y8_INV;
#pragma unroll
                for (int j = 0; j < 2; ++j) { const u32x2 yv = t ? yb[r][j] : ya[r][j];
#pragma unroll
                    for (int i = 0; i < 2; ++i) { const auto lo2 = __builtin_amdgcn_cvt_pk_f32_fp8((int)yv[i], false), hi2 = __builtin_amdgcn_cvt_pk_f32_fp8((int)yv[i], true);
                        v[8 * j + 4 * i] += g * lo2[0]; v[8 * j + 4 * i + 1] += g * lo2[1]; v[8 * j + 4 * i + 2] += g * hi2[0]; v[8 * j + 4 * i + 3] += g * hi2[1]; } } }
            if (out32) {
#pragma unroll
                for (int j = 0; j < 2; ++j)
#pragma unroll
                    for (int h = 0; h < 2; ++h) ((f32x4*)(out32 + (size_t)m * DM))[128 * j + 2 * lane + h] = (f32x4){v[8 * j + 4 * h], v[8 * j + 4 * h + 1], v[8 * j + 4 * h + 2], v[8 * j + 4 * h + 3]};
            } else {
#pragma unroll
                for (int j = 0; j < 2; ++j) { u32x4 q;
#pragma unroll
                    for (int i = 0; i < 4; ++i) q[i] = cvt_pk_bf16(v[8 * j + 2 * i], v[8 * j + 2 * i + 1]);
                    ((u32x4*)xrow)[64 * j + lane] = q; } }
            if (g_next) {
                float s = 0.f;
#pragma unroll
                for (int i = 0; i < 16; ++i) s += v[i] * v[i];
                const float rstd = 1.0f / sqrtf(wave_sum(s) * (1.f / DM) + EPS);
                float w[16];
#pragma unroll
                for (int j = 0; j < 2; ++j)
#pragma unroll
                    for (int h = 0; h < 2; ++h) { const f32x4 gg = ((const f32x4*)g_next)[128 * j + 2 * lane + h];
#pragma unroll
                        for (int i = 0; i < 4; ++i) w[8 * j + 4 * h + i] = v[8 * j + 4 * h + i] * rstd * gg[i]; }
                if (xn_fp8) {
#pragma unroll
                    for (int j = 0; j < 2; ++j) { u32x2 q; q.x = pk4_fp8(w[8 * j], w[8 * j + 1], w[8 * j + 2], w[8 * j + 3]); q.y = pk4_fp8(w[8 * j + 4], w[8 * j + 5], w[8 * j + 6], w[8 * j + 7]);
                        ((u32x2*)(XN + (size_t)m * DM))[64 * j + lane] = q; }
                } else {
#pragma unroll
                    for (int j = 0; j < 2; ++j) { u32x4 q;
#pragma unroll
                        for (int i = 0; i < 4; ++i) q[i] = cvt_pk_bf16(w[8 * j + 2 * i], w[8 * j + 2 * i + 1]);
                        ((u32x4*)(XN + (size_t)m * DM * 2))[64 * j + lane] = q; } }
            }
        }
    }
}

__device__ __forceinline__ void unpack8f8(const u32x2 w, float (&f)[8]) { const f32x2 a = __builtin_amdgcn_cvt_pk_f32_fp8((int)w.x, false), b = __builtin_amdgcn_cvt_pk_f32_fp8((int)w.x, true),
    c = __builtin_amdgcn_cvt_pk_f32_fp8((int)w.y, false), d = __builtin_amdgcn_cvt_pk_f32_fp8((int)w.y, true); f[0] = a.x; f[1] = a.y; f[2] = b.x; f[3] = b.y; f[4] = c.x; f[5] = c.y; f[6] = d.x; f[7] = d.y; }
__device__ __forceinline__ void unpack4f8(const unsigned w, float (&f)[4]) { const f32x2 a = __builtin_amdgcn_cvt_pk_f32_fp8((int)w, false), b = __builtin_amdgcn_cvt_pk_f32_fp8((int)w, true); f[0] = a.x; f[1] = a.y; f[2] = b.x; f[3] = b.y; }
__device__ __forceinline__ void unpack8(const u32x4 w, float (&f)[8]) { f[0] = bflo(w.x); f[1] = bfhi(w.x); f[2] = bflo(w.y); f[3] = bfhi(w.y); f[4] = bflo(w.z); f[5] = bfhi(w.z); f[6] = bflo(w.w); f[7] = bfhi(w.w); }
__device__ __forceinline__ void unpack4(const u32x2 w, float (&f)[4]) { f[0] = bflo(w.x); f[1] = bfhi(w.x); f[2] = bflo(w.y); f[3] = bfhi(w.y); }
__device__ __forceinline__ void fin_head(const float (&a)[8], const float (&b)[8], const float (&x1)[4], const float (&x2)[4], const float (&g)[24], const float (&cs)[4], const float (&sn)[4], unsigned char* op, int j, float scale) {
    float ss = 0.f;
#pragma unroll
    for (int i = 0; i < 8; ++i) ss += a[i] * a[i] + b[i] * b[i];
#pragma unroll
    for (int i = 0; i < 4; ++i) ss += x1[i] * x1[i] + x2[i] * x2[i];
    ss += __shfl_xor(ss, 1); ss += __shfl_xor(ss, 2); ss += __shfl_xor(ss, 4);
    const float rstd = scale / sqrtf(ss * (1.0f / 192.0f) + EPS);
    u32x4 o0;
    o0.x = pk4_fp8(a[0] * rstd * g[0], a[1] * rstd * g[1], a[2] * rstd * g[2], a[3] * rstd * g[3]); o0.y = pk4_fp8(a[4] * rstd * g[4], a[5] * rstd * g[5], a[6] * rstd * g[6], a[7] * rstd * g[7]);
    o0.z = pk4_fp8(b[0] * rstd * g[8], b[1] * rstd * g[9], b[2] * rstd * g[10], b[3] * rstd * g[11]); o0.w = pk4_fp8(b[4] * rstd * g[12], b[5] * rstd * g[13], b[6] * rstd * g[14], b[7] * rstd * g[15]);
    float y1[4], y2[4];
#pragma unroll
    for (int i = 0; i < 4; ++i) { const float u = x1[i] * rstd * g[16 + i], v = x2[i] * rstd * g[20 + i]; y1[i] = u * cs[i] - v * sn[i]; y2[i] = u * sn[i] + v * cs[i]; }
    *(u32x4*)(op + 16 * j) = o0; *(unsigned*)(op + 128 + 4 * j) = pk4_fp8(y1[0], y1[1], y1[2], y1[3]); *(unsigned*)(op + 160 + 4 * j) = pk4_fp8(y2[0], y2[1], y2[2], y2[3]);
}
__device__ __forceinline__ void mla_finalize_phase(Frame& F, const unsigned char* QR, const unsigned char* KVR, const bf16_t* Z, const float* gq, const float* gk, unsigned char* QF, unsigned char* KF) {
    int tid_ = threadIdx.x; asm volatile("" : "+v"(tid_));
    const int gw = F.vcu * NWAVES + __builtin_amdgcn_readfirstlane(tid_ >> 6), NGW = F.G * NWAVES, lane = tid_ & 63;
    const int h = lane >> 3, j = lane & 7;
    float gqv[24], gkv[24], invf[4];
#pragma unroll
    for (int i = 0; i < 16; ++i) { gqv[i] = gq[16 * j + i]; gkv[i] = gk[16 * j + i]; }
#pragma unroll
    for (int i = 0; i < 4; ++i) { gqv[16 + i] = gq[128 + 4 * j + i]; gqv[20 + i] = gq[160 + 4 * j + i]; gkv[16 + i] = gk[128 + 4 * j + i]; gkv[20 + i] = gk[160 + 4 * j + i];
        invf[i] = __builtin_amdgcn_exp2f(-(float)(4 * j + i) * (13.287712379549449f / 32.0f)); }
#pragma unroll 2
    for (int m = gw; m < M; m += NGW) {
        const int pos = m & (SEQ - 1);
        float cs[4], sn[4];
#pragma unroll
        for (int i = 0; i < 4; ++i) { const double rev = (double)pos * (double)invf[i] * 0.15915494309189535; const float fr = (float)(rev - __builtin_rint(rev));
            sn[i] = __builtin_amdgcn_sinf(fr); cs[i] = __builtin_amdgcn_cosf(fr); }
        const unsigned char* qp = QR + (size_t)m * 1536 + h * 192; const unsigned char* kp = KVR + (size_t)m * 2048 + h * 256; const bf16_t* zp = Z + (size_t)m * ODD_INP + 768;
        const u32x4 qn = *(const u32x4*)(qp + 16 * j); const unsigned qr1 = *(const unsigned*)(qp + 128 + 4 * j), qr2 = *(const unsigned*)(qp + 160 + 4 * j);
        const u32x4 kn = *(const u32x4*)(kp + 16 * j); const u32x2 kr1 = *(const u32x2*)(zp + 4 * j), kr2 = *(const u32x2*)(zp + 32 + 4 * j);
        float a[8], b[8], x1[4], x2[4];
        unpack8f8((u32x2){qn.x, qn.y}, a); unpack8f8((u32x2){qn.z, qn.w}, b); unpack4f8(qr1, x1); unpack4f8(qr2, x2);
        fin_head(a, b, x1, x2, gqv, cs, sn, QF + (size_t)m * 1536 + h * 192, j, 8.0f * C2_C);
        unpack8f8((u32x2){kn.x, kn.y}, a); unpack8f8((u32x2){kn.z, kn.w}, b); unpack4(kr1, x1); unpack4(kr2, x2);
        fin_head(a, b, x1, x2, gkv, cs, sn, KF + (size_t)m * 1536 + h * 192, j, 1.0f);
    }
}

__device__ __forceinline__ void vt_phase(Frame& F, const unsigned char* KVR, unsigned char* VT8) {
    int tid_ = threadIdx.x; asm volatile("" : "+v"(tid_));
    const int tid = tid_;
    LAS unsigned char* T = F.lds + RING_OFF;
    for (int it = F.vcu; it < M / 64; it += F.G) {
        const int m0 = it * 64, b = m0 / SEQ, tok0 = m0 % SEQ;
#pragma unroll 4
        for (int k = 0; k < 8; ++k) { const int idx = tid + 512 * k, tok = idx >> 6, grp = idx & 63, h = grp >> 3, d16 = (grp & 7) * 16;
            const u32x4 w = *(const u32x4*)(KVR + (size_t)(m0 + tok) * 2048 + h * 256 + 128 + d16);
            LAS unsigned char* tp = T + (h * 128 + d16) * 80 + tok;
#pragma unroll
            for (int i = 0; i < 4; ++i) { const unsigned x = w[i]; tp[(4 * i) * 80] = (unsigned char)x; tp[(4 * i + 1) * 80] = (unsigned char)(x >> 8); tp[(4 * i + 2) * 80] = (unsigned char)(x >> 16); tp[(4 * i + 3) * 80] = (unsigned char)(x >> 24); } }
        __syncthreads();
#pragma unroll 4
        for (int k = 0; k < 8; ++k) { const int idx = tid + 512 * k, row = idx >> 2, q = idx & 3;
            const u32x4 v = *(const LAS u32x4*)(T + row * 80 + 16 * q);
            *(u32x4*)(VT8 + ((size_t)b * 1024 + row) * SEQ + tok0 + 16 * q) = v; }
        __syncthreads();
    }
}

#ifndef PHMASK
#define PHMASK 0xFFFF
#endif
#ifndef REPMASK
#define REPMASK 0
#endif
#ifndef REPCNT
#define REPCNT 3
#endif
#define NREP(k) ((((REPMASK) >> (k)) & 1) ? (REPCNT) : 1)

#define LAUNDER_S(x) asm volatile("" : "+s"(x))
__device__ __forceinline__ const float* in_ptr(const Args& a, int i) { LAUNDER_S(i); return a.in[i]; }
#define PHASE_BEGIN() unsigned wso_ = 0u; LAUNDER_S(wso_); unsigned char* ws = args.ws + wso_; Frame Fp = F; Fp.vcu = __builtin_amdgcn_readfirstlane(Fp.vcu); Fp.G = __builtin_amdgcn_readfirstlane(Fp.G); LAUNDER_S(Fp.vcu); LAUNDER_S(Fp.G); \
    int bx_ = __builtin_amdgcn_readfirstlane((int)blockIdx.x); LAUNDER_S(bx_); (void)bx_; (void)ws
#define XN  ((unsigned char*)(ws + WS_XN))
#define Z   ((bf16_t*)(ws + WS_Z))
#define MIX ((bf16_t*)(ws + WS_MIX))
#define QR  ((unsigned char*)(ws + WS_QR))
#define KVR ((unsigned char*)(ws + WS_KVR))
#define QF  ((unsigned char*)(ws + WS_QF))
#define KF  ((unsigned char*)(ws + WS_KF))
#define XG  ((unsigned char*)(ws + WS_XG))
#define ACT ((unsigned char*)(ws + WS_ACT))
#define YB  ((bf16_t*)(ws + WS_Y))
#define SSQ ((float*)(ws + WS_SSQ))
#define TOKER ((unsigned*)(ws + WS_TOKER))
#define TOKG ((float*)(ws + WS_TOKG))
#define B1P ((float*)(ws + WS_B1P))
#define IN(i) in_ptr(args, (i))
__global__ void __launch_bounds__(NWAVES * 64, 2) trunk_fwd(Args args) {
    extern __shared__ __attribute__((aligned(16))) unsigned char lds_raw[];
    Frame F;
    F.lds = (LAS unsigned char*)lds_raw;
    F.G = gridDim.x; { const int bx = blockIdx.x; F.vcu = (F.G % 8 == 0) ? (bx % 8) * (F.G / 8) + bx / 8 : bx; }
    for (int u = threadIdx.x; u < (SCR_OFF - LDSCTL_OFF) / 4; u += NWAVES * 64) ((LAS unsigned*)(F.lds + LDSCTL_OFF))[u] = 0u;
    __syncthreads();
    (void)xcd_barrier_post((unsigned*)((gu32*)(args.ws + WS_CTL) + CW_BAR), (volatile LAS unsigned*)(F.lds + MISC_OFF) + 8);
#define GRID_BAR() do { unsigned wsb_ = 0u; LAUNDER_S(wsb_); XcdBarrier bar_; bar_.bar = (unsigned*)((gu32*)(args.ws + wsb_ + WS_CTL) + CW_BAR); bar_.x = xb_xcc_id(); \
        bar_.st = (volatile LAS unsigned*)(F.lds + MISC_OFF) + 8; xcd_barrier(bar_); } while (0)
#define X16 ((bf16_t*)(ws + WS_X16))
    const int stage_limit = args.stage_limit;

#if (PHMASK >> 0) & 1
            _Pragma("unroll") for (int rep_ = 0; rep_ < NREP(0); ++rep_) { if (rep_) GRID_BAR();
    {   PHASE_BEGIN(); const int ptid = threadIdx.x, gw = Fp.vcu * NWAVES + __builtin_amdgcn_readfirstlane(ptid >> 6), NGW = Fp.G * NWAVES;
        transpose_job<1>(Fp, IN(I_EWIN), DM, EVEN_IN, 2, (size_t)DM * EVEN_IN, (bf16_t*)(ws + WS_WEIN), (size_t)EVEN_IN * DM, nullptr, 0);
        transpose_job<0>(Fp, IN(I_EWOUT), DM, DM, 2, (size_t)DM * DM, (bf16_t*)(ws + WS_WEOUT), (size_t)DM * DM, nullptr, 0);
        transpose_job_fp8<0>(Fp, IN(I_OWIN), DM, ODD_IN, 2, (size_t)DM * ODD_IN, ws + WS_WOIN, (size_t)ODD_INP * DM);
        transpose_job_fp8<0>(Fp, IN(I_OWUQ), 512, 1536, 2, (size_t)512 * 1536, ws + WS_WUQ, (size_t)1536 * 512, IN(I_OGCQ), 512);
        transpose_job_fp8<0>(Fp, IN(I_OWUKV), 256, 2048, 2, (size_t)256 * 2048, ws + WS_WUKV, (size_t)2048 * 256, IN(I_OGCKV), 256);
        transpose_job_fp8<0>(Fp, IN(I_OWOUT), DM, DM, 2, (size_t)DM * DM, ws + WS_WOOUT, (size_t)DM * DM);
        transpose_job_fp8<2>(Fp, IN(I_W1), DM, 2 * DE, DEPTH * NE, (size_t)DM * 2 * DE, ws + WS_W1, (size_t)2 * DE * DM);
        transpose_job_fp8<0>(Fp, IN(I_W2), DE, DM, DEPTH * NE, (size_t)DE * DM, ws + WS_W2, (size_t)DM * DE);
        for (int i = bx_ * 512 + ptid; i < 2 * 12288; i += Fp.G * 512) { const int mi = i / 12288, r = i % 12288;
            *(u32x4*)(ws + WS_WOIN + (size_t)mi * ODD_INP * DM + (size_t)ODD_IN * DM + (size_t)r * 16) = (u32x4){0u, 0u, 0u, 0u}; }
        for (int i = bx_ * 512 + ptid; i < DEPTH * NE * 2048; i += Fp.G * 512) { const int c = i & 2047, o = 2 * (128 * (c >> 8) + (c & 127)) + ((c >> 7) & 1);
            B1P[i] = IN(I_B1)[(size_t)(i & ~2047) + o]; }
        for (int m = gw; m < M; m += NGW) rms_row_to_bf16(ptid & 63, IN(I_X) + (size_t)m * DM, IN(I_MIXN), (bf16_t*)XN + (size_t)m * DM, nullptr);
    }
            }
#endif
    GRID_BAR();

#ifdef EXTRA_BARS
    for (int xb_ = 0; xb_ < EXTRA_BARS; ++xb_) GRID_BAR();
#endif
    for (int l = 0; l < DEPTH; ++l) {
        const int li = l >> 1;
        if (2 * l + 1 > stage_limit) break;
        if ((l & 1) == 0) {
#if (PHMASK >> 1) & 1
            _Pragma("unroll") for (int rep_ = 0; rep_ < NREP(1); ++rep_) { if (rep_) GRID_BAR();
            {   PHASE_BEGIN(); pg8::Gemm g{(const bf16_t*)XN, (const bf16_t*)(ws + WS_WEIN) + (size_t)li * EVEN_IN * DM, DM, DM, nullptr, nullptr}; pg8::StaticOrder S; S.init(M, EVEN_IN, Fp.G, bx_);
                pg8::EpiEvenIn E{Z, IN(I_EGQ) + li * 64, IN(I_EGK) + li * 64};
                pg8::gemm_phase<pg8::EpiEvenIn, pg8::StaticOrder>(Fp.lds + RING_OFF, g, S, E); }
            }
#endif
            GRID_BAR();
            {   PHASE_BEGIN();
#if (PHMASK >> 2) & 1
            _Pragma("unroll") for (int rep_ = 0; rep_ < NREP(2); ++rep_) { if (rep_) GRID_BAR();
                for (int u = Fp.vcu; u < 512; u += Fp.G)
                    gmlp_unit(Fp, Z, MIX, IN(I_EWS) + (size_t)li * 4 * 128 * 128, IN(I_EBS) + li * 512, IN(I_EGV) + li * 512, u);
            }
#endif
#if (PHMASK >> 3) & 1
            _Pragma("unroll") for (int rep_ = 0; rep_ < NREP(3); ++rep_) { if (rep_) GRID_BAR();
                for (int u = Fp.vcu; u < 256; u += Fp.G) { const int bh = u >> 4, s = u & 15, b = bh >> 3, h = bh & 7;
                    for (int pass = 0; pass < 2; ++pass) { const int qb = pass ? 31 - s : s;
                        const bf16_t* zb = Z + (size_t)b * SEQ * EVEN_IN;
                        dil::unit(zb + 1024 + 64 * h, zb + 1536 + 64 * h, zb + 2048 + 64 * h, EVEN_IN, MIX + (size_t)b * SEQ * DM + 512 + 64 * h, DM, qb * 256, Fp.lds + RING_OFF, (LAS float*)(Fp.lds + SCR_OFF)); } }
            }
#endif
            }
            GRID_BAR();
#if (PHMASK >> 4) & 1
            _Pragma("unroll") for (int rep_ = 0; rep_ < NREP(4); ++rep_) { if (rep_) GRID_BAR();
            {   PHASE_BEGIN(); pg8::Gemm g{MIX, (const bf16_t*)(ws + WS_WEOUT) + (size_t)li * DM * DM, DM, DM, nullptr, nullptr}; pg8::StaticOrder S; S.init(M, DM, Fp.G, bx_);
                pg8::EpiResid E{l == 0 ? IN(I_X) : nullptr, X16};
                pg8::gemm_phase<pg8::EpiResid, pg8::StaticOrder>(Fp.lds + RING_OFF, g, S, E); }
            }
#endif
            GRID_BAR();
        } else {
#if (PHMASK >> 5) & 1
            _Pragma("unroll") for (int rep_ = 0; rep_ < NREP(5); ++rep_) { if (rep_) GRID_BAR();
            {   PHASE_BEGIN(); pg8::Gemm g{(const bf16_t*)XN, (const bf16_t*)(ws + WS_WOIN + (size_t)li * ODD_INP * DM), DM / 2, DM / 2, nullptr, nullptr}; pg8::StaticOrder S; S.init(M, ODD_INP, Fp.G, bx_);
                pg8::EpiOddIn E{Z, ws + WS_Z8, SSQ};
                pg8::gemm_phase<pg8::EpiOddIn, pg8::StaticOrder, true>(Fp.lds + RING_OFF, g, S, E); }
            }
#endif
            GRID_BAR();
#if (PHMASK >> 6) & 1
            _Pragma("unroll") for (int rep_ = 0; rep_ < NREP(6); ++rep_) { if (rep_) GRID_BAR();
            {   PHASE_BEGIN(); pg8::Gemm g{(const bf16_t*)(ws + WS_Z8 + 512), (const bf16_t*)(ws + WS_WUKV + (size_t)li * 2048 * 256), ODD_INP / 2, 128, nullptr, nullptr}; pg8::StaticOrder S; S.init(M, 2048, Fp.G, bx_);
                pg8::EpiRowScale<1> E{KVR, 2048, SSQ, 8, 1.0f / 256.0f};
                pg8::gemm_phase<pg8::EpiRowScale<1>, pg8::StaticOrder, true>(Fp.lds + RING_OFF, g, S, E); }
            {   PHASE_BEGIN(); pg8::Gemm g{(const bf16_t*)(ws + WS_Z8), (const bf16_t*)(ws + WS_WUQ + (size_t)li * 1536 * 512), ODD_INP / 2, 256, nullptr, nullptr}; pg8::StaticOrder S; S.init(M, 1536, Fp.G, bx_);
                pg8::EpiRowScale<2> E{QR, 1536, SSQ, 0, 1.0f / 512.0f};
                pg8::gemm_phase<pg8::EpiRowScale<2>, pg8::StaticOrder, true>(Fp.lds + RING_OFF, g, S, E); }
            }
#endif
            GRID_BAR();
#if (PHMASK >> 7) & 1
            _Pragma("unroll") for (int rep_ = 0; rep_ < NREP(7); ++rep_) { if (rep_) GRID_BAR();
            {   PHASE_BEGIN(); mla_finalize_phase(Fp, QR, KVR, Z, IN(I_OGQ) + li * 192, IN(I_OGK) + li * 192, QF, KF); vt_phase(Fp, KVR, ws + WS_VT); }
            }
#endif
            GRID_BAR();
#if (PHMASK >> 8) & 1
            _Pragma("unroll") for (int rep_ = 0; rep_ < NREP(8); ++rep_) { if (rep_) GRID_BAR();
            {   PHASE_BEGIN();
                for (int u = Fp.vcu; u < 256; u += Fp.G) { const int bh = u >> 4, s = u & 15, b = bh >> 3, h = bh & 7;
                    for (int pass = 0; pass < 2; ++pass) { const int qb = pass ? 31 - s : s;
                        mla::unit(QF + (size_t)b * SEQ * 1536 + 192 * h, KF + (size_t)b * SEQ * 1536 + 192 * h, 1536, ws + WS_VT + ((size_t)(b * 8 + h) * 128) * SEQ,
                                  ws + WS_MIX8 + (size_t)b * SEQ * DM + 128 * h, DM, qb * 256, Fp.lds + RING_OFF); } }
            }
            }
#endif
            GRID_BAR();
#if (PHMASK >> 9) & 1
            _Pragma("unroll") for (int rep_ = 0; rep_ < NREP(9); ++rep_) { if (rep_) GRID_BAR();
            {   PHASE_BEGIN(); pg8::Gemm g{(const bf16_t*)(ws + WS_MIX8), (const bf16_t*)(ws + WS_WOOUT + (size_t)li * DM * DM), DM / 2, DM / 2, nullptr, nullptr}; pg8::StaticOrder S; S.init(M, DM, Fp.G, bx_);
                pg8::EpiResidT<true> E{nullptr, X16};
                pg8::gemm_phase<pg8::EpiResidT<true>, pg8::StaticOrder, true>(Fp.lds + RING_OFF, g, S, E); }
            }
#endif
            GRID_BAR();
        }
        if (2 * l + 2 > stage_limit) break;
#if (PHMASK >> 10) & 1
            _Pragma("unroll") for (int rep_ = 0; rep_ < NREP(10); ++rep_) {
        {   PHASE_BEGIN(); const bool dry = rep_ + 1 < NREP(10);
            gu32* cnt = (gu32*)(ws + WS_CTL) + CW_CNT + (size_t)(dry ? 8 + 4 * rep_ + l : l) * 32 * 64;
        router_phase(Fp, X16, IN(I_FFNN) + l * DM, IN(I_RW) + (size_t)l * DM * NE, IN(I_RB) + l * NE, cnt, dry ? (unsigned*)(ws + WS_QR) : TOKER, dry ? (float*)(ws + WS_QR + MiB) : TOKG, dry ? ACT : XG); }
        GRID_BAR();
            }
#endif
        LAS int* tbl = (LAS int*)(F.lds + SCR_OFF + 12288);
        {   PHASE_BEGIN(); gu32* cnt = (gu32*)(ws + WS_CTL) + CW_CNT + (size_t)l * 32 * 64;
        if (threadIdx.x == 0) { int acc = 0; for (int e = 0; e < NE; ++e) { tbl[e] = acc; const unsigned c = __hip_atomic_load(cnt + 64 * e, RLX_AGENT); acc += (int)((c + 255u) >> 8); } tbl[NE] = acc; }
        __syncthreads(); }
#if (PHMASK >> 11) & 1
            _Pragma("unroll") for (int rep_ = 0; rep_ < NREP(11); ++rep_) { if (rep_) GRID_BAR();
        {   PHASE_BEGIN();
            pg8::Gemm g{(const bf16_t*)XG, (const bf16_t*)(ws + WS_W1 + (size_t)l * NE * 2 * DE * DM), DM / 2, DM / 2, (const bf16_t*)ACT, (const bf16_t*)(ws + WS_W2 + (size_t)l * NE * DM * DE)};
            pg8::MoeMergedOrder S{tbl, Fp.G, Fp.vcu, (gu32*)(ws + WS_CTL) + CW_MOE + (size_t)(l * 320 + 1280 * rep_) * 16, -1};
            pg8::EpiMoe E{{ACT, B1P + (size_t)l * NE * 2048}, {YB, IN(I_B2) + (size_t)l * NE * DM}};
            pg8::gemm_phase<pg8::EpiMoe, pg8::MoeMergedOrder, true>(Fp.lds + RING_OFF, g, S, E); }
            }
#endif
        GRID_BAR();
#if (PHMASK >> 13) & 1
            _Pragma("unroll") for (int rep_ = 0; rep_ < NREP(13); ++rep_) {
        {   PHASE_BEGIN(); const bool dry = rep_ + 1 < NREP(13);
            combine_phase(Fp, dry ? (bf16_t*)(ACT + (size_t)128 * MiB) : X16, (!dry && l + 1 == DEPTH) ? args.out : nullptr, TOKER, TOKG, YB, (l + 1 < DEPTH) ? IN(I_MIXN) + (l + 1) * DM : nullptr, dry ? (ACT + (size_t)64 * MiB) : XN, (l & 1) == 0); }
        GRID_BAR();
            }
#endif
    }
#undef GRID_BAR
}

extern "C" void kernel_launch(void* const* d_in, const int* in_sizes, int n_in, void* d_out, int out_size, void* d_ws, size_t ws_size, hipStream_t stream) {
    static int grid = 0;
    if (grid == 0) {
        if (n_in != 24 || in_sizes[0] != M * DM || out_size != M * DM || ws_size < WS_END) {
            fprintf(stderr, "kernel_launch: unexpected shapes (n_in %d, in0 %d, out %d, ws %zu, need %zu)\n", n_in, n_in > 0 ? in_sizes[0] : -1, out_size, ws_size, (size_t)WS_END); grid = -1; return; }
        int dev = 0, cus = 0, per_cu = 0;
        if (hipGetDevice(&dev) != hipSuccess || hipDeviceGetAttribute(&cus, hipDeviceAttributeMultiprocessorCount, dev) != hipSuccess) { grid = -1; return; }
        if (hipFuncSetAttribute((const void*)trunk_fwd, hipFuncAttributeMaxDynamicSharedMemorySize, LDS_BYTES) != hipSuccess) { fprintf(stderr, "kernel_launch: hipFuncSetAttribute failed\n"); grid = -1; return; }
        if (hipOccupancyMaxActiveBlocksPerMultiprocessor(&per_cu, (const void*)trunk_fwd, NWAVES * 64, LDS_BYTES) != hipSuccess || per_cu < 1)
            fprintf(stderr, "kernel_launch: occupancy query reports %d workgroups per CU\n", per_cu);
        (void)hipGetLastError();
        if (cus < 256) { fprintf(stderr, "kernel_launch: needs 256 CUs, device has %d\n", cus); grid = -1; return; }
        grid = 256;
    }
    if (grid < 0) return;
    if (hipMemsetAsync((char*)d_ws + WS_CTL, 0, CTL_ZERO_BYTES, stream) != hipSuccess) return;
    Args a{};
    for (int i = 0; i < 24; ++i) a.in[i] = (const float*)d_in[i];
    a.out = (float*)d_out; a.ws = (unsigned char*)d_ws; a.stage_limit = STAGE_LIMIT; a.pad = 0;
    hipLaunchKernelGGL(trunk_fwd, dim3(grid), dim3(NWAVES * 64), LDS_BYTES, stream, a);
}
```

```cpp
#include <hip/hip_runtime.h>
#include <hip/hip_bf16.h>
#include <cstdio>
#include <cstdint>

#define LAS __attribute__((address_space(3)))
#define GAS __attribute__((address_space(1)))
typedef unsigned short bf16_t;
typedef short bf16x8 __attribute__((ext_vector_type(8)));
typedef short s16x4 __attribute__((ext_vector_type(4)));
typedef float f32x2 __attribute__((ext_vector_type(2)));
typedef float f32x4 __attribute__((ext_vector_type(4)));
typedef float f32x16 __attribute__((ext_vector_type(16)));
typedef unsigned u32x2 __attribute__((ext_vector_type(2)));
typedef unsigned u32x4 __attribute__((ext_vector_type(4)));
typedef int i32x4 __attribute__((ext_vector_type(4)));
typedef int i32x8 __attribute__((ext_vector_type(8)));

constexpr int BATCH = 2, SEQ = 8192, DM = 1024, M = BATCH * SEQ, DEPTH = 4;
constexpr int EVEN_IN = 2560, ODD_IN = 832, ODD_INP = 1024;
constexpr int NE = 32, DE = 1024, ECAP = 16384;
constexpr float EPS = 1e-6f;
constexpr float LOG2E = 1.4426950408889634f;
constexpr float C2_B = 0.125f * LOG2E;
constexpr float C2_C = 0.07216878364870322f * LOG2E;

__device__ __forceinline__ unsigned cvt_pk_bf16(float lo, float hi) { unsigned r; asm volatile("v_cvt_pk_bf16_f32 %0, %1, %2" : "=v"(r) : "v"(lo), "v"(hi)); return r; }
__device__ __forceinline__ float bf2f(bf16_t v) { return __uint_as_float(((unsigned)v) << 16); }
__device__ __forceinline__ float bflo(unsigned w) { return __uint_as_float(w << 16); }
__device__ __forceinline__ float bfhi(unsigned w) { return __uint_as_float(w & 0xffff0000u); }
__device__ __forceinline__ bf16_t f2bf(float f) { return (bf16_t)(cvt_pk_bf16(f, 0.f) & 0xffffu); }

__device__ __forceinline__ unsigned pk4_fp8(float a, float b, float c, float d) { int w = 0; w = __builtin_amdgcn_cvt_pk_fp8_f32(a, b, w, false); w = __builtin_amdgcn_cvt_pk_fp8_f32(c, d, w, true); return (unsigned)w; }
constexpr float W8_SCALE = 64.0f, W8_INV = 1.0f / 64.0f;
constexpr float Y8_SCALE = 16.0f, Y8_INV = 1.0f / 16.0f;

namespace pg8 {
constexpr int BM = 256, BK = 64, HALF = 128, HTB = HALF * BK * 2, STAGE_BYTES = 8 * HTB, NXCD = 8, WGM = 8;
__host__ __device__ __forceinline__ int lds_byte(int r, int c) { const int st = (r >> 4) * 2 + (c >> 5), rr = r & 15, cc = c & 31, ob = rr * 64 + cc * 2; return st * 1024 + (ob ^ (((ob >> 9) & 1) << 5)); }
__host__ __device__ __forceinline__ void stage_rc(int b, int& R, int& C) { const int st = b / 1024, sb = b % 1024, swz = sb ^ (((sb >> 9) & 1) << 5); R = (st >> 1) * 16 + swz / 64; C = (st & 1) * 32 + (swz % 64) / 2; }
__host__ __device__ __forceinline__ int perm32(int rho) { const int n = rho >> 4, i = rho & 15; return 8 * (i >> 2) + 4 * n + (i & 3); }

struct Unit { int pm, pn, pb, kind, rb; };
struct Gemm { const bf16_t* A; const bf16_t* Bt; int lda, K; const bf16_t* A2; const bf16_t* Bt2; };

struct StaticOrder {
    static constexpr bool GATHER = false;
    int nM, nN, nwg, G, c;
    __device__ void init(int M_, int N_, int G_, int c_) { nM = M_ / BM; nN = N_ / BM; nwg = nM * nN; G = G_; c = c_; }
    __device__ bool next(int i, Unit& u) const {
        const long L = (long)i * G + c; if (L >= nwg) return false;
        int wgid = (int)L; { const int q = nwg / NXCD, r = nwg % NXCD, xcd = wgid % NXCD, off = wgid / NXCD; wgid = (xcd < r ? xcd * (q + 1) : r * (q + 1) + (xcd - r) * q) + off; }
        const int nig = WGM * nN, gid = wgid / nig, fm = gid * WGM, gsz = (nM - fm) < WGM ? (nM - fm) : WGM;
        u.pm = fm + ((wgid % nig) % gsz); u.pn = (wgid % nig) / gsz; u.pb = u.pn; u.kind = 0; u.rb = 0; return true;
    }
    __device__ __forceinline__ void a_ready(const Unit&) const {}
    __device__ __forceinline__ void peek(const Unit&) const {}
    __device__ __forceinline__ void early_acquire(const Unit&) const {}
    __device__ __forceinline__ void pre_epi() const {}
    __device__ __forceinline__ void done(const Unit&) const {}
    __device__ __forceinline__ void finish() const {}
};

__device__ __forceinline__ f32x2 gelu_pk(f32x2 v) {
    const f32x2 av = __builtin_elementwise_abs(v), d = av * 0.2316418882f + 1.0f;
    f32x2 t; t.x = __builtin_amdgcn_rcpf(d.x); t.y = __builtin_amdgcn_rcpf(d.y);
    f32x2 q = t * 0.5307027145f + (-0.7265760135f); q = q * t + 0.7107068705f; q = q * t + (-0.142248368f); q = q * t + 0.127414796f; q = q * t;
    const f32x2 s = (v * v) * (-0.72134752044f);
    f32x2 e; e.x = __builtin_amdgcn_exp2f(s.x); e.y = __builtin_amdgcn_exp2f(s.y);
    const f32x2 m = v * (q * e), r = v - m;
    f32x2 o; o.x = v.x < 0.f ? m.x : r.x; o.y = v.y < 0.f ? m.y : r.y; return o;
}
__device__ __forceinline__ f32x4 gelu4(f32x4 v) { const f32x2 a = gelu_pk((f32x2){v[0], v[1]}), b = gelu_pk((f32x2){v[2], v[3]}); return (f32x4){a.x, a.y, b.x, b.y}; }

template <class Epi, class Sched, bool FP8 = false>
__device__ __forceinline__ void gemm_phase(LAS unsigned char* lds, const Gemm g, const Sched& S, const Epi& E) {
    int tid_ = threadIdx.x; asm volatile("" : "+v"(tid_));
    const int tid = tid_, wid = __builtin_amdgcn_readfirstlane(tid >> 6), lane = tid & 63, wr = wid >> 2, wc = wid & 3, fr = lane & 15, fq = lane >> 4;
    const int K = g.K, nt = K / BK;
    unsigned voffA[2], voffB[2];
    constexpr bool GATHER = Sched::GATHER;
    unsigned gA[2][2] = {{0u, 0u}, {0u, 0u}}; unsigned gRC = 0u;
#pragma unroll
    for (int i = 0; i < 2; ++i) { int R, C; stage_rc(tid * 16 + i * 8192, R, C); const int Rb = Epi::PERM ? ((R & ~31) + perm32(R & 31)) : R;
        voffA[i] = (unsigned)(R * g.lda + C) * 2u; voffB[i] = (unsigned)(Rb * K + C) * 2u; if (i == 0) gRC = (unsigned)R | ((unsigned)C * 2u << 8); }
    const size_t kstep = (size_t)(BK * 2);
    const size_t hstepA = (size_t)HALF * g.lda * 2, tstepA = 2 * hstepA;
    const size_t hstepB = (size_t)HALF * K * 2, tstepB = 2 * hstepB;
    const unsigned ldsw = (unsigned)wid * 1024u;
    const int aoff = lds_byte(wr * 64 + fr, fq * 8), boff = lds_byte(wc * 32 + fr, fq * 8);
#define PG8_SA(b, h) (((b) * 2 + (h)) * HTB)
#define PG8_SB(b, h) ((4 + (b) * 2 + (h)) * HTB)
#define PG8_STAGE(bufoff, gbase, voff) do { _Pragma("unroll") for (int _i = 0; _i < 2; ++_i) \
        __builtin_amdgcn_global_load_lds((const unsigned*)((const char*)(gbase) + (voff)[_i]), (LAS unsigned*)(lds + (bufoff) + ldsw + _i * 8192), 16, 0, 0); } while (0)
#define PG8_STAGE_A(bufoff, gbase, h) do { if constexpr (GATHER) { PG8_STAGE(bufoff, gbase, gA[h]); } else { PG8_STAGE(bufoff, (gbase) + (h) * hstepA, voffA); } } while (0)
#define PG8_GATHER_SET(U) do { const unsigned rb_ = (unsigned)g.lda * 2u; \
        _Pragma("unroll") for (int h_ = 0; h_ < 2; ++h_) _Pragma("unroll") for (int i_ = 0; i_ < 2; ++i_) { const int r_ = 128 * h_ + 64 * i_ + (int)(gRC & 255u); \
            const unsigned row_ = (U).kind ? (unsigned)((U).pm * BM + r_) : (S.tokt[r_] & 16383u); gA[h_][i_] = row_ * rb_ + (gRC >> 8); } } while (0)
#define PG8_GATHER_FETCH(U) do { if ((U).kind == 0 && wid < 4) \
        __builtin_amdgcn_global_load_lds((const unsigned*)(S.slot2tok + (size_t)(U).pm * BM + wid * 64 + lane), (LAS unsigned*)((LAS unsigned*)S.tokt + wid * 64), 4, 0, 0); } while (0)
#define PG8_LDA(dst, b, h) do { _Pragma("unroll") for (int m = 0; m < 4; ++m) { if constexpr (FP8) { const i32x4 lo_ = *(const LAS i32x4*)(lds + PG8_SA(b, h) + aoff + m * 2048), hi_ = *(const LAS i32x4*)(lds + PG8_SA(b, h) + aoff + m * 2048 + 1024); dst##8[m] = __builtin_shufflevector(lo_, hi_, 0, 1, 2, 3, 4, 5, 6, 7); } \
        else { _Pragma("unroll") for (int k = 0; k < 2; ++k) dst[m][k] = *(const LAS bf16x8*)(lds + PG8_SA(b, h) + aoff + m * 2048 + k * 1024); } } } while (0)
#define PG8_LDB(dst, b, h) do { _Pragma("unroll") for (int n = 0; n < 2; ++n) { if constexpr (FP8) { const i32x4 lo_ = *(const LAS i32x4*)(lds + PG8_SB(b, h) + boff + n * 2048), hi_ = *(const LAS i32x4*)(lds + PG8_SB(b, h) + boff + n * 2048 + 1024); dst##8[n] = __builtin_shufflevector(lo_, hi_, 0, 1, 2, 3, 4, 5, 6, 7); } \
        else { _Pragma("unroll") for (int k = 0; k < 2; ++k) dst[n][k] = *(const LAS bf16x8*)(lds + PG8_SB(b, h) + boff + n * 2048 + k * 1024); } } } while (0)
#define PG8_MMA(ai, bj, At, Bt) do { __builtin_amdgcn_s_setprio(1); _Pragma("unroll") for (int m = 0; m < 4; ++m) _Pragma("unroll") for (int n = 0; n < 2; ++n) { \
        if constexpr (FP8) asm volatile("s_nop 1\n\tv_mfma_f32_16x16x128_f8f6f4 %0, %1, %2, %0" : "+v"(acc[ai][bj][m][n]) : "v"(Bt##8[n]), "v"(At##8[m])); \
        else { _Pragma("unroll") for (int k = 0; k < 2; ++k) acc[ai][bj][m][n] = __builtin_amdgcn_mfma_f32_16x16x32_bf16(Bt[n][k], At[m][k], acc[ai][bj][m][n], 0, 0, 0); } } \
        __builtin_amdgcn_s_setprio(0); } while (0)
#define PG8_WAIT_V(n) asm volatile("s_waitcnt vmcnt(" #n ")" ::: "memory")
#define PG8_WAIT_L(n) asm volatile("s_waitcnt lgkmcnt(" #n ")" ::: "memory")
#define PG8_BAR __builtin_amdgcn_s_barrier()
#define PG8_SCHED __builtin_amdgcn_sched_barrier(0)
    Unit cur, nxt; int ui = 0;
    if (!S.next(0, cur)) return;
    f32x4 acc[2][2][4][2];
#pragma unroll
    for (int a = 0; a < 2; ++a)
#pragma unroll
        for (int b = 0; b < 2; ++b)
#pragma unroll
            for (int m = 0; m < 4; ++m)
#pragma unroll
                for (int n = 0; n < 2; ++n) acc[a][b][m][n] = (f32x4){0.f, 0.f, 0.f, 0.f};
    bf16x8 At[4][2], B0[2][2], B1[2][2]; i32x8 At8[4], B08[2], B18[2];
    const char* cA = (const char*)(cur.kind ? g.A2 : g.A) + (GATHER ? (size_t)0 : (size_t)cur.pm * tstepA); const char* cB = (const char*)(cur.kind ? g.Bt2 : g.Bt) + (size_t)cur.pb * tstepB;
    S.a_ready(cur);
    if constexpr (GATHER) { PG8_GATHER_FETCH(cur); asm volatile("s_waitcnt vmcnt(0)" ::: "memory"); __builtin_amdgcn_s_barrier(); PG8_GATHER_SET(cur); }
    PG8_STAGE(PG8_SB(0, 0), cB, voffB); PG8_STAGE(PG8_SB(0, 1), cB + hstepB, voffB); PG8_STAGE_A(PG8_SA(0, 0), cA, 0); PG8_STAGE_A(PG8_SA(0, 1), cA, 1);
    if (wr == 1) PG8_BAR;
    PG8_WAIT_V(2); PG8_BAR;
    PG8_STAGE(PG8_SB(1, 0), cB + kstep, voffB); PG8_STAGE_A(PG8_SA(1, 0), cA + kstep, 0); PG8_STAGE(PG8_SB(1, 1), cB + hstepB + kstep, voffB);
    PG8_WAIT_V(6); PG8_BAR;
    for (;;) {
        const bool has_next = S.next(ui + 1, nxt);
        const char* nA = has_next ? (const char*)(nxt.kind ? g.A2 : g.A) + (GATHER ? (size_t)0 : (size_t)nxt.pm * tstepA) : cA; const char* nB = has_next ? (const char*)(nxt.kind ? g.Bt2 : g.Bt) + (size_t)nxt.pb * tstepB : cB;
#pragma unroll 1
        for (int t = 0; t < nt; t += 2) {
            const bool last = (t == nt - 2);
            const char* a1 = cA + (size_t)(t + 1) * kstep;
            const char* a2 = last ? nA : cA + (size_t)(t + 2) * kstep; const char* b2 = last ? nB : cB + (size_t)(t + 2) * kstep;
            const char* a3 = a2 + kstep; const char* b3 = b2 + kstep;
            if constexpr (GATHER) { if (t == nt - 4 && has_next) PG8_GATHER_FETCH(nxt); }
            if (t == nt - 6 && has_next) S.peek(nxt);
            if (t == nt - 4 && has_next) S.early_acquire(nxt);
            if (last && has_next) S.a_ready(nxt);
            PG8_LDB(B0, 0, 0); PG8_LDB(B1, 0, 1); PG8_SCHED; PG8_LDA(At, 0, 0); PG8_STAGE_A(PG8_SA(1, 1), a1, 1);
            if constexpr (GATHER) { if (last && has_next) PG8_GATHER_SET(nxt); }
            PG8_WAIT_V(8); PG8_WAIT_L(0); PG8_BAR; PG8_MMA(0, 0, At, B0); PG8_MMA(0, 1, At, B1); PG8_BAR; PG8_SCHED;
            PG8_LDA(At, 0, 1); PG8_STAGE(PG8_SB(0, 0), b2, voffB); PG8_STAGE(PG8_SB(0, 1), b2 + hstepB, voffB); PG8_STAGE_A(PG8_SA(0, 0), a2, 0);
            PG8_WAIT_V(8); PG8_WAIT_L(0); PG8_BAR; PG8_MMA(1, 0, At, B0); PG8_MMA(1, 1, At, B1); PG8_BAR; PG8_SCHED;
            PG8_LDB(B0, 1, 0); PG8_LDB(B1, 1, 1); PG8_SCHED; PG8_LDA(At, 1, 0); PG8_STAGE_A(PG8_SA(0, 1), a2, 1);
            PG8_WAIT_V(8); PG8_WAIT_L(0); PG8_BAR; PG8_MMA(0, 0, At, B0); PG8_MMA(0, 1, At, B1); PG8_BAR; PG8_SCHED;
            PG8_LDA(At, 1, 1); PG8_STAGE(PG8_SB(1, 0), b3, voffB); PG8_STAGE(PG8_SB(1, 1), b3 + hstepB, voffB); PG8_STAGE_A(PG8_SA(1, 0), a3, 0);
            PG8_WAIT_V(8); PG8_WAIT_L(0); PG8_BAR; PG8_MMA(1, 0, At, B0); PG8_MMA(1, 1, At, B1); PG8_BAR; PG8_SCHED;
        }
        if (wr == 0) PG8_BAR;
        if constexpr (FP8) asm volatile("s_nop 15\n\ts_nop 7" ::: "memory");
        S.pre_epi();
        { int te_ = threadIdx.x; asm volatile("" : "+v"(te_));
          E(acc, cur, wr, wc, te_ & 15, (te_ & 63) >> 4); }
        S.done(cur);
        if (!has_next) break;
#pragma unroll
        for (int a = 0; a < 2; ++a)
#pragma unroll
            for (int b = 0; b < 2; ++b)
#pragma unroll
                for (int m = 0; m < 4; ++m)
#pragma unroll
                    for (int n = 0; n < 2; ++n) acc[a][b][m][n] = (f32x4){0.f, 0.f, 0.f, 0.f};
        cur = nxt; cA = nA; cB = nB; ++ui;
        if (wr == 1) PG8_BAR;
    }
    PG8_WAIT_V(0);
    S.finish();
    PG8_BAR;
#undef PG8_SA
#undef PG8_SB
#undef PG8_STAGE
#undef PG8_LDA
#undef PG8_STAGE_A
#undef PG8_GATHER_SET
#undef PG8_GATHER_FETCH
#undef PG8_LDB
#undef PG8_MMA
#undef PG8_WAIT_V
#undef PG8_WAIT_L
#undef PG8_BAR
#undef PG8_SCHED
}
}
constexpr int STAGE_LIMIT = 8;
#define Y8 1
#define E1F8 1

namespace att {
__device__ __forceinline__ int crow(int r, int hi) { return (r & 3) + 8 * (r >> 2) + 4 * hi; }
__device__ __forceinline__ int v_rd_base(int lane) { return ((lane & 3) << 3) | (((lane >> 2) & 3) << 6) | (((lane >> 4) & 1) << 5) | (((lane >> 5) & 1) << 8); }
}

namespace dil {
using att::crow; using att::v_rd_base;
constexpr int QB = 512;
constexpr int OFF_O = 0, OFF_V = 65536, VWAVE = 8192;
template <int S_>
__device__ __forceinline__ void pass(const bf16_t* __restrict__ Qh, const bf16_t* __restrict__ Kh, const bf16_t* __restrict__ Vh, int pitch, int q0, LAS unsigned char* lds, LAS float* scr, int wid, int lane) {
    const int r32 = lane & 31, hi = lane >> 5;
    LAS bf16_t* Oacc = (LAS bf16_t*)(lds + OFF_O); LAS float* macc = scr; LAS float* lacc = scr + QB; LAS float* wsf = scr + 2 * QB + wid * 64;
    LAS unsigned char* vbuf = lds + OFF_V + wid * VWAVE;
    constexpr int NQ = (S_ == 16) ? 1 : 2, NG = (S_ == 16) ? 2 : 1, NST = 4 + NQ;
    int vk[4], vc[4];
#pragma unroll
    for (int i = 0; i < 4; ++i) { const int off = (i * 64 + lane) * 16, st = off >> 9, within = off & 511, kk = (st >> 1) * 8 + (within >> 6);
        vk[i] = (kk & ~0xC) | ((kk & 4) << 1) | ((kk & 8) >> 1); vc[i] = (st & 1) * 32 + ((within & 63) >> 1); }
    const unsigned vb0 = (unsigned)(uintptr_t)vbuf + (unsigned)v_rd_base(lane);
#pragma unroll
    for (int gi = 0; gi < NG; ++gi) {
        const int rho = (S_ == 1) ? 0 : (S_ == 4) ? (wid & 3) : (2 * wid + gi);
        const int i0 = (S_ == 1) ? 64 * wid : (S_ == 4) ? 64 * (wid >> 2) : 0;
        const int qiA = i0 + r32, qiB = i0 + 32 + r32;
        bf16x8 qrA[4], qrB[4];
#pragma unroll
        for (int d0 = 0; d0 < 4; ++d0) { qrA[d0] = *(const bf16x8*)(Qh + (size_t)(q0 + rho + S_ * qiA) * pitch + d0 * 16 + hi * 8);
            if (NQ == 2) qrB[d0] = *(const bf16x8*)(Qh + (size_t)(q0 + rho + S_ * qiB) * pitch + d0 * 16 + hi * 8); }
        const int j0 = i0 - 128;
        const int tokb = q0 + rho + S_ * j0;
        bf16x8 kfA[4], kfB[4];
#define DIL_KLOAD(dst, c) do { int tk_ = tokb + S_ * (32 * (c) + r32); tk_ = tk_ < 0 ? 0 : (tk_ > SEQ - 1 ? SEQ - 1 : tk_);     \
            _Pragma("unroll") for (int d0 = 0; d0 < 4; ++d0) dst[d0] = *(const bf16x8*)(Kh + (size_t)tk_ * pitch + d0 * 16 + hi * 8); } while (0)
#define DIL_VDMA(c, bf) do { _Pragma("unroll") for (int i = 0; i < 4; ++i) { int tk_ = tokb + S_ * (32 * (c) + vk[i]); tk_ = tk_ < 0 ? 0 : (tk_ > SEQ - 1 ? SEQ - 1 : tk_); \
            __builtin_amdgcn_global_load_lds((const unsigned*)(Vh + (size_t)tk_ * pitch + vc[i]), (LAS unsigned*)(vbuf + (bf) * 4096 + i * 1024), 16, 0, 0); } } while (0)
        float mA = -1e30f, lA = 0.f, mB = -1e30f, lB = 0.f; f32x16 oA[2], oB[2]; oA[0] = f32x16{}; oA[1] = f32x16{}; oB[0] = f32x16{}; oB[1] = f32x16{};
        DIL_KLOAD(kfA, 0); DIL_VDMA(0, 0);
#define DIL_PK4(P, B_, OUT) do { unsigned a0 = cvt_pk_bf16(P[B_+0], P[B_+1]), a1 = cvt_pk_bf16(P[B_+2], P[B_+3]);                          \
            unsigned b0_ = cvt_pk_bf16(P[B_+4], P[B_+5]), b1_ = cvt_pk_bf16(P[B_+6], P[B_+7]);                                             \
            auto r0 = __builtin_amdgcn_permlane32_swap(a0, b0_, false, false); auto r1 = __builtin_amdgcn_permlane32_swap(a1, b1_, false, false); \
            u32x4 w = {r0[0], r1[0], r0[1], r1[1]}; OUT = __builtin_bit_cast(bf16x8, w); } while (0)
#define DIL_TILE(KF, QR, QI, M_, L_, O_, T, c) do { \
            f32x16 p = f32x16{}; \
            _Pragma("unroll") for (int d0 = 0; d0 < 4; ++d0) p = __builtin_amdgcn_mfma_f32_32x32x16_bf16(KF[d0], QR[d0], p, 0, 0, 0); \
              \
            { const float NEG = -__builtin_inff(); const int db = QI - j0 - 32 * (c) - 4 * hi; const int tb = tokb + S_ * (32 * (c) + 4 * hi); \
              if ((c) == (T) || (c) == (T) + 4 || tokb < 0) { \
                _Pragma("unroll") for (int r = 0; r < 16; ++r) { const int cr = (r & 3) + 8 * (r >> 2); \
                    const bool ok = ((unsigned)(db - cr) <= 128u) && (tb + S_ * cr >= 0); p[r] = ok ? p[r] : NEG; } } } \
            float pmax = p[0]; \
            _Pragma("unroll") for (int r = 1; r < 16; ++r) pmax = fmaxf(pmax, p[r]); \
            { auto rr = __builtin_amdgcn_permlane32_swap(__float_as_uint(pmax), __float_as_uint(pmax), false, false); pmax = fmaxf(__uint_as_float(rr[0]), __uint_as_float(rr[1])); } \
            const float mn = fmaxf(M_, pmax); const float alpha = __builtin_amdgcn_exp2f(M_ - mn); M_ = mn; \
            float ps = 0.f; \
            _Pragma("unroll") for (int r = 0; r < 16; ++r) { p[r] = __builtin_amdgcn_exp2f(p[r] - mn); ps += p[r]; } \
            { auto rr = __builtin_amdgcn_permlane32_swap(__float_as_uint(ps), __float_as_uint(ps), false, false); ps = __uint_as_float(rr[0]) + __uint_as_float(rr[1]); } \
            L_ = L_ * alpha + ps; \
            bf16x8 pa0, pa1; DIL_PK4(p, 0, pa0); DIL_PK4(p, 8, pa1); \
            if (__any(alpha < 1.f)) { if (hi == 0) wsf[r32] = alpha; asm volatile("s_waitcnt lgkmcnt(0)" ::: "memory"); \
                _Pragma("unroll") for (int r = 0; r < 16; ++r) { const float a = wsf[crow(r, hi)]; O_[0][r] *= a; O_[1][r] *= a; } } \
            asm volatile("s_waitcnt lgkmcnt(0)" ::: "memory"); __builtin_amdgcn_sched_barrier(0); \
            _Pragma("unroll") for (int d0 = 0; d0 < 2; ++d0) { \
                O_[d0] = __builtin_amdgcn_mfma_f32_32x32x16_bf16(pa0, (bf16x8){vl0[d0][0], vl0[d0][1], vl0[d0][2], vl0[d0][3], vh0[d0][0], vh0[d0][1], vh0[d0][2], vh0[d0][3]}, O_[d0], 0, 0, 0); \
                O_[d0] = __builtin_amdgcn_mfma_f32_32x32x16_bf16(pa1, (bf16x8){vl1[d0][0], vl1[d0][1], vl1[d0][2], vl1[d0][3], vh1[d0][0], vh1[d0][1], vh1[d0][2], vh1[d0][3]}, O_[d0], 0, 0, 0); } \
        } while (0)
#define DIL_STEP(KF, KN, c) do { \
            if ((c) + 1 < NST) { DIL_KLOAD(KN, (c) + 1); DIL_VDMA((c) + 1, ((c) + 1) & 1); asm volatile("s_waitcnt vmcnt(8)" ::: "memory"); } \
            else { asm volatile("s_waitcnt vmcnt(0)" ::: "memory"); } \
            const unsigned vb = vb0 + (unsigned)(((c) & 1) * 4096); \
            s16x4 vl0[2], vh0[2], vl1[2], vh1[2]; \
            _Pragma("unroll") for (int d0 = 0; d0 < 2; ++d0) { \
                asm volatile("ds_read_b64_tr_b16 %0, %1 offset:%2" : "=&v"(vl0[d0]) : "v"(vb), "i"(d0 * 512) : "memory"); \
                asm volatile("ds_read_b64_tr_b16 %0, %1 offset:%2" : "=&v"(vh0[d0]) : "v"(vb), "i"(d0 * 512 + 1024) : "memory"); \
                asm volatile("ds_read_b64_tr_b16 %0, %1 offset:%2" : "=&v"(vl1[d0]) : "v"(vb), "i"(d0 * 512 + 2048) : "memory"); \
                asm volatile("ds_read_b64_tr_b16 %0, %1 offset:%2" : "=&v"(vh1[d0]) : "v"(vb), "i"(d0 * 512 + 3072) : "memory"); } \
            if ((c) <= 4) DIL_TILE(KF, qrA, qiA, mA, lA, oA, 0, c); \
            if (NQ == 2 && (c) >= 1) DIL_TILE(KF, qrB, qiB, mB, lB, oB, 1, c); \
        } while (0)
        DIL_STEP(kfA, kfB, 0); DIL_STEP(kfB, kfA, 1); DIL_STEP(kfA, kfB, 2); DIL_STEP(kfB, kfA, 3); DIL_STEP(kfA, kfB, 4);
        if (NQ == 2) DIL_STEP(kfB, kfA, 5);
#undef DIL_STEP
#undef DIL_TILE
#undef DIL_PK4
#undef DIL_KLOAD
#undef DIL_VDMA
#define DIL_MERGE(QI, M_, L_, O_, T) do { const int ql = rho + S_ * (QI);                            \
            float fo = 0.f, fc = 1.f; \
            if (S_ != 1) { const float mo = macc[ql], lo = lacc[ql]; const float mnew = fmaxf(mo, M_); fo = __builtin_amdgcn_exp2f(mo - mnew); fc = __builtin_amdgcn_exp2f(M_ - mnew); \
                L_ = lo * fo + L_ * fc; M_ = mnew; } \
            if (hi == 0) { macc[ql] = M_; lacc[ql] = L_; wsf[r32] = fo; wsf[32 + r32] = fc; } \
            asm volatile("s_waitcnt lgkmcnt(0)" ::: "memory"); \
            _Pragma("unroll") for (int r = 0; r < 16; ++r) { const int row = crow(r, hi); \
                const int qrow = rho + S_ * (i0 + 32 * (T) + row); LAS bf16_t* op = Oacc + qrow * 64 + r32; \
                if (S_ == 1) { op[0] = f2bf(O_[0][r]); op[32] = f2bf(O_[1][r]); } \
                else { const float a = wsf[row], b = wsf[32 + row]; op[0] = f2bf(bf2f(op[0]) * a + O_[0][r] * b); op[32] = f2bf(bf2f(op[32]) * a + O_[1][r] * b); } } \
            asm volatile("s_waitcnt lgkmcnt(0)" ::: "memory"); } while (0)
        DIL_MERGE(qiA, mA, lA, oA, 0);
        if (NQ == 2) DIL_MERGE(qiB, mB, lB, oB, 1);
#undef DIL_MERGE
    }
}
__device__ __forceinline__ void unit(const bf16_t* Qh, const bf16_t* Kh, const bf16_t* Vh, int pitch, bf16_t* Oh, int op, int q0, LAS unsigned char* lds, LAS float* scr) {
    int tid_ = threadIdx.x; asm volatile("" : "+v"(tid_));
    const int tid = tid_, wid = __builtin_amdgcn_readfirstlane(tid >> 6), lane = tid & 63;
    pass<1>(Qh, Kh, Vh, pitch, q0, lds, scr, wid, lane);
    __syncthreads();
    pass<4>(Qh, Kh, Vh, pitch, q0, lds, scr, wid, lane);
    __syncthreads();
    pass<16>(Qh, Kh, Vh, pitch, q0, lds, scr, wid, lane);
    __syncthreads();
    {   const int q = tid; const LAS u32x4* src = (const LAS u32x4*)(lds + OFF_O + q * 128); const float rl = 1.0f / scr[QB + q];
        bf16_t* dst = Oh + (size_t)(q0 + q) * op;
#pragma unroll
        for (int i = 0; i < 8; ++i) { const u32x4 sv = src[i];
            u32x4 w; w.x = cvt_pk_bf16(bflo(sv.x) * rl, bfhi(sv.x) * rl); w.y = cvt_pk_bf16(bflo(sv.y) * rl, bfhi(sv.y) * rl); w.z = cvt_pk_bf16(bflo(sv.z) * rl, bfhi(sv.z) * rl); w.w = cvt_pk_bf16(bflo(sv.w) * rl, bfhi(sv.w) * rl);
            *(u32x4*)(dst + 8 * i) = w; } }
    __syncthreads();
}
}

namespace mla {
using att::crow;
constexpr int DQ = 192, DV_ = 128;
constexpr int KB = 64 * DQ;
constexpr int VB = DV_ * 64;
constexpr int NBUF = 3;
constexpr int OFF_K = 0, OFF_V = NBUF * KB, OFF_WS = NBUF * (KB + VB), BYTES = OFF_WS + 8 * 256;
constexpr int NKP = KB / 1024, KPW = (NKP + 7) / 8;
constexpr int NVP = VB / 1024;
static_assert(BYTES <= 131072 && NKP == 12 && NVP == 8, "mla LDS image");
constexpr float PSHIFT = 8.0f;

__device__ __forceinline__ void unit(const unsigned char* __restrict__ Qh, const unsigned char* __restrict__ Kh, int pitch, const unsigned char* __restrict__ VTh  ,
                                     unsigned char* __restrict__ Oh, int op, int q0, LAS unsigned char* lds) {
    int tid_ = threadIdx.x; asm volatile("" : "+v"(tid_));
    const int tid = tid_, wid = __builtin_amdgcn_readfirstlane(tid >> 6), lane = tid & 63, r32 = lane & 31, hi = lane >> 5;
    const int qlo = q0 + wid * 32, qpos = qlo + r32;
    LAS float* wsf = (LAS float*)(lds + OFF_WS) + wid * 64;
    const int NT = (q0 + 256) / 64;
    unsigned kso[KPW], vso;
#pragma unroll
    for (int i = 0; i < KPW; ++i) { const int G = ((wid + 8 * i) * 64 + lane) % (NKP * 64), R = G / 12, rem = G % 12, sg = rem >> 2, qq = rem & 3, f = (R >> 2) & 3;
        const int key = 32 * ((R >> 2) & 1) + 16 * (R >> 5) + 4 * ((R >> 3) & 3) + (R & 3);
        kso[i] = (unsigned)(key * pitch + 64 * sg + 16 * (qq ^ f)); }
    {   const int G = wid * 64 + lane, d = G >> 2, qq = G & 3, f = (d >> 2) & 3; vso = (unsigned)(d * SEQ + 16 * (qq ^ f)); }
#define MLA_DMA(j, bf) do { const unsigned char* kt_ = Kh + (size_t)(j) * 64 * pitch; const unsigned char* vt_ = VTh + (size_t)(j) * 64; \
        _Pragma("unroll") for (int i = 0; i < KPW; ++i) if (wid + 8 * i < NKP) \
            __builtin_amdgcn_global_load_lds((const unsigned*)(kt_ + kso[i]), (LAS unsigned*)(lds + OFF_K + (bf) * KB + (wid + 8 * i) * 1024), 16, 0, 0); \
        __builtin_amdgcn_global_load_lds((const unsigned*)(vt_ + vso), (LAS unsigned*)(lds + OFF_V + (bf) * VB + wid * 1024), 16, 0, 0); } while (0)
#define MLA_MFMA(acc, a, b) asm volatile("v_mfma_f32_32x32x64_f8f6f4 %0, %1, %2, %0" : "+v"(acc) : "v"(a), "v"(b))
#define MLA_MFMA0(acc, a, b) asm volatile("v_mfma_f32_32x32x64_f8f6f4 %0, %1, %2, 0" : "=v"(acc) : "v"(a), "v"(b))
#define MLA_MFMA_DRAIN2(a, b) asm volatile("s_nop 15\n\ts_nop 3" : "+v"(a), "+v"(b) :: "memory")
    i32x8 qr[3];
#pragma unroll
    for (int s = 0; s < 3; ++s) { const i32x4 lo_ = *(const i32x4*)(Qh + (size_t)qpos * pitch + 64 * s + 32 * hi), hi_ = *(const i32x4*)(Qh + (size_t)qpos * pitch + 64 * s + 32 * hi + 16);
        qr[s] = __builtin_shufflevector(lo_, hi_, 0, 1, 2, 3, 4, 5, 6, 7); }
    MLA_DMA(0, 0); MLA_DMA(1, 1);
#define MLA_WAIT_OLDER() do { if (wid < NKP - 8) asm volatile("s_waitcnt vmcnt(%0)" :: "n"(KPW + 1) : "memory"); else asm volatile("s_waitcnt vmcnt(%0)" :: "n"(KPW) : "memory"); } while (0)
    float m_reg = -1e30f;
    f32x16 o[4], ol = f32x16{};
#pragma unroll
    for (int d = 0; d < 4; ++d) o[d] = f32x16{};
    const int fsw = (r32 >> 2) & 3;
    const int koff = r32 * DQ + 16 * ((2 * hi) ^ fsw), voff = r32 * 64 + 16 * ((2 * hi) ^ fsw);
    MLA_WAIT_OLDER();
    asm volatile("" :: "v"(qr[0]), "v"(qr[1]), "v"(qr[2]));
    __builtin_amdgcn_s_barrier();
#define MLA_LD8(dst, base, off) do { const i32x4 lo_ = *(const LAS i32x4*)((base) + (off)), hi_ = *(const LAS i32x4*)((base) + ((off) ^ 16)); dst = __builtin_shufflevector(lo_, hi_, 0, 1, 2, 3, 4, 5, 6, 7); } while (0)
    int buf = 0;
    for (int t = 0; t < NT; ++t) {
        const int kb = t * 64;
        if (kb <= qlo + 31) {
            const LAS unsigned char* kp_ = lds + OFF_K + buf * KB;
            const LAS unsigned char* vp_ = lds + OFF_V + buf * VB;
            f32x16 s0, s1;
            if (kb + 63 <= qlo) {
                i32x8 k0[3], k1[3];
#pragma unroll
                for (int s = 0; s < 3; ++s) MLA_LD8(k0[s], kp_ + 64 * s, koff);
                MLA_MFMA0(s0, k0[0], qr[0]);
#pragma unroll
                for (int s = 0; s < 3; ++s) MLA_LD8(k1[s], kp_ + 32 * DQ + 64 * s, koff);
                MLA_MFMA(s0, k0[1], qr[1]); MLA_MFMA(s0, k0[2], qr[2]);
                MLA_MFMA0(s1, k1[0], qr[0]); MLA_MFMA(s1, k1[1], qr[1]); MLA_MFMA(s1, k1[2], qr[2]);
            } else {
                const float NEG = -__builtin_inff(); const int dq = qpos - kb - 32 * hi;
                int kq_ = koff; asm volatile("" : "+v"(kq_));
                {   i32x8 k0[3];
#pragma unroll
                    for (int s = 0; s < 3; ++s) MLA_LD8(k0[s], kp_ + 64 * s, kq_);
                    MLA_MFMA0(s0, k0[0], qr[0]); MLA_MFMA(s0, k0[1], qr[1]); MLA_MFMA(s0, k0[2], qr[2]);
                }
                {   i32x8 k1[3];
#pragma unroll
                    for (int s = 0; s < 3; ++s) MLA_LD8(k1[s], kp_ + 32 * DQ + 64 * s, kq_);
                    MLA_MFMA0(s1, k1[0], qr[0]); MLA_MFMA(s1, k1[1], qr[1]); MLA_MFMA(s1, k1[2], qr[2]);
                }
                MLA_MFMA_DRAIN2(s0, s1);
#pragma unroll
                for (int r = 0; r < 16; ++r) { if (r > dq) s0[r] = NEG; if (r + 16 > dq) s1[r] = NEG; }
            }

            i32x8 vv[4];
#pragma unroll
            for (int d0 = 0; d0 < 4; ++d0) MLA_LD8(vv[d0], vp_ + d0 * 32 * 64, voff);
            MLA_MFMA_DRAIN2(s0, s1);
            __builtin_amdgcn_sched_barrier(0);
            float pm0 = s0[0], pm1 = s0[8];
#define MLA_MAX8(pm, B_) asm("v_max3_f32 %0, %0, %1, %2\n\tv_max3_f32 %0, %0, %3, %4\n\tv_max3_f32 %0, %0, %5, %6\n\tv_max3_f32 %0, %0, %7, %8\n\tv_max3_f32 %0, %0, %9, %10\n\tv_max3_f32 %0, %0, %11, %12\n\tv_max3_f32 %0, %0, %13, %14\n\tv_max3_f32 %0, %0, %15, %16" \
                : "+v"(pm) : "v"(s0[B_ + 0]), "v"(s1[B_ + 0]), "v"(s0[B_ + 1]), "v"(s1[B_ + 1]), "v"(s0[B_ + 2]), "v"(s1[B_ + 2]), "v"(s0[B_ + 3]), "v"(s1[B_ + 3]), \
                              "v"(s0[B_ + 4]), "v"(s1[B_ + 4]), "v"(s0[B_ + 5]), "v"(s1[B_ + 5]), "v"(s0[B_ + 6]), "v"(s1[B_ + 6]), "v"(s0[B_ + 7]), "v"(s1[B_ + 7]))
            MLA_MAX8(pm0, 0); MLA_MAX8(pm1, 8);
#undef MLA_MAX8
            float pmax = fmaxf(pm0, pm1);
            { auto rr = __builtin_amdgcn_permlane32_swap(__float_as_uint(pmax), __float_as_uint(pmax), false, false); pmax = fmaxf(__uint_as_float(rr[0]), __uint_as_float(rr[1])); }
            const float mn = fmaxf(m_reg, pmax); const float alpha = __builtin_amdgcn_exp2f((m_reg - mn) * 0.125f); m_reg = mn;
            const float b8 = 8.0f * (PSHIFT + 7.0f) - mn;
            i32x8 pa;
            const f32x16 t0 = s0 + b8, t1 = s1 + b8;
#pragma unroll
            for (int g = 0; g < 4; ++g) { unsigned w0 = 0u, w1 = 0u;
#pragma unroll
                for (int b_ = 0; b_ < 4; ++b_) { w0 = __builtin_amdgcn_cvt_pk_u8_f32(t0[4 * g + b_], b_, w0); w1 = __builtin_amdgcn_cvt_pk_u8_f32(t1[4 * g + b_], b_, w1); }
                pa[g] = (int)w0; pa[4 + g] = (int)w1; }
            if (__any(alpha < 1.f)) { if (hi == 0) wsf[r32] = alpha; asm volatile("s_waitcnt lgkmcnt(0)" ::: "memory");
#pragma unroll
                for (int r = 0; r < 16; ++r) { const float a = wsf[crow(r, hi)]; ol[r] *= a;
#pragma unroll
                    for (int d = 0; d < 4; ++d) o[d][r] *= a; } }
            int one_ = 0x38383838; asm volatile("" : "+v"(one_));
            const i32x8 ones8 = {one_, one_, one_, one_, one_, one_, one_, one_};
            asm volatile("s_nop 1" ::: "memory");
            MLA_MFMA(ol, pa, ones8);
#pragma unroll
            for (int d0 = 0; d0 < 4; ++d0) MLA_MFMA(o[d0], pa, vv[d0]);
        }
        if (t + 2 < NT) { const int b2 = buf == 0 ? 2 : buf - 1; MLA_DMA(t + 2, b2); }
        if (t + 2 < NT) { MLA_WAIT_OLDER(); } else { asm volatile("s_waitcnt vmcnt(0)" ::: "memory"); }
        asm volatile("s_waitcnt lgkmcnt(0)" ::: "memory");
        __builtin_amdgcn_s_barrier();
        buf = buf == 2 ? 0 : buf + 1;
    }
    MLA_MFMA_DRAIN2(o[0], o[1]); MLA_MFMA_DRAIN2(o[2], o[3]); MLA_MFMA_DRAIN2(ol, o[0]);
#undef MLA_MFMA_DRAIN2
#undef MLA_MFMA0
#undef MLA_MFMA
#undef MLA_LD8
#undef MLA_WAIT_OLDER
#undef MLA_DMA
    unsigned char* Ow = Oh + (size_t)qlo * op;
#pragma unroll
    for (int r = 0; r < 16; ++r) { const int orow = crow(r, hi); const float rl = __builtin_amdgcn_rcpf(ol[r]);
#pragma unroll
        for (int d0 = 0; d0 < 4; ++d0) { const float v = o[d0][r] * rl; const float v1 = __shfl_down(v, 1), v2 = __shfl_down(v, 2), v3 = __shfl_down(v, 3);
            if ((r32 & 3) == 0) *(unsigned*)(Ow + (size_t)orow * op + d0 * 32 + r32) = pk4_fp8(v, v1, v2, v3); } }
    __syncthreads();
}
}

constexpr int NWAVES = 8;
constexpr size_t MiB = 1u << 20;
constexpr size_t WS_CTL = 0, CTL_ZERO_BYTES = 1 * MiB;
constexpr size_t WS_WEIN = 2 * MiB;
constexpr size_t WS_WEOUT = 12 * MiB;
constexpr size_t WS_WOIN = 16 * MiB;
constexpr size_t WS_WUQ = 20 * MiB;
constexpr size_t WS_WUKV = 23 * MiB;
constexpr size_t WS_WOOUT = 25 * MiB;
constexpr size_t WS_B1P = 29 * MiB;
constexpr size_t WS_SSQ = 30 * MiB;
constexpr size_t WS_TOKER = 31 * MiB;
constexpr size_t WS_TOKG = 31 * MiB + 512 * 1024;
constexpr size_t WS_XN = 32 * MiB;
constexpr size_t WS_Z = 64 * MiB;
constexpr size_t WS_MIX = 144 * MiB;
constexpr size_t WS_QR = 176 * MiB;
constexpr size_t WS_KVR = 224 * MiB;
constexpr size_t WS_QF = 288 * MiB;
constexpr size_t WS_KF = 336 * MiB;
constexpr size_t WS_Z8 = 104 * MiB;
constexpr size_t WS_MIX8 = 160 * MiB;
constexpr size_t WS_VT = 3200 * MiB;
constexpr size_t WS_W1 = 384 * MiB;
constexpr size_t WS_W2 = 896 * MiB;
constexpr size_t WS_XG = 1152 * MiB;
constexpr size_t WS_ACT = 1664 * MiB;
constexpr size_t WS_Y = 2176 * MiB;
constexpr size_t WS_X16 = 3216 * MiB;
constexpr size_t WS_END = 3248 * MiB;
constexpr int CW_MOE = 65536;
constexpr int CW_TMO = 0, CW_CODE = 1, CW_BAR = 4096, CW_CNT = 16384;
constexpr int RING_OFF = 0, RING_BYTES = 131072;
constexpr int LDSCTL_OFF = RING_BYTES, MISC_OFF = LDSCTL_OFF + 320;
constexpr int SCR_OFF = RING_BYTES + 1024;
constexpr int LDS_BYTES = 155648;
constexpr int SCR_BYTES = LDS_BYTES - SCR_OFF;

typedef GAS unsigned gu32;
#define RLX_AGENT __ATOMIC_RELAXED, __HIP_MEMORY_SCOPE_AGENT

#define XB_TMO      128
#define XB_XCNT(j)  (256  + 64 * (j))
#define XB_XSUB(j)  (1280 + 64 * (j))
#define XB_XGEN(j)  (2304 + 64 * (j))
#define XB_TOP      3328
#define XB_TOPGEN   3392
#define XCD_BAR_WORDS 3456
#define XB_SPIN_CAP (1u << 18)
__device__ __forceinline__ unsigned xb_ld(unsigned* p)              { return __hip_atomic_load(p, __ATOMIC_RELAXED, __HIP_MEMORY_SCOPE_AGENT); }
__device__ __forceinline__ unsigned xb_add(unsigned* p, unsigned v) { return __hip_atomic_fetch_add(p, v, __ATOMIC_RELAXED, __HIP_MEMORY_SCOPE_AGENT); }
__device__ __forceinline__ unsigned xb_xcc_id() { return (unsigned)__builtin_amdgcn_s_getreg((3 << 11) | 20) & 0xFu; }
#define XB_SPIN(cond, bar) do { unsigned _sp = 0; while (cond) { __builtin_amdgcn_s_sleep(1); \
    if ((++_sp & 255u) == 0u) { if (xb_ld(&(bar)[XB_TMO])) break; if (_sp > XB_SPIN_CAP) { atomicAdd(&(bar)[XB_TMO], 1u); break; } } } } while (0)
struct XcdBarrier { unsigned* bar; unsigned x; volatile LAS unsigned* st; };
__device__ __forceinline__ XcdBarrier xcd_barrier_post(unsigned* bar, volatile LAS unsigned* st) {
    XcdBarrier b; b.bar = bar; b.x = xb_xcc_id(); b.st = st;
    if (threadIdx.x == 0) (void)xb_add(&bar[XB_XCNT(b.x)], 1u);
    return b;
}
__device__ __forceinline__ void xcd_barrier_complete(unsigned* bar, unsigned x, unsigned& nloc, unsigned& nx) {
    const unsigned G = gridDim.x * gridDim.y * gridDim.z;
    unsigned sum, cnt, mine, sp = 0u;
    for (;;) {
        sum = 0u; cnt = 0u; mine = 0u;
#pragma unroll
        for (unsigned j = 0; j < 16; ++j) { const unsigned c = xb_ld(&bar[XB_XCNT(j)]); sum += c; cnt += (c > 0u) ? 1u : 0u; mine = (j == x) ? c : mine; }
        if (sum == G) break;
        __builtin_amdgcn_s_sleep(1);
        if ((++sp & 255u) == 0u) { if (xb_ld(&bar[XB_TMO])) break; if (sp > XB_SPIN_CAP) { atomicAdd(&bar[XB_TMO], 1u); break; } }
    }
    nloc = mine > 0u ? mine : 1u; nx = cnt > 0u ? cnt : 1u;
}
__device__ __forceinline__ void xcd_barrier(const XcdBarrier& b) {
    asm volatile("s_waitcnt vmcnt(0)" ::: "memory");
    __syncthreads();
    if (threadIdx.x == 0) {
        unsigned* bar = b.bar;
        __builtin_amdgcn_s_waitcnt(0);
        unsigned nloc = b.st[0], nx = b.st[1];
        if (nloc == 0u) { xcd_barrier_complete(bar, b.x, nloc, nx); b.st[0] = nloc; b.st[1] = nx; }
        const unsigned old = xb_add(&bar[XB_XSUB(b.x)], 1u);
        asm volatile("buffer_inv sc1" ::: "memory");
        const unsigned gen = old / nloc;
        if (old + 1u == (gen + 1u) * nloc) {
            __builtin_amdgcn_fence(__ATOMIC_RELEASE, "agent");
            asm volatile("s_waitcnt vmcnt(0)" ::: "memory");
            const unsigned og = xb_add(&bar[XB_TOP], 1u);
            const unsigned tg = og / nx;
            if (og + 1u == (tg + 1u) * nx) {
#pragma unroll
                for (unsigned j = 0; j < 16; ++j) (void)xb_add(&bar[XB_XGEN(j)], 1u);
            } else XB_SPIN(xb_ld(&bar[XB_XGEN(b.x)]) == tg, bar);
            asm volatile("s_waitcnt vmcnt(0)" ::: "memory");
        } else {
            XB_SPIN(xb_ld(&bar[XB_XGEN(b.x)]) == gen, bar);
            asm volatile("s_waitcnt vmcnt(0)" ::: "memory");
        }
    }
    __syncthreads();
}

struct Args {
    const float* in[24]; float* out; unsigned char* ws; int stage_limit; int pad;
};
enum { I_X = 0, I_MIXN, I_FFNN, I_EWIN, I_EWS, I_EBS, I_EGV, I_EGQ, I_EGK, I_EWOUT, I_OWIN, I_OGCQ, I_OGCKV, I_OWUQ, I_OWUKV, I_OGQ, I_OGK, I_OWOUT,
       I_RW, I_RB, I_W1, I_B1, I_W2, I_B2 };

struct Frame {
    LAS unsigned char* lds;
    int vcu, G;
};

__device__ __forceinline__ float wave_sum(float v) {
#pragma unroll
    for (int o = 1; o < 64; o <<= 1) v += __shfl_xor(v, o);
    return v;
}
#define LDS_WAIT() asm volatile("s_waitcnt lgkmcnt(0)" ::: "memory")

template <int MODE> __device__ __forceinline__ int dst_row(int o) {
    if (MODE == 1) { if (o >= 1024 && o < 2048) return (o & ~255) | (((o >> 5) & 1) << 7) | (((o >> 6) & 3) << 5) | (o & 31); return o; }
    if (MODE == 2) return ((o >> 8) << 8) | ((o & 1) << 7) | ((o & 255) >> 1);
    return o;
}
template <int MODE>
__device__ __forceinline__ void transpose_item(const float* __restrict__ W, int K, int N, bf16_t* __restrict__ WT, const float* __restrict__ gain, LAS float* scr, int item, int lane) {
    const int nblk = N / 32, kb = item / nblk, nb = item % nblk, k0 = 64 * kb, n0 = 32 * nb;
#pragma unroll 8
    for (int i = 0; i < 32; ++i) { const int kk = 2 * i + (lane >> 5); float w = W[(size_t)(k0 + kk) * N + n0 + (lane & 31)]; if (gain) w *= gain[k0 + kk]; scr[kk * 33 + (lane & 31)] = w; }
    LDS_WAIT(); asm volatile("" ::: "memory");
    const int c = lane & 7;
#pragma unroll
    for (int j = 0; j < 4; ++j) { const int n = (lane >> 3) + 8 * j; const LAS float* s = scr + (8 * c) * 33 + n;
        u32x4 o; o.x = cvt_pk_bf16(s[0 * 33], s[1 * 33]); o.y = cvt_pk_bf16(s[2 * 33], s[3 * 33]); o.z = cvt_pk_bf16(s[4 * 33], s[5 * 33]); o.w = cvt_pk_bf16(s[6 * 33], s[7 * 33]);
        *(u32x4*)(WT + (size_t)dst_row<MODE>(n0 + n) * K + k0 + 8 * c) = o; }
    LDS_WAIT(); asm volatile("" ::: "memory");
}
template <int MODE>
__device__ __forceinline__ void transpose_job(Frame& F, const float* W, int K, int N, int nmat, size_t src_stride, bf16_t* WT, size_t dst_stride, const float* gain, int gain_stride) {
    int tid_ = threadIdx.x; asm volatile("" : "+v"(tid_));
    const int wave = __builtin_amdgcn_readfirstlane(tid_ >> 6), lane = tid_ & 63;
    LAS float* scr = (LAS float*)(F.lds + RING_OFF + wave * 16384);
    const int gw = F.vcu * NWAVES + wave, NGW = F.G * NWAVES;
    const int per = (K / 64) * (N / 32), total = per * nmat;
    for (int it = gw; it < total; it += NGW) { const int mi = it / per, item = it - mi * per;
        transpose_item<MODE>(W + (size_t)mi * src_stride, K, N, WT + (size_t)mi * dst_stride, gain ? gain + (size_t)mi * gain_stride : nullptr, scr, item, lane); }
}


__device__ __forceinline__ void tr8_load(f32x4 (&v)[16], const float* __restrict__ W, int N, int item, int lane) {
    const int nblk = N / 32, kb = item / nblk, nb = item % nblk, k0 = 128 * kb, n0 = 32 * nb;
#pragma unroll
    for (int i = 0; i < 16; ++i) v[i] = __builtin_nontemporal_load((const f32x4*)(W + (size_t)(k0 + 8 * i + (lane >> 3)) * N + n0 + 4 * (lane & 7)));
}
template <int MODE>
__device__ __forceinline__ void tr8_store(const f32x4 (&v)[16], int K, int N, unsigned char* __restrict__ WT, const float* __restrict__ gain, LAS unsigned char* scr, int item, int lane) {
    const int nblk = N / 32, kb = item / nblk, nb = item % nblk, k0 = 128 * kb, n0 = 32 * nb;
    constexpr int TP = 144;
#pragma unroll
    for (int i = 0; i < 16; ++i) { const int kl = 8 * i + (lane >> 3); const float sc = gain ? W8_SCALE * gain[k0 + kl] : W8_SCALE;
        const unsigned w = pk4_fp8(v[i].x * sc, v[i].y * sc, v[i].z * sc, v[i].w * sc); LAS unsigned char* d = scr + (4 * (lane & 7)) * TP + kl;
        d[0] = (unsigned char)w; d[TP] = (unsigned char)(w >> 8); d[2 * TP] = (unsigned char)(w >> 16); d[3 * TP] = (unsigned char)(w >> 24); }
    LDS_WAIT(); asm volatile("" ::: "memory");
#pragma unroll
    for (int m = 0; m < 4; ++m) { const int q = lane + 64 * m, n = q >> 3, kc = q & 7;
        const u32x4 o = *(const LAS u32x4*)(scr + n * TP + 16 * kc);
        __builtin_nontemporal_store(o, (u32x4*)(WT + (size_t)dst_row<MODE>(n0 + n) * K + k0 + 16 * kc)); }
    LDS_WAIT(); asm volatile("" ::: "memory");
}
template <int MODE>
__device__ __forceinline__ void transpose_job_fp8(Frame& F, const float* W, int K, int N, int nmat, size_t src_stride, unsigned char* WT, size_t dst_stride, const float* gain = nullptr, int gain_stride = 0) {
    int tid_ = threadIdx.x; asm volatile("" : "+v"(tid_));
    const int wave = __builtin_amdgcn_readfirstlane(tid_ >> 6), lane = tid_ & 63;
    LAS unsigned char* scr = F.lds + RING_OFF + wave * 16384;
    const int gw = F.vcu * NWAVES + wave, NGW = F.G * NWAVES;
    const int per = (K / 128) * (N / 32), total = per * nmat;
    f32x4 cur[16], nxt[16];
    int it = gw;
    if (it < total) { const int mi = it / per; tr8_load(cur, W + (size_t)mi * src_stride, N, it - mi * per, lane); }
    for (; it < total; it += NGW) {
        const int itn = it + NGW;
        if (itn < total) { const int mn = itn / per; tr8_load(nxt, W + (size_t)mn * src_stride, N, itn - mn * per, lane); }
        const int mi = it / per;
        tr8_store<MODE>(cur, K, N, WT + (size_t)mi * dst_stride, gain ? gain + (size_t)mi * gain_stride : nullptr, scr, it - mi * per, lane);
#pragma unroll
        for (int i = 0; i < 16; ++i) cur[i] = nxt[i];
    }
}

__device__ __forceinline__ void rms_row_to_fp8(int lane, const float* xrow, const float* g, unsigned char* orow, float* copy) {
    const f32x4* xr = (const f32x4*)xrow + lane; const f32x4* gr = (const f32x4*)g + lane;
    f32x4 v[4]; float s = 0.f;
#pragma unroll
    for (int j = 0; j < 4; ++j) { v[j] = xr[64 * j]; s += (v[j].x * v[j].x + v[j].y * v[j].y) + (v[j].z * v[j].z + v[j].w * v[j].w); }
    const float rstd = 1.0f / sqrtf(wave_sum(s) * (1.f / DM) + EPS);
    unsigned* o4 = (unsigned*)orow + lane;
#pragma unroll
    for (int j = 0; j < 4; ++j) { const f32x4 gg = gr[64 * j]; if (copy) ((f32x4*)copy + lane)[64 * j] = v[j];
        o4[64 * j] = pk4_fp8(v[j].x * rstd * gg.x, v[j].y * rstd * gg.y, v[j].z * rstd * gg.z, v[j].w * rstd * gg.w); }
}
__device__ __forceinline__ void rms_row_to_bf16(int lane, const float* xrow, const float* g, bf16_t* orow, float* copy) {
    const f32x4* xr = (const f32x4*)xrow + lane; const f32x4* gr = (const f32x4*)g + lane;
    f32x4 v[4]; float s = 0.f;
#pragma unroll
    for (int j = 0; j < 4; ++j) { v[j] = xr[64 * j]; s += (v[j].x * v[j].x + v[j].y * v[j].y) + (v[j].z * v[j].z + v[j].w * v[j].w); }
    const float rstd = 1.0f / sqrtf(wave_sum(s) * (1.f / DM) + EPS);
    u32x2* o8 = (u32x2*)orow + lane;
#pragma unroll
    for (int j = 0; j < 4; ++j) { const f32x4 gg = gr[64 * j]; if (copy) ((f32x4*)copy + lane)[64 * j] = v[j];
        u32x2 w; w.x = cvt_pk_bf16(v[j].x * rstd * gg.x, v[j].y * rstd * gg.y); w.y = cvt_pk_bf16(v[j].z * rstd * gg.z, v[j].w * rstd * gg.w); o8[64 * j] = w; }
}

namespace pg8 {
#ifdef E1F8
constexpr float E1_INV = W8_INV;
#else
constexpr float E1_INV = 1.0f;
#endif
struct EpiEvenIn {
    static constexpr bool PERM = false;
    bf16_t* Z; const float* gq; const float* gk;
    __device__ __forceinline__ void operator()(const f32x4 (&acc)[2][2][4][2], const Unit& u, int wr, int wc, int fr, int fq) const {
        const int row0 = u.pm * BM + wr * 64 + fr, pn = u.pn;
        if (pn >= 4 && pn < 8) {
            const float* g = pn < 6 ? gq : gk; const float sc = pn < 6 ? C2_B : 1.0f;
            f32x4 gv[2][2];
#pragma unroll
            for (int bj = 0; bj < 2; ++bj)
#pragma unroll
                for (int n = 0; n < 2; ++n) gv[bj][n] = *(const f32x4*)(g + 32 * bj + 16 * n + 4 * fq);
#pragma unroll
            for (int ai = 0; ai < 2; ++ai)
#pragma unroll
                for (int m = 0; m < 4; ++m) {
                    float ss = 0.f;
#pragma unroll
                    for (int bj = 0; bj < 2; ++bj)
#pragma unroll
                        for (int n = 0; n < 2; ++n) { const f32x4 v = acc[ai][bj][m][n] * E1_INV; ss += (v[0] * v[0] + v[1] * v[1]) + (v[2] * v[2] + v[3] * v[3]); }
                    ss += __shfl_xor(ss, 16); ss += __shfl_xor(ss, 32);
                    const float rstd = sc * E1_INV / sqrtf(ss * (1.0f / 64.0f) + EPS);
                    bf16_t* rowp = Z + (size_t)(row0 + ai * HALF + m * 16) * EVEN_IN + pn * BM + wc * 64 + 4 * fq;
#pragma unroll
                    for (int bj = 0; bj < 2; ++bj)
#pragma unroll
                        for (int n = 0; n < 2; ++n) { const f32x4 v = acc[ai][bj][m][n] * rstd * gv[bj][n];
                            u32x2 w; w.x = cvt_pk_bf16(v[0], v[1]); w.y = cvt_pk_bf16(v[2], v[3]); *(u32x2*)(rowp + 32 * bj + 16 * n) = w; }
                }
        } else {
            const bool act = pn < 4;
#pragma unroll
            for (int ai = 0; ai < 2; ++ai)
#pragma unroll
                for (int m = 0; m < 4; ++m) { bf16_t* rowp = Z + (size_t)(row0 + ai * HALF + m * 16) * EVEN_IN + pn * BM + wc * 32 + 4 * fq;
#pragma unroll
                    for (int bj = 0; bj < 2; ++bj)
#pragma unroll
                        for (int n = 0; n < 2; ++n) { f32x4 v = acc[ai][bj][m][n] * E1_INV; if (act) v = gelu4(v);
                            u32x2 w; w.x = cvt_pk_bf16(v[0], v[1]); w.y = cvt_pk_bf16(v[2], v[3]); *(u32x2*)(rowp + bj * HALF + 16 * n) = w; } }
        }
    }
};
template <bool F8 = false> struct EpiResidT {
    static constexpr bool PERM = false;
    const float* src32; bf16_t* X;
    __device__ __forceinline__ void operator()(const f32x4 (&acc)[2][2][4][2], const Unit& u, int wr, int wc, int fr, int fq) const {
        const int row0 = u.pm * BM + wr * 64 + fr;
#pragma unroll
        for (int ai = 0; ai < 2; ++ai)
#pragma unroll
            for (int m = 0; m < 4; ++m) { const size_t ro = (size_t)(row0 + ai * HALF + m * 16) * DM + u.pn * BM + wc * 32 + 4 * fq;
#pragma unroll
                for (int bj = 0; bj < 2; ++bj)
#pragma unroll
                    for (int n = 0; n < 2; ++n) { const size_t o_ = ro + bj * HALF + 16 * n; f32x4 b;
                        if (src32) b = *(const f32x4*)(src32 + o_); else { const u32x2 t = *(const u32x2*)(X + o_); b = (f32x4){bflo(t.x), bfhi(t.x), bflo(t.y), bfhi(t.y)}; }
                        const f32x4 r = b + (F8 ? acc[ai][bj][m][n] * W8_INV : acc[ai][bj][m][n]);
                        u32x2 w; w.x = cvt_pk_bf16(r[0], r[1]); w.y = cvt_pk_bf16(r[2], r[3]); *(u32x2*)(X + o_) = w; }
                if (m & 1) asm volatile("" ::: "memory"); }
    }
};
typedef EpiResidT<false> EpiResid;
struct EpiOddIn {
    static constexpr bool PERM = false;
    bf16_t* Z; unsigned char* Z8; float* ssq;
    __device__ __forceinline__ void operator()(const f32x4 (&acc)[2][2][4][2], const Unit& u, int wr, int wc, int fr, int fq) const {
        const int row0 = u.pm * BM + wr * 64 + fr, pn = u.pn;
#pragma unroll
        for (int ai = 0; ai < 2; ++ai)
#pragma unroll
            for (int m = 0; m < 4; ++m) { const int row = row0 + ai * HALF + m * 16; bf16_t* rowp = Z + (size_t)row * ODD_INP + pn * BM + wc * 32 + 4 * fq;
                float ss = 0.f;
#pragma unroll
                for (int bj = 0; bj < 2; ++bj)
#pragma unroll
                    for (int n = 0; n < 2; ++n) { const f32x4 v = acc[ai][bj][m][n] * W8_INV; ss += (v[0] * v[0] + v[1] * v[1]) + (v[2] * v[2] + v[3] * v[3]);
                        if (pn < 3) *(unsigned*)(Z8 + (size_t)row * ODD_INP + pn * BM + wc * 32 + 4 * fq + bj * HALF + 16 * n) = pk4_fp8(v[0], v[1], v[2], v[3]);
                        else { u32x2 w; w.x = cvt_pk_bf16(v[0], v[1]); w.y = cvt_pk_bf16(v[2], v[3]); *(u32x2*)(rowp + bj * HALF + 16 * n) = w; } }
                ss += __shfl_xor(ss, 16); ss += __shfl_xor(ss, 32);
                if (fq == 0) ssq[(size_t)row * 16 + pn * 4 + wc] = ss; }
    }
};
template <int NS> struct EpiRowScale {
    static constexpr bool PERM = true;
    unsigned char* O; int ldc; const float* ssq; int s0; float inv_cols;
    __device__ __forceinline__ void operator()(const f32x4 (&acc)[2][2][4][2], const Unit& u, int wr, int wc, int fr, int fq) const {
        const int row0 = u.pm * BM + wr * 64 + fr; const int col0 = u.pn * BM + wc * 32 + 8 * fq;
#pragma unroll
        for (int ai = 0; ai < 2; ++ai)
#pragma unroll
            for (int m = 0; m < 4; ++m) { const int row = row0 + ai * HALF + m * 16;
                float ss = 0.f; const f32x4* sp = (const f32x4*)(ssq + (size_t)row * 16 + s0);
#pragma unroll
                for (int q = 0; q < NS; ++q) { const f32x4 t = sp[q]; ss += (t[0] + t[1]) + (t[2] + t[3]); }
                const float rstd = W8_INV / sqrtf(ss * inv_cols + EPS);
                unsigned char* rowp = O + (size_t)row * ldc + col0;
#pragma unroll
                for (int bj = 0; bj < 2; ++bj) { const f32x4 v0 = acc[ai][bj][m][0] * rstd, v1 = acc[ai][bj][m][1] * rstd;
                    u32x2 w; w.x = pk4_fp8(v0[0], v0[1], v0[2], v0[3]); w.y = pk4_fp8(v1[0], v1[1], v1[2], v1[3]);
                    *(u32x2*)(rowp + bj * HALF) = w; }
                asm volatile("" ::: "memory"); }
    }
};
__device__ __forceinline__ void store8_sc1(void* p, u32x2 v) { asm volatile("global_store_dwordx2 %0, %1, off sc1" :: "v"(p), "v"(v) : "memory"); }
template <bool WT = false> struct EpiSwigluT {
    static constexpr bool PERM = true;
    unsigned char* ACT; const float* b1p;
    __device__ __forceinline__ void operator()(const f32x4 (&acc)[2][2][4][2], const Unit& u, int wr, int wc, int fr, int fq) const {
        const int row0 = u.pm * BM + wr * 64 + fr, e = u.pb >> 3, pn = u.pn;
        const float* bp = b1p + (size_t)e * 2048 + pn * BM + wc * 32 + 8 * fq;
        f32x4 bg[2], bl[2];
#pragma unroll
        for (int n = 0; n < 2; ++n) { bg[n] = *(const f32x4*)(bp + 4 * n); bl[n] = *(const f32x4*)(bp + HALF + 4 * n) + 1.0f; }
#pragma unroll
        for (int ai = 0; ai < 2; ++ai)
#pragma unroll
            for (int m = 0; m < 4; ++m) { unsigned char* rowp = ACT + (size_t)(row0 + ai * HALF + m * 16) * DE + pn * HALF + wc * 32 + 8 * fq;
                float a[8];
#pragma unroll
                for (int n = 0; n < 2; ++n) { const f32x4 gv = acc[ai][0][m][n] * W8_INV + bg[n], lv = acc[ai][1][m][n] * W8_INV + bl[n];
#pragma unroll
                    for (int i = 0; i < 4; ++i) { const float gl = fminf(gv[i], 7.0f), li1 = __builtin_amdgcn_fmed3f(lv[i], -6.0f, 8.0f);
                        const float sg = __builtin_amdgcn_rcpf(1.0f + __builtin_amdgcn_exp2f(-1.702f * LOG2E * gl));
                        a[4 * n + i] = gl * sg * li1; } }
                u32x2 w; w.x = pk4_fp8(a[0], a[1], a[2], a[3]); w.y = pk4_fp8(a[4], a[5], a[6], a[7]);
                if (WT) store8_sc1(rowp, w); else *(u32x2*)rowp = w; }
    }
};
typedef EpiSwigluT<false> EpiSwiglu;
struct EpiDown {
    static constexpr bool PERM = true;
    bf16_t* Y; const float* b2;
    __device__ __forceinline__ void operator()(const f32x4 (&acc)[2][2][4][2], const Unit& u, int wr, int wc, int fr, int fq) const {
        const int row0 = u.pm * BM + wr * 64 + fr, e = u.pb >> 2, pn = u.pn;
        const float* bp = b2 + (size_t)e * DM + pn * BM + wc * 32 + 8 * fq;
        f32x4 bv[2][2];
#pragma unroll
        for (int bj = 0; bj < 2; ++bj)
#pragma unroll
            for (int n = 0; n < 2; ++n) bv[bj][n] = *(const f32x4*)(bp + bj * HALF + 4 * n);
#pragma unroll
        for (int ai = 0; ai < 2; ++ai)
#pragma unroll
            for (int m = 0; m < 4; ++m) {
#ifdef Y8
                unsigned char* rowp = (unsigned char*)Y + (size_t)(row0 + ai * HALF + m * 16) * DM + pn * BM + wc * 32 + 8 * fq;
#pragma unroll
                for (int bj = 0; bj < 2; ++bj) { const f32x4 v0 = (acc[ai][bj][m][0] * W8_INV + bv[bj][0]) * Y8_SCALE, v1 = (acc[ai][bj][m][1] * W8_INV + bv[bj][1]) * Y8_SCALE;
                    u32x2 w; w.x = pk4_fp8(v0[0], v0[1], v0[2], v0[3]); w.y = pk4_fp8(v1[0], v1[1], v1[2], v1[3]);
                    *(u32x2*)(rowp + bj * HALF) = w; }
#else
                bf16_t* rowp = Y + (size_t)(row0 + ai * HALF + m * 16) * DM + pn * BM + wc * 32 + 8 * fq;
#pragma unroll
                for (int bj = 0; bj < 2; ++bj) { const f32x4 v0 = acc[ai][bj][m][0] * W8_INV + bv[bj][0], v1 = acc[ai][bj][m][1] * W8_INV + bv[bj][1];
                    u32x4 w; w.x = cvt_pk_bf16(v0[0], v0[1]); w.y = cvt_pk_bf16(v0[2], v0[3]); w.z = cvt_pk_bf16(v1[0], v1[1]); w.w = cvt_pk_bf16(v1[2], v1[3]);
                    *(u32x4*)(rowp + bj * HALF) = w; }
#endif
            }
    }
};
struct MoeOrder {
    static constexpr bool GATHER = false;
    const LAS int* tbl; int nN, G, c;
    __device__ bool next(int i, Unit& u) const {
        const long L = (long)i * G + c; const int rb = (int)(L / nN);
        if (rb >= __builtin_amdgcn_readfirstlane(tbl[32])) return false;
        int e = 0;
#pragma unroll
        for (int k = 1; k < 32; ++k) e += (tbl[k] <= rb) ? 1 : 0;
        e = __builtin_amdgcn_readfirstlane(e); const int rbl = __builtin_amdgcn_readfirstlane(rb - tbl[e]);
        u.pm = e * (ECAP / BM) + rbl; u.pn = (int)(L % nN); u.pb = e * nN + u.pn; u.kind = 0; u.rb = rb; return true;
    }
    __device__ __forceinline__ void a_ready(const Unit&) const {}
    __device__ __forceinline__ void peek(const Unit&) const {}
    __device__ __forceinline__ void early_acquire(const Unit&) const {}
    __device__ __forceinline__ void pre_epi() const {}
    __device__ __forceinline__ void done(const Unit&) const {}
    __device__ __forceinline__ void finish() const {}
};

constexpr unsigned MOE_SPIN_CAP = 1u << 22;
struct MoeMergedOrder {
    static constexpr bool GATHER = true;
    const LAS int* tbl; int G, c; gu32* cnt;
    mutable int pend;
    const unsigned* slot2tok; const LAS unsigned* tokt;
    mutable int acq; const LAS unsigned* peekw;
    __device__ __forceinline__ void peek(const Unit& u) const {
        acq = 0;
        if (u.kind == 1 && __builtin_amdgcn_readfirstlane((int)(threadIdx.x >> 6)) == 0)
            __builtin_amdgcn_global_load_lds((const unsigned*)(cnt + 16 * u.rb), (LAS unsigned*)peekw, 4, 0, 16);
    }
    __device__ __forceinline__ void early_acquire(const Unit& u) const {
        if (u.kind == 1 && __builtin_amdgcn_readfirstlane((int)(threadIdx.x >> 6)) == 0) {
            const unsigned v = (unsigned)__builtin_amdgcn_readfirstlane((int)peekw[0]);
            if (v >= 64u) { asm volatile("buffer_inv sc1" ::: "memory"); acq = 1; }
        }
    }
    __device__ __forceinline__ void flush() const {
        if (pend >= 0) { asm volatile("s_waitcnt vmcnt(0)" ::: "memory");
            if ((threadIdx.x & 63) == 0) __hip_atomic_fetch_add(cnt + 16 * pend, 1u, __ATOMIC_RELAXED, __HIP_MEMORY_SCOPE_AGENT);
            pend = -1; } }
    __device__ bool next(int i, Unit& u) const {
        const int nb = __builtin_amdgcn_readfirstlane(tbl[32]);
        long L = (long)i * G + c; int nN = 8, kind = 0;
        if (L >= (long)nb * 8) { L -= (long)nb * 8; nN = 4; kind = 1; if (L >= (long)nb * 4) return false; }
        const int rb = (int)(L / nN);
        int e = 0;
#pragma unroll
        for (int k = 1; k < 32; ++k) e += (tbl[k] <= rb) ? 1 : 0;
        e = __builtin_amdgcn_readfirstlane(e); const int rbl = __builtin_amdgcn_readfirstlane(rb - tbl[e]);
        u.pm = e * (ECAP / BM) + rbl; u.pn = (int)(L % nN); u.pb = e * nN + u.pn; u.kind = kind; u.rb = rb; return true;
    }
    __device__ __forceinline__ void a_ready(const Unit& u) const {
        if (u.kind == 1) {
            flush();
            if (__builtin_amdgcn_readfirstlane((int)(threadIdx.x >> 6)) == 0 && acq == 0) {
                unsigned sp = 0;
                while ((unsigned)__builtin_amdgcn_readfirstlane(__hip_atomic_load(cnt + 16 * u.rb, __ATOMIC_RELAXED, __HIP_MEMORY_SCOPE_AGENT)) < 64u) { __builtin_amdgcn_s_sleep(2); if (++sp > MOE_SPIN_CAP) break; }
                __builtin_amdgcn_fence(__ATOMIC_ACQUIRE, "agent");
                asm volatile("s_waitcnt vmcnt(0)" ::: "memory");
            }
            __builtin_amdgcn_s_barrier();
        }
    }
    __device__ __forceinline__ void pre_epi() const { flush(); }
    __device__ __forceinline__ void done(const Unit& u) const { if (u.kind == 0) pend = u.rb; }
    __device__ __forceinline__ void finish() const { flush(); }
};
struct EpiMoe {
    static constexpr bool PERM = true;
    EpiSwigluT<true> up; EpiDown down;
    __device__ __forceinline__ void operator()(const f32x4 (&acc)[2][2][4][2], const Unit& u, int wr, int wc, int fr, int fq) const {
        if (u.kind == 0) up(acc, u, wr, wc, fr, fq); else down(acc, u, wr, wc, fr, fq);
    }
};
}

__device__ __forceinline__ void gmlp_unit(Frame& F, const bf16_t* Z, bf16_t* MIX, const float* Ws, const float* bs, const float* gv, int unit) {
    constexpr int VP = 272;
    LAS unsigned char* VT = F.lds + RING_OFF;
    const int h = unit & 3, chunk = unit >> 2;
    int tid_ = threadIdx.x; asm volatile("" : "+v"(tid_));
    const int t0 = chunk * 128, tid = tid_, lane = tid & 63, w = __builtin_amdgcn_readfirstlane(tid >> 6);
    {
        const int s = tid >> 2, dq = (tid & 3) * 32;
        const bf16_t* vp = Z + (size_t)(t0 + s) * EVEN_IN + 512 + h * 128 + dq;
        u32x4 raw[4]; float ss = 0.f;
#pragma unroll
        for (int i = 0; i < 4; ++i) { raw[i] = *(const u32x4*)(vp + 8 * i);
#pragma unroll
            for (int j = 0; j < 4; ++j) { const float a = bflo(raw[i][j]), b = bfhi(raw[i][j]); ss += a * a + b * b; } }
        ss += __shfl_xor(ss, 1); ss += __shfl_xor(ss, 2);
        const float rstd = 1.0f / sqrtf(ss * (1.0f / 128.0f) + EPS);
#pragma unroll
        for (int i = 0; i < 4; ++i)
#pragma unroll
            for (int j = 0; j < 4; ++j) { const int d = dq + 8 * i + 2 * j;
                *(LAS bf16_t*)(VT + (d) * VP + s * 2) = f2bf(bflo(raw[i][j]) * rstd);
                *(LAS bf16_t*)(VT + (d + 1) * VP + s * 2) = f2bf(bfhi(raw[i][j]) * rstd); }
    }
    __syncthreads();
    const int fr = lane & 15, fq = lane >> 4;
    f32x4 acc[8];
#pragma unroll
    for (int nb = 0; nb < 8; ++nb) acc[nb] = (f32x4){0.f, 0.f, 0.f, 0.f};
    const int trow = 16 * w + fr;
    const float* wrow = Ws + ((size_t)h * 128 + trow) * 128;
#pragma unroll
    for (int ks = 0; ks < 4; ++ks) {
        if (32 * ks <= 16 * w + 15) {
            const int s0 = 32 * ks + 8 * fq;
            const f32x4 wa = *(const f32x4*)(wrow + s0), wb = *(const f32x4*)(wrow + s0 + 4);
            float wv[8] = {wa[0], wa[1], wa[2], wa[3], wb[0], wb[1], wb[2], wb[3]};
#pragma unroll
            for (int j = 0; j < 8; ++j) if (s0 + j > trow) wv[j] = 0.f;
            u32x4 aw; aw.x = cvt_pk_bf16(wv[0], wv[1]); aw.y = cvt_pk_bf16(wv[2], wv[3]); aw.z = cvt_pk_bf16(wv[4], wv[5]); aw.w = cvt_pk_bf16(wv[6], wv[7]);
            const bf16x8 af = __builtin_bit_cast(bf16x8, aw);
#pragma unroll
            for (int nb = 0; nb < 8; ++nb) { const bf16x8 bfr = *(const LAS bf16x8*)(VT + (16 * nb + fr) * VP + s0 * 2);
                acc[nb] = __builtin_amdgcn_mfma_f32_16x16x32_bf16(af, bfr, acc[nb], 0, 0, 0); }
        }
    }
    LAS bf16_t* DT = (LAS bf16_t*)(F.lds + RING_OFF + 36864);
#pragma unroll
    for (int i = 0; i < 4; ++i) { const int tl = 16 * w + 4 * fq + i; const float bt = bs[h * 128 + tl];
#pragma unroll
        for (int nb = 0; nb < 8; ++nb) DT[tl * 136 + 16 * nb + fr] = f2bf(gv[h * 128 + 16 * nb + fr] * acc[nb][i] + bt); }
    __syncthreads();
#pragma unroll
    for (int k = 0; k < 4; ++k) { const int idx = tid + 512 * k, tl = idx >> 4, c8 = (idx & 15) * 8;
        const u32x4 mv = *(const LAS u32x4*)(DT + tl * 136 + c8); const u32x4 uv = *(const u32x4*)(Z + (size_t)(t0 + tl) * EVEN_IN + h * 128 + c8);
        u32x4 o; o.x = cvt_pk_bf16(bflo(uv.x) * bflo(mv.x), bfhi(uv.x) * bfhi(mv.x)); o.y = cvt_pk_bf16(bflo(uv.y) * bflo(mv.y), bfhi(uv.y) * bfhi(mv.y));
        o.z = cvt_pk_bf16(bflo(uv.z) * bflo(mv.z), bfhi(uv.z) * bfhi(mv.z)); o.w = cvt_pk_bf16(bflo(uv.w) * bflo(mv.w), bfhi(uv.w) * bfhi(mv.w));
        *(u32x4*)(MIX + (size_t)(t0 + tl) * DM + h * 128 + c8) = o; }
    __syncthreads();
}

__device__ __forceinline__ void router_phase(Frame& F, const bf16_t* x, const float* gain, const float* Wr, const float* br, gu32* cnt  ,
                                             unsigned* tok_er, float* tok_g, unsigned char* XN8, unsigned* slot2tok) {
    LAS float* part = (LAS float*)(F.lds + RING_OFF);
    LAS float* ssqp = (LAS float*)(F.lds + RING_OFF + 8 * 64 * 33 * 4);
    LAS float* lg = (LAS float*)(F.lds + SCR_OFF);
    LAS unsigned* hist = (LAS unsigned*)(F.lds + SCR_OFF + 64 * 33 * 4);
    LAS unsigned* base = hist + 32;
    LAS unsigned* ers = base + 32;
    int tid_ = threadIdx.x; asm volatile("" : "+v"(tid_));
    const int tid = tid_, lane = tid & 63, w = __builtin_amdgcn_readfirstlane(tid >> 6), r32 = lane & 31, hi = lane >> 5;
#ifndef RTR_REP_A
#define RTR_REP_A 1
#define RTR_REP_B 1
#define RTR_REP_C 1
#endif
    f32x4 gg[4];
#pragma unroll
    for (int j = 0; j < 4; ++j) gg[j] = ((const f32x4*)gain)[4 * lane + j];
    {   const int tg = F.vcu;
    const int tokb = tg * 64;
    if (tid < 32) hist[tid] = 0u;
    for (int rb_ = 0; rb_ < RTR_REP_B; ++rb_) {
        bf16x8 wh[8], wl[8];
#pragma unroll
        for (int ks = 0; ks < 8; ++ks) { float wv[8];
#pragma unroll
            for (int j = 0; j < 8; ++j) { const int k = 128 * w + 16 * ks + 8 * hi + j; wv[j] = Wr[(size_t)k * NE + r32] * gain[k]; }
            u32x4 h4, l4;
#pragma unroll
            for (int j = 0; j < 4; ++j) { const unsigned hp = cvt_pk_bf16(wv[2 * j], wv[2 * j + 1]); h4[j] = hp; l4[j] = cvt_pk_bf16(wv[2 * j] - bflo(hp), wv[2 * j + 1] - bfhi(hp)); }
            wh[ks] = __builtin_bit_cast(bf16x8, h4); wl[ks] = __builtin_bit_cast(bf16x8, l4); }
#pragma unroll
        for (int g2 = 0; g2 < 2; ++g2) {
            const bf16_t* xr = x + (size_t)(tokb + 32 * g2 + r32) * DM + 128 * w + 8 * hi;
            f32x16 d = f32x16{}; float ss = 0.f;
#pragma unroll
            for (int ks = 0; ks < 8; ++ks) { const u32x4 xw = *(const u32x4*)(xr + 16 * ks);
#pragma unroll
                for (int j = 0; j < 4; ++j) { const float a = bflo(xw[j]), b = bfhi(xw[j]); ss += a * a + b * b; }
                const bf16x8 xh = __builtin_bit_cast(bf16x8, xw);
                d = __builtin_amdgcn_mfma_f32_32x32x16_bf16(wh[ks], xh, d, 0, 0, 0);
                d = __builtin_amdgcn_mfma_f32_32x32x16_bf16(wl[ks], xh, d, 0, 0, 0); }
            { auto rr = __builtin_amdgcn_permlane32_swap(__float_as_uint(ss), __float_as_uint(ss), false, false); ss = __uint_as_float(rr[0]) + __uint_as_float(rr[1]); }
            if (hi == 0) ssqp[w * 64 + 32 * g2 + r32] = ss;
#pragma unroll
            for (int r = 0; r < 16; ++r) part[(w * 64 + 32 * g2 + r32) * 33 + (r & 3) + 8 * (r >> 2) + 4 * hi] = d[r];
        }
    }
    __syncthreads();
    {   const int t = tid >> 3, q4 = (tid & 7) * 4; float s = 0.f;
#pragma unroll
        for (int ww = 0; ww < 8; ++ww) s += ssqp[ww * 64 + t];
        const float rstd = 1.0f / sqrtf(s * (1.f / DM) + EPS);
#pragma unroll
        for (int i = 0; i < 4; ++i) { float a = 0.f;
#pragma unroll
            for (int ww = 0; ww < 8; ++ww) a += part[(ww * 64 + t) * 33 + q4 + i];
            lg[t * 33 + q4 + i] = a * rstd + br[q4 + i]; } }
    __syncthreads();
    unsigned my_e[4] = {0, 0, 0, 0}, my_lr[4] = {0, 0, 0, 0}; float my_g[4] = {0, 0, 0, 0};
    if (tid < 64) {
        float v[32];
#pragma unroll
        for (int e = 0; e < 32; ++e) v[e] = lg[tid * 33 + e];
        int c0 = -1, c1 = -1, c2 = -1; float tv[4];
#pragma unroll
        for (int r = 0; r < 4; ++r) { float best = -__builtin_inff(); int bi = 0;
#pragma unroll
            for (int e = 0; e < 32; ++e) { const bool ok = (e != c0) && (e != c1) && (e != c2); if (ok && v[e] > best) { best = v[e]; bi = e; } }
            tv[r] = best; my_e[r] = (unsigned)bi; if (r == 0) c0 = bi; else if (r == 1) c1 = bi; else if (r == 2) c2 = bi; }
        const float p1 = __expf(tv[1] - tv[0]), p2 = __expf(tv[2] - tv[0]), p3 = __expf(tv[3] - tv[0]); const float inv = 1.0f / (1.0f + p1 + p2 + p3);
        my_g[0] = inv; my_g[1] = p1 * inv; my_g[2] = p2 * inv; my_g[3] = p3 * inv;
#pragma unroll
        for (int r = 0; r < 4; ++r) my_lr[r] = __hip_atomic_fetch_add(hist + my_e[r], 1u, __ATOMIC_RELAXED, __HIP_MEMORY_SCOPE_WORKGROUP);
    }
    __syncthreads();
    if (tid < 32) { const unsigned hc = hist[tid]; base[tid] = hc ? __hip_atomic_fetch_add(cnt + 64 * tid, hc, RLX_AGENT) : 0u; }
    __syncthreads();
    if (tid < 64) {
        u32x4 er; f32x4 gt;
#pragma unroll
        for (int r = 0; r < 4; ++r) { const unsigned rank = base[my_e[r]] + my_lr[r]; er[r] = (my_e[r] << 16) | rank; gt[r] = my_g[r]; ers[tid * 4 + r] = er[r]; }
        *(u32x4*)(tok_er + (size_t)(tokb + tid) * 4) = er; *(f32x4*)(tok_g + (size_t)(tokb + tid) * 4) = gt;
    }
    __syncthreads();
    for (int rc_ = 0; rc_ < RTR_REP_C; ++rc_)
#pragma unroll 2
    for (int tt = 0; tt < 8; ++tt) {
        const int tl = w * 8 + tt; const bf16_t* xrow = x + (size_t)(tokb + tl) * DM;
        f32x4 hv[4]; float s = 0.f;
        {   const u32x4 t0 = ((const u32x4*)xrow)[2 * lane], t1 = ((const u32x4*)xrow)[2 * lane + 1];
            hv[0] = (f32x4){bflo(t0.x), bfhi(t0.x), bflo(t0.y), bfhi(t0.y)}; hv[1] = (f32x4){bflo(t0.z), bfhi(t0.z), bflo(t0.w), bfhi(t0.w)};
            hv[2] = (f32x4){bflo(t1.x), bfhi(t1.x), bflo(t1.y), bfhi(t1.y)}; hv[3] = (f32x4){bflo(t1.z), bfhi(t1.z), bflo(t1.w), bfhi(t1.w)}; }
#pragma unroll
        for (int j = 0; j < 4; ++j) s += (hv[j].x * hv[j].x + hv[j].y * hv[j].y) + (hv[j].z * hv[j].z + hv[j].w * hv[j].w);
        const float rstd = 1.0f / sqrtf(wave_sum(s) * (1.f / DM) + EPS);
        u32x4 wv;
#pragma unroll
        for (int j = 0; j < 4; ++j) { const f32x4 t = hv[j] * rstd * gg[j]; wv[j] = pk4_fp8(t.x, t.y, t.z, t.w); }
        ((u32x4*)(XN8 + (size_t)(tokb + tl) * DM))[lane] = wv;
        if (lane < 4) { const unsigned er = ers[tl * 4 + lane]; slot2tok[(size_t)(er >> 16) * ECAP + (er & 0xffffu)] = (unsigned)(tokb + tl); }
    }
    __syncthreads();
    }
}

__device__ __forceinline__ void combine_phase(Frame& F, bf16_t* x, float* out32  , const unsigned* tok_er, const float* tok_g, const bf16_t* Y, const float* g_next, unsigned char* XN, bool xn_fp8) {
    int tid_ = threadIdx.x; asm volatile("" : "+v"(tid_));
    const int gw = F.vcu * NWAVES + __builtin_amdgcn_readfirstlane(tid_ >> 6), NGW = F.G * NWAVES, lane = tid_ & 63;
    u32x4 erA, erB, erAn, erBn; f32x4 gtA, gtB, gtAn, gtBn;
    { const int ma = gw < M ? gw : 0, mb0 = gw + NGW < M ? gw + NGW : ma;
      erAn = *(const u32x4*)(tok_er + (size_t)ma * 4); erBn = *(const u32x4*)(tok_er + (size_t)mb0 * 4); gtAn = *(const f32x4*)(tok_g + (size_t)ma * 4); gtBn = *(const f32x4*)(tok_g + (size_t)mb0 * 4); }
    for (int m0 = gw; m0 < M; m0 += 2 * NGW) {
        const int m1 = m0 + NGW; const bool two = m1 < M; const int mb = two ? m1 : m0;
        erA = erAn; erB = erBn; gtA = gtAn; gtB = gtBn;
        { const int na = m0 + 2 * NGW < M ? m0 + 2 * NGW : m0, nb2 = m0 + 3 * NGW < M ? m0 + 3 * NGW : na;
          erAn = *(const u32x4*)(tok_er + (size_t)na * 4); erBn = *(const u32x4*)(tok_er + (size_t)nb2 * 4); gtAn = *(const f32x4*)(tok_g + (size_t)na * 4); gtBn = *(const f32x4*)(tok_g + (size_t)nb2 * 4); }
        bf16_t* xrA = x + (size_t)m0 * DM; bf16_t* xrB = x + (size_t)mb * DM;
        u32x4 xa[2], xb[2]; u32x2 ya[4][2], yb[4][2];
#pragma unroll
        for (int j = 0; j < 2; ++j) { xa[j] = ((const u32x4*)xrA)[64 * j + lane]; xb[j] = ((const u32x4*)xrB)[64 * j + lane]; }
#pragma unroll
        for (int r = 0; r < 4; ++r) { const size_t sA = (size_t)(erA[r] >> 16) * ECAP + (erA[r] & 0xffffu), sB = (size_t)(erB[r] >> 16) * ECAP + (erB[r] & 0xffffu);
#pragma unroll
            for (int j = 0; j < 2; ++j) { ya[r][j] = ((const u32x2*)((const unsigned char*)Y + sA * DM))[64 * j + lane]; yb[r][j] = ((const u32x2*)((const unsigned char*)Y + sB * DM))[64 * j + lane]; } }
#pragma unroll
        for (int t = 0; t < 2; ++t) {
            if (t == 1 && !two) break;
            const int m = t ? m1 : m0; bf16_t* xrow = t ? xrB : xrA; const f32x4 gt = t ? gtB : gtA;
            float v[16];
#pragma unroll
            for (int j = 0; j < 2; ++j) { const u32x4 q = t ? xb[j] : xa[j];
#pragma unroll
                for (int i = 0; i < 4; ++i) { v[8 * j + 2 * i] = bflo(q[i]); v[8 * j + 2 * i + 1] = bfhi(q[i]); } }
#pragma unroll
            for (int r = 0; r < 4; ++r) { const float g = gt[r] * Y8_INV;
#pragma unroll
                for (int j = 0; j < 2; ++j) { const u32x2 yv = t ? yb[r][j] : ya[r][j];
#pragma unroll
                    for (int i = 0; i < 2; ++i) { const auto lo2 = __builtin_amdgcn_cvt_pk_f32_fp8((int)yv[i], false), hi2 = __builtin_amdgcn_cvt_pk_f32_fp8((int)yv[i], true);
                        v[8 * j + 4 * i] += g * lo2[0]; v[8 * j + 4 * i + 1] += g * lo2[1]; v[8 * j + 4 * i + 2] += g * hi2[0]; v[8 * j + 4 * i + 3] += g * hi2[1]; } } }
            if (out32) {
#pragma unroll
                for (int j = 0; j < 2; ++j)
#pragma unroll
                    for (int h = 0; h < 2; ++h) ((f32x4*)(out32 + (size_t)m * DM))[128 * j + 2 * lane + h] = (f32x4){v[8 * j + 4 * h], v[8 * j + 4 * h + 1], v[8 * j + 4 * h + 2], v[8 * j + 4 * h + 3]};
            } else {
#pragma unroll
                for (int j = 0; j < 2; ++j) { u32x4 q;
#pragma unroll
                    for (int i = 0; i < 4; ++i) q[i] = cvt_pk_bf16(v[8 * j + 2 * i], v[8 * j + 2 * i + 1]);
                    ((u32x4*)xrow)[64 * j + lane] = q; } }
            if (g_next) {
                float s = 0.f;
#pragma unroll
                for (int i = 0; i < 16; ++i) s += v[i] * v[i];
                const float rstd = 1.0f / sqrtf(wave_sum(s) * (1.f / DM) + EPS);
                float w[16];
#pragma unroll
                for (int j = 0; j < 2; ++j)
#pragma unroll
                    for (int h = 0; h < 2; ++h) { const f32x4 gg = ((const f32x4*)g_next)[128 * j + 2 * lane + h];
#pragma unroll
                        for (int i = 0; i < 4; ++i) w[8 * j + 4 * h + i] = v[8 * j + 4 * h + i] * rstd * gg[i]; }
                if (xn_fp8) {
#pragma unroll
                    for (int j = 0; j < 2; ++j) { u32x2 q; q.x = pk4_fp8(w[8 * j], w[8 * j + 1], w[8 * j + 2], w[8 * j + 3]); q.y = pk4_fp8(w[8 * j + 4], w[8 * j + 5], w[8 * j + 6], w[8 * j + 7]);
                        ((u32x2*)(XN + (size_t)m * DM))[64 * j + lane] = q; }
                } else {
#pragma unroll
                    for (int j = 0; j < 2; ++j) { u32x4 q;
#pragma unroll
                        for (int i = 0; i < 4; ++i) q[i] = cvt_pk_bf16(w[8 * j + 2 * i], w[8 * j + 2 * i + 1]);
                        ((u32x4*)(XN + (size_t)m * DM * 2))[64 * j + lane] = q; } }
            }
        }
    }
}

__device__ __forceinline__ void unpack8f8(const u32x2 w, float (&f)[8]) { const f32x2 a = __builtin_amdgcn_cvt_pk_f32_fp8((int)w.x, false), b = __builtin_amdgcn_cvt_pk_f32_fp8((int)w.x, true),
    c = __builtin_amdgcn_cvt_pk_f32_fp8((int)w.y, false), d = __builtin_amdgcn_cvt_pk_f32_fp8((int)w.y, true); f[0] = a.x; f[1] = a.y; f[2] = b.x; f[3] = b.y; f[4] = c.x; f[5] = c.y; f[6] = d.x; f[7] = d.y; }
__device__ __forceinline__ void unpack4f8(const unsigned w, float (&f)[4]) { const f32x2 a = __builtin_amdgcn_cvt_pk_f32_fp8((int)w, false), b = __builtin_amdgcn_cvt_pk_f32_fp8((int)w, true); f[0] = a.x; f[1] = a.y; f[2] = b.x; f[3] = b.y; }
__device__ __forceinline__ void unpack8(const u32x4 w, float (&f)[8]) { f[0] = bflo(w.x); f[1] = bfhi(w.x); f[2] = bflo(w.y); f[3] = bfhi(w.y); f[4] = bflo(w.z); f[5] = bfhi(w.z); f[6] = bflo(w.w); f[7] = bfhi(w.w); }
__device__ __forceinline__ void unpack4(const u32x2 w, float (&f)[4]) { f[0] = bflo(w.x); f[1] = bfhi(w.x); f[2] = bflo(w.y); f[3] = bfhi(w.y); }
__device__ __forceinline__ void fin_head(const float (&a)[8], const float (&b)[8], const float (&x1)[4], const float (&x2)[4], const float (&g)[24], const float (&cs)[4], const float (&sn)[4], unsigned char* op, int j, float scale) {
    float ss = 0.f;
#pragma unroll
    for (int i = 0; i < 8; ++i) ss += a[i] * a[i] + b[i] * b[i];
#pragma unroll
    for (int i = 0; i < 4; ++i) ss += x1[i] * x1[i] + x2[i] * x2[i];
    ss += __shfl_xor(ss, 1); ss += __shfl_xor(ss, 2); ss += __shfl_xor(ss, 4);
    const float rstd = scale / sqrtf(ss * (1.0f / 192.0f) + EPS);
    u32x4 o0;
    o0.x = pk4_fp8(a[0] * rstd * g[0], a[1] * rstd * g[1], a[2] * rstd * g[2], a[3] * rstd * g[3]); o0.y = pk4_fp8(a[4] * rstd * g[4], a[5] * rstd * g[5], a[6] * rstd * g[6], a[7] * rstd * g[7]);
    o0.z = pk4_fp8(b[0] * rstd * g[8], b[1] * rstd * g[9], b[2] * rstd * g[10], b[3] * rstd * g[11]); o0.w = pk4_fp8(b[4] * rstd * g[12], b[5] * rstd * g[13], b[6] * rstd * g[14], b[7] * rstd * g[15]);
    float y1[4], y2[4];
#pragma unroll
    for (int i = 0; i < 4; ++i) { const float u = x1[i] * rstd * g[16 + i], v = x2[i] * rstd * g[20 + i]; y1[i] = u * cs[i] - v * sn[i]; y2[i] = u * sn[i] + v * cs[i]; }
    *(u32x4*)(op + 16 * j) = o0; *(unsigned*)(op + 128 + 4 * j) = pk4_fp8(y1[0], y1[1], y1[2], y1[3]); *(unsigned*)(op + 160 + 4 * j) = pk4_fp8(y2[0], y2[1], y2[2], y2[3]);
}
__device__ __forceinline__ void mla_finalize_phase(Frame& F, const unsigned char* QR, const unsigned char* KVR, const bf16_t* Z, const float* gq, const float* gk, unsigned char* QF, unsigned char* KF) {
    int tid_ = threadIdx.x; asm volatile("" : "+v"(tid_));
    const int gw = F.vcu * NWAVES + __builtin_amdgcn_readfirstlane(tid_ >> 6), NGW = F.G * NWAVES, lane = tid_ & 63;
    const int h = lane >> 3, j = lane & 7;
    float gqv[24], gkv[24], invf[4];
#pragma unroll
    for (int i = 0; i < 16; ++i) { gqv[i] = gq[16 * j + i]; gkv[i] = gk[16 * j + i]; }
#pragma unroll
    for (int i = 0; i < 4; ++i) { gqv[16 + i] = gq[128 + 4 * j + i]; gqv[20 + i] = gq[160 + 4 * j + i]; gkv[16 + i] = gk[128 + 4 * j + i]; gkv[20 + i] = gk[160 + 4 * j + i];
        invf[i] = __builtin_amdgcn_exp2f(-(float)(4 * j + i) * (13.287712379549449f / 32.0f)); }
#pragma unroll 2
    for (int m = gw; m < M; m += NGW) {
        const int pos = m & (SEQ - 1);
        float cs[4], sn[4];
#pragma unroll
        for (int i = 0; i < 4; ++i) { const double rev = (double)pos * (double)invf[i] * 0.15915494309189535; const float fr = (float)(rev - __builtin_rint(rev));
            sn[i] = __builtin_amdgcn_sinf(fr); cs[i] = __builtin_amdgcn_cosf(fr); }
        const unsigned char* qp = QR + (size_t)m * 1536 + h * 192; const unsigned char* kp = KVR + (size_t)m * 2048 + h * 256; const bf16_t* zp = Z + (size_t)m * ODD_INP + 768;
        const u32x4 qn = *(const u32x4*)(qp + 16 * j); const unsigned qr1 = *(const unsigned*)(qp + 128 + 4 * j), qr2 = *(const unsigned*)(qp + 160 + 4 * j);
        const u32x4 kn = *(const u32x4*)(kp + 16 * j); const u32x2 kr1 = *(const u32x2*)(zp + 4 * j), kr2 = *(const u32x2*)(zp + 32 + 4 * j);
        float a[8], b[8], x1[4], x2[4];
        unpack8f8((u32x2){qn.x, qn.y}, a); unpack8f8((u32x2){qn.z, qn.w}, b); unpack4f8(qr1, x1); unpack4f8(qr2, x2);
        fin_head(a, b, x1, x2, gqv, cs, sn, QF + (size_t)m * 1536 + h * 192, j, 8.0f * C2_C);
        unpack8f8((u32x2){kn.x, kn.y}, a); unpack8f8((u32x2){kn.z, kn.w}, b); unpack4(kr1, x1); unpack4(kr2, x2);
        fin_head(a, b, x1, x2, gkv, cs, sn, KF + (size_t)m * 1536 + h * 192, j, 1.0f);
    }
}

__device__ __forceinline__ void vt_phase(Frame& F, const unsigned char* KVR, unsigned char* VT8) {
    int tid_ = threadIdx.x; asm volatile("" : "+v"(tid_));
    const int tid = tid_;
    LAS unsigned char* T = F.lds + RING_OFF;
    for (int it = F.vcu; it < M / 64; it += F.G) {
        const int m0 = it * 64, b = m0 / SEQ, tok0 = m0 % SEQ;
#pragma unroll 4
        for (int k = 0; k < 8; ++k) { const int tok = 8 * k + (tid & 7), h = tid >> 6, d16 = ((tid >> 3) & 7) * 16;
            const u32x4 w = *(const u32x4*)(KVR + (size_t)(m0 + tok) * 2048 + h * 256 + 128 + d16);
            LAS unsigned char* tp = T + (h * 128 + d16) * 80 + 16 * (((tok >> 4) + (h * 8 + (d16 >> 4))) & 3) + (tok & 15);
#pragma unroll
            for (int i = 0; i < 4; ++i) { const unsigned x = w[i]; tp[(4 * i) * 80] = (unsigned char)x; tp[(4 * i + 1) * 80] = (unsigned char)(x >> 8); tp[(4 * i + 2) * 80] = (unsigned char)(x >> 16); tp[(4 * i + 3) * 80] = (unsigned char)(x >> 24); } }
        __syncthreads();
#pragma unroll 4
        for (int k = 0; k < 8; ++k) { const int idx = tid + 512 * k, row = idx >> 2, q = idx & 3;
            const u32x4 v = *(const LAS u32x4*)(T + row * 80 + 16 * ((q + (row >> 4)) & 3));
            *(u32x4*)(VT8 + ((size_t)b * 1024 + row) * SEQ + tok0 + 16 * q) = v; }
        __syncthreads();
    }
}

#ifndef PHMASK
#define PHMASK 0xFFFF
#endif
#ifndef REPMASK
#define REPMASK 0
#endif
#ifndef REPCNT
#define REPCNT 3
#endif
#define NREP(k) ((((REPMASK) >> (k)) & 1) ? (REPCNT) : 1)

#define LAUNDER_S(x) asm volatile("" : "+s"(x))
__device__ __forceinline__ const float* in_ptr(const Args& a, int i) { LAUNDER_S(i); return a.in[i]; }
#define PHASE_BEGIN() unsigned wso_ = 0u; LAUNDER_S(wso_); unsigned char* ws = args.ws + wso_; Frame Fp = F; Fp.vcu = __builtin_amdgcn_readfirstlane(Fp.vcu); Fp.G = __builtin_amdgcn_readfirstlane(Fp.G); LAUNDER_S(Fp.vcu); LAUNDER_S(Fp.G); \
    int bx_ = __builtin_amdgcn_readfirstlane((int)blockIdx.x); LAUNDER_S(bx_); (void)bx_; (void)ws
#define XN  ((unsigned char*)(ws + WS_XN))
#define Z   ((bf16_t*)(ws + WS_Z))
#define MIX ((bf16_t*)(ws + WS_MIX))
#define QR  ((unsigned char*)(ws + WS_QR))
#define KVR ((unsigned char*)(ws + WS_KVR))
#define QF  ((unsigned char*)(ws + WS_QF))
#define KF  ((unsigned char*)(ws + WS_KF))
#define XG  ((unsigned char*)(ws + WS_XG))
#define ACT ((unsigned char*)(ws + WS_ACT))
#define YB  ((bf16_t*)(ws + WS_Y))
#define SSQ ((float*)(ws + WS_SSQ))
#define TOKER ((unsigned*)(ws + WS_TOKER))
#define TOKG ((float*)(ws + WS_TOKG))
#define B1P ((float*)(ws + WS_B1P))
#define IN(i) in_ptr(args, (i))
__global__ void __launch_bounds__(NWAVES * 64, 2) trunk_fwd(Args args) {
    extern __shared__ __attribute__((aligned(16))) unsigned char lds_raw[];
    Frame F;
    F.lds = (LAS unsigned char*)lds_raw;
    F.G = gridDim.x; { const int bx = blockIdx.x; F.vcu = (F.G % 8 == 0) ? (bx % 8) * (F.G / 8) + bx / 8 : bx; }
    for (int u = threadIdx.x; u < (SCR_OFF - LDSCTL_OFF) / 4; u += NWAVES * 64) ((LAS unsigned*)(F.lds + LDSCTL_OFF))[u] = 0u;
    __syncthreads();
    (void)xcd_barrier_post((unsigned*)((gu32*)(args.ws + WS_CTL) + CW_BAR), (volatile LAS unsigned*)(F.lds + MISC_OFF) + 8);
#define GRID_BAR() do { unsigned wsb_ = 0u; LAUNDER_S(wsb_); XcdBarrier bar_; bar_.bar = (unsigned*)((gu32*)(args.ws + wsb_ + WS_CTL) + CW_BAR); bar_.x = xb_xcc_id(); \
        bar_.st = (volatile LAS unsigned*)(F.lds + MISC_OFF) + 8; xcd_barrier(bar_); } while (0)
#define X16 ((bf16_t*)(ws + WS_X16))
    const int stage_limit = args.stage_limit;

#if (PHMASK >> 0) & 1
            _Pragma("unroll") for (int rep_ = 0; rep_ < NREP(0); ++rep_) { if (rep_) GRID_BAR();
    {   PHASE_BEGIN(); const int ptid = threadIdx.x, gw = Fp.vcu * NWAVES + __builtin_amdgcn_readfirstlane(ptid >> 6), NGW = Fp.G * NWAVES;
#ifdef E1F8
        transpose_job_fp8<1>(Fp, IN(I_EWIN), DM, EVEN_IN, 2, (size_t)DM * EVEN_IN, ws + WS_WEIN, (size_t)EVEN_IN * DM);
#else
        transpose_job<1>(Fp, IN(I_EWIN), DM, EVEN_IN, 2, (size_t)DM * EVEN_IN, (bf16_t*)(ws + WS_WEIN), (size_t)EVEN_IN * DM, nullptr, 0);
#endif
        transpose_job<0>(Fp, IN(I_EWOUT), DM, DM, 2, (size_t)DM * DM, (bf16_t*)(ws + WS_WEOUT), (size_t)DM * DM, nullptr, 0);
        transpose_job_fp8<0>(Fp, IN(I_OWIN), DM, ODD_IN, 2, (size_t)DM * ODD_IN, ws + WS_WOIN, (size_t)ODD_INP * DM);
        transpose_job_fp8<0>(Fp, IN(I_OWUQ), 512, 1536, 2, (size_t)512 * 1536, ws + WS_WUQ, (size_t)1536 * 512, IN(I_OGCQ), 512);
        transpose_job_fp8<0>(Fp, IN(I_OWUKV), 256, 2048, 2, (size_t)256 * 2048, ws + WS_WUKV, (size_t)2048 * 256, IN(I_OGCKV), 256);
        transpose_job_fp8<0>(Fp, IN(I_OWOUT), DM, DM, 2, (size_t)DM * DM, ws + WS_WOOUT, (size_t)DM * DM);
        transpose_job_fp8<2>(Fp, IN(I_W1), DM, 2 * DE, DEPTH * NE, (size_t)DM * 2 * DE, ws + WS_W1, (size_t)2 * DE * DM);
        transpose_job_fp8<0>(Fp, IN(I_W2), DE, DM, DEPTH * NE, (size_t)DE * DM, ws + WS_W2, (size_t)DM * DE);
        for (int i = bx_ * 512 + ptid; i < 2 * 12288; i += Fp.G * 512) { const int mi = i / 12288, r = i % 12288;
            *(u32x4*)(ws + WS_WOIN + (size_t)mi * ODD_INP * DM + (size_t)ODD_IN * DM + (size_t)r * 16) = (u32x4){0u, 0u, 0u, 0u}; }
        for (int i = bx_ * 512 + ptid; i < DEPTH * NE * 2048; i += Fp.G * 512) { const int c = i & 2047, o = 2 * (128 * (c >> 8) + (c & 127)) + ((c >> 7) & 1);
            B1P[i] = IN(I_B1)[(size_t)(i & ~2047) + o]; }
#ifdef E1F8
        for (int m = gw; m < M; m += NGW) rms_row_to_fp8(ptid & 63, IN(I_X) + (size_t)m * DM, IN(I_MIXN), XN + (size_t)m * DM, nullptr);
#else
        for (int m = gw; m < M; m += NGW) rms_row_to_bf16(ptid & 63, IN(I_X) + (size_t)m * DM, IN(I_MIXN), (bf16_t*)XN + (size_t)m * DM, nullptr);
#endif
    }
            }
#endif
    GRID_BAR();

#ifdef EXTRA_BARS
    for (int xb_ = 0; xb_ < EXTRA_BARS; ++xb_) GRID_BAR();
#endif
    for (int l = 0; l < DEPTH; ++l) {
        const int li = l >> 1;
        if (2 * l + 1 > stage_limit) break;
        if ((l & 1) == 0) {
#if (PHMASK >> 1) & 1
            _Pragma("unroll") for (int rep_ = 0; rep_ < NREP(1); ++rep_) { if (rep_) GRID_BAR();
#ifdef E1F8
            {   PHASE_BEGIN(); pg8::Gemm g{(const bf16_t*)XN, (const bf16_t*)(ws + WS_WEIN + (size_t)li * EVEN_IN * DM), DM / 2, DM / 2, nullptr, nullptr}; pg8::StaticOrder S; S.init(M, EVEN_IN, Fp.G, bx_);
                pg8::EpiEvenIn E{Z, IN(I_EGQ) + li * 64, IN(I_EGK) + li * 64};
                pg8::gemm_phase<pg8::EpiEvenIn, pg8::StaticOrder, true>(Fp.lds + RING_OFF, g, S, E); }
#else
            {   PHASE_BEGIN(); pg8::Gemm g{(const bf16_t*)XN, (const bf16_t*)(ws + WS_WEIN) + (size_t)li * EVEN_IN * DM, DM, DM, nullptr, nullptr}; pg8::StaticOrder S; S.init(M, EVEN_IN, Fp.G, bx_);
                pg8::EpiEvenIn E{Z, IN(I_EGQ) + li * 64, IN(I_EGK) + li * 64};
                pg8::gemm_phase<pg8::EpiEvenIn, pg8::StaticOrder>(Fp.lds + RING_OFF, g, S, E); }
#endif
            }
#endif
            GRID_BAR();
            {   PHASE_BEGIN();
#if (PHMASK >> 2) & 1
            _Pragma("unroll") for (int rep_ = 0; rep_ < NREP(2); ++rep_) { if (rep_) GRID_BAR();
                for (int u = Fp.vcu; u < 512; u += Fp.G)
                    gmlp_unit(Fp, Z, MIX, IN(I_EWS) + (size_t)li * 4 * 128 * 128, IN(I_EBS) + li * 512, IN(I_EGV) + li * 512, u);
            }
#endif
#if (PHMASK >> 3) & 1
            _Pragma("unroll") for (int rep_ = 0; rep_ < NREP(3); ++rep_) { if (rep_) GRID_BAR();
                for (int u = Fp.vcu; u < 256; u += Fp.G) { const int bh = u >> 4, qb = u & 15, b = bh >> 3, h = bh & 7;
                    const bf16_t* zb = Z + (size_t)b * SEQ * EVEN_IN;
                    dil::unit(zb + 1024 + 64 * h, zb + 1536 + 64 * h, zb + 2048 + 64 * h, EVEN_IN, MIX + (size_t)b * SEQ * DM + 512 + 64 * h, DM, qb * dil::QB, Fp.lds + RING_OFF, (LAS float*)(Fp.lds + SCR_OFF)); }
            }
#endif
            }
            GRID_BAR();
#if (PHMASK >> 4) & 1
            _Pragma("unroll") for (int rep_ = 0; rep_ < NREP(4); ++rep_) { if (rep_) GRID_BAR();
            {   PHASE_BEGIN(); pg8::Gemm g{MIX, (const bf16_t*)(ws + WS_WEOUT) + (size_t)li * DM * DM, DM, DM, nullptr, nullptr}; pg8::StaticOrder S; S.init(M, DM, Fp.G, bx_);
                pg8::EpiResid E{l == 0 ? IN(I_X) : nullptr, X16};
                pg8::gemm_phase<pg8::EpiResid, pg8::StaticOrder>(Fp.lds + RING_OFF, g, S, E); }
            }
#endif
            GRID_BAR();
        } else {
#if (PHMASK >> 5) & 1
            _Pragma("unroll") for (int rep_ = 0; rep_ < NREP(5); ++rep_) { if (rep_) GRID_BAR();
            {   PHASE_BEGIN(); pg8::Gemm g{(const bf16_t*)XN, (const bf16_t*)(ws + WS_WOIN + (size_t)li * ODD_INP * DM), DM / 2, DM / 2, nullptr, nullptr}; pg8::StaticOrder S; S.init(M, ODD_INP, Fp.G, bx_);
                pg8::EpiOddIn E{Z, ws + WS_Z8, SSQ};
                pg8::gemm_phase<pg8::EpiOddIn, pg8::StaticOrder, true>(Fp.lds + RING_OFF, g, S, E); }
            }
#endif
            GRID_BAR();
#if (PHMASK >> 6) & 1
            _Pragma("unroll") for (int rep_ = 0; rep_ < NREP(6); ++rep_) { if (rep_) GRID_BAR();
            {   PHASE_BEGIN(); pg8::Gemm g{(const bf16_t*)(ws + WS_Z8 + 512), (const bf16_t*)(ws + WS_WUKV + (size_t)li * 2048 * 256), ODD_INP / 2, 128, nullptr, nullptr}; pg8::StaticOrder S; S.init(M, 2048, Fp.G, bx_);
                pg8::EpiRowScale<1> E{KVR, 2048, SSQ, 8, 1.0f / 256.0f};
                pg8::gemm_phase<pg8::EpiRowScale<1>, pg8::StaticOrder, true>(Fp.lds + RING_OFF, g, S, E); }
            {   PHASE_BEGIN(); pg8::Gemm g{(const bf16_t*)(ws + WS_Z8), (const bf16_t*)(ws + WS_WUQ + (size_t)li * 1536 * 512), ODD_INP / 2, 256, nullptr, nullptr}; pg8::StaticOrder S; S.init(M, 1536, Fp.G, bx_);
                pg8::EpiRowScale<2> E{QR, 1536, SSQ, 0, 1.0f / 512.0f};
                pg8::gemm_phase<pg8::EpiRowScale<2>, pg8::StaticOrder, true>(Fp.lds + RING_OFF, g, S, E); }
            }
#endif
            GRID_BAR();
#if (PHMASK >> 7) & 1
            _Pragma("unroll") for (int rep_ = 0; rep_ < NREP(7); ++rep_) { if (rep_) GRID_BAR();
            {   PHASE_BEGIN(); mla_finalize_phase(Fp, QR, KVR, Z, IN(I_OGQ) + li * 192, IN(I_OGK) + li * 192, QF, KF); vt_phase(Fp, KVR, ws + WS_VT); }
            }
#endif
            GRID_BAR();
#if (PHMASK >> 8) & 1
            _Pragma("unroll") for (int rep_ = 0; rep_ < NREP(8); ++rep_) { if (rep_) GRID_BAR();
            {   PHASE_BEGIN();
                for (int u = Fp.vcu; u < 256; u += Fp.G) { const int pr = u >> 5, s = u & 15, hh = (u >> 4) & 1;
                    for (int pass = 0; pass < 2; ++pass) { const int bh = 2 * pr + pass, b = bh >> 3, h = bh & 7, qb = (hh ^ pass) ? 31 - s : s;
                        mla::unit(QF + (size_t)b * SEQ * 1536 + 192 * h, KF + (size_t)b * SEQ * 1536 + 192 * h, 1536, ws + WS_VT + ((size_t)(b * 8 + h) * 128) * SEQ,
                                  ws + WS_MIX8 + (size_t)b * SEQ * DM + 128 * h, DM, qb * 256, Fp.lds + RING_OFF); } }
            }
            }
#endif
            GRID_BAR();
#if (PHMASK >> 9) & 1
            _Pragma("unroll") for (int rep_ = 0; rep_ < NREP(9); ++rep_) { if (rep_) GRID_BAR();
            {   PHASE_BEGIN(); pg8::Gemm g{(const bf16_t*)(ws + WS_MIX8), (const bf16_t*)(ws + WS_WOOUT + (size_t)li * DM * DM), DM / 2, DM / 2, nullptr, nullptr}; pg8::StaticOrder S; S.init(M, DM, Fp.G, bx_);
                pg8::EpiResidT<true> E{nullptr, X16};
                pg8::gemm_phase<pg8::EpiResidT<true>, pg8::StaticOrder, true>(Fp.lds + RING_OFF, g, S, E); }
            }
#endif
            GRID_BAR();
        }
        if (2 * l + 2 > stage_limit) break;
#if (PHMASK >> 10) & 1
            _Pragma("unroll") for (int rep_ = 0; rep_ < NREP(10); ++rep_) {
        {   PHASE_BEGIN(); const bool dry = rep_ + 1 < NREP(10);
            gu32* cnt = (gu32*)(ws + WS_CTL) + CW_CNT + (size_t)(dry ? 8 + 4 * rep_ + l : l) * 32 * 64;
        router_phase(Fp, X16, IN(I_FFNN) + l * DM, IN(I_RW) + (size_t)l * DM * NE, IN(I_RB) + l * NE, cnt, dry ? (unsigned*)(ws + WS_QR) : TOKER, dry ? (float*)(ws + WS_QR + MiB) : TOKG, dry ? ACT : XG, dry ? (unsigned*)(ACT + (size_t)64 * MiB) : (unsigned*)(ws + WS_XG + (size_t)64 * MiB)); }
        GRID_BAR();
            }
#endif
        LAS int* tbl = (LAS int*)(F.lds + SCR_OFF + 12288);
        {   PHASE_BEGIN(); gu32* cnt = (gu32*)(ws + WS_CTL) + CW_CNT + (size_t)l * 32 * 64;
        int tt_ = threadIdx.x; asm volatile("" : "+v"(tt_));
        if (tt_ < 32) { const unsigned c = __hip_atomic_load(cnt + 64 * tt_, RLX_AGENT); tbl[NE + 1 + tt_] = (int)((c + 255u) >> 8); }
        __syncthreads();
        if (tt_ == 0) { int acc = 0; for (int e = 0; e < NE; ++e) { tbl[e] = acc; acc += tbl[NE + 1 + e]; } tbl[NE] = acc; }
        __syncthreads(); }
#if (PHMASK >> 11) & 1
            _Pragma("unroll") for (int rep_ = 0; rep_ < NREP(11); ++rep_) { if (rep_) GRID_BAR();
        {   PHASE_BEGIN();
            pg8::Gemm g{(const bf16_t*)XG, (const bf16_t*)(ws + WS_W1 + (size_t)l * NE * 2 * DE * DM), DM / 2, DM / 2, (const bf16_t*)ACT, (const bf16_t*)(ws + WS_W2 + (size_t)l * NE * DM * DE)};
            pg8::MoeMergedOrder S{tbl, Fp.G, Fp.vcu, (gu32*)(ws + WS_CTL) + CW_MOE + (size_t)(l * 320 + 1280 * rep_) * 16, -1, (const unsigned*)(ws + WS_XG + (size_t)64 * MiB), (const LAS unsigned*)(Fp.lds + SCR_OFF + 16384), 0, (const LAS unsigned*)(Fp.lds + SCR_OFF + 18432)};
            pg8::EpiMoe E{{ACT, B1P + (size_t)l * NE * 2048}, {YB, IN(I_B2) + (size_t)l * NE * DM}};
            pg8::gemm_phase<pg8::EpiMoe, pg8::MoeMergedOrder, true>(Fp.lds + RING_OFF, g, S, E); }
            }
#endif
        GRID_BAR();
#if (PHMASK >> 13) & 1
            _Pragma("unroll") for (int rep_ = 0; rep_ < NREP(13); ++rep_) {
        {   PHASE_BEGIN(); const bool dry = rep_ + 1 < NREP(13);
            combine_phase(Fp, dry ? (bf16_t*)(ACT + (size_t)128 * MiB) : X16, (!dry && l + 1 == DEPTH) ? args.out : nullptr, TOKER, TOKG, YB, (l + 1 < DEPTH) ? IN(I_MIXN) + (l + 1) * DM : nullptr, dry ? (ACT + (size_t)64 * MiB) : XN,
#ifdef E1F8
                          true
#else
                          (l & 1) == 0
#endif
                          ); }
        if (rep_ + 1 < NREP(13) || l + 1 < DEPTH) GRID_BAR();
            }
#endif
    }
#undef GRID_BAR
}

extern "C" void kernel_launch(void* const* d_in, const int* in_sizes, int n_in, void* d_out, int out_size, void* d_ws, size_t ws_size, hipStream_t stream) {
    static int grid = 0;
    if (grid == 0) {
        if (n_in != 24 || in_sizes[0] != M * DM || out_size != M * DM || ws_size < WS_END) {
            fprintf(stderr, "kernel_launch: unexpected shapes (n_in %d, in0 %d, out %d, ws %zu, need %zu)\n", n_in, n_in > 0 ? in_sizes[0] : -1, out_size, ws_size, (size_t)WS_END); grid = -1; return; }
        int dev = 0, cus = 0, per_cu = 0;
        if (hipGetDevice(&dev) != hipSuccess || hipDeviceGetAttribute(&cus, hipDeviceAttributeMultiprocessorCount, dev) != hipSuccess) { grid = -1; return; }
        if (hipFuncSetAttribute((const void*)trunk_fwd, hipFuncAttributeMaxDynamicSharedMemorySize, LDS_BYTES) != hipSuccess) { fprintf(stderr, "kernel_launch: hipFuncSetAttribute failed\n"); grid = -1; return; }
        if (hipOccupancyMaxActiveBlocksPerMultiprocessor(&per_cu, (const void*)trunk_fwd, NWAVES * 64, LDS_BYTES) != hipSuccess || per_cu < 1)
            fprintf(stderr, "kernel_launch: occupancy query reports %d workgroups per CU\n", per_cu);
        (void)hipGetLastError();
        if (cus < 256) { fprintf(stderr, "kernel_launch: needs 256 CUs, device has %d\n", cus); grid = -1; return; }
        grid = 256;
    }
    if (grid < 0) return;
    if (hipMemsetAsync((char*)d_ws + WS_CTL, 0, CTL_ZERO_BYTES, stream) != hipSuccess) return;
    Args a{};
    for (int i = 0; i < 24; ++i) a.in[i] = (const float*)d_in[i];
    a.out = (float*)d_out; a.ws = (unsigned char*)d_ws; a.stage_limit = STAGE_LIMIT; a.pad = 0;
    hipLaunchKernelGGL(trunk_fwd, dim3(grid), dim3(NWAVES * 64), LDS_BYTES, stream, a);
}
```
